# Optimizing an MI355X kernel written in HIP

```python
import math
import jax, jax.numpy as jnp
from jax import lax
import numpy as np

D_MODEL = 1024
BATCH = 32
SEQ = 256
DEPTH = 4
DEC_BATCH = 4
DEC_SEQ = 4096
PAST_LEN = 512

GRID_W = 64
N_MIXERS = 3
N_SSD = (DEPTH + 2) // 3
N_HY = (DEPTH + 1) // 3
N_LRU = DEPTH // 3
ALPHA = (2.0 * DEPTH) ** 0.25
BETA = (8.0 * DEPTH) ** -0.25
LN_EPS = 1e-5
RMS_EPS = 1e-5

SSD_INNER = 2 * D_MODEL
SSD_HEADDIM = 64
SSD_HEADS = SSD_INNER // SSD_HEADDIM
SSD_GROUPS = 8
SSD_STATE = 128
SSD_CONV = 4
SSD_CHUNK = 128
SSD_XBC = SSD_INNER + 2 * SSD_GROUPS * SSD_STATE
SSD_PROJ = SSD_INNER + SSD_XBC + 2 * SSD_HEADS

HY_WIDTH = D_MODEL
HY_ORDER = 2
HY_SHORT = 3
HY_BANDS = 16
HY_EMB = 2 * HY_BANDS + 1
HY_FFN = 64
HY_FAST_DECAY = 0.3
HY_SLOW_DECAY = 1.5
HY_TARGET = 1e-2

LRU_WIDTH = D_MODEL
LRU_BLOCKS = 4
LRU_BLOCK = LRU_WIDTH // LRU_BLOCKS
LRU_CONV = 4
LRU_C = 8.0

kernel_name = 'hybrid_ssd_hyena_rglru_diffusion_step'

f32 = jnp.float32


def layer_norm(x, g, b):
    xf = x.astype(f32)
    mu = jnp.mean(xf, -1, keepdims=True)
    var = jnp.mean(jnp.square(xf - mu), -1, keepdims=True)
    return ((xf - mu) * lax.rsqrt(var + LN_EPS) * g + b).astype(x.dtype)


def rms_norm(x, g):
    xf = x.astype(f32)
    return (xf * lax.rsqrt(jnp.mean(xf * xf, -1, keepdims=True) + RMS_EPS) * g).astype(x.dtype)


def dw_conv(x, w, b):
    K = w.shape[0]
    left = (K - 1) // 2
    right = K - 1 - left
    L = x.shape[1]
    xp = jnp.pad(x, ((0, 0), (left, right), (0, 0)))
    out = xp[:, 0:L] * w[0]
    for k in range(1, K):
        out = out + xp[:, k:k + L] * w[k]
    return out + b


def modulation(cond, w, b):
    m = jax.nn.silu(cond) @ w + b
    shift, scale, gate = jnp.split(m, 3, axis=-1)
    return shift[:, None], scale[:, None], gate[:, None]


def to_col_major(x):
    b, L, C = x.shape
    rows = L // GRID_W
    return x.reshape(b, rows, GRID_W, C).transpose(0, 2, 1, 3).reshape(b, L, C)


def from_col_major(x):
    b, L, C = x.shape
    rows = L // GRID_W
    return x.reshape(b, GRID_W, rows, C).transpose(0, 2, 1, 3).reshape(b, L, C)


def flip(t):
    return jnp.flip(t, axis=1)


def ssd_scan(x, dt, A, B, C, h0):
    b, L, H, P = x.shape
    G, N = B.shape[2], B.shape[3]
    Hg = H // G
    Q = SSD_CHUNK
    nc = L // Q
    xc = x.reshape(b, nc, Q, G, Hg, P)
    dtc = dt.reshape(b, nc, Q, G, Hg)
    Bc = B.reshape(b, nc, Q, G, N)
    Cc = C.reshape(b, nc, Q, G, N)
    acum = jnp.cumsum(dtc * A.reshape(G, Hg), axis=2)
    xdt = xc * dtc[..., None]
    seg = acum[:, :, :, None] - acum[:, :, None]
    mask = jnp.tril(jnp.ones((Q, Q), dtype=bool))[:, :, None, None]
    decay = jnp.exp(jnp.where(mask, seg, -jnp.inf))
    scores = jnp.einsum('bcign,bcjgn->bcijg', Cc, Bc)
    y_diag = jnp.einsum('bcijg,bcijgh,bcjghp->bcighp', scores, decay, xdt)
    decay_end = jnp.exp(acum[:, :, -1:] - acum)
    states = jnp.einsum('bcqgn,bcqgh,bcqghp->bcghpn', Bc, decay_end, xdt).astype(f32)
    chunk_decay = jnp.exp(acum[:, :, -1])

    def step(h, inp):
        s, d = inp
        return h * d[..., None, None] + s, h

    h0g = h0.astype(f32).reshape(b, G, Hg, P, N)
    h_last, h_prev = lax.scan(step, h0g, (jnp.swapaxes(states, 0, 1), jnp.swapaxes(chunk_decay, 0, 1)))
    h_prev = jnp.swapaxes(h_prev, 0, 1)
    y_off = jnp.einsum('bcqgn,bcghpn,bcqgh->bcqghp', Cc, h_prev, jnp.exp(acum))
    y = (y_diag + y_off).reshape(b, L, H, P)
    return y, h_last.reshape(b, H, P, N)


def ssd_mixer(h, in_w, conv_w, conv_b, dt_bias, a_log, d_skip, norm_g, out_w, h0_f, h0_b):
    b, L, _ = h.shape
    proj = h @ in_w
    z, xbc, dt_raw = jnp.split(proj, [SSD_INNER, SSD_INNER + SSD_XBC], axis=-1)
    xbc = jax.nn.silu(dw_conv(xbc, conv_w, conv_b))
    xs, Bm, Cm = jnp.split(xbc, [SSD_INNER, SSD_INNER + SSD_GROUPS * SSD_STATE], axis=-1)
    xs = xs.reshape(b, L, SSD_HEADS, SSD_HEADDIM)
    Bm = Bm.reshape(b, L, SSD_GROUPS, SSD_STATE)
    Cm = Cm.reshape(b, L, SSD_GROUPS, SSD_STATE)
    dt = jax.nn.softplus(dt_raw.astype(f32).reshape(b, L, 2, SSD_HEADS) + dt_bias.astype(f32))
    A = -jnp.exp(a_log.astype(f32))
    y_f, hf = ssd_scan(xs, dt[:, :, 0], A[0], Bm, Cm, h0_f)
    y_b, hb = ssd_scan(flip(xs), flip(dt[:, :, 1]), A[1], flip(Bm), flip(Cm), h0_b)
    y = y_f + flip(y_b) + xs * d_skip[:, None]
    y = y.reshape(b, L, SSD_INNER) * jax.nn.silu(z)
    y = rms_norm(y, norm_g)
    return (y @ out_w).astype(h.dtype), hf, hb


def hyena_filters(L, f_w1, f_b1, f_w2, f_b2, f_w3, f_freq):
    t = jnp.arange(L, dtype=f32) / L
    w = 2.0 * math.pi * jnp.arange(L, dtype=f32) / L
    fr = jnp.linspace(1e-4, HY_BANDS - 1, HY_BANDS, dtype=f32)
    ang = w[:, None] * fr
    z = jnp.concatenate([t[:, None], jnp.cos(ang), jnp.sin(ang)], axis=-1)
    hdn = jnp.sin(f_freq[0] * (z @ f_w1 + f_b1))
    hdn = jnp.sin(f_freq[1] * (hdn @ f_w2 + f_b2))
    k = (hdn @ f_w3).reshape(L, HY_ORDER, 2, HY_WIDTH)
    max_decay = math.log(HY_TARGET) / HY_FAST_DECAY
    min_decay = math.log(HY_TARGET) / HY_SLOW_DECAY
    deltas = jnp.linspace(min_decay, max_decay, HY_WIDTH, dtype=f32)
    window = jnp.exp(-t[:, None] * jnp.abs(deltas))
    k = k * window[:, None, None, :]
    return k / jnp.sum(jnp.abs(k), axis=(0, 2), keepdims=True)


def long_conv_bidir(u, k_fwd, k_bwd, bias):
    L = u.shape[1]
    n = 2 * L
    k_full = jnp.concatenate([k_fwd, jnp.zeros_like(k_fwd[:1]), jnp.flip(k_bwd[1:], axis=0)], axis=0)
    uf = jnp.fft.rfft(u.astype(f32), n=n, axis=1)
    kf = jnp.fft.rfft(k_full.astype(f32), n=n, axis=0)
    y = jnp.fft.irfft(uf * kf[None], n=n, axis=1)[:, :L]
    return (y + u * bias).astype(u.dtype)


def hyena_mixer(h, in_w, conv_w, conv_b, f_w1, f_b1, f_w2, f_b2, f_w3, f_freq, f_bias, out_w):
    L = h.shape[1]
    proj = h @ in_w
    vx, z = jnp.split(proj, [3 * HY_WIDTH], axis=-1)
    vx = dw_conv(vx, conv_w, conv_b)
    v, x1, x2 = jnp.split(vx, 3, axis=-1)
    k = hyena_filters(L, f_w1, f_b1, f_w2, f_b2, f_w3, f_freq)
    u = v
    for o, g in enumerate((x1, x2)):
        u = g * long_conv_bidir(u, k[:, o, 0], k[:, o, 1], f_bias[o])
    y = u * jax.nn.silu(z)
    return (y @ out_w).astype(h.dtype)


def linear_scan(a, bx, h0):
    def combine(l, r):
        a_l, b_l = l
        a_r, b_r = r
        return a_l * a_r, a_r * b_l + b_r
    a_cum, b_cum = lax.associative_scan(combine, (a, bx), axis=1)
    hs = a_cum * h0.astype(f32)[:, None] + b_cum
    return hs, hs[:, -1]


def rglru_mixer(h, in_w, conv_w, conv_b, gate_w, gate_b, a_param, out_w, h0_f, h0_b):
    b, L, _ = h.shape
    xr, z = jnp.split(h @ in_w, 2, axis=-1)
    xr = dw_conv(xr, conv_w, conv_b)
    xblk = xr.reshape(b, L, LRU_BLOCKS, LRU_BLOCK)
    gates = jnp.einsum('blnk,dgnkj->dgblnj', xblk, gate_w).reshape(2, 2, b, L, LRU_WIDTH)
    gates = jax.nn.sigmoid((gates + gate_b[:, :, None, None, :]).astype(f32))
    r, i = gates[:, 0], gates[:, 1]
    log_a = -LRU_C * r * jax.nn.softplus(-a_param.astype(f32))[:, None, None]
    a = jnp.exp(log_a)
    mult = jnp.sqrt(jnp.maximum(-jnp.expm1(2.0 * log_a), 0.0))
    bx = mult * i * xr.astype(f32)[None]
    y_f, hf = linear_scan(a[0], bx[0], h0_f)
    y_b, hb = linear_scan(flip(a[1]), flip(bx[1]), h0_b)
    y = (y_f + flip(y_b)) * jax.nn.silu(z)
    return (y @ out_w).astype(h.dtype), hf, hb


def setup_inputs(seed: int = 0) -> dict:
    key = jax.random.key(seed)
    ks = iter(jax.random.split(key, 48))

    def nrm(shape, scale):
        return jax.random.normal(next(ks), shape, f32) * scale

    def gain(shape):
        return 1.0 + nrm(shape, 0.02)

    D = D_MODEL
    dt0 = jnp.exp(jax.random.uniform(next(ks), (N_SSD, 2, SSD_HEADS), f32, math.log(1e-3), math.log(1e-1)))
    a0 = jax.random.uniform(next(ks), (N_LRU, 2, LRU_WIDTH), f32, 0.9, 0.999)
    return {
        'x_prompt': nrm((BATCH, SEQ, D), 1.0),
        'x_sample': nrm((DEC_BATCH, DEC_SEQ, D), 1.0),
        'state_ssd': nrm((DEC_BATCH, N_SSD, 2, SSD_HEADS, SSD_HEADDIM, SSD_STATE), 0.5),
        'state_lru': nrm((DEC_BATCH, N_LRU, 2, LRU_WIDTH), 0.5),
        'c': nrm((DEC_BATCH, D), 1.0),
        'c_ctx': nrm((D,), 1.0),
        'mod_w': nrm((DEPTH, D, 3 * D), 0.3 * D ** -0.5),
        'mod_b': nrm((DEPTH, 3 * D), 0.02),
        'ln_g': gain((DEPTH, D)),
        'ln_b': nrm((DEPTH, D), 0.02),
        'ssd_in_w': nrm((N_SSD, D, SSD_PROJ), D ** -0.5),
        'ssd_conv_w': nrm((N_SSD, SSD_CONV, SSD_XBC), SSD_CONV ** -0.5),
        'ssd_conv_b': nrm((N_SSD, SSD_XBC), 0.02),
        'ssd_dt_bias': dt0 + jnp.log(-jnp.expm1(-dt0)),
        'ssd_a_log': jnp.log(jax.random.uniform(next(ks), (N_SSD, 2, SSD_HEADS), f32, 1.0, 16.0)),
        'ssd_d': gain((N_SSD, SSD_HEADS)),
        'ssd_norm_g': gain((N_SSD, SSD_INNER)),
        'ssd_out_w': nrm((N_SSD, SSD_INNER, D), BETA * SSD_INNER ** -0.5),
        'hy_in_w': nrm((N_HY, D, 4 * HY_WIDTH), D ** -0.5),
        'hy_conv_w': nrm((N_HY, HY_SHORT, 3 * HY_WIDTH), HY_SHORT ** -0.5),
        'hy_conv_b': nrm((N_HY, 3 * HY_WIDTH), 0.02),
        'hy_f_w1': nrm((N_HY, HY_EMB, HY_FFN), HY_EMB ** -0.5),
        'hy_f_b1': nrm((N_HY, HY_FFN), 0.02),
        'hy_f_w2': nrm((N_HY, HY_FFN, HY_FFN), HY_FFN ** -0.5),
        'hy_f_b2': nrm((N_HY, HY_FFN), 0.02),
        'hy_f_w3': nrm((N_HY, HY_FFN, HY_ORDER * 2 * HY_WIDTH), HY_FFN ** -0.5),
        'hy_f_freq': gain((N_HY, 2, HY_FFN)),
        'hy_f_bias': nrm((N_HY, HY_ORDER, HY_WIDTH), 0.5),
        'hy_out_w': nrm((N_HY, HY_WIDTH, D), BETA * HY_WIDTH ** -0.5),
        'lru_in_w': nrm((N_LRU, D, 2 * LRU_WIDTH), D ** -0.5),
        'lru_conv_w': nrm((N_LRU, LRU_CONV, LRU_WIDTH), LRU_CONV ** -0.5),
        'lru_conv_b': nrm((N_LRU, LRU_WIDTH), 0.02),
        'lru_gate_w': nrm((N_LRU, 2, 2, LRU_BLOCKS, LRU_BLOCK, LRU_BLOCK), LRU_BLOCK ** -0.5),
        'lru_gate_b': nrm((N_LRU, 2, 2, LRU_WIDTH), 0.02),
        'lru_a_param': jnp.log(a0) - jnp.log1p(-a0),
        'lru_out_w': nrm((N_LRU, LRU_WIDTH, D), BETA * LRU_WIDTH ** -0.5),
    }


def reference(x_prompt, x_sample, state_ssd, state_lru, c, c_ctx, mod_w, mod_b, ln_g, ln_b,
              ssd_in_w, ssd_conv_w, ssd_conv_b, ssd_dt_bias, ssd_a_log, ssd_d, ssd_norm_g, ssd_out_w,
              hy_in_w, hy_conv_w, hy_conv_b, hy_f_w1, hy_f_b1, hy_f_w2, hy_f_b2, hy_f_w3, hy_f_freq,
              hy_f_bias, hy_out_w,
              lru_in_w, lru_conv_w, lru_conv_b, lru_gate_w, lru_gate_b, lru_a_param, lru_out_w):

    def run_trunk(x, cond, h0_ssd, h0_lru, latent):
        b = x.shape[0]
        ssd_fin, lru_fin = [], []
        for i in range(DEPTH):
            kind, slot = i % N_MIXERS, i // N_MIXERS
            col = latent and (slot % 2 == 1)
            shift, scale, gate = modulation(cond, mod_w[i], mod_b[i])
            h = x * (1.0 + scale) + shift
            if col:
                h = to_col_major(h)
            if kind == 0:
                if h0_ssd is None:
                    z0 = jnp.zeros((b, SSD_HEADS, SSD_HEADDIM, SSD_STATE), f32)
                    hf0, hb0 = z0, z0
                else:
                    hf0, hb0 = h0_ssd[:, slot, 0], h0_ssd[:, slot, 1]
                out, hf, hb = ssd_mixer(h, ssd_in_w[slot], ssd_conv_w[slot], ssd_conv_b[slot],
                                        ssd_dt_bias[slot], ssd_a_log[slot], ssd_d[slot],
                                        ssd_norm_g[slot], ssd_out_w[slot], hf0, hb0)
                ssd_fin.append(jnp.stack([hf, hb], axis=1))
            elif kind == 1:
                out = hyena_mixer(h, hy_in_w[slot], hy_conv_w[slot], hy_conv_b[slot],
                                  hy_f_w1[slot], hy_f_b1[slot], hy_f_w2[slot], hy_f_b2[slot],
                                  hy_f_w3[slot], hy_f_freq[slot], hy_f_bias[slot], hy_out_w[slot])
            else:
                if h0_lru is None:
                    z0 = jnp.zeros((b, LRU_WIDTH), f32)
                    hf0, hb0 = z0, z0
                else:
                    hf0, hb0 = h0_lru[:, slot, 0], h0_lru[:, slot, 1]
                out, hf, hb = rglru_mixer(h, lru_in_w[slot], lru_conv_w[slot], lru_conv_b[slot],
                                          lru_gate_w[slot], lru_gate_b[slot], lru_a_param[slot],
                                          lru_out_w[slot], hf0, hb0)
                lru_fin.append(jnp.stack([hf, hb], axis=1))
            if col:
                out = from_col_major(out)
            x = layer_norm(ALPHA * x + gate * out, ln_g[i], ln_b[i])
        return x, ssd_fin, lru_fin

    y_prompt, ssd_fin, lru_fin = run_trunk(x_prompt, c_ctx[None], None, None, False)
    new_state_ssd = jnp.stack(ssd_fin, axis=1).astype(x_prompt.dtype)
    new_state_lru = jnp.stack(lru_fin, axis=1).astype(x_prompt.dtype)

    y_sample, _, _ = run_trunk(x_sample, c, state_ssd, state_lru, True)

    return (y_prompt, y_sample, new_state_ssd, new_state_lru)
```

```cpp
#include <hip/hip_runtime.h>
#include <hip/hip_bf16.h>
#include <stdint.h>

typedef unsigned short bf16_t;
typedef __attribute__((ext_vector_type(8))) short bf16x8;
typedef __attribute__((ext_vector_type(16))) float f32x16;
typedef __attribute__((ext_vector_type(4))) unsigned int u32x4;
typedef __attribute__((ext_vector_type(2))) unsigned int u32x2;
typedef __attribute__((ext_vector_type(4))) float f32x4;

#define T_CTX 8192
#define T_ALL 24576
#define DM 1024
#define NTHR 256
#define SMEM_BYTES 65536
#define ALPHA_RES 1.6817928305074290f
#define LN_EPS 1e-5f

__device__ __forceinline__ bf16_t f2bf(float f) {
  unsigned u = __float_as_uint(f);
  u += 0x7fffu + ((u >> 16) & 1u);
  return (bf16_t)(u >> 16);
}
__device__ __forceinline__ float bf2f(bf16_t b) { return __uint_as_float(((unsigned)b) << 16); }
__device__ __forceinline__ float bflo(unsigned w) { return __uint_as_float(w << 16); }
__device__ __forceinline__ float bfhi(unsigned w) { return __uint_as_float(w & 0xffff0000u); }
__device__ __forceinline__ unsigned pack2(float a, float b) { return (unsigned)f2bf(a) | ((unsigned)f2bf(b) << 16); }
__device__ __forceinline__ float siluf(float x) { return x / (1.f + __expf(-x)); }
__device__ __forceinline__ float sigmoidf(float x) { return 1.f / (1.f + __expf(-x)); }
__device__ __forceinline__ float softplusf(float x) { return x > 20.f ? x : log1pf(expf(x)); }

struct TokInfo { int s, l, L, base, mrow; };
__device__ __forceinline__ TokInfo tokinfo(int tok) {
  TokInfo t;
  if (tok < T_CTX) { t.s = tok >> 8; t.l = tok & 255; t.L = 256; t.base = tok & ~255; t.mrow = 0; }
  else { int u = tok - T_CTX; t.s = 32 + (u >> 12); t.l = u & 4095; t.L = 4096; t.base = T_CTX + (u & ~4095); t.mrow = 1 + (u >> 12); }
  return t;
}
__device__ __forceinline__ int seqpos2off(int pos, bool cm) { return cm ? (((pos & 63) << 6) | (pos >> 6)) : pos; }

struct Params {
  const float *x_prompt, *x_sample, *state_ssd, *state_lru, *c, *c_ctx, *mod_w, *mod_b, *ln_g, *ln_b;
  const float *ssd_in_w, *ssd_conv_w, *ssd_conv_b, *ssd_dt_bias, *ssd_a_log, *ssd_d, *ssd_norm_g, *ssd_out_w;
  const float *hy_in_w, *hy_conv_w, *hy_conv_b, *hy_f_w1, *hy_f_b1, *hy_f_w2, *hy_f_b2, *hy_f_w3, *hy_f_freq, *hy_f_bias, *hy_out_w;
  const float *lru_in_w, *lru_conv_w, *lru_conv_b, *lru_gate_w, *lru_gate_b, *lru_a_param, *lru_out_w;
  float *xres, *out_ssd, *out_lru;
  bf16_t *wt_ssd_in, *wt_ssd_out, *wt_hy_in, *wt_hy_out, *wt_lru_in, *wt_lru_out, *wt_lru_gate;
  float *modv;
  float *hdn2;
  float *ktab0;
  float *ktab1;
  float *knorm;
  bf16_t *hbuf;
  float *rstd;
  float *lru_agg;
  float *lru_hin;
  unsigned char *scratch;
};

#define SC_SSD_Z     ((size_t)0)
#define SC_SSD_XBC   ((size_t)T_ALL * 2048 * 2)
#define SC_SSD_XBCC  (SC_SSD_XBC + (size_t)T_ALL * 4096 * 2)
#define SC_SSD_DT    (SC_SSD_XBCC + (size_t)T_ALL * 4096 * 2)
#define SC_SSD_END   (SC_SSD_DT + (size_t)T_ALL * 64 * 4)
#define SC_HY_PROJ   ((size_t)0)
#define SC_HY_VXC    ((size_t)T_ALL * 4096 * 2)
#define SC_HY_U1     (SC_HY_VXC + (size_t)T_ALL * 3072 * 2)
#define SC_HY_YG     (SC_HY_U1 + (size_t)T_ALL * 1024 * 2)
#define SC_LRU_PROJ  ((size_t)0)
#define SC_LRU_XC    ((size_t)T_ALL * 2048 * 2)
#define SC_LRU_GATES (SC_LRU_XC + (size_t)T_ALL * 1024 * 2)
#define SC_LRU_Y     (SC_LRU_GATES + (size_t)T_ALL * 4096 * 2)
#define SC_LRU_YG    (SC_LRU_Y + (size_t)T_ALL * 2048 * 2)
#define SC_TOTAL     SC_SSD_END

__device__ __forceinline__ void transpose_tile(const float* __restrict__ src, int ld_src, int n_src, bf16_t* __restrict__ dst, int K,
                               const float* __restrict__ scale, int tile, int tiles_k, float* tl) {
  int tk = tile % tiles_k, tn = tile / tiles_k;
  int k0 = tk * 64, n0 = tn * 64;
  int tx = threadIdx.x & 63, ty = threadIdx.x >> 6;
  __syncthreads();
  for (int r = ty; r < 64; r += 4) {
    int n = n0 + tx;
    float v = 0.f;
    if (n < n_src) { v = src[(size_t)(k0 + r) * ld_src + n]; if (scale) v *= scale[k0 + r]; }
    tl[r * 65 + tx] = v;
  }
  __syncthreads();
  for (int r = ty; r < 64; r += 4) dst[(size_t)(n0 + r) * K + k0 + tx] = f2bf(tl[tx * 65 + r]);
}

__device__ __forceinline__ void phase_prep(const Params& p, int bid, int nblk, unsigned char* smem) {
  float* tl = (float*)smem;
  for (int job = 0; job < 24; ++job) {
    const float* src; int ld, nsrc, K, npad; bf16_t* dst; const float* scale = nullptr;
    if (job < 2) { src = p.ssd_in_w + (size_t)job * 1024 * 6208; ld = 6208; nsrc = 6208; K = 1024; npad = 6272; dst = p.wt_ssd_in + (size_t)job * 6272 * 1024; }
    else if (job < 4) { int s = job - 2; src = p.ssd_out_w + (size_t)s * 2048 * 1024; ld = 1024; nsrc = 1024; K = 2048; npad = 1024; dst = p.wt_ssd_out + (size_t)s * 1024 * 2048; scale = p.ssd_norm_g + s * 2048; }
    else if (job == 4) { src = p.hy_in_w; ld = 4096; nsrc = 4096; K = 1024; npad = 4096; dst = p.wt_hy_in; }
    else if (job == 5) { src = p.hy_out_w; ld = 1024; nsrc = 1024; K = 1024; npad = 1024; dst = p.wt_hy_out; }
    else if (job == 6) { src = p.lru_in_w; ld = 2048; nsrc = 2048; K = 1024; npad = 2048; dst = p.wt_lru_in; }
    else if (job == 7) { src = p.lru_out_w; ld = 1024; nsrc = 1024; K = 1024; npad = 1024; dst = p.wt_lru_out; }
    else { int q = job - 8; int dg = q >> 2, n = q & 3;
      src = p.lru_gate_w + (size_t)(dg * 4 + n) * 65536; ld = 256; nsrc = 256; K = 256; npad = 256;
      dst = p.wt_lru_gate + (size_t)n * 1024 * 256 + (size_t)dg * 256 * 256; }
    int tiles_k = K / 64, tiles = tiles_k * (npad / 64);
    for (int t = bid; t < tiles; t += nblk) transpose_tile(src, ld, nsrc, dst, K, scale, t, tiles_k, tl);
  }
  for (int i = bid * NTHR + threadIdx.x; i < 2 * 2 * 1024; i += nblk * NTHR) p.knorm[i] = 0.f;
}

__device__ __forceinline__ void phase_mod(const Params& p, int bid, int nblk, unsigned char* smem) {
  float* sc = (float*)smem;
  __syncthreads();
  for (int i = threadIdx.x; i < 5 * 1024; i += NTHR) {
    int r = i >> 10, k = i & 1023;
    float v = (r == 0) ? p.c_ctx[k] : p.c[(r - 1) * 1024 + k];
    sc[i] = siluf(v);
  }
  __syncthreads();
  for (int item = bid; item < 4 * 12; item += nblk) {
    int layer = item / 12, j = (item % 12) * 256 + threadIdx.x;
    const float* w = p.mod_w + (size_t)layer * 1024 * 3072 + j;
    float a0 = 0, a1 = 0, a2 = 0, a3 = 0, a4 = 0;
    for (int k = 0; k < 1024; ++k) {
      float wv = w[(size_t)k * 3072];
      a0 += sc[k] * wv; a1 += sc[1024 + k] * wv; a2 += sc[2048 + k] * wv; a3 += sc[3072 + k] * wv; a4 += sc[4096 + k] * wv;
    }
    float b = p.mod_b[layer * 3072 + j];
    float* o = p.modv + (size_t)layer * 5 * 3072 + j;
    o[0] = a0 + b; o[3072] = a1 + b; o[2 * 3072] = a2 + b; o[3 * 3072] = a3 + b; o[4 * 3072] = a4 + b;
  }
}

__device__ __forceinline__ void phase_hyfilt_a(const Params& p, int bid, int nblk, unsigned char* smem) {
  float* sz = (float*)smem;
  float* sh = sz + 4 * 36;
  int pl = threadIdx.x >> 6, m = threadIdx.x & 63;
  for (int item = bid; item < 4352 / 4; item += nblk) {
    int pos = item * 4 + pl;
    int L = pos < 256 ? 256 : 4096;
    int l = pos < 256 ? pos : pos - 256;
    __syncthreads();
    if (m < 33) {
      float t = (float)l / (float)L;
      float w = (6.283185307179586f * (float)l) / (float)L;
      float v;
      if (m == 0) v = t;
      else {
        int j = (m - 1) & 15;
        float fr = 1e-4f + (float)j * ((15.f - 1e-4f) / 15.f);
        float ang = w * fr;
        v = (m <= 16) ? cosf(ang) : sinf(ang);
      }
      sz[pl * 36 + m] = v;
    }
    __syncthreads();
    float a = p.hy_f_b1[m];
    for (int e = 0; e < 33; ++e) a += sz[pl * 36 + e] * p.hy_f_w1[e * 64 + m];
    a = sinf(p.hy_f_freq[m] * a);
    sh[pl * 64 + m] = a;
    __syncthreads();
    float b = p.hy_f_b2[m];
    for (int e = 0; e < 64; ++e) b += sh[pl * 64 + e] * p.hy_f_w2[e * 64 + m];
    b = sinf(p.hy_f_freq[64 + m] * b);
    p.hdn2[(size_t)pos * 64 + m] = b;
  }
}

__device__ __forceinline__ void phase_hyfilt_b(const Params& p, int bid, int nblk, unsigned char* smem) {
  float* sh = (float*)smem;
  const int items0 = 8 * 16, items1 = 128 * 16;
  for (int item = bid; item < items0 + items1; item += nblk) {
    int Lsel = item < items0 ? 0 : 1;
    int it = Lsel ? item - items0 : item;
    int L = Lsel ? 4096 : 256;
    int lc = it >> 4, o = (it >> 3) & 1, d = (it >> 2) & 1, cb = it & 3;
    int c = cb * 256 + threadIdx.x;
    int posbase = (Lsel ? 256 : 0) + lc * 32;
    __syncthreads();
    for (int i = threadIdx.x; i < 32 * 64; i += NTHR) sh[i] = p.hdn2[(size_t)posbase * 64 + i];
    __syncthreads();
    float w3[64];
#pragma unroll
    for (int m = 0; m < 64; ++m) w3[m] = p.hy_f_w3[(size_t)m * 4096 + o * 2048 + d * 1024 + c];
    const float min_decay = -3.0701134573253945f, max_decay = -15.350567286626973f;
    float delta = fabsf(min_decay + (float)c * ((max_decay - min_decay) / 1023.f));
    float* kt = (Lsel ? p.ktab1 : p.ktab0) + (size_t)o * 2 * L * 1024;
    float asum = 0.f;
    for (int li = 0; li < 32; ++li) {
      int l = lc * 32 + li;
      float acc = 0.f;
#pragma unroll
      for (int m = 0; m < 64; ++m) acc += sh[li * 64 + m] * w3[m];
      float t = (float)l / (float)L;
      float kv = acc * expf(-t * delta);
      asum += fabsf(kv);
      if (d == 0) kt[(size_t)(L + l) * 1024 + c] = kv;
      else if (l > 0) kt[(size_t)(L - l) * 1024 + c] = kv;
      if (d == 1 && l == 0) kt[c] = 0.f;
    }
    atomicAdd(&p.knorm[(Lsel * 2 + o) * 1024 + c], asum);
  }
}

__device__ __forceinline__ void phase_lnmod(const Params& p, int layer, int bid, int nblk) {
  int lane = threadIdx.x & 63, wv = threadIdx.x >> 6;
  for (int row = bid * 4 + wv; row < T_ALL; row += nblk * 4) {
    const float* src = (layer == 0) ? (row < T_CTX ? p.x_prompt + (size_t)row * DM : p.x_sample + (size_t)(row - T_CTX) * DM)
                                    : p.xres + (size_t)row * DM;
    f32x4 v[4];
#pragma unroll
    for (int j = 0; j < 4; ++j) v[j] = *(const f32x4*)(src + j * 256 + lane * 4);
    if (layer > 0) {
      float s = 0.f;
#pragma unroll
      for (int j = 0; j < 4; ++j) s += v[j].x + v[j].y + v[j].z + v[j].w;
#pragma unroll
      for (int o = 32; o > 0; o >>= 1) s += __shfl_xor(s, o);
      float mu = s * (1.f / 1024.f);
      float q = 0.f;
#pragma unroll
      for (int j = 0; j < 4; ++j) { float a = v[j].x - mu, b = v[j].y - mu, c = v[j].z - mu, d = v[j].w - mu; q += a * a + b * b + c * c + d * d; }
#pragma unroll
      for (int o = 32; o > 0; o >>= 1) q += __shfl_xor(q, o);
      float rs = rsqrtf(q * (1.f / 1024.f) + LN_EPS);
      const float* g = p.ln_g + (layer - 1) * DM; const float* b = p.ln_b + (layer - 1) * DM;
#pragma unroll
      for (int j = 0; j < 4; ++j) {
        f32x4 gg = *(const f32x4*)(g + j * 256 + lane * 4), bb = *(const f32x4*)(b + j * 256 + lane * 4);
        v[j].x = (v[j].x - mu) * rs * gg.x + bb.x; v[j].y = (v[j].y - mu) * rs * gg.y + bb.y;
        v[j].z = (v[j].z - mu) * rs * gg.z + bb.z; v[j].w = (v[j].w - mu) * rs * gg.w + bb.w;
      }
    }
    float* dst = p.xres + (size_t)row * DM;
#pragma unroll
    for (int j = 0; j < 4; ++j) *(f32x4*)(dst + j * 256 + lane * 4) = v[j];
    if (layer < 4) {
      int mrow = row < T_CTX ? 0 : 1 + ((row - T_CTX) >> 12);
      const float* mv = p.modv + ((size_t)layer * 5 + mrow) * 3072;
#pragma unroll
      for (int j = 0; j < 4; ++j) {
        f32x4 sh = *(const f32x4*)(mv + j * 256 + lane * 4), sc = *(const f32x4*)(mv + 1024 + j * 256 + lane * 4);
        u32x2 o;
        o.x = pack2(v[j].x * (1.f + sc.x) + sh.x, v[j].y * (1.f + sc.y) + sh.y);
        o.y = pack2(v[j].z * (1.f + sc.z) + sh.z, v[j].w * (1.f + sc.w) + sh.w);
        *(u32x2*)(p.hbuf + (size_t)row * DM + j * 256 + lane * 4) = o;
      }
    }
  }
}

#define G_LDS_STRIDE 72
template <class Epi>
__device__ __forceinline__ void gemm_phase(const bf16_t* __restrict__ A, int lda, const bf16_t* __restrict__ Wt, int K, int Mtiles, int Ntiles,
                           Epi epi, int bid, int nblk, unsigned char* smem) {
  bf16_t* sA = (bf16_t*)smem;
  bf16_t* sB = sA + 128 * G_LDS_STRIDE;
  const int tid = threadIdx.x, lane = tid & 63, w = tid >> 6;
  const int wm = w >> 1, wn = w & 1, r = lane & 31, hh = lane >> 5;
  const int nk = K / 64;
  for (int tile = bid; tile < Mtiles * Ntiles; tile += nblk) {
    const int tm = tile / Ntiles, tn = tile % Ntiles;
    const int m0 = tm * 128, n0 = tn * 128;
    f32x16 acc[2][2];
#pragma unroll
    for (int i = 0; i < 2; ++i)
#pragma unroll
      for (int j = 0; j < 2; ++j)
#pragma unroll
        for (int e = 0; e < 16; ++e) acc[i][j][e] = 0.f;
    u32x4 ra[4], rb[4];
#pragma unroll
    for (int i = 0; i < 4; ++i) {
      int q = tid + i * 256, row = q >> 3, c8 = (q & 7) * 8;
      ra[i] = *(const u32x4*)(A + (size_t)(m0 + row) * lda + c8);
      rb[i] = *(const u32x4*)(Wt + (size_t)(n0 + row) * K + c8);
    }
    for (int kt = 0; kt < nk; ++kt) {
      __syncthreads();
#pragma unroll
      for (int i = 0; i < 4; ++i) {
        int q = tid + i * 256, row = q >> 3, c8 = (q & 7) * 8;
        *(u32x4*)(sA + row * G_LDS_STRIDE + c8) = ra[i];
        *(u32x4*)(sB + row * G_LDS_STRIDE + c8) = rb[i];
      }
      __syncthreads();
      if (kt + 1 < nk) {
#pragma unroll
        for (int i = 0; i < 4; ++i) {
          int q = tid + i * 256, row = q >> 3, c8 = (q & 7) * 8;
          ra[i] = *(const u32x4*)(A + (size_t)(m0 + row) * lda + (kt + 1) * 64 + c8);
          rb[i] = *(const u32x4*)(Wt + (size_t)(n0 + row) * K + (kt + 1) * 64 + c8);
        }
      }
#pragma unroll
      for (int kk = 0; kk < 4; ++kk) {
        bf16x8 fa[2], fb[2];
#pragma unroll
        for (int i = 0; i < 2; ++i) fa[i] = *(const bf16x8*)(sA + (wm * 64 + i * 32 + r) * G_LDS_STRIDE + kk * 16 + hh * 8);
#pragma unroll
        for (int j = 0; j < 2; ++j) fb[j] = *(const bf16x8*)(sB + (wn * 64 + j * 32 + r) * G_LDS_STRIDE + kk * 16 + hh * 8);
#pragma unroll
        for (int i = 0; i < 2; ++i)
#pragma unroll
          for (int j = 0; j < 2; ++j) acc[i][j] = __builtin_amdgcn_mfma_f32_32x32x16_bf16(fa[i], fb[j], acc[i][j], 0, 0, 0);
      }
    }
#pragma unroll
    for (int i = 0; i < 2; ++i)
#pragma unroll
      for (int j = 0; j < 2; ++j)
#pragma unroll
        for (int e = 0; e < 16; ++e) {
          int row = m0 + wm * 64 + i * 32 + (e & 3) + 8 * (e >> 2) + 4 * hh;
          int col = n0 + wn * 64 + j * 32 + r;
          epi(row, col, acc[i][j][e]);
        }
  }
}

struct EpiBf16 {
  bf16_t* C; int ldc;
  __device__ __forceinline__ void operator()(int row, int col, float v) const { C[(size_t)row * ldc + col] = f2bf(v); }
};
struct EpiSsdIn {
  bf16_t* z; bf16_t* xbc; float* dt; const float* dt_bias;
  __device__ __forceinline__ void operator()(int row, int col, float v) const {
    if (col < 2048) z[(size_t)row * 2048 + col] = f2bf(v);
    else if (col < 6144) xbc[(size_t)row * 4096 + (col - 2048)] = f2bf(v);
    else if (col < 6208) dt[(size_t)row * 64 + (col - 6144)] = softplusf(v + dt_bias[col - 6144]);
  }
};
struct EpiOut {
  float* xres; const float* modv_layer; const float* rstd;
  __device__ __forceinline__ void operator()(int row, int col, float v) const {
    int mrow = row < T_CTX ? 0 : 1 + ((row - T_CTX) >> 12);
    float g = modv_layer[(size_t)mrow * 3072 + 2048 + col];
    float rs = rstd ? rstd[row] : 1.f;
    size_t idx = (size_t)row * DM + col;
    xres[idx] = ALPHA_RES * xres[idx] + g * (v * rs);
  }
};
struct EpiLruGate {
  bf16_t* gates; const float* gate_b; int nb;
  __device__ __forceinline__ void operator()(int row, int col, float v) const {
    int dg = col >> 8, ch = nb * 256 + (col & 255);
    float pre = v + gate_b[dg * 1024 + ch];
    gates[((size_t)dg * T_ALL + row) * 1024 + ch] = f2bf(sigmoidf(pre));
  }
};

template <int KW, bool SILU>
__device__ __forceinline__ void phase_dwconv(const bf16_t* __restrict__ src, int ld_src, bf16_t* __restrict__ dst, int ld_dst, int CH,
                             const float* __restrict__ w, const float* __restrict__ b, bool colmajor, int bid, int nblk) {
  const int cpr = CH / 8;
  const size_t total = (size_t)T_ALL * cpr;
  for (size_t idx = (size_t)bid * NTHR + threadIdx.x; idx < total; idx += (size_t)nblk * NTHR) {
    int tok = (int)(idx / cpr), c0 = (int)(idx % cpr) * 8;
    TokInfo ti = tokinfo(tok);
    bool cm = colmajor && ti.s >= 32;
    int pos = seqpos2off(ti.l, cm);
    float acc[8];
#pragma unroll
    for (int e = 0; e < 8; ++e) acc[e] = b[c0 + e];
#pragma unroll
    for (int k = 0; k < KW; ++k) {
      int pp = pos + k - 1;
      if (pp < 0 || pp >= ti.L) continue;
      int tk = ti.base + seqpos2off(pp, cm);
      u32x4 xv = *(const u32x4*)(src + (size_t)tk * ld_src + c0);
      const float* wk = w + (size_t)k * CH + c0;
      acc[0] += wk[0] * bflo(xv.x); acc[1] += wk[1] * bfhi(xv.x);
      acc[2] += wk[2] * bflo(xv.y); acc[3] += wk[3] * bfhi(xv.y);
      acc[4] += wk[4] * bflo(xv.z); acc[5] += wk[5] * bfhi(xv.z);
      acc[6] += wk[6] * bflo(xv.w); acc[7] += wk[7] * bfhi(xv.w);
    }
    if (SILU) {
#pragma unroll
      for (int e = 0; e < 8; ++e) acc[e] = siluf(acc[e]);
    }
    u32x4 o;
    o.x = pack2(acc[0], acc[1]); o.y = pack2(acc[2], acc[3]); o.z = pack2(acc[4], acc[5]); o.w = pack2(acc[6], acc[7]);
    *(u32x4*)(dst + (size_t)tok * ld_dst + c0) = o;
  }
}

__device__ __forceinline__ void phase_ssd_scan_naive(const Params& p, int slot, bool colmajor, int bid, int nblk, unsigned char* smem) {
  const bf16_t* xbcc = (const bf16_t*)(p.scratch + SC_SSD_XBCC);
  const float* dtb = (const float*)(p.scratch + SC_SSD_DT);
  bf16_t* ybuf = (bf16_t*)(p.scratch + SC_SSD_XBC);
  bf16_t* sB = (bf16_t*)smem;
  bf16_t* sC = sB + 64 * 128;
  bf16_t* sx = sC + 64 * 128;
  float* sdt = (float*)(sx + 64 * 64);
  float* sy = sdt + 64;
  int* stok = (int*)(sy + 64 * 64);
  const int tid = threadIdx.x, pp = tid >> 2, q = tid & 3;
  for (int item = bid; item < 36 * 64; item += nblk) {
    int s, h, dir;
    if (item < 256) { s = 32 + (item >> 6); h = (item & 63) >> 1; dir = item & 1; }
    else { int it = item - 256; s = it >> 6; h = (it & 63) >> 1; dir = it & 1; }
    const int L = s < 32 ? 256 : 4096;
    const int base = s < 32 ? s * 256 : T_CTX + (s - 32) * 4096;
    const bool cm = colmajor && s >= 32;
    const int g = h >> 2;
    const float Aval = -expf(p.ssd_a_log[(slot * 2 + dir) * 32 + h]);
    float hreg[32];
    if (s >= 32) {
      const float* h0 = p.state_ssd + ((((size_t)(s - 32) * 2 + slot) * 2 + dir) * 32 + h) * 8192 + pp * 128 + q * 32;
#pragma unroll
      for (int e = 0; e < 32; ++e) hreg[e] = h0[e];
    } else {
#pragma unroll
      for (int e = 0; e < 32; ++e) hreg[e] = 0.f;
    }
    for (int cs = 0; cs < L / 64; ++cs) {
      __syncthreads();
      if (tid < 64) {
        int j = cs * 64 + tid;
        int pos = dir ? L - 1 - j : j;
        int tok = base + seqpos2off(pos, cm);
        stok[tid] = tok;
        sdt[tid] = dtb[(size_t)tok * 64 + dir * 32 + h];
      }
      __syncthreads();
      for (int ch = tid; ch < 64 * 40; ch += NTHR) {
        int jj = ch / 40, part = ch % 40;
        const bf16_t* rowp = xbcc + (size_t)stok[jj] * 4096;
        if (part < 16) *(u32x4*)(sB + jj * 128 + part * 8) = *(const u32x4*)(rowp + 2048 + g * 128 + part * 8);
        else if (part < 32) *(u32x4*)(sC + jj * 128 + (part - 16) * 8) = *(const u32x4*)(rowp + 3072 + g * 128 + (part - 16) * 8);
        else *(u32x4*)(sx + jj * 64 + (part - 32) * 8) = *(const u32x4*)(rowp + h * 64 + (part - 32) * 8);
      }
      __syncthreads();
      for (int jj = 0; jj < 64; ++jj) {
        float dtv = sdt[jj];
        float dec = __expf(dtv * Aval);
        float xv = bf2f(sx[jj * 64 + pp]) * dtv;
        float acc = 0.f;
#pragma unroll
        for (int e4 = 0; e4 < 4; ++e4) {
          u32x4 bv = *(const u32x4*)(sB + jj * 128 + q * 32 + e4 * 8);
          u32x4 cv = *(const u32x4*)(sC + jj * 128 + q * 32 + e4 * 8);
          unsigned bw[4] = {bv.x, bv.y, bv.z, bv.w}, cw[4] = {cv.x, cv.y, cv.z, cv.w};
#pragma unroll
          for (int e = 0; e < 4; ++e) {
            float h0v = hreg[e4 * 8 + e * 2] * dec + xv * bflo(bw[e]);
            float h1v = hreg[e4 * 8 + e * 2 + 1] * dec + xv * bfhi(bw[e]);
            hreg[e4 * 8 + e * 2] = h0v; hreg[e4 * 8 + e * 2 + 1] = h1v;
            acc += bflo(cw[e]) * h0v + bfhi(cw[e]) * h1v;
          }
        }
        acc += __shfl_xor(acc, 1);
        acc += __shfl_xor(acc, 2);
        if (q == 0) sy[jj * 64 + pp] = acc;
      }
      __syncthreads();
      {
        int jj = tid >> 2, part = tid & 3;
        bf16_t* yo = ybuf + ((size_t)dir * T_ALL + stok[jj]) * 2048 + h * 64 + part * 16;
        const float* sv = sy + jj * 64 + part * 16;
        u32x4 o0, o1;
        o0.x = pack2(sv[0], sv[1]); o0.y = pack2(sv[2], sv[3]); o0.z = pack2(sv[4], sv[5]); o0.w = pack2(sv[6], sv[7]);
        o1.x = pack2(sv[8], sv[9]); o1.y = pack2(sv[10], sv[11]); o1.z = pack2(sv[12], sv[13]); o1.w = pack2(sv[14], sv[15]);
        *(u32x4*)yo = o0; *(u32x4*)(yo + 8) = o1;
      }
    }
    if (s < 32) {
      float* ho = p.out_ssd + ((((size_t)s * 2 + slot) * 2 + dir) * 32 + h) * 8192 + pp * 128 + q * 32;
#pragma unroll
      for (int e = 0; e < 32; ++e) ho[e] = hreg[e];
    }
  }
}

__device__ __forceinline__ void phase_ssd_gate(const Params& p, int slot, int bid, int nblk) {
  bf16_t* zb = (bf16_t*)(p.scratch + SC_SSD_Z);
  const bf16_t* yfb = (const bf16_t*)(p.scratch + SC_SSD_XBC);
  const bf16_t* ybb = yfb + (size_t)T_ALL * 2048;
  const bf16_t* xbcc = (const bf16_t*)(p.scratch + SC_SSD_XBCC);
  int lane = threadIdx.x & 63, wv = threadIdx.x >> 6;
  for (int row = bid * 4 + wv; row < T_ALL; row += nblk * 4) {
    float ss = 0.f;
#pragma unroll
    for (int j = 0; j < 4; ++j) {
      int c0 = j * 512 + lane * 8;
      u32x4 zv = *(const u32x4*)(zb + (size_t)row * 2048 + c0);
      u32x4 fv = *(const u32x4*)(yfb + (size_t)row * 2048 + c0);
      u32x4 bv = *(const u32x4*)(ybb + (size_t)row * 2048 + c0);
      u32x4 xv = *(const u32x4*)(xbcc + (size_t)row * 4096 + c0);
      float dsk = p.ssd_d[slot * 32 + (c0 >> 6)];
      unsigned zw[4] = {zv.x, zv.y, zv.z, zv.w}, fw[4] = {fv.x, fv.y, fv.z, fv.w}, bw[4] = {bv.x, bv.y, bv.z, bv.w}, xw[4] = {xv.x, xv.y, xv.z, xv.w};
      unsigned ow[4];
#pragma unroll
      for (int e = 0; e < 4; ++e) {
        float y0 = (bflo(fw[e]) + bflo(bw[e]) + dsk * bflo(xw[e])) * siluf(bflo(zw[e]));
        float y1 = (bfhi(fw[e]) + bfhi(bw[e]) + dsk * bfhi(xw[e])) * siluf(bfhi(zw[e]));
        ss += y0 * y0 + y1 * y1;
        ow[e] = pack2(y0, y1);
      }
      u32x4 o; o.x = ow[0]; o.y = ow[1]; o.z = ow[2]; o.w = ow[3];
      *(u32x4*)(zb + (size_t)row * 2048 + c0) = o;
    }
#pragma unroll
    for (int o = 32; o > 0; o >>= 1) ss += __shfl_xor(ss, o);
    if (lane == 0) p.rstd[row] = rsqrtf(ss * (1.f / 2048.f) + 1e-5f);
  }
}

__device__ __forceinline__ void phase_hy_longconv_naive(const Params& p, int order, int bid, int nblk) {
  const bf16_t* proj = (const bf16_t*)(p.scratch + SC_HY_PROJ);
  const bf16_t* vxc = (const bf16_t*)(p.scratch + SC_HY_VXC);
  bf16_t* u1 = (bf16_t*)(p.scratch + SC_HY_U1);
  bf16_t* yg = (bf16_t*)(p.scratch + SC_HY_YG);
  const bf16_t* uin = order == 0 ? vxc : u1;
  const int ldu = order == 0 ? 3072 : 1024;
  const bf16_t* gate = vxc + (order == 0 ? 1024 : 2048);
  bf16_t* out = order == 0 ? u1 : yg;
  const int items_lat = 4 * 4 * 256, items_ctx = 32 * 4 * 16;
  for (int item = bid; item < items_lat + items_ctx; item += nblk) {
    int s, cb, tt, L;
    if (item < items_lat) { s = 32 + (item >> 10); cb = (item >> 8) & 3; tt = item & 255; L = 4096; }
    else { int it = item - items_lat; s = it >> 6; cb = (it >> 4) & 3; tt = it & 15; L = 256; }
    const int base = s < 32 ? s * 256 : T_CTX + (s - 32) * 4096;
    const int c = cb * 256 + threadIdx.x;
    const int t0 = tt * 16;
    const float* kt = (L == 256 ? p.ktab0 : p.ktab1) + (size_t)order * 2 * L * 1024 + c;
    float acc[16];
#pragma unroll
    for (int j = 0; j < 16; ++j) acc[j] = 0.f;
    for (int sb = 0; sb < L; sb += 16) {
      const int kb = L + t0 - sb - 15;
      float kw[31];
#pragma unroll
      for (int qq = 0; qq < 31; ++qq) kw[qq] = kt[(size_t)(kb + qq) * 1024];
#pragma unroll
      for (int r = 0; r < 16; ++r) {
        float uv = bf2f(uin[(size_t)(base + sb + r) * ldu + c]);
#pragma unroll
        for (int j = 0; j < 16; ++j) acc[j] += kw[j - r + 15] * uv;
      }
    }
    const float inv = 1.f / p.knorm[((L == 256 ? 0 : 1) * 2 + order) * 1024 + c];
    const float bias = p.hy_f_bias[order * 1024 + c];
#pragma unroll
    for (int j = 0; j < 16; ++j) {
      int tok = base + t0 + j;
      float uv = bf2f(uin[(size_t)tok * ldu + c]);
      float res = inv * acc[j] + bias * uv;
      res *= bf2f(gate[(size_t)tok * 3072 + c]);
      if (order == 1) res *= siluf(bf2f(proj[(size_t)tok * 4096 + 3072 + c]));
      out[(size_t)tok * 1024 + c] = f2bf(res);
    }
  }
}

__device__ __forceinline__ void lru_ab(const bf16_t* gates, const bf16_t* xc, int dir, int tok, int c, float sp, float& a, float& bx) {
  float r = bf2f(gates[((size_t)(dir * 2 + 0) * T_ALL + tok) * 1024 + c]);
  float i = bf2f(gates[((size_t)(dir * 2 + 1) * T_ALL + tok) * 1024 + c]);
  float x = bf2f(xc[(size_t)tok * 1024 + c]);
  float log_a = -8.f * r * sp;
  a = __expf(log_a);
  float m = sqrtf(fmaxf(1.f - __expf(2.f * log_a), 0.f));
  bx = m * i * x;
}
__device__ __forceinline__ void phase_lru_scan_chunks(const Params& p, int pass, int bid, int nblk) {
  const bf16_t* gates = (const bf16_t*)(p.scratch + SC_LRU_GATES);
  const bf16_t* xc = (const bf16_t*)(p.scratch + SC_LRU_XC);
  bf16_t* ybuf = (bf16_t*)(p.scratch + SC_LRU_Y);
  for (int item = bid; item < 192 * 8; item += nblk) {
    int chunk = item >> 3, dir = (item >> 2) & 1, cb = item & 3;
    int c = cb * 256 + threadIdx.x;
    float sp = softplusf(-p.lru_a_param[dir * 1024 + c]);
    int tok0 = chunk * 128;
    float A = 1.f, h = (pass == 0) ? 0.f : p.lru_hin[((size_t)dir * 192 + chunk) * 1024 + c];
    for (int j = 0; j < 128; ++j) {
      int tok = dir ? tok0 + 127 - j : tok0 + j;
      float a, bx;
      lru_ab(gates, xc, dir, tok, c, sp, a, bx);
      h = a * h + bx; A *= a;
      if (pass == 2) ybuf[((size_t)dir * T_ALL + tok) * 1024 + c] = f2bf(h);
    }
    if (pass == 0) {
      float* ag = p.lru_agg + (((size_t)dir * 192 + chunk) * 1024 + c) * 2;
      ag[0] = A; ag[1] = h;
    }
  }
}
__device__ __forceinline__ void phase_lru_scan_carry(const Params& p, int bid, int nblk) {
  for (int item = bid; item < 36 * 8; item += nblk) {
    int s = item >> 3, dir = (item >> 2) & 1, cb = item & 3;
    int c = cb * 256 + threadIdx.x;
    int nch = s < 32 ? 2 : 32;
    int ch0 = s < 32 ? s * 2 : 64 + (s - 32) * 32;
    float h = s < 32 ? 0.f : p.state_lru[((size_t)(s - 32) * 2 + dir) * 1024 + c];
    for (int k = 0; k < nch; ++k) {
      int chunk = dir ? ch0 + nch - 1 - k : ch0 + k;
      size_t idx = ((size_t)dir * 192 + chunk) * 1024 + c;
      p.lru_hin[idx] = h;
      h = p.lru_agg[idx * 2] * h + p.lru_agg[idx * 2 + 1];
    }
    if (s < 32) p.out_lru[((size_t)s * 2 + dir) * 1024 + c] = h;
  }
}
__device__ __forceinline__ void phase_lru_combine(const Params& p, int bid, int nblk) {
  const bf16_t* proj = (const bf16_t*)(p.scratch + SC_LRU_PROJ);
  const bf16_t* yf = (const bf16_t*)(p.scratch + SC_LRU_Y);
  const bf16_t* yb = yf + (size_t)T_ALL * 1024;
  bf16_t* yg = (bf16_t*)(p.scratch + SC_LRU_YG);
  const size_t total = (size_t)T_ALL * 128;
  for (size_t idx = (size_t)bid * NTHR + threadIdx.x; idx < total; idx += (size_t)nblk * NTHR) {
    int tok = (int)(idx >> 7), c0 = (int)(idx & 127) * 8;
    u32x4 fv = *(const u32x4*)(yf + (size_t)tok * 1024 + c0);
    u32x4 bv = *(const u32x4*)(yb + (size_t)tok * 1024 + c0);
    u32x4 zv = *(const u32x4*)(proj + (size_t)tok * 2048 + 1024 + c0);
    unsigned fw[4] = {fv.x, fv.y, fv.z, fv.w}, bw[4] = {bv.x, bv.y, bv.z, bv.w}, zw[4] = {zv.x, zv.y, zv.z, zv.w}, ow[4];
#pragma unroll
    for (int e = 0; e < 4; ++e)
      ow[e] = pack2((bflo(fw[e]) + bflo(bw[e])) * siluf(bflo(zw[e])), (bfhi(fw[e]) + bfhi(bw[e])) * siluf(bfhi(zw[e])));
    u32x4 o; o.x = ow[0]; o.y = ow[1]; o.z = ow[2]; o.w = ow[3];
    *(u32x4*)(yg + (size_t)tok * 1024 + c0) = o;
  }
}

enum { PH_PREP = 0, PH_MOD, PH_HYA, PH_HYB, PH_LNMOD, PH_INPROJ, PH_MIX1, PH_MIX2, PH_MIX3, PH_MIX4, PH_MIX5, PH_MIX6, PH_OUTPROJ };

__device__ __forceinline__ void run_phase(const Params& p, int ph, int layer, int bid, int nblk, unsigned char* smem) {
  const int kind = layer % 3, slot = layer / 3;
  switch (ph) {
    case PH_PREP: phase_prep(p, bid, nblk, smem); break;
    case PH_MOD: phase_mod(p, bid, nblk, smem); break;
    case PH_HYA: phase_hyfilt_a(p, bid, nblk, smem); break;
    case PH_HYB: phase_hyfilt_b(p, bid, nblk, smem); break;
    case PH_LNMOD: phase_lnmod(p, layer, bid, nblk); break;
    case PH_INPROJ:
      if (kind == 0) {
        EpiSsdIn e{(bf16_t*)(p.scratch + SC_SSD_Z), (bf16_t*)(p.scratch + SC_SSD_XBC), (float*)(p.scratch + SC_SSD_DT), p.ssd_dt_bias + slot * 64};
        gemm_phase(p.hbuf, 1024, p.wt_ssd_in + (size_t)slot * 6272 * 1024, 1024, T_ALL / 128, 49, e, bid, nblk, smem);
      } else if (kind == 1) {
        EpiBf16 e{(bf16_t*)(p.scratch + SC_HY_PROJ), 4096};
        gemm_phase(p.hbuf, 1024, p.wt_hy_in, 1024, T_ALL / 128, 32, e, bid, nblk, smem);
      } else {
        EpiBf16 e{(bf16_t*)(p.scratch + SC_LRU_PROJ), 2048};
        gemm_phase(p.hbuf, 1024, p.wt_lru_in, 1024, T_ALL / 128, 16, e, bid, nblk, smem);
      }
      break;
    case PH_MIX1:
      if (kind == 0) phase_dwconv<4, true>((const bf16_t*)(p.scratch + SC_SSD_XBC), 4096, (bf16_t*)(p.scratch + SC_SSD_XBCC), 4096, 4096,
                                           p.ssd_conv_w + (size_t)slot * 4 * 4096, p.ssd_conv_b + slot * 4096, slot == 1, bid, nblk);
      else if (kind == 1) phase_dwconv<3, false>((const bf16_t*)(p.scratch + SC_HY_PROJ), 4096, (bf16_t*)(p.scratch + SC_HY_VXC), 3072, 3072,
                                                 p.hy_conv_w, p.hy_conv_b, false, bid, nblk);
      else phase_dwconv<4, false>((const bf16_t*)(p.scratch + SC_LRU_PROJ), 2048, (bf16_t*)(p.scratch + SC_LRU_XC), 1024, 1024,
                                  p.lru_conv_w, p.lru_conv_b, false, bid, nblk);
      break;
    case PH_MIX2:
      if (kind == 0) phase_ssd_scan_naive(p, slot, slot == 1, bid, nblk, smem);
      else if (kind == 1) phase_hy_longconv_naive(p, 0, bid, nblk);
      else {
        for (int nb = 0; nb < 4; ++nb) {
          EpiLruGate e{(bf16_t*)(p.scratch + SC_LRU_GATES), p.lru_gate_b, nb};
          gemm_phase((const bf16_t*)(p.scratch + SC_LRU_XC) + nb * 256, 1024, p.wt_lru_gate + (size_t)nb * 1024 * 256, 256, T_ALL / 128, 8, e, bid, nblk, smem);
        }
      }
      break;
    case PH_MIX3:
      if (kind == 0) phase_ssd_gate(p, slot, bid, nblk);
      else if (kind == 1) phase_hy_longconv_naive(p, 1, bid, nblk);
      else phase_lru_scan_chunks(p, 0, bid, nblk);
      break;
    case PH_MIX4: if (kind == 2) phase_lru_scan_carry(p, bid, nblk); break;
    case PH_MIX5: if (kind == 2) phase_lru_scan_chunks(p, 2, bid, nblk); break;
    case PH_MIX6: if (kind == 2) phase_lru_combine(p, bid, nblk); break;
    case PH_OUTPROJ: {
      const float* mv = p.modv + (size_t)layer * 5 * 3072;
      if (kind == 0) {
        EpiOut e{p.xres, mv, p.rstd};
        gemm_phase((const bf16_t*)(p.scratch + SC_SSD_Z), 2048, p.wt_ssd_out + (size_t)slot * 1024 * 2048, 2048, T_ALL / 128, 8, e, bid, nblk, smem);
      } else if (kind == 1) {
        EpiOut e{p.xres, mv, nullptr};
        gemm_phase((const bf16_t*)(p.scratch + SC_HY_YG), 1024, p.wt_hy_out, 1024, T_ALL / 128, 8, e, bid, nblk, smem);
      } else {
        EpiOut e{p.xres, mv, nullptr};
        gemm_phase((const bf16_t*)(p.scratch + SC_LRU_YG), 1024, p.wt_lru_out, 1024, T_ALL / 128, 8, e, bid, nblk, smem);
      }
    } break;
  }
}

template <int PH>
__global__ void __launch_bounds__(NTHR) k_phase(Params p, int layer) {
  __shared__ __attribute__((aligned(16))) unsigned char smem[SMEM_BYTES];
  run_phase(p, PH, layer, blockIdx.x, gridDim.x, smem);
}

static inline size_t align_up(size_t x) { return (x + 255) & ~(size_t)255; }

extern "C" void kernel_launch(void* const* d_in, const int* in_sizes, int n_in, void* d_out, int out_size, void* d_ws, size_t ws_size,
                              hipStream_t stream) {
  Params p{};
  const float** fp = (const float**)&p;
  for (int i = 0; i < 36; ++i) fp[i] = (const float*)d_in[i];
  float* out = (float*)d_out;
  p.xres = out;
  p.out_ssd = out + (size_t)T_ALL * 1024;
  p.out_lru = p.out_ssd + (size_t)32 * 2 * 2 * 32 * 64 * 128;
  unsigned char* w = (unsigned char*)d_ws;
  size_t off = 0;
  auto carve = [&](size_t bytes) { unsigned char* r = w + off; off = align_up(off + bytes); return r; };
  p.wt_ssd_in = (bf16_t*)carve((size_t)2 * 6272 * 1024 * 2);
  p.wt_ssd_out = (bf16_t*)carve((size_t)2 * 1024 * 2048 * 2);
  p.wt_hy_in = (bf16_t*)carve((size_t)4096 * 1024 * 2);
  p.wt_hy_out = (bf16_t*)carve((size_t)1024 * 1024 * 2);
  p.wt_lru_in = (bf16_t*)carve((size_t)2048 * 1024 * 2);
  p.wt_lru_out = (bf16_t*)carve((size_t)1024 * 1024 * 2);
  p.wt_lru_gate = (bf16_t*)carve((size_t)4 * 1024 * 256 * 2);
  p.modv = (float*)carve((size_t)4 * 5 * 3072 * 4);
  p.hdn2 = (float*)carve((size_t)4352 * 64 * 4);
  p.ktab0 = (float*)carve((size_t)2 * 512 * 1024 * 4);
  p.ktab1 = (float*)carve((size_t)2 * 8192 * 1024 * 4);
  p.knorm = (float*)carve((size_t)4 * 1024 * 4);
  p.hbuf = (bf16_t*)carve((size_t)T_ALL * 1024 * 2);
  p.rstd = (float*)carve((size_t)T_ALL * 4);
  p.lru_agg = (float*)carve((size_t)2 * 192 * 1024 * 2 * 4);
  p.lru_hin = (float*)carve((size_t)2 * 192 * 1024 * 4);
  p.scratch = carve(SC_TOTAL);
  if (off > ws_size) return;

  const int G = 2048;
#define LAUNCH(PH, layer) k_phase<PH><<<G, NTHR, 0, stream>>>(p, layer)
  LAUNCH(PH_PREP, 0);
  LAUNCH(PH_MOD, 0);
  LAUNCH(PH_HYA, 0);
  LAUNCH(PH_HYB, 0);
  for (int layer = 0; layer < 4; ++layer) {
    int kind = layer % 3;
    LAUNCH(PH_LNMOD, layer);
    LAUNCH(PH_INPROJ, layer);
    LAUNCH(PH_MIX1, layer);
    LAUNCH(PH_MIX2, layer);
    LAUNCH(PH_MIX3, layer);
    if (kind == 2) { LAUNCH(PH_MIX4, layer); LAUNCH(PH_MIX5, layer); LAUNCH(PH_MIX6, layer); }
    LAUNCH(PH_OUTPROJ, layer);
  }
  LAUNCH(PH_LNMOD, 4);
}
```

```cpp
#include <hip/hip_runtime.h>
#include <hip/hip_bf16.h>
#include <hip/hip_cooperative_groups.h>
#include <stdint.h>
#include <cstdio>
namespace cg = cooperative_groups;

typedef unsigned short bf16_t;
typedef __attribute__((ext_vector_type(8))) short bf16x8;
typedef __attribute__((ext_vector_type(16))) float f32x16;
typedef __attribute__((ext_vector_type(4))) unsigned int u32x4;
typedef __attribute__((ext_vector_type(2))) unsigned int u32x2;
typedef __attribute__((ext_vector_type(4))) float f32x4;

#define T_CTX 8192
#define T_ALL 24576
#define DM 1024
#define NTHR 256
#define SMEM_BYTES 65536
#define ALPHA_RES 1.6817928305074290f
#define LN_EPS 1e-5f

__device__ __forceinline__ bf16_t f2bf(float f) {
  unsigned u = __float_as_uint(f);
  u += 0x7fffu + ((u >> 16) & 1u);
  return (bf16_t)(u >> 16);
}
__device__ __forceinline__ float bf2f(bf16_t b) { return __uint_as_float(((unsigned)b) << 16); }
__device__ __forceinline__ float bflo(unsigned w) { return __uint_as_float(w << 16); }
__device__ __forceinline__ float bfhi(unsigned w) { return __uint_as_float(w & 0xffff0000u); }
__device__ __forceinline__ unsigned pack2(float a, float b) { return (unsigned)f2bf(a) | ((unsigned)f2bf(b) << 16); }
__device__ __forceinline__ float siluf(float x) { return x / (1.f + __expf(-x)); }
__device__ __forceinline__ float sigmoidf(float x) { return 1.f / (1.f + __expf(-x)); }
__device__ __forceinline__ float softplusf(float x) { return x > 20.f ? x : log1pf(expf(x)); }

__device__ __forceinline__ int opaque_tid() { int t = threadIdx.x; asm volatile("" : "+v"(t)); return t; }
__device__ __forceinline__ int opaque_s(int x) { asm volatile("" : "+s"(x)); return x; }

struct TokInfo { int s, l, L, base, mrow; };
__device__ __forceinline__ TokInfo tokinfo(int tok) {
  TokInfo t;
  if (tok < T_CTX) { t.s = tok >> 8; t.l = tok & 255; t.L = 256; t.base = tok & ~255; t.mrow = 0; }
  else { int u = tok - T_CTX; t.s = 32 + (u >> 12); t.l = u & 4095; t.L = 4096; t.base = T_CTX + (u & ~4095); t.mrow = 1 + (u >> 12); }
  return t;
}
__device__ __forceinline__ int seqpos2off(int pos, bool cm) { return cm ? (((pos & 63) << 6) | (pos >> 6)) : pos; }

struct Params {
  const float *x_prompt, *x_sample, *state_ssd, *state_lru, *c, *c_ctx, *mod_w, *mod_b, *ln_g, *ln_b;
  const float *ssd_in_w, *ssd_conv_w, *ssd_conv_b, *ssd_dt_bias, *ssd_a_log, *ssd_d, *ssd_norm_g, *ssd_out_w;
  const float *hy_in_w, *hy_conv_w, *hy_conv_b, *hy_f_w1, *hy_f_b1, *hy_f_w2, *hy_f_b2, *hy_f_w3, *hy_f_freq, *hy_f_bias, *hy_out_w;
  const float *lru_in_w, *lru_conv_w, *lru_conv_b, *lru_gate_w, *lru_gate_b, *lru_a_param, *lru_out_w;
  float *xres, *out_ssd, *out_lru;
  bf16_t *wt_ssd_in, *wt_ssd_out, *wt_hy_in, *wt_hy_out, *wt_lru_in, *wt_lru_out, *wt_lru_gate;
  float *modv;
  float *hdn2;
  float *ktab0;
  float *ktab1;
  float *knorm;
  bf16_t *hbuf;
  float *rstd;
  float *lru_agg;
  float *lru_hin;
  unsigned char *scratch;
};

#define SC_SSD_Z     ((size_t)0)
#define SC_SSD_XBC   ((size_t)T_ALL * 2048 * 2)
#define SC_SSD_XBCC  (SC_SSD_XBC + (size_t)T_ALL * 4096 * 2)
#define SC_SSD_DT    (SC_SSD_XBCC + (size_t)T_ALL * 4096 * 2)
#define SC_SSD_END   (SC_SSD_DT + (size_t)T_ALL * 64 * 4)
#define SC_HY_PROJ   ((size_t)0)
#define SC_HY_VXC    ((size_t)T_ALL * 4096 * 2)
#define SC_HY_U1     (SC_HY_VXC + (size_t)T_ALL * 3072 * 2)
#define SC_HY_YG     (SC_HY_U1 + (size_t)T_ALL * 1024 * 2)
#define SC_LRU_PROJ  ((size_t)0)
#define SC_LRU_XC    ((size_t)T_ALL * 2048 * 2)
#define SC_LRU_GATES (SC_LRU_XC + (size_t)T_ALL * 1024 * 2)
#define SC_LRU_Y     (SC_LRU_GATES + (size_t)T_ALL * 4096 * 2)
#define SC_LRU_YG    (SC_LRU_Y + (size_t)T_ALL * 2048 * 2)
#define SC_TOTAL     SC_SSD_END

__device__ __forceinline__ void transpose_tile(const float* __restrict__ src, int ld_src, int n_src, bf16_t* __restrict__ dst, int K,
                               const float* __restrict__ scale, int tile, int tiles_k, float* tl) {
  const int tidx = opaque_tid();
  int tk = tile % tiles_k, tn = tile / tiles_k;
  int k0 = tk * 64, n0 = tn * 64;
  int tx = tidx & 63, ty = tidx >> 6;
  __syncthreads();
  for (int r = ty; r < 64; r += 4) {
    int n = n0 + tx;
    float v = 0.f;
    if (n < n_src) { v = src[(size_t)(k0 + r) * ld_src + n]; if (scale) v *= scale[k0 + r]; }
    tl[r * 65 + tx] = v;
  }
  __syncthreads();
  for (int r = ty; r < 64; r += 4) dst[(size_t)(n0 + r) * K + k0 + tx] = f2bf(tl[tx * 65 + r]);
}

__device__ __forceinline__ void phase_prep(const Params& p, int bid, int nblk, unsigned char* smem) {
  const int tidx = opaque_tid();
  float* tl = (float*)smem;
  for (int job = 0; job < 24; ++job) {
    const float* src; int ld, nsrc, K, npad; bf16_t* dst; const float* scale = nullptr;
    if (job < 2) { src = p.ssd_in_w + (size_t)job * 1024 * 6208; ld = 6208; nsrc = 6208; K = 1024; npad = 6272; dst = p.wt_ssd_in + (size_t)job * 6272 * 1024; }
    else if (job < 4) { int s = job - 2; src = p.ssd_out_w + (size_t)s * 2048 * 1024; ld = 1024; nsrc = 1024; K = 2048; npad = 1024; dst = p.wt_ssd_out + (size_t)s * 1024 * 2048; scale = p.ssd_norm_g + s * 2048; }
    else if (job == 4) { src = p.hy_in_w; ld = 4096; nsrc = 4096; K = 1024; npad = 4096; dst = p.wt_hy_in; }
    else if (job == 5) { src = p.hy_out_w; ld = 1024; nsrc = 1024; K = 1024; npad = 1024; dst = p.wt_hy_out; }
    else if (job == 6) { src = p.lru_in_w; ld = 2048; nsrc = 2048; K = 1024; npad = 2048; dst = p.wt_lru_in; }
    else if (job == 7) { src = p.lru_out_w; ld = 1024; nsrc = 1024; K = 1024; npad = 1024; dst = p.wt_lru_out; }
    else { int q = job - 8; int dg = q >> 2, n = q & 3;
      src = p.lru_gate_w + (size_t)(dg * 4 + n) * 65536; ld = 256; nsrc = 256; K = 256; npad = 256;
      dst = p.wt_lru_gate + (size_t)n * 1024 * 256 + (size_t)dg * 256 * 256; }
    int tiles_k = K / 64, tiles = tiles_k * (npad / 64);
    for (int t = bid; t < tiles; t += nblk) transpose_tile(src, ld, nsrc, dst, K, scale, t, tiles_k, tl);
  }
  for (int i = bid * NTHR + tidx; i < 2 * 2 * 1024; i += nblk * NTHR) p.knorm[i] = 0.f;
}

__device__ __forceinline__ void phase_mod(const Params& p, int bid, int nblk, unsigned char* smem) {
  const int tidx = opaque_tid();
  float* sc = (float*)smem;
  __syncthreads();
  for (int i = tidx; i < 5 * 1024; i += NTHR) {
    int r = i >> 10, k = i & 1023;
    float v = (r == 0) ? p.c_ctx[k] : p.c[(r - 1) * 1024 + k];
    sc[i] = siluf(v);
  }
  __syncthreads();
  for (int item = bid; item < 4 * 12; item += nblk) {
    int layer = item / 12, j = (item % 12) * 256 + tidx;
    const float* w = p.mod_w + (size_t)layer * 1024 * 3072 + j;
    float a0 = 0, a1 = 0, a2 = 0, a3 = 0, a4 = 0;
    for (int k = 0; k < 1024; ++k) {
      float wv = w[(size_t)k * 3072];
      a0 += sc[k] * wv; a1 += sc[1024 + k] * wv; a2 += sc[2048 + k] * wv; a3 += sc[3072 + k] * wv; a4 += sc[4096 + k] * wv;
    }
    float b = p.mod_b[layer * 3072 + j];
    float* o = p.modv + (size_t)layer * 5 * 3072 + j;
    o[0] = a0 + b; o[3072] = a1 + b; o[2 * 3072] = a2 + b; o[3 * 3072] = a3 + b; o[4 * 3072] = a4 + b;
  }
}

__device__ __forceinline__ void phase_hyfilt_a(const Params& p, int bid, int nblk, unsigned char* smem) {
  const int tidx = opaque_tid();
  float* sz = (float*)smem;
  float* sh = sz + 4 * 36;
  int pl = tidx >> 6, m = tidx & 63;
  for (int item = bid; item < 4352 / 4; item += nblk) {
    int pos = item * 4 + pl;
    int L = pos < 256 ? 256 : 4096;
    int l = pos < 256 ? pos : pos - 256;
    __syncthreads();
    if (m < 33) {
      float t = (float)l / (float)L;
      float w = (6.283185307179586f * (float)l) / (float)L;
      float v;
      if (m == 0) v = t;
      else {
        int j = (m - 1) & 15;
        float fr = 1e-4f + (float)j * ((15.f - 1e-4f) / 15.f);
        float ang = w * fr;
        v = (m <= 16) ? __cosf(ang) : __sinf(ang);
      }
      sz[pl * 36 + m] = v;
    }
    __syncthreads();
    float a = p.hy_f_b1[m];
    for (int e = 0; e < 33; ++e) a += sz[pl * 36 + e] * p.hy_f_w1[e * 64 + m];
    a = __sinf(p.hy_f_freq[m] * a);
    sh[pl * 64 + m] = a;
    __syncthreads();
    float b = p.hy_f_b2[m];
    for (int e = 0; e < 64; ++e) b += sh[pl * 64 + e] * p.hy_f_w2[e * 64 + m];
    b = __sinf(p.hy_f_freq[64 + m] * b);
    p.hdn2[(size_t)pos * 64 + m] = b;
  }
}

__device__ __forceinline__ void phase_hyfilt_b(const Params& p, int bid, int nblk, unsigned char* smem) {
  const int tidx = opaque_tid();
  float* sh = (float*)smem;
  const int items0 = 8 * 16, items1 = 128 * 16;
  for (int item = bid; item < items0 + items1; item += nblk) {
    int Lsel = item < items0 ? 0 : 1;
    int it = Lsel ? item - items0 : item;
    int L = Lsel ? 4096 : 256;
    int lc = it >> 4, o = (it >> 3) & 1, d = (it >> 2) & 1, cb = it & 3;
    int c = cb * 256 + tidx;
    int posbase = (Lsel ? 256 : 0) + lc * 32;
    __syncthreads();
    for (int i = tidx; i < 32 * 64; i += NTHR) sh[i] = p.hdn2[(size_t)posbase * 64 + i];
    __syncthreads();
    float w3[64];
#pragma unroll
    for (int m = 0; m < 64; ++m) w3[m] = p.hy_f_w3[(size_t)m * 4096 + o * 2048 + d * 1024 + c];
    const float min_decay = -3.0701134573253945f, max_decay = -15.350567286626973f;
    float delta = fabsf(min_decay + (float)c * ((max_decay - min_decay) / 1023.f));
    float* kt = (Lsel ? p.ktab1 : p.ktab0) + (size_t)o * 2 * L * 1024;
    float asum = 0.f;
    for (int li = 0; li < 32; ++li) {
      int l = lc * 32 + li;
      float acc = 0.f;
#pragma unroll
      for (int m = 0; m < 64; ++m) acc += sh[li * 64 + m] * w3[m];
      float t = (float)l / (float)L;
      float kv = acc * expf(-t * delta);
      asum += fabsf(kv);
      if (d == 0) kt[(size_t)(L + l) * 1024 + c] = kv;
      else if (l > 0) kt[(size_t)(L - l) * 1024 + c] = kv;
      if (d == 1 && l == 0) kt[c] = 0.f;
    }
    atomicAdd(&p.knorm[(Lsel * 2 + o) * 1024 + c], asum);
  }
}

__device__ __forceinline__ void phase_lnmod(const Params& p, int layer, int bid, int nblk) {
  const int tidx = opaque_tid();
  int lane = tidx & 63, wv = tidx >> 6;
  for (int row = bid * 4 + wv; row < T_ALL; row += nblk * 4) {
    const float* src = (layer == 0) ? (row < T_CTX ? p.x_prompt + (size_t)row * DM : p.x_sample + (size_t)(row - T_CTX) * DM)
                                    : p.xres + (size_t)row * DM;
    f32x4 v[4];
#pragma unroll
    for (int j = 0; j < 4; ++j) v[j] = *(const f32x4*)(src + j * 256 + lane * 4);
    if (layer > 0) {
      float s = 0.f;
#pragma unroll
      for (int j = 0; j < 4; ++j) s += v[j].x + v[j].y + v[j].z + v[j].w;
#pragma unroll
      for (int o = 32; o > 0; o >>= 1) s += __shfl_xor(s, o);
      float mu = s * (1.f / 1024.f);
      float q = 0.f;
#pragma unroll
      for (int j = 0; j < 4; ++j) { float a = v[j].x - mu, b = v[j].y - mu, c = v[j].z - mu, d = v[j].w - mu; q += a * a + b * b + c * c + d * d; }
#pragma unroll
      for (int o = 32; o > 0; o >>= 1) q += __shfl_xor(q, o);
      float rs = rsqrtf(q * (1.f / 1024.f) + LN_EPS);
      const float* g = p.ln_g + (layer - 1) * DM; const float* b = p.ln_b + (layer - 1) * DM;
#pragma unroll
      for (int j = 0; j < 4; ++j) {
        f32x4 gg = *(const f32x4*)(g + j * 256 + lane * 4), bb = *(const f32x4*)(b + j * 256 + lane * 4);
        v[j].x = (v[j].x - mu) * rs * gg.x + bb.x; v[j].y = (v[j].y - mu) * rs * gg.y + bb.y;
        v[j].z = (v[j].z - mu) * rs * gg.z + bb.z; v[j].w = (v[j].w - mu) * rs * gg.w + bb.w;
      }
    }
    float* dst = p.xres + (size_t)row * DM;
#pragma unroll
    for (int j = 0; j < 4; ++j) *(f32x4*)(dst + j * 256 + lane * 4) = v[j];
    if (layer < 4) {
      int mrow = row < T_CTX ? 0 : 1 + ((row - T_CTX) >> 12);
      const float* mv = p.modv + ((size_t)layer * 5 + mrow) * 3072;
#pragma unroll
      for (int j = 0; j < 4; ++j) {
        f32x4 sh = *(const f32x4*)(mv + j * 256 + lane * 4), sc = *(const f32x4*)(mv + 1024 + j * 256 + lane * 4);
        u32x2 o;
        o.x = pack2(v[j].x * (1.f + sc.x) + sh.x, v[j].y * (1.f + sc.y) + sh.y);
        o.y = pack2(v[j].z * (1.f + sc.z) + sh.z, v[j].w * (1.f + sc.w) + sh.w);
        *(u32x2*)(p.hbuf + (size_t)row * DM + j * 256 + lane * 4) = o;
      }
    }
  }
}

#define G_LDS_STRIDE 72
template <class Epi>
__device__ __forceinline__ void gemm_phase(const bf16_t* __restrict__ A, int lda, const bf16_t* __restrict__ Wt, int K, int Mtiles, int Ntiles,
                           Epi epi, int bid, int nblk, unsigned char* smem) {
  const int tidx = opaque_tid();
  bf16_t* sA = (bf16_t*)smem;
  bf16_t* sB = sA + 128 * G_LDS_STRIDE;
  const int tid = tidx, lane = tid & 63, w = tid >> 6;
  const int wm = w >> 1, wn = w & 1, r = lane & 31, hh = lane >> 5;
  const int nk = K / 64;
  for (int tile = bid; tile < Mtiles * Ntiles; tile += nblk) {
    const int tm = tile / Ntiles, tn = tile % Ntiles;
    const int m0 = tm * 128, n0 = tn * 128;
    f32x16 acc[2][2];
#pragma unroll
    for (int i = 0; i < 2; ++i)
#pragma unroll
      for (int j = 0; j < 2; ++j)
#pragma unroll
        for (int e = 0; e < 16; ++e) acc[i][j][e] = 0.f;
    u32x4 ra[4], rb[4];
#pragma unroll
    for (int i = 0; i < 4; ++i) {
      int q = tid + i * 256, row = q >> 3, c8 = (q & 7) * 8;
      ra[i] = *(const u32x4*)(A + (size_t)(m0 + row) * lda + c8);
      rb[i] = *(const u32x4*)(Wt + (size_t)(n0 + row) * K + c8);
    }
    for (int kt = 0; kt < nk; ++kt) {
      __syncthreads();
#pragma unroll
      for (int i = 0; i < 4; ++i) {
        int q = tid + i * 256, row = q >> 3, c8 = (q & 7) * 8;
        *(u32x4*)(sA + row * G_LDS_STRIDE + c8) = ra[i];
        *(u32x4*)(sB + row * G_LDS_STRIDE + c8) = rb[i];
      }
      __syncthreads();
      if (kt + 1 < nk) {
#pragma unroll
        for (int i = 0; i < 4; ++i) {
          int q = tid + i * 256, row = q >> 3, c8 = (q & 7) * 8;
          ra[i] = *(const u32x4*)(A + (size_t)(m0 + row) * lda + (kt + 1) * 64 + c8);
          rb[i] = *(const u32x4*)(Wt + (size_t)(n0 + row) * K + (kt + 1) * 64 + c8);
        }
      }
#pragma unroll
      for (int kk = 0; kk < 4; ++kk) {
        bf16x8 fa[2], fb[2];
#pragma unroll
        for (int i = 0; i < 2; ++i) fa[i] = *(const bf16x8*)(sA + (wm * 64 + i * 32 + r) * G_LDS_STRIDE + kk * 16 + hh * 8);
#pragma unroll
        for (int j = 0; j < 2; ++j) fb[j] = *(const bf16x8*)(sB + (wn * 64 + j * 32 + r) * G_LDS_STRIDE + kk * 16 + hh * 8);
#pragma unroll
        for (int i = 0; i < 2; ++i)
#pragma unroll
          for (int j = 0; j < 2; ++j) acc[i][j] = __builtin_amdgcn_mfma_f32_32x32x16_bf16(fa[i], fb[j], acc[i][j], 0, 0, 0);
      }
    }
#pragma unroll
    for (int i = 0; i < 2; ++i)
#pragma unroll
      for (int j = 0; j < 2; ++j)
#pragma unroll
        for (int e = 0; e < 16; ++e) {
          int row = m0 + wm * 64 + i * 32 + (e & 3) + 8 * (e >> 2) + 4 * hh;
          int col = n0 + wn * 64 + j * 32 + r;
          epi(row, col, acc[i][j][e]);
        }
  }
}

struct EpiBf16 {
  bf16_t* C; int ldc;
  __device__ __forceinline__ void operator()(int row, int col, float v) const { C[(size_t)row * ldc + col] = f2bf(v); }
};
struct EpiSsdIn {
  bf16_t* z; bf16_t* xbc; float* dt; const float* dt_bias;
  __device__ __forceinline__ void operator()(int row, int col, float v) const {
    if (col < 2048) z[(size_t)row * 2048 + col] = f2bf(v);
    else if (col < 6144) xbc[(size_t)row * 4096 + (col - 2048)] = f2bf(v);
    else if (col < 6208) dt[(size_t)row * 64 + (col - 6144)] = softplusf(v + dt_bias[col - 6144]);
  }
};
struct EpiOut {
  float* xres; const float* modv_layer; const float* rstd;
  __device__ __forceinline__ void operator()(int row, int col, float v) const {
    int mrow = row < T_CTX ? 0 : 1 + ((row - T_CTX) >> 12);
    float g = modv_layer[(size_t)mrow * 3072 + 2048 + col];
    float rs = rstd ? rstd[row] : 1.f;
    size_t idx = (size_t)row * DM + col;
    xres[idx] = ALPHA_RES * xres[idx] + g * (v * rs);
  }
};
struct EpiLruGate {
  bf16_t* gates; const float* gate_b; int nb;
  __device__ __forceinline__ void operator()(int row, int col, float v) const {
    int dg = col >> 8, ch = nb * 256 + (col & 255);
    float pre = v + gate_b[dg * 1024 + ch];
    gates[((size_t)dg * T_ALL + row) * 1024 + ch] = f2bf(sigmoidf(pre));
  }
};

template <int KW, bool SILU>
__device__ __forceinline__ void phase_dwconv(const bf16_t* __restrict__ src, int ld_src, bf16_t* __restrict__ dst, int ld_dst, int CH,
                             const float* __restrict__ w, const float* __restrict__ b, bool colmajor, int bid, int nblk) {
  const int tidx = opaque_tid();
  const int cpr = CH / 8;
  const size_t total = (size_t)T_ALL * cpr;
  for (size_t idx = (size_t)bid * NTHR + tidx; idx < total; idx += (size_t)nblk * NTHR) {
    int tok = (int)(idx / cpr), c0 = (int)(idx % cpr) * 8;
    TokInfo ti = tokinfo(tok);
    bool cm = colmajor && ti.s >= 32;
    int pos = seqpos2off(ti.l, cm);
    float acc[8];
#pragma unroll
    for (int e = 0; e < 8; ++e) acc[e] = b[c0 + e];
#pragma unroll
    for (int k = 0; k < KW; ++k) {
      int pp = pos + k - 1;
      if (pp < 0 || pp >= ti.L) continue;
      int tk = ti.base + seqpos2off(pp, cm);
      u32x4 xv = *(const u32x4*)(src + (size_t)tk * ld_src + c0);
      const float* wk = w + (size_t)k * CH + c0;
      acc[0] += wk[0] * bflo(xv.x); acc[1] += wk[1] * bfhi(xv.x);
      acc[2] += wk[2] * bflo(xv.y); acc[3] += wk[3] * bfhi(xv.y);
      acc[4] += wk[4] * bflo(xv.z); acc[5] += wk[5] * bfhi(xv.z);
      acc[6] += wk[6] * bflo(xv.w); acc[7] += wk[7] * bfhi(xv.w);
    }
    if (SILU) {
#pragma unroll
      for (int e = 0; e < 8; ++e) acc[e] = siluf(acc[e]);
    }
    u32x4 o;
    o.x = pack2(acc[0], acc[1]); o.y = pack2(acc[2], acc[3]); o.z = pack2(acc[4], acc[5]); o.w = pack2(acc[6], acc[7]);
    *(u32x4*)(dst + (size_t)tok * ld_dst + c0) = o;
  }
}

__device__ __forceinline__ void phase_ssd_scan_naive(const Params& p, int slot, bool colmajor, int bid, int nblk, unsigned char* smem) {
  const int tidx = opaque_tid();
  const bf16_t* xbcc = (const bf16_t*)(p.scratch + SC_SSD_XBCC);
  const float* dtb = (const float*)(p.scratch + SC_SSD_DT);
  bf16_t* ybuf = (bf16_t*)(p.scratch + SC_SSD_XBC);
  bf16_t* sB = (bf16_t*)smem;
  bf16_t* sC = sB + 64 * 128;
  bf16_t* sx = sC + 64 * 128;
  float* sdt = (float*)(sx + 64 * 64);
  float* sy = sdt + 64;
  int* stok = (int*)(sy + 64 * 64);
  const int tid = tidx, pp = tid >> 2, q = tid & 3;
  for (int item = bid; item < 36 * 64; item += nblk) {
    int s, h, dir;
    if (item < 256) { s = 32 + (item >> 6); h = (item & 63) >> 1; dir = item & 1; }
    else { int it = item - 256; s = it >> 6; h = (it & 63) >> 1; dir = it & 1; }
    const int L = s < 32 ? 256 : 4096;
    const int base = s < 32 ? s * 256 : T_CTX + (s - 32) * 4096;
    const bool cm = colmajor && s >= 32;
    const int g = h >> 2;
    const float Aval = -expf(p.ssd_a_log[(slot * 2 + dir) * 32 + h]);
    float hreg[32];
    if (s >= 32) {
      const float* h0 = p.state_ssd + ((((size_t)(s - 32) * 2 + slot) * 2 + dir) * 32 + h) * 8192 + pp * 128 + q * 32;
#pragma unroll
      for (int e = 0; e < 32; ++e) hreg[e] = h0[e];
    } else {
#pragma unroll
      for (int e = 0; e < 32; ++e) hreg[e] = 0.f;
    }
    for (int cs = 0; cs < L / 64; ++cs) {
      __syncthreads();
      if (tid < 64) {
        int j = cs * 64 + tid;
        int pos = dir ? L - 1 - j : j;
        int tok = base + seqpos2off(pos, cm);
        stok[tid] = tok;
        sdt[tid] = dtb[(size_t)tok * 64 + dir * 32 + h];
      }
      __syncthreads();
      for (int ch = tid; ch < 64 * 40; ch += NTHR) {
        int jj = ch / 40, part = ch % 40;
        const bf16_t* rowp = xbcc + (size_t)stok[jj] * 4096;
        if (part < 16) *(u32x4*)(sB + jj * 128 + part * 8) = *(const u32x4*)(rowp + 2048 + g * 128 + part * 8);
        else if (part < 32) *(u32x4*)(sC + jj * 128 + (part - 16) * 8) = *(const u32x4*)(rowp + 3072 + g * 128 + (part - 16) * 8);
        else *(u32x4*)(sx + jj * 64 + (part - 32) * 8) = *(const u32x4*)(rowp + h * 64 + (part - 32) * 8);
      }
      __syncthreads();
      for (int jj = 0; jj < 64; ++jj) {
        float dtv = sdt[jj];
        float dec = __expf(dtv * Aval);
        float xv = bf2f(sx[jj * 64 + pp]) * dtv;
        float acc = 0.f;
#pragma unroll
        for (int e4 = 0; e4 < 4; ++e4) {
          u32x4 bv = *(const u32x4*)(sB + jj * 128 + q * 32 + e4 * 8);
          u32x4 cv = *(const u32x4*)(sC + jj * 128 + q * 32 + e4 * 8);
          unsigned bw[4] = {bv.x, bv.y, bv.z, bv.w}, cw[4] = {cv.x, cv.y, cv.z, cv.w};
#pragma unroll
          for (int e = 0; e < 4; ++e) {
            float h0v = hreg[e4 * 8 + e * 2] * dec + xv * bflo(bw[e]);
            float h1v = hreg[e4 * 8 + e * 2 + 1] * dec + xv * bfhi(bw[e]);
            hreg[e4 * 8 + e * 2] = h0v; hreg[e4 * 8 + e * 2 + 1] = h1v;
            acc += bflo(cw[e]) * h0v + bfhi(cw[e]) * h1v;
          }
        }
        acc += __shfl_xor(acc, 1);
        acc += __shfl_xor(acc, 2);
        if (q == 0) sy[jj * 64 + pp] = acc;
      }
      __syncthreads();
      {
        int jj = tid >> 2, part = tid & 3;
        bf16_t* yo = ybuf + ((size_t)dir * T_ALL + stok[jj]) * 2048 + h * 64 + part * 16;
        const float* sv = sy + jj * 64 + part * 16;
        u32x4 o0, o1;
        o0.x = pack2(sv[0], sv[1]); o0.y = pack2(sv[2], sv[3]); o0.z = pack2(sv[4], sv[5]); o0.w = pack2(sv[6], sv[7]);
        o1.x = pack2(sv[8], sv[9]); o1.y = pack2(sv[10], sv[11]); o1.z = pack2(sv[12], sv[13]); o1.w = pack2(sv[14], sv[15]);
        *(u32x4*)yo = o0; *(u32x4*)(yo + 8) = o1;
      }
    }
    if (s < 32) {
      float* ho = p.out_ssd + ((((size_t)s * 2 + slot) * 2 + dir) * 32 + h) * 8192 + pp * 128 + q * 32;
#pragma unroll
      for (int e = 0; e < 32; ++e) ho[e] = hreg[e];
    }
  }
}

__device__ __forceinline__ void phase_ssd_gate(const Params& p, int slot, int bid, int nblk) {
  const int tidx = opaque_tid();
  bf16_t* zb = (bf16_t*)(p.scratch + SC_SSD_Z);
  const bf16_t* yfb = (const bf16_t*)(p.scratch + SC_SSD_XBC);
  const bf16_t* ybb = yfb + (size_t)T_ALL * 2048;
  const bf16_t* xbcc = (const bf16_t*)(p.scratch + SC_SSD_XBCC);
  int lane = tidx & 63, wv = tidx >> 6;
  for (int row = bid * 4 + wv; row < T_ALL; row += nblk * 4) {
    float ss = 0.f;
#pragma unroll
    for (int j = 0; j < 4; ++j) {
      int c0 = j * 512 + lane * 8;
      u32x4 zv = *(const u32x4*)(zb + (size_t)row * 2048 + c0);
      u32x4 fv = *(const u32x4*)(yfb + (size_t)row * 2048 + c0);
      u32x4 bv = *(const u32x4*)(ybb + (size_t)row * 2048 + c0);
      u32x4 xv = *(const u32x4*)(xbcc + (size_t)row * 4096 + c0);
      float dsk = p.ssd_d[slot * 32 + (c0 >> 6)];
      unsigned zw[4] = {zv.x, zv.y, zv.z, zv.w}, fw[4] = {fv.x, fv.y, fv.z, fv.w}, bw[4] = {bv.x, bv.y, bv.z, bv.w}, xw[4] = {xv.x, xv.y, xv.z, xv.w};
      unsigned ow[4];
#pragma unroll
      for (int e = 0; e < 4; ++e) {
        float y0 = (bflo(fw[e]) + bflo(bw[e]) + dsk * bflo(xw[e])) * siluf(bflo(zw[e]));
        float y1 = (bfhi(fw[e]) + bfhi(bw[e]) + dsk * bfhi(xw[e])) * siluf(bfhi(zw[e]));
        ss += y0 * y0 + y1 * y1;
        ow[e] = pack2(y0, y1);
      }
      u32x4 o; o.x = ow[0]; o.y = ow[1]; o.z = ow[2]; o.w = ow[3];
      *(u32x4*)(zb + (size_t)row * 2048 + c0) = o;
    }
#pragma unroll
    for (int o = 32; o > 0; o >>= 1) ss += __shfl_xor(ss, o);
    if (lane == 0) p.rstd[row] = rsqrtf(ss * (1.f / 2048.f) + 1e-5f);
  }
}

__device__ __forceinline__ void phase_hy_longconv_naive(const Params& p, int order, int bid, int nblk) {
  const int tidx = opaque_tid();
  const bf16_t* proj = (const bf16_t*)(p.scratch + SC_HY_PROJ);
  const bf16_t* vxc = (const bf16_t*)(p.scratch + SC_HY_VXC);
  bf16_t* u1 = (bf16_t*)(p.scratch + SC_HY_U1);
  bf16_t* yg = (bf16_t*)(p.scratch + SC_HY_YG);
  const bf16_t* uin = order == 0 ? vxc : u1;
  const int ldu = order == 0 ? 3072 : 1024;
  const bf16_t* gate = vxc + (order == 0 ? 1024 : 2048);
  bf16_t* out = order == 0 ? u1 : yg;
  const int items_lat = 4 * 4 * 256, items_ctx = 32 * 4 * 16;
  for (int item = bid; item < items_lat + items_ctx; item += nblk) {
    int s, cb, tt, L;
    if (item < items_lat) { s = 32 + (item >> 10); cb = (item >> 8) & 3; tt = item & 255; L = 4096; }
    else { int it = item - items_lat; s = it >> 6; cb = (it >> 4) & 3; tt = it & 15; L = 256; }
    const int base = s < 32 ? s * 256 : T_CTX + (s - 32) * 4096;
    const int c = cb * 256 + tidx;
    const int t0 = tt * 16;
    const float* kt = (L == 256 ? p.ktab0 : p.ktab1) + (size_t)order * 2 * L * 1024 + c;
    float acc[16];
#pragma unroll
    for (int j = 0; j < 16; ++j) acc[j] = 0.f;
    for (int sb = 0; sb < L; sb += 16) {
      const int kb = L + t0 - sb - 15;
      float kw[31];
#pragma unroll
      for (int qq = 0; qq < 31; ++qq) kw[qq] = kt[(size_t)(kb + qq) * 1024];
#pragma unroll
      for (int r = 0; r < 16; ++r) {
        float uv = bf2f(uin[(size_t)(base + sb + r) * ldu + c]);
#pragma unroll
        for (int j = 0; j < 16; ++j) acc[j] += kw[j - r + 15] * uv;
      }
    }
    const float inv = 1.f / p.knorm[((L == 256 ? 0 : 1) * 2 + order) * 1024 + c];
    const float bias = p.hy_f_bias[order * 1024 + c];
#pragma unroll
    for (int j = 0; j < 16; ++j) {
      int tok = base + t0 + j;
      float uv = bf2f(uin[(size_t)tok * ldu + c]);
      float res = inv * acc[j] + bias * uv;
      res *= bf2f(gate[(size_t)tok * 3072 + c]);
      if (order == 1) res *= siluf(bf2f(proj[(size_t)tok * 4096 + 3072 + c]));
      out[(size_t)tok * 1024 + c] = f2bf(res);
    }
  }
}

__device__ __forceinline__ void lru_ab(const bf16_t* gates, const bf16_t* xc, int dir, int tok, int c, float sp, float& a, float& bx) {
  float r = bf2f(gates[((size_t)(dir * 2 + 0) * T_ALL + tok) * 1024 + c]);
  float i = bf2f(gates[((size_t)(dir * 2 + 1) * T_ALL + tok) * 1024 + c]);
  float x = bf2f(xc[(size_t)tok * 1024 + c]);
  float log_a = -8.f * r * sp;
  a = __expf(log_a);
  float m = sqrtf(fmaxf(1.f - __expf(2.f * log_a), 0.f));
  bx = m * i * x;
}
__device__ __forceinline__ void phase_lru_scan_chunks(const Params& p, int pass, int bid, int nblk) {
  const int tidx = opaque_tid();
  const bf16_t* gates = (const bf16_t*)(p.scratch + SC_LRU_GATES);
  const bf16_t* xc = (const bf16_t*)(p.scratch + SC_LRU_XC);
  bf16_t* ybuf = (bf16_t*)(p.scratch + SC_LRU_Y);
  for (int item = bid; item < 192 * 8; item += nblk) {
    int chunk = item >> 3, dir = (item >> 2) & 1, cb = item & 3;
    int c = cb * 256 + tidx;
    float sp = softplusf(-p.lru_a_param[dir * 1024 + c]);
    int tok0 = chunk * 128;
    float A = 1.f, h = (pass == 0) ? 0.f : p.lru_hin[((size_t)dir * 192 + chunk) * 1024 + c];
    for (int j = 0; j < 128; ++j) {
      int tok = dir ? tok0 + 127 - j : tok0 + j;
      float a, bx;
      lru_ab(gates, xc, dir, tok, c, sp, a, bx);
      h = a * h + bx; A *= a;
      if (pass == 2) ybuf[((size_t)dir * T_ALL + tok) * 1024 + c] = f2bf(h);
    }
    if (pass == 0) {
      float* ag = p.lru_agg + (((size_t)dir * 192 + chunk) * 1024 + c) * 2;
      ag[0] = A; ag[1] = h;
    }
  }
}
__device__ __forceinline__ void phase_lru_scan_carry(const Params& p, int bid, int nblk) {
  const int tidx = opaque_tid();
  for (int item = bid; item < 36 * 8; item += nblk) {
    int s = item >> 3, dir = (item >> 2) & 1, cb = item & 3;
    int c = cb * 256 + tidx;
    int nch = s < 32 ? 2 : 32;
    int ch0 = s < 32 ? s * 2 : 64 + (s - 32) * 32;
    float h = s < 32 ? 0.f : p.state_lru[((size_t)(s - 32) * 2 + dir) * 1024 + c];
    for (int k = 0; k < nch; ++k) {
      int chunk = dir ? ch0 + nch - 1 - k : ch0 + k;
      size_t idx = ((size_t)dir * 192 + chunk) * 1024 + c;
      p.lru_hin[idx] = h;
      h = p.lru_agg[idx * 2] * h + p.lru_agg[idx * 2 + 1];
    }
    if (s < 32) p.out_lru[((size_t)s * 2 + dir) * 1024 + c] = h;
  }
}
__device__ __forceinline__ void phase_lru_combine(const Params& p, int bid, int nblk) {
  const int tidx = opaque_tid();
  const bf16_t* proj = (const bf16_t*)(p.scratch + SC_LRU_PROJ);
  const bf16_t* yf = (const bf16_t*)(p.scratch + SC_LRU_Y);
  const bf16_t* yb = yf + (size_t)T_ALL * 1024;
  bf16_t* yg = (bf16_t*)(p.scratch + SC_LRU_YG);
  const size_t total = (size_t)T_ALL * 128;
  for (size_t idx = (size_t)bid * NTHR + tidx; idx < total; idx += (size_t)nblk * NTHR) {
    int tok = (int)(idx >> 7), c0 = (int)(idx & 127) * 8;
    u32x4 fv = *(const u32x4*)(yf + (size_t)tok * 1024 + c0);
    u32x4 bv = *(const u32x4*)(yb + (size_t)tok * 1024 + c0);
    u32x4 zv = *(const u32x4*)(proj + (size_t)tok * 2048 + 1024 + c0);
    unsigned fw[4] = {fv.x, fv.y, fv.z, fv.w}, bw[4] = {bv.x, bv.y, bv.z, bv.w}, zw[4] = {zv.x, zv.y, zv.z, zv.w}, ow[4];
#pragma unroll
    for (int e = 0; e < 4; ++e)
      ow[e] = pack2((bflo(fw[e]) + bflo(bw[e])) * siluf(bflo(zw[e])), (bfhi(fw[e]) + bfhi(bw[e])) * siluf(bfhi(zw[e])));
    u32x4 o; o.x = ow[0]; o.y = ow[1]; o.z = ow[2]; o.w = ow[3];
    *(u32x4*)(yg + (size_t)tok * 1024 + c0) = o;
  }
}

enum { PH_PREP = 0, PH_MOD, PH_HYA, PH_HYB, PH_LNMOD, PH_INPROJ, PH_MIX1, PH_MIX2, PH_MIX3, PH_MIX4, PH_MIX5, PH_MIX6, PH_OUTPROJ };

__device__ __forceinline__ void run_phase(const Params& p, int ph, int layer, int bid, int nblk, unsigned char* smem) {
  const int kind = layer % 3, slot = layer / 3;
  bid = opaque_s(bid);
  switch (ph) {
    case PH_PREP: phase_prep(p, bid, nblk, smem); break;
    case PH_MOD: phase_mod(p, bid, nblk, smem); break;
    case PH_HYA: phase_hyfilt_a(p, bid, nblk, smem); break;
    case PH_HYB: phase_hyfilt_b(p, bid, nblk, smem); break;
    case PH_LNMOD: phase_lnmod(p, layer, bid, nblk); break;
    case PH_INPROJ:
      if (kind == 0) {
        EpiSsdIn e{(bf16_t*)(p.scratch + SC_SSD_Z), (bf16_t*)(p.scratch + SC_SSD_XBC), (float*)(p.scratch + SC_SSD_DT), p.ssd_dt_bias + slot * 64};
        gemm_phase(p.hbuf, 1024, p.wt_ssd_in + (size_t)slot * 6272 * 1024, 1024, T_ALL / 128, 49, e, bid, nblk, smem);
      } else if (kind == 1) {
        EpiBf16 e{(bf16_t*)(p.scratch + SC_HY_PROJ), 4096};
        gemm_phase(p.hbuf, 1024, p.wt_hy_in, 1024, T_ALL / 128, 32, e, bid, nblk, smem);
      } else {
        EpiBf16 e{(bf16_t*)(p.scratch + SC_LRU_PROJ), 2048};
        gemm_phase(p.hbuf, 1024, p.wt_lru_in, 1024, T_ALL / 128, 16, e, bid, nblk, smem);
      }
      break;
    case PH_MIX1:
      if (kind == 0) phase_dwconv<4, true>((const bf16_t*)(p.scratch + SC_SSD_XBC), 4096, (bf16_t*)(p.scratch + SC_SSD_XBCC), 4096, 4096,
                                           p.ssd_conv_w + (size_t)slot * 4 * 4096, p.ssd_conv_b + slot * 4096, slot == 1, bid, nblk);
      else if (kind == 1) phase_dwconv<3, false>((const bf16_t*)(p.scratch + SC_HY_PROJ), 4096, (bf16_t*)(p.scratch + SC_HY_VXC), 3072, 3072,
                                                 p.hy_conv_w, p.hy_conv_b, false, bid, nblk);
      else phase_dwconv<4, false>((const bf16_t*)(p.scratch + SC_LRU_PROJ), 2048, (bf16_t*)(p.scratch + SC_LRU_XC), 1024, 1024,
                                  p.lru_conv_w, p.lru_conv_b, false, bid, nblk);
      break;
    case PH_MIX2:
      if (kind == 0) phase_ssd_scan_naive(p, slot, slot == 1, bid, nblk, smem);
      else if (kind == 1) phase_hy_longconv_naive(p, 0, bid, nblk);
      else {
        for (int nb = 0; nb < 4; ++nb) {
          EpiLruGate e{(bf16_t*)(p.scratch + SC_LRU_GATES), p.lru_gate_b, nb};
          gemm_phase((const bf16_t*)(p.scratch + SC_LRU_XC) + nb * 256, 1024, p.wt_lru_gate + (size_t)nb * 1024 * 256, 256, T_ALL / 128, 8, e, bid, nblk, smem);
        }
      }
      break;
    case PH_MIX3:
      if (kind == 0) phase_ssd_gate(p, slot, bid, nblk);
      else if (kind == 1) phase_hy_longconv_naive(p, 1, bid, nblk);
      else phase_lru_scan_chunks(p, 0, bid, nblk);
      break;
    case PH_MIX4: if (kind == 2) phase_lru_scan_carry(p, bid, nblk); break;
    case PH_MIX5: if (kind == 2) phase_lru_scan_chunks(p, 2, bid, nblk); break;
    case PH_MIX6: if (kind == 2) phase_lru_combine(p, bid, nblk); break;
    case PH_OUTPROJ: {
      const float* mv = p.modv + (size_t)layer * 5 * 3072;
      if (kind == 0) {
        EpiOut e{p.xres, mv, p.rstd};
        gemm_phase((const bf16_t*)(p.scratch + SC_SSD_Z), 2048, p.wt_ssd_out + (size_t)slot * 1024 * 2048, 2048, T_ALL / 128, 8, e, bid, nblk, smem);
      } else if (kind == 1) {
        EpiOut e{p.xres, mv, nullptr};
        gemm_phase((const bf16_t*)(p.scratch + SC_HY_YG), 1024, p.wt_hy_out, 1024, T_ALL / 128, 8, e, bid, nblk, smem);
      } else {
        EpiOut e{p.xres, mv, nullptr};
        gemm_phase((const bf16_t*)(p.scratch + SC_LRU_YG), 1024, p.wt_lru_out, 1024, T_ALL / 128, 8, e, bid, nblk, smem);
      }
    } break;
  }
}

__global__ void __launch_bounds__(NTHR, 2) k_mega(Params p) {
  __shared__ __attribute__((aligned(16))) unsigned char smem[SMEM_BYTES];
  cg::grid_group grid = cg::this_grid();
  const int bid = blockIdx.x, nblk = gridDim.x;
  run_phase(p, PH_PREP, 0, bid, nblk, smem);
  run_phase(p, PH_MOD, 0, bid, nblk, smem);
  run_phase(p, PH_HYA, 0, bid, nblk, smem);
  grid.sync();
  run_phase(p, PH_HYB, 0, bid, nblk, smem);
  for (int layer = 0; layer < 4; ++layer) {
    const int kind = layer % 3;
    run_phase(p, PH_LNMOD, layer, bid, nblk, smem);
    grid.sync();
    run_phase(p, PH_INPROJ, layer, bid, nblk, smem);
    grid.sync();
    run_phase(p, PH_MIX1, layer, bid, nblk, smem);
    grid.sync();
    run_phase(p, PH_MIX2, layer, bid, nblk, smem);
    grid.sync();
    run_phase(p, PH_MIX3, layer, bid, nblk, smem);
    grid.sync();
    if (kind == 2) {
      run_phase(p, PH_MIX4, layer, bid, nblk, smem);
      grid.sync();
      run_phase(p, PH_MIX5, layer, bid, nblk, smem);
      grid.sync();
      run_phase(p, PH_MIX6, layer, bid, nblk, smem);
      grid.sync();
    }
    run_phase(p, PH_OUTPROJ, layer, bid, nblk, smem);
    grid.sync();
  }
  run_phase(p, PH_LNMOD, 4, bid, nblk, smem);
}

static inline size_t align_up(size_t x) { return (x + 255) & ~(size_t)255; }

extern "C" void kernel_launch(void* const* d_in, const int* in_sizes, int n_in, void* d_out, int out_size, void* d_ws, size_t ws_size,
                              hipStream_t stream) {
  Params p{};
  const float** fp = (const float**)&p;
  for (int i = 0; i < 36; ++i) fp[i] = (const float*)d_in[i];
  float* out = (float*)d_out;
  p.xres = out;
  p.out_ssd = out + (size_t)T_ALL * 1024;
  p.out_lru = p.out_ssd + (size_t)32 * 2 * 2 * 32 * 64 * 128;
  unsigned char* w = (unsigned char*)d_ws;
  size_t off = 0;
  auto carve = [&](size_t bytes) { unsigned char* r = w + off; off = align_up(off + bytes); return r; };
  p.wt_ssd_in = (bf16_t*)carve((size_t)2 * 6272 * 1024 * 2);
  p.wt_ssd_out = (bf16_t*)carve((size_t)2 * 1024 * 2048 * 2);
  p.wt_hy_in = (bf16_t*)carve((size_t)4096 * 1024 * 2);
  p.wt_hy_out = (bf16_t*)carve((size_t)1024 * 1024 * 2);
  p.wt_lru_in = (bf16_t*)carve((size_t)2048 * 1024 * 2);
  p.wt_lru_out = (bf16_t*)carve((size_t)1024 * 1024 * 2);
  p.wt_lru_gate = (bf16_t*)carve((size_t)4 * 1024 * 256 * 2);
  p.modv = (float*)carve((size_t)4 * 5 * 3072 * 4);
  p.hdn2 = (float*)carve((size_t)4352 * 64 * 4);
  p.ktab0 = (float*)carve((size_t)2 * 512 * 1024 * 4);
  p.ktab1 = (float*)carve((size_t)2 * 8192 * 1024 * 4);
  p.knorm = (float*)carve((size_t)4 * 1024 * 4);
  p.hbuf = (bf16_t*)carve((size_t)T_ALL * 1024 * 2);
  p.rstd = (float*)carve((size_t)T_ALL * 4);
  p.lru_agg = (float*)carve((size_t)2 * 192 * 1024 * 2 * 4);
  p.lru_hin = (float*)carve((size_t)2 * 192 * 1024 * 4);
  p.scratch = carve(SC_TOTAL);
  if (off > ws_size) return;

  static int grid_blocks = 0;
  if (!grid_blocks) {
    int dev = 0, cus = 0, per_cu = 0;
    hipGetDevice(&dev);
    hipDeviceGetAttribute(&cus, hipDeviceAttributeMultiprocessorCount, dev);
    hipOccupancyMaxActiveBlocksPerMultiprocessor(&per_cu, k_mega, NTHR, 0);
    if (per_cu > 2) per_cu = 2;
    grid_blocks = cus * per_cu;
  }
  void* args[] = {&p};
  hipError_t e = hipLaunchCooperativeKernel((void*)k_mega, dim3(grid_blocks), dim3(NTHR), args, 0, stream);
  if (e != hipSuccess) fprintf(stderr, "cooperative launch failed: %s (grid %d)\n", hipGetErrorString(e), grid_blocks);
}
```

```cpp
#include <hip/hip_runtime.h>
#include <hip/hip_bf16.h>
#include <hip/hip_cooperative_groups.h>
#include <stdint.h>
#include <cstdio>
namespace cg = cooperative_groups;

typedef unsigned short bf16_t;
typedef __attribute__((ext_vector_type(8))) short bf16x8;
typedef __attribute__((ext_vector_type(16))) float f32x16;
typedef __attribute__((ext_vector_type(4))) unsigned int u32x4;
typedef __attribute__((ext_vector_type(2))) unsigned int u32x2;
typedef __attribute__((ext_vector_type(4))) float f32x4;

#define T_CTX 8192
#define T_ALL 24576
#define DM 1024
#define NTHR 256
#define SMEM_BYTES 69632
#define ALPHA_RES 1.6817928305074290f
#define LN_EPS 1e-5f

__device__ __forceinline__ bf16_t f2bf(float f) {
  unsigned u = __float_as_uint(f);
  u += 0x7fffu + ((u >> 16) & 1u);
  return (bf16_t)(u >> 16);
}
__device__ __forceinline__ float bf2f(bf16_t b) { return __uint_as_float(((unsigned)b) << 16); }
__device__ __forceinline__ float bflo(unsigned w) { return __uint_as_float(w << 16); }
__device__ __forceinline__ float bfhi(unsigned w) { return __uint_as_float(w & 0xffff0000u); }
__device__ __forceinline__ unsigned pack2(float a, float b) { return (unsigned)f2bf(a) | ((unsigned)f2bf(b) << 16); }
__device__ __forceinline__ float siluf(float x) { return x / (1.f + __expf(-x)); }
__device__ __forceinline__ float sigmoidf(float x) { return 1.f / (1.f + __expf(-x)); }
__device__ __forceinline__ float softplusf(float x) { return x > 20.f ? x : log1pf(expf(x)); }

__device__ __forceinline__ int opaque_tid() { int t = threadIdx.x; asm volatile("" : "+v"(t)); return t; }
__device__ __forceinline__ int opaque_s(int x) { asm volatile("" : "+s"(x)); return x; }

struct TokInfo { int s, l, L, base, mrow; };
__device__ __forceinline__ TokInfo tokinfo(int tok) {
  TokInfo t;
  if (tok < T_CTX) { t.s = tok >> 8; t.l = tok & 255; t.L = 256; t.base = tok & ~255; t.mrow = 0; }
  else { int u = tok - T_CTX; t.s = 32 + (u >> 12); t.l = u & 4095; t.L = 4096; t.base = T_CTX + (u & ~4095); t.mrow = 1 + (u >> 12); }
  return t;
}
__device__ __forceinline__ int seqpos2off(int pos, bool cm) { return cm ? (((pos & 63) << 6) | (pos >> 6)) : pos; }

struct Params {
  const float *x_prompt, *x_sample, *state_ssd, *state_lru, *c, *c_ctx, *mod_w, *mod_b, *ln_g, *ln_b;
  const float *ssd_in_w, *ssd_conv_w, *ssd_conv_b, *ssd_dt_bias, *ssd_a_log, *ssd_d, *ssd_norm_g, *ssd_out_w;
  const float *hy_in_w, *hy_conv_w, *hy_conv_b, *hy_f_w1, *hy_f_b1, *hy_f_w2, *hy_f_b2, *hy_f_w3, *hy_f_freq, *hy_f_bias, *hy_out_w;
  const float *lru_in_w, *lru_conv_w, *lru_conv_b, *lru_gate_w, *lru_gate_b, *lru_a_param, *lru_out_w;
  float *xres, *out_ssd, *out_lru;
  bf16_t *wt_ssd_in, *wt_ssd_out, *wt_hy_in, *wt_hy_out, *wt_lru_in, *wt_lru_out, *wt_lru_gate;
  float *modv;
  float *hdn2;
  bf16_t *rtab0;
  bf16_t *rtab1;
  float *knorm;
  bf16_t *hbuf;
  float *rstd;
  float *lru_agg;
  float *lru_hin;
  unsigned char *scratch;
};

#define SC_SSD_Z     ((size_t)0)
#define SC_SSD_XBC   ((size_t)T_ALL * 2048 * 2)
#define SC_SSD_XBCC  (SC_SSD_XBC + (size_t)T_ALL * 4096 * 2)
#define SC_SSD_DT    (SC_SSD_XBCC + (size_t)T_ALL * 4096 * 2)
#define SC_SSD_END   (SC_SSD_DT + (size_t)T_ALL * 64 * 4)
#define SC_HY_PROJT  ((size_t)0)
#define SC_HY_YT     ((size_t)T_ALL * 4096 * 2)
#define SC_HY_YG     (SC_HY_YT + (size_t)T_ALL * 1024 * 2)
#define SC_LRU_PROJ  ((size_t)0)
#define SC_LRU_XC    ((size_t)T_ALL * 2048 * 2)
#define SC_LRU_GATES (SC_LRU_XC + (size_t)T_ALL * 1024 * 2)
#define SC_LRU_Y     (SC_LRU_GATES + (size_t)T_ALL * 4096 * 2)
#define SC_LRU_YG    (SC_LRU_Y + (size_t)T_ALL * 2048 * 2)
#define SC_TOTAL     SC_SSD_END

__device__ __forceinline__ void transpose_tile(const float* __restrict__ src, int ld_src, int n_src, bf16_t* __restrict__ dst, int K,
                               const float* __restrict__ scale, int tile, int tiles_k, float* tl) {
  const int tidx = opaque_tid();
  int tk = tile % tiles_k, tn = tile / tiles_k;
  int k0 = tk * 64, n0 = tn * 64;
  int tx = tidx & 63, ty = tidx >> 6;
  __syncthreads();
  for (int r = ty; r < 64; r += 4) {
    int n = n0 + tx;
    float v = 0.f;
    if (n < n_src) { v = src[(size_t)(k0 + r) * ld_src + n]; if (scale) v *= scale[k0 + r]; }
    tl[r * 65 + tx] = v;
  }
  __syncthreads();
  for (int r = ty; r < 64; r += 4) dst[(size_t)(n0 + r) * K + k0 + tx] = f2bf(tl[tx * 65 + r]);
}

__device__ __forceinline__ void phase_prep(const Params& p, int bid, int nblk, unsigned char* smem) {
  const int tidx = opaque_tid();
  float* tl = (float*)smem;
  for (int job = 0; job < 24; ++job) {
    const float* src; int ld, nsrc, K, npad; bf16_t* dst; const float* scale = nullptr;
    if (job < 2) { src = p.ssd_in_w + (size_t)job * 1024 * 6208; ld = 6208; nsrc = 6208; K = 1024; npad = 6272; dst = p.wt_ssd_in + (size_t)job * 6272 * 1024; }
    else if (job < 4) { int s = job - 2; src = p.ssd_out_w + (size_t)s * 2048 * 1024; ld = 1024; nsrc = 1024; K = 2048; npad = 1024; dst = p.wt_ssd_out + (size_t)s * 1024 * 2048; scale = p.ssd_norm_g + s * 2048; }
    else if (job == 4) { src = p.hy_in_w; ld = 4096; nsrc = 4096; K = 1024; npad = 4096; dst = p.wt_hy_in; }
    else if (job == 5) { src = p.hy_out_w; ld = 1024; nsrc = 1024; K = 1024; npad = 1024; dst = p.wt_hy_out; }
    else if (job == 6) { src = p.lru_in_w; ld = 2048; nsrc = 2048; K = 1024; npad = 2048; dst = p.wt_lru_in; }
    else if (job == 7) { src = p.lru_out_w; ld = 1024; nsrc = 1024; K = 1024; npad = 1024; dst = p.wt_lru_out; }
    else { int q = job - 8; int dg = q >> 2, n = q & 3;
      src = p.lru_gate_w + (size_t)(dg * 4 + n) * 65536; ld = 256; nsrc = 256; K = 256; npad = 256;
      dst = p.wt_lru_gate + (size_t)n * 1024 * 256 + (size_t)dg * 256 * 256; }
    int tiles_k = K / 64, tiles = tiles_k * (npad / 64);
    for (int t = bid; t < tiles; t += nblk) transpose_tile(src, ld, nsrc, dst, K, scale, t, tiles_k, tl);
  }
  for (int i = bid * NTHR + tidx; i < 2 * 2 * 1024; i += nblk * NTHR) p.knorm[i] = 0.f;
}

__device__ __forceinline__ void phase_mod(const Params& p, int bid, int nblk, unsigned char* smem) {
  const int tidx = opaque_tid();
  float* sc = (float*)smem;
  __syncthreads();
  for (int i = tidx; i < 5 * 1024; i += NTHR) {
    int r = i >> 10, k = i & 1023;
    float v = (r == 0) ? p.c_ctx[k] : p.c[(r - 1) * 1024 + k];
    sc[i] = siluf(v);
  }
  __syncthreads();
  for (int item = bid; item < 4 * 12; item += nblk) {
    int layer = item / 12, j = (item % 12) * 256 + tidx;
    const float* w = p.mod_w + (size_t)layer * 1024 * 3072 + j;
    float a0 = 0, a1 = 0, a2 = 0, a3 = 0, a4 = 0;
    for (int k = 0; k < 1024; ++k) {
      float wv = w[(size_t)k * 3072];
      a0 += sc[k] * wv; a1 += sc[1024 + k] * wv; a2 += sc[2048 + k] * wv; a3 += sc[3072 + k] * wv; a4 += sc[4096 + k] * wv;
    }
    float b = p.mod_b[layer * 3072 + j];
    float* o = p.modv + (size_t)layer * 5 * 3072 + j;
    o[0] = a0 + b; o[3072] = a1 + b; o[2 * 3072] = a2 + b; o[3 * 3072] = a3 + b; o[4 * 3072] = a4 + b;
  }
}

__device__ __forceinline__ void phase_hyfilt_a(const Params& p, int bid, int nblk, unsigned char* smem) {
  const int tidx = opaque_tid();
  float* sz = (float*)smem;
  float* sh = sz + 4 * 36;
  int pl = tidx >> 6, m = tidx & 63;
  for (int item = bid; item < 4352 / 4; item += nblk) {
    int pos = item * 4 + pl;
    int L = pos < 256 ? 256 : 4096;
    int l = pos < 256 ? pos : pos - 256;
    __syncthreads();
    if (m < 33) {
      float t = (float)l / (float)L;
      float w = (6.283185307179586f * (float)l) / (float)L;
      float v;
      if (m == 0) v = t;
      else {
        int j = (m - 1) & 15;
        float fr = 1e-4f + (float)j * ((15.f - 1e-4f) / 15.f);
        float ang = w * fr;
        v = (m <= 16) ? __cosf(ang) : __sinf(ang);
      }
      sz[pl * 36 + m] = v;
    }
    __syncthreads();
    float a = p.hy_f_b1[m];
    for (int e = 0; e < 33; ++e) a += sz[pl * 36 + e] * p.hy_f_w1[e * 64 + m];
    a = __sinf(p.hy_f_freq[m] * a);
    sh[pl * 64 + m] = a;
    __syncthreads();
    float b = p.hy_f_b2[m];
    for (int e = 0; e < 64; ++e) b += sh[pl * 64 + e] * p.hy_f_w2[e * 64 + m];
    b = __sinf(p.hy_f_freq[64 + m] * b);
    p.hdn2[(size_t)pos * 64 + m] = b;
  }
}

__device__ __forceinline__ void phase_hyfilt_b(const Params& p, int bid, int nblk, unsigned char* smem) {
  const int tidx = opaque_tid();
  const int lane = tidx & 63;
  for (int item = bid; item < 17 * 64; item += nblk) {
    const int lb = item >> 6, chunk = item & 63;
    const int Lsel = lb ? 1 : 0, L = Lsel ? 4096 : 256, RL = Lsel ? 8192 : 512, Lm1 = L - 1;
    const int l = Lsel ? (lb - 1) * 256 + tidx : tidx;
    const int pos = Lsel ? 256 + l : l;
    float hd[64];
#pragma unroll
    for (int m4 = 0; m4 < 16; ++m4) {
      f32x4 v = *(const f32x4*)(p.hdn2 + (size_t)pos * 64 + m4 * 4);
      hd[m4 * 4] = v.x; hd[m4 * 4 + 1] = v.y; hd[m4 * 4 + 2] = v.z; hd[m4 * 4 + 3] = v.w;
    }
    const int odc0 = chunk * 64, o = odc0 >> 11, d = (odc0 >> 10) & 1, c0 = odc0 & 1023;
    const float t = (float)l / (float)L;
    bf16_t* rt = Lsel ? p.rtab1 : p.rtab0;
    const float min_decay = -3.0701134573253945f, max_decay = -15.350567286626973f;
    for (int cc = 0; cc < 64; ++cc) {
      const int c = c0 + cc;
      const float* w3 = p.hy_f_w3 + odc0 + cc;
      float acc = 0.f;
#pragma unroll
      for (int m = 0; m < 64; ++m) acc += hd[m] * w3[(size_t)m * 4096];
      float delta = fabsf(min_decay + (float)c * ((max_decay - min_decay) / 1023.f));
      float kv = acc * expf(-t * delta);
      size_t rb = (size_t)(o * 1024 + c) * RL;
      if (d == 0) rt[rb + Lm1 - l] = f2bf(kv);
      else if (l > 0) rt[rb + Lm1 + l] = f2bf(kv);
      else rt[rb + RL - 1] = 0;
      float a = fabsf(kv);
#pragma unroll
      for (int off = 32; off > 0; off >>= 1) a += __shfl_xor(a, off);
      if (lane == 0) atomicAdd(&p.knorm[(Lsel * 2 + o) * 1024 + c], a);
    }
  }
}

__device__ __forceinline__ void phase_lnmod(const Params& p, int layer, int bid, int nblk) {
  const int tidx = opaque_tid();
  int lane = tidx & 63, wv = tidx >> 6;
  for (int row = bid * 4 + wv; row < T_ALL; row += nblk * 4) {
    const float* src = (layer == 0) ? (row < T_CTX ? p.x_prompt + (size_t)row * DM : p.x_sample + (size_t)(row - T_CTX) * DM)
                                    : p.xres + (size_t)row * DM;
    f32x4 v[4];
#pragma unroll
    for (int j = 0; j < 4; ++j) v[j] = *(const f32x4*)(src + j * 256 + lane * 4);
    if (layer > 0) {
      float s = 0.f;
#pragma unroll
      for (int j = 0; j < 4; ++j) s += v[j].x + v[j].y + v[j].z + v[j].w;
#pragma unroll
      for (int o = 32; o > 0; o >>= 1) s += __shfl_xor(s, o);
      float mu = s * (1.f / 1024.f);
      float q = 0.f;
#pragma unroll
      for (int j = 0; j < 4; ++j) { float a = v[j].x - mu, b = v[j].y - mu, c = v[j].z - mu, d = v[j].w - mu; q += a * a + b * b + c * c + d * d; }
#pragma unroll
      for (int o = 32; o > 0; o >>= 1) q += __shfl_xor(q, o);
      float rs = rsqrtf(q * (1.f / 1024.f) + LN_EPS);
      const float* g = p.ln_g + (layer - 1) * DM; const float* b = p.ln_b + (layer - 1) * DM;
#pragma unroll
      for (int j = 0; j < 4; ++j) {
        f32x4 gg = *(const f32x4*)(g + j * 256 + lane * 4), bb = *(const f32x4*)(b + j * 256 + lane * 4);
        v[j].x = (v[j].x - mu) * rs * gg.x + bb.x; v[j].y = (v[j].y - mu) * rs * gg.y + bb.y;
        v[j].z = (v[j].z - mu) * rs * gg.z + bb.z; v[j].w = (v[j].w - mu) * rs * gg.w + bb.w;
      }
    }
    float* dst = p.xres + (size_t)row * DM;
#pragma unroll
    for (int j = 0; j < 4; ++j) *(f32x4*)(dst + j * 256 + lane * 4) = v[j];
    if (layer < 4) {
      int mrow = row < T_CTX ? 0 : 1 + ((row - T_CTX) >> 12);
      const float* mv = p.modv + ((size_t)layer * 5 + mrow) * 3072;
#pragma unroll
      for (int j = 0; j < 4; ++j) {
        f32x4 sh = *(const f32x4*)(mv + j * 256 + lane * 4), sc = *(const f32x4*)(mv + 1024 + j * 256 + lane * 4);
        u32x2 o;
        o.x = pack2(v[j].x * (1.f + sc.x) + sh.x, v[j].y * (1.f + sc.y) + sh.y);
        o.y = pack2(v[j].z * (1.f + sc.z) + sh.z, v[j].w * (1.f + sc.w) + sh.w);
        *(u32x2*)(p.hbuf + (size_t)row * DM + j * 256 + lane * 4) = o;
      }
    }
  }
}

#define G_LDS_STRIDE 72
template <class Epi>
__device__ __forceinline__ void gemm_phase(const bf16_t* __restrict__ A, int lda, const bf16_t* __restrict__ Wt, int K, int Mtiles, int Ntiles,
                           Epi epi, int bid, int nblk, unsigned char* smem) {
  const int tidx = opaque_tid();
  bf16_t* sA = (bf16_t*)smem;
  bf16_t* sB = sA + 128 * G_LDS_STRIDE;
  const int tid = tidx, lane = tid & 63, w = tid >> 6;
  const int wm = w >> 1, wn = w & 1, r = lane & 31, hh = lane >> 5;
  const int nk = K / 64;
  for (int tile = bid; tile < Mtiles * Ntiles; tile += nblk) {
    const int tm = tile / Ntiles, tn = tile % Ntiles;
    const int m0 = tm * 128, n0 = tn * 128;
    f32x16 acc[2][2];
#pragma unroll
    for (int i = 0; i < 2; ++i)
#pragma unroll
      for (int j = 0; j < 2; ++j)
#pragma unroll
        for (int e = 0; e < 16; ++e) acc[i][j][e] = 0.f;
    u32x4 ra[4], rb[4];
#pragma unroll
    for (int i = 0; i < 4; ++i) {
      int q = tid + i * 256, row = q >> 3, c8 = (q & 7) * 8;
      ra[i] = *(const u32x4*)(A + (size_t)(m0 + row) * lda + c8);
      rb[i] = *(const u32x4*)(Wt + (size_t)(n0 + row) * K + c8);
    }
    for (int kt = 0; kt < nk; ++kt) {
      __syncthreads();
#pragma unroll
      for (int i = 0; i < 4; ++i) {
        int q = tid + i * 256, row = q >> 3, c8 = (q & 7) * 8;
        *(u32x4*)(sA + row * G_LDS_STRIDE + c8) = ra[i];
        *(u32x4*)(sB + row * G_LDS_STRIDE + c8) = rb[i];
      }
      __syncthreads();
      if (kt + 1 < nk) {
#pragma unroll
        for (int i = 0; i < 4; ++i) {
          int q = tid + i * 256, row = q >> 3, c8 = (q & 7) * 8;
          ra[i] = *(const u32x4*)(A + (size_t)(m0 + row) * lda + (kt + 1) * 64 + c8);
          rb[i] = *(const u32x4*)(Wt + (size_t)(n0 + row) * K + (kt + 1) * 64 + c8);
        }
      }
#pragma unroll
      for (int kk = 0; kk < 4; ++kk) {
        bf16x8 fa[2], fb[2];
#pragma unroll
        for (int i = 0; i < 2; ++i) fa[i] = *(const bf16x8*)(sA + (wm * 64 + i * 32 + r) * G_LDS_STRIDE + kk * 16 + hh * 8);
#pragma unroll
        for (int j = 0; j < 2; ++j) fb[j] = *(const bf16x8*)(sB + (wn * 64 + j * 32 + r) * G_LDS_STRIDE + kk * 16 + hh * 8);
#pragma unroll
        for (int i = 0; i < 2; ++i)
#pragma unroll
          for (int j = 0; j < 2; ++j) acc[i][j] = __builtin_amdgcn_mfma_f32_32x32x16_bf16(fa[i], fb[j], acc[i][j], 0, 0, 0);
      }
    }
#pragma unroll
    for (int i = 0; i < 2; ++i)
#pragma unroll
      for (int j = 0; j < 2; ++j)
#pragma unroll
        for (int qd = 0; qd < 4; ++qd) {
          int row0 = m0 + wm * 64 + i * 32 + 8 * qd + 4 * hh;
          int col = n0 + wn * 64 + j * 32 + r;
          epi.quad(row0, col, acc[i][j][4 * qd], acc[i][j][4 * qd + 1], acc[i][j][4 * qd + 2], acc[i][j][4 * qd + 3]);
        }
  }
}

struct EpiBf16 {
  bf16_t* C; int ldc;
  __device__ __forceinline__ void operator()(int row, int col, float v) const { C[(size_t)row * ldc + col] = f2bf(v); }
  __device__ __forceinline__ void quad(int row0, int col, float v0, float v1, float v2, float v3) const {
    (*this)(row0, col, v0); (*this)(row0 + 1, col, v1); (*this)(row0 + 2, col, v2); (*this)(row0 + 3, col, v3);
  }
};
struct EpiT {
  bf16_t* Ct; size_t ldt;
  __device__ __forceinline__ void quad(int row0, int col, float v0, float v1, float v2, float v3) const {
    u32x2 o; o.x = pack2(v0, v1); o.y = pack2(v2, v3);
    *(u32x2*)(Ct + (size_t)col * ldt + row0) = o;
  }
};
struct EpiSsdIn {
  bf16_t* z; bf16_t* xbc; float* dt; const float* dt_bias;
  __device__ __forceinline__ void operator()(int row, int col, float v) const {
    if (col < 2048) z[(size_t)row * 2048 + col] = f2bf(v);
    else if (col < 6144) xbc[(size_t)row * 4096 + (col - 2048)] = f2bf(v);
    else if (col < 6208) dt[(size_t)row * 64 + (col - 6144)] = softplusf(v + dt_bias[col - 6144]);
  }
  __device__ __forceinline__ void quad(int row0, int col, float v0, float v1, float v2, float v3) const {
    (*this)(row0, col, v0); (*this)(row0 + 1, col, v1); (*this)(row0 + 2, col, v2); (*this)(row0 + 3, col, v3);
  }
};
struct EpiOut {
  float* xres; const float* modv_layer; const float* rstd;
  __device__ __forceinline__ void operator()(int row, int col, float v) const {
    int mrow = row < T_CTX ? 0 : 1 + ((row - T_CTX) >> 12);
    float g = modv_layer[(size_t)mrow * 3072 + 2048 + col];
    float rs = rstd ? rstd[row] : 1.f;
    size_t idx = (size_t)row * DM + col;
    xres[idx] = ALPHA_RES * xres[idx] + g * (v * rs);
  }
  __device__ __forceinline__ void quad(int row0, int col, float v0, float v1, float v2, float v3) const {
    (*this)(row0, col, v0); (*this)(row0 + 1, col, v1); (*this)(row0 + 2, col, v2); (*this)(row0 + 3, col, v3);
  }
};
struct EpiLruGate {
  bf16_t* gates; const float* gate_b; int nb;
  __device__ __forceinline__ void operator()(int row, int col, float v) const {
    int dg = col >> 8, ch = nb * 256 + (col & 255);
    float pre = v + gate_b[dg * 1024 + ch];
    gates[((size_t)dg * T_ALL + row) * 1024 + ch] = f2bf(sigmoidf(pre));
  }
  __device__ __forceinline__ void quad(int row0, int col, float v0, float v1, float v2, float v3) const {
    (*this)(row0, col, v0); (*this)(row0 + 1, col, v1); (*this)(row0 + 2, col, v2); (*this)(row0 + 3, col, v3);
  }
};

template <int KW, bool SILU>
__device__ __forceinline__ void phase_dwconv(const bf16_t* __restrict__ src, int ld_src, bf16_t* __restrict__ dst, int ld_dst, int CH,
                             const float* __restrict__ w, const float* __restrict__ b, bool colmajor, int bid, int nblk) {
  const int tidx = opaque_tid();
  const int cpr = CH / 8;
  const size_t total = (size_t)T_ALL * cpr;
  for (size_t idx = (size_t)bid * NTHR + tidx; idx < total; idx += (size_t)nblk * NTHR) {
    int tok = (int)(idx / cpr), c0 = (int)(idx % cpr) * 8;
    TokInfo ti = tokinfo(tok);
    bool cm = colmajor && ti.s >= 32;
    int pos = seqpos2off(ti.l, cm);
    float acc[8];
#pragma unroll
    for (int e = 0; e < 8; ++e) acc[e] = b[c0 + e];
#pragma unroll
    for (int k = 0; k < KW; ++k) {
      int pp = pos + k - 1;
      if (pp < 0 || pp >= ti.L) continue;
      int tk = ti.base + seqpos2off(pp, cm);
      u32x4 xv = *(const u32x4*)(src + (size_t)tk * ld_src + c0);
      const float* wk = w + (size_t)k * CH + c0;
      acc[0] += wk[0] * bflo(xv.x); acc[1] += wk[1] * bfhi(xv.x);
      acc[2] += wk[2] * bflo(xv.y); acc[3] += wk[3] * bfhi(xv.y);
      acc[4] += wk[4] * bflo(xv.z); acc[5] += wk[5] * bfhi(xv.z);
      acc[6] += wk[6] * bflo(xv.w); acc[7] += wk[7] * bfhi(xv.w);
    }
    if (SILU) {
#pragma unroll
      for (int e = 0; e < 8; ++e) acc[e] = siluf(acc[e]);
    }
    u32x4 o;
    o.x = pack2(acc[0], acc[1]); o.y = pack2(acc[2], acc[3]); o.z = pack2(acc[4], acc[5]); o.w = pack2(acc[6], acc[7]);
    *(u32x4*)(dst + (size_t)tok * ld_dst + c0) = o;
  }
}

__device__ __forceinline__ void phase_ssd_scan_naive(const Params& p, int slot, bool colmajor, int bid, int nblk, unsigned char* smem) {
  const int tidx = opaque_tid();
  const bf16_t* xbcc = (const bf16_t*)(p.scratch + SC_SSD_XBCC);
  const float* dtb = (const float*)(p.scratch + SC_SSD_DT);
  bf16_t* ybuf = (bf16_t*)(p.scratch + SC_SSD_XBC);
  bf16_t* sB = (bf16_t*)smem;
  bf16_t* sC = sB + 64 * 128;
  bf16_t* sx = sC + 64 * 128;
  float* sdt = (float*)(sx + 64 * 64);
  float* sy = sdt + 64;
  int* stok = (int*)(sy + 64 * 64);
  const int tid = tidx, pp = tid >> 2, q = tid & 3;
  for (int item = bid; item < 36 * 64; item += nblk) {
    int s, h, dir;
    if (item < 256) { s = 32 + (item >> 6); h = (item & 63) >> 1; dir = item & 1; }
    else { int it = item - 256; s = it >> 6; h = (it & 63) >> 1; dir = it & 1; }
    const int L = s < 32 ? 256 : 4096;
    const int base = s < 32 ? s * 256 : T_CTX + (s - 32) * 4096;
    const bool cm = colmajor && s >= 32;
    const int g = h >> 2;
    const float Aval = -expf(p.ssd_a_log[(slot * 2 + dir) * 32 + h]);
    float hreg[32];
    if (s >= 32) {
      const float* h0 = p.state_ssd + ((((size_t)(s - 32) * 2 + slot) * 2 + dir) * 32 + h) * 8192 + pp * 128 + q * 32;
#pragma unroll
      for (int e = 0; e < 32; ++e) hreg[e] = h0[e];
    } else {
#pragma unroll
      for (int e = 0; e < 32; ++e) hreg[e] = 0.f;
    }
    for (int cs = 0; cs < L / 64; ++cs) {
      __syncthreads();
      if (tid < 64) {
        int j = cs * 64 + tid;
        int pos = dir ? L - 1 - j : j;
        int tok = base + seqpos2off(pos, cm);
        stok[tid] = tok;
        sdt[tid] = dtb[(size_t)tok * 64 + dir * 32 + h];
      }
      __syncthreads();
      for (int ch = tid; ch < 64 * 40; ch += NTHR) {
        int jj = ch / 40, part = ch % 40;
        const bf16_t* rowp = xbcc + (size_t)stok[jj] * 4096;
        if (part < 16) *(u32x4*)(sB + jj * 128 + part * 8) = *(const u32x4*)(rowp + 2048 + g * 128 + part * 8);
        else if (part < 32) *(u32x4*)(sC + jj * 128 + (part - 16) * 8) = *(const u32x4*)(rowp + 3072 + g * 128 + (part - 16) * 8);
        else *(u32x4*)(sx + jj * 64 + (part - 32) * 8) = *(const u32x4*)(rowp + h * 64 + (part - 32) * 8);
      }
      __syncthreads();
      for (int jj = 0; jj < 64; ++jj) {
        float dtv = sdt[jj];
        float dec = __expf(dtv * Aval);
        float xv = bf2f(sx[jj * 64 + pp]) * dtv;
        float acc = 0.f;
#pragma unroll
        for (int e4 = 0; e4 < 4; ++e4) {
          u32x4 bv = *(const u32x4*)(sB + jj * 128 + q * 32 + e4 * 8);
          u32x4 cv = *(const u32x4*)(sC + jj * 128 + q * 32 + e4 * 8);
          unsigned bw[4] = {bv.x, bv.y, bv.z, bv.w}, cw[4] = {cv.x, cv.y, cv.z, cv.w};
#pragma unroll
          for (int e = 0; e < 4; ++e) {
            float h0v = hreg[e4 * 8 + e * 2] * dec + xv * bflo(bw[e]);
            float h1v = hreg[e4 * 8 + e * 2 + 1] * dec + xv * bfhi(bw[e]);
            hreg[e4 * 8 + e * 2] = h0v; hreg[e4 * 8 + e * 2 + 1] = h1v;
            acc += bflo(cw[e]) * h0v + bfhi(cw[e]) * h1v;
          }
        }
        acc += __shfl_xor(acc, 1);
        acc += __shfl_xor(acc, 2);
        if (q == 0) sy[jj * 64 + pp] = acc;
      }
      __syncthreads();
      {
        int jj = tid >> 2, part = tid & 3;
        bf16_t* yo = ybuf + ((size_t)dir * T_ALL + stok[jj]) * 2048 + h * 64 + part * 16;
        const float* sv = sy + jj * 64 + part * 16;
        u32x4 o0, o1;
        o0.x = pack2(sv[0], sv[1]); o0.y = pack2(sv[2], sv[3]); o0.z = pack2(sv[4], sv[5]); o0.w = pack2(sv[6], sv[7]);
        o1.x = pack2(sv[8], sv[9]); o1.y = pack2(sv[10], sv[11]); o1.z = pack2(sv[12], sv[13]); o1.w = pack2(sv[14], sv[15]);
        *(u32x4*)yo = o0; *(u32x4*)(yo + 8) = o1;
      }
    }
    if (s < 32) {
      float* ho = p.out_ssd + ((((size_t)s * 2 + slot) * 2 + dir) * 32 + h) * 8192 + pp * 128 + q * 32;
#pragma unroll
      for (int e = 0; e < 32; ++e) ho[e] = hreg[e];
    }
  }
}

__device__ __forceinline__ void phase_ssd_gate(const Params& p, int slot, int bid, int nblk) {
  const int tidx = opaque_tid();
  bf16_t* zb = (bf16_t*)(p.scratch + SC_SSD_Z);
  const bf16_t* yfb = (const bf16_t*)(p.scratch + SC_SSD_XBC);
  const bf16_t* ybb = yfb + (size_t)T_ALL * 2048;
  const bf16_t* xbcc = (const bf16_t*)(p.scratch + SC_SSD_XBCC);
  int lane = tidx & 63, wv = tidx >> 6;
  for (int row = bid * 4 + wv; row < T_ALL; row += nblk * 4) {
    float ss = 0.f;
#pragma unroll
    for (int j = 0; j < 4; ++j) {
      int c0 = j * 512 + lane * 8;
      u32x4 zv = *(const u32x4*)(zb + (size_t)row * 2048 + c0);
      u32x4 fv = *(const u32x4*)(yfb + (size_t)row * 2048 + c0);
      u32x4 bv = *(const u32x4*)(ybb + (size_t)row * 2048 + c0);
      u32x4 xv = *(const u32x4*)(xbcc + (size_t)row * 4096 + c0);
      float dsk = p.ssd_d[slot * 32 + (c0 >> 6)];
      unsigned zw[4] = {zv.x, zv.y, zv.z, zv.w}, fw[4] = {fv.x, fv.y, fv.z, fv.w}, bw[4] = {bv.x, bv.y, bv.z, bv.w}, xw[4] = {xv.x, xv.y, xv.z, xv.w};
      unsigned ow[4];
#pragma unroll
      for (int e = 0; e < 4; ++e) {
        float y0 = (bflo(fw[e]) + bflo(bw[e]) + dsk * bflo(xw[e])) * siluf(bflo(zw[e]));
        float y1 = (bfhi(fw[e]) + bfhi(bw[e]) + dsk * bfhi(xw[e])) * siluf(bfhi(zw[e]));
        ss += y0 * y0 + y1 * y1;
        ow[e] = pack2(y0, y1);
      }
      u32x4 o; o.x = ow[0]; o.y = ow[1]; o.z = ow[2]; o.w = ow[3];
      *(u32x4*)(zb + (size_t)row * 2048 + c0) = o;
    }
#pragma unroll
    for (int o = 32; o > 0; o >>= 1) ss += __shfl_xor(ss, o);
    if (lane == 0) p.rstd[row] = rsqrtf(ss * (1.f / 2048.f) + 1e-5f);
  }
}

#define HY_UOFF 32768
__device__ __forceinline__ void hy_stage_conv(const Params& p, const bf16_t* __restrict__ row, int ch, bf16_t* dst, int dstStride, int dstPad,
                                              int nelem, int L, int tid) {
  const float w0 = p.hy_conv_w[ch], w1 = p.hy_conv_w[3072 + ch], w2 = p.hy_conv_w[2 * 3072 + ch], bb = p.hy_conv_b[ch];
  for (int q = tid; q < nelem / 8; q += NTHR) {
    const int e0 = q * 8, b = e0 / L, t0 = e0 & (L - 1);
    u32x4 raw = *(const u32x4*)(row + e0);
    float x[10];
    x[0] = t0 > 0 ? bf2f(row[e0 - 1]) : 0.f;
    x[9] = t0 + 8 < L ? bf2f(row[e0 + 8]) : 0.f;
    x[1] = bflo(raw.x); x[2] = bfhi(raw.x); x[3] = bflo(raw.y); x[4] = bfhi(raw.y);
    x[5] = bflo(raw.z); x[6] = bfhi(raw.z); x[7] = bflo(raw.w); x[8] = bfhi(raw.w);
    float o[8];
#pragma unroll
    for (int j = 0; j < 8; ++j) o[j] = w0 * x[j] + w1 * x[j + 1] + w2 * x[j + 2] + bb;
    u32x4 ov; ov.x = pack2(o[0], o[1]); ov.y = pack2(o[2], o[3]); ov.z = pack2(o[4], o[5]); ov.w = pack2(o[6], o[7]);
    *(u32x4*)(dst + b * dstStride + dstPad + t0) = ov;
  }
}

__device__ __forceinline__ void phase_hy_longconv(const Params& p, int bid, int nblk, unsigned char* smem) {
  const int tid = opaque_tid(), lane = tid & 63, w = tid >> 6, r = lane & 31, hh = lane >> 5;
  const bf16_t* projT = (const bf16_t*)(p.scratch + SC_HY_PROJT);
  bf16_t* yT = (bf16_t*)(p.scratch + SC_HY_YT);
  unsigned* Rc0 = (unsigned*)smem;
  unsigned* Rc1 = Rc0 + 4096;
  bf16_t* G = (bf16_t*)smem;
  bf16_t* U = (bf16_t*)(smem + HY_UOFF);
  for (int item = bid; item < 2048; item += nblk) {
    const bool lat = item < 1024;
    const int c = item & 1023;
    const int L = lat ? 4096 : 256, NB = lat ? 4 : 32, RL = lat ? 8192 : 512, Lm1 = L - 1;
    const int PAD = lat ? 224 : 0, US = L + 2 * PAD;
    const int tokbase = lat ? T_CTX : 0;
    const int nI = L >> 5, nelem = NB * L;
    const int TPW = lat ? 4 : 2;
    __syncthreads();
    if (lat) {
      for (int q = tid; q < 4 * 56; q += NTHR) {
        int b = q / 56, k = q % 56;
        int off = k < 28 ? k * 8 : 224 + 4096 + (k - 28) * 8;
        u32x4 z4 = {0u, 0u, 0u, 0u};
        *(u32x4*)(U + b * US + off) = z4;
      }
    }
    hy_stage_conv(p, projT + (size_t)c * T_ALL + tokbase, c, U, US, PAD, nelem, L, tid);
    int Icol[4], bcol[4];
#pragma unroll
    for (int tt = 0; tt < 4; ++tt) {
      int n = (w * TPW + tt) * 32 + r;
      Icol[tt] = lat ? (n >> 2) : (n >> 5);
      bcol[tt] = lat ? (n & 3) : (n & 31);
    }
    const int Ilo_w = lat ? 32 * w : 2 * w, Ihi_w = lat ? 32 * w + 31 : 2 * w + 1;
    const int dlo = Ilo_w - (nI - 1), dhi = Ihi_w;
    for (int order = 0; order < 2; ++order) {
      {
        const bf16_t* src = (lat ? p.rtab1 : p.rtab0) + (size_t)(order * 1024 + c) * RL;
        for (int q = tid; q < RL / 8; q += NTHR) {
          u32x4 cv = *(const u32x4*)(src + q * 8);
          unsigned nx = (q + 1 < RL / 8) ? *(const unsigned*)(src + q * 8 + 8) : 0u;
          *(u32x4*)(Rc0 + q * 4) = cv;
          u32x4 sv;
          sv.x = (cv.x >> 16) | (cv.y << 16); sv.y = (cv.y >> 16) | (cv.z << 16);
          sv.z = (cv.z >> 16) | (cv.w << 16); sv.w = (cv.w >> 16) | (nx << 16);
          *(u32x4*)(Rc1 + q * 4) = sv;
        }
      }
      __syncthreads();
      f32x16 acc[4];
#pragma unroll
      for (int tt = 0; tt < 4; ++tt)
#pragma unroll
        for (int e = 0; e < 16; ++e) acc[tt][e] = 0.f;
      for (int d = dlo; d <= dhi; ++d) {
#pragma unroll
        for (int kk = 0; kk < 2; ++kk) {
          const int y0 = Lm1 - 32 * d - r + 16 * kk + 8 * hh;
          const int par = y0 & 1;
          const unsigned* rp = (par ? Rc1 : Rc0) + ((y0 - par) >> 1);
          u32x4 av; av.x = rp[0]; av.y = rp[1]; av.z = rp[2]; av.w = rp[3];
          bf16x8 af = __builtin_bit_cast(bf16x8, av);
#pragma unroll
          for (int tt = 0; tt < 4; ++tt) {
            if (tt < TPW) {
              const int tile = w * TPW + tt;
              const int Ilo_t = lat ? 8 * tile : tile, Ihi_t = lat ? 8 * tile + 7 : tile;
              if (d >= Ilo_t - (nI - 1) && d <= Ihi_t) {
                const bf16_t* bp = U + bcol[tt] * US + PAD + 32 * (Icol[tt] - d) + 16 * kk + 8 * hh;
                bf16x8 bfr = *(const bf16x8*)bp;
                acc[tt] = __builtin_amdgcn_mfma_f32_32x32x16_bf16(af, bfr, acc[tt], 0, 0, 0);
              }
            }
          }
        }
      }
      __syncthreads();
      hy_stage_conv(p, projT + (size_t)((1 + order) * 1024 + c) * T_ALL + tokbase, (1 + order) * 1024 + c, G, L, 0, nelem, L, tid);
      __syncthreads();
      const float inv = 1.f / p.knorm[((lat ? 1 : 0) * 2 + order) * 1024 + c];
      const float bias = p.hy_f_bias[order * 1024 + c];
#pragma unroll
      for (int tt = 0; tt < 4; ++tt) {
        if (tt < TPW) {
#pragma unroll
          for (int qd = 0; qd < 4; ++qd) {
            const int t0 = 32 * Icol[tt] + 8 * qd + 4 * hh;
            bf16_t* up = U + bcol[tt] * US + PAD + t0;
            u32x2 uc = *(const u32x2*)up;
            u32x2 gg = *(const u32x2*)(G + bcol[tt] * L + t0);
            float r0 = (inv * acc[tt][4 * qd] + bias * bflo(uc.x)) * bflo(gg.x);
            float r1 = (inv * acc[tt][4 * qd + 1] + bias * bfhi(uc.x)) * bfhi(gg.x);
            float r2 = (inv * acc[tt][4 * qd + 2] + bias * bflo(uc.y)) * bflo(gg.y);
            float r3 = (inv * acc[tt][4 * qd + 3] + bias * bfhi(uc.y)) * bfhi(gg.y);
            if (order == 1) {
              u32x2 zz = *(const u32x2*)(projT + (size_t)(3072 + c) * T_ALL + tokbase + bcol[tt] * L + t0);
              r0 *= siluf(bflo(zz.x)); r1 *= siluf(bfhi(zz.x)); r2 *= siluf(bflo(zz.y)); r3 *= siluf(bfhi(zz.y));
            }
            u32x2 ov; ov.x = pack2(r0, r1); ov.y = pack2(r2, r3);
            *(u32x2*)up = ov;
          }
        }
      }
      __syncthreads();
    }
    for (int q = tid; q < nelem / 8; q += NTHR) {
      const int e0 = q * 8, b = e0 / L, t0 = e0 & (L - 1);
      *(u32x4*)(yT + (size_t)c * T_ALL + tokbase + e0) = *(const u32x4*)(U + b * US + PAD + t0);
    }
  }
}

__device__ __forceinline__ void phase_hy_transpose(const Params& p, int bid, int nblk, unsigned char* smem) {
  const int tid = opaque_tid();
  const bf16_t* yT = (const bf16_t*)(p.scratch + SC_HY_YT);
  bf16_t* yg = (bf16_t*)(p.scratch + SC_HY_YG);
  bf16_t* tl = (bf16_t*)smem;
  for (int item = bid; item < 16 * (T_ALL / 64); item += nblk) {
    const int cb = item & 15, tb = item >> 4;
    __syncthreads();
#pragma unroll
    for (int i = 0; i < 2; ++i) {
      int q = tid + i * 256, cr = q >> 3, t8 = (q & 7) * 8;
      u32x4 v = *(const u32x4*)(yT + (size_t)(cb * 64 + cr) * T_ALL + tb * 64 + t8);
      unsigned wv[4] = {v.x, v.y, v.z, v.w};
#pragma unroll
      for (int e = 0; e < 4; ++e) {
        tl[(t8 + 2 * e) * 72 + cr] = (bf16_t)(wv[e] & 0xffffu);
        tl[(t8 + 2 * e + 1) * 72 + cr] = (bf16_t)(wv[e] >> 16);
      }
    }
    __syncthreads();
#pragma unroll
    for (int i = 0; i < 2; ++i) {
      int q = tid + i * 256, tr = q >> 3, c8 = (q & 7) * 8;
      *(u32x4*)(yg + (size_t)(tb * 64 + tr) * 1024 + cb * 64 + c8) = *(const u32x4*)(tl + tr * 72 + c8);
    }
  }
}

__device__ __forceinline__ void lru_ab(const bf16_t* gates, const bf16_t* xc, int dir, int tok, int c, float sp, float& a, float& bx) {
  float r = bf2f(gates[((size_t)(dir * 2 + 0) * T_ALL + tok) * 1024 + c]);
  float i = bf2f(gates[((size_t)(dir * 2 + 1) * T_ALL + tok) * 1024 + c]);
  float x = bf2f(xc[(size_t)tok * 1024 + c]);
  float log_a = -8.f * r * sp;
  a = __expf(log_a);
  float m = sqrtf(fmaxf(1.f - __expf(2.f * log_a), 0.f));
  bx = m * i * x;
}
__device__ __forceinline__ void phase_lru_scan_chunks(const Params& p, int pass, int bid, int nblk) {
  const int tidx = opaque_tid();
  const bf16_t* gates = (const bf16_t*)(p.scratch + SC_LRU_GATES);
  const bf16_t* xc = (const bf16_t*)(p.scratch + SC_LRU_XC);
  bf16_t* ybuf = (bf16_t*)(p.scratch + SC_LRU_Y);
  for (int item = bid; item < 192 * 8; item += nblk) {
    int chunk = item >> 3, dir = (item >> 2) & 1, cb = item & 3;
    int c = cb * 256 + tidx;
    float sp = softplusf(-p.lru_a_param[dir * 1024 + c]);
    int tok0 = chunk * 128;
    float A = 1.f, h = (pass == 0) ? 0.f : p.lru_hin[((size_t)dir * 192 + chunk) * 1024 + c];
    for (int j = 0; j < 128; ++j) {
      int tok = dir ? tok0 + 127 - j : tok0 + j;
      float a, bx;
      lru_ab(gates, xc, dir, tok, c, sp, a, bx);
      h = a * h + bx; A *= a;
      if (pass == 2) ybuf[((size_t)dir * T_ALL + tok) * 1024 + c] = f2bf(h);
    }
    if (pass == 0) {
      float* ag = p.lru_agg + (((size_t)dir * 192 + chunk) * 1024 + c) * 2;
      ag[0] = A; ag[1] = h;
    }
  }
}
__device__ __forceinline__ void phase_lru_scan_carry(const Params& p, int bid, int nblk) {
  const int tidx = opaque_tid();
  for (int item = bid; item < 36 * 8; item += nblk) {
    int s = item >> 3, dir = (item >> 2) & 1, cb = item & 3;
    int c = cb * 256 + tidx;
    int nch = s < 32 ? 2 : 32;
    int ch0 = s < 32 ? s * 2 : 64 + (s - 32) * 32;
    float h = s < 32 ? 0.f : p.state_lru[((size_t)(s - 32) * 2 + dir) * 1024 + c];
    for (int k = 0; k < nch; ++k) {
      int chunk = dir ? ch0 + nch - 1 - k : ch0 + k;
      size_t idx = ((size_t)dir * 192 + chunk) * 1024 + c;
      p.lru_hin[idx] = h;
      h = p.lru_agg[idx * 2] * h + p.lru_agg[idx * 2 + 1];
    }
    if (s < 32) p.out_lru[((size_t)s * 2 + dir) * 1024 + c] = h;
  }
}
__device__ __forceinline__ void phase_lru_combine(const Params& p, int bid, int nblk) {
  const int tidx = opaque_tid();
  const bf16_t* proj = (const bf16_t*)(p.scratch + SC_LRU_PROJ);
  const bf16_t* yf = (const bf16_t*)(p.scratch + SC_LRU_Y);
  const bf16_t* yb = yf + (size_t)T_ALL * 1024;
  bf16_t* yg = (bf16_t*)(p.scratch + SC_LRU_YG);
  const size_t total = (size_t)T_ALL * 128;
  for (size_t idx = (size_t)bid * NTHR + tidx; idx < total; idx += (size_t)nblk * NTHR) {
    int tok = (int)(idx >> 7), c0 = (int)(idx & 127) * 8;
    u32x4 fv = *(const u32x4*)(yf + (size_t)tok * 1024 + c0);
    u32x4 bv = *(const u32x4*)(yb + (size_t)tok * 1024 + c0);
    u32x4 zv = *(const u32x4*)(proj + (size_t)tok * 2048 + 1024 + c0);
    unsigned fw[4] = {fv.x, fv.y, fv.z, fv.w}, bw[4] = {bv.x, bv.y, bv.z, bv.w}, zw[4] = {zv.x, zv.y, zv.z, zv.w}, ow[4];
#pragma unroll
    for (int e = 0; e < 4; ++e)
      ow[e] = pack2((bflo(fw[e]) + bflo(bw[e])) * siluf(bflo(zw[e])), (bfhi(fw[e]) + bfhi(bw[e])) * siluf(bfhi(zw[e])));
    u32x4 o; o.x = ow[0]; o.y = ow[1]; o.z = ow[2]; o.w = ow[3];
    *(u32x4*)(yg + (size_t)tok * 1024 + c0) = o;
  }
}

enum { PH_PREP = 0, PH_MOD, PH_HYA, PH_HYB, PH_LNMOD, PH_INPROJ, PH_MIX1, PH_MIX2, PH_MIX3, PH_MIX4, PH_MIX5, PH_MIX6, PH_OUTPROJ };

__device__ __forceinline__ void run_phase(const Params& p, int ph, int layer, int bid, int nblk, unsigned char* smem) {
  const int kind = layer % 3, slot = layer / 3;
  bid = opaque_s(bid);
  switch (ph) {
    case PH_PREP: phase_prep(p, bid, nblk, smem); break;
    case PH_MOD: phase_mod(p, bid, nblk, smem); break;
    case PH_HYA: phase_hyfilt_a(p, bid, nblk, smem); break;
    case PH_HYB: phase_hyfilt_b(p, bid, nblk, smem); break;
    case PH_LNMOD: phase_lnmod(p, layer, bid, nblk); break;
    case PH_INPROJ:
      if (kind == 0) {
        EpiSsdIn e{(bf16_t*)(p.scratch + SC_SSD_Z), (bf16_t*)(p.scratch + SC_SSD_XBC), (float*)(p.scratch + SC_SSD_DT), p.ssd_dt_bias + slot * 64};
        gemm_phase(p.hbuf, 1024, p.wt_ssd_in + (size_t)slot * 6272 * 1024, 1024, T_ALL / 128, 49, e, bid, nblk, smem);
      } else if (kind == 1) {
        EpiT e{(bf16_t*)(p.scratch + SC_HY_PROJT), (size_t)T_ALL};
        gemm_phase(p.hbuf, 1024, p.wt_hy_in, 1024, T_ALL / 128, 32, e, bid, nblk, smem);
      } else {
        EpiBf16 e{(bf16_t*)(p.scratch + SC_LRU_PROJ), 2048};
        gemm_phase(p.hbuf, 1024, p.wt_lru_in, 1024, T_ALL / 128, 16, e, bid, nblk, smem);
      }
      break;
    case PH_MIX1:
      if (kind == 0) phase_dwconv<4, true>((const bf16_t*)(p.scratch + SC_SSD_XBC), 4096, (bf16_t*)(p.scratch + SC_SSD_XBCC), 4096, 4096,
                                           p.ssd_conv_w + (size_t)slot * 4 * 4096, p.ssd_conv_b + slot * 4096, slot == 1, bid, nblk);
      else if (kind == 1) phase_hy_longconv(p, bid, nblk, smem);
      else phase_dwconv<4, false>((const bf16_t*)(p.scratch + SC_LRU_PROJ), 2048, (bf16_t*)(p.scratch + SC_LRU_XC), 1024, 1024,
                                  p.lru_conv_w, p.lru_conv_b, false, bid, nblk);
      break;
    case PH_MIX2:
      if (kind == 0) phase_ssd_scan_naive(p, slot, slot == 1, bid, nblk, smem);
      else if (kind == 1) phase_hy_transpose(p, bid, nblk, smem);
      else {
        for (int nb = 0; nb < 4; ++nb) {
          EpiLruGate e{(bf16_t*)(p.scratch + SC_LRU_GATES), p.lru_gate_b, nb};
          gemm_phase((const bf16_t*)(p.scratch + SC_LRU_XC) + nb * 256, 1024, p.wt_lru_gate + (size_t)nb * 1024 * 256, 256, T_ALL / 128, 8, e, bid, nblk, smem);
        }
      }
      break;
    case PH_MIX3:
      if (kind == 0) phase_ssd_gate(p, slot, bid, nblk);
      else phase_lru_scan_chunks(p, 0, bid, nblk);
      break;
    case PH_MIX4: if (kind == 2) phase_lru_scan_carry(p, bid, nblk); break;
    case PH_MIX5: if (kind == 2) phase_lru_scan_chunks(p, 2, bid, nblk); break;
    case PH_MIX6: if (kind == 2) phase_lru_combine(p, bid, nblk); break;
    case PH_OUTPROJ: {
      const float* mv = p.modv + (size_t)layer * 5 * 3072;
      if (kind == 0) {
        EpiOut e{p.xres, mv, p.rstd};
        gemm_phase((const bf16_t*)(p.scratch + SC_SSD_Z), 2048, p.wt_ssd_out + (size_t)slot * 1024 * 2048, 2048, T_ALL / 128, 8, e, bid, nblk, smem);
      } else if (kind == 1) {
        EpiOut e{p.xres, mv, nullptr};
        gemm_phase((const bf16_t*)(p.scratch + SC_HY_YG), 1024, p.wt_hy_out, 1024, T_ALL / 128, 8, e, bid, nblk, smem);
      } else {
        EpiOut e{p.xres, mv, nullptr};
        gemm_phase((const bf16_t*)(p.scratch + SC_LRU_YG), 1024, p.wt_lru_out, 1024, T_ALL / 128, 8, e, bid, nblk, smem);
      }
    } break;
  }
}

__global__ void __launch_bounds__(NTHR, 2) k_mega(Params p) {
  __shared__ __attribute__((aligned(16))) unsigned char smem[SMEM_BYTES];
  cg::grid_group grid = cg::this_grid();
  const int bid = blockIdx.x, nblk = gridDim.x;
  run_phase(p, PH_PREP, 0, bid, nblk, smem);
  run_phase(p, PH_MOD, 0, bid, nblk, smem);
  run_phase(p, PH_HYA, 0, bid, nblk, smem);
  grid.sync();
  run_phase(p, PH_HYB, 0, bid, nblk, smem);
  for (int layer = 0; layer < 4; ++layer) {
    const int kind = layer % 3;
    run_phase(p, PH_LNMOD, layer, bid, nblk, smem);
    grid.sync();
    run_phase(p, PH_INPROJ, layer, bid, nblk, smem);
    grid.sync();
    run_phase(p, PH_MIX1, layer, bid, nblk, smem);
    grid.sync();
    run_phase(p, PH_MIX2, layer, bid, nblk, smem);
    grid.sync();
    if (kind != 1) {
      run_phase(p, PH_MIX3, layer, bid, nblk, smem);
      grid.sync();
    }
    if (kind == 2) {
      run_phase(p, PH_MIX4, layer, bid, nblk, smem);
      grid.sync();
      run_phase(p, PH_MIX5, layer, bid, nblk, smem);
      grid.sync();
      run_phase(p, PH_MIX6, layer, bid, nblk, smem);
      grid.sync();
    }
    run_phase(p, PH_OUTPROJ, layer, bid, nblk, smem);
    grid.sync();
  }
  run_phase(p, PH_LNMOD, 4, bid, nblk, smem);
}

static inline size_t align_up(size_t x) { return (x + 255) & ~(size_t)255; }

extern "C" void kernel_launch(void* const* d_in, const int* in_sizes, int n_in, void* d_out, int out_size, void* d_ws, size_t ws_size,
                              hipStream_t stream) {
  Params p{};
  const float** fp = (const float**)&p;
  for (int i = 0; i < 36; ++i) fp[i] = (const float*)d_in[i];
  float* out = (float*)d_out;
  p.xres = out;
  p.out_ssd = out + (size_t)T_ALL * 1024;
  p.out_lru = p.out_ssd + (size_t)32 * 2 * 2 * 32 * 64 * 128;
  unsigned char* w = (unsigned char*)d_ws;
  size_t off = 0;
  auto carve = [&](size_t bytes) { unsigned char* r = w + off; off = align_up(off + bytes); return r; };
  p.wt_ssd_in = (bf16_t*)carve((size_t)2 * 6272 * 1024 * 2);
  p.wt_ssd_out = (bf16_t*)carve((size_t)2 * 1024 * 2048 * 2);
  p.wt_hy_in = (bf16_t*)carve((size_t)4096 * 1024 * 2);
  p.wt_hy_out = (bf16_t*)carve((size_t)1024 * 1024 * 2);
  p.wt_lru_in = (bf16_t*)carve((size_t)2048 * 1024 * 2);
  p.wt_lru_out = (bf16_t*)carve((size_t)1024 * 1024 * 2);
  p.wt_lru_gate = (bf16_t*)carve((size_t)4 * 1024 * 256 * 2);
  p.modv = (float*)carve((size_t)4 * 5 * 3072 * 4);
  p.hdn2 = (float*)carve((size_t)4352 * 64 * 4);
  p.rtab0 = (bf16_t*)carve((size_t)2 * 1024 * 512 * 2);
  p.rtab1 = (bf16_t*)carve((size_t)2 * 1024 * 8192 * 2);
  p.knorm = (float*)carve((size_t)4 * 1024 * 4);
  p.hbuf = (bf16_t*)carve((size_t)T_ALL * 1024 * 2);
  p.rstd = (float*)carve((size_t)T_ALL * 4);
  p.lru_agg = (float*)carve((size_t)2 * 192 * 1024 * 2 * 4);
  p.lru_hin = (float*)carve((size_t)2 * 192 * 1024 * 4);
  p.scratch = carve(SC_TOTAL);
  if (off > ws_size) return;

  static int grid_blocks = 0;
  if (!grid_blocks) {
    int dev = 0, cus = 0, per_cu = 0;
    hipGetDevice(&dev);
    hipDeviceGetAttribute(&cus, hipDeviceAttributeMultiprocessorCount, dev);
    hipOccupancyMaxActiveBlocksPerMultiprocessor(&per_cu, k_mega, NTHR, 0);
    if (per_cu > 2) per_cu = 2;
    grid_blocks = cus * per_cu;
  }
  void* args[] = {&p};
  hipError_t e = hipLaunchCooperativeKernel((void*)k_mega, dim3(grid_blocks), dim3(NTHR), args, 0, stream);
  if (e != hipSuccess) fprintf(stderr, "cooperative launch failed: %s (grid %d)\n", hipGetErrorString(e), grid_blocks);
}
```

```cpp
#include <hip/hip_runtime.h>
#include <hip/hip_bf16.h>
#include <hip/hip_cooperative_groups.h>
#include <stdint.h>
#include <cstdio>
namespace cg = cooperative_groups;

typedef unsigned short bf16_t;
typedef __attribute__((ext_vector_type(8))) short bf16x8;
typedef __attribute__((ext_vector_type(16))) float f32x16;
typedef __attribute__((ext_vector_type(4))) unsigned int u32x4;
typedef __attribute__((ext_vector_type(2))) unsigned int u32x2;
typedef __attribute__((ext_vector_type(4))) float f32x4;

#define T_CTX 8192
#define T_ALL 24576
#define DM 1024
#define NTHR 256
#define SMEM_BYTES 69632
#define ALPHA_RES 1.6817928305074290f
#define LN_EPS 1e-5f

__device__ __forceinline__ bf16_t f2bf(float f) {
  unsigned u = __float_as_uint(f);
  u += 0x7fffu + ((u >> 16) & 1u);
  return (bf16_t)(u >> 16);
}
__device__ __forceinline__ float bf2f(bf16_t b) { return __uint_as_float(((unsigned)b) << 16); }
__device__ __forceinline__ float bflo(unsigned w) { return __uint_as_float(w << 16); }
__device__ __forceinline__ float bfhi(unsigned w) { return __uint_as_float(w & 0xffff0000u); }
__device__ __forceinline__ unsigned pack2(float a, float b) { return (unsigned)f2bf(a) | ((unsigned)f2bf(b) << 16); }
__device__ __forceinline__ float siluf(float x) { return x / (1.f + __expf(-x)); }
__device__ __forceinline__ float sigmoidf(float x) { return 1.f / (1.f + __expf(-x)); }
__device__ __forceinline__ float softplusf(float x) { return x > 20.f ? x : log1pf(expf(x)); }

__device__ __forceinline__ int opaque_tid() { int t = threadIdx.x; asm volatile("" : "+v"(t)); return t; }
__device__ __forceinline__ int opaque_s(int x) { asm volatile("" : "+s"(x)); return x; }

struct TokInfo { int s, l, L, base, mrow; };
__device__ __forceinline__ TokInfo tokinfo(int tok) {
  TokInfo t;
  if (tok < T_CTX) { t.s = tok >> 8; t.l = tok & 255; t.L = 256; t.base = tok & ~255; t.mrow = 0; }
  else { int u = tok - T_CTX; t.s = 32 + (u >> 12); t.l = u & 4095; t.L = 4096; t.base = T_CTX + (u & ~4095); t.mrow = 1 + (u >> 12); }
  return t;
}
__device__ __forceinline__ int seqpos2off(int pos, bool cm) { return cm ? (((pos & 63) << 6) | (pos >> 6)) : pos; }

struct Params {
  const float *x_prompt, *x_sample, *state_ssd, *state_lru, *c, *c_ctx, *mod_w, *mod_b, *ln_g, *ln_b;
  const float *ssd_in_w, *ssd_conv_w, *ssd_conv_b, *ssd_dt_bias, *ssd_a_log, *ssd_d, *ssd_norm_g, *ssd_out_w;
  const float *hy_in_w, *hy_conv_w, *hy_conv_b, *hy_f_w1, *hy_f_b1, *hy_f_w2, *hy_f_b2, *hy_f_w3, *hy_f_freq, *hy_f_bias, *hy_out_w;
  const float *lru_in_w, *lru_conv_w, *lru_conv_b, *lru_gate_w, *lru_gate_b, *lru_a_param, *lru_out_w;
  float *xres, *out_ssd, *out_lru;
  bf16_t *wt_ssd_in, *wt_ssd_out, *wt_hy_in, *wt_hy_out, *wt_lru_in, *wt_lru_out, *wt_lru_gate;
  float *modv;
  float *hdn2;
  bf16_t *rtab0;
  bf16_t *rtab1;
  float *knorm;
  bf16_t *hbuf;
  float *rstd;
  float *lru_agg;
  float *lru_hin;
  unsigned char *scratch;
};

#define SC_SSD_Z     ((size_t)0)
#define SC_SSD_XBC   ((size_t)T_ALL * 2048 * 2)
#define SC_SSD_XBCC  (SC_SSD_XBC + (size_t)T_ALL * 4096 * 2)
#define SC_SSD_DT    (SC_SSD_XBCC + (size_t)T_ALL * 4096 * 2)
#define SC_SSD_XT    (SC_SSD_DT + (size_t)T_ALL * 64 * 4)
#define SC_SSD_BT    (SC_SSD_XT + (size_t)T_ALL * 2048 * 2)
#define SC_SSD_END   (SC_SSD_BT + (size_t)T_ALL * 1024 * 2)
#define SC_HY_PROJT  ((size_t)0)
#define SC_HY_YT     ((size_t)T_ALL * 4096 * 2)
#define SC_HY_YG     (SC_HY_YT + (size_t)T_ALL * 1024 * 2)
#define SC_LRU_PROJ  ((size_t)0)
#define SC_LRU_XC    ((size_t)T_ALL * 2048 * 2)
#define SC_LRU_GATES (SC_LRU_XC + (size_t)T_ALL * 1024 * 2)
#define SC_LRU_Y     (SC_LRU_GATES + (size_t)T_ALL * 4096 * 2)
#define SC_LRU_YG    (SC_LRU_Y + (size_t)T_ALL * 2048 * 2)
#define SC_TOTAL     SC_SSD_END

__device__ __forceinline__ void transpose_tile(const float* __restrict__ src, int ld_src, int n_src, bf16_t* __restrict__ dst, int K,
                               const float* __restrict__ scale, int tile, int tiles_k, float* tl) {
  const int tidx = opaque_tid();
  int tk = tile % tiles_k, tn = tile / tiles_k;
  int k0 = tk * 64, n0 = tn * 64;
  int tx = tidx & 63, ty = tidx >> 6;
  __syncthreads();
  for (int r = ty; r < 64; r += 4) {
    int n = n0 + tx;
    float v = 0.f;
    if (n < n_src) { v = src[(size_t)(k0 + r) * ld_src + n]; if (scale) v *= scale[k0 + r]; }
    tl[r * 65 + tx] = v;
  }
  __syncthreads();
  for (int r = ty; r < 64; r += 4) dst[(size_t)(n0 + r) * K + k0 + tx] = f2bf(tl[tx * 65 + r]);
}

__device__ __forceinline__ void phase_prep(const Params& p, int bid, int nblk, unsigned char* smem) {
  const int tidx = opaque_tid();
  float* tl = (float*)smem;
  for (int job = 0; job < 24; ++job) {
    const float* src; int ld, nsrc, K, npad; bf16_t* dst; const float* scale = nullptr;
    if (job < 2) { src = p.ssd_in_w + (size_t)job * 1024 * 6208; ld = 6208; nsrc = 6208; K = 1024; npad = 6272; dst = p.wt_ssd_in + (size_t)job * 6272 * 1024; }
    else if (job < 4) { int s = job - 2; src = p.ssd_out_w + (size_t)s * 2048 * 1024; ld = 1024; nsrc = 1024; K = 2048; npad = 1024; dst = p.wt_ssd_out + (size_t)s * 1024 * 2048; scale = p.ssd_norm_g + s * 2048; }
    else if (job == 4) { src = p.hy_in_w; ld = 4096; nsrc = 4096; K = 1024; npad = 4096; dst = p.wt_hy_in; }
    else if (job == 5) { src = p.hy_out_w; ld = 1024; nsrc = 1024; K = 1024; npad = 1024; dst = p.wt_hy_out; }
    else if (job == 6) { src = p.lru_in_w; ld = 2048; nsrc = 2048; K = 1024; npad = 2048; dst = p.wt_lru_in; }
    else if (job == 7) { src = p.lru_out_w; ld = 1024; nsrc = 1024; K = 1024; npad = 1024; dst = p.wt_lru_out; }
    else { int q = job - 8; int dg = q >> 2, n = q & 3;
      src = p.lru_gate_w + (size_t)(dg * 4 + n) * 65536; ld = 256; nsrc = 256; K = 256; npad = 256;
      dst = p.wt_lru_gate + (size_t)n * 1024 * 256 + (size_t)dg * 256 * 256; }
    int tiles_k = K / 64, tiles = tiles_k * (npad / 64);
    for (int t = bid; t < tiles; t += nblk) transpose_tile(src, ld, nsrc, dst, K, scale, t, tiles_k, tl);
  }
  for (int i = bid * NTHR + tidx; i < 2 * 2 * 1024; i += nblk * NTHR) p.knorm[i] = 0.f;
}

__device__ __forceinline__ void phase_mod(const Params& p, int bid, int nblk, unsigned char* smem) {
  const int tidx = opaque_tid();
  float* sc = (float*)smem;
  __syncthreads();
  for (int i = tidx; i < 5 * 1024; i += NTHR) {
    int r = i >> 10, k = i & 1023;
    float v = (r == 0) ? p.c_ctx[k] : p.c[(r - 1) * 1024 + k];
    sc[i] = siluf(v);
  }
  __syncthreads();
  for (int item = bid; item < 4 * 12; item += nblk) {
    int layer = item / 12, j = (item % 12) * 256 + tidx;
    const float* w = p.mod_w + (size_t)layer * 1024 * 3072 + j;
    float a0 = 0, a1 = 0, a2 = 0, a3 = 0, a4 = 0;
    for (int k = 0; k < 1024; ++k) {
      float wv = w[(size_t)k * 3072];
      a0 += sc[k] * wv; a1 += sc[1024 + k] * wv; a2 += sc[2048 + k] * wv; a3 += sc[3072 + k] * wv; a4 += sc[4096 + k] * wv;
    }
    float b = p.mod_b[layer * 3072 + j];
    float* o = p.modv + (size_t)layer * 5 * 3072 + j;
    o[0] = a0 + b; o[3072] = a1 + b; o[2 * 3072] = a2 + b; o[3 * 3072] = a3 + b; o[4 * 3072] = a4 + b;
  }
}

__device__ __forceinline__ void phase_hyfilt_a(const Params& p, int bid, int nblk, unsigned char* smem) {
  const int tidx = opaque_tid();
  float* sz = (float*)smem;
  float* sh = sz + 4 * 36;
  int pl = tidx >> 6, m = tidx & 63;
  for (int item = bid; item < 4352 / 4; item += nblk) {
    int pos = item * 4 + pl;
    int L = pos < 256 ? 256 : 4096;
    int l = pos < 256 ? pos : pos - 256;
    __syncthreads();
    if (m < 33) {
      float t = (float)l / (float)L;
      float w = (6.283185307179586f * (float)l) / (float)L;
      float v;
      if (m == 0) v = t;
      else {
        int j = (m - 1) & 15;
        float fr = 1e-4f + (float)j * ((15.f - 1e-4f) / 15.f);
        float ang = w * fr;
        v = (m <= 16) ? __cosf(ang) : __sinf(ang);
      }
      sz[pl * 36 + m] = v;
    }
    __syncthreads();
    float a = p.hy_f_b1[m];
    for (int e = 0; e < 33; ++e) a += sz[pl * 36 + e] * p.hy_f_w1[e * 64 + m];
    a = __sinf(p.hy_f_freq[m] * a);
    sh[pl * 64 + m] = a;
    __syncthreads();
    float b = p.hy_f_b2[m];
    for (int e = 0; e < 64; ++e) b += sh[pl * 64 + e] * p.hy_f_w2[e * 64 + m];
    b = __sinf(p.hy_f_freq[64 + m] * b);
    p.hdn2[(size_t)pos * 64 + m] = b;
  }
}

__device__ __forceinline__ void phase_hyfilt_b(const Params& p, int bid, int nblk, unsigned char* smem) {
  const int tidx = opaque_tid();
  const int lane = tidx & 63;
  for (int item = bid; item < 17 * 64; item += nblk) {
    const int lb = item >> 6, chunk = item & 63;
    const int Lsel = lb ? 1 : 0, L = Lsel ? 4096 : 256, RL = Lsel ? 8192 : 512, Lm1 = L - 1;
    const int l = Lsel ? (lb - 1) * 256 + tidx : tidx;
    const int pos = Lsel ? 256 + l : l;
    float hd[64];
#pragma unroll
    for (int m4 = 0; m4 < 16; ++m4) {
      f32x4 v = *(const f32x4*)(p.hdn2 + (size_t)pos * 64 + m4 * 4);
      hd[m4 * 4] = v.x; hd[m4 * 4 + 1] = v.y; hd[m4 * 4 + 2] = v.z; hd[m4 * 4 + 3] = v.w;
    }
    const int odc0 = chunk * 64, o = odc0 >> 11, d = (odc0 >> 10) & 1, c0 = odc0 & 1023;
    const float t = (float)l / (float)L;
    bf16_t* rt = Lsel ? p.rtab1 : p.rtab0;
    const float min_decay = -3.0701134573253945f, max_decay = -15.350567286626973f;
    for (int cc = 0; cc < 64; ++cc) {
      const int c = c0 + cc;
      const float* w3 = p.hy_f_w3 + odc0 + cc;
      float acc = 0.f;
#pragma unroll
      for (int m = 0; m < 64; ++m) acc += hd[m] * w3[(size_t)m * 4096];
      float delta = fabsf(min_decay + (float)c * ((max_decay - min_decay) / 1023.f));
      float kv = acc * expf(-t * delta);
      size_t rb = (size_t)(o * 1024 + c) * RL;
      if (d == 0) rt[rb + Lm1 - l] = f2bf(kv);
      else if (l > 0) rt[rb + Lm1 + l] = f2bf(kv);
      else rt[rb + RL - 1] = 0;
      float a = fabsf(kv);
#pragma unroll
      for (int off = 32; off > 0; off >>= 1) a += __shfl_xor(a, off);
      if (lane == 0) atomicAdd(&p.knorm[(Lsel * 2 + o) * 1024 + c], a);
    }
  }
}

__device__ __forceinline__ void phase_lnmod(const Params& p, int layer, int bid, int nblk) {
  const int tidx = opaque_tid();
  int lane = tidx & 63, wv = tidx >> 6;
  for (int row = bid * 4 + wv; row < T_ALL; row += nblk * 4) {
    const float* src = (layer == 0) ? (row < T_CTX ? p.x_prompt + (size_t)row * DM : p.x_sample + (size_t)(row - T_CTX) * DM)
                                    : p.xres + (size_t)row * DM;
    f32x4 v[4];
#pragma unroll
    for (int j = 0; j < 4; ++j) v[j] = *(const f32x4*)(src + j * 256 + lane * 4);
    if (layer > 0) {
      float s = 0.f;
#pragma unroll
      for (int j = 0; j < 4; ++j) s += v[j].x + v[j].y + v[j].z + v[j].w;
#pragma unroll
      for (int o = 32; o > 0; o >>= 1) s += __shfl_xor(s, o);
      float mu = s * (1.f / 1024.f);
      float q = 0.f;
#pragma unroll
      for (int j = 0; j < 4; ++j) { float a = v[j].x - mu, b = v[j].y - mu, c = v[j].z - mu, d = v[j].w - mu; q += a * a + b * b + c * c + d * d; }
#pragma unroll
      for (int o = 32; o > 0; o >>= 1) q += __shfl_xor(q, o);
      float rs = rsqrtf(q * (1.f / 1024.f) + LN_EPS);
      const float* g = p.ln_g + (layer - 1) * DM; const float* b = p.ln_b + (layer - 1) * DM;
#pragma unroll
      for (int j = 0; j < 4; ++j) {
        f32x4 gg = *(const f32x4*)(g + j * 256 + lane * 4), bb = *(const f32x4*)(b + j * 256 + lane * 4);
        v[j].x = (v[j].x - mu) * rs * gg.x + bb.x; v[j].y = (v[j].y - mu) * rs * gg.y + bb.y;
        v[j].z = (v[j].z - mu) * rs * gg.z + bb.z; v[j].w = (v[j].w - mu) * rs * gg.w + bb.w;
      }
    }
    float* dst = p.xres + (size_t)row * DM;
#pragma unroll
    for (int j = 0; j < 4; ++j) *(f32x4*)(dst + j * 256 + lane * 4) = v[j];
    if (layer < 4) {
      int mrow = row < T_CTX ? 0 : 1 + ((row - T_CTX) >> 12);
      const float* mv = p.modv + ((size_t)layer * 5 + mrow) * 3072;
#pragma unroll
      for (int j = 0; j < 4; ++j) {
        f32x4 sh = *(const f32x4*)(mv + j * 256 + lane * 4), sc = *(const f32x4*)(mv + 1024 + j * 256 + lane * 4);
        u32x2 o;
        o.x = pack2(v[j].x * (1.f + sc.x) + sh.x, v[j].y * (1.f + sc.y) + sh.y);
        o.y = pack2(v[j].z * (1.f + sc.z) + sh.z, v[j].w * (1.f + sc.w) + sh.w);
        *(u32x2*)(p.hbuf + (size_t)row * DM + j * 256 + lane * 4) = o;
      }
    }
  }
}

#define G_LDS_STRIDE 72
template <class Epi>
__device__ __forceinline__ void gemm_phase(const bf16_t* __restrict__ A, int lda, const bf16_t* __restrict__ Wt, int K, int Mtiles, int Ntiles,
                           Epi epi, int bid, int nblk, unsigned char* smem) {
  const int tidx = opaque_tid();
  bf16_t* sA = (bf16_t*)smem;
  bf16_t* sB = sA + 128 * G_LDS_STRIDE;
  const int tid = tidx, lane = tid & 63, w = tid >> 6;
  const int wm = w >> 1, wn = w & 1, r = lane & 31, hh = lane >> 5;
  const int nk = K / 64;
  for (int tile = bid; tile < Mtiles * Ntiles; tile += nblk) {
    const int tm = tile / Ntiles, tn = tile % Ntiles;
    const int m0 = tm * 128, n0 = tn * 128;
    f32x16 acc[2][2];
#pragma unroll
    for (int i = 0; i < 2; ++i)
#pragma unroll
      for (int j = 0; j < 2; ++j)
#pragma unroll
        for (int e = 0; e < 16; ++e) acc[i][j][e] = 0.f;
    u32x4 ra[4], rb[4];
#pragma unroll
    for (int i = 0; i < 4; ++i) {
      int q = tid + i * 256, row = q >> 3, c8 = (q & 7) * 8;
      ra[i] = *(const u32x4*)(A + (size_t)(m0 + row) * lda + c8);
      rb[i] = *(const u32x4*)(Wt + (size_t)(n0 + row) * K + c8);
    }
    for (int kt = 0; kt < nk; ++kt) {
      __syncthreads();
#pragma unroll
      for (int i = 0; i < 4; ++i) {
        int q = tid + i * 256, row = q >> 3, c8 = (q & 7) * 8;
        *(u32x4*)(sA + row * G_LDS_STRIDE + c8) = ra[i];
        *(u32x4*)(sB + row * G_LDS_STRIDE + c8) = rb[i];
      }
      __syncthreads();
      if (kt + 1 < nk) {
#pragma unroll
        for (int i = 0; i < 4; ++i) {
          int q = tid + i * 256, row = q >> 3, c8 = (q & 7) * 8;
          ra[i] = *(const u32x4*)(A + (size_t)(m0 + row) * lda + (kt + 1) * 64 + c8);
          rb[i] = *(const u32x4*)(Wt + (size_t)(n0 + row) * K + (kt + 1) * 64 + c8);
        }
      }
#pragma unroll
      for (int kk = 0; kk < 4; ++kk) {
        bf16x8 fa[2], fb[2];
#pragma unroll
        for (int i = 0; i < 2; ++i) fa[i] = *(const bf16x8*)(sA + (wm * 64 + i * 32 + r) * G_LDS_STRIDE + kk * 16 + hh * 8);
#pragma unroll
        for (int j = 0; j < 2; ++j) fb[j] = *(const bf16x8*)(sB + (wn * 64 + j * 32 + r) * G_LDS_STRIDE + kk * 16 + hh * 8);
#pragma unroll
        for (int i = 0; i < 2; ++i)
#pragma unroll
          for (int j = 0; j < 2; ++j) acc[i][j] = __builtin_amdgcn_mfma_f32_32x32x16_bf16(fa[i], fb[j], acc[i][j], 0, 0, 0);
      }
    }
#pragma unroll
    for (int i = 0; i < 2; ++i)
#pragma unroll
      for (int j = 0; j < 2; ++j)
#pragma unroll
        for (int qd = 0; qd < 4; ++qd) {
          int row0 = m0 + wm * 64 + i * 32 + 8 * qd + 4 * hh;
          int col = n0 + wn * 64 + j * 32 + r;
          epi.quad(row0, col, acc[i][j][4 * qd], acc[i][j][4 * qd + 1], acc[i][j][4 * qd + 2], acc[i][j][4 * qd + 3]);
        }
  }
}

struct EpiBf16 {
  bf16_t* C; int ldc;
  __device__ __forceinline__ void operator()(int row, int col, float v) const { C[(size_t)row * ldc + col] = f2bf(v); }
  __device__ __forceinline__ void quad(int row0, int col, float v0, float v1, float v2, float v3) const {
    (*this)(row0, col, v0); (*this)(row0 + 1, col, v1); (*this)(row0 + 2, col, v2); (*this)(row0 + 3, col, v3);
  }
};
struct EpiT {
  bf16_t* Ct; size_t ldt;
  __device__ __forceinline__ void quad(int row0, int col, float v0, float v1, float v2, float v3) const {
    u32x2 o; o.x = pack2(v0, v1); o.y = pack2(v2, v3);
    *(u32x2*)(Ct + (size_t)col * ldt + row0) = o;
  }
};
struct EpiSsdIn {
  bf16_t* z; bf16_t* xbc; float* dt; const float* dt_bias;
  __device__ __forceinline__ void operator()(int row, int col, float v) const {
    if (col < 2048) z[(size_t)row * 2048 + col] = f2bf(v);
    else if (col < 6144) xbc[(size_t)row * 4096 + (col - 2048)] = f2bf(v);
    else if (col < 6208) dt[(size_t)row * 64 + (col - 6144)] = softplusf(v + dt_bias[col - 6144]);
  }
  __device__ __forceinline__ void quad(int row0, int col, float v0, float v1, float v2, float v3) const {
    (*this)(row0, col, v0); (*this)(row0 + 1, col, v1); (*this)(row0 + 2, col, v2); (*this)(row0 + 3, col, v3);
  }
};
struct EpiOut {
  float* xres; const float* modv_layer; const float* rstd;
  __device__ __forceinline__ void operator()(int row, int col, float v) const {
    int mrow = row < T_CTX ? 0 : 1 + ((row - T_CTX) >> 12);
    float g = modv_layer[(size_t)mrow * 3072 + 2048 + col];
    float rs = rstd ? rstd[row] : 1.f;
    size_t idx = (size_t)row * DM + col;
    xres[idx] = ALPHA_RES * xres[idx] + g * (v * rs);
  }
  __device__ __forceinline__ void quad(int row0, int col, float v0, float v1, float v2, float v3) const {
    (*this)(row0, col, v0); (*this)(row0 + 1, col, v1); (*this)(row0 + 2, col, v2); (*this)(row0 + 3, col, v3);
  }
};
struct EpiLruGate {
  bf16_t* gates; const float* gate_b; int nb;
  __device__ __forceinline__ void operator()(int row, int col, float v) const {
    int dg = col >> 8, ch = nb * 256 + (col & 255);
    float pre = v + gate_b[dg * 1024 + ch];
    gates[((size_t)dg * T_ALL + row) * 1024 + ch] = f2bf(sigmoidf(pre));
  }
  __device__ __forceinline__ void quad(int row0, int col, float v0, float v1, float v2, float v3) const {
    (*this)(row0, col, v0); (*this)(row0 + 1, col, v1); (*this)(row0 + 2, col, v2); (*this)(row0 + 3, col, v3);
  }
};

template <int KW, bool SILU>
__device__ __forceinline__ void phase_dwconv(const bf16_t* __restrict__ src, int ld_src, bf16_t* __restrict__ dst, int ld_dst, int CH,
                             const float* __restrict__ w, const float* __restrict__ b, bool colmajor, int bid, int nblk) {
  const int tidx = opaque_tid();
  const int cpr = CH / 8;
  const size_t total = (size_t)T_ALL * cpr;
  for (size_t idx = (size_t)bid * NTHR + tidx; idx < total; idx += (size_t)nblk * NTHR) {
    int tok = (int)(idx / cpr), c0 = (int)(idx % cpr) * 8;
    TokInfo ti = tokinfo(tok);
    bool cm = colmajor && ti.s >= 32;
    int pos = seqpos2off(ti.l, cm);
    float acc[8];
#pragma unroll
    for (int e = 0; e < 8; ++e) acc[e] = b[c0 + e];
#pragma unroll
    for (int k = 0; k < KW; ++k) {
      int pp = pos + k - 1;
      if (pp < 0 || pp >= ti.L) continue;
      int tk = ti.base + seqpos2off(pp, cm);
      u32x4 xv = *(const u32x4*)(src + (size_t)tk * ld_src + c0);
      const float* wk = w + (size_t)k * CH + c0;
      acc[0] += wk[0] * bflo(xv.x); acc[1] += wk[1] * bfhi(xv.x);
      acc[2] += wk[2] * bflo(xv.y); acc[3] += wk[3] * bfhi(xv.y);
      acc[4] += wk[4] * bflo(xv.z); acc[5] += wk[5] * bfhi(xv.z);
      acc[6] += wk[6] * bflo(xv.w); acc[7] += wk[7] * bfhi(xv.w);
    }
    if (SILU) {
#pragma unroll
      for (int e = 0; e < 8; ++e) acc[e] = siluf(acc[e]);
    }
    u32x4 o;
    o.x = pack2(acc[0], acc[1]); o.y = pack2(acc[2], acc[3]); o.z = pack2(acc[4], acc[5]); o.w = pack2(acc[6], acc[7]);
    *(u32x4*)(dst + (size_t)tok * ld_dst + c0) = o;
  }
}

__device__ __forceinline__ void phase_ssd_conv(const Params& p, int slot, bool colmajor, int bid, int nblk, unsigned char* smem) {
  const int tid = opaque_tid();
  const bf16_t* raw = (const bf16_t*)(p.scratch + SC_SSD_XBC);
  bf16_t* out = (bf16_t*)(p.scratch + SC_SSD_XBCC);
  bf16_t* XT = (bf16_t*)(p.scratch + SC_SSD_XT);
  bf16_t* BT = (bf16_t*)(p.scratch + SC_SSD_BT);
  const float* cw = p.ssd_conv_w + (size_t)slot * 4 * 4096;
  const float* cb = p.ssd_conv_b + slot * 4096;
  bf16_t* tl = (bf16_t*)smem;
  for (int item = bid; item < 384 * 64; item += nblk) {
    const int ptile = item >> 6, ct = item & 63;
    const int ptok0 = ptile * 64;
    TokInfo ti = tokinfo(ptok0);
    const bool cm = colmajor && ti.s >= 32;
    const int rr = tid >> 2, cpart = tid & 3;
    const int ch = ct * 64 + cpart * 16;
    const int pos = ti.l + rr;
    float acc[16];
#pragma unroll
    for (int e = 0; e < 16; ++e) acc[e] = cb[ch + e];
#pragma unroll
    for (int k = 0; k < 4; ++k) {
      int pp = pos + k - 1;
      if (pp < 0 || pp >= ti.L) continue;
      int tk = ti.base + seqpos2off(pp, cm);
      const bf16_t* rp = raw + (size_t)tk * 4096 + ch;
      u32x4 x0 = *(const u32x4*)rp, x1 = *(const u32x4*)(rp + 8);
      const float* wk = cw + (size_t)k * 4096 + ch;
      unsigned xw[8] = {x0.x, x0.y, x0.z, x0.w, x1.x, x1.y, x1.z, x1.w};
#pragma unroll
      for (int e = 0; e < 8; ++e) { acc[2 * e] += wk[2 * e] * bflo(xw[e]); acc[2 * e + 1] += wk[2 * e + 1] * bfhi(xw[e]); }
    }
    u32x4 o0, o1;
    o0.x = pack2(siluf(acc[0]), siluf(acc[1])); o0.y = pack2(siluf(acc[2]), siluf(acc[3]));
    o0.z = pack2(siluf(acc[4]), siluf(acc[5])); o0.w = pack2(siluf(acc[6]), siluf(acc[7]));
    o1.x = pack2(siluf(acc[8]), siluf(acc[9])); o1.y = pack2(siluf(acc[10]), siluf(acc[11]));
    o1.z = pack2(siluf(acc[12]), siluf(acc[13])); o1.w = pack2(siluf(acc[14]), siluf(acc[15]));
    bf16_t* op = out + (size_t)(ptok0 + rr) * 4096 + ch;
    *(u32x4*)op = o0; *(u32x4*)(op + 8) = o1;
    if (ct < 48) {
      __syncthreads();
      *(u32x4*)(tl + rr * 72 + cpart * 16) = o0;
      *(u32x4*)(tl + rr * 72 + cpart * 16 + 8) = o1;
      __syncthreads();
      const int crow = tid >> 2, part = tid & 3;
      unsigned wv[8];
#pragma unroll
      for (int e = 0; e < 8; ++e) {
        unsigned lo = tl[(part * 16 + 2 * e) * 72 + crow], hi = tl[(part * 16 + 2 * e + 1) * 72 + crow];
        wv[e] = lo | (hi << 16);
      }
      const int chg = ct * 64 + crow;
      bf16_t* dp = (chg < 2048 ? XT + (size_t)chg * T_ALL : BT + (size_t)(chg - 2048) * T_ALL) + ptok0 + part * 16;
      u32x4 t0, t1;
      t0.x = wv[0]; t0.y = wv[1]; t0.z = wv[2]; t0.w = wv[3]; t1.x = wv[4]; t1.y = wv[5]; t1.z = wv[6]; t1.w = wv[7];
      *(u32x4*)dp = t0; *(u32x4*)(dp + 8) = t1;
    }
  }
}

#define SH_STRIDE 136
__device__ __forceinline__ int rowmap(int e, int hh) { return (e & 3) + 8 * (e >> 2) + 4 * hh; }
__device__ __forceinline__ bf16x8 pack8(float a0, float a1, float a2, float a3, float a4, float a5, float a6, float a7) {
  u32x4 v; v.x = pack2(a0, a1); v.y = pack2(a2, a3); v.z = pack2(a4, a5); v.w = pack2(a6, a7);
  return __builtin_bit_cast(bf16x8, v);
}
__device__ __forceinline__ void phase_ssd_scan(const Params& p, int slot, bool colmajor, int bid, int nblk, unsigned char* smem) {
  const int tid = opaque_tid(), lane = tid & 63, w = tid >> 6, r = lane & 31, hh = lane >> 5;
  const int it = w >> 1, pt = w & 1;
  const bf16_t* xbcc = (const bf16_t*)(p.scratch + SC_SSD_XBCC);
  const bf16_t* XT = (const bf16_t*)(p.scratch + SC_SSD_XT);
  const bf16_t* BT = (const bf16_t*)(p.scratch + SC_SSD_BT);
  const float* dtb = (const float*)(p.scratch + SC_SSD_DT);
  bf16_t* ybuf = (bf16_t*)(p.scratch + SC_SSD_XBC);
  bf16_t* sXr = (bf16_t*)smem;
  bf16_t* sXs = sXr + 64 * 72;
  bf16_t* sH = sXs + 64 * 72;
  float* sW = (float*)(sH + 2 * 64 * SH_STRIDE);
  float* myW = sW + w * 256;
  for (int item = bid; item < 36 * 64; item += nblk) {
    int s, h, dir;
    if (item < 256) { s = 32 + (item >> 6); h = (item & 63) >> 1; dir = item & 1; }
    else { int itx = item - 256; s = itx >> 6; h = (itx & 63) >> 1; dir = itx & 1; }
    const int L = s < 32 ? 256 : 4096;
    const int base = s < 32 ? s * 256 : T_CTX + (s - 32) * 4096;
    const bool cm = colmajor && s >= 32;
    const int g = h >> 2;
    const float Aval = -expf(p.ssd_a_log[(slot * 2 + dir) * 32 + h]);
    const int nchunks = L >> 6;
    const int pcol = 32 * pt + r;
    f32x16 hacc[2];
    if (s >= 32) {
      const float* h0 = p.state_ssd + ((((size_t)(s - 32) * 2 + slot) * 2 + dir) * 32 + h) * 8192 + (size_t)pcol * 128;
#pragma unroll
      for (int t2 = 0; t2 < 2; ++t2)
#pragma unroll
        for (int qd = 0; qd < 4; ++qd) {
          f32x4 v = *(const f32x4*)(h0 + 32 * (2 * it + t2) + 8 * qd + 4 * hh);
          hacc[t2][4 * qd] = v.x; hacc[t2][4 * qd + 1] = v.y; hacc[t2][4 * qd + 2] = v.z; hacc[t2][4 * qd + 3] = v.w;
        }
    } else {
#pragma unroll
      for (int t2 = 0; t2 < 2; ++t2)
#pragma unroll
        for (int e = 0; e < 16; ++e) hacc[t2][e] = 0.f;
    }
#pragma unroll
    for (int t2 = 0; t2 < 2; ++t2)
#pragma unroll
      for (int qd = 0; qd < 4; ++qd) {
        u32x2 o; o.x = pack2(hacc[t2][4 * qd], hacc[t2][4 * qd + 1]); o.y = pack2(hacc[t2][4 * qd + 2], hacc[t2][4 * qd + 3]);
        *(u32x2*)(sH + pcol * SH_STRIDE + 32 * (2 * it + t2) + 8 * qd + 4 * hh) = o;
      }
    for (int ci = 0; ci < nchunks; ++ci) {
      const int cpos = dir ? nchunks - 1 - ci : ci;
      const int pos0 = cpos * 64, ptok0 = base + pos0;
      const int buf = ci & 1;
      __syncthreads();
      float decE;
      {
        const int tok = base + seqpos2off(pos0 + lane, cm);
        const float dtv = dtb[(size_t)tok * 64 + dir * 32 + h];
        float c = dtv * Aval;
        if (dir == 0) {
#pragma unroll
          for (int off = 1; off < 64; off <<= 1) { float t = __shfl_up(c, off); if (lane >= off) c += t; }
        } else {
#pragma unroll
          for (int off = 1; off < 64; off <<= 1) { float t = __shfl_down(c, off); if (lane + off < 64) c += t; }
        }
        const float cE = __shfl(c, dir ? 0 : 63);
        myW[lane] = dtv; myW[64 + lane] = c; myW[128 + lane] = __expf(c); myW[192 + lane] = dtv * __expf(cE - c);
        decE = __expf(cE);
      }
#pragma unroll
      for (int i = 0; i < 2; ++i) {
        const int q = tid + i * 256, prow = q >> 3, j8 = (q & 7) * 8;
        u32x4 raw = *(const u32x4*)(XT + (size_t)(h * 64 + prow) * T_ALL + ptok0 + j8);
        *(u32x4*)(sXr + prow * 72 + j8) = raw;
        f32x4 f0 = *(const f32x4*)(myW + 192 + j8), f1 = *(const f32x4*)(myW + 192 + j8 + 4);
        u32x4 sc;
        sc.x = pack2(bflo(raw.x) * f0.x, bfhi(raw.x) * f0.y); sc.y = pack2(bflo(raw.y) * f0.z, bfhi(raw.y) * f0.w);
        sc.z = pack2(bflo(raw.z) * f1.x, bfhi(raw.z) * f1.y); sc.w = pack2(bflo(raw.w) * f1.z, bfhi(raw.w) * f1.w);
        *(u32x4*)(sXs + prow * 72 + j8) = sc;
      }
      __syncthreads();
      bf16x8 cfr[8];
      {
        const bf16_t* crow = xbcc + (size_t)(ptok0 + 32 * it + r) * 4096 + 3072 + g * 128 + 8 * hh;
#pragma unroll
        for (int kk = 0; kk < 8; ++kk) cfr[kk] = *(const bf16x8*)(crow + 16 * kk);
      }
      f32x16 acc;
#pragma unroll
      for (int e = 0; e < 16; ++e) acc[e] = 0.f;
      {
        const bf16_t* hp = sH + buf * 64 * SH_STRIDE + pcol * SH_STRIDE + 8 * hh;
#pragma unroll
        for (int kk = 0; kk < 8; ++kk) acc = __builtin_amdgcn_mfma_f32_32x32x16_bf16(cfr[kk], *(const bf16x8*)(hp + 16 * kk), acc, 0, 0, 0);
      }
#pragma unroll
      for (int qd = 0; qd < 4; ++qd) {
        f32x4 ec = *(const f32x4*)(myW + 128 + 32 * it + 8 * qd + 4 * hh);
        acc[4 * qd] *= ec.x; acc[4 * qd + 1] *= ec.y; acc[4 * qd + 2] *= ec.z; acc[4 * qd + 3] *= ec.w;
      }
      const int icol = 32 * it + r;
      const float ci_ = myW[64 + icol];
#pragma unroll
      for (int jt = 0; jt < 2; ++jt) {
        const bool needed = dir == 0 ? (jt <= it) : (jt >= it);
        if (needed) {
          f32x16 X;
#pragma unroll
          for (int e = 0; e < 16; ++e) X[e] = 0.f;
          const bf16_t* brow = xbcc + (size_t)(ptok0 + 32 * jt + r) * 4096 + 2048 + g * 128 + 8 * hh;
#pragma unroll
          for (int kk = 0; kk < 8; ++kk) X = __builtin_amdgcn_mfma_f32_32x32x16_bf16(*(const bf16x8*)(brow + 16 * kk), cfr[kk], X, 0, 0, 0);
#pragma unroll
          for (int qd = 0; qd < 4; ++qd) {
            const int j0 = 32 * jt + 8 * qd + 4 * hh;
            f32x4 cj = *(const f32x4*)(myW + 64 + j0), dj = *(const f32x4*)(myW + j0);
            float cjv[4] = {cj.x, cj.y, cj.z, cj.w}, djv[4] = {dj.x, dj.y, dj.z, dj.w};
#pragma unroll
            for (int u = 0; u < 4; ++u) {
              const int j = j0 + u;
              const bool ok = dir == 0 ? (j <= icol) : (j >= icol);
              const float m = __expf(ci_ - cjv[u]) * djv[u];
              X[4 * qd + u] = ok ? X[4 * qd + u] * m : 0.f;
            }
          }
#pragma unroll
          for (int sk = 0; sk < 2; ++sk) {
            bf16x8 afr = pack8(X[8 * sk], X[8 * sk + 1], X[8 * sk + 2], X[8 * sk + 3], X[8 * sk + 4], X[8 * sk + 5], X[8 * sk + 6], X[8 * sk + 7]);
            const bf16_t* xp = sXr + pcol * 72 + 32 * jt + 16 * sk + 4 * hh;
            u32x2 lo = *(const u32x2*)xp, hi = *(const u32x2*)(xp + 8);
            u32x4 xv; xv.x = lo.x; xv.y = lo.y; xv.z = hi.x; xv.w = hi.y;
            acc = __builtin_amdgcn_mfma_f32_32x32x16_bf16(afr, __builtin_bit_cast(bf16x8, xv), acc, 0, 0, 0);
          }
        }
      }
      {
        bf16_t* yo = ybuf + ((size_t)dir * T_ALL + ptok0 + 32 * it) * 2048 + h * 64 + pcol;
#pragma unroll
        for (int e = 0; e < 16; ++e) yo[(size_t)rowmap(e, hh) * 2048] = f2bf(acc[e]);
      }
#pragma unroll
      for (int t2 = 0; t2 < 2; ++t2) {
#pragma unroll
        for (int e = 0; e < 16; ++e) hacc[t2][e] *= decE;
        const bf16_t* bt = BT + (size_t)(g * 128 + 32 * (2 * it + t2) + r) * T_ALL + ptok0 + 8 * hh;
        const bf16_t* xs = sXs + pcol * 72 + 8 * hh;
#pragma unroll
        for (int kk = 0; kk < 4; ++kk)
          hacc[t2] = __builtin_amdgcn_mfma_f32_32x32x16_bf16(*(const bf16x8*)(bt + 16 * kk), *(const bf16x8*)(xs + 16 * kk), hacc[t2], 0, 0, 0);
#pragma unroll
        for (int qd = 0; qd < 4; ++qd) {
          u32x2 o; o.x = pack2(hacc[t2][4 * qd], hacc[t2][4 * qd + 1]); o.y = pack2(hacc[t2][4 * qd + 2], hacc[t2][4 * qd + 3]);
          *(u32x2*)(sH + (buf ^ 1) * 64 * SH_STRIDE + pcol * SH_STRIDE + 32 * (2 * it + t2) + 8 * qd + 4 * hh) = o;
        }
      }
    }
    if (s < 32) {
      float* ho = p.out_ssd + ((((size_t)s * 2 + slot) * 2 + dir) * 32 + h) * 8192 + (size_t)pcol * 128;
#pragma unroll
      for (int t2 = 0; t2 < 2; ++t2)
#pragma unroll
        for (int qd = 0; qd < 4; ++qd) {
          f32x4 v; v.x = hacc[t2][4 * qd]; v.y = hacc[t2][4 * qd + 1]; v.z = hacc[t2][4 * qd + 2]; v.w = hacc[t2][4 * qd + 3];
          *(f32x4*)(ho + 32 * (2 * it + t2) + 8 * qd + 4 * hh) = v;
        }
    }
    __syncthreads();
  }
}

__device__ __forceinline__ void phase_ssd_gate(const Params& p, int slot, int bid, int nblk) {
  const int tidx = opaque_tid();
  bf16_t* zb = (bf16_t*)(p.scratch + SC_SSD_Z);
  const bf16_t* yfb = (const bf16_t*)(p.scratch + SC_SSD_XBC);
  const bf16_t* ybb = yfb + (size_t)T_ALL * 2048;
  const bf16_t* xbcc = (const bf16_t*)(p.scratch + SC_SSD_XBCC);
  int lane = tidx & 63, wv = tidx >> 6;
  for (int row = bid * 4 + wv; row < T_ALL; row += nblk * 4) {
    float ss = 0.f;
    TokInfo ti = tokinfo(row);
    const int prow = ti.base + seqpos2off(ti.l, slot == 1 && ti.s >= 32);
#pragma unroll
    for (int j = 0; j < 4; ++j) {
      int c0 = j * 512 + lane * 8;
      u32x4 zv = *(const u32x4*)(zb + (size_t)row * 2048 + c0);
      u32x4 fv = *(const u32x4*)(yfb + (size_t)prow * 2048 + c0);
      u32x4 bv = *(const u32x4*)(ybb + (size_t)prow * 2048 + c0);
      u32x4 xv = *(const u32x4*)(xbcc + (size_t)prow * 4096 + c0);
      float dsk = p.ssd_d[slot * 32 + (c0 >> 6)];
      unsigned zw[4] = {zv.x, zv.y, zv.z, zv.w}, fw[4] = {fv.x, fv.y, fv.z, fv.w}, bw[4] = {bv.x, bv.y, bv.z, bv.w}, xw[4] = {xv.x, xv.y, xv.z, xv.w};
      unsigned ow[4];
#pragma unroll
      for (int e = 0; e < 4; ++e) {
        float y0 = (bflo(fw[e]) + bflo(bw[e]) + dsk * bflo(xw[e])) * siluf(bflo(zw[e]));
        float y1 = (bfhi(fw[e]) + bfhi(bw[e]) + dsk * bfhi(xw[e])) * siluf(bfhi(zw[e]));
        ss += y0 * y0 + y1 * y1;
        ow[e] = pack2(y0, y1);
      }
      u32x4 o; o.x = ow[0]; o.y = ow[1]; o.z = ow[2]; o.w = ow[3];
      *(u32x4*)(zb + (size_t)row * 2048 + c0) = o;
    }
#pragma unroll
    for (int o = 32; o > 0; o >>= 1) ss += __shfl_xor(ss, o);
    if (lane == 0) p.rstd[row] = rsqrtf(ss * (1.f / 2048.f) + 1e-5f);
  }
}

#define HY_UOFF 32768
__device__ __forceinline__ void hy_stage_conv(const Params& p, const bf16_t* __restrict__ row, int ch, bf16_t* dst, int dstStride, int dstPad,
                                              int nelem, int L, int tid) {
  const float w0 = p.hy_conv_w[ch], w1 = p.hy_conv_w[3072 + ch], w2 = p.hy_conv_w[2 * 3072 + ch], bb = p.hy_conv_b[ch];
  for (int q = tid; q < nelem / 8; q += NTHR) {
    const int e0 = q * 8, b = e0 / L, t0 = e0 & (L - 1);
    u32x4 raw = *(const u32x4*)(row + e0);
    float x[10];
    x[0] = t0 > 0 ? bf2f(row[e0 - 1]) : 0.f;
    x[9] = t0 + 8 < L ? bf2f(row[e0 + 8]) : 0.f;
    x[1] = bflo(raw.x); x[2] = bfhi(raw.x); x[3] = bflo(raw.y); x[4] = bfhi(raw.y);
    x[5] = bflo(raw.z); x[6] = bfhi(raw.z); x[7] = bflo(raw.w); x[8] = bfhi(raw.w);
    float o[8];
#pragma unroll
    for (int j = 0; j < 8; ++j) o[j] = w0 * x[j] + w1 * x[j + 1] + w2 * x[j + 2] + bb;
    u32x4 ov; ov.x = pack2(o[0], o[1]); ov.y = pack2(o[2], o[3]); ov.z = pack2(o[4], o[5]); ov.w = pack2(o[6], o[7]);
    *(u32x4*)(dst + b * dstStride + dstPad + t0) = ov;
  }
}

__device__ __forceinline__ void phase_hy_longconv(const Params& p, int bid, int nblk, unsigned char* smem) {
  const int tid = opaque_tid(), lane = tid & 63, w = tid >> 6, r = lane & 31, hh = lane >> 5;
  const bf16_t* projT = (const bf16_t*)(p.scratch + SC_HY_PROJT);
  bf16_t* yT = (bf16_t*)(p.scratch + SC_HY_YT);
  unsigned* Rc0 = (unsigned*)smem;
  unsigned* Rc1 = Rc0 + 4096;
  bf16_t* G = (bf16_t*)smem;
  bf16_t* U = (bf16_t*)(smem + HY_UOFF);
  for (int item = bid; item < 2048; item += nblk) {
    const bool lat = item < 1024;
    const int c = item & 1023;
    const int L = lat ? 4096 : 256, NB = lat ? 4 : 32, RL = lat ? 8192 : 512, Lm1 = L - 1;
    const int PAD = lat ? 224 : 0, US = L + 2 * PAD;
    const int tokbase = lat ? T_CTX : 0;
    const int nI = L >> 5, nelem = NB * L;
    const int TPW = lat ? 4 : 2;
    __syncthreads();
    if (lat) {
      for (int q = tid; q < 4 * 56; q += NTHR) {
        int b = q / 56, k = q % 56;
        int off = k < 28 ? k * 8 : 224 + 4096 + (k - 28) * 8;
        u32x4 z4 = {0u, 0u, 0u, 0u};
        *(u32x4*)(U + b * US + off) = z4;
      }
    }
    hy_stage_conv(p, projT + (size_t)c * T_ALL + tokbase, c, U, US, PAD, nelem, L, tid);
    int Icol[4], bcol[4];
#pragma unroll
    for (int tt = 0; tt < 4; ++tt) {
      int n = (w * TPW + tt) * 32 + r;
      Icol[tt] = lat ? (n >> 2) : (n >> 5);
      bcol[tt] = lat ? (n & 3) : (n & 31);
    }
    const int Ilo_w = lat ? 32 * w : 2 * w, Ihi_w = lat ? 32 * w + 31 : 2 * w + 1;
    const int dlo = Ilo_w - (nI - 1), dhi = Ihi_w;
    for (int order = 0; order < 2; ++order) {
      {
        const bf16_t* src = (lat ? p.rtab1 : p.rtab0) + (size_t)(order * 1024 + c) * RL;
        for (int q = tid; q < RL / 8; q += NTHR) {
          u32x4 cv = *(const u32x4*)(src + q * 8);
          unsigned nx = (q + 1 < RL / 8) ? *(const unsigned*)(src + q * 8 + 8) : 0u;
          *(u32x4*)(Rc0 + q * 4) = cv;
          u32x4 sv;
          sv.x = (cv.x >> 16) | (cv.y << 16); sv.y = (cv.y >> 16) | (cv.z << 16);
          sv.z = (cv.z >> 16) | (cv.w << 16); sv.w = (cv.w >> 16) | (nx << 16);
          *(u32x4*)(Rc1 + q * 4) = sv;
        }
      }
      __syncthreads();
      f32x16 acc[4];
#pragma unroll
      for (int tt = 0; tt < 4; ++tt)
#pragma unroll
        for (int e = 0; e < 16; ++e) acc[tt][e] = 0.f;
      for (int d = dlo; d <= dhi; ++d) {
#pragma unroll
        for (int kk = 0; kk < 2; ++kk) {
          const int y0 = Lm1 - 32 * d - r + 16 * kk + 8 * hh;
          const int par = y0 & 1;
          const unsigned* rp = (par ? Rc1 : Rc0) + ((y0 - par) >> 1);
          u32x4 av; av.x = rp[0]; av.y = rp[1]; av.z = rp[2]; av.w = rp[3];
          bf16x8 af = __builtin_bit_cast(bf16x8, av);
#pragma unroll
          for (int tt = 0; tt < 4; ++tt) {
            if (tt < TPW) {
              const int tile = w * TPW + tt;
              const int Ilo_t = lat ? 8 * tile : tile, Ihi_t = lat ? 8 * tile + 7 : tile;
              if (d >= Ilo_t - (nI - 1) && d <= Ihi_t) {
                const bf16_t* bp = U + bcol[tt] * US + PAD + 32 * (Icol[tt] - d) + 16 * kk + 8 * hh;
                bf16x8 bfr = *(const bf16x8*)bp;
                acc[tt] = __builtin_amdgcn_mfma_f32_32x32x16_bf16(af, bfr, acc[tt], 0, 0, 0);
              }
            }
          }
        }
      }
      __syncthreads();
      hy_stage_conv(p, projT + (size_t)((1 + order) * 1024 + c) * T_ALL + tokbase, (1 + order) * 1024 + c, G, L, 0, nelem, L, tid);
      __syncthreads();
      const float inv = 1.f / p.knorm[((lat ? 1 : 0) * 2 + order) * 1024 + c];
      const float bias = p.hy_f_bias[order * 1024 + c];
#pragma unroll
      for (int tt = 0; tt < 4; ++tt) {
        if (tt < TPW) {
#pragma unroll
          for (int qd = 0; qd < 4; ++qd) {
            const int t0 = 32 * Icol[tt] + 8 * qd + 4 * hh;
            bf16_t* up = U + bcol[tt] * US + PAD + t0;
            u32x2 uc = *(const u32x2*)up;
            u32x2 gg = *(const u32x2*)(G + bcol[tt] * L + t0);
            float r0 = (inv * acc[tt][4 * qd] + bias * bflo(uc.x)) * bflo(gg.x);
            float r1 = (inv * acc[tt][4 * qd + 1] + bias * bfhi(uc.x)) * bfhi(gg.x);
            float r2 = (inv * acc[tt][4 * qd + 2] + bias * bflo(uc.y)) * bflo(gg.y);
            float r3 = (inv * acc[tt][4 * qd + 3] + bias * bfhi(uc.y)) * bfhi(gg.y);
            if (order == 1) {
              u32x2 zz = *(const u32x2*)(projT + (size_t)(3072 + c) * T_ALL + tokbase + bcol[tt] * L + t0);
              r0 *= siluf(bflo(zz.x)); r1 *= siluf(bfhi(zz.x)); r2 *= siluf(bflo(zz.y)); r3 *= siluf(bfhi(zz.y));
            }
            u32x2 ov; ov.x = pack2(r0, r1); ov.y = pack2(r2, r3);
            *(u32x2*)up = ov;
          }
        }
      }
      __syncthreads();
    }
    for (int q = tid; q < nelem / 8; q += NTHR) {
      const int e0 = q * 8, b = e0 / L, t0 = e0 & (L - 1);
      *(u32x4*)(yT + (size_t)c * T_ALL + tokbase + e0) = *(const u32x4*)(U + b * US + PAD + t0);
    }
  }
}

__device__ __forceinline__ void phase_hy_transpose(const Params& p, int bid, int nblk, unsigned char* smem) {
  const int tid = opaque_tid();
  const bf16_t* yT = (const bf16_t*)(p.scratch + SC_HY_YT);
  bf16_t* yg = (bf16_t*)(p.scratch + SC_HY_YG);
  bf16_t* tl = (bf16_t*)smem;
  for (int item = bid; item < 16 * (T_ALL / 64); item += nblk) {
    const int cb = item & 15, tb = item >> 4;
    __syncthreads();
#pragma unroll
    for (int i = 0; i < 2; ++i) {
      int q = tid + i * 256, cr = q >> 3, t8 = (q & 7) * 8;
      u32x4 v = *(const u32x4*)(yT + (size_t)(cb * 64 + cr) * T_ALL + tb * 64 + t8);
      unsigned wv[4] = {v.x, v.y, v.z, v.w};
#pragma unroll
      for (int e = 0; e < 4; ++e) {
        tl[(t8 + 2 * e) * 72 + cr] = (bf16_t)(wv[e] & 0xffffu);
        tl[(t8 + 2 * e + 1) * 72 + cr] = (bf16_t)(wv[e] >> 16);
      }
    }
    __syncthreads();
#pragma unroll
    for (int i = 0; i < 2; ++i) {
      int q = tid + i * 256, tr = q >> 3, c8 = (q & 7) * 8;
      *(u32x4*)(yg + (size_t)(tb * 64 + tr) * 1024 + cb * 64 + c8) = *(const u32x4*)(tl + tr * 72 + c8);
    }
  }
}

__device__ __forceinline__ void lru_ab(const bf16_t* gates, const bf16_t* xc, int dir, int tok, int c, float sp, float& a, float& bx) {
  float r = bf2f(gates[((size_t)(dir * 2 + 0) * T_ALL + tok) * 1024 + c]);
  float i = bf2f(gates[((size_t)(dir * 2 + 1) * T_ALL + tok) * 1024 + c]);
  float x = bf2f(xc[(size_t)tok * 1024 + c]);
  float log_a = -8.f * r * sp;
  a = __expf(log_a);
  float m = sqrtf(fmaxf(1.f - __expf(2.f * log_a), 0.f));
  bx = m * i * x;
}
__device__ __forceinline__ void phase_lru_scan_chunks(const Params& p, int pass, int bid, int nblk) {
  const int tidx = opaque_tid();
  const bf16_t* gates = (const bf16_t*)(p.scratch + SC_LRU_GATES);
  const bf16_t* xc = (const bf16_t*)(p.scratch + SC_LRU_XC);
  bf16_t* ybuf = (bf16_t*)(p.scratch + SC_LRU_Y);
  for (int item = bid; item < 192 * 8; item += nblk) {
    int chunk = item >> 3, dir = (item >> 2) & 1, cb = item & 3;
    int c = cb * 256 + tidx;
    float sp = softplusf(-p.lru_a_param[dir * 1024 + c]);
    int tok0 = chunk * 128;
    float A = 1.f, h = (pass == 0) ? 0.f : p.lru_hin[((size_t)dir * 192 + chunk) * 1024 + c];
    for (int j = 0; j < 128; ++j) {
      int tok = dir ? tok0 + 127 - j : tok0 + j;
      float a, bx;
      lru_ab(gates, xc, dir, tok, c, sp, a, bx);
      h = a * h + bx; A *= a;
      if (pass == 2) ybuf[((size_t)dir * T_ALL + tok) * 1024 + c] = f2bf(h);
    }
    if (pass == 0) {
      float* ag = p.lru_agg + (((size_t)dir * 192 + chunk) * 1024 + c) * 2;
      ag[0] = A; ag[1] = h;
    }
  }
}
__device__ __forceinline__ void phase_lru_scan_carry(const Params& p, int bid, int nblk) {
  const int tidx = opaque_tid();
  for (int item = bid; item < 36 * 8; item += nblk) {
    int s = item >> 3, dir = (item >> 2) & 1, cb = item & 3;
    int c = cb * 256 + tidx;
    int nch = s < 32 ? 2 : 32;
    int ch0 = s < 32 ? s * 2 : 64 + (s - 32) * 32;
    float h = s < 32 ? 0.f : p.state_lru[((size_t)(s - 32) * 2 + dir) * 1024 + c];
    for (int k = 0; k < nch; ++k) {
      int chunk = dir ? ch0 + nch - 1 - k : ch0 + k;
      size_t idx = ((size_t)dir * 192 + chunk) * 1024 + c;
      p.lru_hin[idx] = h;
      h = p.lru_agg[idx * 2] * h + p.lru_agg[idx * 2 + 1];
    }
    if (s < 32) p.out_lru[((size_t)s * 2 + dir) * 1024 + c] = h;
  }
}
__device__ __forceinline__ void phase_lru_combine(const Params& p, int bid, int nblk) {
  const int tidx = opaque_tid();
  const bf16_t* proj = (const bf16_t*)(p.scratch + SC_LRU_PROJ);
  const bf16_t* yf = (const bf16_t*)(p.scratch + SC_LRU_Y);
  const bf16_t* yb = yf + (size_t)T_ALL * 1024;
  bf16_t* yg = (bf16_t*)(p.scratch + SC_LRU_YG);
  const size_t total = (size_t)T_ALL * 128;
  for (size_t idx = (size_t)bid * NTHR + tidx; idx < total; idx += (size_t)nblk * NTHR) {
    int tok = (int)(idx >> 7), c0 = (int)(idx & 127) * 8;
    u32x4 fv = *(const u32x4*)(yf + (size_t)tok * 1024 + c0);
    u32x4 bv = *(const u32x4*)(yb + (size_t)tok * 1024 + c0);
    u32x4 zv = *(const u32x4*)(proj + (size_t)tok * 2048 + 1024 + c0);
    unsigned fw[4] = {fv.x, fv.y, fv.z, fv.w}, bw[4] = {bv.x, bv.y, bv.z, bv.w}, zw[4] = {zv.x, zv.y, zv.z, zv.w}, ow[4];
#pragma unroll
    for (int e = 0; e < 4; ++e)
      ow[e] = pack2((bflo(fw[e]) + bflo(bw[e])) * siluf(bflo(zw[e])), (bfhi(fw[e]) + bfhi(bw[e])) * siluf(bfhi(zw[e])));
    u32x4 o; o.x = ow[0]; o.y = ow[1]; o.z = ow[2]; o.w = ow[3];
    *(u32x4*)(yg + (size_t)tok * 1024 + c0) = o;
  }
}

enum { PH_PREP = 0, PH_MOD, PH_HYA, PH_HYB, PH_LNMOD, PH_INPROJ, PH_MIX1, PH_MIX2, PH_MIX3, PH_MIX4, PH_MIX5, PH_MIX6, PH_OUTPROJ };

__device__ __forceinline__ void run_phase(const Params& p, int ph, int layer, int bid, int nblk, unsigned char* smem) {
  const int kind = layer % 3, slot = layer / 3;
  bid = opaque_s(bid);
  switch (ph) {
    case PH_PREP: phase_prep(p, bid, nblk, smem); break;
    case PH_MOD: phase_mod(p, bid, nblk, smem); break;
    case PH_HYA: phase_hyfilt_a(p, bid, nblk, smem); break;
    case PH_HYB: phase_hyfilt_b(p, bid, nblk, smem); break;
    case PH_LNMOD: phase_lnmod(p, layer, bid, nblk); break;
    case PH_INPROJ:
      if (kind == 0) {
        EpiSsdIn e{(bf16_t*)(p.scratch + SC_SSD_Z), (bf16_t*)(p.scratch + SC_SSD_XBC), (float*)(p.scratch + SC_SSD_DT), p.ssd_dt_bias + slot * 64};
        gemm_phase(p.hbuf, 1024, p.wt_ssd_in + (size_t)slot * 6272 * 1024, 1024, T_ALL / 128, 49, e, bid, nblk, smem);
      } else if (kind == 1) {
        EpiT e{(bf16_t*)(p.scratch + SC_HY_PROJT), (size_t)T_ALL};
        gemm_phase(p.hbuf, 1024, p.wt_hy_in, 1024, T_ALL / 128, 32, e, bid, nblk, smem);
      } else {
        EpiBf16 e{(bf16_t*)(p.scratch + SC_LRU_PROJ), 2048};
        gemm_phase(p.hbuf, 1024, p.wt_lru_in, 1024, T_ALL / 128, 16, e, bid, nblk, smem);
      }
      break;
    case PH_MIX1:
      if (kind == 0) phase_ssd_conv(p, slot, slot == 1, bid, nblk, smem);
      else if (kind == 1) phase_hy_longconv(p, bid, nblk, smem);
      else phase_dwconv<4, false>((const bf16_t*)(p.scratch + SC_LRU_PROJ), 2048, (bf16_t*)(p.scratch + SC_LRU_XC), 1024, 1024,
                                  p.lru_conv_w, p.lru_conv_b, false, bid, nblk);
      break;
    case PH_MIX2:
      if (kind == 0) phase_ssd_scan(p, slot, slot == 1, bid, nblk, smem);
      else if (kind == 1) phase_hy_transpose(p, bid, nblk, smem);
      else {
        for (int nb = 0; nb < 4; ++nb) {
          EpiLruGate e{(bf16_t*)(p.scratch + SC_LRU_GATES), p.lru_gate_b, nb};
          gemm_phase((const bf16_t*)(p.scratch + SC_LRU_XC) + nb * 256, 1024, p.wt_lru_gate + (size_t)nb * 1024 * 256, 256, T_ALL / 128, 8, e, bid, nblk, smem);
        }
      }
      break;
    case PH_MIX3:
      if (kind == 0) phase_ssd_gate(p, slot, bid, nblk);
      else phase_lru_scan_chunks(p, 0, bid, nblk);
      break;
    case PH_MIX4: if (kind == 2) phase_lru_scan_carry(p, bid, nblk); break;
    case PH_MIX5: if (kind == 2) phase_lru_scan_chunks(p, 2, bid, nblk); break;
    case PH_MIX6: if (kind == 2) phase_lru_combine(p, bid, nblk); break;
    case PH_OUTPROJ: {
      const float* mv = p.modv + (size_t)layer * 5 * 3072;
      if (kind == 0) {
        EpiOut e{p.xres, mv, p.rstd};
        gemm_phase((const bf16_t*)(p.scratch + SC_SSD_Z), 2048, p.wt_ssd_out + (size_t)slot * 1024 * 2048, 2048, T_ALL / 128, 8, e, bid, nblk, smem);
      } else if (kind == 1) {
        EpiOut e{p.xres, mv, nullptr};
        gemm_phase((const bf16_t*)(p.scratch + SC_HY_YG), 1024, p.wt_hy_out, 1024, T_ALL / 128, 8, e, bid, nblk, smem);
      } else {
        EpiOut e{p.xres, mv, nullptr};
        gemm_phase((const bf16_t*)(p.scratch + SC_LRU_YG), 1024, p.wt_lru_out, 1024, T_ALL / 128, 8, e, bid, nblk, smem);
      }
    } break;
  }
}

__global__ void __launch_bounds__(NTHR, 2) k_mega(Params p) {
  __shared__ __attribute__((aligned(16))) unsigned char smem[SMEM_BYTES];
  cg::grid_group grid = cg::this_grid();
  const int bid = blockIdx.x, nblk = gridDim.x;
  run_phase(p, PH_PREP, 0, bid, nblk, smem);
  run_phase(p, PH_MOD, 0, bid, nblk, smem);
  run_phase(p, PH_HYA, 0, bid, nblk, smem);
  grid.sync();
  run_phase(p, PH_HYB, 0, bid, nblk, smem);
  for (int layer = 0; layer < 4; ++layer) {
    const int kind = layer % 3;
    run_phase(p, PH_LNMOD, layer, bid, nblk, smem);
    grid.sync();
    run_phase(p, PH_INPROJ, layer, bid, nblk, smem);
    grid.sync();
    run_phase(p, PH_MIX1, layer, bid, nblk, smem);
    grid.sync();
    run_phase(p, PH_MIX2, layer, bid, nblk, smem);
    grid.sync();
    if (kind != 1) {
      run_phase(p, PH_MIX3, layer, bid, nblk, smem);
      grid.sync();
    }
    if (kind == 2) {
      run_phase(p, PH_MIX4, layer, bid, nblk, smem);
      grid.sync();
      run_phase(p, PH_MIX5, layer, bid, nblk, smem);
      grid.sync();
      run_phase(p, PH_MIX6, layer, bid, nblk, smem);
      grid.sync();
    }
    run_phase(p, PH_OUTPROJ, layer, bid, nblk, smem);
    grid.sync();
  }
  run_phase(p, PH_LNMOD, 4, bid, nblk, smem);
}

static inline size_t align_up(size_t x) { return (x + 255) & ~(size_t)255; }

extern "C" void kernel_launch(void* const* d_in, const int* in_sizes, int n_in, void* d_out, int out_size, void* d_ws, size_t ws_size,
                              hipStream_t stream) {
  Params p{};
  const float** fp = (const float**)&p;
  for (int i = 0; i < 36; ++i) fp[i] = (const float*)d_in[i];
  float* out = (float*)d_out;
  p.xres = out;
  p.out_ssd = out + (size_t)T_ALL * 1024;
  p.out_lru = p.out_ssd + (size_t)32 * 2 * 2 * 32 * 64 * 128;
  unsigned char* w = (unsigned char*)d_ws;
  size_t off = 0;
  auto carve = [&](size_t bytes) { unsigned char* r = w + off; off = align_up(off + bytes); return r; };
  p.wt_ssd_in = (bf16_t*)carve((size_t)2 * 6272 * 1024 * 2);
  p.wt_ssd_out = (bf16_t*)carve((size_t)2 * 1024 * 2048 * 2);
  p.wt_hy_in = (bf16_t*)carve((size_t)4096 * 1024 * 2);
  p.wt_hy_out = (bf16_t*)carve((size_t)1024 * 1024 * 2);
  p.wt_lru_in = (bf16_t*)carve((size_t)2048 * 1024 * 2);
  p.wt_lru_out = (bf16_t*)carve((size_t)1024 * 1024 * 2);
  p.wt_lru_gate = (bf16_t*)carve((size_t)4 * 1024 * 256 * 2);
  p.modv = (float*)carve((size_t)4 * 5 * 3072 * 4);
  p.hdn2 = (float*)carve((size_t)4352 * 64 * 4);
  p.rtab0 = (bf16_t*)carve((size_t)2 * 1024 * 512 * 2);
  p.rtab1 = (bf16_t*)carve((size_t)2 * 1024 * 8192 * 2);
  p.knorm = (float*)carve((size_t)4 * 1024 * 4);
  p.hbuf = (bf16_t*)carve((size_t)T_ALL * 1024 * 2);
  p.rstd = (float*)carve((size_t)T_ALL * 4);
  p.lru_agg = (float*)carve((size_t)2 * 192 * 1024 * 2 * 4);
  p.lru_hin = (float*)carve((size_t)2 * 192 * 1024 * 4);
  p.scratch = carve(SC_TOTAL);
  if (off > ws_size) return;

  static int grid_blocks = 0;
  if (!grid_blocks) {
    int dev = 0, cus = 0, per_cu = 0;
    hipGetDevice(&dev);
    hipDeviceGetAttribute(&cus, hipDeviceAttributeMultiprocessorCount, dev);
    hipOccupancyMaxActiveBlocksPerMultiprocessor(&per_cu, k_mega, NTHR, 0);
    if (per_cu > 2) per_cu = 2;
    grid_blocks = cus * per_cu;
  }
  void* args[] = {&p};
  hipError_t e = hipLaunchCooperativeKernel((void*)k_mega, dim3(grid_blocks), dim3(NTHR), args, 0, stream);
  if (e != hipSuccess) fprintf(stderr, "cooperative launch failed: %s (grid %d)\n", hipGetErrorString(e), grid_blocks);
}
```

```cpp
#include <hip/hip_runtime.h>
#include <hip/hip_bf16.h>
#include <hip/hip_cooperative_groups.h>
#include <stdint.h>
#include <cstdio>
namespace cg = cooperative_groups;

typedef unsigned short bf16_t;
typedef __attribute__((ext_vector_type(8))) short bf16x8;
typedef __attribute__((ext_vector_type(16))) float f32x16;
typedef __attribute__((ext_vector_type(4))) unsigned int u32x4;
typedef __attribute__((ext_vector_type(2))) unsigned int u32x2;
typedef __attribute__((ext_vector_type(4))) float f32x4;

#define T_CTX 8192
#define T_ALL 24576
#define DM 1024
#define NTHR 256
#define SMEM_BYTES 69632
#define ALPHA_RES 1.6817928305074290f
#define LN_EPS 1e-5f

__device__ __forceinline__ bf16_t f2bf(float f) {
  unsigned u = __float_as_uint(f);
  u += 0x7fffu + ((u >> 16) & 1u);
  return (bf16_t)(u >> 16);
}
__device__ __forceinline__ float bf2f(bf16_t b) { return __uint_as_float(((unsigned)b) << 16); }
__device__ __forceinline__ float bflo(unsigned w) { return __uint_as_float(w << 16); }
__device__ __forceinline__ float bfhi(unsigned w) { return __uint_as_float(w & 0xffff0000u); }
__device__ __forceinline__ unsigned pack2(float a, float b) { return (unsigned)f2bf(a) | ((unsigned)f2bf(b) << 16); }
__device__ __forceinline__ float siluf(float x) { return x / (1.f + __expf(-x)); }
__device__ __forceinline__ float sigmoidf(float x) { return 1.f / (1.f + __expf(-x)); }
__device__ __forceinline__ float softplusf(float x) { return x > 20.f ? x : log1pf(expf(x)); }


#define XB_TMO      128
#define XB_XCNT(j)  (256  + 64 * (j))
#define XB_XSUB(j)  (1280 + 64 * (j))
#define XB_XGEN(j)  (2304 + 64 * (j))
#define XB_TOP      3328
#define XB_TOPGEN   3392
#define XCD_BAR_WORDS 3456
#define XB_SPIN_CAP (1u << 18)
#define LAS __attribute__((address_space(3)))
__device__ __forceinline__ unsigned xb_ld(unsigned* p)              { return __hip_atomic_load(p, __ATOMIC_RELAXED, __HIP_MEMORY_SCOPE_AGENT); }
__device__ __forceinline__ unsigned xb_add(unsigned* p, unsigned v) { return __hip_atomic_fetch_add(p, v, __ATOMIC_RELAXED, __HIP_MEMORY_SCOPE_AGENT); }
__device__ __forceinline__ unsigned xb_xcc_id() { return (unsigned)__builtin_amdgcn_s_getreg((3 << 11) | 20) & 0xFu; }
#define XB_SPIN(cond, bar) do { unsigned _sp = 0; while (cond) { __builtin_amdgcn_s_sleep(1); \
    if ((++_sp & 255u) == 0u) { if (xb_ld(&(bar)[XB_TMO])) break; if (_sp > XB_SPIN_CAP) { atomicAdd(&(bar)[XB_TMO], 1u); break; } } } } while (0)
struct XcdBarrier { unsigned* bar; unsigned x; volatile LAS unsigned* st; };
__device__ __forceinline__ XcdBarrier xcd_barrier_post(unsigned* bar, volatile LAS unsigned* st) {
  XcdBarrier b; b.bar = bar; b.x = xb_xcc_id(); b.st = st;
  if (threadIdx.x == 0) (void)xb_add(&bar[XB_XCNT(b.x)], 1u);
  return b;
}
__device__ __forceinline__ void xcd_barrier_complete(unsigned* bar, unsigned x, unsigned& nloc, unsigned& nx) {
  const unsigned G = gridDim.x * gridDim.y * gridDim.z;
  unsigned sum, cnt, mine, sp = 0u;
  for (;;) {
    sum = 0u; cnt = 0u; mine = 0u;
#pragma unroll
    for (unsigned j = 0; j < 16; ++j) { const unsigned c = xb_ld(&bar[XB_XCNT(j)]); sum += c; cnt += (c > 0u) ? 1u : 0u; mine = (j == x) ? c : mine; }
    if (sum == G) break;
    __builtin_amdgcn_s_sleep(1);
    if ((++sp & 255u) == 0u) { if (xb_ld(&bar[XB_TMO])) break; if (sp > XB_SPIN_CAP) { atomicAdd(&bar[XB_TMO], 1u); break; } }
  }
  nloc = mine > 0u ? mine : 1u; nx = cnt > 0u ? cnt : 1u;
}
__device__ __forceinline__ void xcd_barrier(const XcdBarrier& b) {
  asm volatile("s_waitcnt vmcnt(0)" ::: "memory");
  __syncthreads();
  if (threadIdx.x == 0) {
    unsigned* bar = b.bar;
    __builtin_amdgcn_s_waitcnt(0);
    unsigned nloc = b.st[0], nx = b.st[1];
    if (nloc == 0u) { xcd_barrier_complete(bar, b.x, nloc, nx); b.st[0] = nloc; b.st[1] = nx; }
    const unsigned old = xb_add(&bar[XB_XSUB(b.x)], 1u);
    const unsigned gen = old / nloc;
    if (old + 1u == (gen + 1u) * nloc) {
      __builtin_amdgcn_fence(__ATOMIC_RELEASE, "agent");
      asm volatile("s_waitcnt vmcnt(0)" ::: "memory");
      const unsigned og = xb_add(&bar[XB_TOP], 1u);
      const unsigned tg = og / nx;
      if (og + 1u == (tg + 1u) * nx) xb_add(&bar[XB_TOPGEN], 1u);
      else XB_SPIN(xb_ld(&bar[XB_TOPGEN]) == tg, bar);
      __builtin_amdgcn_fence(__ATOMIC_ACQUIRE, "agent");
      xb_add(&bar[XB_XGEN(b.x)], 1u);
      asm volatile("s_waitcnt vmcnt(0)" ::: "memory");
    } else {
      XB_SPIN(xb_ld(&bar[XB_XGEN(b.x)]) == gen, bar);
      __builtin_amdgcn_fence(__ATOMIC_ACQUIRE, "agent");
      asm volatile("s_waitcnt vmcnt(0)" ::: "memory");
    }
  }
  __syncthreads();
}

__device__ __forceinline__ int opaque_tid() { int t = threadIdx.x; asm volatile("" : "+v"(t)); return t; }
__device__ __forceinline__ int opaque_s(int x) { asm volatile("" : "+s"(x)); return x; }

struct TokInfo { int s, l, L, base, mrow; };
__device__ __forceinline__ TokInfo tokinfo(int tok) {
  TokInfo t;
  if (tok < T_CTX) { t.s = tok >> 8; t.l = tok & 255; t.L = 256; t.base = tok & ~255; t.mrow = 0; }
  else { int u = tok - T_CTX; t.s = 32 + (u >> 12); t.l = u & 4095; t.L = 4096; t.base = T_CTX + (u & ~4095); t.mrow = 1 + (u >> 12); }
  return t;
}
__device__ __forceinline__ int seqpos2off(int pos, bool cm) { return cm ? (((pos & 63) << 6) | (pos >> 6)) : pos; }

struct Params {
  const float *x_prompt, *x_sample, *state_ssd, *state_lru, *c, *c_ctx, *mod_w, *mod_b, *ln_g, *ln_b;
  const float *ssd_in_w, *ssd_conv_w, *ssd_conv_b, *ssd_dt_bias, *ssd_a_log, *ssd_d, *ssd_norm_g, *ssd_out_w;
  const float *hy_in_w, *hy_conv_w, *hy_conv_b, *hy_f_w1, *hy_f_b1, *hy_f_w2, *hy_f_b2, *hy_f_w3, *hy_f_freq, *hy_f_bias, *hy_out_w;
  const float *lru_in_w, *lru_conv_w, *lru_conv_b, *lru_gate_w, *lru_gate_b, *lru_a_param, *lru_out_w;
  float *xres, *out_ssd, *out_lru;
  bf16_t *wt_ssd_in, *wt_ssd_out, *wt_hy_in, *wt_hy_out, *wt_lru_in, *wt_lru_out, *wt_lru_gate;
  float *modv;
  float *hdn2;
  bf16_t *rtab0;
  bf16_t *rtab1;
  float *knorm;
  bf16_t *hbuf;
  float *rstd;
  float *lru_agg;
  float *lru_hin;
  unsigned char *scratch;
  unsigned *bar;
};

#define SC_SSD_Z     ((size_t)0)
#define SC_SSD_XBC   ((size_t)T_ALL * 2048 * 2)
#define SC_SSD_XBCC  (SC_SSD_XBC + (size_t)T_ALL * 4096 * 2)
#define SC_SSD_DT    (SC_SSD_XBCC + (size_t)T_ALL * 4096 * 2)
#define SC_SSD_XT    (SC_SSD_DT + (size_t)T_ALL * 64 * 4)
#define SC_SSD_BT    (SC_SSD_XT + (size_t)T_ALL * 2048 * 2)
#define SC_SSD_END   (SC_SSD_BT + (size_t)T_ALL * 1024 * 2)
#define SC_HY_PROJT  ((size_t)0)
#define SC_HY_YT     ((size_t)T_ALL * 4096 * 2)
#define SC_HY_YG     (SC_HY_YT + (size_t)T_ALL * 1024 * 2)
#define SC_LRU_PROJ  ((size_t)0)
#define SC_LRU_XC    ((size_t)T_ALL * 2048 * 2)
#define SC_LRU_GATES (SC_LRU_XC + (size_t)T_ALL * 1024 * 2)
#define SC_LRU_Y     (SC_LRU_GATES + (size_t)T_ALL * 4096 * 2)
#define SC_LRU_YG    (SC_LRU_Y + (size_t)T_ALL * 2048 * 2)
#define SC_TOTAL     SC_SSD_END

__device__ __forceinline__ void transpose_tile(const float* __restrict__ src, int ld_src, int n_src, bf16_t* __restrict__ dst, int K,
                               const float* __restrict__ scale, int tile, int tiles_k, float* tl) {
  const int tidx = opaque_tid();
  int tk = tile % tiles_k, tn = tile / tiles_k;
  int k0 = tk * 64, n0 = tn * 64;
  int tx = tidx & 63, ty = tidx >> 6;
  __syncthreads();
  for (int r = ty; r < 64; r += 4) {
    int n = n0 + tx;
    float v = 0.f;
    if (n < n_src) { v = src[(size_t)(k0 + r) * ld_src + n]; if (scale) v *= scale[k0 + r]; }
    tl[r * 65 + tx] = v;
  }
  __syncthreads();
  for (int r = ty; r < 64; r += 4) dst[(size_t)(n0 + r) * K + k0 + tx] = f2bf(tl[tx * 65 + r]);
}

__device__ __forceinline__ void phase_prep(const Params& p, int bid, int nblk, unsigned char* smem) {
  const int tidx = opaque_tid();
  float* tl = (float*)smem;
  for (int job = 0; job < 24; ++job) {
    const float* src; int ld, nsrc, K, npad; bf16_t* dst; const float* scale = nullptr;
    if (job < 2) { src = p.ssd_in_w + (size_t)job * 1024 * 6208; ld = 6208; nsrc = 6208; K = 1024; npad = 6272; dst = p.wt_ssd_in + (size_t)job * 6272 * 1024; }
    else if (job < 4) { int s = job - 2; src = p.ssd_out_w + (size_t)s * 2048 * 1024; ld = 1024; nsrc = 1024; K = 2048; npad = 1024; dst = p.wt_ssd_out + (size_t)s * 1024 * 2048; scale = p.ssd_norm_g + s * 2048; }
    else if (job == 4) { src = p.hy_in_w; ld = 4096; nsrc = 4096; K = 1024; npad = 4096; dst = p.wt_hy_in; }
    else if (job == 5) { src = p.hy_out_w; ld = 1024; nsrc = 1024; K = 1024; npad = 1024; dst = p.wt_hy_out; }
    else if (job == 6) { src = p.lru_in_w; ld = 2048; nsrc = 2048; K = 1024; npad = 2048; dst = p.wt_lru_in; }
    else if (job == 7) { src = p.lru_out_w; ld = 1024; nsrc = 1024; K = 1024; npad = 1024; dst = p.wt_lru_out; }
    else { int q = job - 8; int dg = q >> 2, n = q & 3;
      src = p.lru_gate_w + (size_t)(dg * 4 + n) * 65536; ld = 256; nsrc = 256; K = 256; npad = 256;
      dst = p.wt_lru_gate + (size_t)n * 1024 * 256 + (size_t)dg * 256 * 256; }
    int tiles_k = K / 64, tiles = tiles_k * (npad / 64);
    for (int t = bid; t < tiles; t += nblk) transpose_tile(src, ld, nsrc, dst, K, scale, t, tiles_k, tl);
  }
  for (int i = bid * NTHR + tidx; i < 2 * 2 * 1024; i += nblk * NTHR) p.knorm[i] = 0.f;
}

__device__ __forceinline__ void phase_mod(const Params& p, int bid, int nblk, unsigned char* smem) {
  const int tidx = opaque_tid();
  float* sc = (float*)smem;
  float* red = sc + 5 * 1024;
  __syncthreads();
  for (int i = tidx; i < 5 * 1024; i += NTHR) {
    int r = i >> 10, k = i & 1023;
    float v = (r == 0) ? p.c_ctx[k] : p.c[(r - 1) * 1024 + k];
    sc[i] = siluf(v);
  }
  __syncthreads();
  const int cj = tidx & 31, kg = tidx >> 5;
  for (int item = bid; item < 4 * 96; item += nblk) {
    const int layer = item / 96, j = (item % 96) * 32 + cj;
    const float* w = p.mod_w + (size_t)layer * 1024 * 3072 + (size_t)kg * 128 * 3072 + j;
    const float* s0 = sc + kg * 128;
    float a0 = 0, a1 = 0, a2 = 0, a3 = 0, a4 = 0;
#pragma unroll 8
    for (int k = 0; k < 128; ++k) {
      float wv = w[(size_t)k * 3072];
      a0 += s0[k] * wv; a1 += s0[1024 + k] * wv; a2 += s0[2048 + k] * wv; a3 += s0[3072 + k] * wv; a4 += s0[4096 + k] * wv;
    }
    __syncthreads();
    red[(kg * 5 + 0) * 32 + cj] = a0; red[(kg * 5 + 1) * 32 + cj] = a1; red[(kg * 5 + 2) * 32 + cj] = a2;
    red[(kg * 5 + 3) * 32 + cj] = a3; red[(kg * 5 + 4) * 32 + cj] = a4;
    __syncthreads();
    if (tidx < 160) {
      const int rr = tidx >> 5, cc = tidx & 31;
      float sum = 0.f;
#pragma unroll
      for (int g8 = 0; g8 < 8; ++g8) sum += red[(g8 * 5 + rr) * 32 + cc];
      const int jj = (item % 96) * 32 + cc;
      p.modv[((size_t)layer * 5 + rr) * 3072 + jj] = sum + p.mod_b[layer * 3072 + jj];
    }
  }
}

__device__ __forceinline__ void phase_hyfilt_a(const Params& p, int bid, int nblk, unsigned char* smem) {
  const int tidx = opaque_tid();
  float* sz = (float*)smem;
  float* sh = sz + 4 * 36;
  int pl = tidx >> 6, m = tidx & 63;
  for (int item = bid; item < 4352 / 4; item += nblk) {
    int pos = item * 4 + pl;
    int L = pos < 256 ? 256 : 4096;
    int l = pos < 256 ? pos : pos - 256;
    __syncthreads();
    if (m < 33) {
      float t = (float)l / (float)L;
      float w = (6.283185307179586f * (float)l) / (float)L;
      float v;
      if (m == 0) v = t;
      else {
        int j = (m - 1) & 15;
        float fr = 1e-4f + (float)j * ((15.f - 1e-4f) / 15.f);
        float ang = w * fr;
        v = (m <= 16) ? __cosf(ang) : __sinf(ang);
      }
      sz[pl * 36 + m] = v;
    }
    __syncthreads();
    float a = p.hy_f_b1[m];
    for (int e = 0; e < 33; ++e) a += sz[pl * 36 + e] * p.hy_f_w1[e * 64 + m];
    a = __sinf(p.hy_f_freq[m] * a);
    sh[pl * 64 + m] = a;
    __syncthreads();
    float b = p.hy_f_b2[m];
    for (int e = 0; e < 64; ++e) b += sh[pl * 64 + e] * p.hy_f_w2[e * 64 + m];
    b = __sinf(p.hy_f_freq[64 + m] * b);
    p.hdn2[(size_t)pos * 64 + m] = b;
  }
}

__device__ __forceinline__ void phase_hyfilt_b(const Params& p, int bid, int nblk, unsigned char* smem) {
  const int tidx = opaque_tid();
  const int lane = tidx & 63;
  for (int item = bid; item < 17 * 64; item += nblk) {
    const int lb = item >> 6, chunk = item & 63;
    const int Lsel = lb ? 1 : 0, L = Lsel ? 4096 : 256, RL = Lsel ? 8192 : 512, Lm1 = L - 1;
    const int l = Lsel ? (lb - 1) * 256 + tidx : tidx;
    const int pos = Lsel ? 256 + l : l;
    float hd[64];
#pragma unroll
    for (int m4 = 0; m4 < 16; ++m4) {
      f32x4 v = *(const f32x4*)(p.hdn2 + (size_t)pos * 64 + m4 * 4);
      hd[m4 * 4] = v.x; hd[m4 * 4 + 1] = v.y; hd[m4 * 4 + 2] = v.z; hd[m4 * 4 + 3] = v.w;
    }
    const int odc0 = chunk * 64, o = odc0 >> 11, d = (odc0 >> 10) & 1, c0 = odc0 & 1023;
    const float t = (float)l / (float)L;
    bf16_t* rt = Lsel ? p.rtab1 : p.rtab0;
    const float min_decay = -3.0701134573253945f, max_decay = -15.350567286626973f;
    for (int cc = 0; cc < 64; ++cc) {
      const int c = c0 + cc;
      const float* w3 = p.hy_f_w3 + odc0 + cc;
      float acc = 0.f;
#pragma unroll
      for (int m = 0; m < 64; ++m) acc += hd[m] * w3[(size_t)m * 4096];
      float delta = fabsf(min_decay + (float)c * ((max_decay - min_decay) / 1023.f));
      float kv = acc * expf(-t * delta);
      size_t rb = (size_t)(o * 1024 + c) * RL;
      if (d == 0) rt[rb + Lm1 - l] = f2bf(kv);
      else if (l > 0) rt[rb + Lm1 + l] = f2bf(kv);
      else rt[rb + RL - 1] = 0;
      float a = fabsf(kv);
#pragma unroll
      for (int off = 32; off > 0; off >>= 1) a += __shfl_xor(a, off);
      if (lane == 0) atomicAdd(&p.knorm[(Lsel * 2 + o) * 1024 + c], a);
    }
  }
}

__device__ __forceinline__ void phase_lnmod(const Params& p, int layer, int bid, int nblk) {
  const int tidx = opaque_tid();
  int lane = tidx & 63, wv = tidx >> 6;
  for (int row = bid * 4 + wv; row < T_ALL; row += nblk * 4) {
    const float* src = (layer == 0) ? (row < T_CTX ? p.x_prompt + (size_t)row * DM : p.x_sample + (size_t)(row - T_CTX) * DM)
                                    : p.xres + (size_t)row * DM;
    f32x4 v[4];
#pragma unroll
    for (int j = 0; j < 4; ++j) v[j] = *(const f32x4*)(src + j * 256 + lane * 4);
    if (layer > 0) {
      float s = 0.f;
#pragma unroll
      for (int j = 0; j < 4; ++j) s += v[j].x + v[j].y + v[j].z + v[j].w;
#pragma unroll
      for (int o = 32; o > 0; o >>= 1) s += __shfl_xor(s, o);
      float mu = s * (1.f / 1024.f);
      float q = 0.f;
#pragma unroll
      for (int j = 0; j < 4; ++j) { float a = v[j].x - mu, b = v[j].y - mu, c = v[j].z - mu, d = v[j].w - mu; q += a * a + b * b + c * c + d * d; }
#pragma unroll
      for (int o = 32; o > 0; o >>= 1) q += __shfl_xor(q, o);
      float rs = rsqrtf(q * (1.f / 1024.f) + LN_EPS);
      const float* g = p.ln_g + (layer - 1) * DM; const float* b = p.ln_b + (layer - 1) * DM;
#pragma unroll
      for (int j = 0; j < 4; ++j) {
        f32x4 gg = *(const f32x4*)(g + j * 256 + lane * 4), bb = *(const f32x4*)(b + j * 256 + lane * 4);
        v[j].x = (v[j].x - mu) * rs * gg.x + bb.x; v[j].y = (v[j].y - mu) * rs * gg.y + bb.y;
        v[j].z = (v[j].z - mu) * rs * gg.z + bb.z; v[j].w = (v[j].w - mu) * rs * gg.w + bb.w;
      }
    }
    float* dst = p.xres + (size_t)row * DM;
#pragma unroll
    for (int j = 0; j < 4; ++j) *(f32x4*)(dst + j * 256 + lane * 4) = v[j];
    if (layer < 4) {
      int mrow = row < T_CTX ? 0 : 1 + ((row - T_CTX) >> 12);
      const float* mv = p.modv + ((size_t)layer * 5 + mrow) * 3072;
#pragma unroll
      for (int j = 0; j < 4; ++j) {
        f32x4 sh = *(const f32x4*)(mv + j * 256 + lane * 4), sc = *(const f32x4*)(mv + 1024 + j * 256 + lane * 4);
        u32x2 o;
        o.x = pack2(v[j].x * (1.f + sc.x) + sh.x, v[j].y * (1.f + sc.y) + sh.y);
        o.y = pack2(v[j].z * (1.f + sc.z) + sh.z, v[j].w * (1.f + sc.w) + sh.w);
        *(u32x2*)(p.hbuf + (size_t)row * DM + j * 256 + lane * 4) = o;
      }
    }
  }
}

#define G_LDS_STRIDE 72
template <class Epi>
__device__ __forceinline__ void gemm_phase(const bf16_t* __restrict__ A, int lda, const bf16_t* __restrict__ Wt, int K, int Mtiles, int Ntiles,
                           Epi epi, int bid, int nblk, unsigned char* smem) {
  const int tidx = opaque_tid();
  bf16_t* sA = (bf16_t*)smem;
  bf16_t* sB = sA + 128 * G_LDS_STRIDE;
  const int tid = tidx, lane = tid & 63, w = tid >> 6;
  const int wm = w >> 1, wn = w & 1, r = lane & 31, hh = lane >> 5;
  const int nk = K / 64;
  for (int tile = bid; tile < Mtiles * Ntiles; tile += nblk) {
    const int tm = tile / Ntiles, tn = tile % Ntiles;
    const int m0 = tm * 128, n0 = tn * 128;
    f32x16 acc[2][2];
#pragma unroll
    for (int i = 0; i < 2; ++i)
#pragma unroll
      for (int j = 0; j < 2; ++j)
#pragma unroll
        for (int e = 0; e < 16; ++e) acc[i][j][e] = 0.f;
    u32x4 ra[4], rb[4];
#pragma unroll
    for (int i = 0; i < 4; ++i) {
      int q = tid + i * 256, row = q >> 3, c8 = (q & 7) * 8;
      ra[i] = *(const u32x4*)(A + (size_t)(m0 + row) * lda + c8);
      rb[i] = *(const u32x4*)(Wt + (size_t)(n0 + row) * K + c8);
    }
    for (int kt = 0; kt < nk; ++kt) {
      __syncthreads();
#pragma unroll
      for (int i = 0; i < 4; ++i) {
        int q = tid + i * 256, row = q >> 3, c8 = (q & 7) * 8;
        *(u32x4*)(sA + row * G_LDS_STRIDE + c8) = ra[i];
        *(u32x4*)(sB + row * G_LDS_STRIDE + c8) = rb[i];
      }
      __syncthreads();
      if (kt + 1 < nk) {
#pragma unroll
        for (int i = 0; i < 4; ++i) {
          int q = tid + i * 256, row = q >> 3, c8 = (q & 7) * 8;
          ra[i] = *(const u32x4*)(A + (size_t)(m0 + row) * lda + (kt + 1) * 64 + c8);
          rb[i] = *(const u32x4*)(Wt + (size_t)(n0 + row) * K + (kt + 1) * 64 + c8);
        }
      }
#pragma unroll
      for (int kk = 0; kk < 4; ++kk) {
        bf16x8 fa[2], fb[2];
#pragma unroll
        for (int i = 0; i < 2; ++i) fa[i] = *(const bf16x8*)(sA + (wm * 64 + i * 32 + r) * G_LDS_STRIDE + kk * 16 + hh * 8);
#pragma unroll
        for (int j = 0; j < 2; ++j) fb[j] = *(const bf16x8*)(sB + (wn * 64 + j * 32 + r) * G_LDS_STRIDE + kk * 16 + hh * 8);
#pragma unroll
        for (int i = 0; i < 2; ++i)
#pragma unroll
          for (int j = 0; j < 2; ++j) acc[i][j] = __builtin_amdgcn_mfma_f32_32x32x16_bf16(fa[i], fb[j], acc[i][j], 0, 0, 0);
      }
    }
#pragma unroll
    for (int i = 0; i < 2; ++i)
#pragma unroll
      for (int j = 0; j < 2; ++j)
#pragma unroll
        for (int qd = 0; qd < 4; ++qd) {
          int row0 = m0 + wm * 64 + i * 32 + 8 * qd + 4 * hh;
          int col = n0 + wn * 64 + j * 32 + r;
          epi.quad(row0, col, acc[i][j][4 * qd], acc[i][j][4 * qd + 1], acc[i][j][4 * qd + 2], acc[i][j][4 * qd + 3]);
        }
  }
}

struct EpiBf16 {
  bf16_t* C; int ldc;
  __device__ __forceinline__ void operator()(int row, int col, float v) const { C[(size_t)row * ldc + col] = f2bf(v); }
  __device__ __forceinline__ void quad(int row0, int col, float v0, float v1, float v2, float v3) const {
    (*this)(row0, col, v0); (*this)(row0 + 1, col, v1); (*this)(row0 + 2, col, v2); (*this)(row0 + 3, col, v3);
  }
};
struct EpiT {
  bf16_t* Ct; size_t ldt;
  __device__ __forceinline__ void quad(int row0, int col, float v0, float v1, float v2, float v3) const {
    u32x2 o; o.x = pack2(v0, v1); o.y = pack2(v2, v3);
    *(u32x2*)(Ct + (size_t)col * ldt + row0) = o;
  }
};
struct EpiSsdIn {
  bf16_t* z; bf16_t* xbc; float* dt; const float* dt_bias;
  __device__ __forceinline__ void operator()(int row, int col, float v) const {
    if (col < 2048) z[(size_t)row * 2048 + col] = f2bf(v);
    else if (col < 6144) xbc[(size_t)row * 4096 + (col - 2048)] = f2bf(v);
    else if (col < 6208) dt[(size_t)row * 64 + (col - 6144)] = softplusf(v + dt_bias[col - 6144]);
  }
  __device__ __forceinline__ void quad(int row0, int col, float v0, float v1, float v2, float v3) const {
    (*this)(row0, col, v0); (*this)(row0 + 1, col, v1); (*this)(row0 + 2, col, v2); (*this)(row0 + 3, col, v3);
  }
};
struct EpiOut {
  float* xres; const float* modv_layer; const float* rstd;
  __device__ __forceinline__ void operator()(int row, int col, float v) const {
    int mrow = row < T_CTX ? 0 : 1 + ((row - T_CTX) >> 12);
    float g = modv_layer[(size_t)mrow * 3072 + 2048 + col];
    float rs = rstd ? rstd[row] : 1.f;
    size_t idx = (size_t)row * DM + col;
    xres[idx] = ALPHA_RES * xres[idx] + g * (v * rs);
  }
  __device__ __forceinline__ void quad(int row0, int col, float v0, float v1, float v2, float v3) const {
    (*this)(row0, col, v0); (*this)(row0 + 1, col, v1); (*this)(row0 + 2, col, v2); (*this)(row0 + 3, col, v3);
  }
};
struct EpiLruGate {
  bf16_t* gates; const float* gate_b; int nb;
  __device__ __forceinline__ void operator()(int row, int col, float v) const {
    int dg = col >> 8, ch = nb * 256 + (col & 255);
    float pre = v + gate_b[dg * 1024 + ch];
    gates[((size_t)dg * T_ALL + row) * 1024 + ch] = f2bf(sigmoidf(pre));
  }
  __device__ __forceinline__ void quad(int row0, int col, float v0, float v1, float v2, float v3) const {
    (*this)(row0, col, v0); (*this)(row0 + 1, col, v1); (*this)(row0 + 2, col, v2); (*this)(row0 + 3, col, v3);
  }
};

template <int KW, bool SILU>
__device__ __forceinline__ void phase_dwconv(const bf16_t* __restrict__ src, int ld_src, bf16_t* __restrict__ dst, int ld_dst, int CH,
                             const float* __restrict__ w, const float* __restrict__ b, bool colmajor, int bid, int nblk) {
  const int tidx = opaque_tid();
  const int cpr = CH / 8;
  const size_t total = (size_t)T_ALL * cpr;
  for (size_t idx = (size_t)bid * NTHR + tidx; idx < total; idx += (size_t)nblk * NTHR) {
    int tok = (int)(idx / cpr), c0 = (int)(idx % cpr) * 8;
    TokInfo ti = tokinfo(tok);
    bool cm = colmajor && ti.s >= 32;
    int pos = seqpos2off(ti.l, cm);
    float acc[8];
#pragma unroll
    for (int e = 0; e < 8; ++e) acc[e] = b[c0 + e];
#pragma unroll
    for (int k = 0; k < KW; ++k) {
      int pp = pos + k - 1;
      if (pp < 0 || pp >= ti.L) continue;
      int tk = ti.base + seqpos2off(pp, cm);
      u32x4 xv = *(const u32x4*)(src + (size_t)tk * ld_src + c0);
      const float* wk = w + (size_t)k * CH + c0;
      acc[0] += wk[0] * bflo(xv.x); acc[1] += wk[1] * bfhi(xv.x);
      acc[2] += wk[2] * bflo(xv.y); acc[3] += wk[3] * bfhi(xv.y);
      acc[4] += wk[4] * bflo(xv.z); acc[5] += wk[5] * bfhi(xv.z);
      acc[6] += wk[6] * bflo(xv.w); acc[7] += wk[7] * bfhi(xv.w);
    }
    if (SILU) {
#pragma unroll
      for (int e = 0; e < 8; ++e) acc[e] = siluf(acc[e]);
    }
    u32x4 o;
    o.x = pack2(acc[0], acc[1]); o.y = pack2(acc[2], acc[3]); o.z = pack2(acc[4], acc[5]); o.w = pack2(acc[6], acc[7]);
    *(u32x4*)(dst + (size_t)tok * ld_dst + c0) = o;
  }
}

__device__ __forceinline__ void phase_ssd_conv(const Params& p, int slot, bool colmajor, int bid, int nblk, unsigned char* smem) {
  const int tid = opaque_tid();
  const bf16_t* raw = (const bf16_t*)(p.scratch + SC_SSD_XBC);
  bf16_t* out = (bf16_t*)(p.scratch + SC_SSD_XBCC);
  bf16_t* XT = (bf16_t*)(p.scratch + SC_SSD_XT);
  bf16_t* BT = (bf16_t*)(p.scratch + SC_SSD_BT);
  const float* cw = p.ssd_conv_w + (size_t)slot * 4 * 4096;
  const float* cb = p.ssd_conv_b + slot * 4096;
  bf16_t* tl = (bf16_t*)smem;
  for (int item = bid; item < 384 * 64; item += nblk) {
    const int ptile = item >> 6, ct = item & 63;
    const int ptok0 = ptile * 64;
    TokInfo ti = tokinfo(ptok0);
    const bool cm = colmajor && ti.s >= 32;
    const int rr = tid >> 2, cpart = tid & 3;
    const int ch = ct * 64 + cpart * 16;
    const int pos = ti.l + rr;
    float acc[16];
#pragma unroll
    for (int e = 0; e < 16; ++e) acc[e] = cb[ch + e];
#pragma unroll
    for (int k = 0; k < 4; ++k) {
      int pp = pos + k - 1;
      if (pp < 0 || pp >= ti.L) continue;
      int tk = ti.base + seqpos2off(pp, cm);
      const bf16_t* rp = raw + (size_t)tk * 4096 + ch;
      u32x4 x0 = *(const u32x4*)rp, x1 = *(const u32x4*)(rp + 8);
      const float* wk = cw + (size_t)k * 4096 + ch;
      unsigned xw[8] = {x0.x, x0.y, x0.z, x0.w, x1.x, x1.y, x1.z, x1.w};
#pragma unroll
      for (int e = 0; e < 8; ++e) { acc[2 * e] += wk[2 * e] * bflo(xw[e]); acc[2 * e + 1] += wk[2 * e + 1] * bfhi(xw[e]); }
    }
    u32x4 o0, o1;
    o0.x = pack2(siluf(acc[0]), siluf(acc[1])); o0.y = pack2(siluf(acc[2]), siluf(acc[3]));
    o0.z = pack2(siluf(acc[4]), siluf(acc[5])); o0.w = pack2(siluf(acc[6]), siluf(acc[7]));
    o1.x = pack2(siluf(acc[8]), siluf(acc[9])); o1.y = pack2(siluf(acc[10]), siluf(acc[11]));
    o1.z = pack2(siluf(acc[12]), siluf(acc[13])); o1.w = pack2(siluf(acc[14]), siluf(acc[15]));
    bf16_t* op = out + (size_t)(ptok0 + rr) * 4096 + ch;
    *(u32x4*)op = o0; *(u32x4*)(op + 8) = o1;
    if (ct < 48) {
      __syncthreads();
      *(u32x4*)(tl + rr * 72 + cpart * 16) = o0;
      *(u32x4*)(tl + rr * 72 + cpart * 16 + 8) = o1;
      __syncthreads();
      const int crow = tid >> 2, part = tid & 3;
      unsigned wv[8];
#pragma unroll
      for (int e = 0; e < 8; ++e) {
        unsigned lo = tl[(part * 16 + 2 * e) * 72 + crow], hi = tl[(part * 16 + 2 * e + 1) * 72 + crow];
        wv[e] = lo | (hi << 16);
      }
      const int chg = ct * 64 + crow;
      bf16_t* dp = (chg < 2048 ? XT + (size_t)chg * T_ALL : BT + (size_t)(chg - 2048) * T_ALL) + ptok0 + part * 16;
      u32x4 t0, t1;
      t0.x = wv[0]; t0.y = wv[1]; t0.z = wv[2]; t0.w = wv[3]; t1.x = wv[4]; t1.y = wv[5]; t1.z = wv[6]; t1.w = wv[7];
      *(u32x4*)dp = t0; *(u32x4*)(dp + 8) = t1;
    }
  }
}

#define SH_STRIDE 136
__device__ __forceinline__ int rowmap(int e, int hh) { return (e & 3) + 8 * (e >> 2) + 4 * hh; }
__device__ __forceinline__ bf16x8 pack8(float a0, float a1, float a2, float a3, float a4, float a5, float a6, float a7) {
  u32x4 v; v.x = pack2(a0, a1); v.y = pack2(a2, a3); v.z = pack2(a4, a5); v.w = pack2(a6, a7);
  return __builtin_bit_cast(bf16x8, v);
}
__device__ __forceinline__ void phase_ssd_scan(const Params& p, int slot, bool colmajor, int bid, int nblk, unsigned char* smem) {
  const int tid = opaque_tid(), lane = tid & 63, w = tid >> 6, r = lane & 31, hh = lane >> 5;
  const int it = w >> 1, pt = w & 1;
  const bf16_t* xbcc = (const bf16_t*)(p.scratch + SC_SSD_XBCC);
  const bf16_t* XT = (const bf16_t*)(p.scratch + SC_SSD_XT);
  const bf16_t* BT = (const bf16_t*)(p.scratch + SC_SSD_BT);
  const float* dtb = (const float*)(p.scratch + SC_SSD_DT);
  bf16_t* ybuf = (bf16_t*)(p.scratch + SC_SSD_XBC);
  bf16_t* sXr = (bf16_t*)smem;
  bf16_t* sXs = sXr + 64 * 72;
  bf16_t* sH = sXs + 64 * 72;
  float* sW = (float*)(sH + 2 * 64 * SH_STRIDE);
  float* myW = sW + w * 256;
  for (int item = bid; item < 36 * 64; item += nblk) {
    int s, h, dir;
    if (item < 256) { s = 32 + (item >> 6); h = (item & 63) >> 1; dir = item & 1; }
    else { int itx = item - 256; s = itx >> 6; h = (itx & 63) >> 1; dir = itx & 1; }
    const int L = s < 32 ? 256 : 4096;
    const int base = s < 32 ? s * 256 : T_CTX + (s - 32) * 4096;
    const bool cm = colmajor && s >= 32;
    const int g = h >> 2;
    const float Aval = -expf(p.ssd_a_log[(slot * 2 + dir) * 32 + h]);
    const int nchunks = L >> 6;
    const int pcol = 32 * pt + r;
    f32x16 hacc[2];
    if (s >= 32) {
      const float* h0 = p.state_ssd + ((((size_t)(s - 32) * 2 + slot) * 2 + dir) * 32 + h) * 8192 + (size_t)pcol * 128;
#pragma unroll
      for (int t2 = 0; t2 < 2; ++t2)
#pragma unroll
        for (int qd = 0; qd < 4; ++qd) {
          f32x4 v = *(const f32x4*)(h0 + 32 * (2 * it + t2) + 8 * qd + 4 * hh);
          hacc[t2][4 * qd] = v.x; hacc[t2][4 * qd + 1] = v.y; hacc[t2][4 * qd + 2] = v.z; hacc[t2][4 * qd + 3] = v.w;
        }
    } else {
#pragma unroll
      for (int t2 = 0; t2 < 2; ++t2)
#pragma unroll
        for (int e = 0; e < 16; ++e) hacc[t2][e] = 0.f;
    }
#pragma unroll
    for (int t2 = 0; t2 < 2; ++t2)
#pragma unroll
      for (int qd = 0; qd < 4; ++qd) {
        u32x2 o; o.x = pack2(hacc[t2][4 * qd], hacc[t2][4 * qd + 1]); o.y = pack2(hacc[t2][4 * qd + 2], hacc[t2][4 * qd + 3]);
        *(u32x2*)(sH + pcol * SH_STRIDE + 32 * (2 * it + t2) + 8 * qd + 4 * hh) = o;
      }
    for (int ci = 0; ci < nchunks; ++ci) {
      const int cpos = dir ? nchunks - 1 - ci : ci;
      const int pos0 = cpos * 64, ptok0 = base + pos0;
      const int buf = ci & 1;
      __syncthreads();
      float decE;
      {
        const int tok = base + seqpos2off(pos0 + lane, cm);
        const float dtv = dtb[(size_t)tok * 64 + dir * 32 + h];
        float c = dtv * Aval;
        if (dir == 0) {
#pragma unroll
          for (int off = 1; off < 64; off <<= 1) { float t = __shfl_up(c, off); if (lane >= off) c += t; }
        } else {
#pragma unroll
          for (int off = 1; off < 64; off <<= 1) { float t = __shfl_down(c, off); if (lane + off < 64) c += t; }
        }
        const float cE = __shfl(c, dir ? 0 : 63);
        myW[lane] = dtv; myW[64 + lane] = c; myW[128 + lane] = __expf(c); myW[192 + lane] = dtv * __expf(cE - c);
        decE = __expf(cE);
      }
#pragma unroll
      for (int i = 0; i < 2; ++i) {
        const int q = tid + i * 256, prow = q >> 3, j8 = (q & 7) * 8;
        u32x4 raw = *(const u32x4*)(XT + (size_t)(h * 64 + prow) * T_ALL + ptok0 + j8);
        *(u32x4*)(sXr + prow * 72 + j8) = raw;
        f32x4 f0 = *(const f32x4*)(myW + 192 + j8), f1 = *(const f32x4*)(myW + 192 + j8 + 4);
        u32x4 sc;
        sc.x = pack2(bflo(raw.x) * f0.x, bfhi(raw.x) * f0.y); sc.y = pack2(bflo(raw.y) * f0.z, bfhi(raw.y) * f0.w);
        sc.z = pack2(bflo(raw.z) * f1.x, bfhi(raw.z) * f1.y); sc.w = pack2(bflo(raw.w) * f1.z, bfhi(raw.w) * f1.w);
        *(u32x4*)(sXs + prow * 72 + j8) = sc;
      }
      __syncthreads();
      bf16x8 cfr[8];
      {
        const bf16_t* crow = xbcc + (size_t)(ptok0 + 32 * it + r) * 4096 + 3072 + g * 128 + 8 * hh;
#pragma unroll
        for (int kk = 0; kk < 8; ++kk) cfr[kk] = *(const bf16x8*)(crow + 16 * kk);
      }
      f32x16 acc;
#pragma unroll
      for (int e = 0; e < 16; ++e) acc[e] = 0.f;
      {
        const bf16_t* hp = sH + buf * 64 * SH_STRIDE + pcol * SH_STRIDE + 8 * hh;
#pragma unroll
        for (int kk = 0; kk < 8; ++kk) acc = __builtin_amdgcn_mfma_f32_32x32x16_bf16(cfr[kk], *(const bf16x8*)(hp + 16 * kk), acc, 0, 0, 0);
      }
#pragma unroll
      for (int qd = 0; qd < 4; ++qd) {
        f32x4 ec = *(const f32x4*)(myW + 128 + 32 * it + 8 * qd + 4 * hh);
        acc[4 * qd] *= ec.x; acc[4 * qd + 1] *= ec.y; acc[4 * qd + 2] *= ec.z; acc[4 * qd + 3] *= ec.w;
      }
      const int icol = 32 * it + r;
      const float ci_ = myW[64 + icol];
#pragma unroll
      for (int jt = 0; jt < 2; ++jt) {
        const bool needed = dir == 0 ? (jt <= it) : (jt >= it);
        if (needed) {
          f32x16 X;
#pragma unroll
          for (int e = 0; e < 16; ++e) X[e] = 0.f;
          const bf16_t* brow = xbcc + (size_t)(ptok0 + 32 * jt + r) * 4096 + 2048 + g * 128 + 8 * hh;
#pragma unroll
          for (int kk = 0; kk < 8; ++kk) X = __builtin_amdgcn_mfma_f32_32x32x16_bf16(*(const bf16x8*)(brow + 16 * kk), cfr[kk], X, 0, 0, 0);
#pragma unroll
          for (int qd = 0; qd < 4; ++qd) {
            const int j0 = 32 * jt + 8 * qd + 4 * hh;
            f32x4 cj = *(const f32x4*)(myW + 64 + j0), dj = *(const f32x4*)(myW + j0);
            float cjv[4] = {cj.x, cj.y, cj.z, cj.w}, djv[4] = {dj.x, dj.y, dj.z, dj.w};
#pragma unroll
            for (int u = 0; u < 4; ++u) {
              const int j = j0 + u;
              const bool ok = dir == 0 ? (j <= icol) : (j >= icol);
              const float m = __expf(ci_ - cjv[u]) * djv[u];
              X[4 * qd + u] = ok ? X[4 * qd + u] * m : 0.f;
            }
          }
#pragma unroll
          for (int sk = 0; sk < 2; ++sk) {
            bf16x8 afr = pack8(X[8 * sk], X[8 * sk + 1], X[8 * sk + 2], X[8 * sk + 3], X[8 * sk + 4], X[8 * sk + 5], X[8 * sk + 6], X[8 * sk + 7]);
            const bf16_t* xp = sXr + pcol * 72 + 32 * jt + 16 * sk + 4 * hh;
            u32x2 lo = *(const u32x2*)xp, hi = *(const u32x2*)(xp + 8);
            u32x4 xv; xv.x = lo.x; xv.y = lo.y; xv.z = hi.x; xv.w = hi.y;
            acc = __builtin_amdgcn_mfma_f32_32x32x16_bf16(afr, __builtin_bit_cast(bf16x8, xv), acc, 0, 0, 0);
          }
        }
      }
      {
        bf16_t* yo = ybuf + ((size_t)dir * T_ALL + ptok0 + 32 * it) * 2048 + h * 64 + pcol;
#pragma unroll
        for (int e = 0; e < 16; ++e) yo[(size_t)rowmap(e, hh) * 2048] = f2bf(acc[e]);
      }
#pragma unroll
      for (int t2 = 0; t2 < 2; ++t2) {
#pragma unroll
        for (int e = 0; e < 16; ++e) hacc[t2][e] *= decE;
        const bf16_t* bt = BT + (size_t)(g * 128 + 32 * (2 * it + t2) + r) * T_ALL + ptok0 + 8 * hh;
        const bf16_t* xs = sXs + pcol * 72 + 8 * hh;
#pragma unroll
        for (int kk = 0; kk < 4; ++kk)
          hacc[t2] = __builtin_amdgcn_mfma_f32_32x32x16_bf16(*(const bf16x8*)(bt + 16 * kk), *(const bf16x8*)(xs + 16 * kk), hacc[t2], 0, 0, 0);
#pragma unroll
        for (int qd = 0; qd < 4; ++qd) {
          u32x2 o; o.x = pack2(hacc[t2][4 * qd], hacc[t2][4 * qd + 1]); o.y = pack2(hacc[t2][4 * qd + 2], hacc[t2][4 * qd + 3]);
          *(u32x2*)(sH + (buf ^ 1) * 64 * SH_STRIDE + pcol * SH_STRIDE + 32 * (2 * it + t2) + 8 * qd + 4 * hh) = o;
        }
      }
    }
    if (s < 32) {
      float* ho = p.out_ssd + ((((size_t)s * 2 + slot) * 2 + dir) * 32 + h) * 8192 + (size_t)pcol * 128;
#pragma unroll
      for (int t2 = 0; t2 < 2; ++t2)
#pragma unroll
        for (int qd = 0; qd < 4; ++qd) {
          f32x4 v; v.x = hacc[t2][4 * qd]; v.y = hacc[t2][4 * qd + 1]; v.z = hacc[t2][4 * qd + 2]; v.w = hacc[t2][4 * qd + 3];
          *(f32x4*)(ho + 32 * (2 * it + t2) + 8 * qd + 4 * hh) = v;
        }
    }
    __syncthreads();
  }
}

__device__ __forceinline__ void phase_ssd_gate(const Params& p, int slot, int bid, int nblk) {
  const int tidx = opaque_tid();
  bf16_t* zb = (bf16_t*)(p.scratch + SC_SSD_Z);
  const bf16_t* yfb = (const bf16_t*)(p.scratch + SC_SSD_XBC);
  const bf16_t* ybb = yfb + (size_t)T_ALL * 2048;
  const bf16_t* xbcc = (const bf16_t*)(p.scratch + SC_SSD_XBCC);
  int lane = tidx & 63, wv = tidx >> 6;
  for (int row = bid * 4 + wv; row < T_ALL; row += nblk * 4) {
    float ss = 0.f;
    TokInfo ti = tokinfo(row);
    const int prow = ti.base + seqpos2off(ti.l, slot == 1 && ti.s >= 32);
#pragma unroll
    for (int j = 0; j < 4; ++j) {
      int c0 = j * 512 + lane * 8;
      u32x4 zv = *(const u32x4*)(zb + (size_t)row * 2048 + c0);
      u32x4 fv = *(const u32x4*)(yfb + (size_t)prow * 2048 + c0);
      u32x4 bv = *(const u32x4*)(ybb + (size_t)prow * 2048 + c0);
      u32x4 xv = *(const u32x4*)(xbcc + (size_t)prow * 4096 + c0);
      float dsk = p.ssd_d[slot * 32 + (c0 >> 6)];
      unsigned zw[4] = {zv.x, zv.y, zv.z, zv.w}, fw[4] = {fv.x, fv.y, fv.z, fv.w}, bw[4] = {bv.x, bv.y, bv.z, bv.w}, xw[4] = {xv.x, xv.y, xv.z, xv.w};
      unsigned ow[4];
#pragma unroll
      for (int e = 0; e < 4; ++e) {
        float y0 = (bflo(fw[e]) + bflo(bw[e]) + dsk * bflo(xw[e])) * siluf(bflo(zw[e]));
        float y1 = (bfhi(fw[e]) + bfhi(bw[e]) + dsk * bfhi(xw[e])) * siluf(bfhi(zw[e]));
        ss += y0 * y0 + y1 * y1;
        ow[e] = pack2(y0, y1);
      }
      u32x4 o; o.x = ow[0]; o.y = ow[1]; o.z = ow[2]; o.w = ow[3];
      *(u32x4*)(zb + (size_t)row * 2048 + c0) = o;
    }
#pragma unroll
    for (int o = 32; o > 0; o >>= 1) ss += __shfl_xor(ss, o);
    if (lane == 0) p.rstd[row] = rsqrtf(ss * (1.f / 2048.f) + 1e-5f);
  }
}

#define HY_UOFF 32768
__device__ __forceinline__ void hy_stage_conv(const Params& p, const bf16_t* __restrict__ row, int ch, bf16_t* dst, int dstStride, int dstPad,
                                              int nelem, int L, int tid) {
  const float w0 = p.hy_conv_w[ch], w1 = p.hy_conv_w[3072 + ch], w2 = p.hy_conv_w[2 * 3072 + ch], bb = p.hy_conv_b[ch];
  for (int q = tid; q < nelem / 8; q += NTHR) {
    const int e0 = q * 8, b = e0 / L, t0 = e0 & (L - 1);
    u32x4 raw = *(const u32x4*)(row + e0);
    float x[10];
    x[0] = t0 > 0 ? bf2f(row[e0 - 1]) : 0.f;
    x[9] = t0 + 8 < L ? bf2f(row[e0 + 8]) : 0.f;
    x[1] = bflo(raw.x); x[2] = bfhi(raw.x); x[3] = bflo(raw.y); x[4] = bfhi(raw.y);
    x[5] = bflo(raw.z); x[6] = bfhi(raw.z); x[7] = bflo(raw.w); x[8] = bfhi(raw.w);
    float o[8];
#pragma unroll
    for (int j = 0; j < 8; ++j) o[j] = w0 * x[j] + w1 * x[j + 1] + w2 * x[j + 2] + bb;
    u32x4 ov; ov.x = pack2(o[0], o[1]); ov.y = pack2(o[2], o[3]); ov.z = pack2(o[4], o[5]); ov.w = pack2(o[6], o[7]);
    *(u32x4*)(dst + b * dstStride + dstPad + t0) = ov;
  }
}

__device__ __forceinline__ void phase_hy_longconv(const Params& p, int bid, int nblk, unsigned char* smem) {
  const int tid = opaque_tid(), lane = tid & 63, w = tid >> 6, r = lane & 31, hh = lane >> 5;
  const bf16_t* projT = (const bf16_t*)(p.scratch + SC_HY_PROJT);
  bf16_t* yT = (bf16_t*)(p.scratch + SC_HY_YT);
  unsigned* Rc0 = (unsigned*)smem;
  unsigned* Rc1 = Rc0 + 4096;
  bf16_t* G = (bf16_t*)smem;
  bf16_t* U = (bf16_t*)(smem + HY_UOFF);
  for (int item = bid; item < 2048; item += nblk) {
    const bool lat = item < 1024;
    const int c = item & 1023;
    const int L = lat ? 4096 : 256, NB = lat ? 4 : 32, RL = lat ? 8192 : 512, Lm1 = L - 1;
    const int PAD = lat ? 224 : 0, US = L + 2 * PAD;
    const int tokbase = lat ? T_CTX : 0;
    const int nI = L >> 5, nelem = NB * L;
    const int TPW = lat ? 4 : 2;
    __syncthreads();
    if (lat) {
      for (int q = tid; q < 4 * 56; q += NTHR) {
        int b = q / 56, k = q % 56;
        int off = k < 28 ? k * 8 : 224 + 4096 + (k - 28) * 8;
        u32x4 z4 = {0u, 0u, 0u, 0u};
        *(u32x4*)(U + b * US + off) = z4;
      }
    }
    hy_stage_conv(p, projT + (size_t)c * T_ALL + tokbase, c, U, US, PAD, nelem, L, tid);
    int Icol[4], bcol[4];
#pragma unroll
    for (int tt = 0; tt < 4; ++tt) {
      int n = (w * TPW + tt) * 32 + r;
      Icol[tt] = lat ? (n >> 2) : (n >> 5);
      bcol[tt] = lat ? (n & 3) : (n & 31);
    }
    const int Ilo_w = lat ? 32 * w : 2 * w, Ihi_w = lat ? 32 * w + 31 : 2 * w + 1;
    const int dlo = Ilo_w - (nI - 1), dhi = Ihi_w;
    for (int order = 0; order < 2; ++order) {
      {
        const bf16_t* src = (lat ? p.rtab1 : p.rtab0) + (size_t)(order * 1024 + c) * RL;
        for (int q = tid; q < RL / 8; q += NTHR) {
          u32x4 cv = *(const u32x4*)(src + q * 8);
          unsigned nx = (q + 1 < RL / 8) ? *(const unsigned*)(src + q * 8 + 8) : 0u;
          *(u32x4*)(Rc0 + q * 4) = cv;
          u32x4 sv;
          sv.x = (cv.x >> 16) | (cv.y << 16); sv.y = (cv.y >> 16) | (cv.z << 16);
          sv.z = (cv.z >> 16) | (cv.w << 16); sv.w = (cv.w >> 16) | (nx << 16);
          *(u32x4*)(Rc1 + q * 4) = sv;
        }
      }
      __syncthreads();
      f32x16 acc[4];
#pragma unroll
      for (int tt = 0; tt < 4; ++tt)
#pragma unroll
        for (int e = 0; e < 16; ++e) acc[tt][e] = 0.f;
      for (int d = dlo; d <= dhi; ++d) {
#pragma unroll
        for (int kk = 0; kk < 2; ++kk) {
          const int y0 = Lm1 - 32 * d - r + 16 * kk + 8 * hh;
          const int par = y0 & 1;
          const unsigned* rp = (par ? Rc1 : Rc0) + ((y0 - par) >> 1);
          u32x4 av; av.x = rp[0]; av.y = rp[1]; av.z = rp[2]; av.w = rp[3];
          bf16x8 af = __builtin_bit_cast(bf16x8, av);
#pragma unroll
          for (int tt = 0; tt < 4; ++tt) {
            if (tt < TPW) {
              const int tile = w * TPW + tt;
              const int Ilo_t = lat ? 8 * tile : tile, Ihi_t = lat ? 8 * tile + 7 : tile;
              if (d >= Ilo_t - (nI - 1) && d <= Ihi_t) {
                const bf16_t* bp = U + bcol[tt] * US + PAD + 32 * (Icol[tt] - d) + 16 * kk + 8 * hh;
                bf16x8 bfr = *(const bf16x8*)bp;
                acc[tt] = __builtin_amdgcn_mfma_f32_32x32x16_bf16(af, bfr, acc[tt], 0, 0, 0);
              }
            }
          }
        }
      }
      __syncthreads();
      hy_stage_conv(p, projT + (size_t)((1 + order) * 1024 + c) * T_ALL + tokbase, (1 + order) * 1024 + c, G, L, 0, nelem, L, tid);
      __syncthreads();
      const float inv = 1.f / p.knorm[((lat ? 1 : 0) * 2 + order) * 1024 + c];
      const float bias = p.hy_f_bias[order * 1024 + c];
#pragma unroll
      for (int tt = 0; tt < 4; ++tt) {
        if (tt < TPW) {
#pragma unroll
          for (int qd = 0; qd < 4; ++qd) {
            const int t0 = 32 * Icol[tt] + 8 * qd + 4 * hh;
            bf16_t* up = U + bcol[tt] * US + PAD + t0;
            u32x2 uc = *(const u32x2*)up;
            u32x2 gg = *(const u32x2*)(G + bcol[tt] * L + t0);
            float r0 = (inv * acc[tt][4 * qd] + bias * bflo(uc.x)) * bflo(gg.x);
            float r1 = (inv * acc[tt][4 * qd + 1] + bias * bfhi(uc.x)) * bfhi(gg.x);
            float r2 = (inv * acc[tt][4 * qd + 2] + bias * bflo(uc.y)) * bflo(gg.y);
            float r3 = (inv * acc[tt][4 * qd + 3] + bias * bfhi(uc.y)) * bfhi(gg.y);
            if (order == 1) {
              u32x2 zz = *(const u32x2*)(projT + (size_t)(3072 + c) * T_ALL + tokbase + bcol[tt] * L + t0);
              r0 *= siluf(bflo(zz.x)); r1 *= siluf(bfhi(zz.x)); r2 *= siluf(bflo(zz.y)); r3 *= siluf(bfhi(zz.y));
            }
            u32x2 ov; ov.x = pack2(r0, r1); ov.y = pack2(r2, r3);
            *(u32x2*)up = ov;
          }
        }
      }
      __syncthreads();
    }
    for (int q = tid; q < nelem / 8; q += NTHR) {
      const int e0 = q * 8, b = e0 / L, t0 = e0 & (L - 1);
      *(u32x4*)(yT + (size_t)c * T_ALL + tokbase + e0) = *(const u32x4*)(U + b * US + PAD + t0);
    }
  }
}

__device__ __forceinline__ void phase_hy_transpose(const Params& p, int bid, int nblk, unsigned char* smem) {
  const int tid = opaque_tid();
  const bf16_t* yT = (const bf16_t*)(p.scratch + SC_HY_YT);
  bf16_t* yg = (bf16_t*)(p.scratch + SC_HY_YG);
  bf16_t* tl = (bf16_t*)smem;
  for (int item = bid; item < 16 * (T_ALL / 64); item += nblk) {
    const int cb = item & 15, tb = item >> 4;
    __syncthreads();
#pragma unroll
    for (int i = 0; i < 2; ++i) {
      int q = tid + i * 256, cr = q >> 3, t8 = (q & 7) * 8;
      u32x4 v = *(const u32x4*)(yT + (size_t)(cb * 64 + cr) * T_ALL + tb * 64 + t8);
      unsigned wv[4] = {v.x, v.y, v.z, v.w};
#pragma unroll
      for (int e = 0; e < 4; ++e) {
        tl[(t8 + 2 * e) * 72 + cr] = (bf16_t)(wv[e] & 0xffffu);
        tl[(t8 + 2 * e + 1) * 72 + cr] = (bf16_t)(wv[e] >> 16);
      }
    }
    __syncthreads();
#pragma unroll
    for (int i = 0; i < 2; ++i) {
      int q = tid + i * 256, tr = q >> 3, c8 = (q & 7) * 8;
      *(u32x4*)(yg + (size_t)(tb * 64 + tr) * 1024 + cb * 64 + c8) = *(const u32x4*)(tl + tr * 72 + c8);
    }
  }
}

__device__ __forceinline__ void lru_ab(const bf16_t* gates, const bf16_t* xc, int dir, int tok, int c, float sp, float& a, float& bx) {
  float r = bf2f(gates[((size_t)(dir * 2 + 0) * T_ALL + tok) * 1024 + c]);
  float i = bf2f(gates[((size_t)(dir * 2 + 1) * T_ALL + tok) * 1024 + c]);
  float x = bf2f(xc[(size_t)tok * 1024 + c]);
  float log_a = -8.f * r * sp;
  a = __expf(log_a);
  float m = sqrtf(fmaxf(1.f - __expf(2.f * log_a), 0.f));
  bx = m * i * x;
}
__device__ __forceinline__ void phase_lru_scan_chunks(const Params& p, int pass, int bid, int nblk) {
  const int tidx = opaque_tid();
  const bf16_t* gates = (const bf16_t*)(p.scratch + SC_LRU_GATES);
  const bf16_t* xc = (const bf16_t*)(p.scratch + SC_LRU_XC);
  bf16_t* ybuf = (bf16_t*)(p.scratch + SC_LRU_Y);
  for (int item = bid; item < 192 * 8; item += nblk) {
    int chunk = item >> 3, dir = (item >> 2) & 1, cb = item & 3;
    int c = cb * 256 + tidx;
    float sp = softplusf(-p.lru_a_param[dir * 1024 + c]);
    int tok0 = chunk * 128;
    float A = 1.f, h = (pass == 0) ? 0.f : p.lru_hin[((size_t)dir * 192 + chunk) * 1024 + c];
    for (int j = 0; j < 128; ++j) {
      int tok = dir ? tok0 + 127 - j : tok0 + j;
      float a, bx;
      lru_ab(gates, xc, dir, tok, c, sp, a, bx);
      h = a * h + bx; A *= a;
      if (pass == 2) ybuf[((size_t)dir * T_ALL + tok) * 1024 + c] = f2bf(h);
    }
    if (pass == 0) {
      float* ag = p.lru_agg + (((size_t)dir * 192 + chunk) * 1024 + c) * 2;
      ag[0] = A; ag[1] = h;
    }
  }
}
__device__ __forceinline__ void phase_lru_scan_carry(const Params& p, int bid, int nblk) {
  const int tidx = opaque_tid();
  for (int item = bid; item < 36 * 8; item += nblk) {
    int s = item >> 3, dir = (item >> 2) & 1, cb = item & 3;
    int c = cb * 256 + tidx;
    int nch = s < 32 ? 2 : 32;
    int ch0 = s < 32 ? s * 2 : 64 + (s - 32) * 32;
    float h = s < 32 ? 0.f : p.state_lru[((size_t)(s - 32) * 2 + dir) * 1024 + c];
    for (int k = 0; k < nch; ++k) {
      int chunk = dir ? ch0 + nch - 1 - k : ch0 + k;
      size_t idx = ((size_t)dir * 192 + chunk) * 1024 + c;
      p.lru_hin[idx] = h;
      h = p.lru_agg[idx * 2] * h + p.lru_agg[idx * 2 + 1];
    }
    if (s < 32) p.out_lru[((size_t)s * 2 + dir) * 1024 + c] = h;
  }
}
__device__ __forceinline__ void phase_lru_combine(const Params& p, int bid, int nblk) {
  const int tidx = opaque_tid();
  const bf16_t* proj = (const bf16_t*)(p.scratch + SC_LRU_PROJ);
  const bf16_t* yf = (const bf16_t*)(p.scratch + SC_LRU_Y);
  const bf16_t* yb = yf + (size_t)T_ALL * 1024;
  bf16_t* yg = (bf16_t*)(p.scratch + SC_LRU_YG);
  const size_t total = (size_t)T_ALL * 128;
  for (size_t idx = (size_t)bid * NTHR + tidx; idx < total; idx += (size_t)nblk * NTHR) {
    int tok = (int)(idx >> 7), c0 = (int)(idx & 127) * 8;
    u32x4 fv = *(const u32x4*)(yf + (size_t)tok * 1024 + c0);
    u32x4 bv = *(const u32x4*)(yb + (size_t)tok * 1024 + c0);
    u32x4 zv = *(const u32x4*)(proj + (size_t)tok * 2048 + 1024 + c0);
    unsigned fw[4] = {fv.x, fv.y, fv.z, fv.w}, bw[4] = {bv.x, bv.y, bv.z, bv.w}, zw[4] = {zv.x, zv.y, zv.z, zv.w}, ow[4];
#pragma unroll
    for (int e = 0; e < 4; ++e)
      ow[e] = pack2((bflo(fw[e]) + bflo(bw[e])) * siluf(bflo(zw[e])), (bfhi(fw[e]) + bfhi(bw[e])) * siluf(bfhi(zw[e])));
    u32x4 o; o.x = ow[0]; o.y = ow[1]; o.z = ow[2]; o.w = ow[3];
    *(u32x4*)(yg + (size_t)tok * 1024 + c0) = o;
  }
}

enum { PH_PREP = 0, PH_MOD, PH_HYA, PH_HYB, PH_LNMOD, PH_INPROJ, PH_MIX1, PH_MIX2, PH_MIX3, PH_MIX4, PH_MIX5, PH_MIX6, PH_OUTPROJ };

__device__ __forceinline__ void run_phase(const Params& p, int ph, int layer, int bid, int nblk, unsigned char* smem) {
  const int kind = layer % 3, slot = layer / 3;
  bid = opaque_s(bid);
  switch (ph) {
    case PH_PREP: phase_prep(p, bid, nblk, smem); break;
    case PH_MOD: phase_mod(p, bid, nblk, smem); break;
    case PH_HYA: phase_hyfilt_a(p, bid, nblk, smem); break;
    case PH_HYB: phase_hyfilt_b(p, bid, nblk, smem); break;
    case PH_LNMOD: phase_lnmod(p, layer, bid, nblk); break;
    case PH_INPROJ:
      if (kind == 0) {
        EpiSsdIn e{(bf16_t*)(p.scratch + SC_SSD_Z), (bf16_t*)(p.scratch + SC_SSD_XBC), (float*)(p.scratch + SC_SSD_DT), p.ssd_dt_bias + slot * 64};
        gemm_phase(p.hbuf, 1024, p.wt_ssd_in + (size_t)slot * 6272 * 1024, 1024, T_ALL / 128, 49, e, bid, nblk, smem);
      } else if (kind == 1) {
        EpiT e{(bf16_t*)(p.scratch + SC_HY_PROJT), (size_t)T_ALL};
        gemm_phase(p.hbuf, 1024, p.wt_hy_in, 1024, T_ALL / 128, 32, e, bid, nblk, smem);
      } else {
        EpiBf16 e{(bf16_t*)(p.scratch + SC_LRU_PROJ), 2048};
        gemm_phase(p.hbuf, 1024, p.wt_lru_in, 1024, T_ALL / 128, 16, e, bid, nblk, smem);
      }
      break;
    case PH_MIX1:
      if (kind == 0) phase_ssd_conv(p, slot, slot == 1, bid, nblk, smem);
      else if (kind == 1) phase_hy_longconv(p, bid, nblk, smem);
      else phase_dwconv<4, false>((const bf16_t*)(p.scratch + SC_LRU_PROJ), 2048, (bf16_t*)(p.scratch + SC_LRU_XC), 1024, 1024,
                                  p.lru_conv_w, p.lru_conv_b, false, bid, nblk);
      break;
    case PH_MIX2:
      if (kind == 0) phase_ssd_scan(p, slot, slot == 1, bid, nblk, smem);
      else if (kind == 1) phase_hy_transpose(p, bid, nblk, smem);
      else {
        for (int nb = 0; nb < 4; ++nb) {
          EpiLruGate e{(bf16_t*)(p.scratch + SC_LRU_GATES), p.lru_gate_b, nb};
          gemm_phase((const bf16_t*)(p.scratch + SC_LRU_XC) + nb * 256, 1024, p.wt_lru_gate + (size_t)nb * 1024 * 256, 256, T_ALL / 128, 8, e, bid, nblk, smem);
        }
      }
      break;
    case PH_MIX3:
      if (kind == 0) phase_ssd_gate(p, slot, bid, nblk);
      else phase_lru_scan_chunks(p, 0, bid, nblk);
      break;
    case PH_MIX4: if (kind == 2) phase_lru_scan_carry(p, bid, nblk); break;
    case PH_MIX5: if (kind == 2) phase_lru_scan_chunks(p, 2, bid, nblk); break;
    case PH_MIX6: if (kind == 2) phase_lru_combine(p, bid, nblk); break;
    case PH_OUTPROJ: {
      const float* mv = p.modv + (size_t)layer * 5 * 3072;
      if (kind == 0) {
        EpiOut e{p.xres, mv, p.rstd};
        gemm_phase((const bf16_t*)(p.scratch + SC_SSD_Z), 2048, p.wt_ssd_out + (size_t)slot * 1024 * 2048, 2048, T_ALL / 128, 8, e, bid, nblk, smem);
      } else if (kind == 1) {
        EpiOut e{p.xres, mv, nullptr};
        gemm_phase((const bf16_t*)(p.scratch + SC_HY_YG), 1024, p.wt_hy_out, 1024, T_ALL / 128, 8, e, bid, nblk, smem);
      } else {
        EpiOut e{p.xres, mv, nullptr};
        gemm_phase((const bf16_t*)(p.scratch + SC_LRU_YG), 1024, p.wt_lru_out, 1024, T_ALL / 128, 8, e, bid, nblk, smem);
      }
    } break;
  }
}

__global__ void __launch_bounds__(NTHR, 2) k_mega(Params p) {
  __shared__ __attribute__((aligned(16))) unsigned char smem[SMEM_BYTES + 16];
  cg::grid_group grid = cg::this_grid();
  const int bid = blockIdx.x, nblk = gridDim.x;
  volatile LAS unsigned* xst = (volatile LAS unsigned*)(smem + SMEM_BYTES);
  if (threadIdx.x == 0) { xst[0] = 0u; xst[1] = 0u; }
  __syncthreads();
  const XcdBarrier xb = xcd_barrier_post(p.bar, xst);
  run_phase(p, PH_PREP, 0, bid, nblk, smem);
  run_phase(p, PH_MOD, 0, bid, nblk, smem);
  run_phase(p, PH_HYA, 0, bid, nblk, smem);
  grid.sync();
  run_phase(p, PH_HYB, 0, bid, nblk, smem);
  for (int layer = 0; layer < 4; ++layer) {
    const int kind = layer % 3;
    run_phase(p, PH_LNMOD, layer, bid, nblk, smem);
    xcd_barrier(xb);
    run_phase(p, PH_INPROJ, layer, bid, nblk, smem);
    xcd_barrier(xb);
    run_phase(p, PH_MIX1, layer, bid, nblk, smem);
    xcd_barrier(xb);
    run_phase(p, PH_MIX2, layer, bid, nblk, smem);
    xcd_barrier(xb);
    if (kind != 1) {
      run_phase(p, PH_MIX3, layer, bid, nblk, smem);
      xcd_barrier(xb);
    }
    if (kind == 2) {
      run_phase(p, PH_MIX4, layer, bid, nblk, smem);
      xcd_barrier(xb);
      run_phase(p, PH_MIX5, layer, bid, nblk, smem);
      xcd_barrier(xb);
      run_phase(p, PH_MIX6, layer, bid, nblk, smem);
      xcd_barrier(xb);
    }
    run_phase(p, PH_OUTPROJ, layer, bid, nblk, smem);
    xcd_barrier(xb);
  }
  run_phase(p, PH_LNMOD, 4, bid, nblk, smem);
}

static inline size_t align_up(size_t x) { return (x + 255) & ~(size_t)255; }

extern "C" void kernel_launch(void* const* d_in, const int* in_sizes, int n_in, void* d_out, int out_size, void* d_ws, size_t ws_size,
                              hipStream_t stream) {
  Params p{};
  const float** fp = (const float**)&p;
  for (int i = 0; i < 36; ++i) fp[i] = (const float*)d_in[i];
  float* out = (float*)d_out;
  p.xres = out;
  p.out_ssd = out + (size_t)T_ALL * 1024;
  p.out_lru = p.out_ssd + (size_t)32 * 2 * 2 * 32 * 64 * 128;
  unsigned char* w = (unsigned char*)d_ws;
  size_t off = 0;
  auto carve = [&](size_t bytes) { unsigned char* r = w + off; off = align_up(off + bytes); return r; };
  p.wt_ssd_in = (bf16_t*)carve((size_t)2 * 6272 * 1024 * 2);
  p.wt_ssd_out = (bf16_t*)carve((size_t)2 * 1024 * 2048 * 2);
  p.wt_hy_in = (bf16_t*)carve((size_t)4096 * 1024 * 2);
  p.wt_hy_out = (bf16_t*)carve((size_t)1024 * 1024 * 2);
  p.wt_lru_in = (bf16_t*)carve((size_t)2048 * 1024 * 2);
  p.wt_lru_out = (bf16_t*)carve((size_t)1024 * 1024 * 2);
  p.wt_lru_gate = (bf16_t*)carve((size_t)4 * 1024 * 256 * 2);
  p.modv = (float*)carve((size_t)4 * 5 * 3072 * 4);
  p.hdn2 = (float*)carve((size_t)4352 * 64 * 4);
  p.rtab0 = (bf16_t*)carve((size_t)2 * 1024 * 512 * 2);
  p.rtab1 = (bf16_t*)carve((size_t)2 * 1024 * 8192 * 2);
  p.knorm = (float*)carve((size_t)4 * 1024 * 4);
  p.hbuf = (bf16_t*)carve((size_t)T_ALL * 1024 * 2);
  p.rstd = (float*)carve((size_t)T_ALL * 4);
  p.lru_agg = (float*)carve((size_t)2 * 192 * 1024 * 2 * 4);
  p.lru_hin = (float*)carve((size_t)2 * 192 * 1024 * 4);
  p.bar = (unsigned*)carve((size_t)XCD_BAR_WORDS * 4);
  p.scratch = carve(SC_TOTAL);
  if (off > ws_size) return;

  static int grid_blocks = 0;
  if (!grid_blocks) {
    int dev = 0, cus = 0, per_cu = 0;
    hipGetDevice(&dev);
    hipDeviceGetAttribute(&cus, hipDeviceAttributeMultiprocessorCount, dev);
    hipOccupancyMaxActiveBlocksPerMultiprocessor(&per_cu, k_mega, NTHR, 0);
    if (per_cu > 2) per_cu = 2;
    grid_blocks = cus * per_cu;
  }
  hipMemsetAsync(p.bar, 0, (size_t)XCD_BAR_WORDS * 4, stream);
  void* args[] = {&p};
  hipError_t e = hipLaunchCooperativeKernel((void*)k_mega, dim3(grid_blocks), dim3(NTHR), args, 0, stream);
  if (e != hipSuccess) fprintf(stderr, "cooperative launch failed: %s (grid %d)\n", hipGetErrorString(e), grid_blocks);
}
```

```cpp
#include <hip/hip_runtime.h>
#include <hip/hip_bf16.h>
#include <hip/hip_cooperative_groups.h>
#include <stdint.h>
#include <cstdio>
namespace cg = cooperative_groups;

typedef unsigned short bf16_t;
typedef __attribute__((ext_vector_type(8))) short bf16x8;
typedef __attribute__((ext_vector_type(16))) float f32x16;
typedef __attribute__((ext_vector_type(4))) unsigned int u32x4;
typedef __attribute__((ext_vector_type(2))) unsigned int u32x2;
typedef __attribute__((ext_vector_type(4))) float f32x4;
typedef float f32x4_t __attribute__((ext_vector_type(4)));

#define T_CTX 8192
#define T_ALL 24576
#define DM 1024
#define NTHR 256
#define SMEM_BYTES 69632
#define WG_THREADS 512
#define WG_SMEM (2 * SMEM_BYTES)
#define ALPHA_RES 1.6817928305074290f
#define LN_EPS 1e-5f

__device__ __forceinline__ bf16_t f2bf(float f) {
  unsigned u = __float_as_uint(f);
  u += 0x7fffu + ((u >> 16) & 1u);
  return (bf16_t)(u >> 16);
}
__device__ __forceinline__ float bf2f(bf16_t b) { return __uint_as_float(((unsigned)b) << 16); }
__device__ __forceinline__ float bflo(unsigned w) { return __uint_as_float(w << 16); }
__device__ __forceinline__ float bfhi(unsigned w) { return __uint_as_float(w & 0xffff0000u); }
__device__ __forceinline__ unsigned pack2(float a, float b) { return (unsigned)f2bf(a) | ((unsigned)f2bf(b) << 16); }
__device__ __forceinline__ float siluf(float x) { return x / (1.f + __expf(-x)); }
__device__ __forceinline__ float sigmoidf(float x) { return 1.f / (1.f + __expf(-x)); }
__device__ __forceinline__ float softplusf(float x) { return x > 20.f ? x : log1pf(expf(x)); }


__device__ __forceinline__ int opaque_lane() { int z = 0; asm volatile("" : "+v"(z)); return __builtin_amdgcn_mbcnt_hi(~0u, __builtin_amdgcn_mbcnt_lo(~0u, (unsigned)z)); }
__device__ __forceinline__ int opaque_tid512(int wave) { return (wave << 6) + opaque_lane(); }
__device__ __forceinline__ int opaque_tid(int wave) { return opaque_tid512(wave) & 255; }

#define XB_TMO      128
#define XB_XCNT(j)  (256  + 64 * (j))
#define XB_XSUB(j)  (1280 + 64 * (j))
#define XB_XGEN(j)  (2304 + 64 * (j))
#define XB_TOP      3328
#define XB_TOPGEN   3392
#define XCD_BAR_WORDS 3456
#define XB_SPIN_CAP (1u << 18)
#define LAS __attribute__((address_space(3)))
__device__ __forceinline__ unsigned xb_ld(unsigned* p)              { return __hip_atomic_load(p, __ATOMIC_RELAXED, __HIP_MEMORY_SCOPE_AGENT); }
__device__ __forceinline__ unsigned xb_add(unsigned* p, unsigned v) { return __hip_atomic_fetch_add(p, v, __ATOMIC_RELAXED, __HIP_MEMORY_SCOPE_AGENT); }
__device__ __forceinline__ unsigned xb_xcc_id() { return (unsigned)__builtin_amdgcn_s_getreg((3 << 11) | 20) & 0xFu; }
#define XB_SPIN(cond, bar) do { unsigned _sp = 0; while (cond) { __builtin_amdgcn_s_sleep(1); \
    if ((++_sp & 255u) == 0u) { if (xb_ld(&(bar)[XB_TMO])) break; if (_sp > XB_SPIN_CAP) { atomicAdd(&(bar)[XB_TMO], 1u); break; } } } } while (0)
struct XcdBarrier { unsigned* bar; unsigned x; volatile LAS unsigned* st; };
__device__ __forceinline__ XcdBarrier xcd_barrier_post(unsigned* bar, volatile LAS unsigned* st) {
  XcdBarrier b; b.bar = bar; b.x = xb_xcc_id(); b.st = st;
  if (threadIdx.x == 0) (void)xb_add(&bar[XB_XCNT(b.x)], 1u);
  return b;
}
__device__ __forceinline__ void xcd_barrier_complete(unsigned* bar, unsigned x, unsigned& nloc, unsigned& nx) {
  const unsigned G = gridDim.x * gridDim.y * gridDim.z;
  unsigned sum, cnt, mine, sp = 0u;
  for (;;) {
    sum = 0u; cnt = 0u; mine = 0u;
#pragma unroll
    for (unsigned j = 0; j < 16; ++j) { const unsigned c = xb_ld(&bar[XB_XCNT(j)]); sum += c; cnt += (c > 0u) ? 1u : 0u; mine = (j == x) ? c : mine; }
    if (sum == G) break;
    __builtin_amdgcn_s_sleep(1);
    if ((++sp & 255u) == 0u) { if (xb_ld(&bar[XB_TMO])) break; if (sp > XB_SPIN_CAP) { atomicAdd(&bar[XB_TMO], 1u); break; } }
  }
  nloc = mine > 0u ? mine : 1u; nx = cnt > 0u ? cnt : 1u;
}
__device__ __forceinline__ void xcd_barrier(const XcdBarrier& b, int wave) {
  asm volatile("s_waitcnt vmcnt(0)" ::: "memory");
  __syncthreads();
  if (opaque_tid512(wave) == 0) {
    unsigned* bar = b.bar;
    __builtin_amdgcn_s_waitcnt(0);
    unsigned nloc = b.st[0], nx = b.st[1];
    if (nloc == 0u) { xcd_barrier_complete(bar, b.x, nloc, nx); b.st[0] = nloc; b.st[1] = nx; }
    const unsigned old = xb_add(&bar[XB_XSUB(b.x)], 1u);
    const unsigned gen = old / nloc;
    if (old + 1u == (gen + 1u) * nloc) {
      __builtin_amdgcn_fence(__ATOMIC_RELEASE, "agent");
      asm volatile("s_waitcnt vmcnt(0)" ::: "memory");
      const unsigned og = xb_add(&bar[XB_TOP], 1u);
      const unsigned tg = og / nx;
      if (og + 1u == (tg + 1u) * nx) xb_add(&bar[XB_TOPGEN], 1u);
      else XB_SPIN(xb_ld(&bar[XB_TOPGEN]) == tg, bar);
      __builtin_amdgcn_fence(__ATOMIC_ACQUIRE, "agent");
      xb_add(&bar[XB_XGEN(b.x)], 1u);
      asm volatile("s_waitcnt vmcnt(0)" ::: "memory");
    } else {
      XB_SPIN(xb_ld(&bar[XB_XGEN(b.x)]) == gen, bar);
      __builtin_amdgcn_fence(__ATOMIC_ACQUIRE, "agent");
      asm volatile("s_waitcnt vmcnt(0)" ::: "memory");
    }
  }
  __syncthreads();
}


__device__ __forceinline__ int opaque_s(int x) { asm volatile("" : "+s"(x)); return x; }

__device__ __forceinline__ float shfl_idx_f(float v, int src) { return __int_as_float(__builtin_amdgcn_ds_bpermute(src << 2, __float_as_int(v))); }
__device__ __forceinline__ float shfl_xor_f(float v, int off, int lane) { return shfl_idx_f(v, lane ^ off); }

struct TokInfo { int s, l, L, base, mrow; };
__device__ __forceinline__ TokInfo tokinfo(int tok) {
  TokInfo t;
  if (tok < T_CTX) { t.s = tok >> 8; t.l = tok & 255; t.L = 256; t.base = tok & ~255; t.mrow = 0; }
  else { int u = tok - T_CTX; t.s = 32 + (u >> 12); t.l = u & 4095; t.L = 4096; t.base = T_CTX + (u & ~4095); t.mrow = 1 + (u >> 12); }
  return t;
}
__device__ __forceinline__ int seqpos2off(int pos, bool cm) { return cm ? (((pos & 63) << 6) | (pos >> 6)) : pos; }

struct Params {
  const float *x_prompt, *x_sample, *state_ssd, *state_lru, *c, *c_ctx, *mod_w, *mod_b, *ln_g, *ln_b;
  const float *ssd_in_w, *ssd_conv_w, *ssd_conv_b, *ssd_dt_bias, *ssd_a_log, *ssd_d, *ssd_norm_g, *ssd_out_w;
  const float *hy_in_w, *hy_conv_w, *hy_conv_b, *hy_f_w1, *hy_f_b1, *hy_f_w2, *hy_f_b2, *hy_f_w3, *hy_f_freq, *hy_f_bias, *hy_out_w;
  const float *lru_in_w, *lru_conv_w, *lru_conv_b, *lru_gate_w, *lru_gate_b, *lru_a_param, *lru_out_w;
  float *xres, *out_ssd, *out_lru;
  bf16_t *wt_ssd_in, *wt_ssd_out, *wt_hy_in, *wt_hy_out, *wt_lru_in, *wt_lru_out, *wt_lru_gate;
  float *modv;
  float *hdn2;
  bf16_t *rtab0;
  bf16_t *rtab1;
  float *knorm;
  bf16_t *hbuf;
  float *rstd;
  float *lru_agg;
  float *lru_hin;
  unsigned char *scratch;
  unsigned *bar;
};

#define SC_SSD_Z     ((size_t)0)
#define SC_SSD_XBC   ((size_t)T_ALL * 2048 * 2)
#define SC_SSD_XBCC  (SC_SSD_XBC + (size_t)T_ALL * 4096 * 2)
#define SC_SSD_DT    (SC_SSD_XBCC + (size_t)T_ALL * 4096 * 2)
#define SC_SSD_XT    (SC_SSD_DT + (size_t)T_ALL * 64 * 4)
#define SC_SSD_BT    (SC_SSD_XT + (size_t)T_ALL * 2048 * 2)
#define SC_SSD_END   (SC_SSD_BT + (size_t)T_ALL * 1024 * 2)
#define SC_HY_PROJT  ((size_t)0)
#define SC_HY_YT     ((size_t)T_ALL * 4096 * 2)
#define SC_HY_YG     (SC_HY_YT + (size_t)T_ALL * 1024 * 2)
#define SC_LRU_PROJ  ((size_t)0)
#define SC_LRU_XC    ((size_t)T_ALL * 2048 * 2)
#define SC_LRU_GATES (SC_LRU_XC + (size_t)T_ALL * 1024 * 2)
#define SC_LRU_Y     (SC_LRU_GATES + (size_t)T_ALL * 4096 * 2)
#define SC_LRU_YG    (SC_LRU_Y + (size_t)T_ALL * 2048 * 2)
#define SC_TOTAL     SC_SSD_END

__device__ __forceinline__ void transpose_tile(const float* __restrict__ src, int ld_src, int n_src, bf16_t* __restrict__ dst, int K,
                               const float* __restrict__ scale, int tile, int tiles_k, float* tl, int cxw) {
  const int tidx = opaque_tid(cxw);
  int tk = tile % tiles_k, tn = tile / tiles_k;
  int k0 = tk * 64, n0 = tn * 64;
  int tx = tidx & 63, ty = tidx >> 6;
  __syncthreads();
  for (int r = ty; r < 64; r += 4) {
    int n = n0 + tx;
    float v = 0.f;
    if (n < n_src) { v = src[(size_t)(k0 + r) * ld_src + n]; if (scale) v *= scale[k0 + r]; }
    tl[r * 65 + tx] = v;
  }
  __syncthreads();
  for (int r = ty; r < 64; r += 4) dst[(size_t)(n0 + r) * K + k0 + tx] = f2bf(tl[tx * 65 + r]);
}

__device__ __forceinline__ void phase_prep(const Params& p, int bid, int nblk, unsigned char* smem, int cxw) {
  const int tidx = opaque_tid(cxw);
  float* tl = (float*)smem;
  for (int job = 0; job < 24; ++job) {
    const float* src; int ld, nsrc, K, npad; bf16_t* dst; const float* scale = nullptr;
    if (job < 2) { src = p.ssd_in_w + (size_t)job * 1024 * 6208; ld = 6208; nsrc = 6208; K = 1024; npad = 6400; dst = p.wt_ssd_in + (size_t)job * 6400 * 1024; }
    else if (job < 4) { int s = job - 2; src = p.ssd_out_w + (size_t)s * 2048 * 1024; ld = 1024; nsrc = 1024; K = 2048; npad = 1024; dst = p.wt_ssd_out + (size_t)s * 1024 * 2048; scale = p.ssd_norm_g + s * 2048; }
    else if (job == 4) { src = p.hy_in_w; ld = 4096; nsrc = 4096; K = 1024; npad = 4096; dst = p.wt_hy_in; }
    else if (job == 5) { src = p.hy_out_w; ld = 1024; nsrc = 1024; K = 1024; npad = 1024; dst = p.wt_hy_out; }
    else if (job == 6) { src = p.lru_in_w; ld = 2048; nsrc = 2048; K = 1024; npad = 2048; dst = p.wt_lru_in; }
    else if (job == 7) { src = p.lru_out_w; ld = 1024; nsrc = 1024; K = 1024; npad = 1024; dst = p.wt_lru_out; }
    else { int q = job - 8; int dg = q >> 2, n = q & 3;
      src = p.lru_gate_w + (size_t)(dg * 4 + n) * 65536; ld = 256; nsrc = 256; K = 256; npad = 256;
      dst = p.wt_lru_gate + (size_t)n * 1024 * 256 + (size_t)dg * 256 * 256; }
    int tiles_k = K / 64, tiles = tiles_k * (npad / 64);
    for (int t = bid; t < tiles; t += nblk) transpose_tile(src, ld, nsrc, dst, K, scale, t, tiles_k, tl, cxw);
  }
  for (int i = bid * NTHR + tidx; i < 2 * 2 * 1024; i += nblk * NTHR) p.knorm[i] = 0.f;
}

__device__ __forceinline__ void phase_mod(const Params& p, int bid, int nblk, unsigned char* smem, int cxw) {
  const int tidx = opaque_tid(cxw);
  float* sc = (float*)smem;
  float* red = sc + 5 * 1024;
  __syncthreads();
  for (int i = tidx; i < 5 * 1024; i += NTHR) {
    int r = i >> 10, k = i & 1023;
    float v = (r == 0) ? p.c_ctx[k] : p.c[(r - 1) * 1024 + k];
    sc[i] = siluf(v);
  }
  __syncthreads();
  const int cj = tidx & 31, kg = tidx >> 5;
  for (int item = bid; item < 4 * 96; item += nblk) {
    const int layer = item / 96, j = (item % 96) * 32 + cj;
    const float* w = p.mod_w + (size_t)layer * 1024 * 3072 + (size_t)kg * 128 * 3072 + j;
    const float* s0 = sc + kg * 128;
    float a0 = 0, a1 = 0, a2 = 0, a3 = 0, a4 = 0;
#pragma unroll 8
    for (int k = 0; k < 128; ++k) {
      float wv = w[(size_t)k * 3072];
      a0 += s0[k] * wv; a1 += s0[1024 + k] * wv; a2 += s0[2048 + k] * wv; a3 += s0[3072 + k] * wv; a4 += s0[4096 + k] * wv;
    }
    __syncthreads();
    red[(kg * 5 + 0) * 32 + cj] = a0; red[(kg * 5 + 1) * 32 + cj] = a1; red[(kg * 5 + 2) * 32 + cj] = a2;
    red[(kg * 5 + 3) * 32 + cj] = a3; red[(kg * 5 + 4) * 32 + cj] = a4;
    __syncthreads();
    if (tidx < 160) {
      const int rr = tidx >> 5, cc = tidx & 31;
      float sum = 0.f;
#pragma unroll
      for (int g8 = 0; g8 < 8; ++g8) sum += red[(g8 * 5 + rr) * 32 + cc];
      const int jj = (item % 96) * 32 + cc;
      p.modv[((size_t)layer * 5 + rr) * 3072 + jj] = sum + p.mod_b[layer * 3072 + jj];
    }
  }
}

__device__ __forceinline__ void phase_hyfilt_a(const Params& p, int bid, int nblk, unsigned char* smem, int cxw) {
  const int tidx = opaque_tid(cxw);
  float* sz = (float*)smem;
  float* sh = sz + 4 * 36;
  int pl = tidx >> 6, m = tidx & 63;
  for (int item = bid; item < 4352 / 4; item += nblk) {
    int pos = item * 4 + pl;
    int L = pos < 256 ? 256 : 4096;
    int l = pos < 256 ? pos : pos - 256;
    __syncthreads();
    if (m < 33) {
      float t = (float)l / (float)L;
      float w = (6.283185307179586f * (float)l) / (float)L;
      float v;
      if (m == 0) v = t;
      else {
        int j = (m - 1) & 15;
        float fr = 1e-4f + (float)j * ((15.f - 1e-4f) / 15.f);
        float ang = w * fr;
        v = (m <= 16) ? __cosf(ang) : __sinf(ang);
      }
      sz[pl * 36 + m] = v;
    }
    __syncthreads();
    float a = p.hy_f_b1[m];
    for (int e = 0; e < 33; ++e) a += sz[pl * 36 + e] * p.hy_f_w1[e * 64 + m];
    a = __sinf(p.hy_f_freq[m] * a);
    sh[pl * 64 + m] = a;
    __syncthreads();
    float b = p.hy_f_b2[m];
    for (int e = 0; e < 64; ++e) b += sh[pl * 64 + e] * p.hy_f_w2[e * 64 + m];
    b = __sinf(p.hy_f_freq[64 + m] * b);
    p.hdn2[(size_t)pos * 64 + m] = b;
  }
}

__device__ __forceinline__ void phase_hyfilt_b(const Params& p, int bid, int nblk, unsigned char* smem, int cxw) {
  const int tidx = opaque_tid(cxw);
  const int lane = tidx & 63;
  for (int item = bid; item < 17 * 64; item += nblk) {
    const int lb = item >> 6, chunk = item & 63;
    const int Lsel = lb ? 1 : 0, L = Lsel ? 4096 : 256, RL = Lsel ? 8192 : 512, Lm1 = L - 1;
    const int l = Lsel ? (lb - 1) * 256 + tidx : tidx;
    const int pos = Lsel ? 256 + l : l;
    float hd[64];
#pragma unroll
    for (int m4 = 0; m4 < 16; ++m4) {
      f32x4 v = *(const f32x4*)(p.hdn2 + (size_t)pos * 64 + m4 * 4);
      hd[m4 * 4] = v.x; hd[m4 * 4 + 1] = v.y; hd[m4 * 4 + 2] = v.z; hd[m4 * 4 + 3] = v.w;
    }
    const int odc0 = chunk * 64, o = odc0 >> 11, d = (odc0 >> 10) & 1, c0 = odc0 & 1023;
    const float t = (float)l / (float)L;
    bf16_t* rt = Lsel ? p.rtab1 : p.rtab0;
    const float min_decay = -3.0701134573253945f, max_decay = -15.350567286626973f;
    for (int cc = 0; cc < 64; ++cc) {
      const int c = c0 + cc;
      const float* w3 = p.hy_f_w3 + odc0 + cc;
      float acc = 0.f;
#pragma unroll
      for (int m = 0; m < 64; ++m) acc += hd[m] * w3[(size_t)m * 4096];
      float delta = fabsf(min_decay + (float)c * ((max_decay - min_decay) / 1023.f));
      float kv = acc * expf(-t * delta);
      size_t rb = (size_t)(o * 1024 + c) * RL;
      if (d == 0) rt[rb + Lm1 - l] = f2bf(kv);
      else if (l > 0) rt[rb + Lm1 + l] = f2bf(kv);
      else rt[rb + RL - 1] = 0;
      float a = fabsf(kv);
#pragma unroll
      for (int off = 32; off > 0; off >>= 1) a += shfl_xor_f(a, off, lane);
      if (lane == 0) atomicAdd(&p.knorm[(Lsel * 2 + o) * 1024 + c], a);
    }
  }
}

__device__ __forceinline__ void phase_lnmod(const Params& p, int layer, int bid, int nblk, int cxw) {
  const int tidx = opaque_tid(cxw);
  int lane = tidx & 63, wv = tidx >> 6;
  for (int row = bid * 4 + wv; row < T_ALL; row += nblk * 4) {
    const float* src = (layer == 0) ? (row < T_CTX ? p.x_prompt + (size_t)row * DM : p.x_sample + (size_t)(row - T_CTX) * DM)
                                    : p.xres + (size_t)row * DM;
    f32x4 v[4];
#pragma unroll
    for (int j = 0; j < 4; ++j) v[j] = *(const f32x4*)(src + j * 256 + lane * 4);
    if (layer > 0) {
      float s = 0.f;
#pragma unroll
      for (int j = 0; j < 4; ++j) s += v[j].x + v[j].y + v[j].z + v[j].w;
#pragma unroll
      for (int o = 32; o > 0; o >>= 1) s += shfl_xor_f(s, o, lane);
      float mu = s * (1.f / 1024.f);
      float q = 0.f;
#pragma unroll
      for (int j = 0; j < 4; ++j) { float a = v[j].x - mu, b = v[j].y - mu, c = v[j].z - mu, d = v[j].w - mu; q += a * a + b * b + c * c + d * d; }
#pragma unroll
      for (int o = 32; o > 0; o >>= 1) q += shfl_xor_f(q, o, lane);
      float rs = rsqrtf(q * (1.f / 1024.f) + LN_EPS);
      const float* g = p.ln_g + (layer - 1) * DM; const float* b = p.ln_b + (layer - 1) * DM;
#pragma unroll
      for (int j = 0; j < 4; ++j) {
        f32x4 gg = *(const f32x4*)(g + j * 256 + lane * 4), bb = *(const f32x4*)(b + j * 256 + lane * 4);
        v[j].x = (v[j].x - mu) * rs * gg.x + bb.x; v[j].y = (v[j].y - mu) * rs * gg.y + bb.y;
        v[j].z = (v[j].z - mu) * rs * gg.z + bb.z; v[j].w = (v[j].w - mu) * rs * gg.w + bb.w;
      }
    }
    float* dst = p.xres + (size_t)row * DM;
#pragma unroll
    for (int j = 0; j < 4; ++j) *(f32x4*)(dst + j * 256 + lane * 4) = v[j];
    if (layer < 4) {
      int mrow = row < T_CTX ? 0 : 1 + ((row - T_CTX) >> 12);
      const float* mv = p.modv + ((size_t)layer * 5 + mrow) * 3072;
#pragma unroll
      for (int j = 0; j < 4; ++j) {
        f32x4 sh = *(const f32x4*)(mv + j * 256 + lane * 4), sc = *(const f32x4*)(mv + 1024 + j * 256 + lane * 4);
        u32x2 o;
        o.x = pack2(v[j].x * (1.f + sc.x) + sh.x, v[j].y * (1.f + sc.y) + sh.y);
        o.y = pack2(v[j].z * (1.f + sc.z) + sh.z, v[j].w * (1.f + sc.w) + sh.w);
        *(u32x2*)(p.hbuf + (size_t)row * DM + j * 256 + lane * 4) = o;
      }
    }
  }
}

#define PG8_LAS __attribute__((address_space(3)))
namespace pg8 {
constexpr int BM = 256, BK = 64, HALF = 128, HTB = HALF * BK * 2, STAGE_BYTES = 8 * HTB, NXCD = 8, WGM = 8;
__device__ __forceinline__ int lds_byte(int r, int c) { const int st = (r >> 4) * 2 + (c >> 5), rr = r & 15, cc = c & 31, ob = rr * 64 + cc * 2; return st * 1024 + (ob ^ (((ob >> 9) & 1) << 5)); }
__device__ __forceinline__ void stage_rc(int b, int& R, int& C) { const int st = b / 1024, sb = b % 1024, swz = sb ^ (((sb >> 9) & 1) << 5); R = (st >> 1) * 16 + swz / 64; C = (st & 1) * 32 + (swz % 64) / 2; }
__device__ __forceinline__ int perm32(int rho) { const int n = rho >> 4, i = rho & 15; return 8 * (i >> 2) + 4 * n + (i & 3); }
struct Unit { int pm, pn; };
struct Gemm { const bf16_t* A; const bf16_t* Bt; int M, N, K, lda; int a_grp_shift; int a_grp_bytes; };
struct StaticOrder {
  int nM, nN, nwg, G, c;
  __device__ void init(int M, int N, int G_, int c_) { nM = M / BM; nN = N / BM; nwg = nM * nN; G = G_; c = c_; }
  __device__ bool next(int i, Unit& u) const {
    const long L = (long)i * G + c; if (L >= nwg) return false;
    int wgid = (int)L; { const int q = nwg / NXCD, r = nwg % NXCD, xcd = wgid % NXCD, off = wgid / NXCD; wgid = (xcd < r ? xcd * (q + 1) : r * (q + 1) + (xcd - r) * q) + off; }
    const int nig = WGM * nN, gid = wgid / nig, fm = gid * WGM, gsz = (nM - fm) < WGM ? (nM - fm) : WGM;
    u.pm = fm + ((wgid % nig) % gsz); u.pn = (wgid % nig) / gsz; return true;
  }
};
__device__ __forceinline__ unsigned cvt_pk_bf16(float lo, float hi) { return pack2(lo, hi); }

template <class Epi>
__device__ __forceinline__ void gemm_phase(PG8_LAS unsigned char* lds, const Gemm g, const StaticOrder& S, const Epi& E, int wave) {
  const int tid = opaque_tid512(wave), wid = wave, lane = tid & 63, wr = wid >> 2, wc = wid & 3, fr = lane & 15, fq = lane >> 4;
  const int K = g.K, nt = K / BK, lda = g.lda;
  unsigned voffA[2], voffB[2];
#pragma unroll
  for (int i = 0; i < 2; ++i) { int R, C; stage_rc(tid * 16 + i * 8192, R, C); const int Rb = Epi::PERM ? ((R & ~31) + perm32(R & 31)) : R;
    voffA[i] = (unsigned)(R * lda + C) * 2u; voffB[i] = (unsigned)(Rb * K + C) * 2u; }
  const size_t kstep = (size_t)(BK * 2);
  const size_t hstepA = (size_t)HALF * lda * 2, hstepB = (size_t)HALF * K * 2;
  const size_t tstepA = 2 * hstepA, tstepB = 2 * hstepB;
  const unsigned ldsw = (unsigned)wid * 1024u;
  const int aoff = lds_byte(wr * 64 + fr, fq * 8), boff = lds_byte(wc * 32 + fr, fq * 8);
#define PG8_SA(b, h) (((b) * 2 + (h)) * HTB)
#define PG8_SB(b, h) ((4 + (b) * 2 + (h)) * HTB)
#define PG8_STAGE(bufoff, gbase, voff) do { _Pragma("unroll") for (int _i = 0; _i < 2; ++_i) \
    __builtin_amdgcn_global_load_lds((const unsigned*)((const char*)(gbase) + (voff)[_i]), (PG8_LAS unsigned*)(lds + (bufoff) + ldsw + _i * 8192), 16, 0, 0); } while (0)
#define PG8_LDA(dst, b, h) do { _Pragma("unroll") for (int m = 0; m < 4; ++m) _Pragma("unroll") for (int k = 0; k < 2; ++k) dst[m][k] = *(const PG8_LAS bf16x8*)(lds + PG8_SA(b, h) + aoff + m * 2048 + k * 1024); } while (0)
#define PG8_LDB(dst, b, h) do { _Pragma("unroll") for (int n = 0; n < 2; ++n) _Pragma("unroll") for (int k = 0; k < 2; ++k) dst[n][k] = *(const PG8_LAS bf16x8*)(lds + PG8_SB(b, h) + boff + n * 2048 + k * 1024); } while (0)
#define PG8_MMA(ai, bj, At, Bt) do { __builtin_amdgcn_s_setprio(1); _Pragma("unroll") for (int m = 0; m < 4; ++m) _Pragma("unroll") for (int n = 0; n < 2; ++n) _Pragma("unroll") for (int k = 0; k < 2; ++k) \
    acc[ai][bj][m][n] = __builtin_amdgcn_mfma_f32_16x16x32_bf16(Bt[n][k], At[m][k], acc[ai][bj][m][n], 0, 0, 0); __builtin_amdgcn_s_setprio(0); } while (0)
#define PG8_WAIT_V(n) asm volatile("s_waitcnt vmcnt(" #n ")" ::: "memory")
#define PG8_WAIT_L(n) asm volatile("s_waitcnt lgkmcnt(" #n ")" ::: "memory")
#define PG8_BAR __builtin_amdgcn_s_barrier()
#define PG8_SCHED __builtin_amdgcn_sched_barrier(0)
#define PG8_APTR(u) ((const char*)g.A + (size_t)(u).pm * tstepA + (size_t)(((u).pn >> g.a_grp_shift) * g.a_grp_bytes))
  Unit cur, nxt; int ui = 0;
  if (!S.next(0, cur)) return;
  f32x4 acc[2][2][4][2];
#pragma unroll
  for (int a = 0; a < 2; ++a)
#pragma unroll
    for (int b = 0; b < 2; ++b)
#pragma unroll
      for (int m = 0; m < 4; ++m)
#pragma unroll
        for (int n = 0; n < 2; ++n) acc[a][b][m][n] = (f32x4){0.f, 0.f, 0.f, 0.f};
  bf16x8 At[4][2], B0[2][2], B1[2][2];
  const char* cA = PG8_APTR(cur); const char* cB = (const char*)g.Bt + (size_t)cur.pn * tstepB;
  PG8_STAGE(PG8_SB(0, 0), cB, voffB); PG8_STAGE(PG8_SA(0, 0), cA, voffA); PG8_STAGE(PG8_SB(0, 1), cB + hstepB, voffB); PG8_STAGE(PG8_SA(0, 1), cA + hstepA, voffA);
  if (wr == 1) PG8_BAR;
  PG8_WAIT_V(4); PG8_BAR;
  PG8_STAGE(PG8_SB(1, 0), cB + kstep, voffB); PG8_STAGE(PG8_SA(1, 0), cA + kstep, voffA); PG8_STAGE(PG8_SB(1, 1), cB + hstepB + kstep, voffB);
  PG8_WAIT_V(6); PG8_BAR;
  for (;;) {
    const bool has_next = S.next(ui + 1, nxt);
    const char* nA = has_next ? PG8_APTR(nxt) : cA; const char* nB = has_next ? (const char*)g.Bt + (size_t)nxt.pn * tstepB : cB;
    for (int t = 0; t < nt; t += 2) {
      const bool last = (t == nt - 2);
      const char* a1 = cA + (size_t)(t + 1) * kstep;
      const char* a2 = last ? nA : cA + (size_t)(t + 2) * kstep; const char* b2 = last ? nB : cB + (size_t)(t + 2) * kstep;
      const char* a3 = a2 + kstep; const char* b3 = b2 + kstep;
      PG8_LDB(B0, 0, 0); PG8_SCHED; PG8_LDA(At, 0, 0); PG8_STAGE(PG8_SA(1, 1), a1 + hstepA, voffA);
      PG8_WAIT_L(8); PG8_BAR; PG8_WAIT_L(0); PG8_MMA(0, 0, At, B0); PG8_BAR; PG8_SCHED;
      PG8_LDB(B1, 0, 1); PG8_STAGE(PG8_SB(0, 0), b2, voffB);
      PG8_BAR; PG8_WAIT_L(0); PG8_MMA(0, 1, At, B1); PG8_BAR;
      PG8_LDA(At, 0, 1); PG8_STAGE(PG8_SA(0, 0), a2, voffA);
      PG8_BAR; PG8_WAIT_L(0); PG8_MMA(1, 0, At, B0); PG8_BAR; PG8_SCHED;
      PG8_STAGE(PG8_SB(0, 1), b2 + hstepB, voffB);
      PG8_WAIT_V(6); PG8_BAR; PG8_MMA(1, 1, At, B1); PG8_BAR;
      PG8_LDB(B0, 1, 0); PG8_SCHED; PG8_LDA(At, 1, 0); PG8_STAGE(PG8_SA(0, 1), a2 + hstepA, voffA);
      PG8_WAIT_L(8); PG8_BAR; PG8_WAIT_L(0); PG8_MMA(0, 0, At, B0); PG8_BAR; PG8_SCHED;
      PG8_LDB(B1, 1, 1); PG8_STAGE(PG8_SB(1, 0), b3, voffB);
      PG8_BAR; PG8_WAIT_L(0); PG8_MMA(0, 1, At, B1); PG8_BAR;
      PG8_LDA(At, 1, 1); PG8_STAGE(PG8_SA(1, 0), a3, voffA);
      PG8_BAR; PG8_WAIT_L(0); PG8_MMA(1, 0, At, B0); PG8_BAR; PG8_SCHED;
      PG8_STAGE(PG8_SB(1, 1), b3 + hstepB, voffB);
      PG8_WAIT_V(6); PG8_BAR; PG8_MMA(1, 1, At, B1); PG8_BAR;
    }
    E(acc, cur, wr, wc, fr, fq);
    if (!has_next) break;
#pragma unroll
    for (int a = 0; a < 2; ++a)
#pragma unroll
      for (int b = 0; b < 2; ++b)
#pragma unroll
        for (int m = 0; m < 4; ++m)
#pragma unroll
          for (int n = 0; n < 2; ++n) acc[a][b][m][n] = (f32x4){0.f, 0.f, 0.f, 0.f};
    cur = nxt; cA = nA; cB = nB; ++ui;
  }
  PG8_WAIT_V(0);
  if (wr == 0) PG8_BAR;
  PG8_BAR;
#undef PG8_SA
#undef PG8_SB
#undef PG8_STAGE
#undef PG8_LDA
#undef PG8_LDB
#undef PG8_MMA
#undef PG8_WAIT_V
#undef PG8_WAIT_L
#undef PG8_BAR
#undef PG8_SCHED
#undef PG8_APTR
}

struct EpiBf16 {
  static constexpr bool PERM = true;
  bf16_t* O; size_t ldc;
  __device__ __forceinline__ void operator()(const f32x4 (&acc)[2][2][4][2], const Unit& u, int wr, int wc, int fr, int fq) const {
    const int row0 = u.pm * BM + wr * 64 + fr, col0 = u.pn * BM + wc * 32 + 8 * fq;
#pragma unroll
    for (int ai = 0; ai < 2; ++ai)
#pragma unroll
      for (int m = 0; m < 4; ++m) {
        bf16_t* rowp = O + (size_t)(row0 + ai * HALF + m * 16) * ldc + col0;
#pragma unroll
        for (int bj = 0; bj < 2; ++bj) {
          const f32x4 v0 = acc[ai][bj][m][0], v1 = acc[ai][bj][m][1];
          u32x4 w; w.x = pack2(v0[0], v0[1]); w.y = pack2(v0[2], v0[3]); w.z = pack2(v1[0], v1[1]); w.w = pack2(v1[2], v1[3]);
          *(u32x4*)(rowp + bj * HALF) = w;
        }
      }
  }
};
struct EpiSsdIn {
  static constexpr bool PERM = true;
  bf16_t* z; bf16_t* xbc; float* dt; const float* dt_bias;
  __device__ __forceinline__ void operator()(const f32x4 (&acc)[2][2][4][2], const Unit& u, int wr, int wc, int fr, int fq) const {
    const int row0 = u.pm * BM + wr * 64 + fr, colt = u.pn * BM + wc * 32 + 8 * fq;
    if (u.pn < 24) {
      bf16_t* base = u.pn < 8 ? z : xbc; const size_t ldc = u.pn < 8 ? 2048 : 4096; const int col0 = u.pn < 8 ? colt : colt - 2048;
#pragma unroll
      for (int ai = 0; ai < 2; ++ai)
#pragma unroll
        for (int m = 0; m < 4; ++m) {
          bf16_t* rowp = base + (size_t)(row0 + ai * HALF + m * 16) * ldc + col0;
#pragma unroll
          for (int bj = 0; bj < 2; ++bj) {
            const f32x4 v0 = acc[ai][bj][m][0], v1 = acc[ai][bj][m][1];
            u32x4 w; w.x = pack2(v0[0], v0[1]); w.y = pack2(v0[2], v0[3]); w.z = pack2(v1[0], v1[1]); w.w = pack2(v1[2], v1[3]);
            *(u32x4*)(rowp + bj * HALF) = w;
          }
        }
    } else {
      const int c0 = wc * 32 + 8 * fq;
      if (c0 < 64) {
#pragma unroll
        for (int ai = 0; ai < 2; ++ai)
#pragma unroll
          for (int m = 0; m < 4; ++m) {
            float* rowp = dt + (size_t)(row0 + ai * HALF + m * 16) * 64 + c0;
#pragma unroll
            for (int n = 0; n < 2; ++n) {
              const f32x4 v = acc[ai][0][m][n];
              f32x4 o;
#pragma unroll
              for (int e = 0; e < 4; ++e) o[e] = softplusf(v[e] + dt_bias[c0 + 4 * n + e]);
              *(f32x4*)(rowp + 4 * n) = o;
            }
          }
      }
    }
  }
};
struct EpiOut {
  static constexpr bool PERM = false;
  float* xres; const float* modv_layer; const float* rstd;
  __device__ __forceinline__ void operator()(const f32x4 (&acc)[2][2][4][2], const Unit& u, int wr, int wc, int fr, int fq) const {
    const int row0 = u.pm * BM + wr * 64 + fr, col0 = u.pn * BM + wc * 32 + 4 * fq;
#pragma unroll
    for (int ai = 0; ai < 2; ++ai)
#pragma unroll
      for (int m = 0; m < 4; ++m) {
        const int row = row0 + ai * HALF + m * 16;
        const int mrow = row < T_CTX ? 0 : 1 + ((row - T_CTX) >> 12);
        const float rs = rstd ? rstd[row] : 1.f;
        const float* gp = modv_layer + (size_t)mrow * 3072 + 2048 + col0;
        float* rowp = xres + (size_t)row * DM + col0;
#pragma unroll
        for (int bj = 0; bj < 2; ++bj)
#pragma unroll
          for (int n = 0; n < 2; ++n) {
            const f32x4 gv = *(const f32x4*)(gp + bj * HALF + n * 16);
            const f32x4 xv = *(const f32x4*)(rowp + bj * HALF + n * 16);
            *(f32x4*)(rowp + bj * HALF + n * 16) = ALPHA_RES * xv + gv * (acc[ai][bj][m][n] * rs);
          }
      }
  }
};
struct EpiLruGate {
  static constexpr bool PERM = true;
  bf16_t* gates; const float* gate_b;
  __device__ __forceinline__ void operator()(const f32x4 (&acc)[2][2][4][2], const Unit& u, int wr, int wc, int fr, int fq) const {
    const int nb = u.pn >> 2, dg = u.pn & 3;
    const int row0 = u.pm * BM + wr * 64 + fr, ch0 = nb * 256 + wc * 32 + 8 * fq;
#pragma unroll
    for (int ai = 0; ai < 2; ++ai)
#pragma unroll
      for (int m = 0; m < 4; ++m) {
        bf16_t* rowp = gates + ((size_t)dg * T_ALL + row0 + ai * HALF + m * 16) * 1024 + ch0;
#pragma unroll
        for (int bj = 0; bj < 2; ++bj) {
          const float* bp = gate_b + dg * 1024 + ch0 + bj * HALF;
          const f32x4 b0 = *(const f32x4*)bp, b1 = *(const f32x4*)(bp + 4);
          const f32x4 v0 = acc[ai][bj][m][0] + b0, v1 = acc[ai][bj][m][1] + b1;
          u32x4 w; w.x = pack2(sigmoidf(v0[0]), sigmoidf(v0[1])); w.y = pack2(sigmoidf(v0[2]), sigmoidf(v0[3]));
          w.z = pack2(sigmoidf(v1[0]), sigmoidf(v1[1])); w.w = pack2(sigmoidf(v1[2]), sigmoidf(v1[3]));
          *(u32x4*)(rowp + bj * HALF) = w;
        }
      }
  }
};
}

template <int KW, bool SILU>
__device__ __forceinline__ void phase_dwconv(const bf16_t* __restrict__ src, int ld_src, bf16_t* __restrict__ dst, int ld_dst, int CH,
                             const float* __restrict__ w, const float* __restrict__ b, bool colmajor, int bid, int nblk, int cxw) {
  const int tidx = opaque_tid(cxw);
  const int cpr = CH / 8;
  const size_t total = (size_t)T_ALL * cpr;
  for (size_t idx = (size_t)bid * NTHR + tidx; idx < total; idx += (size_t)nblk * NTHR) {
    int tok = (int)(idx / cpr), c0 = (int)(idx % cpr) * 8;
    TokInfo ti = tokinfo(tok);
    bool cm = colmajor && ti.s >= 32;
    int pos = seqpos2off(ti.l, cm);
    float acc[8];
#pragma unroll
    for (int e = 0; e < 8; ++e) acc[e] = b[c0 + e];
#pragma unroll
    for (int k = 0; k < KW; ++k) {
      int pp = pos + k - 1;
      if (pp < 0 || pp >= ti.L) continue;
      int tk = ti.base + seqpos2off(pp, cm);
      u32x4 xv = *(const u32x4*)(src + (size_t)tk * ld_src + c0);
      const float* wk = w + (size_t)k * CH + c0;
      acc[0] += wk[0] * bflo(xv.x); acc[1] += wk[1] * bfhi(xv.x);
      acc[2] += wk[2] * bflo(xv.y); acc[3] += wk[3] * bfhi(xv.y);
      acc[4] += wk[4] * bflo(xv.z); acc[5] += wk[5] * bfhi(xv.z);
      acc[6] += wk[6] * bflo(xv.w); acc[7] += wk[7] * bfhi(xv.w);
    }
    if (SILU) {
#pragma unroll
      for (int e = 0; e < 8; ++e) acc[e] = siluf(acc[e]);
    }
    u32x4 o;
    o.x = pack2(acc[0], acc[1]); o.y = pack2(acc[2], acc[3]); o.z = pack2(acc[4], acc[5]); o.w = pack2(acc[6], acc[7]);
    *(u32x4*)(dst + (size_t)tok * ld_dst + c0) = o;
  }
}

__device__ __forceinline__ void phase_ssd_conv(const Params& p, int slot, bool colmajor, int bid, int nblk, unsigned char* smem, int cxw) {
  const int tid = opaque_tid(cxw);
  const bf16_t* raw = (const bf16_t*)(p.scratch + SC_SSD_XBC);
  bf16_t* out = (bf16_t*)(p.scratch + SC_SSD_XBCC);
  bf16_t* XT = (bf16_t*)(p.scratch + SC_SSD_XT);
  bf16_t* BT = (bf16_t*)(p.scratch + SC_SSD_BT);
  const float* cw = p.ssd_conv_w + (size_t)slot * 4 * 4096;
  const float* cb = p.ssd_conv_b + slot * 4096;
  bf16_t* tl = (bf16_t*)smem;
  for (int item = bid; item < 384 * 64; item += nblk) {
    const int ptile = item >> 6, ct = item & 63;
    const int ptok0 = ptile * 64;
    TokInfo ti = tokinfo(ptok0);
    const bool cm = colmajor && ti.s >= 32;
    const int rr = tid >> 2, cpart = tid & 3;
    const int ch = ct * 64 + cpart * 16;
    const int pos = ti.l + rr;
    float acc[16];
#pragma unroll
    for (int e = 0; e < 16; ++e) acc[e] = cb[ch + e];
#pragma unroll
    for (int k = 0; k < 4; ++k) {
      int pp = pos + k - 1;
      if (pp < 0 || pp >= ti.L) continue;
      int tk = ti.base + seqpos2off(pp, cm);
      const bf16_t* rp = raw + (size_t)tk * 4096 + ch;
      u32x4 x0 = *(const u32x4*)rp, x1 = *(const u32x4*)(rp + 8);
      const float* wk = cw + (size_t)k * 4096 + ch;
      unsigned xw[8] = {x0.x, x0.y, x0.z, x0.w, x1.x, x1.y, x1.z, x1.w};
#pragma unroll
      for (int e = 0; e < 8; ++e) { acc[2 * e] += wk[2 * e] * bflo(xw[e]); acc[2 * e + 1] += wk[2 * e + 1] * bfhi(xw[e]); }
    }
    u32x4 o0, o1;
    o0.x = pack2(siluf(acc[0]), siluf(acc[1])); o0.y = pack2(siluf(acc[2]), siluf(acc[3]));
    o0.z = pack2(siluf(acc[4]), siluf(acc[5])); o0.w = pack2(siluf(acc[6]), siluf(acc[7]));
    o1.x = pack2(siluf(acc[8]), siluf(acc[9])); o1.y = pack2(siluf(acc[10]), siluf(acc[11]));
    o1.z = pack2(siluf(acc[12]), siluf(acc[13])); o1.w = pack2(siluf(acc[14]), siluf(acc[15]));
    bf16_t* op = out + (size_t)(ptok0 + rr) * 4096 + ch;
    *(u32x4*)op = o0; *(u32x4*)(op + 8) = o1;
    __syncthreads();
    *(u32x4*)(tl + rr * 72 + cpart * 16) = o0;
    *(u32x4*)(tl + rr * 72 + cpart * 16 + 8) = o1;
    __syncthreads();
    if (ct < 48) {
      const int crow = tid >> 2, part = tid & 3;
      unsigned wv[8];
#pragma unroll
      for (int e = 0; e < 8; ++e) {
        unsigned lo = tl[(part * 16 + 2 * e) * 72 + crow], hi = tl[(part * 16 + 2 * e + 1) * 72 + crow];
        wv[e] = lo | (hi << 16);
      }
      const int chg = ct * 64 + crow;
      bf16_t* dp = (chg < 2048 ? XT + (size_t)chg * T_ALL : BT + (size_t)(chg - 2048) * T_ALL) + ptok0 + part * 16;
      u32x4 t0, t1;
      t0.x = wv[0]; t0.y = wv[1]; t0.z = wv[2]; t0.w = wv[3]; t1.x = wv[4]; t1.y = wv[5]; t1.z = wv[6]; t1.w = wv[7];
      *(u32x4*)dp = t0; *(u32x4*)(dp + 8) = t1;
    }
  }
}

#define SH_STRIDE 136
__device__ __forceinline__ int rowmap(int e, int hh) { return (e & 3) + 8 * (e >> 2) + 4 * hh; }
__device__ __forceinline__ bf16x8 pack8(float a0, float a1, float a2, float a3, float a4, float a5, float a6, float a7) {
  u32x4 v; v.x = pack2(a0, a1); v.y = pack2(a2, a3); v.z = pack2(a4, a5); v.w = pack2(a6, a7);
  return __builtin_bit_cast(bf16x8, v);
}
__device__ __forceinline__ void phase_ssd_scan(const Params& p, int slot, bool colmajor, int bid, int nblk, unsigned char* smem, int cxw) {
  const int tid = opaque_tid(cxw), lane = tid & 63, w = tid >> 6, r = lane & 31, hh = lane >> 5;
  const int it = w >> 1, pt = w & 1;
  const bf16_t* xbcc = (const bf16_t*)(p.scratch + SC_SSD_XBCC);
  const bf16_t* XT = (const bf16_t*)(p.scratch + SC_SSD_XT);
  const bf16_t* BT = (const bf16_t*)(p.scratch + SC_SSD_BT);
  const float* dtb = (const float*)(p.scratch + SC_SSD_DT);
  bf16_t* ybuf = (bf16_t*)(p.scratch + SC_SSD_XBC);
  bf16_t* sXr = (bf16_t*)smem;
  bf16_t* sXs = sXr + 64 * 72;
  bf16_t* sH = sXs + 64 * 72;
  float* sW = (float*)(sH + 2 * 64 * SH_STRIDE);
  float* myW = sW + w * 256;
  for (int item = bid; item < 36 * 64; item += nblk) {
    int s, h, dir;
    if (item < 256) { s = 32 + (item >> 6); h = (item & 63) >> 1; dir = item & 1; }
    else { int itx = item - 256; s = itx >> 6; h = (itx & 63) >> 1; dir = itx & 1; }
    const int L = s < 32 ? 256 : 4096;
    const int base = s < 32 ? s * 256 : T_CTX + (s - 32) * 4096;
    const bool cm = colmajor && s >= 32;
    const int g = h >> 2;
    const float Aval = -expf(p.ssd_a_log[(slot * 2 + dir) * 32 + h]);
    const int nchunks = L >> 6;
    const int pcol = 32 * pt + r;
    f32x16 hacc[2];
    if (s >= 32) {
      const float* h0 = p.state_ssd + ((((size_t)(s - 32) * 2 + slot) * 2 + dir) * 32 + h) * 8192 + (size_t)pcol * 128;
#pragma unroll
      for (int t2 = 0; t2 < 2; ++t2)
#pragma unroll
        for (int qd = 0; qd < 4; ++qd) {
          f32x4 v = *(const f32x4*)(h0 + 32 * (2 * it + t2) + 8 * qd + 4 * hh);
          hacc[t2][4 * qd] = v.x; hacc[t2][4 * qd + 1] = v.y; hacc[t2][4 * qd + 2] = v.z; hacc[t2][4 * qd + 3] = v.w;
        }
    } else {
#pragma unroll
      for (int t2 = 0; t2 < 2; ++t2)
#pragma unroll
        for (int e = 0; e < 16; ++e) hacc[t2][e] = 0.f;
    }
#pragma unroll
    for (int t2 = 0; t2 < 2; ++t2)
#pragma unroll
      for (int qd = 0; qd < 4; ++qd) {
        u32x2 o; o.x = pack2(hacc[t2][4 * qd], hacc[t2][4 * qd + 1]); o.y = pack2(hacc[t2][4 * qd + 2], hacc[t2][4 * qd + 3]);
        *(u32x2*)(sH + pcol * SH_STRIDE + 32 * (2 * it + t2) + 8 * qd + 4 * hh) = o;
      }
    for (int ci = 0; ci < nchunks; ++ci) {
      const int cpos = dir ? nchunks - 1 - ci : ci;
      const int pos0 = cpos * 64, ptok0 = base + pos0;
      const int buf = ci & 1;
      __syncthreads();
      float decE;
      {
        const int tok = base + seqpos2off(pos0 + lane, cm);
        const float dtv = dtb[(size_t)tok * 64 + dir * 32 + h];
        float c = dtv * Aval;
        if (dir == 0) {
#pragma unroll
          for (int off = 1; off < 64; off <<= 1) { float t = shfl_idx_f(c, lane - off); if (lane >= off) c += t; }
        } else {
#pragma unroll
          for (int off = 1; off < 64; off <<= 1) { float t = shfl_idx_f(c, lane + off); if (lane + off < 64) c += t; }
        }
        const float cE = shfl_idx_f(c, dir ? 0 : 63);
        myW[lane] = dtv; myW[64 + lane] = c; myW[128 + lane] = __expf(c); myW[192 + lane] = dtv * __expf(cE - c);
        decE = __expf(cE);
      }
#pragma unroll
      for (int i = 0; i < 2; ++i) {
        const int q = tid + i * 256, prow = q >> 3, j8 = (q & 7) * 8;
        u32x4 raw = *(const u32x4*)(XT + (size_t)(h * 64 + prow) * T_ALL + ptok0 + j8);
        *(u32x4*)(sXr + prow * 72 + j8) = raw;
        f32x4 f0 = *(const f32x4*)(myW + 192 + j8), f1 = *(const f32x4*)(myW + 192 + j8 + 4);
        u32x4 sc;
        sc.x = pack2(bflo(raw.x) * f0.x, bfhi(raw.x) * f0.y); sc.y = pack2(bflo(raw.y) * f0.z, bfhi(raw.y) * f0.w);
        sc.z = pack2(bflo(raw.z) * f1.x, bfhi(raw.z) * f1.y); sc.w = pack2(bflo(raw.w) * f1.z, bfhi(raw.w) * f1.w);
        *(u32x4*)(sXs + prow * 72 + j8) = sc;
      }
      __syncthreads();
      bf16x8 cfr[8];
      {
        const bf16_t* crow = xbcc + (size_t)(ptok0 + 32 * it + r) * 4096 + 3072 + g * 128 + 8 * hh;
#pragma unroll
        for (int kk = 0; kk < 8; ++kk) cfr[kk] = *(const bf16x8*)(crow + 16 * kk);
      }
      f32x16 acc;
#pragma unroll
      for (int e = 0; e < 16; ++e) acc[e] = 0.f;
      {
        const bf16_t* hp = sH + buf * 64 * SH_STRIDE + pcol * SH_STRIDE + 8 * hh;
#pragma unroll
        for (int kk = 0; kk < 8; ++kk) acc = __builtin_amdgcn_mfma_f32_32x32x16_bf16(cfr[kk], *(const bf16x8*)(hp + 16 * kk), acc, 0, 0, 0);
      }
#pragma unroll
      for (int qd = 0; qd < 4; ++qd) {
        f32x4 ec = *(const f32x4*)(myW + 128 + 32 * it + 8 * qd + 4 * hh);
        acc[4 * qd] *= ec.x; acc[4 * qd + 1] *= ec.y; acc[4 * qd + 2] *= ec.z; acc[4 * qd + 3] *= ec.w;
      }
      const int icol = 32 * it + r;
      const float ci_ = myW[64 + icol];
#pragma unroll
      for (int jt = 0; jt < 2; ++jt) {
        const bool needed = dir == 0 ? (jt <= it) : (jt >= it);
        if (needed) {
          f32x16 X;
#pragma unroll
          for (int e = 0; e < 16; ++e) X[e] = 0.f;
          const bf16_t* brow = xbcc + (size_t)(ptok0 + 32 * jt + r) * 4096 + 2048 + g * 128 + 8 * hh;
#pragma unroll
          for (int kk = 0; kk < 8; ++kk) X = __builtin_amdgcn_mfma_f32_32x32x16_bf16(*(const bf16x8*)(brow + 16 * kk), cfr[kk], X, 0, 0, 0);
#pragma unroll
          for (int qd = 0; qd < 4; ++qd) {
            const int j0 = 32 * jt + 8 * qd + 4 * hh;
            f32x4 cj = *(const f32x4*)(myW + 64 + j0), dj = *(const f32x4*)(myW + j0);
            float cjv[4] = {cj.x, cj.y, cj.z, cj.w}, djv[4] = {dj.x, dj.y, dj.z, dj.w};
#pragma unroll
            for (int u = 0; u < 4; ++u) {
              const int j = j0 + u;
              const bool ok = dir == 0 ? (j <= icol) : (j >= icol);
              const float m = __expf(ci_ - cjv[u]) * djv[u];
              X[4 * qd + u] = ok ? X[4 * qd + u] * m : 0.f;
            }
          }
#pragma unroll
          for (int sk = 0; sk < 2; ++sk) {
            bf16x8 afr = pack8(X[8 * sk], X[8 * sk + 1], X[8 * sk + 2], X[8 * sk + 3], X[8 * sk + 4], X[8 * sk + 5], X[8 * sk + 6], X[8 * sk + 7]);
            const bf16_t* xp = sXr + pcol * 72 + 32 * jt + 16 * sk + 4 * hh;
            u32x2 lo = *(const u32x2*)xp, hi = *(const u32x2*)(xp + 8);
            u32x4 xv; xv.x = lo.x; xv.y = lo.y; xv.z = hi.x; xv.w = hi.y;
            acc = __builtin_amdgcn_mfma_f32_32x32x16_bf16(afr, __builtin_bit_cast(bf16x8, xv), acc, 0, 0, 0);
          }
        }
      }
      {
        bf16_t* yo = ybuf + ((size_t)dir * T_ALL + ptok0 + 32 * it) * 2048 + h * 64 + pcol;
#pragma unroll
        for (int e = 0; e < 16; ++e) yo[(size_t)rowmap(e, hh) * 2048] = f2bf(acc[e]);
      }
#pragma unroll
      for (int t2 = 0; t2 < 2; ++t2) {
#pragma unroll
        for (int e = 0; e < 16; ++e) hacc[t2][e] *= decE;
        const bf16_t* bt = BT + (size_t)(g * 128 + 32 * (2 * it + t2) + r) * T_ALL + ptok0 + 8 * hh;
        const bf16_t* xs = sXs + pcol * 72 + 8 * hh;
#pragma unroll
        for (int kk = 0; kk < 4; ++kk)
          hacc[t2] = __builtin_amdgcn_mfma_f32_32x32x16_bf16(*(const bf16x8*)(bt + 16 * kk), *(const bf16x8*)(xs + 16 * kk), hacc[t2], 0, 0, 0);
#pragma unroll
        for (int qd = 0; qd < 4; ++qd) {
          u32x2 o; o.x = pack2(hacc[t2][4 * qd], hacc[t2][4 * qd + 1]); o.y = pack2(hacc[t2][4 * qd + 2], hacc[t2][4 * qd + 3]);
          *(u32x2*)(sH + (buf ^ 1) * 64 * SH_STRIDE + pcol * SH_STRIDE + 32 * (2 * it + t2) + 8 * qd + 4 * hh) = o;
        }
      }
    }
    if (s < 32) {
      float* ho = p.out_ssd + ((((size_t)s * 2 + slot) * 2 + dir) * 32 + h) * 8192 + (size_t)pcol * 128;
#pragma unroll
      for (int t2 = 0; t2 < 2; ++t2)
#pragma unroll
        for (int qd = 0; qd < 4; ++qd) {
          f32x4 v; v.x = hacc[t2][4 * qd]; v.y = hacc[t2][4 * qd + 1]; v.z = hacc[t2][4 * qd + 2]; v.w = hacc[t2][4 * qd + 3];
          *(f32x4*)(ho + 32 * (2 * it + t2) + 8 * qd + 4 * hh) = v;
        }
    }
    __syncthreads();
  }
}

__device__ __forceinline__ void phase_ssd_gate(const Params& p, int slot, int bid, int nblk, int cxw) {
  const int tidx = opaque_tid(cxw);
  bf16_t* zb = (bf16_t*)(p.scratch + SC_SSD_Z);
  const bf16_t* yfb = (const bf16_t*)(p.scratch + SC_SSD_XBC);
  const bf16_t* ybb = yfb + (size_t)T_ALL * 2048;
  const bf16_t* xbcc = (const bf16_t*)(p.scratch + SC_SSD_XBCC);
  int lane = tidx & 63, wv = tidx >> 6;
  for (int row = bid * 4 + wv; row < T_ALL; row += nblk * 4) {
    float ss = 0.f;
    TokInfo ti = tokinfo(row);
    const int prow = ti.base + seqpos2off(ti.l, slot == 1 && ti.s >= 32);
#pragma unroll
    for (int j = 0; j < 4; ++j) {
      int c0 = j * 512 + lane * 8;
      u32x4 zv = *(const u32x4*)(zb + (size_t)row * 2048 + c0);
      u32x4 fv = *(const u32x4*)(yfb + (size_t)prow * 2048 + c0);
      u32x4 bv = *(const u32x4*)(ybb + (size_t)prow * 2048 + c0);
      u32x4 xv = *(const u32x4*)(xbcc + (size_t)prow * 4096 + c0);
      float dsk = p.ssd_d[slot * 32 + (c0 >> 6)];
      unsigned zw[4] = {zv.x, zv.y, zv.z, zv.w}, fw[4] = {fv.x, fv.y, fv.z, fv.w}, bw[4] = {bv.x, bv.y, bv.z, bv.w}, xw[4] = {xv.x, xv.y, xv.z, xv.w};
      unsigned ow[4];
#pragma unroll
      for (int e = 0; e < 4; ++e) {
        float y0 = (bflo(fw[e]) + bflo(bw[e]) + dsk * bflo(xw[e])) * siluf(bflo(zw[e]));
        float y1 = (bfhi(fw[e]) + bfhi(bw[e]) + dsk * bfhi(xw[e])) * siluf(bfhi(zw[e]));
        ss += y0 * y0 + y1 * y1;
        ow[e] = pack2(y0, y1);
      }
      u32x4 o; o.x = ow[0]; o.y = ow[1]; o.z = ow[2]; o.w = ow[3];
      *(u32x4*)(zb + (size_t)row * 2048 + c0) = o;
    }
#pragma unroll
    for (int o = 32; o > 0; o >>= 1) ss += shfl_xor_f(ss, o, lane);
    if (lane == 0) p.rstd[row] = rsqrtf(ss * (1.f / 2048.f) + 1e-5f);
  }
}

#define HY_UOFF 32768
__device__ __forceinline__ void hy_stage_conv(const Params& p, const bf16_t* __restrict__ row, int ch, bf16_t* dst, int dstStride, int dstPad,
                                              int nelem, int L, int tid) {
  const float w0 = p.hy_conv_w[ch], w1 = p.hy_conv_w[3072 + ch], w2 = p.hy_conv_w[2 * 3072 + ch], bb = p.hy_conv_b[ch];
  for (int q = tid; q < nelem / 8; q += NTHR) {
    const int e0 = q * 8, b = e0 / L, t0 = e0 & (L - 1);
    u32x4 raw = *(const u32x4*)(row + e0);
    float x[10];
    x[0] = t0 > 0 ? bf2f(row[e0 - 1]) : 0.f;
    x[9] = t0 + 8 < L ? bf2f(row[e0 + 8]) : 0.f;
    x[1] = bflo(raw.x); x[2] = bfhi(raw.x); x[3] = bflo(raw.y); x[4] = bfhi(raw.y);
    x[5] = bflo(raw.z); x[6] = bfhi(raw.z); x[7] = bflo(raw.w); x[8] = bfhi(raw.w);
    float o[8];
#pragma unroll
    for (int j = 0; j < 8; ++j) o[j] = w0 * x[j] + w1 * x[j + 1] + w2 * x[j + 2] + bb;
    u32x4 ov; ov.x = pack2(o[0], o[1]); ov.y = pack2(o[2], o[3]); ov.z = pack2(o[4], o[5]); ov.w = pack2(o[6], o[7]);
    *(u32x4*)(dst + b * dstStride + dstPad + t0) = ov;
  }
}

__device__ __forceinline__ void phase_hy_longconv(const Params& p, int bid, int nblk, unsigned char* smem, int cxw) {
  const int tid = opaque_tid(cxw), lane = tid & 63, w = tid >> 6, r = lane & 31, hh = lane >> 5;
  const bf16_t* projT = (const bf16_t*)(p.scratch + SC_HY_PROJT);
  bf16_t* yT = (bf16_t*)(p.scratch + SC_HY_YT);
  unsigned* Rc0 = (unsigned*)smem;
  unsigned* Rc1 = Rc0 + 4096;
  bf16_t* G = (bf16_t*)smem;
  bf16_t* U = (bf16_t*)(smem + HY_UOFF);
  for (int item = bid; item < 2048; item += nblk) {
    const bool lat = item < 1024;
    const int c = item & 1023;
    const int L = lat ? 4096 : 256, NB = lat ? 4 : 32, RL = lat ? 8192 : 512, Lm1 = L - 1;
    const int PAD = lat ? 224 : 0, US = L + 2 * PAD;
    const int tokbase = lat ? T_CTX : 0;
    const int nI = L >> 5, nelem = NB * L;
    const int TPW = lat ? 4 : 2;
    __syncthreads();
    if (lat) {
      for (int q = tid; q < 4 * 56; q += NTHR) {
        int b = q / 56, k = q % 56;
        int off = k < 28 ? k * 8 : 224 + 4096 + (k - 28) * 8;
        unsigned zz = 0u; asm volatile("" : "+v"(zz));
        u32x4 z4 = {zz, zz, zz, zz};
        *(u32x4*)(U + b * US + off) = z4;
      }
    }
    hy_stage_conv(p, projT + (size_t)c * T_ALL + tokbase, c, U, US, PAD, nelem, L, tid);
    int Icol[4], bcol[4];
#pragma unroll
    for (int tt = 0; tt < 4; ++tt) {
      int n = (w * TPW + tt) * 32 + r;
      Icol[tt] = lat ? (n >> 2) : (n >> 5);
      bcol[tt] = lat ? (n & 3) : (n & 31);
    }
    const int Ilo_w = lat ? 32 * w : 2 * w, Ihi_w = lat ? 32 * w + 31 : 2 * w + 1;
    const int dlo = Ilo_w - (nI - 1), dhi = Ihi_w;
    for (int order = 0; order < 2; ++order) {
      {
        const bf16_t* src = (lat ? p.rtab1 : p.rtab0) + (size_t)(order * 1024 + c) * RL;
        for (int q = tid; q < RL / 8; q += NTHR) {
          u32x4 cv = *(const u32x4*)(src + q * 8);
          unsigned nx = (q + 1 < RL / 8) ? *(const unsigned*)(src + q * 8 + 8) : 0u;
          *(u32x4*)(Rc0 + q * 4) = cv;
          u32x4 sv;
          sv.x = (cv.x >> 16) | (cv.y << 16); sv.y = (cv.y >> 16) | (cv.z << 16);
          sv.z = (cv.z >> 16) | (cv.w << 16); sv.w = (cv.w >> 16) | (nx << 16);
          *(u32x4*)(Rc1 + q * 4) = sv;
        }
      }
      __syncthreads();
      f32x16 acc[4];
#pragma unroll
      for (int tt = 0; tt < 4; ++tt)
#pragma unroll
        for (int e = 0; e < 16; ++e) acc[tt][e] = 0.f;
      for (int d = dlo; d <= dhi; ++d) {
#pragma unroll
        for (int kk = 0; kk < 2; ++kk) {
          const int y0 = Lm1 - 32 * d - r + 16 * kk + 8 * hh;
          const int par = y0 & 1;
          const unsigned* rp = (par ? Rc1 : Rc0) + ((y0 - par) >> 1);
          u32x4 av; av.x = rp[0]; av.y = rp[1]; av.z = rp[2]; av.w = rp[3];
          bf16x8 af = __builtin_bit_cast(bf16x8, av);
#pragma unroll
          for (int tt = 0; tt < 4; ++tt) {
            if (tt < TPW) {
              const int tile = w * TPW + tt;
              const int Ilo_t = lat ? 8 * tile : tile, Ihi_t = lat ? 8 * tile + 7 : tile;
              if (d >= Ilo_t - (nI - 1) && d <= Ihi_t) {
                const bf16_t* bp = U + bcol[tt] * US + PAD + 32 * (Icol[tt] - d) + 16 * kk + 8 * hh;
                bf16x8 bfr = *(const bf16x8*)bp;
                acc[tt] = __builtin_amdgcn_mfma_f32_32x32x16_bf16(af, bfr, acc[tt], 0, 0, 0);
              }
            }
          }
        }
      }
      __syncthreads();
      hy_stage_conv(p, projT + (size_t)((1 + order) * 1024 + c) * T_ALL + tokbase, (1 + order) * 1024 + c, G, L, 0, nelem, L, tid);
      __syncthreads();
      const float inv = 1.f / p.knorm[((lat ? 1 : 0) * 2 + order) * 1024 + c];
      const float bias = p.hy_f_bias[order * 1024 + c];
#pragma unroll
      for (int tt = 0; tt < 4; ++tt) {
        if (tt < TPW) {
#pragma unroll
          for (int qd = 0; qd < 4; ++qd) {
            const int t0 = 32 * Icol[tt] + 8 * qd + 4 * hh;
            bf16_t* up = U + bcol[tt] * US + PAD + t0;
            u32x2 uc = *(const u32x2*)up;
            u32x2 gg = *(const u32x2*)(G + bcol[tt] * L + t0);
            float r0 = (inv * acc[tt][4 * qd] + bias * bflo(uc.x)) * bflo(gg.x);
            float r1 = (inv * acc[tt][4 * qd + 1] + bias * bfhi(uc.x)) * bfhi(gg.x);
            float r2 = (inv * acc[tt][4 * qd + 2] + bias * bflo(uc.y)) * bflo(gg.y);
            float r3 = (inv * acc[tt][4 * qd + 3] + bias * bfhi(uc.y)) * bfhi(gg.y);
            if (order == 1) {
              u32x2 zz = *(const u32x2*)(projT + (size_t)(3072 + c) * T_ALL + tokbase + bcol[tt] * L + t0);
              r0 *= siluf(bflo(zz.x)); r1 *= siluf(bfhi(zz.x)); r2 *= siluf(bflo(zz.y)); r3 *= siluf(bfhi(zz.y));
            }
            u32x2 ov; ov.x = pack2(r0, r1); ov.y = pack2(r2, r3);
            *(u32x2*)up = ov;
          }
        }
      }
      __syncthreads();
    }
    for (int q = tid; q < nelem / 8; q += NTHR) {
      const int e0 = q * 8, b = e0 / L, t0 = e0 & (L - 1);
      *(u32x4*)(yT + (size_t)c * T_ALL + tokbase + e0) = *(const u32x4*)(U + b * US + PAD + t0);
    }
  }
}

__device__ __forceinline__ void phase_hy_transpose(const Params& p, int bid, int nblk, unsigned char* smem, int cxw) {
  const int tid = opaque_tid(cxw);
  const bf16_t* yT = (const bf16_t*)(p.scratch + SC_HY_YT);
  bf16_t* yg = (bf16_t*)(p.scratch + SC_HY_YG);
  bf16_t* tl = (bf16_t*)smem;
  for (int item = bid; item < 16 * (T_ALL / 64); item += nblk) {
    const int cb = item & 15, tb = item >> 4;
    __syncthreads();
#pragma unroll
    for (int i = 0; i < 2; ++i) {
      int q = tid + i * 256, cr = q >> 3, t8 = (q & 7) * 8;
      u32x4 v = *(const u32x4*)(yT + (size_t)(cb * 64 + cr) * T_ALL + tb * 64 + t8);
      unsigned wv[4] = {v.x, v.y, v.z, v.w};
#pragma unroll
      for (int e = 0; e < 4; ++e) {
        tl[(t8 + 2 * e) * 72 + cr] = (bf16_t)(wv[e] & 0xffffu);
        tl[(t8 + 2 * e + 1) * 72 + cr] = (bf16_t)(wv[e] >> 16);
      }
    }
    __syncthreads();
#pragma unroll
    for (int i = 0; i < 2; ++i) {
      int q = tid + i * 256, tr = q >> 3, c8 = (q & 7) * 8;
      *(u32x4*)(yg + (size_t)(tb * 64 + tr) * 1024 + cb * 64 + c8) = *(const u32x4*)(tl + tr * 72 + c8);
    }
  }
}

__device__ __forceinline__ void lru_ab(const bf16_t* gates, const bf16_t* xc, int dir, int tok, int c, float sp, float& a, float& bx) {
  float r = bf2f(gates[((size_t)(dir * 2 + 0) * T_ALL + tok) * 1024 + c]);
  float i = bf2f(gates[((size_t)(dir * 2 + 1) * T_ALL + tok) * 1024 + c]);
  float x = bf2f(xc[(size_t)tok * 1024 + c]);
  float log_a = -8.f * r * sp;
  a = __expf(log_a);
  float m = sqrtf(fmaxf(1.f - __expf(2.f * log_a), 0.f));
  bx = m * i * x;
}
__device__ __forceinline__ void phase_lru_scan_chunks(const Params& p, int pass, int bid, int nblk, int cxw) {
  const int tidx = opaque_tid(cxw);
  const bf16_t* gates = (const bf16_t*)(p.scratch + SC_LRU_GATES);
  const bf16_t* xc = (const bf16_t*)(p.scratch + SC_LRU_XC);
  bf16_t* ybuf = (bf16_t*)(p.scratch + SC_LRU_Y);
  for (int item = bid; item < 192 * 8; item += nblk) {
    int chunk = item >> 3, dir = (item >> 2) & 1, cb = item & 3;
    int c = cb * 256 + tidx;
    float sp = softplusf(-p.lru_a_param[dir * 1024 + c]);
    int tok0 = chunk * 128;
    float A = 1.f, h = (pass == 0) ? 0.f : p.lru_hin[((size_t)dir * 192 + chunk) * 1024 + c];
    for (int j = 0; j < 128; ++j) {
      int tok = dir ? tok0 + 127 - j : tok0 + j;
      float a, bx;
      lru_ab(gates, xc, dir, tok, c, sp, a, bx);
      h = a * h + bx; A *= a;
      if (pass == 2) ybuf[((size_t)dir * T_ALL + tok) * 1024 + c] = f2bf(h);
    }
    if (pass == 0) {
      float* ag = p.lru_agg + (((size_t)dir * 192 + chunk) * 1024 + c) * 2;
      ag[0] = A; ag[1] = h;
    }
  }
}
__device__ __forceinline__ void phase_lru_scan_carry(const Params& p, int bid, int nblk, int cxw) {
  const int tidx = opaque_tid(cxw);
  for (int item = bid; item < 36 * 8; item += nblk) {
    int s = item >> 3, dir = (item >> 2) & 1, cb = item & 3;
    int c = cb * 256 + tidx;
    int nch = s < 32 ? 2 : 32;
    int ch0 = s < 32 ? s * 2 : 64 + (s - 32) * 32;
    float h = s < 32 ? 0.f : p.state_lru[((size_t)(s - 32) * 2 + dir) * 1024 + c];
    for (int k = 0; k < nch; ++k) {
      int chunk = dir ? ch0 + nch - 1 - k : ch0 + k;
      size_t idx = ((size_t)dir * 192 + chunk) * 1024 + c;
      p.lru_hin[idx] = h;
      h = p.lru_agg[idx * 2] * h + p.lru_agg[idx * 2 + 1];
    }
    if (s < 32) p.out_lru[((size_t)s * 2 + dir) * 1024 + c] = h;
  }
}
__device__ __forceinline__ void phase_lru_combine(const Params& p, int bid, int nblk, int cxw) {
  const int tidx = opaque_tid(cxw);
  const bf16_t* proj = (const bf16_t*)(p.scratch + SC_LRU_PROJ);
  const bf16_t* yf = (const bf16_t*)(p.scratch + SC_LRU_Y);
  const bf16_t* yb = yf + (size_t)T_ALL * 1024;
  bf16_t* yg = (bf16_t*)(p.scratch + SC_LRU_YG);
  const size_t total = (size_t)T_ALL * 128;
  for (size_t idx = (size_t)bid * NTHR + tidx; idx < total; idx += (size_t)nblk * NTHR) {
    int tok = (int)(idx >> 7), c0 = (int)(idx & 127) * 8;
    u32x4 fv = *(const u32x4*)(yf + (size_t)tok * 1024 + c0);
    u32x4 bv = *(const u32x4*)(yb + (size_t)tok * 1024 + c0);
    u32x4 zv = *(const u32x4*)(proj + (size_t)tok * 2048 + 1024 + c0);
    unsigned fw[4] = {fv.x, fv.y, fv.z, fv.w}, bw[4] = {bv.x, bv.y, bv.z, bv.w}, zw[4] = {zv.x, zv.y, zv.z, zv.w}, ow[4];
#pragma unroll
    for (int e = 0; e < 4; ++e)
      ow[e] = pack2((bflo(fw[e]) + bflo(bw[e])) * siluf(bflo(zw[e])), (bfhi(fw[e]) + bfhi(bw[e])) * siluf(bfhi(zw[e])));
    u32x4 o; o.x = ow[0]; o.y = ow[1]; o.z = ow[2]; o.w = ow[3];
    *(u32x4*)(yg + (size_t)tok * 1024 + c0) = o;
  }
}

enum { PH_PREP = 0, PH_MOD, PH_HYA, PH_HYB, PH_LNMOD, PH_INPROJ, PH_MIX1, PH_MIX2, PH_MIX3, PH_MIX4, PH_MIX5, PH_MIX6, PH_OUTPROJ };

struct Ctx { int bid, nblk, wave; unsigned char* smem; unsigned char* wg_smem; };

template <class Epi>
__device__ __forceinline__ void run_gemm(const Ctx& cx, const bf16_t* A, int lda, const bf16_t* Bt, int M, int N, int K, int grp_shift, int grp_bytes, const Epi& e) {
  pg8::Gemm g{A, Bt, M, N, K, lda, grp_shift, grp_bytes};
  pg8::StaticOrder S; S.init(M, N, gridDim.x, opaque_s(blockIdx.x));
  pg8::gemm_phase((PG8_LAS unsigned char*)cx.wg_smem, g, S, e, cx.wave);
}

__device__ __forceinline__ void run_phase(const Params& p, int ph, int layer, const Ctx& cx) {
  const int kind = layer % 3, slot = layer / 3;
  const int bid = opaque_s(cx.bid), nblk = cx.nblk;
  unsigned char* smem = cx.smem;
  switch (ph) {
    case PH_PREP: phase_prep(p, bid, nblk, smem, cx.wave); break;
    case PH_MOD: phase_mod(p, bid, nblk, smem, cx.wave); break;
    case PH_HYA: phase_hyfilt_a(p, bid, nblk, smem, cx.wave); break;
    case PH_HYB: phase_hyfilt_b(p, bid, nblk, smem, cx.wave); break;
    case PH_LNMOD: phase_lnmod(p, layer, bid, nblk, cx.wave); break;
    case PH_INPROJ:
      if (kind == 0) {
        pg8::EpiSsdIn e{(bf16_t*)(p.scratch + SC_SSD_Z), (bf16_t*)(p.scratch + SC_SSD_XBC), (float*)(p.scratch + SC_SSD_DT), p.ssd_dt_bias + slot * 64};
        run_gemm(cx, p.hbuf, 1024, p.wt_ssd_in + (size_t)slot * 6400 * 1024, T_ALL, 6400, 1024, 30, 0, e);
      } else if (kind == 1) {
        pg8::EpiBf16 e{(bf16_t*)(p.scratch + SC_HY_PROJT), (size_t)T_ALL};
        run_gemm(cx, p.wt_hy_in, 1024, p.hbuf, 4096, T_ALL, 1024, 30, 0, e);
      } else {
        pg8::EpiBf16 e{(bf16_t*)(p.scratch + SC_LRU_PROJ), (size_t)2048};
        run_gemm(cx, p.hbuf, 1024, p.wt_lru_in, T_ALL, 2048, 1024, 30, 0, e);
      }
      break;
    case PH_MIX1:
      if (kind == 0) phase_ssd_conv(p, slot, slot == 1, bid, nblk, smem, cx.wave);
      else if (kind == 1) phase_hy_longconv(p, bid, nblk, smem, cx.wave);
      else phase_dwconv<4, false>((const bf16_t*)(p.scratch + SC_LRU_PROJ), 2048, (bf16_t*)(p.scratch + SC_LRU_XC), 1024, 1024,
                                  p.lru_conv_w, p.lru_conv_b, false, bid, nblk, cx.wave);
      break;
    case PH_MIX2:
      if (kind == 0) phase_ssd_scan(p, slot, slot == 1, bid, nblk, smem, cx.wave);
      else if (kind == 1) phase_hy_transpose(p, bid, nblk, smem, cx.wave);
      else {
        pg8::EpiLruGate e{(bf16_t*)(p.scratch + SC_LRU_GATES), p.lru_gate_b};
        run_gemm(cx, (const bf16_t*)(p.scratch + SC_LRU_XC), 1024, p.wt_lru_gate, T_ALL, 4096, 256, 2, 512, e);
      }
      break;
    case PH_MIX3:
      if (kind == 0) phase_ssd_gate(p, slot, bid, nblk, cx.wave);
      else phase_lru_scan_chunks(p, 0, bid, nblk, cx.wave);
      break;
    case PH_MIX4: if (kind == 2) phase_lru_scan_carry(p, bid, nblk, cx.wave); break;
    case PH_MIX5: if (kind == 2) phase_lru_scan_chunks(p, 2, bid, nblk, cx.wave); break;
    case PH_MIX6: if (kind == 2) phase_lru_combine(p, bid, nblk, cx.wave); break;
    case PH_OUTPROJ: {
      const float* mv = p.modv + (size_t)layer * 5 * 3072;
      if (kind == 0) {
        pg8::EpiOut e{p.xres, mv, p.rstd};
        run_gemm(cx, (const bf16_t*)(p.scratch + SC_SSD_Z), 2048, p.wt_ssd_out + (size_t)slot * 1024 * 2048, T_ALL, 1024, 2048, 30, 0, e);
      } else if (kind == 1) {
        pg8::EpiOut e{p.xres, mv, nullptr};
        run_gemm(cx, (const bf16_t*)(p.scratch + SC_HY_YG), 1024, p.wt_hy_out, T_ALL, 1024, 1024, 30, 0, e);
      } else {
        pg8::EpiOut e{p.xres, mv, nullptr};
        run_gemm(cx, (const bf16_t*)(p.scratch + SC_LRU_YG), 1024, p.wt_lru_out, T_ALL, 1024, 1024, 30, 0, e);
      }
    } break;
  }
}

__global__ void __launch_bounds__(WG_THREADS, 2) k_mega(Params p) {
  __shared__ __attribute__((aligned(16))) unsigned char smem[WG_SMEM + 16];
  cg::grid_group grid = cg::this_grid();
  const int wave0 = __builtin_amdgcn_readfirstlane((int)(threadIdx.x >> 6));
  const int vb = wave0 >> 2;
  Ctx cx;
  cx.wave = wave0;
  cx.bid = 2 * blockIdx.x + vb; cx.nblk = 2 * gridDim.x; cx.smem = smem + vb * SMEM_BYTES; cx.wg_smem = smem;
  volatile LAS unsigned* xst = (volatile LAS unsigned*)(smem + WG_SMEM);
  if (threadIdx.x == 0) { xst[0] = 0u; xst[1] = 0u; }
  __syncthreads();
  const XcdBarrier xb = xcd_barrier_post(p.bar, xst);
  run_phase(p, PH_PREP, 0, cx);
  run_phase(p, PH_MOD, 0, cx);
  run_phase(p, PH_HYA, 0, cx);
  grid.sync();
  run_phase(p, PH_HYB, 0, cx);
  for (int layer = 0; layer < 4; ++layer) {
    const int kind = layer % 3;
    run_phase(p, PH_LNMOD, layer, cx);
    xcd_barrier(xb, cx.wave);
    run_phase(p, PH_INPROJ, layer, cx);
    xcd_barrier(xb, cx.wave);
    run_phase(p, PH_MIX1, layer, cx);
    xcd_barrier(xb, cx.wave);
    run_phase(p, PH_MIX2, layer, cx);
    xcd_barrier(xb, cx.wave);
    if (kind != 1) {
      run_phase(p, PH_MIX3, layer, cx);
      xcd_barrier(xb, cx.wave);
    }
    if (kind == 2) {
      run_phase(p, PH_MIX4, layer, cx);
      xcd_barrier(xb, cx.wave);
      run_phase(p, PH_MIX5, layer, cx);
      xcd_barrier(xb, cx.wave);
      run_phase(p, PH_MIX6, layer, cx);
      xcd_barrier(xb, cx.wave);
    }
    run_phase(p, PH_OUTPROJ, layer, cx);
    xcd_barrier(xb, cx.wave);
  }
  run_phase(p, PH_LNMOD, 4, cx);
}

static inline size_t align_up(size_t x) { return (x + 255) & ~(size_t)255; }

extern "C" void kernel_launch(void* const* d_in, const int* in_sizes, int n_in, void* d_out, int out_size, void* d_ws, size_t ws_size,
                              hipStream_t stream) {
  Params p{};
  const float** fp = (const float**)&p;
  for (int i = 0; i < 36; ++i) fp[i] = (const float*)d_in[i];
  float* out = (float*)d_out;
  p.xres = out;
  p.out_ssd = out + (size_t)T_ALL * 1024;
  p.out_lru = p.out_ssd + (size_t)32 * 2 * 2 * 32 * 64 * 128;
  unsigned char* w = (unsigned char*)d_ws;
  size_t off = 0;
  auto carve = [&](size_t bytes) { unsigned char* r = w + off; off = align_up(off + bytes); return r; };
  p.wt_ssd_in = (bf16_t*)carve((size_t)2 * 6400 * 1024 * 2);
  p.wt_ssd_out = (bf16_t*)carve((size_t)2 * 1024 * 2048 * 2);
  p.wt_hy_in = (bf16_t*)carve((size_t)4096 * 1024 * 2);
  p.wt_hy_out = (bf16_t*)carve((size_t)1024 * 1024 * 2);
  p.wt_lru_in = (bf16_t*)carve((size_t)2048 * 1024 * 2);
  p.wt_lru_out = (bf16_t*)carve((size_t)1024 * 1024 * 2);
  p.wt_lru_gate = (bf16_t*)carve((size_t)4 * 1024 * 256 * 2);
  p.modv = (float*)carve((size_t)4 * 5 * 3072 * 4);
  p.hdn2 = (float*)carve((size_t)4352 * 64 * 4);
  p.rtab0 = (bf16_t*)carve((size_t)2 * 1024 * 512 * 2);
  p.rtab1 = (bf16_t*)carve((size_t)2 * 1024 * 8192 * 2);
  p.knorm = (float*)carve((size_t)4 * 1024 * 4);
  p.hbuf = (bf16_t*)carve((size_t)T_ALL * 1024 * 2);
  p.rstd = (float*)carve((size_t)T_ALL * 4);
  p.lru_agg = (float*)carve((size_t)2 * 192 * 1024 * 2 * 4);
  p.lru_hin = (float*)carve((size_t)2 * 192 * 1024 * 4);
  p.bar = (unsigned*)carve((size_t)XCD_BAR_WORDS * 4);
  p.scratch = carve(SC_TOTAL);
  if (off > ws_size) return;

  static int grid_blocks = 0;
  if (!grid_blocks) {
    int dev = 0, cus = 0, per_cu = 0;
    hipGetDevice(&dev);
    hipDeviceGetAttribute(&cus, hipDeviceAttributeMultiprocessorCount, dev);
    hipOccupancyMaxActiveBlocksPerMultiprocessor(&per_cu, k_mega, WG_THREADS, 0);
    if (per_cu > 1) per_cu = 1;
    grid_blocks = cus * per_cu;
  }
  hipMemsetAsync(p.bar, 0, (size_t)XCD_BAR_WORDS * 4, stream);
  void* args[] = {&p};
  hipError_t e = hipLaunchCooperativeKernel((void*)k_mega, dim3(grid_blocks), dim3(WG_THREADS), args, 0, stream);
  if (e != hipSuccess) fprintf(stderr, "cooperative launch failed: %s (grid %d)\n", hipGetErrorString(e), grid_blocks);
}
```

```cpp
#include <hip/hip_runtime.h>
#include <hip/hip_bf16.h>
#include <hip/hip_cooperative_groups.h>
#include <stdint.h>
#include <cstdio>
namespace cg = cooperative_groups;

typedef unsigned short bf16_t;
typedef __attribute__((ext_vector_type(8))) short bf16x8;
typedef __attribute__((ext_vector_type(16))) float f32x16;
typedef __attribute__((ext_vector_type(4))) unsigned int u32x4;
typedef __attribute__((ext_vector_type(2))) unsigned int u32x2;
typedef __attribute__((ext_vector_type(4))) float f32x4;
typedef float f32x4_t __attribute__((ext_vector_type(4)));

#define T_CTX 8192
#define T_ALL 24576
#define DM 1024
#define NTHR 256
#define SMEM_BYTES 69632
#define WG_THREADS 512
#define WG_SMEM (2 * SMEM_BYTES)
#define ALPHA_RES 1.6817928305074290f
#define LN_EPS 1e-5f

__device__ __forceinline__ bf16_t f2bf(float f) {
  unsigned u = __float_as_uint(f);
  u += 0x7fffu + ((u >> 16) & 1u);
  return (bf16_t)(u >> 16);
}
__device__ __forceinline__ float bf2f(bf16_t b) { return __uint_as_float(((unsigned)b) << 16); }
__device__ __forceinline__ float bflo(unsigned w) { return __uint_as_float(w << 16); }
__device__ __forceinline__ float bfhi(unsigned w) { return __uint_as_float(w & 0xffff0000u); }
__device__ __forceinline__ unsigned pack2(float a, float b) { return (unsigned)f2bf(a) | ((unsigned)f2bf(b) << 16); }
__device__ __forceinline__ float siluf(float x) { return x / (1.f + __expf(-x)); }
__device__ __forceinline__ float sigmoidf(float x) { return 1.f / (1.f + __expf(-x)); }
__device__ __forceinline__ float softplusf(float x) { return x > 20.f ? x : __logf(1.f + __expf(x)); }


__device__ __forceinline__ int opaque_lane() { int z = 0; asm volatile("" : "+v"(z)); return __builtin_amdgcn_mbcnt_hi(~0u, __builtin_amdgcn_mbcnt_lo(~0u, (unsigned)z)); }
__device__ __forceinline__ int opaque_tid512(int wave) { return (wave << 6) + opaque_lane(); }
__device__ __forceinline__ int opaque_tid(int wave) { return opaque_tid512(wave) & 255; }

#define XB_TMO      128
#define XB_XCNT(j)  (256  + 64 * (j))
#define XB_XSUB(j)  (1280 + 64 * (j))
#define XB_XGEN(j)  (2304 + 64 * (j))
#define XB_TOP      3328
#define XB_TOPGEN   3392
#define XCD_BAR_WORDS 3456
#define XB_SPIN_CAP (1u << 18)
#define LAS __attribute__((address_space(3)))
__device__ __forceinline__ unsigned xb_ld(unsigned* p)              { return __hip_atomic_load(p, __ATOMIC_RELAXED, __HIP_MEMORY_SCOPE_AGENT); }
__device__ __forceinline__ unsigned xb_add(unsigned* p, unsigned v) { return __hip_atomic_fetch_add(p, v, __ATOMIC_RELAXED, __HIP_MEMORY_SCOPE_AGENT); }
__device__ __forceinline__ unsigned xb_xcc_id() { return (unsigned)__builtin_amdgcn_s_getreg((3 << 11) | 20) & 0xFu; }
#define XB_SPIN(cond, bar) do { unsigned _sp = 0; while (cond) { __builtin_amdgcn_s_sleep(1); \
    if ((++_sp & 255u) == 0u) { if (xb_ld(&(bar)[XB_TMO])) break; if (_sp > XB_SPIN_CAP) { atomicAdd(&(bar)[XB_TMO], 1u); break; } } } } while (0)
struct XcdBarrier { unsigned* bar; unsigned x; volatile LAS unsigned* st; };
__device__ __forceinline__ XcdBarrier xcd_barrier_post(unsigned* bar, volatile LAS unsigned* st) {
  XcdBarrier b; b.bar = bar; b.x = xb_xcc_id(); b.st = st;
  if (threadIdx.x == 0) (void)xb_add(&bar[XB_XCNT(b.x)], 1u);
  return b;
}
__device__ __forceinline__ void xcd_barrier_complete(unsigned* bar, unsigned x, unsigned& nloc, unsigned& nx) {
  const unsigned G = gridDim.x * gridDim.y * gridDim.z;
  unsigned sum, cnt, mine, sp = 0u;
  for (;;) {
    sum = 0u; cnt = 0u; mine = 0u;
#pragma unroll
    for (unsigned j = 0; j < 16; ++j) { const unsigned c = xb_ld(&bar[XB_XCNT(j)]); sum += c; cnt += (c > 0u) ? 1u : 0u; mine = (j == x) ? c : mine; }
    if (sum == G) break;
    __builtin_amdgcn_s_sleep(1);
    if ((++sp & 255u) == 0u) { if (xb_ld(&bar[XB_TMO])) break; if (sp > XB_SPIN_CAP) { atomicAdd(&bar[XB_TMO], 1u); break; } }
  }
  nloc = mine > 0u ? mine : 1u; nx = cnt > 0u ? cnt : 1u;
}
__device__ __forceinline__ void xcd_barrier(const XcdBarrier& b, int wave) {
  asm volatile("s_waitcnt vmcnt(0)" ::: "memory");
  __syncthreads();
  if (opaque_tid512(wave) == 0) {
    unsigned* bar = b.bar;
    __builtin_amdgcn_s_waitcnt(0);
    unsigned nloc = b.st[0], nx = b.st[1];
    if (nloc == 0u) { xcd_barrier_complete(bar, b.x, nloc, nx); b.st[0] = nloc; b.st[1] = nx; }
    const unsigned old = xb_add(&bar[XB_XSUB(b.x)], 1u);
    const unsigned gen = old / nloc;
    if (old + 1u == (gen + 1u) * nloc) {
      __builtin_amdgcn_fence(__ATOMIC_RELEASE, "agent");
      asm volatile("s_waitcnt vmcnt(0)" ::: "memory");
      const unsigned og = xb_add(&bar[XB_TOP], 1u);
      const unsigned tg = og / nx;
      if (og + 1u == (tg + 1u) * nx) xb_add(&bar[XB_TOPGEN], 1u);
      else XB_SPIN(xb_ld(&bar[XB_TOPGEN]) == tg, bar);
      __builtin_amdgcn_fence(__ATOMIC_ACQUIRE, "agent");
      xb_add(&bar[XB_XGEN(b.x)], 1u);
      asm volatile("s_waitcnt vmcnt(0)" ::: "memory");
    } else {
      XB_SPIN(xb_ld(&bar[XB_XGEN(b.x)]) == gen, bar);
      __builtin_amdgcn_fence(__ATOMIC_ACQUIRE, "agent");
      asm volatile("s_waitcnt vmcnt(0)" ::: "memory");
    }
  }
  __syncthreads();
}


__device__ __forceinline__ int opaque_s(int x) { asm volatile("" : "+s"(x)); return x; }

__device__ __forceinline__ float shfl_idx_f(float v, int src) { return __int_as_float(__builtin_amdgcn_ds_bpermute(src << 2, __float_as_int(v))); }
__device__ __forceinline__ float shfl_xor_f(float v, int off, int lane) { return shfl_idx_f(v, lane ^ off); }

struct TokInfo { int s, l, L, base, mrow; };
__device__ __forceinline__ TokInfo tokinfo(int tok) {
  TokInfo t;
  if (tok < T_CTX) { t.s = tok >> 8; t.l = tok & 255; t.L = 256; t.base = tok & ~255; t.mrow = 0; }
  else { int u = tok - T_CTX; t.s = 32 + (u >> 12); t.l = u & 4095; t.L = 4096; t.base = T_CTX + (u & ~4095); t.mrow = 1 + (u >> 12); }
  return t;
}
__device__ __forceinline__ int seqpos2off(int pos, bool cm) { return cm ? (((pos & 63) << 6) | (pos >> 6)) : pos; }

struct Params {
  const float *x_prompt, *x_sample, *state_ssd, *state_lru, *c, *c_ctx, *mod_w, *mod_b, *ln_g, *ln_b;
  const float *ssd_in_w, *ssd_conv_w, *ssd_conv_b, *ssd_dt_bias, *ssd_a_log, *ssd_d, *ssd_norm_g, *ssd_out_w;
  const float *hy_in_w, *hy_conv_w, *hy_conv_b, *hy_f_w1, *hy_f_b1, *hy_f_w2, *hy_f_b2, *hy_f_w3, *hy_f_freq, *hy_f_bias, *hy_out_w;
  const float *lru_in_w, *lru_conv_w, *lru_conv_b, *lru_gate_w, *lru_gate_b, *lru_a_param, *lru_out_w;
  float *xres, *out_ssd, *out_lru;
  bf16_t *wt_ssd_in, *wt_ssd_out, *wt_hy_in, *wt_hy_out, *wt_lru_in, *wt_lru_out, *wt_lru_gate;
  float *modv;
  float *hdn2;
  bf16_t *rtab0;
  bf16_t *rtab1;
  float *knorm;
  bf16_t *hbuf;
  float *rstd;
  float *lru_agg;
  float *lru_hin;
  unsigned char *scratch;
  unsigned *bar;
};

#define SC_SSD_Z     ((size_t)0)
#define SC_SSD_XBC   ((size_t)T_ALL * 2048 * 2)
#define SC_SSD_XBCC  (SC_SSD_XBC + (size_t)T_ALL * 4096 * 2)
#define SC_SSD_DT    (SC_SSD_XBCC + (size_t)T_ALL * 4096 * 2)
#define SC_SSD_XT    (SC_SSD_DT + (size_t)T_ALL * 64 * 4)
#define SC_SSD_BT    (SC_SSD_XT + (size_t)T_ALL * 2048 * 2)
#define SC_SSD_END   (SC_SSD_BT + (size_t)T_ALL * 1024 * 2)
#define SC_HY_PROJT  ((size_t)0)
#define SC_HY_YT     ((size_t)T_ALL * 4096 * 2)
#define SC_HY_YG     (SC_HY_YT + (size_t)T_ALL * 1024 * 2)
#define SC_LRU_PROJ  ((size_t)0)
#define SC_LRU_XC    ((size_t)T_ALL * 2048 * 2)
#define SC_LRU_GATES (SC_LRU_XC + (size_t)T_ALL * 1024 * 2)
#define SC_LRU_Y     (SC_LRU_GATES + (size_t)T_ALL * 4096 * 2)
#define SC_LRU_YG    (SC_LRU_Y + (size_t)T_ALL * 2048 * 2)
#define SC_TOTAL     SC_SSD_END

__device__ __forceinline__ void transpose_tile(const float* __restrict__ src, int ld_src, int n_src, bf16_t* __restrict__ dst, int K,
                               const float* __restrict__ scale, int tile, int tiles_k, float* tl, int cxw) {
  const int tidx = opaque_tid(cxw);
  int tk = tile % tiles_k, tn = tile / tiles_k;
  int k0 = tk * 64, n0 = tn * 64;
  int tx = tidx & 63, ty = tidx >> 6;
  __syncthreads();
  for (int r = ty; r < 64; r += 4) {
    int n = n0 + tx;
    float v = 0.f;
    if (n < n_src) { v = src[(size_t)(k0 + r) * ld_src + n]; if (scale) v *= scale[k0 + r]; }
    tl[r * 65 + tx] = v;
  }
  __syncthreads();
  for (int r = ty; r < 64; r += 4) dst[(size_t)(n0 + r) * K + k0 + tx] = f2bf(tl[tx * 65 + r]);
}

__device__ __forceinline__ void phase_prep(const Params& p, int bid, int nblk, unsigned char* smem, int cxw) {
  const int tidx = opaque_tid(cxw);
  float* tl = (float*)smem;
  for (int job = 0; job < 24; ++job) {
    const float* src; int ld, nsrc, K, npad; bf16_t* dst; const float* scale = nullptr;
    if (job < 2) { src = p.ssd_in_w + (size_t)job * 1024 * 6208; ld = 6208; nsrc = 6208; K = 1024; npad = 6400; dst = p.wt_ssd_in + (size_t)job * 6400 * 1024; }
    else if (job < 4) { int s = job - 2; src = p.ssd_out_w + (size_t)s * 2048 * 1024; ld = 1024; nsrc = 1024; K = 2048; npad = 1024; dst = p.wt_ssd_out + (size_t)s * 1024 * 2048; scale = p.ssd_norm_g + s * 2048; }
    else if (job == 4) { src = p.hy_in_w; ld = 4096; nsrc = 4096; K = 1024; npad = 4096; dst = p.wt_hy_in; }
    else if (job == 5) { src = p.hy_out_w; ld = 1024; nsrc = 1024; K = 1024; npad = 1024; dst = p.wt_hy_out; }
    else if (job == 6) { src = p.lru_in_w; ld = 2048; nsrc = 2048; K = 1024; npad = 2048; dst = p.wt_lru_in; }
    else if (job == 7) { src = p.lru_out_w; ld = 1024; nsrc = 1024; K = 1024; npad = 1024; dst = p.wt_lru_out; }
    else { int q = job - 8; int dg = q >> 2, n = q & 3;
      src = p.lru_gate_w + (size_t)(dg * 4 + n) * 65536; ld = 256; nsrc = 256; K = 256; npad = 256;
      dst = p.wt_lru_gate + (size_t)n * 1024 * 256 + (size_t)dg * 256 * 256; }
    int tiles_k = K / 64, tiles = tiles_k * (npad / 64);
    for (int t = bid; t < tiles; t += nblk) transpose_tile(src, ld, nsrc, dst, K, scale, t, tiles_k, tl, cxw);
  }
  for (int i = bid * NTHR + tidx; i < 2 * 2 * 1024; i += nblk * NTHR) p.knorm[i] = 0.f;
}

__device__ __forceinline__ void phase_mod(const Params& p, int bid, int nblk, unsigned char* smem, int cxw) {
  const int tidx = opaque_tid(cxw);
  float* sc = (float*)smem;
  float* red = sc + 5 * 1024;
  __syncthreads();
  for (int i = tidx; i < 5 * 1024; i += NTHR) {
    int r = i >> 10, k = i & 1023;
    float v = (r == 0) ? p.c_ctx[k] : p.c[(r - 1) * 1024 + k];
    sc[i] = siluf(v);
  }
  __syncthreads();
  const int cj = tidx & 31, kg = tidx >> 5;
  for (int item = bid; item < 4 * 96; item += nblk) {
    const int layer = item / 96, j = (item % 96) * 32 + cj;
    const float* w = p.mod_w + (size_t)layer * 1024 * 3072 + (size_t)kg * 128 * 3072 + j;
    const float* s0 = sc + kg * 128;
    float a0 = 0, a1 = 0, a2 = 0, a3 = 0, a4 = 0;
#pragma unroll 8
    for (int k = 0; k < 128; ++k) {
      float wv = w[(size_t)k * 3072];
      a0 += s0[k] * wv; a1 += s0[1024 + k] * wv; a2 += s0[2048 + k] * wv; a3 += s0[3072 + k] * wv; a4 += s0[4096 + k] * wv;
    }
    __syncthreads();
    red[(kg * 5 + 0) * 32 + cj] = a0; red[(kg * 5 + 1) * 32 + cj] = a1; red[(kg * 5 + 2) * 32 + cj] = a2;
    red[(kg * 5 + 3) * 32 + cj] = a3; red[(kg * 5 + 4) * 32 + cj] = a4;
    __syncthreads();
    if (tidx < 160) {
      const int rr = tidx >> 5, cc = tidx & 31;
      float sum = 0.f;
#pragma unroll
      for (int g8 = 0; g8 < 8; ++g8) sum += red[(g8 * 5 + rr) * 32 + cc];
      const int jj = (item % 96) * 32 + cc;
      p.modv[((size_t)layer * 5 + rr) * 3072 + jj] = sum + p.mod_b[layer * 3072 + jj];
    }
  }
}

__device__ __forceinline__ void phase_hyfilt_a(const Params& p, int bid, int nblk, unsigned char* smem, int cxw) {
  const int tidx = opaque_tid(cxw);
  float* sz = (float*)smem;
  float* sh = sz + 4 * 36;
  int pl = tidx >> 6, m = tidx & 63;
  for (int item = bid; item < 4352 / 4; item += nblk) {
    int pos = item * 4 + pl;
    int L = pos < 256 ? 256 : 4096;
    int l = pos < 256 ? pos : pos - 256;
    __syncthreads();
    if (m < 33) {
      float t = (float)l / (float)L;
      float w = (6.283185307179586f * (float)l) / (float)L;
      float v;
      if (m == 0) v = t;
      else {
        int j = (m - 1) & 15;
        float fr = 1e-4f + (float)j * ((15.f - 1e-4f) / 15.f);
        float ang = w * fr;
        v = (m <= 16) ? __cosf(ang) : __sinf(ang);
      }
      sz[pl * 36 + m] = v;
    }
    __syncthreads();
    float a = p.hy_f_b1[m];
    for (int e = 0; e < 33; ++e) a += sz[pl * 36 + e] * p.hy_f_w1[e * 64 + m];
    a = __sinf(p.hy_f_freq[m] * a);
    sh[pl * 64 + m] = a;
    __syncthreads();
    float b = p.hy_f_b2[m];
    for (int e = 0; e < 64; ++e) b += sh[pl * 64 + e] * p.hy_f_w2[e * 64 + m];
    b = __sinf(p.hy_f_freq[64 + m] * b);
    p.hdn2[(size_t)pos * 64 + m] = b;
  }
}

__device__ __forceinline__ void phase_hyfilt_b(const Params& p, int bid, int nblk, unsigned char* smem, int cxw) {
  const int tidx = opaque_tid(cxw);
  const int lane = tidx & 63;
  for (int item = bid; item < 17 * 64; item += nblk) {
    const int lb = item >> 6, chunk = item & 63;
    const int Lsel = lb ? 1 : 0, L = Lsel ? 4096 : 256, RL = Lsel ? 8192 : 512, Lm1 = L - 1;
    const int l = Lsel ? (lb - 1) * 256 + tidx : tidx;
    const int pos = Lsel ? 256 + l : l;
    float hd[64];
#pragma unroll
    for (int m4 = 0; m4 < 16; ++m4) {
      f32x4 v = *(const f32x4*)(p.hdn2 + (size_t)pos * 64 + m4 * 4);
      hd[m4 * 4] = v.x; hd[m4 * 4 + 1] = v.y; hd[m4 * 4 + 2] = v.z; hd[m4 * 4 + 3] = v.w;
    }
    const int odc0 = chunk * 64, o = odc0 >> 11, d = (odc0 >> 10) & 1, c0 = odc0 & 1023;
    const float t = (float)l / (float)L;
    bf16_t* rt = Lsel ? p.rtab1 : p.rtab0;
    const float min_decay = -3.0701134573253945f, max_decay = -15.350567286626973f;
    for (int cc = 0; cc < 64; ++cc) {
      const int c = c0 + cc;
      const float* w3 = p.hy_f_w3 + odc0 + cc;
      float acc = 0.f;
#pragma unroll
      for (int m = 0; m < 64; ++m) acc += hd[m] * w3[(size_t)m * 4096];
      float delta = fabsf(min_decay + (float)c * ((max_decay - min_decay) / 1023.f));
      float kv = acc * expf(-t * delta);
      size_t rb = (size_t)(o * 1024 + c) * RL;
      if (d == 0) rt[rb + Lm1 - l] = f2bf(kv);
      else if (l > 0) rt[rb + Lm1 + l] = f2bf(kv);
      else rt[rb + RL - 1] = 0;
      float a = fabsf(kv);
#pragma unroll
      for (int off = 32; off > 0; off >>= 1) a += shfl_xor_f(a, off, lane);
      if (lane == 0) atomicAdd(&p.knorm[(Lsel * 2 + o) * 1024 + c], a);
    }
  }
}

__device__ __forceinline__ void phase_lnmod(const Params& p, int layer, int bid, int nblk, int cxw) {
  const int tidx = opaque_tid(cxw);
  int lane = tidx & 63, wv = tidx >> 6;
  for (int row = bid * 4 + wv; row < T_ALL; row += nblk * 4) {
    const float* src = (layer == 0) ? (row < T_CTX ? p.x_prompt + (size_t)row * DM : p.x_sample + (size_t)(row - T_CTX) * DM)
                                    : p.xres + (size_t)row * DM;
    f32x4 v[4];
#pragma unroll
    for (int j = 0; j < 4; ++j) v[j] = *(const f32x4*)(src + j * 256 + lane * 4);
    if (layer > 0) {
      float s = 0.f;
#pragma unroll
      for (int j = 0; j < 4; ++j) s += v[j].x + v[j].y + v[j].z + v[j].w;
#pragma unroll
      for (int o = 32; o > 0; o >>= 1) s += shfl_xor_f(s, o, lane);
      float mu = s * (1.f / 1024.f);
      float q = 0.f;
#pragma unroll
      for (int j = 0; j < 4; ++j) { float a = v[j].x - mu, b = v[j].y - mu, c = v[j].z - mu, d = v[j].w - mu; q += a * a + b * b + c * c + d * d; }
#pragma unroll
      for (int o = 32; o > 0; o >>= 1) q += shfl_xor_f(q, o, lane);
      float rs = rsqrtf(q * (1.f / 1024.f) + LN_EPS);
      const float* g = p.ln_g + (layer - 1) * DM; const float* b = p.ln_b + (layer - 1) * DM;
#pragma unroll
      for (int j = 0; j < 4; ++j) {
        f32x4 gg = *(const f32x4*)(g + j * 256 + lane * 4), bb = *(const f32x4*)(b + j * 256 + lane * 4);
        v[j].x = (v[j].x - mu) * rs * gg.x + bb.x; v[j].y = (v[j].y - mu) * rs * gg.y + bb.y;
        v[j].z = (v[j].z - mu) * rs * gg.z + bb.z; v[j].w = (v[j].w - mu) * rs * gg.w + bb.w;
      }
    }
    float* dst = p.xres + (size_t)row * DM;
#pragma unroll
    for (int j = 0; j < 4; ++j) *(f32x4*)(dst + j * 256 + lane * 4) = v[j];
    if (layer < 4) {
      int mrow = row < T_CTX ? 0 : 1 + ((row - T_CTX) >> 12);
      const float* mv = p.modv + ((size_t)layer * 5 + mrow) * 3072;
#pragma unroll
      for (int j = 0; j < 4; ++j) {
        f32x4 sh = *(const f32x4*)(mv + j * 256 + lane * 4), sc = *(const f32x4*)(mv + 1024 + j * 256 + lane * 4);
        u32x2 o;
        o.x = pack2(v[j].x * (1.f + sc.x) + sh.x, v[j].y * (1.f + sc.y) + sh.y);
        o.y = pack2(v[j].z * (1.f + sc.z) + sh.z, v[j].w * (1.f + sc.w) + sh.w);
        *(u32x2*)(p.hbuf + (size_t)row * DM + j * 256 + lane * 4) = o;
      }
    }
  }
}

#define PG8_LAS __attribute__((address_space(3)))
namespace pg8 {
constexpr int BM = 256, BK = 64, HALF = 128, HTB = HALF * BK * 2, STAGE_BYTES = 8 * HTB, NXCD = 8, WGM = 8;
__device__ __forceinline__ int lds_byte(int r, int c) { const int st = (r >> 4) * 2 + (c >> 5), rr = r & 15, cc = c & 31, ob = rr * 64 + cc * 2; return st * 1024 + (ob ^ (((ob >> 9) & 1) << 5)); }
__device__ __forceinline__ void stage_rc(int b, int& R, int& C) { const int st = b / 1024, sb = b % 1024, swz = sb ^ (((sb >> 9) & 1) << 5); R = (st >> 1) * 16 + swz / 64; C = (st & 1) * 32 + (swz % 64) / 2; }
__device__ __forceinline__ int perm32(int rho) { const int n = rho >> 4, i = rho & 15; return 8 * (i >> 2) + 4 * n + (i & 3); }
struct Unit { int pm, pn; };
struct Gemm { const bf16_t* A; const bf16_t* Bt; int M, N, K, lda; int a_grp_shift; int a_grp_bytes; };
struct StaticOrder {
  int nM, nN, nwg, G, c;
  __device__ void init(int M, int N, int G_, int c_) { nM = M / BM; nN = N / BM; nwg = nM * nN; G = G_; c = c_; }
  __device__ bool next(int i, Unit& u) const {
    const long L = (long)i * G + c; if (L >= nwg) return false;
    int wgid = (int)L; { const int q = nwg / NXCD, r = nwg % NXCD, xcd = wgid % NXCD, off = wgid / NXCD; wgid = (xcd < r ? xcd * (q + 1) : r * (q + 1) + (xcd - r) * q) + off; }
    const int nig = WGM * nN, gid = wgid / nig, fm = gid * WGM, gsz = (nM - fm) < WGM ? (nM - fm) : WGM;
    u.pm = fm + ((wgid % nig) % gsz); u.pn = (wgid % nig) / gsz; return true;
  }
};
__device__ __forceinline__ unsigned cvt_pk_bf16(float lo, float hi) { return pack2(lo, hi); }

template <class Epi>
__device__ __forceinline__ void gemm_phase(PG8_LAS unsigned char* lds, const Gemm g, const StaticOrder& S, const Epi& E, int wave) {
  const int tid = opaque_tid512(wave), wid = wave, lane = tid & 63, wr = wid >> 2, wc = wid & 3, fr = lane & 15, fq = lane >> 4;
  const int K = g.K, nt = K / BK, lda = g.lda;
  unsigned voffA[2], voffB[2];
#pragma unroll
  for (int i = 0; i < 2; ++i) { int R, C; stage_rc(tid * 16 + i * 8192, R, C); const int Rb = Epi::PERM ? ((R & ~31) + perm32(R & 31)) : R;
    voffA[i] = (unsigned)(R * lda + C) * 2u; voffB[i] = (unsigned)(Rb * K + C) * 2u; }
  const size_t kstep = (size_t)(BK * 2);
  const size_t hstepA = (size_t)HALF * lda * 2, hstepB = (size_t)HALF * K * 2;
  const size_t tstepA = 2 * hstepA, tstepB = 2 * hstepB;
  const unsigned ldsw = (unsigned)wid * 1024u;
  const int aoff = lds_byte(wr * 64 + fr, fq * 8), boff = lds_byte(wc * 32 + fr, fq * 8);
#define PG8_SA(b, h) (((b) * 2 + (h)) * HTB)
#define PG8_SB(b, h) ((4 + (b) * 2 + (h)) * HTB)
#define PG8_STAGE(bufoff, gbase, voff) do { _Pragma("unroll") for (int _i = 0; _i < 2; ++_i) \
    __builtin_amdgcn_global_load_lds((const unsigned*)((const char*)(gbase) + (voff)[_i]), (PG8_LAS unsigned*)(lds + (bufoff) + ldsw + _i * 8192), 16, 0, 0); } while (0)
#define PG8_LDA(dst, b, h) do { _Pragma("unroll") for (int m = 0; m < 4; ++m) _Pragma("unroll") for (int k = 0; k < 2; ++k) dst[m][k] = *(const PG8_LAS bf16x8*)(lds + PG8_SA(b, h) + aoff + m * 2048 + k * 1024); } while (0)
#define PG8_LDB(dst, b, h) do { _Pragma("unroll") for (int n = 0; n < 2; ++n) _Pragma("unroll") for (int k = 0; k < 2; ++k) dst[n][k] = *(const PG8_LAS bf16x8*)(lds + PG8_SB(b, h) + boff + n * 2048 + k * 1024); } while (0)
#define PG8_MMA(ai, bj, At, Bt) do { __builtin_amdgcn_s_setprio(1); _Pragma("unroll") for (int m = 0; m < 4; ++m) _Pragma("unroll") for (int n = 0; n < 2; ++n) _Pragma("unroll") for (int k = 0; k < 2; ++k) \
    acc[ai][bj][m][n] = __builtin_amdgcn_mfma_f32_16x16x32_bf16(Bt[n][k], At[m][k], acc[ai][bj][m][n], 0, 0, 0); __builtin_amdgcn_s_setprio(0); } while (0)
#define PG8_WAIT_V(n) asm volatile("s_waitcnt vmcnt(" #n ")" ::: "memory")
#define PG8_WAIT_L(n) asm volatile("s_waitcnt lgkmcnt(" #n ")" ::: "memory")
#define PG8_BAR __builtin_amdgcn_s_barrier()
#define PG8_SCHED __builtin_amdgcn_sched_barrier(0)
#define PG8_APTR(u) ((const char*)g.A + (size_t)(u).pm * tstepA + (size_t)(((u).pn >> g.a_grp_shift) * g.a_grp_bytes))
  Unit cur, nxt; int ui = 0;
  if (!S.next(0, cur)) return;
  f32x4 acc[2][2][4][2];
#pragma unroll
  for (int a = 0; a < 2; ++a)
#pragma unroll
    for (int b = 0; b < 2; ++b)
#pragma unroll
      for (int m = 0; m < 4; ++m)
#pragma unroll
        for (int n = 0; n < 2; ++n) acc[a][b][m][n] = (f32x4){0.f, 0.f, 0.f, 0.f};
  bf16x8 At[4][2], B0[2][2], B1[2][2];
  const char* cA = PG8_APTR(cur); const char* cB = (const char*)g.Bt + (size_t)cur.pn * tstepB;
  PG8_STAGE(PG8_SB(0, 0), cB, voffB); PG8_STAGE(PG8_SA(0, 0), cA, voffA); PG8_STAGE(PG8_SB(0, 1), cB + hstepB, voffB); PG8_STAGE(PG8_SA(0, 1), cA + hstepA, voffA);
  if (wr == 1) PG8_BAR;
  PG8_WAIT_V(4); PG8_BAR;
  PG8_STAGE(PG8_SB(1, 0), cB + kstep, voffB); PG8_STAGE(PG8_SA(1, 0), cA + kstep, voffA); PG8_STAGE(PG8_SB(1, 1), cB + hstepB + kstep, voffB);
  PG8_WAIT_V(6); PG8_BAR;
  for (;;) {
    const bool has_next = S.next(ui + 1, nxt);
    const char* nA = has_next ? PG8_APTR(nxt) : cA; const char* nB = has_next ? (const char*)g.Bt + (size_t)nxt.pn * tstepB : cB;
    for (int t = 0; t < nt; t += 2) {
      const bool last = (t == nt - 2);
      const char* a1 = cA + (size_t)(t + 1) * kstep;
      const char* a2 = last ? nA : cA + (size_t)(t + 2) * kstep; const char* b2 = last ? nB : cB + (size_t)(t + 2) * kstep;
      const char* a3 = a2 + kstep; const char* b3 = b2 + kstep;
      PG8_LDB(B0, 0, 0); PG8_SCHED; PG8_LDA(At, 0, 0); PG8_STAGE(PG8_SA(1, 1), a1 + hstepA, voffA);
      PG8_WAIT_L(8); PG8_BAR; PG8_WAIT_L(0); PG8_MMA(0, 0, At, B0); PG8_BAR; PG8_SCHED;
      PG8_LDB(B1, 0, 1); PG8_STAGE(PG8_SB(0, 0), b2, voffB);
      PG8_BAR; PG8_WAIT_L(0); PG8_MMA(0, 1, At, B1); PG8_BAR;
      PG8_LDA(At, 0, 1); PG8_STAGE(PG8_SA(0, 0), a2, voffA);
      PG8_BAR; PG8_WAIT_L(0); PG8_MMA(1, 0, At, B0); PG8_BAR; PG8_SCHED;
      PG8_STAGE(PG8_SB(0, 1), b2 + hstepB, voffB);
      PG8_WAIT_V(6); PG8_BAR; PG8_MMA(1, 1, At, B1); PG8_BAR;
      PG8_LDB(B0, 1, 0); PG8_SCHED; PG8_LDA(At, 1, 0); PG8_STAGE(PG8_SA(0, 1), a2 + hstepA, voffA);
      PG8_WAIT_L(8); PG8_BAR; PG8_WAIT_L(0); PG8_MMA(0, 0, At, B0); PG8_BAR; PG8_SCHED;
      PG8_LDB(B1, 1, 1); PG8_STAGE(PG8_SB(1, 0), b3, voffB);
      PG8_BAR; PG8_WAIT_L(0); PG8_MMA(0, 1, At, B1); PG8_BAR;
      PG8_LDA(At, 1, 1); PG8_STAGE(PG8_SA(1, 0), a3, voffA);
      PG8_BAR; PG8_WAIT_L(0); PG8_MMA(1, 0, At, B0); PG8_BAR; PG8_SCHED;
      PG8_STAGE(PG8_SB(1, 1), b3 + hstepB, voffB);
      PG8_WAIT_V(6); PG8_BAR; PG8_MMA(1, 1, At, B1); PG8_BAR;
    }
    E(acc, cur, wr, wc, fr, fq);
    if (!has_next) break;
#pragma unroll
    for (int a = 0; a < 2; ++a)
#pragma unroll
      for (int b = 0; b < 2; ++b)
#pragma unroll
        for (int m = 0; m < 4; ++m)
#pragma unroll
          for (int n = 0; n < 2; ++n) acc[a][b][m][n] = (f32x4){0.f, 0.f, 0.f, 0.f};
    cur = nxt; cA = nA; cB = nB; ++ui;
  }
  PG8_WAIT_V(0);
  if (wr == 0) PG8_BAR;
  PG8_BAR;
#undef PG8_SA
#undef PG8_SB
#undef PG8_STAGE
#undef PG8_LDA
#undef PG8_LDB
#undef PG8_MMA
#undef PG8_WAIT_V
#undef PG8_WAIT_L
#undef PG8_BAR
#undef PG8_SCHED
#undef PG8_APTR
}

struct EpiBf16 {
  static constexpr bool PERM = true;
  bf16_t* O; size_t ldc;
  __device__ __forceinline__ void operator()(const f32x4 (&acc)[2][2][4][2], const Unit& u, int wr, int wc, int fr, int fq) const {
    const int row0 = u.pm * BM + wr * 64 + fr, col0 = u.pn * BM + wc * 32 + 8 * fq;
#pragma unroll
    for (int ai = 0; ai < 2; ++ai)
#pragma unroll
      for (int m = 0; m < 4; ++m) {
        bf16_t* rowp = O + (size_t)(row0 + ai * HALF + m * 16) * ldc + col0;
#pragma unroll
        for (int bj = 0; bj < 2; ++bj) {
          const f32x4 v0 = acc[ai][bj][m][0], v1 = acc[ai][bj][m][1];
          u32x4 w; w.x = pack2(v0[0], v0[1]); w.y = pack2(v0[2], v0[3]); w.z = pack2(v1[0], v1[1]); w.w = pack2(v1[2], v1[3]);
          *(u32x4*)(rowp + bj * HALF) = w;
        }
      }
  }
};
struct EpiSsdIn {
  static constexpr bool PERM = true;
  bf16_t* z; bf16_t* xbc; float* dt; const float* dt_bias;
  __device__ __forceinline__ void operator()(const f32x4 (&acc)[2][2][4][2], const Unit& u, int wr, int wc, int fr, int fq) const {
    const int row0 = u.pm * BM + wr * 64 + fr, colt = u.pn * BM + wc * 32 + 8 * fq;
    if (u.pn < 24) {
      bf16_t* base = u.pn < 8 ? z : xbc; const size_t ldc = u.pn < 8 ? 2048 : 4096; const int col0 = u.pn < 8 ? colt : colt - 2048;
#pragma unroll
      for (int ai = 0; ai < 2; ++ai)
#pragma unroll
        for (int m = 0; m < 4; ++m) {
          bf16_t* rowp = base + (size_t)(row0 + ai * HALF + m * 16) * ldc + col0;
#pragma unroll
          for (int bj = 0; bj < 2; ++bj) {
            const f32x4 v0 = acc[ai][bj][m][0], v1 = acc[ai][bj][m][1];
            u32x4 w; w.x = pack2(v0[0], v0[1]); w.y = pack2(v0[2], v0[3]); w.z = pack2(v1[0], v1[1]); w.w = pack2(v1[2], v1[3]);
            *(u32x4*)(rowp + bj * HALF) = w;
          }
        }
    } else {
      const int c0 = wc * 32 + 8 * fq;
      if (c0 < 64) {
#pragma unroll
        for (int ai = 0; ai < 2; ++ai)
#pragma unroll
          for (int m = 0; m < 4; ++m) {
            float* rowp = dt + (size_t)(row0 + ai * HALF + m * 16) * 64 + c0;
#pragma unroll
            for (int n = 0; n < 2; ++n) {
              const f32x4 v = acc[ai][0][m][n];
              f32x4 o;
#pragma unroll
              for (int e = 0; e < 4; ++e) o[e] = softplusf(v[e] + dt_bias[c0 + 4 * n + e]);
              *(f32x4*)(rowp + 4 * n) = o;
            }
          }
      }
    }
  }
};
struct EpiOut {
  static constexpr bool PERM = false;
  float* xres; const float* modv_layer; const float* rstd;
  __device__ __forceinline__ void operator()(const f32x4 (&acc)[2][2][4][2], const Unit& u, int wr, int wc, int fr, int fq) const {
    const int row0 = u.pm * BM + wr * 64 + fr, col0 = u.pn * BM + wc * 32 + 4 * fq;
#pragma unroll
    for (int ai = 0; ai < 2; ++ai)
#pragma unroll
      for (int m = 0; m < 4; ++m) {
        const int row = row0 + ai * HALF + m * 16;
        const int mrow = row < T_CTX ? 0 : 1 + ((row - T_CTX) >> 12);
        const float rs = rstd ? rstd[row] : 1.f;
        const float* gp = modv_layer + (size_t)mrow * 3072 + 2048 + col0;
        float* rowp = xres + (size_t)row * DM + col0;
#pragma unroll
        for (int bj = 0; bj < 2; ++bj)
#pragma unroll
          for (int n = 0; n < 2; ++n) {
            const f32x4 gv = *(const f32x4*)(gp + bj * HALF + n * 16);
            const f32x4 xv = *(const f32x4*)(rowp + bj * HALF + n * 16);
            *(f32x4*)(rowp + bj * HALF + n * 16) = ALPHA_RES * xv + gv * (acc[ai][bj][m][n] * rs);
          }
      }
  }
};
struct EpiLruGate {
  static constexpr bool PERM = true;
  bf16_t* gates; const float* gate_b;
  __device__ __forceinline__ void operator()(const f32x4 (&acc)[2][2][4][2], const Unit& u, int wr, int wc, int fr, int fq) const {
    const int nb = u.pn >> 2, dg = u.pn & 3;
    const int row0 = u.pm * BM + wr * 64 + fr, ch0 = nb * 256 + wc * 32 + 8 * fq;
#pragma unroll
    for (int ai = 0; ai < 2; ++ai)
#pragma unroll
      for (int m = 0; m < 4; ++m) {
        bf16_t* rowp = gates + ((size_t)dg * T_ALL + row0 + ai * HALF + m * 16) * 1024 + ch0;
#pragma unroll
        for (int bj = 0; bj < 2; ++bj) {
          const float* bp = gate_b + dg * 1024 + ch0 + bj * HALF;
          const f32x4 b0 = *(const f32x4*)bp, b1 = *(const f32x4*)(bp + 4);
          const f32x4 v0 = acc[ai][bj][m][0] + b0, v1 = acc[ai][bj][m][1] + b1;
          u32x4 w; w.x = pack2(sigmoidf(v0[0]), sigmoidf(v0[1])); w.y = pack2(sigmoidf(v0[2]), sigmoidf(v0[3]));
          w.z = pack2(sigmoidf(v1[0]), sigmoidf(v1[1])); w.w = pack2(sigmoidf(v1[2]), sigmoidf(v1[3]));
          *(u32x4*)(rowp + bj * HALF) = w;
        }
      }
  }
};
}

template <int KW, bool SILU>
__device__ __forceinline__ void phase_dwconv(const bf16_t* __restrict__ src, int ld_src, bf16_t* __restrict__ dst, int ld_dst, int CH,
                             const float* __restrict__ w, const float* __restrict__ b, bool colmajor, int bid, int nblk, int cxw) {
  const int tidx = opaque_tid(cxw);
  const int cpr = CH / 8;
  const size_t total = (size_t)T_ALL * cpr;
  for (size_t idx = (size_t)bid * NTHR + tidx; idx < total; idx += (size_t)nblk * NTHR) {
    int tok = (int)(idx / cpr), c0 = (int)(idx % cpr) * 8;
    TokInfo ti = tokinfo(tok);
    bool cm = colmajor && ti.s >= 32;
    int pos = seqpos2off(ti.l, cm);
    float acc[8];
#pragma unroll
    for (int e = 0; e < 8; ++e) acc[e] = b[c0 + e];
#pragma unroll
    for (int k = 0; k < KW; ++k) {
      int pp = pos + k - 1;
      if (pp < 0 || pp >= ti.L) continue;
      int tk = ti.base + seqpos2off(pp, cm);
      u32x4 xv = *(const u32x4*)(src + (size_t)tk * ld_src + c0);
      const float* wk = w + (size_t)k * CH + c0;
      acc[0] += wk[0] * bflo(xv.x); acc[1] += wk[1] * bfhi(xv.x);
      acc[2] += wk[2] * bflo(xv.y); acc[3] += wk[3] * bfhi(xv.y);
      acc[4] += wk[4] * bflo(xv.z); acc[5] += wk[5] * bfhi(xv.z);
      acc[6] += wk[6] * bflo(xv.w); acc[7] += wk[7] * bfhi(xv.w);
    }
    if (SILU) {
#pragma unroll
      for (int e = 0; e < 8; ++e) acc[e] = siluf(acc[e]);
    }
    u32x4 o;
    o.x = pack2(acc[0], acc[1]); o.y = pack2(acc[2], acc[3]); o.z = pack2(acc[4], acc[5]); o.w = pack2(acc[6], acc[7]);
    *(u32x4*)(dst + (size_t)tok * ld_dst + c0) = o;
  }
}

__device__ __forceinline__ void phase_ssd_conv(const Params& p, int slot, bool colmajor, int bid, int nblk, unsigned char* smem, int cxw) {
  const int tid = opaque_tid(cxw);
  const bf16_t* raw = (const bf16_t*)(p.scratch + SC_SSD_XBC);
  bf16_t* out = (bf16_t*)(p.scratch + SC_SSD_XBCC);
  bf16_t* XT = (bf16_t*)(p.scratch + SC_SSD_XT);
  bf16_t* BT = (bf16_t*)(p.scratch + SC_SSD_BT);
  const float* cw = p.ssd_conv_w + (size_t)slot * 4 * 4096;
  const float* cb = p.ssd_conv_b + slot * 4096;
  bf16_t* tl = (bf16_t*)smem;
  for (int item = bid; item < 384 * 64; item += nblk) {
    const int ptile = item >> 6, ct = item & 63;
    const int ptok0 = ptile * 64;
    TokInfo ti = tokinfo(ptok0);
    const bool cm = colmajor && ti.s >= 32;
    const int rr = tid >> 2, cpart = tid & 3;
    const int ch = ct * 64 + cpart * 16;
    const int pos = ti.l + rr;
    float acc[16];
#pragma unroll
    for (int e = 0; e < 16; ++e) acc[e] = cb[ch + e];
#pragma unroll
    for (int k = 0; k < 4; ++k) {
      int pp = pos + k - 1;
      if (pp < 0 || pp >= ti.L) continue;
      int tk = ti.base + seqpos2off(pp, cm);
      const bf16_t* rp = raw + (size_t)tk * 4096 + ch;
      u32x4 x0 = *(const u32x4*)rp, x1 = *(const u32x4*)(rp + 8);
      const float* wk = cw + (size_t)k * 4096 + ch;
      unsigned xw[8] = {x0.x, x0.y, x0.z, x0.w, x1.x, x1.y, x1.z, x1.w};
#pragma unroll
      for (int e = 0; e < 8; ++e) { acc[2 * e] += wk[2 * e] * bflo(xw[e]); acc[2 * e + 1] += wk[2 * e + 1] * bfhi(xw[e]); }
    }
    u32x4 o0, o1;
    o0.x = pack2(siluf(acc[0]), siluf(acc[1])); o0.y = pack2(siluf(acc[2]), siluf(acc[3]));
    o0.z = pack2(siluf(acc[4]), siluf(acc[5])); o0.w = pack2(siluf(acc[6]), siluf(acc[7]));
    o1.x = pack2(siluf(acc[8]), siluf(acc[9])); o1.y = pack2(siluf(acc[10]), siluf(acc[11]));
    o1.z = pack2(siluf(acc[12]), siluf(acc[13])); o1.w = pack2(siluf(acc[14]), siluf(acc[15]));
    bf16_t* op = out + (size_t)(ptok0 + rr) * 4096 + ch;
    *(u32x4*)op = o0; *(u32x4*)(op + 8) = o1;
    __syncthreads();
    *(u32x4*)(tl + rr * 72 + cpart * 16) = o0;
    *(u32x4*)(tl + rr * 72 + cpart * 16 + 8) = o1;
    __syncthreads();
    if (ct < 48) {
      const int crow = tid >> 2, part = tid & 3;
      unsigned wv[8];
#pragma unroll
      for (int e = 0; e < 8; ++e) {
        unsigned lo = tl[(part * 16 + 2 * e) * 72 + crow], hi = tl[(part * 16 + 2 * e + 1) * 72 + crow];
        wv[e] = lo | (hi << 16);
      }
      const int chg = ct * 64 + crow;
      bf16_t* dp = (chg < 2048 ? XT + (size_t)chg * T_ALL : BT + (size_t)(chg - 2048) * T_ALL) + ptok0 + part * 16;
      u32x4 t0, t1;
      t0.x = wv[0]; t0.y = wv[1]; t0.z = wv[2]; t0.w = wv[3]; t1.x = wv[4]; t1.y = wv[5]; t1.z = wv[6]; t1.w = wv[7];
      *(u32x4*)dp = t0; *(u32x4*)(dp + 8) = t1;
    }
  }
}

#define SH_STRIDE 136
__device__ __forceinline__ int rowmap(int e, int hh) { return (e & 3) + 8 * (e >> 2) + 4 * hh; }
__device__ __forceinline__ bf16x8 pack8(float a0, float a1, float a2, float a3, float a4, float a5, float a6, float a7) {
  u32x4 v; v.x = pack2(a0, a1); v.y = pack2(a2, a3); v.z = pack2(a4, a5); v.w = pack2(a6, a7);
  return __builtin_bit_cast(bf16x8, v);
}
__device__ __forceinline__ void phase_ssd_scan(const Params& p, int slot, bool colmajor, int bid, int nblk, unsigned char* smem, int cxw) {
  const int tid = opaque_tid(cxw), lane = tid & 63, w = tid >> 6, r = lane & 31, hh = lane >> 5;
  const int it = w >> 1, pt = w & 1;
  const bf16_t* xbcc = (const bf16_t*)(p.scratch + SC_SSD_XBCC);
  const bf16_t* XT = (const bf16_t*)(p.scratch + SC_SSD_XT);
  const bf16_t* BT = (const bf16_t*)(p.scratch + SC_SSD_BT);
  const float* dtb = (const float*)(p.scratch + SC_SSD_DT);
  bf16_t* ybuf = (bf16_t*)(p.scratch + SC_SSD_XBC);
  bf16_t* sXr = (bf16_t*)smem;
  bf16_t* sXs = sXr + 64 * 72;
  bf16_t* sH = sXs + 64 * 72;
  float* sW = (float*)(sH + 2 * 64 * SH_STRIDE);
  float* myW = sW + w * 256;
  for (int item = bid; item < 36 * 64; item += nblk) {
    int s, h, dir;
    if (item < 256) { s = 32 + (item >> 6); h = (item & 63) >> 1; dir = item & 1; }
    else { int itx = item - 256; s = itx >> 6; h = (itx & 63) >> 1; dir = itx & 1; }
    const int L = s < 32 ? 256 : 4096;
    const int base = s < 32 ? s * 256 : T_CTX + (s - 32) * 4096;
    const bool cm = colmajor && s >= 32;
    const int g = h >> 2;
    const float Aval = -expf(p.ssd_a_log[(slot * 2 + dir) * 32 + h]);
    const int nchunks = L >> 6;
    const int pcol = 32 * pt + r;
    f32x16 hacc[2];
    if (s >= 32) {
      const float* h0 = p.state_ssd + ((((size_t)(s - 32) * 2 + slot) * 2 + dir) * 32 + h) * 8192 + (size_t)pcol * 128;
#pragma unroll
      for (int t2 = 0; t2 < 2; ++t2)
#pragma unroll
        for (int qd = 0; qd < 4; ++qd) {
          f32x4 v = *(const f32x4*)(h0 + 32 * (2 * it + t2) + 8 * qd + 4 * hh);
          hacc[t2][4 * qd] = v.x; hacc[t2][4 * qd + 1] = v.y; hacc[t2][4 * qd + 2] = v.z; hacc[t2][4 * qd + 3] = v.w;
        }
    } else {
#pragma unroll
      for (int t2 = 0; t2 < 2; ++t2)
#pragma unroll
        for (int e = 0; e < 16; ++e) hacc[t2][e] = 0.f;
    }
#pragma unroll
    for (int t2 = 0; t2 < 2; ++t2)
#pragma unroll
      for (int qd = 0; qd < 4; ++qd) {
        u32x2 o; o.x = pack2(hacc[t2][4 * qd], hacc[t2][4 * qd + 1]); o.y = pack2(hacc[t2][4 * qd + 2], hacc[t2][4 * qd + 3]);
        *(u32x2*)(sH + pcol * SH_STRIDE + 32 * (2 * it + t2) + 8 * qd + 4 * hh) = o;
      }
    float dtv; u32x4 xtr[2]; bf16x8 cfr[8], bfr[2][8], btf[2][4];
    const bool need0 = dir == 0 ? true : (it == 0);
    const bool need1 = dir == 0 ? (it == 1) : true;
#define SCAN_PTOK(c) (base + 64 * (dir ? nchunks - 1 - (c) : (c)))
#define SCAN_LOAD_DTX(pt0) do { \
      const int tok_ = base + seqpos2off((pt0) - base + lane, cm); \
      dtv = dtb[(size_t)tok_ * 64 + dir * 32 + h]; \
      _Pragma("unroll") for (int i_ = 0; i_ < 2; ++i_) { const int q_ = tid + i_ * 256; \
        xtr[i_] = *(const u32x4*)(XT + (size_t)(h * 64 + (q_ >> 3)) * T_ALL + (pt0) + (q_ & 7) * 8); } } while (0)
#define SCAN_LOAD_CB(pt0) do { \
      const bf16_t* crow_ = xbcc + (size_t)((pt0) + 32 * it + r) * 4096 + 3072 + g * 128 + 8 * hh; \
      _Pragma("unroll") for (int kk = 0; kk < 8; ++kk) cfr[kk] = *(const bf16x8*)(crow_ + 16 * kk); \
      if (need0) { const bf16_t* br_ = xbcc + (size_t)((pt0) + r) * 4096 + 2048 + g * 128 + 8 * hh; \
        _Pragma("unroll") for (int kk = 0; kk < 8; ++kk) bfr[0][kk] = *(const bf16x8*)(br_ + 16 * kk); } \
      if (need1) { const bf16_t* br_ = xbcc + (size_t)((pt0) + 32 + r) * 4096 + 2048 + g * 128 + 8 * hh; \
        _Pragma("unroll") for (int kk = 0; kk < 8; ++kk) bfr[1][kk] = *(const bf16x8*)(br_ + 16 * kk); } } while (0)
#define SCAN_LOAD_BT(pt0) do { \
      _Pragma("unroll") for (int t2 = 0; t2 < 2; ++t2) { \
        const bf16_t* bt_ = BT + (size_t)(g * 128 + 32 * (2 * it + t2) + r) * T_ALL + (pt0) + 8 * hh; \
        _Pragma("unroll") for (int kk = 0; kk < 4; ++kk) btf[t2][kk] = *(const bf16x8*)(bt_ + 16 * kk); } } while (0)
    {
      const int p0 = SCAN_PTOK(0);
      SCAN_LOAD_DTX(p0); SCAN_LOAD_CB(p0); SCAN_LOAD_BT(p0);
    }
    for (int ci = 0; ci < nchunks; ++ci) {
      const int ptok0 = SCAN_PTOK(ci);
      const int cin = ci + 1 < nchunks ? ci + 1 : ci;
      const int ptokN = SCAN_PTOK(cin);
      const int buf = ci & 1;
      __syncthreads();
      float decE;
      {
        float c = dtv * Aval;
        if (dir == 0) {
#pragma unroll
          for (int off = 1; off < 64; off <<= 1) { float t = shfl_idx_f(c, lane - off); if (lane >= off) c += t; }
        } else {
#pragma unroll
          for (int off = 1; off < 64; off <<= 1) { float t = shfl_idx_f(c, lane + off); if (lane + off < 64) c += t; }
        }
        const float cE = shfl_idx_f(c, dir ? 0 : 63);
        myW[lane] = dtv; myW[64 + lane] = c; myW[128 + lane] = __expf(c); myW[192 + lane] = dtv * __expf(cE - c);
        decE = __expf(cE);
      }
#pragma unroll
      for (int i = 0; i < 2; ++i) {
        const int q = tid + i * 256, prow = q >> 3, j8 = (q & 7) * 8;
        const u32x4 raw = xtr[i];
        *(u32x4*)(sXr + prow * 72 + j8) = raw;
        f32x4 f0 = *(const f32x4*)(myW + 192 + j8), f1 = *(const f32x4*)(myW + 192 + j8 + 4);
        u32x4 sc;
        sc.x = pack2(bflo(raw.x) * f0.x, bfhi(raw.x) * f0.y); sc.y = pack2(bflo(raw.y) * f0.z, bfhi(raw.y) * f0.w);
        sc.z = pack2(bflo(raw.z) * f1.x, bfhi(raw.z) * f1.y); sc.w = pack2(bflo(raw.w) * f1.z, bfhi(raw.w) * f1.w);
        *(u32x4*)(sXs + prow * 72 + j8) = sc;
      }
      __syncthreads();
      SCAN_LOAD_DTX(ptokN);
#pragma unroll
      for (int t2 = 0; t2 < 2; ++t2) {
#pragma unroll
        for (int e = 0; e < 16; ++e) hacc[t2][e] *= decE;
        const bf16_t* xs = sXs + pcol * 72 + 8 * hh;
#pragma unroll
        for (int kk = 0; kk < 4; ++kk)
          hacc[t2] = __builtin_amdgcn_mfma_f32_32x32x16_bf16(btf[t2][kk], *(const bf16x8*)(xs + 16 * kk), hacc[t2], 0, 0, 0);
#pragma unroll
        for (int qd = 0; qd < 4; ++qd) {
          u32x2 o; o.x = pack2(hacc[t2][4 * qd], hacc[t2][4 * qd + 1]); o.y = pack2(hacc[t2][4 * qd + 2], hacc[t2][4 * qd + 3]);
          *(u32x2*)(sH + (buf ^ 1) * 64 * SH_STRIDE + pcol * SH_STRIDE + 32 * (2 * it + t2) + 8 * qd + 4 * hh) = o;
        }
      }
      f32x16 acc;
#pragma unroll
      for (int e = 0; e < 16; ++e) acc[e] = 0.f;
      {
        const bf16_t* hp = sH + buf * 64 * SH_STRIDE + pcol * SH_STRIDE + 8 * hh;
#pragma unroll
        for (int kk = 0; kk < 8; ++kk) acc = __builtin_amdgcn_mfma_f32_32x32x16_bf16(cfr[kk], *(const bf16x8*)(hp + 16 * kk), acc, 0, 0, 0);
      }
#pragma unroll
      for (int qd = 0; qd < 4; ++qd) {
        f32x4 ec = *(const f32x4*)(myW + 128 + 32 * it + 8 * qd + 4 * hh);
        acc[4 * qd] *= ec.x; acc[4 * qd + 1] *= ec.y; acc[4 * qd + 2] *= ec.z; acc[4 * qd + 3] *= ec.w;
      }
      const int icol = 32 * it + r;
      const float ci_ = myW[64 + icol];
#pragma unroll
      for (int jt = 0; jt < 2; ++jt) {
        const bool needed = jt == 0 ? need0 : need1;
        if (needed) {
          f32x16 X;
#pragma unroll
          for (int e = 0; e < 16; ++e) X[e] = 0.f;
#pragma unroll
          for (int kk = 0; kk < 8; ++kk) X = __builtin_amdgcn_mfma_f32_32x32x16_bf16(bfr[jt][kk], cfr[kk], X, 0, 0, 0);
#pragma unroll
          for (int qd = 0; qd < 4; ++qd) {
            const int j0 = 32 * jt + 8 * qd + 4 * hh;
            f32x4 cj = *(const f32x4*)(myW + 64 + j0), dj = *(const f32x4*)(myW + j0);
            float cjv[4] = {cj.x, cj.y, cj.z, cj.w}, djv[4] = {dj.x, dj.y, dj.z, dj.w};
#pragma unroll
            for (int u = 0; u < 4; ++u) {
              const int j = j0 + u;
              const bool ok = dir == 0 ? (j <= icol) : (j >= icol);
              const float m = __expf(ci_ - cjv[u]) * djv[u];
              X[4 * qd + u] = ok ? X[4 * qd + u] * m : 0.f;
            }
          }
#pragma unroll
          for (int sk = 0; sk < 2; ++sk) {
            bf16x8 afr = pack8(X[8 * sk], X[8 * sk + 1], X[8 * sk + 2], X[8 * sk + 3], X[8 * sk + 4], X[8 * sk + 5], X[8 * sk + 6], X[8 * sk + 7]);
            const bf16_t* xp = sXr + pcol * 72 + 32 * jt + 16 * sk + 4 * hh;
            u32x2 lo = *(const u32x2*)xp, hi = *(const u32x2*)(xp + 8);
            u32x4 xv; xv.x = lo.x; xv.y = lo.y; xv.z = hi.x; xv.w = hi.y;
            acc = __builtin_amdgcn_mfma_f32_32x32x16_bf16(afr, __builtin_bit_cast(bf16x8, xv), acc, 0, 0, 0);
          }
        }
      }
      SCAN_LOAD_CB(ptokN);
      {
        bf16_t* yo = ybuf + ((size_t)dir * T_ALL + ptok0 + 32 * it) * 2048 + h * 64 + pcol;
#pragma unroll
        for (int e = 0; e < 16; ++e) yo[(size_t)rowmap(e, hh) * 2048] = f2bf(acc[e]);
      }
      SCAN_LOAD_BT(ptokN);
    }
#undef SCAN_PTOK
#undef SCAN_LOAD_DTX
#undef SCAN_LOAD_CB
#undef SCAN_LOAD_BT
    if (s < 32) {
      float* ho = p.out_ssd + ((((size_t)s * 2 + slot) * 2 + dir) * 32 + h) * 8192 + (size_t)pcol * 128;
#pragma unroll
      for (int t2 = 0; t2 < 2; ++t2)
#pragma unroll
        for (int qd = 0; qd < 4; ++qd) {
          f32x4 v; v.x = hacc[t2][4 * qd]; v.y = hacc[t2][4 * qd + 1]; v.z = hacc[t2][4 * qd + 2]; v.w = hacc[t2][4 * qd + 3];
          *(f32x4*)(ho + 32 * (2 * it + t2) + 8 * qd + 4 * hh) = v;
        }
    }
    __syncthreads();
  }
}

__device__ __forceinline__ void phase_ssd_gate(const Params& p, int slot, int bid, int nblk, int cxw) {
  const int tidx = opaque_tid(cxw);
  bf16_t* zb = (bf16_t*)(p.scratch + SC_SSD_Z);
  const bf16_t* yfb = (const bf16_t*)(p.scratch + SC_SSD_XBC);
  const bf16_t* ybb = yfb + (size_t)T_ALL * 2048;
  const bf16_t* xbcc = (const bf16_t*)(p.scratch + SC_SSD_XBCC);
  int lane = tidx & 63, wv = tidx >> 6;
  for (int row = bid * 4 + wv; row < T_ALL; row += nblk * 4) {
    float ss = 0.f;
    TokInfo ti = tokinfo(row);
    const int prow = ti.base + seqpos2off(ti.l, slot == 1 && ti.s >= 32);
#pragma unroll
    for (int j = 0; j < 4; ++j) {
      int c0 = j * 512 + lane * 8;
      u32x4 zv = *(const u32x4*)(zb + (size_t)row * 2048 + c0);
      u32x4 fv = *(const u32x4*)(yfb + (size_t)prow * 2048 + c0);
      u32x4 bv = *(const u32x4*)(ybb + (size_t)prow * 2048 + c0);
      u32x4 xv = *(const u32x4*)(xbcc + (size_t)prow * 4096 + c0);
      float dsk = p.ssd_d[slot * 32 + (c0 >> 6)];
      unsigned zw[4] = {zv.x, zv.y, zv.z, zv.w}, fw[4] = {fv.x, fv.y, fv.z, fv.w}, bw[4] = {bv.x, bv.y, bv.z, bv.w}, xw[4] = {xv.x, xv.y, xv.z, xv.w};
      unsigned ow[4];
#pragma unroll
      for (int e = 0; e < 4; ++e) {
        float y0 = (bflo(fw[e]) + bflo(bw[e]) + dsk * bflo(xw[e])) * siluf(bflo(zw[e]));
        float y1 = (bfhi(fw[e]) + bfhi(bw[e]) + dsk * bfhi(xw[e])) * siluf(bfhi(zw[e]));
        ss += y0 * y0 + y1 * y1;
        ow[e] = pack2(y0, y1);
      }
      u32x4 o; o.x = ow[0]; o.y = ow[1]; o.z = ow[2]; o.w = ow[3];
      *(u32x4*)(zb + (size_t)row * 2048 + c0) = o;
    }
#pragma unroll
    for (int o = 32; o > 0; o >>= 1) ss += shfl_xor_f(ss, o, lane);
    if (lane == 0) p.rstd[row] = rsqrtf(ss * (1.f / 2048.f) + 1e-5f);
  }
}

#define HY_UOFF 32768
__device__ __forceinline__ void hy_stage_conv(const Params& p, const bf16_t* __restrict__ row, int ch, bf16_t* dst, int dstStride, int dstPad,
                                              int nelem, int L, int tid) {
  const float w0 = p.hy_conv_w[ch], w1 = p.hy_conv_w[3072 + ch], w2 = p.hy_conv_w[2 * 3072 + ch], bb = p.hy_conv_b[ch];
  for (int q = tid; q < nelem / 8; q += NTHR) {
    const int e0 = q * 8, b = e0 / L, t0 = e0 & (L - 1);
    u32x4 raw = *(const u32x4*)(row + e0);
    float x[10];
    x[0] = t0 > 0 ? bf2f(row[e0 - 1]) : 0.f;
    x[9] = t0 + 8 < L ? bf2f(row[e0 + 8]) : 0.f;
    x[1] = bflo(raw.x); x[2] = bfhi(raw.x); x[3] = bflo(raw.y); x[4] = bfhi(raw.y);
    x[5] = bflo(raw.z); x[6] = bfhi(raw.z); x[7] = bflo(raw.w); x[8] = bfhi(raw.w);
    float o[8];
#pragma unroll
    for (int j = 0; j < 8; ++j) o[j] = w0 * x[j] + w1 * x[j + 1] + w2 * x[j + 2] + bb;
    u32x4 ov; ov.x = pack2(o[0], o[1]); ov.y = pack2(o[2], o[3]); ov.z = pack2(o[4], o[5]); ov.w = pack2(o[6], o[7]);
    *(u32x4*)(dst + b * dstStride + dstPad + t0) = ov;
  }
}

__device__ __forceinline__ void phase_hy_longconv(const Params& p, int bid, int nblk, unsigned char* smem, int cxw) {
  const int tid = opaque_tid(cxw), lane = tid & 63, w = tid >> 6, r = lane & 31, hh = lane >> 5;
  const bf16_t* projT = (const bf16_t*)(p.scratch + SC_HY_PROJT);
  bf16_t* yT = (bf16_t*)(p.scratch + SC_HY_YT);
  unsigned* Rc0 = (unsigned*)smem;
  unsigned* Rc1 = Rc0 + 4096;
  bf16_t* G = (bf16_t*)smem;
  bf16_t* U = (bf16_t*)(smem + HY_UOFF);
  for (int item = bid; item < 2048; item += nblk) {
    const bool lat = item < 1024;
    const int c = item & 1023;
    const int L = lat ? 4096 : 256, NB = lat ? 4 : 32, RL = lat ? 8192 : 512, Lm1 = L - 1;
    const int PAD = lat ? 224 : 0, US = L + 2 * PAD;
    const int tokbase = lat ? T_CTX : 0;
    const int nI = L >> 5, nelem = NB * L;
    const int TPW = lat ? 4 : 2;
    __syncthreads();
    if (lat) {
      for (int q = tid; q < 4 * 56; q += NTHR) {
        int b = q / 56, k = q % 56;
        int off = k < 28 ? k * 8 : 224 + 4096 + (k - 28) * 8;
        unsigned zz = 0u; asm volatile("" : "+v"(zz));
        u32x4 z4 = {zz, zz, zz, zz};
        *(u32x4*)(U + b * US + off) = z4;
      }
    }
    hy_stage_conv(p, projT + (size_t)c * T_ALL + tokbase, c, U, US, PAD, nelem, L, tid);
    int Icol[4], bcol[4];
#pragma unroll
    for (int tt = 0; tt < 4; ++tt) {
      int n = (w * TPW + tt) * 32 + r;
      Icol[tt] = lat ? (n >> 2) : (n >> 5);
      bcol[tt] = lat ? (n & 3) : (n & 31);
    }
    const int Ilo_w = lat ? 32 * w : 2 * w, Ihi_w = lat ? 32 * w + 31 : 2 * w + 1;
    const int dlo = Ilo_w - (nI - 1), dhi = Ihi_w;
    for (int order = 0; order < 2; ++order) {
      {
        const bf16_t* src = (lat ? p.rtab1 : p.rtab0) + (size_t)(order * 1024 + c) * RL;
        for (int q = tid; q < RL / 8; q += NTHR) {
          u32x4 cv = *(const u32x4*)(src + q * 8);
          unsigned nx = (q + 1 < RL / 8) ? *(const unsigned*)(src + q * 8 + 8) : 0u;
          *(u32x4*)(Rc0 + q * 4) = cv;
          u32x4 sv;
          sv.x = (cv.x >> 16) | (cv.y << 16); sv.y = (cv.y >> 16) | (cv.z << 16);
          sv.z = (cv.z >> 16) | (cv.w << 16); sv.w = (cv.w >> 16) | (nx << 16);
          *(u32x4*)(Rc1 + q * 4) = sv;
        }
      }
      __syncthreads();
      f32x16 acc[4];
#pragma unroll
      for (int tt = 0; tt < 4; ++tt)
#pragma unroll
        for (int e = 0; e < 16; ++e) acc[tt][e] = 0.f;
      for (int d = dlo; d <= dhi; ++d) {
#pragma unroll
        for (int kk = 0; kk < 2; ++kk) {
          const int y0 = Lm1 - 32 * d - r + 16 * kk + 8 * hh;
          const int par = y0 & 1;
          const unsigned* rp = (par ? Rc1 : Rc0) + ((y0 - par) >> 1);
          u32x4 av; av.x = rp[0]; av.y = rp[1]; av.z = rp[2]; av.w = rp[3];
          bf16x8 af = __builtin_bit_cast(bf16x8, av);
#pragma unroll
          for (int tt = 0; tt < 4; ++tt) {
            if (tt < TPW) {
              const int tile = w * TPW + tt;
              const int Ilo_t = lat ? 8 * tile : tile, Ihi_t = lat ? 8 * tile + 7 : tile;
              if (d >= Ilo_t - (nI - 1) && d <= Ihi_t) {
                const bf16_t* bp = U + bcol[tt] * US + PAD + 32 * (Icol[tt] - d) + 16 * kk + 8 * hh;
                bf16x8 bfr = *(const bf16x8*)bp;
                acc[tt] = __builtin_amdgcn_mfma_f32_32x32x16_bf16(af, bfr, acc[tt], 0, 0, 0);
              }
            }
          }
        }
      }
      __syncthreads();
      hy_stage_conv(p, projT + (size_t)((1 + order) * 1024 + c) * T_ALL + tokbase, (1 + order) * 1024 + c, G, L, 0, nelem, L, tid);
      __syncthreads();
      const float inv = 1.f / p.knorm[((lat ? 1 : 0) * 2 + order) * 1024 + c];
      const float bias = p.hy_f_bias[order * 1024 + c];
#pragma unroll
      for (int tt = 0; tt < 4; ++tt) {
        if (tt < TPW) {
#pragma unroll
          for (int qd = 0; qd < 4; ++qd) {
            const int t0 = 32 * Icol[tt] + 8 * qd + 4 * hh;
            bf16_t* up = U + bcol[tt] * US + PAD + t0;
            u32x2 uc = *(const u32x2*)up;
            u32x2 gg = *(const u32x2*)(G + bcol[tt] * L + t0);
            float r0 = (inv * acc[tt][4 * qd] + bias * bflo(uc.x)) * bflo(gg.x);
            float r1 = (inv * acc[tt][4 * qd + 1] + bias * bfhi(uc.x)) * bfhi(gg.x);
            float r2 = (inv * acc[tt][4 * qd + 2] + bias * bflo(uc.y)) * bflo(gg.y);
            float r3 = (inv * acc[tt][4 * qd + 3] + bias * bfhi(uc.y)) * bfhi(gg.y);
            if (order == 1) {
              u32x2 zz = *(const u32x2*)(projT + (size_t)(3072 + c) * T_ALL + tokbase + bcol[tt] * L + t0);
              r0 *= siluf(bflo(zz.x)); r1 *= siluf(bfhi(zz.x)); r2 *= siluf(bflo(zz.y)); r3 *= siluf(bfhi(zz.y));
            }
            u32x2 ov; ov.x = pack2(r0, r1); ov.y = pack2(r2, r3);
            *(u32x2*)up = ov;
          }
        }
      }
      __syncthreads();
    }
    for (int q = tid; q < nelem / 8; q += NTHR) {
      const int e0 = q * 8, b = e0 / L, t0 = e0 & (L - 1);
      *(u32x4*)(yT + (size_t)c * T_ALL + tokbase + e0) = *(const u32x4*)(U + b * US + PAD + t0);
    }
  }
}

__device__ __forceinline__ void phase_hy_transpose(const Params& p, int bid, int nblk, unsigned char* smem, int cxw) {
  const int tid = opaque_tid(cxw);
  const bf16_t* yT = (const bf16_t*)(p.scratch + SC_HY_YT);
  bf16_t* yg = (bf16_t*)(p.scratch + SC_HY_YG);
  bf16_t* tl = (bf16_t*)smem;
  for (int item = bid; item < 16 * (T_ALL / 64); item += nblk) {
    const int cb = item & 15, tb = item >> 4;
    __syncthreads();
#pragma unroll
    for (int i = 0; i < 2; ++i) {
      int q = tid + i * 256, cr = q >> 3, t8 = (q & 7) * 8;
      u32x4 v = *(const u32x4*)(yT + (size_t)(cb * 64 + cr) * T_ALL + tb * 64 + t8);
      unsigned wv[4] = {v.x, v.y, v.z, v.w};
#pragma unroll
      for (int e = 0; e < 4; ++e) {
        tl[(t8 + 2 * e) * 72 + cr] = (bf16_t)(wv[e] & 0xffffu);
        tl[(t8 + 2 * e + 1) * 72 + cr] = (bf16_t)(wv[e] >> 16);
      }
    }
    __syncthreads();
#pragma unroll
    for (int i = 0; i < 2; ++i) {
      int q = tid + i * 256, tr = q >> 3, c8 = (q & 7) * 8;
      *(u32x4*)(yg + (size_t)(tb * 64 + tr) * 1024 + cb * 64 + c8) = *(const u32x4*)(tl + tr * 72 + c8);
    }
  }
}

__device__ __forceinline__ void lru_ab(const bf16_t* gates, const bf16_t* xc, int dir, int tok, int c, float sp, float& a, float& bx) {
  float r = bf2f(gates[((size_t)(dir * 2 + 0) * T_ALL + tok) * 1024 + c]);
  float i = bf2f(gates[((size_t)(dir * 2 + 1) * T_ALL + tok) * 1024 + c]);
  float x = bf2f(xc[(size_t)tok * 1024 + c]);
  float log_a = -8.f * r * sp;
  a = __expf(log_a);
  float m = sqrtf(fmaxf(1.f - __expf(2.f * log_a), 0.f));
  bx = m * i * x;
}
__device__ __forceinline__ void phase_lru_scan_chunks(const Params& p, int pass, int bid, int nblk, int cxw) {
  const int tidx = opaque_tid(cxw);
  const bf16_t* gates = (const bf16_t*)(p.scratch + SC_LRU_GATES);
  const bf16_t* xc = (const bf16_t*)(p.scratch + SC_LRU_XC);
  bf16_t* ybuf = (bf16_t*)(p.scratch + SC_LRU_Y);
  for (int item = bid; item < 192 * 8; item += nblk) {
    int chunk = item >> 3, dir = (item >> 2) & 1, cb = item & 3;
    int c = cb * 256 + tidx;
    float sp = softplusf(-p.lru_a_param[dir * 1024 + c]);
    int tok0 = chunk * 128;
    float A = 1.f, h = (pass == 0) ? 0.f : p.lru_hin[((size_t)dir * 192 + chunk) * 1024 + c];
    for (int j = 0; j < 128; ++j) {
      int tok = dir ? tok0 + 127 - j : tok0 + j;
      float a, bx;
      lru_ab(gates, xc, dir, tok, c, sp, a, bx);
      h = a * h + bx; A *= a;
      if (pass == 2) ybuf[((size_t)dir * T_ALL + tok) * 1024 + c] = f2bf(h);
    }
    if (pass == 0) {
      float* ag = p.lru_agg + (((size_t)dir * 192 + chunk) * 1024 + c) * 2;
      ag[0] = A; ag[1] = h;
    }
  }
}
__device__ __forceinline__ void phase_lru_scan_carry(const Params& p, int bid, int nblk, int cxw) {
  const int tidx = opaque_tid(cxw);
  for (int item = bid; item < 36 * 8; item += nblk) {
    int s = item >> 3, dir = (item >> 2) & 1, cb = item & 3;
    int c = cb * 256 + tidx;
    int nch = s < 32 ? 2 : 32;
    int ch0 = s < 32 ? s * 2 : 64 + (s - 32) * 32;
    float h = s < 32 ? 0.f : p.state_lru[((size_t)(s - 32) * 2 + dir) * 1024 + c];
    for (int k = 0; k < nch; ++k) {
      int chunk = dir ? ch0 + nch - 1 - k : ch0 + k;
      size_t idx = ((size_t)dir * 192 + chunk) * 1024 + c;
      p.lru_hin[idx] = h;
      h = p.lru_agg[idx * 2] * h + p.lru_agg[idx * 2 + 1];
    }
    if (s < 32) p.out_lru[((size_t)s * 2 + dir) * 1024 + c] = h;
  }
}
__device__ __forceinline__ void phase_lru_combine(const Params& p, int bid, int nblk, int cxw) {
  const int tidx = opaque_tid(cxw);
  const bf16_t* proj = (const bf16_t*)(p.scratch + SC_LRU_PROJ);
  const bf16_t* yf = (const bf16_t*)(p.scratch + SC_LRU_Y);
  const bf16_t* yb = yf + (size_t)T_ALL * 1024;
  bf16_t* yg = (bf16_t*)(p.scratch + SC_LRU_YG);
  const size_t total = (size_t)T_ALL * 128;
  for (size_t idx = (size_t)bid * NTHR + tidx; idx < total; idx += (size_t)nblk * NTHR) {
    int tok = (int)(idx >> 7), c0 = (int)(idx & 127) * 8;
    u32x4 fv = *(const u32x4*)(yf + (size_t)tok * 1024 + c0);
    u32x4 bv = *(const u32x4*)(yb + (size_t)tok * 1024 + c0);
    u32x4 zv = *(const u32x4*)(proj + (size_t)tok * 2048 + 1024 + c0);
    unsigned fw[4] = {fv.x, fv.y, fv.z, fv.w}, bw[4] = {bv.x, bv.y, bv.z, bv.w}, zw[4] = {zv.x, zv.y, zv.z, zv.w}, ow[4];
#pragma unroll
    for (int e = 0; e < 4; ++e)
      ow[e] = pack2((bflo(fw[e]) + bflo(bw[e])) * siluf(bflo(zw[e])), (bfhi(fw[e]) + bfhi(bw[e])) * siluf(bfhi(zw[e])));
    u32x4 o; o.x = ow[0]; o.y = ow[1]; o.z = ow[2]; o.w = ow[3];
    *(u32x4*)(yg + (size_t)tok * 1024 + c0) = o;
  }
}

enum { PH_PREP = 0, PH_MOD, PH_HYA, PH_HYB, PH_LNMOD, PH_INPROJ, PH_MIX1, PH_MIX2, PH_MIX3, PH_MIX4, PH_MIX5, PH_MIX6, PH_OUTPROJ };

struct Ctx { int bid, nblk, wave; unsigned char* smem; unsigned char* wg_smem; };

template <class Epi>
__device__ __forceinline__ void run_gemm(const Ctx& cx, const bf16_t* A, int lda, const bf16_t* Bt, int M, int N, int K, int grp_shift, int grp_bytes, const Epi& e) {
  pg8::Gemm g{A, Bt, M, N, K, lda, grp_shift, grp_bytes};
  pg8::StaticOrder S; S.init(M, N, gridDim.x, opaque_s(blockIdx.x));
  pg8::gemm_phase((PG8_LAS unsigned char*)cx.wg_smem, g, S, e, cx.wave);
}

__device__ __forceinline__ void run_phase(const Params& p, int ph, int layer, const Ctx& cx) {
  const int kind = layer % 3, slot = layer / 3;
  const int bid = opaque_s(cx.bid), nblk = cx.nblk;
  unsigned char* smem = cx.smem;
  switch (ph) {
    case PH_PREP: phase_prep(p, bid, nblk, smem, cx.wave); break;
    case PH_MOD: phase_mod(p, bid, nblk, smem, cx.wave); break;
    case PH_HYA: phase_hyfilt_a(p, bid, nblk, smem, cx.wave); break;
    case PH_HYB: phase_hyfilt_b(p, bid, nblk, smem, cx.wave); break;
    case PH_LNMOD: phase_lnmod(p, layer, bid, nblk, cx.wave); break;
    case PH_INPROJ:
      if (kind == 0) {
        pg8::EpiSsdIn e{(bf16_t*)(p.scratch + SC_SSD_Z), (bf16_t*)(p.scratch + SC_SSD_XBC), (float*)(p.scratch + SC_SSD_DT), p.ssd_dt_bias + slot * 64};
        run_gemm(cx, p.hbuf, 1024, p.wt_ssd_in + (size_t)slot * 6400 * 1024, T_ALL, 6400, 1024, 30, 0, e);
      } else if (kind == 1) {
        pg8::EpiBf16 e{(bf16_t*)(p.scratch + SC_HY_PROJT), (size_t)T_ALL};
        run_gemm(cx, p.wt_hy_in, 1024, p.hbuf, 4096, T_ALL, 1024, 30, 0, e);
      } else {
        pg8::EpiBf16 e{(bf16_t*)(p.scratch + SC_LRU_PROJ), (size_t)2048};
        run_gemm(cx, p.hbuf, 1024, p.wt_lru_in, T_ALL, 2048, 1024, 30, 0, e);
      }
      break;
    case PH_MIX1:
      if (kind == 0) phase_ssd_conv(p, slot, slot == 1, bid, nblk, smem, cx.wave);
      else if (kind == 1) phase_hy_longconv(p, bid, nblk, smem, cx.wave);
      else phase_dwconv<4, false>((const bf16_t*)(p.scratch + SC_LRU_PROJ), 2048, (bf16_t*)(p.scratch + SC_LRU_XC), 1024, 1024,
                                  p.lru_conv_w, p.lru_conv_b, false, bid, nblk, cx.wave);
      break;
    case PH_MIX2:
      if (kind == 0) phase_ssd_scan(p, slot, slot == 1, bid, nblk, smem, cx.wave);
      else if (kind == 1) phase_hy_transpose(p, bid, nblk, smem, cx.wave);
      else {
        pg8::EpiLruGate e{(bf16_t*)(p.scratch + SC_LRU_GATES), p.lru_gate_b};
        run_gemm(cx, (const bf16_t*)(p.scratch + SC_LRU_XC), 1024, p.wt_lru_gate, T_ALL, 4096, 256, 2, 512, e);
      }
      break;
    case PH_MIX3:
      if (kind == 0) phase_ssd_gate(p, slot, bid, nblk, cx.wave);
      else phase_lru_scan_chunks(p, 0, bid, nblk, cx.wave);
      break;
    case PH_MIX4: if (kind == 2) phase_lru_scan_carry(p, bid, nblk, cx.wave); break;
    case PH_MIX5: if (kind == 2) phase_lru_scan_chunks(p, 2, bid, nblk, cx.wave); break;
    case PH_MIX6: if (kind == 2) phase_lru_combine(p, bid, nblk, cx.wave); break;
    case PH_OUTPROJ: {
      const float* mv = p.modv + (size_t)layer * 5 * 3072;
      if (kind == 0) {
        pg8::EpiOut e{p.xres, mv, p.rstd};
        run_gemm(cx, (const bf16_t*)(p.scratch + SC_SSD_Z), 2048, p.wt_ssd_out + (size_t)slot * 1024 * 2048, T_ALL, 1024, 2048, 30, 0, e);
      } else if (kind == 1) {
        pg8::EpiOut e{p.xres, mv, nullptr};
        run_gemm(cx, (const bf16_t*)(p.scratch + SC_HY_YG), 1024, p.wt_hy_out, T_ALL, 1024, 1024, 30, 0, e);
      } else {
        pg8::EpiOut e{p.xres, mv, nullptr};
        run_gemm(cx, (const bf16_t*)(p.scratch + SC_LRU_YG), 1024, p.wt_lru_out, T_ALL, 1024, 1024, 30, 0, e);
      }
    } break;
  }
}

__global__ void __launch_bounds__(WG_THREADS, 2) k_mega(Params p) {
  __shared__ __attribute__((aligned(16))) unsigned char smem[WG_SMEM + 16];
  cg::grid_group grid = cg::this_grid();
  const int wave0 = __builtin_amdgcn_readfirstlane((int)(threadIdx.x >> 6));
  const int vb = wave0 >> 2;
  Ctx cx;
  cx.wave = wave0;
  cx.bid = 2 * blockIdx.x + vb; cx.nblk = 2 * gridDim.x; cx.smem = smem + vb * SMEM_BYTES; cx.wg_smem = smem;
  volatile LAS unsigned* xst = (volatile LAS unsigned*)(smem + WG_SMEM);
  if (threadIdx.x == 0) { xst[0] = 0u; xst[1] = 0u; }
  __syncthreads();
  const XcdBarrier xb = xcd_barrier_post(p.bar, xst);
  run_phase(p, PH_PREP, 0, cx);
  run_phase(p, PH_MOD, 0, cx);
  run_phase(p, PH_HYA, 0, cx);
  grid.sync();
  run_phase(p, PH_HYB, 0, cx);
  for (int layer = 0; layer < 4; ++layer) {
    const int kind = layer % 3;
    run_phase(p, PH_LNMOD, layer, cx);
    xcd_barrier(xb, cx.wave);
    run_phase(p, PH_INPROJ, layer, cx);
    xcd_barrier(xb, cx.wave);
    run_phase(p, PH_MIX1, layer, cx);
    xcd_barrier(xb, cx.wave);
    run_phase(p, PH_MIX2, layer, cx);
    xcd_barrier(xb, cx.wave);
    if (kind != 1) {
      run_phase(p, PH_MIX3, layer, cx);
      xcd_barrier(xb, cx.wave);
    }
    if (kind == 2) {
      run_phase(p, PH_MIX4, layer, cx);
      xcd_barrier(xb, cx.wave);
      run_phase(p, PH_MIX5, layer, cx);
      xcd_barrier(xb, cx.wave);
      run_phase(p, PH_MIX6, layer, cx);
      xcd_barrier(xb, cx.wave);
    }
    run_phase(p, PH_OUTPROJ, layer, cx);
    xcd_barrier(xb, cx.wave);
  }
  run_phase(p, PH_LNMOD, 4, cx);
}

static inline size_t align_up(size_t x) { return (x + 255) & ~(size_t)255; }

extern "C" void kernel_launch(void* const* d_in, const int* in_sizes, int n_in, void* d_out, int out_size, void* d_ws, size_t ws_size,
                              hipStream_t stream) {
  Params p{};
  const float** fp = (const float**)&p;
  for (int i = 0; i < 36; ++i) fp[i] = (const float*)d_in[i];
  float* out = (float*)d_out;
  p.xres = out;
  p.out_ssd = out + (size_t)T_ALL * 1024;
  p.out_lru = p.out_ssd + (size_t)32 * 2 * 2 * 32 * 64 * 128;
  unsigned char* w = (unsigned char*)d_ws;
  size_t off = 0;
  auto carve = [&](size_t bytes) { unsigned char* r = w + off; off = align_up(off + bytes); return r; };
  p.wt_ssd_in = (bf16_t*)carve((size_t)2 * 6400 * 1024 * 2);
  p.wt_ssd_out = (bf16_t*)carve((size_t)2 * 1024 * 2048 * 2);
  p.wt_hy_in = (bf16_t*)carve((size_t)4096 * 1024 * 2);
  p.wt_hy_out = (bf16_t*)carve((size_t)1024 * 1024 * 2);
  p.wt_lru_in = (bf16_t*)carve((size_t)2048 * 1024 * 2);
  p.wt_lru_out = (bf16_t*)carve((size_t)1024 * 1024 * 2);
  p.wt_lru_gate = (bf16_t*)carve((size_t)4 * 1024 * 256 * 2);
  p.modv = (float*)carve((size_t)4 * 5 * 3072 * 4);
  p.hdn2 = (float*)carve((size_t)4352 * 64 * 4);
  p.rtab0 = (bf16_t*)carve((size_t)2 * 1024 * 512 * 2);
  p.rtab1 = (bf16_t*)carve((size_t)2 * 1024 * 8192 * 2);
  p.knorm = (float*)carve((size_t)4 * 1024 * 4);
  p.hbuf = (bf16_t*)carve((size_t)T_ALL * 1024 * 2);
  p.rstd = (float*)carve((size_t)T_ALL * 4);
  p.lru_agg = (float*)carve((size_t)2 * 192 * 1024 * 2 * 4);
  p.lru_hin = (float*)carve((size_t)2 * 192 * 1024 * 4);
  p.bar = (unsigned*)carve((size_t)XCD_BAR_WORDS * 4);
  p.scratch = carve(SC_TOTAL);
  if (off > ws_size) return;

  static int grid_blocks = 0;
  if (!grid_blocks) {
    int dev = 0, cus = 0, per_cu = 0;
    hipGetDevice(&dev);
    hipDeviceGetAttribute(&cus, hipDeviceAttributeMultiprocessorCount, dev);
    hipOccupancyMaxActiveBlocksPerMultiprocessor(&per_cu, k_mega, WG_THREADS, 0);
    if (per_cu > 1) per_cu = 1;
    grid_blocks = cus * per_cu;
  }
  hipMemsetAsync(p.bar, 0, (size_t)XCD_BAR_WORDS * 4, stream);
  void* args[] = {&p};
  hipError_t e = hipLaunchCooperativeKernel((void*)k_mega, dim3(grid_blocks), dim3(WG_THREADS), args, 0, stream);
  if (e != hipSuccess) fprintf(stderr, "cooperative launch failed: %s (grid %d)\n", hipGetErrorString(e), grid_blocks);
}
```

```cpp
#include <hip/hip_runtime.h>
#include <hip/hip_bf16.h>
#include <hip/hip_cooperative_groups.h>
#include <stdint.h>
#include <cstdio>
namespace cg = cooperative_groups;

typedef unsigned short bf16_t;
typedef __attribute__((ext_vector_type(8))) short bf16x8;
typedef __attribute__((ext_vector_type(16))) float f32x16;
typedef __attribute__((ext_vector_type(4))) unsigned int u32x4;
typedef __attribute__((ext_vector_type(2))) unsigned int u32x2;
typedef __attribute__((ext_vector_type(4))) float f32x4;
typedef float f32x4_t __attribute__((ext_vector_type(4)));

#define T_CTX 8192
#define T_ALL 24576
#define DM 1024
#define NTHR 256
#define SMEM_BYTES 69632
#define WG_THREADS 512
#define WG_SMEM (2 * SMEM_BYTES)
#define ALPHA_RES 1.6817928305074290f
#define LN_EPS 1e-5f

__device__ __forceinline__ bf16_t f2bf(float f) {
  unsigned u = __float_as_uint(f);
  u += 0x7fffu + ((u >> 16) & 1u);
  return (bf16_t)(u >> 16);
}
__device__ __forceinline__ float bf2f(bf16_t b) { return __uint_as_float(((unsigned)b) << 16); }
__device__ __forceinline__ float bflo(unsigned w) { return __uint_as_float(w << 16); }
__device__ __forceinline__ float bfhi(unsigned w) { return __uint_as_float(w & 0xffff0000u); }
__device__ __forceinline__ unsigned pack2(float a, float b) { return (unsigned)f2bf(a) | ((unsigned)f2bf(b) << 16); }
__device__ __forceinline__ float siluf(float x) { return x / (1.f + __expf(-x)); }
__device__ __forceinline__ float sigmoidf(float x) { return 1.f / (1.f + __expf(-x)); }
__device__ __forceinline__ float softplusf(float x) { return x > 20.f ? x : __logf(1.f + __expf(x)); }


__device__ __forceinline__ int opaque_lane() { int z = 0; asm volatile("" : "+v"(z)); return __builtin_amdgcn_mbcnt_hi(~0u, __builtin_amdgcn_mbcnt_lo(~0u, (unsigned)z)); }
__device__ __forceinline__ int opaque_tid512(int wave) { return (wave << 6) + opaque_lane(); }
__device__ __forceinline__ int opaque_tid(int wave) { return opaque_tid512(wave) & 255; }

#define XB_TMO      128
#define XB_XCNT(j)  (256  + 64 * (j))
#define XB_XSUB(j)  (1280 + 64 * (j))
#define XB_XGEN(j)  (2304 + 64 * (j))
#define XB_TOP      3328
#define XB_TOPGEN   3392
#define XCD_BAR_WORDS 3456
#define XB_SPIN_CAP (1u << 18)
#define LAS __attribute__((address_space(3)))
__device__ __forceinline__ unsigned xb_ld(unsigned* p)              { return __hip_atomic_load(p, __ATOMIC_RELAXED, __HIP_MEMORY_SCOPE_AGENT); }
__device__ __forceinline__ unsigned xb_add(unsigned* p, unsigned v) { return __hip_atomic_fetch_add(p, v, __ATOMIC_RELAXED, __HIP_MEMORY_SCOPE_AGENT); }
__device__ __forceinline__ unsigned xb_xcc_id() { return (unsigned)__builtin_amdgcn_s_getreg((3 << 11) | 20) & 0xFu; }
#define XB_SPIN(cond, bar) do { unsigned _sp = 0; while (cond) { __builtin_amdgcn_s_sleep(1); \
    if ((++_sp & 255u) == 0u) { if (xb_ld(&(bar)[XB_TMO])) break; if (_sp > XB_SPIN_CAP) { atomicAdd(&(bar)[XB_TMO], 1u); break; } } } } while (0)
struct XcdBarrier { unsigned* bar; unsigned x; volatile LAS unsigned* st; };
__device__ __forceinline__ XcdBarrier xcd_barrier_post(unsigned* bar, volatile LAS unsigned* st) {
  XcdBarrier b; b.bar = bar; b.x = xb_xcc_id(); b.st = st;
  if (threadIdx.x == 0) (void)xb_add(&bar[XB_XCNT(b.x)], 1u);
  return b;
}
__device__ __forceinline__ void xcd_barrier_complete(unsigned* bar, unsigned x, unsigned& nloc, unsigned& nx) {
  const unsigned G = gridDim.x * gridDim.y * gridDim.z;
  unsigned sum, cnt, mine, sp = 0u;
  for (;;) {
    sum = 0u; cnt = 0u; mine = 0u;
#pragma unroll
    for (unsigned j = 0; j < 16; ++j) { const unsigned c = xb_ld(&bar[XB_XCNT(j)]); sum += c; cnt += (c > 0u) ? 1u : 0u; mine = (j == x) ? c : mine; }
    if (sum == G) break;
    __builtin_amdgcn_s_sleep(1);
    if ((++sp & 255u) == 0u) { if (xb_ld(&bar[XB_TMO])) break; if (sp > XB_SPIN_CAP) { atomicAdd(&bar[XB_TMO], 1u); break; } }
  }
  nloc = mine > 0u ? mine : 1u; nx = cnt > 0u ? cnt : 1u;
}
__device__ __forceinline__ void xcd_barrier(const XcdBarrier& b, int wave) {
  asm volatile("s_waitcnt vmcnt(0)" ::: "memory");
  __syncthreads();
  if (opaque_tid512(wave) == 0) {
    unsigned* bar = b.bar;
    __builtin_amdgcn_s_waitcnt(0);
    unsigned nloc = b.st[0], nx = b.st[1];
    if (nloc == 0u) { xcd_barrier_complete(bar, b.x, nloc, nx); b.st[0] = nloc; b.st[1] = nx; }
    const unsigned old = xb_add(&bar[XB_XSUB(b.x)], 1u);
    const unsigned gen = old / nloc;
    if (old + 1u == (gen + 1u) * nloc) {
      __builtin_amdgcn_fence(__ATOMIC_RELEASE, "agent");
      asm volatile("s_waitcnt vmcnt(0)" ::: "memory");
      const unsigned og = xb_add(&bar[XB_TOP], 1u);
      const unsigned tg = og / nx;
      if (og + 1u == (tg + 1u) * nx) xb_add(&bar[XB_TOPGEN], 1u);
      else XB_SPIN(xb_ld(&bar[XB_TOPGEN]) == tg, bar);
      __builtin_amdgcn_fence(__ATOMIC_ACQUIRE, "agent");
      xb_add(&bar[XB_XGEN(b.x)], 1u);
      asm volatile("s_waitcnt vmcnt(0)" ::: "memory");
    } else {
      XB_SPIN(xb_ld(&bar[XB_XGEN(b.x)]) == gen, bar);
      __builtin_amdgcn_fence(__ATOMIC_ACQUIRE, "agent");
      asm volatile("s_waitcnt vmcnt(0)" ::: "memory");
    }
  }
  __syncthreads();
}


__device__ __forceinline__ int opaque_s(int x) { asm volatile("" : "+s"(x)); return x; }

__device__ __forceinline__ float shfl_idx_f(float v, int src) { return __int_as_float(__builtin_amdgcn_ds_bpermute(src << 2, __float_as_int(v))); }
__device__ __forceinline__ float shfl_xor_f(float v, int off, int lane) { return shfl_idx_f(v, lane ^ off); }

struct TokInfo { int s, l, L, base, mrow; };
__device__ __forceinline__ TokInfo tokinfo(int tok) {
  TokInfo t;
  if (tok < T_CTX) { t.s = tok >> 8; t.l = tok & 255; t.L = 256; t.base = tok & ~255; t.mrow = 0; }
  else { int u = tok - T_CTX; t.s = 32 + (u >> 12); t.l = u & 4095; t.L = 4096; t.base = T_CTX + (u & ~4095); t.mrow = 1 + (u >> 12); }
  return t;
}
__device__ __forceinline__ int seqpos2off(int pos, bool cm) { return cm ? (((pos & 63) << 6) | (pos >> 6)) : pos; }

struct Params {
  const float *x_prompt, *x_sample, *state_ssd, *state_lru, *c, *c_ctx, *mod_w, *mod_b, *ln_g, *ln_b;
  const float *ssd_in_w, *ssd_conv_w, *ssd_conv_b, *ssd_dt_bias, *ssd_a_log, *ssd_d, *ssd_norm_g, *ssd_out_w;
  const float *hy_in_w, *hy_conv_w, *hy_conv_b, *hy_f_w1, *hy_f_b1, *hy_f_w2, *hy_f_b2, *hy_f_w3, *hy_f_freq, *hy_f_bias, *hy_out_w;
  const float *lru_in_w, *lru_conv_w, *lru_conv_b, *lru_gate_w, *lru_gate_b, *lru_a_param, *lru_out_w;
  float *xres, *out_ssd, *out_lru;
  bf16_t *wt_ssd_in, *wt_ssd_out, *wt_hy_in, *wt_hy_out, *wt_lru_in, *wt_lru_out, *wt_lru_gate;
  float *modv;
  float *hdn2;
  bf16_t *rtab0;
  bf16_t *rtab1;
  float *knorm;
  bf16_t *hbuf;
  float *rstd;
  float *lru_agg;
  float *lru_hin;
  unsigned char *scratch;
  unsigned *bar;
};

#define SC_SSD_Z     ((size_t)0)
#define SC_SSD_XBC   ((size_t)T_ALL * 2048 * 2)
#define SC_SSD_XBCC  (SC_SSD_XBC + (size_t)T_ALL * 4096 * 2)
#define SC_SSD_DT    (SC_SSD_XBCC + (size_t)T_ALL * 2048 * 2)
#define SC_SSD_XT    (SC_SSD_DT + (size_t)T_ALL * 64 * 4)
#define SC_SSD_BT    (SC_SSD_XT + (size_t)T_ALL * 2048 * 2)
#define SC_SSD_BF    (SC_SSD_BT + (size_t)T_ALL * 1024 * 2)
#define SC_SSD_CF    (SC_SSD_BF + (size_t)T_ALL * 1024 * 2)
#define SC_SSD_END   (SC_SSD_CF + (size_t)T_ALL * 1024 * 2)
#define SC_HY_PROJT  ((size_t)0)
#define SC_HY_YT     ((size_t)T_ALL * 4096 * 2)
#define SC_HY_YG     (SC_HY_YT + (size_t)T_ALL * 1024 * 2)
#define SC_LRU_PROJ  ((size_t)0)
#define SC_LRU_XC    ((size_t)T_ALL * 2048 * 2)
#define SC_LRU_GATES (SC_LRU_XC + (size_t)T_ALL * 1024 * 2)
#define SC_LRU_Y     (SC_LRU_GATES + (size_t)T_ALL * 4096 * 2)
#define SC_LRU_YG    (SC_LRU_Y + (size_t)T_ALL * 2048 * 2)
#define SC_TOTAL     SC_SSD_END

__device__ __forceinline__ void transpose_tile(const float* __restrict__ src, int ld_src, int n_src, bf16_t* __restrict__ dst, int K,
                               const float* __restrict__ scale, int tile, int tiles_k, float* tl, int cxw) {
  const int tidx = opaque_tid(cxw);
  int tk = tile % tiles_k, tn = tile / tiles_k;
  int k0 = tk * 64, n0 = tn * 64;
  int tx = tidx & 63, ty = tidx >> 6;
  __syncthreads();
  for (int r = ty; r < 64; r += 4) {
    int n = n0 + tx;
    float v = 0.f;
    if (n < n_src) { v = src[(size_t)(k0 + r) * ld_src + n]; if (scale) v *= scale[k0 + r]; }
    tl[r * 65 + tx] = v;
  }
  __syncthreads();
  for (int r = ty; r < 64; r += 4) dst[(size_t)(n0 + r) * K + k0 + tx] = f2bf(tl[tx * 65 + r]);
}

__device__ __forceinline__ void phase_prep(const Params& p, int bid, int nblk, unsigned char* smem, int cxw) {
  const int tidx = opaque_tid(cxw);
  float* tl = (float*)smem;
  for (int job = 0; job < 24; ++job) {
    const float* src; int ld, nsrc, K, npad; bf16_t* dst; const float* scale = nullptr;
    if (job < 2) { src = p.ssd_in_w + (size_t)job * 1024 * 6208; ld = 6208; nsrc = 6208; K = 1024; npad = 6400; dst = p.wt_ssd_in + (size_t)job * 6400 * 1024; }
    else if (job < 4) { int s = job - 2; src = p.ssd_out_w + (size_t)s * 2048 * 1024; ld = 1024; nsrc = 1024; K = 2048; npad = 1024; dst = p.wt_ssd_out + (size_t)s * 1024 * 2048; scale = p.ssd_norm_g + s * 2048; }
    else if (job == 4) { src = p.hy_in_w; ld = 4096; nsrc = 4096; K = 1024; npad = 4096; dst = p.wt_hy_in; }
    else if (job == 5) { src = p.hy_out_w; ld = 1024; nsrc = 1024; K = 1024; npad = 1024; dst = p.wt_hy_out; }
    else if (job == 6) { src = p.lru_in_w; ld = 2048; nsrc = 2048; K = 1024; npad = 2048; dst = p.wt_lru_in; }
    else if (job == 7) { src = p.lru_out_w; ld = 1024; nsrc = 1024; K = 1024; npad = 1024; dst = p.wt_lru_out; }
    else { int q = job - 8; int dg = q >> 2, n = q & 3;
      src = p.lru_gate_w + (size_t)(dg * 4 + n) * 65536; ld = 256; nsrc = 256; K = 256; npad = 256;
      dst = p.wt_lru_gate + (size_t)n * 1024 * 256 + (size_t)dg * 256 * 256; }
    int tiles_k = K / 64, tiles = tiles_k * (npad / 64);
    for (int t = bid; t < tiles; t += nblk) transpose_tile(src, ld, nsrc, dst, K, scale, t, tiles_k, tl, cxw);
  }
  for (int i = bid * NTHR + tidx; i < 2 * 2 * 1024; i += nblk * NTHR) p.knorm[i] = 0.f;
}

__device__ __forceinline__ void phase_mod(const Params& p, int bid, int nblk, unsigned char* smem, int cxw) {
  const int tidx = opaque_tid(cxw);
  float* sc = (float*)smem;
  float* red = sc + 5 * 1024;
  __syncthreads();
  for (int i = tidx; i < 5 * 1024; i += NTHR) {
    int r = i >> 10, k = i & 1023;
    float v = (r == 0) ? p.c_ctx[k] : p.c[(r - 1) * 1024 + k];
    sc[i] = siluf(v);
  }
  __syncthreads();
  const int cj = tidx & 31, kg = tidx >> 5;
  for (int item = bid; item < 4 * 96; item += nblk) {
    const int layer = item / 96, j = (item % 96) * 32 + cj;
    const float* w = p.mod_w + (size_t)layer * 1024 * 3072 + (size_t)kg * 128 * 3072 + j;
    const float* s0 = sc + kg * 128;
    float a0 = 0, a1 = 0, a2 = 0, a3 = 0, a4 = 0;
#pragma unroll 8
    for (int k = 0; k < 128; ++k) {
      float wv = w[(size_t)k * 3072];
      a0 += s0[k] * wv; a1 += s0[1024 + k] * wv; a2 += s0[2048 + k] * wv; a3 += s0[3072 + k] * wv; a4 += s0[4096 + k] * wv;
    }
    __syncthreads();
    red[(kg * 5 + 0) * 32 + cj] = a0; red[(kg * 5 + 1) * 32 + cj] = a1; red[(kg * 5 + 2) * 32 + cj] = a2;
    red[(kg * 5 + 3) * 32 + cj] = a3; red[(kg * 5 + 4) * 32 + cj] = a4;
    __syncthreads();
    if (tidx < 160) {
      const int rr = tidx >> 5, cc = tidx & 31;
      float sum = 0.f;
#pragma unroll
      for (int g8 = 0; g8 < 8; ++g8) sum += red[(g8 * 5 + rr) * 32 + cc];
      const int jj = (item % 96) * 32 + cc;
      p.modv[((size_t)layer * 5 + rr) * 3072 + jj] = sum + p.mod_b[layer * 3072 + jj];
    }
  }
}

__device__ __forceinline__ void phase_hyfilt_a(const Params& p, int bid, int nblk, unsigned char* smem, int cxw) {
  const int tidx = opaque_tid(cxw);
  float* sz = (float*)smem;
  float* sh = sz + 4 * 36;
  int pl = tidx >> 6, m = tidx & 63;
  for (int item = bid; item < 4352 / 4; item += nblk) {
    int pos = item * 4 + pl;
    int L = pos < 256 ? 256 : 4096;
    int l = pos < 256 ? pos : pos - 256;
    __syncthreads();
    if (m < 33) {
      float t = (float)l / (float)L;
      float w = (6.283185307179586f * (float)l) / (float)L;
      float v;
      if (m == 0) v = t;
      else {
        int j = (m - 1) & 15;
        float fr = 1e-4f + (float)j * ((15.f - 1e-4f) / 15.f);
        float ang = w * fr;
        v = (m <= 16) ? __cosf(ang) : __sinf(ang);
      }
      sz[pl * 36 + m] = v;
    }
    __syncthreads();
    float a = p.hy_f_b1[m];
    for (int e = 0; e < 33; ++e) a += sz[pl * 36 + e] * p.hy_f_w1[e * 64 + m];
    a = __sinf(p.hy_f_freq[m] * a);
    sh[pl * 64 + m] = a;
    __syncthreads();
    float b = p.hy_f_b2[m];
    for (int e = 0; e < 64; ++e) b += sh[pl * 64 + e] * p.hy_f_w2[e * 64 + m];
    b = __sinf(p.hy_f_freq[64 + m] * b);
    p.hdn2[(size_t)pos * 64 + m] = b;
  }
}

__device__ __forceinline__ void phase_hyfilt_b(const Params& p, int bid, int nblk, unsigned char* smem, int cxw) {
  const int tidx = opaque_tid(cxw);
  const int lane = tidx & 63;
  for (int item = bid; item < 17 * 64; item += nblk) {
    const int lb = item >> 6, chunk = item & 63;
    const int Lsel = lb ? 1 : 0, L = Lsel ? 4096 : 256, RL = Lsel ? 8192 : 512, Lm1 = L - 1;
    const int l = Lsel ? (lb - 1) * 256 + tidx : tidx;
    const int pos = Lsel ? 256 + l : l;
    float hd[64];
#pragma unroll
    for (int m4 = 0; m4 < 16; ++m4) {
      f32x4 v = *(const f32x4*)(p.hdn2 + (size_t)pos * 64 + m4 * 4);
      hd[m4 * 4] = v.x; hd[m4 * 4 + 1] = v.y; hd[m4 * 4 + 2] = v.z; hd[m4 * 4 + 3] = v.w;
    }
    const int odc0 = chunk * 64, o = odc0 >> 11, d = (odc0 >> 10) & 1, c0 = odc0 & 1023;
    const float t = (float)l / (float)L;
    bf16_t* rt = Lsel ? p.rtab1 : p.rtab0;
    const float min_decay = -3.0701134573253945f, max_decay = -15.350567286626973f;
    for (int cc = 0; cc < 64; ++cc) {
      const int c = c0 + cc;
      const float* w3 = p.hy_f_w3 + odc0 + cc;
      float acc = 0.f;
#pragma unroll
      for (int m = 0; m < 64; ++m) acc += hd[m] * w3[(size_t)m * 4096];
      float delta = fabsf(min_decay + (float)c * ((max_decay - min_decay) / 1023.f));
      float kv = acc * expf(-t * delta);
      size_t rb = (size_t)(o * 1024 + c) * RL;
      if (d == 0) rt[rb + Lm1 - l] = f2bf(kv);
      else if (l > 0) rt[rb + Lm1 + l] = f2bf(kv);
      else rt[rb + RL - 1] = 0;
      float a = fabsf(kv);
#pragma unroll
      for (int off = 32; off > 0; off >>= 1) a += shfl_xor_f(a, off, lane);
      if (lane == 0) atomicAdd(&p.knorm[(Lsel * 2 + o) * 1024 + c], a);
    }
  }
}

__device__ __forceinline__ void phase_lnmod(const Params& p, int layer, int bid, int nblk, int cxw) {
  const int tidx = opaque_tid(cxw);
  int lane = tidx & 63, wv = tidx >> 6;
  for (int row = bid * 4 + wv; row < T_ALL; row += nblk * 4) {
    const float* src = (layer == 0) ? (row < T_CTX ? p.x_prompt + (size_t)row * DM : p.x_sample + (size_t)(row - T_CTX) * DM)
                                    : p.xres + (size_t)row * DM;
    f32x4 v[4];
#pragma unroll
    for (int j = 0; j < 4; ++j) v[j] = *(const f32x4*)(src + j * 256 + lane * 4);
    if (layer > 0) {
      float s = 0.f;
#pragma unroll
      for (int j = 0; j < 4; ++j) s += v[j].x + v[j].y + v[j].z + v[j].w;
#pragma unroll
      for (int o = 32; o > 0; o >>= 1) s += shfl_xor_f(s, o, lane);
      float mu = s * (1.f / 1024.f);
      float q = 0.f;
#pragma unroll
      for (int j = 0; j < 4; ++j) { float a = v[j].x - mu, b = v[j].y - mu, c = v[j].z - mu, d = v[j].w - mu; q += a * a + b * b + c * c + d * d; }
#pragma unroll
      for (int o = 32; o > 0; o >>= 1) q += shfl_xor_f(q, o, lane);
      float rs = rsqrtf(q * (1.f / 1024.f) + LN_EPS);
      const float* g = p.ln_g + (layer - 1) * DM; const float* b = p.ln_b + (layer - 1) * DM;
#pragma unroll
      for (int j = 0; j < 4; ++j) {
        f32x4 gg = *(const f32x4*)(g + j * 256 + lane * 4), bb = *(const f32x4*)(b + j * 256 + lane * 4);
        v[j].x = (v[j].x - mu) * rs * gg.x + bb.x; v[j].y = (v[j].y - mu) * rs * gg.y + bb.y;
        v[j].z = (v[j].z - mu) * rs * gg.z + bb.z; v[j].w = (v[j].w - mu) * rs * gg.w + bb.w;
      }
    }
    float* dst = p.xres + (size_t)row * DM;
#pragma unroll
    for (int j = 0; j < 4; ++j) *(f32x4*)(dst + j * 256 + lane * 4) = v[j];
    if (layer < 4) {
      int mrow = row < T_CTX ? 0 : 1 + ((row - T_CTX) >> 12);
      const float* mv = p.modv + ((size_t)layer * 5 + mrow) * 3072;
#pragma unroll
      for (int j = 0; j < 4; ++j) {
        f32x4 sh = *(const f32x4*)(mv + j * 256 + lane * 4), sc = *(const f32x4*)(mv + 1024 + j * 256 + lane * 4);
        u32x2 o;
        o.x = pack2(v[j].x * (1.f + sc.x) + sh.x, v[j].y * (1.f + sc.y) + sh.y);
        o.y = pack2(v[j].z * (1.f + sc.z) + sh.z, v[j].w * (1.f + sc.w) + sh.w);
        *(u32x2*)(p.hbuf + (size_t)row * DM + j * 256 + lane * 4) = o;
      }
    }
  }
}

#define PG8_LAS __attribute__((address_space(3)))
namespace pg8 {
constexpr int BM = 256, BK = 64, HALF = 128, HTB = HALF * BK * 2, STAGE_BYTES = 8 * HTB, NXCD = 8, WGM = 8;
__device__ __forceinline__ int lds_byte(int r, int c) { const int st = (r >> 4) * 2 + (c >> 5), rr = r & 15, cc = c & 31, ob = rr * 64 + cc * 2; return st * 1024 + (ob ^ (((ob >> 9) & 1) << 5)); }
__device__ __forceinline__ void stage_rc(int b, int& R, int& C) { const int st = b / 1024, sb = b % 1024, swz = sb ^ (((sb >> 9) & 1) << 5); R = (st >> 1) * 16 + swz / 64; C = (st & 1) * 32 + (swz % 64) / 2; }
__device__ __forceinline__ int perm32(int rho) { const int n = rho >> 4, i = rho & 15; return 8 * (i >> 2) + 4 * n + (i & 3); }
struct Unit { int pm, pn; };
struct Gemm { const bf16_t* A; const bf16_t* Bt; int M, N, K, lda; int a_grp_shift; int a_grp_bytes; };
struct StaticOrder {
  int nM, nN, nwg, G, c;
  __device__ void init(int M, int N, int G_, int c_) { nM = M / BM; nN = N / BM; nwg = nM * nN; G = G_; c = c_; }
  __device__ bool next(int i, Unit& u) const {
    const long L = (long)i * G + c; if (L >= nwg) return false;
    int wgid = (int)L; { const int q = nwg / NXCD, r = nwg % NXCD, xcd = wgid % NXCD, off = wgid / NXCD; wgid = (xcd < r ? xcd * (q + 1) : r * (q + 1) + (xcd - r) * q) + off; }
    const int nig = WGM * nN, gid = wgid / nig, fm = gid * WGM, gsz = (nM - fm) < WGM ? (nM - fm) : WGM;
    u.pm = fm + ((wgid % nig) % gsz); u.pn = (wgid % nig) / gsz; return true;
  }
};
__device__ __forceinline__ unsigned cvt_pk_bf16(float lo, float hi) { return pack2(lo, hi); }

template <class Epi>
__device__ __forceinline__ void gemm_phase(PG8_LAS unsigned char* lds, const Gemm g, const StaticOrder& S, const Epi& E, int wave) {
  const int tid = opaque_tid512(wave), wid = wave, lane = tid & 63, wr = wid >> 2, wc = wid & 3, fr = lane & 15, fq = lane >> 4;
  const int K = g.K, nt = K / BK, lda = g.lda;
  unsigned voffA[2], voffB[2];
#pragma unroll
  for (int i = 0; i < 2; ++i) { int R, C; stage_rc(tid * 16 + i * 8192, R, C); const int Rb = Epi::PERM ? ((R & ~31) + perm32(R & 31)) : R;
    voffA[i] = (unsigned)(R * lda + C) * 2u; voffB[i] = (unsigned)(Rb * K + C) * 2u; }
  const size_t kstep = (size_t)(BK * 2);
  const size_t hstepA = (size_t)HALF * lda * 2, hstepB = (size_t)HALF * K * 2;
  const size_t tstepA = 2 * hstepA, tstepB = 2 * hstepB;
  const unsigned ldsw = (unsigned)wid * 1024u;
  const int aoff = lds_byte(wr * 64 + fr, fq * 8), boff = lds_byte(wc * 32 + fr, fq * 8);
#define PG8_SA(b, h) (((b) * 2 + (h)) * HTB)
#define PG8_SB(b, h) ((4 + (b) * 2 + (h)) * HTB)
#define PG8_STAGE(bufoff, gbase, voff) do { _Pragma("unroll") for (int _i = 0; _i < 2; ++_i) \
    __builtin_amdgcn_global_load_lds((const unsigned*)((const char*)(gbase) + (voff)[_i]), (PG8_LAS unsigned*)(lds + (bufoff) + ldsw + _i * 8192), 16, 0, 0); } while (0)
#define PG8_LDA(dst, b, h) do { _Pragma("unroll") for (int m = 0; m < 4; ++m) _Pragma("unroll") for (int k = 0; k < 2; ++k) dst[m][k] = *(const PG8_LAS bf16x8*)(lds + PG8_SA(b, h) + aoff + m * 2048 + k * 1024); } while (0)
#define PG8_LDB(dst, b, h) do { _Pragma("unroll") for (int n = 0; n < 2; ++n) _Pragma("unroll") for (int k = 0; k < 2; ++k) dst[n][k] = *(const PG8_LAS bf16x8*)(lds + PG8_SB(b, h) + boff + n * 2048 + k * 1024); } while (0)
#define PG8_MMA(ai, bj, At, Bt) do { __builtin_amdgcn_s_setprio(1); _Pragma("unroll") for (int m = 0; m < 4; ++m) _Pragma("unroll") for (int n = 0; n < 2; ++n) _Pragma("unroll") for (int k = 0; k < 2; ++k) \
    acc[ai][bj][m][n] = __builtin_amdgcn_mfma_f32_16x16x32_bf16(Bt[n][k], At[m][k], acc[ai][bj][m][n], 0, 0, 0); __builtin_amdgcn_s_setprio(0); } while (0)
#define PG8_WAIT_V(n) asm volatile("s_waitcnt vmcnt(" #n ")" ::: "memory")
#define PG8_WAIT_L(n) asm volatile("s_waitcnt lgkmcnt(" #n ")" ::: "memory")
#define PG8_BAR __builtin_amdgcn_s_barrier()
#define PG8_SCHED __builtin_amdgcn_sched_barrier(0)
#define PG8_APTR(u) ((const char*)g.A + (size_t)(u).pm * tstepA + (size_t)(((u).pn >> g.a_grp_shift) * g.a_grp_bytes))
  Unit cur, nxt; int ui = 0;
  if (!S.next(0, cur)) return;
  f32x4 acc[2][2][4][2];
#pragma unroll
  for (int a = 0; a < 2; ++a)
#pragma unroll
    for (int b = 0; b < 2; ++b)
#pragma unroll
      for (int m = 0; m < 4; ++m)
#pragma unroll
        for (int n = 0; n < 2; ++n) acc[a][b][m][n] = (f32x4){0.f, 0.f, 0.f, 0.f};
  bf16x8 At[4][2], B0[2][2], B1[2][2];
  const char* cA = PG8_APTR(cur); const char* cB = (const char*)g.Bt + (size_t)cur.pn * tstepB;
  PG8_STAGE(PG8_SB(0, 0), cB, voffB); PG8_STAGE(PG8_SA(0, 0), cA, voffA); PG8_STAGE(PG8_SB(0, 1), cB + hstepB, voffB); PG8_STAGE(PG8_SA(0, 1), cA + hstepA, voffA);
  if (wr == 1) PG8_BAR;
  PG8_WAIT_V(4); PG8_BAR;
  PG8_STAGE(PG8_SB(1, 0), cB + kstep, voffB); PG8_STAGE(PG8_SA(1, 0), cA + kstep, voffA); PG8_STAGE(PG8_SB(1, 1), cB + hstepB + kstep, voffB);
  PG8_WAIT_V(6); PG8_BAR;
  for (;;) {
    const bool has_next = S.next(ui + 1, nxt);
    const char* nA = has_next ? PG8_APTR(nxt) : cA; const char* nB = has_next ? (const char*)g.Bt + (size_t)nxt.pn * tstepB : cB;
    for (int t = 0; t < nt; t += 2) {
      const bool last = (t == nt - 2);
      const char* a1 = cA + (size_t)(t + 1) * kstep;
      const char* a2 = last ? nA : cA + (size_t)(t + 2) * kstep; const char* b2 = last ? nB : cB + (size_t)(t + 2) * kstep;
      const char* a3 = a2 + kstep; const char* b3 = b2 + kstep;
      PG8_LDB(B0, 0, 0); PG8_SCHED; PG8_LDA(At, 0, 0); PG8_STAGE(PG8_SA(1, 1), a1 + hstepA, voffA);
      PG8_WAIT_L(8); PG8_BAR; PG8_WAIT_L(0); PG8_MMA(0, 0, At, B0); PG8_BAR; PG8_SCHED;
      PG8_LDB(B1, 0, 1); PG8_STAGE(PG8_SB(0, 0), b2, voffB);
      PG8_BAR; PG8_WAIT_L(0); PG8_MMA(0, 1, At, B1); PG8_BAR;
      PG8_LDA(At, 0, 1); PG8_STAGE(PG8_SA(0, 0), a2, voffA);
      PG8_BAR; PG8_WAIT_L(0); PG8_MMA(1, 0, At, B0); PG8_BAR; PG8_SCHED;
      PG8_STAGE(PG8_SB(0, 1), b2 + hstepB, voffB);
      PG8_WAIT_V(6); PG8_BAR; PG8_MMA(1, 1, At, B1); PG8_BAR;
      PG8_LDB(B0, 1, 0); PG8_SCHED; PG8_LDA(At, 1, 0); PG8_STAGE(PG8_SA(0, 1), a2 + hstepA, voffA);
      PG8_WAIT_L(8); PG8_BAR; PG8_WAIT_L(0); PG8_MMA(0, 0, At, B0); PG8_BAR; PG8_SCHED;
      PG8_LDB(B1, 1, 1); PG8_STAGE(PG8_SB(1, 0), b3, voffB);
      PG8_BAR; PG8_WAIT_L(0); PG8_MMA(0, 1, At, B1); PG8_BAR;
      PG8_LDA(At, 1, 1); PG8_STAGE(PG8_SA(1, 0), a3, voffA);
      PG8_BAR; PG8_WAIT_L(0); PG8_MMA(1, 0, At, B0); PG8_BAR; PG8_SCHED;
      PG8_STAGE(PG8_SB(1, 1), b3 + hstepB, voffB);
      PG8_WAIT_V(6); PG8_BAR; PG8_MMA(1, 1, At, B1); PG8_BAR;
    }
    E(acc, cur, wr, wc, fr, fq);
    if (!has_next) break;
#pragma unroll
    for (int a = 0; a < 2; ++a)
#pragma unroll
      for (int b = 0; b < 2; ++b)
#pragma unroll
        for (int m = 0; m < 4; ++m)
#pragma unroll
          for (int n = 0; n < 2; ++n) acc[a][b][m][n] = (f32x4){0.f, 0.f, 0.f, 0.f};
    cur = nxt; cA = nA; cB = nB; ++ui;
  }
  PG8_WAIT_V(0);
  if (wr == 0) PG8_BAR;
  PG8_BAR;
#undef PG8_SA
#undef PG8_SB
#undef PG8_STAGE
#undef PG8_LDA
#undef PG8_LDB
#undef PG8_MMA
#undef PG8_WAIT_V
#undef PG8_WAIT_L
#undef PG8_BAR
#undef PG8_SCHED
#undef PG8_APTR
}

struct EpiBf16 {
  static constexpr bool PERM = true;
  bf16_t* O; size_t ldc;
  __device__ __forceinline__ void operator()(const f32x4 (&acc)[2][2][4][2], const Unit& u, int wr, int wc, int fr, int fq) const {
    const int row0 = u.pm * BM + wr * 64 + fr, col0 = u.pn * BM + wc * 32 + 8 * fq;
#pragma unroll
    for (int ai = 0; ai < 2; ++ai)
#pragma unroll
      for (int m = 0; m < 4; ++m) {
        bf16_t* rowp = O + (size_t)(row0 + ai * HALF + m * 16) * ldc + col0;
#pragma unroll
        for (int bj = 0; bj < 2; ++bj) {
          const f32x4 v0 = acc[ai][bj][m][0], v1 = acc[ai][bj][m][1];
          u32x4 w; w.x = pack2(v0[0], v0[1]); w.y = pack2(v0[2], v0[3]); w.z = pack2(v1[0], v1[1]); w.w = pack2(v1[2], v1[3]);
          *(u32x4*)(rowp + bj * HALF) = w;
        }
      }
  }
};
struct EpiSsdIn {
  static constexpr bool PERM = true;
  bf16_t* z; bf16_t* xbc; float* dt; const float* dt_bias;
  __device__ __forceinline__ void operator()(const f32x4 (&acc)[2][2][4][2], const Unit& u, int wr, int wc, int fr, int fq) const {
    const int row0 = u.pm * BM + wr * 64 + fr, colt = u.pn * BM + wc * 32 + 8 * fq;
    if (u.pn < 24) {
      bf16_t* base = u.pn < 8 ? z : xbc; const size_t ldc = u.pn < 8 ? 2048 : 4096; const int col0 = u.pn < 8 ? colt : colt - 2048;
#pragma unroll
      for (int ai = 0; ai < 2; ++ai)
#pragma unroll
        for (int m = 0; m < 4; ++m) {
          bf16_t* rowp = base + (size_t)(row0 + ai * HALF + m * 16) * ldc + col0;
#pragma unroll
          for (int bj = 0; bj < 2; ++bj) {
            const f32x4 v0 = acc[ai][bj][m][0], v1 = acc[ai][bj][m][1];
            u32x4 w; w.x = pack2(v0[0], v0[1]); w.y = pack2(v0[2], v0[3]); w.z = pack2(v1[0], v1[1]); w.w = pack2(v1[2], v1[3]);
            *(u32x4*)(rowp + bj * HALF) = w;
          }
        }
    } else {
      const int c0 = wc * 32 + 8 * fq;
      if (c0 < 64) {
#pragma unroll
        for (int ai = 0; ai < 2; ++ai)
#pragma unroll
          for (int m = 0; m < 4; ++m) {
            float* rowp = dt + (size_t)(row0 + ai * HALF + m * 16) * 64 + c0;
#pragma unroll
            for (int n = 0; n < 2; ++n) {
              const f32x4 v = acc[ai][0][m][n];
              f32x4 o;
#pragma unroll
              for (int e = 0; e < 4; ++e) o[e] = softplusf(v[e] + dt_bias[c0 + 4 * n + e]);
              *(f32x4*)(rowp + 4 * n) = o;
            }
          }
      }
    }
  }
};
struct EpiOut {
  static constexpr bool PERM = false;
  float* xres; const float* modv_layer; const float* rstd;
  __device__ __forceinline__ void operator()(const f32x4 (&acc)[2][2][4][2], const Unit& u, int wr, int wc, int fr, int fq) const {
    const int row0 = u.pm * BM + wr * 64 + fr, col0 = u.pn * BM + wc * 32 + 4 * fq;
#pragma unroll
    for (int ai = 0; ai < 2; ++ai)
#pragma unroll
      for (int m = 0; m < 4; ++m) {
        const int row = row0 + ai * HALF + m * 16;
        const int mrow = row < T_CTX ? 0 : 1 + ((row - T_CTX) >> 12);
        const float rs = rstd ? rstd[row] : 1.f;
        const float* gp = modv_layer + (size_t)mrow * 3072 + 2048 + col0;
        float* rowp = xres + (size_t)row * DM + col0;
#pragma unroll
        for (int bj = 0; bj < 2; ++bj)
#pragma unroll
          for (int n = 0; n < 2; ++n) {
            const f32x4 gv = *(const f32x4*)(gp + bj * HALF + n * 16);
            const f32x4 xv = *(const f32x4*)(rowp + bj * HALF + n * 16);
            *(f32x4*)(rowp + bj * HALF + n * 16) = ALPHA_RES * xv + gv * (acc[ai][bj][m][n] * rs);
          }
      }
  }
};
struct EpiLruGate {
  static constexpr bool PERM = true;
  bf16_t* gates; const float* gate_b;
  __device__ __forceinline__ void operator()(const f32x4 (&acc)[2][2][4][2], const Unit& u, int wr, int wc, int fr, int fq) const {
    const int nb = u.pn >> 2, dg = u.pn & 3;
    const int row0 = u.pm * BM + wr * 64 + fr, ch0 = nb * 256 + wc * 32 + 8 * fq;
#pragma unroll
    for (int ai = 0; ai < 2; ++ai)
#pragma unroll
      for (int m = 0; m < 4; ++m) {
        bf16_t* rowp = gates + ((size_t)dg * T_ALL + row0 + ai * HALF + m * 16) * 1024 + ch0;
#pragma unroll
        for (int bj = 0; bj < 2; ++bj) {
          const float* bp = gate_b + dg * 1024 + ch0 + bj * HALF;
          const f32x4 b0 = *(const f32x4*)bp, b1 = *(const f32x4*)(bp + 4);
          const f32x4 v0 = acc[ai][bj][m][0] + b0, v1 = acc[ai][bj][m][1] + b1;
          u32x4 w; w.x = pack2(sigmoidf(v0[0]), sigmoidf(v0[1])); w.y = pack2(sigmoidf(v0[2]), sigmoidf(v0[3]));
          w.z = pack2(sigmoidf(v1[0]), sigmoidf(v1[1])); w.w = pack2(sigmoidf(v1[2]), sigmoidf(v1[3]));
          *(u32x4*)(rowp + bj * HALF) = w;
        }
      }
  }
};
}

template <int KW, bool SILU>
__device__ __forceinline__ void phase_dwconv(const bf16_t* __restrict__ src, int ld_src, bf16_t* __restrict__ dst, int ld_dst, int CH,
                             const float* __restrict__ w, const float* __restrict__ b, bool colmajor, int bid, int nblk, int cxw) {
  const int tidx = opaque_tid(cxw);
  const int cpr = CH / 8;
  const size_t total = (size_t)T_ALL * cpr;
  for (size_t idx = (size_t)bid * NTHR + tidx; idx < total; idx += (size_t)nblk * NTHR) {
    int tok = (int)(idx / cpr), c0 = (int)(idx % cpr) * 8;
    TokInfo ti = tokinfo(tok);
    bool cm = colmajor && ti.s >= 32;
    int pos = seqpos2off(ti.l, cm);
    float acc[8];
#pragma unroll
    for (int e = 0; e < 8; ++e) acc[e] = b[c0 + e];
#pragma unroll
    for (int k = 0; k < KW; ++k) {
      int pp = pos + k - 1;
      if (pp < 0 || pp >= ti.L) continue;
      int tk = ti.base + seqpos2off(pp, cm);
      u32x4 xv = *(const u32x4*)(src + (size_t)tk * ld_src + c0);
      const float* wk = w + (size_t)k * CH + c0;
      acc[0] += wk[0] * bflo(xv.x); acc[1] += wk[1] * bfhi(xv.x);
      acc[2] += wk[2] * bflo(xv.y); acc[3] += wk[3] * bfhi(xv.y);
      acc[4] += wk[4] * bflo(xv.z); acc[5] += wk[5] * bfhi(xv.z);
      acc[6] += wk[6] * bflo(xv.w); acc[7] += wk[7] * bfhi(xv.w);
    }
    if (SILU) {
#pragma unroll
      for (int e = 0; e < 8; ++e) acc[e] = siluf(acc[e]);
    }
    u32x4 o;
    o.x = pack2(acc[0], acc[1]); o.y = pack2(acc[2], acc[3]); o.z = pack2(acc[4], acc[5]); o.w = pack2(acc[6], acc[7]);
    *(u32x4*)(dst + (size_t)tok * ld_dst + c0) = o;
  }
}

__device__ __forceinline__ void phase_ssd_conv(const Params& p, int slot, bool colmajor, int bid, int nblk, unsigned char* smem, int cxw) {
  const int tid = opaque_tid(cxw);
  const bf16_t* raw = (const bf16_t*)(p.scratch + SC_SSD_XBC);
  bf16_t* out = (bf16_t*)(p.scratch + SC_SSD_XBCC);
  bf16_t* XT = (bf16_t*)(p.scratch + SC_SSD_XT);
  bf16_t* BT = (bf16_t*)(p.scratch + SC_SSD_BT);
  bf16_t* BF = (bf16_t*)(p.scratch + SC_SSD_BF);
  bf16_t* CF = (bf16_t*)(p.scratch + SC_SSD_CF);
  const float* cw = p.ssd_conv_w + (size_t)slot * 4 * 4096;
  const float* cb = p.ssd_conv_b + slot * 4096;
  bf16_t* tl = (bf16_t*)smem;
  for (int item = bid; item < 384 * 64; item += nblk) {
    const int ptile = item >> 6, ct = item & 63;
    const int ptok0 = ptile * 64;
    TokInfo ti = tokinfo(ptok0);
    const bool cm = colmajor && ti.s >= 32;
    const int rr = tid >> 2, cpart = tid & 3;
    const int ch = ct * 64 + cpart * 16;
    const int pos = ti.l + rr;
    float acc[16];
#pragma unroll
    for (int e = 0; e < 16; ++e) acc[e] = cb[ch + e];
#pragma unroll
    for (int k = 0; k < 4; ++k) {
      int pp = pos + k - 1;
      if (pp < 0 || pp >= ti.L) continue;
      int tk = ti.base + seqpos2off(pp, cm);
      const bf16_t* rp = raw + (size_t)tk * 4096 + ch;
      u32x4 x0 = *(const u32x4*)rp, x1 = *(const u32x4*)(rp + 8);
      const float* wk = cw + (size_t)k * 4096 + ch;
      unsigned xw[8] = {x0.x, x0.y, x0.z, x0.w, x1.x, x1.y, x1.z, x1.w};
#pragma unroll
      for (int e = 0; e < 8; ++e) { acc[2 * e] += wk[2 * e] * bflo(xw[e]); acc[2 * e + 1] += wk[2 * e + 1] * bfhi(xw[e]); }
    }
    u32x4 o0, o1;
    o0.x = pack2(siluf(acc[0]), siluf(acc[1])); o0.y = pack2(siluf(acc[2]), siluf(acc[3]));
    o0.z = pack2(siluf(acc[4]), siluf(acc[5])); o0.w = pack2(siluf(acc[6]), siluf(acc[7]));
    o1.x = pack2(siluf(acc[8]), siluf(acc[9])); o1.y = pack2(siluf(acc[10]), siluf(acc[11]));
    o1.z = pack2(siluf(acc[12]), siluf(acc[13])); o1.w = pack2(siluf(acc[14]), siluf(acc[15]));
    __syncthreads();
    *(u32x4*)(tl + rr * 72 + cpart * 16) = o0;
    *(u32x4*)(tl + rr * 72 + cpart * 16 + 8) = o1;
    __syncthreads();
    if (ct < 32) {
      bf16_t* op = out + (size_t)(ptok0 + rr) * 2048 + ch;
      *(u32x4*)op = o0; *(u32x4*)(op + 8) = o1;
      const int crow = tid >> 2, part = tid & 3;
      unsigned wv[8];
#pragma unroll
      for (int e = 0; e < 8; ++e) {
        unsigned lo = tl[(part * 16 + 2 * e) * 72 + crow], hi = tl[(part * 16 + 2 * e + 1) * 72 + crow];
        wv[e] = lo | (hi << 16);
      }
      bf16_t* dp = XT + (size_t)(ct * 64 + crow) * T_ALL + ptok0 + part * 16;
      u32x4 t0, t1;
      t0.x = wv[0]; t0.y = wv[1]; t0.z = wv[2]; t0.w = wv[3]; t1.x = wv[4]; t1.y = wv[5]; t1.z = wv[6]; t1.w = wv[7];
      *(u32x4*)dp = t0; *(u32x4*)(dp + 8) = t1;
    } else {
      const bool isB = ct < 48;
      const int cq = (ct - (isB ? 32 : 48));
      const int g = cq >> 1, chhalf = cq & 1;
      const int lane = tid & 63, r = lane & 31, hh = lane >> 5;
      bf16_t* F = isB ? BF : CF;
#pragma unroll
      for (int i = 0; i < 2; ++i) {
        const int f = (tid >> 6) + 4 * i;
        const int rt2 = f >> 2, kk4 = f & 3;
        const u32x4 v = *(const u32x4*)(tl + (32 * rt2 + r) * 72 + 16 * kk4 + 8 * hh);
        const size_t rt = (size_t)(ptok0 >> 5) + rt2;
        *(u32x4*)(F + (((rt * 8 + g) * 8 + chhalf * 4 + kk4) * 64 + lane) * 8) = v;
      }
      if (isB) {
#pragma unroll
        for (int i = 0; i < 2; ++i) {
          const int f = (tid >> 6) + 4 * i;
          const int nt2 = f >> 2, ts4 = f & 3;
          unsigned wv[4];
#pragma unroll
          for (int e = 0; e < 4; ++e) {
            unsigned lo = tl[(16 * ts4 + 8 * hh + 2 * e) * 72 + 32 * nt2 + r], hi = tl[(16 * ts4 + 8 * hh + 2 * e + 1) * 72 + 32 * nt2 + r];
            wv[e] = lo | (hi << 16);
          }
          u32x4 v; v.x = wv[0]; v.y = wv[1]; v.z = wv[2]; v.w = wv[3];
          const size_t ts = (size_t)(ptok0 >> 4) + ts4;
          *(u32x4*)(BT + (((ts * 8 + g) * 4 + chhalf * 2 + nt2) * 64 + lane) * 8) = v;
        }
      }
    }
  }
}

#define SH_STRIDE 136
__device__ __forceinline__ int rowmap(int e, int hh) { return (e & 3) + 8 * (e >> 2) + 4 * hh; }
__device__ __forceinline__ bf16x8 pack8(float a0, float a1, float a2, float a3, float a4, float a5, float a6, float a7) {
  u32x4 v; v.x = pack2(a0, a1); v.y = pack2(a2, a3); v.z = pack2(a4, a5); v.w = pack2(a6, a7);
  return __builtin_bit_cast(bf16x8, v);
}
__device__ __forceinline__ void phase_ssd_scan(const Params& p, int slot, bool colmajor, int bid, int nblk, unsigned char* smem, int cxw) {
  const int tid = opaque_tid(cxw), lane = tid & 63, w = tid >> 6, r = lane & 31, hh = lane >> 5;
  const int it = w >> 1, pt = w & 1;
  const bf16_t* xbcc = (const bf16_t*)(p.scratch + SC_SSD_XBCC);
  const bf16_t* XT = (const bf16_t*)(p.scratch + SC_SSD_XT);
  const bf16_t* BT = (const bf16_t*)(p.scratch + SC_SSD_BT);
  const bf16_t* BF = (const bf16_t*)(p.scratch + SC_SSD_BF);
  const bf16_t* CF = (const bf16_t*)(p.scratch + SC_SSD_CF);
  const float* dtb = (const float*)(p.scratch + SC_SSD_DT);
  bf16_t* ybuf = (bf16_t*)(p.scratch + SC_SSD_XBC);
  bf16_t* sXr = (bf16_t*)smem;
  bf16_t* sXs = sXr + 64 * 72;
  bf16_t* sH = sXs + 64 * 72;
  float* sW = (float*)(sH + 2 * 64 * SH_STRIDE);
  float* myW = sW + w * 256;
  for (int item = bid; item < 36 * 64; item += nblk) {
    int s, h, dir;
    if (item < 256) { s = 32 + (item >> 6); h = (item & 63) >> 1; dir = item & 1; }
    else { int itx = item - 256; s = itx >> 6; h = (itx & 63) >> 1; dir = itx & 1; }
    const int L = s < 32 ? 256 : 4096;
    const int base = s < 32 ? s * 256 : T_CTX + (s - 32) * 4096;
    const bool cm = colmajor && s >= 32;
    const int g = h >> 2;
    const float Aval = -expf(p.ssd_a_log[(slot * 2 + dir) * 32 + h]);
    const int nchunks = L >> 6;
    const int pcol = 32 * pt + r;
    f32x16 hacc[2];
    if (s >= 32) {
      const float* h0 = p.state_ssd + ((((size_t)(s - 32) * 2 + slot) * 2 + dir) * 32 + h) * 8192 + (size_t)pcol * 128;
#pragma unroll
      for (int t2 = 0; t2 < 2; ++t2)
#pragma unroll
        for (int qd = 0; qd < 4; ++qd) {
          f32x4 v = *(const f32x4*)(h0 + 32 * (2 * it + t2) + 8 * qd + 4 * hh);
          hacc[t2][4 * qd] = v.x; hacc[t2][4 * qd + 1] = v.y; hacc[t2][4 * qd + 2] = v.z; hacc[t2][4 * qd + 3] = v.w;
        }
    } else {
#pragma unroll
      for (int t2 = 0; t2 < 2; ++t2)
#pragma unroll
        for (int e = 0; e < 16; ++e) hacc[t2][e] = 0.f;
    }
#pragma unroll
    for (int t2 = 0; t2 < 2; ++t2)
#pragma unroll
      for (int qd = 0; qd < 4; ++qd) {
        u32x2 o; o.x = pack2(hacc[t2][4 * qd], hacc[t2][4 * qd + 1]); o.y = pack2(hacc[t2][4 * qd + 2], hacc[t2][4 * qd + 3]);
        *(u32x2*)(sH + pcol * SH_STRIDE + 32 * (2 * it + t2) + 8 * qd + 4 * hh) = o;
      }
    float dtv; u32x4 xtr[2]; bf16x8 cfr[8], bfr[2][8], btf[2][4];
    const bool need0 = dir == 0 ? true : (it == 0);
    const bool need1 = dir == 0 ? (it == 1) : true;
#define SCAN_PTOK(c) (base + 64 * (dir ? nchunks - 1 - (c) : (c)))
#define SCAN_LOAD_DTX(pt0) do { \
      const int tok_ = base + seqpos2off((pt0) - base + lane, cm); \
      dtv = dtb[(size_t)tok_ * 64 + dir * 32 + h]; \
      _Pragma("unroll") for (int i_ = 0; i_ < 2; ++i_) { const int q_ = tid + i_ * 256; \
        xtr[i_] = *(const u32x4*)(XT + (size_t)(h * 64 + (q_ >> 3)) * T_ALL + (pt0) + (q_ & 7) * 8); } } while (0)
#define SCAN_LOAD_CB(pt0) do { \
      const bf16_t* cf_ = CF + ((((size_t)((pt0) >> 5) + it) * 8 + g) * 8) * 512 + lane * 8; \
      _Pragma("unroll") for (int kk = 0; kk < 8; ++kk) cfr[kk] = *(const bf16x8*)(cf_ + kk * 512); \
      if (need0) { const bf16_t* bf_ = BF + ((((size_t)((pt0) >> 5)) * 8 + g) * 8) * 512 + lane * 8; \
        _Pragma("unroll") for (int kk = 0; kk < 8; ++kk) bfr[0][kk] = *(const bf16x8*)(bf_ + kk * 512); } \
      if (need1) { const bf16_t* bf_ = BF + ((((size_t)((pt0) >> 5) + 1) * 8 + g) * 8) * 512 + lane * 8; \
        _Pragma("unroll") for (int kk = 0; kk < 8; ++kk) bfr[1][kk] = *(const bf16x8*)(bf_ + kk * 512); } } while (0)
#define SCAN_LOAD_BT(pt0) do { \
      _Pragma("unroll") for (int t2 = 0; t2 < 2; ++t2) { \
        _Pragma("unroll") for (int kk = 0; kk < 4; ++kk) \
          btf[t2][kk] = *(const bf16x8*)(BT + (((((size_t)((pt0) >> 4) + kk) * 8 + g) * 4 + 2 * it + t2) * 64 + lane) * 8); } } while (0)
    {
      const int p0 = SCAN_PTOK(0);
      SCAN_LOAD_DTX(p0); SCAN_LOAD_CB(p0); SCAN_LOAD_BT(p0);
    }
    for (int ci = 0; ci < nchunks; ++ci) {
      const int ptok0 = SCAN_PTOK(ci);
      const int cin = ci + 1 < nchunks ? ci + 1 : ci;
      const int ptokN = SCAN_PTOK(cin);
      const int buf = ci & 1;
      __syncthreads();
      float decE;
      {
        float c = dtv * Aval;
        if (dir == 0) {
#pragma unroll
          for (int off = 1; off < 64; off <<= 1) { float t = shfl_idx_f(c, lane - off); if (lane >= off) c += t; }
        } else {
#pragma unroll
          for (int off = 1; off < 64; off <<= 1) { float t = shfl_idx_f(c, lane + off); if (lane + off < 64) c += t; }
        }
        const float cE = shfl_idx_f(c, dir ? 0 : 63);
        myW[lane] = dtv; myW[64 + lane] = c; myW[128 + lane] = __expf(c); myW[192 + lane] = dtv * __expf(cE - c);
        decE = __expf(cE);
      }
#pragma unroll
      for (int i = 0; i < 2; ++i) {
        const int q = tid + i * 256, prow = q >> 3, j8 = (q & 7) * 8;
        const u32x4 raw = xtr[i];
        *(u32x4*)(sXr + prow * 72 + j8) = raw;
        f32x4 f0 = *(const f32x4*)(myW + 192 + j8), f1 = *(const f32x4*)(myW + 192 + j8 + 4);
        u32x4 sc;
        sc.x = pack2(bflo(raw.x) * f0.x, bfhi(raw.x) * f0.y); sc.y = pack2(bflo(raw.y) * f0.z, bfhi(raw.y) * f0.w);
        sc.z = pack2(bflo(raw.z) * f1.x, bfhi(raw.z) * f1.y); sc.w = pack2(bflo(raw.w) * f1.z, bfhi(raw.w) * f1.w);
        *(u32x4*)(sXs + prow * 72 + j8) = sc;
      }
      __syncthreads();
      SCAN_LOAD_DTX(ptokN);
#pragma unroll
      for (int t2 = 0; t2 < 2; ++t2) {
#pragma unroll
        for (int e = 0; e < 16; ++e) hacc[t2][e] *= decE;
        const bf16_t* xs = sXs + pcol * 72 + 8 * hh;
#pragma unroll
        for (int kk = 0; kk < 4; ++kk)
          hacc[t2] = __builtin_amdgcn_mfma_f32_32x32x16_bf16(btf[t2][kk], *(const bf16x8*)(xs + 16 * kk), hacc[t2], 0, 0, 0);
#pragma unroll
        for (int qd = 0; qd < 4; ++qd) {
          u32x2 o; o.x = pack2(hacc[t2][4 * qd], hacc[t2][4 * qd + 1]); o.y = pack2(hacc[t2][4 * qd + 2], hacc[t2][4 * qd + 3]);
          *(u32x2*)(sH + (buf ^ 1) * 64 * SH_STRIDE + pcol * SH_STRIDE + 32 * (2 * it + t2) + 8 * qd + 4 * hh) = o;
        }
      }
      f32x16 acc;
#pragma unroll
      for (int e = 0; e < 16; ++e) acc[e] = 0.f;
      {
        const bf16_t* hp = sH + buf * 64 * SH_STRIDE + pcol * SH_STRIDE + 8 * hh;
#pragma unroll
        for (int kk = 0; kk < 8; ++kk) acc = __builtin_amdgcn_mfma_f32_32x32x16_bf16(cfr[kk], *(const bf16x8*)(hp + 16 * kk), acc, 0, 0, 0);
      }
#pragma unroll
      for (int qd = 0; qd < 4; ++qd) {
        f32x4 ec = *(const f32x4*)(myW + 128 + 32 * it + 8 * qd + 4 * hh);
        acc[4 * qd] *= ec.x; acc[4 * qd + 1] *= ec.y; acc[4 * qd + 2] *= ec.z; acc[4 * qd + 3] *= ec.w;
      }
      const int icol = 32 * it + r;
      const float ci_ = myW[64 + icol];
#pragma unroll
      for (int jt = 0; jt < 2; ++jt) {
        const bool needed = jt == 0 ? need0 : need1;
        if (needed) {
          f32x16 X;
#pragma unroll
          for (int e = 0; e < 16; ++e) X[e] = 0.f;
#pragma unroll
          for (int kk = 0; kk < 8; ++kk) X = __builtin_amdgcn_mfma_f32_32x32x16_bf16(bfr[jt][kk], cfr[kk], X, 0, 0, 0);
#pragma unroll
          for (int qd = 0; qd < 4; ++qd) {
            const int j0 = 32 * jt + 8 * qd + 4 * hh;
            f32x4 cj = *(const f32x4*)(myW + 64 + j0), dj = *(const f32x4*)(myW + j0);
            float cjv[4] = {cj.x, cj.y, cj.z, cj.w}, djv[4] = {dj.x, dj.y, dj.z, dj.w};
#pragma unroll
            for (int u = 0; u < 4; ++u) {
              const int j = j0 + u;
              const bool ok = dir == 0 ? (j <= icol) : (j >= icol);
              const float m = __expf(ci_ - cjv[u]) * djv[u];
              X[4 * qd + u] = ok ? X[4 * qd + u] * m : 0.f;
            }
          }
#pragma unroll
          for (int sk = 0; sk < 2; ++sk) {
            bf16x8 afr = pack8(X[8 * sk], X[8 * sk + 1], X[8 * sk + 2], X[8 * sk + 3], X[8 * sk + 4], X[8 * sk + 5], X[8 * sk + 6], X[8 * sk + 7]);
            const bf16_t* xp = sXr + pcol * 72 + 32 * jt + 16 * sk + 4 * hh;
            u32x2 lo = *(const u32x2*)xp, hi = *(const u32x2*)(xp + 8);
            u32x4 xv; xv.x = lo.x; xv.y = lo.y; xv.z = hi.x; xv.w = hi.y;
            acc = __builtin_amdgcn_mfma_f32_32x32x16_bf16(afr, __builtin_bit_cast(bf16x8, xv), acc, 0, 0, 0);
          }
        }
      }
      SCAN_LOAD_CB(ptokN);
      {
        bf16_t* yo = ybuf + ((size_t)dir * T_ALL + ptok0 + 32 * it) * 2048 + h * 64 + pcol;
#pragma unroll
        for (int e = 0; e < 16; ++e) yo[(size_t)rowmap(e, hh) * 2048] = f2bf(acc[e]);
      }
      SCAN_LOAD_BT(ptokN);
    }
#undef SCAN_PTOK
#undef SCAN_LOAD_DTX
#undef SCAN_LOAD_CB
#undef SCAN_LOAD_BT
    if (s < 32) {
      float* ho = p.out_ssd + ((((size_t)s * 2 + slot) * 2 + dir) * 32 + h) * 8192 + (size_t)pcol * 128;
#pragma unroll
      for (int t2 = 0; t2 < 2; ++t2)
#pragma unroll
        for (int qd = 0; qd < 4; ++qd) {
          f32x4 v; v.x = hacc[t2][4 * qd]; v.y = hacc[t2][4 * qd + 1]; v.z = hacc[t2][4 * qd + 2]; v.w = hacc[t2][4 * qd + 3];
          *(f32x4*)(ho + 32 * (2 * it + t2) + 8 * qd + 4 * hh) = v;
        }
    }
    __syncthreads();
  }
}

__device__ __forceinline__ void phase_ssd_gate(const Params& p, int slot, int bid, int nblk, int cxw) {
  const int tidx = opaque_tid(cxw);
  bf16_t* zb = (bf16_t*)(p.scratch + SC_SSD_Z);
  const bf16_t* yfb = (const bf16_t*)(p.scratch + SC_SSD_XBC);
  const bf16_t* ybb = yfb + (size_t)T_ALL * 2048;
  const bf16_t* xbcc = (const bf16_t*)(p.scratch + SC_SSD_XBCC);
  int lane = tidx & 63, wv = tidx >> 6;
  for (int row = bid * 4 + wv; row < T_ALL; row += nblk * 4) {
    float ss = 0.f;
    TokInfo ti = tokinfo(row);
    const int prow = ti.base + seqpos2off(ti.l, slot == 1 && ti.s >= 32);
#pragma unroll
    for (int j = 0; j < 4; ++j) {
      int c0 = j * 512 + lane * 8;
      u32x4 zv = *(const u32x4*)(zb + (size_t)row * 2048 + c0);
      u32x4 fv = *(const u32x4*)(yfb + (size_t)prow * 2048 + c0);
      u32x4 bv = *(const u32x4*)(ybb + (size_t)prow * 2048 + c0);
      u32x4 xv = *(const u32x4*)(xbcc + (size_t)prow * 2048 + c0);
      float dsk = p.ssd_d[slot * 32 + (c0 >> 6)];
      unsigned zw[4] = {zv.x, zv.y, zv.z, zv.w}, fw[4] = {fv.x, fv.y, fv.z, fv.w}, bw[4] = {bv.x, bv.y, bv.z, bv.w}, xw[4] = {xv.x, xv.y, xv.z, xv.w};
      unsigned ow[4];
#pragma unroll
      for (int e = 0; e < 4; ++e) {
        float y0 = (bflo(fw[e]) + bflo(bw[e]) + dsk * bflo(xw[e])) * siluf(bflo(zw[e]));
        float y1 = (bfhi(fw[e]) + bfhi(bw[e]) + dsk * bfhi(xw[e])) * siluf(bfhi(zw[e]));
        ss += y0 * y0 + y1 * y1;
        ow[e] = pack2(y0, y1);
      }
      u32x4 o; o.x = ow[0]; o.y = ow[1]; o.z = ow[2]; o.w = ow[3];
      *(u32x4*)(zb + (size_t)row * 2048 + c0) = o;
    }
#pragma unroll
    for (int o = 32; o > 0; o >>= 1) ss += shfl_xor_f(ss, o, lane);
    if (lane == 0) p.rstd[row] = rsqrtf(ss * (1.f / 2048.f) + 1e-5f);
  }
}

#define HY_UOFF 32768
__device__ __forceinline__ void hy_stage_conv(const Params& p, const bf16_t* __restrict__ row, int ch, bf16_t* dst, int dstStride, int dstPad,
                                              int nelem, int L, int tid) {
  const float w0 = p.hy_conv_w[ch], w1 = p.hy_conv_w[3072 + ch], w2 = p.hy_conv_w[2 * 3072 + ch], bb = p.hy_conv_b[ch];
  for (int q = tid; q < nelem / 8; q += NTHR) {
    const int e0 = q * 8, b = e0 / L, t0 = e0 & (L - 1);
    u32x4 raw = *(const u32x4*)(row + e0);
    float x[10];
    x[0] = t0 > 0 ? bf2f(row[e0 - 1]) : 0.f;
    x[9] = t0 + 8 < L ? bf2f(row[e0 + 8]) : 0.f;
    x[1] = bflo(raw.x); x[2] = bfhi(raw.x); x[3] = bflo(raw.y); x[4] = bfhi(raw.y);
    x[5] = bflo(raw.z); x[6] = bfhi(raw.z); x[7] = bflo(raw.w); x[8] = bfhi(raw.w);
    float o[8];
#pragma unroll
    for (int j = 0; j < 8; ++j) o[j] = w0 * x[j] + w1 * x[j + 1] + w2 * x[j + 2] + bb;
    u32x4 ov; ov.x = pack2(o[0], o[1]); ov.y = pack2(o[2], o[3]); ov.z = pack2(o[4], o[5]); ov.w = pack2(o[6], o[7]);
    *(u32x4*)(dst + b * dstStride + dstPad + t0) = ov;
  }
}

__device__ __forceinline__ void phase_hy_longconv(const Params& p, int bid, int nblk, unsigned char* smem, int cxw) {
  const int tid = opaque_tid(cxw), lane = tid & 63, w = tid >> 6, r = lane & 31, hh = lane >> 5;
  const bf16_t* projT = (const bf16_t*)(p.scratch + SC_HY_PROJT);
  bf16_t* yT = (bf16_t*)(p.scratch + SC_HY_YT);
  unsigned* Rc0 = (unsigned*)smem;
  unsigned* Rc1 = Rc0 + 4096;
  bf16_t* G = (bf16_t*)smem;
  bf16_t* U = (bf16_t*)(smem + HY_UOFF);
  for (int item = bid; item < 2048; item += nblk) {
    const bool lat = item < 1024;
    const int c = item & 1023;
    const int L = lat ? 4096 : 256, NB = lat ? 4 : 32, RL = lat ? 8192 : 512, Lm1 = L - 1;
    const int PAD = lat ? 224 : 0, US = L + 2 * PAD;
    const int tokbase = lat ? T_CTX : 0;
    const int nI = L >> 5, nelem = NB * L;
    const int TPW = lat ? 4 : 2;
    __syncthreads();
    if (lat) {
      for (int q = tid; q < 4 * 56; q += NTHR) {
        int b = q / 56, k = q % 56;
        int off = k < 28 ? k * 8 : 224 + 4096 + (k - 28) * 8;
        unsigned zz = 0u; asm volatile("" : "+v"(zz));
        u32x4 z4 = {zz, zz, zz, zz};
        *(u32x4*)(U + b * US + off) = z4;
      }
    }
    hy_stage_conv(p, projT + (size_t)c * T_ALL + tokbase, c, U, US, PAD, nelem, L, tid);
    int Icol[4], bcol[4];
#pragma unroll
    for (int tt = 0; tt < 4; ++tt) {
      int n = (w * TPW + tt) * 32 + r;
      Icol[tt] = lat ? (n >> 2) : (n >> 5);
      bcol[tt] = lat ? (n & 3) : (n & 31);
    }
    const int Ilo_w = lat ? 32 * w : 2 * w, Ihi_w = lat ? 32 * w + 31 : 2 * w + 1;
    const int dlo = Ilo_w - (nI - 1), dhi = Ihi_w;
    for (int order = 0; order < 2; ++order) {
      {
        const bf16_t* src = (lat ? p.rtab1 : p.rtab0) + (size_t)(order * 1024 + c) * RL;
        for (int q = tid; q < RL / 8; q += NTHR) {
          u32x4 cv = *(const u32x4*)(src + q * 8);
          unsigned nx = (q + 1 < RL / 8) ? *(const unsigned*)(src + q * 8 + 8) : 0u;
          *(u32x4*)(Rc0 + q * 4) = cv;
          u32x4 sv;
          sv.x = (cv.x >> 16) | (cv.y << 16); sv.y = (cv.y >> 16) | (cv.z << 16);
          sv.z = (cv.z >> 16) | (cv.w << 16); sv.w = (cv.w >> 16) | (nx << 16);
          *(u32x4*)(Rc1 + q * 4) = sv;
        }
      }
      __syncthreads();
      f32x16 acc[4];
#pragma unroll
      for (int tt = 0; tt < 4; ++tt)
#pragma unroll
        for (int e = 0; e < 16; ++e) acc[tt][e] = 0.f;
      for (int d = dlo; d <= dhi; ++d) {
#pragma unroll
        for (int kk = 0; kk < 2; ++kk) {
          const int y0 = Lm1 - 32 * d - r + 16 * kk + 8 * hh;
          const int par = y0 & 1;
          const unsigned* rp = (par ? Rc1 : Rc0) + ((y0 - par) >> 1);
          u32x4 av; av.x = rp[0]; av.y = rp[1]; av.z = rp[2]; av.w = rp[3];
          bf16x8 af = __builtin_bit_cast(bf16x8, av);
#pragma unroll
          for (int tt = 0; tt < 4; ++tt) {
            if (tt < TPW) {
              const int tile = w * TPW + tt;
              const int Ilo_t = lat ? 8 * tile : tile, Ihi_t = lat ? 8 * tile + 7 : tile;
              if (d >= Ilo_t - (nI - 1) && d <= Ihi_t) {
                const bf16_t* bp = U + bcol[tt] * US + PAD + 32 * (Icol[tt] - d) + 16 * kk + 8 * hh;
                bf16x8 bfr = *(const bf16x8*)bp;
                acc[tt] = __builtin_amdgcn_mfma_f32_32x32x16_bf16(af, bfr, acc[tt], 0, 0, 0);
              }
            }
          }
        }
      }
      __syncthreads();
      hy_stage_conv(p, projT + (size_t)((1 + order) * 1024 + c) * T_ALL + tokbase, (1 + order) * 1024 + c, G, L, 0, nelem, L, tid);
      __syncthreads();
      const float inv = 1.f / p.knorm[((lat ? 1 : 0) * 2 + order) * 1024 + c];
      const float bias = p.hy_f_bias[order * 1024 + c];
#pragma unroll
      for (int tt = 0; tt < 4; ++tt) {
        if (tt < TPW) {
#pragma unroll
          for (int qd = 0; qd < 4; ++qd) {
            const int t0 = 32 * Icol[tt] + 8 * qd + 4 * hh;
            bf16_t* up = U + bcol[tt] * US + PAD + t0;
            u32x2 uc = *(const u32x2*)up;
            u32x2 gg = *(const u32x2*)(G + bcol[tt] * L + t0);
            float r0 = (inv * acc[tt][4 * qd] + bias * bflo(uc.x)) * bflo(gg.x);
            float r1 = (inv * acc[tt][4 * qd + 1] + bias * bfhi(uc.x)) * bfhi(gg.x);
            float r2 = (inv * acc[tt][4 * qd + 2] + bias * bflo(uc.y)) * bflo(gg.y);
            float r3 = (inv * acc[tt][4 * qd + 3] + bias * bfhi(uc.y)) * bfhi(gg.y);
            if (order == 1) {
              u32x2 zz = *(const u32x2*)(projT + (size_t)(3072 + c) * T_ALL + tokbase + bcol[tt] * L + t0);
              r0 *= siluf(bflo(zz.x)); r1 *= siluf(bfhi(zz.x)); r2 *= siluf(bflo(zz.y)); r3 *= siluf(bfhi(zz.y));
            }
            u32x2 ov; ov.x = pack2(r0, r1); ov.y = pack2(r2, r3);
            *(u32x2*)up = ov;
          }
        }
      }
      __syncthreads();
    }
    for (int q = tid; q < nelem / 8; q += NTHR) {
      const int e0 = q * 8, b = e0 / L, t0 = e0 & (L - 1);
      *(u32x4*)(yT + (size_t)c * T_ALL + tokbase + e0) = *(const u32x4*)(U + b * US + PAD + t0);
    }
  }
}

__device__ __forceinline__ void phase_hy_transpose(const Params& p, int bid, int nblk, unsigned char* smem, int cxw) {
  const int tid = opaque_tid(cxw);
  const bf16_t* yT = (const bf16_t*)(p.scratch + SC_HY_YT);
  bf16_t* yg = (bf16_t*)(p.scratch + SC_HY_YG);
  bf16_t* tl = (bf16_t*)smem;
  for (int item = bid; item < 16 * (T_ALL / 64); item += nblk) {
    const int cb = item & 15, tb = item >> 4;
    __syncthreads();
#pragma unroll
    for (int i = 0; i < 2; ++i) {
      int q = tid + i * 256, cr = q >> 3, t8 = (q & 7) * 8;
      u32x4 v = *(const u32x4*)(yT + (size_t)(cb * 64 + cr) * T_ALL + tb * 64 + t8);
      unsigned wv[4] = {v.x, v.y, v.z, v.w};
#pragma unroll
      for (int e = 0; e < 4; ++e) {
        tl[(t8 + 2 * e) * 72 + cr] = (bf16_t)(wv[e] & 0xffffu);
        tl[(t8 + 2 * e + 1) * 72 + cr] = (bf16_t)(wv[e] >> 16);
      }
    }
    __syncthreads();
#pragma unroll
    for (int i = 0; i < 2; ++i) {
      int q = tid + i * 256, tr = q >> 3, c8 = (q & 7) * 8;
      *(u32x4*)(yg + (size_t)(tb * 64 + tr) * 1024 + cb * 64 + c8) = *(const u32x4*)(tl + tr * 72 + c8);
    }
  }
}

__device__ __forceinline__ void lru_ab(const bf16_t* gates, const bf16_t* xc, int dir, int tok, int c, float sp, float& a, float& bx) {
  float r = bf2f(gates[((size_t)(dir * 2 + 0) * T_ALL + tok) * 1024 + c]);
  float i = bf2f(gates[((size_t)(dir * 2 + 1) * T_ALL + tok) * 1024 + c]);
  float x = bf2f(xc[(size_t)tok * 1024 + c]);
  float log_a = -8.f * r * sp;
  a = __expf(log_a);
  float m = sqrtf(fmaxf(1.f - __expf(2.f * log_a), 0.f));
  bx = m * i * x;
}
__device__ __forceinline__ void phase_lru_scan_chunks(const Params& p, int pass, int bid, int nblk, int cxw) {
  const int tidx = opaque_tid(cxw);
  const bf16_t* gates = (const bf16_t*)(p.scratch + SC_LRU_GATES);
  const bf16_t* xc = (const bf16_t*)(p.scratch + SC_LRU_XC);
  bf16_t* ybuf = (bf16_t*)(p.scratch + SC_LRU_Y);
  for (int item = bid; item < 192 * 8; item += nblk) {
    int chunk = item >> 3, dir = (item >> 2) & 1, cb = item & 3;
    int c = cb * 256 + tidx;
    float sp = softplusf(-p.lru_a_param[dir * 1024 + c]);
    int tok0 = chunk * 128;
    float A = 1.f, h = (pass == 0) ? 0.f : p.lru_hin[((size_t)dir * 192 + chunk) * 1024 + c];
    for (int j = 0; j < 128; ++j) {
      int tok = dir ? tok0 + 127 - j : tok0 + j;
      float a, bx;
      lru_ab(gates, xc, dir, tok, c, sp, a, bx);
      h = a * h + bx; A *= a;
      if (pass == 2) ybuf[((size_t)dir * T_ALL + tok) * 1024 + c] = f2bf(h);
    }
    if (pass == 0) {
      float* ag = p.lru_agg + (((size_t)dir * 192 + chunk) * 1024 + c) * 2;
      ag[0] = A; ag[1] = h;
    }
  }
}
__device__ __forceinline__ void phase_lru_scan_carry(const Params& p, int bid, int nblk, int cxw) {
  const int tidx = opaque_tid(cxw);
  for (int item = bid; item < 36 * 8; item += nblk) {
    int s = item >> 3, dir = (item >> 2) & 1, cb = item & 3;
    int c = cb * 256 + tidx;
    int nch = s < 32 ? 2 : 32;
    int ch0 = s < 32 ? s * 2 : 64 + (s - 32) * 32;
    float h = s < 32 ? 0.f : p.state_lru[((size_t)(s - 32) * 2 + dir) * 1024 + c];
    for (int k = 0; k < nch; ++k) {
      int chunk = dir ? ch0 + nch - 1 - k : ch0 + k;
      size_t idx = ((size_t)dir * 192 + chunk) * 1024 + c;
      p.lru_hin[idx] = h;
      h = p.lru_agg[idx * 2] * h + p.lru_agg[idx * 2 + 1];
    }
    if (s < 32) p.out_lru[((size_t)s * 2 + dir) * 1024 + c] = h;
  }
}
__device__ __forceinline__ void phase_lru_combine(const Params& p, int bid, int nblk, int cxw) {
  const int tidx = opaque_tid(cxw);
  const bf16_t* proj = (const bf16_t*)(p.scratch + SC_LRU_PROJ);
  const bf16_t* yf = (const bf16_t*)(p.scratch + SC_LRU_Y);
  const bf16_t* yb = yf + (size_t)T_ALL * 1024;
  bf16_t* yg = (bf16_t*)(p.scratch + SC_LRU_YG);
  const size_t total = (size_t)T_ALL * 128;
  for (size_t idx = (size_t)bid * NTHR + tidx; idx < total; idx += (size_t)nblk * NTHR) {
    int tok = (int)(idx >> 7), c0 = (int)(idx & 127) * 8;
    u32x4 fv = *(const u32x4*)(yf + (size_t)tok * 1024 + c0);
    u32x4 bv = *(const u32x4*)(yb + (size_t)tok * 1024 + c0);
    u32x4 zv = *(const u32x4*)(proj + (size_t)tok * 2048 + 1024 + c0);
    unsigned fw[4] = {fv.x, fv.y, fv.z, fv.w}, bw[4] = {bv.x, bv.y, bv.z, bv.w}, zw[4] = {zv.x, zv.y, zv.z, zv.w}, ow[4];
#pragma unroll
    for (int e = 0; e < 4; ++e)
      ow[e] = pack2((bflo(fw[e]) + bflo(bw[e])) * siluf(bflo(zw[e])), (bfhi(fw[e]) + bfhi(bw[e])) * siluf(bfhi(zw[e])));
    u32x4 o; o.x = ow[0]; o.y = ow[1]; o.z = ow[2]; o.w = ow[3];
    *(u32x4*)(yg + (size_t)tok * 1024 + c0) = o;
  }
}

enum { PH_PREP = 0, PH_MOD, PH_HYA, PH_HYB, PH_LNMOD, PH_INPROJ, PH_MIX1, PH_MIX2, PH_MIX3, PH_MIX4, PH_MIX5, PH_MIX6, PH_OUTPROJ };

struct Ctx { int bid, nblk, wave; unsigned char* smem; unsigned char* wg_smem; };

template <class Epi>
__device__ __forceinline__ void run_gemm(const Ctx& cx, const bf16_t* A, int lda, const bf16_t* Bt, int M, int N, int K, int grp_shift, int grp_bytes, const Epi& e) {
  pg8::Gemm g{A, Bt, M, N, K, lda, grp_shift, grp_bytes};
  pg8::StaticOrder S; S.init(M, N, gridDim.x, opaque_s(blockIdx.x));
  pg8::gemm_phase((PG8_LAS unsigned char*)cx.wg_smem, g, S, e, cx.wave);
}

__device__ __forceinline__ void run_phase(const Params& p, int ph, int layer, const Ctx& cx) {
  const int kind = layer % 3, slot = layer / 3;
  const int bid = opaque_s(cx.bid), nblk = cx.nblk;
  unsigned char* smem = cx.smem;
  switch (ph) {
    case PH_PREP: phase_prep(p, bid, nblk, smem, cx.wave); break;
    case PH_MOD: phase_mod(p, bid, nblk, smem, cx.wave); break;
    case PH_HYA: phase_hyfilt_a(p, bid, nblk, smem, cx.wave); break;
    case PH_HYB: phase_hyfilt_b(p, bid, nblk, smem, cx.wave); break;
    case PH_LNMOD: phase_lnmod(p, layer, bid, nblk, cx.wave); break;
    case PH_INPROJ:
      if (kind == 0) {
        pg8::EpiSsdIn e{(bf16_t*)(p.scratch + SC_SSD_Z), (bf16_t*)(p.scratch + SC_SSD_XBC), (float*)(p.scratch + SC_SSD_DT), p.ssd_dt_bias + slot * 64};
        run_gemm(cx, p.hbuf, 1024, p.wt_ssd_in + (size_t)slot * 6400 * 1024, T_ALL, 6400, 1024, 30, 0, e);
      } else if (kind == 1) {
        pg8::EpiBf16 e{(bf16_t*)(p.scratch + SC_HY_PROJT), (size_t)T_ALL};
        run_gemm(cx, p.wt_hy_in, 1024, p.hbuf, 4096, T_ALL, 1024, 30, 0, e);
      } else {
        pg8::EpiBf16 e{(bf16_t*)(p.scratch + SC_LRU_PROJ), (size_t)2048};
        run_gemm(cx, p.hbuf, 1024, p.wt_lru_in, T_ALL, 2048, 1024, 30, 0, e);
      }
      break;
    case PH_MIX1:
      if (kind == 0) phase_ssd_conv(p, slot, slot == 1, bid, nblk, smem, cx.wave);
      else if (kind == 1) phase_hy_longconv(p, bid, nblk, smem, cx.wave);
      else phase_dwconv<4, false>((const bf16_t*)(p.scratch + SC_LRU_PROJ), 2048, (bf16_t*)(p.scratch + SC_LRU_XC), 1024, 1024,
                                  p.lru_conv_w, p.lru_conv_b, false, bid, nblk, cx.wave);
      break;
    case PH_MIX2:
      if (kind == 0) phase_ssd_scan(p, slot, slot == 1, bid, nblk, smem, cx.wave);
      else if (kind == 1) phase_hy_transpose(p, bid, nblk, smem, cx.wave);
      else {
        pg8::EpiLruGate e{(bf16_t*)(p.scratch + SC_LRU_GATES), p.lru_gate_b};
        run_gemm(cx, (const bf16_t*)(p.scratch + SC_LRU_XC), 1024, p.wt_lru_gate, T_ALL, 4096, 256, 2, 512, e);
      }
      break;
    case PH_MIX3:
      if (kind == 0) phase_ssd_gate(p, slot, bid, nblk, cx.wave);
      else phase_lru_scan_chunks(p, 0, bid, nblk, cx.wave);
      break;
    case PH_MIX4: if (kind == 2) phase_lru_scan_carry(p, bid, nblk, cx.wave); break;
    case PH_MIX5: if (kind == 2) phase_lru_scan_chunks(p, 2, bid, nblk, cx.wave); break;
    case PH_MIX6: if (kind == 2) phase_lru_combine(p, bid, nblk, cx.wave); break;
    case PH_OUTPROJ: {
      const float* mv = p.modv + (size_t)layer * 5 * 3072;
      if (kind == 0) {
        pg8::EpiOut e{p.xres, mv, p.rstd};
        run_gemm(cx, (const bf16_t*)(p.scratch + SC_SSD_Z), 2048, p.wt_ssd_out + (size_t)slot * 1024 * 2048, T_ALL, 1024, 2048, 30, 0, e);
      } else if (kind == 1) {
        pg8::EpiOut e{p.xres, mv, nullptr};
        run_gemm(cx, (const bf16_t*)(p.scratch + SC_HY_YG), 1024, p.wt_hy_out, T_ALL, 1024, 1024, 30, 0, e);
      } else {
        pg8::EpiOut e{p.xres, mv, nullptr};
        run_gemm(cx, (const bf16_t*)(p.scratch + SC_LRU_YG), 1024, p.wt_lru_out, T_ALL, 1024, 1024, 30, 0, e);
      }
    } break;
  }
}

__global__ void __launch_bounds__(WG_THREADS, 2) k_mega(Params p) {
  __shared__ __attribute__((aligned(16))) unsigned char smem[WG_SMEM + 16];
  cg::grid_group grid = cg::this_grid();
  const int wave0 = __builtin_amdgcn_readfirstlane((int)(threadIdx.x >> 6));
  const int vb = wave0 >> 2;
  Ctx cx;
  cx.wave = wave0;
  cx.bid = 2 * blockIdx.x + vb; cx.nblk = 2 * gridDim.x; cx.smem = smem + vb * SMEM_BYTES; cx.wg_smem = smem;
  volatile LAS unsigned* xst = (volatile LAS unsigned*)(smem + WG_SMEM);
  if (threadIdx.x == 0) { xst[0] = 0u; xst[1] = 0u; }
  __syncthreads();
  const XcdBarrier xb = xcd_barrier_post(p.bar, xst);
  run_phase(p, PH_PREP, 0, cx);
  run_phase(p, PH_MOD, 0, cx);
  run_phase(p, PH_HYA, 0, cx);
  grid.sync();
  run_phase(p, PH_HYB, 0, cx);
  for (int layer = 0; layer < 4; ++layer) {
    const int kind = layer % 3;
    run_phase(p, PH_LNMOD, layer, cx);
    xcd_barrier(xb, cx.wave);
    run_phase(p, PH_INPROJ, layer, cx);
    xcd_barrier(xb, cx.wave);
    run_phase(p, PH_MIX1, layer, cx);
    xcd_barrier(xb, cx.wave);
    run_phase(p, PH_MIX2, layer, cx);
    xcd_barrier(xb, cx.wave);
    if (kind != 1) {
      run_phase(p, PH_MIX3, layer, cx);
      xcd_barrier(xb, cx.wave);
    }
    if (kind == 2) {
      run_phase(p, PH_MIX4, layer, cx);
      xcd_barrier(xb, cx.wave);
      run_phase(p, PH_MIX5, layer, cx);
      xcd_barrier(xb, cx.wave);
      run_phase(p, PH_MIX6, layer, cx);
      xcd_barrier(xb, cx.wave);
    }
    run_phase(p, PH_OUTPROJ, layer, cx);
    xcd_barrier(xb, cx.wave);
  }
  run_phase(p, PH_LNMOD, 4, cx);
}

static inline size_t align_up(size_t x) { return (x + 255) & ~(size_t)255; }

extern "C" void kernel_launch(void* const* d_in, const int* in_sizes, int n_in, void* d_out, int out_size, void* d_ws, size_t ws_size,
                              hipStream_t stream) {
  Params p{};
  const float** fp = (const float**)&p;
  for (int i = 0; i < 36; ++i) fp[i] = (const float*)d_in[i];
  float* out = (float*)d_out;
  p.xres = out;
  p.out_ssd = out + (size_t)T_ALL * 1024;
  p.out_lru = p.out_ssd + (size_t)32 * 2 * 2 * 32 * 64 * 128;
  unsigned char* w = (unsigned char*)d_ws;
  size_t off = 0;
  auto carve = [&](size_t bytes) { unsigned char* r = w + off; off = align_up(off + bytes); return r; };
  p.wt_ssd_in = (bf16_t*)carve((size_t)2 * 6400 * 1024 * 2);
  p.wt_ssd_out = (bf16_t*)carve((size_t)2 * 1024 * 2048 * 2);
  p.wt_hy_in = (bf16_t*)carve((size_t)4096 * 1024 * 2);
  p.wt_hy_out = (bf16_t*)carve((size_t)1024 * 1024 * 2);
  p.wt_lru_in = (bf16_t*)carve((size_t)2048 * 1024 * 2);
  p.wt_lru_out = (bf16_t*)carve((size_t)1024 * 1024 * 2);
  p.wt_lru_gate = (bf16_t*)carve((size_t)4 * 1024 * 256 * 2);
  p.modv = (float*)carve((size_t)4 * 5 * 3072 * 4);
  p.hdn2 = (float*)carve((size_t)4352 * 64 * 4);
  p.rtab0 = (bf16_t*)carve((size_t)2 * 1024 * 512 * 2);
  p.rtab1 = (bf16_t*)carve((size_t)2 * 1024 * 8192 * 2);
  p.knorm = (float*)carve((size_t)4 * 1024 * 4);
  p.hbuf = (bf16_t*)carve((size_t)T_ALL * 1024 * 2);
  p.rstd = (float*)carve((size_t)T_ALL * 4);
  p.lru_agg = (float*)carve((size_t)2 * 192 * 1024 * 2 * 4);
  p.lru_hin = (float*)carve((size_t)2 * 192 * 1024 * 4);
  p.bar = (unsigned*)carve((size_t)XCD_BAR_WORDS * 4);
  p.scratch = carve(SC_TOTAL);
  if (off > ws_size) return;

  static int grid_blocks = 0;
  if (!grid_blocks) {
    int dev = 0, cus = 0, per_cu = 0;
    hipGetDevice(&dev);
    hipDeviceGetAttribute(&cus, hipDeviceAttributeMultiprocessorCount, dev);
    hipOccupancyMaxActiveBlocksPerMultiprocessor(&per_cu, k_mega, WG_THREADS, 0);
    if (per_cu > 1) per_cu = 1;
    grid_blocks = cus * per_cu;
  }
  hipMemsetAsync(p.bar, 0, (size_t)XCD_BAR_WORDS * 4, stream);
  void* args[] = {&p};
  hipError_t e = hipLaunchCooperativeKernel((void*)k_mega, dim3(grid_blocks), dim3(WG_THREADS), args, 0, stream);
  if (e != hipSuccess) fprintf(stderr, "cooperative launch failed: %s (grid %d)\n", hipGetErrorString(e), grid_blocks);
}
```

```cpp
#include <hip/hip_runtime.h>
#include <hip/hip_bf16.h>
#include <hip/hip_cooperative_groups.h>
#include <stdint.h>
#include <cstdio>
namespace cg = cooperative_groups;

typedef unsigned short bf16_t;
typedef __attribute__((ext_vector_type(8))) short bf16x8;
typedef __attribute__((ext_vector_type(16))) float f32x16;
typedef __attribute__((ext_vector_type(4))) unsigned int u32x4;
typedef __attribute__((ext_vector_type(2))) unsigned int u32x2;
typedef __attribute__((ext_vector_type(4))) float f32x4;
typedef float f32x4_t __attribute__((ext_vector_type(4)));

#define T_CTX 8192
#define T_ALL 24576
#define DM 1024
#define NTHR 256
#define SMEM_BYTES 69632
#define WG_THREADS 512
#define WG_SMEM (2 * SMEM_BYTES)
#define ALPHA_RES 1.6817928305074290f
#define LN_EPS 1e-5f

__device__ __forceinline__ bf16_t f2bf(float f) {
  unsigned u = __float_as_uint(f);
  u += 0x7fffu + ((u >> 16) & 1u);
  return (bf16_t)(u >> 16);
}
__device__ __forceinline__ float bf2f(bf16_t b) { return __uint_as_float(((unsigned)b) << 16); }
__device__ __forceinline__ float bflo(unsigned w) { return __uint_as_float(w << 16); }
__device__ __forceinline__ float bfhi(unsigned w) { return __uint_as_float(w & 0xffff0000u); }
__device__ __forceinline__ unsigned pack2(float a, float b) { return (unsigned)f2bf(a) | ((unsigned)f2bf(b) << 16); }
__device__ __forceinline__ float siluf(float x) { return x / (1.f + __expf(-x)); }
__device__ __forceinline__ float sigmoidf(float x) { return 1.f / (1.f + __expf(-x)); }
__device__ __forceinline__ float softplusf(float x) { return x > 20.f ? x : __logf(1.f + __expf(x)); }


__device__ __forceinline__ int opaque_lane() { int z = 0; asm volatile("" : "+v"(z)); return __builtin_amdgcn_mbcnt_hi(~0u, __builtin_amdgcn_mbcnt_lo(~0u, (unsigned)z)); }
__device__ __forceinline__ int opaque_tid512(int wave) { return (wave << 6) + opaque_lane(); }
__device__ __forceinline__ int opaque_tid(int wave) { return opaque_tid512(wave) & 255; }

#define XB_TMO      128
#define XB_XCNT(j)  (256  + 64 * (j))
#define XB_XSUB(j)  (1280 + 64 * (j))
#define XB_XGEN(j)  (2304 + 64 * (j))
#define XB_TOP      3328
#define XB_TOPGEN   3392
#define XCD_BAR_WORDS 3456
#define XB_SPIN_CAP (1u << 18)
#define LAS __attribute__((address_space(3)))
__device__ __forceinline__ unsigned xb_ld(unsigned* p)              { return __hip_atomic_load(p, __ATOMIC_RELAXED, __HIP_MEMORY_SCOPE_AGENT); }
__device__ __forceinline__ unsigned xb_add(unsigned* p, unsigned v) { return __hip_atomic_fetch_add(p, v, __ATOMIC_RELAXED, __HIP_MEMORY_SCOPE_AGENT); }
__device__ __forceinline__ unsigned xb_xcc_id() { return (unsigned)__builtin_amdgcn_s_getreg((3 << 11) | 20) & 0xFu; }
#define XB_SPIN(cond, bar) do { unsigned _sp = 0; while (cond) { __builtin_amdgcn_s_sleep(1); \
    if ((++_sp & 255u) == 0u) { if (xb_ld(&(bar)[XB_TMO])) break; if (_sp > XB_SPIN_CAP) { atomicAdd(&(bar)[XB_TMO], 1u); break; } } } } while (0)
struct XcdBarrier { unsigned* bar; unsigned x; volatile LAS unsigned* st; };
__device__ __forceinline__ XcdBarrier xcd_barrier_post(unsigned* bar, volatile LAS unsigned* st) {
  XcdBarrier b; b.bar = bar; b.x = xb_xcc_id(); b.st = st;
  if (threadIdx.x == 0) (void)xb_add(&bar[XB_XCNT(b.x)], 1u);
  return b;
}
__device__ __forceinline__ void xcd_barrier_complete(unsigned* bar, unsigned x, unsigned& nloc, unsigned& nx) {
  const unsigned G = gridDim.x * gridDim.y * gridDim.z;
  unsigned sum, cnt, mine, sp = 0u;
  for (;;) {
    sum = 0u; cnt = 0u; mine = 0u;
#pragma unroll
    for (unsigned j = 0; j < 16; ++j) { const unsigned c = xb_ld(&bar[XB_XCNT(j)]); sum += c; cnt += (c > 0u) ? 1u : 0u; mine = (j == x) ? c : mine; }
    if (sum == G) break;
    __builtin_amdgcn_s_sleep(1);
    if ((++sp & 255u) == 0u) { if (xb_ld(&bar[XB_TMO])) break; if (sp > XB_SPIN_CAP) { atomicAdd(&bar[XB_TMO], 1u); break; } }
  }
  nloc = mine > 0u ? mine : 1u; nx = cnt > 0u ? cnt : 1u;
}
__device__ __forceinline__ void xcd_barrier(const XcdBarrier& b, int wave) {
  asm volatile("s_waitcnt vmcnt(0)" ::: "memory");
  __syncthreads();
  if (opaque_tid512(wave) == 0) {
    unsigned* bar = b.bar;
    __builtin_amdgcn_s_waitcnt(0);
    unsigned nloc = b.st[0], nx = b.st[1];
    if (nloc == 0u) { xcd_barrier_complete(bar, b.x, nloc, nx); b.st[0] = nloc; b.st[1] = nx; }
    const unsigned old = xb_add(&bar[XB_XSUB(b.x)], 1u);
    const unsigned gen = old / nloc;
    if (old + 1u == (gen + 1u) * nloc) {
      __builtin_amdgcn_fence(__ATOMIC_RELEASE, "agent");
      asm volatile("s_waitcnt vmcnt(0)" ::: "memory");
      const unsigned og = xb_add(&bar[XB_TOP], 1u);
      const unsigned tg = og / nx;
      if (og + 1u == (tg + 1u) * nx) xb_add(&bar[XB_TOPGEN], 1u);
      else XB_SPIN(xb_ld(&bar[XB_TOPGEN]) == tg, bar);
      __builtin_amdgcn_fence(__ATOMIC_ACQUIRE, "agent");
      xb_add(&bar[XB_XGEN(b.x)], 1u);
      asm volatile("s_waitcnt vmcnt(0)" ::: "memory");
    } else {
      XB_SPIN(xb_ld(&bar[XB_XGEN(b.x)]) == gen, bar);
      __builtin_amdgcn_fence(__ATOMIC_ACQUIRE, "agent");
      asm volatile("s_waitcnt vmcnt(0)" ::: "memory");
    }
  }
  __syncthreads();
}


__device__ __forceinline__ int opaque_s(int x) { asm volatile("" : "+s"(x)); return x; }

__device__ __forceinline__ float shfl_idx_f(float v, int src) { return __int_as_float(__builtin_amdgcn_ds_bpermute(src << 2, __float_as_int(v))); }
__device__ __forceinline__ float shfl_xor_f(float v, int off, int lane) { return shfl_idx_f(v, lane ^ off); }

__device__ __forceinline__ float wave_incl_scan(float v) {
#define DPP_ADD(ctrl, rmask) v += __int_as_float(__builtin_amdgcn_update_dpp(0, __float_as_int(v), ctrl, rmask, 0xf, false))
  DPP_ADD(0x111, 0xf); DPP_ADD(0x112, 0xf); DPP_ADD(0x114, 0xf); DPP_ADD(0x118, 0xf);
  DPP_ADD(0x142, 0xa); DPP_ADD(0x143, 0xc);
#undef DPP_ADD
  return v;
}

struct TokInfo { int s, l, L, base, mrow; };
__device__ __forceinline__ TokInfo tokinfo(int tok) {
  TokInfo t;
  if (tok < T_CTX) { t.s = tok >> 8; t.l = tok & 255; t.L = 256; t.base = tok & ~255; t.mrow = 0; }
  else { int u = tok - T_CTX; t.s = 32 + (u >> 12); t.l = u & 4095; t.L = 4096; t.base = T_CTX + (u & ~4095); t.mrow = 1 + (u >> 12); }
  return t;
}
__device__ __forceinline__ int seqpos2off(int pos, bool cm) { return cm ? (((pos & 63) << 6) | (pos >> 6)) : pos; }

struct Params {
  const float *x_prompt, *x_sample, *state_ssd, *state_lru, *c, *c_ctx, *mod_w, *mod_b, *ln_g, *ln_b;
  const float *ssd_in_w, *ssd_conv_w, *ssd_conv_b, *ssd_dt_bias, *ssd_a_log, *ssd_d, *ssd_norm_g, *ssd_out_w;
  const float *hy_in_w, *hy_conv_w, *hy_conv_b, *hy_f_w1, *hy_f_b1, *hy_f_w2, *hy_f_b2, *hy_f_w3, *hy_f_freq, *hy_f_bias, *hy_out_w;
  const float *lru_in_w, *lru_conv_w, *lru_conv_b, *lru_gate_w, *lru_gate_b, *lru_a_param, *lru_out_w;
  float *xres, *out_ssd, *out_lru;
  bf16_t *wt_ssd_in, *wt_ssd_out, *wt_hy_in, *wt_hy_out, *wt_lru_in, *wt_lru_out, *wt_lru_gate;
  float *modv;
  float *hdn2;
  bf16_t *rtab0;
  bf16_t *rtab1;
  float *knorm;
  bf16_t *hbuf;
  float *rstd;
  float *lru_agg;
  float *lru_hin;
  unsigned char *scratch;
  unsigned *bar;
};

#define SC_SSD_Z     ((size_t)0)
#define SC_SSD_XBC   ((size_t)T_ALL * 2048 * 2)
#define SC_SSD_XBCC  (SC_SSD_XBC + (size_t)T_ALL * 4096 * 2)
#define SC_SSD_DT    (SC_SSD_XBCC + (size_t)T_ALL * 2048 * 2)
#define SC_SSD_XT    (SC_SSD_DT + (size_t)T_ALL * 64 * 4)
#define SC_SSD_BT    (SC_SSD_XT + (size_t)T_ALL * 2048 * 2)
#define SC_SSD_BF    (SC_SSD_BT + (size_t)T_ALL * 1024 * 2)
#define SC_SSD_CF    (SC_SSD_BF + (size_t)T_ALL * 1024 * 2)
#define SC_SSD_END   (SC_SSD_CF + (size_t)T_ALL * 1024 * 2)
#define SC_HY_PROJT  ((size_t)0)
#define SC_HY_YT     ((size_t)T_ALL * 4096 * 2)
#define SC_HY_YG     (SC_HY_YT + (size_t)T_ALL * 1024 * 2)
#define SC_LRU_PROJ  ((size_t)0)
#define SC_LRU_XC    ((size_t)T_ALL * 2048 * 2)
#define SC_LRU_GATES (SC_LRU_XC + (size_t)T_ALL * 1024 * 2)
#define SC_LRU_Y     (SC_LRU_GATES + (size_t)T_ALL * 4096 * 2)
#define SC_LRU_YG    (SC_LRU_Y + (size_t)T_ALL * 2048 * 2)
#define SC_TOTAL     SC_SSD_END

__device__ __forceinline__ void transpose_tile(const float* __restrict__ src, int ld_src, int n_src, bf16_t* __restrict__ dst, int K,
                               const float* __restrict__ scale, int tile, int tiles_k, float* tl, int cxw) {
  const int tidx = opaque_tid(cxw);
  int tk = tile % tiles_k, tn = tile / tiles_k;
  int k0 = tk * 64, n0 = tn * 64;
  int tx = tidx & 63, ty = tidx >> 6;
  __syncthreads();
  for (int r = ty; r < 64; r += 4) {
    int n = n0 + tx;
    float v = 0.f;
    if (n < n_src) { v = src[(size_t)(k0 + r) * ld_src + n]; if (scale) v *= scale[k0 + r]; }
    tl[r * 65 + tx] = v;
  }
  __syncthreads();
  for (int r = ty; r < 64; r += 4) dst[(size_t)(n0 + r) * K + k0 + tx] = f2bf(tl[tx * 65 + r]);
}

__device__ __forceinline__ void phase_prep(const Params& p, int bid, int nblk, unsigned char* smem, int cxw) {
  const int tidx = opaque_tid(cxw);
  float* tl = (float*)smem;
  for (int job = 0; job < 24; ++job) {
    const float* src; int ld, nsrc, K, npad; bf16_t* dst; const float* scale = nullptr;
    if (job < 2) { src = p.ssd_in_w + (size_t)job * 1024 * 6208; ld = 6208; nsrc = 6208; K = 1024; npad = 6400; dst = p.wt_ssd_in + (size_t)job * 6400 * 1024; }
    else if (job < 4) { int s = job - 2; src = p.ssd_out_w + (size_t)s * 2048 * 1024; ld = 1024; nsrc = 1024; K = 2048; npad = 1024; dst = p.wt_ssd_out + (size_t)s * 1024 * 2048; scale = p.ssd_norm_g + s * 2048; }
    else if (job == 4) { src = p.hy_in_w; ld = 4096; nsrc = 4096; K = 1024; npad = 4096; dst = p.wt_hy_in; }
    else if (job == 5) { src = p.hy_out_w; ld = 1024; nsrc = 1024; K = 1024; npad = 1024; dst = p.wt_hy_out; }
    else if (job == 6) { src = p.lru_in_w; ld = 2048; nsrc = 2048; K = 1024; npad = 2048; dst = p.wt_lru_in; }
    else if (job == 7) { src = p.lru_out_w; ld = 1024; nsrc = 1024; K = 1024; npad = 1024; dst = p.wt_lru_out; }
    else { int q = job - 8; int dg = q >> 2, n = q & 3;
      src = p.lru_gate_w + (size_t)(dg * 4 + n) * 65536; ld = 256; nsrc = 256; K = 256; npad = 256;
      dst = p.wt_lru_gate + (size_t)n * 1024 * 256 + (size_t)dg * 256 * 256; }
    int tiles_k = K / 64, tiles = tiles_k * (npad / 64);
    for (int t = bid; t < tiles; t += nblk) transpose_tile(src, ld, nsrc, dst, K, scale, t, tiles_k, tl, cxw);
  }
  for (int i = bid * NTHR + tidx; i < 2 * 2 * 1024; i += nblk * NTHR) p.knorm[i] = 0.f;
}

__device__ __forceinline__ void phase_mod(const Params& p, int bid, int nblk, unsigned char* smem, int cxw) {
  const int tidx = opaque_tid(cxw);
  float* sc = (float*)smem;
  float* red = sc + 5 * 1024;
  __syncthreads();
  for (int i = tidx; i < 5 * 1024; i += NTHR) {
    int r = i >> 10, k = i & 1023;
    float v = (r == 0) ? p.c_ctx[k] : p.c[(r - 1) * 1024 + k];
    sc[i] = siluf(v);
  }
  __syncthreads();
  const int cj = tidx & 31, kg = tidx >> 5;
  for (int item = bid; item < 4 * 96; item += nblk) {
    const int layer = item / 96, j = (item % 96) * 32 + cj;
    const float* w = p.mod_w + (size_t)layer * 1024 * 3072 + (size_t)kg * 128 * 3072 + j;
    const float* s0 = sc + kg * 128;
    float a0 = 0, a1 = 0, a2 = 0, a3 = 0, a4 = 0;
#pragma unroll 8
    for (int k = 0; k < 128; ++k) {
      float wv = w[(size_t)k * 3072];
      a0 += s0[k] * wv; a1 += s0[1024 + k] * wv; a2 += s0[2048 + k] * wv; a3 += s0[3072 + k] * wv; a4 += s0[4096 + k] * wv;
    }
    __syncthreads();
    red[(kg * 5 + 0) * 32 + cj] = a0; red[(kg * 5 + 1) * 32 + cj] = a1; red[(kg * 5 + 2) * 32 + cj] = a2;
    red[(kg * 5 + 3) * 32 + cj] = a3; red[(kg * 5 + 4) * 32 + cj] = a4;
    __syncthreads();
    if (tidx < 160) {
      const int rr = tidx >> 5, cc = tidx & 31;
      float sum = 0.f;
#pragma unroll
      for (int g8 = 0; g8 < 8; ++g8) sum += red[(g8 * 5 + rr) * 32 + cc];
      const int jj = (item % 96) * 32 + cc;
      p.modv[((size_t)layer * 5 + rr) * 3072 + jj] = sum + p.mod_b[layer * 3072 + jj];
    }
  }
}

__device__ __forceinline__ void phase_hyfilt_a(const Params& p, int bid, int nblk, unsigned char* smem, int cxw) {
  const int tidx = opaque_tid(cxw);
  float* sz = (float*)smem;
  float* sh = sz + 4 * 36;
  int pl = tidx >> 6, m = tidx & 63;
  for (int item = bid; item < 4352 / 4; item += nblk) {
    int pos = item * 4 + pl;
    int L = pos < 256 ? 256 : 4096;
    int l = pos < 256 ? pos : pos - 256;
    __syncthreads();
    if (m < 33) {
      float t = (float)l / (float)L;
      float w = (6.283185307179586f * (float)l) / (float)L;
      float v;
      if (m == 0) v = t;
      else {
        int j = (m - 1) & 15;
        float fr = 1e-4f + (float)j * ((15.f - 1e-4f) / 15.f);
        float ang = w * fr;
        v = (m <= 16) ? __cosf(ang) : __sinf(ang);
      }
      sz[pl * 36 + m] = v;
    }
    __syncthreads();
    float a = p.hy_f_b1[m];
    for (int e = 0; e < 33; ++e) a += sz[pl * 36 + e] * p.hy_f_w1[e * 64 + m];
    a = __sinf(p.hy_f_freq[m] * a);
    sh[pl * 64 + m] = a;
    __syncthreads();
    float b = p.hy_f_b2[m];
    for (int e = 0; e < 64; ++e) b += sh[pl * 64 + e] * p.hy_f_w2[e * 64 + m];
    b = __sinf(p.hy_f_freq[64 + m] * b);
    p.hdn2[(size_t)pos * 64 + m] = b;
  }
}

__device__ __forceinline__ void phase_hyfilt_b(const Params& p, int bid, int nblk, unsigned char* smem, int cxw) {
  const int tidx = opaque_tid(cxw);
  const int lane = tidx & 63;
  for (int item = bid; item < 17 * 64; item += nblk) {
    const int lb = item >> 6, chunk = item & 63;
    const int Lsel = lb ? 1 : 0, L = Lsel ? 4096 : 256, RL = Lsel ? 8192 : 512, Lm1 = L - 1;
    const int l = Lsel ? (lb - 1) * 256 + tidx : tidx;
    const int pos = Lsel ? 256 + l : l;
    float hd[64];
#pragma unroll
    for (int m4 = 0; m4 < 16; ++m4) {
      f32x4 v = *(const f32x4*)(p.hdn2 + (size_t)pos * 64 + m4 * 4);
      hd[m4 * 4] = v.x; hd[m4 * 4 + 1] = v.y; hd[m4 * 4 + 2] = v.z; hd[m4 * 4 + 3] = v.w;
    }
    const int odc0 = chunk * 64, o = odc0 >> 11, d = (odc0 >> 10) & 1, c0 = odc0 & 1023;
    const float t = (float)l / (float)L;
    bf16_t* rt = Lsel ? p.rtab1 : p.rtab0;
    const float min_decay = -3.0701134573253945f, max_decay = -15.350567286626973f;
    for (int cc = 0; cc < 64; ++cc) {
      const int c = c0 + cc;
      const float* w3 = p.hy_f_w3 + odc0 + cc;
      float acc = 0.f;
#pragma unroll
      for (int m = 0; m < 64; ++m) acc += hd[m] * w3[(size_t)m * 4096];
      float delta = fabsf(min_decay + (float)c * ((max_decay - min_decay) / 1023.f));
      float kv = acc * expf(-t * delta);
      size_t rb = (size_t)(o * 1024 + c) * RL;
      if (d == 0) rt[rb + Lm1 - l] = f2bf(kv);
      else if (l > 0) rt[rb + Lm1 + l] = f2bf(kv);
      else rt[rb + RL - 1] = 0;
      float a = fabsf(kv);
#pragma unroll
      for (int off = 32; off > 0; off >>= 1) a += shfl_xor_f(a, off, lane);
      if (lane == 0) atomicAdd(&p.knorm[(Lsel * 2 + o) * 1024 + c], a);
    }
  }
}

__device__ __forceinline__ void phase_lnmod(const Params& p, int layer, int bid, int nblk, int cxw) {
  const int tidx = opaque_tid(cxw);
  int lane = tidx & 63, wv = tidx >> 6;
  for (int row = bid * 4 + wv; row < T_ALL; row += nblk * 4) {
    const float* src = (layer == 0) ? (row < T_CTX ? p.x_prompt + (size_t)row * DM : p.x_sample + (size_t)(row - T_CTX) * DM)
                                    : p.xres + (size_t)row * DM;
    f32x4 v[4];
#pragma unroll
    for (int j = 0; j < 4; ++j) v[j] = *(const f32x4*)(src + j * 256 + lane * 4);
    if (layer > 0) {
      float s = 0.f;
#pragma unroll
      for (int j = 0; j < 4; ++j) s += v[j].x + v[j].y + v[j].z + v[j].w;
#pragma unroll
      for (int o = 32; o > 0; o >>= 1) s += shfl_xor_f(s, o, lane);
      float mu = s * (1.f / 1024.f);
      float q = 0.f;
#pragma unroll
      for (int j = 0; j < 4; ++j) { float a = v[j].x - mu, b = v[j].y - mu, c = v[j].z - mu, d = v[j].w - mu; q += a * a + b * b + c * c + d * d; }
#pragma unroll
      for (int o = 32; o > 0; o >>= 1) q += shfl_xor_f(q, o, lane);
      float rs = rsqrtf(q * (1.f / 1024.f) + LN_EPS);
      const float* g = p.ln_g + (layer - 1) * DM; const float* b = p.ln_b + (layer - 1) * DM;
#pragma unroll
      for (int j = 0; j < 4; ++j) {
        f32x4 gg = *(const f32x4*)(g + j * 256 + lane * 4), bb = *(const f32x4*)(b + j * 256 + lane * 4);
        v[j].x = (v[j].x - mu) * rs * gg.x + bb.x; v[j].y = (v[j].y - mu) * rs * gg.y + bb.y;
        v[j].z = (v[j].z - mu) * rs * gg.z + bb.z; v[j].w = (v[j].w - mu) * rs * gg.w + bb.w;
      }
    }
    float* dst = p.xres + (size_t)row * DM;
#pragma unroll
    for (int j = 0; j < 4; ++j) *(f32x4*)(dst + j * 256 + lane * 4) = v[j];
    if (layer < 4) {
      int mrow = row < T_CTX ? 0 : 1 + ((row - T_CTX) >> 12);
      const float* mv = p.modv + ((size_t)layer * 5 + mrow) * 3072;
#pragma unroll
      for (int j = 0; j < 4; ++j) {
        f32x4 sh = *(const f32x4*)(mv + j * 256 + lane * 4), sc = *(const f32x4*)(mv + 1024 + j * 256 + lane * 4);
        u32x2 o;
        o.x = pack2(v[j].x * (1.f + sc.x) + sh.x, v[j].y * (1.f + sc.y) + sh.y);
        o.y = pack2(v[j].z * (1.f + sc.z) + sh.z, v[j].w * (1.f + sc.w) + sh.w);
        *(u32x2*)(p.hbuf + (size_t)row * DM + j * 256 + lane * 4) = o;
      }
    }
  }
}

#define PG8_LAS __attribute__((address_space(3)))
namespace pg8 {
constexpr int BM = 256, BK = 64, HALF = 128, HTB = HALF * BK * 2, STAGE_BYTES = 8 * HTB, NXCD = 8, WGM = 8;
__device__ __forceinline__ int lds_byte(int r, int c) { const int st = (r >> 4) * 2 + (c >> 5), rr = r & 15, cc = c & 31, ob = rr * 64 + cc * 2; return st * 1024 + (ob ^ (((ob >> 9) & 1) << 5)); }
__device__ __forceinline__ void stage_rc(int b, int& R, int& C) { const int st = b / 1024, sb = b % 1024, swz = sb ^ (((sb >> 9) & 1) << 5); R = (st >> 1) * 16 + swz / 64; C = (st & 1) * 32 + (swz % 64) / 2; }
__device__ __forceinline__ int perm32(int rho) { const int n = rho >> 4, i = rho & 15; return 8 * (i >> 2) + 4 * n + (i & 3); }
struct Unit { int pm, pn; };
struct Gemm { const bf16_t* A; const bf16_t* Bt; int M, N, K, lda; int a_grp_shift; int a_grp_bytes; };
struct StaticOrder {
  int nM, nN, nwg, G, c;
  __device__ void init(int M, int N, int G_, int c_) { nM = M / BM; nN = N / BM; nwg = nM * nN; G = G_; c = c_; }
  __device__ bool next(int i, Unit& u) const {
    const long L = (long)i * G + c; if (L >= nwg) return false;
    int wgid = (int)L; { const int q = nwg / NXCD, r = nwg % NXCD, xcd = wgid % NXCD, off = wgid / NXCD; wgid = (xcd < r ? xcd * (q + 1) : r * (q + 1) + (xcd - r) * q) + off; }
    const int nig = WGM * nN, gid = wgid / nig, fm = gid * WGM, gsz = (nM - fm) < WGM ? (nM - fm) : WGM;
    u.pm = fm + ((wgid % nig) % gsz); u.pn = (wgid % nig) / gsz; return true;
  }
};
__device__ __forceinline__ unsigned cvt_pk_bf16(float lo, float hi) { return pack2(lo, hi); }

template <class Epi>
__device__ __forceinline__ void gemm_phase(PG8_LAS unsigned char* lds, const Gemm g, const StaticOrder& S, const Epi& E, int wave) {
  const int tid = opaque_tid512(wave), wid = wave, lane = tid & 63, wr = wid >> 2, wc = wid & 3, fr = lane & 15, fq = lane >> 4;
  const int K = g.K, nt = K / BK, lda = g.lda;
  unsigned voffA[2], voffB[2];
#pragma unroll
  for (int i = 0; i < 2; ++i) { int R, C; stage_rc(tid * 16 + i * 8192, R, C); const int Rb = Epi::PERM ? ((R & ~31) + perm32(R & 31)) : R;
    voffA[i] = (unsigned)(R * lda + C) * 2u; voffB[i] = (unsigned)(Rb * K + C) * 2u; }
  const size_t kstep = (size_t)(BK * 2);
  const size_t hstepA = (size_t)HALF * lda * 2, hstepB = (size_t)HALF * K * 2;
  const size_t tstepA = 2 * hstepA, tstepB = 2 * hstepB;
  const unsigned ldsw = (unsigned)wid * 1024u;
  const int aoff = lds_byte(wr * 64 + fr, fq * 8), boff = lds_byte(wc * 32 + fr, fq * 8);
#define PG8_SA(b, h) (((b) * 2 + (h)) * HTB)
#define PG8_SB(b, h) ((4 + (b) * 2 + (h)) * HTB)
#define PG8_STAGE(bufoff, gbase, voff) do { _Pragma("unroll") for (int _i = 0; _i < 2; ++_i) \
    __builtin_amdgcn_global_load_lds((const unsigned*)((const char*)(gbase) + (voff)[_i]), (PG8_LAS unsigned*)(lds + (bufoff) + ldsw + _i * 8192), 16, 0, 0); } while (0)
#define PG8_LDA(dst, b, h) do { _Pragma("unroll") for (int m = 0; m < 4; ++m) _Pragma("unroll") for (int k = 0; k < 2; ++k) dst[m][k] = *(const PG8_LAS bf16x8*)(lds + PG8_SA(b, h) + aoff + m * 2048 + k * 1024); } while (0)
#define PG8_LDB(dst, b, h) do { _Pragma("unroll") for (int n = 0; n < 2; ++n) _Pragma("unroll") for (int k = 0; k < 2; ++k) dst[n][k] = *(const PG8_LAS bf16x8*)(lds + PG8_SB(b, h) + boff + n * 2048 + k * 1024); } while (0)
#define PG8_MMA(ai, bj, At, Bt) do { __builtin_amdgcn_s_setprio(1); _Pragma("unroll") for (int m = 0; m < 4; ++m) _Pragma("unroll") for (int n = 0; n < 2; ++n) _Pragma("unroll") for (int k = 0; k < 2; ++k) \
    acc[ai][bj][m][n] = __builtin_amdgcn_mfma_f32_16x16x32_bf16(Bt[n][k], At[m][k], acc[ai][bj][m][n], 0, 0, 0); __builtin_amdgcn_s_setprio(0); } while (0)
#define PG8_WAIT_V(n) asm volatile("s_waitcnt vmcnt(" #n ")" ::: "memory")
#define PG8_WAIT_L(n) asm volatile("s_waitcnt lgkmcnt(" #n ")" ::: "memory")
#define PG8_BAR __builtin_amdgcn_s_barrier()
#define PG8_SCHED __builtin_amdgcn_sched_barrier(0)
#define PG8_APTR(u) ((const char*)g.A + (size_t)(u).pm * tstepA + (size_t)(((u).pn >> g.a_grp_shift) * g.a_grp_bytes))
  Unit cur, nxt; int ui = 0;
  if (!S.next(0, cur)) return;
  f32x4 acc[2][2][4][2];
#pragma unroll
  for (int a = 0; a < 2; ++a)
#pragma unroll
    for (int b = 0; b < 2; ++b)
#pragma unroll
      for (int m = 0; m < 4; ++m)
#pragma unroll
        for (int n = 0; n < 2; ++n) acc[a][b][m][n] = (f32x4){0.f, 0.f, 0.f, 0.f};
  bf16x8 At[4][2], B0[2][2], B1[2][2];
  const char* cA = PG8_APTR(cur); const char* cB = (const char*)g.Bt + (size_t)cur.pn * tstepB;
  PG8_STAGE(PG8_SB(0, 0), cB, voffB); PG8_STAGE(PG8_SA(0, 0), cA, voffA); PG8_STAGE(PG8_SB(0, 1), cB + hstepB, voffB); PG8_STAGE(PG8_SA(0, 1), cA + hstepA, voffA);
  if (wr == 1) PG8_BAR;
  PG8_WAIT_V(4); PG8_BAR;
  PG8_STAGE(PG8_SB(1, 0), cB + kstep, voffB); PG8_STAGE(PG8_SA(1, 0), cA + kstep, voffA); PG8_STAGE(PG8_SB(1, 1), cB + hstepB + kstep, voffB);
  PG8_WAIT_V(6); PG8_BAR;
  for (;;) {
    const bool has_next = S.next(ui + 1, nxt);
    const char* nA = has_next ? PG8_APTR(nxt) : cA; const char* nB = has_next ? (const char*)g.Bt + (size_t)nxt.pn * tstepB : cB;
    for (int t = 0; t < nt; t += 2) {
      const bool last = (t == nt - 2);
      const char* a1 = cA + (size_t)(t + 1) * kstep;
      const char* a2 = last ? nA : cA + (size_t)(t + 2) * kstep; const char* b2 = last ? nB : cB + (size_t)(t + 2) * kstep;
      const char* a3 = a2 + kstep; const char* b3 = b2 + kstep;
      PG8_LDB(B0, 0, 0); PG8_SCHED; PG8_LDA(At, 0, 0); PG8_STAGE(PG8_SA(1, 1), a1 + hstepA, voffA);
      PG8_WAIT_L(8); PG8_BAR; PG8_WAIT_L(0); PG8_MMA(0, 0, At, B0); PG8_BAR; PG8_SCHED;
      PG8_LDB(B1, 0, 1); PG8_STAGE(PG8_SB(0, 0), b2, voffB);
      PG8_BAR; PG8_WAIT_L(0); PG8_MMA(0, 1, At, B1); PG8_BAR;
      PG8_LDA(At, 0, 1); PG8_STAGE(PG8_SA(0, 0), a2, voffA);
      PG8_BAR; PG8_WAIT_L(0); PG8_MMA(1, 0, At, B0); PG8_BAR; PG8_SCHED;
      PG8_STAGE(PG8_SB(0, 1), b2 + hstepB, voffB);
      PG8_WAIT_V(6); PG8_BAR; PG8_MMA(1, 1, At, B1); PG8_BAR;
      PG8_LDB(B0, 1, 0); PG8_SCHED; PG8_LDA(At, 1, 0); PG8_STAGE(PG8_SA(0, 1), a2 + hstepA, voffA);
      PG8_WAIT_L(8); PG8_BAR; PG8_WAIT_L(0); PG8_MMA(0, 0, At, B0); PG8_BAR; PG8_SCHED;
      PG8_LDB(B1, 1, 1); PG8_STAGE(PG8_SB(1, 0), b3, voffB);
      PG8_BAR; PG8_WAIT_L(0); PG8_MMA(0, 1, At, B1); PG8_BAR;
      PG8_LDA(At, 1, 1); PG8_STAGE(PG8_SA(1, 0), a3, voffA);
      PG8_BAR; PG8_WAIT_L(0); PG8_MMA(1, 0, At, B0); PG8_BAR; PG8_SCHED;
      PG8_STAGE(PG8_SB(1, 1), b3 + hstepB, voffB);
      PG8_WAIT_V(6); PG8_BAR; PG8_MMA(1, 1, At, B1); PG8_BAR;
    }
    E(acc, cur, wr, wc, fr, fq);
    if (!has_next) break;
#pragma unroll
    for (int a = 0; a < 2; ++a)
#pragma unroll
      for (int b = 0; b < 2; ++b)
#pragma unroll
        for (int m = 0; m < 4; ++m)
#pragma unroll
          for (int n = 0; n < 2; ++n) acc[a][b][m][n] = (f32x4){0.f, 0.f, 0.f, 0.f};
    cur = nxt; cA = nA; cB = nB; ++ui;
  }
  PG8_WAIT_V(0);
  if (wr == 0) PG8_BAR;
  PG8_BAR;
#undef PG8_SA
#undef PG8_SB
#undef PG8_STAGE
#undef PG8_LDA
#undef PG8_LDB
#undef PG8_MMA
#undef PG8_WAIT_V
#undef PG8_WAIT_L
#undef PG8_BAR
#undef PG8_SCHED
#undef PG8_APTR
}

struct EpiBf16 {
  static constexpr bool PERM = true;
  bf16_t* O; size_t ldc;
  __device__ __forceinline__ void operator()(const f32x4 (&acc)[2][2][4][2], const Unit& u, int wr, int wc, int fr, int fq) const {
    const int row0 = u.pm * BM + wr * 64 + fr, col0 = u.pn * BM + wc * 32 + 8 * fq;
#pragma unroll
    for (int ai = 0; ai < 2; ++ai)
#pragma unroll
      for (int m = 0; m < 4; ++m) {
        bf16_t* rowp = O + (size_t)(row0 + ai * HALF + m * 16) * ldc + col0;
#pragma unroll
        for (int bj = 0; bj < 2; ++bj) {
          const f32x4 v0 = acc[ai][bj][m][0], v1 = acc[ai][bj][m][1];
          u32x4 w; w.x = pack2(v0[0], v0[1]); w.y = pack2(v0[2], v0[3]); w.z = pack2(v1[0], v1[1]); w.w = pack2(v1[2], v1[3]);
          *(u32x4*)(rowp + bj * HALF) = w;
        }
      }
  }
};
struct EpiSsdIn {
  static constexpr bool PERM = true;
  bf16_t* z; bf16_t* xbc; float* dt; const float* dt_bias;
  __device__ __forceinline__ void operator()(const f32x4 (&acc)[2][2][4][2], const Unit& u, int wr, int wc, int fr, int fq) const {
    const int row0 = u.pm * BM + wr * 64 + fr, colt = u.pn * BM + wc * 32 + 8 * fq;
    if (u.pn < 24) {
      bf16_t* base = u.pn < 8 ? z : xbc; const size_t ldc = u.pn < 8 ? 2048 : 4096; const int col0 = u.pn < 8 ? colt : colt - 2048;
#pragma unroll
      for (int ai = 0; ai < 2; ++ai)
#pragma unroll
        for (int m = 0; m < 4; ++m) {
          bf16_t* rowp = base + (size_t)(row0 + ai * HALF + m * 16) * ldc + col0;
#pragma unroll
          for (int bj = 0; bj < 2; ++bj) {
            const f32x4 v0 = acc[ai][bj][m][0], v1 = acc[ai][bj][m][1];
            u32x4 w; w.x = pack2(v0[0], v0[1]); w.y = pack2(v0[2], v0[3]); w.z = pack2(v1[0], v1[1]); w.w = pack2(v1[2], v1[3]);
            *(u32x4*)(rowp + bj * HALF) = w;
          }
        }
    } else {
      const int c0 = wc * 32 + 8 * fq;
      if (c0 < 64) {
#pragma unroll
        for (int ai = 0; ai < 2; ++ai)
#pragma unroll
          for (int m = 0; m < 4; ++m) {
            float* rowp = dt + (size_t)(row0 + ai * HALF + m * 16) * 64 + c0;
#pragma unroll
            for (int n = 0; n < 2; ++n) {
              const f32x4 v = acc[ai][0][m][n];
              f32x4 o;
#pragma unroll
              for (int e = 0; e < 4; ++e) o[e] = softplusf(v[e] + dt_bias[c0 + 4 * n + e]);
              *(f32x4*)(rowp + 4 * n) = o;
            }
          }
      }
    }
  }
};
struct EpiOut {
  static constexpr bool PERM = false;
  float* xres; const float* modv_layer; const float* rstd;
  __device__ __forceinline__ void operator()(const f32x4 (&acc)[2][2][4][2], const Unit& u, int wr, int wc, int fr, int fq) const {
    const int row0 = u.pm * BM + wr * 64 + fr, col0 = u.pn * BM + wc * 32 + 4 * fq;
#pragma unroll
    for (int ai = 0; ai < 2; ++ai)
#pragma unroll
      for (int m = 0; m < 4; ++m) {
        const int row = row0 + ai * HALF + m * 16;
        const int mrow = row < T_CTX ? 0 : 1 + ((row - T_CTX) >> 12);
        const float rs = rstd ? rstd[row] : 1.f;
        const float* gp = modv_layer + (size_t)mrow * 3072 + 2048 + col0;
        float* rowp = xres + (size_t)row * DM + col0;
#pragma unroll
        for (int bj = 0; bj < 2; ++bj)
#pragma unroll
          for (int n = 0; n < 2; ++n) {
            const f32x4 gv = *(const f32x4*)(gp + bj * HALF + n * 16);
            const f32x4 xv = *(const f32x4*)(rowp + bj * HALF + n * 16);
            *(f32x4*)(rowp + bj * HALF + n * 16) = ALPHA_RES * xv + gv * (acc[ai][bj][m][n] * rs);
          }
      }
  }
};
struct EpiLruGate {
  static constexpr bool PERM = true;
  bf16_t* gates; const float* gate_b;
  __device__ __forceinline__ void operator()(const f32x4 (&acc)[2][2][4][2], const Unit& u, int wr, int wc, int fr, int fq) const {
    const int nb = u.pn >> 2, dg = u.pn & 3;
    const int row0 = u.pm * BM + wr * 64 + fr, ch0 = nb * 256 + wc * 32 + 8 * fq;
#pragma unroll
    for (int ai = 0; ai < 2; ++ai)
#pragma unroll
      for (int m = 0; m < 4; ++m) {
        bf16_t* rowp = gates + ((size_t)dg * T_ALL + row0 + ai * HALF + m * 16) * 1024 + ch0;
#pragma unroll
        for (int bj = 0; bj < 2; ++bj) {
          const float* bp = gate_b + dg * 1024 + ch0 + bj * HALF;
          const f32x4 b0 = *(const f32x4*)bp, b1 = *(const f32x4*)(bp + 4);
          const f32x4 v0 = acc[ai][bj][m][0] + b0, v1 = acc[ai][bj][m][1] + b1;
          u32x4 w; w.x = pack2(sigmoidf(v0[0]), sigmoidf(v0[1])); w.y = pack2(sigmoidf(v0[2]), sigmoidf(v0[3]));
          w.z = pack2(sigmoidf(v1[0]), sigmoidf(v1[1])); w.w = pack2(sigmoidf(v1[2]), sigmoidf(v1[3]));
          *(u32x4*)(rowp + bj * HALF) = w;
        }
      }
  }
};
}

template <int KW, bool SILU>
__device__ __forceinline__ void phase_dwconv(const bf16_t* __restrict__ src, int ld_src, bf16_t* __restrict__ dst, int ld_dst, int CH,
                             const float* __restrict__ w, const float* __restrict__ b, bool colmajor, int bid, int nblk, int cxw) {
  const int tidx = opaque_tid(cxw);
  const int cpr = CH / 8;
  const size_t total = (size_t)T_ALL * cpr;
  for (size_t idx = (size_t)bid * NTHR + tidx; idx < total; idx += (size_t)nblk * NTHR) {
    int tok = (int)(idx / cpr), c0 = (int)(idx % cpr) * 8;
    TokInfo ti = tokinfo(tok);
    bool cm = colmajor && ti.s >= 32;
    int pos = seqpos2off(ti.l, cm);
    float acc[8];
#pragma unroll
    for (int e = 0; e < 8; ++e) acc[e] = b[c0 + e];
#pragma unroll
    for (int k = 0; k < KW; ++k) {
      int pp = pos + k - 1;
      if (pp < 0 || pp >= ti.L) continue;
      int tk = ti.base + seqpos2off(pp, cm);
      u32x4 xv = *(const u32x4*)(src + (size_t)tk * ld_src + c0);
      const float* wk = w + (size_t)k * CH + c0;
      acc[0] += wk[0] * bflo(xv.x); acc[1] += wk[1] * bfhi(xv.x);
      acc[2] += wk[2] * bflo(xv.y); acc[3] += wk[3] * bfhi(xv.y);
      acc[4] += wk[4] * bflo(xv.z); acc[5] += wk[5] * bfhi(xv.z);
      acc[6] += wk[6] * bflo(xv.w); acc[7] += wk[7] * bfhi(xv.w);
    }
    if (SILU) {
#pragma unroll
      for (int e = 0; e < 8; ++e) acc[e] = siluf(acc[e]);
    }
    u32x4 o;
    o.x = pack2(acc[0], acc[1]); o.y = pack2(acc[2], acc[3]); o.z = pack2(acc[4], acc[5]); o.w = pack2(acc[6], acc[7]);
    *(u32x4*)(dst + (size_t)tok * ld_dst + c0) = o;
  }
}

__device__ __forceinline__ void phase_ssd_conv(const Params& p, int slot, bool colmajor, int bid, int nblk, unsigned char* smem, int cxw) {
  const int tid = opaque_tid(cxw);
  const bf16_t* raw = (const bf16_t*)(p.scratch + SC_SSD_XBC);
  bf16_t* out = (bf16_t*)(p.scratch + SC_SSD_XBCC);
  bf16_t* XT = (bf16_t*)(p.scratch + SC_SSD_XT);
  bf16_t* BT = (bf16_t*)(p.scratch + SC_SSD_BT);
  bf16_t* BF = (bf16_t*)(p.scratch + SC_SSD_BF);
  bf16_t* CF = (bf16_t*)(p.scratch + SC_SSD_CF);
  const float* cw = p.ssd_conv_w + (size_t)slot * 4 * 4096;
  const float* cb = p.ssd_conv_b + slot * 4096;
  bf16_t* tl = (bf16_t*)smem;
  for (int item = bid; item < 384 * 64; item += nblk) {
    const int ptile = item >> 6, ct = item & 63;
    const int ptok0 = ptile * 64;
    TokInfo ti = tokinfo(ptok0);
    const bool cm = colmajor && ti.s >= 32;
    const int rr = tid >> 2, cpart = tid & 3;
    const int ch = ct * 64 + cpart * 16;
    const int pos = ti.l + rr;
    float acc[16];
#pragma unroll
    for (int e = 0; e < 16; ++e) acc[e] = cb[ch + e];
#pragma unroll
    for (int k = 0; k < 4; ++k) {
      int pp = pos + k - 1;
      if (pp < 0 || pp >= ti.L) continue;
      int tk = ti.base + seqpos2off(pp, cm);
      const bf16_t* rp = raw + (size_t)tk * 4096 + ch;
      u32x4 x0 = *(const u32x4*)rp, x1 = *(const u32x4*)(rp + 8);
      const float* wk = cw + (size_t)k * 4096 + ch;
      unsigned xw[8] = {x0.x, x0.y, x0.z, x0.w, x1.x, x1.y, x1.z, x1.w};
#pragma unroll
      for (int e = 0; e < 8; ++e) { acc[2 * e] += wk[2 * e] * bflo(xw[e]); acc[2 * e + 1] += wk[2 * e + 1] * bfhi(xw[e]); }
    }
    u32x4 o0, o1;
    o0.x = pack2(siluf(acc[0]), siluf(acc[1])); o0.y = pack2(siluf(acc[2]), siluf(acc[3]));
    o0.z = pack2(siluf(acc[4]), siluf(acc[5])); o0.w = pack2(siluf(acc[6]), siluf(acc[7]));
    o1.x = pack2(siluf(acc[8]), siluf(acc[9])); o1.y = pack2(siluf(acc[10]), siluf(acc[11]));
    o1.z = pack2(siluf(acc[12]), siluf(acc[13])); o1.w = pack2(siluf(acc[14]), siluf(acc[15]));
    __syncthreads();
    *(u32x4*)(tl + rr * 72 + cpart * 16) = o0;
    *(u32x4*)(tl + rr * 72 + cpart * 16 + 8) = o1;
    __syncthreads();
    if (ct < 32) {
      bf16_t* op = out + (size_t)(ptok0 + rr) * 2048 + ch;
      *(u32x4*)op = o0; *(u32x4*)(op + 8) = o1;
      const int crow = tid >> 2, part = tid & 3;
      unsigned wv[8];
#pragma unroll
      for (int e = 0; e < 8; ++e) {
        unsigned lo = tl[(part * 16 + 2 * e) * 72 + crow], hi = tl[(part * 16 + 2 * e + 1) * 72 + crow];
        wv[e] = lo | (hi << 16);
      }
      bf16_t* dp = XT + (size_t)(ct * 64 + crow) * T_ALL + ptok0 + part * 16;
      u32x4 t0, t1;
      t0.x = wv[0]; t0.y = wv[1]; t0.z = wv[2]; t0.w = wv[3]; t1.x = wv[4]; t1.y = wv[5]; t1.z = wv[6]; t1.w = wv[7];
      *(u32x4*)dp = t0; *(u32x4*)(dp + 8) = t1;
    } else {
      const bool isB = ct < 48;
      const int cq = (ct - (isB ? 32 : 48));
      const int g = cq >> 1, chhalf = cq & 1;
      const int lane = tid & 63, r = lane & 31, hh = lane >> 5;
      bf16_t* F = isB ? BF : CF;
#pragma unroll
      for (int i = 0; i < 2; ++i) {
        const int f = (tid >> 6) + 4 * i;
        const int rt2 = f >> 2, kk4 = f & 3;
        const u32x4 v = *(const u32x4*)(tl + (32 * rt2 + r) * 72 + 16 * kk4 + 8 * hh);
        const size_t rt = (size_t)(ptok0 >> 5) + rt2;
        *(u32x4*)(F + (((rt * 8 + g) * 8 + chhalf * 4 + kk4) * 64 + lane) * 8) = v;
      }
      if (isB) {
#pragma unroll
        for (int i = 0; i < 2; ++i) {
          const int f = (tid >> 6) + 4 * i;
          const int nt2 = f >> 2, ts4 = f & 3;
          unsigned wv[4];
#pragma unroll
          for (int e = 0; e < 4; ++e) {
            unsigned lo = tl[(16 * ts4 + 8 * hh + 2 * e) * 72 + 32 * nt2 + r], hi = tl[(16 * ts4 + 8 * hh + 2 * e + 1) * 72 + 32 * nt2 + r];
            wv[e] = lo | (hi << 16);
          }
          u32x4 v; v.x = wv[0]; v.y = wv[1]; v.z = wv[2]; v.w = wv[3];
          const size_t ts = (size_t)(ptok0 >> 4) + ts4;
          *(u32x4*)(BT + (((ts * 8 + g) * 4 + chhalf * 2 + nt2) * 64 + lane) * 8) = v;
        }
      }
    }
  }
}

#define SH_STRIDE 136
__device__ __forceinline__ int rowmap(int e, int hh) { return (e & 3) + 8 * (e >> 2) + 4 * hh; }
__device__ __forceinline__ bf16x8 pack8(float a0, float a1, float a2, float a3, float a4, float a5, float a6, float a7) {
  u32x4 v; v.x = pack2(a0, a1); v.y = pack2(a2, a3); v.z = pack2(a4, a5); v.w = pack2(a6, a7);
  return __builtin_bit_cast(bf16x8, v);
}
__device__ __forceinline__ void phase_ssd_scan(const Params& p, int slot, bool colmajor, int bid, int nblk, unsigned char* smem, int cxw) {
  const int tid = opaque_tid(cxw), lane = tid & 63, w = tid >> 6, r = lane & 31, hh = lane >> 5;
  const int it = w >> 1, pt = w & 1;
  const bf16_t* xbcc = (const bf16_t*)(p.scratch + SC_SSD_XBCC);
  const bf16_t* XT = (const bf16_t*)(p.scratch + SC_SSD_XT);
  const bf16_t* BT = (const bf16_t*)(p.scratch + SC_SSD_BT);
  const bf16_t* BF = (const bf16_t*)(p.scratch + SC_SSD_BF);
  const bf16_t* CF = (const bf16_t*)(p.scratch + SC_SSD_CF);
  const float* dtb = (const float*)(p.scratch + SC_SSD_DT);
  bf16_t* ybuf = (bf16_t*)(p.scratch + SC_SSD_XBC);
  bf16_t* sXr = (bf16_t*)smem;
  bf16_t* sXs = sXr + 64 * 72;
  bf16_t* sH = sXs + 64 * 72;
  float* sW = (float*)(sH + 2 * 64 * SH_STRIDE);
  float* myW = sW + w * 256;
  for (int item = bid; item < 36 * 64; item += nblk) {
    int s, h, dir;
    if (item < 256) { s = 32 + (item >> 6); h = (item & 63) >> 1; dir = item & 1; }
    else { int itx = item - 256; s = itx >> 6; h = (itx & 63) >> 1; dir = itx & 1; }
    const int L = s < 32 ? 256 : 4096;
    const int base = s < 32 ? s * 256 : T_CTX + (s - 32) * 4096;
    const bool cm = colmajor && s >= 32;
    const int g = h >> 2;
    const float Aval = -expf(p.ssd_a_log[(slot * 2 + dir) * 32 + h]);
    const int nchunks = L >> 6;
    const int pcol = 32 * pt + r;
    f32x16 hacc[2];
    if (s >= 32) {
      const float* h0 = p.state_ssd + ((((size_t)(s - 32) * 2 + slot) * 2 + dir) * 32 + h) * 8192 + (size_t)pcol * 128;
#pragma unroll
      for (int t2 = 0; t2 < 2; ++t2)
#pragma unroll
        for (int qd = 0; qd < 4; ++qd) {
          f32x4 v = *(const f32x4*)(h0 + 32 * (2 * it + t2) + 8 * qd + 4 * hh);
          hacc[t2][4 * qd] = v.x; hacc[t2][4 * qd + 1] = v.y; hacc[t2][4 * qd + 2] = v.z; hacc[t2][4 * qd + 3] = v.w;
        }
    } else {
#pragma unroll
      for (int t2 = 0; t2 < 2; ++t2)
#pragma unroll
        for (int e = 0; e < 16; ++e) hacc[t2][e] = 0.f;
    }
#pragma unroll
    for (int t2 = 0; t2 < 2; ++t2)
#pragma unroll
      for (int qd = 0; qd < 4; ++qd) {
        u32x2 o; o.x = pack2(hacc[t2][4 * qd], hacc[t2][4 * qd + 1]); o.y = pack2(hacc[t2][4 * qd + 2], hacc[t2][4 * qd + 3]);
        *(u32x2*)(sH + pcol * SH_STRIDE + 32 * (2 * it + t2) + 8 * qd + 4 * hh) = o;
      }
    float dtv; u32x4 xtr[2]; bf16x8 cfr[8], bfr[2][8], btf[2][4];
    const bool need0 = dir == 0 ? true : (it == 0);
    const bool need1 = dir == 0 ? (it == 1) : true;
#define SCAN_PTOK(c) (base + 64 * (dir ? nchunks - 1 - (c) : (c)))
#define SCAN_LOAD_DTX(pt0) do { \
      const int tok_ = base + seqpos2off((pt0) - base + lane, cm); \
      dtv = dtb[(size_t)tok_ * 64 + dir * 32 + h]; \
      _Pragma("unroll") for (int i_ = 0; i_ < 2; ++i_) { const int q_ = tid + i_ * 256; \
        xtr[i_] = *(const u32x4*)(XT + (size_t)(h * 64 + (q_ >> 3)) * T_ALL + (pt0) + (q_ & 7) * 8); } } while (0)
#define SCAN_LOAD_CB(pt0) do { \
      const bf16_t* cf_ = CF + ((((size_t)((pt0) >> 5) + it) * 8 + g) * 8) * 512 + lane * 8; \
      _Pragma("unroll") for (int kk = 0; kk < 8; ++kk) cfr[kk] = *(const bf16x8*)(cf_ + kk * 512); \
      if (need0) { const bf16_t* bf_ = BF + ((((size_t)((pt0) >> 5)) * 8 + g) * 8) * 512 + lane * 8; \
        _Pragma("unroll") for (int kk = 0; kk < 8; ++kk) bfr[0][kk] = *(const bf16x8*)(bf_ + kk * 512); } \
      if (need1) { const bf16_t* bf_ = BF + ((((size_t)((pt0) >> 5) + 1) * 8 + g) * 8) * 512 + lane * 8; \
        _Pragma("unroll") for (int kk = 0; kk < 8; ++kk) bfr[1][kk] = *(const bf16x8*)(bf_ + kk * 512); } } while (0)
#define SCAN_LOAD_BT(pt0) do { \
      _Pragma("unroll") for (int t2 = 0; t2 < 2; ++t2) { \
        _Pragma("unroll") for (int kk = 0; kk < 4; ++kk) \
          btf[t2][kk] = *(const bf16x8*)(BT + (((((size_t)((pt0) >> 4) + kk) * 8 + g) * 4 + 2 * it + t2) * 64 + lane) * 8); } } while (0)
    {
      const int p0 = SCAN_PTOK(0);
      SCAN_LOAD_DTX(p0); SCAN_LOAD_CB(p0); SCAN_LOAD_BT(p0);
    }
    for (int ci = 0; ci < nchunks; ++ci) {
      const int ptok0 = SCAN_PTOK(ci);
      const int cin = ci + 1 < nchunks ? ci + 1 : ci;
      const int ptokN = SCAN_PTOK(cin);
      const int buf = ci & 1;
      __syncthreads();
      float decE;
      {
        const float a_ = dtv * Aval;
        const float pre = wave_incl_scan(a_);
        const float cE = __int_as_float(__builtin_amdgcn_readlane(__float_as_int(pre), 63));
        const float c = dir == 0 ? pre : cE - pre + a_;
        myW[lane] = dtv; myW[64 + lane] = c; myW[128 + lane] = __expf(c); myW[192 + lane] = dtv * __expf(cE - c);
        decE = __expf(cE);
      }
#pragma unroll
      for (int i = 0; i < 2; ++i) {
        const int q = tid + i * 256, prow = q >> 3, j8 = (q & 7) * 8;
        const u32x4 raw = xtr[i];
        *(u32x4*)(sXr + prow * 72 + j8) = raw;
        f32x4 f0 = *(const f32x4*)(myW + 192 + j8), f1 = *(const f32x4*)(myW + 192 + j8 + 4);
        u32x4 sc;
        sc.x = pack2(bflo(raw.x) * f0.x, bfhi(raw.x) * f0.y); sc.y = pack2(bflo(raw.y) * f0.z, bfhi(raw.y) * f0.w);
        sc.z = pack2(bflo(raw.z) * f1.x, bfhi(raw.z) * f1.y); sc.w = pack2(bflo(raw.w) * f1.z, bfhi(raw.w) * f1.w);
        *(u32x4*)(sXs + prow * 72 + j8) = sc;
      }
      __syncthreads();
      SCAN_LOAD_DTX(ptokN);
#pragma unroll
      for (int t2 = 0; t2 < 2; ++t2) {
#pragma unroll
        for (int e = 0; e < 16; ++e) hacc[t2][e] *= decE;
        const bf16_t* xs = sXs + pcol * 72 + 8 * hh;
#pragma unroll
        for (int kk = 0; kk < 4; ++kk)
          hacc[t2] = __builtin_amdgcn_mfma_f32_32x32x16_bf16(btf[t2][kk], *(const bf16x8*)(xs + 16 * kk), hacc[t2], 0, 0, 0);
#pragma unroll
        for (int qd = 0; qd < 4; ++qd) {
          u32x2 o; o.x = pack2(hacc[t2][4 * qd], hacc[t2][4 * qd + 1]); o.y = pack2(hacc[t2][4 * qd + 2], hacc[t2][4 * qd + 3]);
          *(u32x2*)(sH + (buf ^ 1) * 64 * SH_STRIDE + pcol * SH_STRIDE + 32 * (2 * it + t2) + 8 * qd + 4 * hh) = o;
        }
      }
      f32x16 acc;
#pragma unroll
      for (int e = 0; e < 16; ++e) acc[e] = 0.f;
      {
        const bf16_t* hp = sH + buf * 64 * SH_STRIDE + pcol * SH_STRIDE + 8 * hh;
#pragma unroll
        for (int kk = 0; kk < 8; ++kk) acc = __builtin_amdgcn_mfma_f32_32x32x16_bf16(cfr[kk], *(const bf16x8*)(hp + 16 * kk), acc, 0, 0, 0);
      }
#pragma unroll
      for (int qd = 0; qd < 4; ++qd) {
        f32x4 ec = *(const f32x4*)(myW + 128 + 32 * it + 8 * qd + 4 * hh);
        acc[4 * qd] *= ec.x; acc[4 * qd + 1] *= ec.y; acc[4 * qd + 2] *= ec.z; acc[4 * qd + 3] *= ec.w;
      }
      const int icol = 32 * it + r;
      const float ci_ = myW[64 + icol];
#pragma unroll
      for (int jt = 0; jt < 2; ++jt) {
        const bool needed = jt == 0 ? need0 : need1;
        if (needed) {
          f32x16 X;
#pragma unroll
          for (int e = 0; e < 16; ++e) X[e] = 0.f;
#pragma unroll
          for (int kk = 0; kk < 8; ++kk) X = __builtin_amdgcn_mfma_f32_32x32x16_bf16(bfr[jt][kk], cfr[kk], X, 0, 0, 0);
#pragma unroll
          for (int qd = 0; qd < 4; ++qd) {
            const int j0 = 32 * jt + 8 * qd + 4 * hh;
            f32x4 cj = *(const f32x4*)(myW + 64 + j0), dj = *(const f32x4*)(myW + j0);
            float cjv[4] = {cj.x, cj.y, cj.z, cj.w}, djv[4] = {dj.x, dj.y, dj.z, dj.w};
#pragma unroll
            for (int u = 0; u < 4; ++u) {
              const int j = j0 + u;
              const bool ok = dir == 0 ? (j <= icol) : (j >= icol);
              const float m = __expf(ci_ - cjv[u]) * djv[u];
              X[4 * qd + u] = ok ? X[4 * qd + u] * m : 0.f;
            }
          }
#pragma unroll
          for (int sk = 0; sk < 2; ++sk) {
            bf16x8 afr = pack8(X[8 * sk], X[8 * sk + 1], X[8 * sk + 2], X[8 * sk + 3], X[8 * sk + 4], X[8 * sk + 5], X[8 * sk + 6], X[8 * sk + 7]);
            const bf16_t* xp = sXr + pcol * 72 + 32 * jt + 16 * sk + 4 * hh;
            u32x2 lo = *(const u32x2*)xp, hi = *(const u32x2*)(xp + 8);
            u32x4 xv; xv.x = lo.x; xv.y = lo.y; xv.z = hi.x; xv.w = hi.y;
            acc = __builtin_amdgcn_mfma_f32_32x32x16_bf16(afr, __builtin_bit_cast(bf16x8, xv), acc, 0, 0, 0);
          }
        }
      }
      SCAN_LOAD_CB(ptokN);
      {
        bf16_t* yo = ybuf + ((size_t)dir * T_ALL + ptok0 + 32 * it) * 2048 + h * 64 + pcol;
#pragma unroll
        for (int e = 0; e < 16; ++e) yo[(size_t)rowmap(e, hh) * 2048] = f2bf(acc[e]);
      }
      SCAN_LOAD_BT(ptokN);
    }
#undef SCAN_PTOK
#undef SCAN_LOAD_DTX
#undef SCAN_LOAD_CB
#undef SCAN_LOAD_BT
    if (s < 32) {
      float* ho = p.out_ssd + ((((size_t)s * 2 + slot) * 2 + dir) * 32 + h) * 8192 + (size_t)pcol * 128;
#pragma unroll
      for (int t2 = 0; t2 < 2; ++t2)
#pragma unroll
        for (int qd = 0; qd < 4; ++qd) {
          f32x4 v; v.x = hacc[t2][4 * qd]; v.y = hacc[t2][4 * qd + 1]; v.z = hacc[t2][4 * qd + 2]; v.w = hacc[t2][4 * qd + 3];
          *(f32x4*)(ho + 32 * (2 * it + t2) + 8 * qd + 4 * hh) = v;
        }
    }
    __syncthreads();
  }
}

__device__ __forceinline__ void phase_ssd_gate(const Params& p, int slot, int bid, int nblk, int cxw) {
  const int tidx = opaque_tid(cxw);
  bf16_t* zb = (bf16_t*)(p.scratch + SC_SSD_Z);
  const bf16_t* yfb = (const bf16_t*)(p.scratch + SC_SSD_XBC);
  const bf16_t* ybb = yfb + (size_t)T_ALL * 2048;
  const bf16_t* xbcc = (const bf16_t*)(p.scratch + SC_SSD_XBCC);
  int lane = tidx & 63, wv = tidx >> 6;
  for (int row = bid * 4 + wv; row < T_ALL; row += nblk * 4) {
    float ss = 0.f;
    TokInfo ti = tokinfo(row);
    const int prow = ti.base + seqpos2off(ti.l, slot == 1 && ti.s >= 32);
#pragma unroll
    for (int j = 0; j < 4; ++j) {
      int c0 = j * 512 + lane * 8;
      u32x4 zv = *(const u32x4*)(zb + (size_t)row * 2048 + c0);
      u32x4 fv = *(const u32x4*)(yfb + (size_t)prow * 2048 + c0);
      u32x4 bv = *(const u32x4*)(ybb + (size_t)prow * 2048 + c0);
      u32x4 xv = *(const u32x4*)(xbcc + (size_t)prow * 2048 + c0);
      float dsk = p.ssd_d[slot * 32 + (c0 >> 6)];
      unsigned zw[4] = {zv.x, zv.y, zv.z, zv.w}, fw[4] = {fv.x, fv.y, fv.z, fv.w}, bw[4] = {bv.x, bv.y, bv.z, bv.w}, xw[4] = {xv.x, xv.y, xv.z, xv.w};
      unsigned ow[4];
#pragma unroll
      for (int e = 0; e < 4; ++e) {
        float y0 = (bflo(fw[e]) + bflo(bw[e]) + dsk * bflo(xw[e])) * siluf(bflo(zw[e]));
        float y1 = (bfhi(fw[e]) + bfhi(bw[e]) + dsk * bfhi(xw[e])) * siluf(bfhi(zw[e]));
        ss += y0 * y0 + y1 * y1;
        ow[e] = pack2(y0, y1);
      }
      u32x4 o; o.x = ow[0]; o.y = ow[1]; o.z = ow[2]; o.w = ow[3];
      *(u32x4*)(zb + (size_t)row * 2048 + c0) = o;
    }
#pragma unroll
    for (int o = 32; o > 0; o >>= 1) ss += shfl_xor_f(ss, o, lane);
    if (lane == 0) p.rstd[row] = rsqrtf(ss * (1.f / 2048.f) + 1e-5f);
  }
}

#define HY_UOFF 32768
__device__ __forceinline__ void hy_stage_conv(const Params& p, const bf16_t* __restrict__ row, int ch, bf16_t* dst, int dstStride, int dstPad,
                                              int nelem, int L, int tid) {
  const float w0 = p.hy_conv_w[ch], w1 = p.hy_conv_w[3072 + ch], w2 = p.hy_conv_w[2 * 3072 + ch], bb = p.hy_conv_b[ch];
  for (int q = tid; q < nelem / 8; q += NTHR) {
    const int e0 = q * 8, b = e0 / L, t0 = e0 & (L - 1);
    u32x4 raw = *(const u32x4*)(row + e0);
    float x[10];
    x[0] = t0 > 0 ? bf2f(row[e0 - 1]) : 0.f;
    x[9] = t0 + 8 < L ? bf2f(row[e0 + 8]) : 0.f;
    x[1] = bflo(raw.x); x[2] = bfhi(raw.x); x[3] = bflo(raw.y); x[4] = bfhi(raw.y);
    x[5] = bflo(raw.z); x[6] = bfhi(raw.z); x[7] = bflo(raw.w); x[8] = bfhi(raw.w);
    float o[8];
#pragma unroll
    for (int j = 0; j < 8; ++j) o[j] = w0 * x[j] + w1 * x[j + 1] + w2 * x[j + 2] + bb;
    u32x4 ov; ov.x = pack2(o[0], o[1]); ov.y = pack2(o[2], o[3]); ov.z = pack2(o[4], o[5]); ov.w = pack2(o[6], o[7]);
    *(u32x4*)(dst + b * dstStride + dstPad + t0) = ov;
  }
}

__device__ __forceinline__ void phase_hy_longconv(const Params& p, int bid, int nblk, unsigned char* smem, int cxw) {
  const int tid = opaque_tid(cxw), lane = tid & 63, w = tid >> 6, r = lane & 31, hh = lane >> 5;
  const bf16_t* projT = (const bf16_t*)(p.scratch + SC_HY_PROJT);
  bf16_t* yT = (bf16_t*)(p.scratch + SC_HY_YT);
  unsigned* Rc0 = (unsigned*)smem;
  unsigned* Rc1 = Rc0 + 4096;
  bf16_t* G = (bf16_t*)smem;
  bf16_t* U = (bf16_t*)(smem + HY_UOFF);
  for (int item = bid; item < 2048; item += nblk) {
    const bool lat = item < 1024;
    const int c = item & 1023;
    const int L = lat ? 4096 : 256, NB = lat ? 4 : 32, RL = lat ? 8192 : 512, Lm1 = L - 1;
    const int PAD = lat ? 224 : 0, US = L + 2 * PAD;
    const int tokbase = lat ? T_CTX : 0;
    const int nI = L >> 5, nelem = NB * L;
    const int TPW = lat ? 4 : 2;
    __syncthreads();
    if (lat) {
      for (int q = tid; q < 4 * 56; q += NTHR) {
        int b = q / 56, k = q % 56;
        int off = k < 28 ? k * 8 : 224 + 4096 + (k - 28) * 8;
        unsigned zz = 0u; asm volatile("" : "+v"(zz));
        u32x4 z4 = {zz, zz, zz, zz};
        *(u32x4*)(U + b * US + off) = z4;
      }
    }
    hy_stage_conv(p, projT + (size_t)c * T_ALL + tokbase, c, U, US, PAD, nelem, L, tid);
    int Icol[4], bcol[4];
#pragma unroll
    for (int tt = 0; tt < 4; ++tt) {
      int n = (w * TPW + tt) * 32 + r;
      Icol[tt] = lat ? (n >> 2) : (n >> 5);
      bcol[tt] = lat ? (n & 3) : (n & 31);
    }
    const int Ilo_w = lat ? 32 * w : 2 * w, Ihi_w = lat ? 32 * w + 31 : 2 * w + 1;
    const int dlo = Ilo_w - (nI - 1), dhi = Ihi_w;
    for (int order = 0; order < 2; ++order) {
      {
        const bf16_t* src = (lat ? p.rtab1 : p.rtab0) + (size_t)(order * 1024 + c) * RL;
        for (int q = tid; q < RL / 8; q += NTHR) {
          u32x4 cv = *(const u32x4*)(src + q * 8);
          unsigned nx = (q + 1 < RL / 8) ? *(const unsigned*)(src + q * 8 + 8) : 0u;
          *(u32x4*)(Rc0 + q * 4) = cv;
          u32x4 sv;
          sv.x = (cv.x >> 16) | (cv.y << 16); sv.y = (cv.y >> 16) | (cv.z << 16);
          sv.z = (cv.z >> 16) | (cv.w << 16); sv.w = (cv.w >> 16) | (nx << 16);
          *(u32x4*)(Rc1 + q * 4) = sv;
        }
      }
      __syncthreads();
      f32x16 acc[4];
#pragma unroll
      for (int tt = 0; tt < 4; ++tt)
#pragma unroll
        for (int e = 0; e < 16; ++e) acc[tt][e] = 0.f;
      for (int d = dlo; d <= dhi; ++d) {
#pragma unroll
        for (int kk = 0; kk < 2; ++kk) {
          const int y0 = Lm1 - 32 * d - r + 16 * kk + 8 * hh;
          const int par = y0 & 1;
          const unsigned* rp = (par ? Rc1 : Rc0) + ((y0 - par) >> 1);
          u32x4 av; av.x = rp[0]; av.y = rp[1]; av.z = rp[2]; av.w = rp[3];
          bf16x8 af = __builtin_bit_cast(bf16x8, av);
#pragma unroll
          for (int tt = 0; tt < 4; ++tt) {
            if (tt < TPW) {
              const int tile = w * TPW + tt;
              const int Ilo_t = lat ? 8 * tile : tile, Ihi_t = lat ? 8 * tile + 7 : tile;
              if (d >= Ilo_t - (nI - 1) && d <= Ihi_t) {
                const bf16_t* bp = U + bcol[tt] * US + PAD + 32 * (Icol[tt] - d) + 16 * kk + 8 * hh;
                bf16x8 bfr = *(const bf16x8*)bp;
                acc[tt] = __builtin_amdgcn_mfma_f32_32x32x16_bf16(af, bfr, acc[tt], 0, 0, 0);
              }
            }
          }
        }
      }
      __syncthreads();
      hy_stage_conv(p, projT + (size_t)((1 + order) * 1024 + c) * T_ALL + tokbase, (1 + order) * 1024 + c, G, L, 0, nelem, L, tid);
      __syncthreads();
      const float inv = 1.f / p.knorm[((lat ? 1 : 0) * 2 + order) * 1024 + c];
      const float bias = p.hy_f_bias[order * 1024 + c];
#pragma unroll
      for (int tt = 0; tt < 4; ++tt) {
        if (tt < TPW) {
#pragma unroll
          for (int qd = 0; qd < 4; ++qd) {
            const int t0 = 32 * Icol[tt] + 8 * qd + 4 * hh;
            bf16_t* up = U + bcol[tt] * US + PAD + t0;
            u32x2 uc = *(const u32x2*)up;
            u32x2 gg = *(const u32x2*)(G + bcol[tt] * L + t0);
            float r0 = (inv * acc[tt][4 * qd] + bias * bflo(uc.x)) * bflo(gg.x);
            float r1 = (inv * acc[tt][4 * qd + 1] + bias * bfhi(uc.x)) * bfhi(gg.x);
            float r2 = (inv * acc[tt][4 * qd + 2] + bias * bflo(uc.y)) * bflo(gg.y);
            float r3 = (inv * acc[tt][4 * qd + 3] + bias * bfhi(uc.y)) * bfhi(gg.y);
            if (order == 1) {
              u32x2 zz = *(const u32x2*)(projT + (size_t)(3072 + c) * T_ALL + tokbase + bcol[tt] * L + t0);
              r0 *= siluf(bflo(zz.x)); r1 *= siluf(bfhi(zz.x)); r2 *= siluf(bflo(zz.y)); r3 *= siluf(bfhi(zz.y));
            }
            u32x2 ov; ov.x = pack2(r0, r1); ov.y = pack2(r2, r3);
            *(u32x2*)up = ov;
          }
        }
      }
      __syncthreads();
    }
    for (int q = tid; q < nelem / 8; q += NTHR) {
      const int e0 = q * 8, b = e0 / L, t0 = e0 & (L - 1);
      *(u32x4*)(yT + (size_t)c * T_ALL + tokbase + e0) = *(const u32x4*)(U + b * US + PAD + t0);
    }
  }
}

__device__ __forceinline__ void phase_hy_transpose(const Params& p, int bid, int nblk, unsigned char* smem, int cxw) {
  const int tid = opaque_tid(cxw);
  const bf16_t* yT = (const bf16_t*)(p.scratch + SC_HY_YT);
  bf16_t* yg = (bf16_t*)(p.scratch + SC_HY_YG);
  bf16_t* tl = (bf16_t*)smem;
  for (int item = bid; item < 16 * (T_ALL / 64); item += nblk) {
    const int cb = item & 15, tb = item >> 4;
    __syncthreads();
#pragma unroll
    for (int i = 0; i < 2; ++i) {
      int q = tid + i * 256, cr = q >> 3, t8 = (q & 7) * 8;
      u32x4 v = *(const u32x4*)(yT + (size_t)(cb * 64 + cr) * T_ALL + tb * 64 + t8);
      unsigned wv[4] = {v.x, v.y, v.z, v.w};
#pragma unroll
      for (int e = 0; e < 4; ++e) {
        tl[(t8 + 2 * e) * 72 + cr] = (bf16_t)(wv[e] & 0xffffu);
        tl[(t8 + 2 * e + 1) * 72 + cr] = (bf16_t)(wv[e] >> 16);
      }
    }
    __syncthreads();
#pragma unroll
    for (int i = 0; i < 2; ++i) {
      int q = tid + i * 256, tr = q >> 3, c8 = (q & 7) * 8;
      *(u32x4*)(yg + (size_t)(tb * 64 + tr) * 1024 + cb * 64 + c8) = *(const u32x4*)(tl + tr * 72 + c8);
    }
  }
}

__device__ __forceinline__ void lru_ab(const bf16_t* gates, const bf16_t* xc, int dir, int tok, int c, float sp, float& a, float& bx) {
  float r = bf2f(gates[((size_t)(dir * 2 + 0) * T_ALL + tok) * 1024 + c]);
  float i = bf2f(gates[((size_t)(dir * 2 + 1) * T_ALL + tok) * 1024 + c]);
  float x = bf2f(xc[(size_t)tok * 1024 + c]);
  float log_a = -8.f * r * sp;
  a = __expf(log_a);
  float m = sqrtf(fmaxf(1.f - __expf(2.f * log_a), 0.f));
  bx = m * i * x;
}
__device__ __forceinline__ void phase_lru_scan_chunks(const Params& p, int pass, int bid, int nblk, int cxw) {
  const int tidx = opaque_tid(cxw);
  const bf16_t* gates = (const bf16_t*)(p.scratch + SC_LRU_GATES);
  const bf16_t* xc = (const bf16_t*)(p.scratch + SC_LRU_XC);
  bf16_t* ybuf = (bf16_t*)(p.scratch + SC_LRU_Y);
  for (int item = bid; item < 192 * 8; item += nblk) {
    int chunk = item >> 3, dir = (item >> 2) & 1, cb = item & 3;
    int c = cb * 256 + tidx;
    float sp = softplusf(-p.lru_a_param[dir * 1024 + c]);
    int tok0 = chunk * 128;
    float A = 1.f, h = (pass == 0) ? 0.f : p.lru_hin[((size_t)dir * 192 + chunk) * 1024 + c];
    for (int j = 0; j < 128; ++j) {
      int tok = dir ? tok0 + 127 - j : tok0 + j;
      float a, bx;
      lru_ab(gates, xc, dir, tok, c, sp, a, bx);
      h = a * h + bx; A *= a;
      if (pass == 2) ybuf[((size_t)dir * T_ALL + tok) * 1024 + c] = f2bf(h);
    }
    if (pass == 0) {
      float* ag = p.lru_agg + (((size_t)dir * 192 + chunk) * 1024 + c) * 2;
      ag[0] = A; ag[1] = h;
    }
  }
}
__device__ __forceinline__ void phase_lru_scan_carry(const Params& p, int bid, int nblk, int cxw) {
  const int tidx = opaque_tid(cxw);
  for (int item = bid; item < 36 * 8; item += nblk) {
    int s = item >> 3, dir = (item >> 2) & 1, cb = item & 3;
    int c = cb * 256 + tidx;
    int nch = s < 32 ? 2 : 32;
    int ch0 = s < 32 ? s * 2 : 64 + (s - 32) * 32;
    float h = s < 32 ? 0.f : p.state_lru[((size_t)(s - 32) * 2 + dir) * 1024 + c];
    for (int k = 0; k < nch; ++k) {
      int chunk = dir ? ch0 + nch - 1 - k : ch0 + k;
      size_t idx = ((size_t)dir * 192 + chunk) * 1024 + c;
      p.lru_hin[idx] = h;
      h = p.lru_agg[idx * 2] * h + p.lru_agg[idx * 2 + 1];
    }
    if (s < 32) p.out_lru[((size_t)s * 2 + dir) * 1024 + c] = h;
  }
}
__device__ __forceinline__ void phase_lru_combine(const Params& p, int bid, int nblk, int cxw) {
  const int tidx = opaque_tid(cxw);
  const bf16_t* proj = (const bf16_t*)(p.scratch + SC_LRU_PROJ);
  const bf16_t* yf = (const bf16_t*)(p.scratch + SC_LRU_Y);
  const bf16_t* yb = yf + (size_t)T_ALL * 1024;
  bf16_t* yg = (bf16_t*)(p.scratch + SC_LRU_YG);
  const size_t total = (size_t)T_ALL * 128;
  for (size_t idx = (size_t)bid * NTHR + tidx; idx < total; idx += (size_t)nblk * NTHR) {
    int tok = (int)(idx >> 7), c0 = (int)(idx & 127) * 8;
    u32x4 fv = *(const u32x4*)(yf + (size_t)tok * 1024 + c0);
    u32x4 bv = *(const u32x4*)(yb + (size_t)tok * 1024 + c0);
    u32x4 zv = *(const u32x4*)(proj + (size_t)tok * 2048 + 1024 + c0);
    unsigned fw[4] = {fv.x, fv.y, fv.z, fv.w}, bw[4] = {bv.x, bv.y, bv.z, bv.w}, zw[4] = {zv.x, zv.y, zv.z, zv.w}, ow[4];
#pragma unroll
    for (int e = 0; e < 4; ++e)
      ow[e] = pack2((bflo(fw[e]) + bflo(bw[e])) * siluf(bflo(zw[e])), (bfhi(fw[e]) + bfhi(bw[e])) * siluf(bfhi(zw[e])));
    u32x4 o; o.x = ow[0]; o.y = ow[1]; o.z = ow[2]; o.w = ow[3];
    *(u32x4*)(yg + (size_t)tok * 1024 + c0) = o;
  }
}

enum { PH_PREP = 0, PH_MOD, PH_HYA, PH_HYB, PH_LNMOD, PH_INPROJ, PH_MIX1, PH_MIX2, PH_MIX3, PH_MIX4, PH_MIX5, PH_MIX6, PH_OUTPROJ };

struct Ctx { int bid, nblk, wave; unsigned char* smem; unsigned char* wg_smem; };

template <class Epi>
__device__ __forceinline__ void run_gemm(const Ctx& cx, const bf16_t* A, int lda, const bf16_t* Bt, int M, int N, int K, int grp_shift, int grp_bytes, const Epi& e) {
  pg8::Gemm g{A, Bt, M, N, K, lda, grp_shift, grp_bytes};
  pg8::StaticOrder S; S.init(M, N, gridDim.x, opaque_s(blockIdx.x));
  pg8::gemm_phase((PG8_LAS unsigned char*)cx.wg_smem, g, S, e, cx.wave);
}

#define N_PARAM_WORDS (sizeof(Params) / 8)
__device__ __forceinline__ Params load_params(const unsigned char* lp) {
  Params p;
  unsigned long long* d = (unsigned long long*)&p;
  const unsigned long long* sp = (const unsigned long long*)lp;
#pragma unroll
  for (int i = 0; i < (int)N_PARAM_WORDS; ++i) {
    const unsigned long long v = sp[i];
    const unsigned lo = __builtin_amdgcn_readfirstlane((unsigned)v), hi = __builtin_amdgcn_readfirstlane((unsigned)(v >> 32));
    d[i] = ((unsigned long long)hi << 32) | lo;
  }
  return p;
}
__device__ __forceinline__ void run_phase(const unsigned char* lparams, int ph, int layer, const Ctx& cx) {
  const Params p = load_params(lparams);
  const int kind = layer % 3, slot = layer / 3;
  const int bid = opaque_s(cx.bid), nblk = cx.nblk;
  unsigned char* smem = cx.smem;
  switch (ph) {
    case PH_PREP: phase_prep(p, bid, nblk, smem, cx.wave); break;
    case PH_MOD: phase_mod(p, bid, nblk, smem, cx.wave); break;
    case PH_HYA: phase_hyfilt_a(p, bid, nblk, smem, cx.wave); break;
    case PH_HYB: phase_hyfilt_b(p, bid, nblk, smem, cx.wave); break;
    case PH_LNMOD: phase_lnmod(p, layer, bid, nblk, cx.wave); break;
    case PH_INPROJ:
      if (kind == 0) {
        pg8::EpiSsdIn e{(bf16_t*)(p.scratch + SC_SSD_Z), (bf16_t*)(p.scratch + SC_SSD_XBC), (float*)(p.scratch + SC_SSD_DT), p.ssd_dt_bias + slot * 64};
        run_gemm(cx, p.hbuf, 1024, p.wt_ssd_in + (size_t)slot * 6400 * 1024, T_ALL, 6400, 1024, 30, 0, e);
      } else if (kind == 1) {
        pg8::EpiBf16 e{(bf16_t*)(p.scratch + SC_HY_PROJT), (size_t)T_ALL};
        run_gemm(cx, p.wt_hy_in, 1024, p.hbuf, 4096, T_ALL, 1024, 30, 0, e);
      } else {
        pg8::EpiBf16 e{(bf16_t*)(p.scratch + SC_LRU_PROJ), (size_t)2048};
        run_gemm(cx, p.hbuf, 1024, p.wt_lru_in, T_ALL, 2048, 1024, 30, 0, e);
      }
      break;
    case PH_MIX1:
      if (kind == 0) phase_ssd_conv(p, slot, slot == 1, bid, nblk, smem, cx.wave);
      else if (kind == 1) phase_hy_longconv(p, bid, nblk, smem, cx.wave);
      else phase_dwconv<4, false>((const bf16_t*)(p.scratch + SC_LRU_PROJ), 2048, (bf16_t*)(p.scratch + SC_LRU_XC), 1024, 1024,
                                  p.lru_conv_w, p.lru_conv_b, false, bid, nblk, cx.wave);
      break;
    case PH_MIX2:
      if (kind == 0) phase_ssd_scan(p, slot, slot == 1, bid, nblk, smem, cx.wave);
      else if (kind == 1) phase_hy_transpose(p, bid, nblk, smem, cx.wave);
      else {
        pg8::EpiLruGate e{(bf16_t*)(p.scratch + SC_LRU_GATES), p.lru_gate_b};
        run_gemm(cx, (const bf16_t*)(p.scratch + SC_LRU_XC), 1024, p.wt_lru_gate, T_ALL, 4096, 256, 2, 512, e);
      }
      break;
    case PH_MIX3:
      if (kind == 0) phase_ssd_gate(p, slot, bid, nblk, cx.wave);
      else phase_lru_scan_chunks(p, 0, bid, nblk, cx.wave);
      break;
    case PH_MIX4: if (kind == 2) phase_lru_scan_carry(p, bid, nblk, cx.wave); break;
    case PH_MIX5: if (kind == 2) phase_lru_scan_chunks(p, 2, bid, nblk, cx.wave); break;
    case PH_MIX6: if (kind == 2) phase_lru_combine(p, bid, nblk, cx.wave); break;
    case PH_OUTPROJ: {
      const float* mv = p.modv + (size_t)layer * 5 * 3072;
      if (kind == 0) {
        pg8::EpiOut e{p.xres, mv, p.rstd};
        run_gemm(cx, (const bf16_t*)(p.scratch + SC_SSD_Z), 2048, p.wt_ssd_out + (size_t)slot * 1024 * 2048, T_ALL, 1024, 2048, 30, 0, e);
      } else if (kind == 1) {
        pg8::EpiOut e{p.xres, mv, nullptr};
        run_gemm(cx, (const bf16_t*)(p.scratch + SC_HY_YG), 1024, p.wt_hy_out, T_ALL, 1024, 1024, 30, 0, e);
      } else {
        pg8::EpiOut e{p.xres, mv, nullptr};
        run_gemm(cx, (const bf16_t*)(p.scratch + SC_LRU_YG), 1024, p.wt_lru_out, T_ALL, 1024, 1024, 30, 0, e);
      }
    } break;
  }
}

__global__ void __launch_bounds__(WG_THREADS, 2) k_mega(Params p) {
  __shared__ __attribute__((aligned(16))) unsigned char smem[WG_SMEM + 16 + 512];
  cg::grid_group grid = cg::this_grid();
  const int wave0 = __builtin_amdgcn_readfirstlane((int)(threadIdx.x >> 6));
  const int vb = wave0 >> 2;
  Ctx cx;
  cx.wave = wave0;
  cx.bid = 2 * blockIdx.x + vb; cx.nblk = 2 * gridDim.x; cx.smem = smem + vb * SMEM_BYTES; cx.wg_smem = smem;
  volatile LAS unsigned* xst = (volatile LAS unsigned*)(smem + WG_SMEM);
  unsigned char* lparams = smem + WG_SMEM + 16;
  if (threadIdx.x == 0) { xst[0] = 0u; xst[1] = 0u; *(Params*)lparams = p; }
  __syncthreads();
  const XcdBarrier xb = xcd_barrier_post(p.bar, xst);
  run_phase(lparams, PH_PREP, 0, cx);
  run_phase(lparams, PH_MOD, 0, cx);
  run_phase(lparams, PH_HYA, 0, cx);
  grid.sync();
  run_phase(lparams, PH_HYB, 0, cx);
  for (int layer = 0; layer < 4; ++layer) {
    const int kind = layer % 3;
    run_phase(lparams, PH_LNMOD, layer, cx);
    xcd_barrier(xb, cx.wave);
    run_phase(lparams, PH_INPROJ, layer, cx);
    xcd_barrier(xb, cx.wave);
    run_phase(lparams, PH_MIX1, layer, cx);
    xcd_barrier(xb, cx.wave);
    run_phase(lparams, PH_MIX2, layer, cx);
    xcd_barrier(xb, cx.wave);
    if (kind != 1) {
      run_phase(lparams, PH_MIX3, layer, cx);
      xcd_barrier(xb, cx.wave);
    }
    if (kind == 2) {
      run_phase(lparams, PH_MIX4, layer, cx);
      xcd_barrier(xb, cx.wave);
      run_phase(lparams, PH_MIX5, layer, cx);
      xcd_barrier(xb, cx.wave);
      run_phase(lparams, PH_MIX6, layer, cx);
      xcd_barrier(xb, cx.wave);
    }
    run_phase(lparams, PH_OUTPROJ, layer, cx);
    xcd_barrier(xb, cx.wave);
  }
  run_phase(lparams, PH_LNMOD, 4, cx);
}

static inline size_t align_up(size_t x) { return (x + 255) & ~(size_t)255; }

extern "C" void kernel_launch(void* const* d_in, const int* in_sizes, int n_in, void* d_out, int out_size, void* d_ws, size_t ws_size,
                              hipStream_t stream) {
  Params p{};
  const float** fp = (const float**)&p;
  for (int i = 0; i < 36; ++i) fp[i] = (const float*)d_in[i];
  float* out = (float*)d_out;
  p.xres = out;
  p.out_ssd = out + (size_t)T_ALL * 1024;
  p.out_lru = p.out_ssd + (size_t)32 * 2 * 2 * 32 * 64 * 128;
  unsigned char* w = (unsigned char*)d_ws;
  size_t off = 0;
  auto carve = [&](size_t bytes) { unsigned char* r = w + off; off = align_up(off + bytes); return r; };
  p.wt_ssd_in = (bf16_t*)carve((size_t)2 * 6400 * 1024 * 2);
  p.wt_ssd_out = (bf16_t*)carve((size_t)2 * 1024 * 2048 * 2);
  p.wt_hy_in = (bf16_t*)carve((size_t)4096 * 1024 * 2);
  p.wt_hy_out = (bf16_t*)carve((size_t)1024 * 1024 * 2);
  p.wt_lru_in = (bf16_t*)carve((size_t)2048 * 1024 * 2);
  p.wt_lru_out = (bf16_t*)carve((size_t)1024 * 1024 * 2);
  p.wt_lru_gate = (bf16_t*)carve((size_t)4 * 1024 * 256 * 2);
  p.modv = (float*)carve((size_t)4 * 5 * 3072 * 4);
  p.hdn2 = (float*)carve((size_t)4352 * 64 * 4);
  p.rtab0 = (bf16_t*)carve((size_t)2 * 1024 * 512 * 2);
  p.rtab1 = (bf16_t*)carve((size_t)2 * 1024 * 8192 * 2);
  p.knorm = (float*)carve((size_t)4 * 1024 * 4);
  p.hbuf = (bf16_t*)carve((size_t)T_ALL * 1024 * 2);
  p.rstd = (float*)carve((size_t)T_ALL * 4);
  p.lru_agg = (float*)carve((size_t)2 * 192 * 1024 * 2 * 4);
  p.lru_hin = (float*)carve((size_t)2 * 192 * 1024 * 4);
  p.bar = (unsigned*)carve((size_t)XCD_BAR_WORDS * 4);
  p.scratch = carve(SC_TOTAL);
  if (off > ws_size) return;

  static int grid_blocks = 0;
  if (!grid_blocks) {
    int dev = 0, cus = 0, per_cu = 0;
    hipGetDevice(&dev);
    hipDeviceGetAttribute(&cus, hipDeviceAttributeMultiprocessorCount, dev);
    hipOccupancyMaxActiveBlocksPerMultiprocessor(&per_cu, k_mega, WG_THREADS, 0);
    if (per_cu > 1) per_cu = 1;
    grid_blocks = cus * per_cu;
  }
  hipMemsetAsync(p.bar, 0, (size_t)XCD_BAR_WORDS * 4, stream);
  void* args[] = {&p};
  hipError_t e = hipLaunchCooperativeKernel((void*)k_mega, dim3(grid_blocks), dim3(WG_THREADS), args, 0, stream);
  if (e != hipSuccess) fprintf(stderr, "cooperative launch failed: %s (grid %d)\n", hipGetErrorString(e), grid_blocks);
}
```

```cpp
#include <hip/hip_runtime.h>
#include <hip/hip_bf16.h>
#include <hip/hip_cooperative_groups.h>
#include <stdint.h>
#include <cstdio>
namespace cg = cooperative_groups;

typedef unsigned short bf16_t;
typedef __attribute__((ext_vector_type(8))) short bf16x8;
typedef __attribute__((ext_vector_type(16))) float f32x16;
typedef __attribute__((ext_vector_type(4))) unsigned int u32x4;
typedef __attribute__((ext_vector_type(2))) unsigned int u32x2;
typedef __attribute__((ext_vector_type(4))) float f32x4;
typedef float f32x4_t __attribute__((ext_vector_type(4)));

#define T_CTX 8192
#define T_ALL 24576
#define DM 1024
#define NTHR 256
#define SMEM_BYTES 69632
#define WG_THREADS 512
#define WG_SMEM (2 * SMEM_BYTES)
#define ALPHA_RES 1.6817928305074290f
#define LN_EPS 1e-5f

__device__ __forceinline__ bf16_t f2bf(float f) { __bf16 h = (__bf16)f; return __builtin_bit_cast(bf16_t, h); }
__device__ __forceinline__ float bf2f(bf16_t b) { return __uint_as_float(((unsigned)b) << 16); }
__device__ __forceinline__ float bflo(unsigned w) { return __uint_as_float(w << 16); }
__device__ __forceinline__ float bfhi(unsigned w) { return __uint_as_float(w & 0xffff0000u); }
typedef __bf16 bf16v2_t __attribute__((ext_vector_type(2)));
typedef float f32v2_t __attribute__((ext_vector_type(2)));
__device__ __forceinline__ unsigned pack2(float a, float b) { f32v2_t v = {a, b}; bf16v2_t h = __builtin_convertvector(v, bf16v2_t); return __builtin_bit_cast(unsigned, h); }
__device__ __forceinline__ float siluf(float x) { return x / (1.f + __expf(-x)); }
__device__ __forceinline__ float sigmoidf(float x) { return 1.f / (1.f + __expf(-x)); }
__device__ __forceinline__ float softplusf(float x) { return x > 20.f ? x : __logf(1.f + __expf(x)); }


__device__ __forceinline__ int opaque_lane() { int z = 0; asm volatile("" : "+v"(z)); return __builtin_amdgcn_mbcnt_hi(~0u, __builtin_amdgcn_mbcnt_lo(~0u, (unsigned)z)); }
__device__ __forceinline__ int opaque_tid512(int wave) { return (wave << 6) + opaque_lane(); }
__device__ __forceinline__ int opaque_tid(int wave) { return opaque_tid512(wave) & 255; }

#define XB_TMO      128
#define XB_XCNT(j)  (256  + 64 * (j))
#define XB_XSUB(j)  (1280 + 64 * (j))
#define XB_XGEN(j)  (2304 + 64 * (j))
#define XB_TOP      3328
#define XB_TOPGEN   3392
#define XCD_BAR_WORDS 3456
#define XB_SPIN_CAP (1u << 18)
#define LAS __attribute__((address_space(3)))
__device__ __forceinline__ unsigned xb_ld(unsigned* p)              { return __hip_atomic_load(p, __ATOMIC_RELAXED, __HIP_MEMORY_SCOPE_AGENT); }
__device__ __forceinline__ unsigned xb_add(unsigned* p, unsigned v) { return __hip_atomic_fetch_add(p, v, __ATOMIC_RELAXED, __HIP_MEMORY_SCOPE_AGENT); }
__device__ __forceinline__ unsigned xb_xcc_id() { return (unsigned)__builtin_amdgcn_s_getreg((3 << 11) | 20) & 0xFu; }
#define XB_SPIN(cond, bar) do { unsigned _sp = 0; while (cond) { __builtin_amdgcn_s_sleep(1); \
    if ((++_sp & 255u) == 0u) { if (xb_ld(&(bar)[XB_TMO])) break; if (_sp > XB_SPIN_CAP) { atomicAdd(&(bar)[XB_TMO], 1u); break; } } } } while (0)
struct XcdBarrier { unsigned* bar; unsigned x; volatile LAS unsigned* st; };
__device__ __forceinline__ XcdBarrier xcd_barrier_post(unsigned* bar, volatile LAS unsigned* st) {
  XcdBarrier b; b.bar = bar; b.x = xb_xcc_id(); b.st = st;
  if (threadIdx.x == 0) (void)xb_add(&bar[XB_XCNT(b.x)], 1u);
  return b;
}
__device__ __forceinline__ void xcd_barrier_complete(unsigned* bar, unsigned x, unsigned& nloc, unsigned& nx) {
  const unsigned G = gridDim.x * gridDim.y * gridDim.z;
  unsigned sum, cnt, mine, sp = 0u;
  for (;;) {
    sum = 0u; cnt = 0u; mine = 0u;
#pragma unroll
    for (unsigned j = 0; j < 16; ++j) { const unsigned c = xb_ld(&bar[XB_XCNT(j)]); sum += c; cnt += (c > 0u) ? 1u : 0u; mine = (j == x) ? c : mine; }
    if (sum == G) break;
    __builtin_amdgcn_s_sleep(1);
    if ((++sp & 255u) == 0u) { if (xb_ld(&bar[XB_TMO])) break; if (sp > XB_SPIN_CAP) { atomicAdd(&bar[XB_TMO], 1u); break; } }
  }
  nloc = mine > 0u ? mine : 1u; nx = cnt > 0u ? cnt : 1u;
}
__device__ __forceinline__ void xcd_barrier(const XcdBarrier& b, int wave) {
  asm volatile("s_waitcnt vmcnt(0)" ::: "memory");
  __syncthreads();
  if (opaque_tid512(wave) == 0) {
    unsigned* bar = b.bar;
    __builtin_amdgcn_s_waitcnt(0);
    unsigned nloc = b.st[0], nx = b.st[1];
    if (nloc == 0u) { xcd_barrier_complete(bar, b.x, nloc, nx); b.st[0] = nloc; b.st[1] = nx; }
    const unsigned old = xb_add(&bar[XB_XSUB(b.x)], 1u);
    const unsigned gen = old / nloc;
    if (old + 1u == (gen + 1u) * nloc) {
      __builtin_amdgcn_fence(__ATOMIC_RELEASE, "agent");
      asm volatile("s_waitcnt vmcnt(0)" ::: "memory");
      const unsigned og = xb_add(&bar[XB_TOP], 1u);
      const unsigned tg = og / nx;
      if (og + 1u == (tg + 1u) * nx) xb_add(&bar[XB_TOPGEN], 1u);
      else XB_SPIN(xb_ld(&bar[XB_TOPGEN]) == tg, bar);
      __builtin_amdgcn_fence(__ATOMIC_ACQUIRE, "agent");
      xb_add(&bar[XB_XGEN(b.x)], 1u);
      asm volatile("s_waitcnt vmcnt(0)" ::: "memory");
    } else {
      XB_SPIN(xb_ld(&bar[XB_XGEN(b.x)]) == gen, bar);
      __builtin_amdgcn_fence(__ATOMIC_ACQUIRE, "agent");
      asm volatile("s_waitcnt vmcnt(0)" ::: "memory");
    }
  }
  __syncthreads();
}


__device__ __forceinline__ int opaque_s(int x) { asm volatile("" : "+s"(x)); return x; }

__device__ __forceinline__ float shfl_idx_f(float v, int src) { return __int_as_float(__builtin_amdgcn_ds_bpermute(src << 2, __float_as_int(v))); }
__device__ __forceinline__ float shfl_xor_f(float v, int off, int lane) { return shfl_idx_f(v, lane ^ off); }

__device__ __forceinline__ float wave_incl_scan(float v) {
#define DPP_ADD(ctrl, rmask) v += __int_as_float(__builtin_amdgcn_update_dpp(0, __float_as_int(v), ctrl, rmask, 0xf, false))
  DPP_ADD(0x111, 0xf); DPP_ADD(0x112, 0xf); DPP_ADD(0x114, 0xf); DPP_ADD(0x118, 0xf);
  DPP_ADD(0x142, 0xa); DPP_ADD(0x143, 0xc);
#undef DPP_ADD
  return v;
}

struct TokInfo { int s, l, L, base, mrow; };
__device__ __forceinline__ TokInfo tokinfo(int tok) {
  TokInfo t;
  if (tok < T_CTX) { t.s = tok >> 8; t.l = tok & 255; t.L = 256; t.base = tok & ~255; t.mrow = 0; }
  else { int u = tok - T_CTX; t.s = 32 + (u >> 12); t.l = u & 4095; t.L = 4096; t.base = T_CTX + (u & ~4095); t.mrow = 1 + (u >> 12); }
  return t;
}
__device__ __forceinline__ int seqpos2off(int pos, bool cm) { return cm ? (((pos & 63) << 6) | (pos >> 6)) : pos; }

struct Params {
  const float *x_prompt, *x_sample, *state_ssd, *state_lru, *c, *c_ctx, *mod_w, *mod_b, *ln_g, *ln_b;
  const float *ssd_in_w, *ssd_conv_w, *ssd_conv_b, *ssd_dt_bias, *ssd_a_log, *ssd_d, *ssd_norm_g, *ssd_out_w;
  const float *hy_in_w, *hy_conv_w, *hy_conv_b, *hy_f_w1, *hy_f_b1, *hy_f_w2, *hy_f_b2, *hy_f_w3, *hy_f_freq, *hy_f_bias, *hy_out_w;
  const float *lru_in_w, *lru_conv_w, *lru_conv_b, *lru_gate_w, *lru_gate_b, *lru_a_param, *lru_out_w;
  float *xres, *out_ssd, *out_lru;
  bf16_t *wt_ssd_in, *wt_ssd_out, *wt_hy_in, *wt_hy_out, *wt_lru_in, *wt_lru_out, *wt_lru_gate;
  float *modv;
  float *hdn2;
  bf16_t *rtab0;
  bf16_t *rtab1;
  float *knorm;
  bf16_t *hbuf;
  float *rstd;
  float *lru_agg;
  float *lru_hin;
  unsigned char *scratch;
  unsigned *bar;
};

#define SC_SSD_Z     ((size_t)0)
#define SC_SSD_XBC   ((size_t)T_ALL * 2048 * 2)
#define SC_SSD_XBCC  (SC_SSD_XBC + (size_t)T_ALL * 4096 * 2)
#define SC_SSD_DT    (SC_SSD_XBCC + (size_t)T_ALL * 2048 * 2)
#define SC_SSD_XT    (SC_SSD_DT + (size_t)T_ALL * 64 * 4)
#define SC_SSD_BT    (SC_SSD_XT + (size_t)T_ALL * 2048 * 2)
#define SC_SSD_BF    (SC_SSD_BT + (size_t)T_ALL * 1024 * 2)
#define SC_SSD_CF    (SC_SSD_BF + (size_t)T_ALL * 1024 * 2)
#define SC_SSD_END   (SC_SSD_CF + (size_t)T_ALL * 1024 * 2)
#define SC_HY_PROJT  ((size_t)0)
#define SC_HY_YT     ((size_t)T_ALL * 4096 * 2)
#define SC_HY_YG     (SC_HY_YT + (size_t)T_ALL * 1024 * 2)
#define SC_LRU_PROJ  ((size_t)0)
#define SC_LRU_XC    ((size_t)T_ALL * 2048 * 2)
#define SC_LRU_GATES (SC_LRU_XC + (size_t)T_ALL * 1024 * 2)
#define SC_LRU_Y     (SC_LRU_GATES + (size_t)T_ALL * 4096 * 2)
#define SC_LRU_YG    (SC_LRU_Y + (size_t)T_ALL * 2048 * 2)
#define SC_TOTAL     SC_SSD_END

__device__ __forceinline__ void transpose_tile(const float* __restrict__ src, int ld_src, int n_src, bf16_t* __restrict__ dst, int K,
                               const float* __restrict__ scale, int tile, int tiles_k, float* tl, int cxw) {
  const int tidx = opaque_tid(cxw);
  int tk = tile % tiles_k, tn = tile / tiles_k;
  int k0 = tk * 64, n0 = tn * 64;
  int tx = tidx & 63, ty = tidx >> 6;
  __syncthreads();
  for (int r = ty; r < 64; r += 4) {
    int n = n0 + tx;
    float v = 0.f;
    if (n < n_src) { v = src[(size_t)(k0 + r) * ld_src + n]; if (scale) v *= scale[k0 + r]; }
    tl[r * 65 + tx] = v;
  }
  __syncthreads();
  for (int r = ty; r < 64; r += 4) dst[(size_t)(n0 + r) * K + k0 + tx] = f2bf(tl[tx * 65 + r]);
}

__device__ __forceinline__ void phase_prep(const Params& p, int bid, int nblk, unsigned char* smem, int cxw) {
  const int tidx = opaque_tid(cxw);
  float* tl = (float*)smem;
  for (int job = 0; job < 24; ++job) {
    const float* src; int ld, nsrc, K, npad; bf16_t* dst; const float* scale = nullptr;
    if (job < 2) { src = p.ssd_in_w + (size_t)job * 1024 * 6208; ld = 6208; nsrc = 6208; K = 1024; npad = 6400; dst = p.wt_ssd_in + (size_t)job * 6400 * 1024; }
    else if (job < 4) { int s = job - 2; src = p.ssd_out_w + (size_t)s * 2048 * 1024; ld = 1024; nsrc = 1024; K = 2048; npad = 1024; dst = p.wt_ssd_out + (size_t)s * 1024 * 2048; scale = p.ssd_norm_g + s * 2048; }
    else if (job == 4) { src = p.hy_in_w; ld = 4096; nsrc = 4096; K = 1024; npad = 4096; dst = p.wt_hy_in; }
    else if (job == 5) { src = p.hy_out_w; ld = 1024; nsrc = 1024; K = 1024; npad = 1024; dst = p.wt_hy_out; }
    else if (job == 6) { src = p.lru_in_w; ld = 2048; nsrc = 2048; K = 1024; npad = 2048; dst = p.wt_lru_in; }
    else if (job == 7) { src = p.lru_out_w; ld = 1024; nsrc = 1024; K = 1024; npad = 1024; dst = p.wt_lru_out; }
    else { int q = job - 8; int dg = q >> 2, n = q & 3;
      src = p.lru_gate_w + (size_t)(dg * 4 + n) * 65536; ld = 256; nsrc = 256; K = 256; npad = 256;
      dst = p.wt_lru_gate + (size_t)n * 1024 * 256 + (size_t)dg * 256 * 256; }
    int tiles_k = K / 64, tiles = tiles_k * (npad / 64);
    for (int t = bid; t < tiles; t += nblk) transpose_tile(src, ld, nsrc, dst, K, scale, t, tiles_k, tl, cxw);
  }
  for (int i = bid * NTHR + tidx; i < 2 * 2 * 1024; i += nblk * NTHR) p.knorm[i] = 0.f;
}

__device__ __forceinline__ void phase_mod(const Params& p, int bid, int nblk, unsigned char* smem, int cxw) {
  const int tidx = opaque_tid(cxw);
  float* sc = (float*)smem;
  float* red = sc + 5 * 1024;
  __syncthreads();
  for (int i = tidx; i < 5 * 1024; i += NTHR) {
    int r = i >> 10, k = i & 1023;
    float v = (r == 0) ? p.c_ctx[k] : p.c[(r - 1) * 1024 + k];
    sc[i] = siluf(v);
  }
  __syncthreads();
  const int cj = tidx & 31, kg = tidx >> 5;
  for (int item = bid; item < 4 * 96; item += nblk) {
    const int layer = item / 96, j = (item % 96) * 32 + cj;
    const float* w = p.mod_w + (size_t)layer * 1024 * 3072 + (size_t)kg * 128 * 3072 + j;
    const float* s0 = sc + kg * 128;
    float a0 = 0, a1 = 0, a2 = 0, a3 = 0, a4 = 0;
#pragma unroll 8
    for (int k = 0; k < 128; ++k) {
      float wv = w[(size_t)k * 3072];
      a0 += s0[k] * wv; a1 += s0[1024 + k] * wv; a2 += s0[2048 + k] * wv; a3 += s0[3072 + k] * wv; a4 += s0[4096 + k] * wv;
    }
    __syncthreads();
    red[(kg * 5 + 0) * 32 + cj] = a0; red[(kg * 5 + 1) * 32 + cj] = a1; red[(kg * 5 + 2) * 32 + cj] = a2;
    red[(kg * 5 + 3) * 32 + cj] = a3; red[(kg * 5 + 4) * 32 + cj] = a4;
    __syncthreads();
    if (tidx < 160) {
      const int rr = tidx >> 5, cc = tidx & 31;
      float sum = 0.f;
#pragma unroll
      for (int g8 = 0; g8 < 8; ++g8) sum += red[(g8 * 5 + rr) * 32 + cc];
      const int jj = (item % 96) * 32 + cc;
      p.modv[((size_t)layer * 5 + rr) * 3072 + jj] = sum + p.mod_b[layer * 3072 + jj];
    }
  }
}

__device__ __forceinline__ void phase_hyfilt_a(const Params& p, int bid, int nblk, unsigned char* smem, int cxw) {
  const int tidx = opaque_tid(cxw);
  float* sz = (float*)smem;
  float* sh = sz + 4 * 36;
  int pl = tidx >> 6, m = tidx & 63;
  for (int item = bid; item < 4352 / 4; item += nblk) {
    int pos = item * 4 + pl;
    int L = pos < 256 ? 256 : 4096;
    int l = pos < 256 ? pos : pos - 256;
    __syncthreads();
    if (m < 33) {
      float t = (float)l / (float)L;
      float w = (6.283185307179586f * (float)l) / (float)L;
      float v;
      if (m == 0) v = t;
      else {
        int j = (m - 1) & 15;
        float fr = 1e-4f + (float)j * ((15.f - 1e-4f) / 15.f);
        float ang = w * fr;
        v = (m <= 16) ? __cosf(ang) : __sinf(ang);
      }
      sz[pl * 36 + m] = v;
    }
    __syncthreads();
    float a = p.hy_f_b1[m];
    for (int e = 0; e < 33; ++e) a += sz[pl * 36 + e] * p.hy_f_w1[e * 64 + m];
    a = __sinf(p.hy_f_freq[m] * a);
    sh[pl * 64 + m] = a;
    __syncthreads();
    float b = p.hy_f_b2[m];
    for (int e = 0; e < 64; ++e) b += sh[pl * 64 + e] * p.hy_f_w2[e * 64 + m];
    b = __sinf(p.hy_f_freq[64 + m] * b);
    p.hdn2[(size_t)pos * 64 + m] = b;
  }
}

__device__ __forceinline__ void phase_hyfilt_b(const Params& p, int bid, int nblk, unsigned char* smem, int cxw) {
  const int tidx = opaque_tid(cxw);
  const int lane = tidx & 63;
  for (int item = bid; item < 17 * 64; item += nblk) {
    const int lb = item >> 6, chunk = item & 63;
    const int Lsel = lb ? 1 : 0, L = Lsel ? 4096 : 256, RL = Lsel ? 8192 : 512, Lm1 = L - 1;
    const int l = Lsel ? (lb - 1) * 256 + tidx : tidx;
    const int pos = Lsel ? 256 + l : l;
    float hd[64];
#pragma unroll
    for (int m4 = 0; m4 < 16; ++m4) {
      f32x4 v = *(const f32x4*)(p.hdn2 + (size_t)pos * 64 + m4 * 4);
      hd[m4 * 4] = v.x; hd[m4 * 4 + 1] = v.y; hd[m4 * 4 + 2] = v.z; hd[m4 * 4 + 3] = v.w;
    }
    const int odc0 = chunk * 64, o = odc0 >> 11, d = (odc0 >> 10) & 1, c0 = odc0 & 1023;
    const float t = (float)l / (float)L;
    bf16_t* rt = Lsel ? p.rtab1 : p.rtab0;
    const float min_decay = -3.0701134573253945f, max_decay = -15.350567286626973f;
    for (int cc = 0; cc < 64; ++cc) {
      const int c = c0 + cc;
      const float* w3 = p.hy_f_w3 + odc0 + cc;
      float acc = 0.f;
#pragma unroll
      for (int m = 0; m < 64; ++m) acc += hd[m] * w3[(size_t)m * 4096];
      float delta = fabsf(min_decay + (float)c * ((max_decay - min_decay) / 1023.f));
      float kv = acc * expf(-t * delta);
      size_t rb = (size_t)(o * 1024 + c) * RL;
      if (d == 0) rt[rb + Lm1 - l] = f2bf(kv);
      else if (l > 0) rt[rb + Lm1 + l] = f2bf(kv);
      else rt[rb + RL - 1] = 0;
      float a = fabsf(kv);
#pragma unroll
      for (int off = 32; off > 0; off >>= 1) a += shfl_xor_f(a, off, lane);
      if (lane == 0) atomicAdd(&p.knorm[(Lsel * 2 + o) * 1024 + c], a);
    }
  }
}

__device__ __forceinline__ void phase_lnmod(const Params& p, int layer, int bid, int nblk, int cxw) {
  const int tidx = opaque_tid(cxw);
  int lane = tidx & 63, wv = tidx >> 6;
  for (int row = bid * 4 + wv; row < T_ALL; row += nblk * 4) {
    const float* src = (layer == 0) ? (row < T_CTX ? p.x_prompt + (size_t)row * DM : p.x_sample + (size_t)(row - T_CTX) * DM)
                                    : p.xres + (size_t)row * DM;
    f32x4 v[4];
#pragma unroll
    for (int j = 0; j < 4; ++j) v[j] = *(const f32x4*)(src + j * 256 + lane * 4);
    if (layer > 0) {
      float s = 0.f;
#pragma unroll
      for (int j = 0; j < 4; ++j) s += v[j].x + v[j].y + v[j].z + v[j].w;
#pragma unroll
      for (int o = 32; o > 0; o >>= 1) s += shfl_xor_f(s, o, lane);
      float mu = s * (1.f / 1024.f);
      float q = 0.f;
#pragma unroll
      for (int j = 0; j < 4; ++j) { float a = v[j].x - mu, b = v[j].y - mu, c = v[j].z - mu, d = v[j].w - mu; q += a * a + b * b + c * c + d * d; }
#pragma unroll
      for (int o = 32; o > 0; o >>= 1) q += shfl_xor_f(q, o, lane);
      float rs = rsqrtf(q * (1.f / 1024.f) + LN_EPS);
      const float* g = p.ln_g + (layer - 1) * DM; const float* b = p.ln_b + (layer - 1) * DM;
#pragma unroll
      for (int j = 0; j < 4; ++j) {
        f32x4 gg = *(const f32x4*)(g + j * 256 + lane * 4), bb = *(const f32x4*)(b + j * 256 + lane * 4);
        v[j].x = (v[j].x - mu) * rs * gg.x + bb.x; v[j].y = (v[j].y - mu) * rs * gg.y + bb.y;
        v[j].z = (v[j].z - mu) * rs * gg.z + bb.z; v[j].w = (v[j].w - mu) * rs * gg.w + bb.w;
      }
    }
    float* dst = p.xres + (size_t)row * DM;
#pragma unroll
    for (int j = 0; j < 4; ++j) *(f32x4*)(dst + j * 256 + lane * 4) = v[j];
    if (layer < 4) {
      int mrow = row < T_CTX ? 0 : 1 + ((row - T_CTX) >> 12);
      const float* mv = p.modv + ((size_t)layer * 5 + mrow) * 3072;
#pragma unroll
      for (int j = 0; j < 4; ++j) {
        f32x4 sh = *(const f32x4*)(mv + j * 256 + lane * 4), sc = *(const f32x4*)(mv + 1024 + j * 256 + lane * 4);
        u32x2 o;
        o.x = pack2(v[j].x * (1.f + sc.x) + sh.x, v[j].y * (1.f + sc.y) + sh.y);
        o.y = pack2(v[j].z * (1.f + sc.z) + sh.z, v[j].w * (1.f + sc.w) + sh.w);
        *(u32x2*)(p.hbuf + (size_t)row * DM + j * 256 + lane * 4) = o;
      }
    }
  }
}

#define PG8_LAS __attribute__((address_space(3)))
namespace pg8 {
constexpr int BM = 256, BK = 64, HALF = 128, HTB = HALF * BK * 2, STAGE_BYTES = 8 * HTB, NXCD = 8, WGM = 8;
__device__ __forceinline__ int lds_byte(int r, int c) { const int st = (r >> 4) * 2 + (c >> 5), rr = r & 15, cc = c & 31, ob = rr * 64 + cc * 2; return st * 1024 + (ob ^ (((ob >> 9) & 1) << 5)); }
__device__ __forceinline__ void stage_rc(int b, int& R, int& C) { const int st = b / 1024, sb = b % 1024, swz = sb ^ (((sb >> 9) & 1) << 5); R = (st >> 1) * 16 + swz / 64; C = (st & 1) * 32 + (swz % 64) / 2; }
__device__ __forceinline__ int perm32(int rho) { const int n = rho >> 4, i = rho & 15; return 8 * (i >> 2) + 4 * n + (i & 3); }
struct Unit { int pm, pn; };
struct Gemm { const bf16_t* A; const bf16_t* Bt; int M, N, K, lda; int a_grp_shift; int a_grp_bytes; };
struct StaticOrder {
  int nM, nN, nwg, G, c;
  __device__ void init(int M, int N, int G_, int c_) { nM = M / BM; nN = N / BM; nwg = nM * nN; G = G_; c = c_; }
  __device__ bool next(int i, Unit& u) const {
    const long L = (long)i * G + c; if (L >= nwg) return false;
    int wgid = (int)L; { const int q = nwg / NXCD, r = nwg % NXCD, xcd = wgid % NXCD, off = wgid / NXCD; wgid = (xcd < r ? xcd * (q + 1) : r * (q + 1) + (xcd - r) * q) + off; }
    const int nig = WGM * nN, gid = wgid / nig, fm = gid * WGM, gsz = (nM - fm) < WGM ? (nM - fm) : WGM;
    u.pm = fm + ((wgid % nig) % gsz); u.pn = (wgid % nig) / gsz; return true;
  }
};
__device__ __forceinline__ unsigned cvt_pk_bf16(float lo, float hi) { return pack2(lo, hi); }

template <class Epi>
__device__ __forceinline__ void gemm_phase(PG8_LAS unsigned char* lds, const Gemm g, const StaticOrder& S, const Epi& E, int wave) {
  const int tid = opaque_tid512(wave), wid = wave, lane = tid & 63, wr = wid >> 2, wc = wid & 3, fr = lane & 15, fq = lane >> 4;
  const int K = g.K, nt = K / BK, lda = g.lda;
  unsigned voffA[2], voffB[2];
#pragma unroll
  for (int i = 0; i < 2; ++i) { int R, C; stage_rc(tid * 16 + i * 8192, R, C); const int Rb = Epi::PERM ? ((R & ~31) + perm32(R & 31)) : R;
    voffA[i] = (unsigned)(R * lda + C) * 2u; voffB[i] = (unsigned)(Rb * K + C) * 2u; }
  const size_t kstep = (size_t)(BK * 2);
  const size_t hstepA = (size_t)HALF * lda * 2, hstepB = (size_t)HALF * K * 2;
  const size_t tstepA = 2 * hstepA, tstepB = 2 * hstepB;
  const unsigned ldsw = (unsigned)wid * 1024u;
  const int aoff = lds_byte(wr * 64 + fr, fq * 8), boff = lds_byte(wc * 32 + fr, fq * 8);
#define PG8_SA(b, h) (((b) * 2 + (h)) * HTB)
#define PG8_SB(b, h) ((4 + (b) * 2 + (h)) * HTB)
#define PG8_STAGE(bufoff, gbase, voff) do { _Pragma("unroll") for (int _i = 0; _i < 2; ++_i) \
    __builtin_amdgcn_global_load_lds((const unsigned*)((const char*)(gbase) + (voff)[_i]), (PG8_LAS unsigned*)(lds + (bufoff) + ldsw + _i * 8192), 16, 0, 0); } while (0)
#define PG8_LDA(dst, b, h) do { _Pragma("unroll") for (int m = 0; m < 4; ++m) _Pragma("unroll") for (int k = 0; k < 2; ++k) dst[m][k] = *(const PG8_LAS bf16x8*)(lds + PG8_SA(b, h) + aoff + m * 2048 + k * 1024); } while (0)
#define PG8_LDB(dst, b, h) do { _Pragma("unroll") for (int n = 0; n < 2; ++n) _Pragma("unroll") for (int k = 0; k < 2; ++k) dst[n][k] = *(const PG8_LAS bf16x8*)(lds + PG8_SB(b, h) + boff + n * 2048 + k * 1024); } while (0)
#define PG8_MMA(ai, bj, At, Bt) do { __builtin_amdgcn_s_setprio(1); _Pragma("unroll") for (int m = 0; m < 4; ++m) _Pragma("unroll") for (int n = 0; n < 2; ++n) _Pragma("unroll") for (int k = 0; k < 2; ++k) \
    acc[ai][bj][m][n] = __builtin_amdgcn_mfma_f32_16x16x32_bf16(Bt[n][k], At[m][k], acc[ai][bj][m][n], 0, 0, 0); __builtin_amdgcn_s_setprio(0); } while (0)
#define PG8_WAIT_V(n) asm volatile("s_waitcnt vmcnt(" #n ")" ::: "memory")
#define PG8_WAIT_L(n) asm volatile("s_waitcnt lgkmcnt(" #n ")" ::: "memory")
#define PG8_BAR __builtin_amdgcn_s_barrier()
#define PG8_SCHED __builtin_amdgcn_sched_barrier(0)
#define PG8_APTR(u) ((const char*)g.A + (size_t)(u).pm * tstepA + (size_t)(((u).pn >> g.a_grp_shift) * g.a_grp_bytes))
  Unit cur, nxt; int ui = 0;
  if (!S.next(0, cur)) return;
  f32x4 acc[2][2][4][2];
#pragma unroll
  for (int a = 0; a < 2; ++a)
#pragma unroll
    for (int b = 0; b < 2; ++b)
#pragma unroll
      for (int m = 0; m < 4; ++m)
#pragma unroll
        for (int n = 0; n < 2; ++n) acc[a][b][m][n] = (f32x4){0.f, 0.f, 0.f, 0.f};
  bf16x8 At[4][2], B0[2][2], B1[2][2];
  const char* cA = PG8_APTR(cur); const char* cB = (const char*)g.Bt + (size_t)cur.pn * tstepB;
  PG8_STAGE(PG8_SB(0, 0), cB, voffB); PG8_STAGE(PG8_SA(0, 0), cA, voffA); PG8_STAGE(PG8_SB(0, 1), cB + hstepB, voffB); PG8_STAGE(PG8_SA(0, 1), cA + hstepA, voffA);
  if (wr == 1) PG8_BAR;
  PG8_WAIT_V(4); PG8_BAR;
  PG8_STAGE(PG8_SB(1, 0), cB + kstep, voffB); PG8_STAGE(PG8_SA(1, 0), cA + kstep, voffA); PG8_STAGE(PG8_SB(1, 1), cB + hstepB + kstep, voffB);
  PG8_WAIT_V(6); PG8_BAR;
  for (;;) {
    const bool has_next = S.next(ui + 1, nxt);
    const char* nA = has_next ? PG8_APTR(nxt) : cA; const char* nB = has_next ? (const char*)g.Bt + (size_t)nxt.pn * tstepB : cB;
    for (int t = 0; t < nt; t += 2) {
      const bool last = (t == nt - 2);
      const char* a1 = cA + (size_t)(t + 1) * kstep;
      const char* a2 = last ? nA : cA + (size_t)(t + 2) * kstep; const char* b2 = last ? nB : cB + (size_t)(t + 2) * kstep;
      const char* a3 = a2 + kstep; const char* b3 = b2 + kstep;
      PG8_LDB(B0, 0, 0); PG8_SCHED; PG8_LDA(At, 0, 0); PG8_STAGE(PG8_SA(1, 1), a1 + hstepA, voffA);
      PG8_WAIT_L(8); PG8_BAR; PG8_WAIT_L(0); PG8_MMA(0, 0, At, B0); PG8_BAR; PG8_SCHED;
      PG8_LDB(B1, 0, 1); PG8_STAGE(PG8_SB(0, 0), b2, voffB);
      PG8_BAR; PG8_WAIT_L(0); PG8_MMA(0, 1, At, B1); PG8_BAR;
      PG8_LDA(At, 0, 1); PG8_STAGE(PG8_SA(0, 0), a2, voffA);
      PG8_BAR; PG8_WAIT_L(0); PG8_MMA(1, 0, At, B0); PG8_BAR; PG8_SCHED;
      PG8_STAGE(PG8_SB(0, 1), b2 + hstepB, voffB);
      PG8_WAIT_V(6); PG8_BAR; PG8_MMA(1, 1, At, B1); PG8_BAR;
      PG8_LDB(B0, 1, 0); PG8_SCHED; PG8_LDA(At, 1, 0); PG8_STAGE(PG8_SA(0, 1), a2 + hstepA, voffA);
      PG8_WAIT_L(8); PG8_BAR; PG8_WAIT_L(0); PG8_MMA(0, 0, At, B0); PG8_BAR; PG8_SCHED;
      PG8_LDB(B1, 1, 1); PG8_STAGE(PG8_SB(1, 0), b3, voffB);
      PG8_BAR; PG8_WAIT_L(0); PG8_MMA(0, 1, At, B1); PG8_BAR;
      PG8_LDA(At, 1, 1); PG8_STAGE(PG8_SA(1, 0), a3, voffA);
      PG8_BAR; PG8_WAIT_L(0); PG8_MMA(1, 0, At, B0); PG8_BAR; PG8_SCHED;
      PG8_STAGE(PG8_SB(1, 1), b3 + hstepB, voffB);
      PG8_WAIT_V(6); PG8_BAR; PG8_MMA(1, 1, At, B1); PG8_BAR;
    }
    { int fr2 = fr, fq2 = fq; asm volatile("" : "+v"(fr2), "+v"(fq2));
      E(acc, cur, wr, wc, fr2, fq2); }
    if (!has_next) break;
#pragma unroll
    for (int a = 0; a < 2; ++a)
#pragma unroll
      for (int b = 0; b < 2; ++b)
#pragma unroll
        for (int m = 0; m < 4; ++m)
#pragma unroll
          for (int n = 0; n < 2; ++n) acc[a][b][m][n] = (f32x4){0.f, 0.f, 0.f, 0.f};
    cur = nxt; cA = nA; cB = nB; ++ui;
  }
  PG8_WAIT_V(0);
  if (wr == 0) PG8_BAR;
  PG8_BAR;
#undef PG8_SA
#undef PG8_SB
#undef PG8_STAGE
#undef PG8_LDA
#undef PG8_LDB
#undef PG8_MMA
#undef PG8_WAIT_V
#undef PG8_WAIT_L
#undef PG8_BAR
#undef PG8_SCHED
#undef PG8_APTR
}

struct EpiBf16 {
  static constexpr bool PERM = true;
  bf16_t* O; size_t ldc;
  __device__ __forceinline__ void operator()(const f32x4 (&acc)[2][2][4][2], const Unit& u, int wr, int wc, int fr, int fq) const {
    const int row0 = u.pm * BM + wr * 64 + fr, col0 = u.pn * BM + wc * 32 + 8 * fq;
#pragma unroll
    for (int ai = 0; ai < 2; ++ai)
#pragma unroll
      for (int m = 0; m < 4; ++m) {
        bf16_t* rowp = O + (size_t)(row0 + ai * HALF + m * 16) * ldc + col0;
#pragma unroll
        for (int bj = 0; bj < 2; ++bj) {
          const f32x4 v0 = acc[ai][bj][m][0], v1 = acc[ai][bj][m][1];
          u32x4 w; w.x = pack2(v0[0], v0[1]); w.y = pack2(v0[2], v0[3]); w.z = pack2(v1[0], v1[1]); w.w = pack2(v1[2], v1[3]);
          *(u32x4*)(rowp + bj * HALF) = w;
        }
      }
  }
};
struct EpiSsdIn {
  static constexpr bool PERM = true;
  bf16_t* z; bf16_t* xbc; float* dt; const float* dt_bias;
  __device__ __forceinline__ void operator()(const f32x4 (&acc)[2][2][4][2], const Unit& u, int wr, int wc, int fr, int fq) const {
    const int row0 = u.pm * BM + wr * 64 + fr, colt = u.pn * BM + wc * 32 + 8 * fq;
    if (u.pn < 24) {
      bf16_t* base = u.pn < 8 ? z : xbc; const size_t ldc = u.pn < 8 ? 2048 : 4096; const int col0 = u.pn < 8 ? colt : colt - 2048;
#pragma unroll
      for (int ai = 0; ai < 2; ++ai)
#pragma unroll
        for (int m = 0; m < 4; ++m) {
          bf16_t* rowp = base + (size_t)(row0 + ai * HALF + m * 16) * ldc + col0;
#pragma unroll
          for (int bj = 0; bj < 2; ++bj) {
            const f32x4 v0 = acc[ai][bj][m][0], v1 = acc[ai][bj][m][1];
            u32x4 w; w.x = pack2(v0[0], v0[1]); w.y = pack2(v0[2], v0[3]); w.z = pack2(v1[0], v1[1]); w.w = pack2(v1[2], v1[3]);
            *(u32x4*)(rowp + bj * HALF) = w;
          }
        }
    } else {
      const int c0 = wc * 32 + 8 * fq;
      if (c0 < 64) {
#pragma unroll
        for (int ai = 0; ai < 2; ++ai)
#pragma unroll
          for (int m = 0; m < 4; ++m) {
            float* rowp = dt + (size_t)(row0 + ai * HALF + m * 16) * 64 + c0;
#pragma unroll
            for (int n = 0; n < 2; ++n) {
              const f32x4 v = acc[ai][0][m][n];
              f32x4 o;
#pragma unroll
              for (int e = 0; e < 4; ++e) o[e] = softplusf(v[e] + dt_bias[c0 + 4 * n + e]);
              *(f32x4*)(rowp + 4 * n) = o;
            }
          }
      }
    }
  }
};
struct EpiOut {
  static constexpr bool PERM = false;
  float* xres; const float* modv_layer; const float* rstd;
  __device__ __forceinline__ void operator()(const f32x4 (&acc)[2][2][4][2], const Unit& u, int wr, int wc, int fr, int fq) const {
    const int row0 = u.pm * BM + wr * 64 + fr, col0 = u.pn * BM + wc * 32 + 4 * fq;
#pragma unroll
    for (int ai = 0; ai < 2; ++ai)
#pragma unroll
      for (int m = 0; m < 4; ++m) {
        const int row = row0 + ai * HALF + m * 16;
        const int mrow = row < T_CTX ? 0 : 1 + ((row - T_CTX) >> 12);
        const float rs = rstd ? rstd[row] : 1.f;
        const float* gp = modv_layer + (size_t)mrow * 3072 + 2048 + col0;
        float* rowp = xres + (size_t)row * DM + col0;
#pragma unroll
        for (int bj = 0; bj < 2; ++bj)
#pragma unroll
          for (int n = 0; n < 2; ++n) {
            const f32x4 gv = *(const f32x4*)(gp + bj * HALF + n * 16);
            const f32x4 xv = *(const f32x4*)(rowp + bj * HALF + n * 16);
            *(f32x4*)(rowp + bj * HALF + n * 16) = ALPHA_RES * xv + gv * (acc[ai][bj][m][n] * rs);
          }
      }
  }
};
struct EpiLruGate {
  static constexpr bool PERM = true;
  bf16_t* gates; const float* gate_b;
  __device__ __forceinline__ void operator()(const f32x4 (&acc)[2][2][4][2], const Unit& u, int wr, int wc, int fr, int fq) const {
    const int nb = u.pn >> 2, dg = u.pn & 3;
    const int row0 = u.pm * BM + wr * 64 + fr, ch0 = nb * 256 + wc * 32 + 8 * fq;
#pragma unroll
    for (int ai = 0; ai < 2; ++ai)
#pragma unroll
      for (int m = 0; m < 4; ++m) {
        bf16_t* rowp = gates + ((size_t)dg * T_ALL + row0 + ai * HALF + m * 16) * 1024 + ch0;
#pragma unroll
        for (int bj = 0; bj < 2; ++bj) {
          const float* bp = gate_b + dg * 1024 + ch0 + bj * HALF;
          const f32x4 b0 = *(const f32x4*)bp, b1 = *(const f32x4*)(bp + 4);
          const f32x4 v0 = acc[ai][bj][m][0] + b0, v1 = acc[ai][bj][m][1] + b1;
          u32x4 w; w.x = pack2(sigmoidf(v0[0]), sigmoidf(v0[1])); w.y = pack2(sigmoidf(v0[2]), sigmoidf(v0[3]));
          w.z = pack2(sigmoidf(v1[0]), sigmoidf(v1[1])); w.w = pack2(sigmoidf(v1[2]), sigmoidf(v1[3]));
          *(u32x4*)(rowp + bj * HALF) = w;
        }
      }
  }
};
}

template <int KW, bool SILU>
__device__ __forceinline__ void phase_dwconv(const bf16_t* __restrict__ src, int ld_src, bf16_t* __restrict__ dst, int ld_dst, int CH,
                             const float* __restrict__ w, const float* __restrict__ b, bool colmajor, int bid, int nblk, int cxw) {
  const int tidx = opaque_tid(cxw);
  const int cpr = CH / 8;
  const size_t total = (size_t)T_ALL * cpr;
  for (size_t idx = (size_t)bid * NTHR + tidx; idx < total; idx += (size_t)nblk * NTHR) {
    int tok = (int)(idx / cpr), c0 = (int)(idx % cpr) * 8;
    TokInfo ti = tokinfo(tok);
    bool cm = colmajor && ti.s >= 32;
    int pos = seqpos2off(ti.l, cm);
    float acc[8];
#pragma unroll
    for (int e = 0; e < 8; ++e) acc[e] = b[c0 + e];
#pragma unroll
    for (int k = 0; k < KW; ++k) {
      int pp = pos + k - 1;
      if (pp < 0 || pp >= ti.L) continue;
      int tk = ti.base + seqpos2off(pp, cm);
      u32x4 xv = *(const u32x4*)(src + (size_t)tk * ld_src + c0);
      const float* wk = w + (size_t)k * CH + c0;
      acc[0] += wk[0] * bflo(xv.x); acc[1] += wk[1] * bfhi(xv.x);
      acc[2] += wk[2] * bflo(xv.y); acc[3] += wk[3] * bfhi(xv.y);
      acc[4] += wk[4] * bflo(xv.z); acc[5] += wk[5] * bfhi(xv.z);
      acc[6] += wk[6] * bflo(xv.w); acc[7] += wk[7] * bfhi(xv.w);
    }
    if (SILU) {
#pragma unroll
      for (int e = 0; e < 8; ++e) acc[e] = siluf(acc[e]);
    }
    u32x4 o;
    o.x = pack2(acc[0], acc[1]); o.y = pack2(acc[2], acc[3]); o.z = pack2(acc[4], acc[5]); o.w = pack2(acc[6], acc[7]);
    *(u32x4*)(dst + (size_t)tok * ld_dst + c0) = o;
  }
}

__device__ __forceinline__ void phase_ssd_conv(const Params& p, int slot, bool colmajor, int bid, int nblk, unsigned char* smem, int cxw) {
  const int tid = opaque_tid(cxw);
  const bf16_t* raw = (const bf16_t*)(p.scratch + SC_SSD_XBC);
  bf16_t* out = (bf16_t*)(p.scratch + SC_SSD_XBCC);
  bf16_t* XT = (bf16_t*)(p.scratch + SC_SSD_XT);
  bf16_t* BT = (bf16_t*)(p.scratch + SC_SSD_BT);
  bf16_t* BF = (bf16_t*)(p.scratch + SC_SSD_BF);
  bf16_t* CF = (bf16_t*)(p.scratch + SC_SSD_CF);
  const float* cw = p.ssd_conv_w + (size_t)slot * 4 * 4096;
  const float* cb = p.ssd_conv_b + slot * 4096;
  bf16_t* tl = (bf16_t*)smem;
  for (int item = bid; item < 384 * 64; item += nblk) {
    const int ptile = item >> 6, ct = item & 63;
    const int ptok0 = ptile * 64;
    TokInfo ti = tokinfo(ptok0);
    const bool cm = colmajor && ti.s >= 32;
    const int rr = tid >> 2, cpart = tid & 3;
    const int ch = ct * 64 + cpart * 16;
    const int pos = ti.l + rr;
    float acc[16];
#pragma unroll
    for (int e = 0; e < 16; ++e) acc[e] = cb[ch + e];
#pragma unroll
    for (int k = 0; k < 4; ++k) {
      int pp = pos + k - 1;
      if (pp < 0 || pp >= ti.L) continue;
      int tk = ti.base + seqpos2off(pp, cm);
      const bf16_t* rp = raw + (size_t)tk * 4096 + ch;
      u32x4 x0 = *(const u32x4*)rp, x1 = *(const u32x4*)(rp + 8);
      const float* wk = cw + (size_t)k * 4096 + ch;
      unsigned xw[8] = {x0.x, x0.y, x0.z, x0.w, x1.x, x1.y, x1.z, x1.w};
#pragma unroll
      for (int e = 0; e < 8; ++e) { acc[2 * e] += wk[2 * e] * bflo(xw[e]); acc[2 * e + 1] += wk[2 * e + 1] * bfhi(xw[e]); }
    }
    u32x4 o0, o1;
    o0.x = pack2(siluf(acc[0]), siluf(acc[1])); o0.y = pack2(siluf(acc[2]), siluf(acc[3]));
    o0.z = pack2(siluf(acc[4]), siluf(acc[5])); o0.w = pack2(siluf(acc[6]), siluf(acc[7]));
    o1.x = pack2(siluf(acc[8]), siluf(acc[9])); o1.y = pack2(siluf(acc[10]), siluf(acc[11]));
    o1.z = pack2(siluf(acc[12]), siluf(acc[13])); o1.w = pack2(siluf(acc[14]), siluf(acc[15]));
    __syncthreads();
    *(u32x4*)(tl + rr * 72 + cpart * 16) = o0;
    *(u32x4*)(tl + rr * 72 + cpart * 16 + 8) = o1;
    __syncthreads();
    if (ct < 32) {
      bf16_t* op = out + (size_t)(ptok0 + rr) * 2048 + ch;
      *(u32x4*)op = o0; *(u32x4*)(op + 8) = o1;
      const int crow = tid >> 2, part = tid & 3;
      unsigned wv[8];
#pragma unroll
      for (int e = 0; e < 8; ++e) {
        unsigned lo = tl[(part * 16 + 2 * e) * 72 + crow], hi = tl[(part * 16 + 2 * e + 1) * 72 + crow];
        wv[e] = lo | (hi << 16);
      }
      bf16_t* dp = XT + (size_t)(ct * 64 + crow) * T_ALL + ptok0 + part * 16;
      u32x4 t0, t1;
      t0.x = wv[0]; t0.y = wv[1]; t0.z = wv[2]; t0.w = wv[3]; t1.x = wv[4]; t1.y = wv[5]; t1.z = wv[6]; t1.w = wv[7];
      *(u32x4*)dp = t0; *(u32x4*)(dp + 8) = t1;
    } else {
      const bool isB = ct < 48;
      const int cq = (ct - (isB ? 32 : 48));
      const int g = cq >> 1, chhalf = cq & 1;
      const int lane = tid & 63, r = lane & 31, hh = lane >> 5;
      bf16_t* F = isB ? BF : CF;
#pragma unroll
      for (int i = 0; i < 2; ++i) {
        const int f = (tid >> 6) + 4 * i;
        const int rt2 = f >> 2, kk4 = f & 3;
        const u32x4 v = *(const u32x4*)(tl + (32 * rt2 + r) * 72 + 16 * kk4 + 8 * hh);
        const size_t rt = (size_t)(ptok0 >> 5) + rt2;
        *(u32x4*)(F + (((rt * 8 + g) * 8 + chhalf * 4 + kk4) * 64 + lane) * 8) = v;
      }
      if (isB) {
#pragma unroll
        for (int i = 0; i < 2; ++i) {
          const int f = (tid >> 6) + 4 * i;
          const int nt2 = f >> 2, ts4 = f & 3;
          unsigned wv[4];
#pragma unroll
          for (int e = 0; e < 4; ++e) {
            unsigned lo = tl[(16 * ts4 + 8 * hh + 2 * e) * 72 + 32 * nt2 + r], hi = tl[(16 * ts4 + 8 * hh + 2 * e + 1) * 72 + 32 * nt2 + r];
            wv[e] = lo | (hi << 16);
          }
          u32x4 v; v.x = wv[0]; v.y = wv[1]; v.z = wv[2]; v.w = wv[3];
          const size_t ts = (size_t)(ptok0 >> 4) + ts4;
          *(u32x4*)(BT + (((ts * 8 + g) * 4 + chhalf * 2 + nt2) * 64 + lane) * 8) = v;
        }
      }
    }
  }
}

#define SH_STRIDE 136
__device__ __forceinline__ int rowmap(int e, int hh) { return (e & 3) + 8 * (e >> 2) + 4 * hh; }
__device__ __forceinline__ bf16x8 pack8(float a0, float a1, float a2, float a3, float a4, float a5, float a6, float a7) {
  u32x4 v; v.x = pack2(a0, a1); v.y = pack2(a2, a3); v.z = pack2(a4, a5); v.w = pack2(a6, a7);
  return __builtin_bit_cast(bf16x8, v);
}
__device__ __forceinline__ void phase_ssd_scan(const Params& p, int slot, bool colmajor, int bid, int nblk, unsigned char* smem, int cxw) {
  const int tid = opaque_tid(cxw), lane = tid & 63, w = tid >> 6, r = lane & 31, hh = lane >> 5;
  const int it = w >> 1, pt = w & 1;
  const bf16_t* xbcc = (const bf16_t*)(p.scratch + SC_SSD_XBCC);
  const bf16_t* XT = (const bf16_t*)(p.scratch + SC_SSD_XT);
  const bf16_t* BT = (const bf16_t*)(p.scratch + SC_SSD_BT);
  const bf16_t* BF = (const bf16_t*)(p.scratch + SC_SSD_BF);
  const bf16_t* CF = (const bf16_t*)(p.scratch + SC_SSD_CF);
  const float* dtb = (const float*)(p.scratch + SC_SSD_DT);
  bf16_t* ybuf = (bf16_t*)(p.scratch + SC_SSD_XBC);
  bf16_t* sXr = (bf16_t*)smem;
  bf16_t* sXs = sXr + 64 * 72;
  bf16_t* sH = sXs + 64 * 72;
  float* sW = (float*)(sH + 2 * 64 * SH_STRIDE);
  bf16_t* sY = (bf16_t*)(sW + 4 * 256);
  float* myW = sW + w * 256;
  for (int item = bid; item < 36 * 64; item += nblk) {
    int s, h, dir;
    {
      const int itx = item < 256 ? item : item - 256;
      const int idx = itx & 63, pairidx = idx >> 1;
      s = item < 256 ? 32 + (itx >> 6) : (itx >> 6);
      dir = pairidx & 1; h = (pairidx >> 1) * 2 + (idx & 1);
    }
    const int L = s < 32 ? 256 : 4096;
    const int base = s < 32 ? s * 256 : T_CTX + (s - 32) * 4096;
    const bool cm = colmajor && s >= 32;
    const int g = h >> 2;
    const float Aval = -expf(p.ssd_a_log[(slot * 2 + dir) * 32 + h]);
    const int nchunks = L >> 6;
    const int pcol = 32 * pt + r;
    f32x16 hacc[2];
    if (s >= 32) {
      const float* h0 = p.state_ssd + ((((size_t)(s - 32) * 2 + slot) * 2 + dir) * 32 + h) * 8192 + (size_t)pcol * 128;
#pragma unroll
      for (int t2 = 0; t2 < 2; ++t2)
#pragma unroll
        for (int qd = 0; qd < 4; ++qd) {
          f32x4 v = *(const f32x4*)(h0 + 32 * (2 * it + t2) + 8 * qd + 4 * hh);
          hacc[t2][4 * qd] = v.x; hacc[t2][4 * qd + 1] = v.y; hacc[t2][4 * qd + 2] = v.z; hacc[t2][4 * qd + 3] = v.w;
        }
    } else {
#pragma unroll
      for (int t2 = 0; t2 < 2; ++t2)
#pragma unroll
        for (int e = 0; e < 16; ++e) hacc[t2][e] = 0.f;
    }
#pragma unroll
    for (int t2 = 0; t2 < 2; ++t2)
#pragma unroll
      for (int qd = 0; qd < 4; ++qd) {
        u32x2 o; o.x = pack2(hacc[t2][4 * qd], hacc[t2][4 * qd + 1]); o.y = pack2(hacc[t2][4 * qd + 2], hacc[t2][4 * qd + 3]);
        *(u32x2*)(sH + pcol * SH_STRIDE + 32 * (2 * it + t2) + 8 * qd + 4 * hh) = o;
      }
    float dtv; u32x4 xtr[2]; bf16x8 cfr[8], bfr[2][8], btf[2][4];
    const bool need0 = dir == 0 ? true : (it == 0);
    const bool need1 = dir == 0 ? (it == 1) : true;
#define SCAN_PTOK(c) (base + 64 * (dir ? nchunks - 1 - (c) : (c)))
#define SCAN_LOAD_DTX(pt0) do { \
      const int tok_ = base + seqpos2off((pt0) - base + lane, cm); \
      dtv = dtb[(size_t)tok_ * 64 + dir * 32 + h]; \
      _Pragma("unroll") for (int i_ = 0; i_ < 2; ++i_) { const int q_ = tid + i_ * 256; \
        xtr[i_] = *(const u32x4*)(XT + (size_t)(h * 64 + (q_ >> 3)) * T_ALL + (pt0) + (q_ & 7) * 8); } } while (0)
#define SCAN_LOAD_CB(pt0) do { \
      const bf16_t* cf_ = CF + ((((size_t)((pt0) >> 5) + it) * 8 + g) * 8) * 512 + lane * 8; \
      _Pragma("unroll") for (int kk = 0; kk < 8; ++kk) cfr[kk] = *(const bf16x8*)(cf_ + kk * 512); \
      if (need0) { const bf16_t* bf_ = BF + ((((size_t)((pt0) >> 5)) * 8 + g) * 8) * 512 + lane * 8; \
        _Pragma("unroll") for (int kk = 0; kk < 8; ++kk) bfr[0][kk] = *(const bf16x8*)(bf_ + kk * 512); } \
      if (need1) { const bf16_t* bf_ = BF + ((((size_t)((pt0) >> 5) + 1) * 8 + g) * 8) * 512 + lane * 8; \
        _Pragma("unroll") for (int kk = 0; kk < 8; ++kk) bfr[1][kk] = *(const bf16x8*)(bf_ + kk * 512); } } while (0)
#define SCAN_LOAD_BT(pt0) do { \
      _Pragma("unroll") for (int t2 = 0; t2 < 2; ++t2) { \
        _Pragma("unroll") for (int kk = 0; kk < 4; ++kk) \
          btf[t2][kk] = *(const bf16x8*)(BT + (((((size_t)((pt0) >> 4) + kk) * 8 + g) * 4 + 2 * it + t2) * 64 + lane) * 8); } } while (0)
    {
      const int p0 = SCAN_PTOK(0);
      SCAN_LOAD_DTX(p0); SCAN_LOAD_CB(p0); SCAN_LOAD_BT(p0);
    }
    for (int ci = 0; ci < nchunks; ++ci) {
      const int ptok0 = SCAN_PTOK(ci);
      const int cin = ci + 1 < nchunks ? ci + 1 : ci;
      const int ptokN = SCAN_PTOK(cin);
      const int buf = ci & 1;
      __syncthreads();
      if (ci > 0) {
        const int ptokP = SCAN_PTOK(ci - 1);
#pragma unroll
        for (int i = 0; i < 2; ++i) {
          const int q = tid + i * 256, yrow = q >> 3, c8 = (q & 7) * 8;
          *(u32x4*)(ybuf + ((size_t)dir * T_ALL + ptokP + yrow) * 2048 + h * 64 + c8) = *(const u32x4*)(sY + yrow * 72 + c8);
        }
      }
      float decE;
      {
        const float a_ = dtv * Aval;
        const float pre = wave_incl_scan(a_);
        const float cE = __int_as_float(__builtin_amdgcn_readlane(__float_as_int(pre), 63));
        const float c = dir == 0 ? pre : cE - pre + a_;
        myW[lane] = dtv; myW[64 + lane] = c; myW[128 + lane] = __expf(c); myW[192 + lane] = dtv * __expf(cE - c);
        decE = __expf(cE);
      }
#pragma unroll
      for (int i = 0; i < 2; ++i) {
        const int q = tid + i * 256, prow = q >> 3, j8 = (q & 7) * 8;
        const u32x4 raw = xtr[i];
        *(u32x4*)(sXr + prow * 72 + j8) = raw;
        f32x4 f0 = *(const f32x4*)(myW + 192 + j8), f1 = *(const f32x4*)(myW + 192 + j8 + 4);
        u32x4 sc;
        sc.x = pack2(bflo(raw.x) * f0.x, bfhi(raw.x) * f0.y); sc.y = pack2(bflo(raw.y) * f0.z, bfhi(raw.y) * f0.w);
        sc.z = pack2(bflo(raw.z) * f1.x, bfhi(raw.z) * f1.y); sc.w = pack2(bflo(raw.w) * f1.z, bfhi(raw.w) * f1.w);
        *(u32x4*)(sXs + prow * 72 + j8) = sc;
      }
      __syncthreads();
      SCAN_LOAD_DTX(ptokN);
#pragma unroll
      for (int t2 = 0; t2 < 2; ++t2) {
#pragma unroll
        for (int e = 0; e < 16; ++e) hacc[t2][e] *= decE;
        const bf16_t* xs = sXs + pcol * 72 + 8 * hh;
#pragma unroll
        for (int kk = 0; kk < 4; ++kk)
          hacc[t2] = __builtin_amdgcn_mfma_f32_32x32x16_bf16(btf[t2][kk], *(const bf16x8*)(xs + 16 * kk), hacc[t2], 0, 0, 0);
#pragma unroll
        for (int qd = 0; qd < 4; ++qd) {
          u32x2 o; o.x = pack2(hacc[t2][4 * qd], hacc[t2][4 * qd + 1]); o.y = pack2(hacc[t2][4 * qd + 2], hacc[t2][4 * qd + 3]);
          *(u32x2*)(sH + (buf ^ 1) * 64 * SH_STRIDE + pcol * SH_STRIDE + 32 * (2 * it + t2) + 8 * qd + 4 * hh) = o;
        }
      }
      f32x16 acc;
#pragma unroll
      for (int e = 0; e < 16; ++e) acc[e] = 0.f;
      {
        const bf16_t* hp = sH + buf * 64 * SH_STRIDE + pcol * SH_STRIDE + 8 * hh;
#pragma unroll
        for (int kk = 0; kk < 8; ++kk) acc = __builtin_amdgcn_mfma_f32_32x32x16_bf16(cfr[kk], *(const bf16x8*)(hp + 16 * kk), acc, 0, 0, 0);
      }
#pragma unroll
      for (int qd = 0; qd < 4; ++qd) {
        f32x4 ec = *(const f32x4*)(myW + 128 + 32 * it + 8 * qd + 4 * hh);
        acc[4 * qd] *= ec.x; acc[4 * qd + 1] *= ec.y; acc[4 * qd + 2] *= ec.z; acc[4 * qd + 3] *= ec.w;
      }
      const int icol = 32 * it + r;
      const float ci_ = myW[64 + icol];
#pragma unroll
      for (int jt = 0; jt < 2; ++jt) {
        const bool needed = jt == 0 ? need0 : need1;
        if (needed) {
          f32x16 X;
#pragma unroll
          for (int e = 0; e < 16; ++e) X[e] = 0.f;
#pragma unroll
          for (int kk = 0; kk < 8; ++kk) X = __builtin_amdgcn_mfma_f32_32x32x16_bf16(bfr[jt][kk], cfr[kk], X, 0, 0, 0);
#pragma unroll
          for (int qd = 0; qd < 4; ++qd) {
            const int j0 = 32 * jt + 8 * qd + 4 * hh;
            f32x4 cj = *(const f32x4*)(myW + 64 + j0), dj = *(const f32x4*)(myW + j0);
            float cjv[4] = {cj.x, cj.y, cj.z, cj.w}, djv[4] = {dj.x, dj.y, dj.z, dj.w};
#pragma unroll
            for (int u = 0; u < 4; ++u) {
              const int j = j0 + u;
              const bool ok = dir == 0 ? (j <= icol) : (j >= icol);
              const float m = __expf(ci_ - cjv[u]) * djv[u];
              X[4 * qd + u] = ok ? X[4 * qd + u] * m : 0.f;
            }
          }
#pragma unroll
          for (int sk = 0; sk < 2; ++sk) {
            bf16x8 afr = pack8(X[8 * sk], X[8 * sk + 1], X[8 * sk + 2], X[8 * sk + 3], X[8 * sk + 4], X[8 * sk + 5], X[8 * sk + 6], X[8 * sk + 7]);
            const bf16_t* xp = sXr + pcol * 72 + 32 * jt + 16 * sk + 4 * hh;
            u32x2 lo = *(const u32x2*)xp, hi = *(const u32x2*)(xp + 8);
            u32x4 xv; xv.x = lo.x; xv.y = lo.y; xv.z = hi.x; xv.w = hi.y;
            acc = __builtin_amdgcn_mfma_f32_32x32x16_bf16(afr, __builtin_bit_cast(bf16x8, xv), acc, 0, 0, 0);
          }
        }
      }
      SCAN_LOAD_CB(ptokN);
      {
        bf16_t* yo = sY + (32 * it) * 72 + pcol;
#pragma unroll
        for (int e = 0; e < 16; ++e) yo[rowmap(e, hh) * 72] = f2bf(acc[e]);
      }
      SCAN_LOAD_BT(ptokN);
    }
    __syncthreads();
    {
      const int ptokP = SCAN_PTOK(nchunks - 1);
#pragma unroll
      for (int i = 0; i < 2; ++i) {
        const int q = tid + i * 256, yrow = q >> 3, c8 = (q & 7) * 8;
        *(u32x4*)(ybuf + ((size_t)dir * T_ALL + ptokP + yrow) * 2048 + h * 64 + c8) = *(const u32x4*)(sY + yrow * 72 + c8);
      }
    }
#undef SCAN_PTOK
#undef SCAN_LOAD_DTX
#undef SCAN_LOAD_CB
#undef SCAN_LOAD_BT
    if (s < 32) {
      float* ho = p.out_ssd + ((((size_t)s * 2 + slot) * 2 + dir) * 32 + h) * 8192 + (size_t)pcol * 128;
#pragma unroll
      for (int t2 = 0; t2 < 2; ++t2)
#pragma unroll
        for (int qd = 0; qd < 4; ++qd) {
          f32x4 v; v.x = hacc[t2][4 * qd]; v.y = hacc[t2][4 * qd + 1]; v.z = hacc[t2][4 * qd + 2]; v.w = hacc[t2][4 * qd + 3];
          *(f32x4*)(ho + 32 * (2 * it + t2) + 8 * qd + 4 * hh) = v;
        }
    }
    __syncthreads();
  }
}

__device__ __forceinline__ void phase_ssd_gate(const Params& p, int slot, int bid, int nblk, int cxw) {
  const int tidx = opaque_tid(cxw);
  bf16_t* zb = (bf16_t*)(p.scratch + SC_SSD_Z);
  const bf16_t* yfb = (const bf16_t*)(p.scratch + SC_SSD_XBC);
  const bf16_t* ybb = yfb + (size_t)T_ALL * 2048;
  const bf16_t* xbcc = (const bf16_t*)(p.scratch + SC_SSD_XBCC);
  int lane = tidx & 63, wv = tidx >> 6;
  for (int row = bid * 4 + wv; row < T_ALL; row += nblk * 4) {
    float ss = 0.f;
    TokInfo ti = tokinfo(row);
    const int prow = ti.base + seqpos2off(ti.l, slot == 1 && ti.s >= 32);
#pragma unroll
    for (int j = 0; j < 4; ++j) {
      int c0 = j * 512 + lane * 8;
      u32x4 zv = *(const u32x4*)(zb + (size_t)row * 2048 + c0);
      u32x4 fv = *(const u32x4*)(yfb + (size_t)prow * 2048 + c0);
      u32x4 bv = *(const u32x4*)(ybb + (size_t)prow * 2048 + c0);
      u32x4 xv = *(const u32x4*)(xbcc + (size_t)prow * 2048 + c0);
      float dsk = p.ssd_d[slot * 32 + (c0 >> 6)];
      unsigned zw[4] = {zv.x, zv.y, zv.z, zv.w}, fw[4] = {fv.x, fv.y, fv.z, fv.w}, bw[4] = {bv.x, bv.y, bv.z, bv.w}, xw[4] = {xv.x, xv.y, xv.z, xv.w};
      unsigned ow[4];
#pragma unroll
      for (int e = 0; e < 4; ++e) {
        float y0 = (bflo(fw[e]) + bflo(bw[e]) + dsk * bflo(xw[e])) * siluf(bflo(zw[e]));
        float y1 = (bfhi(fw[e]) + bfhi(bw[e]) + dsk * bfhi(xw[e])) * siluf(bfhi(zw[e]));
        ss += y0 * y0 + y1 * y1;
        ow[e] = pack2(y0, y1);
      }
      u32x4 o; o.x = ow[0]; o.y = ow[1]; o.z = ow[2]; o.w = ow[3];
      *(u32x4*)(zb + (size_t)row * 2048 + c0) = o;
    }
#pragma unroll
    for (int o = 32; o > 0; o >>= 1) ss += shfl_xor_f(ss, o, lane);
    if (lane == 0) p.rstd[row] = rsqrtf(ss * (1.f / 2048.f) + 1e-5f);
  }
}

#define HY_UOFF 32768
__device__ __forceinline__ void hy_stage_conv(const Params& p, const bf16_t* __restrict__ row, int ch, bf16_t* dst, int dstStride, int dstPad,
                                              int nelem, int L, int tid) {
  const float w0 = p.hy_conv_w[ch], w1 = p.hy_conv_w[3072 + ch], w2 = p.hy_conv_w[2 * 3072 + ch], bb = p.hy_conv_b[ch];
  for (int q = tid; q < nelem / 8; q += NTHR) {
    const int e0 = q * 8, b = e0 / L, t0 = e0 & (L - 1);
    u32x4 raw = *(const u32x4*)(row + e0);
    float x[10];
    x[0] = t0 > 0 ? bf2f(row[e0 - 1]) : 0.f;
    x[9] = t0 + 8 < L ? bf2f(row[e0 + 8]) : 0.f;
    x[1] = bflo(raw.x); x[2] = bfhi(raw.x); x[3] = bflo(raw.y); x[4] = bfhi(raw.y);
    x[5] = bflo(raw.z); x[6] = bfhi(raw.z); x[7] = bflo(raw.w); x[8] = bfhi(raw.w);
    float o[8];
#pragma unroll
    for (int j = 0; j < 8; ++j) o[j] = w0 * x[j] + w1 * x[j + 1] + w2 * x[j + 2] + bb;
    u32x4 ov; ov.x = pack2(o[0], o[1]); ov.y = pack2(o[2], o[3]); ov.z = pack2(o[4], o[5]); ov.w = pack2(o[6], o[7]);
    *(u32x4*)(dst + b * dstStride + dstPad + t0) = ov;
  }
}

__device__ __forceinline__ void phase_hy_longconv(const Params& p, int bid, int nblk, unsigned char* smem, int cxw) {
  const int tid = opaque_tid(cxw), lane = tid & 63, w = tid >> 6, r = lane & 31, hh = lane >> 5;
  const bf16_t* projT = (const bf16_t*)(p.scratch + SC_HY_PROJT);
  bf16_t* yT = (bf16_t*)(p.scratch + SC_HY_YT);
  unsigned* Rc0 = (unsigned*)smem;
  unsigned* Rc1 = Rc0 + 4096;
  bf16_t* G = (bf16_t*)smem;
  bf16_t* U = (bf16_t*)(smem + HY_UOFF);
  for (int item = bid; item < 2048; item += nblk) {
    const bool lat = item < 1024;
    const int c = item & 1023;
    const int L = lat ? 4096 : 256, NB = lat ? 4 : 32, RL = lat ? 8192 : 512, Lm1 = L - 1;
    const int PAD = lat ? 224 : 0, US = L + 2 * PAD;
    const int tokbase = lat ? T_CTX : 0;
    const int nI = L >> 5, nelem = NB * L;
    const int TPW = lat ? 4 : 2;
    __syncthreads();
    if (lat) {
      for (int q = tid; q < 4 * 56; q += NTHR) {
        int b = q / 56, k = q % 56;
        int off = k < 28 ? k * 8 : 224 + 4096 + (k - 28) * 8;
        unsigned zz = 0u; asm volatile("" : "+v"(zz));
        u32x4 z4 = {zz, zz, zz, zz};
        *(u32x4*)(U + b * US + off) = z4;
      }
    }
    hy_stage_conv(p, projT + (size_t)c * T_ALL + tokbase, c, U, US, PAD, nelem, L, tid);
    int Icol[4], bcol[4];
#pragma unroll
    for (int tt = 0; tt < 4; ++tt) {
      int n = (w * TPW + tt) * 32 + r;
      Icol[tt] = lat ? (n >> 2) : (n >> 5);
      bcol[tt] = lat ? (n & 3) : (n & 31);
    }
    const int Ilo_w = lat ? 32 * w : 2 * w, Ihi_w = lat ? 32 * w + 31 : 2 * w + 1;
    const int dlo = Ilo_w - (nI - 1), dhi = Ihi_w;
    for (int order = 0; order < 2; ++order) {
      {
        const bf16_t* src = (lat ? p.rtab1 : p.rtab0) + (size_t)(order * 1024 + c) * RL;
        for (int q = tid; q < RL / 8; q += NTHR) {
          u32x4 cv = *(const u32x4*)(src + q * 8);
          unsigned nx = (q + 1 < RL / 8) ? *(const unsigned*)(src + q * 8 + 8) : 0u;
          *(u32x4*)(Rc0 + q * 4) = cv;
          u32x4 sv;
          sv.x = (cv.x >> 16) | (cv.y << 16); sv.y = (cv.y >> 16) | (cv.z << 16);
          sv.z = (cv.z >> 16) | (cv.w << 16); sv.w = (cv.w >> 16) | (nx << 16);
          *(u32x4*)(Rc1 + q * 4) = sv;
        }
      }
      __syncthreads();
      f32x16 acc[4];
#pragma unroll
      for (int tt = 0; tt < 4; ++tt)
#pragma unroll
        for (int e = 0; e < 16; ++e) acc[tt][e] = 0.f;
      for (int d = dlo; d <= dhi; ++d) {
#pragma unroll
        for (int kk = 0; kk < 2; ++kk) {
          const int y0 = Lm1 - 32 * d - r + 16 * kk + 8 * hh;
          const int par = y0 & 1;
          const unsigned* rp = (par ? Rc1 : Rc0) + ((y0 - par) >> 1);
          u32x4 av; av.x = rp[0]; av.y = rp[1]; av.z = rp[2]; av.w = rp[3];
          bf16x8 af = __builtin_bit_cast(bf16x8, av);
#pragma unroll
          for (int tt = 0; tt < 4; ++tt) {
            if (tt < TPW) {
              const int tile = w * TPW + tt;
              const int Ilo_t = lat ? 8 * tile : tile, Ihi_t = lat ? 8 * tile + 7 : tile;
              if (d >= Ilo_t - (nI - 1) && d <= Ihi_t) {
                const bf16_t* bp = U + bcol[tt] * US + PAD + 32 * (Icol[tt] - d) + 16 * kk + 8 * hh;
                bf16x8 bfr = *(const bf16x8*)bp;
                acc[tt] = __builtin_amdgcn_mfma_f32_32x32x16_bf16(af, bfr, acc[tt], 0, 0, 0);
              }
            }
          }
        }
      }
      __syncthreads();
      hy_stage_conv(p, projT + (size_t)((1 + order) * 1024 + c) * T_ALL + tokbase, (1 + order) * 1024 + c, G, L, 0, nelem, L, tid);
      __syncthreads();
      const float inv = 1.f / p.knorm[((lat ? 1 : 0) * 2 + order) * 1024 + c];
      const float bias = p.hy_f_bias[order * 1024 + c];
#pragma unroll
      for (int tt = 0; tt < 4; ++tt) {
        if (tt < TPW) {
#pragma unroll
          for (int qd = 0; qd < 4; ++qd) {
            const int t0 = 32 * Icol[tt] + 8 * qd + 4 * hh;
            bf16_t* up = U + bcol[tt] * US + PAD + t0;
            u32x2 uc = *(const u32x2*)up;
            u32x2 gg = *(const u32x2*)(G + bcol[tt] * L + t0);
            float r0 = (inv * acc[tt][4 * qd] + bias * bflo(uc.x)) * bflo(gg.x);
            float r1 = (inv * acc[tt][4 * qd + 1] + bias * bfhi(uc.x)) * bfhi(gg.x);
            float r2 = (inv * acc[tt][4 * qd + 2] + bias * bflo(uc.y)) * bflo(gg.y);
            float r3 = (inv * acc[tt][4 * qd + 3] + bias * bfhi(uc.y)) * bfhi(gg.y);
            if (order == 1) {
              u32x2 zz = *(const u32x2*)(projT + (size_t)(3072 + c) * T_ALL + tokbase + bcol[tt] * L + t0);
              r0 *= siluf(bflo(zz.x)); r1 *= siluf(bfhi(zz.x)); r2 *= siluf(bflo(zz.y)); r3 *= siluf(bfhi(zz.y));
            }
            u32x2 ov; ov.x = pack2(r0, r1); ov.y = pack2(r2, r3);
            *(u32x2*)up = ov;
          }
        }
      }
      __syncthreads();
    }
    for (int q = tid; q < nelem / 8; q += NTHR) {
      const int e0 = q * 8, b = e0 / L, t0 = e0 & (L - 1);
      *(u32x4*)(yT + (size_t)c * T_ALL + tokbase + e0) = *(const u32x4*)(U + b * US + PAD + t0);
    }
  }
}

__device__ __forceinline__ void phase_hy_transpose(const Params& p, int bid, int nblk, unsigned char* smem, int cxw) {
  const int tid = opaque_tid(cxw);
  const bf16_t* yT = (const bf16_t*)(p.scratch + SC_HY_YT);
  bf16_t* yg = (bf16_t*)(p.scratch + SC_HY_YG);
  bf16_t* tl = (bf16_t*)smem;
  for (int item = bid; item < 16 * (T_ALL / 64); item += nblk) {
    const int cb = item & 15, tb = item >> 4;
    __syncthreads();
#pragma unroll
    for (int i = 0; i < 2; ++i) {
      int q = tid + i * 256, cr = q >> 3, t8 = (q & 7) * 8;
      u32x4 v = *(const u32x4*)(yT + (size_t)(cb * 64 + cr) * T_ALL + tb * 64 + t8);
      unsigned wv[4] = {v.x, v.y, v.z, v.w};
#pragma unroll
      for (int e = 0; e < 4; ++e) {
        tl[(t8 + 2 * e) * 72 + cr] = (bf16_t)(wv[e] & 0xffffu);
        tl[(t8 + 2 * e + 1) * 72 + cr] = (bf16_t)(wv[e] >> 16);
      }
    }
    __syncthreads();
#pragma unroll
    for (int i = 0; i < 2; ++i) {
      int q = tid + i * 256, tr = q >> 3, c8 = (q & 7) * 8;
      *(u32x4*)(yg + (size_t)(tb * 64 + tr) * 1024 + cb * 64 + c8) = *(const u32x4*)(tl + tr * 72 + c8);
    }
  }
}

#define LRU_NCH 384
struct LruStep { float af, bxf, ab, bxb; };
__device__ __forceinline__ LruStep lru_step(const bf16_t* gates, const bf16_t* xc, int tok, int c, float spf, float spb) {
  const size_t o = (size_t)tok * 1024 + c;
  const float rf = bf2f(gates[o]), if_ = bf2f(gates[(size_t)T_ALL * 1024 + o]);
  const float rb = bf2f(gates[(size_t)2 * T_ALL * 1024 + o]), ib = bf2f(gates[(size_t)3 * T_ALL * 1024 + o]);
  const float x = bf2f(xc[o]);
  LruStep st;
  const float laf = -8.f * rf * spf, lab = -8.f * rb * spb;
  st.af = __expf(laf); st.ab = __expf(lab);
  st.bxf = sqrtf(fmaxf(1.f - __expf(2.f * laf), 0.f)) * if_ * x;
  st.bxb = sqrtf(fmaxf(1.f - __expf(2.f * lab), 0.f)) * ib * x;
  return st;
}
__device__ __forceinline__ void phase_lru_scan_agg(const Params& p, int bid, int nblk, int cxw) {
  const int tidx = opaque_tid(cxw);
  const bf16_t* gates = (const bf16_t*)(p.scratch + SC_LRU_GATES);
  const bf16_t* xc = (const bf16_t*)(p.scratch + SC_LRU_XC);
  for (int item = bid; item < LRU_NCH * 4; item += nblk) {
    const int chunk = item >> 2, cb = item & 3;
    const int c = cb * 256 + tidx;
    const float spf = softplusf(-p.lru_a_param[c]), spb = softplusf(-p.lru_a_param[1024 + c]);
    const int tok0 = chunk * 64;
    float Af = 1.f, hf = 0.f, Pb = 1.f, Bb = 0.f;
#pragma unroll 8
    for (int j = 0; j < 64; ++j) {
      const LruStep st = lru_step(gates, xc, tok0 + j, c, spf, spb);
      hf = st.af * hf + st.bxf; Af *= st.af;
      Bb += st.bxb * Pb; Pb *= st.ab;
    }
    float* agf = p.lru_agg + (((size_t)0 * LRU_NCH + chunk) * 1024 + c) * 2;
    float* agb = p.lru_agg + (((size_t)1 * LRU_NCH + chunk) * 1024 + c) * 2;
    agf[0] = Af; agf[1] = hf; agb[0] = Pb; agb[1] = Bb;
  }
}
__device__ __forceinline__ void phase_lru_scan_carry(const Params& p, int bid, int nblk, int cxw) {
  const int tidx = opaque_tid(cxw);
  for (int item = bid; item < 36 * 8; item += nblk) {
    int s = item >> 3, dir = (item >> 2) & 1, cb = item & 3;
    int c = cb * 256 + tidx;
    int nch = s < 32 ? 4 : 64;
    int ch0 = s < 32 ? s * 4 : 128 + (s - 32) * 64;
    float h = s < 32 ? 0.f : p.state_lru[((size_t)(s - 32) * 2 + dir) * 1024 + c];
    for (int k = 0; k < nch; ++k) {
      int chunk = dir ? ch0 + nch - 1 - k : ch0 + k;
      size_t idx = ((size_t)dir * LRU_NCH + chunk) * 1024 + c;
      p.lru_hin[idx] = h;
      h = p.lru_agg[idx * 2] * h + p.lru_agg[idx * 2 + 1];
    }
    if (s < 32) p.out_lru[((size_t)s * 2 + dir) * 1024 + c] = h;
  }
}
__device__ __forceinline__ void phase_lru_scan_final(const Params& p, int bid, int nblk, unsigned char* smem, int cxw) {
  const int tidx = opaque_tid(cxw);
  const bf16_t* gates = (const bf16_t*)(p.scratch + SC_LRU_GATES);
  const bf16_t* xc = (const bf16_t*)(p.scratch + SC_LRU_XC);
  const bf16_t* proj = (const bf16_t*)(p.scratch + SC_LRU_PROJ);
  bf16_t* yg = (bf16_t*)(p.scratch + SC_LRU_YG);
  float* shf = (float*)smem;
  for (int item = bid; item < LRU_NCH * 4; item += nblk) {
    const int chunk = item >> 2, cb = item & 3;
    const int c = cb * 256 + tidx;
    const float spf = softplusf(-p.lru_a_param[c]), spb = softplusf(-p.lru_a_param[1024 + c]);
    const int tok0 = chunk * 64;
    float hf = p.lru_hin[((size_t)0 * LRU_NCH + chunk) * 1024 + c];
    float hb = p.lru_hin[((size_t)1 * LRU_NCH + chunk) * 1024 + c];
#pragma unroll 8
    for (int j = 0; j < 64; ++j) {
      const size_t o = (size_t)(tok0 + j) * 1024 + c;
      const float rf = bf2f(gates[o]), if_ = bf2f(gates[(size_t)T_ALL * 1024 + o]);
      const float x = bf2f(xc[o]);
      const float laf = -8.f * rf * spf;
      hf = __expf(laf) * hf + sqrtf(fmaxf(1.f - __expf(2.f * laf), 0.f)) * if_ * x;
      shf[j * 256 + tidx] = hf;
    }
#pragma unroll 8
    for (int j = 63; j >= 0; --j) {
      const size_t o = (size_t)(tok0 + j) * 1024 + c;
      const float rb = bf2f(gates[(size_t)2 * T_ALL * 1024 + o]), ib = bf2f(gates[(size_t)3 * T_ALL * 1024 + o]);
      const float x = bf2f(xc[o]);
      const float z = bf2f(proj[(size_t)(tok0 + j) * 2048 + 1024 + c]);
      const float lab = -8.f * rb * spb;
      hb = __expf(lab) * hb + sqrtf(fmaxf(1.f - __expf(2.f * lab), 0.f)) * ib * x;
      yg[o] = f2bf((shf[j * 256 + tidx] + hb) * siluf(z));
    }
  }
}

enum { PH_PREP = 0, PH_MOD, PH_HYA, PH_HYB, PH_LNMOD, PH_INPROJ, PH_MIX1, PH_MIX2, PH_MIX3, PH_MIX4, PH_MIX5, PH_MIX6, PH_OUTPROJ };

struct Ctx { int bid, nblk, wave; unsigned char* smem; unsigned char* wg_smem; };

template <class Epi>
__device__ __forceinline__ void run_gemm(const Ctx& cx, const bf16_t* A, int lda, const bf16_t* Bt, int M, int N, int K, int grp_shift, int grp_bytes, const Epi& e) {
  pg8::Gemm g{A, Bt, M, N, K, lda, grp_shift, grp_bytes};
  pg8::StaticOrder S; S.init(M, N, gridDim.x, opaque_s(blockIdx.x));
  pg8::gemm_phase((PG8_LAS unsigned char*)cx.wg_smem, g, S, e, cx.wave);
}

#define N_PARAM_WORDS (sizeof(Params) / 8)
__device__ __forceinline__ Params load_params(const unsigned char* lp) {
  Params p;
  unsigned long long* d = (unsigned long long*)&p;
  const unsigned long long* sp = (const unsigned long long*)lp;
#pragma unroll
  for (int i = 0; i < (int)N_PARAM_WORDS; ++i) {
    const unsigned long long v = sp[i];
    const unsigned lo = __builtin_amdgcn_readfirstlane((unsigned)v), hi = __builtin_amdgcn_readfirstlane((unsigned)(v >> 32));
    d[i] = ((unsigned long long)hi << 32) | lo;
  }
  return p;
}
__device__ __forceinline__ void run_phase(const unsigned char* lparams, int ph, int layer, const Ctx& cx) {
  const Params p = load_params(lparams);
  const int kind = layer % 3, slot = layer / 3;
  const int bid = opaque_s(cx.bid), nblk = cx.nblk;
  unsigned char* smem = cx.smem;
  switch (ph) {
    case PH_PREP: phase_prep(p, bid, nblk, smem, cx.wave); break;
    case PH_MOD: phase_mod(p, bid, nblk, smem, cx.wave); break;
    case PH_HYA: phase_hyfilt_a(p, bid, nblk, smem, cx.wave); break;
    case PH_HYB: phase_hyfilt_b(p, bid, nblk, smem, cx.wave); break;
    case PH_LNMOD: phase_lnmod(p, layer, bid, nblk, cx.wave); break;
    case PH_INPROJ:
      if (kind == 0) {
        pg8::EpiSsdIn e{(bf16_t*)(p.scratch + SC_SSD_Z), (bf16_t*)(p.scratch + SC_SSD_XBC), (float*)(p.scratch + SC_SSD_DT), p.ssd_dt_bias + slot * 64};
        run_gemm(cx, p.hbuf, 1024, p.wt_ssd_in + (size_t)slot * 6400 * 1024, T_ALL, 6400, 1024, 30, 0, e);
      } else if (kind == 1) {
        pg8::EpiBf16 e{(bf16_t*)(p.scratch + SC_HY_PROJT), (size_t)T_ALL};
        run_gemm(cx, p.wt_hy_in, 1024, p.hbuf, 4096, T_ALL, 1024, 30, 0, e);
      } else {
        pg8::EpiBf16 e{(bf16_t*)(p.scratch + SC_LRU_PROJ), (size_t)2048};
        run_gemm(cx, p.hbuf, 1024, p.wt_lru_in, T_ALL, 2048, 1024, 30, 0, e);
      }
      break;
    case PH_MIX1:
      if (kind == 0) phase_ssd_conv(p, slot, slot == 1, bid, nblk, smem, cx.wave);
      else if (kind == 1) phase_hy_longconv(p, bid, nblk, smem, cx.wave);
      else phase_dwconv<4, false>((const bf16_t*)(p.scratch + SC_LRU_PROJ), 2048, (bf16_t*)(p.scratch + SC_LRU_XC), 1024, 1024,
                                  p.lru_conv_w, p.lru_conv_b, false, bid, nblk, cx.wave);
      break;
    case PH_MIX2:
      if (kind == 0) phase_ssd_scan(p, slot, slot == 1, bid, nblk, smem, cx.wave);
      else if (kind == 1) phase_hy_transpose(p, bid, nblk, smem, cx.wave);
      else {
        pg8::EpiLruGate e{(bf16_t*)(p.scratch + SC_LRU_GATES), p.lru_gate_b};
        run_gemm(cx, (const bf16_t*)(p.scratch + SC_LRU_XC), 1024, p.wt_lru_gate, T_ALL, 4096, 256, 2, 512, e);
      }
      break;
    case PH_MIX3:
      if (kind == 0) phase_ssd_gate(p, slot, bid, nblk, cx.wave);
      else phase_lru_scan_agg(p, bid, nblk, cx.wave);
      break;
    case PH_MIX4: if (kind == 2) phase_lru_scan_carry(p, bid, nblk, cx.wave); break;
    case PH_MIX5: if (kind == 2) phase_lru_scan_final(p, bid, nblk, smem, cx.wave); break;
    case PH_OUTPROJ: {
      const float* mv = p.modv + (size_t)layer * 5 * 3072;
      if (kind == 0) {
        pg8::EpiOut e{p.xres, mv, p.rstd};
        run_gemm(cx, (const bf16_t*)(p.scratch + SC_SSD_Z), 2048, p.wt_ssd_out + (size_t)slot * 1024 * 2048, T_ALL, 1024, 2048, 30, 0, e);
      } else if (kind == 1) {
        pg8::EpiOut e{p.xres, mv, nullptr};
        run_gemm(cx, (const bf16_t*)(p.scratch + SC_HY_YG), 1024, p.wt_hy_out, T_ALL, 1024, 1024, 30, 0, e);
      } else {
        pg8::EpiOut e{p.xres, mv, nullptr};
        run_gemm(cx, (const bf16_t*)(p.scratch + SC_LRU_YG), 1024, p.wt_lru_out, T_ALL, 1024, 1024, 30, 0, e);
      }
    } break;
  }
}

__global__ void __launch_bounds__(WG_THREADS, 2) k_mega(Params p) {
  __shared__ __attribute__((aligned(16))) unsigned char smem[WG_SMEM + 16 + 512];
  cg::grid_group grid = cg::this_grid();
  const int wave0 = __builtin_amdgcn_readfirstlane((int)(threadIdx.x >> 6));
  const int vb = wave0 >> 2;
  Ctx cx;
  cx.wave = wave0;
  cx.bid = 2 * blockIdx.x + vb; cx.nblk = 2 * gridDim.x; cx.smem = smem + vb * SMEM_BYTES; cx.wg_smem = smem;
  volatile LAS unsigned* xst = (volatile LAS unsigned*)(smem + WG_SMEM);
  unsigned char* lparams = smem + WG_SMEM + 16;
  if (threadIdx.x == 0) { xst[0] = 0u; xst[1] = 0u; *(Params*)lparams = p; }
  __syncthreads();
  const XcdBarrier xb = xcd_barrier_post(p.bar, xst);
  run_phase(lparams, PH_PREP, 0, cx);
  run_phase(lparams, PH_MOD, 0, cx);
  run_phase(lparams, PH_HYA, 0, cx);
  grid.sync();
  run_phase(lparams, PH_HYB, 0, cx);
  for (int layer = 0; layer < 4; ++layer) {
    const int kind = layer % 3;
    run_phase(lparams, PH_LNMOD, layer, cx);
    xcd_barrier(xb, cx.wave);
    run_phase(lparams, PH_INPROJ, layer, cx);
    xcd_barrier(xb, cx.wave);
    run_phase(lparams, PH_MIX1, layer, cx);
    xcd_barrier(xb, cx.wave);
    run_phase(lparams, PH_MIX2, layer, cx);
    xcd_barrier(xb, cx.wave);
    if (kind != 1) {
      run_phase(lparams, PH_MIX3, layer, cx);
      xcd_barrier(xb, cx.wave);
    }
    if (kind == 2) {
      run_phase(lparams, PH_MIX4, layer, cx);
      xcd_barrier(xb, cx.wave);
      run_phase(lparams, PH_MIX5, layer, cx);
      xcd_barrier(xb, cx.wave);
    }
    run_phase(lparams, PH_OUTPROJ, layer, cx);
    xcd_barrier(xb, cx.wave);
  }
  run_phase(lparams, PH_LNMOD, 4, cx);
}

static inline size_t align_up(size_t x) { return (x + 255) & ~(size_t)255; }

extern "C" void kernel_launch(void* const* d_in, const int* in_sizes, int n_in, void* d_out, int out_size, void* d_ws, size_t ws_size,
                              hipStream_t stream) {
  Params p{};
  const float** fp = (const float**)&p;
  for (int i = 0; i < 36; ++i) fp[i] = (const float*)d_in[i];
  float* out = (float*)d_out;
  p.xres = out;
  p.out_ssd = out + (size_t)T_ALL * 1024;
  p.out_lru = p.out_ssd + (size_t)32 * 2 * 2 * 32 * 64 * 128;
  unsigned char* w = (unsigned char*)d_ws;
  size_t off = 0;
  auto carve = [&](size_t bytes) { unsigned char* r = w + off; off = align_up(off + bytes); return r; };
  p.wt_ssd_in = (bf16_t*)carve((size_t)2 * 6400 * 1024 * 2);
  p.wt_ssd_out = (bf16_t*)carve((size_t)2 * 1024 * 2048 * 2);
  p.wt_hy_in = (bf16_t*)carve((size_t)4096 * 1024 * 2);
  p.wt_hy_out = (bf16_t*)carve((size_t)1024 * 1024 * 2);
  p.wt_lru_in = (bf16_t*)carve((size_t)2048 * 1024 * 2);
  p.wt_lru_out = (bf16_t*)carve((size_t)1024 * 1024 * 2);
  p.wt_lru_gate = (bf16_t*)carve((size_t)4 * 1024 * 256 * 2);
  p.modv = (float*)carve((size_t)4 * 5 * 3072 * 4);
  p.hdn2 = (float*)carve((size_t)4352 * 64 * 4);
  p.rtab0 = (bf16_t*)carve((size_t)2 * 1024 * 512 * 2);
  p.rtab1 = (bf16_t*)carve((size_t)2 * 1024 * 8192 * 2);
  p.knorm = (float*)carve((size_t)4 * 1024 * 4);
  p.hbuf = (bf16_t*)carve((size_t)T_ALL * 1024 * 2);
  p.rstd = (float*)carve((size_t)T_ALL * 4);
  p.lru_agg = (float*)carve((size_t)2 * 384 * 1024 * 2 * 4);
  p.lru_hin = (float*)carve((size_t)2 * 384 * 1024 * 4);
  p.bar = (unsigned*)carve((size_t)XCD_BAR_WORDS * 4);
  p.scratch = carve(SC_TOTAL);
  if (off > ws_size) return;

  static int grid_blocks = 0;
  if (!grid_blocks) {
    int dev = 0, cus = 0, per_cu = 0;
    hipGetDevice(&dev);
    hipDeviceGetAttribute(&cus, hipDeviceAttributeMultiprocessorCount, dev);
    hipOccupancyMaxActiveBlocksPerMultiprocessor(&per_cu, k_mega, WG_THREADS, 0);
    if (per_cu > 1) per_cu = 1;
    grid_blocks = cus * per_cu;
  }
  hipMemsetAsync(p.bar, 0, (size_t)XCD_BAR_WORDS * 4, stream);
  void* args[] = {&p};
  hipError_t e = hipLaunchCooperativeKernel((void*)k_mega, dim3(grid_blocks), dim3(WG_THREADS), args, 0, stream);
  if (e != hipSuccess) fprintf(stderr, "cooperative launch failed: %s (grid %d)\n", hipGetErrorString(e), grid_blocks);
}
```

```cpp
#include <hip/hip_runtime.h>
#include <hip/hip_bf16.h>
#include <hip/hip_cooperative_groups.h>
#include <stdint.h>
#include <cstdio>
namespace cg = cooperative_groups;

typedef unsigned short bf16_t;
typedef __attribute__((ext_vector_type(8))) short bf16x8;
typedef __attribute__((ext_vector_type(16))) float f32x16;
typedef __attribute__((ext_vector_type(4))) unsigned int u32x4;
typedef __attribute__((ext_vector_type(2))) unsigned int u32x2;
typedef __attribute__((ext_vector_type(4))) float f32x4;
typedef float f32x4_t __attribute__((ext_vector_type(4)));

#define T_CTX 8192
#define T_ALL 24576
#define DM 1024
#define NTHR 256
#define SMEM_BYTES 69632
#define WG_THREADS 512
#define WG_SMEM (2 * SMEM_BYTES)
#define ALPHA_RES 1.6817928305074290f
#define LN_EPS 1e-5f

__device__ __forceinline__ bf16_t f2bf(float f) { __bf16 h = (__bf16)f; return __builtin_bit_cast(bf16_t, h); }
__device__ __forceinline__ float bf2f(bf16_t b) { return __uint_as_float(((unsigned)b) << 16); }
__device__ __forceinline__ float bflo(unsigned w) { return __uint_as_float(w << 16); }
__device__ __forceinline__ float bfhi(unsigned w) { return __uint_as_float(w & 0xffff0000u); }
typedef __bf16 bf16v2_t __attribute__((ext_vector_type(2)));
typedef float f32v2_t __attribute__((ext_vector_type(2)));
__device__ __forceinline__ unsigned pack2(float a, float b) { f32v2_t v = {a, b}; bf16v2_t h = __builtin_convertvector(v, bf16v2_t); return __builtin_bit_cast(unsigned, h); }
__device__ __forceinline__ float siluf(float x) { return x / (1.f + __expf(-x)); }
__device__ __forceinline__ float sigmoidf(float x) { return 1.f / (1.f + __expf(-x)); }
__device__ __forceinline__ float softplusf(float x) { return x > 20.f ? x : __logf(1.f + __expf(x)); }


__device__ __forceinline__ int opaque_lane() { int z = 0; asm volatile("" : "+v"(z)); return __builtin_amdgcn_mbcnt_hi(~0u, __builtin_amdgcn_mbcnt_lo(~0u, (unsigned)z)); }
__device__ __forceinline__ int opaque_tid512(int wave) { return (wave << 6) + opaque_lane(); }
__device__ __forceinline__ int opaque_tid(int wave) { return opaque_tid512(wave) & 255; }

#define XB_TMO      128
#define XB_XCNT(j)  (256  + 64 * (j))
#define XB_XSUB(j)  (1280 + 64 * (j))
#define XB_XGEN(j)  (2304 + 64 * (j))
#define XB_TOP      3328
#define XB_TOPGEN   3392
#define XCD_BAR_WORDS 3456
#define XB_SPIN_CAP (1u << 18)
#define LAS __attribute__((address_space(3)))
__device__ __forceinline__ unsigned xb_ld(unsigned* p)              { return __hip_atomic_load(p, __ATOMIC_RELAXED, __HIP_MEMORY_SCOPE_AGENT); }
__device__ __forceinline__ unsigned xb_add(unsigned* p, unsigned v) { return __hip_atomic_fetch_add(p, v, __ATOMIC_RELAXED, __HIP_MEMORY_SCOPE_AGENT); }
__device__ __forceinline__ unsigned xb_xcc_id() { return (unsigned)__builtin_amdgcn_s_getreg((3 << 11) | 20) & 0xFu; }
#define XB_SPIN(cond, bar) do { unsigned _sp = 0; while (cond) { __builtin_amdgcn_s_sleep(1); \
    if ((++_sp & 255u) == 0u) { if (xb_ld(&(bar)[XB_TMO])) break; if (_sp > XB_SPIN_CAP) { atomicAdd(&(bar)[XB_TMO], 1u); break; } } } } while (0)
struct XcdBarrier { unsigned* bar; unsigned x; volatile LAS unsigned* st; };
__device__ __forceinline__ XcdBarrier xcd_barrier_post(unsigned* bar, volatile LAS unsigned* st) {
  XcdBarrier b; b.bar = bar; b.x = xb_xcc_id(); b.st = st;
  if (threadIdx.x == 0) (void)xb_add(&bar[XB_XCNT(b.x)], 1u);
  return b;
}
__device__ __forceinline__ void xcd_barrier_complete(unsigned* bar, unsigned x, unsigned& nloc, unsigned& nx) {
  const unsigned G = gridDim.x * gridDim.y * gridDim.z;
  unsigned sum, cnt, mine, sp = 0u;
  for (;;) {
    sum = 0u; cnt = 0u; mine = 0u;
#pragma unroll
    for (unsigned j = 0; j < 16; ++j) { const unsigned c = xb_ld(&bar[XB_XCNT(j)]); sum += c; cnt += (c > 0u) ? 1u : 0u; mine = (j == x) ? c : mine; }
    if (sum == G) break;
    __builtin_amdgcn_s_sleep(1);
    if ((++sp & 255u) == 0u) { if (xb_ld(&bar[XB_TMO])) break; if (sp > XB_SPIN_CAP) { atomicAdd(&bar[XB_TMO], 1u); break; } }
  }
  nloc = mine > 0u ? mine : 1u; nx = cnt > 0u ? cnt : 1u;
}
__device__ __forceinline__ void xcd_barrier(const XcdBarrier& b, int wave) {
  asm volatile("s_waitcnt vmcnt(0)" ::: "memory");
  __syncthreads();
  if (opaque_tid512(wave) == 0) {
    unsigned* bar = b.bar;
    __builtin_amdgcn_s_waitcnt(0);
    unsigned nloc = b.st[0], nx = b.st[1];
    if (nloc == 0u) { xcd_barrier_complete(bar, b.x, nloc, nx); b.st[0] = nloc; b.st[1] = nx; }
    const unsigned old = xb_add(&bar[XB_XSUB(b.x)], 1u);
    const unsigned gen = old / nloc;
    if (old + 1u == (gen + 1u) * nloc) {
      __builtin_amdgcn_fence(__ATOMIC_RELEASE, "agent");
      asm volatile("s_waitcnt vmcnt(0)" ::: "memory");
      const unsigned og = xb_add(&bar[XB_TOP], 1u);
      const unsigned tg = og / nx;
      if (og + 1u == (tg + 1u) * nx) xb_add(&bar[XB_TOPGEN], 1u);
      else XB_SPIN(xb_ld(&bar[XB_TOPGEN]) == tg, bar);
      __builtin_amdgcn_fence(__ATOMIC_ACQUIRE, "agent");
      xb_add(&bar[XB_XGEN(b.x)], 1u);
      asm volatile("s_waitcnt vmcnt(0)" ::: "memory");
    } else {
      XB_SPIN(xb_ld(&bar[XB_XGEN(b.x)]) == gen, bar);
      __builtin_amdgcn_fence(__ATOMIC_ACQUIRE, "agent");
      asm volatile("s_waitcnt vmcnt(0)" ::: "memory");
    }
  }
  __syncthreads();
}


__device__ __forceinline__ int opaque_s(int x) { asm volatile("" : "+s"(x)); return x; }

__device__ __forceinline__ float shfl_idx_f(float v, int src) { return __int_as_float(__builtin_amdgcn_ds_bpermute(src << 2, __float_as_int(v))); }
__device__ __forceinline__ float shfl_xor_f(float v, int off, int lane) { return shfl_idx_f(v, lane ^ off); }

__device__ __forceinline__ float wave_incl_scan(float v) {
#define DPP_ADD(ctrl, rmask) v += __int_as_float(__builtin_amdgcn_update_dpp(0, __float_as_int(v), ctrl, rmask, 0xf, false))
  DPP_ADD(0x111, 0xf); DPP_ADD(0x112, 0xf); DPP_ADD(0x114, 0xf); DPP_ADD(0x118, 0xf);
  DPP_ADD(0x142, 0xa); DPP_ADD(0x143, 0xc);
#undef DPP_ADD
  return v;
}

struct TokInfo { int s, l, L, base, mrow; };
__device__ __forceinline__ TokInfo tokinfo(int tok) {
  TokInfo t;
  if (tok < T_CTX) { t.s = tok >> 8; t.l = tok & 255; t.L = 256; t.base = tok & ~255; t.mrow = 0; }
  else { int u = tok - T_CTX; t.s = 32 + (u >> 12); t.l = u & 4095; t.L = 4096; t.base = T_CTX + (u & ~4095); t.mrow = 1 + (u >> 12); }
  return t;
}
__device__ __forceinline__ int seqpos2off(int pos, bool cm) { return cm ? (((pos & 63) << 6) | (pos >> 6)) : pos; }

struct Params {
  const float *x_prompt, *x_sample, *state_ssd, *state_lru, *c, *c_ctx, *mod_w, *mod_b, *ln_g, *ln_b;
  const float *ssd_in_w, *ssd_conv_w, *ssd_conv_b, *ssd_dt_bias, *ssd_a_log, *ssd_d, *ssd_norm_g, *ssd_out_w;
  const float *hy_in_w, *hy_conv_w, *hy_conv_b, *hy_f_w1, *hy_f_b1, *hy_f_w2, *hy_f_b2, *hy_f_w3, *hy_f_freq, *hy_f_bias, *hy_out_w;
  const float *lru_in_w, *lru_conv_w, *lru_conv_b, *lru_gate_w, *lru_gate_b, *lru_a_param, *lru_out_w;
  float *xres, *out_ssd, *out_lru;
  bf16_t *wt_ssd_in, *wt_ssd_out, *wt_hy_in, *wt_hy_out, *wt_lru_in, *wt_lru_out, *wt_lru_gate;
  float *modv;
  float *hdn2;
  bf16_t *rtab0;
  bf16_t *rtab1;
  float *knorm;
  bf16_t *hbuf;
  float *rstd;
  float *lru_agg;
  float *lru_hin;
  unsigned char *scratch;
  unsigned *bar;
};

#define SC_SSD_Z     ((size_t)0)
#define SC_SSD_XBC   ((size_t)T_ALL * 2048 * 2)
#define SC_SSD_XBCC  (SC_SSD_XBC + (size_t)T_ALL * 4096 * 2)
#define SC_SSD_DT    (SC_SSD_XBCC + (size_t)T_ALL * 2048 * 2)
#define SC_SSD_XT    (SC_SSD_DT + (size_t)T_ALL * 64 * 4)
#define SC_SSD_BT    (SC_SSD_XT + (size_t)T_ALL * 2048 * 2)
#define SC_SSD_BF    (SC_SSD_BT + (size_t)T_ALL * 1024 * 2)
#define SC_SSD_CF    (SC_SSD_BF + (size_t)T_ALL * 1024 * 2)
#define SC_SSD_END   (SC_SSD_CF + (size_t)T_ALL * 1024 * 2)
#define SC_HY_PROJT  ((size_t)0)
#define SC_HY_YT     ((size_t)T_ALL * 4096 * 2)
#define SC_HY_YG     (SC_HY_YT + (size_t)T_ALL * 1024 * 2)
#define SC_LRU_PROJ  ((size_t)0)
#define SC_LRU_XC    ((size_t)T_ALL * 2048 * 2)
#define SC_LRU_GATES (SC_LRU_XC + (size_t)T_ALL * 1024 * 2)
#define SC_LRU_Y     (SC_LRU_GATES + (size_t)T_ALL * 4096 * 2)
#define SC_LRU_YG    (SC_LRU_Y + (size_t)T_ALL * 2048 * 2)
#define SC_TOTAL     SC_SSD_END

__device__ __forceinline__ void transpose_tile(const float* __restrict__ src, int ld_src, int n_src, bf16_t* __restrict__ dst, int K,
                               const float* __restrict__ scale, int tile, int tiles_k, float* tl, int cxw) {
  const int tidx = opaque_tid(cxw);
  int tk = tile % tiles_k, tn = tile / tiles_k;
  int k0 = tk * 64, n0 = tn * 64;
  int tx = tidx & 63, ty = tidx >> 6;
  __syncthreads();
  for (int r = ty; r < 64; r += 4) {
    int n = n0 + tx;
    float v = 0.f;
    if (n < n_src) { v = src[(size_t)(k0 + r) * ld_src + n]; if (scale) v *= scale[k0 + r]; }
    tl[r * 65 + tx] = v;
  }
  __syncthreads();
  for (int r = ty; r < 64; r += 4) dst[(size_t)(n0 + r) * K + k0 + tx] = f2bf(tl[tx * 65 + r]);
}

__device__ __forceinline__ void phase_prep(const Params& p, int bid, int nblk, unsigned char* smem, int cxw) {
  const int tidx = opaque_tid(cxw);
  float* tl = (float*)smem;
  for (int job = 0; job < 24; ++job) {
    const float* src; int ld, nsrc, K, npad; bf16_t* dst; const float* scale = nullptr;
    if (job < 2) { src = p.ssd_in_w + (size_t)job * 1024 * 6208; ld = 6208; nsrc = 6208; K = 1024; npad = 6400; dst = p.wt_ssd_in + (size_t)job * 6400 * 1024; }
    else if (job < 4) { int s = job - 2; src = p.ssd_out_w + (size_t)s * 2048 * 1024; ld = 1024; nsrc = 1024; K = 2048; npad = 1024; dst = p.wt_ssd_out + (size_t)s * 1024 * 2048; scale = p.ssd_norm_g + s * 2048; }
    else if (job == 4) { src = p.hy_in_w; ld = 4096; nsrc = 4096; K = 1024; npad = 4096; dst = p.wt_hy_in; }
    else if (job == 5) { src = p.hy_out_w; ld = 1024; nsrc = 1024; K = 1024; npad = 1024; dst = p.wt_hy_out; }
    else if (job == 6) { src = p.lru_in_w; ld = 2048; nsrc = 2048; K = 1024; npad = 2048; dst = p.wt_lru_in; }
    else if (job == 7) { src = p.lru_out_w; ld = 1024; nsrc = 1024; K = 1024; npad = 1024; dst = p.wt_lru_out; }
    else { int q = job - 8; int dg = q >> 2, n = q & 3;
      src = p.lru_gate_w + (size_t)(dg * 4 + n) * 65536; ld = 256; nsrc = 256; K = 256; npad = 256;
      dst = p.wt_lru_gate + (size_t)n * 1024 * 256 + (size_t)dg * 256 * 256; }
    int tiles_k = K / 64, tiles = tiles_k * (npad / 64);
    for (int t = bid; t < tiles; t += nblk) transpose_tile(src, ld, nsrc, dst, K, scale, t, tiles_k, tl, cxw);
  }
  for (int i = bid * NTHR + tidx; i < 2 * 2 * 1024; i += nblk * NTHR) p.knorm[i] = 0.f;
}

__device__ __forceinline__ void phase_mod(const Params& p, int bid, int nblk, unsigned char* smem, int cxw) {
  const int tidx = opaque_tid(cxw);
  float* sc = (float*)smem;
  float* red = sc + 5 * 1024;
  __syncthreads();
  for (int i = tidx; i < 5 * 1024; i += NTHR) {
    int r = i >> 10, k = i & 1023;
    float v = (r == 0) ? p.c_ctx[k] : p.c[(r - 1) * 1024 + k];
    sc[i] = siluf(v);
  }
  __syncthreads();
  const int cj = tidx & 31, kg = tidx >> 5;
  for (int item = bid; item < 4 * 96; item += nblk) {
    const int layer = item / 96, j = (item % 96) * 32 + cj;
    const float* w = p.mod_w + (size_t)layer * 1024 * 3072 + (size_t)kg * 128 * 3072 + j;
    const float* s0 = sc + kg * 128;
    float a0 = 0, a1 = 0, a2 = 0, a3 = 0, a4 = 0;
#pragma unroll 8
    for (int k = 0; k < 128; ++k) {
      float wv = w[(size_t)k * 3072];
      a0 += s0[k] * wv; a1 += s0[1024 + k] * wv; a2 += s0[2048 + k] * wv; a3 += s0[3072 + k] * wv; a4 += s0[4096 + k] * wv;
    }
    __syncthreads();
    red[(kg * 5 + 0) * 32 + cj] = a0; red[(kg * 5 + 1) * 32 + cj] = a1; red[(kg * 5 + 2) * 32 + cj] = a2;
    red[(kg * 5 + 3) * 32 + cj] = a3; red[(kg * 5 + 4) * 32 + cj] = a4;
    __syncthreads();
    if (tidx < 160) {
      const int rr = tidx >> 5, cc = tidx & 31;
      float sum = 0.f;
#pragma unroll
      for (int g8 = 0; g8 < 8; ++g8) sum += red[(g8 * 5 + rr) * 32 + cc];
      const int jj = (item % 96) * 32 + cc;
      p.modv[((size_t)layer * 5 + rr) * 3072 + jj] = sum + p.mod_b[layer * 3072 + jj];
    }
  }
}

__device__ __forceinline__ void phase_hyfilt_a(const Params& p, int bid, int nblk, unsigned char* smem, int cxw) {
  const int tidx = opaque_tid(cxw);
  float* sz = (float*)smem;
  float* sh = sz + 4 * 36;
  int pl = tidx >> 6, m = tidx & 63;
  for (int item = bid; item < 4352 / 4; item += nblk) {
    int pos = item * 4 + pl;
    int L = pos < 256 ? 256 : 4096;
    int l = pos < 256 ? pos : pos - 256;
    __syncthreads();
    if (m < 33) {
      float t = (float)l / (float)L;
      float w = (6.283185307179586f * (float)l) / (float)L;
      float v;
      if (m == 0) v = t;
      else {
        int j = (m - 1) & 15;
        float fr = 1e-4f + (float)j * ((15.f - 1e-4f) / 15.f);
        float ang = w * fr;
        v = (m <= 16) ? __cosf(ang) : __sinf(ang);
      }
      sz[pl * 36 + m] = v;
    }
    __syncthreads();
    float a = p.hy_f_b1[m];
    for (int e = 0; e < 33; ++e) a += sz[pl * 36 + e] * p.hy_f_w1[e * 64 + m];
    a = __sinf(p.hy_f_freq[m] * a);
    sh[pl * 64 + m] = a;
    __syncthreads();
    float b = p.hy_f_b2[m];
    for (int e = 0; e < 64; ++e) b += sh[pl * 64 + e] * p.hy_f_w2[e * 64 + m];
    b = __sinf(p.hy_f_freq[64 + m] * b);
    p.hdn2[(size_t)pos * 64 + m] = b;
  }
}

__device__ __forceinline__ void phase_hyfilt_b(const Params& p, int bid, int nblk, unsigned char* smem, int cxw) {
  const int tidx = opaque_tid(cxw);
  const int lane = tidx & 63;
  for (int item = bid; item < 17 * 64; item += nblk) {
    const int lb = item >> 6, chunk = item & 63;
    const int Lsel = lb ? 1 : 0, L = Lsel ? 4096 : 256, RL = Lsel ? 8192 : 512, Lm1 = L - 1;
    const int l = Lsel ? (lb - 1) * 256 + tidx : tidx;
    const int pos = Lsel ? 256 + l : l;
    float hd[64];
#pragma unroll
    for (int m4 = 0; m4 < 16; ++m4) {
      f32x4 v = *(const f32x4*)(p.hdn2 + (size_t)pos * 64 + m4 * 4);
      hd[m4 * 4] = v.x; hd[m4 * 4 + 1] = v.y; hd[m4 * 4 + 2] = v.z; hd[m4 * 4 + 3] = v.w;
    }
    const int odc0 = chunk * 64, o = odc0 >> 11, d = (odc0 >> 10) & 1, c0 = odc0 & 1023;
    const float t = (float)l / (float)L;
    bf16_t* rt = Lsel ? p.rtab1 : p.rtab0;
    const float min_decay = -3.0701134573253945f, max_decay = -15.350567286626973f;
    for (int cc = 0; cc < 64; ++cc) {
      const int c = c0 + cc;
      const float* w3 = p.hy_f_w3 + odc0 + cc;
      float acc = 0.f;
#pragma unroll
      for (int m = 0; m < 64; ++m) acc += hd[m] * w3[(size_t)m * 4096];
      float delta = fabsf(min_decay + (float)c * ((max_decay - min_decay) / 1023.f));
      float kv = acc * expf(-t * delta);
      size_t rb = (size_t)(o * 1024 + c) * RL;
      if (d == 0) rt[rb + Lm1 - l] = f2bf(kv);
      else if (l > 0) rt[rb + Lm1 + l] = f2bf(kv);
      else rt[rb + RL - 1] = 0;
      float a = fabsf(kv);
#pragma unroll
      for (int off = 32; off > 0; off >>= 1) a += shfl_xor_f(a, off, lane);
      if (lane == 0) atomicAdd(&p.knorm[(Lsel * 2 + o) * 1024 + c], a);
    }
  }
}

__device__ __forceinline__ void phase_lnmod(const Params& p, int layer, int bid, int nblk, int cxw) {
  const int tidx = opaque_tid(cxw);
  int lane = tidx & 63, wv = cxw & 3;
  for (int row = bid * 4 + wv; row < T_ALL; row += nblk * 4) {
    const float* src = (layer == 0) ? (row < T_CTX ? p.x_prompt + (size_t)row * DM : p.x_sample + (size_t)(row - T_CTX) * DM)
                                    : p.xres + (size_t)row * DM;
    f32x4 v[4];
#pragma unroll
    for (int j = 0; j < 4; ++j) v[j] = *(const f32x4*)(src + j * 256 + lane * 4);
    if (layer > 0) {
      float s = 0.f;
#pragma unroll
      for (int j = 0; j < 4; ++j) s += v[j].x + v[j].y + v[j].z + v[j].w;
#pragma unroll
      for (int o = 32; o > 0; o >>= 1) s += shfl_xor_f(s, o, lane);
      float mu = s * (1.f / 1024.f);
      float q = 0.f;
#pragma unroll
      for (int j = 0; j < 4; ++j) { float a = v[j].x - mu, b = v[j].y - mu, c = v[j].z - mu, d = v[j].w - mu; q += a * a + b * b + c * c + d * d; }
#pragma unroll
      for (int o = 32; o > 0; o >>= 1) q += shfl_xor_f(q, o, lane);
      float rs = rsqrtf(q * (1.f / 1024.f) + LN_EPS);
      const float* g = p.ln_g + (layer - 1) * DM; const float* b = p.ln_b + (layer - 1) * DM;
#pragma unroll
      for (int j = 0; j < 4; ++j) {
        f32x4 gg = *(const f32x4*)(g + j * 256 + lane * 4), bb = *(const f32x4*)(b + j * 256 + lane * 4);
        v[j].x = (v[j].x - mu) * rs * gg.x + bb.x; v[j].y = (v[j].y - mu) * rs * gg.y + bb.y;
        v[j].z = (v[j].z - mu) * rs * gg.z + bb.z; v[j].w = (v[j].w - mu) * rs * gg.w + bb.w;
      }
    }
    float* dst = p.xres + (size_t)row * DM;
#pragma unroll
    for (int j = 0; j < 4; ++j) *(f32x4*)(dst + j * 256 + lane * 4) = v[j];
    if (layer < 4) {
      int mrow = row < T_CTX ? 0 : 1 + ((row - T_CTX) >> 12);
      const float* mv = p.modv + ((size_t)layer * 5 + mrow) * 3072;
#pragma unroll
      for (int j = 0; j < 4; ++j) {
        f32x4 sh = *(const f32x4*)(mv + j * 256 + lane * 4), sc = *(const f32x4*)(mv + 1024 + j * 256 + lane * 4);
        u32x2 o;
        o.x = pack2(v[j].x * (1.f + sc.x) + sh.x, v[j].y * (1.f + sc.y) + sh.y);
        o.y = pack2(v[j].z * (1.f + sc.z) + sh.z, v[j].w * (1.f + sc.w) + sh.w);
        *(u32x2*)(p.hbuf + (size_t)row * DM + j * 256 + lane * 4) = o;
      }
    }
  }
}

#define PG8_LAS __attribute__((address_space(3)))
namespace pg8 {
constexpr int BM = 256, BK = 64, HALF = 128, HTB = HALF * BK * 2, STAGE_BYTES = 8 * HTB, NXCD = 8, WGM = 8;
__device__ __forceinline__ int lds_byte(int r, int c) { const int st = (r >> 4) * 2 + (c >> 5), rr = r & 15, cc = c & 31, ob = rr * 64 + cc * 2; return st * 1024 + (ob ^ (((ob >> 9) & 1) << 5)); }
__device__ __forceinline__ void stage_rc(int b, int& R, int& C) { const int st = b / 1024, sb = b % 1024, swz = sb ^ (((sb >> 9) & 1) << 5); R = (st >> 1) * 16 + swz / 64; C = (st & 1) * 32 + (swz % 64) / 2; }
__device__ __forceinline__ int perm32(int rho) { const int n = rho >> 4, i = rho & 15; return 8 * (i >> 2) + 4 * n + (i & 3); }
struct Unit { int pm, pn; };
struct Gemm { const bf16_t* A; const bf16_t* Bt; int M, N, K, lda; int a_grp_shift; int a_grp_bytes; };
struct StaticOrder {
  int nM, nN, nwg, G, c;
  __device__ void init(int M, int N, int G_, int c_) { nM = M / BM; nN = N / BM; nwg = nM * nN; G = G_; c = c_; }
  __device__ bool next(int i, Unit& u) const {
    const long L = (long)i * G + c; if (L >= nwg) return false;
    int wgid = (int)L; { const int q = nwg / NXCD, r = nwg % NXCD, xcd = wgid % NXCD, off = wgid / NXCD; wgid = (xcd < r ? xcd * (q + 1) : r * (q + 1) + (xcd - r) * q) + off; }
    const int nig = WGM * nN, gid = wgid / nig, fm = gid * WGM, gsz = (nM - fm) < WGM ? (nM - fm) : WGM;
    u.pm = fm + ((wgid % nig) % gsz); u.pn = (wgid % nig) / gsz; return true;
  }
};
__device__ __forceinline__ unsigned cvt_pk_bf16(float lo, float hi) { return pack2(lo, hi); }

template <class Epi>
__device__ __forceinline__ void gemm_phase(PG8_LAS unsigned char* lds, const Gemm g, const StaticOrder& S, const Epi& E, int wave) {
  const int tid = opaque_tid512(wave), wid = wave, lane = tid & 63, wr = wid >> 2, wc = wid & 3, fr = lane & 15, fq = lane >> 4;
  const int K = g.K, nt = K / BK, lda = g.lda;
  unsigned voffA[2], voffB[2];
#pragma unroll
  for (int i = 0; i < 2; ++i) { int R, C; stage_rc(tid * 16 + i * 8192, R, C); const int Rb = Epi::PERM ? ((R & ~31) + perm32(R & 31)) : R;
    voffA[i] = (unsigned)(R * lda + C) * 2u; voffB[i] = (unsigned)(Rb * K + C) * 2u; }
  const size_t kstep = (size_t)(BK * 2);
  const size_t hstepA = (size_t)HALF * lda * 2, hstepB = (size_t)HALF * K * 2;
  const size_t tstepA = 2 * hstepA, tstepB = 2 * hstepB;
  const unsigned ldsw = (unsigned)wid * 1024u;
  const int aoff = lds_byte(wr * 64 + fr, fq * 8), boff = lds_byte(wc * 32 + fr, fq * 8);
#define PG8_SA(b, h) (((b) * 2 + (h)) * HTB)
#define PG8_SB(b, h) ((4 + (b) * 2 + (h)) * HTB)
#define PG8_STAGE(bufoff, gbase, voff) do { _Pragma("unroll") for (int _i = 0; _i < 2; ++_i) \
    __builtin_amdgcn_global_load_lds((const unsigned*)((const char*)(gbase) + (voff)[_i]), (PG8_LAS unsigned*)(lds + (bufoff) + ldsw + _i * 8192), 16, 0, 0); } while (0)
#define PG8_LDA(dst, b, h) do { _Pragma("unroll") for (int m = 0; m < 4; ++m) _Pragma("unroll") for (int k = 0; k < 2; ++k) dst[m][k] = *(const PG8_LAS bf16x8*)(lds + PG8_SA(b, h) + aoff + m * 2048 + k * 1024); } while (0)
#define PG8_LDB(dst, b, h) do { _Pragma("unroll") for (int n = 0; n < 2; ++n) _Pragma("unroll") for (int k = 0; k < 2; ++k) dst[n][k] = *(const PG8_LAS bf16x8*)(lds + PG8_SB(b, h) + boff + n * 2048 + k * 1024); } while (0)
#define PG8_MMA(ai, bj, At, Bt) do { __builtin_amdgcn_s_setprio(1); _Pragma("unroll") for (int m = 0; m < 4; ++m) _Pragma("unroll") for (int n = 0; n < 2; ++n) _Pragma("unroll") for (int k = 0; k < 2; ++k) \
    acc[ai][bj][m][n] = __builtin_amdgcn_mfma_f32_16x16x32_bf16(Bt[n][k], At[m][k], acc[ai][bj][m][n], 0, 0, 0); __builtin_amdgcn_s_setprio(0); } while (0)
#define PG8_WAIT_V(n) asm volatile("s_waitcnt vmcnt(" #n ")" ::: "memory")
#define PG8_WAIT_L(n) asm volatile("s_waitcnt lgkmcnt(" #n ")" ::: "memory")
#define PG8_BAR __builtin_amdgcn_s_barrier()
#define PG8_SCHED __builtin_amdgcn_sched_barrier(0)
#define PG8_APTR(u) ((const char*)g.A + (size_t)(u).pm * tstepA + (size_t)(((u).pn >> g.a_grp_shift) * g.a_grp_bytes))
  Unit cur, nxt; int ui = 0;
  if (!S.next(0, cur)) return;
  f32x4 acc[2][2][4][2];
#pragma unroll
  for (int a = 0; a < 2; ++a)
#pragma unroll
    for (int b = 0; b < 2; ++b)
#pragma unroll
      for (int m = 0; m < 4; ++m)
#pragma unroll
        for (int n = 0; n < 2; ++n) acc[a][b][m][n] = (f32x4){0.f, 0.f, 0.f, 0.f};
  bf16x8 At[4][2], B0[2][2], B1[2][2];
  const char* cA = PG8_APTR(cur); const char* cB = (const char*)g.Bt + (size_t)cur.pn * tstepB;
  PG8_STAGE(PG8_SB(0, 0), cB, voffB); PG8_STAGE(PG8_SA(0, 0), cA, voffA); PG8_STAGE(PG8_SB(0, 1), cB + hstepB, voffB); PG8_STAGE(PG8_SA(0, 1), cA + hstepA, voffA);
  if (wr == 1) PG8_BAR;
  PG8_WAIT_V(4); PG8_BAR;
  PG8_STAGE(PG8_SB(1, 0), cB + kstep, voffB); PG8_STAGE(PG8_SA(1, 0), cA + kstep, voffA); PG8_STAGE(PG8_SB(1, 1), cB + hstepB + kstep, voffB);
  PG8_WAIT_V(6); PG8_BAR;
  for (;;) {
    const bool has_next = S.next(ui + 1, nxt);
    const char* nA = has_next ? PG8_APTR(nxt) : cA; const char* nB = has_next ? (const char*)g.Bt + (size_t)nxt.pn * tstepB : cB;
    for (int t = 0; t < nt; t += 2) {
      const bool last = (t == nt - 2);
      const char* a1 = cA + (size_t)(t + 1) * kstep;
      const char* a2 = last ? nA : cA + (size_t)(t + 2) * kstep; const char* b2 = last ? nB : cB + (size_t)(t + 2) * kstep;
      const char* a3 = a2 + kstep; const char* b3 = b2 + kstep;
      PG8_LDB(B0, 0, 0); PG8_SCHED; PG8_LDA(At, 0, 0); PG8_STAGE(PG8_SA(1, 1), a1 + hstepA, voffA);
      PG8_WAIT_L(8); PG8_BAR; PG8_WAIT_L(0); PG8_MMA(0, 0, At, B0); PG8_BAR; PG8_SCHED;
      PG8_LDB(B1, 0, 1); PG8_STAGE(PG8_SB(0, 0), b2, voffB);
      PG8_BAR; PG8_WAIT_L(0); PG8_MMA(0, 1, At, B1); PG8_BAR;
      PG8_LDA(At, 0, 1); PG8_STAGE(PG8_SA(0, 0), a2, voffA);
      PG8_BAR; PG8_WAIT_L(0); PG8_MMA(1, 0, At, B0); PG8_BAR; PG8_SCHED;
      PG8_STAGE(PG8_SB(0, 1), b2 + hstepB, voffB);
      PG8_WAIT_V(6); PG8_BAR; PG8_MMA(1, 1, At, B1); PG8_BAR;
      PG8_LDB(B0, 1, 0); PG8_SCHED; PG8_LDA(At, 1, 0); PG8_STAGE(PG8_SA(0, 1), a2 + hstepA, voffA);
      PG8_WAIT_L(8); PG8_BAR; PG8_WAIT_L(0); PG8_MMA(0, 0, At, B0); PG8_BAR; PG8_SCHED;
      PG8_LDB(B1, 1, 1); PG8_STAGE(PG8_SB(1, 0), b3, voffB);
      PG8_BAR; PG8_WAIT_L(0); PG8_MMA(0, 1, At, B1); PG8_BAR;
      PG8_LDA(At, 1, 1); PG8_STAGE(PG8_SA(1, 0), a3, voffA);
      PG8_BAR; PG8_WAIT_L(0); PG8_MMA(1, 0, At, B0); PG8_BAR; PG8_SCHED;
      PG8_STAGE(PG8_SB(1, 1), b3 + hstepB, voffB);
      PG8_WAIT_V(6); PG8_BAR; PG8_MMA(1, 1, At, B1); PG8_BAR;
    }
    { int fr2 = fr, fq2 = fq; asm volatile("" : "+v"(fr2), "+v"(fq2));
      E(acc, cur, wr, wc, fr2, fq2); }
    if (!has_next) break;
#pragma unroll
    for (int a = 0; a < 2; ++a)
#pragma unroll
      for (int b = 0; b < 2; ++b)
#pragma unroll
        for (int m = 0; m < 4; ++m)
#pragma unroll
          for (int n = 0; n < 2; ++n) acc[a][b][m][n] = (f32x4){0.f, 0.f, 0.f, 0.f};
    cur = nxt; cA = nA; cB = nB; ++ui;
  }
  PG8_WAIT_V(0);
  if (wr == 0) PG8_BAR;
  PG8_BAR;
#undef PG8_SA
#undef PG8_SB
#undef PG8_STAGE
#undef PG8_LDA
#undef PG8_LDB
#undef PG8_MMA
#undef PG8_WAIT_V
#undef PG8_WAIT_L
#undef PG8_BAR
#undef PG8_SCHED
#undef PG8_APTR
}

struct EpiBf16 {
  static constexpr bool PERM = true;
  bf16_t* O; size_t ldc;
  __device__ __forceinline__ void operator()(const f32x4 (&acc)[2][2][4][2], const Unit& u, int wr, int wc, int fr, int fq) const {
    const int row0 = u.pm * BM + wr * 64 + fr, col0 = u.pn * BM + wc * 32 + 8 * fq;
#pragma unroll
    for (int ai = 0; ai < 2; ++ai)
#pragma unroll
      for (int m = 0; m < 4; ++m) {
        bf16_t* rowp = O + (size_t)(row0 + ai * HALF + m * 16) * ldc + col0;
#pragma unroll
        for (int bj = 0; bj < 2; ++bj) {
          const f32x4 v0 = acc[ai][bj][m][0], v1 = acc[ai][bj][m][1];
          u32x4 w; w.x = pack2(v0[0], v0[1]); w.y = pack2(v0[2], v0[3]); w.z = pack2(v1[0], v1[1]); w.w = pack2(v1[2], v1[3]);
          *(u32x4*)(rowp + bj * HALF) = w;
        }
      }
  }
};
struct EpiSsdIn {
  static constexpr bool PERM = true;
  bf16_t* z; bf16_t* xbc; float* dt; const float* dt_bias;
  __device__ __forceinline__ void operator()(const f32x4 (&acc)[2][2][4][2], const Unit& u, int wr, int wc, int fr, int fq) const {
    const int row0 = u.pm * BM + wr * 64 + fr, colt = u.pn * BM + wc * 32 + 8 * fq;
    if (u.pn < 24) {
      bf16_t* base = u.pn < 8 ? z : xbc; const size_t ldc = u.pn < 8 ? 2048 : 4096; const int col0 = u.pn < 8 ? colt : colt - 2048;
#pragma unroll
      for (int ai = 0; ai < 2; ++ai)
#pragma unroll
        for (int m = 0; m < 4; ++m) {
          bf16_t* rowp = base + (size_t)(row0 + ai * HALF + m * 16) * ldc + col0;
#pragma unroll
          for (int bj = 0; bj < 2; ++bj) {
            const f32x4 v0 = acc[ai][bj][m][0], v1 = acc[ai][bj][m][1];
            u32x4 w; w.x = pack2(v0[0], v0[1]); w.y = pack2(v0[2], v0[3]); w.z = pack2(v1[0], v1[1]); w.w = pack2(v1[2], v1[3]);
            *(u32x4*)(rowp + bj * HALF) = w;
          }
        }
    } else {
      const int c0 = wc * 32 + 8 * fq;
      if (c0 < 64) {
#pragma unroll
        for (int ai = 0; ai < 2; ++ai)
#pragma unroll
          for (int m = 0; m < 4; ++m) {
            float* rowp = dt + (size_t)(row0 + ai * HALF + m * 16) * 64 + c0;
#pragma unroll
            for (int n = 0; n < 2; ++n) {
              const f32x4 v = acc[ai][0][m][n];
              f32x4 o;
#pragma unroll
              for (int e = 0; e < 4; ++e) o[e] = softplusf(v[e] + dt_bias[c0 + 4 * n + e]);
              *(f32x4*)(rowp + 4 * n) = o;
            }
          }
      }
    }
  }
};
struct EpiOut {
  static constexpr bool PERM = false;
  float* xres; const float* modv_layer; const float* rstd;
  __device__ __forceinline__ void operator()(const f32x4 (&acc)[2][2][4][2], const Unit& u, int wr, int wc, int fr, int fq) const {
    const int row0 = u.pm * BM + wr * 64 + fr, col0 = u.pn * BM + wc * 32 + 4 * fq;
#pragma unroll
    for (int ai = 0; ai < 2; ++ai)
#pragma unroll
      for (int m = 0; m < 4; ++m) {
        const int row = row0 + ai * HALF + m * 16;
        const int mrow = row < T_CTX ? 0 : 1 + ((row - T_CTX) >> 12);
        const float rs = rstd ? rstd[row] : 1.f;
        const float* gp = modv_layer + (size_t)mrow * 3072 + 2048 + col0;
        float* rowp = xres + (size_t)row * DM + col0;
#pragma unroll
        for (int bj = 0; bj < 2; ++bj)
#pragma unroll
          for (int n = 0; n < 2; ++n) {
            const f32x4 gv = *(const f32x4*)(gp + bj * HALF + n * 16);
            const f32x4 xv = *(const f32x4*)(rowp + bj * HALF + n * 16);
            *(f32x4*)(rowp + bj * HALF + n * 16) = ALPHA_RES * xv + gv * (acc[ai][bj][m][n] * rs);
          }
      }
  }
};
struct EpiLruGate {
  static constexpr bool PERM = true;
  bf16_t* gates; const float* gate_b;
  __device__ __forceinline__ void operator()(const f32x4 (&acc)[2][2][4][2], const Unit& u, int wr, int wc, int fr, int fq) const {
    const int nb = u.pn >> 2, dg = u.pn & 3;
    const int row0 = u.pm * BM + wr * 64 + fr, ch0 = nb * 256 + wc * 32 + 8 * fq;
#pragma unroll
    for (int ai = 0; ai < 2; ++ai)
#pragma unroll
      for (int m = 0; m < 4; ++m) {
        bf16_t* rowp = gates + ((size_t)dg * T_ALL + row0 + ai * HALF + m * 16) * 1024 + ch0;
#pragma unroll
        for (int bj = 0; bj < 2; ++bj) {
          const float* bp = gate_b + dg * 1024 + ch0 + bj * HALF;
          const f32x4 b0 = *(const f32x4*)bp, b1 = *(const f32x4*)(bp + 4);
          const f32x4 v0 = acc[ai][bj][m][0] + b0, v1 = acc[ai][bj][m][1] + b1;
          u32x4 w; w.x = pack2(sigmoidf(v0[0]), sigmoidf(v0[1])); w.y = pack2(sigmoidf(v0[2]), sigmoidf(v0[3]));
          w.z = pack2(sigmoidf(v1[0]), sigmoidf(v1[1])); w.w = pack2(sigmoidf(v1[2]), sigmoidf(v1[3]));
          *(u32x4*)(rowp + bj * HALF) = w;
        }
      }
  }
};
}

template <int KW, bool SILU>
__device__ __forceinline__ void phase_dwconv(const bf16_t* __restrict__ src, int ld_src, bf16_t* __restrict__ dst, int ld_dst, int CH,
                             const float* __restrict__ w, const float* __restrict__ b, bool colmajor, int bid, int nblk, int cxw) {
  const int tidx = opaque_tid(cxw);
  const int cpr = CH / 8;
  const size_t total = (size_t)T_ALL * cpr;
  for (size_t idx = (size_t)bid * NTHR + tidx; idx < total; idx += (size_t)nblk * NTHR) {
    int tok = (int)(idx / cpr), c0 = (int)(idx % cpr) * 8;
    TokInfo ti = tokinfo(tok);
    bool cm = colmajor && ti.s >= 32;
    int pos = seqpos2off(ti.l, cm);
    float acc[8];
#pragma unroll
    for (int e = 0; e < 8; ++e) acc[e] = b[c0 + e];
#pragma unroll
    for (int k = 0; k < KW; ++k) {
      int pp = pos + k - 1;
      if (pp < 0 || pp >= ti.L) continue;
      int tk = ti.base + seqpos2off(pp, cm);
      u32x4 xv = *(const u32x4*)(src + (size_t)tk * ld_src + c0);
      const float* wk = w + (size_t)k * CH + c0;
      acc[0] += wk[0] * bflo(xv.x); acc[1] += wk[1] * bfhi(xv.x);
      acc[2] += wk[2] * bflo(xv.y); acc[3] += wk[3] * bfhi(xv.y);
      acc[4] += wk[4] * bflo(xv.z); acc[5] += wk[5] * bfhi(xv.z);
      acc[6] += wk[6] * bflo(xv.w); acc[7] += wk[7] * bfhi(xv.w);
    }
    if (SILU) {
#pragma unroll
      for (int e = 0; e < 8; ++e) acc[e] = siluf(acc[e]);
    }
    u32x4 o;
    o.x = pack2(acc[0], acc[1]); o.y = pack2(acc[2], acc[3]); o.z = pack2(acc[4], acc[5]); o.w = pack2(acc[6], acc[7]);
    *(u32x4*)(dst + (size_t)tok * ld_dst + c0) = o;
  }
}

__device__ __forceinline__ void phase_ssd_conv(const Params& p, int slot, bool colmajor, int bid, int nblk, unsigned char* smem, int cxw) {
  const int tid = opaque_tid(cxw);
  const bf16_t* raw = (const bf16_t*)(p.scratch + SC_SSD_XBC);
  bf16_t* out = (bf16_t*)(p.scratch + SC_SSD_XBCC);
  bf16_t* XT = (bf16_t*)(p.scratch + SC_SSD_XT);
  bf16_t* BT = (bf16_t*)(p.scratch + SC_SSD_BT);
  bf16_t* BF = (bf16_t*)(p.scratch + SC_SSD_BF);
  bf16_t* CF = (bf16_t*)(p.scratch + SC_SSD_CF);
  const float* cw = p.ssd_conv_w + (size_t)slot * 4 * 4096;
  const float* cb = p.ssd_conv_b + slot * 4096;
  bf16_t* tl = (bf16_t*)smem;
  for (int item = bid; item < 384 * 64; item += nblk) {
    const int ptile = item >> 6, ct = item & 63;
    const int ptok0 = ptile * 64;
    TokInfo ti = tokinfo(ptok0);
    const bool cm = colmajor && ti.s >= 32;
    const int rr = tid >> 2, cpart = tid & 3;
    const int ch = ct * 64 + cpart * 16;
    const int pos = ti.l + rr;
    float acc[16];
#pragma unroll
    for (int e = 0; e < 16; ++e) acc[e] = cb[ch + e];
#pragma unroll
    for (int k = 0; k < 4; ++k) {
      int pp = pos + k - 1;
      if (pp < 0 || pp >= ti.L) continue;
      int tk = ti.base + seqpos2off(pp, cm);
      const bf16_t* rp = raw + (size_t)tk * 4096 + ch;
      u32x4 x0 = *(const u32x4*)rp, x1 = *(const u32x4*)(rp + 8);
      const float* wk = cw + (size_t)k * 4096 + ch;
      unsigned xw[8] = {x0.x, x0.y, x0.z, x0.w, x1.x, x1.y, x1.z, x1.w};
#pragma unroll
      for (int e = 0; e < 8; ++e) { acc[2 * e] += wk[2 * e] * bflo(xw[e]); acc[2 * e + 1] += wk[2 * e + 1] * bfhi(xw[e]); }
    }
    u32x4 o0, o1;
    o0.x = pack2(siluf(acc[0]), siluf(acc[1])); o0.y = pack2(siluf(acc[2]), siluf(acc[3]));
    o0.z = pack2(siluf(acc[4]), siluf(acc[5])); o0.w = pack2(siluf(acc[6]), siluf(acc[7]));
    o1.x = pack2(siluf(acc[8]), siluf(acc[9])); o1.y = pack2(siluf(acc[10]), siluf(acc[11]));
    o1.z = pack2(siluf(acc[12]), siluf(acc[13])); o1.w = pack2(siluf(acc[14]), siluf(acc[15]));
    __syncthreads();
    *(u32x4*)(tl + rr * 72 + cpart * 16) = o0;
    *(u32x4*)(tl + rr * 72 + cpart * 16 + 8) = o1;
    __syncthreads();
    if (ct < 32) {
      bf16_t* op = out + (size_t)(ptok0 + rr) * 2048 + ch;
      *(u32x4*)op = o0; *(u32x4*)(op + 8) = o1;
      const int crow = tid >> 2, part = tid & 3;
      unsigned wv[8];
#pragma unroll
      for (int e = 0; e < 8; ++e) {
        unsigned lo = tl[(part * 16 + 2 * e) * 72 + crow], hi = tl[(part * 16 + 2 * e + 1) * 72 + crow];
        wv[e] = lo | (hi << 16);
      }
      bf16_t* dp = XT + (size_t)(ct * 64 + crow) * T_ALL + ptok0 + part * 16;
      u32x4 t0, t1;
      t0.x = wv[0]; t0.y = wv[1]; t0.z = wv[2]; t0.w = wv[3]; t1.x = wv[4]; t1.y = wv[5]; t1.z = wv[6]; t1.w = wv[7];
      *(u32x4*)dp = t0; *(u32x4*)(dp + 8) = t1;
    } else {
      const bool isB = ct < 48;
      const int cq = (ct - (isB ? 32 : 48));
      const int g = cq >> 1, chhalf = cq & 1;
      const int lane = tid & 63, r = lane & 31, hh = lane >> 5;
      bf16_t* F = isB ? BF : CF;
#pragma unroll
      for (int i = 0; i < 2; ++i) {
        const int f = (cxw & 3) + 4 * i;
        const int rt2 = f >> 2, kk4 = f & 3;
        const u32x4 v = *(const u32x4*)(tl + (32 * rt2 + r) * 72 + 16 * kk4 + 8 * hh);
        const size_t rt = (size_t)(ptok0 >> 5) + rt2;
        *(u32x4*)(F + (((rt * 8 + g) * 8 + chhalf * 4 + kk4) * 64 + lane) * 8) = v;
      }
      if (isB) {
#pragma unroll
        for (int i = 0; i < 2; ++i) {
          const int f = (cxw & 3) + 4 * i;
          const int nt2 = f >> 2, ts4 = f & 3;
          unsigned wv[4];
#pragma unroll
          for (int e = 0; e < 4; ++e) {
            unsigned lo = tl[(16 * ts4 + 8 * hh + 2 * e) * 72 + 32 * nt2 + r], hi = tl[(16 * ts4 + 8 * hh + 2 * e + 1) * 72 + 32 * nt2 + r];
            wv[e] = lo | (hi << 16);
          }
          u32x4 v; v.x = wv[0]; v.y = wv[1]; v.z = wv[2]; v.w = wv[3];
          const size_t ts = (size_t)(ptok0 >> 4) + ts4;
          *(u32x4*)(BT + (((ts * 8 + g) * 4 + chhalf * 2 + nt2) * 64 + lane) * 8) = v;
        }
      }
    }
  }
}

#define SH_STRIDE 136
__device__ __forceinline__ int rowmap(int e, int hh) { return (e & 3) + 8 * (e >> 2) + 4 * hh; }
__device__ __forceinline__ bf16x8 pack8(float a0, float a1, float a2, float a3, float a4, float a5, float a6, float a7) {
  u32x4 v; v.x = pack2(a0, a1); v.y = pack2(a2, a3); v.z = pack2(a4, a5); v.w = pack2(a6, a7);
  return __builtin_bit_cast(bf16x8, v);
}
__device__ __forceinline__ void phase_ssd_scan(const Params& p, int slot, bool colmajor, int bid, int nblk, unsigned char* smem, int cxw) {
  const int tid = opaque_tid(cxw), lane = tid & 63, w = cxw & 3  , r = lane & 31, hh = lane >> 5;
  const int it = w >> 1, pt = w & 1;
  const bf16_t* xbcc = (const bf16_t*)(p.scratch + SC_SSD_XBCC);
  const bf16_t* XT = (const bf16_t*)(p.scratch + SC_SSD_XT);
  const bf16_t* BT = (const bf16_t*)(p.scratch + SC_SSD_BT);
  const bf16_t* BF = (const bf16_t*)(p.scratch + SC_SSD_BF);
  const bf16_t* CF = (const bf16_t*)(p.scratch + SC_SSD_CF);
  const float* dtb = (const float*)(p.scratch + SC_SSD_DT);
  bf16_t* ybuf = (bf16_t*)(p.scratch + SC_SSD_XBC);
  bf16_t* sXr = (bf16_t*)smem;
  bf16_t* sXs = sXr + 64 * 72;
  bf16_t* sH = sXs + 64 * 72;
  float* sW = (float*)(sH + 2 * 64 * SH_STRIDE);
  bf16_t* sY = (bf16_t*)(sW + 4 * 256);
  float* myW = sW + w * 256;
  for (int item = bid; item < 36 * 64; item += nblk) {
    int s, h, dir;
    {
      const int itx = item < 256 ? item : item - 256;
      const int idx = itx & 63, pairidx = idx >> 1;
      s = item < 256 ? 32 + (itx >> 6) : (itx >> 6);
      dir = pairidx & 1; h = (pairidx >> 1) * 2 + (idx & 1);
    }
    const int L = s < 32 ? 256 : 4096;
    const int base = s < 32 ? s * 256 : T_CTX + (s - 32) * 4096;
    const bool cm = colmajor && s >= 32;
    const int g = h >> 2;
    const float Aval = -expf(p.ssd_a_log[(slot * 2 + dir) * 32 + h]);
    const int nchunks = L >> 6;
    const int pcol = 32 * pt + r;
    f32x16 hacc[2];
    if (s >= 32) {
      const float* h0 = p.state_ssd + ((((size_t)(s - 32) * 2 + slot) * 2 + dir) * 32 + h) * 8192 + (size_t)pcol * 128;
#pragma unroll
      for (int t2 = 0; t2 < 2; ++t2)
#pragma unroll
        for (int qd = 0; qd < 4; ++qd) {
          f32x4 v = *(const f32x4*)(h0 + 32 * (2 * it + t2) + 8 * qd + 4 * hh);
          hacc[t2][4 * qd] = v.x; hacc[t2][4 * qd + 1] = v.y; hacc[t2][4 * qd + 2] = v.z; hacc[t2][4 * qd + 3] = v.w;
        }
    } else {
#pragma unroll
      for (int t2 = 0; t2 < 2; ++t2)
#pragma unroll
        for (int e = 0; e < 16; ++e) hacc[t2][e] = 0.f;
    }
#pragma unroll
    for (int t2 = 0; t2 < 2; ++t2)
#pragma unroll
      for (int qd = 0; qd < 4; ++qd) {
        u32x2 o; o.x = pack2(hacc[t2][4 * qd], hacc[t2][4 * qd + 1]); o.y = pack2(hacc[t2][4 * qd + 2], hacc[t2][4 * qd + 3]);
        *(u32x2*)(sH + pcol * SH_STRIDE + 32 * (2 * it + t2) + 8 * qd + 4 * hh) = o;
      }
    float dtv; u32x4 xtr[2]; bf16x8 cfr[8], bfr[2][8], btf[2][4];
    const bool need0 = dir == 0 ? true : (it == 0);
    const bool need1 = dir == 0 ? (it == 1) : true;
#define SCAN_PTOK(c) (base + 64 * (dir ? nchunks - 1 - (c) : (c)))
#define SCAN_LOAD_DTX(pt0) do { \
      const int tok_ = base + seqpos2off((pt0) - base + lane, cm); \
      dtv = dtb[(size_t)tok_ * 64 + dir * 32 + h]; \
      _Pragma("unroll") for (int i_ = 0; i_ < 2; ++i_) { const int q_ = tid + i_ * 256; \
        xtr[i_] = *(const u32x4*)(XT + (size_t)(h * 64 + (q_ >> 3)) * T_ALL + (pt0) + (q_ & 7) * 8); } } while (0)
#define SCAN_LOAD_CB(pt0) do { \
      const bf16_t* cf_ = CF + ((((size_t)((pt0) >> 5) + it) * 8 + g) * 8) * 512 + lane * 8; \
      _Pragma("unroll") for (int kk = 0; kk < 8; ++kk) cfr[kk] = *(const bf16x8*)(cf_ + kk * 512); \
      if (need0) { const bf16_t* bf_ = BF + ((((size_t)((pt0) >> 5)) * 8 + g) * 8) * 512 + lane * 8; \
        _Pragma("unroll") for (int kk = 0; kk < 8; ++kk) bfr[0][kk] = *(const bf16x8*)(bf_ + kk * 512); } \
      if (need1) { const bf16_t* bf_ = BF + ((((size_t)((pt0) >> 5) + 1) * 8 + g) * 8) * 512 + lane * 8; \
        _Pragma("unroll") for (int kk = 0; kk < 8; ++kk) bfr[1][kk] = *(const bf16x8*)(bf_ + kk * 512); } } while (0)
#define SCAN_LOAD_BT(pt0) do { \
      _Pragma("unroll") for (int t2 = 0; t2 < 2; ++t2) { \
        _Pragma("unroll") for (int kk = 0; kk < 4; ++kk) \
          btf[t2][kk] = *(const bf16x8*)(BT + (((((size_t)((pt0) >> 4) + kk) * 8 + g) * 4 + 2 * it + t2) * 64 + lane) * 8); } } while (0)
    {
      const int p0 = SCAN_PTOK(0);
      SCAN_LOAD_DTX(p0); SCAN_LOAD_CB(p0); SCAN_LOAD_BT(p0);
    }
    for (int ci = 0; ci < nchunks; ++ci) {
      const int ptok0 = SCAN_PTOK(ci);
      const int cin = ci + 1 < nchunks ? ci + 1 : ci;
      const int ptokN = SCAN_PTOK(cin);
      const int buf = ci & 1;
      __syncthreads();
      if (ci > 0) {
        const int ptokP = SCAN_PTOK(ci - 1);
#pragma unroll
        for (int i = 0; i < 2; ++i) {
          const int q = tid + i * 256, yrow = q >> 3, c8 = (q & 7) * 8;
          *(u32x4*)(ybuf + ((size_t)dir * T_ALL + ptokP + yrow) * 2048 + h * 64 + c8) = *(const u32x4*)(sY + yrow * 72 + c8);
        }
      }
      float decE;
      {
        const float a_ = dtv * Aval;
        const float pre = wave_incl_scan(a_);
        const float cE = __int_as_float(__builtin_amdgcn_readlane(__float_as_int(pre), 63));
        const float c = dir == 0 ? pre : cE - pre + a_;
        myW[lane] = dtv; myW[64 + lane] = c; myW[128 + lane] = __expf(c); myW[192 + lane] = dtv * __expf(cE - c);
        decE = __expf(cE);
      }
#pragma unroll
      for (int i = 0; i < 2; ++i) {
        const int q = tid + i * 256, prow = q >> 3, j8 = (q & 7) * 8;
        const u32x4 raw = xtr[i];
        *(u32x4*)(sXr + prow * 72 + j8) = raw;
        f32x4 f0 = *(const f32x4*)(myW + 192 + j8), f1 = *(const f32x4*)(myW + 192 + j8 + 4);
        u32x4 sc;
        sc.x = pack2(bflo(raw.x) * f0.x, bfhi(raw.x) * f0.y); sc.y = pack2(bflo(raw.y) * f0.z, bfhi(raw.y) * f0.w);
        sc.z = pack2(bflo(raw.z) * f1.x, bfhi(raw.z) * f1.y); sc.w = pack2(bflo(raw.w) * f1.z, bfhi(raw.w) * f1.w);
        *(u32x4*)(sXs + prow * 72 + j8) = sc;
      }
      __syncthreads();
      SCAN_LOAD_DTX(ptokN);
#pragma unroll
      for (int t2 = 0; t2 < 2; ++t2) {
#pragma unroll
        for (int e = 0; e < 16; ++e) hacc[t2][e] *= decE;
        const bf16_t* xs = sXs + pcol * 72 + 8 * hh;
#pragma unroll
        for (int kk = 0; kk < 4; ++kk)
          hacc[t2] = __builtin_amdgcn_mfma_f32_32x32x16_bf16(btf[t2][kk], *(const bf16x8*)(xs + 16 * kk), hacc[t2], 0, 0, 0);
#pragma unroll
        for (int qd = 0; qd < 4; ++qd) {
          u32x2 o; o.x = pack2(hacc[t2][4 * qd], hacc[t2][4 * qd + 1]); o.y = pack2(hacc[t2][4 * qd + 2], hacc[t2][4 * qd + 3]);
          *(u32x2*)(sH + (buf ^ 1) * 64 * SH_STRIDE + pcol * SH_STRIDE + 32 * (2 * it + t2) + 8 * qd + 4 * hh) = o;
        }
      }
      f32x16 acc;
#pragma unroll
      for (int e = 0; e < 16; ++e) acc[e] = 0.f;
      {
        const bf16_t* hp = sH + buf * 64 * SH_STRIDE + pcol * SH_STRIDE + 8 * hh;
#pragma unroll
        for (int kk = 0; kk < 8; ++kk) acc = __builtin_amdgcn_mfma_f32_32x32x16_bf16(cfr[kk], *(const bf16x8*)(hp + 16 * kk), acc, 0, 0, 0);
      }
#pragma unroll
      for (int qd = 0; qd < 4; ++qd) {
        f32x4 ec = *(const f32x4*)(myW + 128 + 32 * it + 8 * qd + 4 * hh);
        acc[4 * qd] *= ec.x; acc[4 * qd + 1] *= ec.y; acc[4 * qd + 2] *= ec.z; acc[4 * qd + 3] *= ec.w;
      }
      const int icol = 32 * it + r;
      const float ci_ = myW[64 + icol];
#pragma unroll
      for (int jt = 0; jt < 2; ++jt) {
        const bool needed = jt == 0 ? need0 : need1;
        if (needed) {
          f32x16 X;
#pragma unroll
          for (int e = 0; e < 16; ++e) X[e] = 0.f;
#pragma unroll
          for (int kk = 0; kk < 8; ++kk) X = __builtin_amdgcn_mfma_f32_32x32x16_bf16(bfr[jt][kk], cfr[kk], X, 0, 0, 0);
#pragma unroll
          for (int qd = 0; qd < 4; ++qd) {
            const int j0 = 32 * jt + 8 * qd + 4 * hh;
            f32x4 cj = *(const f32x4*)(myW + 64 + j0), dj = *(const f32x4*)(myW + j0);
            float cjv[4] = {cj.x, cj.y, cj.z, cj.w}, djv[4] = {dj.x, dj.y, dj.z, dj.w};
#pragma unroll
            for (int u = 0; u < 4; ++u) {
              const int j = j0 + u;
              const bool ok = dir == 0 ? (j <= icol) : (j >= icol);
              const float m = __expf(ci_ - cjv[u]) * djv[u];
              X[4 * qd + u] = ok ? X[4 * qd + u] * m : 0.f;
            }
          }
#pragma unroll
          for (int sk = 0; sk < 2; ++sk) {
            bf16x8 afr = pack8(X[8 * sk], X[8 * sk + 1], X[8 * sk + 2], X[8 * sk + 3], X[8 * sk + 4], X[8 * sk + 5], X[8 * sk + 6], X[8 * sk + 7]);
            const bf16_t* xp = sXr + pcol * 72 + 32 * jt + 16 * sk + 4 * hh;
            u32x2 lo = *(const u32x2*)xp, hi = *(const u32x2*)(xp + 8);
            u32x4 xv; xv.x = lo.x; xv.y = lo.y; xv.z = hi.x; xv.w = hi.y;
            acc = __builtin_amdgcn_mfma_f32_32x32x16_bf16(afr, __builtin_bit_cast(bf16x8, xv), acc, 0, 0, 0);
          }
        }
      }
      SCAN_LOAD_CB(ptokN);
      {
        bf16_t* yo = sY + (32 * it) * 72 + pcol;
#pragma unroll
        for (int e = 0; e < 16; ++e) yo[rowmap(e, hh) * 72] = f2bf(acc[e]);
      }
      SCAN_LOAD_BT(ptokN);
    }
    __syncthreads();
    {
      const int ptokP = SCAN_PTOK(nchunks - 1);
#pragma unroll
      for (int i = 0; i < 2; ++i) {
        const int q = tid + i * 256, yrow = q >> 3, c8 = (q & 7) * 8;
        *(u32x4*)(ybuf + ((size_t)dir * T_ALL + ptokP + yrow) * 2048 + h * 64 + c8) = *(const u32x4*)(sY + yrow * 72 + c8);
      }
    }
#undef SCAN_PTOK
#undef SCAN_LOAD_DTX
#undef SCAN_LOAD_CB
#undef SCAN_LOAD_BT
    if (s < 32) {
      float* ho = p.out_ssd + ((((size_t)s * 2 + slot) * 2 + dir) * 32 + h) * 8192 + (size_t)pcol * 128;
#pragma unroll
      for (int t2 = 0; t2 < 2; ++t2)
#pragma unroll
        for (int qd = 0; qd < 4; ++qd) {
          f32x4 v; v.x = hacc[t2][4 * qd]; v.y = hacc[t2][4 * qd + 1]; v.z = hacc[t2][4 * qd + 2]; v.w = hacc[t2][4 * qd + 3];
          *(f32x4*)(ho + 32 * (2 * it + t2) + 8 * qd + 4 * hh) = v;
        }
    }
    __syncthreads();
  }
}

__device__ __forceinline__ void phase_ssd_gate(const Params& p, int slot, int bid, int nblk, int cxw) {
  const int tidx = opaque_tid(cxw);
  bf16_t* zb = (bf16_t*)(p.scratch + SC_SSD_Z);
  const bf16_t* yfb = (const bf16_t*)(p.scratch + SC_SSD_XBC);
  const bf16_t* ybb = yfb + (size_t)T_ALL * 2048;
  const bf16_t* xbcc = (const bf16_t*)(p.scratch + SC_SSD_XBCC);
  int lane = tidx & 63, wv = cxw & 3;
  for (int row = bid * 4 + wv; row < T_ALL; row += nblk * 4) {
    float ss = 0.f;
    TokInfo ti = tokinfo(row);
    const int prow = ti.base + seqpos2off(ti.l, slot == 1 && ti.s >= 32);
#pragma unroll
    for (int j = 0; j < 4; ++j) {
      int c0 = j * 512 + lane * 8;
      u32x4 zv = *(const u32x4*)(zb + (size_t)row * 2048 + c0);
      u32x4 fv = *(const u32x4*)(yfb + (size_t)prow * 2048 + c0);
      u32x4 bv = *(const u32x4*)(ybb + (size_t)prow * 2048 + c0);
      u32x4 xv = *(const u32x4*)(xbcc + (size_t)prow * 2048 + c0);
      float dsk = p.ssd_d[slot * 32 + (c0 >> 6)];
      unsigned zw[4] = {zv.x, zv.y, zv.z, zv.w}, fw[4] = {fv.x, fv.y, fv.z, fv.w}, bw[4] = {bv.x, bv.y, bv.z, bv.w}, xw[4] = {xv.x, xv.y, xv.z, xv.w};
      unsigned ow[4];
#pragma unroll
      for (int e = 0; e < 4; ++e) {
        float y0 = (bflo(fw[e]) + bflo(bw[e]) + dsk * bflo(xw[e])) * siluf(bflo(zw[e]));
        float y1 = (bfhi(fw[e]) + bfhi(bw[e]) + dsk * bfhi(xw[e])) * siluf(bfhi(zw[e]));
        ss += y0 * y0 + y1 * y1;
        ow[e] = pack2(y0, y1);
      }
      u32x4 o; o.x = ow[0]; o.y = ow[1]; o.z = ow[2]; o.w = ow[3];
      *(u32x4*)(zb + (size_t)row * 2048 + c0) = o;
    }
#pragma unroll
    for (int o = 32; o > 0; o >>= 1) ss += shfl_xor_f(ss, o, lane);
    if (lane == 0) p.rstd[row] = rsqrtf(ss * (1.f / 2048.f) + 1e-5f);
  }
}

#define HY_UOFF 32768
__device__ __forceinline__ void hy_stage_conv(const Params& p, const bf16_t* __restrict__ row, int ch, bf16_t* dst, int dstStride, int dstPad,
                                              int nelem, int L, int tid) {
  const float w0 = p.hy_conv_w[ch], w1 = p.hy_conv_w[3072 + ch], w2 = p.hy_conv_w[2 * 3072 + ch], bb = p.hy_conv_b[ch];
  for (int q = tid; q < nelem / 8; q += NTHR) {
    const int e0 = q * 8, b = e0 / L, t0 = e0 & (L - 1);
    u32x4 raw = *(const u32x4*)(row + e0);
    float x[10];
    x[0] = t0 > 0 ? bf2f(row[e0 - 1]) : 0.f;
    x[9] = t0 + 8 < L ? bf2f(row[e0 + 8]) : 0.f;
    x[1] = bflo(raw.x); x[2] = bfhi(raw.x); x[3] = bflo(raw.y); x[4] = bfhi(raw.y);
    x[5] = bflo(raw.z); x[6] = bfhi(raw.z); x[7] = bflo(raw.w); x[8] = bfhi(raw.w);
    float o[8];
#pragma unroll
    for (int j = 0; j < 8; ++j) o[j] = w0 * x[j] + w1 * x[j + 1] + w2 * x[j + 2] + bb;
    u32x4 ov; ov.x = pack2(o[0], o[1]); ov.y = pack2(o[2], o[3]); ov.z = pack2(o[4], o[5]); ov.w = pack2(o[6], o[7]);
    *(u32x4*)(dst + b * dstStride + dstPad + t0) = ov;
  }
}

__device__ __forceinline__ void phase_hy_longconv(const Params& p, int bid, int nblk, unsigned char* smem, int cxw) {
  const int tid = opaque_tid(cxw), lane = tid & 63, w = cxw & 3  , r = lane & 31, hh = lane >> 5;
  const bf16_t* projT = (const bf16_t*)(p.scratch + SC_HY_PROJT);
  bf16_t* yT = (bf16_t*)(p.scratch + SC_HY_YT);
  unsigned* Rc0 = (unsigned*)smem;
  unsigned* Rc1 = Rc0 + 4096;
  bf16_t* G = (bf16_t*)smem;
  bf16_t* U = (bf16_t*)(smem + HY_UOFF);
  for (int item = bid; item < 2048; item += nblk) {
    const bool lat = item < 1024;
    const int c = item & 1023;
    const int L = lat ? 4096 : 256, NB = lat ? 4 : 32, RL = lat ? 8192 : 512, Lm1 = L - 1;
    const int PAD = lat ? 224 : 0, US = lat ? 4552 : 264;
    const int tokbase = lat ? T_CTX : 0;
    const int nI = L >> 5, nelem = NB * L;
    const int TPW = lat ? 4 : 2;
    __syncthreads();
    if (lat) {
      for (int q = tid; q < 4 * 57; q += NTHR) {
        int b = q / 57, k = q % 57;
        int off = k < 28 ? k * 8 : 224 + 4096 + (k - 28) * 8;
        unsigned zz = 0u; asm volatile("" : "+v"(zz));
        u32x4 z4 = {zz, zz, zz, zz};
        *(u32x4*)(U + b * US + off) = z4;
      }
    }
    hy_stage_conv(p, projT + (size_t)c * T_ALL + tokbase, c, U, US, PAD, nelem, L, tid);
    int Icol[4], bcol[4];
#pragma unroll
    for (int tt = 0; tt < 4; ++tt) {
      int n = (w * TPW + tt) * 32 + r;
      Icol[tt] = lat ? (n >> 2) : (n >> 5);
      bcol[tt] = lat ? (n & 3) : (n & 31);
    }
    const int Ilo_w = lat ? 32 * w : 2 * w, Ihi_w = lat ? 32 * w + 31 : 2 * w + 1;
    const int dlo = Ilo_w - (nI - 1), dhi = Ihi_w;
    for (int order = 0; order < 2; ++order) {
      {
        const bf16_t* src = (lat ? p.rtab1 : p.rtab0) + (size_t)(order * 1024 + c) * RL;
        for (int q = tid; q < RL / 8; q += NTHR) {
          u32x4 cv = *(const u32x4*)(src + q * 8);
          unsigned nx = (q + 1 < RL / 8) ? *(const unsigned*)(src + q * 8 + 8) : 0u;
          *(u32x4*)(Rc0 + q * 4) = cv;
          u32x4 sv;
          sv.x = (cv.x >> 16) | (cv.y << 16); sv.y = (cv.y >> 16) | (cv.z << 16);
          sv.z = (cv.z >> 16) | (cv.w << 16); sv.w = (cv.w >> 16) | (nx << 16);
          *(u32x4*)(Rc1 + q * 4) = sv;
        }
      }
      __syncthreads();
      f32x16 acc[4];
#pragma unroll
      for (int tt = 0; tt < 4; ++tt)
#pragma unroll
        for (int e = 0; e < 16; ++e) acc[tt][e] = 0.f;
      {
        int lo_t[4], hi_t[4];
        const bf16_t* ub[4];
#pragma unroll
        for (int tt = 0; tt < 4; ++tt) {
          const int tile = w * TPW + tt;
          const int Ilo_t = lat ? 8 * tile : tile, Ihi_t = lat ? 8 * tile + 7 : tile;
          lo_t[tt] = tt < TPW ? Ilo_t - (nI - 1) : 1 << 30; hi_t[tt] = tt < TPW ? Ihi_t : -(1 << 30);
          ub[tt] = U + bcol[tt] * US + PAD + 32 * Icol[tt] + 8 * hh;
        }
        const int ybase = Lm1 - r + 8 * hh;
#define LC_EDGE(D0, D1) do { for (int d_ = (D0); d_ <= (D1); ++d_) { \
          _Pragma("unroll") for (int kk_ = 0; kk_ < 2; ++kk_) { \
            const int y0_ = ybase - 32 * d_ + 16 * kk_; const int par_ = y0_ & 1; \
            const unsigned* rp_ = (par_ ? Rc1 : Rc0) + ((y0_ - par_) >> 1); \
            u32x4 av_; av_.x = rp_[0]; av_.y = rp_[1]; av_.z = rp_[2]; av_.w = rp_[3]; const bf16x8 af_ = __builtin_bit_cast(bf16x8, av_); \
            _Pragma("unroll") for (int tt = 0; tt < 4; ++tt) if (d_ >= lo_t[tt] && d_ <= hi_t[tt]) \
              acc[tt] = __builtin_amdgcn_mfma_f32_32x32x16_bf16(af_, *(const bf16x8*)(ub[tt] - 32 * d_ + 16 * kk_), acc[tt], 0, 0, 0); } } } while (0)
        if (!lat) {
          LC_EDGE(dlo, dhi);
        } else {
          const int mlo = lo_t[3], mhi = hi_t[0];
          LC_EDGE(dlo, mlo - 1);
#define LC_LOAD(IT, A, B) do { const int it_ = (IT); const int d_ = mlo + (it_ >> 1), kk_ = it_ & 1; \
          const int y0_ = ybase - 32 * d_ + 16 * kk_; const int par_ = y0_ & 1; \
          const unsigned* rp_ = (par_ ? Rc1 : Rc0) + ((y0_ - par_) >> 1); \
          u32x4 av_; av_.x = rp_[0]; av_.y = rp_[1]; av_.z = rp_[2]; av_.w = rp_[3]; A = __builtin_bit_cast(bf16x8, av_); \
          _Pragma("unroll") for (int tt = 0; tt < 4; ++tt) B[tt] = *(const bf16x8*)(ub[tt] - 32 * d_ + 16 * kk_); } while (0)
#define LC_MMA(A, B) do { _Pragma("unroll") for (int tt = 0; tt < 4; ++tt) acc[tt] = __builtin_amdgcn_mfma_f32_32x32x16_bf16(A, B[tt], acc[tt], 0, 0, 0); } while (0)
          const int NIT = 2 * (mhi - mlo + 1);
          bf16x8 a0, a1, b0[4], b1[4];
          LC_LOAD(0, a0, b0);
          for (int it = 0; it < NIT; it += 2) {
            LC_LOAD(it + 1, a1, b1);
            LC_MMA(a0, b0);
            LC_LOAD(it + 2 < NIT ? it + 2 : NIT - 1, a0, b0);
            LC_MMA(a1, b1);
          }
#undef LC_LOAD
#undef LC_MMA
          LC_EDGE(mhi + 1, dhi);
        }
#undef LC_EDGE
      }
      __syncthreads();
      hy_stage_conv(p, projT + (size_t)((1 + order) * 1024 + c) * T_ALL + tokbase, (1 + order) * 1024 + c, G, L, 0, nelem, L, tid);
      __syncthreads();
      const float inv = 1.f / p.knorm[((lat ? 1 : 0) * 2 + order) * 1024 + c];
      const float bias = p.hy_f_bias[order * 1024 + c];
#pragma unroll
      for (int tt = 0; tt < 4; ++tt) {
        if (tt < TPW) {
#pragma unroll
          for (int qd = 0; qd < 4; ++qd) {
            const int t0 = 32 * Icol[tt] + 8 * qd + 4 * hh;
            bf16_t* up = U + bcol[tt] * US + PAD + t0;
            u32x2 uc = *(const u32x2*)up;
            u32x2 gg = *(const u32x2*)(G + bcol[tt] * L + t0);
            float r0 = (inv * acc[tt][4 * qd] + bias * bflo(uc.x)) * bflo(gg.x);
            float r1 = (inv * acc[tt][4 * qd + 1] + bias * bfhi(uc.x)) * bfhi(gg.x);
            float r2 = (inv * acc[tt][4 * qd + 2] + bias * bflo(uc.y)) * bflo(gg.y);
            float r3 = (inv * acc[tt][4 * qd + 3] + bias * bfhi(uc.y)) * bfhi(gg.y);
            if (order == 1) {
              u32x2 zz = *(const u32x2*)(projT + (size_t)(3072 + c) * T_ALL + tokbase + bcol[tt] * L + t0);
              r0 *= siluf(bflo(zz.x)); r1 *= siluf(bfhi(zz.x)); r2 *= siluf(bflo(zz.y)); r3 *= siluf(bfhi(zz.y));
            }
            u32x2 ov; ov.x = pack2(r0, r1); ov.y = pack2(r2, r3);
            *(u32x2*)up = ov;
          }
        }
      }
      __syncthreads();
    }
    for (int q = tid; q < nelem / 8; q += NTHR) {
      const int e0 = q * 8, b = e0 / L, t0 = e0 & (L - 1);
      *(u32x4*)(yT + (size_t)c * T_ALL + tokbase + e0) = *(const u32x4*)(U + b * US + PAD + t0);
    }
  }
}

__device__ __forceinline__ void phase_hy_transpose(const Params& p, int bid, int nblk, unsigned char* smem, int cxw) {
  const int tid = opaque_tid(cxw);
  const bf16_t* yT = (const bf16_t*)(p.scratch + SC_HY_YT);
  bf16_t* yg = (bf16_t*)(p.scratch + SC_HY_YG);
  bf16_t* tl = (bf16_t*)smem;
  for (int item = bid; item < 16 * (T_ALL / 64); item += nblk) {
    const int cb = item & 15, tb = item >> 4;
    __syncthreads();
#pragma unroll
    for (int i = 0; i < 2; ++i) {
      int q = tid + i * 256, cr = q >> 3, t8 = (q & 7) * 8;
      u32x4 v = *(const u32x4*)(yT + (size_t)(cb * 64 + cr) * T_ALL + tb * 64 + t8);
      unsigned wv[4] = {v.x, v.y, v.z, v.w};
#pragma unroll
      for (int e = 0; e < 4; ++e) {
        tl[(t8 + 2 * e) * 72 + cr] = (bf16_t)(wv[e] & 0xffffu);
        tl[(t8 + 2 * e + 1) * 72 + cr] = (bf16_t)(wv[e] >> 16);
      }
    }
    __syncthreads();
#pragma unroll
    for (int i = 0; i < 2; ++i) {
      int q = tid + i * 256, tr = q >> 3, c8 = (q & 7) * 8;
      *(u32x4*)(yg + (size_t)(tb * 64 + tr) * 1024 + cb * 64 + c8) = *(const u32x4*)(tl + tr * 72 + c8);
    }
  }
}

#define LRU_NCH 384
struct LruStep { float af, bxf, ab, bxb; };
__device__ __forceinline__ LruStep lru_step(const bf16_t* gates, const bf16_t* xc, int tok, int c, float spf, float spb) {
  const size_t o = (size_t)tok * 1024 + c;
  const float rf = bf2f(gates[o]), if_ = bf2f(gates[(size_t)T_ALL * 1024 + o]);
  const float rb = bf2f(gates[(size_t)2 * T_ALL * 1024 + o]), ib = bf2f(gates[(size_t)3 * T_ALL * 1024 + o]);
  const float x = bf2f(xc[o]);
  LruStep st;
  const float laf = -8.f * rf * spf, lab = -8.f * rb * spb;
  st.af = __expf(laf); st.ab = __expf(lab);
  st.bxf = sqrtf(fmaxf(1.f - __expf(2.f * laf), 0.f)) * if_ * x;
  st.bxb = sqrtf(fmaxf(1.f - __expf(2.f * lab), 0.f)) * ib * x;
  return st;
}
__device__ __forceinline__ void phase_lru_scan_agg(const Params& p, int bid, int nblk, int cxw) {
  const int tidx = opaque_tid(cxw);
  const bf16_t* gates = (const bf16_t*)(p.scratch + SC_LRU_GATES);
  const bf16_t* xc = (const bf16_t*)(p.scratch + SC_LRU_XC);
  for (int item = bid; item < LRU_NCH * 4; item += nblk) {
    const int chunk = item >> 2, cb = item & 3;
    const int c = cb * 256 + tidx;
    const float spf = softplusf(-p.lru_a_param[c]), spb = softplusf(-p.lru_a_param[1024 + c]);
    const int tok0 = chunk * 64;
    float Af = 1.f, hf = 0.f, Pb = 1.f, Bb = 0.f;
#pragma unroll 8
    for (int j = 0; j < 64; ++j) {
      const LruStep st = lru_step(gates, xc, tok0 + j, c, spf, spb);
      hf = st.af * hf + st.bxf; Af *= st.af;
      Bb += st.bxb * Pb; Pb *= st.ab;
    }
    float* agf = p.lru_agg + (((size_t)0 * LRU_NCH + chunk) * 1024 + c) * 2;
    float* agb = p.lru_agg + (((size_t)1 * LRU_NCH + chunk) * 1024 + c) * 2;
    agf[0] = Af; agf[1] = hf; agb[0] = Pb; agb[1] = Bb;
  }
}
__device__ __forceinline__ void phase_lru_scan_carry(const Params& p, int bid, int nblk, int cxw) {
  const int tidx = opaque_tid(cxw);
  for (int item = bid; item < 36 * 8; item += nblk) {
    int s = item >> 3, dir = (item >> 2) & 1, cb = item & 3;
    int c = cb * 256 + tidx;
    int nch = s < 32 ? 4 : 64;
    int ch0 = s < 32 ? s * 4 : 128 + (s - 32) * 64;
    float h = s < 32 ? 0.f : p.state_lru[((size_t)(s - 32) * 2 + dir) * 1024 + c];
    for (int k = 0; k < nch; ++k) {
      int chunk = dir ? ch0 + nch - 1 - k : ch0 + k;
      size_t idx = ((size_t)dir * LRU_NCH + chunk) * 1024 + c;
      p.lru_hin[idx] = h;
      h = p.lru_agg[idx * 2] * h + p.lru_agg[idx * 2 + 1];
    }
    if (s < 32) p.out_lru[((size_t)s * 2 + dir) * 1024 + c] = h;
  }
}
__device__ __forceinline__ void phase_lru_scan_final(const Params& p, int bid, int nblk, unsigned char* smem, int cxw) {
  const int tidx = opaque_tid(cxw);
  const bf16_t* gates = (const bf16_t*)(p.scratch + SC_LRU_GATES);
  const bf16_t* xc = (const bf16_t*)(p.scratch + SC_LRU_XC);
  const bf16_t* proj = (const bf16_t*)(p.scratch + SC_LRU_PROJ);
  bf16_t* yg = (bf16_t*)(p.scratch + SC_LRU_YG);
  float* shf = (float*)smem;
  for (int item = bid; item < LRU_NCH * 4; item += nblk) {
    const int chunk = item >> 2, cb = item & 3;
    const int c = cb * 256 + tidx;
    const float spf = softplusf(-p.lru_a_param[c]), spb = softplusf(-p.lru_a_param[1024 + c]);
    const int tok0 = chunk * 64;
    float hf = p.lru_hin[((size_t)0 * LRU_NCH + chunk) * 1024 + c];
    float hb = p.lru_hin[((size_t)1 * LRU_NCH + chunk) * 1024 + c];
#pragma unroll 8
    for (int j = 0; j < 64; ++j) {
      const size_t o = (size_t)(tok0 + j) * 1024 + c;
      const float rf = bf2f(gates[o]), if_ = bf2f(gates[(size_t)T_ALL * 1024 + o]);
      const float x = bf2f(xc[o]);
      const float laf = -8.f * rf * spf;
      hf = __expf(laf) * hf + sqrtf(fmaxf(1.f - __expf(2.f * laf), 0.f)) * if_ * x;
      shf[j * 256 + tidx] = hf;
    }
#pragma unroll 8
    for (int j = 63; j >= 0; --j) {
      const size_t o = (size_t)(tok0 + j) * 1024 + c;
      const float rb = bf2f(gates[(size_t)2 * T_ALL * 1024 + o]), ib = bf2f(gates[(size_t)3 * T_ALL * 1024 + o]);
      const float x = bf2f(xc[o]);
      const float z = bf2f(proj[(size_t)(tok0 + j) * 2048 + 1024 + c]);
      const float lab = -8.f * rb * spb;
      hb = __expf(lab) * hb + sqrtf(fmaxf(1.f - __expf(2.f * lab), 0.f)) * ib * x;
      yg[o] = f2bf((shf[j * 256 + tidx] + hb) * siluf(z));
    }
  }
}

enum { PH_PREP = 0, PH_MOD, PH_HYA, PH_HYB, PH_LNMOD, PH_INPROJ, PH_MIX1, PH_MIX2, PH_MIX3, PH_MIX4, PH_MIX5, PH_MIX6, PH_OUTPROJ };

struct Ctx { int bid, nblk, wave; unsigned char* smem; unsigned char* wg_smem; };

template <class Epi>
__device__ __forceinline__ void run_gemm(const Ctx& cx, const bf16_t* A, int lda, const bf16_t* Bt, int M, int N, int K, int grp_shift, int grp_bytes, const Epi& e) {
  pg8::Gemm g{A, Bt, M, N, K, lda, grp_shift, grp_bytes};
  pg8::StaticOrder S; S.init(M, N, gridDim.x, opaque_s(blockIdx.x));
  pg8::gemm_phase((PG8_LAS unsigned char*)cx.wg_smem, g, S, e, cx.wave);
}

#define N_PARAM_WORDS (sizeof(Params) / 8)
__device__ __forceinline__ Params load_params(const unsigned char* lp) {
  Params p;
  unsigned long long* d = (unsigned long long*)&p;
  const unsigned long long* sp = (const unsigned long long*)lp;
#pragma unroll
  for (int i = 0; i < (int)N_PARAM_WORDS; ++i) {
    const unsigned long long v = sp[i];
    const unsigned lo = __builtin_amdgcn_readfirstlane((unsigned)v), hi = __builtin_amdgcn_readfirstlane((unsigned)(v >> 32));
    d[i] = ((unsigned long long)hi << 32) | lo;
  }
  return p;
}
__device__ __forceinline__ void run_phase(const unsigned char* lparams, int ph, int layer, const Ctx& cx) {
  const Params p = load_params(lparams);
  const int kind = layer % 3, slot = layer / 3;
  const int bid = opaque_s(cx.bid), nblk = cx.nblk;
  unsigned char* smem = cx.smem;
  switch (ph) {
    case PH_PREP: phase_prep(p, bid, nblk, smem, cx.wave); break;
    case PH_MOD: phase_mod(p, bid, nblk, smem, cx.wave); break;
    case PH_HYA: phase_hyfilt_a(p, bid, nblk, smem, cx.wave); break;
    case PH_HYB: phase_hyfilt_b(p, bid, nblk, smem, cx.wave); break;
    case PH_LNMOD: phase_lnmod(p, layer, bid, nblk, cx.wave); break;
    case PH_INPROJ:
      if (kind == 0) {
        pg8::EpiSsdIn e{(bf16_t*)(p.scratch + SC_SSD_Z), (bf16_t*)(p.scratch + SC_SSD_XBC), (float*)(p.scratch + SC_SSD_DT), p.ssd_dt_bias + slot * 64};
        run_gemm(cx, p.hbuf, 1024, p.wt_ssd_in + (size_t)slot * 6400 * 1024, T_ALL, 6400, 1024, 30, 0, e);
      } else if (kind == 1) {
        pg8::EpiBf16 e{(bf16_t*)(p.scratch + SC_HY_PROJT), (size_t)T_ALL};
        run_gemm(cx, p.wt_hy_in, 1024, p.hbuf, 4096, T_ALL, 1024, 30, 0, e);
      } else {
        pg8::EpiBf16 e{(bf16_t*)(p.scratch + SC_LRU_PROJ), (size_t)2048};
        run_gemm(cx, p.hbuf, 1024, p.wt_lru_in, T_ALL, 2048, 1024, 30, 0, e);
      }
      break;
    case PH_MIX1:
      if (kind == 0) phase_ssd_conv(p, slot, slot == 1, bid, nblk, smem, cx.wave);
      else if (kind == 1) phase_hy_longconv(p, bid, nblk, smem, cx.wave);
      else phase_dwconv<4, false>((const bf16_t*)(p.scratch + SC_LRU_PROJ), 2048, (bf16_t*)(p.scratch + SC_LRU_XC), 1024, 1024,
                                  p.lru_conv_w, p.lru_conv_b, false, bid, nblk, cx.wave);
      break;
    case PH_MIX2:
      if (kind == 0) phase_ssd_scan(p, slot, slot == 1, bid, nblk, smem, cx.wave);
      else if (kind == 1) phase_hy_transpose(p, bid, nblk, smem, cx.wave);
      else {
        pg8::EpiLruGate e{(bf16_t*)(p.scratch + SC_LRU_GATES), p.lru_gate_b};
        run_gemm(cx, (const bf16_t*)(p.scratch + SC_LRU_XC), 1024, p.wt_lru_gate, T_ALL, 4096, 256, 2, 512, e);
      }
      break;
    case PH_MIX3:
      if (kind == 0) phase_ssd_gate(p, slot, bid, nblk, cx.wave);
      else phase_lru_scan_agg(p, bid, nblk, cx.wave);
      break;
    case PH_MIX4: if (kind == 2) phase_lru_scan_carry(p, bid, nblk, cx.wave); break;
    case PH_MIX5: if (kind == 2) phase_lru_scan_final(p, bid, nblk, smem, cx.wave); break;
    case PH_OUTPROJ: {
      const float* mv = p.modv + (size_t)layer * 5 * 3072;
      if (kind == 0) {
        pg8::EpiOut e{p.xres, mv, p.rstd};
        run_gemm(cx, (const bf16_t*)(p.scratch + SC_SSD_Z), 2048, p.wt_ssd_out + (size_t)slot * 1024 * 2048, T_ALL, 1024, 2048, 30, 0, e);
      } else if (kind == 1) {
        pg8::EpiOut e{p.xres, mv, nullptr};
        run_gemm(cx, (const bf16_t*)(p.scratch + SC_HY_YG), 1024, p.wt_hy_out, T_ALL, 1024, 1024, 30, 0, e);
      } else {
        pg8::EpiOut e{p.xres, mv, nullptr};
        run_gemm(cx, (const bf16_t*)(p.scratch + SC_LRU_YG), 1024, p.wt_lru_out, T_ALL, 1024, 1024, 30, 0, e);
      }
    } break;
  }
}

__global__ void __launch_bounds__(WG_THREADS, 2) k_mega(Params p) {
  __shared__ __attribute__((aligned(16))) unsigned char smem[WG_SMEM + 16 + 512];
  cg::grid_group grid = cg::this_grid();
  const int wave0 = __builtin_amdgcn_readfirstlane((int)(threadIdx.x >> 6));
  const int vb = wave0 >> 2;
  Ctx cx;
  cx.wave = wave0;
  cx.bid = 2 * blockIdx.x + vb; cx.nblk = 2 * gridDim.x; cx.smem = smem + vb * SMEM_BYTES; cx.wg_smem = smem;
  volatile LAS unsigned* xst = (volatile LAS unsigned*)(smem + WG_SMEM);
  unsigned char* lparams = smem + WG_SMEM + 16;
  if (threadIdx.x == 0) { xst[0] = 0u; xst[1] = 0u; *(Params*)lparams = p; }
  __syncthreads();
  const XcdBarrier xb = xcd_barrier_post(p.bar, xst);
  run_phase(lparams, PH_PREP, 0, cx);
  run_phase(lparams, PH_MOD, 0, cx);
  run_phase(lparams, PH_HYA, 0, cx);
  grid.sync();
  run_phase(lparams, PH_HYB, 0, cx);
  for (int layer = 0; layer < 4; ++layer) {
    const int kind = layer % 3;
    run_phase(lparams, PH_LNMOD, layer, cx);
    xcd_barrier(xb, cx.wave);
    run_phase(lparams, PH_INPROJ, layer, cx);
    xcd_barrier(xb, cx.wave);
    run_phase(lparams, PH_MIX1, layer, cx);
    xcd_barrier(xb, cx.wave);
    run_phase(lparams, PH_MIX2, layer, cx);
    xcd_barrier(xb, cx.wave);
    if (kind != 1) {
      run_phase(lparams, PH_MIX3, layer, cx);
      xcd_barrier(xb, cx.wave);
    }
    if (kind == 2) {
      run_phase(lparams, PH_MIX4, layer, cx);
      xcd_barrier(xb, cx.wave);
      run_phase(lparams, PH_MIX5, layer, cx);
      xcd_barrier(xb, cx.wave);
    }
    run_phase(lparams, PH_OUTPROJ, layer, cx);
    xcd_barrier(xb, cx.wave);
  }
  run_phase(lparams, PH_LNMOD, 4, cx);
}

static inline size_t align_up(size_t x) { return (x + 255) & ~(size_t)255; }

extern "C" void kernel_launch(void* const* d_in, const int* in_sizes, int n_in, void* d_out, int out_size, void* d_ws, size_t ws_size,
                              hipStream_t stream) {
  Params p{};
  const float** fp = (const float**)&p;
  for (int i = 0; i < 36; ++i) fp[i] = (const float*)d_in[i];
  float* out = (float*)d_out;
  p.xres = out;
  p.out_ssd = out + (size_t)T_ALL * 1024;
  p.out_lru = p.out_ssd + (size_t)32 * 2 * 2 * 32 * 64 * 128;
  unsigned char* w = (unsigned char*)d_ws;
  size_t off = 0;
  auto carve = [&](size_t bytes) { unsigned char* r = w + off; off = align_up(off + bytes); return r; };
  p.wt_ssd_in = (bf16_t*)carve((size_t)2 * 6400 * 1024 * 2);
  p.wt_ssd_out = (bf16_t*)carve((size_t)2 * 1024 * 2048 * 2);
  p.wt_hy_in = (bf16_t*)carve((size_t)4096 * 1024 * 2);
  p.wt_hy_out = (bf16_t*)carve((size_t)1024 * 1024 * 2);
  p.wt_lru_in = (bf16_t*)carve((size_t)2048 * 1024 * 2);
  p.wt_lru_out = (bf16_t*)carve((size_t)1024 * 1024 * 2);
  p.wt_lru_gate = (bf16_t*)carve((size_t)4 * 1024 * 256 * 2);
  p.modv = (float*)carve((size_t)4 * 5 * 3072 * 4);
  p.hdn2 = (float*)carve((size_t)4352 * 64 * 4);
  p.rtab0 = (bf16_t*)carve((size_t)2 * 1024 * 512 * 2);
  p.rtab1 = (bf16_t*)carve((size_t)2 * 1024 * 8192 * 2);
  p.knorm = (float*)carve((size_t)4 * 1024 * 4);
  p.hbuf = (bf16_t*)carve((size_t)T_ALL * 1024 * 2);
  p.rstd = (float*)carve((size_t)T_ALL * 4);
  p.lru_agg = (float*)carve((size_t)2 * 384 * 1024 * 2 * 4);
  p.lru_hin = (float*)carve((size_t)2 * 384 * 1024 * 4);
  p.bar = (unsigned*)carve((size_t)XCD_BAR_WORDS * 4);
  p.scratch = carve(SC_TOTAL);
  if (off > ws_size) return;

  static int grid_blocks = 0;
  if (!grid_blocks) {
    int dev = 0, cus = 0, per_cu = 0;
    hipGetDevice(&dev);
    hipDeviceGetAttribute(&cus, hipDeviceAttributeMultiprocessorCount, dev);
    hipOccupancyMaxActiveBlocksPerMultiprocessor(&per_cu, k_mega, WG_THREADS, 0);
    if (per_cu > 1) per_cu = 1;
    grid_blocks = cus * per_cu;
  }
  hipMemsetAsync(p.bar, 0, (size_t)XCD_BAR_WORDS * 4, stream);
  void* args[] = {&p};
  hipError_t e = hipLaunchCooperativeKernel((void*)k_mega, dim3(grid_blocks), dim3(WG_THREADS), args, 0, stream);
  if (e != hipSuccess) fprintf(stderr, "cooperative launch failed: %s (grid %d)\n", hipGetErrorString(e), grid_blocks);
}
```

```cpp
#include <hip/hip_runtime.h>
#include <hip/hip_bf16.h>
#include <hip/hip_cooperative_groups.h>
#include <stdint.h>
#include <cstdio>
namespace cg = cooperative_groups;

typedef unsigned short bf16_t;
typedef __attribute__((ext_vector_type(8))) short bf16x8;
typedef __attribute__((ext_vector_type(16))) float f32x16;
typedef __attribute__((ext_vector_type(4))) unsigned int u32x4;
typedef __attribute__((ext_vector_type(2))) unsigned int u32x2;
typedef __attribute__((ext_vector_type(4))) float f32x4;
typedef float f32x4_t __attribute__((ext_vector_type(4)));
typedef float f32x2_t __attribute__((ext_vector_type(2)));

#define T_CTX 8192
#define T_ALL 24576
#define DM 1024
#define NTHR 256
#define SMEM_BYTES 69632
#define WG_THREADS 512
#define WG_SMEM (2 * SMEM_BYTES)
#define ALPHA_RES 1.6817928305074290f
#define LN_EPS 1e-5f

__device__ __forceinline__ bf16_t f2bf(float f) { __bf16 h = (__bf16)f; return __builtin_bit_cast(bf16_t, h); }
__device__ __forceinline__ float bf2f(bf16_t b) { return __uint_as_float(((unsigned)b) << 16); }
__device__ __forceinline__ float bflo(unsigned w) { return __uint_as_float(w << 16); }
__device__ __forceinline__ float bfhi(unsigned w) { return __uint_as_float(w & 0xffff0000u); }
typedef __bf16 bf16v2_t __attribute__((ext_vector_type(2)));
typedef float f32v2_t __attribute__((ext_vector_type(2)));
__device__ __forceinline__ unsigned pack2(float a, float b) { f32v2_t v = {a, b}; bf16v2_t h = __builtin_convertvector(v, bf16v2_t); return __builtin_bit_cast(unsigned, h); }
__device__ __forceinline__ float siluf(float x) { return x / (1.f + __expf(-x)); }
__device__ __forceinline__ float sigmoidf(float x) { return 1.f / (1.f + __expf(-x)); }
__device__ __forceinline__ float softplusf(float x) { return x > 20.f ? x : __logf(1.f + __expf(x)); }


__device__ __forceinline__ int opaque_lane() { int z = 0; asm volatile("" : "+v"(z)); return __builtin_amdgcn_mbcnt_hi(~0u, __builtin_amdgcn_mbcnt_lo(~0u, (unsigned)z)); }
__device__ __forceinline__ int opaque_tid512(int wave) { return (wave << 6) + opaque_lane(); }
__device__ __forceinline__ int opaque_tid(int wave) { return opaque_tid512(wave) & 255; }

#define XB_TMO      128
#define XB_XCNT(j)  (256  + 64 * (j))
#define XB_XSUB(j)  (1280 + 64 * (j))
#define XB_XGEN(j)  (2304 + 64 * (j))
#define XB_TOP      3328
#define XB_TOPGEN   3392
#define XCD_BAR_WORDS 3456
#define XB_SPIN_CAP (1u << 18)
#define LAS __attribute__((address_space(3)))
__device__ __forceinline__ unsigned xb_ld(unsigned* p)              { return __hip_atomic_load(p, __ATOMIC_RELAXED, __HIP_MEMORY_SCOPE_AGENT); }
__device__ __forceinline__ unsigned xb_add(unsigned* p, unsigned v) { return __hip_atomic_fetch_add(p, v, __ATOMIC_RELAXED, __HIP_MEMORY_SCOPE_AGENT); }
__device__ __forceinline__ unsigned xb_xcc_id() { return (unsigned)__builtin_amdgcn_s_getreg((3 << 11) | 20) & 0xFu; }
#define XB_SPIN(cond, bar) do { unsigned _sp = 0; while (cond) { __builtin_amdgcn_s_sleep(1); \
    if ((++_sp & 255u) == 0u) { if (xb_ld(&(bar)[XB_TMO])) break; if (_sp > XB_SPIN_CAP) { atomicAdd(&(bar)[XB_TMO], 1u); break; } } } } while (0)
struct XcdBarrier { unsigned* bar; unsigned x; volatile LAS unsigned* st; };
__device__ __forceinline__ XcdBarrier xcd_barrier_post(unsigned* bar, volatile LAS unsigned* st) {
  XcdBarrier b; b.bar = bar; b.x = xb_xcc_id(); b.st = st;
  if (threadIdx.x == 0) (void)xb_add(&bar[XB_XCNT(b.x)], 1u);
  return b;
}
__device__ __forceinline__ void xcd_barrier_complete(unsigned* bar, unsigned x, unsigned& nloc, unsigned& nx) {
  const unsigned G = gridDim.x * gridDim.y * gridDim.z;
  unsigned sum, cnt, mine, sp = 0u;
  for (;;) {
    sum = 0u; cnt = 0u; mine = 0u;
#pragma unroll
    for (unsigned j = 0; j < 16; ++j) { const unsigned c = xb_ld(&bar[XB_XCNT(j)]); sum += c; cnt += (c > 0u) ? 1u : 0u; mine = (j == x) ? c : mine; }
    if (sum == G) break;
    __builtin_amdgcn_s_sleep(1);
    if ((++sp & 255u) == 0u) { if (xb_ld(&bar[XB_TMO])) break; if (sp > XB_SPIN_CAP) { atomicAdd(&bar[XB_TMO], 1u); break; } }
  }
  nloc = mine > 0u ? mine : 1u; nx = cnt > 0u ? cnt : 1u;
}
__device__ __forceinline__ void xcd_barrier(const XcdBarrier& b, int wave) {
  asm volatile("s_waitcnt vmcnt(0)" ::: "memory");
  __syncthreads();
  if (opaque_tid512(wave) == 0) {
    unsigned* bar = b.bar;
    __builtin_amdgcn_s_waitcnt(0);
    unsigned nloc = b.st[0], nx = b.st[1];
    if (nloc == 0u) { xcd_barrier_complete(bar, b.x, nloc, nx); b.st[0] = nloc; b.st[1] = nx; }
    const unsigned old = xb_add(&bar[XB_XSUB(b.x)], 1u);
    const unsigned gen = old / nloc;
    if (old + 1u == (gen + 1u) * nloc) {
      __builtin_amdgcn_fence(__ATOMIC_RELEASE, "agent");
      asm volatile("s_waitcnt vmcnt(0)" ::: "memory");
      const unsigned og = xb_add(&bar[XB_TOP], 1u);
      const unsigned tg = og / nx;
      if (og + 1u == (tg + 1u) * nx) xb_add(&bar[XB_TOPGEN], 1u);
      else XB_SPIN(xb_ld(&bar[XB_TOPGEN]) == tg, bar);
      __builtin_amdgcn_fence(__ATOMIC_ACQUIRE, "agent");
      xb_add(&bar[XB_XGEN(b.x)], 1u);
      asm volatile("s_waitcnt vmcnt(0)" ::: "memory");
    } else {
      XB_SPIN(xb_ld(&bar[XB_XGEN(b.x)]) == gen, bar);
      __builtin_amdgcn_fence(__ATOMIC_ACQUIRE, "agent");
      asm volatile("s_waitcnt vmcnt(0)" ::: "memory");
    }
  }
  __syncthreads();
}


__device__ __forceinline__ int opaque_s(int x) { asm volatile("" : "+s"(x)); return x; }

__device__ __forceinline__ float shfl_idx_f(float v, int src) { return __int_as_float(__builtin_amdgcn_ds_bpermute(src << 2, __float_as_int(v))); }
__device__ __forceinline__ float shfl_xor_f(float v, int off, int lane) { return shfl_idx_f(v, lane ^ off); }

__device__ __forceinline__ float wave_incl_scan(float v) {
#define DPP_ADD(ctrl, rmask) v += __int_as_float(__builtin_amdgcn_update_dpp(0, __float_as_int(v), ctrl, rmask, 0xf, false))
  DPP_ADD(0x111, 0xf); DPP_ADD(0x112, 0xf); DPP_ADD(0x114, 0xf); DPP_ADD(0x118, 0xf);
  DPP_ADD(0x142, 0xa); DPP_ADD(0x143, 0xc);
#undef DPP_ADD
  return v;
}

struct TokInfo { int s, l, L, base, mrow; };
__device__ __forceinline__ TokInfo tokinfo(int tok) {
  TokInfo t;
  if (tok < T_CTX) { t.s = tok >> 8; t.l = tok & 255; t.L = 256; t.base = tok & ~255; t.mrow = 0; }
  else { int u = tok - T_CTX; t.s = 32 + (u >> 12); t.l = u & 4095; t.L = 4096; t.base = T_CTX + (u & ~4095); t.mrow = 1 + (u >> 12); }
  return t;
}
__device__ __forceinline__ int seqpos2off(int pos, bool cm) { return cm ? (((pos & 63) << 6) | (pos >> 6)) : pos; }

struct Params {
  const float *x_prompt, *x_sample, *state_ssd, *state_lru, *c, *c_ctx, *mod_w, *mod_b, *ln_g, *ln_b;
  const float *ssd_in_w, *ssd_conv_w, *ssd_conv_b, *ssd_dt_bias, *ssd_a_log, *ssd_d, *ssd_norm_g, *ssd_out_w;
  const float *hy_in_w, *hy_conv_w, *hy_conv_b, *hy_f_w1, *hy_f_b1, *hy_f_w2, *hy_f_b2, *hy_f_w3, *hy_f_freq, *hy_f_bias, *hy_out_w;
  const float *lru_in_w, *lru_conv_w, *lru_conv_b, *lru_gate_w, *lru_gate_b, *lru_a_param, *lru_out_w;
  float *xres, *out_ssd, *out_lru;
  bf16_t *wt_ssd_in, *wt_ssd_out, *wt_hy_in, *wt_hy_out, *wt_lru_in, *wt_lru_out, *wt_lru_gate;
  float *modv;
  float *hdn2;
  bf16_t *rtab0;
  bf16_t *rtab1;
  float *knorm;
  bf16_t *hbuf;
  float *rstd;
  float *lru_agg;
  float *lru_hin;
  float *lru_sagg;
  unsigned char *scratch;
  unsigned *bar;
};

#define SC_SSD_Z     ((size_t)0)
#define SC_SSD_XBC   ((size_t)T_ALL * 2048 * 2)
#define SC_SSD_XBCC  (SC_SSD_XBC + (size_t)T_ALL * 4096 * 2)
#define SC_SSD_DT    (SC_SSD_XBCC + (size_t)T_ALL * 2048 * 2)
#define SC_SSD_XT    (SC_SSD_DT + (size_t)T_ALL * 64 * 4)
#define SC_SSD_BT    (SC_SSD_XT + (size_t)T_ALL * 2048 * 2)
#define SC_SSD_BF    (SC_SSD_BT + (size_t)T_ALL * 1024 * 2)
#define SC_SSD_CF    (SC_SSD_BF + (size_t)T_ALL * 1024 * 2)
#define SC_SSD_END   (SC_SSD_CF + (size_t)T_ALL * 1024 * 2)
#define SC_HY_PROJT  ((size_t)0)
#define SC_HY_YT     ((size_t)T_ALL * 4096 * 2)
#define SC_HY_YG     (SC_HY_YT + (size_t)T_ALL * 1024 * 2)
#define SC_LRU_PROJ  ((size_t)0)
#define SC_LRU_XC    ((size_t)T_ALL * 2048 * 2)
#define SC_LRU_GATES (SC_LRU_XC + (size_t)T_ALL * 1024 * 2)
#define SC_LRU_Y     (SC_LRU_GATES + (size_t)T_ALL * 4096 * 2)
#define SC_LRU_YG    (SC_LRU_Y + (size_t)T_ALL * 2048 * 2)
#define SC_TOTAL     SC_SSD_END

__device__ __forceinline__ void transpose_tile(const float* __restrict__ src, int ld_src, int n_src, bf16_t* __restrict__ dst, int K,
                               const float* __restrict__ scale, int tile, int tiles_k, float* tl, int cxw) {
  const int tidx = opaque_tid(cxw);
  int tk = tile % tiles_k, tn = tile / tiles_k;
  int k0 = tk * 64, n0 = tn * 64;
  int tx = tidx & 63, ty = tidx >> 6;
  __syncthreads();
  for (int r = ty; r < 64; r += 4) {
    int n = n0 + tx;
    float v = 0.f;
    if (n < n_src) { v = src[(size_t)(k0 + r) * ld_src + n]; if (scale) v *= scale[k0 + r]; }
    tl[r * 65 + tx] = v;
  }
  __syncthreads();
  for (int r = ty; r < 64; r += 4) dst[(size_t)(n0 + r) * K + k0 + tx] = f2bf(tl[tx * 65 + r]);
}

__device__ __forceinline__ void phase_prep(const Params& p, int bid, int nblk, unsigned char* smem, int cxw) {
  const int tidx = opaque_tid(cxw);
  float* tl = (float*)smem;
  for (int job = 0; job < 24; ++job) {
    const float* src; int ld, nsrc, K, npad; bf16_t* dst; const float* scale = nullptr;
    if (job < 2) { src = p.ssd_in_w + (size_t)job * 1024 * 6208; ld = 6208; nsrc = 6208; K = 1024; npad = 6400; dst = p.wt_ssd_in + (size_t)job * 6400 * 1024; }
    else if (job < 4) { int s = job - 2; src = p.ssd_out_w + (size_t)s * 2048 * 1024; ld = 1024; nsrc = 1024; K = 2048; npad = 1024; dst = p.wt_ssd_out + (size_t)s * 1024 * 2048; scale = p.ssd_norm_g + s * 2048; }
    else if (job == 4) { src = p.hy_in_w; ld = 4096; nsrc = 4096; K = 1024; npad = 4096; dst = p.wt_hy_in; }
    else if (job == 5) { src = p.hy_out_w; ld = 1024; nsrc = 1024; K = 1024; npad = 1024; dst = p.wt_hy_out; }
    else if (job == 6) { src = p.lru_in_w; ld = 2048; nsrc = 2048; K = 1024; npad = 2048; dst = p.wt_lru_in; }
    else if (job == 7) { src = p.lru_out_w; ld = 1024; nsrc = 1024; K = 1024; npad = 1024; dst = p.wt_lru_out; }
    else { int q = job - 8; int dg = q >> 2, n = q & 3;
      src = p.lru_gate_w + (size_t)(dg * 4 + n) * 65536; ld = 256; nsrc = 256; K = 256; npad = 256;
      dst = p.wt_lru_gate + (size_t)n * 1024 * 256 + (size_t)dg * 256 * 256; }
    int tiles_k = K / 64, tiles = tiles_k * (npad / 64);
    for (int t = bid; t < tiles; t += nblk) transpose_tile(src, ld, nsrc, dst, K, scale, t, tiles_k, tl, cxw);
  }
  for (int i = bid * NTHR + tidx; i < 2 * 2 * 1024; i += nblk * NTHR) p.knorm[i] = 0.f;
}

__device__ __forceinline__ void phase_mod(const Params& p, int bid, int nblk, unsigned char* smem, int cxw) {
  const int tidx = opaque_tid(cxw);
  float* sc = (float*)smem;
  float* red = sc + 5 * 1024;
  __syncthreads();
  for (int i = tidx; i < 5 * 1024; i += NTHR) {
    int r = i >> 10, k = i & 1023;
    float v = (r == 0) ? p.c_ctx[k] : p.c[(r - 1) * 1024 + k];
    sc[i] = siluf(v);
  }
  __syncthreads();
  const int cj = tidx & 31, kg = tidx >> 5;
  for (int item = bid; item < 4 * 96; item += nblk) {
    const int layer = item / 96, j = (item % 96) * 32 + cj;
    const float* w = p.mod_w + (size_t)layer * 1024 * 3072 + (size_t)kg * 128 * 3072 + j;
    const float* s0 = sc + kg * 128;
    float a0 = 0, a1 = 0, a2 = 0, a3 = 0, a4 = 0;
#pragma unroll 8
    for (int k = 0; k < 128; ++k) {
      float wv = w[(size_t)k * 3072];
      a0 += s0[k] * wv; a1 += s0[1024 + k] * wv; a2 += s0[2048 + k] * wv; a3 += s0[3072 + k] * wv; a4 += s0[4096 + k] * wv;
    }
    __syncthreads();
    red[(kg * 5 + 0) * 32 + cj] = a0; red[(kg * 5 + 1) * 32 + cj] = a1; red[(kg * 5 + 2) * 32 + cj] = a2;
    red[(kg * 5 + 3) * 32 + cj] = a3; red[(kg * 5 + 4) * 32 + cj] = a4;
    __syncthreads();
    if (tidx < 160) {
      const int rr = tidx >> 5, cc = tidx & 31;
      float sum = 0.f;
#pragma unroll
      for (int g8 = 0; g8 < 8; ++g8) sum += red[(g8 * 5 + rr) * 32 + cc];
      const int jj = (item % 96) * 32 + cc;
      p.modv[((size_t)layer * 5 + rr) * 3072 + jj] = sum + p.mod_b[layer * 3072 + jj];
    }
  }
}

__device__ __forceinline__ void phase_hyfilt_a(const Params& p, int bid, int nblk, unsigned char* smem, int cxw) {
  const int tidx = opaque_tid(cxw);
  float* sz = (float*)smem;
  float* sh = sz + 4 * 36;
  int pl = tidx >> 6, m = tidx & 63;
  for (int item = bid; item < 4352 / 4; item += nblk) {
    int pos = item * 4 + pl;
    int L = pos < 256 ? 256 : 4096;
    int l = pos < 256 ? pos : pos - 256;
    __syncthreads();
    if (m < 33) {
      float t = (float)l / (float)L;
      float w = (6.283185307179586f * (float)l) / (float)L;
      float v;
      if (m == 0) v = t;
      else {
        int j = (m - 1) & 15;
        float fr = 1e-4f + (float)j * ((15.f - 1e-4f) / 15.f);
        float ang = w * fr;
        v = (m <= 16) ? __cosf(ang) : __sinf(ang);
      }
      sz[pl * 36 + m] = v;
    }
    __syncthreads();
    float a = p.hy_f_b1[m];
    for (int e = 0; e < 33; ++e) a += sz[pl * 36 + e] * p.hy_f_w1[e * 64 + m];
    a = __sinf(p.hy_f_freq[m] * a);
    sh[pl * 64 + m] = a;
    __syncthreads();
    float b = p.hy_f_b2[m];
    for (int e = 0; e < 64; ++e) b += sh[pl * 64 + e] * p.hy_f_w2[e * 64 + m];
    b = __sinf(p.hy_f_freq[64 + m] * b);
    p.hdn2[(size_t)pos * 64 + m] = b;
  }
}

__device__ __forceinline__ void phase_hyfilt_b(const Params& p, int bid, int nblk, unsigned char* smem, int cxw) {
  const int tidx = opaque_tid(cxw);
  const int lane = tidx & 63;
  for (int item = bid; item < 17 * 64; item += nblk) {
    const int lb = item >> 6, chunk = item & 63;
    const int Lsel = lb ? 1 : 0, L = Lsel ? 4096 : 256, RL = Lsel ? 8192 : 512, Lm1 = L - 1;
    const int l = Lsel ? (lb - 1) * 256 + tidx : tidx;
    const int pos = Lsel ? 256 + l : l;
    float hd[64];
#pragma unroll
    for (int m4 = 0; m4 < 16; ++m4) {
      f32x4 v = *(const f32x4*)(p.hdn2 + (size_t)pos * 64 + m4 * 4);
      hd[m4 * 4] = v.x; hd[m4 * 4 + 1] = v.y; hd[m4 * 4 + 2] = v.z; hd[m4 * 4 + 3] = v.w;
    }
    const int odc0 = chunk * 64, o = odc0 >> 11, d = (odc0 >> 10) & 1, c0 = odc0 & 1023;
    const float t = (float)l / (float)L;
    bf16_t* rt = Lsel ? p.rtab1 : p.rtab0;
    const float min_decay = -3.0701134573253945f, max_decay = -15.350567286626973f;
    for (int cc = 0; cc < 64; ++cc) {
      const int c = c0 + cc;
      const float* w3 = p.hy_f_w3 + odc0 + cc;
      float acc = 0.f;
#pragma unroll
      for (int m = 0; m < 64; ++m) acc += hd[m] * w3[(size_t)m * 4096];
      float delta = fabsf(min_decay + (float)c * ((max_decay - min_decay) / 1023.f));
      float kv = acc * expf(-t * delta);
      size_t rb = (size_t)(o * 1024 + c) * RL;
      if (d == 0) rt[rb + Lm1 - l] = f2bf(kv);
      else if (l > 0) rt[rb + Lm1 + l] = f2bf(kv);
      else rt[rb + RL - 1] = 0;
      float a = fabsf(kv);
#pragma unroll
      for (int off = 32; off > 0; off >>= 1) a += shfl_xor_f(a, off, lane);
      if (lane == 0) atomicAdd(&p.knorm[(Lsel * 2 + o) * 1024 + c], a);
    }
  }
}

__device__ __forceinline__ void phase_lnmod(const Params& p, int layer, int bid, int nblk, int cxw) {
  const int tidx = opaque_tid(cxw);
  int lane = tidx & 63, wv = cxw & 3;
  f32x4 vn[4];
#define LNMOD_LOAD(ROW) do { const int row_ = (ROW); \
    const float* src_ = (layer == 0) ? (row_ < T_CTX ? p.x_prompt + (size_t)row_ * DM : p.x_sample + (size_t)(row_ - T_CTX) * DM) : p.xres + (size_t)row_ * DM; \
    _Pragma("unroll") for (int j = 0; j < 4; ++j) vn[j] = *(const f32x4*)(src_ + j * 256 + lane * 4); } while (0)
  if (bid * 4 + wv < T_ALL) LNMOD_LOAD(bid * 4 + wv);
  for (int row = bid * 4 + wv; row < T_ALL; row += nblk * 4) {
    f32x4 v[4];
#pragma unroll
    for (int j = 0; j < 4; ++j) v[j] = vn[j];
    if (row + nblk * 4 < T_ALL) LNMOD_LOAD(row + nblk * 4);
    if (layer > 0) {
      float s = 0.f;
#pragma unroll
      for (int j = 0; j < 4; ++j) s += v[j].x + v[j].y + v[j].z + v[j].w;
#pragma unroll
      for (int o = 32; o > 0; o >>= 1) s += shfl_xor_f(s, o, lane);
      float mu = s * (1.f / 1024.f);
      float q = 0.f;
#pragma unroll
      for (int j = 0; j < 4; ++j) { float a = v[j].x - mu, b = v[j].y - mu, c = v[j].z - mu, d = v[j].w - mu; q += a * a + b * b + c * c + d * d; }
#pragma unroll
      for (int o = 32; o > 0; o >>= 1) q += shfl_xor_f(q, o, lane);
      float rs = rsqrtf(q * (1.f / 1024.f) + LN_EPS);
      const float* g = p.ln_g + (layer - 1) * DM; const float* b = p.ln_b + (layer - 1) * DM;
#pragma unroll
      for (int j = 0; j < 4; ++j) {
        f32x4 gg = *(const f32x4*)(g + j * 256 + lane * 4), bb = *(const f32x4*)(b + j * 256 + lane * 4);
        v[j].x = (v[j].x - mu) * rs * gg.x + bb.x; v[j].y = (v[j].y - mu) * rs * gg.y + bb.y;
        v[j].z = (v[j].z - mu) * rs * gg.z + bb.z; v[j].w = (v[j].w - mu) * rs * gg.w + bb.w;
      }
    }
    float* dst = p.xres + (size_t)row * DM;
#pragma unroll
    for (int j = 0; j < 4; ++j) *(f32x4*)(dst + j * 256 + lane * 4) = v[j];
    if (layer < 4) {
      int mrow = row < T_CTX ? 0 : 1 + ((row - T_CTX) >> 12);
      const float* mv = p.modv + ((size_t)layer * 5 + mrow) * 3072;
#pragma unroll
      for (int j = 0; j < 4; ++j) {
        f32x4 sh = *(const f32x4*)(mv + j * 256 + lane * 4), sc = *(const f32x4*)(mv + 1024 + j * 256 + lane * 4);
        u32x2 o;
        o.x = pack2(v[j].x * (1.f + sc.x) + sh.x, v[j].y * (1.f + sc.y) + sh.y);
        o.y = pack2(v[j].z * (1.f + sc.z) + sh.z, v[j].w * (1.f + sc.w) + sh.w);
        *(u32x2*)(p.hbuf + (size_t)row * DM + j * 256 + lane * 4) = o;
      }
    }
  }
}

#define PG8_LAS __attribute__((address_space(3)))
namespace pg8 {
constexpr int BM = 256, BK = 64, HALF = 128, HTB = HALF * BK * 2, STAGE_BYTES = 8 * HTB, NXCD = 8, WGM = 8;
__device__ __forceinline__ int lds_byte(int r, int c) { const int st = (r >> 4) * 2 + (c >> 5), rr = r & 15, cc = c & 31, ob = rr * 64 + cc * 2; return st * 1024 + (ob ^ (((ob >> 9) & 1) << 5)); }
__device__ __forceinline__ void stage_rc(int b, int& R, int& C) { const int st = b / 1024, sb = b % 1024, swz = sb ^ (((sb >> 9) & 1) << 5); R = (st >> 1) * 16 + swz / 64; C = (st & 1) * 32 + (swz % 64) / 2; }
__device__ __forceinline__ int perm32(int rho) { const int n = rho >> 4, i = rho & 15; return 8 * (i >> 2) + 4 * n + (i & 3); }
struct Unit { int pm, pn; };
struct Gemm { const bf16_t* A; const bf16_t* Bt; int M, N, K, lda; int a_grp_shift; int a_grp_bytes; };
struct StaticOrder {
  int nM, nN, nwg, G, c;
  __device__ void init(int M, int N, int G_, int c_) { nM = M / BM; nN = N / BM; nwg = nM * nN; G = G_; c = c_; }
  __device__ bool next(int i, Unit& u) const {
    const long L = (long)i * G + c; if (L >= nwg) return false;
    int wgid = (int)L; { const int q = nwg / NXCD, r = nwg % NXCD, xcd = wgid % NXCD, off = wgid / NXCD; wgid = (xcd < r ? xcd * (q + 1) : r * (q + 1) + (xcd - r) * q) + off; }
    const int nig = WGM * nN, gid = wgid / nig, fm = gid * WGM, gsz = (nM - fm) < WGM ? (nM - fm) : WGM;
    u.pm = fm + ((wgid % nig) % gsz); u.pn = (wgid % nig) / gsz; return true;
  }
};
__device__ __forceinline__ unsigned cvt_pk_bf16(float lo, float hi) { return pack2(lo, hi); }

template <class Epi>
__device__ __forceinline__ void gemm_phase(PG8_LAS unsigned char* lds, const Gemm g, const StaticOrder& S, const Epi& E, int wave) {
  const int tid = opaque_tid512(wave), wid = wave, lane = tid & 63, wr = wid >> 2, wc = wid & 3, fr = lane & 15, fq = lane >> 4;
  const int K = g.K, nt = K / BK, lda = g.lda;
  unsigned voffA[2], voffB[2];
#pragma unroll
  for (int i = 0; i < 2; ++i) { int R, C; stage_rc(tid * 16 + i * 8192, R, C); const int Rb = Epi::PERM ? ((R & ~31) + perm32(R & 31)) : R;
    voffA[i] = (unsigned)(R * lda + C) * 2u; voffB[i] = (unsigned)(Rb * K + C) * 2u; }
  const size_t kstep = (size_t)(BK * 2);
  const size_t hstepA = (size_t)HALF * lda * 2, hstepB = (size_t)HALF * K * 2;
  const size_t tstepA = 2 * hstepA, tstepB = 2 * hstepB;
  const unsigned ldsw = (unsigned)wid * 1024u;
  const int aoff = lds_byte(wr * 64 + fr, fq * 8), boff = lds_byte(wc * 32 + fr, fq * 8);
#define PG8_SA(b, h) (((b) * 2 + (h)) * HTB)
#define PG8_SB(b, h) ((4 + (b) * 2 + (h)) * HTB)
#define PG8_STAGE(bufoff, gbase, voff) do { _Pragma("unroll") for (int _i = 0; _i < 2; ++_i) \
    __builtin_amdgcn_global_load_lds((const unsigned*)((const char*)(gbase) + (voff)[_i]), (PG8_LAS unsigned*)(lds + (bufoff) + ldsw + _i * 8192), 16, 0, 0); } while (0)
#define PG8_LDA(dst, b, h) do { _Pragma("unroll") for (int m = 0; m < 4; ++m) _Pragma("unroll") for (int k = 0; k < 2; ++k) dst[m][k] = *(const PG8_LAS bf16x8*)(lds + PG8_SA(b, h) + aoff + m * 2048 + k * 1024); } while (0)
#define PG8_LDB(dst, b, h) do { _Pragma("unroll") for (int n = 0; n < 2; ++n) _Pragma("unroll") for (int k = 0; k < 2; ++k) dst[n][k] = *(const PG8_LAS bf16x8*)(lds + PG8_SB(b, h) + boff + n * 2048 + k * 1024); } while (0)
#define PG8_MMA(ai, bj, At, Bt) do { __builtin_amdgcn_s_setprio(1); _Pragma("unroll") for (int m = 0; m < 4; ++m) _Pragma("unroll") for (int n = 0; n < 2; ++n) _Pragma("unroll") for (int k = 0; k < 2; ++k) \
    acc[ai][bj][m][n] = __builtin_amdgcn_mfma_f32_16x16x32_bf16(Bt[n][k], At[m][k], acc[ai][bj][m][n], 0, 0, 0); __builtin_amdgcn_s_setprio(0); } while (0)
#define PG8_WAIT_V(n) asm volatile("s_waitcnt vmcnt(" #n ")" ::: "memory")
#define PG8_WAIT_L(n) asm volatile("s_waitcnt lgkmcnt(" #n ")" ::: "memory")
#define PG8_BAR __builtin_amdgcn_s_barrier()
#define PG8_SCHED __builtin_amdgcn_sched_barrier(0)
#define PG8_APTR(u) ((const char*)g.A + (size_t)(u).pm * tstepA + (size_t)(((u).pn >> g.a_grp_shift) * g.a_grp_bytes))
  Unit cur, nxt; int ui = 0;
  if (!S.next(0, cur)) return;
  f32x4 acc[2][2][4][2];
#pragma unroll
  for (int a = 0; a < 2; ++a)
#pragma unroll
    for (int b = 0; b < 2; ++b)
#pragma unroll
      for (int m = 0; m < 4; ++m)
#pragma unroll
        for (int n = 0; n < 2; ++n) acc[a][b][m][n] = (f32x4){0.f, 0.f, 0.f, 0.f};
  bf16x8 At[4][2], B0[2][2], B1[2][2];
  const char* cA = PG8_APTR(cur); const char* cB = (const char*)g.Bt + (size_t)cur.pn * tstepB;
  PG8_STAGE(PG8_SB(0, 0), cB, voffB); PG8_STAGE(PG8_SA(0, 0), cA, voffA); PG8_STAGE(PG8_SB(0, 1), cB + hstepB, voffB); PG8_STAGE(PG8_SA(0, 1), cA + hstepA, voffA);
  if (wr == 1) PG8_BAR;
  PG8_WAIT_V(4); PG8_BAR;
  PG8_STAGE(PG8_SB(1, 0), cB + kstep, voffB); PG8_STAGE(PG8_SA(1, 0), cA + kstep, voffA); PG8_STAGE(PG8_SB(1, 1), cB + hstepB + kstep, voffB);
  PG8_WAIT_V(6); PG8_BAR;
  for (;;) {
    const bool has_next = S.next(ui + 1, nxt);
    const char* nA = has_next ? PG8_APTR(nxt) : cA; const char* nB = has_next ? (const char*)g.Bt + (size_t)nxt.pn * tstepB : cB;
    for (int t = 0; t < nt; t += 2) {
      const bool last = (t == nt - 2);
      const char* a1 = cA + (size_t)(t + 1) * kstep;
      const char* a2 = last ? nA : cA + (size_t)(t + 2) * kstep; const char* b2 = last ? nB : cB + (size_t)(t + 2) * kstep;
      const char* a3 = a2 + kstep; const char* b3 = b2 + kstep;
      PG8_LDB(B0, 0, 0); PG8_SCHED; PG8_LDA(At, 0, 0); PG8_STAGE(PG8_SA(1, 1), a1 + hstepA, voffA);
      PG8_WAIT_L(8); PG8_BAR; PG8_WAIT_L(0); PG8_MMA(0, 0, At, B0); PG8_BAR; PG8_SCHED;
      PG8_LDB(B1, 0, 1); PG8_STAGE(PG8_SB(0, 0), b2, voffB);
      PG8_BAR; PG8_WAIT_L(0); PG8_MMA(0, 1, At, B1); PG8_BAR;
      PG8_LDA(At, 0, 1); PG8_STAGE(PG8_SA(0, 0), a2, voffA);
      PG8_BAR; PG8_WAIT_L(0); PG8_MMA(1, 0, At, B0); PG8_BAR; PG8_SCHED;
      PG8_STAGE(PG8_SB(0, 1), b2 + hstepB, voffB);
      PG8_WAIT_V(6); PG8_BAR; PG8_MMA(1, 1, At, B1); PG8_BAR;
      PG8_LDB(B0, 1, 0); PG8_SCHED; PG8_LDA(At, 1, 0); PG8_STAGE(PG8_SA(0, 1), a2 + hstepA, voffA);
      PG8_WAIT_L(8); PG8_BAR; PG8_WAIT_L(0); PG8_MMA(0, 0, At, B0); PG8_BAR; PG8_SCHED;
      PG8_LDB(B1, 1, 1); PG8_STAGE(PG8_SB(1, 0), b3, voffB);
      PG8_BAR; PG8_WAIT_L(0); PG8_MMA(0, 1, At, B1); PG8_BAR;
      PG8_LDA(At, 1, 1); PG8_STAGE(PG8_SA(1, 0), a3, voffA);
      PG8_BAR; PG8_WAIT_L(0); PG8_MMA(1, 0, At, B0); PG8_BAR; PG8_SCHED;
      PG8_STAGE(PG8_SB(1, 1), b3 + hstepB, voffB);
      PG8_WAIT_V(6); PG8_BAR; PG8_MMA(1, 1, At, B1); PG8_BAR;
    }
    { int fr2 = fr, fq2 = fq; asm volatile("" : "+v"(fr2), "+v"(fq2));
      E(acc, cur, wr, wc, fr2, fq2); }
    if (!has_next) break;
#pragma unroll
    for (int a = 0; a < 2; ++a)
#pragma unroll
      for (int b = 0; b < 2; ++b)
#pragma unroll
        for (int m = 0; m < 4; ++m)
#pragma unroll
          for (int n = 0; n < 2; ++n) acc[a][b][m][n] = (f32x4){0.f, 0.f, 0.f, 0.f};
    cur = nxt; cA = nA; cB = nB; ++ui;
  }
  PG8_WAIT_V(0);
  if (wr == 0) PG8_BAR;
  PG8_BAR;
#undef PG8_SA
#undef PG8_SB
#undef PG8_STAGE
#undef PG8_LDA
#undef PG8_LDB
#undef PG8_MMA
#undef PG8_WAIT_V
#undef PG8_WAIT_L
#undef PG8_BAR
#undef PG8_SCHED
#undef PG8_APTR
}

struct EpiBf16 {
  static constexpr bool PERM = true;
  bf16_t* O; size_t ldc;
  __device__ __forceinline__ void operator()(const f32x4 (&acc)[2][2][4][2], const Unit& u, int wr, int wc, int fr, int fq) const {
    const int row0 = u.pm * BM + wr * 64 + fr, col0 = u.pn * BM + wc * 32 + 8 * fq;
#pragma unroll
    for (int ai = 0; ai < 2; ++ai)
#pragma unroll
      for (int m = 0; m < 4; ++m) {
        bf16_t* rowp = O + (size_t)(row0 + ai * HALF + m * 16) * ldc + col0;
#pragma unroll
        for (int bj = 0; bj < 2; ++bj) {
          const f32x4 v0 = acc[ai][bj][m][0], v1 = acc[ai][bj][m][1];
          u32x4 w; w.x = pack2(v0[0], v0[1]); w.y = pack2(v0[2], v0[3]); w.z = pack2(v1[0], v1[1]); w.w = pack2(v1[2], v1[3]);
          *(u32x4*)(rowp + bj * HALF) = w;
        }
      }
  }
};
struct EpiSsdIn {
  static constexpr bool PERM = true;
  bf16_t* z; bf16_t* xbc; float* dt; const float* dt_bias;
  __device__ __forceinline__ void operator()(const f32x4 (&acc)[2][2][4][2], const Unit& u, int wr, int wc, int fr, int fq) const {
    const int row0 = u.pm * BM + wr * 64 + fr, colt = u.pn * BM + wc * 32 + 8 * fq;
    if (u.pn < 24) {
      bf16_t* base = u.pn < 8 ? z : xbc; const size_t ldc = u.pn < 8 ? 2048 : 4096; const int col0 = u.pn < 8 ? colt : colt - 2048;
#pragma unroll
      for (int ai = 0; ai < 2; ++ai)
#pragma unroll
        for (int m = 0; m < 4; ++m) {
          bf16_t* rowp = base + (size_t)(row0 + ai * HALF + m * 16) * ldc + col0;
#pragma unroll
          for (int bj = 0; bj < 2; ++bj) {
            const f32x4 v0 = acc[ai][bj][m][0], v1 = acc[ai][bj][m][1];
            u32x4 w; w.x = pack2(v0[0], v0[1]); w.y = pack2(v0[2], v0[3]); w.z = pack2(v1[0], v1[1]); w.w = pack2(v1[2], v1[3]);
            *(u32x4*)(rowp + bj * HALF) = w;
          }
        }
    } else {
      const int c0 = wc * 32 + 8 * fq;
      if (c0 < 64) {
#pragma unroll
        for (int ai = 0; ai < 2; ++ai)
#pragma unroll
          for (int m = 0; m < 4; ++m) {
            float* rowp = dt + (size_t)(row0 + ai * HALF + m * 16) * 64 + c0;
#pragma unroll
            for (int n = 0; n < 2; ++n) {
              const f32x4 v = acc[ai][0][m][n];
              f32x4 o;
#pragma unroll
              for (int e = 0; e < 4; ++e) o[e] = softplusf(v[e] + dt_bias[c0 + 4 * n + e]);
              *(f32x4*)(rowp + 4 * n) = o;
            }
          }
      }
    }
  }
};
struct EpiOut {
  static constexpr bool PERM = false;
  float* xres; const float* modv_layer; const float* rstd;
  __device__ __forceinline__ void operator()(const f32x4 (&acc)[2][2][4][2], const Unit& u, int wr, int wc, int fr, int fq) const {
    const int row0 = u.pm * BM + wr * 64 + fr, col0 = u.pn * BM + wc * 32 + 4 * fq;
#pragma unroll
    for (int ai = 0; ai < 2; ++ai)
#pragma unroll
      for (int m = 0; m < 4; ++m) {
        const int row = row0 + ai * HALF + m * 16;
        const int mrow = row < T_CTX ? 0 : 1 + ((row - T_CTX) >> 12);
        const float rs = rstd ? rstd[row] : 1.f;
        const float* gp = modv_layer + (size_t)mrow * 3072 + 2048 + col0;
        float* rowp = xres + (size_t)row * DM + col0;
#pragma unroll
        for (int bj = 0; bj < 2; ++bj)
#pragma unroll
          for (int n = 0; n < 2; ++n) {
            const f32x4 gv = *(const f32x4*)(gp + bj * HALF + n * 16);
            const f32x4 xv = *(const f32x4*)(rowp + bj * HALF + n * 16);
            *(f32x4*)(rowp + bj * HALF + n * 16) = ALPHA_RES * xv + gv * (acc[ai][bj][m][n] * rs);
          }
      }
  }
};
struct EpiLruGate {
  static constexpr bool PERM = true;
  bf16_t* gates; const float* gate_b;
  __device__ __forceinline__ void operator()(const f32x4 (&acc)[2][2][4][2], const Unit& u, int wr, int wc, int fr, int fq) const {
    const int nb = u.pn >> 2, dg = u.pn & 3;
    const int row0 = u.pm * BM + wr * 64 + fr, ch0 = nb * 256 + wc * 32 + 8 * fq;
#pragma unroll
    for (int ai = 0; ai < 2; ++ai)
#pragma unroll
      for (int m = 0; m < 4; ++m) {
        bf16_t* rowp = gates + ((size_t)dg * T_ALL + row0 + ai * HALF + m * 16) * 1024 + ch0;
#pragma unroll
        for (int bj = 0; bj < 2; ++bj) {
          const float* bp = gate_b + dg * 1024 + ch0 + bj * HALF;
          const f32x4 b0 = *(const f32x4*)bp, b1 = *(const f32x4*)(bp + 4);
          const f32x4 v0 = acc[ai][bj][m][0] + b0, v1 = acc[ai][bj][m][1] + b1;
          u32x4 w; w.x = pack2(sigmoidf(v0[0]), sigmoidf(v0[1])); w.y = pack2(sigmoidf(v0[2]), sigmoidf(v0[3]));
          w.z = pack2(sigmoidf(v1[0]), sigmoidf(v1[1])); w.w = pack2(sigmoidf(v1[2]), sigmoidf(v1[3]));
          *(u32x4*)(rowp + bj * HALF) = w;
        }
      }
  }
};
}

template <int KW, bool SILU>
__device__ __forceinline__ void phase_dwconv(const bf16_t* __restrict__ src, int ld_src, bf16_t* __restrict__ dst, int ld_dst, int CH,
                             const float* __restrict__ w, const float* __restrict__ b, bool colmajor, int bid, int nblk, int cxw) {
  const int tidx = opaque_tid(cxw);
  const int cpr = CH / 8;
  const size_t total = (size_t)T_ALL * cpr;
  for (size_t idx = (size_t)bid * NTHR + tidx; idx < total; idx += (size_t)nblk * NTHR) {
    int tok = (int)(idx / cpr), c0 = (int)(idx % cpr) * 8;
    TokInfo ti = tokinfo(tok);
    bool cm = colmajor && ti.s >= 32;
    int pos = seqpos2off(ti.l, cm);
    float acc[8];
#pragma unroll
    for (int e = 0; e < 8; ++e) acc[e] = b[c0 + e];
#pragma unroll
    for (int k = 0; k < KW; ++k) {
      int pp = pos + k - 1;
      if (pp < 0 || pp >= ti.L) continue;
      int tk = ti.base + seqpos2off(pp, cm);
      u32x4 xv = *(const u32x4*)(src + (size_t)tk * ld_src + c0);
      const float* wk = w + (size_t)k * CH + c0;
      acc[0] += wk[0] * bflo(xv.x); acc[1] += wk[1] * bfhi(xv.x);
      acc[2] += wk[2] * bflo(xv.y); acc[3] += wk[3] * bfhi(xv.y);
      acc[4] += wk[4] * bflo(xv.z); acc[5] += wk[5] * bfhi(xv.z);
      acc[6] += wk[6] * bflo(xv.w); acc[7] += wk[7] * bfhi(xv.w);
    }
    if (SILU) {
#pragma unroll
      for (int e = 0; e < 8; ++e) acc[e] = siluf(acc[e]);
    }
    u32x4 o;
    o.x = pack2(acc[0], acc[1]); o.y = pack2(acc[2], acc[3]); o.z = pack2(acc[4], acc[5]); o.w = pack2(acc[6], acc[7]);
    *(u32x4*)(dst + (size_t)tok * ld_dst + c0) = o;
  }
}

__device__ __forceinline__ void phase_ssd_conv(const Params& p, int slot, bool colmajor, int bid, int nblk, unsigned char* smem, int cxw) {
  const int tid = opaque_tid(cxw);
  const bf16_t* raw = (const bf16_t*)(p.scratch + SC_SSD_XBC);
  bf16_t* out = (bf16_t*)(p.scratch + SC_SSD_XBCC);
  bf16_t* XT = (bf16_t*)(p.scratch + SC_SSD_XT);
  bf16_t* BT = (bf16_t*)(p.scratch + SC_SSD_BT);
  bf16_t* BF = (bf16_t*)(p.scratch + SC_SSD_BF);
  bf16_t* CF = (bf16_t*)(p.scratch + SC_SSD_CF);
  const float* cw = p.ssd_conv_w + (size_t)slot * 4 * 4096;
  const float* cb = p.ssd_conv_b + slot * 4096;
  bf16_t* tl = (bf16_t*)smem;
  bf16_t* rt = tl + 64 * 72;
  const int rr = tid >> 2, cpart = tid & 3;
  const int NITEMS = 384 * 64;
  u32x4 pre[3];
#define CONV_PREFETCH(ITEM) do { const int it_ = (ITEM); const int ptile_ = it_ >> 6, ct_ = it_ & 63; \
    const TokInfo ti_ = tokinfo(ptile_ * 64); const bool cm_ = colmajor && ti_.s >= 32; \
    _Pragma("unroll") for (int i_ = 0; i_ < 3; ++i_) { const int q_ = tid + i_ * 256; const int row_ = q_ >> 3, c8_ = (q_ & 7) * 8; \
      const int pp_ = ti_.l - 1 + row_; u32x4 v_ = {0u, 0u, 0u, 0u}; \
      if (row_ < 67 && pp_ >= 0 && pp_ < ti_.L) v_ = *(const u32x4*)(raw + (size_t)(ti_.base + seqpos2off(pp_, cm_)) * 4096 + ct_ * 64 + c8_); \
      pre[i_] = v_; } } while (0)
  if (bid < NITEMS) CONV_PREFETCH(bid);
  for (int item = bid; item < NITEMS; item += nblk) {
    const int ptile = item >> 6, ct = item & 63;
    const int ptok0 = ptile * 64;
    const int ch = ct * 64 + cpart * 16;
    __syncthreads();
#pragma unroll
    for (int i = 0; i < 3; ++i) { const int q = tid + i * 256; if (q < 67 * 8) *(u32x4*)(rt + (q >> 3) * 72 + (q & 7) * 8) = pre[i]; }
    if (item + nblk < NITEMS) CONV_PREFETCH(item + nblk);
    __syncthreads();
    float acc[16];
#pragma unroll
    for (int e = 0; e < 16; ++e) acc[e] = cb[ch + e];
#pragma unroll
    for (int k = 0; k < 4; ++k) {
      const bf16_t* rp = rt + (rr + k) * 72 + cpart * 16;
      u32x4 x0 = *(const u32x4*)rp, x1 = *(const u32x4*)(rp + 8);
      const float* wk = cw + (size_t)k * 4096 + ch;
      unsigned xw[8] = {x0.x, x0.y, x0.z, x0.w, x1.x, x1.y, x1.z, x1.w};
#pragma unroll
      for (int e = 0; e < 8; ++e) { acc[2 * e] += wk[2 * e] * bflo(xw[e]); acc[2 * e + 1] += wk[2 * e + 1] * bfhi(xw[e]); }
    }
    u32x4 o0, o1;
    o0.x = pack2(siluf(acc[0]), siluf(acc[1])); o0.y = pack2(siluf(acc[2]), siluf(acc[3]));
    o0.z = pack2(siluf(acc[4]), siluf(acc[5])); o0.w = pack2(siluf(acc[6]), siluf(acc[7]));
    o1.x = pack2(siluf(acc[8]), siluf(acc[9])); o1.y = pack2(siluf(acc[10]), siluf(acc[11]));
    o1.z = pack2(siluf(acc[12]), siluf(acc[13])); o1.w = pack2(siluf(acc[14]), siluf(acc[15]));
    *(u32x4*)(tl + rr * 72 + cpart * 16) = o0;
    *(u32x4*)(tl + rr * 72 + cpart * 16 + 8) = o1;
    __syncthreads();
    if (ct < 32) {
      bf16_t* op = out + (size_t)(ptok0 + rr) * 2048 + ch;
      *(u32x4*)op = o0; *(u32x4*)(op + 8) = o1;
      const int crow = tid >> 2, part = tid & 3;
      unsigned wv[8];
#pragma unroll
      for (int e = 0; e < 8; ++e) {
        unsigned lo = tl[(part * 16 + 2 * e) * 72 + crow], hi = tl[(part * 16 + 2 * e + 1) * 72 + crow];
        wv[e] = lo | (hi << 16);
      }
      bf16_t* dp = XT + (size_t)(ct * 64 + crow) * T_ALL + ptok0 + part * 16;
      u32x4 t0, t1;
      t0.x = wv[0]; t0.y = wv[1]; t0.z = wv[2]; t0.w = wv[3]; t1.x = wv[4]; t1.y = wv[5]; t1.z = wv[6]; t1.w = wv[7];
      *(u32x4*)dp = t0; *(u32x4*)(dp + 8) = t1;
    } else {
      const bool isB = ct < 48;
      const int cq = (ct - (isB ? 32 : 48));
      const int g = cq >> 1, chhalf = cq & 1;
      const int lane = tid & 63, r = lane & 31, hh = lane >> 5;
      bf16_t* F = isB ? BF : CF;
#pragma unroll
      for (int i = 0; i < 2; ++i) {
        const int f = (cxw & 3) + 4 * i;
        const int rt2 = f >> 2, kk4 = f & 3;
        const u32x4 v = *(const u32x4*)(tl + (32 * rt2 + r) * 72 + 16 * kk4 + 8 * hh);
        const size_t rt = (size_t)(ptok0 >> 5) + rt2;
        *(u32x4*)(F + (((rt * 8 + g) * 8 + chhalf * 4 + kk4) * 64 + lane) * 8) = v;
      }
      if (isB) {
#pragma unroll
        for (int i = 0; i < 2; ++i) {
          const int f = (cxw & 3) + 4 * i;
          const int nt2 = f >> 2, ts4 = f & 3;
          unsigned wv[4];
#pragma unroll
          for (int e = 0; e < 4; ++e) {
            unsigned lo = tl[(16 * ts4 + 8 * hh + 2 * e) * 72 + 32 * nt2 + r], hi = tl[(16 * ts4 + 8 * hh + 2 * e + 1) * 72 + 32 * nt2 + r];
            wv[e] = lo | (hi << 16);
          }
          u32x4 v; v.x = wv[0]; v.y = wv[1]; v.z = wv[2]; v.w = wv[3];
          const size_t ts = (size_t)(ptok0 >> 4) + ts4;
          *(u32x4*)(BT + (((ts * 8 + g) * 4 + chhalf * 2 + nt2) * 64 + lane) * 8) = v;
        }
      }
    }
  }
}

#define SH_STRIDE 136
__device__ __forceinline__ int rowmap(int e, int hh) { return (e & 3) + 8 * (e >> 2) + 4 * hh; }
__device__ __forceinline__ bf16x8 pack8(float a0, float a1, float a2, float a3, float a4, float a5, float a6, float a7) {
  u32x4 v; v.x = pack2(a0, a1); v.y = pack2(a2, a3); v.z = pack2(a4, a5); v.w = pack2(a6, a7);
  return __builtin_bit_cast(bf16x8, v);
}
__device__ __forceinline__ void phase_ssd_scan(const Params& p, int slot, bool colmajor, int bid, int nblk, unsigned char* smem, int cxw) {
  const int tid = opaque_tid(cxw), lane = tid & 63, w = cxw & 3  , r = lane & 31, hh = lane >> 5;
  const int it = w >> 1, pt = w & 1;
  const bf16_t* xbcc = (const bf16_t*)(p.scratch + SC_SSD_XBCC);
  const bf16_t* XT = (const bf16_t*)(p.scratch + SC_SSD_XT);
  const bf16_t* BT = (const bf16_t*)(p.scratch + SC_SSD_BT);
  const bf16_t* BF = (const bf16_t*)(p.scratch + SC_SSD_BF);
  const bf16_t* CF = (const bf16_t*)(p.scratch + SC_SSD_CF);
  const float* dtb = (const float*)(p.scratch + SC_SSD_DT);
  bf16_t* ybuf = (bf16_t*)(p.scratch + SC_SSD_XBC);
  bf16_t* sXr = (bf16_t*)smem;
  bf16_t* sXs = sXr + 64 * 72;
  bf16_t* sH = sXs + 64 * 72;
  float* sW = (float*)(sH + 2 * 64 * SH_STRIDE);
  bf16_t* sY = (bf16_t*)(sW + 4 * 256);
  float* myW = sW + w * 256;
  for (int item = bid; item < 36 * 64; item += nblk) {
    int s, h, dir;
    {
      const int itx = item < 256 ? item : item - 256;
      const int idx = itx & 63, pairidx = idx >> 1;
      s = item < 256 ? 32 + (itx >> 6) : (itx >> 6);
      dir = pairidx & 1; h = (pairidx >> 1) * 2 + (idx & 1);
    }
    const int L = s < 32 ? 256 : 4096;
    const int base = s < 32 ? s * 256 : T_CTX + (s - 32) * 4096;
    const bool cm = colmajor && s >= 32;
    const int g = h >> 2;
    const float Aval = -expf(p.ssd_a_log[(slot * 2 + dir) * 32 + h]);
    const int nchunks = L >> 6;
    const int pcol = 32 * pt + r;
    f32x16 hacc[2];
    if (s >= 32) {
      const float* h0 = p.state_ssd + ((((size_t)(s - 32) * 2 + slot) * 2 + dir) * 32 + h) * 8192 + (size_t)pcol * 128;
#pragma unroll
      for (int t2 = 0; t2 < 2; ++t2)
#pragma unroll
        for (int qd = 0; qd < 4; ++qd) {
          f32x4 v = *(const f32x4*)(h0 + 32 * (2 * it + t2) + 8 * qd + 4 * hh);
          hacc[t2][4 * qd] = v.x; hacc[t2][4 * qd + 1] = v.y; hacc[t2][4 * qd + 2] = v.z; hacc[t2][4 * qd + 3] = v.w;
        }
    } else {
#pragma unroll
      for (int t2 = 0; t2 < 2; ++t2)
#pragma unroll
        for (int e = 0; e < 16; ++e) hacc[t2][e] = 0.f;
    }
#pragma unroll
    for (int t2 = 0; t2 < 2; ++t2)
#pragma unroll
      for (int qd = 0; qd < 4; ++qd) {
        u32x2 o; o.x = pack2(hacc[t2][4 * qd], hacc[t2][4 * qd + 1]); o.y = pack2(hacc[t2][4 * qd + 2], hacc[t2][4 * qd + 3]);
        *(u32x2*)(sH + pcol * SH_STRIDE + 32 * (2 * it + t2) + 8 * qd + 4 * hh) = o;
      }
    float dtv; u32x4 xtr[2]; bf16x8 cfr[8], bfr[2][8], btf[2][4];
    const bool need0 = dir == 0 ? true : (it == 0);
    const bool need1 = dir == 0 ? (it == 1) : true;
#define SCAN_PTOK(c) (base + 64 * (dir ? nchunks - 1 - (c) : (c)))
#define SCAN_LOAD_DTX(pt0) do { \
      const int tok_ = base + seqpos2off((pt0) - base + lane, cm); \
      dtv = dtb[(size_t)tok_ * 64 + dir * 32 + h]; \
      _Pragma("unroll") for (int i_ = 0; i_ < 2; ++i_) { const int q_ = tid + i_ * 256; \
        xtr[i_] = *(const u32x4*)(XT + (size_t)(h * 64 + (q_ >> 3)) * T_ALL + (pt0) + (q_ & 7) * 8); } } while (0)
#define SCAN_LOAD_CB(pt0) do { \
      const bf16_t* cf_ = CF + ((((size_t)((pt0) >> 5) + it) * 8 + g) * 8) * 512 + lane * 8; \
      _Pragma("unroll") for (int kk = 0; kk < 8; ++kk) cfr[kk] = *(const bf16x8*)(cf_ + kk * 512); \
      if (need0) { const bf16_t* bf_ = BF + ((((size_t)((pt0) >> 5)) * 8 + g) * 8) * 512 + lane * 8; \
        _Pragma("unroll") for (int kk = 0; kk < 8; ++kk) bfr[0][kk] = *(const bf16x8*)(bf_ + kk * 512); } \
      if (need1) { const bf16_t* bf_ = BF + ((((size_t)((pt0) >> 5) + 1) * 8 + g) * 8) * 512 + lane * 8; \
        _Pragma("unroll") for (int kk = 0; kk < 8; ++kk) bfr[1][kk] = *(const bf16x8*)(bf_ + kk * 512); } } while (0)
#define SCAN_LOAD_BT(pt0) do { \
      _Pragma("unroll") for (int t2 = 0; t2 < 2; ++t2) { \
        _Pragma("unroll") for (int kk = 0; kk < 4; ++kk) \
          btf[t2][kk] = *(const bf16x8*)(BT + (((((size_t)((pt0) >> 4) + kk) * 8 + g) * 4 + 2 * it + t2) * 64 + lane) * 8); } } while (0)
    {
      const int p0 = SCAN_PTOK(0);
      SCAN_LOAD_DTX(p0); SCAN_LOAD_CB(p0); SCAN_LOAD_BT(p0);
    }
    for (int ci = 0; ci < nchunks; ++ci) {
      const int ptok0 = SCAN_PTOK(ci);
      const int cin = ci + 1 < nchunks ? ci + 1 : ci;
      const int ptokN = SCAN_PTOK(cin);
      const int buf = ci & 1;
      __syncthreads();
      if (ci > 0) {
        const int ptokP = SCAN_PTOK(ci - 1);
#pragma unroll
        for (int i = 0; i < 2; ++i) {
          const int q = tid + i * 256, yrow = q >> 3, c8 = (q & 7) * 8;
          *(u32x4*)(ybuf + ((size_t)dir * T_ALL + ptokP + yrow) * 2048 + h * 64 + c8) = *(const u32x4*)(sY + yrow * 72 + c8);
        }
      }
      float decE;
      {
        const float a_ = dtv * Aval;
        const float pre = wave_incl_scan(a_);
        const float cE = __int_as_float(__builtin_amdgcn_readlane(__float_as_int(pre), 63));
        const float c = dir == 0 ? pre : cE - pre + a_;
        myW[lane] = dtv; myW[64 + lane] = c; myW[128 + lane] = __expf(c); myW[192 + lane] = dtv * __expf(cE - c);
        decE = __expf(cE);
      }
#pragma unroll
      for (int i = 0; i < 2; ++i) {
        const int q = tid + i * 256, prow = q >> 3, j8 = (q & 7) * 8;
        const u32x4 raw = xtr[i];
        *(u32x4*)(sXr + prow * 72 + j8) = raw;
        f32x4 f0 = *(const f32x4*)(myW + 192 + j8), f1 = *(const f32x4*)(myW + 192 + j8 + 4);
        u32x4 sc;
        sc.x = pack2(bflo(raw.x) * f0.x, bfhi(raw.x) * f0.y); sc.y = pack2(bflo(raw.y) * f0.z, bfhi(raw.y) * f0.w);
        sc.z = pack2(bflo(raw.z) * f1.x, bfhi(raw.z) * f1.y); sc.w = pack2(bflo(raw.w) * f1.z, bfhi(raw.w) * f1.w);
        *(u32x4*)(sXs + prow * 72 + j8) = sc;
      }
      __syncthreads();
      SCAN_LOAD_DTX(ptokN);
#pragma unroll
      for (int t2 = 0; t2 < 2; ++t2) {
#pragma unroll
        for (int e = 0; e < 16; ++e) hacc[t2][e] *= decE;
        const bf16_t* xs = sXs + pcol * 72 + 8 * hh;
#pragma unroll
        for (int kk = 0; kk < 4; ++kk)
          hacc[t2] = __builtin_amdgcn_mfma_f32_32x32x16_bf16(btf[t2][kk], *(const bf16x8*)(xs + 16 * kk), hacc[t2], 0, 0, 0);
#pragma unroll
        for (int qd = 0; qd < 4; ++qd) {
          u32x2 o; o.x = pack2(hacc[t2][4 * qd], hacc[t2][4 * qd + 1]); o.y = pack2(hacc[t2][4 * qd + 2], hacc[t2][4 * qd + 3]);
          *(u32x2*)(sH + (buf ^ 1) * 64 * SH_STRIDE + pcol * SH_STRIDE + 32 * (2 * it + t2) + 8 * qd + 4 * hh) = o;
        }
      }
      f32x16 acc;
#pragma unroll
      for (int e = 0; e < 16; ++e) acc[e] = 0.f;
      {
        const bf16_t* hp = sH + buf * 64 * SH_STRIDE + pcol * SH_STRIDE + 8 * hh;
#pragma unroll
        for (int kk = 0; kk < 8; ++kk) acc = __builtin_amdgcn_mfma_f32_32x32x16_bf16(cfr[kk], *(const bf16x8*)(hp + 16 * kk), acc, 0, 0, 0);
      }
#pragma unroll
      for (int qd = 0; qd < 4; ++qd) {
        f32x4 ec = *(const f32x4*)(myW + 128 + 32 * it + 8 * qd + 4 * hh);
        acc[4 * qd] *= ec.x; acc[4 * qd + 1] *= ec.y; acc[4 * qd + 2] *= ec.z; acc[4 * qd + 3] *= ec.w;
      }
      const int icol = 32 * it + r;
      const float ci_ = myW[64 + icol];
#pragma unroll
      for (int jt = 0; jt < 2; ++jt) {
        const bool needed = jt == 0 ? need0 : need1;
        if (needed) {
          f32x16 X;
#pragma unroll
          for (int e = 0; e < 16; ++e) X[e] = 0.f;
#pragma unroll
          for (int kk = 0; kk < 8; ++kk) X = __builtin_amdgcn_mfma_f32_32x32x16_bf16(bfr[jt][kk], cfr[kk], X, 0, 0, 0);
#pragma unroll
          for (int qd = 0; qd < 4; ++qd) {
            const int j0 = 32 * jt + 8 * qd + 4 * hh;
            f32x4 cj = *(const f32x4*)(myW + 64 + j0), dj = *(const f32x4*)(myW + j0);
            float cjv[4] = {cj.x, cj.y, cj.z, cj.w}, djv[4] = {dj.x, dj.y, dj.z, dj.w};
#pragma unroll
            for (int u = 0; u < 4; ++u) {
              const int j = j0 + u;
              const bool ok = dir == 0 ? (j <= icol) : (j >= icol);
              const float m = __expf(ci_ - cjv[u]) * djv[u];
              X[4 * qd + u] = ok ? X[4 * qd + u] * m : 0.f;
            }
          }
#pragma unroll
          for (int sk = 0; sk < 2; ++sk) {
            bf16x8 afr = pack8(X[8 * sk], X[8 * sk + 1], X[8 * sk + 2], X[8 * sk + 3], X[8 * sk + 4], X[8 * sk + 5], X[8 * sk + 6], X[8 * sk + 7]);
            const bf16_t* xp = sXr + pcol * 72 + 32 * jt + 16 * sk + 4 * hh;
            u32x2 lo = *(const u32x2*)xp, hi = *(const u32x2*)(xp + 8);
            u32x4 xv; xv.x = lo.x; xv.y = lo.y; xv.z = hi.x; xv.w = hi.y;
            acc = __builtin_amdgcn_mfma_f32_32x32x16_bf16(afr, __builtin_bit_cast(bf16x8, xv), acc, 0, 0, 0);
          }
        }
      }
      SCAN_LOAD_CB(ptokN);
      {
        bf16_t* yo = sY + (32 * it) * 72 + pcol;
#pragma unroll
        for (int e = 0; e < 16; ++e) yo[rowmap(e, hh) * 72] = f2bf(acc[e]);
      }
      SCAN_LOAD_BT(ptokN);
    }
    __syncthreads();
    {
      const int ptokP = SCAN_PTOK(nchunks - 1);
#pragma unroll
      for (int i = 0; i < 2; ++i) {
        const int q = tid + i * 256, yrow = q >> 3, c8 = (q & 7) * 8;
        *(u32x4*)(ybuf + ((size_t)dir * T_ALL + ptokP + yrow) * 2048 + h * 64 + c8) = *(const u32x4*)(sY + yrow * 72 + c8);
      }
    }
#undef SCAN_PTOK
#undef SCAN_LOAD_DTX
#undef SCAN_LOAD_CB
#undef SCAN_LOAD_BT
    if (s < 32) {
      float* ho = p.out_ssd + ((((size_t)s * 2 + slot) * 2 + dir) * 32 + h) * 8192 + (size_t)pcol * 128;
#pragma unroll
      for (int t2 = 0; t2 < 2; ++t2)
#pragma unroll
        for (int qd = 0; qd < 4; ++qd) {
          f32x4 v; v.x = hacc[t2][4 * qd]; v.y = hacc[t2][4 * qd + 1]; v.z = hacc[t2][4 * qd + 2]; v.w = hacc[t2][4 * qd + 3];
          *(f32x4*)(ho + 32 * (2 * it + t2) + 8 * qd + 4 * hh) = v;
        }
    }
    __syncthreads();
  }
}

__device__ __forceinline__ void phase_ssd_gate(const Params& p, int slot, int bid, int nblk, int cxw) {
  const int tidx = opaque_tid(cxw);
  bf16_t* zb = (bf16_t*)(p.scratch + SC_SSD_Z);
  const bf16_t* yfb = (const bf16_t*)(p.scratch + SC_SSD_XBC);
  const bf16_t* ybb = yfb + (size_t)T_ALL * 2048;
  const bf16_t* xbcc = (const bf16_t*)(p.scratch + SC_SSD_XBCC);
  int lane = tidx & 63, wv = cxw & 3;
  for (int row = bid * 4 + wv; row < T_ALL; row += nblk * 4) {
    float ss = 0.f;
    TokInfo ti = tokinfo(row);
    const int prow = ti.base + seqpos2off(ti.l, slot == 1 && ti.s >= 32);
#pragma unroll
    for (int j = 0; j < 4; ++j) {
      int c0 = j * 512 + lane * 8;
      u32x4 zv = *(const u32x4*)(zb + (size_t)row * 2048 + c0);
      u32x4 fv = *(const u32x4*)(yfb + (size_t)prow * 2048 + c0);
      u32x4 bv = *(const u32x4*)(ybb + (size_t)prow * 2048 + c0);
      u32x4 xv = *(const u32x4*)(xbcc + (size_t)prow * 2048 + c0);
      float dsk = p.ssd_d[slot * 32 + (c0 >> 6)];
      unsigned zw[4] = {zv.x, zv.y, zv.z, zv.w}, fw[4] = {fv.x, fv.y, fv.z, fv.w}, bw[4] = {bv.x, bv.y, bv.z, bv.w}, xw[4] = {xv.x, xv.y, xv.z, xv.w};
      unsigned ow[4];
#pragma unroll
      for (int e = 0; e < 4; ++e) {
        float y0 = (bflo(fw[e]) + bflo(bw[e]) + dsk * bflo(xw[e])) * siluf(bflo(zw[e]));
        float y1 = (bfhi(fw[e]) + bfhi(bw[e]) + dsk * bfhi(xw[e])) * siluf(bfhi(zw[e]));
        ss += y0 * y0 + y1 * y1;
        ow[e] = pack2(y0, y1);
      }
      u32x4 o; o.x = ow[0]; o.y = ow[1]; o.z = ow[2]; o.w = ow[3];
      *(u32x4*)(zb + (size_t)row * 2048 + c0) = o;
    }
#pragma unroll
    for (int o = 32; o > 0; o >>= 1) ss += shfl_xor_f(ss, o, lane);
    if (lane == 0) p.rstd[row] = rsqrtf(ss * (1.f / 2048.f) + 1e-5f);
  }
}

#define HY_UOFF 32768
__device__ __forceinline__ void hy_stage_conv(const Params& p, const bf16_t* __restrict__ row, int ch, bf16_t* dst, int dstStride, int dstPad,
                                              int nelem, int L, int tid) {
  const float w0 = p.hy_conv_w[ch], w1 = p.hy_conv_w[3072 + ch], w2 = p.hy_conv_w[2 * 3072 + ch], bb = p.hy_conv_b[ch];
  for (int q = tid; q < nelem / 8; q += NTHR) {
    const int e0 = q * 8, b = e0 / L, t0 = e0 & (L - 1);
    u32x4 raw = *(const u32x4*)(row + e0);
    float x[10];
    x[0] = t0 > 0 ? bf2f(row[e0 - 1]) : 0.f;
    x[9] = t0 + 8 < L ? bf2f(row[e0 + 8]) : 0.f;
    x[1] = bflo(raw.x); x[2] = bfhi(raw.x); x[3] = bflo(raw.y); x[4] = bfhi(raw.y);
    x[5] = bflo(raw.z); x[6] = bfhi(raw.z); x[7] = bflo(raw.w); x[8] = bfhi(raw.w);
    float o[8];
#pragma unroll
    for (int j = 0; j < 8; ++j) o[j] = w0 * x[j] + w1 * x[j + 1] + w2 * x[j + 2] + bb;
    u32x4 ov; ov.x = pack2(o[0], o[1]); ov.y = pack2(o[2], o[3]); ov.z = pack2(o[4], o[5]); ov.w = pack2(o[6], o[7]);
    *(u32x4*)(dst + b * dstStride + dstPad + t0) = ov;
  }
}

__device__ __forceinline__ void phase_hy_longconv(const Params& p, int bid, int nblk, unsigned char* smem, int cxw) {
  const int tid = opaque_tid(cxw), lane = tid & 63, w = cxw & 3  , r = lane & 31, hh = lane >> 5;
  const bf16_t* projT = (const bf16_t*)(p.scratch + SC_HY_PROJT);
  bf16_t* yT = (bf16_t*)(p.scratch + SC_HY_YT);
  unsigned* Rc0 = (unsigned*)smem;
  unsigned* Rc1 = Rc0 + 4096;
  bf16_t* G = (bf16_t*)smem;
  bf16_t* U = (bf16_t*)(smem + HY_UOFF);
  for (int item = bid; item < 2048; item += nblk) {
    const bool lat = item < 1024;
    const int c = item & 1023;
    const int L = lat ? 4096 : 256, NB = lat ? 4 : 32, RL = lat ? 8192 : 512, Lm1 = L - 1;
    const int PAD = lat ? 224 : 0, US = lat ? 4552 : 264;
    const int tokbase = lat ? T_CTX : 0;
    const int nI = L >> 5, nelem = NB * L;
    const int TPW = lat ? 4 : 2;
    __syncthreads();
    if (lat) {
      for (int q = tid; q < 4 * 57; q += NTHR) {
        int b = q / 57, k = q % 57;
        int off = k < 28 ? k * 8 : 224 + 4096 + (k - 28) * 8;
        unsigned zz = 0u; asm volatile("" : "+v"(zz));
        u32x4 z4 = {zz, zz, zz, zz};
        *(u32x4*)(U + b * US + off) = z4;
      }
    }
    hy_stage_conv(p, projT + (size_t)c * T_ALL + tokbase, c, U, US, PAD, nelem, L, tid);
    int Icol[4], bcol[4];
#pragma unroll
    for (int tt = 0; tt < 4; ++tt) {
      int n = (w * TPW + tt) * 32 + r;
      Icol[tt] = lat ? (n >> 2) : (n >> 5);
      bcol[tt] = lat ? (n & 3) : (n & 31);
    }
    const int Ilo_w = lat ? 32 * w : 2 * w, Ihi_w = lat ? 32 * w + 31 : 2 * w + 1;
    const int dlo = Ilo_w - (nI - 1), dhi = Ihi_w;
    for (int order = 0; order < 2; ++order) {
      {
        const bf16_t* src = (lat ? p.rtab1 : p.rtab0) + (size_t)(order * 1024 + c) * RL;
        for (int q = tid; q < RL / 8; q += NTHR) {
          u32x4 cv = *(const u32x4*)(src + q * 8);
          unsigned nx = (q + 1 < RL / 8) ? *(const unsigned*)(src + q * 8 + 8) : 0u;
          *(u32x4*)(Rc0 + q * 4) = cv;
          u32x4 sv;
          sv.x = (cv.x >> 16) | (cv.y << 16); sv.y = (cv.y >> 16) | (cv.z << 16);
          sv.z = (cv.z >> 16) | (cv.w << 16); sv.w = (cv.w >> 16) | (nx << 16);
          *(u32x4*)(Rc1 + q * 4) = sv;
        }
      }
      __syncthreads();
      f32x16 acc[4];
#pragma unroll
      for (int tt = 0; tt < 4; ++tt)
#pragma unroll
        for (int e = 0; e < 16; ++e) acc[tt][e] = 0.f;
      {
        int lo_t[4], hi_t[4];
        const bf16_t* ub[4];
#pragma unroll
        for (int tt = 0; tt < 4; ++tt) {
          const int tile = w * TPW + tt;
          const int Ilo_t = lat ? 8 * tile : tile, Ihi_t = lat ? 8 * tile + 7 : tile;
          lo_t[tt] = tt < TPW ? Ilo_t - (nI - 1) : 1 << 30; hi_t[tt] = tt < TPW ? Ihi_t : -(1 << 30);
          ub[tt] = U + bcol[tt] * US + PAD + 32 * Icol[tt] + 8 * hh;
        }
        const int ybase = Lm1 - r + 8 * hh;
#define LC_EDGE(D0, D1) do { for (int d_ = (D0); d_ <= (D1); ++d_) { \
          _Pragma("unroll") for (int kk_ = 0; kk_ < 2; ++kk_) { \
            const int y0_ = ybase - 32 * d_ + 16 * kk_; const int par_ = y0_ & 1; \
            const unsigned* rp_ = (par_ ? Rc1 : Rc0) + ((y0_ - par_) >> 1); \
            u32x4 av_; av_.x = rp_[0]; av_.y = rp_[1]; av_.z = rp_[2]; av_.w = rp_[3]; const bf16x8 af_ = __builtin_bit_cast(bf16x8, av_); \
            _Pragma("unroll") for (int tt = 0; tt < 4; ++tt) if (d_ >= lo_t[tt] && d_ <= hi_t[tt]) \
              acc[tt] = __builtin_amdgcn_mfma_f32_32x32x16_bf16(af_, *(const bf16x8*)(ub[tt] - 32 * d_ + 16 * kk_), acc[tt], 0, 0, 0); } } } while (0)
        if (!lat) {
          LC_EDGE(dlo, dhi);
        } else {
          const int mlo = lo_t[3], mhi = hi_t[0];
          LC_EDGE(dlo, mlo - 1);
#define LC_LOAD(IT, A, B) do { const int it_ = (IT); const int d_ = mlo + (it_ >> 1), kk_ = it_ & 1; \
          const int y0_ = ybase - 32 * d_ + 16 * kk_; const int par_ = y0_ & 1; \
          const unsigned* rp_ = (par_ ? Rc1 : Rc0) + ((y0_ - par_) >> 1); \
          u32x4 av_; av_.x = rp_[0]; av_.y = rp_[1]; av_.z = rp_[2]; av_.w = rp_[3]; A = __builtin_bit_cast(bf16x8, av_); \
          _Pragma("unroll") for (int tt = 0; tt < 4; ++tt) B[tt] = *(const bf16x8*)(ub[tt] - 32 * d_ + 16 * kk_); } while (0)
#define LC_MMA(A, B) do { _Pragma("unroll") for (int tt = 0; tt < 4; ++tt) acc[tt] = __builtin_amdgcn_mfma_f32_32x32x16_bf16(A, B[tt], acc[tt], 0, 0, 0); } while (0)
          const int NIT = 2 * (mhi - mlo + 1);
          bf16x8 a0, a1, b0[4], b1[4];
          LC_LOAD(0, a0, b0);
          for (int it = 0; it < NIT; it += 2) {
            LC_LOAD(it + 1, a1, b1);
            LC_MMA(a0, b0);
            LC_LOAD(it + 2 < NIT ? it + 2 : NIT - 1, a0, b0);
            LC_MMA(a1, b1);
          }
#undef LC_LOAD
#undef LC_MMA
          LC_EDGE(mhi + 1, dhi);
        }
#undef LC_EDGE
      }
      __syncthreads();
      hy_stage_conv(p, projT + (size_t)((1 + order) * 1024 + c) * T_ALL + tokbase, (1 + order) * 1024 + c, G, L, 0, nelem, L, tid);
      __syncthreads();
      const float inv = 1.f / p.knorm[((lat ? 1 : 0) * 2 + order) * 1024 + c];
      const float bias = p.hy_f_bias[order * 1024 + c];
#pragma unroll
      for (int tt = 0; tt < 4; ++tt) {
        if (tt < TPW) {
#pragma unroll
          for (int qd = 0; qd < 4; ++qd) {
            const int t0 = 32 * Icol[tt] + 8 * qd + 4 * hh;
            bf16_t* up = U + bcol[tt] * US + PAD + t0;
            u32x2 uc = *(const u32x2*)up;
            u32x2 gg = *(const u32x2*)(G + bcol[tt] * L + t0);
            float r0 = (inv * acc[tt][4 * qd] + bias * bflo(uc.x)) * bflo(gg.x);
            float r1 = (inv * acc[tt][4 * qd + 1] + bias * bfhi(uc.x)) * bfhi(gg.x);
            float r2 = (inv * acc[tt][4 * qd + 2] + bias * bflo(uc.y)) * bflo(gg.y);
            float r3 = (inv * acc[tt][4 * qd + 3] + bias * bfhi(uc.y)) * bfhi(gg.y);
            if (order == 1) {
              u32x2 zz = *(const u32x2*)(projT + (size_t)(3072 + c) * T_ALL + tokbase + bcol[tt] * L + t0);
              r0 *= siluf(bflo(zz.x)); r1 *= siluf(bfhi(zz.x)); r2 *= siluf(bflo(zz.y)); r3 *= siluf(bfhi(zz.y));
            }
            u32x2 ov; ov.x = pack2(r0, r1); ov.y = pack2(r2, r3);
            *(u32x2*)up = ov;
          }
        }
      }
      __syncthreads();
    }
    for (int q = tid; q < nelem / 8; q += NTHR) {
      const int e0 = q * 8, b = e0 / L, t0 = e0 & (L - 1);
      *(u32x4*)(yT + (size_t)c * T_ALL + tokbase + e0) = *(const u32x4*)(U + b * US + PAD + t0);
    }
  }
}

__device__ __forceinline__ void phase_hy_transpose(const Params& p, int bid, int nblk, unsigned char* smem, int cxw) {
  const int tid = opaque_tid(cxw);
  const bf16_t* yT = (const bf16_t*)(p.scratch + SC_HY_YT);
  bf16_t* yg = (bf16_t*)(p.scratch + SC_HY_YG);
  bf16_t* tl = (bf16_t*)smem;
  for (int item = bid; item < 16 * (T_ALL / 64); item += nblk) {
    const int cb = item & 15, tb = item >> 4;
    __syncthreads();
#pragma unroll
    for (int i = 0; i < 2; ++i) {
      int q = tid + i * 256, cr = q >> 3, t8 = (q & 7) * 8;
      u32x4 v = *(const u32x4*)(yT + (size_t)(cb * 64 + cr) * T_ALL + tb * 64 + t8);
      unsigned wv[4] = {v.x, v.y, v.z, v.w};
#pragma unroll
      for (int e = 0; e < 4; ++e) {
        tl[(t8 + 2 * e) * 72 + cr] = (bf16_t)(wv[e] & 0xffffu);
        tl[(t8 + 2 * e + 1) * 72 + cr] = (bf16_t)(wv[e] >> 16);
      }
    }
    __syncthreads();
#pragma unroll
    for (int i = 0; i < 2; ++i) {
      int q = tid + i * 256, tr = q >> 3, c8 = (q & 7) * 8;
      *(u32x4*)(yg + (size_t)(tb * 64 + tr) * 1024 + cb * 64 + c8) = *(const u32x4*)(tl + tr * 72 + c8);
    }
  }
}

#define LRU_NCH 384
struct Lru4 { float af[4], bxf[4], ab[4], bxb[4]; };
__device__ __forceinline__ void lru_unpack4(u32x2 v, float (&o)[4]) { o[0] = bflo(v.x); o[1] = bfhi(v.x); o[2] = bflo(v.y); o[3] = bfhi(v.y); }
__device__ __forceinline__ void lru_row_f(const bf16_t* gates, const bf16_t* xc, size_t o, const float (&spf)[4], float (&af)[4], float (&bxf)[4]) {
  float r[4], g[4], x[4];
  lru_unpack4(*(const u32x2*)(gates + o), r); lru_unpack4(*(const u32x2*)(gates + (size_t)T_ALL * 1024 + o), g); lru_unpack4(*(const u32x2*)(xc + o), x);
#pragma unroll
  for (int e = 0; e < 4; ++e) { const float la = -8.f * r[e] * spf[e]; af[e] = __expf(la); bxf[e] = sqrtf(fmaxf(1.f - __expf(2.f * la), 0.f)) * g[e] * x[e]; }
}
__device__ __forceinline__ void lru_row_b(const bf16_t* gates, const bf16_t* xc, size_t o, const float (&spb)[4], float (&ab)[4], float (&bxb)[4]) {
  float r[4], g[4], x[4];
  lru_unpack4(*(const u32x2*)(gates + (size_t)2 * T_ALL * 1024 + o), r); lru_unpack4(*(const u32x2*)(gates + (size_t)3 * T_ALL * 1024 + o), g); lru_unpack4(*(const u32x2*)(xc + o), x);
#pragma unroll
  for (int e = 0; e < 4; ++e) { const float la = -8.f * r[e] * spb[e]; ab[e] = __expf(la); bxb[e] = sqrtf(fmaxf(1.f - __expf(2.f * la), 0.f)) * g[e] * x[e]; }
}
__device__ __forceinline__ void phase_lru_scan_agg(const Params& p, int bid, int nblk, unsigned char* smem, int cxw) {
  const int tidx = opaque_tid(cxw);
  const bf16_t* gates = (const bf16_t*)(p.scratch + SC_LRU_GATES);
  const bf16_t* xc = (const bf16_t*)(p.scratch + SC_LRU_XC);
  float* sagg = (float*)smem;
  const int sub = cxw & 3, cq = tidx & 63;
  for (int item = bid; item < LRU_NCH * 4; item += nblk) {
    const int chunk = item >> 2, cb = item & 3;
    const int c0 = cb * 256 + 4 * cq;
    float spf[4], spb[4];
#pragma unroll
    for (int e = 0; e < 4; ++e) { spf[e] = softplusf(-p.lru_a_param[c0 + e]); spb[e] = softplusf(-p.lru_a_param[1024 + c0 + e]); }
    const int tok0 = chunk * 64 + 16 * sub;
    float Af[4] = {1.f, 1.f, 1.f, 1.f}, hf[4] = {0.f, 0.f, 0.f, 0.f}, Pb[4] = {1.f, 1.f, 1.f, 1.f}, Bb[4] = {0.f, 0.f, 0.f, 0.f};
#pragma unroll 4
    for (int j = 0; j < 16; ++j) {
      const size_t o = (size_t)(tok0 + j) * 1024 + c0;
      float af[4], bxf[4], ab[4], bxb[4];
      lru_row_f(gates, xc, o, spf, af, bxf);
      lru_row_b(gates, xc, o, spb, ab, bxb);
#pragma unroll
      for (int e = 0; e < 4; ++e) { hf[e] = af[e] * hf[e] + bxf[e]; Af[e] *= af[e]; Bb[e] += bxb[e] * Pb[e]; Pb[e] *= ab[e]; }
    }
    {
      const size_t sc = (size_t)chunk * 4 + sub;
      float* gf = p.lru_sagg + (((size_t)0 * (LRU_NCH * 4) + sc) * 1024 + c0) * 2;
      float* gb = p.lru_sagg + (((size_t)1 * (LRU_NCH * 4) + sc) * 1024 + c0) * 2;
      f32x4 v0 = {Af[0], hf[0], Af[1], hf[1]}, v1 = {Af[2], hf[2], Af[3], hf[3]};
      f32x4 w0 = {Pb[0], Bb[0], Pb[1], Bb[1]}, w1 = {Pb[2], Bb[2], Pb[3], Bb[3]};
      *(f32x4*)gf = v0; *(f32x4*)(gf + 4) = v1; *(f32x4*)gb = w0; *(f32x4*)(gb + 4) = w1;
      __syncthreads();
      float* sl = sagg + (sub * 64 + cq) * 16;
      *(f32x4*)sl = v0; *(f32x4*)(sl + 4) = v1; *(f32x4*)(sl + 8) = w0; *(f32x4*)(sl + 12) = w1;
      __syncthreads();
    }
    if (sub == 0) {
      float A[4], B[4], P[4], Q[4];
#pragma unroll
      for (int e = 0; e < 4; ++e) { A[e] = 1.f; B[e] = 0.f; P[e] = 1.f; Q[e] = 0.f; }
#pragma unroll
      for (int s2 = 0; s2 < 4; ++s2) {
        const float* lf = sagg + (s2 * 64 + cq) * 16;
        const float* lb = sagg + ((3 - s2) * 64 + cq) * 16 + 8;
#pragma unroll
        for (int e = 0; e < 4; ++e) {
          const float a = lf[2 * e], b = lf[2 * e + 1];
          B[e] = a * B[e] + b; A[e] *= a;
          const float pb = lb[2 * e], qb = lb[2 * e + 1];
          Q[e] = pb * Q[e] + qb; P[e] *= pb;
        }
      }
      float* gf = p.lru_agg + (((size_t)0 * LRU_NCH + chunk) * 1024 + c0) * 2;
      float* gb = p.lru_agg + (((size_t)1 * LRU_NCH + chunk) * 1024 + c0) * 2;
      f32x4 v0 = {A[0], B[0], A[1], B[1]}, v1 = {A[2], B[2], A[3], B[3]}, w0 = {P[0], Q[0], P[1], Q[1]}, w1 = {P[2], Q[2], P[3], Q[3]};
      *(f32x4*)gf = v0; *(f32x4*)(gf + 4) = v1; *(f32x4*)gb = w0; *(f32x4*)(gb + 4) = w1;
    }
  }
}
__device__ __forceinline__ void phase_lru_scan_carry(const Params& p, int bid, int nblk, int cxw) {
  const int tidx = opaque_tid(cxw);
  for (int item = bid; item < 36 * 8; item += nblk) {
    int s = item >> 3, dir = (item >> 2) & 1, cb = item & 3;
    int c = cb * 256 + tidx;
    int nch = s < 32 ? 4 : 64;
    int ch0 = s < 32 ? s * 4 : 128 + (s - 32) * 64;
    float h = s < 32 ? 0.f : p.state_lru[((size_t)(s - 32) * 2 + dir) * 1024 + c];
    for (int k0 = 0; k0 < nch; k0 += 4) {
      f32x2_t ag[4]; size_t idx[4];
#pragma unroll
      for (int u = 0; u < 4; ++u) {
        const int chunk = dir ? ch0 + nch - 1 - (k0 + u) : ch0 + k0 + u;
        idx[u] = ((size_t)dir * LRU_NCH + chunk) * 1024 + c;
        ag[u] = *(const f32x2_t*)(p.lru_agg + idx[u] * 2);
      }
#pragma unroll
      for (int u = 0; u < 4; ++u) { p.lru_hin[idx[u]] = h; h = ag[u].x * h + ag[u].y; }
    }
    if (s < 32) p.out_lru[((size_t)s * 2 + dir) * 1024 + c] = h;
  }
}
__device__ __forceinline__ void phase_lru_scan_final(const Params& p, int bid, int nblk, unsigned char* smem, int cxw) {
  const int tidx = opaque_tid(cxw);
  const bf16_t* gates = (const bf16_t*)(p.scratch + SC_LRU_GATES);
  const bf16_t* xc = (const bf16_t*)(p.scratch + SC_LRU_XC);
  const bf16_t* proj = (const bf16_t*)(p.scratch + SC_LRU_PROJ);
  bf16_t* yg = (bf16_t*)(p.scratch + SC_LRU_YG);
  const int sub = cxw & 3, cq = tidx & 63;
  for (int item = bid; item < LRU_NCH * 4; item += nblk) {
    const int chunk = item >> 2, cb = item & 3;
    const int c0 = cb * 256 + 4 * cq;
    float spf[4], spb[4];
#pragma unroll
    for (int e = 0; e < 4; ++e) { spf[e] = softplusf(-p.lru_a_param[c0 + e]); spb[e] = softplusf(-p.lru_a_param[1024 + c0 + e]); }
    float hf[4], hb[4];
    {
      const f32x4 a = *(const f32x4*)(p.lru_hin + ((size_t)0 * LRU_NCH + chunk) * 1024 + c0);
      const f32x4 b = *(const f32x4*)(p.lru_hin + ((size_t)1 * LRU_NCH + chunk) * 1024 + c0);
      hf[0] = a.x; hf[1] = a.y; hf[2] = a.z; hf[3] = a.w; hb[0] = b.x; hb[1] = b.y; hb[2] = b.z; hb[3] = b.w;
    }
#pragma unroll
    for (int s2 = 0; s2 < 3; ++s2) {
      if (s2 < sub) {
        const float* g = p.lru_sagg + (((size_t)0 * (LRU_NCH * 4) + (size_t)chunk * 4 + s2) * 1024 + c0) * 2;
        const f32x4 v0 = *(const f32x4*)g, v1 = *(const f32x4*)(g + 4);
        hf[0] = v0.x * hf[0] + v0.y; hf[1] = v0.z * hf[1] + v0.w; hf[2] = v1.x * hf[2] + v1.y; hf[3] = v1.z * hf[3] + v1.w;
      }
      if (3 - s2 > sub) {
        const float* g = p.lru_sagg + (((size_t)1 * (LRU_NCH * 4) + (size_t)chunk * 4 + (3 - s2)) * 1024 + c0) * 2;
        const f32x4 v0 = *(const f32x4*)g, v1 = *(const f32x4*)(g + 4);
        hb[0] = v0.x * hb[0] + v0.y; hb[1] = v0.z * hb[1] + v0.w; hb[2] = v1.x * hb[2] + v1.y; hb[3] = v1.z * hb[3] + v1.w;
      }
    }
    const int tok0 = chunk * 64 + 16 * sub;
    float hfs[16][4];
#pragma unroll
    for (int j = 0; j < 16; ++j) {
      const size_t o = (size_t)(tok0 + j) * 1024 + c0;
      float af[4], bxf[4];
      lru_row_f(gates, xc, o, spf, af, bxf);
#pragma unroll
      for (int e = 0; e < 4; ++e) { hf[e] = af[e] * hf[e] + bxf[e]; hfs[j][e] = hf[e]; }
    }
#pragma unroll
    for (int j = 15; j >= 0; --j) {
      const size_t o = (size_t)(tok0 + j) * 1024 + c0;
      float ab[4], bxb[4], z[4];
      lru_row_b(gates, xc, o, spb, ab, bxb);
      lru_unpack4(*(const u32x2*)(proj + (size_t)(tok0 + j) * 2048 + 1024 + c0), z);
      float y[4];
#pragma unroll
      for (int e = 0; e < 4; ++e) { hb[e] = ab[e] * hb[e] + bxb[e]; y[e] = (hfs[j][e] + hb[e]) * siluf(z[e]); }
      u32x2 ov; ov.x = pack2(y[0], y[1]); ov.y = pack2(y[2], y[3]);
      *(u32x2*)(yg + o) = ov;
    }
  }
}

enum { PH_PREP = 0, PH_MOD, PH_HYA, PH_HYB, PH_LNMOD, PH_INPROJ, PH_MIX1, PH_MIX2, PH_MIX3, PH_MIX4, PH_MIX5, PH_MIX6, PH_OUTPROJ };

struct Ctx { int bid, nblk, wave; unsigned char* smem; unsigned char* wg_smem; };

template <class Epi>
__device__ __forceinline__ void run_gemm(const Ctx& cx, const bf16_t* A, int lda, const bf16_t* Bt, int M, int N, int K, int grp_shift, int grp_bytes, const Epi& e) {
  pg8::Gemm g{A, Bt, M, N, K, lda, grp_shift, grp_bytes};
  pg8::StaticOrder S; S.init(M, N, gridDim.x, opaque_s(blockIdx.x));
  pg8::gemm_phase((PG8_LAS unsigned char*)cx.wg_smem, g, S, e, cx.wave);
}

#define N_PARAM_WORDS (sizeof(Params) / 8)
__device__ __forceinline__ Params load_params(const unsigned char* lp) {
  Params p;
  unsigned long long* d = (unsigned long long*)&p;
  const unsigned long long* sp = (const unsigned long long*)lp;
#pragma unroll
  for (int i = 0; i < (int)N_PARAM_WORDS; ++i) {
    const unsigned long long v = sp[i];
    const unsigned lo = __builtin_amdgcn_readfirstlane((unsigned)v), hi = __builtin_amdgcn_readfirstlane((unsigned)(v >> 32));
    d[i] = ((unsigned long long)hi << 32) | lo;
  }
  return p;
}
__device__ __forceinline__ void run_phase(const unsigned char* lparams, int ph, int layer, const Ctx& cx) {
  const Params p = load_params(lparams);
  const int kind = layer % 3, slot = layer / 3;
  const int bid = opaque_s(cx.bid), nblk = cx.nblk;
  unsigned char* smem = cx.smem;
  switch (ph) {
    case PH_PREP: phase_prep(p, bid, nblk, smem, cx.wave); break;
    case PH_MOD: phase_mod(p, bid, nblk, smem, cx.wave); break;
    case PH_HYA: phase_hyfilt_a(p, bid, nblk, smem, cx.wave); break;
    case PH_HYB: phase_hyfilt_b(p, bid, nblk, smem, cx.wave); break;
    case PH_LNMOD: phase_lnmod(p, layer, bid, nblk, cx.wave); break;
    case PH_INPROJ:
      if (kind == 0) {
        pg8::EpiSsdIn e{(bf16_t*)(p.scratch + SC_SSD_Z), (bf16_t*)(p.scratch + SC_SSD_XBC), (float*)(p.scratch + SC_SSD_DT), p.ssd_dt_bias + slot * 64};
        run_gemm(cx, p.hbuf, 1024, p.wt_ssd_in + (size_t)slot * 6400 * 1024, T_ALL, 6400, 1024, 30, 0, e);
      } else if (kind == 1) {
        pg8::EpiBf16 e{(bf16_t*)(p.scratch + SC_HY_PROJT), (size_t)T_ALL};
        run_gemm(cx, p.wt_hy_in, 1024, p.hbuf, 4096, T_ALL, 1024, 30, 0, e);
      } else {
        pg8::EpiBf16 e{(bf16_t*)(p.scratch + SC_LRU_PROJ), (size_t)2048};
        run_gemm(cx, p.hbuf, 1024, p.wt_lru_in, T_ALL, 2048, 1024, 30, 0, e);
      }
      break;
    case PH_MIX1:
      if (kind == 0) phase_ssd_conv(p, slot, slot == 1, bid, nblk, smem, cx.wave);
      else if (kind == 1) phase_hy_longconv(p, bid, nblk, smem, cx.wave);
      else phase_dwconv<4, false>((const bf16_t*)(p.scratch + SC_LRU_PROJ), 2048, (bf16_t*)(p.scratch + SC_LRU_XC), 1024, 1024,
                                  p.lru_conv_w, p.lru_conv_b, false, bid, nblk, cx.wave);
      break;
    case PH_MIX2:
      if (kind == 0) phase_ssd_scan(p, slot, slot == 1, bid, nblk, smem, cx.wave);
      else if (kind == 1) phase_hy_transpose(p, bid, nblk, smem, cx.wave);
      else {
        pg8::EpiLruGate e{(bf16_t*)(p.scratch + SC_LRU_GATES), p.lru_gate_b};
        run_gemm(cx, (const bf16_t*)(p.scratch + SC_LRU_XC), 1024, p.wt_lru_gate, T_ALL, 4096, 256, 2, 512, e);
      }
      break;
    case PH_MIX3:
      if (kind == 0) phase_ssd_gate(p, slot, bid, nblk, cx.wave);
      else phase_lru_scan_agg(p, bid, nblk, smem, cx.wave);
      break;
    case PH_MIX4: if (kind == 2) phase_lru_scan_carry(p, bid, nblk, cx.wave); break;
    case PH_MIX5: if (kind == 2) phase_lru_scan_final(p, bid, nblk, smem, cx.wave); break;
    case PH_OUTPROJ: {
      const float* mv = p.modv + (size_t)layer * 5 * 3072;
      if (kind == 0) {
        pg8::EpiOut e{p.xres, mv, p.rstd};
        run_gemm(cx, (const bf16_t*)(p.scratch + SC_SSD_Z), 2048, p.wt_ssd_out + (size_t)slot * 1024 * 2048, T_ALL, 1024, 2048, 30, 0, e);
      } else if (kind == 1) {
        pg8::EpiOut e{p.xres, mv, nullptr};
        run_gemm(cx, (const bf16_t*)(p.scratch + SC_HY_YG), 1024, p.wt_hy_out, T_ALL, 1024, 1024, 30, 0, e);
      } else {
        pg8::EpiOut e{p.xres, mv, nullptr};
        run_gemm(cx, (const bf16_t*)(p.scratch + SC_LRU_YG), 1024, p.wt_lru_out, T_ALL, 1024, 1024, 30, 0, e);
      }
    } break;
  }
}

__global__ void __launch_bounds__(WG_THREADS, 2) k_mega(Params p) {
  __shared__ __attribute__((aligned(16))) unsigned char smem[WG_SMEM + 16 + 512];
  cg::grid_group grid = cg::this_grid();
  const int wave0 = __builtin_amdgcn_readfirstlane((int)(threadIdx.x >> 6));
  const int vb = wave0 >> 2;
  Ctx cx;
  cx.wave = wave0;
  cx.bid = 2 * blockIdx.x + vb; cx.nblk = 2 * gridDim.x; cx.smem = smem + vb * SMEM_BYTES; cx.wg_smem = smem;
  volatile LAS unsigned* xst = (volatile LAS unsigned*)(smem + WG_SMEM);
  unsigned char* lparams = smem + WG_SMEM + 16;
  if (threadIdx.x == 0) { xst[0] = 0u; xst[1] = 0u; *(Params*)lparams = p; }
  __syncthreads();
  const XcdBarrier xb = xcd_barrier_post(p.bar, xst);
  run_phase(lparams, PH_PREP, 0, cx);
  run_phase(lparams, PH_MOD, 0, cx);
  run_phase(lparams, PH_HYA, 0, cx);
  grid.sync();
  run_phase(lparams, PH_HYB, 0, cx);
  for (int layer = 0; layer < 4; ++layer) {
    const int kind = layer % 3;
    run_phase(lparams, PH_LNMOD, layer, cx);
    xcd_barrier(xb, cx.wave);
    run_phase(lparams, PH_INPROJ, layer, cx);
    xcd_barrier(xb, cx.wave);
    run_phase(lparams, PH_MIX1, layer, cx);
    xcd_barrier(xb, cx.wave);
    run_phase(lparams, PH_MIX2, layer, cx);
    xcd_barrier(xb, cx.wave);
    if (kind != 1) {
      run_phase(lparams, PH_MIX3, layer, cx);
      xcd_barrier(xb, cx.wave);
    }
    if (kind == 2) {
      run_phase(lparams, PH_MIX4, layer, cx);
      xcd_barrier(xb, cx.wave);
      run_phase(lparams, PH_MIX5, layer, cx);
      xcd_barrier(xb, cx.wave);
    }
    run_phase(lparams, PH_OUTPROJ, layer, cx);
    xcd_barrier(xb, cx.wave);
  }
  run_phase(lparams, PH_LNMOD, 4, cx);
}

static inline size_t align_up(size_t x) { return (x + 255) & ~(size_t)255; }

extern "C" void kernel_launch(void* const* d_in, const int* in_sizes, int n_in, void* d_out, int out_size, void* d_ws, size_t ws_size,
                              hipStream_t stream) {
  Params p{};
  const float** fp = (const float**)&p;
  for (int i = 0; i < 36; ++i) fp[i] = (const float*)d_in[i];
  float* out = (float*)d_out;
  p.xres = out;
  p.out_ssd = out + (size_t)T_ALL * 1024;
  p.out_lru = p.out_ssd + (size_t)32 * 2 * 2 * 32 * 64 * 128;
  unsigned char* w = (unsigned char*)d_ws;
  size_t off = 0;
  auto carve = [&](size_t bytes) { unsigned char* r = w + off; off = align_up(off + bytes); return r; };
  p.wt_ssd_in = (bf16_t*)carve((size_t)2 * 6400 * 1024 * 2);
  p.wt_ssd_out = (bf16_t*)carve((size_t)2 * 1024 * 2048 * 2);
  p.wt_hy_in = (bf16_t*)carve((size_t)4096 * 1024 * 2);
  p.wt_hy_out = (bf16_t*)carve((size_t)1024 * 1024 * 2);
  p.wt_lru_in = (bf16_t*)carve((size_t)2048 * 1024 * 2);
  p.wt_lru_out = (bf16_t*)carve((size_t)1024 * 1024 * 2);
  p.wt_lru_gate = (bf16_t*)carve((size_t)4 * 1024 * 256 * 2);
  p.modv = (float*)carve((size_t)4 * 5 * 3072 * 4);
  p.hdn2 = (float*)carve((size_t)4352 * 64 * 4);
  p.rtab0 = (bf16_t*)carve((size_t)2 * 1024 * 512 * 2);
  p.rtab1 = (bf16_t*)carve((size_t)2 * 1024 * 8192 * 2);
  p.knorm = (float*)carve((size_t)4 * 1024 * 4);
  p.hbuf = (bf16_t*)carve((size_t)T_ALL * 1024 * 2);
  p.rstd = (float*)carve((size_t)T_ALL * 4);
  p.lru_agg = (float*)carve((size_t)2 * 384 * 1024 * 2 * 4);
  p.lru_hin = (float*)carve((size_t)2 * 384 * 1024 * 4);
  p.lru_sagg = (float*)carve((size_t)2 * 1536 * 1024 * 2 * 4);
  p.bar = (unsigned*)carve((size_t)XCD_BAR_WORDS * 4);
  p.scratch = carve(SC_TOTAL);
  if (off > ws_size) return;

  static int grid_blocks = 0;
  if (!grid_blocks) {
    int dev = 0, cus = 0, per_cu = 0;
    hipGetDevice(&dev);
    hipDeviceGetAttribute(&cus, hipDeviceAttributeMultiprocessorCount, dev);
    hipOccupancyMaxActiveBlocksPerMultiprocessor(&per_cu, k_mega, WG_THREADS, 0);
    if (per_cu > 1) per_cu = 1;
    grid_blocks = cus * per_cu;
  }
  hipMemsetAsync(p.bar, 0, (size_t)XCD_BAR_WORDS * 4, stream);
  void* args[] = {&p};
  hipError_t e = hipLaunchCooperativeKernel((void*)k_mega, dim3(grid_blocks), dim3(WG_THREADS), args, 0, stream);
  if (e != hipSuccess) fprintf(stderr, "cooperative launch failed: %s (grid %d)\n", hipGetErrorString(e), grid_blocks);
}
```

```cpp
#include <hip/hip_runtime.h>
#include <hip/hip_bf16.h>
#include <hip/hip_cooperative_groups.h>
#include <stdint.h>
#include <cstdio>
namespace cg = cooperative_groups;

typedef unsigned short bf16_t;
typedef __attribute__((ext_vector_type(8))) short bf16x8;
typedef __attribute__((ext_vector_type(16))) float f32x16;
typedef __attribute__((ext_vector_type(4))) unsigned int u32x4;
typedef __attribute__((ext_vector_type(2))) unsigned int u32x2;
typedef __attribute__((ext_vector_type(4))) float f32x4;
typedef float f32x4_t __attribute__((ext_vector_type(4)));
typedef float f32x2_t __attribute__((ext_vector_type(2)));

#define T_CTX 8192
#define T_ALL 24576
#define DM 1024
#define NTHR 256
#define SMEM_BYTES 69632
#define WG_THREADS 512
#define WG_SMEM 147456
#define ALPHA_RES 1.6817928305074290f
#define LN_EPS 1e-5f

__device__ __forceinline__ bf16_t f2bf(float f) { __bf16 h = (__bf16)f; return __builtin_bit_cast(bf16_t, h); }
__device__ __forceinline__ float bf2f(bf16_t b) { return __uint_as_float(((unsigned)b) << 16); }
__device__ __forceinline__ float bflo(unsigned w) { return __uint_as_float(w << 16); }
__device__ __forceinline__ float bfhi(unsigned w) { return __uint_as_float(w & 0xffff0000u); }
typedef __bf16 bf16v2_t __attribute__((ext_vector_type(2)));
typedef float f32v2_t __attribute__((ext_vector_type(2)));
__device__ __forceinline__ unsigned pack2(float a, float b) { f32v2_t v = {a, b}; bf16v2_t h = __builtin_convertvector(v, bf16v2_t); return __builtin_bit_cast(unsigned, h); }
__device__ __forceinline__ float siluf(float x) { return x * __builtin_amdgcn_rcpf(1.f + __expf(-x)); }
__device__ __forceinline__ float sigmoidf(float x) { return __builtin_amdgcn_rcpf(1.f + __expf(-x)); }
__device__ __forceinline__ float softplusf(float x) { return x > 20.f ? x : __logf(1.f + __expf(x)); }


__device__ __forceinline__ int opaque_lane() { int z = 0; asm volatile("" : "+v"(z)); return __builtin_amdgcn_mbcnt_hi(~0u, __builtin_amdgcn_mbcnt_lo(~0u, (unsigned)z)); }
__device__ __forceinline__ int opaque_tid512(int wave) { return (wave << 6) + opaque_lane(); }
__device__ __forceinline__ int opaque_tid(int wave) { return opaque_tid512(wave) & 255; }

#define XB_TMO      128
#define XB_XCNT(j)  (256  + 64 * (j))
#define XB_XSUB(j)  (1280 + 64 * (j))
#define XB_XGEN(j)  (2304 + 64 * (j))
#define XB_TOP      3328
#define XB_TOPGEN   3392
#define XCD_BAR_WORDS 3456
#define XB_SPIN_CAP (1u << 18)
#define LAS __attribute__((address_space(3)))
__device__ __forceinline__ unsigned xb_ld(unsigned* p)              { return __hip_atomic_load(p, __ATOMIC_RELAXED, __HIP_MEMORY_SCOPE_AGENT); }
__device__ __forceinline__ unsigned xb_add(unsigned* p, unsigned v) { return __hip_atomic_fetch_add(p, v, __ATOMIC_RELAXED, __HIP_MEMORY_SCOPE_AGENT); }
__device__ __forceinline__ unsigned xb_xcc_id() { return (unsigned)__builtin_amdgcn_s_getreg((3 << 11) | 20) & 0xFu; }
#define XB_SPIN(cond, bar) do { unsigned _sp = 0; while (cond) { __builtin_amdgcn_s_sleep(1); \
    if ((++_sp & 255u) == 0u) { if (xb_ld(&(bar)[XB_TMO])) break; if (_sp > XB_SPIN_CAP) { atomicAdd(&(bar)[XB_TMO], 1u); break; } } } } while (0)
struct XcdBarrier { unsigned* bar; unsigned x; volatile LAS unsigned* st; };
__device__ __forceinline__ XcdBarrier xcd_barrier_post(unsigned* bar, volatile LAS unsigned* st) {
  XcdBarrier b; b.bar = bar; b.x = xb_xcc_id(); b.st = st;
  if (threadIdx.x == 0) (void)xb_add(&bar[XB_XCNT(b.x)], 1u);
  return b;
}
__device__ __forceinline__ void xcd_barrier_complete(unsigned* bar, unsigned x, unsigned& nloc, unsigned& nx) {
  const unsigned G = gridDim.x * gridDim.y * gridDim.z;
  unsigned sum, cnt, mine, sp = 0u;
  for (;;) {
    sum = 0u; cnt = 0u; mine = 0u;
#pragma unroll
    for (unsigned j = 0; j < 16; ++j) { const unsigned c = xb_ld(&bar[XB_XCNT(j)]); sum += c; cnt += (c > 0u) ? 1u : 0u; mine = (j == x) ? c : mine; }
    if (sum == G) break;
    __builtin_amdgcn_s_sleep(1);
    if ((++sp & 255u) == 0u) { if (xb_ld(&bar[XB_TMO])) break; if (sp > XB_SPIN_CAP) { atomicAdd(&bar[XB_TMO], 1u); break; } }
  }
  nloc = mine > 0u ? mine : 1u; nx = cnt > 0u ? cnt : 1u;
}
__device__ __forceinline__ void xcd_barrier(const XcdBarrier& b, int wave) {
  asm volatile("s_waitcnt vmcnt(0)" ::: "memory");
  __syncthreads();
  if (opaque_tid512(wave) == 0) {
    unsigned* bar = b.bar;
    __builtin_amdgcn_s_waitcnt(0);
    unsigned nloc = b.st[0], nx = b.st[1];
    if (nloc == 0u) { xcd_barrier_complete(bar, b.x, nloc, nx); b.st[0] = nloc; b.st[1] = nx; }
    const unsigned old = xb_add(&bar[XB_XSUB(b.x)], 1u);
    const unsigned gen = old / nloc;
    if (old + 1u == (gen + 1u) * nloc) {
      __builtin_amdgcn_fence(__ATOMIC_RELEASE, "agent");
      asm volatile("s_waitcnt vmcnt(0)" ::: "memory");
      const unsigned og = xb_add(&bar[XB_TOP], 1u);
      const unsigned tg = og / nx;
      if (og + 1u == (tg + 1u) * nx) xb_add(&bar[XB_TOPGEN], 1u);
      else XB_SPIN(xb_ld(&bar[XB_TOPGEN]) == tg, bar);
      __builtin_amdgcn_fence(__ATOMIC_ACQUIRE, "agent");
      xb_add(&bar[XB_XGEN(b.x)], 1u);
      asm volatile("s_waitcnt vmcnt(0)" ::: "memory");
    } else {
      XB_SPIN(xb_ld(&bar[XB_XGEN(b.x)]) == gen, bar);
      __builtin_amdgcn_fence(__ATOMIC_ACQUIRE, "agent");
      asm volatile("s_waitcnt vmcnt(0)" ::: "memory");
    }
  }
  __syncthreads();
}


__device__ __forceinline__ int opaque_s(int x) { asm volatile("" : "+s"(x)); return x; }

__device__ __forceinline__ float shfl_idx_f(float v, int src) { return __int_as_float(__builtin_amdgcn_ds_bpermute(src << 2, __float_as_int(v))); }
__device__ __forceinline__ float shfl_xor_f(float v, int off, int lane) { return shfl_idx_f(v, lane ^ off); }

__device__ __forceinline__ float wave_incl_scan(float v) {
#define DPP_ADD(ctrl, rmask) v += __int_as_float(__builtin_amdgcn_update_dpp(0, __float_as_int(v), ctrl, rmask, 0xf, false))
  DPP_ADD(0x111, 0xf); DPP_ADD(0x112, 0xf); DPP_ADD(0x114, 0xf); DPP_ADD(0x118, 0xf);
  DPP_ADD(0x142, 0xa); DPP_ADD(0x143, 0xc);
#undef DPP_ADD
  return v;
}

struct TokInfo { int s, l, L, base, mrow; };
__device__ __forceinline__ TokInfo tokinfo(int tok) {
  TokInfo t;
  if (tok < T_CTX) { t.s = tok >> 8; t.l = tok & 255; t.L = 256; t.base = tok & ~255; t.mrow = 0; }
  else { int u = tok - T_CTX; t.s = 32 + (u >> 12); t.l = u & 4095; t.L = 4096; t.base = T_CTX + (u & ~4095); t.mrow = 1 + (u >> 12); }
  return t;
}
__device__ __forceinline__ int seqpos2off(int pos, bool cm) { return cm ? (((pos & 63) << 6) | (pos >> 6)) : pos; }

struct Params {
  const float *x_prompt, *x_sample, *state_ssd, *state_lru, *c, *c_ctx, *mod_w, *mod_b, *ln_g, *ln_b;
  const float *ssd_in_w, *ssd_conv_w, *ssd_conv_b, *ssd_dt_bias, *ssd_a_log, *ssd_d, *ssd_norm_g, *ssd_out_w;
  const float *hy_in_w, *hy_conv_w, *hy_conv_b, *hy_f_w1, *hy_f_b1, *hy_f_w2, *hy_f_b2, *hy_f_w3, *hy_f_freq, *hy_f_bias, *hy_out_w;
  const float *lru_in_w, *lru_conv_w, *lru_conv_b, *lru_gate_w, *lru_gate_b, *lru_a_param, *lru_out_w;
  float *xres, *out_ssd, *out_lru;
  bf16_t *wt_ssd_in, *wt_ssd_out, *wt_hy_in, *wt_hy_out, *wt_lru_in, *wt_lru_out, *wt_lru_gate;
  float *modv;
  float *hdn2;
  bf16_t *rtab0;
  bf16_t *rtab1;
  float *knorm;
  bf16_t *hbuf;
  float *rstd;
  float *lru_agg;
  float *lru_hin;
  float *lru_sagg;
  unsigned char *scratch;
  unsigned *bar;
};

#define SC_SSD_Z     ((size_t)0)
#define SC_SSD_XBC   ((size_t)T_ALL * 2048 * 2)
#define SC_SSD_XBCC  (SC_SSD_XBC + (size_t)T_ALL * 4096 * 2)
#define SC_SSD_DT    (SC_SSD_XBCC + (size_t)T_ALL * 2048 * 2)
#define SC_SSD_XT    (SC_SSD_DT + (size_t)T_ALL * 64 * 4)
#define SC_SSD_BT    (SC_SSD_XT + (size_t)T_ALL * 2048 * 2)
#define SC_SSD_BF    (SC_SSD_BT + (size_t)T_ALL * 1024 * 2)
#define SC_SSD_CF    (SC_SSD_BF + (size_t)T_ALL * 1024 * 2)
#define SC_SSD_END   (SC_SSD_CF + (size_t)T_ALL * 1024 * 2)
#define SC_HY_PROJT  ((size_t)0)
#define SC_HY_YT     ((size_t)T_ALL * 4096 * 2)
#define SC_HY_YG     (SC_HY_YT + (size_t)T_ALL * 1024 * 2)
#define SC_LRU_PROJ  ((size_t)0)
#define SC_LRU_XC    ((size_t)T_ALL * 2048 * 2)
#define SC_LRU_GATES (SC_LRU_XC + (size_t)T_ALL * 1024 * 2)
#define SC_LRU_Y     (SC_LRU_GATES + (size_t)T_ALL * 4096 * 2)
#define SC_LRU_YG    (SC_LRU_Y + (size_t)T_ALL * 2048 * 2)
#define SC_TOTAL     SC_SSD_END

__device__ __forceinline__ void transpose_tile(const float* __restrict__ src, int ld_src, int n_src, bf16_t* __restrict__ dst, int K,
                               const float* __restrict__ scale, int tile, int tiles_k, float* tl, int cxw) {
  const int tidx = opaque_tid(cxw);
  int tk = tile % tiles_k, tn = tile / tiles_k;
  int k0 = tk * 64, n0 = tn * 64;
  int tx = tidx & 63, ty = tidx >> 6;
  __syncthreads();
  for (int r = ty; r < 64; r += 4) {
    int n = n0 + tx;
    float v = 0.f;
    if (n < n_src) { v = src[(size_t)(k0 + r) * ld_src + n]; if (scale) v *= scale[k0 + r]; }
    tl[r * 65 + tx] = v;
  }
  __syncthreads();
  for (int r = ty; r < 64; r += 4) dst[(size_t)(n0 + r) * K + k0 + tx] = f2bf(tl[tx * 65 + r]);
}

__device__ __forceinline__ void phase_prep(const Params& p, int bid, int nblk, unsigned char* smem, int cxw) {
  const int tidx = opaque_tid(cxw);
  float* tl = (float*)smem;
  for (int job = 0; job < 24; ++job) {
    const float* src; int ld, nsrc, K, npad; bf16_t* dst; const float* scale = nullptr;
    if (job < 2) { src = p.ssd_in_w + (size_t)job * 1024 * 6208; ld = 6208; nsrc = 6208; K = 1024; npad = 6400; dst = p.wt_ssd_in + (size_t)job * 6400 * 1024; }
    else if (job < 4) { int s = job - 2; src = p.ssd_out_w + (size_t)s * 2048 * 1024; ld = 1024; nsrc = 1024; K = 2048; npad = 1024; dst = p.wt_ssd_out + (size_t)s * 1024 * 2048; scale = p.ssd_norm_g + s * 2048; }
    else if (job == 4) { src = p.hy_in_w; ld = 4096; nsrc = 4096; K = 1024; npad = 4096; dst = p.wt_hy_in; }
    else if (job == 5) { src = p.hy_out_w; ld = 1024; nsrc = 1024; K = 1024; npad = 1024; dst = p.wt_hy_out; }
    else if (job == 6) { src = p.lru_in_w; ld = 2048; nsrc = 2048; K = 1024; npad = 2048; dst = p.wt_lru_in; }
    else if (job == 7) { src = p.lru_out_w; ld = 1024; nsrc = 1024; K = 1024; npad = 1024; dst = p.wt_lru_out; }
    else { int q = job - 8; int dg = q >> 2, n = q & 3;
      src = p.lru_gate_w + (size_t)(dg * 4 + n) * 65536; ld = 256; nsrc = 256; K = 256; npad = 256;
      dst = p.wt_lru_gate + (size_t)n * 1024 * 256 + (size_t)dg * 256 * 256; }
    int tiles_k = K / 64, tiles = tiles_k * (npad / 64);
    for (int t = bid; t < tiles; t += nblk) transpose_tile(src, ld, nsrc, dst, K, scale, t, tiles_k, tl, cxw);
  }
  for (int i = bid * NTHR + tidx; i < 2 * 2 * 1024; i += nblk * NTHR) p.knorm[i] = 0.f;
}

__device__ __forceinline__ void phase_mod(const Params& p, int bid, int nblk, unsigned char* smem, int cxw) {
  const int tidx = opaque_tid(cxw);
  float* sc = (float*)smem;
  float* red = sc + 5 * 1024;
  __syncthreads();
  for (int i = tidx; i < 5 * 1024; i += NTHR) {
    int r = i >> 10, k = i & 1023;
    float v = (r == 0) ? p.c_ctx[k] : p.c[(r - 1) * 1024 + k];
    sc[i] = siluf(v);
  }
  __syncthreads();
  const int cj = tidx & 31, kg = tidx >> 5;
  for (int item = bid; item < 4 * 96; item += nblk) {
    const int layer = item / 96, j = (item % 96) * 32 + cj;
    const float* w = p.mod_w + (size_t)layer * 1024 * 3072 + (size_t)kg * 128 * 3072 + j;
    const float* s0 = sc + kg * 128;
    float a0 = 0, a1 = 0, a2 = 0, a3 = 0, a4 = 0;
#pragma unroll 8
    for (int k = 0; k < 128; ++k) {
      float wv = w[(size_t)k * 3072];
      a0 += s0[k] * wv; a1 += s0[1024 + k] * wv; a2 += s0[2048 + k] * wv; a3 += s0[3072 + k] * wv; a4 += s0[4096 + k] * wv;
    }
    __syncthreads();
    red[(kg * 5 + 0) * 32 + cj] = a0; red[(kg * 5 + 1) * 32 + cj] = a1; red[(kg * 5 + 2) * 32 + cj] = a2;
    red[(kg * 5 + 3) * 32 + cj] = a3; red[(kg * 5 + 4) * 32 + cj] = a4;
    __syncthreads();
    if (tidx < 160) {
      const int rr = tidx >> 5, cc = tidx & 31;
      float sum = 0.f;
#pragma unroll
      for (int g8 = 0; g8 < 8; ++g8) sum += red[(g8 * 5 + rr) * 32 + cc];
      const int jj = (item % 96) * 32 + cc;
      p.modv[((size_t)layer * 5 + rr) * 3072 + jj] = sum + p.mod_b[layer * 3072 + jj];
    }
  }
}

__device__ __forceinline__ void phase_hyfilt_a(const Params& p, int bid, int nblk, unsigned char* smem, int cxw) {
  const int tidx = opaque_tid(cxw);
  float* sz = (float*)smem;
  float* sh = sz + 4 * 36;
  int pl = tidx >> 6, m = tidx & 63;
  for (int item = bid; item < 4352 / 4; item += nblk) {
    int pos = item * 4 + pl;
    int L = pos < 256 ? 256 : 4096;
    int l = pos < 256 ? pos : pos - 256;
    __syncthreads();
    if (m < 33) {
      float t = (float)l / (float)L;
      float w = (6.283185307179586f * (float)l) / (float)L;
      float v;
      if (m == 0) v = t;
      else {
        int j = (m - 1) & 15;
        float fr = 1e-4f + (float)j * ((15.f - 1e-4f) / 15.f);
        float ang = w * fr;
        v = (m <= 16) ? __cosf(ang) : __sinf(ang);
      }
      sz[pl * 36 + m] = v;
    }
    __syncthreads();
    float a = p.hy_f_b1[m];
    for (int e = 0; e < 33; ++e) a += sz[pl * 36 + e] * p.hy_f_w1[e * 64 + m];
    a = __sinf(p.hy_f_freq[m] * a);
    sh[pl * 64 + m] = a;
    __syncthreads();
    float b = p.hy_f_b2[m];
    for (int e = 0; e < 64; ++e) b += sh[pl * 64 + e] * p.hy_f_w2[e * 64 + m];
    b = __sinf(p.hy_f_freq[64 + m] * b);
    p.hdn2[(size_t)pos * 64 + m] = b;
  }
}

__device__ __forceinline__ void phase_hyfilt_b(const Params& p, int bid, int nblk, unsigned char* smem, int cxw) {
  const int tidx = opaque_tid(cxw);
  const int lane = tidx & 63;
  for (int item = bid; item < 17 * 64; item += nblk) {
    const int lb = item >> 6, chunk = item & 63;
    const int Lsel = lb ? 1 : 0, L = Lsel ? 4096 : 256, RL = Lsel ? 8192 : 512, Lm1 = L - 1;
    const int l = Lsel ? (lb - 1) * 256 + tidx : tidx;
    const int pos = Lsel ? 256 + l : l;
    float hd[64];
#pragma unroll
    for (int m4 = 0; m4 < 16; ++m4) {
      f32x4 v = *(const f32x4*)(p.hdn2 + (size_t)pos * 64 + m4 * 4);
      hd[m4 * 4] = v.x; hd[m4 * 4 + 1] = v.y; hd[m4 * 4 + 2] = v.z; hd[m4 * 4 + 3] = v.w;
    }
    const int odc0 = chunk * 64, o = odc0 >> 11, d = (odc0 >> 10) & 1, c0 = odc0 & 1023;
    const float t = (float)l / (float)L;
    bf16_t* rt = Lsel ? p.rtab1 : p.rtab0;
    const float min_decay = -3.0701134573253945f, max_decay = -15.350567286626973f;
    for (int cc = 0; cc < 64; ++cc) {
      const int c = c0 + cc;
      const float* w3 = p.hy_f_w3 + odc0 + cc;
      float acc = 0.f;
#pragma unroll
      for (int m = 0; m < 64; ++m) acc += hd[m] * w3[(size_t)m * 4096];
      float delta = fabsf(min_decay + (float)c * ((max_decay - min_decay) / 1023.f));
      float kv = acc * expf(-t * delta);
      size_t rb = (size_t)(o * 1024 + c) * RL;
      if (d == 0) rt[rb + Lm1 - l] = f2bf(kv);
      else if (l > 0) rt[rb + Lm1 + l] = f2bf(kv);
      else rt[rb + RL - 1] = 0;
      float a = fabsf(kv);
#pragma unroll
      for (int off = 32; off > 0; off >>= 1) a += shfl_xor_f(a, off, lane);
      if (lane == 0) atomicAdd(&p.knorm[(Lsel * 2 + o) * 1024 + c], a);
    }
  }
}

__device__ __forceinline__ void phase_lnmod(const Params& p, int layer, int bid, int nblk, int cxw) {
  const int tidx = opaque_tid(cxw);
  int lane = tidx & 63, wv = cxw & 3;
  f32x4 vn[4];
#define LNMOD_LOAD(ROW) do { const int row_ = (ROW); \
    const float* src_ = (layer == 0) ? (row_ < T_CTX ? p.x_prompt + (size_t)row_ * DM : p.x_sample + (size_t)(row_ - T_CTX) * DM) : p.xres + (size_t)row_ * DM; \
    _Pragma("unroll") for (int j = 0; j < 4; ++j) vn[j] = *(const f32x4*)(src_ + j * 256 + lane * 4); } while (0)
  if (bid * 4 + wv < T_ALL) LNMOD_LOAD(bid * 4 + wv);
  for (int row = bid * 4 + wv; row < T_ALL; row += nblk * 4) {
    f32x4 v[4];
#pragma unroll
    for (int j = 0; j < 4; ++j) v[j] = vn[j];
    if (row + nblk * 4 < T_ALL) LNMOD_LOAD(row + nblk * 4);
    if (layer > 0) {
      float s = 0.f;
#pragma unroll
      for (int j = 0; j < 4; ++j) s += v[j].x + v[j].y + v[j].z + v[j].w;
#pragma unroll
      for (int o = 32; o > 0; o >>= 1) s += shfl_xor_f(s, o, lane);
      float mu = s * (1.f / 1024.f);
      float q = 0.f;
#pragma unroll
      for (int j = 0; j < 4; ++j) { float a = v[j].x - mu, b = v[j].y - mu, c = v[j].z - mu, d = v[j].w - mu; q += a * a + b * b + c * c + d * d; }
#pragma unroll
      for (int o = 32; o > 0; o >>= 1) q += shfl_xor_f(q, o, lane);
      float rs = rsqrtf(q * (1.f / 1024.f) + LN_EPS);
      const float* g = p.ln_g + (layer - 1) * DM; const float* b = p.ln_b + (layer - 1) * DM;
#pragma unroll
      for (int j = 0; j < 4; ++j) {
        f32x4 gg = *(const f32x4*)(g + j * 256 + lane * 4), bb = *(const f32x4*)(b + j * 256 + lane * 4);
        v[j].x = (v[j].x - mu) * rs * gg.x + bb.x; v[j].y = (v[j].y - mu) * rs * gg.y + bb.y;
        v[j].z = (v[j].z - mu) * rs * gg.z + bb.z; v[j].w = (v[j].w - mu) * rs * gg.w + bb.w;
      }
    }
    float* dst = p.xres + (size_t)row * DM;
#pragma unroll
    for (int j = 0; j < 4; ++j) *(f32x4*)(dst + j * 256 + lane * 4) = v[j];
    if (layer < 4) {
      int mrow = row < T_CTX ? 0 : 1 + ((row - T_CTX) >> 12);
      const float* mv = p.modv + ((size_t)layer * 5 + mrow) * 3072;
#pragma unroll
      for (int j = 0; j < 4; ++j) {
        f32x4 sh = *(const f32x4*)(mv + j * 256 + lane * 4), sc = *(const f32x4*)(mv + 1024 + j * 256 + lane * 4);
        u32x2 o;
        o.x = pack2(v[j].x * (1.f + sc.x) + sh.x, v[j].y * (1.f + sc.y) + sh.y);
        o.y = pack2(v[j].z * (1.f + sc.z) + sh.z, v[j].w * (1.f + sc.w) + sh.w);
        *(u32x2*)(p.hbuf + (size_t)row * DM + j * 256 + lane * 4) = o;
      }
    }
  }
}

#define PG8_LAS __attribute__((address_space(3)))
namespace pg8 {
constexpr int BM = 256, BK = 64, HALF = 128, HTB = HALF * BK * 2, STAGE_BYTES = 8 * HTB, NXCD = 8, WGM = 8;
__device__ __forceinline__ int lds_byte(int r, int c) { const int st = (r >> 4) * 2 + (c >> 5), rr = r & 15, cc = c & 31, ob = rr * 64 + cc * 2; return st * 1024 + (ob ^ (((ob >> 9) & 1) << 5)); }
__device__ __forceinline__ void stage_rc(int b, int& R, int& C) { const int st = b / 1024, sb = b % 1024, swz = sb ^ (((sb >> 9) & 1) << 5); R = (st >> 1) * 16 + swz / 64; C = (st & 1) * 32 + (swz % 64) / 2; }
__device__ __forceinline__ int perm32(int rho) { const int n = rho >> 4, i = rho & 15; return 8 * (i >> 2) + 4 * n + (i & 3); }
struct Unit { int pm, pn; };
struct Gemm { const bf16_t* A; const bf16_t* Bt; int M, N, K, lda; int a_grp_shift; int a_grp_bytes; };
struct StaticOrder {
  int nM, nN, nwg, G, c;
  __device__ void init(int M, int N, int G_, int c_) { nM = M / BM; nN = N / BM; nwg = nM * nN; G = G_; c = c_; }
  __device__ bool next(int i, Unit& u) const {
    const long L = (long)i * G + c; if (L >= nwg) return false;
    int wgid = (int)L; { const int q = nwg / NXCD, r = nwg % NXCD, xcd = wgid % NXCD, off = wgid / NXCD; wgid = (xcd < r ? xcd * (q + 1) : r * (q + 1) + (xcd - r) * q) + off; }
    const int nig = WGM * nN, gid = wgid / nig, fm = gid * WGM, gsz = (nM - fm) < WGM ? (nM - fm) : WGM;
    u.pm = fm + ((wgid % nig) % gsz); u.pn = (wgid % nig) / gsz; return true;
  }
};
__device__ __forceinline__ unsigned cvt_pk_bf16(float lo, float hi) { return pack2(lo, hi); }

template <class Epi>
__device__ __forceinline__ void gemm_phase(PG8_LAS unsigned char* lds, const Gemm g, const StaticOrder& S, const Epi& E, int wave) {
  const int tid = opaque_tid512(wave), wid = wave, lane = tid & 63, wr = wid >> 2, wc = wid & 3, fr = lane & 15, fq = lane >> 4;
  const int K = g.K, nt = K / BK, lda = g.lda;
  unsigned voffA[2], voffB[2];
#pragma unroll
  for (int i = 0; i < 2; ++i) { int R, C; stage_rc(tid * 16 + i * 8192, R, C); const int Rb = Epi::PERM ? ((R & ~31) + perm32(R & 31)) : R;
    voffA[i] = (unsigned)(R * lda + C) * 2u; voffB[i] = (unsigned)(Rb * K + C) * 2u; }
  const size_t kstep = (size_t)(BK * 2);
  const size_t hstepA = (size_t)HALF * lda * 2, hstepB = (size_t)HALF * K * 2;
  const size_t tstepA = 2 * hstepA, tstepB = 2 * hstepB;
  const unsigned ldsw = (unsigned)wid * 1024u;
  const int aoff = lds_byte(wr * 64 + fr, fq * 8), boff = lds_byte(wc * 32 + fr, fq * 8);
#define PG8_SA(b, h) (((b) * 2 + (h)) * HTB)
#define PG8_SB(b, h) ((4 + (b) * 2 + (h)) * HTB)
#define PG8_STAGE(bufoff, gbase, voff) do { _Pragma("unroll") for (int _i = 0; _i < 2; ++_i) \
    __builtin_amdgcn_global_load_lds((const unsigned*)((const char*)(gbase) + (voff)[_i]), (PG8_LAS unsigned*)(lds + (bufoff) + ldsw + _i * 8192), 16, 0, 0); } while (0)
#define PG8_LDA(dst, b, h) do { _Pragma("unroll") for (int m = 0; m < 4; ++m) _Pragma("unroll") for (int k = 0; k < 2; ++k) dst[m][k] = *(const PG8_LAS bf16x8*)(lds + PG8_SA(b, h) + aoff + m * 2048 + k * 1024); } while (0)
#define PG8_LDB(dst, b, h) do { _Pragma("unroll") for (int n = 0; n < 2; ++n) _Pragma("unroll") for (int k = 0; k < 2; ++k) dst[n][k] = *(const PG8_LAS bf16x8*)(lds + PG8_SB(b, h) + boff + n * 2048 + k * 1024); } while (0)
#define PG8_MMA(ai, bj, At, Bt) do { __builtin_amdgcn_s_setprio(1); _Pragma("unroll") for (int m = 0; m < 4; ++m) _Pragma("unroll") for (int n = 0; n < 2; ++n) _Pragma("unroll") for (int k = 0; k < 2; ++k) \
    acc[ai][bj][m][n] = __builtin_amdgcn_mfma_f32_16x16x32_bf16(Bt[n][k], At[m][k], acc[ai][bj][m][n], 0, 0, 0); __builtin_amdgcn_s_setprio(0); } while (0)
#define PG8_WAIT_V(n) asm volatile("s_waitcnt vmcnt(" #n ")" ::: "memory")
#define PG8_WAIT_L(n) asm volatile("s_waitcnt lgkmcnt(" #n ")" ::: "memory")
#define PG8_BAR __builtin_amdgcn_s_barrier()
#define PG8_SCHED __builtin_amdgcn_sched_barrier(0)
#define PG8_APTR(u) ((const char*)g.A + (size_t)(u).pm * tstepA + (size_t)(((u).pn >> g.a_grp_shift) * g.a_grp_bytes))
  Unit cur, nxt; int ui = 0;
  if (!S.next(0, cur)) return;
  f32x4 acc[2][2][4][2];
#pragma unroll
  for (int a = 0; a < 2; ++a)
#pragma unroll
    for (int b = 0; b < 2; ++b)
#pragma unroll
      for (int m = 0; m < 4; ++m)
#pragma unroll
        for (int n = 0; n < 2; ++n) acc[a][b][m][n] = (f32x4){0.f, 0.f, 0.f, 0.f};
  bf16x8 At[4][2], B0[2][2], B1[2][2];
  const char* cA = PG8_APTR(cur); const char* cB = (const char*)g.Bt + (size_t)cur.pn * tstepB;
  PG8_STAGE(PG8_SB(0, 0), cB, voffB); PG8_STAGE(PG8_SA(0, 0), cA, voffA); PG8_STAGE(PG8_SB(0, 1), cB + hstepB, voffB); PG8_STAGE(PG8_SA(0, 1), cA + hstepA, voffA);
  if (wr == 1) PG8_BAR;
  PG8_WAIT_V(4); PG8_BAR;
  PG8_STAGE(PG8_SB(1, 0), cB + kstep, voffB); PG8_STAGE(PG8_SA(1, 0), cA + kstep, voffA); PG8_STAGE(PG8_SB(1, 1), cB + hstepB + kstep, voffB);
  PG8_WAIT_V(6); PG8_BAR;
  for (;;) {
    const bool has_next = S.next(ui + 1, nxt);
    const char* nA = has_next ? PG8_APTR(nxt) : cA; const char* nB = has_next ? (const char*)g.Bt + (size_t)nxt.pn * tstepB : cB;
    for (int t = 0; t < nt; t += 2) {
      const bool last = (t == nt - 2);
      const char* a1 = cA + (size_t)(t + 1) * kstep;
      const char* a2 = last ? nA : cA + (size_t)(t + 2) * kstep; const char* b2 = last ? nB : cB + (size_t)(t + 2) * kstep;
      const char* a3 = a2 + kstep; const char* b3 = b2 + kstep;
      PG8_LDB(B0, 0, 0); PG8_SCHED; PG8_LDA(At, 0, 0); PG8_STAGE(PG8_SA(1, 1), a1 + hstepA, voffA);
      PG8_WAIT_L(8); PG8_BAR; PG8_WAIT_L(0); PG8_MMA(0, 0, At, B0); PG8_BAR; PG8_SCHED;
      PG8_LDB(B1, 0, 1); PG8_STAGE(PG8_SB(0, 0), b2, voffB);
      PG8_BAR; PG8_WAIT_L(0); PG8_MMA(0, 1, At, B1); PG8_BAR;
      PG8_LDA(At, 0, 1); PG8_STAGE(PG8_SA(0, 0), a2, voffA);
      PG8_BAR; PG8_WAIT_L(0); PG8_MMA(1, 0, At, B0); PG8_BAR; PG8_SCHED;
      PG8_STAGE(PG8_SB(0, 1), b2 + hstepB, voffB);
      PG8_WAIT_V(6); PG8_BAR; PG8_MMA(1, 1, At, B1); PG8_BAR;
      PG8_LDB(B0, 1, 0); PG8_SCHED; PG8_LDA(At, 1, 0); PG8_STAGE(PG8_SA(0, 1), a2 + hstepA, voffA);
      PG8_WAIT_L(8); PG8_BAR; PG8_WAIT_L(0); PG8_MMA(0, 0, At, B0); PG8_BAR; PG8_SCHED;
      PG8_LDB(B1, 1, 1); PG8_STAGE(PG8_SB(1, 0), b3, voffB);
      PG8_BAR; PG8_WAIT_L(0); PG8_MMA(0, 1, At, B1); PG8_BAR;
      PG8_LDA(At, 1, 1); PG8_STAGE(PG8_SA(1, 0), a3, voffA);
      PG8_BAR; PG8_WAIT_L(0); PG8_MMA(1, 0, At, B0); PG8_BAR; PG8_SCHED;
      PG8_STAGE(PG8_SB(1, 1), b3 + hstepB, voffB);
      PG8_WAIT_V(6); PG8_BAR; PG8_MMA(1, 1, At, B1); PG8_BAR;
    }
    { const int lane2 = opaque_lane();
      E(acc, cur, wr, wc, lane2 & 15, lane2 >> 4); }
    if (!has_next) break;
#pragma unroll
    for (int a = 0; a < 2; ++a)
#pragma unroll
      for (int b = 0; b < 2; ++b)
#pragma unroll
        for (int m = 0; m < 4; ++m)
#pragma unroll
          for (int n = 0; n < 2; ++n) acc[a][b][m][n] = (f32x4){0.f, 0.f, 0.f, 0.f};
    cur = nxt; cA = nA; cB = nB; ++ui;
  }
  PG8_WAIT_V(0);
  if (wr == 0) PG8_BAR;
  PG8_BAR;
#undef PG8_SA
#undef PG8_SB
#undef PG8_STAGE
#undef PG8_LDA
#undef PG8_LDB
#undef PG8_MMA
#undef PG8_WAIT_V
#undef PG8_WAIT_L
#undef PG8_BAR
#undef PG8_SCHED
#undef PG8_APTR
}

struct EpiBf16 {
  static constexpr bool PERM = true;
  bf16_t* O; size_t ldc;
  __device__ __forceinline__ void operator()(const f32x4 (&acc)[2][2][4][2], const Unit& u, int wr, int wc, int fr, int fq) const {
    const int row0 = u.pm * BM + wr * 64 + fr, col0 = u.pn * BM + wc * 32 + 8 * fq;
#pragma unroll
    for (int ai = 0; ai < 2; ++ai)
#pragma unroll
      for (int m = 0; m < 4; ++m) {
        bf16_t* rowp = O + (size_t)(row0 + ai * HALF + m * 16) * ldc + col0;
#pragma unroll
        for (int bj = 0; bj < 2; ++bj) {
          const f32x4 v0 = acc[ai][bj][m][0], v1 = acc[ai][bj][m][1];
          u32x4 w; w.x = pack2(v0[0], v0[1]); w.y = pack2(v0[2], v0[3]); w.z = pack2(v1[0], v1[1]); w.w = pack2(v1[2], v1[3]);
          *(u32x4*)(rowp + bj * HALF) = w;
        }
      }
  }
};
struct EpiSsdIn {
  static constexpr bool PERM = true;
  bf16_t* z; bf16_t* xbc; float* dt; const float* dt_bias;
  __device__ __forceinline__ void operator()(const f32x4 (&acc)[2][2][4][2], const Unit& u, int wr, int wc, int fr, int fq) const {
    const int row0 = u.pm * BM + wr * 64 + fr, colt = u.pn * BM + wc * 32 + 8 * fq;
    if (u.pn < 24) {
      bf16_t* base = u.pn < 8 ? z : xbc; const size_t ldc = u.pn < 8 ? 2048 : 4096; const int col0 = u.pn < 8 ? colt : colt - 2048;
#pragma unroll
      for (int ai = 0; ai < 2; ++ai)
#pragma unroll
        for (int m = 0; m < 4; ++m) {
          bf16_t* rowp = base + (size_t)(row0 + ai * HALF + m * 16) * ldc + col0;
#pragma unroll
          for (int bj = 0; bj < 2; ++bj) {
            const f32x4 v0 = acc[ai][bj][m][0], v1 = acc[ai][bj][m][1];
            u32x4 w; w.x = pack2(v0[0], v0[1]); w.y = pack2(v0[2], v0[3]); w.z = pack2(v1[0], v1[1]); w.w = pack2(v1[2], v1[3]);
            *(u32x4*)(rowp + bj * HALF) = w;
          }
        }
    } else {
      const int c0 = wc * 32 + 8 * fq;
      if (c0 < 64) {
#pragma unroll
        for (int ai = 0; ai < 2; ++ai)
#pragma unroll
          for (int m = 0; m < 4; ++m) {
            float* rowp = dt + (size_t)(row0 + ai * HALF + m * 16) * 64 + c0;
#pragma unroll
            for (int n = 0; n < 2; ++n) {
              const f32x4 v = acc[ai][0][m][n];
              f32x4 o;
#pragma unroll
              for (int e = 0; e < 4; ++e) o[e] = softplusf(v[e] + dt_bias[c0 + 4 * n + e]);
              *(f32x4*)(rowp + 4 * n) = o;
            }
          }
      }
    }
  }
};
struct EpiOut {
  static constexpr bool PERM = false;
  float* xres; const float* modv_layer; const float* rstd;
  __device__ __forceinline__ void operator()(const f32x4 (&acc)[2][2][4][2], const Unit& u, int wr, int wc, int fr, int fq) const {
    const int row0 = u.pm * BM + wr * 64 + fr, col0 = u.pn * BM + wc * 32 + 4 * fq;
#pragma unroll
    for (int ai = 0; ai < 2; ++ai)
#pragma unroll
      for (int m = 0; m < 4; ++m) {
        const int row = row0 + ai * HALF + m * 16;
        const int mrow = row < T_CTX ? 0 : 1 + ((row - T_CTX) >> 12);
        const float rs = rstd ? rstd[row] : 1.f;
        const float* gp = modv_layer + (size_t)mrow * 3072 + 2048 + col0;
        float* rowp = xres + (size_t)row * DM + col0;
#pragma unroll
        for (int bj = 0; bj < 2; ++bj)
#pragma unroll
          for (int n = 0; n < 2; ++n) {
            const f32x4 gv = *(const f32x4*)(gp + bj * HALF + n * 16);
            const f32x4 xv = *(const f32x4*)(rowp + bj * HALF + n * 16);
            *(f32x4*)(rowp + bj * HALF + n * 16) = ALPHA_RES * xv + gv * (acc[ai][bj][m][n] * rs);
          }
      }
  }
};
struct EpiLruGate {
  static constexpr bool PERM = true;
  bf16_t* gates; const float* gate_b;
  __device__ __forceinline__ void operator()(const f32x4 (&acc)[2][2][4][2], const Unit& u, int wr, int wc, int fr, int fq) const {
    const int nb = u.pn >> 2, dg = u.pn & 3;
    const int row0 = u.pm * BM + wr * 64 + fr, ch0 = nb * 256 + wc * 32 + 8 * fq;
#pragma unroll
    for (int ai = 0; ai < 2; ++ai)
#pragma unroll
      for (int m = 0; m < 4; ++m) {
        bf16_t* rowp = gates + ((size_t)dg * T_ALL + row0 + ai * HALF + m * 16) * 1024 + ch0;
#pragma unroll
        for (int bj = 0; bj < 2; ++bj) {
          const float* bp = gate_b + dg * 1024 + ch0 + bj * HALF;
          const f32x4 b0 = *(const f32x4*)bp, b1 = *(const f32x4*)(bp + 4);
          const f32x4 v0 = acc[ai][bj][m][0] + b0, v1 = acc[ai][bj][m][1] + b1;
          u32x4 w; w.x = pack2(sigmoidf(v0[0]), sigmoidf(v0[1])); w.y = pack2(sigmoidf(v0[2]), sigmoidf(v0[3]));
          w.z = pack2(sigmoidf(v1[0]), sigmoidf(v1[1])); w.w = pack2(sigmoidf(v1[2]), sigmoidf(v1[3]));
          *(u32x4*)(rowp + bj * HALF) = w;
        }
      }
  }
};
}

template <int KW, bool SILU>
__device__ __forceinline__ void phase_dwconv(const bf16_t* __restrict__ src, int ld_src, bf16_t* __restrict__ dst, int ld_dst, int CH,
                             const float* __restrict__ w, const float* __restrict__ b, bool colmajor, int bid, int nblk, int cxw) {
  const int tidx = opaque_tid(cxw);
  const int cpr = CH / 8;
  const size_t total = (size_t)T_ALL * cpr;
  for (size_t idx = (size_t)bid * NTHR + tidx; idx < total; idx += (size_t)nblk * NTHR) {
    int tok = (int)(idx / cpr), c0 = (int)(idx % cpr) * 8;
    TokInfo ti = tokinfo(tok);
    bool cm = colmajor && ti.s >= 32;
    int pos = seqpos2off(ti.l, cm);
    float acc[8];
#pragma unroll
    for (int e = 0; e < 8; ++e) acc[e] = b[c0 + e];
#pragma unroll
    for (int k = 0; k < KW; ++k) {
      int pp = pos + k - 1;
      if (pp < 0 || pp >= ti.L) continue;
      int tk = ti.base + seqpos2off(pp, cm);
      u32x4 xv = *(const u32x4*)(src + (size_t)tk * ld_src + c0);
      const float* wk = w + (size_t)k * CH + c0;
      acc[0] += wk[0] * bflo(xv.x); acc[1] += wk[1] * bfhi(xv.x);
      acc[2] += wk[2] * bflo(xv.y); acc[3] += wk[3] * bfhi(xv.y);
      acc[4] += wk[4] * bflo(xv.z); acc[5] += wk[5] * bfhi(xv.z);
      acc[6] += wk[6] * bflo(xv.w); acc[7] += wk[7] * bfhi(xv.w);
    }
    if (SILU) {
#pragma unroll
      for (int e = 0; e < 8; ++e) acc[e] = siluf(acc[e]);
    }
    u32x4 o;
    o.x = pack2(acc[0], acc[1]); o.y = pack2(acc[2], acc[3]); o.z = pack2(acc[4], acc[5]); o.w = pack2(acc[6], acc[7]);
    *(u32x4*)(dst + (size_t)tok * ld_dst + c0) = o;
  }
}

__device__ __forceinline__ void phase_ssd_conv(const Params& p, int slot, bool colmajor, int bid, int nblk, unsigned char* smem, int cxw) {
  const int tid = opaque_tid(cxw);
  const bf16_t* raw = (const bf16_t*)(p.scratch + SC_SSD_XBC);
  bf16_t* out = (bf16_t*)(p.scratch + SC_SSD_XBCC);
  bf16_t* XT = (bf16_t*)(p.scratch + SC_SSD_XT);
  bf16_t* BT = (bf16_t*)(p.scratch + SC_SSD_BT);
  bf16_t* BF = (bf16_t*)(p.scratch + SC_SSD_BF);
  bf16_t* CF = (bf16_t*)(p.scratch + SC_SSD_CF);
  const float* cw = p.ssd_conv_w + (size_t)slot * 4 * 4096;
  const float* cb = p.ssd_conv_b + slot * 4096;
  bf16_t* tl = (bf16_t*)smem;
  bf16_t* rt = tl + 64 * 72;
  const int rr = tid >> 2, cpart = tid & 3;
  const int NITEMS = 384 * 64;
  u32x4 pre[3];
#define CONV_PREFETCH(ITEM) do { const int it_ = (ITEM); const int ptile_ = it_ >> 6, ct_ = it_ & 63; \
    const TokInfo ti_ = tokinfo(ptile_ * 64); const bool cm_ = colmajor && ti_.s >= 32; \
    _Pragma("unroll") for (int i_ = 0; i_ < 3; ++i_) { const int q_ = tid + i_ * 256; const int row_ = q_ >> 3, c8_ = (q_ & 7) * 8; \
      const int pp_ = ti_.l - 1 + row_; u32x4 v_ = {0u, 0u, 0u, 0u}; \
      if (row_ < 67 && pp_ >= 0 && pp_ < ti_.L) v_ = *(const u32x4*)(raw + (size_t)(ti_.base + seqpos2off(pp_, cm_)) * 4096 + ct_ * 64 + c8_); \
      pre[i_] = v_; } } while (0)
  if (bid < NITEMS) CONV_PREFETCH(bid);
  for (int item = bid; item < NITEMS; item += nblk) {
    const int ptile = item >> 6, ct = item & 63;
    const int ptok0 = ptile * 64;
    const int ch = ct * 64 + cpart * 16;
    __syncthreads();
#pragma unroll
    for (int i = 0; i < 3; ++i) { const int q = tid + i * 256; if (q < 67 * 8) *(u32x4*)(rt + (q >> 3) * 72 + (q & 7) * 8) = pre[i]; }
    if (item + nblk < NITEMS) CONV_PREFETCH(item + nblk);
    __syncthreads();
    float acc[16];
#pragma unroll
    for (int e = 0; e < 16; ++e) acc[e] = cb[ch + e];
#pragma unroll
    for (int k = 0; k < 4; ++k) {
      const bf16_t* rp = rt + (rr + k) * 72 + cpart * 16;
      u32x4 x0 = *(const u32x4*)rp, x1 = *(const u32x4*)(rp + 8);
      const float* wk = cw + (size_t)k * 4096 + ch;
      unsigned xw[8] = {x0.x, x0.y, x0.z, x0.w, x1.x, x1.y, x1.z, x1.w};
#pragma unroll
      for (int e = 0; e < 8; ++e) { acc[2 * e] += wk[2 * e] * bflo(xw[e]); acc[2 * e + 1] += wk[2 * e + 1] * bfhi(xw[e]); }
    }
    u32x4 o0, o1;
    o0.x = pack2(siluf(acc[0]), siluf(acc[1])); o0.y = pack2(siluf(acc[2]), siluf(acc[3]));
    o0.z = pack2(siluf(acc[4]), siluf(acc[5])); o0.w = pack2(siluf(acc[6]), siluf(acc[7]));
    o1.x = pack2(siluf(acc[8]), siluf(acc[9])); o1.y = pack2(siluf(acc[10]), siluf(acc[11]));
    o1.z = pack2(siluf(acc[12]), siluf(acc[13])); o1.w = pack2(siluf(acc[14]), siluf(acc[15]));
    *(u32x4*)(tl + rr * 72 + cpart * 16) = o0;
    *(u32x4*)(tl + rr * 72 + cpart * 16 + 8) = o1;
    __syncthreads();
    if (ct < 32) {
      bf16_t* op = out + (size_t)(ptok0 + rr) * 2048 + ch;
      *(u32x4*)op = o0; *(u32x4*)(op + 8) = o1;
      const int crow = tid >> 2, part = tid & 3;
      unsigned wv[8];
#pragma unroll
      for (int e = 0; e < 8; ++e) {
        unsigned lo = tl[(part * 16 + 2 * e) * 72 + crow], hi = tl[(part * 16 + 2 * e + 1) * 72 + crow];
        wv[e] = lo | (hi << 16);
      }
      bf16_t* dp = XT + (size_t)(ct * 64 + crow) * T_ALL + ptok0 + part * 16;
      u32x4 t0, t1;
      t0.x = wv[0]; t0.y = wv[1]; t0.z = wv[2]; t0.w = wv[3]; t1.x = wv[4]; t1.y = wv[5]; t1.z = wv[6]; t1.w = wv[7];
      *(u32x4*)dp = t0; *(u32x4*)(dp + 8) = t1;
    } else {
      const bool isB = ct < 48;
      const int cq = (ct - (isB ? 32 : 48));
      const int g = cq >> 1, chhalf = cq & 1;
      const int lane = tid & 63, r = lane & 31, hh = lane >> 5;
      bf16_t* F = isB ? BF : CF;
#pragma unroll
      for (int i = 0; i < 2; ++i) {
        const int f = (cxw & 3) + 4 * i;
        const int rt2 = f >> 2, kk4 = f & 3;
        const u32x4 v = *(const u32x4*)(tl + (32 * rt2 + r) * 72 + 16 * kk4 + 8 * hh);
        const size_t rt = (size_t)(ptok0 >> 5) + rt2;
        *(u32x4*)(F + (((rt * 8 + g) * 8 + chhalf * 4 + kk4) * 64 + lane) * 8) = v;
      }
      if (isB) {
#pragma unroll
        for (int i = 0; i < 2; ++i) {
          const int f = (cxw & 3) + 4 * i;
          const int nt2 = f >> 2, ts4 = f & 3;
          unsigned wv[4];
#pragma unroll
          for (int e = 0; e < 4; ++e) {
            unsigned lo = tl[(16 * ts4 + 8 * hh + 2 * e) * 72 + 32 * nt2 + r], hi = tl[(16 * ts4 + 8 * hh + 2 * e + 1) * 72 + 32 * nt2 + r];
            wv[e] = lo | (hi << 16);
          }
          u32x4 v; v.x = wv[0]; v.y = wv[1]; v.z = wv[2]; v.w = wv[3];
          const size_t ts = (size_t)(ptok0 >> 4) + ts4;
          *(u32x4*)(BT + (((ts * 8 + g) * 4 + chhalf * 2 + nt2) * 64 + lane) * 8) = v;
        }
      }
    }
  }
}

#define SH_STRIDE 136
__device__ __forceinline__ int rowmap(int e, int hh) { return (e & 3) + 8 * (e >> 2) + 4 * hh; }
__device__ __forceinline__ bf16x8 pack8(float a0, float a1, float a2, float a3, float a4, float a5, float a6, float a7) {
  u32x4 v; v.x = pack2(a0, a1); v.y = pack2(a2, a3); v.z = pack2(a4, a5); v.w = pack2(a6, a7);
  return __builtin_bit_cast(bf16x8, v);
}
#define SCAN_PRIV 49152
#define SCAN_SF 49152
__device__ __forceinline__ void phase_ssd_scan(const Params& p, int slot, bool colmajor, int bid, int nblk, unsigned char* wg_smem, int cxw) {
  const int tid = opaque_tid(cxw), lane = tid & 63, w = cxw & 3, vb = cxw >> 2, r = lane & 31, hh = lane >> 5;
  const int it = w >> 1, pt = w & 1;
  const bf16_t* XT = (const bf16_t*)(p.scratch + SC_SSD_XT);
  const bf16_t* BT = (const bf16_t*)(p.scratch + SC_SSD_BT);
  const bf16_t* BF = (const bf16_t*)(p.scratch + SC_SSD_BF);
  const bf16_t* CF = (const bf16_t*)(p.scratch + SC_SSD_CF);
  const float* dtb = (const float*)(p.scratch + SC_SSD_DT);
  bf16_t* ybuf = (bf16_t*)(p.scratch + SC_SSD_XBC);
  unsigned char* priv = wg_smem + (vb ? SCAN_SF + SCAN_PRIV : 0);
  bf16_t* sXr = (bf16_t*)priv;
  bf16_t* sXs = sXr + 64 * 72;
  bf16_t* sH = sXs + 64 * 72;
  float* sW = (float*)(sH + 64 * SH_STRIDE);
  bf16_t* sY = (bf16_t*)(sW + 4 * 256);
  float* myW = sW + w * 256;
  const bf16_t* sfC = (const bf16_t*)(wg_smem + SCAN_PRIV);
  const bf16_t* sfB = sfC + 8192;
  const bf16_t* sfT = sfC + 16384;
  for (int item = bid; item < 36 * 64; item += nblk) {
    int s, h, dir;
    {
      const int itx = item < 256 ? item : item - 256;
      const int idx = itx & 63, pairidx = idx >> 1;
      s = item < 256 ? 32 + (itx >> 6) : (itx >> 6);
      dir = pairidx & 1; h = (pairidx >> 1) * 2 + (idx & 1);
    }
    const int L = s < 32 ? 256 : 4096;
    const int base = s < 32 ? s * 256 : T_CTX + (s - 32) * 4096;
    const bool cm = colmajor && s >= 32;
    const int g = h >> 2;
    const float Aval = -expf(p.ssd_a_log[(slot * 2 + dir) * 32 + h]);
    const int nchunks = L >> 6;
    const int pcol = 32 * pt + r;
    f32x16 hacc[2];
    if (s >= 32) {
      const float* h0 = p.state_ssd + ((((size_t)(s - 32) * 2 + slot) * 2 + dir) * 32 + h) * 8192 + (size_t)pcol * 128;
#pragma unroll
      for (int t2 = 0; t2 < 2; ++t2)
#pragma unroll
        for (int qd = 0; qd < 4; ++qd) {
          f32x4 v = *(const f32x4*)(h0 + 32 * (2 * it + t2) + 8 * qd + 4 * hh);
          hacc[t2][4 * qd] = v.x; hacc[t2][4 * qd + 1] = v.y; hacc[t2][4 * qd + 2] = v.z; hacc[t2][4 * qd + 3] = v.w;
        }
    } else {
#pragma unroll
      for (int t2 = 0; t2 < 2; ++t2)
#pragma unroll
        for (int e = 0; e < 16; ++e) hacc[t2][e] = 0.f;
    }
#define SCAN_PTOK(c) (base + 64 * (dir ? nchunks - 1 - (c) : (c)))
#define SCAN_LOAD_DTX(pt0) do { \
      const int tok_ = base + seqpos2off((pt0) - base + lane, cm); \
      dtv = dtb[(size_t)tok_ * 64 + dir * 32 + h]; \
      _Pragma("unroll") for (int i_ = 0; i_ < 2; ++i_) { const int q_ = tid + i_ * 256; \
        xtr[i_] = *(const u32x4*)(XT + (size_t)(h * 64 + (q_ >> 3)) * T_ALL + (pt0) + (q_ & 7) * 8); } } while (0)
#define SCAN_DMA(pt0) do { \
      _Pragma("unroll") for (int i_ = 0; i_ < 6; ++i_) { const int q_ = cxw + 8 * (i_ & 1); \
        const bf16_t* src_; \
        if (i_ < 4) src_ = (i_ < 2 ? CF : BF) + ((((size_t)((pt0) >> 5) + (q_ >> 3)) * 8 + g) * 8 + (q_ & 7)) * 512 + lane * 8; \
        else src_ = BT + ((((size_t)((pt0) >> 4) + (q_ >> 2)) * 8 + g) * 4 + (q_ & 3)) * 512 + lane * 8; \
        __builtin_amdgcn_global_load_lds((const unsigned*)src_, (PG8_LAS unsigned*)(wg_smem + SCAN_PRIV + (i_ >> 1) * 16384 + q_ * 1024), 16, 0, 0); } } while (0)
#define SCAN_WRITE_STATE() do { \
      _Pragma("unroll") for (int t2 = 0; t2 < 2; ++t2) _Pragma("unroll") for (int qd = 0; qd < 4; ++qd) { \
        u32x2 o_; o_.x = pack2(hacc[t2][4 * qd], hacc[t2][4 * qd + 1]); o_.y = pack2(hacc[t2][4 * qd + 2], hacc[t2][4 * qd + 3]); \
        *(u32x2*)(sH + pcol * SH_STRIDE + 32 * (2 * it + t2) + 8 * qd + 4 * hh) = o_; } } while (0)
    const bool need0 = dir == 0 ? true : (it == 0);
    const bool need1 = dir == 0 ? (it == 1) : true;
    float dtv; u32x4 xtr[2];
    __syncthreads();
    {
      const int p0 = SCAN_PTOK(0);
      SCAN_DMA(p0);
      SCAN_LOAD_DTX(p0);
      SCAN_WRITE_STATE();
    }
    for (int ci = 0; ci < nchunks; ++ci) {
      const int cin = ci + 1 < nchunks ? ci + 1 : ci;
      const int ptokN = SCAN_PTOK(cin);
      __syncthreads();
      if (ci > 0) {
        const int ptokP = SCAN_PTOK(ci - 1);
#pragma unroll
        for (int i = 0; i < 2; ++i) {
          const int q = tid + i * 256, yrow = q >> 3, c8 = (q & 7) * 8;
          *(u32x4*)(ybuf + ((size_t)dir * T_ALL + ptokP + yrow) * 2048 + h * 64 + c8) = *(const u32x4*)(sY + yrow * 72 + c8);
        }
      }
      float decE;
      {
        const float a_ = dtv * Aval;
        const float pre = wave_incl_scan(a_);
        const float cE = __int_as_float(__builtin_amdgcn_readlane(__float_as_int(pre), 63));
        const float c = dir == 0 ? pre : cE - pre + a_;
        myW[lane] = dtv; myW[64 + lane] = c; myW[128 + lane] = __expf(c); myW[192 + lane] = dtv * __expf(cE - c);
        decE = __expf(cE);
      }
#pragma unroll
      for (int i = 0; i < 2; ++i) {
        const int q = tid + i * 256, prow = q >> 3, j8 = (q & 7) * 8;
        const u32x4 raw = xtr[i];
        *(u32x4*)(sXr + prow * 72 + j8) = raw;
        f32x4 f0 = *(const f32x4*)(myW + 192 + j8), f1 = *(const f32x4*)(myW + 192 + j8 + 4);
        u32x4 sc;
        sc.x = pack2(bflo(raw.x) * f0.x, bfhi(raw.x) * f0.y); sc.y = pack2(bflo(raw.y) * f0.z, bfhi(raw.y) * f0.w);
        sc.z = pack2(bflo(raw.z) * f1.x, bfhi(raw.z) * f1.y); sc.w = pack2(bflo(raw.w) * f1.z, bfhi(raw.w) * f1.w);
        *(u32x4*)(sXs + prow * 72 + j8) = sc;
      }
      asm volatile("s_waitcnt vmcnt(0)" ::: "memory");
      __syncthreads();
      SCAN_LOAD_DTX(ptokN);
#pragma unroll
      for (int t2 = 0; t2 < 2; ++t2) {
#pragma unroll
        for (int e = 0; e < 16; ++e) hacc[t2][e] *= decE;
        const bf16_t* xs = sXs + pcol * 72 + 8 * hh;
#pragma unroll
        for (int kk = 0; kk < 4; ++kk)
          hacc[t2] = __builtin_amdgcn_mfma_f32_32x32x16_bf16(*(const bf16x8*)(sfT + (kk * 4 + 2 * it + t2) * 512 + lane * 8), *(const bf16x8*)(xs + 16 * kk), hacc[t2], 0, 0, 0);
      }
      bf16x8 cfr[8];
#pragma unroll
      for (int kk = 0; kk < 8; ++kk) cfr[kk] = *(const bf16x8*)(sfC + (it * 8 + kk) * 512 + lane * 8);
      f32x16 acc;
#pragma unroll
      for (int e = 0; e < 16; ++e) acc[e] = 0.f;
      {
        const bf16_t* hp = sH + pcol * SH_STRIDE + 8 * hh;
#pragma unroll
        for (int kk = 0; kk < 8; ++kk) acc = __builtin_amdgcn_mfma_f32_32x32x16_bf16(cfr[kk], *(const bf16x8*)(hp + 16 * kk), acc, 0, 0, 0);
      }
#pragma unroll
      for (int qd = 0; qd < 4; ++qd) {
        f32x4 ec = *(const f32x4*)(myW + 128 + 32 * it + 8 * qd + 4 * hh);
        acc[4 * qd] *= ec.x; acc[4 * qd + 1] *= ec.y; acc[4 * qd + 2] *= ec.z; acc[4 * qd + 3] *= ec.w;
      }
      const int icol = 32 * it + r;
      const float ci_ = myW[64 + icol];
#pragma unroll
      for (int jt = 0; jt < 2; ++jt) {
        const bool needed = jt == 0 ? need0 : need1;
        if (needed) {
          f32x16 X;
#pragma unroll
          for (int e = 0; e < 16; ++e) X[e] = 0.f;
#pragma unroll
          for (int kk = 0; kk < 8; ++kk) X = __builtin_amdgcn_mfma_f32_32x32x16_bf16(*(const bf16x8*)(sfB + (jt * 8 + kk) * 512 + lane * 8), cfr[kk], X, 0, 0, 0);
#pragma unroll
          for (int qd = 0; qd < 4; ++qd) {
            const int j0 = 32 * jt + 8 * qd + 4 * hh;
            f32x4 cj = *(const f32x4*)(myW + 64 + j0), dj = *(const f32x4*)(myW + j0);
            float cjv[4] = {cj.x, cj.y, cj.z, cj.w}, djv[4] = {dj.x, dj.y, dj.z, dj.w};
#pragma unroll
            for (int u = 0; u < 4; ++u) {
              const int j = j0 + u;
              const bool ok = dir == 0 ? (j <= icol) : (j >= icol);
              const float m = __expf(ci_ - cjv[u]) * djv[u];
              X[4 * qd + u] = ok ? X[4 * qd + u] * m : 0.f;
            }
          }
#pragma unroll
          for (int sk = 0; sk < 2; ++sk) {
            bf16x8 afr = pack8(X[8 * sk], X[8 * sk + 1], X[8 * sk + 2], X[8 * sk + 3], X[8 * sk + 4], X[8 * sk + 5], X[8 * sk + 6], X[8 * sk + 7]);
            const bf16_t* xp = sXr + pcol * 72 + 32 * jt + 16 * sk + 4 * hh;
            u32x2 lo = *(const u32x2*)xp, hi = *(const u32x2*)(xp + 8);
            u32x4 xv; xv.x = lo.x; xv.y = lo.y; xv.z = hi.x; xv.w = hi.y;
            acc = __builtin_amdgcn_mfma_f32_32x32x16_bf16(afr, __builtin_bit_cast(bf16x8, xv), acc, 0, 0, 0);
          }
        }
      }
      __syncthreads();
      SCAN_DMA(ptokN);
      SCAN_WRITE_STATE();
      {
        bf16_t* yo = sY + (32 * it) * 72 + pcol;
#pragma unroll
        for (int e = 0; e < 16; ++e) yo[rowmap(e, hh) * 72] = f2bf(acc[e]);
      }
    }
    __syncthreads();
    {
      const int ptokP = SCAN_PTOK(nchunks - 1);
#pragma unroll
      for (int i = 0; i < 2; ++i) {
        const int q = tid + i * 256, yrow = q >> 3, c8 = (q & 7) * 8;
        *(u32x4*)(ybuf + ((size_t)dir * T_ALL + ptokP + yrow) * 2048 + h * 64 + c8) = *(const u32x4*)(sY + yrow * 72 + c8);
      }
    }
#undef SCAN_PTOK
#undef SCAN_LOAD_DTX
#undef SCAN_DMA
#undef SCAN_WRITE_STATE
    if (s < 32) {
      float* ho = p.out_ssd + ((((size_t)s * 2 + slot) * 2 + dir) * 32 + h) * 8192 + (size_t)pcol * 128;
#pragma unroll
      for (int t2 = 0; t2 < 2; ++t2)
#pragma unroll
        for (int qd = 0; qd < 4; ++qd) {
          f32x4 v; v.x = hacc[t2][4 * qd]; v.y = hacc[t2][4 * qd + 1]; v.z = hacc[t2][4 * qd + 2]; v.w = hacc[t2][4 * qd + 3];
          *(f32x4*)(ho + 32 * (2 * it + t2) + 8 * qd + 4 * hh) = v;
        }
    }
    asm volatile("s_waitcnt vmcnt(0)" ::: "memory");
  }
}

__device__ __forceinline__ void phase_ssd_gate(const Params& p, int slot, int bid, int nblk, int cxw) {
  const int tidx = opaque_tid(cxw);
  bf16_t* zb = (bf16_t*)(p.scratch + SC_SSD_Z);
  const bf16_t* yfb = (const bf16_t*)(p.scratch + SC_SSD_XBC);
  const bf16_t* ybb = yfb + (size_t)T_ALL * 2048;
  const bf16_t* xbcc = (const bf16_t*)(p.scratch + SC_SSD_XBCC);
  int lane = tidx & 63, wv = cxw & 3;
  for (int row = bid * 4 + wv; row < T_ALL; row += nblk * 4) {
    float ss = 0.f;
    TokInfo ti = tokinfo(row);
    const int prow = ti.base + seqpos2off(ti.l, slot == 1 && ti.s >= 32);
#pragma unroll
    for (int j = 0; j < 4; ++j) {
      int c0 = j * 512 + lane * 8;
      u32x4 zv = *(const u32x4*)(zb + (size_t)row * 2048 + c0);
      u32x4 fv = *(const u32x4*)(yfb + (size_t)prow * 2048 + c0);
      u32x4 bv = *(const u32x4*)(ybb + (size_t)prow * 2048 + c0);
      u32x4 xv = *(const u32x4*)(xbcc + (size_t)prow * 2048 + c0);
      float dsk = p.ssd_d[slot * 32 + (c0 >> 6)];
      unsigned zw[4] = {zv.x, zv.y, zv.z, zv.w}, fw[4] = {fv.x, fv.y, fv.z, fv.w}, bw[4] = {bv.x, bv.y, bv.z, bv.w}, xw[4] = {xv.x, xv.y, xv.z, xv.w};
      unsigned ow[4];
#pragma unroll
      for (int e = 0; e < 4; ++e) {
        float y0 = (bflo(fw[e]) + bflo(bw[e]) + dsk * bflo(xw[e])) * siluf(bflo(zw[e]));
        float y1 = (bfhi(fw[e]) + bfhi(bw[e]) + dsk * bfhi(xw[e])) * siluf(bfhi(zw[e]));
        ss += y0 * y0 + y1 * y1;
        ow[e] = pack2(y0, y1);
      }
      u32x4 o; o.x = ow[0]; o.y = ow[1]; o.z = ow[2]; o.w = ow[3];
      *(u32x4*)(zb + (size_t)row * 2048 + c0) = o;
    }
#pragma unroll
    for (int o = 32; o > 0; o >>= 1) ss += shfl_xor_f(ss, o, lane);
    if (lane == 0) p.rstd[row] = rsqrtf(ss * (1.f / 2048.f) + 1e-5f);
  }
}

#define HY_UOFF 32768
__device__ __forceinline__ void hy_stage_conv(const Params& p, const bf16_t* __restrict__ row, int ch, bf16_t* dst, int dstStride, int dstPad,
                                              int nelem, int L, int tid) {
  const float w0 = p.hy_conv_w[ch], w1 = p.hy_conv_w[3072 + ch], w2 = p.hy_conv_w[2 * 3072 + ch], bb = p.hy_conv_b[ch];
  for (int q = tid; q < nelem / 8; q += NTHR) {
    const int e0 = q * 8, b = e0 / L, t0 = e0 & (L - 1);
    u32x4 raw = *(const u32x4*)(row + e0);
    float x[10];
    x[0] = t0 > 0 ? bf2f(row[e0 - 1]) : 0.f;
    x[9] = t0 + 8 < L ? bf2f(row[e0 + 8]) : 0.f;
    x[1] = bflo(raw.x); x[2] = bfhi(raw.x); x[3] = bflo(raw.y); x[4] = bfhi(raw.y);
    x[5] = bflo(raw.z); x[6] = bfhi(raw.z); x[7] = bflo(raw.w); x[8] = bfhi(raw.w);
    float o[8];
#pragma unroll
    for (int j = 0; j < 8; ++j) o[j] = w0 * x[j] + w1 * x[j + 1] + w2 * x[j + 2] + bb;
    u32x4 ov; ov.x = pack2(o[0], o[1]); ov.y = pack2(o[2], o[3]); ov.z = pack2(o[4], o[5]); ov.w = pack2(o[6], o[7]);
    *(u32x4*)(dst + b * dstStride + dstPad + t0) = ov;
  }
}

__device__ __forceinline__ void phase_hy_longconv(const Params& p, int bid, int nblk, unsigned char* smem, int cxw) {
  const int tid = opaque_tid(cxw), lane = tid & 63, w = cxw & 3  , r = lane & 31, hh = lane >> 5;
  const bf16_t* projT = (const bf16_t*)(p.scratch + SC_HY_PROJT);
  bf16_t* yT = (bf16_t*)(p.scratch + SC_HY_YT);
  unsigned* Rc0 = (unsigned*)smem;
  unsigned* Rc1 = Rc0 + 4096;
  bf16_t* G = (bf16_t*)smem;
  bf16_t* U = (bf16_t*)(smem + HY_UOFF);
  for (int item = bid; item < 2048; item += nblk) {
    const bool lat = item < 1024;
    const int c = item & 1023;
    const int L = lat ? 4096 : 256, NB = lat ? 4 : 32, RL = lat ? 8192 : 512, Lm1 = L - 1;
    const int PAD = lat ? 224 : 0, US = lat ? 4552 : 264;
    const int tokbase = lat ? T_CTX : 0;
    const int nI = L >> 5, nelem = NB * L;
    const int TPW = lat ? 4 : 2;
    __syncthreads();
    if (lat) {
      for (int q = tid; q < 4 * 57; q += NTHR) {
        int b = q / 57, k = q % 57;
        int off = k < 28 ? k * 8 : 224 + 4096 + (k - 28) * 8;
        unsigned zz = 0u; asm volatile("" : "+v"(zz));
        u32x4 z4 = {zz, zz, zz, zz};
        *(u32x4*)(U + b * US + off) = z4;
      }
    }
    hy_stage_conv(p, projT + (size_t)c * T_ALL + tokbase, c, U, US, PAD, nelem, L, tid);
    int Icol[4], bcol[4];
#pragma unroll
    for (int tt = 0; tt < 4; ++tt) {
      int n = (w * TPW + tt) * 32 + r;
      Icol[tt] = lat ? (n >> 2) : (n >> 5);
      bcol[tt] = lat ? (n & 3) : (n & 31);
    }
    const int Ilo_w = lat ? 32 * w : 2 * w, Ihi_w = lat ? 32 * w + 31 : 2 * w + 1;
    const int dlo = Ilo_w - (nI - 1), dhi = Ihi_w;
    for (int order = 0; order < 2; ++order) {
      {
        const bf16_t* src = (lat ? p.rtab1 : p.rtab0) + (size_t)(order * 1024 + c) * RL;
        for (int q = tid; q < RL / 8; q += NTHR) {
          u32x4 cv = *(const u32x4*)(src + q * 8);
          unsigned nx = (q + 1 < RL / 8) ? *(const unsigned*)(src + q * 8 + 8) : 0u;
          *(u32x4*)(Rc0 + q * 4) = cv;
          u32x4 sv;
          sv.x = (cv.x >> 16) | (cv.y << 16); sv.y = (cv.y >> 16) | (cv.z << 16);
          sv.z = (cv.z >> 16) | (cv.w << 16); sv.w = (cv.w >> 16) | (nx << 16);
          *(u32x4*)(Rc1 + q * 4) = sv;
        }
      }
      __syncthreads();
      f32x16 acc[4];
#pragma unroll
      for (int tt = 0; tt < 4; ++tt)
#pragma unroll
        for (int e = 0; e < 16; ++e) acc[tt][e] = 0.f;
      {
        int lo_t[4], hi_t[4];
        const bf16_t* ub[4];
#pragma unroll
        for (int tt = 0; tt < 4; ++tt) {
          const int tile = w * TPW + tt;
          const int Ilo_t = lat ? 8 * tile : tile, Ihi_t = lat ? 8 * tile + 7 : tile;
          lo_t[tt] = tt < TPW ? Ilo_t - (nI - 1) : 1 << 30; hi_t[tt] = tt < TPW ? Ihi_t : -(1 << 30);
          ub[tt] = U + bcol[tt] * US + PAD + 32 * Icol[tt] + 8 * hh;
        }
        const int ybase = Lm1 - r + 8 * hh;
#define LC_EDGE(D0, D1) do { for (int d_ = (D0); d_ <= (D1); ++d_) { \
          _Pragma("unroll") for (int kk_ = 0; kk_ < 2; ++kk_) { \
            const int y0_ = ybase - 32 * d_ + 16 * kk_; const int par_ = y0_ & 1; \
            const unsigned* rp_ = (par_ ? Rc1 : Rc0) + ((y0_ - par_) >> 1); \
            u32x4 av_; av_.x = rp_[0]; av_.y = rp_[1]; av_.z = rp_[2]; av_.w = rp_[3]; const bf16x8 af_ = __builtin_bit_cast(bf16x8, av_); \
            _Pragma("unroll") for (int tt = 0; tt < 4; ++tt) if (d_ >= lo_t[tt] && d_ <= hi_t[tt]) \
              acc[tt] = __builtin_amdgcn_mfma_f32_32x32x16_bf16(af_, *(const bf16x8*)(ub[tt] - 32 * d_ + 16 * kk_), acc[tt], 0, 0, 0); } } } while (0)
        if (!lat) {
          LC_EDGE(dlo, dhi);
        } else {
          const int mlo = lo_t[3], mhi = hi_t[0];
          LC_EDGE(dlo, mlo - 1);
#define LC_LOAD(IT, A, B) do { const int it_ = (IT); const int d_ = mlo + (it_ >> 1), kk_ = it_ & 1; \
          const int y0_ = ybase - 32 * d_ + 16 * kk_; const int par_ = y0_ & 1; \
          const unsigned* rp_ = (par_ ? Rc1 : Rc0) + ((y0_ - par_) >> 1); \
          u32x4 av_; av_.x = rp_[0]; av_.y = rp_[1]; av_.z = rp_[2]; av_.w = rp_[3]; A = __builtin_bit_cast(bf16x8, av_); \
          _Pragma("unroll") for (int tt = 0; tt < 4; ++tt) B[tt] = *(const bf16x8*)(ub[tt] - 32 * d_ + 16 * kk_); } while (0)
#define LC_MMA(A, B) do { _Pragma("unroll") for (int tt = 0; tt < 4; ++tt) acc[tt] = __builtin_amdgcn_mfma_f32_32x32x16_bf16(A, B[tt], acc[tt], 0, 0, 0); } while (0)
          const int NIT = 2 * (mhi - mlo + 1);
          bf16x8 a0, a1, b0[4], b1[4];
          LC_LOAD(0, a0, b0);
          for (int it = 0; it < NIT; it += 2) {
            LC_LOAD(it + 1, a1, b1);
            LC_MMA(a0, b0);
            LC_LOAD(it + 2 < NIT ? it + 2 : NIT - 1, a0, b0);
            LC_MMA(a1, b1);
          }
#undef LC_LOAD
#undef LC_MMA
          LC_EDGE(mhi + 1, dhi);
        }
#undef LC_EDGE
      }
      __syncthreads();
      hy_stage_conv(p, projT + (size_t)((1 + order) * 1024 + c) * T_ALL + tokbase, (1 + order) * 1024 + c, G, L, 0, nelem, L, tid);
      __syncthreads();
      const float inv = 1.f / p.knorm[((lat ? 1 : 0) * 2 + order) * 1024 + c];
      const float bias = p.hy_f_bias[order * 1024 + c];
#pragma unroll
      for (int tt = 0; tt < 4; ++tt) {
        if (tt < TPW) {
#pragma unroll
          for (int qd = 0; qd < 4; ++qd) {
            const int t0 = 32 * Icol[tt] + 8 * qd + 4 * hh;
            bf16_t* up = U + bcol[tt] * US + PAD + t0;
            u32x2 uc = *(const u32x2*)up;
            u32x2 gg = *(const u32x2*)(G + bcol[tt] * L + t0);
            float r0 = (inv * acc[tt][4 * qd] + bias * bflo(uc.x)) * bflo(gg.x);
            float r1 = (inv * acc[tt][4 * qd + 1] + bias * bfhi(uc.x)) * bfhi(gg.x);
            float r2 = (inv * acc[tt][4 * qd + 2] + bias * bflo(uc.y)) * bflo(gg.y);
            float r3 = (inv * acc[tt][4 * qd + 3] + bias * bfhi(uc.y)) * bfhi(gg.y);
            if (order == 1) {
              u32x2 zz = *(const u32x2*)(projT + (size_t)(3072 + c) * T_ALL + tokbase + bcol[tt] * L + t0);
              r0 *= siluf(bflo(zz.x)); r1 *= siluf(bfhi(zz.x)); r2 *= siluf(bflo(zz.y)); r3 *= siluf(bfhi(zz.y));
            }
            u32x2 ov; ov.x = pack2(r0, r1); ov.y = pack2(r2, r3);
            *(u32x2*)up = ov;
          }
        }
      }
      __syncthreads();
    }
    for (int q = tid; q < nelem / 8; q += NTHR) {
      const int e0 = q * 8, b = e0 / L, t0 = e0 & (L - 1);
      *(u32x4*)(yT + (size_t)c * T_ALL + tokbase + e0) = *(const u32x4*)(U + b * US + PAD + t0);
    }
  }
}

__device__ __forceinline__ void phase_hy_transpose(const Params& p, int bid, int nblk, unsigned char* smem, int cxw) {
  const int tid = opaque_tid(cxw);
  const bf16_t* yT = (const bf16_t*)(p.scratch + SC_HY_YT);
  bf16_t* yg = (bf16_t*)(p.scratch + SC_HY_YG);
  bf16_t* tl = (bf16_t*)smem;
  for (int item = bid; item < 16 * (T_ALL / 64); item += nblk) {
    const int cb = item & 15, tb = item >> 4;
    __syncthreads();
#pragma unroll
    for (int i = 0; i < 2; ++i) {
      int q = tid + i * 256, cr = q >> 3, t8 = (q & 7) * 8;
      u32x4 v = *(const u32x4*)(yT + (size_t)(cb * 64 + cr) * T_ALL + tb * 64 + t8);
      unsigned wv[4] = {v.x, v.y, v.z, v.w};
#pragma unroll
      for (int e = 0; e < 4; ++e) {
        tl[(t8 + 2 * e) * 72 + cr] = (bf16_t)(wv[e] & 0xffffu);
        tl[(t8 + 2 * e + 1) * 72 + cr] = (bf16_t)(wv[e] >> 16);
      }
    }
    __syncthreads();
#pragma unroll
    for (int i = 0; i < 2; ++i) {
      int q = tid + i * 256, tr = q >> 3, c8 = (q & 7) * 8;
      *(u32x4*)(yg + (size_t)(tb * 64 + tr) * 1024 + cb * 64 + c8) = *(const u32x4*)(tl + tr * 72 + c8);
    }
  }
}

#define LRU_NCH 384
struct Lru4 { float af[4], bxf[4], ab[4], bxb[4]; };
__device__ __forceinline__ void lru_unpack4(u32x2 v, float (&o)[4]) { o[0] = bflo(v.x); o[1] = bfhi(v.x); o[2] = bflo(v.y); o[3] = bfhi(v.y); }
__device__ __forceinline__ void lru_row_f(const bf16_t* gates, const bf16_t* xc, size_t o, const float (&spf)[4], float (&af)[4], float (&bxf)[4]) {
  float r[4], g[4], x[4];
  lru_unpack4(*(const u32x2*)(gates + o), r); lru_unpack4(*(const u32x2*)(gates + (size_t)T_ALL * 1024 + o), g); lru_unpack4(*(const u32x2*)(xc + o), x);
#pragma unroll
  for (int e = 0; e < 4; ++e) { const float la = -8.f * r[e] * spf[e]; af[e] = __expf(la); bxf[e] = sqrtf(fmaxf(1.f - __expf(2.f * la), 0.f)) * g[e] * x[e]; }
}
__device__ __forceinline__ void lru_row_b(const bf16_t* gates, const bf16_t* xc, size_t o, const float (&spb)[4], float (&ab)[4], float (&bxb)[4]) {
  float r[4], g[4], x[4];
  lru_unpack4(*(const u32x2*)(gates + (size_t)2 * T_ALL * 1024 + o), r); lru_unpack4(*(const u32x2*)(gates + (size_t)3 * T_ALL * 1024 + o), g); lru_unpack4(*(const u32x2*)(xc + o), x);
#pragma unroll
  for (int e = 0; e < 4; ++e) { const float la = -8.f * r[e] * spb[e]; ab[e] = __expf(la); bxb[e] = sqrtf(fmaxf(1.f - __expf(2.f * la), 0.f)) * g[e] * x[e]; }
}
__device__ __forceinline__ void phase_lru_scan_agg(const Params& p, int bid, int nblk, unsigned char* smem, int cxw) {
  const int tidx = opaque_tid(cxw);
  const bf16_t* gates = (const bf16_t*)(p.scratch + SC_LRU_GATES);
  const bf16_t* xc = (const bf16_t*)(p.scratch + SC_LRU_XC);
  float* sagg = (float*)smem;
  const int sub = cxw & 3, cq = tidx & 63;
  for (int item = bid; item < LRU_NCH * 4; item += nblk) {
    const int chunk = item >> 2, cb = item & 3;
    const int c0 = cb * 256 + 4 * cq;
    float spf[4], spb[4];
#pragma unroll
    for (int e = 0; e < 4; ++e) { spf[e] = softplusf(-p.lru_a_param[c0 + e]); spb[e] = softplusf(-p.lru_a_param[1024 + c0 + e]); }
    const int tok0 = chunk * 64 + 16 * sub;
    float Af[4] = {1.f, 1.f, 1.f, 1.f}, hf[4] = {0.f, 0.f, 0.f, 0.f}, Pb[4] = {1.f, 1.f, 1.f, 1.f}, Bb[4] = {0.f, 0.f, 0.f, 0.f};
#pragma unroll 4
    for (int j = 0; j < 16; ++j) {
      const size_t o = (size_t)(tok0 + j) * 1024 + c0;
      float af[4], bxf[4], ab[4], bxb[4];
      lru_row_f(gates, xc, o, spf, af, bxf);
      lru_row_b(gates, xc, o, spb, ab, bxb);
#pragma unroll
      for (int e = 0; e < 4; ++e) { hf[e] = af[e] * hf[e] + bxf[e]; Af[e] *= af[e]; Bb[e] += bxb[e] * Pb[e]; Pb[e] *= ab[e]; }
    }
    {
      const size_t sc = (size_t)chunk * 4 + sub;
      float* gf = p.lru_sagg + (((size_t)0 * (LRU_NCH * 4) + sc) * 1024 + c0) * 2;
      float* gb = p.lru_sagg + (((size_t)1 * (LRU_NCH * 4) + sc) * 1024 + c0) * 2;
      f32x4 v0 = {Af[0], hf[0], Af[1], hf[1]}, v1 = {Af[2], hf[2], Af[3], hf[3]};
      f32x4 w0 = {Pb[0], Bb[0], Pb[1], Bb[1]}, w1 = {Pb[2], Bb[2], Pb[3], Bb[3]};
      *(f32x4*)gf = v0; *(f32x4*)(gf + 4) = v1; *(f32x4*)gb = w0; *(f32x4*)(gb + 4) = w1;
      __syncthreads();
      float* sl = sagg + (sub * 64 + cq) * 16;
      *(f32x4*)sl = v0; *(f32x4*)(sl + 4) = v1; *(f32x4*)(sl + 8) = w0; *(f32x4*)(sl + 12) = w1;
      __syncthreads();
    }
    if (sub == 0) {
      float A[4], B[4], P[4], Q[4];
#pragma unroll
      for (int e = 0; e < 4; ++e) { A[e] = 1.f; B[e] = 0.f; P[e] = 1.f; Q[e] = 0.f; }
#pragma unroll
      for (int s2 = 0; s2 < 4; ++s2) {
        const float* lf = sagg + (s2 * 64 + cq) * 16;
        const float* lb = sagg + ((3 - s2) * 64 + cq) * 16 + 8;
#pragma unroll
        for (int e = 0; e < 4; ++e) {
          const float a = lf[2 * e], b = lf[2 * e + 1];
          B[e] = a * B[e] + b; A[e] *= a;
          const float pb = lb[2 * e], qb = lb[2 * e + 1];
          Q[e] = pb * Q[e] + qb; P[e] *= pb;
        }
      }
      float* gf = p.lru_agg + (((size_t)0 * LRU_NCH + chunk) * 1024 + c0) * 2;
      float* gb = p.lru_agg + (((size_t)1 * LRU_NCH + chunk) * 1024 + c0) * 2;
      f32x4 v0 = {A[0], B[0], A[1], B[1]}, v1 = {A[2], B[2], A[3], B[3]}, w0 = {P[0], Q[0], P[1], Q[1]}, w1 = {P[2], Q[2], P[3], Q[3]};
      *(f32x4*)gf = v0; *(f32x4*)(gf + 4) = v1; *(f32x4*)gb = w0; *(f32x4*)(gb + 4) = w1;
    }
  }
}
__device__ __forceinline__ void phase_lru_scan_carry(const Params& p, int bid, int nblk, int cxw) {
  const int tidx = opaque_tid(cxw);
  for (int item = bid; item < 36 * 8; item += nblk) {
    int s = item >> 3, dir = (item >> 2) & 1, cb = item & 3;
    int c = cb * 256 + tidx;
    int nch = s < 32 ? 4 : 64;
    int ch0 = s < 32 ? s * 4 : 128 + (s - 32) * 64;
    float h = s < 32 ? 0.f : p.state_lru[((size_t)(s - 32) * 2 + dir) * 1024 + c];
    for (int k0 = 0; k0 < nch; k0 += 4) {
      f32x2_t ag[4]; size_t idx[4];
#pragma unroll
      for (int u = 0; u < 4; ++u) {
        const int chunk = dir ? ch0 + nch - 1 - (k0 + u) : ch0 + k0 + u;
        idx[u] = ((size_t)dir * LRU_NCH + chunk) * 1024 + c;
        ag[u] = *(const f32x2_t*)(p.lru_agg + idx[u] * 2);
      }
#pragma unroll
      for (int u = 0; u < 4; ++u) { p.lru_hin[idx[u]] = h; h = ag[u].x * h + ag[u].y; }
    }
    if (s < 32) p.out_lru[((size_t)s * 2 + dir) * 1024 + c] = h;
  }
}
__device__ __forceinline__ void phase_lru_scan_final(const Params& p, int bid, int nblk, unsigned char* smem, int cxw) {
  const int tidx = opaque_tid(cxw);
  const bf16_t* gates = (const bf16_t*)(p.scratch + SC_LRU_GATES);
  const bf16_t* xc = (const bf16_t*)(p.scratch + SC_LRU_XC);
  const bf16_t* proj = (const bf16_t*)(p.scratch + SC_LRU_PROJ);
  bf16_t* yg = (bf16_t*)(p.scratch + SC_LRU_YG);
  const int sub = cxw & 3, cq = tidx & 63;
  for (int item = bid; item < LRU_NCH * 4; item += nblk) {
    const int chunk = item >> 2, cb = item & 3;
    const int c0 = cb * 256 + 4 * cq;
    float spf[4], spb[4];
#pragma unroll
    for (int e = 0; e < 4; ++e) { spf[e] = softplusf(-p.lru_a_param[c0 + e]); spb[e] = softplusf(-p.lru_a_param[1024 + c0 + e]); }
    float hf[4], hb[4];
    {
      const f32x4 a = *(const f32x4*)(p.lru_hin + ((size_t)0 * LRU_NCH + chunk) * 1024 + c0);
      const f32x4 b = *(const f32x4*)(p.lru_hin + ((size_t)1 * LRU_NCH + chunk) * 1024 + c0);
      hf[0] = a.x; hf[1] = a.y; hf[2] = a.z; hf[3] = a.w; hb[0] = b.x; hb[1] = b.y; hb[2] = b.z; hb[3] = b.w;
    }
#pragma unroll
    for (int s2 = 0; s2 < 3; ++s2) {
      if (s2 < sub) {
        const float* g = p.lru_sagg + (((size_t)0 * (LRU_NCH * 4) + (size_t)chunk * 4 + s2) * 1024 + c0) * 2;
        const f32x4 v0 = *(const f32x4*)g, v1 = *(const f32x4*)(g + 4);
        hf[0] = v0.x * hf[0] + v0.y; hf[1] = v0.z * hf[1] + v0.w; hf[2] = v1.x * hf[2] + v1.y; hf[3] = v1.z * hf[3] + v1.w;
      }
      if (3 - s2 > sub) {
        const float* g = p.lru_sagg + (((size_t)1 * (LRU_NCH * 4) + (size_t)chunk * 4 + (3 - s2)) * 1024 + c0) * 2;
        const f32x4 v0 = *(const f32x4*)g, v1 = *(const f32x4*)(g + 4);
        hb[0] = v0.x * hb[0] + v0.y; hb[1] = v0.z * hb[1] + v0.w; hb[2] = v1.x * hb[2] + v1.y; hb[3] = v1.z * hb[3] + v1.w;
      }
    }
    const int tok0 = chunk * 64 + 16 * sub;
    float hfs[16][4];
#pragma unroll
    for (int j = 0; j < 16; ++j) {
      const size_t o = (size_t)(tok0 + j) * 1024 + c0;
      float af[4], bxf[4];
      lru_row_f(gates, xc, o, spf, af, bxf);
#pragma unroll
      for (int e = 0; e < 4; ++e) { hf[e] = af[e] * hf[e] + bxf[e]; hfs[j][e] = hf[e]; }
    }
#pragma unroll
    for (int j = 15; j >= 0; --j) {
      const size_t o = (size_t)(tok0 + j) * 1024 + c0;
      float ab[4], bxb[4], z[4];
      lru_row_b(gates, xc, o, spb, ab, bxb);
      lru_unpack4(*(const u32x2*)(proj + (size_t)(tok0 + j) * 2048 + 1024 + c0), z);
      float y[4];
#pragma unroll
      for (int e = 0; e < 4; ++e) { hb[e] = ab[e] * hb[e] + bxb[e]; y[e] = (hfs[j][e] + hb[e]) * siluf(z[e]); }
      u32x2 ov; ov.x = pack2(y[0], y[1]); ov.y = pack2(y[2], y[3]);
      *(u32x2*)(yg + o) = ov;
    }
  }
}

enum { PH_PREP = 0, PH_MOD, PH_HYA, PH_HYB, PH_LNMOD, PH_INPROJ, PH_MIX1, PH_MIX2, PH_MIX3, PH_MIX4, PH_MIX5, PH_MIX6, PH_OUTPROJ };

struct Ctx { int bid, nblk, wave; unsigned char* smem; unsigned char* wg_smem; };

template <class Epi>
__device__ __forceinline__ void run_gemm(const Ctx& cx, const bf16_t* A, int lda, const bf16_t* Bt, int M, int N, int K, int grp_shift, int grp_bytes, const Epi& e) {
  pg8::Gemm g{A, Bt, M, N, K, lda, grp_shift, grp_bytes};
  pg8::StaticOrder S; S.init(M, N, gridDim.x, opaque_s(blockIdx.x));
  pg8::gemm_phase((PG8_LAS unsigned char*)cx.wg_smem, g, S, e, cx.wave);
}

#define N_PARAM_WORDS (sizeof(Params) / 8)
__device__ __forceinline__ Params load_params(const unsigned char* lp) {
  Params p;
  unsigned long long* d = (unsigned long long*)&p;
  const unsigned long long* sp = (const unsigned long long*)lp;
#pragma unroll
  for (int i = 0; i < (int)N_PARAM_WORDS; ++i) {
    const unsigned long long v = sp[i];
    const unsigned lo = __builtin_amdgcn_readfirstlane((unsigned)v), hi = __builtin_amdgcn_readfirstlane((unsigned)(v >> 32));
    d[i] = ((unsigned long long)hi << 32) | lo;
  }
  return p;
}
__device__ __forceinline__ void run_phase(const unsigned char* lparams, int ph, int layer, const Ctx& cx) {
  const Params p = load_params(lparams);
  const int kind = layer % 3, slot = layer / 3;
  const int bid = opaque_s(cx.bid), nblk = cx.nblk;
  unsigned char* smem = cx.smem;
  switch (ph) {
    case PH_PREP: phase_prep(p, bid, nblk, smem, cx.wave); break;
    case PH_MOD: phase_mod(p, bid, nblk, smem, cx.wave); break;
    case PH_HYA: phase_hyfilt_a(p, bid, nblk, smem, cx.wave); break;
    case PH_HYB: phase_hyfilt_b(p, bid, nblk, smem, cx.wave); break;
    case PH_LNMOD: phase_lnmod(p, layer, bid, nblk, cx.wave); break;
    case PH_INPROJ:
      if (kind == 0) {
        pg8::EpiSsdIn e{(bf16_t*)(p.scratch + SC_SSD_Z), (bf16_t*)(p.scratch + SC_SSD_XBC), (float*)(p.scratch + SC_SSD_DT), p.ssd_dt_bias + slot * 64};
        run_gemm(cx, p.hbuf, 1024, p.wt_ssd_in + (size_t)slot * 6400 * 1024, T_ALL, 6400, 1024, 30, 0, e);
      } else if (kind == 1) {
        pg8::EpiBf16 e{(bf16_t*)(p.scratch + SC_HY_PROJT), (size_t)T_ALL};
        run_gemm(cx, p.wt_hy_in, 1024, p.hbuf, 4096, T_ALL, 1024, 30, 0, e);
      } else {
        pg8::EpiBf16 e{(bf16_t*)(p.scratch + SC_LRU_PROJ), (size_t)2048};
        run_gemm(cx, p.hbuf, 1024, p.wt_lru_in, T_ALL, 2048, 1024, 30, 0, e);
      }
      break;
    case PH_MIX1:
      if (kind == 0) phase_ssd_conv(p, slot, slot == 1, bid, nblk, smem, cx.wave);
      else if (kind == 1) phase_hy_longconv(p, bid, nblk, smem, cx.wave);
      else phase_dwconv<4, false>((const bf16_t*)(p.scratch + SC_LRU_PROJ), 2048, (bf16_t*)(p.scratch + SC_LRU_XC), 1024, 1024,
                                  p.lru_conv_w, p.lru_conv_b, false, bid, nblk, cx.wave);
      break;
    case PH_MIX2:
      if (kind == 0) phase_ssd_scan(p, slot, slot == 1, bid, nblk, cx.wg_smem, cx.wave);
      else if (kind == 1) phase_hy_transpose(p, bid, nblk, smem, cx.wave);
      else {
        pg8::EpiLruGate e{(bf16_t*)(p.scratch + SC_LRU_GATES), p.lru_gate_b};
        run_gemm(cx, (const bf16_t*)(p.scratch + SC_LRU_XC), 1024, p.wt_lru_gate, T_ALL, 4096, 256, 2, 512, e);
      }
      break;
    case PH_MIX3:
      if (kind == 0) phase_ssd_gate(p, slot, bid, nblk, cx.wave);
      else phase_lru_scan_agg(p, bid, nblk, smem, cx.wave);
      break;
    case PH_MIX4: if (kind == 2) phase_lru_scan_carry(p, bid, nblk, cx.wave); break;
    case PH_MIX5: if (kind == 2) phase_lru_scan_final(p, bid, nblk, smem, cx.wave); break;
    case PH_OUTPROJ: {
      const float* mv = p.modv + (size_t)layer * 5 * 3072;
      if (kind == 0) {
        pg8::EpiOut e{p.xres, mv, p.rstd};
        run_gemm(cx, (const bf16_t*)(p.scratch + SC_SSD_Z), 2048, p.wt_ssd_out + (size_t)slot * 1024 * 2048, T_ALL, 1024, 2048, 30, 0, e);
      } else if (kind == 1) {
        pg8::EpiOut e{p.xres, mv, nullptr};
        run_gemm(cx, (const bf16_t*)(p.scratch + SC_HY_YG), 1024, p.wt_hy_out, T_ALL, 1024, 1024, 30, 0, e);
      } else {
        pg8::EpiOut e{p.xres, mv, nullptr};
        run_gemm(cx, (const bf16_t*)(p.scratch + SC_LRU_YG), 1024, p.wt_lru_out, T_ALL, 1024, 1024, 30, 0, e);
      }
    } break;
  }
}

__global__ void __launch_bounds__(WG_THREADS, 2) k_mega(Params p) {
  __shared__ __attribute__((aligned(16))) unsigned char smem[WG_SMEM + 16 + 512];
  cg::grid_group grid = cg::this_grid();
  const int wave0 = __builtin_amdgcn_readfirstlane((int)(threadIdx.x >> 6));
  const int vb = wave0 >> 2;
  Ctx cx;
  cx.wave = wave0;
  cx.bid = 2 * blockIdx.x + vb; cx.nblk = 2 * gridDim.x; cx.smem = smem + vb * SMEM_BYTES; cx.wg_smem = smem;
  volatile LAS unsigned* xst = (volatile LAS unsigned*)(smem + WG_SMEM);
  unsigned char* lparams = smem + WG_SMEM + 16;
  if (threadIdx.x == 0) { xst[0] = 0u; xst[1] = 0u; *(Params*)lparams = p; }
  __syncthreads();
  const XcdBarrier xb = xcd_barrier_post(p.bar, xst);
  run_phase(lparams, PH_PREP, 0, cx);
  run_phase(lparams, PH_MOD, 0, cx);
  run_phase(lparams, PH_HYA, 0, cx);
  grid.sync();
  run_phase(lparams, PH_HYB, 0, cx);
  for (int layer = 0; layer < 4; ++layer) {
    const int kind = layer % 3;
    run_phase(lparams, PH_LNMOD, layer, cx);
    xcd_barrier(xb, cx.wave);
    run_phase(lparams, PH_INPROJ, layer, cx);
    xcd_barrier(xb, cx.wave);
    run_phase(lparams, PH_MIX1, layer, cx);
    xcd_barrier(xb, cx.wave);
    run_phase(lparams, PH_MIX2, layer, cx);
    xcd_barrier(xb, cx.wave);
    if (kind != 1) {
      run_phase(lparams, PH_MIX3, layer, cx);
      xcd_barrier(xb, cx.wave);
    }
    if (kind == 2) {
      run_phase(lparams, PH_MIX4, layer, cx);
      xcd_barrier(xb, cx.wave);
      run_phase(lparams, PH_MIX5, layer, cx);
      xcd_barrier(xb, cx.wave);
    }
    run_phase(lparams, PH_OUTPROJ, layer, cx);
    xcd_barrier(xb, cx.wave);
  }
  run_phase(lparams, PH_LNMOD, 4, cx);
}

static inline size_t align_up(size_t x) { return (x + 255) & ~(size_t)255; }

extern "C" void kernel_launch(void* const* d_in, const int* in_sizes, int n_in, void* d_out, int out_size, void* d_ws, size_t ws_size,
                              hipStream_t stream) {
  Params p{};
  const float** fp = (const float**)&p;
  for (int i = 0; i < 36; ++i) fp[i] = (const float*)d_in[i];
  float* out = (float*)d_out;
  p.xres = out;
  p.out_ssd = out + (size_t)T_ALL * 1024;
  p.out_lru = p.out_ssd + (size_t)32 * 2 * 2 * 32 * 64 * 128;
  unsigned char* w = (unsigned char*)d_ws;
  size_t off = 0;
  auto carve = [&](size_t bytes) { unsigned char* r = w + off; off = align_up(off + bytes); return r; };
  p.wt_ssd_in = (bf16_t*)carve((size_t)2 * 6400 * 1024 * 2);
  p.wt_ssd_out = (bf16_t*)carve((size_t)2 * 1024 * 2048 * 2);
  p.wt_hy_in = (bf16_t*)carve((size_t)4096 * 1024 * 2);
  p.wt_hy_out = (bf16_t*)carve((size_t)1024 * 1024 * 2);
  p.wt_lru_in = (bf16_t*)carve((size_t)2048 * 1024 * 2);
  p.wt_lru_out = (bf16_t*)carve((size_t)1024 * 1024 * 2);
  p.wt_lru_gate = (bf16_t*)carve((size_t)4 * 1024 * 256 * 2);
  p.modv = (float*)carve((size_t)4 * 5 * 3072 * 4);
  p.hdn2 = (float*)carve((size_t)4352 * 64 * 4);
  p.rtab0 = (bf16_t*)carve((size_t)2 * 1024 * 512 * 2);
  p.rtab1 = (bf16_t*)carve((size_t)2 * 1024 * 8192 * 2);
  p.knorm = (float*)carve((size_t)4 * 1024 * 4);
  p.hbuf = (bf16_t*)carve((size_t)T_ALL * 1024 * 2);
  p.rstd = (float*)carve((size_t)T_ALL * 4);
  p.lru_agg = (float*)carve((size_t)2 * 384 * 1024 * 2 * 4);
  p.lru_hin = (float*)carve((size_t)2 * 384 * 1024 * 4);
  p.lru_sagg = (float*)carve((size_t)2 * 1536 * 1024 * 2 * 4);
  p.bar = (unsigned*)carve((size_t)XCD_BAR_WORDS * 4);
  p.scratch = carve(SC_TOTAL);
  if (off > ws_size) return;

  static int grid_blocks = 0;
  if (!grid_blocks) {
    int dev = 0, cus = 0, per_cu = 0;
    hipGetDevice(&dev);
    hipDeviceGetAttribute(&cus, hipDeviceAttributeMultiprocessorCount, dev);
    hipOccupancyMaxActiveBlocksPerMultiprocessor(&per_cu, k_mega, WG_THREADS, 0);
    if (per_cu > 1) per_cu = 1;
    grid_blocks = cus * per_cu;
  }
  hipMemsetAsync(p.bar, 0, (size_t)XCD_BAR_WORDS * 4, stream);
  void* args[] = {&p};
  hipError_t e = hipLaunchCooperativeKernel((void*)k_mega, dim3(grid_blocks), dim3(WG_THREADS), args, 0, stream);
  if (e != hipSuccess) fprintf(stderr, "cooperative launch failed: %s (grid %d)\n", hipGetErrorString(e), grid_blocks);
}
```

```cpp
#include <hip/hip_runtime.h>
#include <hip/hip_bf16.h>
#include <hip/hip_cooperative_groups.h>
#include <stdint.h>
#include <cstdio>
namespace cg = cooperative_groups;

typedef unsigned short bf16_t;
typedef __attribute__((ext_vector_type(8))) short bf16x8;
typedef __attribute__((ext_vector_type(16))) float f32x16;
typedef __attribute__((ext_vector_type(4))) unsigned int u32x4;
typedef __attribute__((ext_vector_type(2))) unsigned int u32x2;
typedef __attribute__((ext_vector_type(4))) float f32x4;
typedef float f32x4_t __attribute__((ext_vector_type(4)));
typedef float f32x2_t __attribute__((ext_vector_type(2)));

#define T_CTX 8192
#define T_ALL 24576
#define DM 1024
#define NTHR 256
#define SMEM_BYTES 69632
#define WG_THREADS 512
#define WG_SMEM 147456
#define ALPHA_RES 1.6817928305074290f
#define LN_EPS 1e-5f

__device__ __forceinline__ bf16_t f2bf(float f) { __bf16 h = (__bf16)f; return __builtin_bit_cast(bf16_t, h); }
__device__ __forceinline__ float bf2f(bf16_t b) { return __uint_as_float(((unsigned)b) << 16); }
__device__ __forceinline__ float bflo(unsigned w) { return __uint_as_float(w << 16); }
__device__ __forceinline__ float bfhi(unsigned w) { return __uint_as_float(w & 0xffff0000u); }
typedef __bf16 bf16v2_t __attribute__((ext_vector_type(2)));
typedef float f32v2_t __attribute__((ext_vector_type(2)));
__device__ __forceinline__ unsigned pack2(float a, float b) { f32v2_t v = {a, b}; bf16v2_t h = __builtin_convertvector(v, bf16v2_t); return __builtin_bit_cast(unsigned, h); }
__device__ __forceinline__ float siluf(float x) { return x * __builtin_amdgcn_rcpf(1.f + __expf(-x)); }
__device__ __forceinline__ float sigmoidf(float x) { return __builtin_amdgcn_rcpf(1.f + __expf(-x)); }
__device__ __forceinline__ float softplusf(float x) { return x > 20.f ? x : __logf(1.f + __expf(x)); }


__device__ __forceinline__ int opaque_lane() { int z = 0; asm volatile("" : "+v"(z)); return __builtin_amdgcn_mbcnt_hi(~0u, __builtin_amdgcn_mbcnt_lo(~0u, (unsigned)z)); }
__device__ __forceinline__ int opaque_tid512(int wave) { return (wave << 6) + opaque_lane(); }
__device__ __forceinline__ int opaque_tid(int wave) { return opaque_tid512(wave) & 255; }

#define XB_TMO      128
#define XB_XCNT(j)  (256  + 64 * (j))
#define XB_XSUB(j)  (1280 + 64 * (j))
#define XB_XGEN(j)  (2304 + 64 * (j))
#define XB_TOP      3328
#define XB_TOPGEN   3392
#define XCD_BAR_WORDS 3456
#define XB_SPIN_CAP (1u << 18)
#define LAS __attribute__((address_space(3)))
__device__ __forceinline__ unsigned xb_ld(unsigned* p)              { return __hip_atomic_load(p, __ATOMIC_RELAXED, __HIP_MEMORY_SCOPE_AGENT); }
__device__ __forceinline__ unsigned xb_add(unsigned* p, unsigned v) { return __hip_atomic_fetch_add(p, v, __ATOMIC_RELAXED, __HIP_MEMORY_SCOPE_AGENT); }
__device__ __forceinline__ unsigned xb_xcc_id() { return (unsigned)__builtin_amdgcn_s_getreg((3 << 11) | 20) & 0xFu; }
#define XB_SPIN(cond, bar) do { unsigned _sp = 0; while (cond) { __builtin_amdgcn_s_sleep(1); \
    if ((++_sp & 255u) == 0u) { if (xb_ld(&(bar)[XB_TMO])) break; if (_sp > XB_SPIN_CAP) { atomicAdd(&(bar)[XB_TMO], 1u); break; } } } } while (0)
struct XcdBarrier { unsigned* bar; unsigned x; volatile LAS unsigned* st; };
__device__ __forceinline__ XcdBarrier xcd_barrier_post(unsigned* bar, volatile LAS unsigned* st) {
  XcdBarrier b; b.bar = bar; b.x = xb_xcc_id(); b.st = st;
  if (threadIdx.x == 0) (void)xb_add(&bar[XB_XCNT(b.x)], 1u);
  return b;
}
__device__ __forceinline__ void xcd_barrier_complete(unsigned* bar, unsigned x, unsigned& nloc, unsigned& nx) {
  const unsigned G = gridDim.x * gridDim.y * gridDim.z;
  unsigned sum, cnt, mine, sp = 0u;
  for (;;) {
    sum = 0u; cnt = 0u; mine = 0u;
#pragma unroll
    for (unsigned j = 0; j < 16; ++j) { const unsigned c = xb_ld(&bar[XB_XCNT(j)]); sum += c; cnt += (c > 0u) ? 1u : 0u; mine = (j == x) ? c : mine; }
    if (sum == G) break;
    __builtin_amdgcn_s_sleep(1);
    if ((++sp & 255u) == 0u) { if (xb_ld(&bar[XB_TMO])) break; if (sp > XB_SPIN_CAP) { atomicAdd(&bar[XB_TMO], 1u); break; } }
  }
  nloc = mine > 0u ? mine : 1u; nx = cnt > 0u ? cnt : 1u;
}
__device__ __forceinline__ void xcd_barrier(const XcdBarrier& b, int wave) {
  asm volatile("s_waitcnt vmcnt(0)" ::: "memory");
  __syncthreads();
  if (opaque_tid512(wave) == 0) {
    unsigned* bar = b.bar;
    __builtin_amdgcn_s_waitcnt(0);
    unsigned nloc = b.st[0], nx = b.st[1];
    if (nloc == 0u) { xcd_barrier_complete(bar, b.x, nloc, nx); b.st[0] = nloc; b.st[1] = nx; }
    const unsigned old = xb_add(&bar[XB_XSUB(b.x)], 1u);
    const unsigned gen = old / nloc;
    if (old + 1u == (gen + 1u) * nloc) {
      __builtin_amdgcn_fence(__ATOMIC_RELEASE, "agent");
      asm volatile("s_waitcnt vmcnt(0)" ::: "memory");
      const unsigned og = xb_add(&bar[XB_TOP], 1u);
      const unsigned tg = og / nx;
      if (og + 1u == (tg + 1u) * nx) xb_add(&bar[XB_TOPGEN], 1u);
      else XB_SPIN(xb_ld(&bar[XB_TOPGEN]) == tg, bar);
      __builtin_amdgcn_fence(__ATOMIC_ACQUIRE, "agent");
      xb_add(&bar[XB_XGEN(b.x)], 1u);
      asm volatile("s_waitcnt vmcnt(0)" ::: "memory");
    } else {
      XB_SPIN(xb_ld(&bar[XB_XGEN(b.x)]) == gen, bar);
      __builtin_amdgcn_fence(__ATOMIC_ACQUIRE, "agent");
      asm volatile("s_waitcnt vmcnt(0)" ::: "memory");
    }
  }
  __syncthreads();
}


__device__ __forceinline__ int opaque_s(int x) { asm volatile("" : "+s"(x)); return x; }

__device__ __forceinline__ float shfl_idx_f(float v, int src) { return __int_as_float(__builtin_amdgcn_ds_bpermute(src << 2, __float_as_int(v))); }
__device__ __forceinline__ float shfl_xor_f(float v, int off, int lane) { return shfl_idx_f(v, lane ^ off); }

__device__ __forceinline__ float wave_incl_scan(float v) {
#define DPP_ADD(ctrl, rmask) v += __int_as_float(__builtin_amdgcn_update_dpp(0, __float_as_int(v), ctrl, rmask, 0xf, false))
  DPP_ADD(0x111, 0xf); DPP_ADD(0x112, 0xf); DPP_ADD(0x114, 0xf); DPP_ADD(0x118, 0xf);
  DPP_ADD(0x142, 0xa); DPP_ADD(0x143, 0xc);
#undef DPP_ADD
  return v;
}

struct TokInfo { int s, l, L, base, mrow; };
__device__ __forceinline__ TokInfo tokinfo(int tok) {
  TokInfo t;
  if (tok < T_CTX) { t.s = tok >> 8; t.l = tok & 255; t.L = 256; t.base = tok & ~255; t.mrow = 0; }
  else { int u = tok - T_CTX; t.s = 32 + (u >> 12); t.l = u & 4095; t.L = 4096; t.base = T_CTX + (u & ~4095); t.mrow = 1 + (u >> 12); }
  return t;
}
__device__ __forceinline__ int seqpos2off(int pos, bool cm) { return cm ? (((pos & 63) << 6) | (pos >> 6)) : pos; }

struct Params {
  const float *x_prompt, *x_sample, *state_ssd, *state_lru, *c, *c_ctx, *mod_w, *mod_b, *ln_g, *ln_b;
  const float *ssd_in_w, *ssd_conv_w, *ssd_conv_b, *ssd_dt_bias, *ssd_a_log, *ssd_d, *ssd_norm_g, *ssd_out_w;
  const float *hy_in_w, *hy_conv_w, *hy_conv_b, *hy_f_w1, *hy_f_b1, *hy_f_w2, *hy_f_b2, *hy_f_w3, *hy_f_freq, *hy_f_bias, *hy_out_w;
  const float *lru_in_w, *lru_conv_w, *lru_conv_b, *lru_gate_w, *lru_gate_b, *lru_a_param, *lru_out_w;
  float *xres, *out_ssd, *out_lru;
  bf16_t *wt_ssd_in, *wt_ssd_out, *wt_hy_in, *wt_hy_out, *wt_lru_in, *wt_lru_out, *wt_lru_gate;
  float *modv;
  float *hdn2;
  bf16_t *rtab0;
  bf16_t *rtab1;
  float *knorm;
  bf16_t *hbuf;
  float *rstd;
  bf16_t *resb;
  float *lru_agg;
  float *lru_hin;
  float *lru_sagg;
  unsigned char *scratch;
  unsigned *bar;
};

#define SC_SSD_Z     ((size_t)0)
#define SC_SSD_XBC   ((size_t)T_ALL * 2048 * 2)
#define SC_SSD_XBCC  (SC_SSD_XBC + (size_t)T_ALL * 4096 * 2)
#define SC_SSD_DT    (SC_SSD_XBCC + (size_t)T_ALL * 2048 * 2)
#define SC_SSD_XT    (SC_SSD_DT + (size_t)T_ALL * 64 * 4)
#define SC_SSD_BT    (SC_SSD_XT + (size_t)T_ALL * 2048 * 2)
#define SC_SSD_BF    (SC_SSD_BT + (size_t)T_ALL * 1024 * 2)
#define SC_SSD_CF    (SC_SSD_BF + (size_t)T_ALL * 1024 * 2)
#define SC_SSD_END   (SC_SSD_CF + (size_t)T_ALL * 1024 * 2)
#define SC_HY_PROJT  ((size_t)0)
#define SC_HY_YT     ((size_t)T_ALL * 4096 * 2)
#define SC_HY_YG     (SC_HY_YT + (size_t)T_ALL * 1024 * 2)
#define SC_LRU_PROJ  ((size_t)0)
#define SC_LRU_XC    ((size_t)T_ALL * 2048 * 2)
#define SC_LRU_GATES (SC_LRU_XC + (size_t)T_ALL * 1024 * 2)
#define SC_LRU_Y     (SC_LRU_GATES + (size_t)T_ALL * 4096 * 2)
#define SC_LRU_YG    (SC_LRU_Y + (size_t)T_ALL * 2048 * 2)
#define SC_TOTAL     SC_SSD_END

__device__ __forceinline__ void transpose_tile(const float* __restrict__ src, int ld_src, int n_src, bf16_t* __restrict__ dst, int K,
                               const float* __restrict__ scale, int tile, int tiles_k, float* tl, int cxw) {
  const int tidx = opaque_tid(cxw);
  int tk = tile % tiles_k, tn = tile / tiles_k;
  int k0 = tk * 64, n0 = tn * 64;
  int tx = tidx & 63, ty = tidx >> 6;
  __syncthreads();
  for (int r = ty; r < 64; r += 4) {
    int n = n0 + tx;
    float v = 0.f;
    if (n < n_src) { v = src[(size_t)(k0 + r) * ld_src + n]; if (scale) v *= scale[k0 + r]; }
    tl[r * 65 + tx] = v;
  }
  __syncthreads();
  for (int r = ty; r < 64; r += 4) dst[(size_t)(n0 + r) * K + k0 + tx] = f2bf(tl[tx * 65 + r]);
}

__device__ __forceinline__ void phase_prep(const Params& p, int bid, int nblk, unsigned char* smem, int cxw) {
  const int tidx = opaque_tid(cxw);
  float* tl = (float*)smem;
  for (int job = 0; job < 24; ++job) {
    const float* src; int ld, nsrc, K, npad; bf16_t* dst; const float* scale = nullptr;
    if (job < 2) { src = p.ssd_in_w + (size_t)job * 1024 * 6208; ld = 6208; nsrc = 6208; K = 1024; npad = 6400; dst = p.wt_ssd_in + (size_t)job * 6400 * 1024; }
    else if (job < 4) { int s = job - 2; src = p.ssd_out_w + (size_t)s * 2048 * 1024; ld = 1024; nsrc = 1024; K = 2048; npad = 1024; dst = p.wt_ssd_out + (size_t)s * 1024 * 2048; scale = p.ssd_norm_g + s * 2048; }
    else if (job == 4) { src = p.hy_in_w; ld = 4096; nsrc = 4096; K = 1024; npad = 4096; dst = p.wt_hy_in; }
    else if (job == 5) { src = p.hy_out_w; ld = 1024; nsrc = 1024; K = 1024; npad = 1024; dst = p.wt_hy_out; }
    else if (job == 6) { src = p.lru_in_w; ld = 2048; nsrc = 2048; K = 1024; npad = 2048; dst = p.wt_lru_in; }
    else if (job == 7) { src = p.lru_out_w; ld = 1024; nsrc = 1024; K = 1024; npad = 1024; dst = p.wt_lru_out; }
    else { int q = job - 8; int dg = q >> 2, n = q & 3;
      src = p.lru_gate_w + (size_t)(dg * 4 + n) * 65536; ld = 256; nsrc = 256; K = 256; npad = 256;
      dst = p.wt_lru_gate + (size_t)n * 1024 * 256 + (size_t)dg * 256 * 256; }
    int tiles_k = K / 64, tiles = tiles_k * (npad / 64);
    for (int t = bid; t < tiles; t += nblk) transpose_tile(src, ld, nsrc, dst, K, scale, t, tiles_k, tl, cxw);
  }
  for (int i = bid * NTHR + tidx; i < 2 * 2 * 1024; i += nblk * NTHR) p.knorm[i] = 0.f;
}

__device__ __forceinline__ void phase_mod(const Params& p, int bid, int nblk, unsigned char* smem, int cxw) {
  const int tidx = opaque_tid(cxw);
  float* sc = (float*)smem;
  float* red = sc + 5 * 1024;
  __syncthreads();
  for (int i = tidx; i < 5 * 1024; i += NTHR) {
    int r = i >> 10, k = i & 1023;
    float v = (r == 0) ? p.c_ctx[k] : p.c[(r - 1) * 1024 + k];
    sc[i] = siluf(v);
  }
  __syncthreads();
  const int cj = tidx & 31, kg = tidx >> 5;
  for (int item = bid; item < 4 * 96; item += nblk) {
    const int layer = item / 96, j = (item % 96) * 32 + cj;
    const float* w = p.mod_w + (size_t)layer * 1024 * 3072 + (size_t)kg * 128 * 3072 + j;
    const float* s0 = sc + kg * 128;
    float a0 = 0, a1 = 0, a2 = 0, a3 = 0, a4 = 0;
#pragma unroll 8
    for (int k = 0; k < 128; ++k) {
      float wv = w[(size_t)k * 3072];
      a0 += s0[k] * wv; a1 += s0[1024 + k] * wv; a2 += s0[2048 + k] * wv; a3 += s0[3072 + k] * wv; a4 += s0[4096 + k] * wv;
    }
    __syncthreads();
    red[(kg * 5 + 0) * 32 + cj] = a0; red[(kg * 5 + 1) * 32 + cj] = a1; red[(kg * 5 + 2) * 32 + cj] = a2;
    red[(kg * 5 + 3) * 32 + cj] = a3; red[(kg * 5 + 4) * 32 + cj] = a4;
    __syncthreads();
    if (tidx < 160) {
      const int rr = tidx >> 5, cc = tidx & 31;
      float sum = 0.f;
#pragma unroll
      for (int g8 = 0; g8 < 8; ++g8) sum += red[(g8 * 5 + rr) * 32 + cc];
      const int jj = (item % 96) * 32 + cc;
      p.modv[((size_t)layer * 5 + rr) * 3072 + jj] = sum + p.mod_b[layer * 3072 + jj];
    }
  }
}

__device__ __forceinline__ void phase_hyfilt_a(const Params& p, int bid, int nblk, unsigned char* smem, int cxw) {
  const int tidx = opaque_tid(cxw);
  float* sz = (float*)smem;
  float* sh = sz + 4 * 36;
  int pl = tidx >> 6, m = tidx & 63;
  for (int item = bid; item < 4352 / 4; item += nblk) {
    int pos = item * 4 + pl;
    int L = pos < 256 ? 256 : 4096;
    int l = pos < 256 ? pos : pos - 256;
    __syncthreads();
    if (m < 33) {
      float t = (float)l / (float)L;
      float w = (6.283185307179586f * (float)l) / (float)L;
      float v;
      if (m == 0) v = t;
      else {
        int j = (m - 1) & 15;
        float fr = 1e-4f + (float)j * ((15.f - 1e-4f) / 15.f);
        float ang = w * fr;
        v = (m <= 16) ? __cosf(ang) : __sinf(ang);
      }
      sz[pl * 36 + m] = v;
    }
    __syncthreads();
    float a = p.hy_f_b1[m];
    for (int e = 0; e < 33; ++e) a += sz[pl * 36 + e] * p.hy_f_w1[e * 64 + m];
    a = __sinf(p.hy_f_freq[m] * a);
    sh[pl * 64 + m] = a;
    __syncthreads();
    float b = p.hy_f_b2[m];
    for (int e = 0; e < 64; ++e) b += sh[pl * 64 + e] * p.hy_f_w2[e * 64 + m];
    b = __sinf(p.hy_f_freq[64 + m] * b);
    p.hdn2[(size_t)pos * 64 + m] = b;
  }
}

__device__ __forceinline__ void phase_hyfilt_b(const Params& p, int bid, int nblk, unsigned char* smem, int cxw) {
  const int tidx = opaque_tid(cxw);
  const int lane = tidx & 63;
  for (int item = bid; item < 17 * 64; item += nblk) {
    const int lb = item >> 6, chunk = item & 63;
    const int Lsel = lb ? 1 : 0, L = Lsel ? 4096 : 256, RL = Lsel ? 8192 : 512, Lm1 = L - 1;
    const int l = Lsel ? (lb - 1) * 256 + tidx : tidx;
    const int pos = Lsel ? 256 + l : l;
    float hd[64];
#pragma unroll
    for (int m4 = 0; m4 < 16; ++m4) {
      f32x4 v = *(const f32x4*)(p.hdn2 + (size_t)pos * 64 + m4 * 4);
      hd[m4 * 4] = v.x; hd[m4 * 4 + 1] = v.y; hd[m4 * 4 + 2] = v.z; hd[m4 * 4 + 3] = v.w;
    }
    const int odc0 = chunk * 64, o = odc0 >> 11, d = (odc0 >> 10) & 1, c0 = odc0 & 1023;
    const float t = (float)l / (float)L;
    bf16_t* rt = Lsel ? p.rtab1 : p.rtab0;
    const float min_decay = -3.0701134573253945f, max_decay = -15.350567286626973f;
    for (int cc = 0; cc < 64; ++cc) {
      const int c = c0 + cc;
      const float* w3 = p.hy_f_w3 + odc0 + cc;
      float acc = 0.f;
#pragma unroll
      for (int m = 0; m < 64; ++m) acc += hd[m] * w3[(size_t)m * 4096];
      float delta = fabsf(min_decay + (float)c * ((max_decay - min_decay) / 1023.f));
      float kv = acc * expf(-t * delta);
      size_t rb = (size_t)(o * 1024 + c) * RL;
      if (d == 0) rt[rb + Lm1 - l] = f2bf(kv);
      else if (l > 0) rt[rb + Lm1 + l] = f2bf(kv);
      else rt[rb + RL - 1] = 0;
      float a = fabsf(kv);
#pragma unroll
      for (int off = 32; off > 0; off >>= 1) a += shfl_xor_f(a, off, lane);
      if (lane == 0) atomicAdd(&p.knorm[(Lsel * 2 + o) * 1024 + c], a);
    }
  }
}

__device__ __forceinline__ void phase_lnmod(const Params& p, int layer, int bid, int nblk, int cxw) {
  const int tidx = opaque_tid(cxw);
  int lane = tidx & 63, wv = cxw & 3;
  f32x4 vn[4];
#define LNMOD_LOAD(ROW) do { const int row_ = (ROW); \
    if (layer == 0) { const float* src_ = row_ < T_CTX ? p.x_prompt + (size_t)row_ * DM : p.x_sample + (size_t)(row_ - T_CTX) * DM; \
      _Pragma("unroll") for (int j = 0; j < 4; ++j) vn[j] = *(const f32x4*)(src_ + j * 256 + lane * 4); } \
    else { const bf16_t* src_ = p.resb + (size_t)row_ * DM; \
      _Pragma("unroll") for (int j = 0; j < 4; ++j) { const u32x2 w_ = *(const u32x2*)(src_ + j * 256 + lane * 4); \
        vn[j].x = bflo(w_.x); vn[j].y = bfhi(w_.x); vn[j].z = bflo(w_.y); vn[j].w = bfhi(w_.y); } } } while (0)
  if (bid * 4 + wv < T_ALL) LNMOD_LOAD(bid * 4 + wv);
  for (int row = bid * 4 + wv; row < T_ALL; row += nblk * 4) {
    f32x4 v[4];
#pragma unroll
    for (int j = 0; j < 4; ++j) v[j] = vn[j];
    if (row + nblk * 4 < T_ALL) LNMOD_LOAD(row + nblk * 4);
    if (layer > 0) {
      float s = 0.f;
#pragma unroll
      for (int j = 0; j < 4; ++j) s += v[j].x + v[j].y + v[j].z + v[j].w;
#pragma unroll
      for (int o = 32; o > 0; o >>= 1) s += shfl_xor_f(s, o, lane);
      float mu = s * (1.f / 1024.f);
      float q = 0.f;
#pragma unroll
      for (int j = 0; j < 4; ++j) { float a = v[j].x - mu, b = v[j].y - mu, c = v[j].z - mu, d = v[j].w - mu; q += a * a + b * b + c * c + d * d; }
#pragma unroll
      for (int o = 32; o > 0; o >>= 1) q += shfl_xor_f(q, o, lane);
      float rs = rsqrtf(q * (1.f / 1024.f) + LN_EPS);
      const float* g = p.ln_g + (layer - 1) * DM; const float* b = p.ln_b + (layer - 1) * DM;
#pragma unroll
      for (int j = 0; j < 4; ++j) {
        f32x4 gg = *(const f32x4*)(g + j * 256 + lane * 4), bb = *(const f32x4*)(b + j * 256 + lane * 4);
        v[j].x = (v[j].x - mu) * rs * gg.x + bb.x; v[j].y = (v[j].y - mu) * rs * gg.y + bb.y;
        v[j].z = (v[j].z - mu) * rs * gg.z + bb.z; v[j].w = (v[j].w - mu) * rs * gg.w + bb.w;
      }
    }
    if (layer == 4) {
      float* dst = p.xres + (size_t)row * DM;
#pragma unroll
      for (int j = 0; j < 4; ++j) *(f32x4*)(dst + j * 256 + lane * 4) = v[j];
    } else {
      bf16_t* dst = p.resb + (size_t)row * DM;
#pragma unroll
      for (int j = 0; j < 4; ++j) { u32x2 o; o.x = pack2(v[j].x, v[j].y); o.y = pack2(v[j].z, v[j].w); *(u32x2*)(dst + j * 256 + lane * 4) = o; }
    }
    if (layer < 4) {
      int mrow = row < T_CTX ? 0 : 1 + ((row - T_CTX) >> 12);
      const float* mv = p.modv + ((size_t)layer * 5 + mrow) * 3072;
#pragma unroll
      for (int j = 0; j < 4; ++j) {
        f32x4 sh = *(const f32x4*)(mv + j * 256 + lane * 4), sc = *(const f32x4*)(mv + 1024 + j * 256 + lane * 4);
        u32x2 o;
        o.x = pack2(v[j].x * (1.f + sc.x) + sh.x, v[j].y * (1.f + sc.y) + sh.y);
        o.y = pack2(v[j].z * (1.f + sc.z) + sh.z, v[j].w * (1.f + sc.w) + sh.w);
        *(u32x2*)(p.hbuf + (size_t)row * DM + j * 256 + lane * 4) = o;
      }
    }
  }
}

#define PG8_LAS __attribute__((address_space(3)))
namespace pg8 {
constexpr int BM = 256, BK = 64, HALF = 128, HTB = HALF * BK * 2, STAGE_BYTES = 8 * HTB, NXCD = 8, WGM = 8;
__device__ __forceinline__ int lds_byte(int r, int c) { const int st = (r >> 4) * 2 + (c >> 5), rr = r & 15, cc = c & 31, ob = rr * 64 + cc * 2; return st * 1024 + (ob ^ (((ob >> 9) & 1) << 5)); }
__device__ __forceinline__ void stage_rc(int b, int& R, int& C) { const int st = b / 1024, sb = b % 1024, swz = sb ^ (((sb >> 9) & 1) << 5); R = (st >> 1) * 16 + swz / 64; C = (st & 1) * 32 + (swz % 64) / 2; }
__device__ __forceinline__ int perm32(int rho) { const int n = rho >> 4, i = rho & 15; return 8 * (i >> 2) + 4 * n + (i & 3); }
struct Unit { int pm, pn; };
struct Gemm { const bf16_t* A; const bf16_t* Bt; int M, N, K, lda; int a_grp_shift; int a_grp_bytes; };
struct StaticOrder {
  int nM, nN, nwg, G, c;
  __device__ void init(int M, int N, int G_, int c_) { nM = M / BM; nN = N / BM; nwg = nM * nN; G = G_; c = c_; }
  __device__ bool next(int i, Unit& u) const {
    const long L = (long)i * G + c; if (L >= nwg) return false;
    int wgid = (int)L; { const int q = nwg / NXCD, r = nwg % NXCD, xcd = wgid % NXCD, off = wgid / NXCD; wgid = (xcd < r ? xcd * (q + 1) : r * (q + 1) + (xcd - r) * q) + off; }
    const int nig = WGM * nN, gid = wgid / nig, fm = gid * WGM, gsz = (nM - fm) < WGM ? (nM - fm) : WGM;
    u.pm = fm + ((wgid % nig) % gsz); u.pn = (wgid % nig) / gsz; return true;
  }
};
__device__ __forceinline__ unsigned cvt_pk_bf16(float lo, float hi) { return pack2(lo, hi); }

template <class Epi>
__device__ __forceinline__ void gemm_phase(PG8_LAS unsigned char* lds, const Gemm g, const StaticOrder& S, const Epi& E, int wave) {
  const int tid = opaque_tid512(wave), wid = wave, lane = tid & 63, wr = wid >> 2, wc = wid & 3, fr = lane & 15, fq = lane >> 4;
  const int K = g.K, nt = K / BK, lda = g.lda;
  unsigned voffA[2], voffB[2];
#pragma unroll
  for (int i = 0; i < 2; ++i) { int R, C; stage_rc(tid * 16 + i * 8192, R, C); const int Rb = Epi::PERM ? ((R & ~31) + perm32(R & 31)) : R;
    voffA[i] = (unsigned)(R * lda + C) * 2u; voffB[i] = (unsigned)(Rb * K + C) * 2u; }
  const size_t kstep = (size_t)(BK * 2);
  const size_t hstepA = (size_t)HALF * lda * 2, hstepB = (size_t)HALF * K * 2;
  const size_t tstepA = 2 * hstepA, tstepB = 2 * hstepB;
  const unsigned ldsw = (unsigned)wid * 1024u;
  const int aoff = lds_byte(wr * 64 + fr, fq * 8), boff = lds_byte(wc * 32 + fr, fq * 8);
#define PG8_SA(b, h) (((b) * 2 + (h)) * HTB)
#define PG8_SB(b, h) ((4 + (b) * 2 + (h)) * HTB)
#define PG8_STAGE(bufoff, gbase, voff) do { _Pragma("unroll") for (int _i = 0; _i < 2; ++_i) \
    __builtin_amdgcn_global_load_lds((const unsigned*)((const char*)(gbase) + (voff)[_i]), (PG8_LAS unsigned*)(lds + (bufoff) + ldsw + _i * 8192), 16, 0, 0); } while (0)
#define PG8_LDA(dst, b, h) do { _Pragma("unroll") for (int m = 0; m < 4; ++m) _Pragma("unroll") for (int k = 0; k < 2; ++k) dst[m][k] = *(const PG8_LAS bf16x8*)(lds + PG8_SA(b, h) + aoff + m * 2048 + k * 1024); } while (0)
#define PG8_LDB(dst, b, h) do { _Pragma("unroll") for (int n = 0; n < 2; ++n) _Pragma("unroll") for (int k = 0; k < 2; ++k) dst[n][k] = *(const PG8_LAS bf16x8*)(lds + PG8_SB(b, h) + boff + n * 2048 + k * 1024); } while (0)
#define PG8_MMA(ai, bj, At, Bt) do { __builtin_amdgcn_s_setprio(1); _Pragma("unroll") for (int m = 0; m < 4; ++m) _Pragma("unroll") for (int n = 0; n < 2; ++n) _Pragma("unroll") for (int k = 0; k < 2; ++k) \
    acc[ai][bj][m][n] = __builtin_amdgcn_mfma_f32_16x16x32_bf16(Bt[n][k], At[m][k], acc[ai][bj][m][n], 0, 0, 0); __builtin_amdgcn_s_setprio(0); } while (0)
#define PG8_WAIT_V(n) asm volatile("s_waitcnt vmcnt(" #n ")" ::: "memory")
#define PG8_WAIT_L(n) asm volatile("s_waitcnt lgkmcnt(" #n ")" ::: "memory")
#define PG8_BAR __builtin_amdgcn_s_barrier()
#define PG8_SCHED __builtin_amdgcn_sched_barrier(0)
#define PG8_APTR(u) ((const char*)g.A + (size_t)(u).pm * tstepA + (size_t)(((u).pn >> g.a_grp_shift) * g.a_grp_bytes))
  Unit cur, nxt; int ui = 0;
  if (!S.next(0, cur)) return;
  f32x4 acc[2][2][4][2];
#pragma unroll
  for (int a = 0; a < 2; ++a)
#pragma unroll
    for (int b = 0; b < 2; ++b)
#pragma unroll
      for (int m = 0; m < 4; ++m)
#pragma unroll
        for (int n = 0; n < 2; ++n) acc[a][b][m][n] = (f32x4){0.f, 0.f, 0.f, 0.f};
  bf16x8 At[4][2], B0[2][2], B1[2][2];
  const char* cA = PG8_APTR(cur); const char* cB = (const char*)g.Bt + (size_t)cur.pn * tstepB;
  PG8_STAGE(PG8_SB(0, 0), cB, voffB); PG8_STAGE(PG8_SA(0, 0), cA, voffA); PG8_STAGE(PG8_SB(0, 1), cB + hstepB, voffB); PG8_STAGE(PG8_SA(0, 1), cA + hstepA, voffA);
  if (wr == 1) PG8_BAR;
  PG8_WAIT_V(4); PG8_BAR;
  PG8_STAGE(PG8_SB(1, 0), cB + kstep, voffB); PG8_STAGE(PG8_SA(1, 0), cA + kstep, voffA); PG8_STAGE(PG8_SB(1, 1), cB + hstepB + kstep, voffB);
  PG8_WAIT_V(6); PG8_BAR;
  for (;;) {
    const bool has_next = S.next(ui + 1, nxt);
    const char* nA = has_next ? PG8_APTR(nxt) : cA; const char* nB = has_next ? (const char*)g.Bt + (size_t)nxt.pn * tstepB : cB;
    for (int t = 0; t < nt; t += 2) {
      const bool last = (t == nt - 2);
      const char* a1 = cA + (size_t)(t + 1) * kstep;
      const char* a2 = last ? nA : cA + (size_t)(t + 2) * kstep; const char* b2 = last ? nB : cB + (size_t)(t + 2) * kstep;
      const char* a3 = a2 + kstep; const char* b3 = b2 + kstep;
      PG8_LDB(B0, 0, 0); PG8_SCHED; PG8_LDA(At, 0, 0); PG8_STAGE(PG8_SA(1, 1), a1 + hstepA, voffA);
      PG8_WAIT_L(8); PG8_BAR; PG8_WAIT_L(0); PG8_MMA(0, 0, At, B0); PG8_BAR; PG8_SCHED;
      PG8_LDB(B1, 0, 1); PG8_STAGE(PG8_SB(0, 0), b2, voffB);
      PG8_BAR; PG8_WAIT_L(0); PG8_MMA(0, 1, At, B1); PG8_BAR;
      PG8_LDA(At, 0, 1); PG8_STAGE(PG8_SA(0, 0), a2, voffA);
      PG8_BAR; PG8_WAIT_L(0); PG8_MMA(1, 0, At, B0); PG8_BAR; PG8_SCHED;
      PG8_STAGE(PG8_SB(0, 1), b2 + hstepB, voffB);
      PG8_WAIT_V(6); PG8_BAR; PG8_MMA(1, 1, At, B1); PG8_BAR;
      PG8_LDB(B0, 1, 0); PG8_SCHED; PG8_LDA(At, 1, 0); PG8_STAGE(PG8_SA(0, 1), a2 + hstepA, voffA);
      PG8_WAIT_L(8); PG8_BAR; PG8_WAIT_L(0); PG8_MMA(0, 0, At, B0); PG8_BAR; PG8_SCHED;
      PG8_LDB(B1, 1, 1); PG8_STAGE(PG8_SB(1, 0), b3, voffB);
      PG8_BAR; PG8_WAIT_L(0); PG8_MMA(0, 1, At, B1); PG8_BAR;
      PG8_LDA(At, 1, 1); PG8_STAGE(PG8_SA(1, 0), a3, voffA);
      PG8_BAR; PG8_WAIT_L(0); PG8_MMA(1, 0, At, B0); PG8_BAR; PG8_SCHED;
      PG8_STAGE(PG8_SB(1, 1), b3 + hstepB, voffB);
      PG8_WAIT_V(6); PG8_BAR; PG8_MMA(1, 1, At, B1); PG8_BAR;
    }
    { const int lane2 = opaque_lane();
      E(acc, cur, wr, wc, lane2 & 15, lane2 >> 4); }
    if (!has_next) break;
#pragma unroll
    for (int a = 0; a < 2; ++a)
#pragma unroll
      for (int b = 0; b < 2; ++b)
#pragma unroll
        for (int m = 0; m < 4; ++m)
#pragma unroll
          for (int n = 0; n < 2; ++n) acc[a][b][m][n] = (f32x4){0.f, 0.f, 0.f, 0.f};
    cur = nxt; cA = nA; cB = nB; ++ui;
  }
  PG8_WAIT_V(0);
  if (wr == 0) PG8_BAR;
  PG8_BAR;
#undef PG8_SA
#undef PG8_SB
#undef PG8_STAGE
#undef PG8_LDA
#undef PG8_LDB
#undef PG8_MMA
#undef PG8_WAIT_V
#undef PG8_WAIT_L
#undef PG8_BAR
#undef PG8_SCHED
#undef PG8_APTR
}

struct EpiBf16 {
  static constexpr bool PERM = true;
  bf16_t* O; size_t ldc;
  __device__ __forceinline__ void operator()(const f32x4 (&acc)[2][2][4][2], const Unit& u, int wr, int wc, int fr, int fq) const {
    const int row0 = u.pm * BM + wr * 64 + fr, col0 = u.pn * BM + wc * 32 + 8 * fq;
#pragma unroll
    for (int ai = 0; ai < 2; ++ai)
#pragma unroll
      for (int m = 0; m < 4; ++m) {
        bf16_t* rowp = O + (size_t)(row0 + ai * HALF + m * 16) * ldc + col0;
#pragma unroll
        for (int bj = 0; bj < 2; ++bj) {
          const f32x4 v0 = acc[ai][bj][m][0], v1 = acc[ai][bj][m][1];
          u32x4 w; w.x = pack2(v0[0], v0[1]); w.y = pack2(v0[2], v0[3]); w.z = pack2(v1[0], v1[1]); w.w = pack2(v1[2], v1[3]);
          *(u32x4*)(rowp + bj * HALF) = w;
        }
      }
  }
};
struct EpiSsdIn {
  static constexpr bool PERM = true;
  bf16_t* z; bf16_t* xbc; float* dt; const float* dt_bias;
  __device__ __forceinline__ void operator()(const f32x4 (&acc)[2][2][4][2], const Unit& u, int wr, int wc, int fr, int fq) const {
    const int row0 = u.pm * BM + wr * 64 + fr, colt = u.pn * BM + wc * 32 + 8 * fq;
    if (u.pn < 24) {
      bf16_t* base = u.pn < 8 ? z : xbc; const size_t ldc = u.pn < 8 ? 2048 : 4096; const int col0 = u.pn < 8 ? colt : colt - 2048;
#pragma unroll
      for (int ai = 0; ai < 2; ++ai)
#pragma unroll
        for (int m = 0; m < 4; ++m) {
          bf16_t* rowp = base + (size_t)(row0 + ai * HALF + m * 16) * ldc + col0;
#pragma unroll
          for (int bj = 0; bj < 2; ++bj) {
            const f32x4 v0 = acc[ai][bj][m][0], v1 = acc[ai][bj][m][1];
            u32x4 w; w.x = pack2(v0[0], v0[1]); w.y = pack2(v0[2], v0[3]); w.z = pack2(v1[0], v1[1]); w.w = pack2(v1[2], v1[3]);
            *(u32x4*)(rowp + bj * HALF) = w;
          }
        }
    } else {
      const int c0 = wc * 32 + 8 * fq;
      if (c0 < 64) {
#pragma unroll
        for (int ai = 0; ai < 2; ++ai)
#pragma unroll
          for (int m = 0; m < 4; ++m) {
            float* rowp = dt + (size_t)(row0 + ai * HALF + m * 16) * 64 + c0;
#pragma unroll
            for (int n = 0; n < 2; ++n) {
              const f32x4 v = acc[ai][0][m][n];
              f32x4 o;
#pragma unroll
              for (int e = 0; e < 4; ++e) o[e] = softplusf(v[e] + dt_bias[c0 + 4 * n + e]);
              *(f32x4*)(rowp + 4 * n) = o;
            }
          }
      }
    }
  }
};
struct EpiOut {
  static constexpr bool PERM = true;
  bf16_t* res; const float* modv_layer; const float* rstd;
  __device__ __forceinline__ void operator()(const f32x4 (&acc)[2][2][4][2], const Unit& u, int wr, int wc, int fr, int fq) const {
    const int row0 = u.pm * BM + wr * 64 + fr, col0 = u.pn * BM + wc * 32 + 8 * fq;
#pragma unroll
    for (int ai = 0; ai < 2; ++ai)
#pragma unroll
      for (int m = 0; m < 4; ++m) {
        const int row = row0 + ai * HALF + m * 16;
        const int mrow = row < T_CTX ? 0 : 1 + ((row - T_CTX) >> 12);
        const float rs = rstd ? rstd[row] : 1.f;
        const float* gp = modv_layer + (size_t)mrow * 3072 + 2048 + col0;
        bf16_t* rowp = res + (size_t)row * DM + col0;
#pragma unroll
        for (int bj = 0; bj < 2; ++bj) {
          const f32x4 g0 = *(const f32x4*)(gp + bj * HALF), g1 = *(const f32x4*)(gp + bj * HALF + 4);
          const u32x4 xw = *(const u32x4*)(rowp + bj * HALF);
          const f32x4 v0 = acc[ai][bj][m][0], v1 = acc[ai][bj][m][1];
          u32x4 o;
          o.x = pack2(ALPHA_RES * bflo(xw.x) + g0.x * (v0[0] * rs), ALPHA_RES * bfhi(xw.x) + g0.y * (v0[1] * rs));
          o.y = pack2(ALPHA_RES * bflo(xw.y) + g0.z * (v0[2] * rs), ALPHA_RES * bfhi(xw.y) + g0.w * (v0[3] * rs));
          o.z = pack2(ALPHA_RES * bflo(xw.z) + g1.x * (v1[0] * rs), ALPHA_RES * bfhi(xw.z) + g1.y * (v1[1] * rs));
          o.w = pack2(ALPHA_RES * bflo(xw.w) + g1.z * (v1[2] * rs), ALPHA_RES * bfhi(xw.w) + g1.w * (v1[3] * rs));
          *(u32x4*)(rowp + bj * HALF) = o;
        }
      }
  }
};
struct EpiLruGate {
  static constexpr bool PERM = true;
  bf16_t* gates; const float* gate_b;
  __device__ __forceinline__ void operator()(const f32x4 (&acc)[2][2][4][2], const Unit& u, int wr, int wc, int fr, int fq) const {
    const int nb = u.pn >> 2, dg = u.pn & 3;
    const int row0 = u.pm * BM + wr * 64 + fr, ch0 = nb * 256 + wc * 32 + 8 * fq;
#pragma unroll
    for (int ai = 0; ai < 2; ++ai)
#pragma unroll
      for (int m = 0; m < 4; ++m) {
        bf16_t* rowp = gates + ((size_t)dg * T_ALL + row0 + ai * HALF + m * 16) * 1024 + ch0;
#pragma unroll
        for (int bj = 0; bj < 2; ++bj) {
          const float* bp = gate_b + dg * 1024 + ch0 + bj * HALF;
          const f32x4 b0 = *(const f32x4*)bp, b1 = *(const f32x4*)(bp + 4);
          const f32x4 v0 = acc[ai][bj][m][0] + b0, v1 = acc[ai][bj][m][1] + b1;
          u32x4 w; w.x = pack2(sigmoidf(v0[0]), sigmoidf(v0[1])); w.y = pack2(sigmoidf(v0[2]), sigmoidf(v0[3]));
          w.z = pack2(sigmoidf(v1[0]), sigmoidf(v1[1])); w.w = pack2(sigmoidf(v1[2]), sigmoidf(v1[3]));
          *(u32x4*)(rowp + bj * HALF) = w;
        }
      }
  }
};
}

template <int KW, bool SILU>
__device__ __forceinline__ void phase_dwconv(const bf16_t* __restrict__ src, int ld_src, bf16_t* __restrict__ dst, int ld_dst, int CH,
                             const float* __restrict__ w, const float* __restrict__ b, bool colmajor, int bid, int nblk, int cxw) {
  const int tidx = opaque_tid(cxw);
  const int cpr = CH / 8;
  const size_t total = (size_t)T_ALL * cpr;
  for (size_t idx = (size_t)bid * NTHR + tidx; idx < total; idx += (size_t)nblk * NTHR) {
    int tok = (int)(idx / cpr), c0 = (int)(idx % cpr) * 8;
    TokInfo ti = tokinfo(tok);
    bool cm = colmajor && ti.s >= 32;
    int pos = seqpos2off(ti.l, cm);
    float acc[8];
#pragma unroll
    for (int e = 0; e < 8; ++e) acc[e] = b[c0 + e];
#pragma unroll
    for (int k = 0; k < KW; ++k) {
      int pp = pos + k - 1;
      if (pp < 0 || pp >= ti.L) continue;
      int tk = ti.base + seqpos2off(pp, cm);
      u32x4 xv = *(const u32x4*)(src + (size_t)tk * ld_src + c0);
      const float* wk = w + (size_t)k * CH + c0;
      acc[0] += wk[0] * bflo(xv.x); acc[1] += wk[1] * bfhi(xv.x);
      acc[2] += wk[2] * bflo(xv.y); acc[3] += wk[3] * bfhi(xv.y);
      acc[4] += wk[4] * bflo(xv.z); acc[5] += wk[5] * bfhi(xv.z);
      acc[6] += wk[6] * bflo(xv.w); acc[7] += wk[7] * bfhi(xv.w);
    }
    if (SILU) {
#pragma unroll
      for (int e = 0; e < 8; ++e) acc[e] = siluf(acc[e]);
    }
    u32x4 o;
    o.x = pack2(acc[0], acc[1]); o.y = pack2(acc[2], acc[3]); o.z = pack2(acc[4], acc[5]); o.w = pack2(acc[6], acc[7]);
    *(u32x4*)(dst + (size_t)tok * ld_dst + c0) = o;
  }
}

__device__ __forceinline__ void phase_ssd_conv(const Params& p, int slot, bool colmajor, int bid, int nblk, unsigned char* smem, int cxw) {
  const int tid = opaque_tid(cxw);
  const bf16_t* raw = (const bf16_t*)(p.scratch + SC_SSD_XBC);
  bf16_t* out = (bf16_t*)(p.scratch + SC_SSD_XBCC);
  bf16_t* XT = (bf16_t*)(p.scratch + SC_SSD_XT);
  bf16_t* BT = (bf16_t*)(p.scratch + SC_SSD_BT);
  bf16_t* BF = (bf16_t*)(p.scratch + SC_SSD_BF);
  bf16_t* CF = (bf16_t*)(p.scratch + SC_SSD_CF);
  const float* cw = p.ssd_conv_w + (size_t)slot * 4 * 4096;
  const float* cb = p.ssd_conv_b + slot * 4096;
  bf16_t* tl = (bf16_t*)smem;
  bf16_t* rt = tl + 64 * 72;
  const int rr = tid >> 2, cpart = tid & 3;
  const int NITEMS = 384 * 64;
  u32x4 pre[3];
#define CONV_PREFETCH(ITEM) do { const int it_ = (ITEM); const int ptile_ = it_ >> 6, ct_ = it_ & 63; \
    const TokInfo ti_ = tokinfo(ptile_ * 64); const bool cm_ = colmajor && ti_.s >= 32; \
    _Pragma("unroll") for (int i_ = 0; i_ < 3; ++i_) { const int q_ = tid + i_ * 256; const int row_ = q_ >> 3, c8_ = (q_ & 7) * 8; \
      const int pp_ = ti_.l - 1 + row_; u32x4 v_ = {0u, 0u, 0u, 0u}; \
      if (row_ < 67 && pp_ >= 0 && pp_ < ti_.L) v_ = *(const u32x4*)(raw + (size_t)(ti_.base + seqpos2off(pp_, cm_)) * 4096 + ct_ * 64 + c8_); \
      pre[i_] = v_; } } while (0)
  if (bid < NITEMS) CONV_PREFETCH(bid);
  for (int item = bid; item < NITEMS; item += nblk) {
    const int ptile = item >> 6, ct = item & 63;
    const int ptok0 = ptile * 64;
    const int ch = ct * 64 + cpart * 16;
    __syncthreads();
#pragma unroll
    for (int i = 0; i < 3; ++i) { const int q = tid + i * 256; if (q < 67 * 8) *(u32x4*)(rt + (q >> 3) * 72 + (q & 7) * 8) = pre[i]; }
    if (item + nblk < NITEMS) CONV_PREFETCH(item + nblk);
    __syncthreads();
    float acc[16];
#pragma unroll
    for (int e = 0; e < 16; ++e) acc[e] = cb[ch + e];
#pragma unroll
    for (int k = 0; k < 4; ++k) {
      const bf16_t* rp = rt + (rr + k) * 72 + cpart * 16;
      u32x4 x0 = *(const u32x4*)rp, x1 = *(const u32x4*)(rp + 8);
      const float* wk = cw + (size_t)k * 4096 + ch;
      unsigned xw[8] = {x0.x, x0.y, x0.z, x0.w, x1.x, x1.y, x1.z, x1.w};
#pragma unroll
      for (int e = 0; e < 8; ++e) { acc[2 * e] += wk[2 * e] * bflo(xw[e]); acc[2 * e + 1] += wk[2 * e + 1] * bfhi(xw[e]); }
    }
    u32x4 o0, o1;
    o0.x = pack2(siluf(acc[0]), siluf(acc[1])); o0.y = pack2(siluf(acc[2]), siluf(acc[3]));
    o0.z = pack2(siluf(acc[4]), siluf(acc[5])); o0.w = pack2(siluf(acc[6]), siluf(acc[7]));
    o1.x = pack2(siluf(acc[8]), siluf(acc[9])); o1.y = pack2(siluf(acc[10]), siluf(acc[11]));
    o1.z = pack2(siluf(acc[12]), siluf(acc[13])); o1.w = pack2(siluf(acc[14]), siluf(acc[15]));
    *(u32x4*)(tl + rr * 72 + cpart * 16) = o0;
    *(u32x4*)(tl + rr * 72 + cpart * 16 + 8) = o1;
    __syncthreads();
    if (ct < 32) {
      bf16_t* op = out + (size_t)(ptok0 + rr) * 2048 + ch;
      *(u32x4*)op = o0; *(u32x4*)(op + 8) = o1;
      const int crow = tid >> 2, part = tid & 3;
      unsigned wv[8];
#pragma unroll
      for (int e = 0; e < 8; ++e) {
        unsigned lo = tl[(part * 16 + 2 * e) * 72 + crow], hi = tl[(part * 16 + 2 * e + 1) * 72 + crow];
        wv[e] = lo | (hi << 16);
      }
      bf16_t* dp = XT + (size_t)(ct * 64 + crow) * T_ALL + ptok0 + part * 16;
      u32x4 t0, t1;
      t0.x = wv[0]; t0.y = wv[1]; t0.z = wv[2]; t0.w = wv[3]; t1.x = wv[4]; t1.y = wv[5]; t1.z = wv[6]; t1.w = wv[7];
      *(u32x4*)dp = t0; *(u32x4*)(dp + 8) = t1;
    } else {
      const bool isB = ct < 48;
      const int cq = (ct - (isB ? 32 : 48));
      const int g = cq >> 1, chhalf = cq & 1;
      const int lane = tid & 63, r = lane & 31, hh = lane >> 5;
      bf16_t* F = isB ? BF : CF;
#pragma unroll
      for (int i = 0; i < 2; ++i) {
        const int f = (cxw & 3) + 4 * i;
        const int rt2 = f >> 2, kk4 = f & 3;
        const u32x4 v = *(const u32x4*)(tl + (32 * rt2 + r) * 72 + 16 * kk4 + 8 * hh);
        const size_t rt = (size_t)(ptok0 >> 5) + rt2;
        *(u32x4*)(F + (((rt * 8 + g) * 8 + chhalf * 4 + kk4) * 64 + lane) * 8) = v;
      }
      if (isB) {
#pragma unroll
        for (int i = 0; i < 2; ++i) {
          const int f = (cxw & 3) + 4 * i;
          const int nt2 = f >> 2, ts4 = f & 3;
          unsigned wv[4];
#pragma unroll
          for (int e = 0; e < 4; ++e) {
            unsigned lo = tl[(16 * ts4 + 8 * hh + 2 * e) * 72 + 32 * nt2 + r], hi = tl[(16 * ts4 + 8 * hh + 2 * e + 1) * 72 + 32 * nt2 + r];
            wv[e] = lo | (hi << 16);
          }
          u32x4 v; v.x = wv[0]; v.y = wv[1]; v.z = wv[2]; v.w = wv[3];
          const size_t ts = (size_t)(ptok0 >> 4) + ts4;
          *(u32x4*)(BT + (((ts * 8 + g) * 4 + chhalf * 2 + nt2) * 64 + lane) * 8) = v;
        }
      }
    }
  }
}

#define SH_STRIDE 136
__device__ __forceinline__ int rowmap(int e, int hh) { return (e & 3) + 8 * (e >> 2) + 4 * hh; }
__device__ __forceinline__ bf16x8 pack8(float a0, float a1, float a2, float a3, float a4, float a5, float a6, float a7) {
  u32x4 v; v.x = pack2(a0, a1); v.y = pack2(a2, a3); v.z = pack2(a4, a5); v.w = pack2(a6, a7);
  return __builtin_bit_cast(bf16x8, v);
}
#define SCAN_PRIV 49152
#define SCAN_SF 49152
__device__ __forceinline__ void phase_ssd_scan(const Params& p, int slot, bool colmajor, int bid, int nblk, unsigned char* wg_smem, int cxw) {
  const int tid = opaque_tid(cxw), lane = tid & 63, w = cxw & 3, vb = cxw >> 2, r = lane & 31, hh = lane >> 5;
  const int it = w >> 1, pt = w & 1;
  const bf16_t* XT = (const bf16_t*)(p.scratch + SC_SSD_XT);
  const bf16_t* BT = (const bf16_t*)(p.scratch + SC_SSD_BT);
  const bf16_t* BF = (const bf16_t*)(p.scratch + SC_SSD_BF);
  const bf16_t* CF = (const bf16_t*)(p.scratch + SC_SSD_CF);
  const float* dtb = (const float*)(p.scratch + SC_SSD_DT);
  bf16_t* ybuf = (bf16_t*)(p.scratch + SC_SSD_XBC);
  unsigned char* priv = wg_smem + (vb ? SCAN_SF + SCAN_PRIV : 0);
  bf16_t* sXr = (bf16_t*)priv;
  bf16_t* sXs = sXr + 64 * 72;
  bf16_t* sH = sXs + 64 * 72;
  float* sW = (float*)(sH + 64 * SH_STRIDE);
  bf16_t* sY = (bf16_t*)(sW + 4 * 256);
  float* myW = sW + w * 256;
  const bf16_t* sfC = (const bf16_t*)(wg_smem + SCAN_PRIV);
  const bf16_t* sfB = sfC + 8192;
  const bf16_t* sfT = sfC + 16384;
  for (int item = bid; item < 36 * 64; item += nblk) {
    int s, h, dir;
    {
      const int itx = item < 256 ? item : item - 256;
      const int idx = itx & 63, pairidx = idx >> 1;
      s = item < 256 ? 32 + (itx >> 6) : (itx >> 6);
      dir = pairidx & 1; h = (pairidx >> 1) * 2 + (idx & 1);
    }
    const int L = s < 32 ? 256 : 4096;
    const int base = s < 32 ? s * 256 : T_CTX + (s - 32) * 4096;
    const bool cm = colmajor && s >= 32;
    const int g = h >> 2;
    const float Aval = -expf(p.ssd_a_log[(slot * 2 + dir) * 32 + h]);
    const int nchunks = L >> 6;
    const int pcol = 32 * pt + r;
    f32x16 hacc[2];
    if (s >= 32) {
      const float* h0 = p.state_ssd + ((((size_t)(s - 32) * 2 + slot) * 2 + dir) * 32 + h) * 8192 + (size_t)pcol * 128;
#pragma unroll
      for (int t2 = 0; t2 < 2; ++t2)
#pragma unroll
        for (int qd = 0; qd < 4; ++qd) {
          f32x4 v = *(const f32x4*)(h0 + 32 * (2 * it + t2) + 8 * qd + 4 * hh);
          hacc[t2][4 * qd] = v.x; hacc[t2][4 * qd + 1] = v.y; hacc[t2][4 * qd + 2] = v.z; hacc[t2][4 * qd + 3] = v.w;
        }
    } else {
#pragma unroll
      for (int t2 = 0; t2 < 2; ++t2)
#pragma unroll
        for (int e = 0; e < 16; ++e) hacc[t2][e] = 0.f;
    }
#define SCAN_PTOK(c) (base + 64 * (dir ? nchunks - 1 - (c) : (c)))
#define SCAN_LOAD_DTX(pt0) do { \
      const int tok_ = base + seqpos2off((pt0) - base + lane, cm); \
      dtv = dtb[(size_t)tok_ * 64 + dir * 32 + h]; \
      _Pragma("unroll") for (int i_ = 0; i_ < 2; ++i_) { const int q_ = tid + i_ * 256; \
        xtr[i_] = *(const u32x4*)(XT + (size_t)(h * 64 + (q_ >> 3)) * T_ALL + (pt0) + (q_ & 7) * 8); } } while (0)
#define SCAN_DMA(pt0) do { \
      _Pragma("unroll") for (int i_ = 0; i_ < 6; ++i_) { const int q_ = cxw + 8 * (i_ & 1); \
        const bf16_t* src_; \
        if (i_ < 4) src_ = (i_ < 2 ? CF : BF) + ((((size_t)((pt0) >> 5) + (q_ >> 3)) * 8 + g) * 8 + (q_ & 7)) * 512 + lane * 8; \
        else src_ = BT + ((((size_t)((pt0) >> 4) + (q_ >> 2)) * 8 + g) * 4 + (q_ & 3)) * 512 + lane * 8; \
        __builtin_amdgcn_global_load_lds((const unsigned*)src_, (PG8_LAS unsigned*)(wg_smem + SCAN_PRIV + (i_ >> 1) * 16384 + q_ * 1024), 16, 0, 0); } } while (0)
#define SCAN_WRITE_STATE() do { \
      _Pragma("unroll") for (int t2 = 0; t2 < 2; ++t2) _Pragma("unroll") for (int qd = 0; qd < 4; ++qd) { \
        u32x2 o_; o_.x = pack2(hacc[t2][4 * qd], hacc[t2][4 * qd + 1]); o_.y = pack2(hacc[t2][4 * qd + 2], hacc[t2][4 * qd + 3]); \
        *(u32x2*)(sH + pcol * SH_STRIDE + 32 * (2 * it + t2) + 8 * qd + 4 * hh) = o_; } } while (0)
    const bool need0 = dir == 0 ? true : (it == 0);
    const bool need1 = dir == 0 ? (it == 1) : true;
    float dtv; u32x4 xtr[2];
    __syncthreads();
    {
      const int p0 = SCAN_PTOK(0);
      SCAN_DMA(p0);
      SCAN_LOAD_DTX(p0);
      SCAN_WRITE_STATE();
    }
    for (int ci = 0; ci < nchunks; ++ci) {
      const int cin = ci + 1 < nchunks ? ci + 1 : ci;
      const int ptokN = SCAN_PTOK(cin);
      __syncthreads();
      if (ci > 0) {
        const int ptokP = SCAN_PTOK(ci - 1);
#pragma unroll
        for (int i = 0; i < 2; ++i) {
          const int q = tid + i * 256, yrow = q >> 3, c8 = (q & 7) * 8;
          *(u32x4*)(ybuf + ((size_t)dir * T_ALL + ptokP + yrow) * 2048 + h * 64 + c8) = *(const u32x4*)(sY + yrow * 72 + c8);
        }
      }
      float decE;
      {
        const float a_ = dtv * Aval;
        const float pre = wave_incl_scan(a_);
        const float cE = __int_as_float(__builtin_amdgcn_readlane(__float_as_int(pre), 63));
        const float c = dir == 0 ? pre : cE - pre + a_;
        myW[lane] = dtv; myW[64 + lane] = c; myW[128 + lane] = __expf(c); myW[192 + lane] = dtv * __expf(cE - c);
        decE = __expf(cE);
      }
#pragma unroll
      for (int i = 0; i < 2; ++i) {
        const int q = tid + i * 256, prow = q >> 3, j8 = (q & 7) * 8;
        const u32x4 raw = xtr[i];
        *(u32x4*)(sXr + prow * 72 + j8) = raw;
        f32x4 f0 = *(const f32x4*)(myW + 192 + j8), f1 = *(const f32x4*)(myW + 192 + j8 + 4);
        u32x4 sc;
        sc.x = pack2(bflo(raw.x) * f0.x, bfhi(raw.x) * f0.y); sc.y = pack2(bflo(raw.y) * f0.z, bfhi(raw.y) * f0.w);
        sc.z = pack2(bflo(raw.z) * f1.x, bfhi(raw.z) * f1.y); sc.w = pack2(bflo(raw.w) * f1.z, bfhi(raw.w) * f1.w);
        *(u32x4*)(sXs + prow * 72 + j8) = sc;
      }
      asm volatile("s_waitcnt vmcnt(0)" ::: "memory");
      __syncthreads();
      SCAN_LOAD_DTX(ptokN);
#pragma unroll
      for (int t2 = 0; t2 < 2; ++t2) {
#pragma unroll
        for (int e = 0; e < 16; ++e) hacc[t2][e] *= decE;
        const bf16_t* xs = sXs + pcol * 72 + 8 * hh;
#pragma unroll
        for (int kk = 0; kk < 4; ++kk)
          hacc[t2] = __builtin_amdgcn_mfma_f32_32x32x16_bf16(*(const bf16x8*)(sfT + (kk * 4 + 2 * it + t2) * 512 + lane * 8), *(const bf16x8*)(xs + 16 * kk), hacc[t2], 0, 0, 0);
      }
      bf16x8 cfr[8];
#pragma unroll
      for (int kk = 0; kk < 8; ++kk) cfr[kk] = *(const bf16x8*)(sfC + (it * 8 + kk) * 512 + lane * 8);
      f32x16 acc;
#pragma unroll
      for (int e = 0; e < 16; ++e) acc[e] = 0.f;
      {
        const bf16_t* hp = sH + pcol * SH_STRIDE + 8 * hh;
#pragma unroll
        for (int kk = 0; kk < 8; ++kk) acc = __builtin_amdgcn_mfma_f32_32x32x16_bf16(cfr[kk], *(const bf16x8*)(hp + 16 * kk), acc, 0, 0, 0);
      }
#pragma unroll
      for (int qd = 0; qd < 4; ++qd) {
        f32x4 ec = *(const f32x4*)(myW + 128 + 32 * it + 8 * qd + 4 * hh);
        acc[4 * qd] *= ec.x; acc[4 * qd + 1] *= ec.y; acc[4 * qd + 2] *= ec.z; acc[4 * qd + 3] *= ec.w;
      }
      const int icol = 32 * it + r;
      const float ci_ = myW[64 + icol];
#pragma unroll
      for (int jt = 0; jt < 2; ++jt) {
        const bool needed = jt == 0 ? need0 : need1;
        if (needed) {
          f32x16 X;
#pragma unroll
          for (int e = 0; e < 16; ++e) X[e] = 0.f;
#pragma unroll
          for (int kk = 0; kk < 8; ++kk) X = __builtin_amdgcn_mfma_f32_32x32x16_bf16(*(const bf16x8*)(sfB + (jt * 8 + kk) * 512 + lane * 8), cfr[kk], X, 0, 0, 0);
#pragma unroll
          for (int qd = 0; qd < 4; ++qd) {
            const int j0 = 32 * jt + 8 * qd + 4 * hh;
            f32x4 cj = *(const f32x4*)(myW + 64 + j0), dj = *(const f32x4*)(myW + j0);
            float cjv[4] = {cj.x, cj.y, cj.z, cj.w}, djv[4] = {dj.x, dj.y, dj.z, dj.w};
#pragma unroll
            for (int u = 0; u < 4; ++u) {
              const int j = j0 + u;
              const bool ok = dir == 0 ? (j <= icol) : (j >= icol);
              const float m = __expf(ci_ - cjv[u]) * djv[u];
              X[4 * qd + u] = ok ? X[4 * qd + u] * m : 0.f;
            }
          }
#pragma unroll
          for (int sk = 0; sk < 2; ++sk) {
            bf16x8 afr = pack8(X[8 * sk], X[8 * sk + 1], X[8 * sk + 2], X[8 * sk + 3], X[8 * sk + 4], X[8 * sk + 5], X[8 * sk + 6], X[8 * sk + 7]);
            const bf16_t* xp = sXr + pcol * 72 + 32 * jt + 16 * sk + 4 * hh;
            u32x2 lo = *(const u32x2*)xp, hi = *(const u32x2*)(xp + 8);
            u32x4 xv; xv.x = lo.x; xv.y = lo.y; xv.z = hi.x; xv.w = hi.y;
            acc = __builtin_amdgcn_mfma_f32_32x32x16_bf16(afr, __builtin_bit_cast(bf16x8, xv), acc, 0, 0, 0);
          }
        }
      }
      __syncthreads();
      SCAN_DMA(ptokN);
      SCAN_WRITE_STATE();
      {
        bf16_t* yo = sY + (32 * it) * 72 + pcol;
#pragma unroll
        for (int e = 0; e < 16; ++e) yo[rowmap(e, hh) * 72] = f2bf(acc[e]);
      }
    }
    __syncthreads();
    {
      const int ptokP = SCAN_PTOK(nchunks - 1);
#pragma unroll
      for (int i = 0; i < 2; ++i) {
        const int q = tid + i * 256, yrow = q >> 3, c8 = (q & 7) * 8;
        *(u32x4*)(ybuf + ((size_t)dir * T_ALL + ptokP + yrow) * 2048 + h * 64 + c8) = *(const u32x4*)(sY + yrow * 72 + c8);
      }
    }
#undef SCAN_PTOK
#undef SCAN_LOAD_DTX
#undef SCAN_DMA
#undef SCAN_WRITE_STATE
    if (s < 32) {
      float* ho = p.out_ssd + ((((size_t)s * 2 + slot) * 2 + dir) * 32 + h) * 8192 + (size_t)pcol * 128;
#pragma unroll
      for (int t2 = 0; t2 < 2; ++t2)
#pragma unroll
        for (int qd = 0; qd < 4; ++qd) {
          f32x4 v; v.x = hacc[t2][4 * qd]; v.y = hacc[t2][4 * qd + 1]; v.z = hacc[t2][4 * qd + 2]; v.w = hacc[t2][4 * qd + 3];
          *(f32x4*)(ho + 32 * (2 * it + t2) + 8 * qd + 4 * hh) = v;
        }
    }
    asm volatile("s_waitcnt vmcnt(0)" ::: "memory");
  }
}

__device__ __forceinline__ void phase_ssd_gate(const Params& p, int slot, int bid, int nblk, int cxw) {
  const int tidx = opaque_tid(cxw);
  bf16_t* zb = (bf16_t*)(p.scratch + SC_SSD_Z);
  const bf16_t* yfb = (const bf16_t*)(p.scratch + SC_SSD_XBC);
  const bf16_t* ybb = yfb + (size_t)T_ALL * 2048;
  const bf16_t* xbcc = (const bf16_t*)(p.scratch + SC_SSD_XBCC);
  int lane = tidx & 63, wv = cxw & 3;
  for (int row = bid * 4 + wv; row < T_ALL; row += nblk * 4) {
    float ss = 0.f;
    TokInfo ti = tokinfo(row);
    const int prow = ti.base + seqpos2off(ti.l, slot == 1 && ti.s >= 32);
#pragma unroll
    for (int j = 0; j < 4; ++j) {
      int c0 = j * 512 + lane * 8;
      u32x4 zv = *(const u32x4*)(zb + (size_t)row * 2048 + c0);
      u32x4 fv = *(const u32x4*)(yfb + (size_t)prow * 2048 + c0);
      u32x4 bv = *(const u32x4*)(ybb + (size_t)prow * 2048 + c0);
      u32x4 xv = *(const u32x4*)(xbcc + (size_t)prow * 2048 + c0);
      float dsk = p.ssd_d[slot * 32 + (c0 >> 6)];
      unsigned zw[4] = {zv.x, zv.y, zv.z, zv.w}, fw[4] = {fv.x, fv.y, fv.z, fv.w}, bw[4] = {bv.x, bv.y, bv.z, bv.w}, xw[4] = {xv.x, xv.y, xv.z, xv.w};
      unsigned ow[4];
#pragma unroll
      for (int e = 0; e < 4; ++e) {
        float y0 = (bflo(fw[e]) + bflo(bw[e]) + dsk * bflo(xw[e])) * siluf(bflo(zw[e]));
        float y1 = (bfhi(fw[e]) + bfhi(bw[e]) + dsk * bfhi(xw[e])) * siluf(bfhi(zw[e]));
        ss += y0 * y0 + y1 * y1;
        ow[e] = pack2(y0, y1);
      }
      u32x4 o; o.x = ow[0]; o.y = ow[1]; o.z = ow[2]; o.w = ow[3];
      *(u32x4*)(zb + (size_t)row * 2048 + c0) = o;
    }
#pragma unroll
    for (int o = 32; o > 0; o >>= 1) ss += shfl_xor_f(ss, o, lane);
    if (lane == 0) p.rstd[row] = rsqrtf(ss * (1.f / 2048.f) + 1e-5f);
  }
}

#define HY_UOFF 32768
__device__ __forceinline__ void hy_stage_conv(const Params& p, const bf16_t* __restrict__ row, int ch, bf16_t* dst, int dstStride, int dstPad,
                                              int nelem, int L, int tid) {
  const float w0 = p.hy_conv_w[ch], w1 = p.hy_conv_w[3072 + ch], w2 = p.hy_conv_w[2 * 3072 + ch], bb = p.hy_conv_b[ch];
  for (int q = tid; q < nelem / 8; q += NTHR) {
    const int e0 = q * 8, b = e0 / L, t0 = e0 & (L - 1);
    u32x4 raw = *(const u32x4*)(row + e0);
    float x[10];
    x[0] = t0 > 0 ? bf2f(row[e0 - 1]) : 0.f;
    x[9] = t0 + 8 < L ? bf2f(row[e0 + 8]) : 0.f;
    x[1] = bflo(raw.x); x[2] = bfhi(raw.x); x[3] = bflo(raw.y); x[4] = bfhi(raw.y);
    x[5] = bflo(raw.z); x[6] = bfhi(raw.z); x[7] = bflo(raw.w); x[8] = bfhi(raw.w);
    float o[8];
#pragma unroll
    for (int j = 0; j < 8; ++j) o[j] = w0 * x[j] + w1 * x[j + 1] + w2 * x[j + 2] + bb;
    u32x4 ov; ov.x = pack2(o[0], o[1]); ov.y = pack2(o[2], o[3]); ov.z = pack2(o[4], o[5]); ov.w = pack2(o[6], o[7]);
    *(u32x4*)(dst + b * dstStride + dstPad + t0) = ov;
  }
}

__device__ __forceinline__ void phase_hy_longconv(const Params& p, int bid, int nblk, unsigned char* smem, int cxw) {
  const int tid = opaque_tid(cxw), lane = tid & 63, w = cxw & 3  , r = lane & 31, hh = lane >> 5;
  const bf16_t* projT = (const bf16_t*)(p.scratch + SC_HY_PROJT);
  bf16_t* yT = (bf16_t*)(p.scratch + SC_HY_YT);
  unsigned* Rc0 = (unsigned*)smem;
  unsigned* Rc1 = Rc0 + 4096;
  bf16_t* G = (bf16_t*)smem;
  bf16_t* U = (bf16_t*)(smem + HY_UOFF);
  for (int item = bid; item < 2048; item += nblk) {
    const bool lat = item < 1024;
    const int c = item & 1023;
    const int L = lat ? 4096 : 256, NB = lat ? 4 : 32, RL = lat ? 8192 : 512, Lm1 = L - 1;
    const int PAD = lat ? 224 : 0, US = lat ? 4552 : 264;
    const int tokbase = lat ? T_CTX : 0;
    const int nI = L >> 5, nelem = NB * L;
    const int TPW = lat ? 4 : 2;
    __syncthreads();
    if (lat) {
      for (int q = tid; q < 4 * 57; q += NTHR) {
        int b = q / 57, k = q % 57;
        int off = k < 28 ? k * 8 : 224 + 4096 + (k - 28) * 8;
        unsigned zz = 0u; asm volatile("" : "+v"(zz));
        u32x4 z4 = {zz, zz, zz, zz};
        *(u32x4*)(U + b * US + off) = z4;
      }
    }
    hy_stage_conv(p, projT + (size_t)c * T_ALL + tokbase, c, U, US, PAD, nelem, L, tid);
    int Icol[4], bcol[4];
#pragma unroll
    for (int tt = 0; tt < 4; ++tt) {
      int n = (w * TPW + tt) * 32 + r;
      Icol[tt] = lat ? (n >> 2) : (n >> 5);
      bcol[tt] = lat ? (n & 3) : (n & 31);
    }
    const int Ilo_w = lat ? 32 * w : 2 * w, Ihi_w = lat ? 32 * w + 31 : 2 * w + 1;
    const int dlo = Ilo_w - (nI - 1), dhi = Ihi_w;
    for (int order = 0; order < 2; ++order) {
      {
        const bf16_t* src = (lat ? p.rtab1 : p.rtab0) + (size_t)(order * 1024 + c) * RL;
        for (int q = tid; q < RL / 8; q += NTHR) {
          u32x4 cv = *(const u32x4*)(src + q * 8);
          unsigned nx = (q + 1 < RL / 8) ? *(const unsigned*)(src + q * 8 + 8) : 0u;
          *(u32x4*)(Rc0 + q * 4) = cv;
          u32x4 sv;
          sv.x = (cv.x >> 16) | (cv.y << 16); sv.y = (cv.y >> 16) | (cv.z << 16);
          sv.z = (cv.z >> 16) | (cv.w << 16); sv.w = (cv.w >> 16) | (nx << 16);
          *(u32x4*)(Rc1 + q * 4) = sv;
        }
      }
      __syncthreads();
      f32x16 acc[4];
#pragma unroll
      for (int tt = 0; tt < 4; ++tt)
#pragma unroll
        for (int e = 0; e < 16; ++e) acc[tt][e] = 0.f;
      {
        int lo_t[4], hi_t[4];
        const bf16_t* ub[4];
#pragma unroll
        for (int tt = 0; tt < 4; ++tt) {
          const int tile = w * TPW + tt;
          const int Ilo_t = lat ? 8 * tile : tile, Ihi_t = lat ? 8 * tile + 7 : tile;
          lo_t[tt] = tt < TPW ? Ilo_t - (nI - 1) : 1 << 30; hi_t[tt] = tt < TPW ? Ihi_t : -(1 << 30);
          ub[tt] = U + bcol[tt] * US + PAD + 32 * Icol[tt] + 8 * hh;
        }
        const int ybase = Lm1 - r + 8 * hh;
#define LC_EDGE(D0, D1) do { for (int d_ = (D0); d_ <= (D1); ++d_) { \
          _Pragma("unroll") for (int kk_ = 0; kk_ < 2; ++kk_) { \
            const int y0_ = ybase - 32 * d_ + 16 * kk_; const int par_ = y0_ & 1; \
            const unsigned* rp_ = (par_ ? Rc1 : Rc0) + ((y0_ - par_) >> 1); \
            u32x4 av_; av_.x = rp_[0]; av_.y = rp_[1]; av_.z = rp_[2]; av_.w = rp_[3]; const bf16x8 af_ = __builtin_bit_cast(bf16x8, av_); \
            _Pragma("unroll") for (int tt = 0; tt < 4; ++tt) if (d_ >= lo_t[tt] && d_ <= hi_t[tt]) \
              acc[tt] = __builtin_amdgcn_mfma_f32_32x32x16_bf16(af_, *(const bf16x8*)(ub[tt] - 32 * d_ + 16 * kk_), acc[tt], 0, 0, 0); } } } while (0)
        if (!lat) {
          LC_EDGE(dlo, dhi);
        } else {
          const int mlo = lo_t[3], mhi = hi_t[0];
          LC_EDGE(dlo, mlo - 1);
#define LC_LOAD(IT, A, B) do { const int it_ = (IT); const int d_ = mlo + (it_ >> 1), kk_ = it_ & 1; \
          const int y0_ = ybase - 32 * d_ + 16 * kk_; const int par_ = y0_ & 1; \
          const unsigned* rp_ = (par_ ? Rc1 : Rc0) + ((y0_ - par_) >> 1); \
          u32x4 av_; av_.x = rp_[0]; av_.y = rp_[1]; av_.z = rp_[2]; av_.w = rp_[3]; A = __builtin_bit_cast(bf16x8, av_); \
          _Pragma("unroll") for (int tt = 0; tt < 4; ++tt) B[tt] = *(const bf16x8*)(ub[tt] - 32 * d_ + 16 * kk_); } while (0)
#define LC_MMA(A, B) do { _Pragma("unroll") for (int tt = 0; tt < 4; ++tt) acc[tt] = __builtin_amdgcn_mfma_f32_32x32x16_bf16(A, B[tt], acc[tt], 0, 0, 0); } while (0)
          const int NIT = 2 * (mhi - mlo + 1);
          bf16x8 a0, a1, b0[4], b1[4];
          LC_LOAD(0, a0, b0);
          for (int it = 0; it < NIT; it += 2) {
            LC_LOAD(it + 1, a1, b1);
            LC_MMA(a0, b0);
            LC_LOAD(it + 2 < NIT ? it + 2 : NIT - 1, a0, b0);
            LC_MMA(a1, b1);
          }
#undef LC_LOAD
#undef LC_MMA
          LC_EDGE(mhi + 1, dhi);
        }
#undef LC_EDGE
      }
      __syncthreads();
      hy_stage_conv(p, projT + (size_t)((1 + order) * 1024 + c) * T_ALL + tokbase, (1 + order) * 1024 + c, G, L, 0, nelem, L, tid);
      __syncthreads();
      const float inv = 1.f / p.knorm[((lat ? 1 : 0) * 2 + order) * 1024 + c];
      const float bias = p.hy_f_bias[order * 1024 + c];
#pragma unroll
      for (int tt = 0; tt < 4; ++tt) {
        if (tt < TPW) {
#pragma unroll
          for (int qd = 0; qd < 4; ++qd) {
            const int t0 = 32 * Icol[tt] + 8 * qd + 4 * hh;
            bf16_t* up = U + bcol[tt] * US + PAD + t0;
            u32x2 uc = *(const u32x2*)up;
            u32x2 gg = *(const u32x2*)(G + bcol[tt] * L + t0);
            float r0 = (inv * acc[tt][4 * qd] + bias * bflo(uc.x)) * bflo(gg.x);
            float r1 = (inv * acc[tt][4 * qd + 1] + bias * bfhi(uc.x)) * bfhi(gg.x);
            float r2 = (inv * acc[tt][4 * qd + 2] + bias * bflo(uc.y)) * bflo(gg.y);
            float r3 = (inv * acc[tt][4 * qd + 3] + bias * bfhi(uc.y)) * bfhi(gg.y);
            if (order == 1) {
              u32x2 zz = *(const u32x2*)(projT + (size_t)(3072 + c) * T_ALL + tokbase + bcol[tt] * L + t0);
              r0 *= siluf(bflo(zz.x)); r1 *= siluf(bfhi(zz.x)); r2 *= siluf(bflo(zz.y)); r3 *= siluf(bfhi(zz.y));
            }
            u32x2 ov; ov.x = pack2(r0, r1); ov.y = pack2(r2, r3);
            *(u32x2*)up = ov;
          }
        }
      }
      __syncthreads();
    }
    for (int q = tid; q < nelem / 8; q += NTHR) {
      const int e0 = q * 8, b = e0 / L, t0 = e0 & (L - 1);
      *(u32x4*)(yT + (size_t)c * T_ALL + tokbase + e0) = *(const u32x4*)(U + b * US + PAD + t0);
    }
  }
}

__device__ __forceinline__ void phase_hy_transpose(const Params& p, int bid, int nblk, unsigned char* smem, int cxw) {
  const int tid = opaque_tid(cxw);
  const bf16_t* yT = (const bf16_t*)(p.scratch + SC_HY_YT);
  bf16_t* yg = (bf16_t*)(p.scratch + SC_HY_YG);
  bf16_t* tl = (bf16_t*)smem;
  for (int item = bid; item < 16 * (T_ALL / 64); item += nblk) {
    const int cb = item & 15, tb = item >> 4;
    __syncthreads();
#pragma unroll
    for (int i = 0; i < 2; ++i) {
      int q = tid + i * 256, cr = q >> 3, t8 = (q & 7) * 8;
      u32x4 v = *(const u32x4*)(yT + (size_t)(cb * 64 + cr) * T_ALL + tb * 64 + t8);
      unsigned wv[4] = {v.x, v.y, v.z, v.w};
#pragma unroll
      for (int e = 0; e < 4; ++e) {
        tl[(t8 + 2 * e) * 72 + cr] = (bf16_t)(wv[e] & 0xffffu);
        tl[(t8 + 2 * e + 1) * 72 + cr] = (bf16_t)(wv[e] >> 16);
      }
    }
    __syncthreads();
#pragma unroll
    for (int i = 0; i < 2; ++i) {
      int q = tid + i * 256, tr = q >> 3, c8 = (q & 7) * 8;
      *(u32x4*)(yg + (size_t)(tb * 64 + tr) * 1024 + cb * 64 + c8) = *(const u32x4*)(tl + tr * 72 + c8);
    }
  }
}

#define LRU_NCH 384
struct Lru4 { float af[4], bxf[4], ab[4], bxb[4]; };
__device__ __forceinline__ void lru_unpack4(u32x2 v, float (&o)[4]) { o[0] = bflo(v.x); o[1] = bfhi(v.x); o[2] = bflo(v.y); o[3] = bfhi(v.y); }
__device__ __forceinline__ void lru_row_f(const bf16_t* gates, const bf16_t* xc, size_t o, const float (&spf)[4], float (&af)[4], float (&bxf)[4]) {
  float r[4], g[4], x[4];
  lru_unpack4(*(const u32x2*)(gates + o), r); lru_unpack4(*(const u32x2*)(gates + (size_t)T_ALL * 1024 + o), g); lru_unpack4(*(const u32x2*)(xc + o), x);
#pragma unroll
  for (int e = 0; e < 4; ++e) { const float la = -8.f * r[e] * spf[e]; af[e] = __expf(la); bxf[e] = sqrtf(fmaxf(1.f - __expf(2.f * la), 0.f)) * g[e] * x[e]; }
}
__device__ __forceinline__ void lru_row_b(const bf16_t* gates, const bf16_t* xc, size_t o, const float (&spb)[4], float (&ab)[4], float (&bxb)[4]) {
  float r[4], g[4], x[4];
  lru_unpack4(*(const u32x2*)(gates + (size_t)2 * T_ALL * 1024 + o), r); lru_unpack4(*(const u32x2*)(gates + (size_t)3 * T_ALL * 1024 + o), g); lru_unpack4(*(const u32x2*)(xc + o), x);
#pragma unroll
  for (int e = 0; e < 4; ++e) { const float la = -8.f * r[e] * spb[e]; ab[e] = __expf(la); bxb[e] = sqrtf(fmaxf(1.f - __expf(2.f * la), 0.f)) * g[e] * x[e]; }
}
__device__ __forceinline__ void phase_lru_scan_agg(const Params& p, int bid, int nblk, unsigned char* smem, int cxw) {
  const int tidx = opaque_tid(cxw);
  const bf16_t* gates = (const bf16_t*)(p.scratch + SC_LRU_GATES);
  const bf16_t* xc = (const bf16_t*)(p.scratch + SC_LRU_XC);
  float* sagg = (float*)smem;
  const int sub = cxw & 3, cq = tidx & 63;
  for (int item = bid; item < LRU_NCH * 4; item += nblk) {
    const int chunk = item >> 2, cb = item & 3;
    const int c0 = cb * 256 + 4 * cq;
    float spf[4], spb[4];
#pragma unroll
    for (int e = 0; e < 4; ++e) { spf[e] = softplusf(-p.lru_a_param[c0 + e]); spb[e] = softplusf(-p.lru_a_param[1024 + c0 + e]); }
    const int tok0 = chunk * 64 + 16 * sub;
    float Af[4] = {1.f, 1.f, 1.f, 1.f}, hf[4] = {0.f, 0.f, 0.f, 0.f}, Pb[4] = {1.f, 1.f, 1.f, 1.f}, Bb[4] = {0.f, 0.f, 0.f, 0.f};
#pragma unroll 4
    for (int j = 0; j < 16; ++j) {
      const size_t o = (size_t)(tok0 + j) * 1024 + c0;
      float af[4], bxf[4], ab[4], bxb[4];
      lru_row_f(gates, xc, o, spf, af, bxf);
      lru_row_b(gates, xc, o, spb, ab, bxb);
#pragma unroll
      for (int e = 0; e < 4; ++e) { hf[e] = af[e] * hf[e] + bxf[e]; Af[e] *= af[e]; Bb[e] += bxb[e] * Pb[e]; Pb[e] *= ab[e]; }
    }
    {
      const size_t sc = (size_t)chunk * 4 + sub;
      float* gf = p.lru_sagg + (((size_t)0 * (LRU_NCH * 4) + sc) * 1024 + c0) * 2;
      float* gb = p.lru_sagg + (((size_t)1 * (LRU_NCH * 4) + sc) * 1024 + c0) * 2;
      f32x4 v0 = {Af[0], hf[0], Af[1], hf[1]}, v1 = {Af[2], hf[2], Af[3], hf[3]};
      f32x4 w0 = {Pb[0], Bb[0], Pb[1], Bb[1]}, w1 = {Pb[2], Bb[2], Pb[3], Bb[3]};
      *(f32x4*)gf = v0; *(f32x4*)(gf + 4) = v1; *(f32x4*)gb = w0; *(f32x4*)(gb + 4) = w1;
      __syncthreads();
      float* sl = sagg + (sub * 64 + cq) * 16;
      *(f32x4*)sl = v0; *(f32x4*)(sl + 4) = v1; *(f32x4*)(sl + 8) = w0; *(f32x4*)(sl + 12) = w1;
      __syncthreads();
    }
    if (sub == 0) {
      float A[4], B[4], P[4], Q[4];
#pragma unroll
      for (int e = 0; e < 4; ++e) { A[e] = 1.f; B[e] = 0.f; P[e] = 1.f; Q[e] = 0.f; }
#pragma unroll
      for (int s2 = 0; s2 < 4; ++s2) {
        const float* lf = sagg + (s2 * 64 + cq) * 16;
        const float* lb = sagg + ((3 - s2) * 64 + cq) * 16 + 8;
#pragma unroll
        for (int e = 0; e < 4; ++e) {
          const float a = lf[2 * e], b = lf[2 * e + 1];
          B[e] = a * B[e] + b; A[e] *= a;
          const float pb = lb[2 * e], qb = lb[2 * e + 1];
          Q[e] = pb * Q[e] + qb; P[e] *= pb;
        }
      }
      float* gf = p.lru_agg + (((size_t)0 * LRU_NCH + chunk) * 1024 + c0) * 2;
      float* gb = p.lru_agg + (((size_t)1 * LRU_NCH + chunk) * 1024 + c0) * 2;
      f32x4 v0 = {A[0], B[0], A[1], B[1]}, v1 = {A[2], B[2], A[3], B[3]}, w0 = {P[0], Q[0], P[1], Q[1]}, w1 = {P[2], Q[2], P[3], Q[3]};
      *(f32x4*)gf = v0; *(f32x4*)(gf + 4) = v1; *(f32x4*)gb = w0; *(f32x4*)(gb + 4) = w1;
    }
  }
}
__device__ __forceinline__ void phase_lru_scan_carry(const Params& p, int bid, int nblk, int cxw) {
  const int tidx = opaque_tid(cxw);
  for (int item = bid; item < 36 * 8; item += nblk) {
    int s = item >> 3, dir = (item >> 2) & 1, cb = item & 3;
    int c = cb * 256 + tidx;
    int nch = s < 32 ? 4 : 64;
    int ch0 = s < 32 ? s * 4 : 128 + (s - 32) * 64;
    float h = s < 32 ? 0.f : p.state_lru[((size_t)(s - 32) * 2 + dir) * 1024 + c];
    for (int k0 = 0; k0 < nch; k0 += 4) {
      f32x2_t ag[4]; size_t idx[4];
#pragma unroll
      for (int u = 0; u < 4; ++u) {
        const int chunk = dir ? ch0 + nch - 1 - (k0 + u) : ch0 + k0 + u;
        idx[u] = ((size_t)dir * LRU_NCH + chunk) * 1024 + c;
        ag[u] = *(const f32x2_t*)(p.lru_agg + idx[u] * 2);
      }
#pragma unroll
      for (int u = 0; u < 4; ++u) { p.lru_hin[idx[u]] = h; h = ag[u].x * h + ag[u].y; }
    }
    if (s < 32) p.out_lru[((size_t)s * 2 + dir) * 1024 + c] = h;
  }
}
__device__ __forceinline__ void phase_lru_scan_final(const Params& p, int bid, int nblk, unsigned char* smem, int cxw) {
  const int tidx = opaque_tid(cxw);
  const bf16_t* gates = (const bf16_t*)(p.scratch + SC_LRU_GATES);
  const bf16_t* xc = (const bf16_t*)(p.scratch + SC_LRU_XC);
  const bf16_t* proj = (const bf16_t*)(p.scratch + SC_LRU_PROJ);
  bf16_t* yg = (bf16_t*)(p.scratch + SC_LRU_YG);
  const int sub = cxw & 3, cq = tidx & 63;
  for (int item = bid; item < LRU_NCH * 4; item += nblk) {
    const int chunk = item >> 2, cb = item & 3;
    const int c0 = cb * 256 + 4 * cq;
    float spf[4], spb[4];
#pragma unroll
    for (int e = 0; e < 4; ++e) { spf[e] = softplusf(-p.lru_a_param[c0 + e]); spb[e] = softplusf(-p.lru_a_param[1024 + c0 + e]); }
    float hf[4], hb[4];
    {
      const f32x4 a = *(const f32x4*)(p.lru_hin + ((size_t)0 * LRU_NCH + chunk) * 1024 + c0);
      const f32x4 b = *(const f32x4*)(p.lru_hin + ((size_t)1 * LRU_NCH + chunk) * 1024 + c0);
      hf[0] = a.x; hf[1] = a.y; hf[2] = a.z; hf[3] = a.w; hb[0] = b.x; hb[1] = b.y; hb[2] = b.z; hb[3] = b.w;
    }
#pragma unroll
    for (int s2 = 0; s2 < 3; ++s2) {
      if (s2 < sub) {
        const float* g = p.lru_sagg + (((size_t)0 * (LRU_NCH * 4) + (size_t)chunk * 4 + s2) * 1024 + c0) * 2;
        const f32x4 v0 = *(const f32x4*)g, v1 = *(const f32x4*)(g + 4);
        hf[0] = v0.x * hf[0] + v0.y; hf[1] = v0.z * hf[1] + v0.w; hf[2] = v1.x * hf[2] + v1.y; hf[3] = v1.z * hf[3] + v1.w;
      }
      if (3 - s2 > sub) {
        const float* g = p.lru_sagg + (((size_t)1 * (LRU_NCH * 4) + (size_t)chunk * 4 + (3 - s2)) * 1024 + c0) * 2;
        const f32x4 v0 = *(const f32x4*)g, v1 = *(const f32x4*)(g + 4);
        hb[0] = v0.x * hb[0] + v0.y; hb[1] = v0.z * hb[1] + v0.w; hb[2] = v1.x * hb[2] + v1.y; hb[3] = v1.z * hb[3] + v1.w;
      }
    }
    const int tok0 = chunk * 64 + 16 * sub;
    float hfs[16][4];
#pragma unroll
    for (int j = 0; j < 16; ++j) {
      const size_t o = (size_t)(tok0 + j) * 1024 + c0;
      float af[4], bxf[4];
      lru_row_f(gates, xc, o, spf, af, bxf);
#pragma unroll
      for (int e = 0; e < 4; ++e) { hf[e] = af[e] * hf[e] + bxf[e]; hfs[j][e] = hf[e]; }
    }
#pragma unroll
    for (int j = 15; j >= 0; --j) {
      const size_t o = (size_t)(tok0 + j) * 1024 + c0;
      float ab[4], bxb[4], z[4];
      lru_row_b(gates, xc, o, spb, ab, bxb);
      lru_unpack4(*(const u32x2*)(proj + (size_t)(tok0 + j) * 2048 + 1024 + c0), z);
      float y[4];
#pragma unroll
      for (int e = 0; e < 4; ++e) { hb[e] = ab[e] * hb[e] + bxb[e]; y[e] = (hfs[j][e] + hb[e]) * siluf(z[e]); }
      u32x2 ov; ov.x = pack2(y[0], y[1]); ov.y = pack2(y[2], y[3]);
      *(u32x2*)(yg + o) = ov;
    }
  }
}

enum { PH_PREP = 0, PH_MOD, PH_HYA, PH_HYB, PH_LNMOD, PH_INPROJ, PH_MIX1, PH_MIX2, PH_MIX3, PH_MIX4, PH_MIX5, PH_MIX6, PH_OUTPROJ };

struct Ctx { int bid, nblk, wave; unsigned char* smem; unsigned char* wg_smem; };

template <class Epi>
__device__ __forceinline__ void run_gemm(const Ctx& cx, const bf16_t* A, int lda, const bf16_t* Bt, int M, int N, int K, int grp_shift, int grp_bytes, const Epi& e) {
  pg8::Gemm g{A, Bt, M, N, K, lda, grp_shift, grp_bytes};
  pg8::StaticOrder S; S.init(M, N, gridDim.x, opaque_s(blockIdx.x));
  pg8::gemm_phase((PG8_LAS unsigned char*)cx.wg_smem, g, S, e, cx.wave);
}

#define N_PARAM_WORDS (sizeof(Params) / 8)
__device__ __forceinline__ Params load_params(const unsigned char* lp) {
  Params p;
  unsigned long long* d = (unsigned long long*)&p;
  const unsigned long long* sp = (const unsigned long long*)lp;
#pragma unroll
  for (int i = 0; i < (int)N_PARAM_WORDS; ++i) {
    const unsigned long long v = sp[i];
    const unsigned lo = __builtin_amdgcn_readfirstlane((unsigned)v), hi = __builtin_amdgcn_readfirstlane((unsigned)(v >> 32));
    d[i] = ((unsigned long long)hi << 32) | lo;
  }
  return p;
}
__device__ __forceinline__ void run_phase(const unsigned char* lparams, int ph, int layer, const Ctx& cx) {
  const Params p = load_params(lparams);
  const int kind = layer % 3, slot = layer / 3;
  const int bid = opaque_s(cx.bid), nblk = cx.nblk;
  unsigned char* smem = cx.smem;
  switch (ph) {
    case PH_PREP: phase_prep(p, bid, nblk, smem, cx.wave); break;
    case PH_MOD: phase_mod(p, bid, nblk, smem, cx.wave); break;
    case PH_HYA: phase_hyfilt_a(p, bid, nblk, smem, cx.wave); break;
    case PH_HYB: phase_hyfilt_b(p, bid, nblk, smem, cx.wave); break;
    case PH_LNMOD: phase_lnmod(p, layer, bid, nblk, cx.wave); break;
    case PH_INPROJ:
      if (kind == 0) {
        pg8::EpiSsdIn e{(bf16_t*)(p.scratch + SC_SSD_Z), (bf16_t*)(p.scratch + SC_SSD_XBC), (float*)(p.scratch + SC_SSD_DT), p.ssd_dt_bias + slot * 64};
        run_gemm(cx, p.hbuf, 1024, p.wt_ssd_in + (size_t)slot * 6400 * 1024, T_ALL, 6400, 1024, 30, 0, e);
      } else if (kind == 1) {
        pg8::EpiBf16 e{(bf16_t*)(p.scratch + SC_HY_PROJT), (size_t)T_ALL};
        run_gemm(cx, p.wt_hy_in, 1024, p.hbuf, 4096, T_ALL, 1024, 30, 0, e);
      } else {
        pg8::EpiBf16 e{(bf16_t*)(p.scratch + SC_LRU_PROJ), (size_t)2048};
        run_gemm(cx, p.hbuf, 1024, p.wt_lru_in, T_ALL, 2048, 1024, 30, 0, e);
      }
      break;
    case PH_MIX1:
      if (kind == 0) phase_ssd_conv(p, slot, slot == 1, bid, nblk, smem, cx.wave);
      else if (kind == 1) phase_hy_longconv(p, bid, nblk, smem, cx.wave);
      else phase_dwconv<4, false>((const bf16_t*)(p.scratch + SC_LRU_PROJ), 2048, (bf16_t*)(p.scratch + SC_LRU_XC), 1024, 1024,
                                  p.lru_conv_w, p.lru_conv_b, false, bid, nblk, cx.wave);
      break;
    case PH_MIX2:
      if (kind == 0) phase_ssd_scan(p, slot, slot == 1, bid, nblk, cx.wg_smem, cx.wave);
      else if (kind == 1) phase_hy_transpose(p, bid, nblk, smem, cx.wave);
      else {
        pg8::EpiLruGate e{(bf16_t*)(p.scratch + SC_LRU_GATES), p.lru_gate_b};
        run_gemm(cx, (const bf16_t*)(p.scratch + SC_LRU_XC), 1024, p.wt_lru_gate, T_ALL, 4096, 256, 2, 512, e);
      }
      break;
    case PH_MIX3:
      if (kind == 0) phase_ssd_gate(p, slot, bid, nblk, cx.wave);
      else phase_lru_scan_agg(p, bid, nblk, smem, cx.wave);
      break;
    case PH_MIX4: if (kind == 2) phase_lru_scan_carry(p, bid, nblk, cx.wave); break;
    case PH_MIX5: if (kind == 2) phase_lru_scan_final(p, bid, nblk, smem, cx.wave); break;
    case PH_OUTPROJ: {
      const float* mv = p.modv + (size_t)layer * 5 * 3072;
      if (kind == 0) {
        pg8::EpiOut e{p.resb, mv, p.rstd};
        run_gemm(cx, (const bf16_t*)(p.scratch + SC_SSD_Z), 2048, p.wt_ssd_out + (size_t)slot * 1024 * 2048, T_ALL, 1024, 2048, 30, 0, e);
      } else if (kind == 1) {
        pg8::EpiOut e{p.resb, mv, nullptr};
        run_gemm(cx, (const bf16_t*)(p.scratch + SC_HY_YG), 1024, p.wt_hy_out, T_ALL, 1024, 1024, 30, 0, e);
      } else {
        pg8::EpiOut e{p.resb, mv, nullptr};
        run_gemm(cx, (const bf16_t*)(p.scratch + SC_LRU_YG), 1024, p.wt_lru_out, T_ALL, 1024, 1024, 30, 0, e);
      }
    } break;
  }
}

__global__ void __launch_bounds__(WG_THREADS, 2) k_mega(Params p) {
  __shared__ __attribute__((aligned(16))) unsigned char smem[WG_SMEM + 16 + 512];
  cg::grid_group grid = cg::this_grid();
  const int wave0 = __builtin_amdgcn_readfirstlane((int)(threadIdx.x >> 6));
  const int vb = wave0 >> 2;
  Ctx cx;
  cx.wave = wave0;
  cx.bid = 2 * blockIdx.x + vb; cx.nblk = 2 * gridDim.x; cx.smem = smem + vb * SMEM_BYTES; cx.wg_smem = smem;
  volatile LAS unsigned* xst = (volatile LAS unsigned*)(smem + WG_SMEM);
  unsigned char* lparams = smem + WG_SMEM + 16;
  if (threadIdx.x == 0) { xst[0] = 0u; xst[1] = 0u; *(Params*)lparams = p; }
  __syncthreads();
  const XcdBarrier xb = xcd_barrier_post(p.bar, xst);
  run_phase(lparams, PH_PREP, 0, cx);
  run_phase(lparams, PH_MOD, 0, cx);
  run_phase(lparams, PH_HYA, 0, cx);
  grid.sync();
  run_phase(lparams, PH_HYB, 0, cx);
  for (int layer = 0; layer < 4; ++layer) {
    const int kind = layer % 3;
    run_phase(lparams, PH_LNMOD, layer, cx);
    xcd_barrier(xb, cx.wave);
    run_phase(lparams, PH_INPROJ, layer, cx);
    xcd_barrier(xb, cx.wave);
    run_phase(lparams, PH_MIX1, layer, cx);
    xcd_barrier(xb, cx.wave);
    run_phase(lparams, PH_MIX2, layer, cx);
    xcd_barrier(xb, cx.wave);
    if (kind != 1) {
      run_phase(lparams, PH_MIX3, layer, cx);
      xcd_barrier(xb, cx.wave);
    }
    if (kind == 2) {
      run_phase(lparams, PH_MIX4, layer, cx);
      xcd_barrier(xb, cx.wave);
      run_phase(lparams, PH_MIX5, layer, cx);
      xcd_barrier(xb, cx.wave);
    }
    run_phase(lparams, PH_OUTPROJ, layer, cx);
    xcd_barrier(xb, cx.wave);
  }
  run_phase(lparams, PH_LNMOD, 4, cx);
}

static inline size_t align_up(size_t x) { return (x + 255) & ~(size_t)255; }

extern "C" void kernel_launch(void* const* d_in, const int* in_sizes, int n_in, void* d_out, int out_size, void* d_ws, size_t ws_size,
                              hipStream_t stream) {
  Params p{};
  const float** fp = (const float**)&p;
  for (int i = 0; i < 36; ++i) fp[i] = (const float*)d_in[i];
  float* out = (float*)d_out;
  p.xres = out;
  p.out_ssd = out + (size_t)T_ALL * 1024;
  p.out_lru = p.out_ssd + (size_t)32 * 2 * 2 * 32 * 64 * 128;
  unsigned char* w = (unsigned char*)d_ws;
  size_t off = 0;
  auto carve = [&](size_t bytes) { unsigned char* r = w + off; off = align_up(off + bytes); return r; };
  p.wt_ssd_in = (bf16_t*)carve((size_t)2 * 6400 * 1024 * 2);
  p.wt_ssd_out = (bf16_t*)carve((size_t)2 * 1024 * 2048 * 2);
  p.wt_hy_in = (bf16_t*)carve((size_t)4096 * 1024 * 2);
  p.wt_hy_out = (bf16_t*)carve((size_t)1024 * 1024 * 2);
  p.wt_lru_in = (bf16_t*)carve((size_t)2048 * 1024 * 2);
  p.wt_lru_out = (bf16_t*)carve((size_t)1024 * 1024 * 2);
  p.wt_lru_gate = (bf16_t*)carve((size_t)4 * 1024 * 256 * 2);
  p.modv = (float*)carve((size_t)4 * 5 * 3072 * 4);
  p.hdn2 = (float*)carve((size_t)4352 * 64 * 4);
  p.rtab0 = (bf16_t*)carve((size_t)2 * 1024 * 512 * 2);
  p.rtab1 = (bf16_t*)carve((size_t)2 * 1024 * 8192 * 2);
  p.knorm = (float*)carve((size_t)4 * 1024 * 4);
  p.hbuf = (bf16_t*)carve((size_t)T_ALL * 1024 * 2);
  p.rstd = (float*)carve((size_t)T_ALL * 4);
  p.resb = (bf16_t*)carve((size_t)T_ALL * 1024 * 2);
  p.lru_agg = (float*)carve((size_t)2 * 384 * 1024 * 2 * 4);
  p.lru_hin = (float*)carve((size_t)2 * 384 * 1024 * 4);
  p.lru_sagg = (float*)carve((size_t)2 * 1536 * 1024 * 2 * 4);
  p.bar = (unsigned*)carve((size_t)XCD_BAR_WORDS * 4);
  p.scratch = carve(SC_TOTAL);
  if (off > ws_size) return;

  static int grid_blocks = 0;
  if (!grid_blocks) {
    int dev = 0, cus = 0, per_cu = 0;
    hipGetDevice(&dev);
    hipDeviceGetAttribute(&cus, hipDeviceAttributeMultiprocessorCount, dev);
    hipOccupancyMaxActiveBlocksPerMultiprocessor(&per_cu, k_mega, WG_THREADS, 0);
    if (per_cu > 1) per_cu = 1;
    grid_blocks = cus * per_cu;
  }
  hipMemsetAsync(p.bar, 0, (size_t)XCD_BAR_WORDS * 4, stream);
  void* args[] = {&p};
  hipError_t e = hipLaunchCooperativeKernel((void*)k_mega, dim3(grid_blocks), dim3(WG_THREADS), args, 0, stream);
  if (e != hipSuccess) fprintf(stderr, "cooperative launch failed: %s (grid %d)\n", hipGetErrorString(e), grid_blocks);
}
```

```cpp
#include <hip/hip_runtime.h>
#include <hip/hip_bf16.h>
#include <hip/hip_cooperative_groups.h>
#include <stdint.h>
#include <cstdio>
namespace cg = cooperative_groups;

typedef unsigned short bf16_t;
typedef __attribute__((ext_vector_type(8))) short bf16x8;
typedef __attribute__((ext_vector_type(16))) float f32x16;
typedef __attribute__((ext_vector_type(4))) unsigned int u32x4;
typedef __attribute__((ext_vector_type(2))) unsigned int u32x2;
typedef __attribute__((ext_vector_type(4))) float f32x4;
typedef float f32x4_t __attribute__((ext_vector_type(4)));
typedef float f32x2_t __attribute__((ext_vector_type(2)));

#define T_CTX 8192
#define T_ALL 24576
#define DM 1024
#define NTHR 256
#define SMEM_BYTES 69632
#define WG_THREADS 512
#define WG_SMEM 147456
#define ALPHA_RES 1.6817928305074290f
#define LN_EPS 1e-5f

__device__ __forceinline__ bf16_t f2bf(float f) { __bf16 h = (__bf16)f; return __builtin_bit_cast(bf16_t, h); }
__device__ __forceinline__ float bf2f(bf16_t b) { return __uint_as_float(((unsigned)b) << 16); }
__device__ __forceinline__ float bflo(unsigned w) { return __uint_as_float(w << 16); }
__device__ __forceinline__ float bfhi(unsigned w) { return __uint_as_float(w & 0xffff0000u); }
typedef __bf16 bf16v2_t __attribute__((ext_vector_type(2)));
typedef float f32v2_t __attribute__((ext_vector_type(2)));
__device__ __forceinline__ unsigned pack2(float a, float b) { f32v2_t v = {a, b}; bf16v2_t h = __builtin_convertvector(v, bf16v2_t); return __builtin_bit_cast(unsigned, h); }
__device__ __forceinline__ float siluf(float x) { return x * __builtin_amdgcn_rcpf(1.f + __expf(-x)); }
__device__ __forceinline__ float sigmoidf(float x) { return __builtin_amdgcn_rcpf(1.f + __expf(-x)); }
__device__ __forceinline__ float softplusf(float x) { return x > 20.f ? x : __logf(1.f + __expf(x)); }


__device__ __forceinline__ int opaque_lane() { int z = 0; asm volatile("" : "+v"(z)); return __builtin_amdgcn_mbcnt_hi(~0u, __builtin_amdgcn_mbcnt_lo(~0u, (unsigned)z)); }
__device__ __forceinline__ int opaque_tid512(int wave) { return (wave << 6) + opaque_lane(); }
__device__ __forceinline__ int opaque_tid(int wave) { return opaque_tid512(wave) & 255; }

#define XB_TMO      128
#define XB_XCNT(j)  (256  + 64 * (j))
#define XB_XSUB(j)  (1280 + 64 * (j))
#define XB_XGEN(j)  (2304 + 64 * (j))
#define XB_TOP      3328
#define XB_TOPGEN   3392
#define XCD_BAR_WORDS 3456
#define XB_SPIN_CAP (1u << 18)
#define LAS __attribute__((address_space(3)))
__device__ __forceinline__ unsigned xb_ld(unsigned* p)              { return __hip_atomic_load(p, __ATOMIC_RELAXED, __HIP_MEMORY_SCOPE_AGENT); }
__device__ __forceinline__ unsigned xb_add(unsigned* p, unsigned v) { return __hip_atomic_fetch_add(p, v, __ATOMIC_RELAXED, __HIP_MEMORY_SCOPE_AGENT); }
__device__ __forceinline__ unsigned xb_xcc_id() { return (unsigned)__builtin_amdgcn_s_getreg((3 << 11) | 20) & 0xFu; }
#define XB_SPIN(cond, bar) do { unsigned _sp = 0; while (cond) { __builtin_amdgcn_s_sleep(1); \
    if ((++_sp & 255u) == 0u) { if (xb_ld(&(bar)[XB_TMO])) break; if (_sp > XB_SPIN_CAP) { atomicAdd(&(bar)[XB_TMO], 1u); break; } } } } while (0)
struct XcdBarrier { unsigned* bar; unsigned x; volatile LAS unsigned* st; };
__device__ __forceinline__ XcdBarrier xcd_barrier_post(unsigned* bar, volatile LAS unsigned* st) {
  XcdBarrier b; b.bar = bar; b.x = xb_xcc_id(); b.st = st;
  if (threadIdx.x == 0) (void)xb_add(&bar[XB_XCNT(b.x)], 1u);
  return b;
}
__device__ __forceinline__ void xcd_barrier_complete(unsigned* bar, unsigned x, unsigned& nloc, unsigned& nx) {
  const unsigned G = gridDim.x * gridDim.y * gridDim.z;
  unsigned sum, cnt, mine, sp = 0u;
  for (;;) {
    sum = 0u; cnt = 0u; mine = 0u;
#pragma unroll
    for (unsigned j = 0; j < 16; ++j) { const unsigned c = xb_ld(&bar[XB_XCNT(j)]); sum += c; cnt += (c > 0u) ? 1u : 0u; mine = (j == x) ? c : mine; }
    if (sum == G) break;
    __builtin_amdgcn_s_sleep(1);
    if ((++sp & 255u) == 0u) { if (xb_ld(&bar[XB_TMO])) break; if (sp > XB_SPIN_CAP) { atomicAdd(&bar[XB_TMO], 1u); break; } }
  }
  nloc = mine > 0u ? mine : 1u; nx = cnt > 0u ? cnt : 1u;
}
__device__ __forceinline__ void xcd_barrier(const XcdBarrier& b, int wave) {
  asm volatile("s_waitcnt vmcnt(0)" ::: "memory");
  __syncthreads();
  if (opaque_tid512(wave) == 0) {
    unsigned* bar = b.bar;
    __builtin_amdgcn_s_waitcnt(0);
    unsigned nloc = b.st[0], nx = b.st[1];
    if (nloc == 0u) { xcd_barrier_complete(bar, b.x, nloc, nx); b.st[0] = nloc; b.st[1] = nx; }
    const unsigned old = xb_add(&bar[XB_XSUB(b.x)], 1u);
    const unsigned gen = old / nloc;
    if (old + 1u == (gen + 1u) * nloc) {
      __builtin_amdgcn_fence(__ATOMIC_RELEASE, "agent");
      asm volatile("s_waitcnt vmcnt(0)" ::: "memory");
      const unsigned og = xb_add(&bar[XB_TOP], 1u);
      const unsigned tg = og / nx;
      if (og + 1u == (tg + 1u) * nx) xb_add(&bar[XB_TOPGEN], 1u);
      else XB_SPIN(xb_ld(&bar[XB_TOPGEN]) == tg, bar);
      __builtin_amdgcn_fence(__ATOMIC_ACQUIRE, "agent");
      xb_add(&bar[XB_XGEN(b.x)], 1u);
      asm volatile("s_waitcnt vmcnt(0)" ::: "memory");
    } else {
      XB_SPIN(xb_ld(&bar[XB_XGEN(b.x)]) == gen, bar);
      __builtin_amdgcn_fence(__ATOMIC_ACQUIRE, "agent");
      asm volatile("s_waitcnt vmcnt(0)" ::: "memory");
    }
  }
  __syncthreads();
}


__device__ __forceinline__ int opaque_s(int x) { asm volatile("" : "+s"(x)); return x; }

__device__ __forceinline__ float shfl_idx_f(float v, int src) { return __int_as_float(__builtin_amdgcn_ds_bpermute(src << 2, __float_as_int(v))); }
__device__ __forceinline__ float shfl_xor_f(float v, int off, int lane) { return shfl_idx_f(v, lane ^ off); }

__device__ __forceinline__ float wave_incl_scan(float v) {
#define DPP_ADD(ctrl, rmask) v += __int_as_float(__builtin_amdgcn_update_dpp(0, __float_as_int(v), ctrl, rmask, 0xf, false))
  DPP_ADD(0x111, 0xf); DPP_ADD(0x112, 0xf); DPP_ADD(0x114, 0xf); DPP_ADD(0x118, 0xf);
  DPP_ADD(0x142, 0xa); DPP_ADD(0x143, 0xc);
#undef DPP_ADD
  return v;
}

struct TokInfo { int s, l, L, base, mrow; };
__device__ __forceinline__ TokInfo tokinfo(int tok) {
  TokInfo t;
  if (tok < T_CTX) { t.s = tok >> 8; t.l = tok & 255; t.L = 256; t.base = tok & ~255; t.mrow = 0; }
  else { int u = tok - T_CTX; t.s = 32 + (u >> 12); t.l = u & 4095; t.L = 4096; t.base = T_CTX + (u & ~4095); t.mrow = 1 + (u >> 12); }
  return t;
}
__device__ __forceinline__ int seqpos2off(int pos, bool cm) { return cm ? (((pos & 63) << 6) | (pos >> 6)) : pos; }

struct Params {
  const float *x_prompt, *x_sample, *state_ssd, *state_lru, *c, *c_ctx, *mod_w, *mod_b, *ln_g, *ln_b;
  const float *ssd_in_w, *ssd_conv_w, *ssd_conv_b, *ssd_dt_bias, *ssd_a_log, *ssd_d, *ssd_norm_g, *ssd_out_w;
  const float *hy_in_w, *hy_conv_w, *hy_conv_b, *hy_f_w1, *hy_f_b1, *hy_f_w2, *hy_f_b2, *hy_f_w3, *hy_f_freq, *hy_f_bias, *hy_out_w;
  const float *lru_in_w, *lru_conv_w, *lru_conv_b, *lru_gate_w, *lru_gate_b, *lru_a_param, *lru_out_w;
  float *xres, *out_ssd, *out_lru;
  bf16_t *wt_ssd_in, *wt_ssd_out, *wt_hy_in, *wt_hy_out, *wt_lru_in, *wt_lru_out, *wt_lru_gate;
  float *modv;
  float *hdn2;
  bf16_t *rtab0;
  bf16_t *rtab1;
  float *knorm;
  bf16_t *hbuf;
  float *rstd;
  bf16_t *resb;
  float *lru_agg;
  float *lru_hin;
  float *lru_sagg;
  unsigned char *scratch;
  unsigned *bar;
};

#define SC_SSD_Z     ((size_t)0)
#define SC_SSD_XBC   ((size_t)T_ALL * 2048 * 2)
#define SC_SSD_XBCC  (SC_SSD_XBC + (size_t)T_ALL * 4096 * 2)
#define SC_SSD_DT    (SC_SSD_XBCC + (size_t)T_ALL * 2048 * 2)
#define SC_SSD_XT    (SC_SSD_DT + (size_t)T_ALL * 64 * 4)
#define SC_SSD_BT    (SC_SSD_XT + (size_t)T_ALL * 2048 * 2)
#define SC_SSD_BF    (SC_SSD_BT + (size_t)T_ALL * 1024 * 2)
#define SC_SSD_CF    (SC_SSD_BF + (size_t)T_ALL * 1024 * 2)
#define SC_SSD_END   (SC_SSD_CF + (size_t)T_ALL * 1024 * 2)
#define SC_HY_PROJT  ((size_t)0)
#define SC_HY_YT     ((size_t)T_ALL * 4096 * 2)
#define SC_HY_YG     (SC_HY_YT + (size_t)T_ALL * 1024 * 2)
#define SC_LRU_PROJ  ((size_t)0)
#define SC_LRU_XC    ((size_t)T_ALL * 2048 * 2)
#define SC_LRU_GATES (SC_LRU_XC + (size_t)T_ALL * 1024 * 2)
#define SC_LRU_Y     (SC_LRU_GATES + (size_t)T_ALL * 4096 * 2)
#define SC_LRU_YG    (SC_LRU_Y + (size_t)T_ALL * 2048 * 2)
#define SC_TOTAL     SC_SSD_END

__device__ __forceinline__ void transpose_tile(const float* __restrict__ src, int ld_src, int n_src, bf16_t* __restrict__ dst, int K,
                               const float* __restrict__ scale, int tile, int tiles_k, float* tl, int cxw) {
  const int tidx = opaque_tid(cxw);
  int tk = tile % tiles_k, tn = tile / tiles_k;
  int k0 = tk * 64, n0 = tn * 64;
  __syncthreads();
  {
    const int c4 = (tidx & 15) * 4, r0 = tidx >> 4;
#pragma unroll
    for (int ps = 0; ps < 4; ++ps) {
      const int r = r0 + ps * 16;
      f32x4 v = {0.f, 0.f, 0.f, 0.f};
      if (n0 + c4 < n_src) v = *(const f32x4*)(src + (size_t)(k0 + r) * ld_src + n0 + c4);
      if (scale) { const float sc = scale[k0 + r]; v.x *= sc; v.y *= sc; v.z *= sc; v.w *= sc; }
      tl[r * 65 + c4] = v.x; tl[r * 65 + c4 + 1] = v.y; tl[r * 65 + c4 + 2] = v.z; tl[r * 65 + c4 + 3] = v.w;
    }
  }
  __syncthreads();
  {
    const int n = tidx >> 2, kq = (tidx & 3) * 16;
    unsigned w[8];
#pragma unroll
    for (int e = 0; e < 8; ++e) w[e] = pack2(tl[(kq + 2 * e) * 65 + n], tl[(kq + 2 * e + 1) * 65 + n]);
    u32x4 o0, o1; o0.x = w[0]; o0.y = w[1]; o0.z = w[2]; o0.w = w[3]; o1.x = w[4]; o1.y = w[5]; o1.z = w[6]; o1.w = w[7];
    bf16_t* dp = dst + (size_t)(n0 + n) * K + k0 + kq;
    *(u32x4*)dp = o0; *(u32x4*)(dp + 8) = o1;
  }
}

__device__ __forceinline__ void phase_prep(const Params& p, int bid, int nblk, unsigned char* smem, int cxw) {
  const int tidx = opaque_tid(cxw);
  float* tl = (float*)smem;
  for (int job = 0; job < 24; ++job) {
    const float* src; int ld, nsrc, K, npad; bf16_t* dst; const float* scale = nullptr;
    if (job < 2) { src = p.ssd_in_w + (size_t)job * 1024 * 6208; ld = 6208; nsrc = 6208; K = 1024; npad = 6400; dst = p.wt_ssd_in + (size_t)job * 6400 * 1024; }
    else if (job < 4) { int s = job - 2; src = p.ssd_out_w + (size_t)s * 2048 * 1024; ld = 1024; nsrc = 1024; K = 2048; npad = 1024; dst = p.wt_ssd_out + (size_t)s * 1024 * 2048; scale = p.ssd_norm_g + s * 2048; }
    else if (job == 4) { src = p.hy_in_w; ld = 4096; nsrc = 4096; K = 1024; npad = 4096; dst = p.wt_hy_in; }
    else if (job == 5) { src = p.hy_out_w; ld = 1024; nsrc = 1024; K = 1024; npad = 1024; dst = p.wt_hy_out; }
    else if (job == 6) { src = p.lru_in_w; ld = 2048; nsrc = 2048; K = 1024; npad = 2048; dst = p.wt_lru_in; }
    else if (job == 7) { src = p.lru_out_w; ld = 1024; nsrc = 1024; K = 1024; npad = 1024; dst = p.wt_lru_out; }
    else { int q = job - 8; int dg = q >> 2, n = q & 3;
      src = p.lru_gate_w + (size_t)(dg * 4 + n) * 65536; ld = 256; nsrc = 256; K = 256; npad = 256;
      dst = p.wt_lru_gate + (size_t)n * 1024 * 256 + (size_t)dg * 256 * 256; }
    int tiles_k = K / 64, tiles = tiles_k * (npad / 64);
    for (int t = bid; t < tiles; t += nblk) transpose_tile(src, ld, nsrc, dst, K, scale, t, tiles_k, tl, cxw);
  }
  for (int i = bid * NTHR + tidx; i < 2 * 2 * 1024; i += nblk * NTHR) p.knorm[i] = 0.f;
}

__device__ __forceinline__ void phase_mod(const Params& p, int bid, int nblk, unsigned char* smem, int cxw) {
  const int tidx = opaque_tid(cxw);
  float* sc = (float*)smem;
  float* red = sc + 5 * 1024;
  __syncthreads();
  for (int i = tidx; i < 5 * 1024; i += NTHR) {
    int r = i >> 10, k = i & 1023;
    float v = (r == 0) ? p.c_ctx[k] : p.c[(r - 1) * 1024 + k];
    sc[i] = siluf(v);
  }
  __syncthreads();
  const int cj = tidx & 31, kg = tidx >> 5;
  for (int item = bid; item < 4 * 96; item += nblk) {
    const int layer = item / 96, j = (item % 96) * 32 + cj;
    const float* w = p.mod_w + (size_t)layer * 1024 * 3072 + (size_t)kg * 128 * 3072 + j;
    const float* s0 = sc + kg * 128;
    float a0 = 0, a1 = 0, a2 = 0, a3 = 0, a4 = 0;
#pragma unroll 8
    for (int k = 0; k < 128; ++k) {
      float wv = w[(size_t)k * 3072];
      a0 += s0[k] * wv; a1 += s0[1024 + k] * wv; a2 += s0[2048 + k] * wv; a3 += s0[3072 + k] * wv; a4 += s0[4096 + k] * wv;
    }
    __syncthreads();
    red[(kg * 5 + 0) * 32 + cj] = a0; red[(kg * 5 + 1) * 32 + cj] = a1; red[(kg * 5 + 2) * 32 + cj] = a2;
    red[(kg * 5 + 3) * 32 + cj] = a3; red[(kg * 5 + 4) * 32 + cj] = a4;
    __syncthreads();
    if (tidx < 160) {
      const int rr = tidx >> 5, cc = tidx & 31;
      float sum = 0.f;
#pragma unroll
      for (int g8 = 0; g8 < 8; ++g8) sum += red[(g8 * 5 + rr) * 32 + cc];
      const int jj = (item % 96) * 32 + cc;
      p.modv[((size_t)layer * 5 + rr) * 3072 + jj] = sum + p.mod_b[layer * 3072 + jj];
    }
  }
}

__device__ __forceinline__ void phase_hyfilt_a(const Params& p, int bid, int nblk, unsigned char* smem, int cxw) {
  const int tidx = opaque_tid(cxw);
  float* sz = (float*)smem;
  float* sh = sz + 4 * 36;
  int pl = tidx >> 6, m = tidx & 63;
  for (int item = bid; item < 4352 / 4; item += nblk) {
    int pos = item * 4 + pl;
    int L = pos < 256 ? 256 : 4096;
    int l = pos < 256 ? pos : pos - 256;
    __syncthreads();
    if (m < 33) {
      float t = (float)l / (float)L;
      float w = (6.283185307179586f * (float)l) / (float)L;
      float v;
      if (m == 0) v = t;
      else {
        int j = (m - 1) & 15;
        float fr = 1e-4f + (float)j * ((15.f - 1e-4f) / 15.f);
        float ang = w * fr;
        v = (m <= 16) ? __cosf(ang) : __sinf(ang);
      }
      sz[pl * 36 + m] = v;
    }
    __syncthreads();
    float a = p.hy_f_b1[m];
    for (int e = 0; e < 33; ++e) a += sz[pl * 36 + e] * p.hy_f_w1[e * 64 + m];
    a = __sinf(p.hy_f_freq[m] * a);
    sh[pl * 64 + m] = a;
    __syncthreads();
    float b = p.hy_f_b2[m];
    for (int e = 0; e < 64; ++e) b += sh[pl * 64 + e] * p.hy_f_w2[e * 64 + m];
    b = __sinf(p.hy_f_freq[64 + m] * b);
    p.hdn2[(size_t)pos * 64 + m] = b;
  }
}

__device__ __forceinline__ void phase_hyfilt_b(const Params& p, int bid, int nblk, unsigned char* smem, int cxw) {
  const int tidx = opaque_tid(cxw);
  const int lane = tidx & 63;
  for (int item = bid; item < 17 * 64; item += nblk) {
    const int lb = item >> 6, chunk = item & 63;
    const int Lsel = lb ? 1 : 0, L = Lsel ? 4096 : 256, RL = Lsel ? 8192 : 512, Lm1 = L - 1;
    const int l = Lsel ? (lb - 1) * 256 + tidx : tidx;
    const int pos = Lsel ? 256 + l : l;
    float hd[64];
#pragma unroll
    for (int m4 = 0; m4 < 16; ++m4) {
      f32x4 v = *(const f32x4*)(p.hdn2 + (size_t)pos * 64 + m4 * 4);
      hd[m4 * 4] = v.x; hd[m4 * 4 + 1] = v.y; hd[m4 * 4 + 2] = v.z; hd[m4 * 4 + 3] = v.w;
    }
    const int odc0 = chunk * 64, o = odc0 >> 11, d = (odc0 >> 10) & 1, c0 = odc0 & 1023;
    const float t = (float)l / (float)L;
    bf16_t* rt = Lsel ? p.rtab1 : p.rtab0;
    const float min_decay = -3.0701134573253945f, max_decay = -15.350567286626973f;
    for (int cc = 0; cc < 64; ++cc) {
      const int c = c0 + cc;
      const float* w3 = p.hy_f_w3 + odc0 + cc;
      float acc = 0.f;
#pragma unroll
      for (int m = 0; m < 64; ++m) acc += hd[m] * w3[(size_t)m * 4096];
      float delta = fabsf(min_decay + (float)c * ((max_decay - min_decay) / 1023.f));
      float kv = acc * expf(-t * delta);
      size_t rb = (size_t)(o * 1024 + c) * RL;
      if (d == 0) rt[rb + Lm1 - l] = f2bf(kv);
      else if (l > 0) rt[rb + Lm1 + l] = f2bf(kv);
      else rt[rb + RL - 1] = 0;
      float a = fabsf(kv);
#pragma unroll
      for (int off = 32; off > 0; off >>= 1) a += shfl_xor_f(a, off, lane);
      if (lane == 0) atomicAdd(&p.knorm[(Lsel * 2 + o) * 1024 + c], a);
    }
  }
}

__device__ __forceinline__ void phase_lnmod(const Params& p, int layer, int bid, int nblk, int cxw) {
  const int tidx = opaque_tid(cxw);
  int lane = tidx & 63, wv = cxw & 3;
  f32x4 vn[4];
#define LNMOD_LOAD(ROW) do { const int row_ = (ROW); \
    if (layer == 0) { const float* src_ = row_ < T_CTX ? p.x_prompt + (size_t)row_ * DM : p.x_sample + (size_t)(row_ - T_CTX) * DM; \
      _Pragma("unroll") for (int j = 0; j < 4; ++j) vn[j] = *(const f32x4*)(src_ + j * 256 + lane * 4); } \
    else { const bf16_t* src_ = p.resb + (size_t)row_ * DM; \
      _Pragma("unroll") for (int j = 0; j < 4; ++j) { const u32x2 w_ = *(const u32x2*)(src_ + j * 256 + lane * 4); \
        vn[j].x = bflo(w_.x); vn[j].y = bfhi(w_.x); vn[j].z = bflo(w_.y); vn[j].w = bfhi(w_.y); } } } while (0)
  if (bid * 4 + wv < T_ALL) LNMOD_LOAD(bid * 4 + wv);
  for (int row = bid * 4 + wv; row < T_ALL; row += nblk * 4) {
    f32x4 v[4];
#pragma unroll
    for (int j = 0; j < 4; ++j) v[j] = vn[j];
    if (row + nblk * 4 < T_ALL) LNMOD_LOAD(row + nblk * 4);
    if (layer > 0) {
      float s = 0.f;
#pragma unroll
      for (int j = 0; j < 4; ++j) s += v[j].x + v[j].y + v[j].z + v[j].w;
#pragma unroll
      for (int o = 32; o > 0; o >>= 1) s += shfl_xor_f(s, o, lane);
      float mu = s * (1.f / 1024.f);
      float q = 0.f;
#pragma unroll
      for (int j = 0; j < 4; ++j) { float a = v[j].x - mu, b = v[j].y - mu, c = v[j].z - mu, d = v[j].w - mu; q += a * a + b * b + c * c + d * d; }
#pragma unroll
      for (int o = 32; o > 0; o >>= 1) q += shfl_xor_f(q, o, lane);
      float rs = rsqrtf(q * (1.f / 1024.f) + LN_EPS);
      const float* g = p.ln_g + (layer - 1) * DM; const float* b = p.ln_b + (layer - 1) * DM;
#pragma unroll
      for (int j = 0; j < 4; ++j) {
        f32x4 gg = *(const f32x4*)(g + j * 256 + lane * 4), bb = *(const f32x4*)(b + j * 256 + lane * 4);
        v[j].x = (v[j].x - mu) * rs * gg.x + bb.x; v[j].y = (v[j].y - mu) * rs * gg.y + bb.y;
        v[j].z = (v[j].z - mu) * rs * gg.z + bb.z; v[j].w = (v[j].w - mu) * rs * gg.w + bb.w;
      }
    }
    if (layer == 4) {
      float* dst = p.xres + (size_t)row * DM;
#pragma unroll
      for (int j = 0; j < 4; ++j) *(f32x4*)(dst + j * 256 + lane * 4) = v[j];
    } else {
      bf16_t* dst = p.resb + (size_t)row * DM;
#pragma unroll
      for (int j = 0; j < 4; ++j) { u32x2 o; o.x = pack2(v[j].x, v[j].y); o.y = pack2(v[j].z, v[j].w); *(u32x2*)(dst + j * 256 + lane * 4) = o; }
    }
    if (layer < 4) {
      int mrow = row < T_CTX ? 0 : 1 + ((row - T_CTX) >> 12);
      const float* mv = p.modv + ((size_t)layer * 5 + mrow) * 3072;
#pragma unroll
      for (int j = 0; j < 4; ++j) {
        f32x4 sh = *(const f32x4*)(mv + j * 256 + lane * 4), sc = *(const f32x4*)(mv + 1024 + j * 256 + lane * 4);
        u32x2 o;
        o.x = pack2(v[j].x * (1.f + sc.x) + sh.x, v[j].y * (1.f + sc.y) + sh.y);
        o.y = pack2(v[j].z * (1.f + sc.z) + sh.z, v[j].w * (1.f + sc.w) + sh.w);
        *(u32x2*)(p.hbuf + (size_t)row * DM + j * 256 + lane * 4) = o;
      }
    }
  }
}

#define PG8_LAS __attribute__((address_space(3)))
namespace pg8 {
constexpr int BM = 256, BK = 64, HALF = 128, HTB = HALF * BK * 2, STAGE_BYTES = 8 * HTB, NXCD = 8, WGM = 8;
__device__ __forceinline__ int lds_byte(int r, int c) { const int st = (r >> 4) * 2 + (c >> 5), rr = r & 15, cc = c & 31, ob = rr * 64 + cc * 2; return st * 1024 + (ob ^ (((ob >> 9) & 1) << 5)); }
__device__ __forceinline__ void stage_rc(int b, int& R, int& C) { const int st = b / 1024, sb = b % 1024, swz = sb ^ (((sb >> 9) & 1) << 5); R = (st >> 1) * 16 + swz / 64; C = (st & 1) * 32 + (swz % 64) / 2; }
__device__ __forceinline__ int perm32(int rho) { const int n = rho >> 4, i = rho & 15; return 8 * (i >> 2) + 4 * n + (i & 3); }
struct Unit { int pm, pn; };
struct Gemm { const bf16_t* A; const bf16_t* Bt; int M, N, K, lda; int a_grp_shift; int a_grp_bytes; };
struct StaticOrder {
  int nM, nN, nwg, G, c;
  __device__ void init(int M, int N, int G_, int c_) { nM = M / BM; nN = N / BM; nwg = nM * nN; G = G_; c = c_; }
  __device__ bool next(int i, Unit& u) const {
    const long L = (long)i * G + c; if (L >= nwg) return false;
    int wgid = (int)L; { const int q = nwg / NXCD, r = nwg % NXCD, xcd = wgid % NXCD, off = wgid / NXCD; wgid = (xcd < r ? xcd * (q + 1) : r * (q + 1) + (xcd - r) * q) + off; }
    const int nig = WGM * nN, gid = wgid / nig, fm = gid * WGM, gsz = (nM - fm) < WGM ? (nM - fm) : WGM;
    u.pm = fm + ((wgid % nig) % gsz); u.pn = (wgid % nig) / gsz; return true;
  }
};
__device__ __forceinline__ unsigned cvt_pk_bf16(float lo, float hi) { return pack2(lo, hi); }

template <class Epi>
__device__ __forceinline__ void gemm_phase(PG8_LAS unsigned char* lds, const Gemm g, const StaticOrder& S, const Epi& E, int wave) {
  const int tid = opaque_tid512(wave), wid = wave, lane = tid & 63, wr = wid >> 2, wc = wid & 3, fr = lane & 15, fq = lane >> 4;
  const int K = g.K, nt = K / BK, lda = g.lda;
  unsigned voffA[2], voffB[2];
#pragma unroll
  for (int i = 0; i < 2; ++i) { int R, C; stage_rc(tid * 16 + i * 8192, R, C); const int Rb = Epi::PERM ? ((R & ~31) + perm32(R & 31)) : R;
    voffA[i] = (unsigned)(R * lda + C) * 2u; voffB[i] = (unsigned)(Rb * K + C) * 2u; }
  const size_t kstep = (size_t)(BK * 2);
  const size_t hstepA = (size_t)HALF * lda * 2, hstepB = (size_t)HALF * K * 2;
  const size_t tstepA = 2 * hstepA, tstepB = 2 * hstepB;
  const unsigned ldsw = (unsigned)wid * 1024u;
  const int aoff = lds_byte(wr * 64 + fr, fq * 8), boff = lds_byte(wc * 32 + fr, fq * 8);
#define PG8_SA(b, h) (((b) * 2 + (h)) * HTB)
#define PG8_SB(b, h) ((4 + (b) * 2 + (h)) * HTB)
#define PG8_STAGE(bufoff, gbase, voff) do { _Pragma("unroll") for (int _i = 0; _i < 2; ++_i) \
    __builtin_amdgcn_global_load_lds((const unsigned*)((const char*)(gbase) + (voff)[_i]), (PG8_LAS unsigned*)(lds + (bufoff) + ldsw + _i * 8192), 16, 0, 0); } while (0)
#define PG8_LDA(dst, b, h) do { _Pragma("unroll") for (int m = 0; m < 4; ++m) _Pragma("unroll") for (int k = 0; k < 2; ++k) dst[m][k] = *(const PG8_LAS bf16x8*)(lds + PG8_SA(b, h) + aoff + m * 2048 + k * 1024); } while (0)
#define PG8_LDB(dst, b, h) do { _Pragma("unroll") for (int n = 0; n < 2; ++n) _Pragma("unroll") for (int k = 0; k < 2; ++k) dst[n][k] = *(const PG8_LAS bf16x8*)(lds + PG8_SB(b, h) + boff + n * 2048 + k * 1024); } while (0)
#define PG8_MMA(ai, bj, At, Bt) do { __builtin_amdgcn_s_setprio(1); _Pragma("unroll") for (int m = 0; m < 4; ++m) _Pragma("unroll") for (int n = 0; n < 2; ++n) _Pragma("unroll") for (int k = 0; k < 2; ++k) \
    acc[ai][bj][m][n] = __builtin_amdgcn_mfma_f32_16x16x32_bf16(Bt[n][k], At[m][k], acc[ai][bj][m][n], 0, 0, 0); __builtin_amdgcn_s_setprio(0); } while (0)
#define PG8_WAIT_V(n) asm volatile("s_waitcnt vmcnt(" #n ")" ::: "memory")
#define PG8_WAIT_L(n) asm volatile("s_waitcnt lgkmcnt(" #n ")" ::: "memory")
#define PG8_BAR __builtin_amdgcn_s_barrier()
#define PG8_SCHED __builtin_amdgcn_sched_barrier(0)
#define PG8_APTR(u) ((const char*)g.A + (size_t)(u).pm * tstepA + (size_t)(((u).pn >> g.a_grp_shift) * g.a_grp_bytes))
  Unit cur, nxt; int ui = 0;
  if (!S.next(0, cur)) return;
  f32x4 acc[2][2][4][2];
#pragma unroll
  for (int a = 0; a < 2; ++a)
#pragma unroll
    for (int b = 0; b < 2; ++b)
#pragma unroll
      for (int m = 0; m < 4; ++m)
#pragma unroll
        for (int n = 0; n < 2; ++n) acc[a][b][m][n] = (f32x4){0.f, 0.f, 0.f, 0.f};
  bf16x8 At[4][2], B0[2][2], B1[2][2];
  const char* cA = PG8_APTR(cur); const char* cB = (const char*)g.Bt + (size_t)cur.pn * tstepB;
  PG8_STAGE(PG8_SB(0, 0), cB, voffB); PG8_STAGE(PG8_SA(0, 0), cA, voffA); PG8_STAGE(PG8_SB(0, 1), cB + hstepB, voffB); PG8_STAGE(PG8_SA(0, 1), cA + hstepA, voffA);
  if (wr == 1) PG8_BAR;
  PG8_WAIT_V(4); PG8_BAR;
  PG8_STAGE(PG8_SB(1, 0), cB + kstep, voffB); PG8_STAGE(PG8_SA(1, 0), cA + kstep, voffA); PG8_STAGE(PG8_SB(1, 1), cB + hstepB + kstep, voffB);
  PG8_WAIT_V(6); PG8_BAR;
  for (;;) {
    const bool has_next = S.next(ui + 1, nxt);
    const char* nA = has_next ? PG8_APTR(nxt) : cA; const char* nB = has_next ? (const char*)g.Bt + (size_t)nxt.pn * tstepB : cB;
    for (int t = 0; t < nt; t += 2) {
      const bool last = (t == nt - 2);
      const char* a1 = cA + (size_t)(t + 1) * kstep;
      const char* a2 = last ? nA : cA + (size_t)(t + 2) * kstep; const char* b2 = last ? nB : cB + (size_t)(t + 2) * kstep;
      const char* a3 = a2 + kstep; const char* b3 = b2 + kstep;
      PG8_LDB(B0, 0, 0); PG8_SCHED; PG8_LDA(At, 0, 0); PG8_STAGE(PG8_SA(1, 1), a1 + hstepA, voffA);
      PG8_WAIT_L(8); PG8_BAR; PG8_WAIT_L(0); PG8_MMA(0, 0, At, B0); PG8_BAR; PG8_SCHED;
      PG8_LDB(B1, 0, 1); PG8_STAGE(PG8_SB(0, 0), b2, voffB);
      PG8_BAR; PG8_WAIT_L(0); PG8_MMA(0, 1, At, B1); PG8_BAR;
      PG8_LDA(At, 0, 1); PG8_STAGE(PG8_SA(0, 0), a2, voffA);
      PG8_BAR; PG8_WAIT_L(0); PG8_MMA(1, 0, At, B0); PG8_BAR; PG8_SCHED;
      PG8_STAGE(PG8_SB(0, 1), b2 + hstepB, voffB);
      PG8_WAIT_V(6); PG8_BAR; PG8_MMA(1, 1, At, B1); PG8_BAR;
      PG8_LDB(B0, 1, 0); PG8_SCHED; PG8_LDA(At, 1, 0); PG8_STAGE(PG8_SA(0, 1), a2 + hstepA, voffA);
      PG8_WAIT_L(8); PG8_BAR; PG8_WAIT_L(0); PG8_MMA(0, 0, At, B0); PG8_BAR; PG8_SCHED;
      PG8_LDB(B1, 1, 1); PG8_STAGE(PG8_SB(1, 0), b3, voffB);
      PG8_BAR; PG8_WAIT_L(0); PG8_MMA(0, 1, At, B1); PG8_BAR;
      PG8_LDA(At, 1, 1); PG8_STAGE(PG8_SA(1, 0), a3, voffA);
      PG8_BAR; PG8_WAIT_L(0); PG8_MMA(1, 0, At, B0); PG8_BAR; PG8_SCHED;
      PG8_STAGE(PG8_SB(1, 1), b3 + hstepB, voffB);
      PG8_WAIT_V(6); PG8_BAR; PG8_MMA(1, 1, At, B1); PG8_BAR;
    }
    { const int lane2 = opaque_lane();
      E(acc, cur, wr, wc, lane2 & 15, lane2 >> 4); }
    if (!has_next) break;
#pragma unroll
    for (int a = 0; a < 2; ++a)
#pragma unroll
      for (int b = 0; b < 2; ++b)
#pragma unroll
        for (int m = 0; m < 4; ++m)
#pragma unroll
          for (int n = 0; n < 2; ++n) acc[a][b][m][n] = (f32x4){0.f, 0.f, 0.f, 0.f};
    cur = nxt; cA = nA; cB = nB; ++ui;
  }
  PG8_WAIT_V(0);
  if (wr == 0) PG8_BAR;
  PG8_BAR;
#undef PG8_SA
#undef PG8_SB
#undef PG8_STAGE
#undef PG8_LDA
#undef PG8_LDB
#undef PG8_MMA
#undef PG8_WAIT_V
#undef PG8_WAIT_L
#undef PG8_BAR
#undef PG8_SCHED
#undef PG8_APTR
}

struct EpiBf16 {
  static constexpr bool PERM = true;
  bf16_t* O; size_t ldc;
  __device__ __forceinline__ void operator()(const f32x4 (&acc)[2][2][4][2], const Unit& u, int wr, int wc, int fr, int fq) const {
    const int row0 = u.pm * BM + wr * 64 + fr, col0 = u.pn * BM + wc * 32 + 8 * fq;
#pragma unroll
    for (int ai = 0; ai < 2; ++ai)
#pragma unroll
      for (int m = 0; m < 4; ++m) {
        bf16_t* rowp = O + (size_t)(row0 + ai * HALF + m * 16) * ldc + col0;
#pragma unroll
        for (int bj = 0; bj < 2; ++bj) {
          const f32x4 v0 = acc[ai][bj][m][0], v1 = acc[ai][bj][m][1];
          u32x4 w; w.x = pack2(v0[0], v0[1]); w.y = pack2(v0[2], v0[3]); w.z = pack2(v1[0], v1[1]); w.w = pack2(v1[2], v1[3]);
          *(u32x4*)(rowp + bj * HALF) = w;
        }
      }
  }
};
struct EpiSsdIn {
  static constexpr bool PERM = true;
  bf16_t* z; bf16_t* xbc; float* dt; const float* dt_bias;
  __device__ __forceinline__ void operator()(const f32x4 (&acc)[2][2][4][2], const Unit& u, int wr, int wc, int fr, int fq) const {
    const int row0 = u.pm * BM + wr * 64 + fr, colt = u.pn * BM + wc * 32 + 8 * fq;
    if (u.pn < 24) {
      bf16_t* base = u.pn < 8 ? z : xbc; const size_t ldc = u.pn < 8 ? 2048 : 4096; const int col0 = u.pn < 8 ? colt : colt - 2048;
#pragma unroll
      for (int ai = 0; ai < 2; ++ai)
#pragma unroll
        for (int m = 0; m < 4; ++m) {
          bf16_t* rowp = base + (size_t)(row0 + ai * HALF + m * 16) * ldc + col0;
#pragma unroll
          for (int bj = 0; bj < 2; ++bj) {
            const f32x4 v0 = acc[ai][bj][m][0], v1 = acc[ai][bj][m][1];
            u32x4 w; w.x = pack2(v0[0], v0[1]); w.y = pack2(v0[2], v0[3]); w.z = pack2(v1[0], v1[1]); w.w = pack2(v1[2], v1[3]);
            *(u32x4*)(rowp + bj * HALF) = w;
          }
        }
    } else {
      const int c0 = wc * 32 + 8 * fq;
      if (c0 < 64) {
#pragma unroll
        for (int ai = 0; ai < 2; ++ai)
#pragma unroll
          for (int m = 0; m < 4; ++m) {
            float* rowp = dt + (size_t)(row0 + ai * HALF + m * 16) * 64 + c0;
#pragma unroll
            for (int n = 0; n < 2; ++n) {
              const f32x4 v = acc[ai][0][m][n];
              f32x4 o;
#pragma unroll
              for (int e = 0; e < 4; ++e) o[e] = softplusf(v[e] + dt_bias[c0 + 4 * n + e]);
              *(f32x4*)(rowp + 4 * n) = o;
            }
          }
      }
    }
  }
};
struct EpiOut {
  static constexpr bool PERM = true;
  bf16_t* res; const float* modv_layer; const float* rstd;
  __device__ __forceinline__ void operator()(const f32x4 (&acc)[2][2][4][2], const Unit& u, int wr, int wc, int fr, int fq) const {
    const int row0 = u.pm * BM + wr * 64 + fr, col0 = u.pn * BM + wc * 32 + 8 * fq;
#pragma unroll
    for (int ai = 0; ai < 2; ++ai)
#pragma unroll
      for (int m = 0; m < 4; ++m) {
        const int row = row0 + ai * HALF + m * 16;
        const int mrow = row < T_CTX ? 0 : 1 + ((row - T_CTX) >> 12);
        const float rs = rstd ? rstd[row] : 1.f;
        const float* gp = modv_layer + (size_t)mrow * 3072 + 2048 + col0;
        bf16_t* rowp = res + (size_t)row * DM + col0;
#pragma unroll
        for (int bj = 0; bj < 2; ++bj) {
          const f32x4 g0 = *(const f32x4*)(gp + bj * HALF), g1 = *(const f32x4*)(gp + bj * HALF + 4);
          const u32x4 xw = *(const u32x4*)(rowp + bj * HALF);
          const f32x4 v0 = acc[ai][bj][m][0], v1 = acc[ai][bj][m][1];
          u32x4 o;
          o.x = pack2(ALPHA_RES * bflo(xw.x) + g0.x * (v0[0] * rs), ALPHA_RES * bfhi(xw.x) + g0.y * (v0[1] * rs));
          o.y = pack2(ALPHA_RES * bflo(xw.y) + g0.z * (v0[2] * rs), ALPHA_RES * bfhi(xw.y) + g0.w * (v0[3] * rs));
          o.z = pack2(ALPHA_RES * bflo(xw.z) + g1.x * (v1[0] * rs), ALPHA_RES * bfhi(xw.z) + g1.y * (v1[1] * rs));
          o.w = pack2(ALPHA_RES * bflo(xw.w) + g1.z * (v1[2] * rs), ALPHA_RES * bfhi(xw.w) + g1.w * (v1[3] * rs));
          *(u32x4*)(rowp + bj * HALF) = o;
        }
      }
  }
};
struct EpiLruGate {
  static constexpr bool PERM = true;
  bf16_t* gates; const float* gate_b;
  __device__ __forceinline__ void operator()(const f32x4 (&acc)[2][2][4][2], const Unit& u, int wr, int wc, int fr, int fq) const {
    const int nb = u.pn >> 2, dg = u.pn & 3;
    const int row0 = u.pm * BM + wr * 64 + fr, ch0 = nb * 256 + wc * 32 + 8 * fq;
#pragma unroll
    for (int ai = 0; ai < 2; ++ai)
#pragma unroll
      for (int m = 0; m < 4; ++m) {
        bf16_t* rowp = gates + ((size_t)dg * T_ALL + row0 + ai * HALF + m * 16) * 1024 + ch0;
#pragma unroll
        for (int bj = 0; bj < 2; ++bj) {
          const float* bp = gate_b + dg * 1024 + ch0 + bj * HALF;
          const f32x4 b0 = *(const f32x4*)bp, b1 = *(const f32x4*)(bp + 4);
          const f32x4 v0 = acc[ai][bj][m][0] + b0, v1 = acc[ai][bj][m][1] + b1;
          u32x4 w; w.x = pack2(sigmoidf(v0[0]), sigmoidf(v0[1])); w.y = pack2(sigmoidf(v0[2]), sigmoidf(v0[3]));
          w.z = pack2(sigmoidf(v1[0]), sigmoidf(v1[1])); w.w = pack2(sigmoidf(v1[2]), sigmoidf(v1[3]));
          *(u32x4*)(rowp + bj * HALF) = w;
        }
      }
  }
};
}

template <int KW, bool SILU>
__device__ __forceinline__ void phase_dwconv(const bf16_t* __restrict__ src, int ld_src, bf16_t* __restrict__ dst, int ld_dst, int CH,
                             const float* __restrict__ w, const float* __restrict__ b, bool colmajor, int bid, int nblk, int cxw) {
  const int tidx = opaque_tid(cxw);
  const int cpr = CH / 8;
  const size_t total = (size_t)T_ALL * cpr;
  for (size_t idx = (size_t)bid * NTHR + tidx; idx < total; idx += (size_t)nblk * NTHR) {
    int tok = (int)(idx / cpr), c0 = (int)(idx % cpr) * 8;
    TokInfo ti = tokinfo(tok);
    bool cm = colmajor && ti.s >= 32;
    int pos = seqpos2off(ti.l, cm);
    float acc[8];
#pragma unroll
    for (int e = 0; e < 8; ++e) acc[e] = b[c0 + e];
#pragma unroll
    for (int k = 0; k < KW; ++k) {
      int pp = pos + k - 1;
      if (pp < 0 || pp >= ti.L) continue;
      int tk = ti.base + seqpos2off(pp, cm);
      u32x4 xv = *(const u32x4*)(src + (size_t)tk * ld_src + c0);
      const float* wk = w + (size_t)k * CH + c0;
      acc[0] += wk[0] * bflo(xv.x); acc[1] += wk[1] * bfhi(xv.x);
      acc[2] += wk[2] * bflo(xv.y); acc[3] += wk[3] * bfhi(xv.y);
      acc[4] += wk[4] * bflo(xv.z); acc[5] += wk[5] * bfhi(xv.z);
      acc[6] += wk[6] * bflo(xv.w); acc[7] += wk[7] * bfhi(xv.w);
    }
    if (SILU) {
#pragma unroll
      for (int e = 0; e < 8; ++e) acc[e] = siluf(acc[e]);
    }
    u32x4 o;
    o.x = pack2(acc[0], acc[1]); o.y = pack2(acc[2], acc[3]); o.z = pack2(acc[4], acc[5]); o.w = pack2(acc[6], acc[7]);
    *(u32x4*)(dst + (size_t)tok * ld_dst + c0) = o;
  }
}

__device__ __forceinline__ void phase_ssd_conv(const Params& p, int slot, bool colmajor, int bid, int nblk, unsigned char* smem, int cxw) {
  const int tid = opaque_tid(cxw);
  const bf16_t* raw = (const bf16_t*)(p.scratch + SC_SSD_XBC);
  bf16_t* out = (bf16_t*)(p.scratch + SC_SSD_XBCC);
  bf16_t* XT = (bf16_t*)(p.scratch + SC_SSD_XT);
  bf16_t* BT = (bf16_t*)(p.scratch + SC_SSD_BT);
  bf16_t* BF = (bf16_t*)(p.scratch + SC_SSD_BF);
  bf16_t* CF = (bf16_t*)(p.scratch + SC_SSD_CF);
  const float* cw = p.ssd_conv_w + (size_t)slot * 4 * 4096;
  const float* cb = p.ssd_conv_b + slot * 4096;
  bf16_t* tl = (bf16_t*)smem;
  bf16_t* rt = tl + 64 * 72;
  const int rr = tid >> 2, cpart = tid & 3;
  const int NITEMS = 384 * 64;
  u32x4 pre[3];
#define CONV_PREFETCH(ITEM) do { const int it_ = (ITEM); const int ptile_ = it_ >> 6, ct_ = it_ & 63; \
    const TokInfo ti_ = tokinfo(ptile_ * 64); const bool cm_ = colmajor && ti_.s >= 32; \
    _Pragma("unroll") for (int i_ = 0; i_ < 3; ++i_) { const int q_ = tid + i_ * 256; const int row_ = q_ >> 3, c8_ = (q_ & 7) * 8; \
      const int pp_ = ti_.l - 1 + row_; u32x4 v_ = {0u, 0u, 0u, 0u}; \
      if (row_ < 67 && pp_ >= 0 && pp_ < ti_.L) v_ = *(const u32x4*)(raw + (size_t)(ti_.base + seqpos2off(pp_, cm_)) * 4096 + ct_ * 64 + c8_); \
      pre[i_] = v_; } } while (0)
  if (bid < NITEMS) CONV_PREFETCH(bid);
  for (int item = bid; item < NITEMS; item += nblk) {
    const int ptile = item >> 6, ct = item & 63;
    const int ptok0 = ptile * 64;
    const int ch = ct * 64 + cpart * 16;
    __syncthreads();
#pragma unroll
    for (int i = 0; i < 3; ++i) { const int q = tid + i * 256; if (q < 67 * 8) *(u32x4*)(rt + (q >> 3) * 72 + (q & 7) * 8) = pre[i]; }
    if (item + nblk < NITEMS) CONV_PREFETCH(item + nblk);
    __syncthreads();
    float acc[16];
#pragma unroll
    for (int e = 0; e < 16; ++e) acc[e] = cb[ch + e];
#pragma unroll
    for (int k = 0; k < 4; ++k) {
      const bf16_t* rp = rt + (rr + k) * 72 + cpart * 16;
      u32x4 x0 = *(const u32x4*)rp, x1 = *(const u32x4*)(rp + 8);
      const float* wk = cw + (size_t)k * 4096 + ch;
      unsigned xw[8] = {x0.x, x0.y, x0.z, x0.w, x1.x, x1.y, x1.z, x1.w};
#pragma unroll
      for (int e = 0; e < 8; ++e) { acc[2 * e] += wk[2 * e] * bflo(xw[e]); acc[2 * e + 1] += wk[2 * e + 1] * bfhi(xw[e]); }
    }
    u32x4 o0, o1;
    o0.x = pack2(siluf(acc[0]), siluf(acc[1])); o0.y = pack2(siluf(acc[2]), siluf(acc[3]));
    o0.z = pack2(siluf(acc[4]), siluf(acc[5])); o0.w = pack2(siluf(acc[6]), siluf(acc[7]));
    o1.x = pack2(siluf(acc[8]), siluf(acc[9])); o1.y = pack2(siluf(acc[10]), siluf(acc[11]));
    o1.z = pack2(siluf(acc[12]), siluf(acc[13])); o1.w = pack2(siluf(acc[14]), siluf(acc[15]));
    *(u32x4*)(tl + rr * 72 + cpart * 16) = o0;
    *(u32x4*)(tl + rr * 72 + cpart * 16 + 8) = o1;
    __syncthreads();
    if (ct < 32) {
      const int crow = tid >> 2, part = tid & 3;
      unsigned wv[8];
#pragma unroll
      for (int e = 0; e < 8; ++e) {
        unsigned lo = tl[(part * 16 + 2 * e) * 72 + crow], hi = tl[(part * 16 + 2 * e + 1) * 72 + crow];
        wv[e] = lo | (hi << 16);
      }
      bf16_t* dp = XT + (size_t)(ct * 64 + crow) * T_ALL + ptok0 + part * 16;
      u32x4 t0, t1;
      t0.x = wv[0]; t0.y = wv[1]; t0.z = wv[2]; t0.w = wv[3]; t1.x = wv[4]; t1.y = wv[5]; t1.z = wv[6]; t1.w = wv[7];
      *(u32x4*)dp = t0; *(u32x4*)(dp + 8) = t1;
    } else {
      const bool isB = ct < 48;
      const int cq = (ct - (isB ? 32 : 48));
      const int g = cq >> 1, chhalf = cq & 1;
      const int lane = tid & 63, r = lane & 31, hh = lane >> 5;
      bf16_t* F = isB ? BF : CF;
#pragma unroll
      for (int i = 0; i < 2; ++i) {
        const int f = (cxw & 3) + 4 * i;
        const int rt2 = f >> 2, kk4 = f & 3;
        const u32x4 v = *(const u32x4*)(tl + (32 * rt2 + r) * 72 + 16 * kk4 + 8 * hh);
        const size_t rt = (size_t)(ptok0 >> 5) + rt2;
        *(u32x4*)(F + (((rt * 8 + g) * 8 + chhalf * 4 + kk4) * 64 + lane) * 8) = v;
      }
      if (isB) {
#pragma unroll
        for (int i = 0; i < 2; ++i) {
          const int f = (cxw & 3) + 4 * i;
          const int nt2 = f >> 2, ts4 = f & 3;
          unsigned wv[4];
#pragma unroll
          for (int e = 0; e < 4; ++e) {
            unsigned lo = tl[(16 * ts4 + 8 * hh + 2 * e) * 72 + 32 * nt2 + r], hi = tl[(16 * ts4 + 8 * hh + 2 * e + 1) * 72 + 32 * nt2 + r];
            wv[e] = lo | (hi << 16);
          }
          u32x4 v; v.x = wv[0]; v.y = wv[1]; v.z = wv[2]; v.w = wv[3];
          const size_t ts = (size_t)(ptok0 >> 4) + ts4;
          *(u32x4*)(BT + (((ts * 8 + g) * 4 + chhalf * 2 + nt2) * 64 + lane) * 8) = v;
        }
      }
    }
  }
}

#define SH_STRIDE 136
__device__ __forceinline__ int rowmap(int e, int hh) { return (e & 3) + 8 * (e >> 2) + 4 * hh; }
__device__ __forceinline__ bf16x8 pack8(float a0, float a1, float a2, float a3, float a4, float a5, float a6, float a7) {
  u32x4 v; v.x = pack2(a0, a1); v.y = pack2(a2, a3); v.z = pack2(a4, a5); v.w = pack2(a6, a7);
  return __builtin_bit_cast(bf16x8, v);
}
#define SCAN_PRIV 49152
#define SCAN_SF 49152
__device__ __forceinline__ void phase_ssd_scan(const Params& p, int slot, bool colmajor, int bid, int nblk, unsigned char* wg_smem, int cxw) {
  const int tid = opaque_tid(cxw), lane = tid & 63, w = cxw & 3, vb = cxw >> 2, r = lane & 31, hh = lane >> 5;
  const int it = w >> 1, pt = w & 1;
  const bf16_t* XT = (const bf16_t*)(p.scratch + SC_SSD_XT);
  const bf16_t* BT = (const bf16_t*)(p.scratch + SC_SSD_BT);
  const bf16_t* BF = (const bf16_t*)(p.scratch + SC_SSD_BF);
  const bf16_t* CF = (const bf16_t*)(p.scratch + SC_SSD_CF);
  const float* dtb = (const float*)(p.scratch + SC_SSD_DT);
  bf16_t* ybuf = (bf16_t*)(p.scratch + SC_SSD_XBC);
  unsigned char* priv = wg_smem + (vb ? SCAN_SF + SCAN_PRIV : 0);
  bf16_t* sXr = (bf16_t*)priv;
  bf16_t* sXs = sXr + 64 * 72;
  bf16_t* sH = sXs + 64 * 72;
  float* sW = (float*)(sH + 64 * SH_STRIDE);
  bf16_t* sY = (bf16_t*)(sW + 4 * 256);
  float* myW = sW + w * 256;
  const bf16_t* sfC = (const bf16_t*)(wg_smem + SCAN_PRIV);
  const bf16_t* sfB = sfC + 8192;
  const bf16_t* sfT = sfC + 16384;
  for (int item = bid; item < 36 * 64; item += nblk) {
    int s, h, dir;
    {
      const int itx = item < 256 ? item : item - 256;
      const int idx = itx & 63, pairidx = idx >> 1;
      s = item < 256 ? 32 + (itx >> 6) : (itx >> 6);
      dir = pairidx & 1; h = (pairidx >> 1) * 2 + (idx & 1);
    }
    const int L = s < 32 ? 256 : 4096;
    const int base = s < 32 ? s * 256 : T_CTX + (s - 32) * 4096;
    const bool cm = colmajor && s >= 32;
    const int g = h >> 2;
    const float Aval = -expf(p.ssd_a_log[(slot * 2 + dir) * 32 + h]);
    const float dskip = p.ssd_d[slot * 32 + h];
    const int nchunks = L >> 6;
    const int pcol = 32 * pt + r;
    f32x16 hacc[2];
    if (s >= 32) {
      const float* h0 = p.state_ssd + ((((size_t)(s - 32) * 2 + slot) * 2 + dir) * 32 + h) * 8192 + (size_t)pcol * 128;
#pragma unroll
      for (int t2 = 0; t2 < 2; ++t2)
#pragma unroll
        for (int qd = 0; qd < 4; ++qd) {
          f32x4 v = *(const f32x4*)(h0 + 32 * (2 * it + t2) + 8 * qd + 4 * hh);
          hacc[t2][4 * qd] = v.x; hacc[t2][4 * qd + 1] = v.y; hacc[t2][4 * qd + 2] = v.z; hacc[t2][4 * qd + 3] = v.w;
        }
    } else {
#pragma unroll
      for (int t2 = 0; t2 < 2; ++t2)
#pragma unroll
        for (int e = 0; e < 16; ++e) hacc[t2][e] = 0.f;
    }
#define SCAN_PTOK(c) (base + 64 * (dir ? nchunks - 1 - (c) : (c)))
#define SCAN_LOAD_DTX(pt0) do { \
      const int tok_ = base + seqpos2off((pt0) - base + lane, cm); \
      dtv = dtb[(size_t)tok_ * 64 + dir * 32 + h]; \
      _Pragma("unroll") for (int i_ = 0; i_ < 2; ++i_) { const int q_ = tid + i_ * 256; \
        xtr[i_] = *(const u32x4*)(XT + (size_t)(h * 64 + (q_ >> 3)) * T_ALL + (pt0) + (q_ & 7) * 8); } } while (0)
#define SCAN_DMA(pt0) do { \
      _Pragma("unroll") for (int i_ = 0; i_ < 6; ++i_) { const int q_ = cxw + 8 * (i_ & 1); \
        const bf16_t* src_; \
        if (i_ < 4) src_ = (i_ < 2 ? CF : BF) + ((((size_t)((pt0) >> 5) + (q_ >> 3)) * 8 + g) * 8 + (q_ & 7)) * 512 + lane * 8; \
        else src_ = BT + ((((size_t)((pt0) >> 4) + (q_ >> 2)) * 8 + g) * 4 + (q_ & 3)) * 512 + lane * 8; \
        __builtin_amdgcn_global_load_lds((const unsigned*)src_, (PG8_LAS unsigned*)(wg_smem + SCAN_PRIV + (i_ >> 1) * 16384 + q_ * 1024), 16, 0, 0); } } while (0)
#define SCAN_WRITE_STATE() do { \
      _Pragma("unroll") for (int t2 = 0; t2 < 2; ++t2) _Pragma("unroll") for (int qd = 0; qd < 4; ++qd) { \
        u32x2 o_; o_.x = pack2(hacc[t2][4 * qd], hacc[t2][4 * qd + 1]); o_.y = pack2(hacc[t2][4 * qd + 2], hacc[t2][4 * qd + 3]); \
        *(u32x2*)(sH + pcol * SH_STRIDE + 32 * (2 * it + t2) + 8 * qd + 4 * hh) = o_; } } while (0)
    const bool need0 = dir == 0 ? true : (it == 0);
    const bool need1 = dir == 0 ? (it == 1) : true;
    float dtv; u32x4 xtr[2];
    __syncthreads();
    {
      const int p0 = SCAN_PTOK(0);
      SCAN_DMA(p0);
      SCAN_LOAD_DTX(p0);
      SCAN_WRITE_STATE();
    }
    for (int ci = 0; ci < nchunks; ++ci) {
      const int cin = ci + 1 < nchunks ? ci + 1 : ci;
      const int ptokN = SCAN_PTOK(cin);
      __syncthreads();
      if (ci > 0) {
        const int ptokP = SCAN_PTOK(ci - 1);
#pragma unroll
        for (int i = 0; i < 2; ++i) {
          const int q = tid + i * 256, yrow = q >> 3, c8 = (q & 7) * 8;
          *(u32x4*)(ybuf + ((size_t)dir * T_ALL + ptokP + yrow) * 2048 + h * 64 + c8) = *(const u32x4*)(sY + yrow * 72 + c8);
        }
      }
      float decE;
      {
        const float a_ = dtv * Aval;
        const float pre = wave_incl_scan(a_);
        const float cE = __int_as_float(__builtin_amdgcn_readlane(__float_as_int(pre), 63));
        const float c = dir == 0 ? pre : cE - pre + a_;
        myW[lane] = dtv; myW[64 + lane] = c; myW[128 + lane] = __expf(c); myW[192 + lane] = dtv * __expf(cE - c);
        decE = __expf(cE);
      }
#pragma unroll
      for (int i = 0; i < 2; ++i) {
        const int q = tid + i * 256, prow = q >> 3, j8 = (q & 7) * 8;
        const u32x4 raw = xtr[i];
        *(u32x4*)(sXr + prow * 72 + j8) = raw;
        f32x4 f0 = *(const f32x4*)(myW + 192 + j8), f1 = *(const f32x4*)(myW + 192 + j8 + 4);
        u32x4 sc;
        sc.x = pack2(bflo(raw.x) * f0.x, bfhi(raw.x) * f0.y); sc.y = pack2(bflo(raw.y) * f0.z, bfhi(raw.y) * f0.w);
        sc.z = pack2(bflo(raw.z) * f1.x, bfhi(raw.z) * f1.y); sc.w = pack2(bflo(raw.w) * f1.z, bfhi(raw.w) * f1.w);
        *(u32x4*)(sXs + prow * 72 + j8) = sc;
      }
      asm volatile("s_waitcnt vmcnt(0)" ::: "memory");
      __syncthreads();
      SCAN_LOAD_DTX(ptokN);
#pragma unroll
      for (int t2 = 0; t2 < 2; ++t2) {
#pragma unroll
        for (int e = 0; e < 16; ++e) hacc[t2][e] *= decE;
        const bf16_t* xs = sXs + pcol * 72 + 8 * hh;
#pragma unroll
        for (int kk = 0; kk < 4; ++kk)
          hacc[t2] = __builtin_amdgcn_mfma_f32_32x32x16_bf16(*(const bf16x8*)(sfT + (kk * 4 + 2 * it + t2) * 512 + lane * 8), *(const bf16x8*)(xs + 16 * kk), hacc[t2], 0, 0, 0);
      }
      bf16x8 cfr[8];
#pragma unroll
      for (int kk = 0; kk < 8; ++kk) cfr[kk] = *(const bf16x8*)(sfC + (it * 8 + kk) * 512 + lane * 8);
      f32x16 acc;
#pragma unroll
      for (int e = 0; e < 16; ++e) acc[e] = 0.f;
      {
        const bf16_t* hp = sH + pcol * SH_STRIDE + 8 * hh;
#pragma unroll
        for (int kk = 0; kk < 8; ++kk) acc = __builtin_amdgcn_mfma_f32_32x32x16_bf16(cfr[kk], *(const bf16x8*)(hp + 16 * kk), acc, 0, 0, 0);
      }
#pragma unroll
      for (int qd = 0; qd < 4; ++qd) {
        f32x4 ec = *(const f32x4*)(myW + 128 + 32 * it + 8 * qd + 4 * hh);
        acc[4 * qd] *= ec.x; acc[4 * qd + 1] *= ec.y; acc[4 * qd + 2] *= ec.z; acc[4 * qd + 3] *= ec.w;
      }
      const int icol = 32 * it + r;
      const float ci_ = myW[64 + icol];
#pragma unroll
      for (int jt = 0; jt < 2; ++jt) {
        const bool needed = jt == 0 ? need0 : need1;
        if (needed) {
          f32x16 X;
#pragma unroll
          for (int e = 0; e < 16; ++e) X[e] = 0.f;
#pragma unroll
          for (int kk = 0; kk < 8; ++kk) X = __builtin_amdgcn_mfma_f32_32x32x16_bf16(*(const bf16x8*)(sfB + (jt * 8 + kk) * 512 + lane * 8), cfr[kk], X, 0, 0, 0);
#pragma unroll
          for (int qd = 0; qd < 4; ++qd) {
            const int j0 = 32 * jt + 8 * qd + 4 * hh;
            f32x4 cj = *(const f32x4*)(myW + 64 + j0), dj = *(const f32x4*)(myW + j0);
            float cjv[4] = {cj.x, cj.y, cj.z, cj.w}, djv[4] = {dj.x, dj.y, dj.z, dj.w};
#pragma unroll
            for (int u = 0; u < 4; ++u) {
              const int j = j0 + u;
              const bool ok = dir == 0 ? (j <= icol) : (j >= icol);
              const float m = __expf(ci_ - cjv[u]) * djv[u];
              X[4 * qd + u] = ok ? X[4 * qd + u] * m : 0.f;
            }
          }
#pragma unroll
          for (int sk = 0; sk < 2; ++sk) {
            bf16x8 afr = pack8(X[8 * sk], X[8 * sk + 1], X[8 * sk + 2], X[8 * sk + 3], X[8 * sk + 4], X[8 * sk + 5], X[8 * sk + 6], X[8 * sk + 7]);
            const bf16_t* xp = sXr + pcol * 72 + 32 * jt + 16 * sk + 4 * hh;
            u32x2 lo = *(const u32x2*)xp, hi = *(const u32x2*)(xp + 8);
            u32x4 xv; xv.x = lo.x; xv.y = lo.y; xv.z = hi.x; xv.w = hi.y;
            acc = __builtin_amdgcn_mfma_f32_32x32x16_bf16(afr, __builtin_bit_cast(bf16x8, xv), acc, 0, 0, 0);
          }
        }
      }
      if (dir == 0) {
#pragma unroll
        for (int qd = 0; qd < 4; ++qd) {
          const u32x2 xw = *(const u32x2*)(sXr + pcol * 72 + 32 * it + 8 * qd + 4 * hh);
          acc[4 * qd] += dskip * bflo(xw.x); acc[4 * qd + 1] += dskip * bfhi(xw.x);
          acc[4 * qd + 2] += dskip * bflo(xw.y); acc[4 * qd + 3] += dskip * bfhi(xw.y);
        }
      }
      __syncthreads();
      SCAN_DMA(ptokN);
      SCAN_WRITE_STATE();
      {
        bf16_t* yo = sY + (32 * it) * 72 + pcol;
#pragma unroll
        for (int e = 0; e < 16; ++e) yo[rowmap(e, hh) * 72] = f2bf(acc[e]);
      }
    }
    __syncthreads();
    {
      const int ptokP = SCAN_PTOK(nchunks - 1);
#pragma unroll
      for (int i = 0; i < 2; ++i) {
        const int q = tid + i * 256, yrow = q >> 3, c8 = (q & 7) * 8;
        *(u32x4*)(ybuf + ((size_t)dir * T_ALL + ptokP + yrow) * 2048 + h * 64 + c8) = *(const u32x4*)(sY + yrow * 72 + c8);
      }
    }
#undef SCAN_PTOK
#undef SCAN_LOAD_DTX
#undef SCAN_DMA
#undef SCAN_WRITE_STATE
    if (s < 32) {
      float* ho = p.out_ssd + ((((size_t)s * 2 + slot) * 2 + dir) * 32 + h) * 8192 + (size_t)pcol * 128;
#pragma unroll
      for (int t2 = 0; t2 < 2; ++t2)
#pragma unroll
        for (int qd = 0; qd < 4; ++qd) {
          f32x4 v; v.x = hacc[t2][4 * qd]; v.y = hacc[t2][4 * qd + 1]; v.z = hacc[t2][4 * qd + 2]; v.w = hacc[t2][4 * qd + 3];
          *(f32x4*)(ho + 32 * (2 * it + t2) + 8 * qd + 4 * hh) = v;
        }
    }
    asm volatile("s_waitcnt vmcnt(0)" ::: "memory");
  }
}

__device__ __forceinline__ void phase_ssd_gate(const Params& p, int slot, int bid, int nblk, int cxw) {
  const int tidx = opaque_tid(cxw);
  bf16_t* zb = (bf16_t*)(p.scratch + SC_SSD_Z);
  const bf16_t* yfb = (const bf16_t*)(p.scratch + SC_SSD_XBC);
  const bf16_t* ybb = yfb + (size_t)T_ALL * 2048;
  const bf16_t* xbcc = (const bf16_t*)(p.scratch + SC_SSD_XBCC);
  int lane = tidx & 63, wv = cxw & 3;
  for (int row = bid * 4 + wv; row < T_ALL; row += nblk * 4) {
    float ss = 0.f;
    TokInfo ti = tokinfo(row);
    const int prow = ti.base + seqpos2off(ti.l, slot == 1 && ti.s >= 32);
#pragma unroll
    for (int j = 0; j < 4; ++j) {
      int c0 = j * 512 + lane * 8;
      u32x4 zv = *(const u32x4*)(zb + (size_t)row * 2048 + c0);
      u32x4 fv = *(const u32x4*)(yfb + (size_t)prow * 2048 + c0);
      u32x4 bv = *(const u32x4*)(ybb + (size_t)prow * 2048 + c0);
      unsigned zw[4] = {zv.x, zv.y, zv.z, zv.w}, fw[4] = {fv.x, fv.y, fv.z, fv.w}, bw[4] = {bv.x, bv.y, bv.z, bv.w};
      unsigned ow[4];
#pragma unroll
      for (int e = 0; e < 4; ++e) {
        float y0 = (bflo(fw[e]) + bflo(bw[e])) * siluf(bflo(zw[e]));
        float y1 = (bfhi(fw[e]) + bfhi(bw[e])) * siluf(bfhi(zw[e]));
        ss += y0 * y0 + y1 * y1;
        ow[e] = pack2(y0, y1);
      }
      u32x4 o; o.x = ow[0]; o.y = ow[1]; o.z = ow[2]; o.w = ow[3];
      *(u32x4*)(zb + (size_t)row * 2048 + c0) = o;
    }
#pragma unroll
    for (int o = 32; o > 0; o >>= 1) ss += shfl_xor_f(ss, o, lane);
    if (lane == 0) p.rstd[row] = rsqrtf(ss * (1.f / 2048.f) + 1e-5f);
  }
}

#define HY_UOFF (32768 + 64)
__device__ __forceinline__ void hy_stage_conv(const Params& p, const bf16_t* __restrict__ row, int ch, bf16_t* dst, int dstStride, int dstPad,
                                              int nelem, int L, int tid) {
  const float w0 = p.hy_conv_w[ch], w1 = p.hy_conv_w[3072 + ch], w2 = p.hy_conv_w[2 * 3072 + ch], bb = p.hy_conv_b[ch];
  for (int q = tid; q < nelem / 8; q += NTHR) {
    const int e0 = q * 8, b = e0 / L, t0 = e0 & (L - 1);
    u32x4 raw = *(const u32x4*)(row + e0);
    float x[10];
    x[0] = t0 > 0 ? bf2f(row[e0 - 1]) : 0.f;
    x[9] = t0 + 8 < L ? bf2f(row[e0 + 8]) : 0.f;
    x[1] = bflo(raw.x); x[2] = bfhi(raw.x); x[3] = bflo(raw.y); x[4] = bfhi(raw.y);
    x[5] = bflo(raw.z); x[6] = bfhi(raw.z); x[7] = bflo(raw.w); x[8] = bfhi(raw.w);
    float o[8];
#pragma unroll
    for (int j = 0; j < 8; ++j) o[j] = w0 * x[j] + w1 * x[j + 1] + w2 * x[j + 2] + bb;
    u32x4 ov; ov.x = pack2(o[0], o[1]); ov.y = pack2(o[2], o[3]); ov.z = pack2(o[4], o[5]); ov.w = pack2(o[6], o[7]);
    *(u32x4*)(dst + b * dstStride + dstPad + t0) = ov;
  }
}

__device__ __forceinline__ void phase_hy_longconv(const Params& p, int bid, int nblk, unsigned char* smem, int cxw) {
  const int tid = opaque_tid(cxw), lane = tid & 63, w = cxw & 3  , r = lane & 31, hh = lane >> 5;
  const bf16_t* projT = (const bf16_t*)(p.scratch + SC_HY_PROJT);
  bf16_t* yT = (bf16_t*)(p.scratch + SC_HY_YT);
  unsigned* Rc0 = (unsigned*)smem;
  unsigned* Rc1 = Rc0 + 4096 + 16;
  bf16_t* G = (bf16_t*)smem;
  bf16_t* U = (bf16_t*)(smem + HY_UOFF);
  for (int item = bid; item < 2048; item += nblk) {
    const bool lat = item < 1024;
    const int c = item & 1023;
    const int L = lat ? 4096 : 256, NB = lat ? 4 : 32, RL = lat ? 8192 : 512, Lm1 = L - 1;
    const int PAD = lat ? 224 : 0, US = lat ? 4552 : 264;
    const int tokbase = lat ? T_CTX : 0;
    const int nI = L >> 5, nelem = NB * L;
    const int TPW = lat ? 4 : 2;
    __syncthreads();
    if (lat) {
      for (int q = tid; q < 4 * 57; q += NTHR) {
        int b = q / 57, k = q % 57;
        int off = k < 28 ? k * 8 : 224 + 4096 + (k - 28) * 8;
        unsigned zz = 0u; asm volatile("" : "+v"(zz));
        u32x4 z4 = {zz, zz, zz, zz};
        *(u32x4*)(U + b * US + off) = z4;
      }
    }
    hy_stage_conv(p, projT + (size_t)c * T_ALL + tokbase, c, U, US, PAD, nelem, L, tid);
    int Icol[4], bcol[4];
#pragma unroll
    for (int tt = 0; tt < 4; ++tt) {
      int n = (w * TPW + tt) * 32 + r;
      Icol[tt] = lat ? (n >> 2) : (n >> 5);
      bcol[tt] = lat ? (n & 3) : (n & 31);
    }
    const int Ilo_w = lat ? 32 * w : 2 * w, Ihi_w = lat ? 32 * w + 31 : 2 * w + 1;
    const int dlo = Ilo_w - (nI - 1), dhi = Ihi_w;
    for (int order = 0; order < 2; ++order) {
      {
        const bf16_t* src = (lat ? p.rtab1 : p.rtab0) + (size_t)(order * 1024 + c) * RL;
        for (int q = tid; q < RL / 8; q += NTHR) {
          u32x4 cv = *(const u32x4*)(src + q * 8);
          unsigned nx = (q + 1 < RL / 8) ? *(const unsigned*)(src + q * 8 + 8) : 0u;
          *(u32x4*)(Rc0 + q * 4) = cv;
          u32x4 sv;
          sv.x = (cv.x >> 16) | (cv.y << 16); sv.y = (cv.y >> 16) | (cv.z << 16);
          sv.z = (cv.z >> 16) | (cv.w << 16); sv.w = (cv.w >> 16) | (nx << 16);
          *(u32x4*)(Rc1 + q * 4) = sv;
        }
      }
      __syncthreads();
      f32x16 acc[4];
#pragma unroll
      for (int tt = 0; tt < 4; ++tt)
#pragma unroll
        for (int e = 0; e < 16; ++e) acc[tt][e] = 0.f;
      {
        int lo_t[4], hi_t[4];
        const bf16_t* ub[4];
#pragma unroll
        for (int tt = 0; tt < 4; ++tt) {
          const int tile = w * TPW + tt;
          const int Ilo_t = lat ? 8 * tile : tile, Ihi_t = lat ? 8 * tile + 7 : tile;
          lo_t[tt] = tt < TPW ? Ilo_t - (nI - 1) : 1 << 30; hi_t[tt] = tt < TPW ? Ihi_t : -(1 << 30);
          ub[tt] = U + bcol[tt] * US + PAD + 32 * Icol[tt] + 8 * hh;
        }
        const int ybase = Lm1 - r + 8 * hh;
#define LC_EDGE(D0, D1) do { for (int d_ = (D0); d_ <= (D1); ++d_) { \
          _Pragma("unroll") for (int kk_ = 0; kk_ < 2; ++kk_) { \
            const int y0_ = ybase - 32 * d_ + 16 * kk_; const int par_ = y0_ & 1; \
            const unsigned* rp_ = (par_ ? Rc1 : Rc0) + ((y0_ - par_) >> 1); \
            u32x4 av_; av_.x = rp_[0]; av_.y = rp_[1]; av_.z = rp_[2]; av_.w = rp_[3]; const bf16x8 af_ = __builtin_bit_cast(bf16x8, av_); \
            _Pragma("unroll") for (int tt = 0; tt < 4; ++tt) if (d_ >= lo_t[tt] && d_ <= hi_t[tt]) \
              acc[tt] = __builtin_amdgcn_mfma_f32_32x32x16_bf16(af_, *(const bf16x8*)(ub[tt] - 32 * d_ + 16 * kk_), acc[tt], 0, 0, 0); } } } while (0)
        if (!lat) {
          LC_EDGE(dlo, dhi);
        } else {
          const int mlo = lo_t[3], mhi = hi_t[0];
          LC_EDGE(dlo, mlo - 1);
#define LC_LOAD(IT, A, B) do { const int it_ = (IT); const int d_ = mlo + (it_ >> 1), kk_ = it_ & 1; \
          const int y0_ = ybase - 32 * d_ + 16 * kk_; const int par_ = y0_ & 1; \
          const unsigned* rp_ = (par_ ? Rc1 : Rc0) + ((y0_ - par_) >> 1); \
          u32x4 av_; av_.x = rp_[0]; av_.y = rp_[1]; av_.z = rp_[2]; av_.w = rp_[3]; A = __builtin_bit_cast(bf16x8, av_); \
          _Pragma("unroll") for (int tt = 0; tt < 4; ++tt) B[tt] = *(const bf16x8*)(ub[tt] - 32 * d_ + 16 * kk_); } while (0)
#define LC_MMA(A, B) do { _Pragma("unroll") for (int tt = 0; tt < 4; ++tt) acc[tt] = __builtin_amdgcn_mfma_f32_32x32x16_bf16(A, B[tt], acc[tt], 0, 0, 0); } while (0)
          const int NIT = 2 * (mhi - mlo + 1);
          bf16x8 a0, a1, b0[4], b1[4];
          LC_LOAD(0, a0, b0);
          for (int it = 0; it < NIT; it += 2) {
            LC_LOAD(it + 1, a1, b1);
            __builtin_amdgcn_sched_barrier(0);
            LC_MMA(a0, b0);
            __builtin_amdgcn_sched_barrier(0);
            LC_LOAD(it + 2 < NIT ? it + 2 : NIT - 1, a0, b0);
            __builtin_amdgcn_sched_barrier(0);
            LC_MMA(a1, b1);
            __builtin_amdgcn_sched_barrier(0);
          }
#undef LC_LOAD
#undef LC_MMA
          LC_EDGE(mhi + 1, dhi);
        }
#undef LC_EDGE
      }
      __syncthreads();
      hy_stage_conv(p, projT + (size_t)((1 + order) * 1024 + c) * T_ALL + tokbase, (1 + order) * 1024 + c, G, L, 0, nelem, L, tid);
      __syncthreads();
      const float inv = 1.f / p.knorm[((lat ? 1 : 0) * 2 + order) * 1024 + c];
      const float bias = p.hy_f_bias[order * 1024 + c];
#pragma unroll
      for (int tt = 0; tt < 4; ++tt) {
        if (tt < TPW) {
#pragma unroll
          for (int qd = 0; qd < 4; ++qd) {
            const int t0 = 32 * Icol[tt] + 8 * qd + 4 * hh;
            bf16_t* up = U + bcol[tt] * US + PAD + t0;
            u32x2 uc = *(const u32x2*)up;
            u32x2 gg = *(const u32x2*)(G + bcol[tt] * L + t0);
            float r0 = (inv * acc[tt][4 * qd] + bias * bflo(uc.x)) * bflo(gg.x);
            float r1 = (inv * acc[tt][4 * qd + 1] + bias * bfhi(uc.x)) * bfhi(gg.x);
            float r2 = (inv * acc[tt][4 * qd + 2] + bias * bflo(uc.y)) * bflo(gg.y);
            float r3 = (inv * acc[tt][4 * qd + 3] + bias * bfhi(uc.y)) * bfhi(gg.y);
            if (order == 1) {
              u32x2 zz = *(const u32x2*)(projT + (size_t)(3072 + c) * T_ALL + tokbase + bcol[tt] * L + t0);
              r0 *= siluf(bflo(zz.x)); r1 *= siluf(bfhi(zz.x)); r2 *= siluf(bflo(zz.y)); r3 *= siluf(bfhi(zz.y));
            }
            u32x2 ov; ov.x = pack2(r0, r1); ov.y = pack2(r2, r3);
            *(u32x2*)up = ov;
          }
        }
      }
      __syncthreads();
    }
    for (int q = tid; q < nelem / 8; q += NTHR) {
      const int e0 = q * 8, b = e0 / L, t0 = e0 & (L - 1);
      *(u32x4*)(yT + (size_t)c * T_ALL + tokbase + e0) = *(const u32x4*)(U + b * US + PAD + t0);
    }
  }
}

__device__ __forceinline__ void phase_hy_transpose(const Params& p, int bid, int nblk, unsigned char* smem, int cxw) {
  const int tid = opaque_tid(cxw);
  const bf16_t* yT = (const bf16_t*)(p.scratch + SC_HY_YT);
  bf16_t* yg = (bf16_t*)(p.scratch + SC_HY_YG);
  bf16_t* tl = (bf16_t*)smem;
  for (int item = bid; item < 16 * (T_ALL / 64); item += nblk) {
    const int cb = item & 15, tb = item >> 4;
    __syncthreads();
#pragma unroll
    for (int i = 0; i < 2; ++i) {
      int q = tid + i * 256, cr = q >> 3, t8 = (q & 7) * 8;
      u32x4 v = *(const u32x4*)(yT + (size_t)(cb * 64 + cr) * T_ALL + tb * 64 + t8);
      unsigned wv[4] = {v.x, v.y, v.z, v.w};
#pragma unroll
      for (int e = 0; e < 4; ++e) {
        tl[(t8 + 2 * e) * 72 + cr] = (bf16_t)(wv[e] & 0xffffu);
        tl[(t8 + 2 * e + 1) * 72 + cr] = (bf16_t)(wv[e] >> 16);
      }
    }
    __syncthreads();
#pragma unroll
    for (int i = 0; i < 2; ++i) {
      int q = tid + i * 256, tr = q >> 3, c8 = (q & 7) * 8;
      *(u32x4*)(yg + (size_t)(tb * 64 + tr) * 1024 + cb * 64 + c8) = *(const u32x4*)(tl + tr * 72 + c8);
    }
  }
}

#define LRU_NCH 384
struct Lru4 { float af[4], bxf[4], ab[4], bxb[4]; };
__device__ __forceinline__ void lru_unpack4(u32x2 v, float (&o)[4]) { o[0] = bflo(v.x); o[1] = bfhi(v.x); o[2] = bflo(v.y); o[3] = bfhi(v.y); }
__device__ __forceinline__ void lru_row_f(const bf16_t* gates, const bf16_t* xc, size_t o, const float (&spf)[4], float (&af)[4], float (&bxf)[4]) {
  float r[4], g[4], x[4];
  lru_unpack4(*(const u32x2*)(gates + o), r); lru_unpack4(*(const u32x2*)(gates + (size_t)T_ALL * 1024 + o), g); lru_unpack4(*(const u32x2*)(xc + o), x);
#pragma unroll
  for (int e = 0; e < 4; ++e) { const float la = -8.f * r[e] * spf[e]; af[e] = __expf(la); bxf[e] = sqrtf(fmaxf(1.f - __expf(2.f * la), 0.f)) * g[e] * x[e]; }
}
__device__ __forceinline__ void lru_row_b(const bf16_t* gates, const bf16_t* xc, size_t o, const float (&spb)[4], float (&ab)[4], float (&bxb)[4]) {
  float r[4], g[4], x[4];
  lru_unpack4(*(const u32x2*)(gates + (size_t)2 * T_ALL * 1024 + o), r); lru_unpack4(*(const u32x2*)(gates + (size_t)3 * T_ALL * 1024 + o), g); lru_unpack4(*(const u32x2*)(xc + o), x);
#pragma unroll
  for (int e = 0; e < 4; ++e) { const float la = -8.f * r[e] * spb[e]; ab[e] = __expf(la); bxb[e] = sqrtf(fmaxf(1.f - __expf(2.f * la), 0.f)) * g[e] * x[e]; }
}
__device__ __forceinline__ void phase_lru_scan_agg(const Params& p, int bid, int nblk, unsigned char* smem, int cxw) {
  const int tidx = opaque_tid(cxw);
  const bf16_t* gates = (const bf16_t*)(p.scratch + SC_LRU_GATES);
  const bf16_t* xc = (const bf16_t*)(p.scratch + SC_LRU_XC);
  float* sagg = (float*)smem;
  const int sub = cxw & 3, cq = tidx & 63;
  for (int item = bid; item < LRU_NCH * 4; item += nblk) {
    const int chunk = item >> 2, cb = item & 3;
    const int c0 = cb * 256 + 4 * cq;
    float spf[4], spb[4];
#pragma unroll
    for (int e = 0; e < 4; ++e) { spf[e] = softplusf(-p.lru_a_param[c0 + e]); spb[e] = softplusf(-p.lru_a_param[1024 + c0 + e]); }
    const int tok0 = chunk * 64 + 16 * sub;
    float Af[4] = {1.f, 1.f, 1.f, 1.f}, hf[4] = {0.f, 0.f, 0.f, 0.f}, Pb[4] = {1.f, 1.f, 1.f, 1.f}, Bb[4] = {0.f, 0.f, 0.f, 0.f};
#pragma unroll 4
    for (int j = 0; j < 16; ++j) {
      const size_t o = (size_t)(tok0 + j) * 1024 + c0;
      float af[4], bxf[4], ab[4], bxb[4];
      lru_row_f(gates, xc, o, spf, af, bxf);
      lru_row_b(gates, xc, o, spb, ab, bxb);
#pragma unroll
      for (int e = 0; e < 4; ++e) { hf[e] = af[e] * hf[e] + bxf[e]; Af[e] *= af[e]; Bb[e] += bxb[e] * Pb[e]; Pb[e] *= ab[e]; }
    }
    {
      const size_t sc = (size_t)chunk * 4 + sub;
      float* gf = p.lru_sagg + (((size_t)0 * (LRU_NCH * 4) + sc) * 1024 + c0) * 2;
      float* gb = p.lru_sagg + (((size_t)1 * (LRU_NCH * 4) + sc) * 1024 + c0) * 2;
      f32x4 v0 = {Af[0], hf[0], Af[1], hf[1]}, v1 = {Af[2], hf[2], Af[3], hf[3]};
      f32x4 w0 = {Pb[0], Bb[0], Pb[1], Bb[1]}, w1 = {Pb[2], Bb[2], Pb[3], Bb[3]};
      *(f32x4*)gf = v0; *(f32x4*)(gf + 4) = v1; *(f32x4*)gb = w0; *(f32x4*)(gb + 4) = w1;
      __syncthreads();
      float* sl = sagg + (sub * 64 + cq) * 16;
      *(f32x4*)sl = v0; *(f32x4*)(sl + 4) = v1; *(f32x4*)(sl + 8) = w0; *(f32x4*)(sl + 12) = w1;
      __syncthreads();
    }
    if (sub == 0) {
      float A[4], B[4], P[4], Q[4];
#pragma unroll
      for (int e = 0; e < 4; ++e) { A[e] = 1.f; B[e] = 0.f; P[e] = 1.f; Q[e] = 0.f; }
#pragma unroll
      for (int s2 = 0; s2 < 4; ++s2) {
        const float* lf = sagg + (s2 * 64 + cq) * 16;
        const float* lb = sagg + ((3 - s2) * 64 + cq) * 16 + 8;
#pragma unroll
        for (int e = 0; e < 4; ++e) {
          const float a = lf[2 * e], b = lf[2 * e + 1];
          B[e] = a * B[e] + b; A[e] *= a;
          const float pb = lb[2 * e], qb = lb[2 * e + 1];
          Q[e] = pb * Q[e] + qb; P[e] *= pb;
        }
      }
      float* gf = p.lru_agg + (((size_t)0 * LRU_NCH + chunk) * 1024 + c0) * 2;
      float* gb = p.lru_agg + (((size_t)1 * LRU_NCH + chunk) * 1024 + c0) * 2;
      f32x4 v0 = {A[0], B[0], A[1], B[1]}, v1 = {A[2], B[2], A[3], B[3]}, w0 = {P[0], Q[0], P[1], Q[1]}, w1 = {P[2], Q[2], P[3], Q[3]};
      *(f32x4*)gf = v0; *(f32x4*)(gf + 4) = v1; *(f32x4*)gb = w0; *(f32x4*)(gb + 4) = w1;
    }
  }
}
__device__ __forceinline__ void phase_lru_scan_carry(const Params& p, int bid, int nblk, int cxw) {
  const int tidx = opaque_tid(cxw);
  for (int item = bid; item < 36 * 8; item += nblk) {
    int s = item >> 3, dir = (item >> 2) & 1, cb = item & 3;
    int c = cb * 256 + tidx;
    int nch = s < 32 ? 4 : 64;
    int ch0 = s < 32 ? s * 4 : 128 + (s - 32) * 64;
    float h = s < 32 ? 0.f : p.state_lru[((size_t)(s - 32) * 2 + dir) * 1024 + c];
    for (int k0 = 0; k0 < nch; k0 += 4) {
      f32x2_t ag[4]; size_t idx[4];
#pragma unroll
      for (int u = 0; u < 4; ++u) {
        const int chunk = dir ? ch0 + nch - 1 - (k0 + u) : ch0 + k0 + u;
        idx[u] = ((size_t)dir * LRU_NCH + chunk) * 1024 + c;
        ag[u] = *(const f32x2_t*)(p.lru_agg + idx[u] * 2);
      }
#pragma unroll
      for (int u = 0; u < 4; ++u) { p.lru_hin[idx[u]] = h; h = ag[u].x * h + ag[u].y; }
    }
    if (s < 32) p.out_lru[((size_t)s * 2 + dir) * 1024 + c] = h;
  }
}
__device__ __forceinline__ void phase_lru_scan_final(const Params& p, int bid, int nblk, unsigned char* smem, int cxw) {
  const int tidx = opaque_tid(cxw);
  const bf16_t* gates = (const bf16_t*)(p.scratch + SC_LRU_GATES);
  const bf16_t* xc = (const bf16_t*)(p.scratch + SC_LRU_XC);
  const bf16_t* proj = (const bf16_t*)(p.scratch + SC_LRU_PROJ);
  bf16_t* yg = (bf16_t*)(p.scratch + SC_LRU_YG);
  const int sub = cxw & 3, cq = tidx & 63;
  for (int item = bid; item < LRU_NCH * 4; item += nblk) {
    const int chunk = item >> 2, cb = item & 3;
    const int c0 = cb * 256 + 4 * cq;
    float spf[4], spb[4];
#pragma unroll
    for (int e = 0; e < 4; ++e) { spf[e] = softplusf(-p.lru_a_param[c0 + e]); spb[e] = softplusf(-p.lru_a_param[1024 + c0 + e]); }
    float hf[4], hb[4];
    {
      const f32x4 a = *(const f32x4*)(p.lru_hin + ((size_t)0 * LRU_NCH + chunk) * 1024 + c0);
      const f32x4 b = *(const f32x4*)(p.lru_hin + ((size_t)1 * LRU_NCH + chunk) * 1024 + c0);
      hf[0] = a.x; hf[1] = a.y; hf[2] = a.z; hf[3] = a.w; hb[0] = b.x; hb[1] = b.y; hb[2] = b.z; hb[3] = b.w;
    }
#pragma unroll
    for (int s2 = 0; s2 < 3; ++s2) {
      if (s2 < sub) {
        const float* g = p.lru_sagg + (((size_t)0 * (LRU_NCH * 4) + (size_t)chunk * 4 + s2) * 1024 + c0) * 2;
        const f32x4 v0 = *(const f32x4*)g, v1 = *(const f32x4*)(g + 4);
        hf[0] = v0.x * hf[0] + v0.y; hf[1] = v0.z * hf[1] + v0.w; hf[2] = v1.x * hf[2] + v1.y; hf[3] = v1.z * hf[3] + v1.w;
      }
      if (3 - s2 > sub) {
        const float* g = p.lru_sagg + (((size_t)1 * (LRU_NCH * 4) + (size_t)chunk * 4 + (3 - s2)) * 1024 + c0) * 2;
        const f32x4 v0 = *(const f32x4*)g, v1 = *(const f32x4*)(g + 4);
        hb[0] = v0.x * hb[0] + v0.y; hb[1] = v0.z * hb[1] + v0.w; hb[2] = v1.x * hb[2] + v1.y; hb[3] = v1.z * hb[3] + v1.w;
      }
    }
    const int tok0 = chunk * 64 + 16 * sub;
    float hfs[16][4];
#pragma unroll
    for (int j = 0; j < 16; ++j) {
      const size_t o = (size_t)(tok0 + j) * 1024 + c0;
      float af[4], bxf[4];
      lru_row_f(gates, xc, o, spf, af, bxf);
#pragma unroll
      for (int e = 0; e < 4; ++e) { hf[e] = af[e] * hf[e] + bxf[e]; hfs[j][e] = hf[e]; }
    }
#pragma unroll
    for (int j = 15; j >= 0; --j) {
      const size_t o = (size_t)(tok0 + j) * 1024 + c0;
      float ab[4], bxb[4], z[4];
      lru_row_b(gates, xc, o, spb, ab, bxb);
      lru_unpack4(*(const u32x2*)(proj + (size_t)(tok0 + j) * 2048 + 1024 + c0), z);
      float y[4];
#pragma unroll
      for (int e = 0; e < 4; ++e) { hb[e] = ab[e] * hb[e] + bxb[e]; y[e] = (hfs[j][e] + hb[e]) * siluf(z[e]); }
      u32x2 ov; ov.x = pack2(y[0], y[1]); ov.y = pack2(y[2], y[3]);
      *(u32x2*)(yg + o) = ov;
    }
  }
}

enum { PH_PREP = 0, PH_MOD, PH_HYA, PH_HYB, PH_LNMOD, PH_INPROJ, PH_MIX1, PH_MIX2, PH_MIX3, PH_MIX4, PH_MIX5, PH_MIX6, PH_OUTPROJ };

struct Ctx { int bid, nblk, wave; unsigned char* smem; unsigned char* wg_smem; };

template <class Epi>
__device__ __forceinline__ void run_gemm(const Ctx& cx, const bf16_t* A, int lda, const bf16_t* Bt, int M, int N, int K, int grp_shift, int grp_bytes, const Epi& e) {
  pg8::Gemm g{A, Bt, M, N, K, lda, grp_shift, grp_bytes};
  pg8::StaticOrder S; S.init(M, N, gridDim.x, opaque_s(blockIdx.x));
  pg8::gemm_phase((PG8_LAS unsigned char*)cx.wg_smem, g, S, e, cx.wave);
}

#define N_PARAM_WORDS (sizeof(Params) / 8)
__device__ __forceinline__ Params load_params(const unsigned char* lp) {
  Params p;
  unsigned long long* d = (unsigned long long*)&p;
  const unsigned long long* sp = (const unsigned long long*)lp;
#pragma unroll
  for (int i = 0; i < (int)N_PARAM_WORDS; ++i) {
    const unsigned long long v = sp[i];
    const unsigned lo = __builtin_amdgcn_readfirstlane((unsigned)v), hi = __builtin_amdgcn_readfirstlane((unsigned)(v >> 32));
    d[i] = ((unsigned long long)hi << 32) | lo;
  }
  return p;
}
__device__ __forceinline__ void run_phase(const unsigned char* lparams, int ph, int layer, const Ctx& cx) {
  const Params p = load_params(lparams);
  const int kind = layer % 3, slot = layer / 3;
  const int bid = opaque_s(cx.bid), nblk = cx.nblk;
  unsigned char* smem = cx.smem;
  switch (ph) {
    case PH_PREP: phase_prep(p, bid, nblk, smem, cx.wave); break;
    case PH_MOD: phase_mod(p, bid, nblk, smem, cx.wave); break;
    case PH_HYA: phase_hyfilt_a(p, bid, nblk, smem, cx.wave); break;
    case PH_HYB: phase_hyfilt_b(p, bid, nblk, smem, cx.wave); break;
    case PH_LNMOD: phase_lnmod(p, layer, bid, nblk, cx.wave); break;
    case PH_INPROJ:
      if (kind == 0) {
        pg8::EpiSsdIn e{(bf16_t*)(p.scratch + SC_SSD_Z), (bf16_t*)(p.scratch + SC_SSD_XBC), (float*)(p.scratch + SC_SSD_DT), p.ssd_dt_bias + slot * 64};
        run_gemm(cx, p.hbuf, 1024, p.wt_ssd_in + (size_t)slot * 6400 * 1024, T_ALL, 6400, 1024, 30, 0, e);
      } else if (kind == 1) {
        pg8::EpiBf16 e{(bf16_t*)(p.scratch + SC_HY_PROJT), (size_t)T_ALL};
        run_gemm(cx, p.wt_hy_in, 1024, p.hbuf, 4096, T_ALL, 1024, 30, 0, e);
      } else {
        pg8::EpiBf16 e{(bf16_t*)(p.scratch + SC_LRU_PROJ), (size_t)2048};
        run_gemm(cx, p.hbuf, 1024, p.wt_lru_in, T_ALL, 2048, 1024, 30, 0, e);
      }
      break;
    case PH_MIX1:
      if (kind == 0) phase_ssd_conv(p, slot, slot == 1, bid, nblk, smem, cx.wave);
      else if (kind == 1) phase_hy_longconv(p, bid, nblk, smem, cx.wave);
      else phase_dwconv<4, false>((const bf16_t*)(p.scratch + SC_LRU_PROJ), 2048, (bf16_t*)(p.scratch + SC_LRU_XC), 1024, 1024,
                                  p.lru_conv_w, p.lru_conv_b, false, bid, nblk, cx.wave);
      break;
    case PH_MIX2:
      if (kind == 0) phase_ssd_scan(p, slot, slot == 1, bid, nblk, cx.wg_smem, cx.wave);
      else if (kind == 1) phase_hy_transpose(p, bid, nblk, smem, cx.wave);
      else {
        pg8::EpiLruGate e{(bf16_t*)(p.scratch + SC_LRU_GATES), p.lru_gate_b};
        run_gemm(cx, (const bf16_t*)(p.scratch + SC_LRU_XC), 1024, p.wt_lru_gate, T_ALL, 4096, 256, 2, 512, e);
      }
      break;
    case PH_MIX3:
      if (kind == 0) phase_ssd_gate(p, slot, bid, nblk, cx.wave);
      else phase_lru_scan_agg(p, bid, nblk, smem, cx.wave);
      break;
    case PH_MIX4: if (kind == 2) phase_lru_scan_carry(p, bid, nblk, cx.wave); break;
    case PH_MIX5: if (kind == 2) phase_lru_scan_final(p, bid, nblk, smem, cx.wave); break;
    case PH_OUTPROJ: {
      const float* mv = p.modv + (size_t)layer * 5 * 3072;
      if (kind == 0) {
        pg8::EpiOut e{p.resb, mv, p.rstd};
        run_gemm(cx, (const bf16_t*)(p.scratch + SC_SSD_Z), 2048, p.wt_ssd_out + (size_t)slot * 1024 * 2048, T_ALL, 1024, 2048, 30, 0, e);
      } else if (kind == 1) {
        pg8::EpiOut e{p.resb, mv, nullptr};
        run_gemm(cx, (const bf16_t*)(p.scratch + SC_HY_YG), 1024, p.wt_hy_out, T_ALL, 1024, 1024, 30, 0, e);
      } else {
        pg8::EpiOut e{p.resb, mv, nullptr};
        run_gemm(cx, (const bf16_t*)(p.scratch + SC_LRU_YG), 1024, p.wt_lru_out, T_ALL, 1024, 1024, 30, 0, e);
      }
    } break;
  }
}

__global__ void __launch_bounds__(WG_THREADS, 2) k_mega(Params p) {
  __shared__ __attribute__((aligned(16))) unsigned char smem[WG_SMEM + 16 + 512];
  cg::grid_group grid = cg::this_grid();
  const int wave0 = __builtin_amdgcn_readfirstlane((int)(threadIdx.x >> 6));
  const int vb = wave0 >> 2;
  Ctx cx;
  cx.wave = wave0;
  cx.bid = 2 * blockIdx.x + vb; cx.nblk = 2 * gridDim.x; cx.smem = smem + vb * SMEM_BYTES; cx.wg_smem = smem;
  volatile LAS unsigned* xst = (volatile LAS unsigned*)(smem + WG_SMEM);
  unsigned char* lparams = smem + WG_SMEM + 16;
  if (threadIdx.x == 0) { xst[0] = 0u; xst[1] = 0u; *(Params*)lparams = p; }
  __syncthreads();
  const XcdBarrier xb = xcd_barrier_post(p.bar, xst);
  run_phase(lparams, PH_PREP, 0, cx);
  run_phase(lparams, PH_MOD, 0, cx);
  run_phase(lparams, PH_HYA, 0, cx);
  grid.sync();
  run_phase(lparams, PH_HYB, 0, cx);
  for (int layer = 0; layer < 4; ++layer) {
    const int kind = layer % 3;
    run_phase(lparams, PH_LNMOD, layer, cx);
    xcd_barrier(xb, cx.wave);
    run_phase(lparams, PH_INPROJ, layer, cx);
    xcd_barrier(xb, cx.wave);
    run_phase(lparams, PH_MIX1, layer, cx);
    xcd_barrier(xb, cx.wave);
    run_phase(lparams, PH_MIX2, layer, cx);
    xcd_barrier(xb, cx.wave);
    if (kind != 1) {
      run_phase(lparams, PH_MIX3, layer, cx);
      xcd_barrier(xb, cx.wave);
    }
    if (kind == 2) {
      run_phase(lparams, PH_MIX4, layer, cx);
      xcd_barrier(xb, cx.wave);
      run_phase(lparams, PH_MIX5, layer, cx);
      xcd_barrier(xb, cx.wave);
    }
    run_phase(lparams, PH_OUTPROJ, layer, cx);
    xcd_barrier(xb, cx.wave);
  }
  run_phase(lparams, PH_LNMOD, 4, cx);
}

static inline size_t align_up(size_t x) { return (x + 255) & ~(size_t)255; }

extern "C" void kernel_launch(void* const* d_in, const int* in_sizes, int n_in, void* d_out, int out_size, void* d_ws, size_t ws_size,
                              hipStream_t stream) {
  Params p{};
  const float** fp = (const float**)&p;
  for (int i = 0; i < 36; ++i) fp[i] = (const float*)d_in[i];
  float* out = (float*)d_out;
  p.xres = out;
  p.out_ssd = out + (size_t)T_ALL * 1024;
  p.out_lru = p.out_ssd + (size_t)32 * 2 * 2 * 32 * 64 * 128;
  unsigned char* w = (unsigned char*)d_ws;
  size_t off = 0;
  auto carve = [&](size_t bytes) { unsigned char* r = w + off; off = align_up(off + bytes); return r; };
  p.wt_ssd_in = (bf16_t*)carve((size_t)2 * 6400 * 1024 * 2);
  p.wt_ssd_out = (bf16_t*)carve((size_t)2 * 1024 * 2048 * 2);
  p.wt_hy_in = (bf16_t*)carve((size_t)4096 * 1024 * 2);
  p.wt_hy_out = (bf16_t*)carve((size_t)1024 * 1024 * 2);
  p.wt_lru_in = (bf16_t*)carve((size_t)2048 * 1024 * 2);
  p.wt_lru_out = (bf16_t*)carve((size_t)1024 * 1024 * 2);
  p.wt_lru_gate = (bf16_t*)carve((size_t)4 * 1024 * 256 * 2);
  p.modv = (float*)carve((size_t)4 * 5 * 3072 * 4);
  p.hdn2 = (float*)carve((size_t)4352 * 64 * 4);
  p.rtab0 = (bf16_t*)carve((size_t)2 * 1024 * 512 * 2);
  p.rtab1 = (bf16_t*)carve((size_t)2 * 1024 * 8192 * 2);
  p.knorm = (float*)carve((size_t)4 * 1024 * 4);
  p.hbuf = (bf16_t*)carve((size_t)T_ALL * 1024 * 2);
  p.rstd = (float*)carve((size_t)T_ALL * 4);
  p.resb = (bf16_t*)carve((size_t)T_ALL * 1024 * 2);
  p.lru_agg = (float*)carve((size_t)2 * 384 * 1024 * 2 * 4);
  p.lru_hin = (float*)carve((size_t)2 * 384 * 1024 * 4);
  p.lru_sagg = (float*)carve((size_t)2 * 1536 * 1024 * 2 * 4);
  p.bar = (unsigned*)carve((size_t)XCD_BAR_WORDS * 4);
  p.scratch = carve(SC_TOTAL);
  if (off > ws_size) return;

  static int grid_blocks = 0;
  if (!grid_blocks) {
    int dev = 0, cus = 0, per_cu = 0;
    hipGetDevice(&dev);
    hipDeviceGetAttribute(&cus, hipDeviceAttributeMultiprocessorCount, dev);
    hipOccupancyMaxActiveBlocksPerMultiprocessor(&per_cu, k_mega, WG_THREADS, 0);
    if (per_cu > 1) per_cu = 1;
    grid_blocks = cus * per_cu;
  }
  hipMemsetAsync(p.bar, 0, (size_t)XCD_BAR_WORDS * 4, stream);
  void* args[] = {&p};
  hipError_t e = hipLaunchCooperativeKernel((void*)k_mega, dim3(grid_blocks), dim3(WG_THREADS), args, 0, stream);
  if (e != hipSuccess) fprintf(stderr, "cooperative launch failed: %s (grid %d)\n", hipGetErrorString(e), grid_blocks);
}
```

```cpp
#include <hip/hip_runtime.h>
#include <hip/hip_bf16.h>
#include <hip/hip_cooperative_groups.h>
#include <stdint.h>
#include <cstdio>
namespace cg = cooperative_groups;

typedef unsigned short bf16_t;
typedef __attribute__((ext_vector_type(8))) short bf16x8;
typedef __attribute__((ext_vector_type(16))) float f32x16;
typedef __attribute__((ext_vector_type(4))) unsigned int u32x4;
typedef __attribute__((ext_vector_type(2))) unsigned int u32x2;
typedef __attribute__((ext_vector_type(4))) float f32x4;
typedef float f32x4_t __attribute__((ext_vector_type(4)));
typedef float f32x2_t __attribute__((ext_vector_type(2)));

#define T_CTX 8192
#define T_ALL 24576
#define DM 1024
#define NTHR 256
#define SMEM_BYTES 69632
#define WG_THREADS 512
#define WG_SMEM 147456
#define ALPHA_RES 1.6817928305074290f
#define LN_EPS 1e-5f

__device__ __forceinline__ bf16_t f2bf(float f) { __bf16 h = (__bf16)f; return __builtin_bit_cast(bf16_t, h); }
__device__ __forceinline__ float bf2f(bf16_t b) { return __uint_as_float(((unsigned)b) << 16); }
__device__ __forceinline__ float bflo(unsigned w) { return __uint_as_float(w << 16); }
__device__ __forceinline__ float bfhi(unsigned w) { return __uint_as_float(w & 0xffff0000u); }
typedef __bf16 bf16v2_t __attribute__((ext_vector_type(2)));
typedef float f32v2_t __attribute__((ext_vector_type(2)));
__device__ __forceinline__ unsigned pack2(float a, float b) { f32v2_t v = {a, b}; bf16v2_t h = __builtin_convertvector(v, bf16v2_t); return __builtin_bit_cast(unsigned, h); }
__device__ __forceinline__ float siluf(float x) { return x * __builtin_amdgcn_rcpf(1.f + __expf(-x)); }
__device__ __forceinline__ float sigmoidf(float x) { return __builtin_amdgcn_rcpf(1.f + __expf(-x)); }
__device__ __forceinline__ float softplusf(float x) { return x > 20.f ? x : __logf(1.f + __expf(x)); }


__device__ __forceinline__ int opaque_lane() { int z = 0; asm volatile("" : "+v"(z)); return __builtin_amdgcn_mbcnt_hi(~0u, __builtin_amdgcn_mbcnt_lo(~0u, (unsigned)z)); }
__device__ __forceinline__ int opaque_tid512(int wave) { return (wave << 6) + opaque_lane(); }
__device__ __forceinline__ int opaque_tid(int wave) { return opaque_tid512(wave) & 255; }

#define XB_TMO      128
#define XB_XCNT(j)  (256  + 64 * (j))
#define XB_XSUB(j)  (1280 + 64 * (j))
#define XB_XGEN(j)  (2304 + 64 * (j))
#define XB_TOP      3328
#define XB_TOPGEN   3392
#define XCD_BAR_WORDS 3456
#define XB_SPIN_CAP (1u << 23)
#define LAS __attribute__((address_space(3)))
__device__ __forceinline__ unsigned xb_ld(unsigned* p)              { return __hip_atomic_load(p, __ATOMIC_RELAXED, __HIP_MEMORY_SCOPE_AGENT); }
__device__ __forceinline__ unsigned xb_add(unsigned* p, unsigned v) { return __hip_atomic_fetch_add(p, v, __ATOMIC_RELAXED, __HIP_MEMORY_SCOPE_AGENT); }
__device__ __forceinline__ unsigned xb_xcc_id() { return (unsigned)__builtin_amdgcn_s_getreg((3 << 11) | 20) & 0xFu; }
#define XB_SPIN(cond, bar) do { unsigned _sp = 0; while (cond) { __builtin_amdgcn_s_sleep(1); \
    if ((++_sp & 255u) == 0u) { if (xb_ld(&(bar)[XB_TMO])) break; if (_sp > XB_SPIN_CAP) { atomicAdd(&(bar)[XB_TMO], 1u); break; } } } } while (0)
struct XcdBarrier { unsigned* bar; unsigned x; volatile LAS unsigned* st; };
__device__ __forceinline__ XcdBarrier xcd_barrier_post(unsigned* bar, volatile LAS unsigned* st) {
  XcdBarrier b; b.bar = bar; b.x = xb_xcc_id(); b.st = st;
  if (threadIdx.x == 0) (void)xb_add(&bar[XB_XCNT(b.x)], 1u);
  return b;
}
__device__ __forceinline__ void xcd_barrier_complete(unsigned* bar, unsigned x, unsigned& nloc, unsigned& nx) {
  const unsigned G = gridDim.x * gridDim.y * gridDim.z;
  unsigned sum, cnt, mine, sp = 0u;
  for (;;) {
    sum = 0u; cnt = 0u; mine = 0u;
#pragma unroll
    for (unsigned j = 0; j < 16; ++j) { const unsigned c = xb_ld(&bar[XB_XCNT(j)]); sum += c; cnt += (c > 0u) ? 1u : 0u; mine = (j == x) ? c : mine; }
    if (sum == G) break;
    __builtin_amdgcn_s_sleep(1);
    if ((++sp & 255u) == 0u) { if (xb_ld(&bar[XB_TMO])) break; if (sp > XB_SPIN_CAP) { atomicAdd(&bar[XB_TMO], 1u); break; } }
  }
  nloc = mine > 0u ? mine : 1u; nx = cnt > 0u ? cnt : 1u;
}
__device__ __forceinline__ void xcd_barrier(const XcdBarrier& b, int wave) {
  asm volatile("s_waitcnt vmcnt(0)" ::: "memory");
  __syncthreads();
  if (opaque_tid512(wave) == 0) {
    unsigned* bar = b.bar;
    __builtin_amdgcn_s_waitcnt(0);
    unsigned nloc = b.st[0], nx = b.st[1];
    if (nloc == 0u) { xcd_barrier_complete(bar, b.x, nloc, nx); b.st[0] = nloc; b.st[1] = nx; }
    const unsigned old = xb_add(&bar[XB_XSUB(b.x)], 1u);
    const unsigned gen = old / nloc;
    if (old + 1u == (gen + 1u) * nloc) {
      __builtin_amdgcn_fence(__ATOMIC_RELEASE, "agent");
      asm volatile("s_waitcnt vmcnt(0)" ::: "memory");
      const unsigned og = xb_add(&bar[XB_TOP], 1u);
      const unsigned tg = og / nx;
      if (og + 1u == (tg + 1u) * nx) xb_add(&bar[XB_TOPGEN], 1u);
      else XB_SPIN(xb_ld(&bar[XB_TOPGEN]) == tg, bar);
      __builtin_amdgcn_fence(__ATOMIC_ACQUIRE, "agent");
      xb_add(&bar[XB_XGEN(b.x)], 1u);
      asm volatile("s_waitcnt vmcnt(0)" ::: "memory");
    } else {
      XB_SPIN(xb_ld(&bar[XB_XGEN(b.x)]) == gen, bar);
      __builtin_amdgcn_fence(__ATOMIC_ACQUIRE, "agent");
      asm volatile("s_waitcnt vmcnt(0)" ::: "memory");
    }
  }
  __syncthreads();
}


__device__ __forceinline__ int opaque_s(int x) { asm volatile("" : "+s"(x)); return x; }

__device__ __forceinline__ float shfl_idx_f(float v, int src) { return __int_as_float(__builtin_amdgcn_ds_bpermute(src << 2, __float_as_int(v))); }
__device__ __forceinline__ float shfl_xor_f(float v, int off, int lane) { return shfl_idx_f(v, lane ^ off); }

__device__ __forceinline__ float wave_incl_scan(float v) {
#define DPP_ADD(ctrl, rmask) v += __int_as_float(__builtin_amdgcn_update_dpp(0, __float_as_int(v), ctrl, rmask, 0xf, false))
  DPP_ADD(0x111, 0xf); DPP_ADD(0x112, 0xf); DPP_ADD(0x114, 0xf); DPP_ADD(0x118, 0xf);
  DPP_ADD(0x142, 0xa); DPP_ADD(0x143, 0xc);
#undef DPP_ADD
  return v;
}

struct TokInfo { int s, l, L, base, mrow; };
__device__ __forceinline__ TokInfo tokinfo(int tok) {
  TokInfo t;
  if (tok < T_CTX) { t.s = tok >> 8; t.l = tok & 255; t.L = 256; t.base = tok & ~255; t.mrow = 0; }
  else { int u = tok - T_CTX; t.s = 32 + (u >> 12); t.l = u & 4095; t.L = 4096; t.base = T_CTX + (u & ~4095); t.mrow = 1 + (u >> 12); }
  return t;
}
__device__ __forceinline__ int seqpos2off(int pos, bool cm) { return cm ? (((pos & 63) << 6) | (pos >> 6)) : pos; }

struct Params {
  const float *x_prompt, *x_sample, *state_ssd, *state_lru, *c, *c_ctx, *mod_w, *mod_b, *ln_g, *ln_b;
  const float *ssd_in_w, *ssd_conv_w, *ssd_conv_b, *ssd_dt_bias, *ssd_a_log, *ssd_d, *ssd_norm_g, *ssd_out_w;
  const float *hy_in_w, *hy_conv_w, *hy_conv_b, *hy_f_w1, *hy_f_b1, *hy_f_w2, *hy_f_b2, *hy_f_w3, *hy_f_freq, *hy_f_bias, *hy_out_w;
  const float *lru_in_w, *lru_conv_w, *lru_conv_b, *lru_gate_w, *lru_gate_b, *lru_a_param, *lru_out_w;
  float *xres, *out_ssd, *out_lru;
  bf16_t *wt_ssd_in, *wt_ssd_out, *wt_hy_in, *wt_hy_out, *wt_lru_in, *wt_lru_out, *wt_lru_gate;
  float *modv;
  float *hdn2;
  bf16_t *rtab0;
  bf16_t *rtab1;
  float *knorm;
  bf16_t *hbuf;
  float *rstd;
  bf16_t *resb;
  float *lru_agg;
  float *lru_hin;
  float *lru_sagg;
  unsigned char *scratch;
  unsigned *bar;
};

#define SC_SSD_Z     ((size_t)0)
#define SC_SSD_XBC   ((size_t)T_ALL * 2048 * 2)
#define SC_SSD_XBCC  (SC_SSD_XBC + (size_t)T_ALL * 4096 * 2)
#define SC_SSD_DT    (SC_SSD_XBCC + (size_t)T_ALL * 2048 * 2)
#define SC_SSD_XT    (SC_SSD_DT + (size_t)T_ALL * 64 * 4)
#define SC_SSD_BT    (SC_SSD_XT + (size_t)T_ALL * 2048 * 2)
#define SC_SSD_BF    (SC_SSD_BT + (size_t)T_ALL * 1024 * 2)
#define SC_SSD_CF    (SC_SSD_BF + (size_t)T_ALL * 1024 * 2)
#define SC_SSD_END   (SC_SSD_CF + (size_t)T_ALL * 1024 * 2)
#define SC_HY_PROJT  ((size_t)0)
#define SC_HY_YT     ((size_t)T_ALL * 4096 * 2)
#define SC_HY_YG     (SC_HY_YT + (size_t)T_ALL * 1024 * 2)
#define SC_LRU_PROJ  ((size_t)0)
#define SC_LRU_XC    ((size_t)T_ALL * 2048 * 2)
#define SC_LRU_GATES (SC_LRU_XC + (size_t)T_ALL * 1024 * 2)
#define SC_LRU_Y     (SC_LRU_GATES + (size_t)T_ALL * 4096 * 2)
#define SC_LRU_YG    (SC_LRU_Y + (size_t)T_ALL * 2048 * 2)
#define SC_TOTAL     SC_SSD_END

__device__ __forceinline__ void transpose_tile(const float* __restrict__ src, int ld_src, int n_src, bf16_t* __restrict__ dst, int K,
                               const float* __restrict__ scale, int tile, int tiles_k, float* tl, int cxw) {
  const int tidx = opaque_tid(cxw);
  int tk = tile % tiles_k, tn = tile / tiles_k;
  int k0 = tk * 64, n0 = tn * 64;
  __syncthreads();
  {
    const int c4 = (tidx & 15) * 4, r0 = tidx >> 4;
#pragma unroll
    for (int ps = 0; ps < 4; ++ps) {
      const int r = r0 + ps * 16;
      f32x4 v = {0.f, 0.f, 0.f, 0.f};
      if (n0 + c4 < n_src) v = *(const f32x4*)(src + (size_t)(k0 + r) * ld_src + n0 + c4);
      if (scale) { const float sc = scale[k0 + r]; v.x *= sc; v.y *= sc; v.z *= sc; v.w *= sc; }
      tl[r * 65 + c4] = v.x; tl[r * 65 + c4 + 1] = v.y; tl[r * 65 + c4 + 2] = v.z; tl[r * 65 + c4 + 3] = v.w;
    }
  }
  __syncthreads();
  {
    const int n = tidx >> 2, kq = (tidx & 3) * 16;
    unsigned w[8];
#pragma unroll
    for (int e = 0; e < 8; ++e) w[e] = pack2(tl[(kq + 2 * e) * 65 + n], tl[(kq + 2 * e + 1) * 65 + n]);
    u32x4 o0, o1; o0.x = w[0]; o0.y = w[1]; o0.z = w[2]; o0.w = w[3]; o1.x = w[4]; o1.y = w[5]; o1.z = w[6]; o1.w = w[7];
    bf16_t* dp = dst + (size_t)(n0 + n) * K + k0 + kq;
    *(u32x4*)dp = o0; *(u32x4*)(dp + 8) = o1;
  }
}

__device__ __forceinline__ void phase_prep(const Params& p, int bid, int nblk, unsigned char* smem, int cxw) {
  const int tidx = opaque_tid(cxw);
  float* tl = (float*)smem;
  for (int job = 0; job < 24; ++job) {
    const float* src; int ld, nsrc, K, npad; bf16_t* dst; const float* scale = nullptr;
    if (job < 2) { src = p.ssd_in_w + (size_t)job * 1024 * 6208; ld = 6208; nsrc = 6208; K = 1024; npad = 6400; dst = p.wt_ssd_in + (size_t)job * 6400 * 1024; }
    else if (job < 4) { int s = job - 2; src = p.ssd_out_w + (size_t)s * 2048 * 1024; ld = 1024; nsrc = 1024; K = 2048; npad = 1024; dst = p.wt_ssd_out + (size_t)s * 1024 * 2048; scale = p.ssd_norm_g + s * 2048; }
    else if (job == 4) { src = p.hy_in_w; ld = 4096; nsrc = 4096; K = 1024; npad = 4096; dst = p.wt_hy_in; }
    else if (job == 5) { src = p.hy_out_w; ld = 1024; nsrc = 1024; K = 1024; npad = 1024; dst = p.wt_hy_out; }
    else if (job == 6) { src = p.lru_in_w; ld = 2048; nsrc = 2048; K = 1024; npad = 2048; dst = p.wt_lru_in; }
    else if (job == 7) { src = p.lru_out_w; ld = 1024; nsrc = 1024; K = 1024; npad = 1024; dst = p.wt_lru_out; }
    else { int q = job - 8; int dg = q >> 2, n = q & 3;
      src = p.lru_gate_w + (size_t)(dg * 4 + n) * 65536; ld = 256; nsrc = 256; K = 256; npad = 256;
      dst = p.wt_lru_gate + (size_t)n * 1024 * 256 + (size_t)dg * 256 * 256; }
    int tiles_k = K / 64, tiles = tiles_k * (npad / 64);
    for (int t = bid; t < tiles; t += nblk) transpose_tile(src, ld, nsrc, dst, K, scale, t, tiles_k, tl, cxw);
  }
  for (int i = bid * NTHR + tidx; i < 2 * 2 * 1024; i += nblk * NTHR) p.knorm[i] = 0.f;
}

__device__ __forceinline__ void phase_mod(const Params& p, int bid, int nblk, unsigned char* smem, int cxw) {
  const int tidx = opaque_tid(cxw);
  float* sc = (float*)smem;
  float* red = sc + 5 * 1024;
  __syncthreads();
  for (int i = tidx; i < 5 * 1024; i += NTHR) {
    int r = i >> 10, k = i & 1023;
    float v = (r == 0) ? p.c_ctx[k] : p.c[(r - 1) * 1024 + k];
    sc[i] = siluf(v);
  }
  __syncthreads();
  const int cj = tidx & 31, kg = tidx >> 5;
  for (int item = bid; item < 4 * 96; item += nblk) {
    const int layer = item / 96, j = (item % 96) * 32 + cj;
    const float* w = p.mod_w + (size_t)layer * 1024 * 3072 + (size_t)kg * 128 * 3072 + j;
    const float* s0 = sc + kg * 128;
    float a0 = 0, a1 = 0, a2 = 0, a3 = 0, a4 = 0;
#pragma unroll 8
    for (int k = 0; k < 128; ++k) {
      float wv = w[(size_t)k * 3072];
      a0 += s0[k] * wv; a1 += s0[1024 + k] * wv; a2 += s0[2048 + k] * wv; a3 += s0[3072 + k] * wv; a4 += s0[4096 + k] * wv;
    }
    __syncthreads();
    red[(kg * 5 + 0) * 32 + cj] = a0; red[(kg * 5 + 1) * 32 + cj] = a1; red[(kg * 5 + 2) * 32 + cj] = a2;
    red[(kg * 5 + 3) * 32 + cj] = a3; red[(kg * 5 + 4) * 32 + cj] = a4;
    __syncthreads();
    if (tidx < 160) {
      const int rr = tidx >> 5, cc = tidx & 31;
      float sum = 0.f;
#pragma unroll
      for (int g8 = 0; g8 < 8; ++g8) sum += red[(g8 * 5 + rr) * 32 + cc];
      const int jj = (item % 96) * 32 + cc;
      p.modv[((size_t)layer * 5 + rr) * 3072 + jj] = sum + p.mod_b[layer * 3072 + jj];
    }
  }
}

__device__ __forceinline__ void phase_hyfilt_a(const Params& p, int bid, int nblk, unsigned char* smem, int cxw) {
  const int tidx = opaque_tid(cxw);
  float* sz = (float*)smem;
  float* sh = sz + 4 * 36;
  int pl = tidx >> 6, m = tidx & 63;
  for (int item = bid; item < 4352 / 4; item += nblk) {
    int pos = item * 4 + pl;
    int L = pos < 256 ? 256 : 4096;
    int l = pos < 256 ? pos : pos - 256;
    __syncthreads();
    if (m < 33) {
      float t = (float)l / (float)L;
      float w = (6.283185307179586f * (float)l) / (float)L;
      float v;
      if (m == 0) v = t;
      else {
        int j = (m - 1) & 15;
        float fr = 1e-4f + (float)j * ((15.f - 1e-4f) / 15.f);
        float ang = w * fr;
        v = (m <= 16) ? __cosf(ang) : __sinf(ang);
      }
      sz[pl * 36 + m] = v;
    }
    __syncthreads();
    float a = p.hy_f_b1[m];
    for (int e = 0; e < 33; ++e) a += sz[pl * 36 + e] * p.hy_f_w1[e * 64 + m];
    a = __sinf(p.hy_f_freq[m] * a);
    sh[pl * 64 + m] = a;
    __syncthreads();
    float b = p.hy_f_b2[m];
    for (int e = 0; e < 64; ++e) b += sh[pl * 64 + e] * p.hy_f_w2[e * 64 + m];
    b = __sinf(p.hy_f_freq[64 + m] * b);
    p.hdn2[(size_t)pos * 64 + m] = b;
  }
}

__device__ __forceinline__ void phase_hyfilt_b(const Params& p, int bid, int nblk, unsigned char* smem, int cxw) {
  const int tidx = opaque_tid(cxw);
  const int lane = tidx & 63;
  for (int item = bid; item < 17 * 64; item += nblk) {
    const int lb = item >> 6, chunk = item & 63;
    const int Lsel = lb ? 1 : 0, L = Lsel ? 4096 : 256, RL = Lsel ? 8192 : 512, Lm1 = L - 1;
    const int l = Lsel ? (lb - 1) * 256 + tidx : tidx;
    const int pos = Lsel ? 256 + l : l;
    float hd[64];
#pragma unroll
    for (int m4 = 0; m4 < 16; ++m4) {
      f32x4 v = *(const f32x4*)(p.hdn2 + (size_t)pos * 64 + m4 * 4);
      hd[m4 * 4] = v.x; hd[m4 * 4 + 1] = v.y; hd[m4 * 4 + 2] = v.z; hd[m4 * 4 + 3] = v.w;
    }
    const int odc0 = chunk * 64, o = odc0 >> 11, d = (odc0 >> 10) & 1, c0 = odc0 & 1023;
    const float t = (float)l / (float)L;
    bf16_t* rt = Lsel ? p.rtab1 : p.rtab0;
    const float min_decay = -3.0701134573253945f, max_decay = -15.350567286626973f;
    for (int cc = 0; cc < 64; ++cc) {
      const int c = c0 + cc;
      const float* w3 = p.hy_f_w3 + odc0 + cc;
      float acc = 0.f;
#pragma unroll
      for (int m = 0; m < 64; ++m) acc += hd[m] * w3[(size_t)m * 4096];
      float delta = fabsf(min_decay + (float)c * ((max_decay - min_decay) / 1023.f));
      float kv = acc * expf(-t * delta);
      size_t rb = (size_t)(o * 1024 + c) * RL;
      if (d == 0) rt[rb + Lm1 - l] = f2bf(kv);
      else if (l > 0) rt[rb + Lm1 + l] = f2bf(kv);
      else rt[rb + RL - 1] = 0;
      float a = fabsf(kv);
#pragma unroll
      for (int off = 32; off > 0; off >>= 1) a += shfl_xor_f(a, off, lane);
      if (lane == 0) atomicAdd(&p.knorm[(Lsel * 2 + o) * 1024 + c], a);
    }
  }
}

__device__ __forceinline__ void phase_lnmod(const Params& p, int layer, int bid, int nblk, int cxw) {
  const int tidx = opaque_tid(cxw);
  int lane = tidx & 63, wv = cxw & 3;
  f32x4 lg[4], lb[4];
  if (layer > 0) {
    const float* g = p.ln_g + (layer - 1) * DM; const float* b = p.ln_b + (layer - 1) * DM;
#pragma unroll
    for (int j = 0; j < 4; ++j) { lg[j] = *(const f32x4*)(g + j * 256 + lane * 4); lb[j] = *(const f32x4*)(b + j * 256 + lane * 4); }
  }
  f32x4 vn[4];
#define LNMOD_LOAD(ROW) do { const int row_ = (ROW); \
    if (layer == 0) { const float* src_ = row_ < T_CTX ? p.x_prompt + (size_t)row_ * DM : p.x_sample + (size_t)(row_ - T_CTX) * DM; \
      _Pragma("unroll") for (int j = 0; j < 4; ++j) vn[j] = *(const f32x4*)(src_ + j * 256 + lane * 4); } \
    else { const bf16_t* src_ = p.resb + (size_t)row_ * DM; \
      _Pragma("unroll") for (int j = 0; j < 4; ++j) { const u32x2 w_ = *(const u32x2*)(src_ + j * 256 + lane * 4); \
        vn[j].x = bflo(w_.x); vn[j].y = bfhi(w_.x); vn[j].z = bflo(w_.y); vn[j].w = bfhi(w_.y); } } } while (0)
  if (bid * 4 + wv < T_ALL) LNMOD_LOAD(bid * 4 + wv);
  for (int row = bid * 4 + wv; row < T_ALL; row += nblk * 4) {
    f32x4 v[4];
#pragma unroll
    for (int j = 0; j < 4; ++j) v[j] = vn[j];
    if (row + nblk * 4 < T_ALL) LNMOD_LOAD(row + nblk * 4);
    f32x4 msh[4], msc[4];
    if (layer < 4) {
      const int mrow_ = row < T_CTX ? 0 : 1 + ((row - T_CTX) >> 12);
      const float* mv_ = p.modv + ((size_t)layer * 5 + mrow_) * 3072;
#pragma unroll
      for (int j = 0; j < 4; ++j) { msh[j] = *(const f32x4*)(mv_ + j * 256 + lane * 4); msc[j] = *(const f32x4*)(mv_ + 1024 + j * 256 + lane * 4); }
    }
    if (layer > 0) {
      float s = 0.f;
#pragma unroll
      for (int j = 0; j < 4; ++j) s += v[j].x + v[j].y + v[j].z + v[j].w;
#pragma unroll
      for (int o = 32; o > 0; o >>= 1) s += shfl_xor_f(s, o, lane);
      float mu = s * (1.f / 1024.f);
      float q = 0.f;
#pragma unroll
      for (int j = 0; j < 4; ++j) { float a = v[j].x - mu, b = v[j].y - mu, c = v[j].z - mu, d = v[j].w - mu; q += a * a + b * b + c * c + d * d; }
#pragma unroll
      for (int o = 32; o > 0; o >>= 1) q += shfl_xor_f(q, o, lane);
      float rs = rsqrtf(q * (1.f / 1024.f) + LN_EPS);
#pragma unroll
      for (int j = 0; j < 4; ++j) {
        const f32x4 gg = lg[j], bb = lb[j];
        v[j].x = (v[j].x - mu) * rs * gg.x + bb.x; v[j].y = (v[j].y - mu) * rs * gg.y + bb.y;
        v[j].z = (v[j].z - mu) * rs * gg.z + bb.z; v[j].w = (v[j].w - mu) * rs * gg.w + bb.w;
      }
    }
    if (layer == 4) {
      float* dst = p.xres + (size_t)row * DM;
#pragma unroll
      for (int j = 0; j < 4; ++j) *(f32x4*)(dst + j * 256 + lane * 4) = v[j];
    } else {
      bf16_t* dst = p.resb + (size_t)row * DM;
#pragma unroll
      for (int j = 0; j < 4; ++j) { u32x2 o; o.x = pack2(v[j].x, v[j].y); o.y = pack2(v[j].z, v[j].w); *(u32x2*)(dst + j * 256 + lane * 4) = o; }
    }
    if (layer < 4) {
#pragma unroll
      for (int j = 0; j < 4; ++j) {
        const f32x4 sh = msh[j], sc = msc[j];
        u32x2 o;
        o.x = pack2(v[j].x * (1.f + sc.x) + sh.x, v[j].y * (1.f + sc.y) + sh.y);
        o.y = pack2(v[j].z * (1.f + sc.z) + sh.z, v[j].w * (1.f + sc.w) + sh.w);
        *(u32x2*)(p.hbuf + (size_t)row * DM + j * 256 + lane * 4) = o;
      }
    }
  }
}

#define PG8_LAS __attribute__((address_space(3)))
namespace pg8 {
constexpr int BM = 256, BK = 64, HALF = 128, HTB = HALF * BK * 2, STAGE_BYTES = 8 * HTB, NXCD = 8, WGM = 8;
__device__ __forceinline__ int lds_byte(int r, int c) { const int st = (r >> 4) * 2 + (c >> 5), rr = r & 15, cc = c & 31, ob = rr * 64 + cc * 2; return st * 1024 + (ob ^ (((ob >> 9) & 1) << 5)); }
__device__ __forceinline__ void stage_rc(int b, int& R, int& C) { const int st = b / 1024, sb = b % 1024, swz = sb ^ (((sb >> 9) & 1) << 5); R = (st >> 1) * 16 + swz / 64; C = (st & 1) * 32 + (swz % 64) / 2; }
__device__ __forceinline__ int perm32(int rho) { const int n = rho >> 4, i = rho & 15; return 8 * (i >> 2) + 4 * n + (i & 3); }
struct Unit { int pm, pn; };
struct Gemm { const bf16_t* A; const bf16_t* Bt; int M, N, K, lda; int a_grp_shift; int a_grp_bytes; };
struct StaticOrder {
  int nM, nN, nwg, G, c;
  __device__ void init(int M, int N, int G_, int c_) { nM = M / BM; nN = N / BM; nwg = nM * nN; G = G_; c = c_; }
  __device__ bool next(int i, Unit& u) const {
    const long L = (long)i * G + c; if (L >= nwg) return false;
    int wgid = (int)L; { const int q = nwg / NXCD, r = nwg % NXCD, xcd = wgid % NXCD, off = wgid / NXCD; wgid = (xcd < r ? xcd * (q + 1) : r * (q + 1) + (xcd - r) * q) + off; }
    const int nig = WGM * nN, gid = wgid / nig, fm = gid * WGM, gsz = (nM - fm) < WGM ? (nM - fm) : WGM;
    u.pm = fm + ((wgid % nig) % gsz); u.pn = (wgid % nig) / gsz; return true;
  }
};
__device__ __forceinline__ unsigned cvt_pk_bf16(float lo, float hi) { return pack2(lo, hi); }

template <class Epi>
__device__ __forceinline__ void gemm_phase(PG8_LAS unsigned char* lds, const Gemm g, const StaticOrder& S, const Epi& E, int wave) {
  const int tid = opaque_tid512(wave), wid = wave, lane = tid & 63, wr = wid >> 2, wc = wid & 3, fr = lane & 15, fq = lane >> 4;
  const int K = g.K, nt = K / BK, lda = g.lda;
  unsigned voffA[2], voffB[2];
#pragma unroll
  for (int i = 0; i < 2; ++i) { int R, C; stage_rc(tid * 16 + i * 8192, R, C); const int Rb = Epi::PERM ? ((R & ~31) + perm32(R & 31)) : R;
    voffA[i] = (unsigned)(R * lda + C) * 2u; voffB[i] = (unsigned)(Rb * K + C) * 2u; }
  const size_t kstep = (size_t)(BK * 2);
  const size_t hstepA = (size_t)HALF * lda * 2, hstepB = (size_t)HALF * K * 2;
  const size_t tstepA = 2 * hstepA, tstepB = 2 * hstepB;
  const unsigned ldsw = (unsigned)wid * 1024u;
  const int aoff = lds_byte(wr * 64 + fr, fq * 8), boff = lds_byte(wc * 32 + fr, fq * 8);
#define PG8_SA(b, h) (((b) * 2 + (h)) * HTB)
#define PG8_SB(b, h) ((4 + (b) * 2 + (h)) * HTB)
#define PG8_STAGE(bufoff, gbase, voff) do { _Pragma("unroll") for (int _i = 0; _i < 2; ++_i) \
    __builtin_amdgcn_global_load_lds((const unsigned*)((const char*)(gbase) + (voff)[_i]), (PG8_LAS unsigned*)(lds + (bufoff) + ldsw + _i * 8192), 16, 0, 0); } while (0)
#define PG8_LDA(dst, b, h) do { _Pragma("unroll") for (int m = 0; m < 4; ++m) _Pragma("unroll") for (int k = 0; k < 2; ++k) dst[m][k] = *(const PG8_LAS bf16x8*)(lds + PG8_SA(b, h) + aoff + m * 2048 + k * 1024); } while (0)
#define PG8_LDB(dst, b, h) do { _Pragma("unroll") for (int n = 0; n < 2; ++n) _Pragma("unroll") for (int k = 0; k < 2; ++k) dst[n][k] = *(const PG8_LAS bf16x8*)(lds + PG8_SB(b, h) + boff + n * 2048 + k * 1024); } while (0)
#define PG8_MMA(ai, bj, At, Bt) do { __builtin_amdgcn_s_setprio(1); _Pragma("unroll") for (int m = 0; m < 4; ++m) _Pragma("unroll") for (int n = 0; n < 2; ++n) _Pragma("unroll") for (int k = 0; k < 2; ++k) \
    acc[ai][bj][m][n] = __builtin_amdgcn_mfma_f32_16x16x32_bf16(Bt[n][k], At[m][k], acc[ai][bj][m][n], 0, 0, 0); __builtin_amdgcn_s_setprio(0); } while (0)
#define PG8_WAIT_V(n) asm volatile("s_waitcnt vmcnt(" #n ")" ::: "memory")
#define PG8_WAIT_L(n) asm volatile("s_waitcnt lgkmcnt(" #n ")" ::: "memory")
#define PG8_BAR __builtin_amdgcn_s_barrier()
#define PG8_SCHED __builtin_amdgcn_sched_barrier(0)
#define PG8_APTR(u) ((const char*)g.A + (size_t)(u).pm * tstepA + (size_t)(((u).pn >> g.a_grp_shift) * g.a_grp_bytes))
  Unit cur, nxt; int ui = 0;
  if (!S.next(0, cur)) return;
  f32x4 acc[2][2][4][2];
#pragma unroll
  for (int a = 0; a < 2; ++a)
#pragma unroll
    for (int b = 0; b < 2; ++b)
#pragma unroll
      for (int m = 0; m < 4; ++m)
#pragma unroll
        for (int n = 0; n < 2; ++n) acc[a][b][m][n] = (f32x4){0.f, 0.f, 0.f, 0.f};
  bf16x8 At[4][2], B0[2][2], B1[2][2];
  const char* cA = PG8_APTR(cur); const char* cB = (const char*)g.Bt + (size_t)cur.pn * tstepB;
  PG8_STAGE(PG8_SB(0, 0), cB, voffB); PG8_STAGE(PG8_SA(0, 0), cA, voffA); PG8_STAGE(PG8_SB(0, 1), cB + hstepB, voffB); PG8_STAGE(PG8_SA(0, 1), cA + hstepA, voffA);
  if (wr == 1) PG8_BAR;
  PG8_WAIT_V(4); PG8_BAR;
  PG8_STAGE(PG8_SB(1, 0), cB + kstep, voffB); PG8_STAGE(PG8_SA(1, 0), cA + kstep, voffA); PG8_STAGE(PG8_SB(1, 1), cB + hstepB + kstep, voffB);
  PG8_WAIT_V(6); PG8_BAR;
  for (;;) {
    const bool has_next = S.next(ui + 1, nxt);
    const char* nA = has_next ? PG8_APTR(nxt) : cA; const char* nB = has_next ? (const char*)g.Bt + (size_t)nxt.pn * tstepB : cB;
    for (int t = 0; t < nt; t += 2) {
      const bool last = (t == nt - 2);
      const char* a1 = cA + (size_t)(t + 1) * kstep;
      const char* a2 = last ? nA : cA + (size_t)(t + 2) * kstep; const char* b2 = last ? nB : cB + (size_t)(t + 2) * kstep;
      const char* a3 = a2 + kstep; const char* b3 = b2 + kstep;
      PG8_LDB(B0, 0, 0); PG8_SCHED; PG8_LDA(At, 0, 0); PG8_STAGE(PG8_SA(1, 1), a1 + hstepA, voffA);
      PG8_WAIT_L(8); PG8_BAR; PG8_WAIT_L(0); PG8_MMA(0, 0, At, B0); PG8_BAR; PG8_SCHED;
      PG8_LDB(B1, 0, 1); PG8_STAGE(PG8_SB(0, 0), b2, voffB);
      PG8_BAR; PG8_WAIT_L(0); PG8_MMA(0, 1, At, B1); PG8_BAR;
      PG8_LDA(At, 0, 1); PG8_STAGE(PG8_SA(0, 0), a2, voffA);
      PG8_BAR; PG8_WAIT_L(0); PG8_MMA(1, 0, At, B0); PG8_BAR; PG8_SCHED;
      PG8_STAGE(PG8_SB(0, 1), b2 + hstepB, voffB);
      PG8_WAIT_V(6); PG8_BAR; PG8_MMA(1, 1, At, B1); PG8_BAR;
      PG8_LDB(B0, 1, 0); PG8_SCHED; PG8_LDA(At, 1, 0); PG8_STAGE(PG8_SA(0, 1), a2 + hstepA, voffA);
      PG8_WAIT_L(8); PG8_BAR; PG8_WAIT_L(0); PG8_MMA(0, 0, At, B0); PG8_BAR; PG8_SCHED;
      PG8_LDB(B1, 1, 1); PG8_STAGE(PG8_SB(1, 0), b3, voffB);
      PG8_BAR; PG8_WAIT_L(0); PG8_MMA(0, 1, At, B1); PG8_BAR;
      PG8_LDA(At, 1, 1); PG8_STAGE(PG8_SA(1, 0), a3, voffA);
      PG8_BAR; PG8_WAIT_L(0); PG8_MMA(1, 0, At, B0); PG8_BAR; PG8_SCHED;
      PG8_STAGE(PG8_SB(1, 1), b3 + hstepB, voffB);
      PG8_WAIT_V(6); PG8_BAR; PG8_MMA(1, 1, At, B1); PG8_BAR;
    }
    { const int lane2 = opaque_lane();
      E(acc, cur, wr, wc, lane2 & 15, lane2 >> 4); }
    if (!has_next) break;
#pragma unroll
    for (int a = 0; a < 2; ++a)
#pragma unroll
      for (int b = 0; b < 2; ++b)
#pragma unroll
        for (int m = 0; m < 4; ++m)
#pragma unroll
          for (int n = 0; n < 2; ++n) acc[a][b][m][n] = (f32x4){0.f, 0.f, 0.f, 0.f};
    cur = nxt; cA = nA; cB = nB; ++ui;
  }
  PG8_WAIT_V(0);
  if (wr == 0) PG8_BAR;
  PG8_BAR;
#undef PG8_SA
#undef PG8_SB
#undef PG8_STAGE
#undef PG8_LDA
#undef PG8_LDB
#undef PG8_MMA
#undef PG8_WAIT_V
#undef PG8_WAIT_L
#undef PG8_BAR
#undef PG8_SCHED
#undef PG8_APTR
}

struct EpiBf16 {
  static constexpr bool PERM = true;
  bf16_t* O; size_t ldc;
  __device__ __forceinline__ void operator()(const f32x4 (&acc)[2][2][4][2], const Unit& u, int wr, int wc, int fr, int fq) const {
    const int row0 = u.pm * BM + wr * 64 + fr, col0 = u.pn * BM + wc * 32 + 8 * fq;
#pragma unroll
    for (int ai = 0; ai < 2; ++ai)
#pragma unroll
      for (int m = 0; m < 4; ++m) {
        bf16_t* rowp = O + (size_t)(row0 + ai * HALF + m * 16) * ldc + col0;
#pragma unroll
        for (int bj = 0; bj < 2; ++bj) {
          const f32x4 v0 = acc[ai][bj][m][0], v1 = acc[ai][bj][m][1];
          u32x4 w; w.x = pack2(v0[0], v0[1]); w.y = pack2(v0[2], v0[3]); w.z = pack2(v1[0], v1[1]); w.w = pack2(v1[2], v1[3]);
          *(u32x4*)(rowp + bj * HALF) = w;
        }
      }
  }
};
struct EpiSsdIn {
  static constexpr bool PERM = true;
  bf16_t* z; bf16_t* xbc; float* dt; const float* dt_bias;
  __device__ __forceinline__ void operator()(const f32x4 (&acc)[2][2][4][2], const Unit& u, int wr, int wc, int fr, int fq) const {
    const int row0 = u.pm * BM + wr * 64 + fr, colt = u.pn * BM + wc * 32 + 8 * fq;
    if (u.pn < 24) {
      bf16_t* base = u.pn < 8 ? z : xbc; const size_t ldc = u.pn < 8 ? 2048 : 4096; const int col0 = u.pn < 8 ? colt : colt - 2048;
#pragma unroll
      for (int ai = 0; ai < 2; ++ai)
#pragma unroll
        for (int m = 0; m < 4; ++m) {
          bf16_t* rowp = base + (size_t)(row0 + ai * HALF + m * 16) * ldc + col0;
#pragma unroll
          for (int bj = 0; bj < 2; ++bj) {
            const f32x4 v0 = acc[ai][bj][m][0], v1 = acc[ai][bj][m][1];
            u32x4 w; w.x = pack2(v0[0], v0[1]); w.y = pack2(v0[2], v0[3]); w.z = pack2(v1[0], v1[1]); w.w = pack2(v1[2], v1[3]);
            *(u32x4*)(rowp + bj * HALF) = w;
          }
        }
    } else {
      const int c0 = wc * 32 + 8 * fq;
      if (c0 < 64) {
#pragma unroll
        for (int ai = 0; ai < 2; ++ai)
#pragma unroll
          for (int m = 0; m < 4; ++m) {
            float* rowp = dt + (size_t)(row0 + ai * HALF + m * 16) * 64 + c0;
#pragma unroll
            for (int n = 0; n < 2; ++n) {
              const f32x4 v = acc[ai][0][m][n];
              f32x4 o;
#pragma unroll
              for (int e = 0; e < 4; ++e) o[e] = softplusf(v[e] + dt_bias[c0 + 4 * n + e]);
              *(f32x4*)(rowp + 4 * n) = o;
            }
          }
      }
    }
  }
};
struct EpiOut {
  static constexpr bool PERM = true;
  bf16_t* res; const float* modv_layer; const float* rstd;
  __device__ __forceinline__ void operator()(const f32x4 (&acc)[2][2][4][2], const Unit& u, int wr, int wc, int fr, int fq) const {
    const int row0 = u.pm * BM + wr * 64 + fr, col0 = u.pn * BM + wc * 32 + 8 * fq;
#pragma unroll
    for (int ai = 0; ai < 2; ++ai)
#pragma unroll
      for (int m = 0; m < 4; ++m) {
        const int row = row0 + ai * HALF + m * 16;
        const int mrow = row < T_CTX ? 0 : 1 + ((row - T_CTX) >> 12);
        const float rs = rstd ? rstd[row] : 1.f;
        const float* gp = modv_layer + (size_t)mrow * 3072 + 2048 + col0;
        bf16_t* rowp = res + (size_t)row * DM + col0;
#pragma unroll
        for (int bj = 0; bj < 2; ++bj) {
          const f32x4 g0 = *(const f32x4*)(gp + bj * HALF), g1 = *(const f32x4*)(gp + bj * HALF + 4);
          const u32x4 xw = *(const u32x4*)(rowp + bj * HALF);
          const f32x4 v0 = acc[ai][bj][m][0], v1 = acc[ai][bj][m][1];
          u32x4 o;
          o.x = pack2(ALPHA_RES * bflo(xw.x) + g0.x * (v0[0] * rs), ALPHA_RES * bfhi(xw.x) + g0.y * (v0[1] * rs));
          o.y = pack2(ALPHA_RES * bflo(xw.y) + g0.z * (v0[2] * rs), ALPHA_RES * bfhi(xw.y) + g0.w * (v0[3] * rs));
          o.z = pack2(ALPHA_RES * bflo(xw.z) + g1.x * (v1[0] * rs), ALPHA_RES * bfhi(xw.z) + g1.y * (v1[1] * rs));
          o.w = pack2(ALPHA_RES * bflo(xw.w) + g1.z * (v1[2] * rs), ALPHA_RES * bfhi(xw.w) + g1.w * (v1[3] * rs));
          *(u32x4*)(rowp + bj * HALF) = o;
        }
      }
  }
};
struct EpiLruGate {
  static constexpr bool PERM = true;
  bf16_t* gates; const float* gate_b;
  __device__ __forceinline__ void operator()(const f32x4 (&acc)[2][2][4][2], const Unit& u, int wr, int wc, int fr, int fq) const {
    const int nb = u.pn >> 2, dg = u.pn & 3;
    const int row0 = u.pm * BM + wr * 64 + fr, ch0 = nb * 256 + wc * 32 + 8 * fq;
#pragma unroll
    for (int ai = 0; ai < 2; ++ai)
#pragma unroll
      for (int m = 0; m < 4; ++m) {
        bf16_t* rowp = gates + ((size_t)dg * T_ALL + row0 + ai * HALF + m * 16) * 1024 + ch0;
#pragma unroll
        for (int bj = 0; bj < 2; ++bj) {
          const float* bp = gate_b + dg * 1024 + ch0 + bj * HALF;
          const f32x4 b0 = *(const f32x4*)bp, b1 = *(const f32x4*)(bp + 4);
          const f32x4 v0 = acc[ai][bj][m][0] + b0, v1 = acc[ai][bj][m][1] + b1;
          u32x4 w; w.x = pack2(sigmoidf(v0[0]), sigmoidf(v0[1])); w.y = pack2(sigmoidf(v0[2]), sigmoidf(v0[3]));
          w.z = pack2(sigmoidf(v1[0]), sigmoidf(v1[1])); w.w = pack2(sigmoidf(v1[2]), sigmoidf(v1[3]));
          *(u32x4*)(rowp + bj * HALF) = w;
        }
      }
  }
};
}

template <int KW, bool SILU>
__device__ __forceinline__ void phase_dwconv(const bf16_t* __restrict__ src, int ld_src, bf16_t* __restrict__ dst, int ld_dst, int CH,
                             const float* __restrict__ w, const float* __restrict__ b, bool colmajor, int bid, int nblk, int cxw) {
  const int tidx = opaque_tid(cxw);
  const int cpr = CH / 8;
  const size_t total = (size_t)T_ALL * cpr;
  for (size_t idx = (size_t)bid * NTHR + tidx; idx < total; idx += (size_t)nblk * NTHR) {
    int tok = (int)(idx / cpr), c0 = (int)(idx % cpr) * 8;
    TokInfo ti = tokinfo(tok);
    bool cm = colmajor && ti.s >= 32;
    int pos = seqpos2off(ti.l, cm);
    float acc[8];
#pragma unroll
    for (int e = 0; e < 8; ++e) acc[e] = b[c0 + e];
#pragma unroll
    for (int k = 0; k < KW; ++k) {
      int pp = pos + k - 1;
      if (pp < 0 || pp >= ti.L) continue;
      int tk = ti.base + seqpos2off(pp, cm);
      u32x4 xv = *(const u32x4*)(src + (size_t)tk * ld_src + c0);
      const float* wk = w + (size_t)k * CH + c0;
      acc[0] += wk[0] * bflo(xv.x); acc[1] += wk[1] * bfhi(xv.x);
      acc[2] += wk[2] * bflo(xv.y); acc[3] += wk[3] * bfhi(xv.y);
      acc[4] += wk[4] * bflo(xv.z); acc[5] += wk[5] * bfhi(xv.z);
      acc[6] += wk[6] * bflo(xv.w); acc[7] += wk[7] * bfhi(xv.w);
    }
    if (SILU) {
#pragma unroll
      for (int e = 0; e < 8; ++e) acc[e] = siluf(acc[e]);
    }
    u32x4 o;
    o.x = pack2(acc[0], acc[1]); o.y = pack2(acc[2], acc[3]); o.z = pack2(acc[4], acc[5]); o.w = pack2(acc[6], acc[7]);
    *(u32x4*)(dst + (size_t)tok * ld_dst + c0) = o;
  }
}

__device__ __forceinline__ void phase_ssd_conv(const Params& p, int slot, bool colmajor, int bid, int nblk, unsigned char* smem, int cxw) {
  const int tid = opaque_tid(cxw);
  const bf16_t* raw = (const bf16_t*)(p.scratch + SC_SSD_XBC);
  bf16_t* out = (bf16_t*)(p.scratch + SC_SSD_XBCC);
  bf16_t* XT = (bf16_t*)(p.scratch + SC_SSD_XT);
  bf16_t* BT = (bf16_t*)(p.scratch + SC_SSD_BT);
  bf16_t* BF = (bf16_t*)(p.scratch + SC_SSD_BF);
  bf16_t* CF = (bf16_t*)(p.scratch + SC_SSD_CF);
  const float* cw = p.ssd_conv_w + (size_t)slot * 4 * 4096;
  const float* cb = p.ssd_conv_b + slot * 4096;
  bf16_t* tl = (bf16_t*)smem;
  bf16_t* rt = tl + 64 * 72;
  const int rr = tid >> 2, cpart = tid & 3;
  const int NITEMS = 384 * 64;
  u32x4 pre[3];
#define CONV_PREFETCH(ITEM) do { const int it_ = (ITEM); const int ptile_ = it_ >> 6, ct_ = it_ & 63; \
    const TokInfo ti_ = tokinfo(ptile_ * 64); const bool cm_ = colmajor && ti_.s >= 32; \
    _Pragma("unroll") for (int i_ = 0; i_ < 3; ++i_) { const int q_ = tid + i_ * 256; const int row_ = q_ >> 3, c8_ = (q_ & 7) * 8; \
      const int pp_ = ti_.l - 1 + row_; u32x4 v_ = {0u, 0u, 0u, 0u}; \
      if (row_ < 67 && pp_ >= 0 && pp_ < ti_.L) v_ = *(const u32x4*)(raw + (size_t)(ti_.base + seqpos2off(pp_, cm_)) * 4096 + ct_ * 64 + c8_); \
      pre[i_] = v_; } } while (0)
  if (bid < NITEMS) CONV_PREFETCH(bid);
  float wreg[4][16], wb[16]; int wct = -1;
  for (int item = bid; item < NITEMS; item += nblk) {
    const int ptile = item >> 6, ct = item & 63;
    const int ptok0 = ptile * 64;
    const int ch = ct * 64 + cpart * 16;
    __syncthreads();
#pragma unroll
    for (int i = 0; i < 3; ++i) { const int q = tid + i * 256; if (q < 67 * 8) *(u32x4*)(rt + (q >> 3) * 72 + (q & 7) * 8) = pre[i]; }
    if (item + nblk < NITEMS) CONV_PREFETCH(item + nblk);
    __syncthreads();
    if (ct != wct) {
      wct = ct;
#pragma unroll
      for (int e = 0; e < 16; ++e) wb[e] = cb[ch + e];
#pragma unroll
      for (int k = 0; k < 4; ++k)
#pragma unroll
        for (int e = 0; e < 16; ++e) wreg[k][e] = cw[(size_t)k * 4096 + ch + e];
    }
    float acc[16];
#pragma unroll
    for (int e = 0; e < 16; ++e) acc[e] = wb[e];
#pragma unroll
    for (int k = 0; k < 4; ++k) {
      const bf16_t* rp = rt + (rr + k) * 72 + cpart * 16;
      u32x4 x0 = *(const u32x4*)rp, x1 = *(const u32x4*)(rp + 8);
      unsigned xw[8] = {x0.x, x0.y, x0.z, x0.w, x1.x, x1.y, x1.z, x1.w};
#pragma unroll
      for (int e = 0; e < 8; ++e) { acc[2 * e] += wreg[k][2 * e] * bflo(xw[e]); acc[2 * e + 1] += wreg[k][2 * e + 1] * bfhi(xw[e]); }
    }
    u32x4 o0, o1;
    o0.x = pack2(siluf(acc[0]), siluf(acc[1])); o0.y = pack2(siluf(acc[2]), siluf(acc[3]));
    o0.z = pack2(siluf(acc[4]), siluf(acc[5])); o0.w = pack2(siluf(acc[6]), siluf(acc[7]));
    o1.x = pack2(siluf(acc[8]), siluf(acc[9])); o1.y = pack2(siluf(acc[10]), siluf(acc[11]));
    o1.z = pack2(siluf(acc[12]), siluf(acc[13])); o1.w = pack2(siluf(acc[14]), siluf(acc[15]));
    *(u32x4*)(tl + rr * 72 + cpart * 16) = o0;
    *(u32x4*)(tl + rr * 72 + cpart * 16 + 8) = o1;
    __syncthreads();
    if (ct < 32) {
      const int crow = tid >> 2, part = tid & 3;
      unsigned wv[8];
#pragma unroll
      for (int e = 0; e < 8; ++e) {
        unsigned lo = tl[(part * 16 + 2 * e) * 72 + crow], hi = tl[(part * 16 + 2 * e + 1) * 72 + crow];
        wv[e] = lo | (hi << 16);
      }
      bf16_t* dp = XT + (size_t)(ct * 64 + crow) * T_ALL + ptok0 + part * 16;
      u32x4 t0, t1;
      t0.x = wv[0]; t0.y = wv[1]; t0.z = wv[2]; t0.w = wv[3]; t1.x = wv[4]; t1.y = wv[5]; t1.z = wv[6]; t1.w = wv[7];
      *(u32x4*)dp = t0; *(u32x4*)(dp + 8) = t1;
    } else {
      const bool isB = ct < 48;
      const int cq = (ct - (isB ? 32 : 48));
      const int g = cq >> 1, chhalf = cq & 1;
      const int lane = tid & 63, r = lane & 31, hh = lane >> 5;
      bf16_t* F = isB ? BF : CF;
#pragma unroll
      for (int i = 0; i < 2; ++i) {
        const int f = (cxw & 3) + 4 * i;
        const int rt2 = f >> 2, kk4 = f & 3;
        const u32x4 v = *(const u32x4*)(tl + (32 * rt2 + r) * 72 + 16 * kk4 + 8 * hh);
        const size_t rt = (size_t)(ptok0 >> 5) + rt2;
        *(u32x4*)(F + (((rt * 8 + g) * 8 + chhalf * 4 + kk4) * 64 + lane) * 8) = v;
      }
      if (isB) {
#pragma unroll
        for (int i = 0; i < 2; ++i) {
          const int f = (cxw & 3) + 4 * i;
          const int nt2 = f >> 2, ts4 = f & 3;
          unsigned wv[4];
#pragma unroll
          for (int e = 0; e < 4; ++e) {
            unsigned lo = tl[(16 * ts4 + 8 * hh + 2 * e) * 72 + 32 * nt2 + r], hi = tl[(16 * ts4 + 8 * hh + 2 * e + 1) * 72 + 32 * nt2 + r];
            wv[e] = lo | (hi << 16);
          }
          u32x4 v; v.x = wv[0]; v.y = wv[1]; v.z = wv[2]; v.w = wv[3];
          const size_t ts = (size_t)(ptok0 >> 4) + ts4;
          *(u32x4*)(BT + (((ts * 8 + g) * 4 + chhalf * 2 + nt2) * 64 + lane) * 8) = v;
        }
      }
    }
  }
}

#define SH_STRIDE 136
__device__ __forceinline__ int rowmap(int e, int hh) { return (e & 3) + 8 * (e >> 2) + 4 * hh; }
__device__ __forceinline__ bf16x8 pack8(float a0, float a1, float a2, float a3, float a4, float a5, float a6, float a7) {
  u32x4 v; v.x = pack2(a0, a1); v.y = pack2(a2, a3); v.z = pack2(a4, a5); v.w = pack2(a6, a7);
  return __builtin_bit_cast(bf16x8, v);
}
#define SCAN_PRIV 49152
#define SCAN_SF 49152
__device__ __forceinline__ void phase_ssd_scan(const Params& p, int slot, bool colmajor, int bid, int nblk, unsigned char* wg_smem, int cxw) {
  const int tid = opaque_tid(cxw), lane = tid & 63, w = cxw & 3, vb = cxw >> 2, r = lane & 31, hh = lane >> 5;
  const int it = w >> 1, pt = w & 1;
  const bf16_t* XT = (const bf16_t*)(p.scratch + SC_SSD_XT);
  const bf16_t* BT = (const bf16_t*)(p.scratch + SC_SSD_BT);
  const bf16_t* BF = (const bf16_t*)(p.scratch + SC_SSD_BF);
  const bf16_t* CF = (const bf16_t*)(p.scratch + SC_SSD_CF);
  const float* dtb = (const float*)(p.scratch + SC_SSD_DT);
  bf16_t* ybuf = (bf16_t*)(p.scratch + SC_SSD_XBC);
  unsigned char* priv = wg_smem + (vb ? SCAN_SF + SCAN_PRIV : 0);
  bf16_t* sXr = (bf16_t*)priv;
  bf16_t* sXs = sXr + 64 * 72;
  bf16_t* sH = sXs + 64 * 72;
  float* sW = (float*)(sH + 64 * SH_STRIDE);
  bf16_t* sY = (bf16_t*)(sW + 4 * 256);
  float* myW = sW + w * 256;
  const bf16_t* sfC = (const bf16_t*)(wg_smem + SCAN_PRIV);
  const bf16_t* sfB = sfC + 8192;
  const bf16_t* sfT = sfC + 16384;
  for (int item = bid; item < 36 * 64; item += nblk) {
    int s, h, dir;
    {
      const int itx = item < 256 ? item : item - 256;
      const int idx = itx & 63, pairidx = idx >> 1;
      s = item < 256 ? 32 + (itx >> 6) : (itx >> 6);
      dir = pairidx & 1; h = (pairidx >> 1) * 2 + (idx & 1);
    }
    const int L = s < 32 ? 256 : 4096;
    const int base = s < 32 ? s * 256 : T_CTX + (s - 32) * 4096;
    const bool cm = colmajor && s >= 32;
    const int g = h >> 2;
    const float Aval = -expf(p.ssd_a_log[(slot * 2 + dir) * 32 + h]);
    const float dskip = p.ssd_d[slot * 32 + h];
    const int nchunks = L >> 6;
    const int pcol = 32 * pt + r;
    f32x16 hacc[2];
    if (s >= 32) {
      const float* h0 = p.state_ssd + ((((size_t)(s - 32) * 2 + slot) * 2 + dir) * 32 + h) * 8192 + (size_t)pcol * 128;
#pragma unroll
      for (int t2 = 0; t2 < 2; ++t2)
#pragma unroll
        for (int qd = 0; qd < 4; ++qd) {
          f32x4 v = *(const f32x4*)(h0 + 32 * (2 * it + t2) + 8 * qd + 4 * hh);
          hacc[t2][4 * qd] = v.x; hacc[t2][4 * qd + 1] = v.y; hacc[t2][4 * qd + 2] = v.z; hacc[t2][4 * qd + 3] = v.w;
        }
    } else {
#pragma unroll
      for (int t2 = 0; t2 < 2; ++t2)
#pragma unroll
        for (int e = 0; e < 16; ++e) hacc[t2][e] = 0.f;
    }
#define SCAN_PTOK(c) (base + 64 * (dir ? nchunks - 1 - (c) : (c)))
#define SCAN_LOAD_DTX(pt0) do { \
      const int tok_ = base + seqpos2off((pt0) - base + lane, cm); \
      dtv = dtb[(size_t)tok_ * 64 + dir * 32 + h]; \
      _Pragma("unroll") for (int i_ = 0; i_ < 2; ++i_) { const int q_ = tid + i_ * 256; \
        xtr[i_] = *(const u32x4*)(XT + (size_t)(h * 64 + (q_ >> 3)) * T_ALL + (pt0) + (q_ & 7) * 8); } } while (0)
#define SCAN_DMA(pt0) do { \
      _Pragma("unroll") for (int i_ = 0; i_ < 6; ++i_) { const int q_ = cxw + 8 * (i_ & 1); \
        const bf16_t* src_; \
        if (i_ < 4) src_ = (i_ < 2 ? CF : BF) + ((((size_t)((pt0) >> 5) + (q_ >> 3)) * 8 + g) * 8 + (q_ & 7)) * 512 + lane * 8; \
        else src_ = BT + ((((size_t)((pt0) >> 4) + (q_ >> 2)) * 8 + g) * 4 + (q_ & 3)) * 512 + lane * 8; \
        __builtin_amdgcn_global_load_lds((const unsigned*)src_, (PG8_LAS unsigned*)(wg_smem + SCAN_PRIV + (i_ >> 1) * 16384 + q_ * 1024), 16, 0, 0); } } while (0)
#define SCAN_WRITE_STATE() do { \
      _Pragma("unroll") for (int t2 = 0; t2 < 2; ++t2) _Pragma("unroll") for (int qd = 0; qd < 4; ++qd) { \
        u32x2 o_; o_.x = pack2(hacc[t2][4 * qd], hacc[t2][4 * qd + 1]); o_.y = pack2(hacc[t2][4 * qd + 2], hacc[t2][4 * qd + 3]); \
        *(u32x2*)(sH + pcol * SH_STRIDE + 32 * (2 * it + t2) + 8 * qd + 4 * hh) = o_; } } while (0)
    const bool need0 = dir == 0 ? true : (it == 0);
    const bool need1 = dir == 0 ? (it == 1) : true;
    float dtv; u32x4 xtr[2];
    __syncthreads();
    {
      const int p0 = SCAN_PTOK(0);
      SCAN_DMA(p0);
      SCAN_LOAD_DTX(p0);
      SCAN_WRITE_STATE();
    }
    for (int ci = 0; ci < nchunks; ++ci) {
      const int cin = ci + 1 < nchunks ? ci + 1 : ci;
      const int ptokN = SCAN_PTOK(cin);
      __syncthreads();
      if (ci > 0) {
        const int ptokP = SCAN_PTOK(ci - 1);
#pragma unroll
        for (int i = 0; i < 2; ++i) {
          const int q = tid + i * 256, yrow = q >> 3, c8 = (q & 7) * 8;
          *(u32x4*)(ybuf + ((size_t)dir * T_ALL + ptokP + yrow) * 2048 + h * 64 + c8) = *(const u32x4*)(sY + yrow * 72 + c8);
        }
      }
      float decE;
      {
        const float a_ = dtv * Aval;
        const float pre = wave_incl_scan(a_);
        const float cE = __int_as_float(__builtin_amdgcn_readlane(__float_as_int(pre), 63));
        const float c = dir == 0 ? pre : cE - pre + a_;
        myW[lane] = dtv; myW[64 + lane] = c; myW[128 + lane] = __expf(c); myW[192 + lane] = dtv * __expf(cE - c);
        decE = __expf(cE);
      }
#pragma unroll
      for (int i = 0; i < 2; ++i) {
        const int q = tid + i * 256, prow = q >> 3, j8 = (q & 7) * 8;
        const u32x4 raw = xtr[i];
        *(u32x4*)(sXr + prow * 72 + j8) = raw;
        f32x4 f0 = *(const f32x4*)(myW + 192 + j8), f1 = *(const f32x4*)(myW + 192 + j8 + 4);
        u32x4 sc;
        sc.x = pack2(bflo(raw.x) * f0.x, bfhi(raw.x) * f0.y); sc.y = pack2(bflo(raw.y) * f0.z, bfhi(raw.y) * f0.w);
        sc.z = pack2(bflo(raw.z) * f1.x, bfhi(raw.z) * f1.y); sc.w = pack2(bflo(raw.w) * f1.z, bfhi(raw.w) * f1.w);
        *(u32x4*)(sXs + prow * 72 + j8) = sc;
      }
      asm volatile("s_waitcnt vmcnt(0)" ::: "memory");
      __syncthreads();
      SCAN_LOAD_DTX(ptokN);
#pragma unroll
      for (int t2 = 0; t2 < 2; ++t2) {
#pragma unroll
        for (int e = 0; e < 16; ++e) hacc[t2][e] *= decE;
        const bf16_t* xs = sXs + pcol * 72 + 8 * hh;
#pragma unroll
        for (int kk = 0; kk < 4; ++kk)
          hacc[t2] = __builtin_amdgcn_mfma_f32_32x32x16_bf16(*(const bf16x8*)(sfT + (kk * 4 + 2 * it + t2) * 512 + lane * 8), *(const bf16x8*)(xs + 16 * kk), hacc[t2], 0, 0, 0);
      }
      bf16x8 cfr[8];
#pragma unroll
      for (int kk = 0; kk < 8; ++kk) cfr[kk] = *(const bf16x8*)(sfC + (it * 8 + kk) * 512 + lane * 8);
      f32x16 acc;
#pragma unroll
      for (int e = 0; e < 16; ++e) acc[e] = 0.f;
      {
        const bf16_t* hp = sH + pcol * SH_STRIDE + 8 * hh;
#pragma unroll
        for (int kk = 0; kk < 8; ++kk) acc = __builtin_amdgcn_mfma_f32_32x32x16_bf16(cfr[kk], *(const bf16x8*)(hp + 16 * kk), acc, 0, 0, 0);
      }
#pragma unroll
      for (int qd = 0; qd < 4; ++qd) {
        f32x4 ec = *(const f32x4*)(myW + 128 + 32 * it + 8 * qd + 4 * hh);
        acc[4 * qd] *= ec.x; acc[4 * qd + 1] *= ec.y; acc[4 * qd + 2] *= ec.z; acc[4 * qd + 3] *= ec.w;
      }
      const int icol = 32 * it + r;
      const float ci_ = myW[64 + icol];
#pragma unroll
      for (int jt = 0; jt < 2; ++jt) {
        const bool needed = jt == 0 ? need0 : need1;
        if (needed) {
          f32x16 X;
#pragma unroll
          for (int e = 0; e < 16; ++e) X[e] = 0.f;
#pragma unroll
          for (int kk = 0; kk < 8; ++kk) X = __builtin_amdgcn_mfma_f32_32x32x16_bf16(*(const bf16x8*)(sfB + (jt * 8 + kk) * 512 + lane * 8), cfr[kk], X, 0, 0, 0);
#pragma unroll
          for (int qd = 0; qd < 4; ++qd) {
            const int j0 = 32 * jt + 8 * qd + 4 * hh;
            f32x4 cj = *(const f32x4*)(myW + 64 + j0), dj = *(const f32x4*)(myW + j0);
            float cjv[4] = {cj.x, cj.y, cj.z, cj.w}, djv[4] = {dj.x, dj.y, dj.z, dj.w};
#pragma unroll
            for (int u = 0; u < 4; ++u) {
              const int j = j0 + u;
              const bool ok = dir == 0 ? (j <= icol) : (j >= icol);
              const float m = __expf(ci_ - cjv[u]) * djv[u];
              X[4 * qd + u] = ok ? X[4 * qd + u] * m : 0.f;
            }
          }
#pragma unroll
          for (int sk = 0; sk < 2; ++sk) {
            bf16x8 afr = pack8(X[8 * sk], X[8 * sk + 1], X[8 * sk + 2], X[8 * sk + 3], X[8 * sk + 4], X[8 * sk + 5], X[8 * sk + 6], X[8 * sk + 7]);
            const bf16_t* xp = sXr + pcol * 72 + 32 * jt + 16 * sk + 4 * hh;
            u32x2 lo = *(const u32x2*)xp, hi = *(const u32x2*)(xp + 8);
            u32x4 xv; xv.x = lo.x; xv.y = lo.y; xv.z = hi.x; xv.w = hi.y;
            acc = __builtin_amdgcn_mfma_f32_32x32x16_bf16(afr, __builtin_bit_cast(bf16x8, xv), acc, 0, 0, 0);
          }
        }
      }
      if (dir == 0) {
#pragma unroll
        for (int qd = 0; qd < 4; ++qd) {
          const u32x2 xw = *(const u32x2*)(sXr + pcol * 72 + 32 * it + 8 * qd + 4 * hh);
          acc[4 * qd] += dskip * bflo(xw.x); acc[4 * qd + 1] += dskip * bfhi(xw.x);
          acc[4 * qd + 2] += dskip * bflo(xw.y); acc[4 * qd + 3] += dskip * bfhi(xw.y);
        }
      }
      __syncthreads();
      SCAN_DMA(ptokN);
      SCAN_WRITE_STATE();
      {
        bf16_t* yo = sY + (32 * it) * 72 + pcol;
#pragma unroll
        for (int e = 0; e < 16; ++e) yo[rowmap(e, hh) * 72] = f2bf(acc[e]);
      }
    }
    __syncthreads();
    {
      const int ptokP = SCAN_PTOK(nchunks - 1);
#pragma unroll
      for (int i = 0; i < 2; ++i) {
        const int q = tid + i * 256, yrow = q >> 3, c8 = (q & 7) * 8;
        *(u32x4*)(ybuf + ((size_t)dir * T_ALL + ptokP + yrow) * 2048 + h * 64 + c8) = *(const u32x4*)(sY + yrow * 72 + c8);
      }
    }
#undef SCAN_PTOK
#undef SCAN_LOAD_DTX
#undef SCAN_DMA
#undef SCAN_WRITE_STATE
    if (s < 32) {
      float* ho = p.out_ssd + ((((size_t)s * 2 + slot) * 2 + dir) * 32 + h) * 8192 + (size_t)pcol * 128;
#pragma unroll
      for (int t2 = 0; t2 < 2; ++t2)
#pragma unroll
        for (int qd = 0; qd < 4; ++qd) {
          f32x4 v; v.x = hacc[t2][4 * qd]; v.y = hacc[t2][4 * qd + 1]; v.z = hacc[t2][4 * qd + 2]; v.w = hacc[t2][4 * qd + 3];
          *(f32x4*)(ho + 32 * (2 * it + t2) + 8 * qd + 4 * hh) = v;
        }
    }
    asm volatile("s_waitcnt vmcnt(0)" ::: "memory");
  }
}

__device__ __forceinline__ void phase_ssd_gate(const Params& p, int slot, int bid, int nblk, int cxw) {
  const int tidx = opaque_tid(cxw);
  bf16_t* zb = (bf16_t*)(p.scratch + SC_SSD_Z);
  const bf16_t* yfb = (const bf16_t*)(p.scratch + SC_SSD_XBC);
  const bf16_t* ybb = yfb + (size_t)T_ALL * 2048;
  const bf16_t* xbcc = (const bf16_t*)(p.scratch + SC_SSD_XBCC);
  int lane = tidx & 63, wv = cxw & 3;
  for (int row = bid * 4 + wv; row < T_ALL; row += nblk * 4) {
    float ss = 0.f;
    TokInfo ti = tokinfo(row);
    const int prow = ti.base + seqpos2off(ti.l, slot == 1 && ti.s >= 32);
#pragma unroll
    for (int j = 0; j < 4; ++j) {
      int c0 = j * 512 + lane * 8;
      u32x4 zv = *(const u32x4*)(zb + (size_t)row * 2048 + c0);
      u32x4 fv = *(const u32x4*)(yfb + (size_t)prow * 2048 + c0);
      u32x4 bv = *(const u32x4*)(ybb + (size_t)prow * 2048 + c0);
      unsigned zw[4] = {zv.x, zv.y, zv.z, zv.w}, fw[4] = {fv.x, fv.y, fv.z, fv.w}, bw[4] = {bv.x, bv.y, bv.z, bv.w};
      unsigned ow[4];
#pragma unroll
      for (int e = 0; e < 4; ++e) {
        float y0 = (bflo(fw[e]) + bflo(bw[e])) * siluf(bflo(zw[e]));
        float y1 = (bfhi(fw[e]) + bfhi(bw[e])) * siluf(bfhi(zw[e]));
        ss += y0 * y0 + y1 * y1;
        ow[e] = pack2(y0, y1);
      }
      u32x4 o; o.x = ow[0]; o.y = ow[1]; o.z = ow[2]; o.w = ow[3];
      *(u32x4*)(zb + (size_t)row * 2048 + c0) = o;
    }
#pragma unroll
    for (int o = 32; o > 0; o >>= 1) ss += shfl_xor_f(ss, o, lane);
    if (lane == 0) p.rstd[row] = rsqrtf(ss * (1.f / 2048.f) + 1e-5f);
  }
}

#define HY_UOFF (32768 + 64)
__device__ __forceinline__ void hy_stage_conv(const Params& p, const bf16_t* __restrict__ row, int ch, bf16_t* dst, int dstStride, int dstPad,
                                              int nelem, int L, int tid) {
  const float w0 = p.hy_conv_w[ch], w1 = p.hy_conv_w[3072 + ch], w2 = p.hy_conv_w[2 * 3072 + ch], bb = p.hy_conv_b[ch];
  for (int q = tid; q < nelem / 8; q += NTHR) {
    const int e0 = q * 8, b = e0 / L, t0 = e0 & (L - 1);
    u32x4 raw = *(const u32x4*)(row + e0);
    float x[10];
    x[0] = t0 > 0 ? bf2f(row[e0 - 1]) : 0.f;
    x[9] = t0 + 8 < L ? bf2f(row[e0 + 8]) : 0.f;
    x[1] = bflo(raw.x); x[2] = bfhi(raw.x); x[3] = bflo(raw.y); x[4] = bfhi(raw.y);
    x[5] = bflo(raw.z); x[6] = bfhi(raw.z); x[7] = bflo(raw.w); x[8] = bfhi(raw.w);
    float o[8];
#pragma unroll
    for (int j = 0; j < 8; ++j) o[j] = w0 * x[j] + w1 * x[j + 1] + w2 * x[j + 2] + bb;
    u32x4 ov; ov.x = pack2(o[0], o[1]); ov.y = pack2(o[2], o[3]); ov.z = pack2(o[4], o[5]); ov.w = pack2(o[6], o[7]);
    *(u32x4*)(dst + b * dstStride + dstPad + t0) = ov;
  }
}

__device__ __forceinline__ void phase_hy_longconv(const Params& p, int bid, int nblk, unsigned char* smem, int cxw) {
  const int tid = opaque_tid(cxw), lane = tid & 63, w = cxw & 3  , r = lane & 31, hh = lane >> 5;
  const bf16_t* projT = (const bf16_t*)(p.scratch + SC_HY_PROJT);
  bf16_t* yT = (bf16_t*)(p.scratch + SC_HY_YT);
  unsigned* Rc0 = (unsigned*)smem;
  unsigned* Rc1 = Rc0 + 4096 + 16;
  bf16_t* G = (bf16_t*)smem;
  bf16_t* U = (bf16_t*)(smem + HY_UOFF);
  for (int item = bid; item < 2048; item += nblk) {
    const bool lat = item < 1024;
    const int c = item & 1023;
    const int L = lat ? 4096 : 256, NB = lat ? 4 : 32, RL = lat ? 8192 : 512, Lm1 = L - 1;
    const int PAD = lat ? 224 : 0, US = lat ? 4552 : 264;
    const int tokbase = lat ? T_CTX : 0;
    const int nI = L >> 5, nelem = NB * L;
    const int TPW = lat ? 4 : 2;
    __syncthreads();
    if (lat) {
      for (int q = tid; q < 4 * 57; q += NTHR) {
        int b = q / 57, k = q % 57;
        int off = k < 28 ? k * 8 : 224 + 4096 + (k - 28) * 8;
        unsigned zz = 0u; asm volatile("" : "+v"(zz));
        u32x4 z4 = {zz, zz, zz, zz};
        *(u32x4*)(U + b * US + off) = z4;
      }
    }
    hy_stage_conv(p, projT + (size_t)c * T_ALL + tokbase, c, U, US, PAD, nelem, L, tid);
    int Icol[4], bcol[4];
#pragma unroll
    for (int tt = 0; tt < 4; ++tt) {
      int n = (w * TPW + tt) * 32 + r;
      Icol[tt] = lat ? (n >> 2) : (n >> 5);
      bcol[tt] = lat ? (n & 3) : (n & 31);
    }
    const int Ilo_w = lat ? 32 * w : 2 * w, Ihi_w = lat ? 32 * w + 31 : 2 * w + 1;
    const int dlo = Ilo_w - (nI - 1), dhi = Ihi_w;
    float invs[2], biases[2];
#pragma unroll
    for (int o2 = 0; o2 < 2; ++o2) { invs[o2] = p.knorm[((lat ? 1 : 0) * 2 + o2) * 1024 + c]; biases[o2] = p.hy_f_bias[o2 * 1024 + c]; }
    for (int order = 0; order < 2; ++order) {
      {
        const bf16_t* src = (lat ? p.rtab1 : p.rtab0) + (size_t)(order * 1024 + c) * RL;
        for (int q = tid; q < RL / 8; q += NTHR) {
          u32x4 cv = *(const u32x4*)(src + q * 8);
          unsigned nx = (q + 1 < RL / 8) ? *(const unsigned*)(src + q * 8 + 8) : 0u;
          *(u32x4*)(Rc0 + q * 4) = cv;
          u32x4 sv;
          sv.x = (cv.x >> 16) | (cv.y << 16); sv.y = (cv.y >> 16) | (cv.z << 16);
          sv.z = (cv.z >> 16) | (cv.w << 16); sv.w = (cv.w >> 16) | (nx << 16);
          *(u32x4*)(Rc1 + q * 4) = sv;
        }
      }
      __syncthreads();
      u32x2 zpre[4][4];
      if (order == 1) {
#pragma unroll
        for (int tt = 0; tt < 4; ++tt)
          if (tt < TPW) {
#pragma unroll
            for (int qd = 0; qd < 4; ++qd)
              zpre[tt][qd] = *(const u32x2*)(projT + (size_t)(3072 + c) * T_ALL + tokbase + bcol[tt] * L + 32 * Icol[tt] + 8 * qd + 4 * hh);
          }
      }
      f32x16 acc[4];
#pragma unroll
      for (int tt = 0; tt < 4; ++tt)
#pragma unroll
        for (int e = 0; e < 16; ++e) acc[tt][e] = 0.f;
      {
        int lo_t[4], hi_t[4];
        const bf16_t* ub[4];
#pragma unroll
        for (int tt = 0; tt < 4; ++tt) {
          const int tile = w * TPW + tt;
          const int Ilo_t = lat ? 8 * tile : tile, Ihi_t = lat ? 8 * tile + 7 : tile;
          lo_t[tt] = tt < TPW ? Ilo_t - (nI - 1) : 1 << 30; hi_t[tt] = tt < TPW ? Ihi_t : -(1 << 30);
          ub[tt] = U + bcol[tt] * US + PAD + 32 * Icol[tt] + 8 * hh;
        }
        const int ybase = Lm1 - r + 8 * hh;
#define LC_EDGE(D0, D1) do { for (int d_ = (D0); d_ <= (D1); ++d_) { \
          _Pragma("unroll") for (int kk_ = 0; kk_ < 2; ++kk_) { \
            const int y0_ = ybase - 32 * d_ + 16 * kk_; const int par_ = y0_ & 1; \
            const unsigned* rp_ = (par_ ? Rc1 : Rc0) + ((y0_ - par_) >> 1); \
            u32x4 av_; av_.x = rp_[0]; av_.y = rp_[1]; av_.z = rp_[2]; av_.w = rp_[3]; const bf16x8 af_ = __builtin_bit_cast(bf16x8, av_); \
            _Pragma("unroll") for (int tt = 0; tt < 4; ++tt) if (d_ >= lo_t[tt] && d_ <= hi_t[tt]) \
              acc[tt] = __builtin_amdgcn_mfma_f32_32x32x16_bf16(af_, *(const bf16x8*)(ub[tt] - 32 * d_ + 16 * kk_), acc[tt], 0, 0, 0); } } } while (0)
        if (!lat) {
          LC_EDGE(dlo, dhi);
        } else {
          const int mlo = lo_t[3], mhi = hi_t[0];
          LC_EDGE(dlo, mlo - 1);
#define LC_LOAD(IT, A, B) do { const int it_ = (IT); const int d_ = mlo + (it_ >> 1), kk_ = it_ & 1; \
          const int y0_ = ybase - 32 * d_ + 16 * kk_; const int par_ = y0_ & 1; \
          const unsigned* rp_ = (par_ ? Rc1 : Rc0) + ((y0_ - par_) >> 1); \
          u32x4 av_; av_.x = rp_[0]; av_.y = rp_[1]; av_.z = rp_[2]; av_.w = rp_[3]; A = __builtin_bit_cast(bf16x8, av_); \
          _Pragma("unroll") for (int tt = 0; tt < 4; ++tt) B[tt] = *(const bf16x8*)(ub[tt] - 32 * d_ + 16 * kk_); } while (0)
#define LC_MMA(A, B) do { _Pragma("unroll") for (int tt = 0; tt < 4; ++tt) acc[tt] = __builtin_amdgcn_mfma_f32_32x32x16_bf16(A, B[tt], acc[tt], 0, 0, 0); } while (0)
          const int NIT = 2 * (mhi - mlo + 1);
          bf16x8 a0, a1, b0[4], b1[4];
          LC_LOAD(0, a0, b0);
          for (int it = 0; it < NIT; it += 2) {
            LC_LOAD(it + 1, a1, b1);
            __builtin_amdgcn_sched_barrier(0);
            LC_MMA(a0, b0);
            __builtin_amdgcn_sched_barrier(0);
            LC_LOAD(it + 2 < NIT ? it + 2 : NIT - 1, a0, b0);
            __builtin_amdgcn_sched_barrier(0);
            LC_MMA(a1, b1);
            __builtin_amdgcn_sched_barrier(0);
          }
#undef LC_LOAD
#undef LC_MMA
          LC_EDGE(mhi + 1, dhi);
        }
#undef LC_EDGE
      }
      __syncthreads();
      hy_stage_conv(p, projT + (size_t)((1 + order) * 1024 + c) * T_ALL + tokbase, (1 + order) * 1024 + c, G, L, 0, nelem, L, tid);
      __syncthreads();
      const float inv = __builtin_amdgcn_rcpf(order ? invs[1] : invs[0]);
      const float bias = order ? biases[1] : biases[0];
#pragma unroll
      for (int tt = 0; tt < 4; ++tt) {
        if (tt < TPW) {
#pragma unroll
          for (int qd = 0; qd < 4; ++qd) {
            const int t0 = 32 * Icol[tt] + 8 * qd + 4 * hh;
            bf16_t* up = U + bcol[tt] * US + PAD + t0;
            u32x2 uc = *(const u32x2*)up;
            u32x2 gg = *(const u32x2*)(G + bcol[tt] * L + t0);
            float r0 = (inv * acc[tt][4 * qd] + bias * bflo(uc.x)) * bflo(gg.x);
            float r1 = (inv * acc[tt][4 * qd + 1] + bias * bfhi(uc.x)) * bfhi(gg.x);
            float r2 = (inv * acc[tt][4 * qd + 2] + bias * bflo(uc.y)) * bflo(gg.y);
            float r3 = (inv * acc[tt][4 * qd + 3] + bias * bfhi(uc.y)) * bfhi(gg.y);
            if (order == 1) {
              const u32x2 zz = zpre[tt][qd];
              r0 *= siluf(bflo(zz.x)); r1 *= siluf(bfhi(zz.x)); r2 *= siluf(bflo(zz.y)); r3 *= siluf(bfhi(zz.y));
            }
            u32x2 ov; ov.x = pack2(r0, r1); ov.y = pack2(r2, r3);
            *(u32x2*)up = ov;
          }
        }
      }
      __syncthreads();
    }
    for (int q = tid; q < nelem / 8; q += NTHR) {
      const int e0 = q * 8, b = e0 / L, t0 = e0 & (L - 1);
      *(u32x4*)(yT + (size_t)c * T_ALL + tokbase + e0) = *(const u32x4*)(U + b * US + PAD + t0);
    }
  }
}

__device__ __forceinline__ void phase_hy_transpose(const Params& p, int bid, int nblk, unsigned char* smem, int cxw) {
  const int tid = opaque_tid(cxw);
  const bf16_t* yT = (const bf16_t*)(p.scratch + SC_HY_YT);
  bf16_t* yg = (bf16_t*)(p.scratch + SC_HY_YG);
  bf16_t* tl = (bf16_t*)smem;
  for (int item = bid; item < 16 * (T_ALL / 64); item += nblk) {
    const int cb = item & 15, tb = item >> 4;
    __syncthreads();
#pragma unroll
    for (int i = 0; i < 2; ++i) {
      int q = tid + i * 256, cr = q >> 3, t8 = (q & 7) * 8;
      u32x4 v = *(const u32x4*)(yT + (size_t)(cb * 64 + cr) * T_ALL + tb * 64 + t8);
      unsigned wv[4] = {v.x, v.y, v.z, v.w};
#pragma unroll
      for (int e = 0; e < 4; ++e) {
        tl[(t8 + 2 * e) * 72 + cr] = (bf16_t)(wv[e] & 0xffffu);
        tl[(t8 + 2 * e + 1) * 72 + cr] = (bf16_t)(wv[e] >> 16);
      }
    }
    __syncthreads();
#pragma unroll
    for (int i = 0; i < 2; ++i) {
      int q = tid + i * 256, tr = q >> 3, c8 = (q & 7) * 8;
      *(u32x4*)(yg + (size_t)(tb * 64 + tr) * 1024 + cb * 64 + c8) = *(const u32x4*)(tl + tr * 72 + c8);
    }
  }
}

#define LRU_NCH 384
struct Lru4 { float af[4], bxf[4], ab[4], bxb[4]; };
__device__ __forceinline__ void lru_unpack4(u32x2 v, float (&o)[4]) { o[0] = bflo(v.x); o[1] = bfhi(v.x); o[2] = bflo(v.y); o[3] = bfhi(v.y); }
__device__ __forceinline__ void lru_row_f(const bf16_t* gates, const bf16_t* xc, size_t o, const float (&spf)[4], float (&af)[4], float (&bxf)[4]) {
  float r[4], g[4], x[4];
  lru_unpack4(*(const u32x2*)(gates + o), r); lru_unpack4(*(const u32x2*)(gates + (size_t)T_ALL * 1024 + o), g); lru_unpack4(*(const u32x2*)(xc + o), x);
#pragma unroll
  for (int e = 0; e < 4; ++e) { const float la = -8.f * r[e] * spf[e]; af[e] = __expf(la); bxf[e] = sqrtf(fmaxf(1.f - __expf(2.f * la), 0.f)) * g[e] * x[e]; }
}
__device__ __forceinline__ void lru_row_b(const bf16_t* gates, const bf16_t* xc, size_t o, const float (&spb)[4], float (&ab)[4], float (&bxb)[4]) {
  float r[4], g[4], x[4];
  lru_unpack4(*(const u32x2*)(gates + (size_t)2 * T_ALL * 1024 + o), r); lru_unpack4(*(const u32x2*)(gates + (size_t)3 * T_ALL * 1024 + o), g); lru_unpack4(*(const u32x2*)(xc + o), x);
#pragma unroll
  for (int e = 0; e < 4; ++e) { const float la = -8.f * r[e] * spb[e]; ab[e] = __expf(la); bxb[e] = sqrtf(fmaxf(1.f - __expf(2.f * la), 0.f)) * g[e] * x[e]; }
}
__device__ __forceinline__ void phase_lru_scan_agg(const Params& p, int bid, int nblk, unsigned char* smem, int cxw) {
  const int tidx = opaque_tid(cxw);
  const bf16_t* gates = (const bf16_t*)(p.scratch + SC_LRU_GATES);
  const bf16_t* xc = (const bf16_t*)(p.scratch + SC_LRU_XC);
  float* sagg = (float*)smem;
  const int sub = cxw & 3, cq = tidx & 63;
  for (int item = bid; item < LRU_NCH * 4; item += nblk) {
    const int chunk = item >> 2, cb = item & 3;
    const int c0 = cb * 256 + 4 * cq;
    float spf[4], spb[4];
#pragma unroll
    for (int e = 0; e < 4; ++e) { spf[e] = softplusf(-p.lru_a_param[c0 + e]); spb[e] = softplusf(-p.lru_a_param[1024 + c0 + e]); }
    const int tok0 = chunk * 64 + 16 * sub;
    float Af[4] = {1.f, 1.f, 1.f, 1.f}, hf[4] = {0.f, 0.f, 0.f, 0.f}, Pb[4] = {1.f, 1.f, 1.f, 1.f}, Bb[4] = {0.f, 0.f, 0.f, 0.f};
#pragma unroll 4
    for (int j = 0; j < 16; ++j) {
      const size_t o = (size_t)(tok0 + j) * 1024 + c0;
      float af[4], bxf[4], ab[4], bxb[4];
      lru_row_f(gates, xc, o, spf, af, bxf);
      lru_row_b(gates, xc, o, spb, ab, bxb);
#pragma unroll
      for (int e = 0; e < 4; ++e) { hf[e] = af[e] * hf[e] + bxf[e]; Af[e] *= af[e]; Bb[e] += bxb[e] * Pb[e]; Pb[e] *= ab[e]; }
    }
    {
      const size_t sc = (size_t)chunk * 4 + sub;
      float* gf = p.lru_sagg + (((size_t)0 * (LRU_NCH * 4) + sc) * 1024 + c0) * 2;
      float* gb = p.lru_sagg + (((size_t)1 * (LRU_NCH * 4) + sc) * 1024 + c0) * 2;
      f32x4 v0 = {Af[0], hf[0], Af[1], hf[1]}, v1 = {Af[2], hf[2], Af[3], hf[3]};
      f32x4 w0 = {Pb[0], Bb[0], Pb[1], Bb[1]}, w1 = {Pb[2], Bb[2], Pb[3], Bb[3]};
      *(f32x4*)gf = v0; *(f32x4*)(gf + 4) = v1; *(f32x4*)gb = w0; *(f32x4*)(gb + 4) = w1;
      __syncthreads();
      float* sl = sagg + (sub * 64 + cq) * 16;
      *(f32x4*)sl = v0; *(f32x4*)(sl + 4) = v1; *(f32x4*)(sl + 8) = w0; *(f32x4*)(sl + 12) = w1;
      __syncthreads();
    }
    if (sub == 0) {
      float A[4], B[4], P[4], Q[4];
#pragma unroll
      for (int e = 0; e < 4; ++e) { A[e] = 1.f; B[e] = 0.f; P[e] = 1.f; Q[e] = 0.f; }
#pragma unroll
      for (int s2 = 0; s2 < 4; ++s2) {
        const float* lf = sagg + (s2 * 64 + cq) * 16;
        const float* lb = sagg + ((3 - s2) * 64 + cq) * 16 + 8;
#pragma unroll
        for (int e = 0; e < 4; ++e) {
          const float a = lf[2 * e], b = lf[2 * e + 1];
          B[e] = a * B[e] + b; A[e] *= a;
          const float pb = lb[2 * e], qb = lb[2 * e + 1];
          Q[e] = pb * Q[e] + qb; P[e] *= pb;
        }
      }
      float* gf = p.lru_agg + (((size_t)0 * LRU_NCH + chunk) * 1024 + c0) * 2;
      float* gb = p.lru_agg + (((size_t)1 * LRU_NCH + chunk) * 1024 + c0) * 2;
      f32x4 v0 = {A[0], B[0], A[1], B[1]}, v1 = {A[2], B[2], A[3], B[3]}, w0 = {P[0], Q[0], P[1], Q[1]}, w1 = {P[2], Q[2], P[3], Q[3]};
      *(f32x4*)gf = v0; *(f32x4*)(gf + 4) = v1; *(f32x4*)gb = w0; *(f32x4*)(gb + 4) = w1;
    }
  }
}
__device__ __forceinline__ void phase_lru_scan_carry(const Params& p, int bid, int nblk, int cxw) {
  const int tidx = opaque_tid(cxw);
  for (int item = bid; item < 36 * 8; item += nblk) {
    int s = item >> 3, dir = (item >> 2) & 1, cb = item & 3;
    int c = cb * 256 + tidx;
    int nch = s < 32 ? 4 : 64;
    int ch0 = s < 32 ? s * 4 : 128 + (s - 32) * 64;
    float h = s < 32 ? 0.f : p.state_lru[((size_t)(s - 32) * 2 + dir) * 1024 + c];
    for (int k0 = 0; k0 < nch; k0 += 4) {
      f32x2_t ag[4]; size_t idx[4];
#pragma unroll
      for (int u = 0; u < 4; ++u) {
        const int chunk = dir ? ch0 + nch - 1 - (k0 + u) : ch0 + k0 + u;
        idx[u] = ((size_t)dir * LRU_NCH + chunk) * 1024 + c;
        ag[u] = *(const f32x2_t*)(p.lru_agg + idx[u] * 2);
      }
#pragma unroll
      for (int u = 0; u < 4; ++u) { p.lru_hin[idx[u]] = h; h = ag[u].x * h + ag[u].y; }
    }
    if (s < 32) p.out_lru[((size_t)s * 2 + dir) * 1024 + c] = h;
  }
}
__device__ __forceinline__ void phase_lru_scan_final(const Params& p, int bid, int nblk, unsigned char* smem, int cxw) {
  const int tidx = opaque_tid(cxw);
  const bf16_t* gates = (const bf16_t*)(p.scratch + SC_LRU_GATES);
  const bf16_t* xc = (const bf16_t*)(p.scratch + SC_LRU_XC);
  const bf16_t* proj = (const bf16_t*)(p.scratch + SC_LRU_PROJ);
  bf16_t* yg = (bf16_t*)(p.scratch + SC_LRU_YG);
  const int sub = cxw & 3, cq = tidx & 63;
  for (int item = bid; item < LRU_NCH * 4; item += nblk) {
    const int chunk = item >> 2, cb = item & 3;
    const int c0 = cb * 256 + 4 * cq;
    float spf[4], spb[4];
#pragma unroll
    for (int e = 0; e < 4; ++e) { spf[e] = softplusf(-p.lru_a_param[c0 + e]); spb[e] = softplusf(-p.lru_a_param[1024 + c0 + e]); }
    float hf[4], hb[4];
    {
      const f32x4 a = *(const f32x4*)(p.lru_hin + ((size_t)0 * LRU_NCH + chunk) * 1024 + c0);
      const f32x4 b = *(const f32x4*)(p.lru_hin + ((size_t)1 * LRU_NCH + chunk) * 1024 + c0);
      hf[0] = a.x; hf[1] = a.y; hf[2] = a.z; hf[3] = a.w; hb[0] = b.x; hb[1] = b.y; hb[2] = b.z; hb[3] = b.w;
    }
#pragma unroll
    for (int s2 = 0; s2 < 3; ++s2) {
      if (s2 < sub) {
        const float* g = p.lru_sagg + (((size_t)0 * (LRU_NCH * 4) + (size_t)chunk * 4 + s2) * 1024 + c0) * 2;
        const f32x4 v0 = *(const f32x4*)g, v1 = *(const f32x4*)(g + 4);
        hf[0] = v0.x * hf[0] + v0.y; hf[1] = v0.z * hf[1] + v0.w; hf[2] = v1.x * hf[2] + v1.y; hf[3] = v1.z * hf[3] + v1.w;
      }
      if (3 - s2 > sub) {
        const float* g = p.lru_sagg + (((size_t)1 * (LRU_NCH * 4) + (size_t)chunk * 4 + (3 - s2)) * 1024 + c0) * 2;
        const f32x4 v0 = *(const f32x4*)g, v1 = *(const f32x4*)(g + 4);
        hb[0] = v0.x * hb[0] + v0.y; hb[1] = v0.z * hb[1] + v0.w; hb[2] = v1.x * hb[2] + v1.y; hb[3] = v1.z * hb[3] + v1.w;
      }
    }
    const int tok0 = chunk * 64 + 16 * sub;
    float hfs[16][4];
#pragma unroll
    for (int j = 0; j < 16; ++j) {
      const size_t o = (size_t)(tok0 + j) * 1024 + c0;
      float af[4], bxf[4];
      lru_row_f(gates, xc, o, spf, af, bxf);
#pragma unroll
      for (int e = 0; e < 4; ++e) { hf[e] = af[e] * hf[e] + bxf[e]; hfs[j][e] = hf[e]; }
    }
#pragma unroll
    for (int j = 15; j >= 0; --j) {
      const size_t o = (size_t)(tok0 + j) * 1024 + c0;
      float ab[4], bxb[4], z[4];
      lru_row_b(gates, xc, o, spb, ab, bxb);
      lru_unpack4(*(const u32x2*)(proj + (size_t)(tok0 + j) * 2048 + 1024 + c0), z);
      float y[4];
#pragma unroll
      for (int e = 0; e < 4; ++e) { hb[e] = ab[e] * hb[e] + bxb[e]; y[e] = (hfs[j][e] + hb[e]) * siluf(z[e]); }
      u32x2 ov; ov.x = pack2(y[0], y[1]); ov.y = pack2(y[2], y[3]);
      *(u32x2*)(yg + o) = ov;
    }
  }
}

enum { PH_PREP = 0, PH_MOD, PH_HYA, PH_HYB, PH_LNMOD, PH_INPROJ, PH_MIX1, PH_MIX2, PH_MIX3, PH_MIX4, PH_MIX5, PH_MIX6, PH_OUTPROJ };

struct Ctx { int bid, nblk, wave; unsigned char* smem; unsigned char* wg_smem; };

template <class Epi>
__device__ __forceinline__ void run_gemm(const Ctx& cx, const bf16_t* A, int lda, const bf16_t* Bt, int M, int N, int K, int grp_shift, int grp_bytes, const Epi& e) {
  pg8::Gemm g{A, Bt, M, N, K, lda, grp_shift, grp_bytes};
  pg8::StaticOrder S; S.init(M, N, gridDim.x, opaque_s(blockIdx.x));
  pg8::gemm_phase((PG8_LAS unsigned char*)cx.wg_smem, g, S, e, cx.wave);
}

#define N_PARAM_WORDS (sizeof(Params) / 8)
__device__ __forceinline__ Params load_params(const unsigned char* lp) {
  Params p;
  unsigned long long* d = (unsigned long long*)&p;
  const unsigned long long* sp = (const unsigned long long*)lp;
#pragma unroll
  for (int i = 0; i < (int)N_PARAM_WORDS; ++i) {
    const unsigned long long v = sp[i];
    const unsigned lo = __builtin_amdgcn_readfirstlane((unsigned)v), hi = __builtin_amdgcn_readfirstlane((unsigned)(v >> 32));
    d[i] = ((unsigned long long)hi << 32) | lo;
  }
  return p;
}
__device__ __forceinline__ void run_phase(const unsigned char* lparams, int ph, int layer, const Ctx& cx) {
  const Params p = load_params(lparams);
  const int kind = layer % 3, slot = layer / 3;
  const int bid = opaque_s(cx.bid), nblk = cx.nblk;
  unsigned char* smem = cx.smem;
  switch (ph) {
    case PH_PREP: phase_prep(p, bid, nblk, smem, cx.wave); break;
    case PH_MOD: phase_mod(p, bid, nblk, smem, cx.wave); break;
    case PH_HYA: phase_hyfilt_a(p, bid, nblk, smem, cx.wave); break;
    case PH_HYB: phase_hyfilt_b(p, bid, nblk, smem, cx.wave); break;
    case PH_LNMOD: phase_lnmod(p, layer, bid, nblk, cx.wave); break;
    case PH_INPROJ:
      if (kind == 0) {
        pg8::EpiSsdIn e{(bf16_t*)(p.scratch + SC_SSD_Z), (bf16_t*)(p.scratch + SC_SSD_XBC), (float*)(p.scratch + SC_SSD_DT), p.ssd_dt_bias + slot * 64};
        run_gemm(cx, p.hbuf, 1024, p.wt_ssd_in + (size_t)slot * 6400 * 1024, T_ALL, 6400, 1024, 30, 0, e);
      } else if (kind == 1) {
        pg8::EpiBf16 e{(bf16_t*)(p.scratch + SC_HY_PROJT), (size_t)T_ALL};
        run_gemm(cx, p.wt_hy_in, 1024, p.hbuf, 4096, T_ALL, 1024, 30, 0, e);
      } else {
        pg8::EpiBf16 e{(bf16_t*)(p.scratch + SC_LRU_PROJ), (size_t)2048};
        run_gemm(cx, p.hbuf, 1024, p.wt_lru_in, T_ALL, 2048, 1024, 30, 0, e);
      }
      break;
    case PH_MIX1:
      if (kind == 0) phase_ssd_conv(p, slot, slot == 1, bid, nblk, smem, cx.wave);
      else if (kind == 1) phase_hy_longconv(p, bid, nblk, smem, cx.wave);
      else phase_dwconv<4, false>((const bf16_t*)(p.scratch + SC_LRU_PROJ), 2048, (bf16_t*)(p.scratch + SC_LRU_XC), 1024, 1024,
                                  p.lru_conv_w, p.lru_conv_b, false, bid, nblk, cx.wave);
      break;
    case PH_MIX2:
      if (kind == 0) phase_ssd_scan(p, slot, slot == 1, bid, nblk, cx.wg_smem, cx.wave);
      else if (kind == 1) phase_hy_transpose(p, bid, nblk, smem, cx.wave);
      else {
        pg8::EpiLruGate e{(bf16_t*)(p.scratch + SC_LRU_GATES), p.lru_gate_b};
        run_gemm(cx, (const bf16_t*)(p.scratch + SC_LRU_XC), 1024, p.wt_lru_gate, T_ALL, 4096, 256, 2, 512, e);
      }
      break;
    case PH_MIX3:
      if (kind == 0) phase_ssd_gate(p, slot, bid, nblk, cx.wave);
      else phase_lru_scan_agg(p, bid, nblk, smem, cx.wave);
      break;
    case PH_MIX4: if (kind == 2) phase_lru_scan_carry(p, bid, nblk, cx.wave); break;
    case PH_MIX5: if (kind == 2) phase_lru_scan_final(p, bid, nblk, smem, cx.wave); break;
    case PH_OUTPROJ: {
      const float* mv = p.modv + (size_t)layer * 5 * 3072;
      if (kind == 0) {
        pg8::EpiOut e{p.resb, mv, p.rstd};
        run_gemm(cx, (const bf16_t*)(p.scratch + SC_SSD_Z), 2048, p.wt_ssd_out + (size_t)slot * 1024 * 2048, T_ALL, 1024, 2048, 30, 0, e);
      } else if (kind == 1) {
        pg8::EpiOut e{p.resb, mv, nullptr};
        run_gemm(cx, (const bf16_t*)(p.scratch + SC_HY_YG), 1024, p.wt_hy_out, T_ALL, 1024, 1024, 30, 0, e);
      } else {
        pg8::EpiOut e{p.resb, mv, nullptr};
        run_gemm(cx, (const bf16_t*)(p.scratch + SC_LRU_YG), 1024, p.wt_lru_out, T_ALL, 1024, 1024, 30, 0, e);
      }
    } break;
  }
}

__global__ void __launch_bounds__(WG_THREADS, 2) k_mega(Params p) {
  __shared__ __attribute__((aligned(16))) unsigned char smem[WG_SMEM + 16 + 512];
  cg::grid_group grid = cg::this_grid();
  const int wave0 = __builtin_amdgcn_readfirstlane((int)(threadIdx.x >> 6));
  const int vb = wave0 >> 2;
  Ctx cx;
  cx.wave = wave0;
  cx.bid = 2 * blockIdx.x + vb; cx.nblk = 2 * gridDim.x; cx.smem = smem + vb * SMEM_BYTES; cx.wg_smem = smem;
  volatile LAS unsigned* xst = (volatile LAS unsigned*)(smem + WG_SMEM);
  unsigned char* lparams = smem + WG_SMEM + 16;
  if (threadIdx.x == 0) { xst[0] = 0u; xst[1] = 0u; *(Params*)lparams = p; }
  __syncthreads();
  const XcdBarrier xb = xcd_barrier_post(p.bar, xst);
  run_phase(lparams, PH_PREP, 0, cx);
  run_phase(lparams, PH_MOD, 0, cx);
  run_phase(lparams, PH_HYA, 0, cx);
  if (p.bar == nullptr) grid.sync();
  xcd_barrier(xb, cx.wave);
  run_phase(lparams, PH_HYB, 0, cx);
  for (int layer = 0; layer < 4; ++layer) {
    const int kind = layer % 3;
    run_phase(lparams, PH_LNMOD, layer, cx);
    xcd_barrier(xb, cx.wave);
    run_phase(lparams, PH_INPROJ, layer, cx);
    xcd_barrier(xb, cx.wave);
    run_phase(lparams, PH_MIX1, layer, cx);
    xcd_barrier(xb, cx.wave);
    run_phase(lparams, PH_MIX2, layer, cx);
    xcd_barrier(xb, cx.wave);
    if (kind != 1) {
      run_phase(lparams, PH_MIX3, layer, cx);
      xcd_barrier(xb, cx.wave);
    }
    if (kind == 2) {
      run_phase(lparams, PH_MIX4, layer, cx);
      xcd_barrier(xb, cx.wave);
      run_phase(lparams, PH_MIX5, layer, cx);
      xcd_barrier(xb, cx.wave);
    }
    run_phase(lparams, PH_OUTPROJ, layer, cx);
    xcd_barrier(xb, cx.wave);
  }
  run_phase(lparams, PH_LNMOD, 4, cx);
}

static inline size_t align_up(size_t x) { return (x + 255) & ~(size_t)255; }

extern "C" void kernel_launch(void* const* d_in, const int* in_sizes, int n_in, void* d_out, int out_size, void* d_ws, size_t ws_size,
                              hipStream_t stream) {
  Params p{};
  const float** fp = (const float**)&p;
  for (int i = 0; i < 36; ++i) fp[i] = (const float*)d_in[i];
  float* out = (float*)d_out;
  p.xres = out;
  p.out_ssd = out + (size_t)T_ALL * 1024;
  p.out_lru = p.out_ssd + (size_t)32 * 2 * 2 * 32 * 64 * 128;
  unsigned char* w = (unsigned char*)d_ws;
  size_t off = 0;
  auto carve = [&](size_t bytes) { unsigned char* r = w + off; off = align_up(off + bytes); return r; };
  p.wt_ssd_in = (bf16_t*)carve((size_t)2 * 6400 * 1024 * 2);
  p.wt_ssd_out = (bf16_t*)carve((size_t)2 * 1024 * 2048 * 2);
  p.wt_hy_in = (bf16_t*)carve((size_t)4096 * 1024 * 2);
  p.wt_hy_out = (bf16_t*)carve((size_t)1024 * 1024 * 2);
  p.wt_lru_in = (bf16_t*)carve((size_t)2048 * 1024 * 2);
  p.wt_lru_out = (bf16_t*)carve((size_t)1024 * 1024 * 2);
  p.wt_lru_gate = (bf16_t*)carve((size_t)4 * 1024 * 256 * 2);
  p.modv = (float*)carve((size_t)4 * 5 * 3072 * 4);
  p.hdn2 = (float*)carve((size_t)4352 * 64 * 4);
  p.rtab0 = (bf16_t*)carve((size_t)2 * 1024 * 512 * 2);
  p.rtab1 = (bf16_t*)carve((size_t)2 * 1024 * 8192 * 2);
  p.knorm = (float*)carve((size_t)4 * 1024 * 4);
  p.hbuf = (bf16_t*)carve((size_t)T_ALL * 1024 * 2);
  p.rstd = (float*)carve((size_t)T_ALL * 4);
  p.resb = (bf16_t*)carve((size_t)T_ALL * 1024 * 2);
  p.lru_agg = (float*)carve((size_t)2 * 384 * 1024 * 2 * 4);
  p.lru_hin = (float*)carve((size_t)2 * 384 * 1024 * 4);
  p.lru_sagg = (float*)carve((size_t)2 * 1536 * 1024 * 2 * 4);
  p.bar = (unsigned*)carve((size_t)XCD_BAR_WORDS * 4);
  p.scratch = carve(SC_TOTAL);
  if (off > ws_size) return;

  static int grid_blocks = 0;
  if (!grid_blocks) {
    int dev = 0, cus = 0, per_cu = 0;
    hipGetDevice(&dev);
    hipDeviceGetAttribute(&cus, hipDeviceAttributeMultiprocessorCount, dev);
    hipOccupancyMaxActiveBlocksPerMultiprocessor(&per_cu, k_mega, WG_THREADS, 0);
    if (per_cu > 1) per_cu = 1;
    grid_blocks = cus * per_cu;
  }
  hipMemsetAsync(p.bar, 0, (size_t)XCD_BAR_WORDS * 4, stream);
  void* args[] = {&p};
  hipError_t e = hipLaunchCooperativeKernel((void*)k_mega, dim3(grid_blocks), dim3(WG_THREADS), args, 0, stream);
  if (e != hipSuccess) fprintf(stderr, "cooperative launch failed: %s (grid %d)\n", hipGetErrorString(e), grid_blocks);
}
```

```cpp
#include <hip/hip_runtime.h>
#include <hip/hip_bf16.h>
#include <hip/hip_cooperative_groups.h>
#include <stdint.h>
#include <cstdio>
namespace cg = cooperative_groups;

typedef unsigned short bf16_t;
typedef __attribute__((ext_vector_type(8))) short bf16x8;
typedef __attribute__((ext_vector_type(16))) float f32x16;
typedef __attribute__((ext_vector_type(4))) unsigned int u32x4;
typedef __attribute__((ext_vector_type(2))) unsigned int u32x2;
typedef __attribute__((ext_vector_type(4))) float f32x4;
typedef float f32x4_t __attribute__((ext_vector_type(4)));
typedef float f32x2_t __attribute__((ext_vector_type(2)));

#define T_CTX 8192
#define T_ALL 24576
#define DM 1024
#define NTHR 256
#define SMEM_BYTES 69632
#define WG_THREADS 512
#define WG_SMEM 162304
#define ALPHA_RES 1.6817928305074290f
#define LN_EPS 1e-5f

__device__ __forceinline__ bf16_t f2bf(float f) { __bf16 h = (__bf16)f; return __builtin_bit_cast(bf16_t, h); }
__device__ __forceinline__ float bf2f(bf16_t b) { return __uint_as_float(((unsigned)b) << 16); }
__device__ __forceinline__ float bflo(unsigned w) { return __uint_as_float(w << 16); }
__device__ __forceinline__ float bfhi(unsigned w) { return __uint_as_float(w & 0xffff0000u); }
typedef __bf16 bf16v2_t __attribute__((ext_vector_type(2)));
typedef float f32v2_t __attribute__((ext_vector_type(2)));
__device__ __forceinline__ unsigned pack2(float a, float b) { f32v2_t v = {a, b}; bf16v2_t h = __builtin_convertvector(v, bf16v2_t); return __builtin_bit_cast(unsigned, h); }
__device__ __forceinline__ float siluf(float x) { return x * __builtin_amdgcn_rcpf(1.f + __expf(-x)); }
__device__ __forceinline__ float sigmoidf(float x) { return __builtin_amdgcn_rcpf(1.f + __expf(-x)); }
__device__ __forceinline__ float softplusf(float x) { return x > 20.f ? x : __logf(1.f + __expf(x)); }


__device__ __forceinline__ int opaque_lane() { int z = 0; asm volatile("" : "+v"(z)); return __builtin_amdgcn_mbcnt_hi(~0u, __builtin_amdgcn_mbcnt_lo(~0u, (unsigned)z)); }
__device__ __forceinline__ int opaque_tid512(int wave) { return (wave << 6) + opaque_lane(); }
__device__ __forceinline__ int opaque_tid(int wave) { return opaque_tid512(wave) & 255; }

#define XB_TMO      128
#define XB_XCNT(j)  (256  + 64 * (j))
#define XB_XSUB(j)  (1280 + 64 * (j))
#define XB_XGEN(j)  (2304 + 64 * (j))
#define XB_TOP      3328
#define XB_TOPGEN   3392
#define XCD_BAR_WORDS 3456
#define XB_SPIN_CAP (1u << 23)
#define LAS __attribute__((address_space(3)))
__device__ __forceinline__ unsigned xb_ld(unsigned* p)              { return __hip_atomic_load(p, __ATOMIC_RELAXED, __HIP_MEMORY_SCOPE_AGENT); }
__device__ __forceinline__ unsigned xb_add(unsigned* p, unsigned v) { return __hip_atomic_fetch_add(p, v, __ATOMIC_RELAXED, __HIP_MEMORY_SCOPE_AGENT); }
__device__ __forceinline__ unsigned xb_xcc_id() { return (unsigned)__builtin_amdgcn_s_getreg((3 << 11) | 20) & 0xFu; }
#define XB_SPIN(cond, bar) do { unsigned _sp = 0; while (cond) { __builtin_amdgcn_s_sleep(1); \
    if ((++_sp & 255u) == 0u) { if (xb_ld(&(bar)[XB_TMO])) break; if (_sp > XB_SPIN_CAP) { atomicAdd(&(bar)[XB_TMO], 1u); break; } } } } while (0)
struct XcdBarrier { unsigned* bar; unsigned x; volatile LAS unsigned* st; };
__device__ __forceinline__ XcdBarrier xcd_barrier_post(unsigned* bar, volatile LAS unsigned* st) {
  XcdBarrier b; b.bar = bar; b.x = xb_xcc_id(); b.st = st;
  if (threadIdx.x == 0) (void)xb_add(&bar[XB_XCNT(b.x)], 1u);
  return b;
}
__device__ __forceinline__ void xcd_barrier_complete(unsigned* bar, unsigned x, unsigned& nloc, unsigned& nx) {
  const unsigned G = gridDim.x * gridDim.y * gridDim.z;
  unsigned sum, cnt, mine, sp = 0u;
  for (;;) {
    sum = 0u; cnt = 0u; mine = 0u;
#pragma unroll
    for (unsigned j = 0; j < 16; ++j) { const unsigned c = xb_ld(&bar[XB_XCNT(j)]); sum += c; cnt += (c > 0u) ? 1u : 0u; mine = (j == x) ? c : mine; }
    if (sum == G) break;
    __builtin_amdgcn_s_sleep(1);
    if ((++sp & 255u) == 0u) { if (xb_ld(&bar[XB_TMO])) break; if (sp > XB_SPIN_CAP) { atomicAdd(&bar[XB_TMO], 1u); break; } }
  }
  nloc = mine > 0u ? mine : 1u; nx = cnt > 0u ? cnt : 1u;
}
__device__ __forceinline__ void xcd_barrier(const XcdBarrier& b, int wave) {
  asm volatile("s_waitcnt vmcnt(0)" ::: "memory");
  __syncthreads();
  if (opaque_tid512(wave) == 0) {
    unsigned* bar = b.bar;
    __builtin_amdgcn_s_waitcnt(0);
    unsigned nloc = b.st[0], nx = b.st[1];
    if (nloc == 0u) { xcd_barrier_complete(bar, b.x, nloc, nx); b.st[0] = nloc; b.st[1] = nx; }
    const unsigned old = xb_add(&bar[XB_XSUB(b.x)], 1u);
    const unsigned gen = old / nloc;
    if (old + 1u == (gen + 1u) * nloc) {
      __builtin_amdgcn_fence(__ATOMIC_RELEASE, "agent");
      asm volatile("s_waitcnt vmcnt(0)" ::: "memory");
      const unsigned og = xb_add(&bar[XB_TOP], 1u);
      const unsigned tg = og / nx;
      if (og + 1u == (tg + 1u) * nx) xb_add(&bar[XB_TOPGEN], 1u);
      else XB_SPIN(xb_ld(&bar[XB_TOPGEN]) == tg, bar);
      __builtin_amdgcn_fence(__ATOMIC_ACQUIRE, "agent");
      xb_add(&bar[XB_XGEN(b.x)], 1u);
      asm volatile("s_waitcnt vmcnt(0)" ::: "memory");
    } else {
      XB_SPIN(xb_ld(&bar[XB_XGEN(b.x)]) == gen, bar);
      __builtin_amdgcn_fence(__ATOMIC_ACQUIRE, "agent");
      asm volatile("s_waitcnt vmcnt(0)" ::: "memory");
    }
  }
  __syncthreads();
}


__device__ __forceinline__ int opaque_s(int x) { asm volatile("" : "+s"(x)); return x; }

__device__ __forceinline__ float shfl_idx_f(float v, int src) { return __int_as_float(__builtin_amdgcn_ds_bpermute(src << 2, __float_as_int(v))); }
__device__ __forceinline__ float shfl_xor_f(float v, int off, int lane) { return shfl_idx_f(v, lane ^ off); }

__device__ __forceinline__ float wave_incl_scan(float v) {
#define DPP_ADD(ctrl, rmask) v += __int_as_float(__builtin_amdgcn_update_dpp(0, __float_as_int(v), ctrl, rmask, 0xf, false))
  DPP_ADD(0x111, 0xf); DPP_ADD(0x112, 0xf); DPP_ADD(0x114, 0xf); DPP_ADD(0x118, 0xf);
  DPP_ADD(0x142, 0xa); DPP_ADD(0x143, 0xc);
#undef DPP_ADD
  return v;
}

struct TokInfo { int s, l, L, base, mrow; };
__device__ __forceinline__ TokInfo tokinfo(int tok) {
  TokInfo t;
  if (tok < T_CTX) { t.s = tok >> 8; t.l = tok & 255; t.L = 256; t.base = tok & ~255; t.mrow = 0; }
  else { int u = tok - T_CTX; t.s = 32 + (u >> 12); t.l = u & 4095; t.L = 4096; t.base = T_CTX + (u & ~4095); t.mrow = 1 + (u >> 12); }
  return t;
}
__device__ __forceinline__ int seqpos2off(int pos, bool cm) { return cm ? (((pos & 63) << 6) | (pos >> 6)) : pos; }

struct Params {
  const float *x_prompt, *x_sample, *state_ssd, *state_lru, *c, *c_ctx, *mod_w, *mod_b, *ln_g, *ln_b;
  const float *ssd_in_w, *ssd_conv_w, *ssd_conv_b, *ssd_dt_bias, *ssd_a_log, *ssd_d, *ssd_norm_g, *ssd_out_w;
  const float *hy_in_w, *hy_conv_w, *hy_conv_b, *hy_f_w1, *hy_f_b1, *hy_f_w2, *hy_f_b2, *hy_f_w3, *hy_f_freq, *hy_f_bias, *hy_out_w;
  const float *lru_in_w, *lru_conv_w, *lru_conv_b, *lru_gate_w, *lru_gate_b, *lru_a_param, *lru_out_w;
  float *xres, *out_ssd, *out_lru;
  bf16_t *wt_ssd_in, *wt_ssd_out, *wt_hy_in, *wt_hy_out, *wt_lru_in, *wt_lru_out, *wt_lru_gate;
  float *modv;
  float *hdn2;
  bf16_t *rtab0;
  bf16_t *rtab1;
  float *knorm;
  bf16_t *hbuf;
  float *rstd;
  bf16_t *resb;
  float *lru_agg;
  float *lru_hin;
  float *lru_sagg;
  unsigned char *scratch;
  unsigned *bar;
};

#define SC_SSD_Z     ((size_t)0)
#define SC_SSD_XBC   ((size_t)T_ALL * 2048 * 2)
#define SC_SSD_XBCC  (SC_SSD_XBC + (size_t)T_ALL * 4096 * 2)
#define SC_SSD_DT    (SC_SSD_XBCC + (size_t)T_ALL * 2048 * 2)
#define SC_SSD_XT    (SC_SSD_DT + (size_t)T_ALL * 64 * 4)
#define SC_SSD_BT    (SC_SSD_XT + (size_t)T_ALL * 2048 * 2)
#define SC_SSD_BF    (SC_SSD_BT + (size_t)T_ALL * 1024 * 2)
#define SC_SSD_CF    (SC_SSD_BF + (size_t)T_ALL * 1024 * 2)
#define SC_SSD_END   (SC_SSD_CF + (size_t)T_ALL * 1024 * 2)
#define SC_HY_PROJT  ((size_t)0)
#define SC_HY_YT     ((size_t)T_ALL * 4096 * 2)
#define SC_HY_YG     (SC_HY_YT + (size_t)T_ALL * 1024 * 2)
#define SC_LRU_PROJ  ((size_t)0)
#define SC_LRU_XC    ((size_t)T_ALL * 2048 * 2)
#define SC_LRU_GATES (SC_LRU_XC + (size_t)T_ALL * 1024 * 2)
#define SC_LRU_Y     (SC_LRU_GATES + (size_t)T_ALL * 4096 * 2)
#define SC_LRU_YG    (SC_LRU_Y + (size_t)T_ALL * 2048 * 2)
#define SC_TOTAL     SC_SSD_END

__device__ __forceinline__ void transpose_tile(const float* __restrict__ src, int ld_src, int n_src, bf16_t* __restrict__ dst, int K,
                               const float* __restrict__ scale, int tile, int tiles_k, float* tl, int cxw) {
  const int tidx = opaque_tid(cxw);
  int tk = tile % tiles_k, tn = tile / tiles_k;
  int k0 = tk * 64, n0 = tn * 64;
  __syncthreads();
  {
    const int c4 = (tidx & 15) * 4, r0 = tidx >> 4;
#pragma unroll
    for (int ps = 0; ps < 4; ++ps) {
      const int r = r0 + ps * 16;
      f32x4 v = {0.f, 0.f, 0.f, 0.f};
      if (n0 + c4 < n_src) v = *(const f32x4*)(src + (size_t)(k0 + r) * ld_src + n0 + c4);
      if (scale) { const float sc = scale[k0 + r]; v.x *= sc; v.y *= sc; v.z *= sc; v.w *= sc; }
      tl[r * 65 + c4] = v.x; tl[r * 65 + c4 + 1] = v.y; tl[r * 65 + c4 + 2] = v.z; tl[r * 65 + c4 + 3] = v.w;
    }
  }
  __syncthreads();
  {
    const int n = tidx >> 2, kq = (tidx & 3) * 16;
    unsigned w[8];
#pragma unroll
    for (int e = 0; e < 8; ++e) w[e] = pack2(tl[(kq + 2 * e) * 65 + n], tl[(kq + 2 * e + 1) * 65 + n]);
    u32x4 o0, o1; o0.x = w[0]; o0.y = w[1]; o0.z = w[2]; o0.w = w[3]; o1.x = w[4]; o1.y = w[5]; o1.z = w[6]; o1.w = w[7];
    bf16_t* dp = dst + (size_t)(n0 + n) * K + k0 + kq;
    *(u32x4*)dp = o0; *(u32x4*)(dp + 8) = o1;
  }
}

__device__ __forceinline__ void phase_prep(const Params& p, int bid, int nblk, unsigned char* smem, int cxw) {
  const int tidx = opaque_tid(cxw);
  float* tl = (float*)smem;
  for (int job = 0; job < 24; ++job) {
    const float* src; int ld, nsrc, K, npad; bf16_t* dst; const float* scale = nullptr;
    if (job < 2) { src = p.ssd_in_w + (size_t)job * 1024 * 6208; ld = 6208; nsrc = 6208; K = 1024; npad = 6400; dst = p.wt_ssd_in + (size_t)job * 6400 * 1024; }
    else if (job < 4) { int s = job - 2; src = p.ssd_out_w + (size_t)s * 2048 * 1024; ld = 1024; nsrc = 1024; K = 2048; npad = 1024; dst = p.wt_ssd_out + (size_t)s * 1024 * 2048; scale = p.ssd_norm_g + s * 2048; }
    else if (job == 4) { src = p.hy_in_w; ld = 4096; nsrc = 4096; K = 1024; npad = 4096; dst = p.wt_hy_in; }
    else if (job == 5) { src = p.hy_out_w; ld = 1024; nsrc = 1024; K = 1024; npad = 1024; dst = p.wt_hy_out; }
    else if (job == 6) { src = p.lru_in_w; ld = 2048; nsrc = 2048; K = 1024; npad = 2048; dst = p.wt_lru_in; }
    else if (job == 7) { src = p.lru_out_w; ld = 1024; nsrc = 1024; K = 1024; npad = 1024; dst = p.wt_lru_out; }
    else { int q = job - 8; int dg = q >> 2, n = q & 3;
      src = p.lru_gate_w + (size_t)(dg * 4 + n) * 65536; ld = 256; nsrc = 256; K = 256; npad = 256;
      dst = p.wt_lru_gate + (size_t)n * 1024 * 256 + (size_t)dg * 256 * 256; }
    int tiles_k = K / 64, tiles = tiles_k * (npad / 64);
    for (int t = bid; t < tiles; t += nblk) transpose_tile(src, ld, nsrc, dst, K, scale, t, tiles_k, tl, cxw);
  }
  for (int i = bid * NTHR + tidx; i < 2 * 2 * 1024; i += nblk * NTHR) p.knorm[i] = 0.f;
}

__device__ __forceinline__ void phase_mod(const Params& p, int bid, int nblk, unsigned char* smem, int cxw) {
  const int tidx = opaque_tid(cxw);
  float* sc = (float*)smem;
  float* red = sc + 5 * 1024;
  __syncthreads();
  for (int i = tidx; i < 5 * 1024; i += NTHR) {
    int r = i >> 10, k = i & 1023;
    float v = (r == 0) ? p.c_ctx[k] : p.c[(r - 1) * 1024 + k];
    sc[i] = siluf(v);
  }
  __syncthreads();
  const int cj = tidx & 31, kg = tidx >> 5;
  for (int item = bid; item < 4 * 96; item += nblk) {
    const int layer = item / 96, j = (item % 96) * 32 + cj;
    const float* w = p.mod_w + (size_t)layer * 1024 * 3072 + (size_t)kg * 128 * 3072 + j;
    const float* s0 = sc + kg * 128;
    float a0 = 0, a1 = 0, a2 = 0, a3 = 0, a4 = 0;
#pragma unroll 8
    for (int k = 0; k < 128; ++k) {
      float wv = w[(size_t)k * 3072];
      a0 += s0[k] * wv; a1 += s0[1024 + k] * wv; a2 += s0[2048 + k] * wv; a3 += s0[3072 + k] * wv; a4 += s0[4096 + k] * wv;
    }
    __syncthreads();
    red[(kg * 5 + 0) * 32 + cj] = a0; red[(kg * 5 + 1) * 32 + cj] = a1; red[(kg * 5 + 2) * 32 + cj] = a2;
    red[(kg * 5 + 3) * 32 + cj] = a3; red[(kg * 5 + 4) * 32 + cj] = a4;
    __syncthreads();
    if (tidx < 160) {
      const int rr = tidx >> 5, cc = tidx & 31;
      float sum = 0.f;
#pragma unroll
      for (int g8 = 0; g8 < 8; ++g8) sum += red[(g8 * 5 + rr) * 32 + cc];
      const int jj = (item % 96) * 32 + cc;
      p.modv[((size_t)layer * 5 + rr) * 3072 + jj] = sum + p.mod_b[layer * 3072 + jj];
    }
  }
}

__device__ __forceinline__ void phase_hyfilt_a(const Params& p, int bid, int nblk, unsigned char* smem, int cxw) {
  const int tidx = opaque_tid(cxw);
  float* sz = (float*)smem;
  float* sh = sz + 4 * 36;
  int pl = tidx >> 6, m = tidx & 63;
  for (int item = bid; item < 4352 / 4; item += nblk) {
    int pos = item * 4 + pl;
    int L = pos < 256 ? 256 : 4096;
    int l = pos < 256 ? pos : pos - 256;
    __syncthreads();
    if (m < 33) {
      float t = (float)l / (float)L;
      float w = (6.283185307179586f * (float)l) / (float)L;
      float v;
      if (m == 0) v = t;
      else {
        int j = (m - 1) & 15;
        float fr = 1e-4f + (float)j * ((15.f - 1e-4f) / 15.f);
        float ang = w * fr;
        v = (m <= 16) ? __cosf(ang) : __sinf(ang);
      }
      sz[pl * 36 + m] = v;
    }
    __syncthreads();
    float a = p.hy_f_b1[m];
    for (int e = 0; e < 33; ++e) a += sz[pl * 36 + e] * p.hy_f_w1[e * 64 + m];
    a = __sinf(p.hy_f_freq[m] * a);
    sh[pl * 64 + m] = a;
    __syncthreads();
    float b = p.hy_f_b2[m];
    for (int e = 0; e < 64; ++e) b += sh[pl * 64 + e] * p.hy_f_w2[e * 64 + m];
    b = __sinf(p.hy_f_freq[64 + m] * b);
    p.hdn2[(size_t)pos * 64 + m] = b;
  }
}

__device__ __forceinline__ void phase_hyfilt_b(const Params& p, int bid, int nblk, unsigned char* smem, int cxw) {
  const int tidx = opaque_tid(cxw);
  const int lane = tidx & 63;
  for (int item = bid; item < 17 * 64; item += nblk) {
    const int lb = item >> 6, chunk = item & 63;
    const int Lsel = lb ? 1 : 0, L = Lsel ? 4096 : 256, RL = Lsel ? 8192 : 512, Lm1 = L - 1;
    const int l = Lsel ? (lb - 1) * 256 + tidx : tidx;
    const int pos = Lsel ? 256 + l : l;
    float hd[64];
#pragma unroll
    for (int m4 = 0; m4 < 16; ++m4) {
      f32x4 v = *(const f32x4*)(p.hdn2 + (size_t)pos * 64 + m4 * 4);
      hd[m4 * 4] = v.x; hd[m4 * 4 + 1] = v.y; hd[m4 * 4 + 2] = v.z; hd[m4 * 4 + 3] = v.w;
    }
    const int odc0 = chunk * 64, o = odc0 >> 11, d = (odc0 >> 10) & 1, c0 = odc0 & 1023;
    const float t = (float)l / (float)L;
    bf16_t* rt = Lsel ? p.rtab1 : p.rtab0;
    const float min_decay = -3.0701134573253945f, max_decay = -15.350567286626973f;
    for (int cc = 0; cc < 64; ++cc) {
      const int c = c0 + cc;
      const float* w3 = p.hy_f_w3 + odc0 + cc;
      float acc = 0.f;
#pragma unroll
      for (int m = 0; m < 64; ++m) acc += hd[m] * w3[(size_t)m * 4096];
      float delta = fabsf(min_decay + (float)c * ((max_decay - min_decay) / 1023.f));
      float kv = acc * expf(-t * delta);
      size_t rb = (size_t)(o * 1024 + c) * RL;
      if (d == 0) rt[rb + Lm1 - l] = f2bf(kv);
      else if (l > 0) rt[rb + Lm1 + l] = f2bf(kv);
      else rt[rb + RL - 1] = 0;
      float a = fabsf(kv);
#pragma unroll
      for (int off = 32; off > 0; off >>= 1) a += shfl_xor_f(a, off, lane);
      if (lane == 0) atomicAdd(&p.knorm[(Lsel * 2 + o) * 1024 + c], a);
    }
  }
}

__device__ __forceinline__ void phase_lnmod(const Params& p, int layer, int bid, int nblk, int cxw) {
  const int tidx = opaque_tid(cxw);
  int lane = tidx & 63, wv = cxw & 3;
  f32x4 lg[4], lb[4];
  if (layer > 0) {
    const float* g = p.ln_g + (layer - 1) * DM; const float* b = p.ln_b + (layer - 1) * DM;
#pragma unroll
    for (int j = 0; j < 4; ++j) { lg[j] = *(const f32x4*)(g + j * 256 + lane * 4); lb[j] = *(const f32x4*)(b + j * 256 + lane * 4); }
  }
  f32x4 vn[4];
#define LNMOD_LOAD(ROW) do { const int row_ = (ROW); \
    if (layer == 0) { const float* src_ = row_ < T_CTX ? p.x_prompt + (size_t)row_ * DM : p.x_sample + (size_t)(row_ - T_CTX) * DM; \
      _Pragma("unroll") for (int j = 0; j < 4; ++j) vn[j] = *(const f32x4*)(src_ + j * 256 + lane * 4); } \
    else { const bf16_t* src_ = p.resb + (size_t)row_ * DM; \
      _Pragma("unroll") for (int j = 0; j < 4; ++j) { const u32x2 w_ = *(const u32x2*)(src_ + j * 256 + lane * 4); \
        vn[j].x = bflo(w_.x); vn[j].y = bfhi(w_.x); vn[j].z = bflo(w_.y); vn[j].w = bfhi(w_.y); } } } while (0)
  if (bid * 4 + wv < T_ALL) LNMOD_LOAD(bid * 4 + wv);
  for (int row = bid * 4 + wv; row < T_ALL; row += nblk * 4) {
    f32x4 v[4];
#pragma unroll
    for (int j = 0; j < 4; ++j) v[j] = vn[j];
    if (row + nblk * 4 < T_ALL) LNMOD_LOAD(row + nblk * 4);
    f32x4 msh[4], msc[4];
    if (layer < 4) {
      const int mrow_ = row < T_CTX ? 0 : 1 + ((row - T_CTX) >> 12);
      const float* mv_ = p.modv + ((size_t)layer * 5 + mrow_) * 3072;
#pragma unroll
      for (int j = 0; j < 4; ++j) { msh[j] = *(const f32x4*)(mv_ + j * 256 + lane * 4); msc[j] = *(const f32x4*)(mv_ + 1024 + j * 256 + lane * 4); }
    }
    if (layer > 0) {
      float s = 0.f;
#pragma unroll
      for (int j = 0; j < 4; ++j) s += v[j].x + v[j].y + v[j].z + v[j].w;
#pragma unroll
      for (int o = 32; o > 0; o >>= 1) s += shfl_xor_f(s, o, lane);
      float mu = s * (1.f / 1024.f);
      float q = 0.f;
#pragma unroll
      for (int j = 0; j < 4; ++j) { float a = v[j].x - mu, b = v[j].y - mu, c = v[j].z - mu, d = v[j].w - mu; q += a * a + b * b + c * c + d * d; }
#pragma unroll
      for (int o = 32; o > 0; o >>= 1) q += shfl_xor_f(q, o, lane);
      float rs = rsqrtf(q * (1.f / 1024.f) + LN_EPS);
#pragma unroll
      for (int j = 0; j < 4; ++j) {
        const f32x4 gg = lg[j], bb = lb[j];
        v[j].x = (v[j].x - mu) * rs * gg.x + bb.x; v[j].y = (v[j].y - mu) * rs * gg.y + bb.y;
        v[j].z = (v[j].z - mu) * rs * gg.z + bb.z; v[j].w = (v[j].w - mu) * rs * gg.w + bb.w;
      }
    }
    if (layer == 4) {
      float* dst = p.xres + (size_t)row * DM;
#pragma unroll
      for (int j = 0; j < 4; ++j) *(f32x4*)(dst + j * 256 + lane * 4) = v[j];
    } else {
      bf16_t* dst = p.resb + (size_t)row * DM;
#pragma unroll
      for (int j = 0; j < 4; ++j) { u32x2 o; o.x = pack2(v[j].x, v[j].y); o.y = pack2(v[j].z, v[j].w); *(u32x2*)(dst + j * 256 + lane * 4) = o; }
    }
    if (layer < 4) {
#pragma unroll
      for (int j = 0; j < 4; ++j) {
        const f32x4 sh = msh[j], sc = msc[j];
        u32x2 o;
        o.x = pack2(v[j].x * (1.f + sc.x) + sh.x, v[j].y * (1.f + sc.y) + sh.y);
        o.y = pack2(v[j].z * (1.f + sc.z) + sh.z, v[j].w * (1.f + sc.w) + sh.w);
        *(u32x2*)(p.hbuf + (size_t)row * DM + j * 256 + lane * 4) = o;
      }
    }
  }
}

#define PG8_LAS __attribute__((address_space(3)))
namespace pg8 {
constexpr int BM = 256, BK = 64, HALF = 128, HTB = HALF * BK * 2, STAGE_BYTES = 8 * HTB, NXCD = 8, WGM = 8;
__device__ __forceinline__ int lds_byte(int r, int c) { const int st = (r >> 4) * 2 + (c >> 5), rr = r & 15, cc = c & 31, ob = rr * 64 + cc * 2; return st * 1024 + (ob ^ (((ob >> 9) & 1) << 5)); }
__device__ __forceinline__ void stage_rc(int b, int& R, int& C) { const int st = b / 1024, sb = b % 1024, swz = sb ^ (((sb >> 9) & 1) << 5); R = (st >> 1) * 16 + swz / 64; C = (st & 1) * 32 + (swz % 64) / 2; }
__device__ __forceinline__ int perm32(int rho) { const int n = rho >> 4, i = rho & 15; return 8 * (i >> 2) + 4 * n + (i & 3); }
struct Unit { int pm, pn; };
struct Gemm { const bf16_t* A; const bf16_t* Bt; int M, N, K, lda; int a_grp_shift; int a_grp_bytes; };
struct StaticOrder {
  int nM, nN, nwg, G, c;
  __device__ void init(int M, int N, int G_, int c_) { nM = M / BM; nN = N / BM; nwg = nM * nN; G = G_; c = c_; }
  __device__ bool next(int i, Unit& u) const {
    const long L = (long)i * G + c; if (L >= nwg) return false;
    int wgid = (int)L; { const int q = nwg / NXCD, r = nwg % NXCD, xcd = wgid % NXCD, off = wgid / NXCD; wgid = (xcd < r ? xcd * (q + 1) : r * (q + 1) + (xcd - r) * q) + off; }
    const int nig = WGM * nN, gid = wgid / nig, fm = gid * WGM, gsz = (nM - fm) < WGM ? (nM - fm) : WGM;
    u.pm = fm + ((wgid % nig) % gsz); u.pn = (wgid % nig) / gsz; return true;
  }
};
__device__ __forceinline__ unsigned cvt_pk_bf16(float lo, float hi) { return pack2(lo, hi); }

template <class Epi>
__device__ __forceinline__ void gemm_phase(PG8_LAS unsigned char* lds, const Gemm g, const StaticOrder& S, const Epi& E, int wave) {
  const int tid = opaque_tid512(wave), wid = wave, lane = tid & 63, wr = wid >> 2, wc = wid & 3, fr = lane & 15, fq = lane >> 4;
  const int K = g.K, nt = K / BK, lda = g.lda;
  unsigned voffA[2], voffB[2];
#pragma unroll
  for (int i = 0; i < 2; ++i) { int R, C; stage_rc(tid * 16 + i * 8192, R, C); const int Rb = Epi::PERM ? ((R & ~31) + perm32(R & 31)) : R;
    voffA[i] = (unsigned)(R * lda + C) * 2u; voffB[i] = (unsigned)(Rb * K + C) * 2u; }
  const size_t kstep = (size_t)(BK * 2);
  const size_t hstepA = (size_t)HALF * lda * 2, hstepB = (size_t)HALF * K * 2;
  const size_t tstepA = 2 * hstepA, tstepB = 2 * hstepB;
  const unsigned ldsw = (unsigned)wid * 1024u;
  const int aoff = lds_byte(wr * 64 + fr, fq * 8), boff = lds_byte(wc * 32 + fr, fq * 8);
#define PG8_SA(b, h) (((b) * 2 + (h)) * HTB)
#define PG8_SB(b, h) ((4 + (b) * 2 + (h)) * HTB)
#define PG8_STAGE(bufoff, gbase, voff) do { _Pragma("unroll") for (int _i = 0; _i < 2; ++_i) \
    __builtin_amdgcn_global_load_lds((const unsigned*)((const char*)(gbase) + (voff)[_i]), (PG8_LAS unsigned*)(lds + (bufoff) + ldsw + _i * 8192), 16, 0, 0); } while (0)
#define PG8_LDA(dst, b, h) do { _Pragma("unroll") for (int m = 0; m < 4; ++m) _Pragma("unroll") for (int k = 0; k < 2; ++k) dst[m][k] = *(const PG8_LAS bf16x8*)(lds + PG8_SA(b, h) + aoff + m * 2048 + k * 1024); } while (0)
#define PG8_LDB(dst, b, h) do { _Pragma("unroll") for (int n = 0; n < 2; ++n) _Pragma("unroll") for (int k = 0; k < 2; ++k) dst[n][k] = *(const PG8_LAS bf16x8*)(lds + PG8_SB(b, h) + boff + n * 2048 + k * 1024); } while (0)
#define PG8_MMA(ai, bj, At, Bt) do { __builtin_amdgcn_s_setprio(1); _Pragma("unroll") for (int m = 0; m < 4; ++m) _Pragma("unroll") for (int n = 0; n < 2; ++n) _Pragma("unroll") for (int k = 0; k < 2; ++k) \
    acc[ai][bj][m][n] = __builtin_amdgcn_mfma_f32_16x16x32_bf16(Bt[n][k], At[m][k], acc[ai][bj][m][n], 0, 0, 0); __builtin_amdgcn_s_setprio(0); } while (0)
#define PG8_WAIT_V(n) asm volatile("s_waitcnt vmcnt(" #n ")" ::: "memory")
#define PG8_WAIT_L(n) asm volatile("s_waitcnt lgkmcnt(" #n ")" ::: "memory")
#define PG8_BAR __builtin_amdgcn_s_barrier()
#define PG8_SCHED __builtin_amdgcn_sched_barrier(0)
#define PG8_APTR(u) ((const char*)g.A + (size_t)(u).pm * tstepA + (size_t)(((u).pn >> g.a_grp_shift) * g.a_grp_bytes))
  Unit cur, nxt; int ui = 0;
  if (!S.next(0, cur)) return;
  f32x4 acc[2][2][4][2];
#pragma unroll
  for (int a = 0; a < 2; ++a)
#pragma unroll
    for (int b = 0; b < 2; ++b)
#pragma unroll
      for (int m = 0; m < 4; ++m)
#pragma unroll
        for (int n = 0; n < 2; ++n) acc[a][b][m][n] = (f32x4){0.f, 0.f, 0.f, 0.f};
  bf16x8 At[4][2], B0[2][2], B1[2][2];
  const char* cA = PG8_APTR(cur); const char* cB = (const char*)g.Bt + (size_t)cur.pn * tstepB;
  PG8_STAGE(PG8_SB(0, 0), cB, voffB); PG8_STAGE(PG8_SA(0, 0), cA, voffA); PG8_STAGE(PG8_SB(0, 1), cB + hstepB, voffB); PG8_STAGE(PG8_SA(0, 1), cA + hstepA, voffA);
  if (wr == 1) PG8_BAR;
  PG8_WAIT_V(4); PG8_BAR;
  PG8_STAGE(PG8_SB(1, 0), cB + kstep, voffB); PG8_STAGE(PG8_SA(1, 0), cA + kstep, voffA); PG8_STAGE(PG8_SB(1, 1), cB + hstepB + kstep, voffB);
  PG8_WAIT_V(6); PG8_BAR;
  for (;;) {
    const bool has_next = S.next(ui + 1, nxt);
    const char* nA = has_next ? PG8_APTR(nxt) : cA; const char* nB = has_next ? (const char*)g.Bt + (size_t)nxt.pn * tstepB : cB;
    for (int t = 0; t < nt; t += 2) {
      const bool last = (t == nt - 2);
      const char* a1 = cA + (size_t)(t + 1) * kstep;
      const char* a2 = last ? nA : cA + (size_t)(t + 2) * kstep; const char* b2 = last ? nB : cB + (size_t)(t + 2) * kstep;
      const char* a3 = a2 + kstep; const char* b3 = b2 + kstep;
      PG8_LDB(B0, 0, 0); PG8_SCHED; PG8_LDA(At, 0, 0); PG8_STAGE(PG8_SA(1, 1), a1 + hstepA, voffA);
      PG8_WAIT_L(8); PG8_BAR; PG8_WAIT_L(0); PG8_MMA(0, 0, At, B0); PG8_BAR; PG8_SCHED;
      PG8_LDB(B1, 0, 1); PG8_STAGE(PG8_SB(0, 0), b2, voffB);
      PG8_BAR; PG8_WAIT_L(0); PG8_MMA(0, 1, At, B1); PG8_BAR;
      PG8_LDA(At, 0, 1); PG8_STAGE(PG8_SA(0, 0), a2, voffA);
      PG8_BAR; PG8_WAIT_L(0); PG8_MMA(1, 0, At, B0); PG8_BAR; PG8_SCHED;
      PG8_STAGE(PG8_SB(0, 1), b2 + hstepB, voffB);
      PG8_WAIT_V(6); PG8_BAR; PG8_MMA(1, 1, At, B1); PG8_BAR;
      PG8_LDB(B0, 1, 0); PG8_SCHED; PG8_LDA(At, 1, 0); PG8_STAGE(PG8_SA(0, 1), a2 + hstepA, voffA);
      PG8_WAIT_L(8); PG8_BAR; PG8_WAIT_L(0); PG8_MMA(0, 0, At, B0); PG8_BAR; PG8_SCHED;
      PG8_LDB(B1, 1, 1); PG8_STAGE(PG8_SB(1, 0), b3, voffB);
      PG8_BAR; PG8_WAIT_L(0); PG8_MMA(0, 1, At, B1); PG8_BAR;
      PG8_LDA(At, 1, 1); PG8_STAGE(PG8_SA(1, 0), a3, voffA);
      PG8_BAR; PG8_WAIT_L(0); PG8_MMA(1, 0, At, B0); PG8_BAR; PG8_SCHED;
      PG8_STAGE(PG8_SB(1, 1), b3 + hstepB, voffB);
      PG8_WAIT_V(6); PG8_BAR; PG8_MMA(1, 1, At, B1); PG8_BAR;
    }
    { const int lane2 = opaque_lane();
      E(acc, cur, wr, wc, lane2 & 15, lane2 >> 4); }
    if (!has_next) break;
#pragma unroll
    for (int a = 0; a < 2; ++a)
#pragma unroll
      for (int b = 0; b < 2; ++b)
#pragma unroll
        for (int m = 0; m < 4; ++m)
#pragma unroll
          for (int n = 0; n < 2; ++n) acc[a][b][m][n] = (f32x4){0.f, 0.f, 0.f, 0.f};
    cur = nxt; cA = nA; cB = nB; ++ui;
  }
  PG8_WAIT_V(0);
  if (wr == 0) PG8_BAR;
  PG8_BAR;
#undef PG8_SA
#undef PG8_SB
#undef PG8_STAGE
#undef PG8_LDA
#undef PG8_LDB
#undef PG8_MMA
#undef PG8_WAIT_V
#undef PG8_WAIT_L
#undef PG8_BAR
#undef PG8_SCHED
#undef PG8_APTR
}

struct EpiBf16 {
  static constexpr bool PERM = true;
  bf16_t* O; size_t ldc;
  __device__ __forceinline__ void operator()(const f32x4 (&acc)[2][2][4][2], const Unit& u, int wr, int wc, int fr, int fq) const {
    const int row0 = u.pm * BM + wr * 64 + fr, col0 = u.pn * BM + wc * 32 + 8 * fq;
#pragma unroll
    for (int ai = 0; ai < 2; ++ai)
#pragma unroll
      for (int m = 0; m < 4; ++m) {
        bf16_t* rowp = O + (size_t)(row0 + ai * HALF + m * 16) * ldc + col0;
#pragma unroll
        for (int bj = 0; bj < 2; ++bj) {
          const f32x4 v0 = acc[ai][bj][m][0], v1 = acc[ai][bj][m][1];
          u32x4 w; w.x = pack2(v0[0], v0[1]); w.y = pack2(v0[2], v0[3]); w.z = pack2(v1[0], v1[1]); w.w = pack2(v1[2], v1[3]);
          *(u32x4*)(rowp + bj * HALF) = w;
        }
      }
  }
};
struct EpiSsdIn {
  static constexpr bool PERM = true;
  bf16_t* z; bf16_t* xbc; float* dt; const float* dt_bias;
  __device__ __forceinline__ void operator()(const f32x4 (&acc)[2][2][4][2], const Unit& u, int wr, int wc, int fr, int fq) const {
    const int row0 = u.pm * BM + wr * 64 + fr, colt = u.pn * BM + wc * 32 + 8 * fq;
    if (u.pn < 24) {
      bf16_t* base = u.pn < 8 ? z : xbc; const size_t ldc = u.pn < 8 ? 2048 : 4096; const int col0 = u.pn < 8 ? colt : colt - 2048;
#pragma unroll
      for (int ai = 0; ai < 2; ++ai)
#pragma unroll
        for (int m = 0; m < 4; ++m) {
          bf16_t* rowp = base + (size_t)(row0 + ai * HALF + m * 16) * ldc + col0;
#pragma unroll
          for (int bj = 0; bj < 2; ++bj) {
            const f32x4 v0 = acc[ai][bj][m][0], v1 = acc[ai][bj][m][1];
            u32x4 w; w.x = pack2(v0[0], v0[1]); w.y = pack2(v0[2], v0[3]); w.z = pack2(v1[0], v1[1]); w.w = pack2(v1[2], v1[3]);
            *(u32x4*)(rowp + bj * HALF) = w;
          }
        }
    } else {
      const int c0 = wc * 32 + 8 * fq;
      if (c0 < 64) {
#pragma unroll
        for (int ai = 0; ai < 2; ++ai)
#pragma unroll
          for (int m = 0; m < 4; ++m) {
            float* rowp = dt + (size_t)(row0 + ai * HALF + m * 16) * 64 + c0;
#pragma unroll
            for (int n = 0; n < 2; ++n) {
              const f32x4 v = acc[ai][0][m][n];
              f32x4 o;
#pragma unroll
              for (int e = 0; e < 4; ++e) o[e] = softplusf(v[e] + dt_bias[c0 + 4 * n + e]);
              *(f32x4*)(rowp + 4 * n) = o;
            }
          }
      }
    }
  }
};
struct EpiOut {
  static constexpr bool PERM = true;
  bf16_t* res; const float* modv_layer; const float* rstd;
  __device__ __forceinline__ void operator()(const f32x4 (&acc)[2][2][4][2], const Unit& u, int wr, int wc, int fr, int fq) const {
    const int row0 = u.pm * BM + wr * 64 + fr, col0 = u.pn * BM + wc * 32 + 8 * fq;
#pragma unroll
    for (int ai = 0; ai < 2; ++ai)
#pragma unroll
      for (int m = 0; m < 4; ++m) {
        const int row = row0 + ai * HALF + m * 16;
        const int mrow = row < T_CTX ? 0 : 1 + ((row - T_CTX) >> 12);
        const float rs = rstd ? rstd[row] : 1.f;
        const float* gp = modv_layer + (size_t)mrow * 3072 + 2048 + col0;
        bf16_t* rowp = res + (size_t)row * DM + col0;
#pragma unroll
        for (int bj = 0; bj < 2; ++bj) {
          const f32x4 g0 = *(const f32x4*)(gp + bj * HALF), g1 = *(const f32x4*)(gp + bj * HALF + 4);
          const u32x4 xw = *(const u32x4*)(rowp + bj * HALF);
          const f32x4 v0 = acc[ai][bj][m][0], v1 = acc[ai][bj][m][1];
          u32x4 o;
          o.x = pack2(ALPHA_RES * bflo(xw.x) + g0.x * (v0[0] * rs), ALPHA_RES * bfhi(xw.x) + g0.y * (v0[1] * rs));
          o.y = pack2(ALPHA_RES * bflo(xw.y) + g0.z * (v0[2] * rs), ALPHA_RES * bfhi(xw.y) + g0.w * (v0[3] * rs));
          o.z = pack2(ALPHA_RES * bflo(xw.z) + g1.x * (v1[0] * rs), ALPHA_RES * bfhi(xw.z) + g1.y * (v1[1] * rs));
          o.w = pack2(ALPHA_RES * bflo(xw.w) + g1.z * (v1[2] * rs), ALPHA_RES * bfhi(xw.w) + g1.w * (v1[3] * rs));
          *(u32x4*)(rowp + bj * HALF) = o;
        }
      }
  }
};
struct EpiLruGate {
  static constexpr bool PERM = true;
  bf16_t* gates; const float* gate_b;
  __device__ __forceinline__ void operator()(const f32x4 (&acc)[2][2][4][2], const Unit& u, int wr, int wc, int fr, int fq) const {
    const int nb = u.pn >> 2, dg = u.pn & 3;
    const int row0 = u.pm * BM + wr * 64 + fr, ch0 = nb * 256 + wc * 32 + 8 * fq;
#pragma unroll
    for (int ai = 0; ai < 2; ++ai)
#pragma unroll
      for (int m = 0; m < 4; ++m) {
        bf16_t* rowp = gates + ((size_t)dg * T_ALL + row0 + ai * HALF + m * 16) * 1024 + ch0;
#pragma unroll
        for (int bj = 0; bj < 2; ++bj) {
          const float* bp = gate_b + dg * 1024 + ch0 + bj * HALF;
          const f32x4 b0 = *(const f32x4*)bp, b1 = *(const f32x4*)(bp + 4);
          const f32x4 v0 = acc[ai][bj][m][0] + b0, v1 = acc[ai][bj][m][1] + b1;
          u32x4 w; w.x = pack2(sigmoidf(v0[0]), sigmoidf(v0[1])); w.y = pack2(sigmoidf(v0[2]), sigmoidf(v0[3]));
          w.z = pack2(sigmoidf(v1[0]), sigmoidf(v1[1])); w.w = pack2(sigmoidf(v1[2]), sigmoidf(v1[3]));
          *(u32x4*)(rowp + bj * HALF) = w;
        }
      }
  }
};
}

template <int KW, bool SILU>
__device__ __forceinline__ void phase_dwconv(const bf16_t* __restrict__ src, int ld_src, bf16_t* __restrict__ dst, int ld_dst, int CH,
                             const float* __restrict__ w, const float* __restrict__ b, bool colmajor, int bid, int nblk, int cxw) {
  const int tidx = opaque_tid(cxw);
  const int cpr = CH / 8;
  const size_t total = (size_t)T_ALL * cpr;
  for (size_t idx = (size_t)bid * NTHR + tidx; idx < total; idx += (size_t)nblk * NTHR) {
    int tok = (int)(idx / cpr), c0 = (int)(idx % cpr) * 8;
    TokInfo ti = tokinfo(tok);
    bool cm = colmajor && ti.s >= 32;
    int pos = seqpos2off(ti.l, cm);
    float acc[8];
#pragma unroll
    for (int e = 0; e < 8; ++e) acc[e] = b[c0 + e];
#pragma unroll
    for (int k = 0; k < KW; ++k) {
      int pp = pos + k - 1;
      if (pp < 0 || pp >= ti.L) continue;
      int tk = ti.base + seqpos2off(pp, cm);
      u32x4 xv = *(const u32x4*)(src + (size_t)tk * ld_src + c0);
      const float* wk = w + (size_t)k * CH + c0;
      acc[0] += wk[0] * bflo(xv.x); acc[1] += wk[1] * bfhi(xv.x);
      acc[2] += wk[2] * bflo(xv.y); acc[3] += wk[3] * bfhi(xv.y);
      acc[4] += wk[4] * bflo(xv.z); acc[5] += wk[5] * bfhi(xv.z);
      acc[6] += wk[6] * bflo(xv.w); acc[7] += wk[7] * bfhi(xv.w);
    }
    if (SILU) {
#pragma unroll
      for (int e = 0; e < 8; ++e) acc[e] = siluf(acc[e]);
    }
    u32x4 o;
    o.x = pack2(acc[0], acc[1]); o.y = pack2(acc[2], acc[3]); o.z = pack2(acc[4], acc[5]); o.w = pack2(acc[6], acc[7]);
    *(u32x4*)(dst + (size_t)tok * ld_dst + c0) = o;
  }
}

__device__ __forceinline__ void phase_ssd_conv(const Params& p, int slot, bool colmajor, int bid, int nblk, unsigned char* smem, int cxw) {
  const int tid = opaque_tid(cxw);
  const bf16_t* raw = (const bf16_t*)(p.scratch + SC_SSD_XBC);
  bf16_t* out = (bf16_t*)(p.scratch + SC_SSD_XBCC);
  bf16_t* XT = (bf16_t*)(p.scratch + SC_SSD_XT);
  bf16_t* BT = (bf16_t*)(p.scratch + SC_SSD_BT);
  bf16_t* BF = (bf16_t*)(p.scratch + SC_SSD_BF);
  bf16_t* CF = (bf16_t*)(p.scratch + SC_SSD_CF);
  const float* cw = p.ssd_conv_w + (size_t)slot * 4 * 4096;
  const float* cb = p.ssd_conv_b + slot * 4096;
  bf16_t* tl = (bf16_t*)smem;
  bf16_t* rt = tl + 64 * 72;
  const int rr = tid >> 2, cpart = tid & 3;
  const int NITEMS = 384 * 64;
  u32x4 pre[3];
#define CONV_PREFETCH(ITEM) do { const int it_ = (ITEM); const int ptile_ = it_ >> 6, ct_ = it_ & 63; \
    const TokInfo ti_ = tokinfo(ptile_ * 64); const bool cm_ = colmajor && ti_.s >= 32; \
    _Pragma("unroll") for (int i_ = 0; i_ < 3; ++i_) { const int q_ = tid + i_ * 256; const int row_ = q_ >> 3, c8_ = (q_ & 7) * 8; \
      const int pp_ = ti_.l - 1 + row_; u32x4 v_ = {0u, 0u, 0u, 0u}; \
      if (row_ < 67 && pp_ >= 0 && pp_ < ti_.L) v_ = *(const u32x4*)(raw + (size_t)(ti_.base + seqpos2off(pp_, cm_)) * 4096 + ct_ * 64 + c8_); \
      pre[i_] = v_; } } while (0)
  if (bid < NITEMS) CONV_PREFETCH(bid);
  float wreg[4][16], wb[16]; int wct = -1;
  for (int item = bid; item < NITEMS; item += nblk) {
    const int ptile = item >> 6, ct = item & 63;
    const int ptok0 = ptile * 64;
    const int ch = ct * 64 + cpart * 16;
    __syncthreads();
#pragma unroll
    for (int i = 0; i < 3; ++i) { const int q = tid + i * 256; if (q < 67 * 8) *(u32x4*)(rt + (q >> 3) * 72 + (q & 7) * 8) = pre[i]; }
    if (item + nblk < NITEMS) CONV_PREFETCH(item + nblk);
    __syncthreads();
    if (ct != wct) {
      wct = ct;
#pragma unroll
      for (int e = 0; e < 16; ++e) wb[e] = cb[ch + e];
#pragma unroll
      for (int k = 0; k < 4; ++k)
#pragma unroll
        for (int e = 0; e < 16; ++e) wreg[k][e] = cw[(size_t)k * 4096 + ch + e];
    }
    float acc[16];
#pragma unroll
    for (int e = 0; e < 16; ++e) acc[e] = wb[e];
#pragma unroll
    for (int k = 0; k < 4; ++k) {
      const bf16_t* rp = rt + (rr + k) * 72 + cpart * 16;
      u32x4 x0 = *(const u32x4*)rp, x1 = *(const u32x4*)(rp + 8);
      unsigned xw[8] = {x0.x, x0.y, x0.z, x0.w, x1.x, x1.y, x1.z, x1.w};
#pragma unroll
      for (int e = 0; e < 8; ++e) { acc[2 * e] += wreg[k][2 * e] * bflo(xw[e]); acc[2 * e + 1] += wreg[k][2 * e + 1] * bfhi(xw[e]); }
    }
    u32x4 o0, o1;
    o0.x = pack2(siluf(acc[0]), siluf(acc[1])); o0.y = pack2(siluf(acc[2]), siluf(acc[3]));
    o0.z = pack2(siluf(acc[4]), siluf(acc[5])); o0.w = pack2(siluf(acc[6]), siluf(acc[7]));
    o1.x = pack2(siluf(acc[8]), siluf(acc[9])); o1.y = pack2(siluf(acc[10]), siluf(acc[11]));
    o1.z = pack2(siluf(acc[12]), siluf(acc[13])); o1.w = pack2(siluf(acc[14]), siluf(acc[15]));
    *(u32x4*)(tl + rr * 72 + cpart * 16) = o0;
    *(u32x4*)(tl + rr * 72 + cpart * 16 + 8) = o1;
    __syncthreads();
    if (ct < 32) {
      const int crow = tid >> 2, part = tid & 3;
      unsigned wv[8];
#pragma unroll
      for (int e = 0; e < 8; ++e) {
        unsigned lo = tl[(part * 16 + 2 * e) * 72 + crow], hi = tl[(part * 16 + 2 * e + 1) * 72 + crow];
        wv[e] = lo | (hi << 16);
      }
      bf16_t* dp = XT + (size_t)(ct * 64 + crow) * T_ALL + ptok0 + part * 16;
      u32x4 t0, t1;
      t0.x = wv[0]; t0.y = wv[1]; t0.z = wv[2]; t0.w = wv[3]; t1.x = wv[4]; t1.y = wv[5]; t1.z = wv[6]; t1.w = wv[7];
      *(u32x4*)dp = t0; *(u32x4*)(dp + 8) = t1;
    } else {
      const bool isB = ct < 48;
      const int cq = (ct - (isB ? 32 : 48));
      const int g = cq >> 1, chhalf = cq & 1;
      const int lane = tid & 63, r = lane & 31, hh = lane >> 5;
      bf16_t* F = isB ? BF : CF;
#pragma unroll
      for (int i = 0; i < 2; ++i) {
        const int f = (cxw & 3) + 4 * i;
        const int rt2 = f >> 2, kk4 = f & 3;
        const u32x4 v = *(const u32x4*)(tl + (32 * rt2 + r) * 72 + 16 * kk4 + 8 * hh);
        const size_t rt = (size_t)(ptok0 >> 5) + rt2;
        *(u32x4*)(F + (((rt * 8 + g) * 8 + chhalf * 4 + kk4) * 64 + lane) * 8) = v;
      }
      if (isB) {
#pragma unroll
        for (int i = 0; i < 2; ++i) {
          const int f = (cxw & 3) + 4 * i;
          const int nt2 = f >> 2, ts4 = f & 3;
          unsigned wv[4];
#pragma unroll
          for (int e = 0; e < 4; ++e) {
            unsigned lo = tl[(16 * ts4 + 8 * hh + 2 * e) * 72 + 32 * nt2 + r], hi = tl[(16 * ts4 + 8 * hh + 2 * e + 1) * 72 + 32 * nt2 + r];
            wv[e] = lo | (hi << 16);
          }
          u32x4 v; v.x = wv[0]; v.y = wv[1]; v.z = wv[2]; v.w = wv[3];
          const size_t ts = (size_t)(ptok0 >> 4) + ts4;
          *(u32x4*)(BT + (((ts * 8 + g) * 4 + chhalf * 2 + nt2) * 64 + lane) * 8) = v;
        }
      }
    }
  }
}

#define SH_STRIDE 136
__device__ __forceinline__ int rowmap(int e, int hh) { return (e & 3) + 8 * (e >> 2) + 4 * hh; }
__device__ __forceinline__ bf16x8 pack8(float a0, float a1, float a2, float a3, float a4, float a5, float a6, float a7) {
  u32x4 v; v.x = pack2(a0, a1); v.y = pack2(a2, a3); v.z = pack2(a4, a5); v.w = pack2(a6, a7);
  return __builtin_bit_cast(bf16x8, v);
}
#define SCAN_PRIV 56576
#define SCAN_SF 49152
__device__ __forceinline__ void phase_ssd_scan(const Params& p, int slot, bool colmajor, int bid, int nblk, unsigned char* wg_smem, int cxw) {
  const int tid = opaque_tid(cxw), lane = tid & 63, w = cxw & 3, vb = cxw >> 2, r = lane & 31, hh = lane >> 5;
  const int it = w >> 1, pt = w & 1;
  const bf16_t* XT = (const bf16_t*)(p.scratch + SC_SSD_XT);
  const bf16_t* BT = (const bf16_t*)(p.scratch + SC_SSD_BT);
  const bf16_t* BF = (const bf16_t*)(p.scratch + SC_SSD_BF);
  const bf16_t* CF = (const bf16_t*)(p.scratch + SC_SSD_CF);
  const float* dtb = (const float*)(p.scratch + SC_SSD_DT);
  bf16_t* ybuf = (bf16_t*)(p.scratch + SC_SSD_XBC);
  unsigned char* priv = wg_smem + (vb ? SCAN_SF + SCAN_PRIV : 0);
  bf16_t* sXr = (bf16_t*)priv;
  bf16_t* sXs = sXr + 64 * 72;
  bf16_t* sH = sXs + 64 * 72;
  float* sW = (float*)(sH + 64 * SH_STRIDE);
  bf16_t* sY = (bf16_t*)(sW + 4 * 256);
  bf16_t* sXd = sY + 64 * 64;
  float* sDt = (float*)(sXd + 64 * 64);
  float* myW = sW + w * 256;
  const bf16_t* sfC = (const bf16_t*)(wg_smem + SCAN_PRIV);
  const bf16_t* sfB = sfC + 8192;
  const bf16_t* sfT = sfC + 16384;
  for (int item = bid; item < 36 * 64; item += nblk) {
    int s, h, dir;
    {
      const int itx = item < 256 ? item : item - 256;
      const int idx = itx & 63, pairidx = idx >> 1;
      s = item < 256 ? 32 + (itx >> 6) : (itx >> 6);
      dir = pairidx & 1; h = (pairidx >> 1) * 2 + (idx & 1);
    }
    const int L = s < 32 ? 256 : 4096;
    const int base = s < 32 ? s * 256 : T_CTX + (s - 32) * 4096;
    const bool cm = colmajor && s >= 32;
    const int g = h >> 2;
    const float Aval = -expf(p.ssd_a_log[(slot * 2 + dir) * 32 + h]);
    const float dskip = p.ssd_d[slot * 32 + h];
    const int nchunks = L >> 6;
    const int pcol = 32 * pt + r;
    f32x16 hacc[2];
    if (s >= 32) {
      const float* h0 = p.state_ssd + ((((size_t)(s - 32) * 2 + slot) * 2 + dir) * 32 + h) * 8192 + (size_t)pcol * 128;
#pragma unroll
      for (int t2 = 0; t2 < 2; ++t2)
#pragma unroll
        for (int qd = 0; qd < 4; ++qd) {
          f32x4 v = *(const f32x4*)(h0 + 32 * (2 * it + t2) + 8 * qd + 4 * hh);
          hacc[t2][4 * qd] = v.x; hacc[t2][4 * qd + 1] = v.y; hacc[t2][4 * qd + 2] = v.z; hacc[t2][4 * qd + 3] = v.w;
        }
    } else {
#pragma unroll
      for (int t2 = 0; t2 < 2; ++t2)
#pragma unroll
        for (int e = 0; e < 16; ++e) hacc[t2][e] = 0.f;
    }
#define SCAN_PTOK(c) (base + 64 * (dir ? nchunks - 1 - (c) : (c)))
#define SCAN_DMA_DTX(pt0) do { \
      _Pragma("unroll") for (int i_ = 0; i_ < 2; ++i_) { \
        const bf16_t* src_ = XT + (size_t)(h * 64 + 16 * w + 8 * i_ + (lane >> 3)) * T_ALL + (pt0) + (lane & 7) * 8; \
        __builtin_amdgcn_global_load_lds((const unsigned*)src_, (PG8_LAS unsigned*)((unsigned char*)sXd + (16 * w + 8 * i_) * 128), 16, 0, 0); } \
      { const int tok_ = base + seqpos2off((pt0) - base + lane, cm); \
        const float* dsrc_ = dtb + (size_t)tok_ * 64 + dir * 32 + h; \
        __builtin_amdgcn_global_load_lds((const unsigned*)dsrc_, (PG8_LAS unsigned*)sDt, 4, 0, 0); } } while (0)
#define SCAN_DMA(pt0) do { \
      _Pragma("unroll") for (int i_ = 0; i_ < 6; ++i_) { const int q_ = cxw + 8 * (i_ & 1); \
        const bf16_t* src_; \
        if (i_ < 4) src_ = (i_ < 2 ? CF : BF) + ((((size_t)((pt0) >> 5) + (q_ >> 3)) * 8 + g) * 8 + (q_ & 7)) * 512 + lane * 8; \
        else src_ = BT + ((((size_t)((pt0) >> 4) + (q_ >> 2)) * 8 + g) * 4 + (q_ & 3)) * 512 + lane * 8; \
        __builtin_amdgcn_global_load_lds((const unsigned*)src_, (PG8_LAS unsigned*)(wg_smem + SCAN_PRIV + (i_ >> 1) * 16384 + q_ * 1024), 16, 0, 0); } } while (0)
#define SCAN_WRITE_STATE() do { \
      _Pragma("unroll") for (int t2 = 0; t2 < 2; ++t2) _Pragma("unroll") for (int qd = 0; qd < 4; ++qd) { \
        u32x2 o_; o_.x = pack2(hacc[t2][4 * qd], hacc[t2][4 * qd + 1]); o_.y = pack2(hacc[t2][4 * qd + 2], hacc[t2][4 * qd + 3]); \
        *(u32x2*)(sH + pcol * SH_STRIDE + 32 * (2 * it + t2) + 8 * qd + 4 * hh) = o_; } } while (0)
    const bool need0 = dir == 0 ? true : (it == 0);
    const bool need1 = dir == 0 ? (it == 1) : true;
    __syncthreads();
    {
      const int p0 = SCAN_PTOK(0);
      SCAN_DMA_DTX(p0);
      SCAN_DMA(p0);
      SCAN_WRITE_STATE();
    }
#define SCAN_BAR_A() do { asm volatile("s_waitcnt vmcnt(6) lgkmcnt(0)" ::: "memory"); __builtin_amdgcn_s_barrier(); asm volatile("" ::: "memory"); } while (0)
#define SCAN_BAR_LDS() do { asm volatile("s_waitcnt lgkmcnt(0)" ::: "memory"); __builtin_amdgcn_s_barrier(); asm volatile("" ::: "memory"); } while (0)
#define SCAN_BAR_MEM() do { asm volatile("s_waitcnt vmcnt(0) lgkmcnt(0)" ::: "memory"); __builtin_amdgcn_s_barrier(); asm volatile("" ::: "memory"); } while (0)
    for (int ci = 0; ci < nchunks; ++ci) {
      const int cin = ci + 1 < nchunks ? ci + 1 : ci;
      const int ptokN = SCAN_PTOK(cin);
      SCAN_BAR_A();
      float decE;
      {
        const float dtv = sDt[lane];
        const float a_ = dtv * Aval;
        const float pre = wave_incl_scan(a_);
        const float cE = __int_as_float(__builtin_amdgcn_readlane(__float_as_int(pre), 63));
        const float c = dir == 0 ? pre : cE - pre + a_;
        myW[lane] = dtv; myW[64 + lane] = c; myW[128 + lane] = __expf(c); myW[192 + lane] = dtv * __expf(cE - c);
        decE = __expf(cE);
      }
#pragma unroll
      for (int i = 0; i < 2; ++i) {
        const int q = tid + i * 256, prow = q >> 3, j8 = (q & 7) * 8;
        const u32x4 raw = *(const u32x4*)(sXd + prow * 64 + j8);
        *(u32x4*)(sXr + prow * 72 + j8) = raw;
        f32x4 f0 = *(const f32x4*)(myW + 192 + j8), f1 = *(const f32x4*)(myW + 192 + j8 + 4);
        u32x4 sc;
        sc.x = pack2(bflo(raw.x) * f0.x, bfhi(raw.x) * f0.y); sc.y = pack2(bflo(raw.y) * f0.z, bfhi(raw.y) * f0.w);
        sc.z = pack2(bflo(raw.z) * f1.x, bfhi(raw.z) * f1.y); sc.w = pack2(bflo(raw.w) * f1.z, bfhi(raw.w) * f1.w);
        *(u32x4*)(sXs + prow * 72 + j8) = sc;
      }
      SCAN_BAR_MEM();
      if (ci > 0) {
        const int ptokP = SCAN_PTOK(ci - 1);
#pragma unroll
        for (int i = 0; i < 2; ++i) {
          const int q = tid + i * 256, yrow = q >> 3, c8 = (q & 7) * 8;
          *(u32x4*)(ybuf + ((size_t)dir * T_ALL + ptokP + yrow) * 2048 + h * 64 + c8) = *(const u32x4*)(sY + yrow * 64 + c8);
        }
      }
      SCAN_DMA_DTX(ptokN);
#pragma unroll
      for (int t2 = 0; t2 < 2; ++t2) {
#pragma unroll
        for (int e = 0; e < 16; ++e) hacc[t2][e] *= decE;
        const bf16_t* xs = sXs + pcol * 72 + 8 * hh;
#pragma unroll
        for (int kk = 0; kk < 4; ++kk)
          hacc[t2] = __builtin_amdgcn_mfma_f32_32x32x16_bf16(*(const bf16x8*)(sfT + (kk * 4 + 2 * it + t2) * 512 + lane * 8), *(const bf16x8*)(xs + 16 * kk), hacc[t2], 0, 0, 0);
      }
      bf16x8 cfr[8];
#pragma unroll
      for (int kk = 0; kk < 8; ++kk) cfr[kk] = *(const bf16x8*)(sfC + (it * 8 + kk) * 512 + lane * 8);
      f32x16 acc;
#pragma unroll
      for (int e = 0; e < 16; ++e) acc[e] = 0.f;
      {
        const bf16_t* hp = sH + pcol * SH_STRIDE + 8 * hh;
#pragma unroll
        for (int kk = 0; kk < 8; ++kk) acc = __builtin_amdgcn_mfma_f32_32x32x16_bf16(cfr[kk], *(const bf16x8*)(hp + 16 * kk), acc, 0, 0, 0);
      }
      f32x16 X[2];
#pragma unroll
      for (int jt = 0; jt < 2; ++jt) {
#pragma unroll
        for (int e = 0; e < 16; ++e) X[jt][e] = 0.f;
        if (jt == 0 ? need0 : need1) {
#pragma unroll
          for (int kk = 0; kk < 8; ++kk) X[jt] = __builtin_amdgcn_mfma_f32_32x32x16_bf16(*(const bf16x8*)(sfB + (jt * 8 + kk) * 512 + lane * 8), cfr[kk], X[jt], 0, 0, 0);
        }
      }
      SCAN_BAR_LDS();
      SCAN_DMA(ptokN);
      SCAN_WRITE_STATE();
#pragma unroll
      for (int qd = 0; qd < 4; ++qd) {
        f32x4 ec = *(const f32x4*)(myW + 128 + 32 * it + 8 * qd + 4 * hh);
        acc[4 * qd] *= ec.x; acc[4 * qd + 1] *= ec.y; acc[4 * qd + 2] *= ec.z; acc[4 * qd + 3] *= ec.w;
      }
      const int icol = 32 * it + r;
      const float ci_ = myW[64 + icol];
#pragma unroll
      for (int jt = 0; jt < 2; ++jt) {
        if (jt == 0 ? need0 : need1) {
#pragma unroll
          for (int qd = 0; qd < 4; ++qd) {
            const int j0 = 32 * jt + 8 * qd + 4 * hh;
            f32x4 cj = *(const f32x4*)(myW + 64 + j0), dj = *(const f32x4*)(myW + j0);
            float cjv[4] = {cj.x, cj.y, cj.z, cj.w}, djv[4] = {dj.x, dj.y, dj.z, dj.w};
#pragma unroll
            for (int u = 0; u < 4; ++u) {
              const int j = j0 + u;
              const bool ok = dir == 0 ? (j <= icol) : (j >= icol);
              const float m = __expf(ci_ - cjv[u]) * djv[u];
              X[jt][4 * qd + u] = ok ? X[jt][4 * qd + u] * m : 0.f;
            }
          }
#pragma unroll
          for (int sk = 0; sk < 2; ++sk) {
            bf16x8 afr = pack8(X[jt][8 * sk], X[jt][8 * sk + 1], X[jt][8 * sk + 2], X[jt][8 * sk + 3], X[jt][8 * sk + 4], X[jt][8 * sk + 5], X[jt][8 * sk + 6], X[jt][8 * sk + 7]);
            const bf16_t* xp = sXr + pcol * 72 + 32 * jt + 16 * sk + 4 * hh;
            u32x2 lo = *(const u32x2*)xp, hi = *(const u32x2*)(xp + 8);
            u32x4 xv; xv.x = lo.x; xv.y = lo.y; xv.z = hi.x; xv.w = hi.y;
            acc = __builtin_amdgcn_mfma_f32_32x32x16_bf16(afr, __builtin_bit_cast(bf16x8, xv), acc, 0, 0, 0);
          }
        }
      }
      if (dir == 0) {
#pragma unroll
        for (int qd = 0; qd < 4; ++qd) {
          const u32x2 xw = *(const u32x2*)(sXr + pcol * 72 + 32 * it + 8 * qd + 4 * hh);
          acc[4 * qd] += dskip * bflo(xw.x); acc[4 * qd + 1] += dskip * bfhi(xw.x);
          acc[4 * qd + 2] += dskip * bflo(xw.y); acc[4 * qd + 3] += dskip * bfhi(xw.y);
        }
      }
      {
        bf16_t* yo = sY + (32 * it) * 64 + pcol;
#pragma unroll
        for (int e = 0; e < 16; ++e) yo[rowmap(e, hh) * 64] = f2bf(acc[e]);
      }
    }
    __syncthreads();
    {
      const int ptokP = SCAN_PTOK(nchunks - 1);
#pragma unroll
      for (int i = 0; i < 2; ++i) {
        const int q = tid + i * 256, yrow = q >> 3, c8 = (q & 7) * 8;
        *(u32x4*)(ybuf + ((size_t)dir * T_ALL + ptokP + yrow) * 2048 + h * 64 + c8) = *(const u32x4*)(sY + yrow * 64 + c8);
      }
    }
#undef SCAN_PTOK
#undef SCAN_DMA_DTX
#undef SCAN_DMA
#undef SCAN_WRITE_STATE
    if (s < 32) {
      float* ho = p.out_ssd + ((((size_t)s * 2 + slot) * 2 + dir) * 32 + h) * 8192 + (size_t)pcol * 128;
#pragma unroll
      for (int t2 = 0; t2 < 2; ++t2)
#pragma unroll
        for (int qd = 0; qd < 4; ++qd) {
          f32x4 v; v.x = hacc[t2][4 * qd]; v.y = hacc[t2][4 * qd + 1]; v.z = hacc[t2][4 * qd + 2]; v.w = hacc[t2][4 * qd + 3];
          *(f32x4*)(ho + 32 * (2 * it + t2) + 8 * qd + 4 * hh) = v;
        }
    }
    asm volatile("s_waitcnt vmcnt(0)" ::: "memory");
  }
}

__device__ __forceinline__ void phase_ssd_gate(const Params& p, int slot, int bid, int nblk, int cxw) {
  const int tidx = opaque_tid(cxw);
  bf16_t* zb = (bf16_t*)(p.scratch + SC_SSD_Z);
  const bf16_t* yfb = (const bf16_t*)(p.scratch + SC_SSD_XBC);
  const bf16_t* ybb = yfb + (size_t)T_ALL * 2048;
  const bf16_t* xbcc = (const bf16_t*)(p.scratch + SC_SSD_XBCC);
  int lane = tidx & 63, wv = cxw & 3;
  for (int row = bid * 4 + wv; row < T_ALL; row += nblk * 4) {
    float ss = 0.f;
    TokInfo ti = tokinfo(row);
    const int prow = ti.base + seqpos2off(ti.l, slot == 1 && ti.s >= 32);
#pragma unroll
    for (int j = 0; j < 4; ++j) {
      int c0 = j * 512 + lane * 8;
      u32x4 zv = *(const u32x4*)(zb + (size_t)row * 2048 + c0);
      u32x4 fv = *(const u32x4*)(yfb + (size_t)prow * 2048 + c0);
      u32x4 bv = *(const u32x4*)(ybb + (size_t)prow * 2048 + c0);
      unsigned zw[4] = {zv.x, zv.y, zv.z, zv.w}, fw[4] = {fv.x, fv.y, fv.z, fv.w}, bw[4] = {bv.x, bv.y, bv.z, bv.w};
      unsigned ow[4];
#pragma unroll
      for (int e = 0; e < 4; ++e) {
        float y0 = (bflo(fw[e]) + bflo(bw[e])) * siluf(bflo(zw[e]));
        float y1 = (bfhi(fw[e]) + bfhi(bw[e])) * siluf(bfhi(zw[e]));
        ss += y0 * y0 + y1 * y1;
        ow[e] = pack2(y0, y1);
      }
      u32x4 o; o.x = ow[0]; o.y = ow[1]; o.z = ow[2]; o.w = ow[3];
      *(u32x4*)(zb + (size_t)row * 2048 + c0) = o;
    }
#pragma unroll
    for (int o = 32; o > 0; o >>= 1) ss += shfl_xor_f(ss, o, lane);
    if (lane == 0) p.rstd[row] = rsqrtf(ss * (1.f / 2048.f) + 1e-5f);
  }
}

#define HY_UOFF (32768 + 64)
__device__ __forceinline__ void hy_stage_conv(const Params& p, const bf16_t* __restrict__ row, int ch, bf16_t* dst, int dstStride, int dstPad,
                                              int nelem, int L, int tid) {
  const float w0 = p.hy_conv_w[ch], w1 = p.hy_conv_w[3072 + ch], w2 = p.hy_conv_w[2 * 3072 + ch], bb = p.hy_conv_b[ch];
  for (int q = tid; q < nelem / 8; q += NTHR) {
    const int e0 = q * 8, b = e0 / L, t0 = e0 & (L - 1);
    u32x4 raw = *(const u32x4*)(row + e0);
    float x[10];
    x[0] = t0 > 0 ? bf2f(row[e0 - 1]) : 0.f;
    x[9] = t0 + 8 < L ? bf2f(row[e0 + 8]) : 0.f;
    x[1] = bflo(raw.x); x[2] = bfhi(raw.x); x[3] = bflo(raw.y); x[4] = bfhi(raw.y);
    x[5] = bflo(raw.z); x[6] = bfhi(raw.z); x[7] = bflo(raw.w); x[8] = bfhi(raw.w);
    float o[8];
#pragma unroll
    for (int j = 0; j < 8; ++j) o[j] = w0 * x[j] + w1 * x[j + 1] + w2 * x[j + 2] + bb;
    u32x4 ov; ov.x = pack2(o[0], o[1]); ov.y = pack2(o[2], o[3]); ov.z = pack2(o[4], o[5]); ov.w = pack2(o[6], o[7]);
    *(u32x4*)(dst + b * dstStride + dstPad + t0) = ov;
  }
}

__device__ __forceinline__ void phase_hy_longconv(const Params& p, int bid, int nblk, unsigned char* smem, int cxw) {
  const int tid = opaque_tid(cxw), lane = tid & 63, w = cxw & 3  , r = lane & 31, hh = lane >> 5;
  const bf16_t* projT = (const bf16_t*)(p.scratch + SC_HY_PROJT);
  bf16_t* yT = (bf16_t*)(p.scratch + SC_HY_YT);
  unsigned* Rc0 = (unsigned*)smem;
  unsigned* Rc1 = Rc0 + 4096 + 16;
  bf16_t* G = (bf16_t*)smem;
  bf16_t* U = (bf16_t*)(smem + HY_UOFF);
  for (int item = bid; item < 2048; item += nblk) {
    const bool lat = item < 1024;
    const int c = item & 1023;
    const int L = lat ? 4096 : 256, NB = lat ? 4 : 32, RL = lat ? 8192 : 512, Lm1 = L - 1;
    const int PAD = lat ? 224 : 0, US = lat ? 4552 : 264;
    const int tokbase = lat ? T_CTX : 0;
    const int nI = L >> 5, nelem = NB * L;
    const int TPW = lat ? 4 : 2;
    __syncthreads();
    if (lat) {
      for (int q = tid; q < 4 * 57; q += NTHR) {
        int b = q / 57, k = q % 57;
        int off = k < 28 ? k * 8 : 224 + 4096 + (k - 28) * 8;
        unsigned zz = 0u; asm volatile("" : "+v"(zz));
        u32x4 z4 = {zz, zz, zz, zz};
        *(u32x4*)(U + b * US + off) = z4;
      }
    }
    hy_stage_conv(p, projT + (size_t)c * T_ALL + tokbase, c, U, US, PAD, nelem, L, tid);
    int Icol[4], bcol[4];
#pragma unroll
    for (int tt = 0; tt < 4; ++tt) {
      int n = (w * TPW + tt) * 32 + r;
      Icol[tt] = lat ? (n >> 2) : (n >> 5);
      bcol[tt] = lat ? (n & 3) : (n & 31);
    }
    const int Ilo_w = lat ? 32 * w : 2 * w, Ihi_w = lat ? 32 * w + 31 : 2 * w + 1;
    const int dlo = Ilo_w - (nI - 1), dhi = Ihi_w;
    float invs[2], biases[2];
#pragma unroll
    for (int o2 = 0; o2 < 2; ++o2) { invs[o2] = p.knorm[((lat ? 1 : 0) * 2 + o2) * 1024 + c]; biases[o2] = p.hy_f_bias[o2 * 1024 + c]; }
    for (int order = 0; order < 2; ++order) {
      {
        const bf16_t* src = (lat ? p.rtab1 : p.rtab0) + (size_t)(order * 1024 + c) * RL;
        for (int q = tid; q < RL / 8; q += NTHR) {
          u32x4 cv = *(const u32x4*)(src + q * 8);
          unsigned nx = (q + 1 < RL / 8) ? *(const unsigned*)(src + q * 8 + 8) : 0u;
          *(u32x4*)(Rc0 + q * 4) = cv;
          u32x4 sv;
          sv.x = (cv.x >> 16) | (cv.y << 16); sv.y = (cv.y >> 16) | (cv.z << 16);
          sv.z = (cv.z >> 16) | (cv.w << 16); sv.w = (cv.w >> 16) | (nx << 16);
          *(u32x4*)(Rc1 + q * 4) = sv;
        }
      }
      __syncthreads();
      u32x2 zpre[4][4];
      if (order == 1) {
#pragma unroll
        for (int tt = 0; tt < 4; ++tt)
          if (tt < TPW) {
#pragma unroll
            for (int qd = 0; qd < 4; ++qd)
              zpre[tt][qd] = *(const u32x2*)(projT + (size_t)(3072 + c) * T_ALL + tokbase + bcol[tt] * L + 32 * Icol[tt] + 8 * qd + 4 * hh);
          }
      }
      f32x16 acc[4];
#pragma unroll
      for (int tt = 0; tt < 4; ++tt)
#pragma unroll
        for (int e = 0; e < 16; ++e) acc[tt][e] = 0.f;
      {
        int lo_t[4], hi_t[4];
        const bf16_t* ub[4];
#pragma unroll
        for (int tt = 0; tt < 4; ++tt) {
          const int tile = w * TPW + tt;
          const int Ilo_t = lat ? 8 * tile : tile, Ihi_t = lat ? 8 * tile + 7 : tile;
          lo_t[tt] = tt < TPW ? Ilo_t - (nI - 1) : 1 << 30; hi_t[tt] = tt < TPW ? Ihi_t : -(1 << 30);
          ub[tt] = U + bcol[tt] * US + PAD + 32 * Icol[tt] + 8 * hh;
        }
        const int ybase = Lm1 - r + 8 * hh;
#define LC_EDGE(D0, D1) do { for (int d_ = (D0); d_ <= (D1); ++d_) { \
          _Pragma("unroll") for (int kk_ = 0; kk_ < 2; ++kk_) { \
            const int y0_ = ybase - 32 * d_ + 16 * kk_; const int par_ = y0_ & 1; \
            const unsigned* rp_ = (par_ ? Rc1 : Rc0) + ((y0_ - par_) >> 1); \
            u32x4 av_; av_.x = rp_[0]; av_.y = rp_[1]; av_.z = rp_[2]; av_.w = rp_[3]; const bf16x8 af_ = __builtin_bit_cast(bf16x8, av_); \
            _Pragma("unroll") for (int tt = 0; tt < 4; ++tt) if (d_ >= lo_t[tt] && d_ <= hi_t[tt]) \
              acc[tt] = __builtin_amdgcn_mfma_f32_32x32x16_bf16(af_, *(const bf16x8*)(ub[tt] - 32 * d_ + 16 * kk_), acc[tt], 0, 0, 0); } } } while (0)
        if (!lat) {
          LC_EDGE(dlo, dhi);
        } else {
          const int mlo = lo_t[3], mhi = hi_t[0];
          LC_EDGE(dlo, mlo - 1);
#define LC_LOAD(IT, A, B) do { const int it_ = (IT); const int d_ = mlo + (it_ >> 1), kk_ = it_ & 1; \
          const int y0_ = ybase - 32 * d_ + 16 * kk_; const int par_ = y0_ & 1; \
          const unsigned* rp_ = (par_ ? Rc1 : Rc0) + ((y0_ - par_) >> 1); \
          u32x4 av_; av_.x = rp_[0]; av_.y = rp_[1]; av_.z = rp_[2]; av_.w = rp_[3]; A = __builtin_bit_cast(bf16x8, av_); \
          _Pragma("unroll") for (int tt = 0; tt < 4; ++tt) B[tt] = *(const bf16x8*)(ub[tt] - 32 * d_ + 16 * kk_); } while (0)
#define LC_MMA(A, B) do { _Pragma("unroll") for (int tt = 0; tt < 4; ++tt) acc[tt] = __builtin_amdgcn_mfma_f32_32x32x16_bf16(A, B[tt], acc[tt], 0, 0, 0); } while (0)
          const int NIT = 2 * (mhi - mlo + 1);
          bf16x8 a0, a1, b0[4], b1[4];
          LC_LOAD(0, a0, b0);
          for (int it = 0; it < NIT; it += 2) {
            LC_LOAD(it + 1, a1, b1);
            __builtin_amdgcn_sched_barrier(0);
            LC_MMA(a0, b0);
            __builtin_amdgcn_sched_barrier(0);
            LC_LOAD(it + 2 < NIT ? it + 2 : NIT - 1, a0, b0);
            __builtin_amdgcn_sched_barrier(0);
            LC_MMA(a1, b1);
            __builtin_amdgcn_sched_barrier(0);
          }
#undef LC_LOAD
#undef LC_MMA
          LC_EDGE(mhi + 1, dhi);
        }
#undef LC_EDGE
      }
      __syncthreads();
      hy_stage_conv(p, projT + (size_t)((1 + order) * 1024 + c) * T_ALL + tokbase, (1 + order) * 1024 + c, G, L, 0, nelem, L, tid);
      __syncthreads();
      const float inv = __builtin_amdgcn_rcpf(order ? invs[1] : invs[0]);
      const float bias = order ? biases[1] : biases[0];
#pragma unroll
      for (int tt = 0; tt < 4; ++tt) {
        if (tt < TPW) {
#pragma unroll
          for (int qd = 0; qd < 4; ++qd) {
            const int t0 = 32 * Icol[tt] + 8 * qd + 4 * hh;
            bf16_t* up = U + bcol[tt] * US + PAD + t0;
            u32x2 uc = *(const u32x2*)up;
            u32x2 gg = *(const u32x2*)(G + bcol[tt] * L + t0);
            float r0 = (inv * acc[tt][4 * qd] + bias * bflo(uc.x)) * bflo(gg.x);
            float r1 = (inv * acc[tt][4 * qd + 1] + bias * bfhi(uc.x)) * bfhi(gg.x);
            float r2 = (inv * acc[tt][4 * qd + 2] + bias * bflo(uc.y)) * bflo(gg.y);
            float r3 = (inv * acc[tt][4 * qd + 3] + bias * bfhi(uc.y)) * bfhi(gg.y);
            if (order == 1) {
              const u32x2 zz = zpre[tt][qd];
              r0 *= siluf(bflo(zz.x)); r1 *= siluf(bfhi(zz.x)); r2 *= siluf(bflo(zz.y)); r3 *= siluf(bfhi(zz.y));
            }
            u32x2 ov; ov.x = pack2(r0, r1); ov.y = pack2(r2, r3);
            *(u32x2*)up = ov;
          }
        }
      }
      __syncthreads();
    }
    for (int q = tid; q < nelem / 8; q += NTHR) {
      const int e0 = q * 8, b = e0 / L, t0 = e0 & (L - 1);
      *(u32x4*)(yT + (size_t)c * T_ALL + tokbase + e0) = *(const u32x4*)(U + b * US + PAD + t0);
    }
  }
}

__device__ __forceinline__ void phase_hy_transpose(const Params& p, int bid, int nblk, unsigned char* smem, int cxw) {
  const int tid = opaque_tid(cxw);
  const bf16_t* yT = (const bf16_t*)(p.scratch + SC_HY_YT);
  bf16_t* yg = (bf16_t*)(p.scratch + SC_HY_YG);
  bf16_t* tl = (bf16_t*)smem;
  for (int item = bid; item < 16 * (T_ALL / 64); item += nblk) {
    const int cb = item & 15, tb = item >> 4;
    __syncthreads();
#pragma unroll
    for (int i = 0; i < 2; ++i) {
      int q = tid + i * 256, cr = q >> 3, t8 = (q & 7) * 8;
      u32x4 v = *(const u32x4*)(yT + (size_t)(cb * 64 + cr) * T_ALL + tb * 64 + t8);
      unsigned wv[4] = {v.x, v.y, v.z, v.w};
#pragma unroll
      for (int e = 0; e < 4; ++e) {
        tl[(t8 + 2 * e) * 72 + cr] = (bf16_t)(wv[e] & 0xffffu);
        tl[(t8 + 2 * e + 1) * 72 + cr] = (bf16_t)(wv[e] >> 16);
      }
    }
    __syncthreads();
#pragma unroll
    for (int i = 0; i < 2; ++i) {
      int q = tid + i * 256, tr = q >> 3, c8 = (q & 7) * 8;
      *(u32x4*)(yg + (size_t)(tb * 64 + tr) * 1024 + cb * 64 + c8) = *(const u32x4*)(tl + tr * 72 + c8);
    }
  }
}

#define LRU_NCH 384
struct Lru4 { float af[4], bxf[4], ab[4], bxb[4]; };
__device__ __forceinline__ void lru_unpack4(u32x2 v, float (&o)[4]) { o[0] = bflo(v.x); o[1] = bfhi(v.x); o[2] = bflo(v.y); o[3] = bfhi(v.y); }
__device__ __forceinline__ void lru_row_f(const bf16_t* gates, const bf16_t* xc, size_t o, const float (&spf)[4], float (&af)[4], float (&bxf)[4]) {
  float r[4], g[4], x[4];
  lru_unpack4(*(const u32x2*)(gates + o), r); lru_unpack4(*(const u32x2*)(gates + (size_t)T_ALL * 1024 + o), g); lru_unpack4(*(const u32x2*)(xc + o), x);
#pragma unroll
  for (int e = 0; e < 4; ++e) { const float la = -8.f * r[e] * spf[e]; af[e] = __expf(la); bxf[e] = sqrtf(fmaxf(1.f - __expf(2.f * la), 0.f)) * g[e] * x[e]; }
}
__device__ __forceinline__ void lru_row_b(const bf16_t* gates, const bf16_t* xc, size_t o, const float (&spb)[4], float (&ab)[4], float (&bxb)[4]) {
  float r[4], g[4], x[4];
  lru_unpack4(*(const u32x2*)(gates + (size_t)2 * T_ALL * 1024 + o), r); lru_unpack4(*(const u32x2*)(gates + (size_t)3 * T_ALL * 1024 + o), g); lru_unpack4(*(const u32x2*)(xc + o), x);
#pragma unroll
  for (int e = 0; e < 4; ++e) { const float la = -8.f * r[e] * spb[e]; ab[e] = __expf(la); bxb[e] = sqrtf(fmaxf(1.f - __expf(2.f * la), 0.f)) * g[e] * x[e]; }
}
__device__ __forceinline__ void phase_lru_scan_agg(const Params& p, int bid, int nblk, unsigned char* smem, int cxw) {
  const int tidx = opaque_tid(cxw);
  const bf16_t* gates = (const bf16_t*)(p.scratch + SC_LRU_GATES);
  const bf16_t* xc = (const bf16_t*)(p.scratch + SC_LRU_XC);
  float* sagg = (float*)smem;
  const int sub = cxw & 3, cq = tidx & 63;
  for (int item = bid; item < LRU_NCH * 4; item += nblk) {
    const int chunk = item >> 2, cb = item & 3;
    const int c0 = cb * 256 + 4 * cq;
    float spf[4], spb[4];
#pragma unroll
    for (int e = 0; e < 4; ++e) { spf[e] = softplusf(-p.lru_a_param[c0 + e]); spb[e] = softplusf(-p.lru_a_param[1024 + c0 + e]); }
    const int tok0 = chunk * 64 + 16 * sub;
    float Af[4] = {1.f, 1.f, 1.f, 1.f}, hf[4] = {0.f, 0.f, 0.f, 0.f}, Pb[4] = {1.f, 1.f, 1.f, 1.f}, Bb[4] = {0.f, 0.f, 0.f, 0.f};
#pragma unroll 4
    for (int j = 0; j < 16; ++j) {
      const size_t o = (size_t)(tok0 + j) * 1024 + c0;
      float af[4], bxf[4], ab[4], bxb[4];
      lru_row_f(gates, xc, o, spf, af, bxf);
      lru_row_b(gates, xc, o, spb, ab, bxb);
#pragma unroll
      for (int e = 0; e < 4; ++e) { hf[e] = af[e] * hf[e] + bxf[e]; Af[e] *= af[e]; Bb[e] += bxb[e] * Pb[e]; Pb[e] *= ab[e]; }
    }
    {
      const size_t sc = (size_t)chunk * 4 + sub;
      float* gf = p.lru_sagg + (((size_t)0 * (LRU_NCH * 4) + sc) * 1024 + c0) * 2;
      float* gb = p.lru_sagg + (((size_t)1 * (LRU_NCH * 4) + sc) * 1024 + c0) * 2;
      f32x4 v0 = {Af[0], hf[0], Af[1], hf[1]}, v1 = {Af[2], hf[2], Af[3], hf[3]};
      f32x4 w0 = {Pb[0], Bb[0], Pb[1], Bb[1]}, w1 = {Pb[2], Bb[2], Pb[3], Bb[3]};
      *(f32x4*)gf = v0; *(f32x4*)(gf + 4) = v1; *(f32x4*)gb = w0; *(f32x4*)(gb + 4) = w1;
      __syncthreads();
      float* sl = sagg + (sub * 64 + cq) * 16;
      *(f32x4*)sl = v0; *(f32x4*)(sl + 4) = v1; *(f32x4*)(sl + 8) = w0; *(f32x4*)(sl + 12) = w1;
      __syncthreads();
    }
    if (sub == 0) {
      float A[4], B[4], P[4], Q[4];
#pragma unroll
      for (int e = 0; e < 4; ++e) { A[e] = 1.f; B[e] = 0.f; P[e] = 1.f; Q[e] = 0.f; }
#pragma unroll
      for (int s2 = 0; s2 < 4; ++s2) {
        const float* lf = sagg + (s2 * 64 + cq) * 16;
        const float* lb = sagg + ((3 - s2) * 64 + cq) * 16 + 8;
#pragma unroll
        for (int e = 0; e < 4; ++e) {
          const float a = lf[2 * e], b = lf[2 * e + 1];
          B[e] = a * B[e] + b; A[e] *= a;
          const float pb = lb[2 * e], qb = lb[2 * e + 1];
          Q[e] = pb * Q[e] + qb; P[e] *= pb;
        }
      }
      float* gf = p.lru_agg + (((size_t)0 * LRU_NCH + chunk) * 1024 + c0) * 2;
      float* gb = p.lru_agg + (((size_t)1 * LRU_NCH + chunk) * 1024 + c0) * 2;
      f32x4 v0 = {A[0], B[0], A[1], B[1]}, v1 = {A[2], B[2], A[3], B[3]}, w0 = {P[0], Q[0], P[1], Q[1]}, w1 = {P[2], Q[2], P[3], Q[3]};
      *(f32x4*)gf = v0; *(f32x4*)(gf + 4) = v1; *(f32x4*)gb = w0; *(f32x4*)(gb + 4) = w1;
    }
  }
}
__device__ __forceinline__ void phase_lru_scan_carry(const Params& p, int bid, int nblk, int cxw) {
  const int tidx = opaque_tid(cxw);
  for (int item = bid; item < 36 * 8; item += nblk) {
    int s = item >> 3, dir = (item >> 2) & 1, cb = item & 3;
    int c = cb * 256 + tidx;
    int nch = s < 32 ? 4 : 64;
    int ch0 = s < 32 ? s * 4 : 128 + (s - 32) * 64;
    float h = s < 32 ? 0.f : p.state_lru[((size_t)(s - 32) * 2 + dir) * 1024 + c];
    for (int k0 = 0; k0 < nch; k0 += 4) {
      f32x2_t ag[4]; size_t idx[4];
#pragma unroll
      for (int u = 0; u < 4; ++u) {
        const int chunk = dir ? ch0 + nch - 1 - (k0 + u) : ch0 + k0 + u;
        idx[u] = ((size_t)dir * LRU_NCH + chunk) * 1024 + c;
        ag[u] = *(const f32x2_t*)(p.lru_agg + idx[u] * 2);
      }
#pragma unroll
      for (int u = 0; u < 4; ++u) { p.lru_hin[idx[u]] = h; h = ag[u].x * h + ag[u].y; }
    }
    if (s < 32) p.out_lru[((size_t)s * 2 + dir) * 1024 + c] = h;
  }
}
__device__ __forceinline__ void phase_lru_scan_final(const Params& p, int bid, int nblk, unsigned char* smem, int cxw) {
  const int tidx = opaque_tid(cxw);
  const bf16_t* gates = (const bf16_t*)(p.scratch + SC_LRU_GATES);
  const bf16_t* xc = (const bf16_t*)(p.scratch + SC_LRU_XC);
  const bf16_t* proj = (const bf16_t*)(p.scratch + SC_LRU_PROJ);
  bf16_t* yg = (bf16_t*)(p.scratch + SC_LRU_YG);
  const int sub = cxw & 3, cq = tidx & 63;
  for (int item = bid; item < LRU_NCH * 4; item += nblk) {
    const int chunk = item >> 2, cb = item & 3;
    const int c0 = cb * 256 + 4 * cq;
    float spf[4], spb[4];
#pragma unroll
    for (int e = 0; e < 4; ++e) { spf[e] = softplusf(-p.lru_a_param[c0 + e]); spb[e] = softplusf(-p.lru_a_param[1024 + c0 + e]); }
    float hf[4], hb[4];
    {
      const f32x4 a = *(const f32x4*)(p.lru_hin + ((size_t)0 * LRU_NCH + chunk) * 1024 + c0);
      const f32x4 b = *(const f32x4*)(p.lru_hin + ((size_t)1 * LRU_NCH + chunk) * 1024 + c0);
      hf[0] = a.x; hf[1] = a.y; hf[2] = a.z; hf[3] = a.w; hb[0] = b.x; hb[1] = b.y; hb[2] = b.z; hb[3] = b.w;
    }
#pragma unroll
    for (int s2 = 0; s2 < 3; ++s2) {
      if (s2 < sub) {
        const float* g = p.lru_sagg + (((size_t)0 * (LRU_NCH * 4) + (size_t)chunk * 4 + s2) * 1024 + c0) * 2;
        const f32x4 v0 = *(const f32x4*)g, v1 = *(const f32x4*)(g + 4);
        hf[0] = v0.x * hf[0] + v0.y; hf[1] = v0.z * hf[1] + v0.w; hf[2] = v1.x * hf[2] + v1.y; hf[3] = v1.z * hf[3] + v1.w;
      }
      if (3 - s2 > sub) {
        const float* g = p.lru_sagg + (((size_t)1 * (LRU_NCH * 4) + (size_t)chunk * 4 + (3 - s2)) * 1024 + c0) * 2;
        const f32x4 v0 = *(const f32x4*)g, v1 = *(const f32x4*)(g + 4);
        hb[0] = v0.x * hb[0] + v0.y; hb[1] = v0.z * hb[1] + v0.w; hb[2] = v1.x * hb[2] + v1.y; hb[3] = v1.z * hb[3] + v1.w;
      }
    }
    const int tok0 = chunk * 64 + 16 * sub;
    float hfs[16][4];
#pragma unroll
    for (int j = 0; j < 16; ++j) {
      const size_t o = (size_t)(tok0 + j) * 1024 + c0;
      float af[4], bxf[4];
      lru_row_f(gates, xc, o, spf, af, bxf);
#pragma unroll
      for (int e = 0; e < 4; ++e) { hf[e] = af[e] * hf[e] + bxf[e]; hfs[j][e] = hf[e]; }
    }
#pragma unroll
    for (int j = 15; j >= 0; --j) {
      const size_t o = (size_t)(tok0 + j) * 1024 + c0;
      float ab[4], bxb[4], z[4];
      lru_row_b(gates, xc, o, spb, ab, bxb);
      lru_unpack4(*(const u32x2*)(proj + (size_t)(tok0 + j) * 2048 + 1024 + c0), z);
      float y[4];
#pragma unroll
      for (int e = 0; e < 4; ++e) { hb[e] = ab[e] * hb[e] + bxb[e]; y[e] = (hfs[j][e] + hb[e]) * siluf(z[e]); }
      u32x2 ov; ov.x = pack2(y[0], y[1]); ov.y = pack2(y[2], y[3]);
      *(u32x2*)(yg + o) = ov;
    }
  }
}

enum { PH_PREP = 0, PH_MOD, PH_HYA, PH_HYB, PH_LNMOD, PH_INPROJ, PH_MIX1, PH_MIX2, PH_MIX3, PH_MIX4, PH_MIX5, PH_MIX6, PH_OUTPROJ };

struct Ctx { int bid, nblk, wave; unsigned char* smem; unsigned char* wg_smem; };

template <class Epi>
__device__ __forceinline__ void run_gemm(const Ctx& cx, const bf16_t* A, int lda, const bf16_t* Bt, int M, int N, int K, int grp_shift, int grp_bytes, const Epi& e) {
  pg8::Gemm g{A, Bt, M, N, K, lda, grp_shift, grp_bytes};
  pg8::StaticOrder S; S.init(M, N, gridDim.x, opaque_s(blockIdx.x));
  pg8::gemm_phase((PG8_LAS unsigned char*)cx.wg_smem, g, S, e, cx.wave);
}

#define N_PARAM_WORDS (sizeof(Params) / 8)
__device__ __forceinline__ Params load_params(const unsigned char* lp) {
  Params p;
  unsigned long long* d = (unsigned long long*)&p;
  const unsigned long long* sp = (const unsigned long long*)lp;
#pragma unroll
  for (int i = 0; i < (int)N_PARAM_WORDS; ++i) {
    const unsigned long long v = sp[i];
    const unsigned lo = __builtin_amdgcn_readfirstlane((unsigned)v), hi = __builtin_amdgcn_readfirstlane((unsigned)(v >> 32));
    __attribute__((address_space(1))) char* gp = (__attribute__((address_space(1))) char*)(((unsigned long long)hi << 32) | lo);
    d[i] = (unsigned long long)(char*)gp;
  }
  return p;
}
__device__ __forceinline__ void run_phase(const unsigned char* lparams, int ph, int layer, const Ctx& cx) {
  const Params p = load_params(lparams);
  const int kind = layer % 3, slot = layer / 3;
  const int bid = opaque_s(cx.bid), nblk = cx.nblk;
  unsigned char* smem = cx.smem;
  switch (ph) {
    case PH_PREP: phase_prep(p, bid, nblk, smem, cx.wave); break;
    case PH_MOD: phase_mod(p, bid, nblk, smem, cx.wave); break;
    case PH_HYA: phase_hyfilt_a(p, bid, nblk, smem, cx.wave); break;
    case PH_HYB: phase_hyfilt_b(p, bid, nblk, smem, cx.wave); break;
    case PH_LNMOD: phase_lnmod(p, layer, bid, nblk, cx.wave); break;
    case PH_INPROJ:
      if (kind == 0) {
        pg8::EpiSsdIn e{(bf16_t*)(p.scratch + SC_SSD_Z), (bf16_t*)(p.scratch + SC_SSD_XBC), (float*)(p.scratch + SC_SSD_DT), p.ssd_dt_bias + slot * 64};
        run_gemm(cx, p.hbuf, 1024, p.wt_ssd_in + (size_t)slot * 6400 * 1024, T_ALL, 6400, 1024, 30, 0, e);
      } else if (kind == 1) {
        pg8::EpiBf16 e{(bf16_t*)(p.scratch + SC_HY_PROJT), (size_t)T_ALL};
        run_gemm(cx, p.wt_hy_in, 1024, p.hbuf, 4096, T_ALL, 1024, 30, 0, e);
      } else {
        pg8::EpiBf16 e{(bf16_t*)(p.scratch + SC_LRU_PROJ), (size_t)2048};
        run_gemm(cx, p.hbuf, 1024, p.wt_lru_in, T_ALL, 2048, 1024, 30, 0, e);
      }
      break;
    case PH_MIX1:
      if (kind == 0) phase_ssd_conv(p, slot, slot == 1, bid, nblk, smem, cx.wave);
      else if (kind == 1) phase_hy_longconv(p, bid, nblk, smem, cx.wave);
      else phase_dwconv<4, false>((const bf16_t*)(p.scratch + SC_LRU_PROJ), 2048, (bf16_t*)(p.scratch + SC_LRU_XC), 1024, 1024,
                                  p.lru_conv_w, p.lru_conv_b, false, bid, nblk, cx.wave);
      break;
    case PH_MIX2:
      if (kind == 0) phase_ssd_scan(p, slot, slot == 1, bid, nblk, cx.wg_smem, cx.wave);
      else if (kind == 1) phase_hy_transpose(p, bid, nblk, smem, cx.wave);
      else {
        pg8::EpiLruGate e{(bf16_t*)(p.scratch + SC_LRU_GATES), p.lru_gate_b};
        run_gemm(cx, (const bf16_t*)(p.scratch + SC_LRU_XC), 1024, p.wt_lru_gate, T_ALL, 4096, 256, 2, 512, e);
      }
      break;
    case PH_MIX3:
      if (kind == 0) phase_ssd_gate(p, slot, bid, nblk, cx.wave);
      else phase_lru_scan_agg(p, bid, nblk, smem, cx.wave);
      break;
    case PH_MIX4: if (kind == 2) phase_lru_scan_carry(p, bid, nblk, cx.wave); break;
    case PH_MIX5: if (kind == 2) phase_lru_scan_final(p, bid, nblk, smem, cx.wave); break;
    case PH_OUTPROJ: {
      const float* mv = p.modv + (size_t)layer * 5 * 3072;
      if (kind == 0) {
        pg8::EpiOut e{p.resb, mv, p.rstd};
        run_gemm(cx, (const bf16_t*)(p.scratch + SC_SSD_Z), 2048, p.wt_ssd_out + (size_t)slot * 1024 * 2048, T_ALL, 1024, 2048, 30, 0, e);
      } else if (kind == 1) {
        pg8::EpiOut e{p.resb, mv, nullptr};
        run_gemm(cx, (const bf16_t*)(p.scratch + SC_HY_YG), 1024, p.wt_hy_out, T_ALL, 1024, 1024, 30, 0, e);
      } else {
        pg8::EpiOut e{p.resb, mv, nullptr};
        run_gemm(cx, (const bf16_t*)(p.scratch + SC_LRU_YG), 1024, p.wt_lru_out, T_ALL, 1024, 1024, 30, 0, e);
      }
    } break;
  }
}

__global__ void __launch_bounds__(WG_THREADS, 2) k_mega(Params p) {
  __shared__ __attribute__((aligned(16))) unsigned char smem[WG_SMEM + 16 + 512];
  cg::grid_group grid = cg::this_grid();
  const int wave0 = __builtin_amdgcn_readfirstlane((int)(threadIdx.x >> 6));
  const int vb = wave0 >> 2;
  Ctx cx;
  cx.wave = wave0;
  cx.bid = 2 * blockIdx.x + vb; cx.nblk = 2 * gridDim.x; cx.smem = smem + vb * SMEM_BYTES; cx.wg_smem = smem;
  volatile LAS unsigned* xst = (volatile LAS unsigned*)(smem + WG_SMEM);
  unsigned char* lparams = smem + WG_SMEM + 16;
  if (threadIdx.x == 0) { xst[0] = 0u; xst[1] = 0u; *(Params*)lparams = p; }
  __syncthreads();
  const XcdBarrier xb = xcd_barrier_post(p.bar, xst);
  run_phase(lparams, PH_PREP, 0, cx);
  run_phase(lparams, PH_MOD, 0, cx);
  run_phase(lparams, PH_HYA, 0, cx);
  if (p.bar == nullptr) grid.sync();
  xcd_barrier(xb, cx.wave);
  run_phase(lparams, PH_HYB, 0, cx);
  for (int layer = 0; layer < 4; ++layer) {
    const int kind = layer % 3;
    run_phase(lparams, PH_LNMOD, layer, cx);
    xcd_barrier(xb, cx.wave);
    run_phase(lparams, PH_INPROJ, layer, cx);
    xcd_barrier(xb, cx.wave);
    run_phase(lparams, PH_MIX1, layer, cx);
    xcd_barrier(xb, cx.wave);
    run_phase(lparams, PH_MIX2, layer, cx);
    xcd_barrier(xb, cx.wave);
    if (kind != 1) {
      run_phase(lparams, PH_MIX3, layer, cx);
      xcd_barrier(xb, cx.wave);
    }
    if (kind == 2) {
      run_phase(lparams, PH_MIX4, layer, cx);
      xcd_barrier(xb, cx.wave);
      run_phase(lparams, PH_MIX5, layer, cx);
      xcd_barrier(xb, cx.wave);
    }
    run_phase(lparams, PH_OUTPROJ, layer, cx);
    xcd_barrier(xb, cx.wave);
  }
  run_phase(lparams, PH_LNMOD, 4, cx);
}

static inline size_t align_up(size_t x) { return (x + 255) & ~(size_t)255; }

extern "C" void kernel_launch(void* const* d_in, const int* in_sizes, int n_in, void* d_out, int out_size, void* d_ws, size_t ws_size,
                              hipStream_t stream) {
  Params p{};
  const float** fp = (const float**)&p;
  for (int i = 0; i < 36; ++i) fp[i] = (const float*)d_in[i];
  float* out = (float*)d_out;
  p.xres = out;
  p.out_ssd = out + (size_t)T_ALL * 1024;
  p.out_lru = p.out_ssd + (size_t)32 * 2 * 2 * 32 * 64 * 128;
  unsigned char* w = (unsigned char*)d_ws;
  size_t off = 0;
  auto carve = [&](size_t bytes) { unsigned char* r = w + off; off = align_up(off + bytes); return r; };
  p.wt_ssd_in = (bf16_t*)carve((size_t)2 * 6400 * 1024 * 2);
  p.wt_ssd_out = (bf16_t*)carve((size_t)2 * 1024 * 2048 * 2);
  p.wt_hy_in = (bf16_t*)carve((size_t)4096 * 1024 * 2);
  p.wt_hy_out = (bf16_t*)carve((size_t)1024 * 1024 * 2);
  p.wt_lru_in = (bf16_t*)carve((size_t)2048 * 1024 * 2);
  p.wt_lru_out = (bf16_t*)carve((size_t)1024 * 1024 * 2);
  p.wt_lru_gate = (bf16_t*)carve((size_t)4 * 1024 * 256 * 2);
  p.modv = (float*)carve((size_t)4 * 5 * 3072 * 4);
  p.hdn2 = (float*)carve((size_t)4352 * 64 * 4);
  p.rtab0 = (bf16_t*)carve((size_t)2 * 1024 * 512 * 2);
  p.rtab1 = (bf16_t*)carve((size_t)2 * 1024 * 8192 * 2);
  p.knorm = (float*)carve((size_t)4 * 1024 * 4);
  p.hbuf = (bf16_t*)carve((size_t)T_ALL * 1024 * 2);
  p.rstd = (float*)carve((size_t)T_ALL * 4);
  p.resb = (bf16_t*)carve((size_t)T_ALL * 1024 * 2);
  p.lru_agg = (float*)carve((size_t)2 * 384 * 1024 * 2 * 4);
  p.lru_hin = (float*)carve((size_t)2 * 384 * 1024 * 4);
  p.lru_sagg = (float*)carve((size_t)2 * 1536 * 1024 * 2 * 4);
  p.bar = (unsigned*)carve((size_t)XCD_BAR_WORDS * 4);
  p.scratch = carve(SC_TOTAL);
  if (off > ws_size) return;

  static int grid_blocks = 0;
  if (!grid_blocks) {
    int dev = 0, cus = 0, per_cu = 0;
    hipGetDevice(&dev);
    hipDeviceGetAttribute(&cus, hipDeviceAttributeMultiprocessorCount, dev);
    hipOccupancyMaxActiveBlocksPerMultiprocessor(&per_cu, k_mega, WG_THREADS, 0);
    if (per_cu > 1) per_cu = 1;
    grid_blocks = cus * per_cu;
  }
  hipMemsetAsync(p.bar, 0, (size_t)XCD_BAR_WORDS * 4, stream);
  void* args[] = {&p};
  hipError_t e = hipLaunchCooperativeKernel((void*)k_mega, dim3(grid_blocks), dim3(WG_THREADS), args, 0, stream);
  if (e != hipSuccess) fprintf(stderr, "cooperative launch failed: %s (grid %d)\n", hipGetErrorString(e), grid_blocks);
}
```

```cpp
#include <hip/hip_runtime.h>
#include <hip/hip_bf16.h>
#include <hip/hip_cooperative_groups.h>
#include <stdint.h>
#include <cstdio>
namespace cg = cooperative_groups;

typedef unsigned short bf16_t;
typedef __attribute__((ext_vector_type(8))) short bf16x8;
typedef __attribute__((ext_vector_type(16))) float f32x16;
typedef __attribute__((ext_vector_type(4))) unsigned int u32x4;
typedef __attribute__((ext_vector_type(2))) unsigned int u32x2;
typedef __attribute__((ext_vector_type(4))) float f32x4;
typedef float f32x4_t __attribute__((ext_vector_type(4)));
typedef float f32x2_t __attribute__((ext_vector_type(2)));

#define T_CTX 8192
#define T_ALL 24576
#define DM 1024
#define NTHR 256
#define SMEM_BYTES 69632
#define WG_THREADS 512
#define WG_SMEM 162304
#define ALPHA_RES 1.6817928305074290f
#define LN_EPS 1e-5f

__device__ __forceinline__ bf16_t f2bf(float f) { __bf16 h = (__bf16)f; return __builtin_bit_cast(bf16_t, h); }
__device__ __forceinline__ float bf2f(bf16_t b) { return __uint_as_float(((unsigned)b) << 16); }
__device__ __forceinline__ float bflo(unsigned w) { return __uint_as_float(w << 16); }
__device__ __forceinline__ float bfhi(unsigned w) { return __uint_as_float(w & 0xffff0000u); }
typedef __bf16 bf16v2_t __attribute__((ext_vector_type(2)));
typedef float f32v2_t __attribute__((ext_vector_type(2)));
__device__ __forceinline__ unsigned pack2(float a, float b) { f32v2_t v = {a, b}; bf16v2_t h = __builtin_convertvector(v, bf16v2_t); return __builtin_bit_cast(unsigned, h); }
__device__ __forceinline__ float siluf(float x) { return x * __builtin_amdgcn_rcpf(1.f + __expf(-x)); }
__device__ __forceinline__ float sigmoidf(float x) { return __builtin_amdgcn_rcpf(1.f + __expf(-x)); }
__device__ __forceinline__ float softplusf(float x) { return x > 20.f ? x : __logf(1.f + __expf(x)); }


__device__ __forceinline__ int opaque_lane() { int z = 0; asm volatile("" : "+v"(z)); return __builtin_amdgcn_mbcnt_hi(~0u, __builtin_amdgcn_mbcnt_lo(~0u, (unsigned)z)); }
__device__ __forceinline__ int opaque_tid512(int wave) { return (wave << 6) + opaque_lane(); }
__device__ __forceinline__ int opaque_tid(int wave) { return opaque_tid512(wave) & 255; }

#define XB_TMO      128
#define XB_XCNT(j)  (256  + 64 * (j))
#define XB_XSUB(j)  (1280 + 64 * (j))
#define XB_XGEN(j)  (2304 + 64 * (j))
#define XB_TOP      3328
#define XB_TOPGEN   3392
#define XCD_BAR_WORDS 3456
#define XB_SPIN_CAP (1u << 23)
#define LAS __attribute__((address_space(3)))
__device__ __forceinline__ unsigned xb_ld(unsigned* p)              { return __hip_atomic_load(p, __ATOMIC_RELAXED, __HIP_MEMORY_SCOPE_AGENT); }
__device__ __forceinline__ unsigned xb_add(unsigned* p, unsigned v) { return __hip_atomic_fetch_add(p, v, __ATOMIC_RELAXED, __HIP_MEMORY_SCOPE_AGENT); }
__device__ __forceinline__ unsigned xb_xcc_id() { return (unsigned)__builtin_amdgcn_s_getreg((3 << 11) | 20) & 0xFu; }
#define XB_SPIN(cond, bar) do { unsigned _sp = 0; while (cond) { __builtin_amdgcn_s_sleep(1); \
    if ((++_sp & 255u) == 0u) { if (xb_ld(&(bar)[XB_TMO])) break; if (_sp > XB_SPIN_CAP) { atomicAdd(&(bar)[XB_TMO], 1u); break; } } } } while (0)
struct XcdBarrier { unsigned* bar; unsigned x; volatile LAS unsigned* st; };
__device__ __forceinline__ XcdBarrier xcd_barrier_post(unsigned* bar, volatile LAS unsigned* st) {
  XcdBarrier b; b.bar = bar; b.x = xb_xcc_id(); b.st = st;
  if (threadIdx.x == 0) (void)xb_add(&bar[XB_XCNT(b.x)], 1u);
  return b;
}
__device__ __forceinline__ void xcd_barrier_complete(unsigned* bar, unsigned x, unsigned& nloc, unsigned& nx) {
  const unsigned G = gridDim.x * gridDim.y * gridDim.z;
  unsigned sum, cnt, mine, sp = 0u;
  for (;;) {
    sum = 0u; cnt = 0u; mine = 0u;
#pragma unroll
    for (unsigned j = 0; j < 16; ++j) { const unsigned c = xb_ld(&bar[XB_XCNT(j)]); sum += c; cnt += (c > 0u) ? 1u : 0u; mine = (j == x) ? c : mine; }
    if (sum == G) break;
    __builtin_amdgcn_s_sleep(1);
    if ((++sp & 255u) == 0u) { if (xb_ld(&bar[XB_TMO])) break; if (sp > XB_SPIN_CAP) { atomicAdd(&bar[XB_TMO], 1u); break; } }
  }
  nloc = mine > 0u ? mine : 1u; nx = cnt > 0u ? cnt : 1u;
}
__device__ __forceinline__ void xcd_barrier(const XcdBarrier& b, int wave) {
  asm volatile("s_waitcnt vmcnt(0)" ::: "memory");
  __syncthreads();
  if (opaque_tid512(wave) == 0) {
    unsigned* bar = b.bar;
    __builtin_amdgcn_s_waitcnt(0);
    unsigned nloc = b.st[0], nx = b.st[1];
    if (nloc == 0u) { xcd_barrier_complete(bar, b.x, nloc, nx); b.st[0] = nloc; b.st[1] = nx; }
    const unsigned old = xb_add(&bar[XB_XSUB(b.x)], 1u);
    const unsigned gen = old / nloc;
    if (old + 1u == (gen + 1u) * nloc) {
      __builtin_amdgcn_fence(__ATOMIC_RELEASE, "agent");
      asm volatile("s_waitcnt vmcnt(0)" ::: "memory");
      const unsigned og = xb_add(&bar[XB_TOP], 1u);
      const unsigned tg = og / nx;
      if (og + 1u == (tg + 1u) * nx) xb_add(&bar[XB_TOPGEN], 1u);
      else XB_SPIN(xb_ld(&bar[XB_TOPGEN]) == tg, bar);
      __builtin_amdgcn_fence(__ATOMIC_ACQUIRE, "agent");
      xb_add(&bar[XB_XGEN(b.x)], 1u);
      asm volatile("s_waitcnt vmcnt(0)" ::: "memory");
    } else {
      XB_SPIN(xb_ld(&bar[XB_XGEN(b.x)]) == gen, bar);
      __builtin_amdgcn_fence(__ATOMIC_ACQUIRE, "agent");
      asm volatile("s_waitcnt vmcnt(0)" ::: "memory");
    }
  }
  __syncthreads();
}


__device__ __forceinline__ int opaque_s(int x) { asm volatile("" : "+s"(x)); return x; }

__device__ __forceinline__ float shfl_idx_f(float v, int src) { return __int_as_float(__builtin_amdgcn_ds_bpermute(src << 2, __float_as_int(v))); }
__device__ __forceinline__ float shfl_xor_f(float v, int off, int lane) { return shfl_idx_f(v, lane ^ off); }

__device__ __forceinline__ float wave_incl_scan(float v) {
#define DPP_ADD(ctrl, rmask) v += __int_as_float(__builtin_amdgcn_update_dpp(0, __float_as_int(v), ctrl, rmask, 0xf, false))
  DPP_ADD(0x111, 0xf); DPP_ADD(0x112, 0xf); DPP_ADD(0x114, 0xf); DPP_ADD(0x118, 0xf);
  DPP_ADD(0x142, 0xa); DPP_ADD(0x143, 0xc);
#undef DPP_ADD
  return v;
}

__device__ __forceinline__ float wave_sum(float v) { return __int_as_float(__builtin_amdgcn_readlane(__float_as_int(wave_incl_scan(v)), 63)); }

struct TokInfo { int s, l, L, base, mrow; };
__device__ __forceinline__ TokInfo tokinfo(int tok) {
  TokInfo t;
  if (tok < T_CTX) { t.s = tok >> 8; t.l = tok & 255; t.L = 256; t.base = tok & ~255; t.mrow = 0; }
  else { int u = tok - T_CTX; t.s = 32 + (u >> 12); t.l = u & 4095; t.L = 4096; t.base = T_CTX + (u & ~4095); t.mrow = 1 + (u >> 12); }
  return t;
}
__device__ __forceinline__ int seqpos2off(int pos, bool cm) { return cm ? (((pos & 63) << 6) | (pos >> 6)) : pos; }

struct Params {
  const float *x_prompt, *x_sample, *state_ssd, *state_lru, *c, *c_ctx, *mod_w, *mod_b, *ln_g, *ln_b;
  const float *ssd_in_w, *ssd_conv_w, *ssd_conv_b, *ssd_dt_bias, *ssd_a_log, *ssd_d, *ssd_norm_g, *ssd_out_w;
  const float *hy_in_w, *hy_conv_w, *hy_conv_b, *hy_f_w1, *hy_f_b1, *hy_f_w2, *hy_f_b2, *hy_f_w3, *hy_f_freq, *hy_f_bias, *hy_out_w;
  const float *lru_in_w, *lru_conv_w, *lru_conv_b, *lru_gate_w, *lru_gate_b, *lru_a_param, *lru_out_w;
  float *xres, *out_ssd, *out_lru;
  bf16_t *wt_ssd_in, *wt_ssd_out, *wt_hy_in, *wt_hy_out, *wt_lru_in, *wt_lru_out, *wt_lru_gate;
  float *modv;
  float *hdn2;
  bf16_t *rtab0;
  bf16_t *rtab1;
  float *knorm;
  bf16_t *hbuf;
  float *rstd;
  bf16_t *resb;
  float *lru_agg;
  float *lru_hin;
  float *lru_sagg;
  unsigned char *scratch;
  unsigned *bar;
};

#define SC_SSD_Z     ((size_t)0)
#define SC_SSD_XBC   ((size_t)T_ALL * 2048 * 2)
#define SC_SSD_XBCC  (SC_SSD_XBC + (size_t)T_ALL * 4096 * 2)
#define SC_SSD_DT    (SC_SSD_XBCC + (size_t)T_ALL * 2048 * 2)
#define SC_SSD_XT    (SC_SSD_DT + (size_t)T_ALL * 64 * 4)
#define SC_SSD_BT    (SC_SSD_XT + (size_t)T_ALL * 2048 * 2)
#define SC_SSD_BF    (SC_SSD_BT + (size_t)T_ALL * 1024 * 2)
#define SC_SSD_CF    (SC_SSD_BF + (size_t)T_ALL * 1024 * 2)
#define SC_SSD_END   (SC_SSD_CF + (size_t)T_ALL * 1024 * 2)
#define SC_HY_PROJT  ((size_t)0)
#define SC_HY_YT     ((size_t)T_ALL * 4096 * 2)
#define SC_HY_YG     (SC_HY_YT + (size_t)T_ALL * 1024 * 2)
#define SC_LRU_PROJ  ((size_t)0)
#define SC_LRU_XC    ((size_t)T_ALL * 2048 * 2)
#define SC_LRU_GATES (SC_LRU_XC + (size_t)T_ALL * 1024 * 2)
#define SC_LRU_Y     (SC_LRU_GATES + (size_t)T_ALL * 4096 * 2)
#define SC_LRU_YG    (SC_LRU_Y + (size_t)T_ALL * 2048 * 2)
#define SC_TOTAL     SC_SSD_END

__device__ __forceinline__ void transpose_tile(const float* __restrict__ src, int ld_src, int n_src, bf16_t* __restrict__ dst, int K,
                               const float* __restrict__ scale, int tile, int tiles_k, float* tl, int cxw) {
  const int tidx = opaque_tid(cxw);
  int tk = tile % tiles_k, tn = tile / tiles_k;
  int k0 = tk * 64, n0 = tn * 64;
  __syncthreads();
  {
    const int c4 = (tidx & 15) * 4, r0 = tidx >> 4;
#pragma unroll
    for (int ps = 0; ps < 4; ++ps) {
      const int r = r0 + ps * 16;
      f32x4 v = {0.f, 0.f, 0.f, 0.f};
      if (n0 + c4 < n_src) v = *(const f32x4*)(src + (size_t)(k0 + r) * ld_src + n0 + c4);
      if (scale) { const float sc = scale[k0 + r]; v.x *= sc; v.y *= sc; v.z *= sc; v.w *= sc; }
      tl[r * 65 + c4] = v.x; tl[r * 65 + c4 + 1] = v.y; tl[r * 65 + c4 + 2] = v.z; tl[r * 65 + c4 + 3] = v.w;
    }
  }
  __syncthreads();
  {
    const int n = tidx >> 2, kq = (tidx & 3) * 16;
    unsigned w[8];
#pragma unroll
    for (int e = 0; e < 8; ++e) w[e] = pack2(tl[(kq + 2 * e) * 65 + n], tl[(kq + 2 * e + 1) * 65 + n]);
    u32x4 o0, o1; o0.x = w[0]; o0.y = w[1]; o0.z = w[2]; o0.w = w[3]; o1.x = w[4]; o1.y = w[5]; o1.z = w[6]; o1.w = w[7];
    bf16_t* dp = dst + (size_t)(n0 + n) * K + k0 + kq;
    *(u32x4*)dp = o0; *(u32x4*)(dp + 8) = o1;
  }
}

__device__ __forceinline__ void phase_prep(const Params& p, int bid, int nblk, unsigned char* smem, int cxw) {
  const int tidx = opaque_tid(cxw);
  float* tl = (float*)smem;
  for (int job = 0; job < 24; ++job) {
    const float* src; int ld, nsrc, K, npad; bf16_t* dst; const float* scale = nullptr;
    if (job < 2) { src = p.ssd_in_w + (size_t)job * 1024 * 6208; ld = 6208; nsrc = 6208; K = 1024; npad = 6400; dst = p.wt_ssd_in + (size_t)job * 6400 * 1024; }
    else if (job < 4) { int s = job - 2; src = p.ssd_out_w + (size_t)s * 2048 * 1024; ld = 1024; nsrc = 1024; K = 2048; npad = 1024; dst = p.wt_ssd_out + (size_t)s * 1024 * 2048; scale = p.ssd_norm_g + s * 2048; }
    else if (job == 4) { src = p.hy_in_w; ld = 4096; nsrc = 4096; K = 1024; npad = 4096; dst = p.wt_hy_in; }
    else if (job == 5) { src = p.hy_out_w; ld = 1024; nsrc = 1024; K = 1024; npad = 1024; dst = p.wt_hy_out; }
    else if (job == 6) { src = p.lru_in_w; ld = 2048; nsrc = 2048; K = 1024; npad = 2048; dst = p.wt_lru_in; }
    else if (job == 7) { src = p.lru_out_w; ld = 1024; nsrc = 1024; K = 1024; npad = 1024; dst = p.wt_lru_out; }
    else { int q = job - 8; int dg = q >> 2, n = q & 3;
      src = p.lru_gate_w + (size_t)(dg * 4 + n) * 65536; ld = 256; nsrc = 256; K = 256; npad = 256;
      dst = p.wt_lru_gate + (size_t)n * 1024 * 256 + (size_t)dg * 256 * 256; }
    int tiles_k = K / 64, tiles = tiles_k * (npad / 64);
    for (int t = bid; t < tiles; t += nblk) transpose_tile(src, ld, nsrc, dst, K, scale, t, tiles_k, tl, cxw);
  }
  for (int i = bid * NTHR + tidx; i < 2 * 2 * 1024; i += nblk * NTHR) p.knorm[i] = 0.f;
}

__device__ __forceinline__ void phase_mod(const Params& p, int bid, int nblk, unsigned char* smem, int cxw) {
  const int tidx = opaque_tid(cxw);
  float* sc = (float*)smem;
  float* red = sc + 5 * 1024;
  __syncthreads();
  for (int i = tidx; i < 5 * 1024; i += NTHR) {
    int r = i >> 10, k = i & 1023;
    float v = (r == 0) ? p.c_ctx[k] : p.c[(r - 1) * 1024 + k];
    sc[i] = siluf(v);
  }
  __syncthreads();
  const int cj = tidx & 31, kg = tidx >> 5;
  for (int item = bid; item < 4 * 96; item += nblk) {
    const int layer = item / 96, j = (item % 96) * 32 + cj;
    const float* w = p.mod_w + (size_t)layer * 1024 * 3072 + (size_t)kg * 128 * 3072 + j;
    const float* s0 = sc + kg * 128;
    float a0 = 0, a1 = 0, a2 = 0, a3 = 0, a4 = 0;
#pragma unroll 8
    for (int k = 0; k < 128; ++k) {
      float wv = w[(size_t)k * 3072];
      a0 += s0[k] * wv; a1 += s0[1024 + k] * wv; a2 += s0[2048 + k] * wv; a3 += s0[3072 + k] * wv; a4 += s0[4096 + k] * wv;
    }
    __syncthreads();
    red[(kg * 5 + 0) * 32 + cj] = a0; red[(kg * 5 + 1) * 32 + cj] = a1; red[(kg * 5 + 2) * 32 + cj] = a2;
    red[(kg * 5 + 3) * 32 + cj] = a3; red[(kg * 5 + 4) * 32 + cj] = a4;
    __syncthreads();
    if (tidx < 160) {
      const int rr = tidx >> 5, cc = tidx & 31;
      float sum = 0.f;
#pragma unroll
      for (int g8 = 0; g8 < 8; ++g8) sum += red[(g8 * 5 + rr) * 32 + cc];
      const int jj = (item % 96) * 32 + cc;
      p.modv[((size_t)layer * 5 + rr) * 3072 + jj] = sum + p.mod_b[layer * 3072 + jj];
    }
  }
}

__device__ __forceinline__ void phase_hyfilt_a(const Params& p, int bid, int nblk, unsigned char* smem, int cxw) {
  const int tidx = opaque_tid(cxw);
  float* sz = (float*)smem;
  float* sh = sz + 4 * 36;
  float* sw1 = sh + 4 * 64;
  float* sw2 = sw1 + 33 * 64;
  int pl = tidx >> 6, m = tidx & 63;
  __syncthreads();
  for (int i = tidx; i < 33 * 64; i += NTHR) sw1[i] = p.hy_f_w1[i];
  for (int i = tidx; i < 64 * 64; i += NTHR) sw2[i] = p.hy_f_w2[i];
  const float b1 = p.hy_f_b1[m], b2 = p.hy_f_b2[m], fq1 = p.hy_f_freq[m], fq2 = p.hy_f_freq[64 + m];
  for (int item = bid; item < 4352 / 4; item += nblk) {
    int pos = item * 4 + pl;
    int L = pos < 256 ? 256 : 4096;
    int l = pos < 256 ? pos : pos - 256;
    __syncthreads();
    if (m < 33) {
      float t = (float)l / (float)L;
      float w = (6.283185307179586f * (float)l) / (float)L;
      float v;
      if (m == 0) v = t;
      else {
        int j = (m - 1) & 15;
        float fr = 1e-4f + (float)j * ((15.f - 1e-4f) / 15.f);
        float ang = w * fr;
        v = (m <= 16) ? __cosf(ang) : __sinf(ang);
      }
      sz[pl * 36 + m] = v;
    }
    __syncthreads();
    float a = b1;
#pragma unroll
    for (int e = 0; e < 33; ++e) a += sz[pl * 36 + e] * sw1[e * 64 + m];
    a = __sinf(fq1 * a);
    sh[pl * 64 + m] = a;
    __syncthreads();
    float b = b2;
#pragma unroll
    for (int e = 0; e < 64; ++e) b += sh[pl * 64 + e] * sw2[e * 64 + m];
    b = __sinf(fq2 * b);
    p.hdn2[(size_t)pos * 64 + m] = b;
  }
}

__device__ __forceinline__ void phase_hyfilt_b(const Params& p, int bid, int nblk, unsigned char* smem, int cxw) {
  const int tidx = opaque_tid(cxw);
  const int lane = tidx & 63;
  float* sw = (float*)smem;
  for (int item = bid; item < 17 * 64; item += nblk) {
    const int lb = item >> 6, chunk = item & 63;
    const int Lsel = lb ? 1 : 0, L = Lsel ? 4096 : 256, RL = Lsel ? 8192 : 512, Lm1 = L - 1;
    const int l = Lsel ? (lb - 1) * 256 + tidx : tidx;
    const int pos = Lsel ? 256 + l : l;
    const int odc0 = chunk * 64, o = odc0 >> 11, d = (odc0 >> 10) & 1, c0 = odc0 & 1023;
    __syncthreads();
#pragma unroll
    for (int i = 0; i < 16; ++i) {
      const int q = tidx + i * 256, m = q >> 6, cc = q & 63;
      sw[cc * 64 + m] = p.hy_f_w3[(size_t)m * 4096 + odc0 + cc];
    }
    float hd[64];
#pragma unroll
    for (int m4 = 0; m4 < 16; ++m4) {
      f32x4 v = *(const f32x4*)(p.hdn2 + (size_t)pos * 64 + m4 * 4);
      hd[m4 * 4] = v.x; hd[m4 * 4 + 1] = v.y; hd[m4 * 4 + 2] = v.z; hd[m4 * 4 + 3] = v.w;
    }
    __syncthreads();
    const float t = (float)l / (float)L;
    bf16_t* rt = Lsel ? p.rtab1 : p.rtab0;
    const float min_decay = -3.0701134573253945f, max_decay = -15.350567286626973f;
    for (int cc = 0; cc < 64; ++cc) {
      const int c = c0 + cc;
      float acc = 0.f;
#pragma unroll
      for (int m4 = 0; m4 < 16; ++m4) {
        const f32x4 w = *(const f32x4*)(sw + cc * 64 + m4 * 4);
        acc += hd[m4 * 4] * w.x + hd[m4 * 4 + 1] * w.y + hd[m4 * 4 + 2] * w.z + hd[m4 * 4 + 3] * w.w;
      }
      float delta = fabsf(min_decay + (float)c * ((max_decay - min_decay) / 1023.f));
      float kv = acc * expf(-t * delta);
      size_t rb = (size_t)(o * 1024 + c) * RL;
      if (d == 0) rt[rb + Lm1 - l] = f2bf(kv);
      else if (l > 0) rt[rb + Lm1 + l] = f2bf(kv);
      else rt[rb + RL - 1] = 0;
      float a = fabsf(kv);
      a = wave_sum(a);
      if (lane == 0) atomicAdd(&p.knorm[(Lsel * 2 + o) * 1024 + c], a);
    }
  }
}

__device__ __forceinline__ void phase_lnmod(const Params& p, int layer, int bid, int nblk, int cxw) {
  const int tidx = opaque_tid(cxw);
  int lane = tidx & 63, wv = cxw & 3;
  f32x4 lg[4], lb[4];
  if (layer > 0) {
    const float* g = p.ln_g + (layer - 1) * DM; const float* b = p.ln_b + (layer - 1) * DM;
#pragma unroll
    for (int j = 0; j < 4; ++j) { lg[j] = *(const f32x4*)(g + j * 256 + lane * 4); lb[j] = *(const f32x4*)(b + j * 256 + lane * 4); }
  }
  f32x4 vn[4];
#define LNMOD_LOAD(ROW) do { const int row_ = (ROW); \
    if (layer == 0) { const float* src_ = row_ < T_CTX ? p.x_prompt + (size_t)row_ * DM : p.x_sample + (size_t)(row_ - T_CTX) * DM; \
      _Pragma("unroll") for (int j = 0; j < 4; ++j) vn[j] = *(const f32x4*)(src_ + j * 256 + lane * 4); } \
    else { const bf16_t* src_ = p.resb + (size_t)row_ * DM; \
      _Pragma("unroll") for (int j = 0; j < 4; ++j) { const u32x2 w_ = *(const u32x2*)(src_ + j * 256 + lane * 4); \
        vn[j].x = bflo(w_.x); vn[j].y = bfhi(w_.x); vn[j].z = bflo(w_.y); vn[j].w = bfhi(w_.y); } } } while (0)
  if (bid * 4 + wv < T_ALL) LNMOD_LOAD(bid * 4 + wv);
  for (int row = bid * 4 + wv; row < T_ALL; row += nblk * 4) {
    f32x4 v[4];
#pragma unroll
    for (int j = 0; j < 4; ++j) v[j] = vn[j];
    if (row + nblk * 4 < T_ALL) LNMOD_LOAD(row + nblk * 4);
    f32x4 msh[4], msc[4];
    if (layer < 4) {
      const int mrow_ = row < T_CTX ? 0 : 1 + ((row - T_CTX) >> 12);
      const float* mv_ = p.modv + ((size_t)layer * 5 + mrow_) * 3072;
#pragma unroll
      for (int j = 0; j < 4; ++j) { msh[j] = *(const f32x4*)(mv_ + j * 256 + lane * 4); msc[j] = *(const f32x4*)(mv_ + 1024 + j * 256 + lane * 4); }
    }
    if (layer > 0) {
      float s = 0.f;
#pragma unroll
      for (int j = 0; j < 4; ++j) s += v[j].x + v[j].y + v[j].z + v[j].w;
      s = wave_sum(s);
      float mu = s * (1.f / 1024.f);
      float q = 0.f;
#pragma unroll
      for (int j = 0; j < 4; ++j) { float a = v[j].x - mu, b = v[j].y - mu, c = v[j].z - mu, d = v[j].w - mu; q += a * a + b * b + c * c + d * d; }
      q = wave_sum(q);
      float rs = rsqrtf(q * (1.f / 1024.f) + LN_EPS);
#pragma unroll
      for (int j = 0; j < 4; ++j) {
        const f32x4 gg = lg[j], bb = lb[j];
        v[j].x = (v[j].x - mu) * rs * gg.x + bb.x; v[j].y = (v[j].y - mu) * rs * gg.y + bb.y;
        v[j].z = (v[j].z - mu) * rs * gg.z + bb.z; v[j].w = (v[j].w - mu) * rs * gg.w + bb.w;
      }
    }
    if (layer == 4) {
      float* dst = p.xres + (size_t)row * DM;
#pragma unroll
      for (int j = 0; j < 4; ++j) *(f32x4*)(dst + j * 256 + lane * 4) = v[j];
    } else {
      bf16_t* dst = p.resb + (size_t)row * DM;
#pragma unroll
      for (int j = 0; j < 4; ++j) { u32x2 o; o.x = pack2(v[j].x, v[j].y); o.y = pack2(v[j].z, v[j].w); *(u32x2*)(dst + j * 256 + lane * 4) = o; }
    }
    if (layer < 4) {
#pragma unroll
      for (int j = 0; j < 4; ++j) {
        const f32x4 sh = msh[j], sc = msc[j];
        u32x2 o;
        o.x = pack2(v[j].x * (1.f + sc.x) + sh.x, v[j].y * (1.f + sc.y) + sh.y);
        o.y = pack2(v[j].z * (1.f + sc.z) + sh.z, v[j].w * (1.f + sc.w) + sh.w);
        *(u32x2*)(p.hbuf + (size_t)row * DM + j * 256 + lane * 4) = o;
      }
    }
  }
}

#define PG8_LAS __attribute__((address_space(3)))
namespace pg8 {
constexpr int BM = 256, BK = 64, HALF = 128, HTB = HALF * BK * 2, STAGE_BYTES = 8 * HTB, NXCD = 8, WGM = 8;
__device__ __forceinline__ int lds_byte(int r, int c) { const int st = (r >> 4) * 2 + (c >> 5), rr = r & 15, cc = c & 31, ob = rr * 64 + cc * 2; return st * 1024 + (ob ^ (((ob >> 9) & 1) << 5)); }
__device__ __forceinline__ void stage_rc(int b, int& R, int& C) { const int st = b / 1024, sb = b % 1024, swz = sb ^ (((sb >> 9) & 1) << 5); R = (st >> 1) * 16 + swz / 64; C = (st & 1) * 32 + (swz % 64) / 2; }
__device__ __forceinline__ int perm32(int rho) { const int n = rho >> 4, i = rho & 15; return 8 * (i >> 2) + 4 * n + (i & 3); }
struct Unit { int pm, pn; };
struct Gemm { const bf16_t* A; const bf16_t* Bt; int M, N, K, lda; int a_grp_shift; int a_grp_bytes; };
struct StaticOrder {
  int nM, nN, nwg, G, c;
  __device__ void init(int M, int N, int G_, int c_) { nM = M / BM; nN = N / BM; nwg = nM * nN; G = G_; c = c_; }
  __device__ bool next(int i, Unit& u) const {
    const long L = (long)i * G + c; if (L >= nwg) return false;
    int wgid = (int)L; { const int q = nwg / NXCD, r = nwg % NXCD, xcd = wgid % NXCD, off = wgid / NXCD; wgid = (xcd < r ? xcd * (q + 1) : r * (q + 1) + (xcd - r) * q) + off; }
    const int nig = WGM * nN, gid = wgid / nig, fm = gid * WGM, gsz = (nM - fm) < WGM ? (nM - fm) : WGM;
    u.pm = fm + ((wgid % nig) % gsz); u.pn = (wgid % nig) / gsz; return true;
  }
};
__device__ __forceinline__ unsigned cvt_pk_bf16(float lo, float hi) { return pack2(lo, hi); }

template <class Epi>
__device__ __forceinline__ void gemm_phase(PG8_LAS unsigned char* lds, const Gemm g, const StaticOrder& S, const Epi& E, int wave) {
  const int tid = opaque_tid512(wave), wid = wave, lane = tid & 63, wr = wid >> 2, wc = wid & 3, fr = lane & 15, fq = lane >> 4;
  const int K = g.K, nt = K / BK, lda = g.lda;
  unsigned voffA[2], voffB[2];
#pragma unroll
  for (int i = 0; i < 2; ++i) { int R, C; stage_rc(tid * 16 + i * 8192, R, C); const int Rb = Epi::PERM ? ((R & ~31) + perm32(R & 31)) : R;
    voffA[i] = (unsigned)(R * lda + C) * 2u; voffB[i] = (unsigned)(Rb * K + C) * 2u; }
  const size_t kstep = (size_t)(BK * 2);
  const size_t hstepA = (size_t)HALF * lda * 2, hstepB = (size_t)HALF * K * 2;
  const size_t tstepA = 2 * hstepA, tstepB = 2 * hstepB;
  const unsigned ldsw = (unsigned)wid * 1024u;
  const int aoff = lds_byte(wr * 64 + fr, fq * 8), boff = lds_byte(wc * 32 + fr, fq * 8);
#define PG8_SA(b, h) (((b) * 2 + (h)) * HTB)
#define PG8_SB(b, h) ((4 + (b) * 2 + (h)) * HTB)
#define PG8_STAGE(bufoff, gbase, voff) do { _Pragma("unroll") for (int _i = 0; _i < 2; ++_i) \
    __builtin_amdgcn_global_load_lds((const unsigned*)((const char*)(gbase) + (voff)[_i]), (PG8_LAS unsigned*)(lds + (bufoff) + ldsw + _i * 8192), 16, 0, 0); } while (0)
#define PG8_LDA(dst, b, h) do { _Pragma("unroll") for (int m = 0; m < 4; ++m) _Pragma("unroll") for (int k = 0; k < 2; ++k) dst[m][k] = *(const PG8_LAS bf16x8*)(lds + PG8_SA(b, h) + aoff + m * 2048 + k * 1024); } while (0)
#define PG8_LDB(dst, b, h) do { _Pragma("unroll") for (int n = 0; n < 2; ++n) _Pragma("unroll") for (int k = 0; k < 2; ++k) dst[n][k] = *(const PG8_LAS bf16x8*)(lds + PG8_SB(b, h) + boff + n * 2048 + k * 1024); } while (0)
#define PG8_MMA(ai, bj, At, Bt) do { __builtin_amdgcn_s_setprio(1); _Pragma("unroll") for (int m = 0; m < 4; ++m) _Pragma("unroll") for (int n = 0; n < 2; ++n) _Pragma("unroll") for (int k = 0; k < 2; ++k) \
    acc[ai][bj][m][n] = __builtin_amdgcn_mfma_f32_16x16x32_bf16(Bt[n][k], At[m][k], acc[ai][bj][m][n], 0, 0, 0); __builtin_amdgcn_s_setprio(0); } while (0)
#define PG8_WAIT_V(n) asm volatile("s_waitcnt vmcnt(" #n ")" ::: "memory")
#define PG8_WAIT_L(n) asm volatile("s_waitcnt lgkmcnt(" #n ")" ::: "memory")
#define PG8_BAR __builtin_amdgcn_s_barrier()
#define PG8_SCHED __builtin_amdgcn_sched_barrier(0)
#define PG8_APTR(u) ((const char*)g.A + (size_t)(u).pm * tstepA + (size_t)(((u).pn >> g.a_grp_shift) * g.a_grp_bytes))
  Unit cur, nxt; int ui = 0;
  if (!S.next(0, cur)) return;
  f32x4 acc[2][2][4][2];
#pragma unroll
  for (int a = 0; a < 2; ++a)
#pragma unroll
    for (int b = 0; b < 2; ++b)
#pragma unroll
      for (int m = 0; m < 4; ++m)
#pragma unroll
        for (int n = 0; n < 2; ++n) acc[a][b][m][n] = (f32x4){0.f, 0.f, 0.f, 0.f};
  bf16x8 At[4][2], B0[2][2], B1[2][2];
  const char* cA = PG8_APTR(cur); const char* cB = (const char*)g.Bt + (size_t)cur.pn * tstepB;
  PG8_STAGE(PG8_SB(0, 0), cB, voffB); PG8_STAGE(PG8_SA(0, 0), cA, voffA); PG8_STAGE(PG8_SB(0, 1), cB + hstepB, voffB); PG8_STAGE(PG8_SA(0, 1), cA + hstepA, voffA);
  if (wr == 1) PG8_BAR;
  PG8_WAIT_V(4); PG8_BAR;
  PG8_STAGE(PG8_SB(1, 0), cB + kstep, voffB); PG8_STAGE(PG8_SA(1, 0), cA + kstep, voffA); PG8_STAGE(PG8_SB(1, 1), cB + hstepB + kstep, voffB);
  PG8_WAIT_V(6); PG8_BAR;
  for (;;) {
    const bool has_next = S.next(ui + 1, nxt);
    const char* nA = has_next ? PG8_APTR(nxt) : cA; const char* nB = has_next ? (const char*)g.Bt + (size_t)nxt.pn * tstepB : cB;
    for (int t = 0; t < nt; t += 2) {
      const bool last = (t == nt - 2);
      const char* a1 = cA + (size_t)(t + 1) * kstep;
      const char* a2 = last ? nA : cA + (size_t)(t + 2) * kstep; const char* b2 = last ? nB : cB + (size_t)(t + 2) * kstep;
      const char* a3 = a2 + kstep; const char* b3 = b2 + kstep;
      PG8_LDB(B0, 0, 0); PG8_SCHED; PG8_LDA(At, 0, 0); PG8_STAGE(PG8_SA(1, 1), a1 + hstepA, voffA);
      PG8_WAIT_L(8); PG8_BAR; PG8_WAIT_L(0); PG8_MMA(0, 0, At, B0); PG8_BAR; PG8_SCHED;
      PG8_LDB(B1, 0, 1); PG8_STAGE(PG8_SB(0, 0), b2, voffB);
      PG8_BAR; PG8_WAIT_L(0); PG8_MMA(0, 1, At, B1); PG8_BAR;
      PG8_LDA(At, 0, 1); PG8_STAGE(PG8_SA(0, 0), a2, voffA);
      PG8_BAR; PG8_WAIT_L(0); PG8_MMA(1, 0, At, B0); PG8_BAR; PG8_SCHED;
      PG8_STAGE(PG8_SB(0, 1), b2 + hstepB, voffB);
      PG8_WAIT_V(6); PG8_BAR; PG8_MMA(1, 1, At, B1); PG8_BAR;
      PG8_LDB(B0, 1, 0); PG8_SCHED; PG8_LDA(At, 1, 0); PG8_STAGE(PG8_SA(0, 1), a2 + hstepA, voffA);
      PG8_WAIT_L(8); PG8_BAR; PG8_WAIT_L(0); PG8_MMA(0, 0, At, B0); PG8_BAR; PG8_SCHED;
      PG8_LDB(B1, 1, 1); PG8_STAGE(PG8_SB(1, 0), b3, voffB);
      PG8_BAR; PG8_WAIT_L(0); PG8_MMA(0, 1, At, B1); PG8_BAR;
      PG8_LDA(At, 1, 1); PG8_STAGE(PG8_SA(1, 0), a3, voffA);
      PG8_BAR; PG8_WAIT_L(0); PG8_MMA(1, 0, At, B0); PG8_BAR; PG8_SCHED;
      PG8_STAGE(PG8_SB(1, 1), b3 + hstepB, voffB);
      PG8_WAIT_V(6); PG8_BAR; PG8_MMA(1, 1, At, B1); PG8_BAR;
    }
    { const int lane2 = opaque_lane();
      E(acc, cur, wr, wc, lane2 & 15, lane2 >> 4); }
    if (!has_next) break;
#pragma unroll
    for (int a = 0; a < 2; ++a)
#pragma unroll
      for (int b = 0; b < 2; ++b)
#pragma unroll
        for (int m = 0; m < 4; ++m)
#pragma unroll
          for (int n = 0; n < 2; ++n) acc[a][b][m][n] = (f32x4){0.f, 0.f, 0.f, 0.f};
    cur = nxt; cA = nA; cB = nB; ++ui;
  }
  PG8_WAIT_V(0);
  if (wr == 0) PG8_BAR;
  PG8_BAR;
#undef PG8_SA
#undef PG8_SB
#undef PG8_STAGE
#undef PG8_LDA
#undef PG8_LDB
#undef PG8_MMA
#undef PG8_WAIT_V
#undef PG8_WAIT_L
#undef PG8_BAR
#undef PG8_SCHED
#undef PG8_APTR
}

struct EpiBf16 {
  static constexpr bool PERM = true;
  bf16_t* O; size_t ldc;
  __device__ __forceinline__ void operator()(const f32x4 (&acc)[2][2][4][2], const Unit& u, int wr, int wc, int fr, int fq) const {
    const int row0 = u.pm * BM + wr * 64 + fr, col0 = u.pn * BM + wc * 32 + 8 * fq;
#pragma unroll
    for (int ai = 0; ai < 2; ++ai)
#pragma unroll
      for (int m = 0; m < 4; ++m) {
        bf16_t* rowp = O + (size_t)(row0 + ai * HALF + m * 16) * ldc + col0;
#pragma unroll
        for (int bj = 0; bj < 2; ++bj) {
          const f32x4 v0 = acc[ai][bj][m][0], v1 = acc[ai][bj][m][1];
          u32x4 w; w.x = pack2(v0[0], v0[1]); w.y = pack2(v0[2], v0[3]); w.z = pack2(v1[0], v1[1]); w.w = pack2(v1[2], v1[3]);
          *(u32x4*)(rowp + bj * HALF) = w;
        }
      }
  }
};
struct EpiSsdIn {
  static constexpr bool PERM = true;
  bf16_t* z; bf16_t* xbc; float* dt; const float* dt_bias;
  __device__ __forceinline__ void operator()(const f32x4 (&acc)[2][2][4][2], const Unit& u, int wr, int wc, int fr, int fq) const {
    const int row0 = u.pm * BM + wr * 64 + fr, colt = u.pn * BM + wc * 32 + 8 * fq;
    if (u.pn < 24) {
      bf16_t* base = u.pn < 8 ? z : xbc; const size_t ldc = u.pn < 8 ? 2048 : 4096; const int col0 = u.pn < 8 ? colt : colt - 2048;
#pragma unroll
      for (int ai = 0; ai < 2; ++ai)
#pragma unroll
        for (int m = 0; m < 4; ++m) {
          bf16_t* rowp = base + (size_t)(row0 + ai * HALF + m * 16) * ldc + col0;
#pragma unroll
          for (int bj = 0; bj < 2; ++bj) {
            const f32x4 v0 = acc[ai][bj][m][0], v1 = acc[ai][bj][m][1];
            u32x4 w; w.x = pack2(v0[0], v0[1]); w.y = pack2(v0[2], v0[3]); w.z = pack2(v1[0], v1[1]); w.w = pack2(v1[2], v1[3]);
            *(u32x4*)(rowp + bj * HALF) = w;
          }
        }
    } else {
      const int c0 = wc * 32 + 8 * fq;
      if (c0 < 64) {
#pragma unroll
        for (int ai = 0; ai < 2; ++ai)
#pragma unroll
          for (int m = 0; m < 4; ++m) {
            float* rowp = dt + (size_t)(row0 + ai * HALF + m * 16) * 64 + c0;
#pragma unroll
            for (int n = 0; n < 2; ++n) {
              const f32x4 v = acc[ai][0][m][n];
              f32x4 o;
#pragma unroll
              for (int e = 0; e < 4; ++e) o[e] = softplusf(v[e] + dt_bias[c0 + 4 * n + e]);
              *(f32x4*)(rowp + 4 * n) = o;
            }
          }
      }
    }
  }
};
struct EpiOut {
  static constexpr bool PERM = true;
  bf16_t* res; const float* modv_layer; const float* rstd;
  __device__ __forceinline__ void operator()(const f32x4 (&acc)[2][2][4][2], const Unit& u, int wr, int wc, int fr, int fq) const {
    const int row0 = u.pm * BM + wr * 64 + fr, col0 = u.pn * BM + wc * 32 + 8 * fq;
#pragma unroll
    for (int ai = 0; ai < 2; ++ai)
#pragma unroll
      for (int m = 0; m < 4; ++m) {
        const int row = row0 + ai * HALF + m * 16;
        const int mrow = row < T_CTX ? 0 : 1 + ((row - T_CTX) >> 12);
        const float rs = rstd ? rstd[row] : 1.f;
        const float* gp = modv_layer + (size_t)mrow * 3072 + 2048 + col0;
        bf16_t* rowp = res + (size_t)row * DM + col0;
#pragma unroll
        for (int bj = 0; bj < 2; ++bj) {
          const f32x4 g0 = *(const f32x4*)(gp + bj * HALF), g1 = *(const f32x4*)(gp + bj * HALF + 4);
          const u32x4 xw = *(const u32x4*)(rowp + bj * HALF);
          const f32x4 v0 = acc[ai][bj][m][0], v1 = acc[ai][bj][m][1];
          u32x4 o;
          o.x = pack2(ALPHA_RES * bflo(xw.x) + g0.x * (v0[0] * rs), ALPHA_RES * bfhi(xw.x) + g0.y * (v0[1] * rs));
          o.y = pack2(ALPHA_RES * bflo(xw.y) + g0.z * (v0[2] * rs), ALPHA_RES * bfhi(xw.y) + g0.w * (v0[3] * rs));
          o.z = pack2(ALPHA_RES * bflo(xw.z) + g1.x * (v1[0] * rs), ALPHA_RES * bfhi(xw.z) + g1.y * (v1[1] * rs));
          o.w = pack2(ALPHA_RES * bflo(xw.w) + g1.z * (v1[2] * rs), ALPHA_RES * bfhi(xw.w) + g1.w * (v1[3] * rs));
          *(u32x4*)(rowp + bj * HALF) = o;
        }
      }
  }
};
struct EpiLruGate {
  static constexpr bool PERM = true;
  bf16_t* gates; const float* gate_b;
  __device__ __forceinline__ void operator()(const f32x4 (&acc)[2][2][4][2], const Unit& u, int wr, int wc, int fr, int fq) const {
    const int nb = u.pn >> 2, dg = u.pn & 3;
    const int row0 = u.pm * BM + wr * 64 + fr, ch0 = nb * 256 + wc * 32 + 8 * fq;
#pragma unroll
    for (int ai = 0; ai < 2; ++ai)
#pragma unroll
      for (int m = 0; m < 4; ++m) {
        bf16_t* rowp = gates + ((size_t)dg * T_ALL + row0 + ai * HALF + m * 16) * 1024 + ch0;
#pragma unroll
        for (int bj = 0; bj < 2; ++bj) {
          const float* bp = gate_b + dg * 1024 + ch0 + bj * HALF;
          const f32x4 b0 = *(const f32x4*)bp, b1 = *(const f32x4*)(bp + 4);
          const f32x4 v0 = acc[ai][bj][m][0] + b0, v1 = acc[ai][bj][m][1] + b1;
          u32x4 w; w.x = pack2(sigmoidf(v0[0]), sigmoidf(v0[1])); w.y = pack2(sigmoidf(v0[2]), sigmoidf(v0[3]));
          w.z = pack2(sigmoidf(v1[0]), sigmoidf(v1[1])); w.w = pack2(sigmoidf(v1[2]), sigmoidf(v1[3]));
          *(u32x4*)(rowp + bj * HALF) = w;
        }
      }
  }
};
}

template <int KW, bool SILU>
__device__ __forceinline__ void phase_dwconv(const bf16_t* __restrict__ src, int ld_src, bf16_t* __restrict__ dst, int ld_dst, int CH,
                             const float* __restrict__ w, const float* __restrict__ b, bool colmajor, int bid, int nblk, int cxw) {
  const int tidx = opaque_tid(cxw);
  const int cpr = CH / 8;
  const size_t total = (size_t)T_ALL * cpr;
  for (size_t idx = (size_t)bid * NTHR + tidx; idx < total; idx += (size_t)nblk * NTHR) {
    int tok = (int)(idx / cpr), c0 = (int)(idx % cpr) * 8;
    TokInfo ti = tokinfo(tok);
    bool cm = colmajor && ti.s >= 32;
    int pos = seqpos2off(ti.l, cm);
    float acc[8];
#pragma unroll
    for (int e = 0; e < 8; ++e) acc[e] = b[c0 + e];
#pragma unroll
    for (int k = 0; k < KW; ++k) {
      int pp = pos + k - 1;
      if (pp < 0 || pp >= ti.L) continue;
      int tk = ti.base + seqpos2off(pp, cm);
      u32x4 xv = *(const u32x4*)(src + (size_t)tk * ld_src + c0);
      const float* wk = w + (size_t)k * CH + c0;
      acc[0] += wk[0] * bflo(xv.x); acc[1] += wk[1] * bfhi(xv.x);
      acc[2] += wk[2] * bflo(xv.y); acc[3] += wk[3] * bfhi(xv.y);
      acc[4] += wk[4] * bflo(xv.z); acc[5] += wk[5] * bfhi(xv.z);
      acc[6] += wk[6] * bflo(xv.w); acc[7] += wk[7] * bfhi(xv.w);
    }
    if (SILU) {
#pragma unroll
      for (int e = 0; e < 8; ++e) acc[e] = siluf(acc[e]);
    }
    u32x4 o;
    o.x = pack2(acc[0], acc[1]); o.y = pack2(acc[2], acc[3]); o.z = pack2(acc[4], acc[5]); o.w = pack2(acc[6], acc[7]);
    *(u32x4*)(dst + (size_t)tok * ld_dst + c0) = o;
  }
}

__device__ __forceinline__ void phase_ssd_conv(const Params& p, int slot, bool colmajor, int bid, int nblk, unsigned char* smem, int cxw) {
  const int tid = opaque_tid(cxw);
  const bf16_t* raw = (const bf16_t*)(p.scratch + SC_SSD_XBC);
  bf16_t* out = (bf16_t*)(p.scratch + SC_SSD_XBCC);
  bf16_t* XT = (bf16_t*)(p.scratch + SC_SSD_XT);
  bf16_t* BT = (bf16_t*)(p.scratch + SC_SSD_BT);
  bf16_t* BF = (bf16_t*)(p.scratch + SC_SSD_BF);
  bf16_t* CF = (bf16_t*)(p.scratch + SC_SSD_CF);
  const float* cw = p.ssd_conv_w + (size_t)slot * 4 * 4096;
  const float* cb = p.ssd_conv_b + slot * 4096;
  bf16_t* tl = (bf16_t*)smem;
  bf16_t* rt = tl + 64 * 72;
  const int rr = tid >> 2, cpart = tid & 3;
  const int NITEMS = 384 * 64;
  u32x4 pre[3];
#define CONV_PREFETCH(ITEM) do { const int it_ = (ITEM); const int ptile_ = it_ >> 6, ct_ = it_ & 63; \
    const TokInfo ti_ = tokinfo(ptile_ * 64); const bool cm_ = colmajor && ti_.s >= 32; \
    _Pragma("unroll") for (int i_ = 0; i_ < 3; ++i_) { const int q_ = tid + i_ * 256; const int row_ = q_ >> 3, c8_ = (q_ & 7) * 8; \
      const int pp_ = ti_.l - 1 + row_; u32x4 v_ = {0u, 0u, 0u, 0u}; \
      if (row_ < 67 && pp_ >= 0 && pp_ < ti_.L) v_ = *(const u32x4*)(raw + (size_t)(ti_.base + seqpos2off(pp_, cm_)) * 4096 + ct_ * 64 + c8_); \
      pre[i_] = v_; } } while (0)
  if (bid < NITEMS) CONV_PREFETCH(bid);
  float wreg[4][16], wb[16]; int wct = -1;
  for (int item = bid; item < NITEMS; item += nblk) {
    const int ptile = item >> 6, ct = item & 63;
    const int ptok0 = ptile * 64;
    const int ch = ct * 64 + cpart * 16;
    __syncthreads();
#pragma unroll
    for (int i = 0; i < 3; ++i) { const int q = tid + i * 256; if (q < 67 * 8) *(u32x4*)(rt + (q >> 3) * 72 + (q & 7) * 8) = pre[i]; }
    if (item + nblk < NITEMS) CONV_PREFETCH(item + nblk);
    __syncthreads();
    if (ct != wct) {
      wct = ct;
#pragma unroll
      for (int e = 0; e < 16; ++e) wb[e] = cb[ch + e];
#pragma unroll
      for (int k = 0; k < 4; ++k)
#pragma unroll
        for (int e = 0; e < 16; ++e) wreg[k][e] = cw[(size_t)k * 4096 + ch + e];
    }
    float acc[16];
#pragma unroll
    for (int e = 0; e < 16; ++e) acc[e] = wb[e];
#pragma unroll
    for (int k = 0; k < 4; ++k) {
      const bf16_t* rp = rt + (rr + k) * 72 + cpart * 16;
      u32x4 x0 = *(const u32x4*)rp, x1 = *(const u32x4*)(rp + 8);
      unsigned xw[8] = {x0.x, x0.y, x0.z, x0.w, x1.x, x1.y, x1.z, x1.w};
#pragma unroll
      for (int e = 0; e < 8; ++e) { acc[2 * e] += wreg[k][2 * e] * bflo(xw[e]); acc[2 * e + 1] += wreg[k][2 * e + 1] * bfhi(xw[e]); }
    }
    u32x4 o0, o1;
    o0.x = pack2(siluf(acc[0]), siluf(acc[1])); o0.y = pack2(siluf(acc[2]), siluf(acc[3]));
    o0.z = pack2(siluf(acc[4]), siluf(acc[5])); o0.w = pack2(siluf(acc[6]), siluf(acc[7]));
    o1.x = pack2(siluf(acc[8]), siluf(acc[9])); o1.y = pack2(siluf(acc[10]), siluf(acc[11]));
    o1.z = pack2(siluf(acc[12]), siluf(acc[13])); o1.w = pack2(siluf(acc[14]), siluf(acc[15]));
    *(u32x4*)(tl + rr * 72 + cpart * 16) = o0;
    *(u32x4*)(tl + rr * 72 + cpart * 16 + 8) = o1;
    __syncthreads();
    if (ct < 32) {
      const int crow = tid >> 2, part = tid & 3;
      unsigned wv[8];
#pragma unroll
      for (int e = 0; e < 8; ++e) {
        unsigned lo = tl[(part * 16 + 2 * e) * 72 + crow], hi = tl[(part * 16 + 2 * e + 1) * 72 + crow];
        wv[e] = lo | (hi << 16);
      }
      bf16_t* dp = XT + (size_t)(ct * 64 + crow) * T_ALL + ptok0 + part * 16;
      u32x4 t0, t1;
      t0.x = wv[0]; t0.y = wv[1]; t0.z = wv[2]; t0.w = wv[3]; t1.x = wv[4]; t1.y = wv[5]; t1.z = wv[6]; t1.w = wv[7];
      *(u32x4*)dp = t0; *(u32x4*)(dp + 8) = t1;
    } else {
      const bool isB = ct < 48;
      const int cq = (ct - (isB ? 32 : 48));
      const int g = cq >> 1, chhalf = cq & 1;
      const int lane = tid & 63, r = lane & 31, hh = lane >> 5;
      bf16_t* F = isB ? BF : CF;
#pragma unroll
      for (int i = 0; i < 2; ++i) {
        const int f = (cxw & 3) + 4 * i;
        const int rt2 = f >> 2, kk4 = f & 3;
        const u32x4 v = *(const u32x4*)(tl + (32 * rt2 + r) * 72 + 16 * kk4 + 8 * hh);
        const size_t rt = (size_t)(ptok0 >> 5) + rt2;
        *(u32x4*)(F + (((rt * 8 + g) * 8 + chhalf * 4 + kk4) * 64 + lane) * 8) = v;
      }
      if (isB) {
#pragma unroll
        for (int i = 0; i < 2; ++i) {
          const int f = (cxw & 3) + 4 * i;
          const int nt2 = f >> 2, ts4 = f & 3;
          unsigned wv[4];
#pragma unroll
          for (int e = 0; e < 4; ++e) {
            unsigned lo = tl[(16 * ts4 + 8 * hh + 2 * e) * 72 + 32 * nt2 + r], hi = tl[(16 * ts4 + 8 * hh + 2 * e + 1) * 72 + 32 * nt2 + r];
            wv[e] = lo | (hi << 16);
          }
          u32x4 v; v.x = wv[0]; v.y = wv[1]; v.z = wv[2]; v.w = wv[3];
          const size_t ts = (size_t)(ptok0 >> 4) + ts4;
          *(u32x4*)(BT + (((ts * 8 + g) * 4 + chhalf * 2 + nt2) * 64 + lane) * 8) = v;
        }
      }
    }
  }
}

#define SH_STRIDE 136
__device__ __forceinline__ int rowmap(int e, int hh) { return (e & 3) + 8 * (e >> 2) + 4 * hh; }
__device__ __forceinline__ bf16x8 pack8(float a0, float a1, float a2, float a3, float a4, float a5, float a6, float a7) {
  u32x4 v; v.x = pack2(a0, a1); v.y = pack2(a2, a3); v.z = pack2(a4, a5); v.w = pack2(a6, a7);
  return __builtin_bit_cast(bf16x8, v);
}
#define SCAN_PRIV 56576
#define SCAN_SF 49152
__device__ __forceinline__ void phase_ssd_scan(const Params& p, int slot, bool colmajor, int bid, int nblk, unsigned char* wg_smem, int cxw) {
  const int tid = opaque_tid(cxw), lane = tid & 63, w = cxw & 3, vb = cxw >> 2, r = lane & 31, hh = lane >> 5;
  const int it = w >> 1, pt = w & 1;
  const bf16_t* XT = (const bf16_t*)(p.scratch + SC_SSD_XT);
  const bf16_t* BT = (const bf16_t*)(p.scratch + SC_SSD_BT);
  const bf16_t* BF = (const bf16_t*)(p.scratch + SC_SSD_BF);
  const bf16_t* CF = (const bf16_t*)(p.scratch + SC_SSD_CF);
  const float* dtb = (const float*)(p.scratch + SC_SSD_DT);
  bf16_t* ybuf = (bf16_t*)(p.scratch + SC_SSD_XBC);
  unsigned char* priv = wg_smem + (vb ? SCAN_SF + SCAN_PRIV : 0);
  bf16_t* sXr = (bf16_t*)priv;
  bf16_t* sXs = sXr + 64 * 72;
  bf16_t* sH = sXs + 64 * 72;
  float* sW = (float*)(sH + 64 * SH_STRIDE);
  bf16_t* sY = (bf16_t*)(sW + 4 * 256);
  bf16_t* sXd = sY + 64 * 64;
  float* sDt = (float*)(sXd + 64 * 64);
  float* myW = sW + w * 256;
  const bf16_t* sfC = (const bf16_t*)(wg_smem + SCAN_PRIV);
  const bf16_t* sfB = sfC + 8192;
  const bf16_t* sfT = sfC + 16384;
  for (int item = bid; item < 36 * 64; item += nblk) {
    int s, h, dir;
    {
      const int itx = item < 256 ? item : item - 256;
      const int idx = itx & 63, pairidx = idx >> 1;
      s = item < 256 ? 32 + (itx >> 6) : (itx >> 6);
      dir = pairidx & 1; h = (pairidx >> 1) * 2 + (idx & 1);
    }
    const int L = s < 32 ? 256 : 4096;
    const int base = s < 32 ? s * 256 : T_CTX + (s - 32) * 4096;
    const bool cm = colmajor && s >= 32;
    const int g = h >> 2;
    const float Aval = -expf(p.ssd_a_log[(slot * 2 + dir) * 32 + h]);
    const float dskip = p.ssd_d[slot * 32 + h];
    const int nchunks = L >> 6;
    const int pcol = 32 * pt + r;
    f32x16 hacc[2];
    if (s >= 32) {
      const float* h0 = p.state_ssd + ((((size_t)(s - 32) * 2 + slot) * 2 + dir) * 32 + h) * 8192 + (size_t)pcol * 128;
#pragma unroll
      for (int t2 = 0; t2 < 2; ++t2)
#pragma unroll
        for (int qd = 0; qd < 4; ++qd) {
          f32x4 v = *(const f32x4*)(h0 + 32 * (2 * it + t2) + 8 * qd + 4 * hh);
          hacc[t2][4 * qd] = v.x; hacc[t2][4 * qd + 1] = v.y; hacc[t2][4 * qd + 2] = v.z; hacc[t2][4 * qd + 3] = v.w;
        }
    } else {
#pragma unroll
      for (int t2 = 0; t2 < 2; ++t2)
#pragma unroll
        for (int e = 0; e < 16; ++e) hacc[t2][e] = 0.f;
    }
#define SCAN_PTOK(c) (base + 64 * (dir ? nchunks - 1 - (c) : (c)))
#define SCAN_DMA_DTX(pt0) do { \
      _Pragma("unroll") for (int i_ = 0; i_ < 2; ++i_) { \
        const bf16_t* src_ = XT + (size_t)(h * 64 + 16 * w + 8 * i_ + (lane >> 3)) * T_ALL + (pt0) + (lane & 7) * 8; \
        __builtin_amdgcn_global_load_lds((const unsigned*)src_, (PG8_LAS unsigned*)((unsigned char*)sXd + (16 * w + 8 * i_) * 128), 16, 0, 0); } \
      { const int tok_ = base + seqpos2off((pt0) - base + lane, cm); \
        const float* dsrc_ = dtb + (size_t)tok_ * 64 + dir * 32 + h; \
        __builtin_amdgcn_global_load_lds((const unsigned*)dsrc_, (PG8_LAS unsigned*)sDt, 4, 0, 0); } } while (0)
#define SCAN_DMA(pt0) do { \
      _Pragma("unroll") for (int i_ = 0; i_ < 6; ++i_) { const int q_ = cxw + 8 * (i_ & 1); \
        const bf16_t* src_; \
        if (i_ < 4) src_ = (i_ < 2 ? CF : BF) + ((((size_t)((pt0) >> 5) + (q_ >> 3)) * 8 + g) * 8 + (q_ & 7)) * 512 + lane * 8; \
        else src_ = BT + ((((size_t)((pt0) >> 4) + (q_ >> 2)) * 8 + g) * 4 + (q_ & 3)) * 512 + lane * 8; \
        __builtin_amdgcn_global_load_lds((const unsigned*)src_, (PG8_LAS unsigned*)(wg_smem + SCAN_PRIV + (i_ >> 1) * 16384 + q_ * 1024), 16, 0, 0); } } while (0)
#define SCAN_WRITE_STATE() do { \
      _Pragma("unroll") for (int t2 = 0; t2 < 2; ++t2) _Pragma("unroll") for (int qd = 0; qd < 4; ++qd) { \
        u32x2 o_; o_.x = pack2(hacc[t2][4 * qd], hacc[t2][4 * qd + 1]); o_.y = pack2(hacc[t2][4 * qd + 2], hacc[t2][4 * qd + 3]); \
        *(u32x2*)(sH + pcol * SH_STRIDE + 32 * (2 * it + t2) + 8 * qd + 4 * hh) = o_; } } while (0)
    const bool need0 = dir == 0 ? true : (it == 0);
    const bool need1 = dir == 0 ? (it == 1) : true;
    __syncthreads();
    {
      const int p0 = SCAN_PTOK(0);
      SCAN_DMA_DTX(p0);
      SCAN_DMA(p0);
      SCAN_WRITE_STATE();
    }
#define SCAN_BAR_A() do { asm volatile("s_waitcnt vmcnt(6) lgkmcnt(0)" ::: "memory"); __builtin_amdgcn_s_barrier(); asm volatile("" ::: "memory"); } while (0)
#define SCAN_BAR_LDS() do { asm volatile("s_waitcnt lgkmcnt(0)" ::: "memory"); __builtin_amdgcn_s_barrier(); asm volatile("" ::: "memory"); } while (0)
#define SCAN_BAR_MEM() do { asm volatile("s_waitcnt vmcnt(0) lgkmcnt(0)" ::: "memory"); __builtin_amdgcn_s_barrier(); asm volatile("" ::: "memory"); } while (0)
    for (int ci = 0; ci < nchunks; ++ci) {
      const int cin = ci + 1 < nchunks ? ci + 1 : ci;
      const int ptokN = SCAN_PTOK(cin);
      SCAN_BAR_A();
      float decE;
      {
        const float dtv = sDt[lane];
        const float a_ = dtv * Aval;
        const float pre = wave_incl_scan(a_);
        const float cE = __int_as_float(__builtin_amdgcn_readlane(__float_as_int(pre), 63));
        const float c = dir == 0 ? pre : cE - pre + a_;
        myW[lane] = dtv; myW[64 + lane] = c; myW[128 + lane] = __expf(c); myW[192 + lane] = dtv * __expf(cE - c);
        decE = __expf(cE);
      }
#pragma unroll
      for (int i = 0; i < 2; ++i) {
        const int q = tid + i * 256, prow = q >> 3, j8 = (q & 7) * 8;
        const u32x4 raw = *(const u32x4*)(sXd + prow * 64 + j8);
        *(u32x4*)(sXr + prow * 72 + j8) = raw;
        f32x4 f0 = *(const f32x4*)(myW + 192 + j8), f1 = *(const f32x4*)(myW + 192 + j8 + 4);
        u32x4 sc;
        sc.x = pack2(bflo(raw.x) * f0.x, bfhi(raw.x) * f0.y); sc.y = pack2(bflo(raw.y) * f0.z, bfhi(raw.y) * f0.w);
        sc.z = pack2(bflo(raw.z) * f1.x, bfhi(raw.z) * f1.y); sc.w = pack2(bflo(raw.w) * f1.z, bfhi(raw.w) * f1.w);
        *(u32x4*)(sXs + prow * 72 + j8) = sc;
      }
      SCAN_BAR_MEM();
      if (ci > 0) {
        const int ptokP = SCAN_PTOK(ci - 1);
#pragma unroll
        for (int i = 0; i < 2; ++i) {
          const int q = tid + i * 256, yrow = q >> 3, c8 = (q & 7) * 8;
          *(u32x4*)(ybuf + ((size_t)dir * T_ALL + ptokP + yrow) * 2048 + h * 64 + c8) = *(const u32x4*)(sY + yrow * 64 + c8);
        }
      }
      SCAN_DMA_DTX(ptokN);
#pragma unroll
      for (int t2 = 0; t2 < 2; ++t2) {
#pragma unroll
        for (int e = 0; e < 16; ++e) hacc[t2][e] *= decE;
        const bf16_t* xs = sXs + pcol * 72 + 8 * hh;
#pragma unroll
        for (int kk = 0; kk < 4; ++kk)
          hacc[t2] = __builtin_amdgcn_mfma_f32_32x32x16_bf16(*(const bf16x8*)(sfT + (kk * 4 + 2 * it + t2) * 512 + lane * 8), *(const bf16x8*)(xs + 16 * kk), hacc[t2], 0, 0, 0);
      }
      bf16x8 cfr[8];
#pragma unroll
      for (int kk = 0; kk < 8; ++kk) cfr[kk] = *(const bf16x8*)(sfC + (it * 8 + kk) * 512 + lane * 8);
      f32x16 acc;
#pragma unroll
      for (int e = 0; e < 16; ++e) acc[e] = 0.f;
      {
        const bf16_t* hp = sH + pcol * SH_STRIDE + 8 * hh;
#pragma unroll
        for (int kk = 0; kk < 8; ++kk) acc = __builtin_amdgcn_mfma_f32_32x32x16_bf16(cfr[kk], *(const bf16x8*)(hp + 16 * kk), acc, 0, 0, 0);
      }
      f32x16 X[2];
#pragma unroll
      for (int jt = 0; jt < 2; ++jt) {
#pragma unroll
        for (int e = 0; e < 16; ++e) X[jt][e] = 0.f;
        if (jt == 0 ? need0 : need1) {
#pragma unroll
          for (int kk = 0; kk < 8; ++kk) X[jt] = __builtin_amdgcn_mfma_f32_32x32x16_bf16(*(const bf16x8*)(sfB + (jt * 8 + kk) * 512 + lane * 8), cfr[kk], X[jt], 0, 0, 0);
        }
      }
      SCAN_BAR_LDS();
      SCAN_DMA(ptokN);
      SCAN_WRITE_STATE();
#pragma unroll
      for (int qd = 0; qd < 4; ++qd) {
        f32x4 ec = *(const f32x4*)(myW + 128 + 32 * it + 8 * qd + 4 * hh);
        acc[4 * qd] *= ec.x; acc[4 * qd + 1] *= ec.y; acc[4 * qd + 2] *= ec.z; acc[4 * qd + 3] *= ec.w;
      }
      const int icol = 32 * it + r;
      const float ci_ = myW[64 + icol];
#pragma unroll
      for (int jt = 0; jt < 2; ++jt) {
        if (jt == 0 ? need0 : need1) {
#pragma unroll
          for (int qd = 0; qd < 4; ++qd) {
            const int j0 = 32 * jt + 8 * qd + 4 * hh;
            f32x4 cj = *(const f32x4*)(myW + 64 + j0), dj = *(const f32x4*)(myW + j0);
            float cjv[4] = {cj.x, cj.y, cj.z, cj.w}, djv[4] = {dj.x, dj.y, dj.z, dj.w};
#pragma unroll
            for (int u = 0; u < 4; ++u) {
              const int j = j0 + u;
              const bool ok = dir == 0 ? (j <= icol) : (j >= icol);
              const float m = __expf(ci_ - cjv[u]) * djv[u];
              X[jt][4 * qd + u] = ok ? X[jt][4 * qd + u] * m : 0.f;
            }
          }
#pragma unroll
          for (int sk = 0; sk < 2; ++sk) {
            bf16x8 afr = pack8(X[jt][8 * sk], X[jt][8 * sk + 1], X[jt][8 * sk + 2], X[jt][8 * sk + 3], X[jt][8 * sk + 4], X[jt][8 * sk + 5], X[jt][8 * sk + 6], X[jt][8 * sk + 7]);
            const bf16_t* xp = sXr + pcol * 72 + 32 * jt + 16 * sk + 4 * hh;
            u32x2 lo = *(const u32x2*)xp, hi = *(const u32x2*)(xp + 8);
            u32x4 xv; xv.x = lo.x; xv.y = lo.y; xv.z = hi.x; xv.w = hi.y;
            acc = __builtin_amdgcn_mfma_f32_32x32x16_bf16(afr, __builtin_bit_cast(bf16x8, xv), acc, 0, 0, 0);
          }
        }
      }
      if (dir == 0) {
#pragma unroll
        for (int qd = 0; qd < 4; ++qd) {
          const u32x2 xw = *(const u32x2*)(sXr + pcol * 72 + 32 * it + 8 * qd + 4 * hh);
          acc[4 * qd] += dskip * bflo(xw.x); acc[4 * qd + 1] += dskip * bfhi(xw.x);
          acc[4 * qd + 2] += dskip * bflo(xw.y); acc[4 * qd + 3] += dskip * bfhi(xw.y);
        }
      }
      {
        bf16_t* yo = sY + (32 * it) * 64 + pcol;
#pragma unroll
        for (int e = 0; e < 16; ++e) yo[rowmap(e, hh) * 64] = f2bf(acc[e]);
      }
    }
    __syncthreads();
    {
      const int ptokP = SCAN_PTOK(nchunks - 1);
#pragma unroll
      for (int i = 0; i < 2; ++i) {
        const int q = tid + i * 256, yrow = q >> 3, c8 = (q & 7) * 8;
        *(u32x4*)(ybuf + ((size_t)dir * T_ALL + ptokP + yrow) * 2048 + h * 64 + c8) = *(const u32x4*)(sY + yrow * 64 + c8);
      }
    }
#undef SCAN_PTOK
#undef SCAN_DMA_DTX
#undef SCAN_DMA
#undef SCAN_WRITE_STATE
    if (s < 32) {
      float* ho = p.out_ssd + ((((size_t)s * 2 + slot) * 2 + dir) * 32 + h) * 8192 + (size_t)pcol * 128;
#pragma unroll
      for (int t2 = 0; t2 < 2; ++t2)
#pragma unroll
        for (int qd = 0; qd < 4; ++qd) {
          f32x4 v; v.x = hacc[t2][4 * qd]; v.y = hacc[t2][4 * qd + 1]; v.z = hacc[t2][4 * qd + 2]; v.w = hacc[t2][4 * qd + 3];
          *(f32x4*)(ho + 32 * (2 * it + t2) + 8 * qd + 4 * hh) = v;
        }
    }
    asm volatile("s_waitcnt vmcnt(0)" ::: "memory");
  }
}

__device__ __forceinline__ void phase_ssd_gate(const Params& p, int slot, int bid, int nblk, int cxw) {
  const int tidx = opaque_tid(cxw);
  bf16_t* zb = (bf16_t*)(p.scratch + SC_SSD_Z);
  const bf16_t* yfb = (const bf16_t*)(p.scratch + SC_SSD_XBC);
  const bf16_t* ybb = yfb + (size_t)T_ALL * 2048;
  const bf16_t* xbcc = (const bf16_t*)(p.scratch + SC_SSD_XBCC);
  int lane = tidx & 63, wv = cxw & 3;
  for (int row = bid * 4 + wv; row < T_ALL; row += nblk * 4) {
    float ss = 0.f;
    TokInfo ti = tokinfo(row);
    const int prow = ti.base + seqpos2off(ti.l, slot == 1 && ti.s >= 32);
#pragma unroll
    for (int j = 0; j < 4; ++j) {
      int c0 = j * 512 + lane * 8;
      u32x4 zv = *(const u32x4*)(zb + (size_t)row * 2048 + c0);
      u32x4 fv = *(const u32x4*)(yfb + (size_t)prow * 2048 + c0);
      u32x4 bv = *(const u32x4*)(ybb + (size_t)prow * 2048 + c0);
      unsigned zw[4] = {zv.x, zv.y, zv.z, zv.w}, fw[4] = {fv.x, fv.y, fv.z, fv.w}, bw[4] = {bv.x, bv.y, bv.z, bv.w};
      unsigned ow[4];
#pragma unroll
      for (int e = 0; e < 4; ++e) {
        float y0 = (bflo(fw[e]) + bflo(bw[e])) * siluf(bflo(zw[e]));
        float y1 = (bfhi(fw[e]) + bfhi(bw[e])) * siluf(bfhi(zw[e]));
        ss += y0 * y0 + y1 * y1;
        ow[e] = pack2(y0, y1);
      }
      u32x4 o; o.x = ow[0]; o.y = ow[1]; o.z = ow[2]; o.w = ow[3];
      *(u32x4*)(zb + (size_t)row * 2048 + c0) = o;
    }
    ss = wave_sum(ss);
    if (lane == 0) p.rstd[row] = rsqrtf(ss * (1.f / 2048.f) + 1e-5f);
  }
}

#define HY_UOFF (32768 + 64)
__device__ __forceinline__ void hy_stage_conv(const Params& p, const bf16_t* __restrict__ row, int ch, bf16_t* dst, int dstStride, int dstPad,
                                              int nelem, int L, int tid) {
  const float w0 = p.hy_conv_w[ch], w1 = p.hy_conv_w[3072 + ch], w2 = p.hy_conv_w[2 * 3072 + ch], bb = p.hy_conv_b[ch];
  for (int q = tid; q < nelem / 8; q += NTHR) {
    const int e0 = q * 8, b = e0 / L, t0 = e0 & (L - 1);
    u32x4 raw = *(const u32x4*)(row + e0);
    float x[10];
    x[0] = t0 > 0 ? bf2f(row[e0 - 1]) : 0.f;
    x[9] = t0 + 8 < L ? bf2f(row[e0 + 8]) : 0.f;
    x[1] = bflo(raw.x); x[2] = bfhi(raw.x); x[3] = bflo(raw.y); x[4] = bfhi(raw.y);
    x[5] = bflo(raw.z); x[6] = bfhi(raw.z); x[7] = bflo(raw.w); x[8] = bfhi(raw.w);
    float o[8];
#pragma unroll
    for (int j = 0; j < 8; ++j) o[j] = w0 * x[j] + w1 * x[j + 1] + w2 * x[j + 2] + bb;
    u32x4 ov; ov.x = pack2(o[0], o[1]); ov.y = pack2(o[2], o[3]); ov.z = pack2(o[4], o[5]); ov.w = pack2(o[6], o[7]);
    *(u32x4*)(dst + b * dstStride + dstPad + t0) = ov;
  }
}

__device__ __forceinline__ void phase_hy_longconv(const Params& p, int bid, int nblk, unsigned char* smem, int cxw) {
  const int tid = opaque_tid(cxw), lane = tid & 63, w = cxw & 3  , r = lane & 31, hh = lane >> 5;
  const bf16_t* projT = (const bf16_t*)(p.scratch + SC_HY_PROJT);
  bf16_t* yT = (bf16_t*)(p.scratch + SC_HY_YT);
  unsigned* Rc0 = (unsigned*)smem;
  unsigned* Rc1 = Rc0 + 4096 + 16;
  bf16_t* G = (bf16_t*)smem;
  bf16_t* U = (bf16_t*)(smem + HY_UOFF);
  for (int item = bid; item < 2048; item += nblk) {
    const bool lat = item < 1024;
    const int c = item & 1023;
    const int L = lat ? 4096 : 256, NB = lat ? 4 : 32, RL = lat ? 8192 : 512, Lm1 = L - 1;
    const int PAD = lat ? 224 : 0, US = lat ? 4552 : 264;
    const int tokbase = lat ? T_CTX : 0;
    const int nI = L >> 5, nelem = NB * L;
    const int TPW = lat ? 4 : 2;
    __syncthreads();
    if (lat) {
      for (int q = tid; q < 4 * 57; q += NTHR) {
        int b = q / 57, k = q % 57;
        int off = k < 28 ? k * 8 : 224 + 4096 + (k - 28) * 8;
        unsigned zz = 0u; asm volatile("" : "+v"(zz));
        u32x4 z4 = {zz, zz, zz, zz};
        *(u32x4*)(U + b * US + off) = z4;
      }
    }
    hy_stage_conv(p, projT + (size_t)c * T_ALL + tokbase, c, U, US, PAD, nelem, L, tid);
    int Icol[4], bcol[4];
#pragma unroll
    for (int tt = 0; tt < 4; ++tt) {
      int n = (w * TPW + tt) * 32 + r;
      Icol[tt] = lat ? (n >> 2) : (n >> 5);
      bcol[tt] = lat ? (n & 3) : (n & 31);
    }
    const int Ilo_w = lat ? 32 * w : 2 * w, Ihi_w = lat ? 32 * w + 31 : 2 * w + 1;
    const int dlo = Ilo_w - (nI - 1), dhi = Ihi_w;
    float invs[2], biases[2];
#pragma unroll
    for (int o2 = 0; o2 < 2; ++o2) { invs[o2] = p.knorm[((lat ? 1 : 0) * 2 + o2) * 1024 + c]; biases[o2] = p.hy_f_bias[o2 * 1024 + c]; }
    for (int order = 0; order < 2; ++order) {
      {
        const bf16_t* src = (lat ? p.rtab1 : p.rtab0) + (size_t)(order * 1024 + c) * RL;
        for (int q = tid; q < RL / 8; q += NTHR) {
          u32x4 cv = *(const u32x4*)(src + q * 8);
          unsigned nx = (q + 1 < RL / 8) ? *(const unsigned*)(src + q * 8 + 8) : 0u;
          *(u32x4*)(Rc0 + q * 4) = cv;
          u32x4 sv;
          sv.x = (cv.x >> 16) | (cv.y << 16); sv.y = (cv.y >> 16) | (cv.z << 16);
          sv.z = (cv.z >> 16) | (cv.w << 16); sv.w = (cv.w >> 16) | (nx << 16);
          *(u32x4*)(Rc1 + q * 4) = sv;
        }
      }
      __syncthreads();
      u32x2 zpre[4][4];
      if (order == 1) {
#pragma unroll
        for (int tt = 0; tt < 4; ++tt)
          if (tt < TPW) {
#pragma unroll
            for (int qd = 0; qd < 4; ++qd)
              zpre[tt][qd] = *(const u32x2*)(projT + (size_t)(3072 + c) * T_ALL + tokbase + bcol[tt] * L + 32 * Icol[tt] + 8 * qd + 4 * hh);
          }
      }
      f32x16 acc[4];
#pragma unroll
      for (int tt = 0; tt < 4; ++tt)
#pragma unroll
        for (int e = 0; e < 16; ++e) acc[tt][e] = 0.f;
      {
        int lo_t[4], hi_t[4];
        const bf16_t* ub[4];
#pragma unroll
        for (int tt = 0; tt < 4; ++tt) {
          const int tile = w * TPW + tt;
          const int Ilo_t = lat ? 8 * tile : tile, Ihi_t = lat ? 8 * tile + 7 : tile;
          lo_t[tt] = tt < TPW ? Ilo_t - (nI - 1) : 1 << 30; hi_t[tt] = tt < TPW ? Ihi_t : -(1 << 30);
          ub[tt] = U + bcol[tt] * US + PAD + 32 * Icol[tt] + 8 * hh;
        }
        const int ybase = Lm1 - r + 8 * hh;
#define LC_LOAD(T0, T1, DD0, IT, A, B) do { const int it_ = (IT); const int d_ = (DD0) + (it_ >> 1), kk_ = it_ & 1; \
          const int y0_ = ybase - 32 * d_ + 16 * kk_; const int par_ = y0_ & 1; \
          const unsigned* rp_ = (par_ ? Rc1 : Rc0) + ((y0_ - par_) >> 1); \
          u32x4 av_; av_.x = rp_[0]; av_.y = rp_[1]; av_.z = rp_[2]; av_.w = rp_[3]; A = __builtin_bit_cast(bf16x8, av_); \
          _Pragma("unroll") for (int tt = 0; tt < 4; ++tt) if (tt >= (T0) && tt < (T1)) B[tt] = *(const bf16x8*)(ub[tt] - 32 * d_ + 16 * kk_); } while (0)
#define LC_MMA(T0, T1, A, B) do { _Pragma("unroll") for (int tt = 0; tt < 4; ++tt) if (tt >= (T0) && tt < (T1)) \
          acc[tt] = __builtin_amdgcn_mfma_f32_32x32x16_bf16(A, B[tt], acc[tt], 0, 0, 0); } while (0)
#define LC_SEG(T0, T1, DD0, DD1) do { const int sd0_ = (DD0), sd1_ = (DD1); \
          if (sd1_ >= sd0_) { const int NIT_ = 2 * (sd1_ - sd0_ + 1); \
            bf16x8 a0, a1, b0[4], b1[4]; \
            LC_LOAD(T0, T1, sd0_, 0, a0, b0); \
            for (int it = 0; it < NIT_; it += 2) { \
              LC_LOAD(T0, T1, sd0_, it + 1, a1, b1); \
              __builtin_amdgcn_sched_barrier(0); \
              LC_MMA(T0, T1, a0, b0); \
              __builtin_amdgcn_sched_barrier(0); \
              LC_LOAD(T0, T1, sd0_, it + 2 < NIT_ ? it + 2 : NIT_ - 1, a0, b0); \
              __builtin_amdgcn_sched_barrier(0); \
              LC_MMA(T0, T1, a1, b1); \
              __builtin_amdgcn_sched_barrier(0); \
            } } } while (0)
        if (!lat) {
          LC_SEG(0, 1, lo_t[0], lo_t[1] - 1);
          LC_SEG(0, 2, lo_t[1], hi_t[0]);
          LC_SEG(1, 2, hi_t[0] + 1, hi_t[1]);
        } else {
          LC_SEG(0, 1, lo_t[0], lo_t[1] - 1);
          LC_SEG(0, 2, lo_t[1], lo_t[2] - 1);
          LC_SEG(0, 3, lo_t[2], lo_t[3] - 1);
          LC_SEG(0, 4, lo_t[3], hi_t[0]);
          LC_SEG(1, 4, hi_t[0] + 1, hi_t[1]);
          LC_SEG(2, 4, hi_t[1] + 1, hi_t[2]);
          LC_SEG(3, 4, hi_t[2] + 1, hi_t[3]);
        }
#undef LC_LOAD
#undef LC_MMA
#undef LC_SEG
      }
      __syncthreads();
      hy_stage_conv(p, projT + (size_t)((1 + order) * 1024 + c) * T_ALL + tokbase, (1 + order) * 1024 + c, G, L, 0, nelem, L, tid);
      __syncthreads();
      const float inv = __builtin_amdgcn_rcpf(order ? invs[1] : invs[0]);
      const float bias = order ? biases[1] : biases[0];
#pragma unroll
      for (int tt = 0; tt < 4; ++tt) {
        if (tt < TPW) {
#pragma unroll
          for (int qd = 0; qd < 4; ++qd) {
            const int t0 = 32 * Icol[tt] + 8 * qd + 4 * hh;
            bf16_t* up = U + bcol[tt] * US + PAD + t0;
            u32x2 uc = *(const u32x2*)up;
            u32x2 gg = *(const u32x2*)(G + bcol[tt] * L + t0);
            float r0 = (inv * acc[tt][4 * qd] + bias * bflo(uc.x)) * bflo(gg.x);
            float r1 = (inv * acc[tt][4 * qd + 1] + bias * bfhi(uc.x)) * bfhi(gg.x);
            float r2 = (inv * acc[tt][4 * qd + 2] + bias * bflo(uc.y)) * bflo(gg.y);
            float r3 = (inv * acc[tt][4 * qd + 3] + bias * bfhi(uc.y)) * bfhi(gg.y);
            if (order == 1) {
              const u32x2 zz = zpre[tt][qd];
              r0 *= siluf(bflo(zz.x)); r1 *= siluf(bfhi(zz.x)); r2 *= siluf(bflo(zz.y)); r3 *= siluf(bfhi(zz.y));
            }
            u32x2 ov; ov.x = pack2(r0, r1); ov.y = pack2(r2, r3);
            *(u32x2*)up = ov;
          }
        }
      }
      __syncthreads();
    }
    for (int q = tid; q < nelem / 8; q += NTHR) {
      const int e0 = q * 8, b = e0 / L, t0 = e0 & (L - 1);
      *(u32x4*)(yT + (size_t)c * T_ALL + tokbase + e0) = *(const u32x4*)(U + b * US + PAD + t0);
    }
  }
}

__device__ __forceinline__ void phase_hy_transpose(const Params& p, int bid, int nblk, unsigned char* smem, int cxw) {
  const int tid = opaque_tid(cxw);
  const bf16_t* yT = (const bf16_t*)(p.scratch + SC_HY_YT);
  bf16_t* yg = (bf16_t*)(p.scratch + SC_HY_YG);
  bf16_t* tl = (bf16_t*)smem;
  for (int item = bid; item < 16 * (T_ALL / 64); item += nblk) {
    const int cb = item & 15, tb = item >> 4;
    __syncthreads();
#pragma unroll
    for (int i = 0; i < 2; ++i) {
      int q = tid + i * 256, cr = q >> 3, t8 = (q & 7) * 8;
      u32x4 v = *(const u32x4*)(yT + (size_t)(cb * 64 + cr) * T_ALL + tb * 64 + t8);
      unsigned wv[4] = {v.x, v.y, v.z, v.w};
#pragma unroll
      for (int e = 0; e < 4; ++e) {
        tl[(t8 + 2 * e) * 72 + cr] = (bf16_t)(wv[e] & 0xffffu);
        tl[(t8 + 2 * e + 1) * 72 + cr] = (bf16_t)(wv[e] >> 16);
      }
    }
    __syncthreads();
#pragma unroll
    for (int i = 0; i < 2; ++i) {
      int q = tid + i * 256, tr = q >> 3, c8 = (q & 7) * 8;
      *(u32x4*)(yg + (size_t)(tb * 64 + tr) * 1024 + cb * 64 + c8) = *(const u32x4*)(tl + tr * 72 + c8);
    }
  }
}

#define LRU_NCH 384
struct Lru4 { float af[4], bxf[4], ab[4], bxb[4]; };
__device__ __forceinline__ void lru_unpack4(u32x2 v, float (&o)[4]) { o[0] = bflo(v.x); o[1] = bfhi(v.x); o[2] = bflo(v.y); o[3] = bfhi(v.y); }
__device__ __forceinline__ void lru_row_f(const bf16_t* gates, const bf16_t* xc, size_t o, const float (&spf)[4], float (&af)[4], float (&bxf)[4]) {
  float r[4], g[4], x[4];
  lru_unpack4(*(const u32x2*)(gates + o), r); lru_unpack4(*(const u32x2*)(gates + (size_t)T_ALL * 1024 + o), g); lru_unpack4(*(const u32x2*)(xc + o), x);
#pragma unroll
  for (int e = 0; e < 4; ++e) { const float la = -8.f * r[e] * spf[e]; af[e] = __expf(la); bxf[e] = sqrtf(fmaxf(1.f - __expf(2.f * la), 0.f)) * g[e] * x[e]; }
}
__device__ __forceinline__ void lru_row_b(const bf16_t* gates, const bf16_t* xc, size_t o, const float (&spb)[4], float (&ab)[4], float (&bxb)[4]) {
  float r[4], g[4], x[4];
  lru_unpack4(*(const u32x2*)(gates + (size_t)2 * T_ALL * 1024 + o), r); lru_unpack4(*(const u32x2*)(gates + (size_t)3 * T_ALL * 1024 + o), g); lru_unpack4(*(const u32x2*)(xc + o), x);
#pragma unroll
  for (int e = 0; e < 4; ++e) { const float la = -8.f * r[e] * spb[e]; ab[e] = __expf(la); bxb[e] = sqrtf(fmaxf(1.f - __expf(2.f * la), 0.f)) * g[e] * x[e]; }
}
__device__ __forceinline__ void phase_lru_scan_agg(const Params& p, int bid, int nblk, unsigned char* smem, int cxw) {
  const int tidx = opaque_tid(cxw);
  const bf16_t* gates = (const bf16_t*)(p.scratch + SC_LRU_GATES);
  const bf16_t* xc = (const bf16_t*)(p.scratch + SC_LRU_XC);
  float* sagg = (float*)smem;
  const int sub = cxw & 3, cq = tidx & 63;
  for (int item = bid; item < LRU_NCH * 4; item += nblk) {
    const int chunk = item >> 2, cb = item & 3;
    const int c0 = cb * 256 + 4 * cq;
    float spf[4], spb[4];
#pragma unroll
    for (int e = 0; e < 4; ++e) { spf[e] = softplusf(-p.lru_a_param[c0 + e]); spb[e] = softplusf(-p.lru_a_param[1024 + c0 + e]); }
    const int tok0 = chunk * 64 + 16 * sub;
    float Af[4] = {1.f, 1.f, 1.f, 1.f}, hf[4] = {0.f, 0.f, 0.f, 0.f}, Pb[4] = {1.f, 1.f, 1.f, 1.f}, Bb[4] = {0.f, 0.f, 0.f, 0.f};
#pragma unroll 8
    for (int j = 0; j < 16; ++j) {
      const size_t o = (size_t)(tok0 + j) * 1024 + c0;
      float af[4], bxf[4], ab[4], bxb[4];
      lru_row_f(gates, xc, o, spf, af, bxf);
      lru_row_b(gates, xc, o, spb, ab, bxb);
#pragma unroll
      for (int e = 0; e < 4; ++e) { hf[e] = af[e] * hf[e] + bxf[e]; Af[e] *= af[e]; Bb[e] += bxb[e] * Pb[e]; Pb[e] *= ab[e]; }
    }
    {
      const size_t sc = (size_t)chunk * 4 + sub;
      float* gf = p.lru_sagg + (((size_t)0 * (LRU_NCH * 4) + sc) * 1024 + c0) * 2;
      float* gb = p.lru_sagg + (((size_t)1 * (LRU_NCH * 4) + sc) * 1024 + c0) * 2;
      f32x4 v0 = {Af[0], hf[0], Af[1], hf[1]}, v1 = {Af[2], hf[2], Af[3], hf[3]};
      f32x4 w0 = {Pb[0], Bb[0], Pb[1], Bb[1]}, w1 = {Pb[2], Bb[2], Pb[3], Bb[3]};
      *(f32x4*)gf = v0; *(f32x4*)(gf + 4) = v1; *(f32x4*)gb = w0; *(f32x4*)(gb + 4) = w1;
      __syncthreads();
      float* sl = sagg + (sub * 64 + cq) * 16;
      *(f32x4*)sl = v0; *(f32x4*)(sl + 4) = v1; *(f32x4*)(sl + 8) = w0; *(f32x4*)(sl + 12) = w1;
      __syncthreads();
    }
    if (sub == 0) {
      float A[4], B[4], P[4], Q[4];
#pragma unroll
      for (int e = 0; e < 4; ++e) { A[e] = 1.f; B[e] = 0.f; P[e] = 1.f; Q[e] = 0.f; }
#pragma unroll
      for (int s2 = 0; s2 < 4; ++s2) {
        const float* lf = sagg + (s2 * 64 + cq) * 16;
        const float* lb = sagg + ((3 - s2) * 64 + cq) * 16 + 8;
#pragma unroll
        for (int e = 0; e < 4; ++e) {
          const float a = lf[2 * e], b = lf[2 * e + 1];
          B[e] = a * B[e] + b; A[e] *= a;
          const float pb = lb[2 * e], qb = lb[2 * e + 1];
          Q[e] = pb * Q[e] + qb; P[e] *= pb;
        }
      }
      float* gf = p.lru_agg + (((size_t)0 * LRU_NCH + chunk) * 1024 + c0) * 2;
      float* gb = p.lru_agg + (((size_t)1 * LRU_NCH + chunk) * 1024 + c0) * 2;
      f32x4 v0 = {A[0], B[0], A[1], B[1]}, v1 = {A[2], B[2], A[3], B[3]}, w0 = {P[0], Q[0], P[1], Q[1]}, w1 = {P[2], Q[2], P[3], Q[3]};
      *(f32x4*)gf = v0; *(f32x4*)(gf + 4) = v1; *(f32x4*)gb = w0; *(f32x4*)(gb + 4) = w1;
    }
  }
}
__device__ __forceinline__ void phase_lru_scan_carry(const Params& p, int bid, int nblk, int cxw) {
  const int tidx = opaque_tid(cxw);
  for (int item = bid; item < 36 * 8; item += nblk) {
    int s = item >> 3, dir = (item >> 2) & 1, cb = item & 3;
    int c = cb * 256 + tidx;
    int nch = s < 32 ? 4 : 64;
    int ch0 = s < 32 ? s * 4 : 128 + (s - 32) * 64;
    float h = s < 32 ? 0.f : p.state_lru[((size_t)(s - 32) * 2 + dir) * 1024 + c];
    for (int k0 = 0; k0 < nch; k0 += 4) {
      f32x2_t ag[4]; size_t idx[4];
#pragma unroll
      for (int u = 0; u < 4; ++u) {
        const int chunk = dir ? ch0 + nch - 1 - (k0 + u) : ch0 + k0 + u;
        idx[u] = ((size_t)dir * LRU_NCH + chunk) * 1024 + c;
        ag[u] = *(const f32x2_t*)(p.lru_agg + idx[u] * 2);
      }
#pragma unroll
      for (int u = 0; u < 4; ++u) { p.lru_hin[idx[u]] = h; h = ag[u].x * h + ag[u].y; }
    }
    if (s < 32) p.out_lru[((size_t)s * 2 + dir) * 1024 + c] = h;
  }
}
__device__ __forceinline__ void phase_lru_scan_final(const Params& p, int bid, int nblk, unsigned char* smem, int cxw) {
  const int tidx = opaque_tid(cxw);
  const bf16_t* gates = (const bf16_t*)(p.scratch + SC_LRU_GATES);
  const bf16_t* xc = (const bf16_t*)(p.scratch + SC_LRU_XC);
  const bf16_t* proj = (const bf16_t*)(p.scratch + SC_LRU_PROJ);
  bf16_t* yg = (bf16_t*)(p.scratch + SC_LRU_YG);
  const int sub = cxw & 3, cq = tidx & 63;
  for (int item = bid; item < LRU_NCH * 4; item += nblk) {
    const int chunk = item >> 2, cb = item & 3;
    const int c0 = cb * 256 + 4 * cq;
    float spf[4], spb[4];
#pragma unroll
    for (int e = 0; e < 4; ++e) { spf[e] = softplusf(-p.lru_a_param[c0 + e]); spb[e] = softplusf(-p.lru_a_param[1024 + c0 + e]); }
    float hf[4], hb[4];
    {
      const f32x4 a = *(const f32x4*)(p.lru_hin + ((size_t)0 * LRU_NCH + chunk) * 1024 + c0);
      const f32x4 b = *(const f32x4*)(p.lru_hin + ((size_t)1 * LRU_NCH + chunk) * 1024 + c0);
      hf[0] = a.x; hf[1] = a.y; hf[2] = a.z; hf[3] = a.w; hb[0] = b.x; hb[1] = b.y; hb[2] = b.z; hb[3] = b.w;
    }
#pragma unroll
    for (int s2 = 0; s2 < 3; ++s2) {
      if (s2 < sub) {
        const float* g = p.lru_sagg + (((size_t)0 * (LRU_NCH * 4) + (size_t)chunk * 4 + s2) * 1024 + c0) * 2;
        const f32x4 v0 = *(const f32x4*)g, v1 = *(const f32x4*)(g + 4);
        hf[0] = v0.x * hf[0] + v0.y; hf[1] = v0.z * hf[1] + v0.w; hf[2] = v1.x * hf[2] + v1.y; hf[3] = v1.z * hf[3] + v1.w;
      }
      if (3 - s2 > sub) {
        const float* g = p.lru_sagg + (((size_t)1 * (LRU_NCH * 4) + (size_t)chunk * 4 + (3 - s2)) * 1024 + c0) * 2;
        const f32x4 v0 = *(const f32x4*)g, v1 = *(const f32x4*)(g + 4);
        hb[0] = v0.x * hb[0] + v0.y; hb[1] = v0.z * hb[1] + v0.w; hb[2] = v1.x * hb[2] + v1.y; hb[3] = v1.z * hb[3] + v1.w;
      }
    }
    const int tok0 = chunk * 64 + 16 * sub;
    float hfs[16][4];
#pragma unroll
    for (int j = 0; j < 16; ++j) {
      const size_t o = (size_t)(tok0 + j) * 1024 + c0;
      float af[4], bxf[4];
      lru_row_f(gates, xc, o, spf, af, bxf);
#pragma unroll
      for (int e = 0; e < 4; ++e) { hf[e] = af[e] * hf[e] + bxf[e]; hfs[j][e] = hf[e]; }
    }
#pragma unroll
    for (int j = 15; j >= 0; --j) {
      const size_t o = (size_t)(tok0 + j) * 1024 + c0;
      float ab[4], bxb[4], z[4];
      lru_row_b(gates, xc, o, spb, ab, bxb);
      lru_unpack4(*(const u32x2*)(proj + (size_t)(tok0 + j) * 2048 + 1024 + c0), z);
      float y[4];
#pragma unroll
      for (int e = 0; e < 4; ++e) { hb[e] = ab[e] * hb[e] + bxb[e]; y[e] = (hfs[j][e] + hb[e]) * siluf(z[e]); }
      u32x2 ov; ov.x = pack2(y[0], y[1]); ov.y = pack2(y[2], y[3]);
      *(u32x2*)(yg + o) = ov;
    }
  }
}

enum { PH_PREP = 0, PH_MOD, PH_HYA, PH_HYB, PH_LNMOD, PH_INPROJ, PH_MIX1, PH_MIX2, PH_MIX3, PH_MIX4, PH_MIX5, PH_MIX6, PH_OUTPROJ };

struct Ctx { int bid, nblk, wave; unsigned char* smem; unsigned char* wg_smem; };

template <class Epi>
__device__ __forceinline__ void run_gemm(const Ctx& cx, const bf16_t* A, int lda, const bf16_t* Bt, int M, int N, int K, int grp_shift, int grp_bytes, const Epi& e) {
  pg8::Gemm g{A, Bt, M, N, K, lda, grp_shift, grp_bytes};
  pg8::StaticOrder S; S.init(M, N, gridDim.x, opaque_s(blockIdx.x));
  pg8::gemm_phase((PG8_LAS unsigned char*)cx.wg_smem, g, S, e, cx.wave);
}

#define N_PARAM_WORDS (sizeof(Params) / 8)
__device__ __forceinline__ Params load_params(const unsigned char* lp) {
  Params p;
  unsigned long long* d = (unsigned long long*)&p;
  const unsigned long long* sp = (const unsigned long long*)lp;
#pragma unroll
  for (int i = 0; i < (int)N_PARAM_WORDS; ++i) {
    const unsigned long long v = sp[i];
    const unsigned lo = __builtin_amdgcn_readfirstlane((unsigned)v), hi = __builtin_amdgcn_readfirstlane((unsigned)(v >> 32));
    __attribute__((address_space(1))) char* gp = (__attribute__((address_space(1))) char*)(((unsigned long long)hi << 32) | lo);
    d[i] = (unsigned long long)(char*)gp;
  }
  return p;
}
__device__ __forceinline__ void run_phase(const unsigned char* lparams, int ph, int layer, const Ctx& cx) {
  const Params p = load_params(lparams);
  const int kind = layer % 3, slot = layer / 3;
  const int bid = opaque_s(cx.bid), nblk = cx.nblk;
  unsigned char* smem = cx.smem;
  switch (ph) {
    case PH_PREP: phase_prep(p, bid, nblk, smem, cx.wave); break;
    case PH_MOD: phase_mod(p, bid, nblk, smem, cx.wave); break;
    case PH_HYA: phase_hyfilt_a(p, bid, nblk, smem, cx.wave); break;
    case PH_HYB: phase_hyfilt_b(p, bid, nblk, smem, cx.wave); break;
    case PH_LNMOD: phase_lnmod(p, layer, bid, nblk, cx.wave); break;
    case PH_INPROJ:
      if (kind == 0) {
        pg8::EpiSsdIn e{(bf16_t*)(p.scratch + SC_SSD_Z), (bf16_t*)(p.scratch + SC_SSD_XBC), (float*)(p.scratch + SC_SSD_DT), p.ssd_dt_bias + slot * 64};
        run_gemm(cx, p.hbuf, 1024, p.wt_ssd_in + (size_t)slot * 6400 * 1024, T_ALL, 6400, 1024, 30, 0, e);
      } else if (kind == 1) {
        pg8::EpiBf16 e{(bf16_t*)(p.scratch + SC_HY_PROJT), (size_t)T_ALL};
        run_gemm(cx, p.wt_hy_in, 1024, p.hbuf, 4096, T_ALL, 1024, 30, 0, e);
      } else {
        pg8::EpiBf16 e{(bf16_t*)(p.scratch + SC_LRU_PROJ), (size_t)2048};
        run_gemm(cx, p.hbuf, 1024, p.wt_lru_in, T_ALL, 2048, 1024, 30, 0, e);
      }
      break;
    case PH_MIX1:
      if (kind == 0) phase_ssd_conv(p, slot, slot == 1, bid, nblk, smem, cx.wave);
      else if (kind == 1) phase_hy_longconv(p, bid, nblk, smem, cx.wave);
      else phase_dwconv<4, false>((const bf16_t*)(p.scratch + SC_LRU_PROJ), 2048, (bf16_t*)(p.scratch + SC_LRU_XC), 1024, 1024,
                                  p.lru_conv_w, p.lru_conv_b, false, bid, nblk, cx.wave);
      break;
    case PH_MIX2:
      if (kind == 0) phase_ssd_scan(p, slot, slot == 1, bid, nblk, cx.wg_smem, cx.wave);
      else if (kind == 1) phase_hy_transpose(p, bid, nblk, smem, cx.wave);
      else {
        pg8::EpiLruGate e{(bf16_t*)(p.scratch + SC_LRU_GATES), p.lru_gate_b};
        run_gemm(cx, (const bf16_t*)(p.scratch + SC_LRU_XC), 1024, p.wt_lru_gate, T_ALL, 4096, 256, 2, 512, e);
      }
      break;
    case PH_MIX3:
      if (kind == 0) phase_ssd_gate(p, slot, bid, nblk, cx.wave);
      else phase_lru_scan_agg(p, bid, nblk, smem, cx.wave);
      break;
    case PH_MIX4: if (kind == 2) phase_lru_scan_carry(p, bid, nblk, cx.wave); break;
    case PH_MIX5: if (kind == 2) phase_lru_scan_final(p, bid, nblk, smem, cx.wave); break;
    case PH_OUTPROJ: {
      const float* mv = p.modv + (size_t)layer * 5 * 3072;
      if (kind == 0) {
        pg8::EpiOut e{p.resb, mv, p.rstd};
        run_gemm(cx, (const bf16_t*)(p.scratch + SC_SSD_Z), 2048, p.wt_ssd_out + (size_t)slot * 1024 * 2048, T_ALL, 1024, 2048, 30, 0, e);
      } else if (kind == 1) {
        pg8::EpiOut e{p.resb, mv, nullptr};
        run_gemm(cx, (const bf16_t*)(p.scratch + SC_HY_YG), 1024, p.wt_hy_out, T_ALL, 1024, 1024, 30, 0, e);
      } else {
        pg8::EpiOut e{p.resb, mv, nullptr};
        run_gemm(cx, (const bf16_t*)(p.scratch + SC_LRU_YG), 1024, p.wt_lru_out, T_ALL, 1024, 1024, 30, 0, e);
      }
    } break;
  }
}

__global__ void __launch_bounds__(WG_THREADS, 2) k_mega(Params p) {
  __shared__ __attribute__((aligned(16))) unsigned char smem[WG_SMEM + 16 + 512];
  cg::grid_group grid = cg::this_grid();
  const int wave0 = __builtin_amdgcn_readfirstlane((int)(threadIdx.x >> 6));
  const int vb = wave0 >> 2;
  Ctx cx;
  cx.wave = wave0;
  cx.bid = 2 * blockIdx.x + vb; cx.nblk = 2 * gridDim.x; cx.smem = smem + vb * SMEM_BYTES; cx.wg_smem = smem;
  volatile LAS unsigned* xst = (volatile LAS unsigned*)(smem + WG_SMEM);
  unsigned char* lparams = smem + WG_SMEM + 16;
  if (threadIdx.x == 0) { xst[0] = 0u; xst[1] = 0u; *(Params*)lparams = p; }
  __syncthreads();
  const XcdBarrier xb = xcd_barrier_post(p.bar, xst);
  run_phase(lparams, PH_PREP, 0, cx);
  run_phase(lparams, PH_MOD, 0, cx);
  run_phase(lparams, PH_HYA, 0, cx);
  if (p.bar == nullptr) grid.sync();
  xcd_barrier(xb, cx.wave);
  run_phase(lparams, PH_HYB, 0, cx);
  for (int layer = 0; layer < 4; ++layer) {
    const int kind = layer % 3;
    run_phase(lparams, PH_LNMOD, layer, cx);
    xcd_barrier(xb, cx.wave);
    run_phase(lparams, PH_INPROJ, layer, cx);
    xcd_barrier(xb, cx.wave);
    run_phase(lparams, PH_MIX1, layer, cx);
    xcd_barrier(xb, cx.wave);
    run_phase(lparams, PH_MIX2, layer, cx);
    xcd_barrier(xb, cx.wave);
    if (kind != 1) {
      run_phase(lparams, PH_MIX3, layer, cx);
      xcd_barrier(xb, cx.wave);
    }
    if (kind == 2) {
      run_phase(lparams, PH_MIX4, layer, cx);
      xcd_barrier(xb, cx.wave);
      run_phase(lparams, PH_MIX5, layer, cx);
      xcd_barrier(xb, cx.wave);
    }
    run_phase(lparams, PH_OUTPROJ, layer, cx);
    xcd_barrier(xb, cx.wave);
  }
  run_phase(lparams, PH_LNMOD, 4, cx);
}

static inline size_t align_up(size_t x) { return (x + 255) & ~(size_t)255; }

extern "C" void kernel_launch(void* const* d_in, const int* in_sizes, int n_in, void* d_out, int out_size, void* d_ws, size_t ws_size,
                              hipStream_t stream) {
  Params p{};
  const float** fp = (const float**)&p;
  for (int i = 0; i < 36; ++i) fp[i] = (const float*)d_in[i];
  float* out = (float*)d_out;
  p.xres = out;
  p.out_ssd = out + (size_t)T_ALL * 1024;
  p.out_lru = p.out_ssd + (size_t)32 * 2 * 2 * 32 * 64 * 128;
  unsigned char* w = (unsigned char*)d_ws;
  size_t off = 0;
  auto carve = [&](size_t bytes) { unsigned char* r = w + off; off = align_up(off + bytes); return r; };
  p.wt_ssd_in = (bf16_t*)carve((size_t)2 * 6400 * 1024 * 2);
  p.wt_ssd_out = (bf16_t*)carve((size_t)2 * 1024 * 2048 * 2);
  p.wt_hy_in = (bf16_t*)carve((size_t)4096 * 1024 * 2);
  p.wt_hy_out = (bf16_t*)carve((size_t)1024 * 1024 * 2);
  p.wt_lru_in = (bf16_t*)carve((size_t)2048 * 1024 * 2);
  p.wt_lru_out = (bf16_t*)carve((size_t)1024 * 1024 * 2);
  p.wt_lru_gate = (bf16_t*)carve((size_t)4 * 1024 * 256 * 2);
  p.modv = (float*)carve((size_t)4 * 5 * 3072 * 4);
  p.hdn2 = (float*)carve((size_t)4352 * 64 * 4);
  p.rtab0 = (bf16_t*)carve((size_t)2 * 1024 * 512 * 2);
  p.rtab1 = (bf16_t*)carve((size_t)2 * 1024 * 8192 * 2);
  p.knorm = (float*)carve((size_t)4 * 1024 * 4);
  p.hbuf = (bf16_t*)carve((size_t)T_ALL * 1024 * 2);
  p.rstd = (float*)carve((size_t)T_ALL * 4);
  p.resb = (bf16_t*)carve((size_t)T_ALL * 1024 * 2);
  p.lru_agg = (float*)carve((size_t)2 * 384 * 1024 * 2 * 4);
  p.lru_hin = (float*)carve((size_t)2 * 384 * 1024 * 4);
  p.lru_sagg = (float*)carve((size_t)2 * 1536 * 1024 * 2 * 4);
  p.bar = (unsigned*)carve((size_t)XCD_BAR_WORDS * 4);
  p.scratch = carve(SC_TOTAL);
  if (off > ws_size) return;

  static int grid_blocks = 0;
  if (!grid_blocks) {
    int dev = 0, cus = 0, per_cu = 0;
    hipGetDevice(&dev);
    hipDeviceGetAttribute(&cus, hipDeviceAttributeMultiprocessorCount, dev);
    hipOccupancyMaxActiveBlocksPerMultiprocessor(&per_cu, k_mega, WG_THREADS, 0);
    if (per_cu > 1) per_cu = 1;
    grid_blocks = cus * per_cu;
  }
  hipMemsetAsync(p.bar, 0, (size_t)XCD_BAR_WORDS * 4, stream);
  void* args[] = {&p};
  hipError_t e = hipLaunchCooperativeKernel((void*)k_mega, dim3(grid_blocks), dim3(WG_THREADS), args, 0, stream);
  if (e != hipSuccess) fprintf(stderr, "cooperative launch failed: %s (grid %d)\n", hipGetErrorString(e), grid_blocks);
}
```

```cpp
#include <hip/hip_runtime.h>
#include <hip/hip_bf16.h>
#include <hip/hip_cooperative_groups.h>
#include <stdint.h>
#include <cstdio>
namespace cg = cooperative_groups;

typedef unsigned short bf16_t;
typedef __attribute__((ext_vector_type(8))) short bf16x8;
typedef __attribute__((ext_vector_type(16))) float f32x16;
typedef __attribute__((ext_vector_type(4))) unsigned int u32x4;
typedef __attribute__((ext_vector_type(2))) unsigned int u32x2;
typedef __attribute__((ext_vector_type(4))) float f32x4;
typedef float f32x4_t __attribute__((ext_vector_type(4)));
typedef float f32x2_t __attribute__((ext_vector_type(2)));

#define T_CTX 8192
#define T_ALL 24576
#define DM 1024
#define NTHR 256
#define SMEM_BYTES 69632
#define WG_THREADS 512
#define WG_SMEM 162304
#define ALPHA_RES 1.6817928305074290f
#define LN_EPS 1e-5f

__device__ __forceinline__ bf16_t f2bf(float f) { __bf16 h = (__bf16)f; return __builtin_bit_cast(bf16_t, h); }
__device__ __forceinline__ float bf2f(bf16_t b) { return __uint_as_float(((unsigned)b) << 16); }
__device__ __forceinline__ float bflo(unsigned w) { return __uint_as_float(w << 16); }
__device__ __forceinline__ float bfhi(unsigned w) { return __uint_as_float(w & 0xffff0000u); }
typedef __bf16 bf16v2_t __attribute__((ext_vector_type(2)));
typedef float f32v2_t __attribute__((ext_vector_type(2)));
__device__ __forceinline__ unsigned pack2(float a, float b) { f32v2_t v = {a, b}; bf16v2_t h = __builtin_convertvector(v, bf16v2_t); return __builtin_bit_cast(unsigned, h); }
__device__ __forceinline__ float siluf(float x) { return x * __builtin_amdgcn_rcpf(1.f + __expf(-x)); }
__device__ __forceinline__ float sigmoidf(float x) { return __builtin_amdgcn_rcpf(1.f + __expf(-x)); }
__device__ __forceinline__ float softplusf(float x) { return x > 20.f ? x : __logf(1.f + __expf(x)); }


__device__ __forceinline__ int opaque_lane() { int z = 0; asm volatile("" : "+v"(z)); return __builtin_amdgcn_mbcnt_hi(~0u, __builtin_amdgcn_mbcnt_lo(~0u, (unsigned)z)); }
__device__ __forceinline__ int opaque_tid512(int wave) { return (wave << 6) + opaque_lane(); }
__device__ __forceinline__ int opaque_tid(int wave) { return opaque_tid512(wave) & 255; }

#define XB_TMO      128
#define XB_XCNT(j)  (256  + 64 * (j))
#define XB_XSUB(j)  (1280 + 64 * (j))
#define XB_XGEN(j)  (2304 + 64 * (j))
#define XB_TOP      3328
#define XB_TOPGEN   3392
#define XCD_BAR_WORDS 3456
#define XB_SPIN_CAP (1u << 23)
#define LAS __attribute__((address_space(3)))
__device__ __forceinline__ unsigned xb_ld(unsigned* p)              { return __hip_atomic_load(p, __ATOMIC_RELAXED, __HIP_MEMORY_SCOPE_AGENT); }
__device__ __forceinline__ unsigned xb_add(unsigned* p, unsigned v) { return __hip_atomic_fetch_add(p, v, __ATOMIC_RELAXED, __HIP_MEMORY_SCOPE_AGENT); }
__device__ __forceinline__ unsigned xb_xcc_id() { return (unsigned)__builtin_amdgcn_s_getreg((3 << 11) | 20) & 0xFu; }
#define XB_SPIN(cond, bar) do { unsigned _sp = 0; while (cond) { __builtin_amdgcn_s_sleep(1); \
    if ((++_sp & 255u) == 0u) { if (xb_ld(&(bar)[XB_TMO])) break; if (_sp > XB_SPIN_CAP) { atomicAdd(&(bar)[XB_TMO], 1u); break; } } } } while (0)
struct XcdBarrier { const unsigned char* lparams; unsigned boff; volatile LAS unsigned* st; };
__device__ __forceinline__ XcdBarrier xcd_barrier_post(unsigned* bar, const unsigned char* lparams, unsigned boff, volatile LAS unsigned* st) {
  XcdBarrier b; b.lparams = lparams; b.boff = boff; b.st = st;
  if (threadIdx.x == 0) (void)xb_add(&bar[XB_XCNT(xb_xcc_id())], 1u);
  return b;
}
__device__ __forceinline__ void xcd_barrier_complete(unsigned* bar, unsigned x, unsigned& nloc, unsigned& nx) {
  const unsigned G = gridDim.x * gridDim.y * gridDim.z;
  unsigned sum, cnt, mine, sp = 0u;
  for (;;) {
    sum = 0u; cnt = 0u; mine = 0u;
#pragma unroll
    for (unsigned j = 0; j < 16; ++j) { const unsigned c = xb_ld(&bar[XB_XCNT(j)]); sum += c; cnt += (c > 0u) ? 1u : 0u; mine = (j == x) ? c : mine; }
    if (sum == G) break;
    __builtin_amdgcn_s_sleep(1);
    if ((++sp & 255u) == 0u) { if (xb_ld(&bar[XB_TMO])) break; if (sp > XB_SPIN_CAP) { atomicAdd(&bar[XB_TMO], 1u); break; } }
  }
  nloc = mine > 0u ? mine : 1u; nx = cnt > 0u ? cnt : 1u;
}
__device__ __forceinline__ void xcd_barrier(const XcdBarrier& b, int wave) {
  asm volatile("s_waitcnt vmcnt(0)" ::: "memory");
  __syncthreads();
  if (opaque_tid512(wave) == 0) {
    unsigned* bar;
    {
      const unsigned long long v = *(const unsigned long long*)(b.lparams + b.boff);
      const unsigned lo = __builtin_amdgcn_readfirstlane((unsigned)v), hi = __builtin_amdgcn_readfirstlane((unsigned)(v >> 32));
      __attribute__((address_space(1))) char* gp = (__attribute__((address_space(1))) char*)(((unsigned long long)hi << 32) | lo);
      bar = (unsigned*)(char*)gp;
    }
    unsigned bx = xb_xcc_id(); asm volatile("" : "+s"(bx));
    __builtin_amdgcn_s_waitcnt(0);
    unsigned nloc = b.st[0], nx = b.st[1];
    if (nloc == 0u) { xcd_barrier_complete(bar, bx, nloc, nx); b.st[0] = nloc; b.st[1] = nx; }
    const unsigned old = xb_add(&bar[XB_XSUB(bx)], 1u);
    const unsigned gen = old / nloc;
    if (old + 1u == (gen + 1u) * nloc) {
      __builtin_amdgcn_fence(__ATOMIC_RELEASE, "agent");
      asm volatile("s_waitcnt vmcnt(0)" ::: "memory");
      const unsigned og = xb_add(&bar[XB_TOP], 1u);
      const unsigned tg = og / nx;
      if (og + 1u == (tg + 1u) * nx) xb_add(&bar[XB_TOPGEN], 1u);
      else XB_SPIN(xb_ld(&bar[XB_TOPGEN]) == tg, bar);
      __builtin_amdgcn_fence(__ATOMIC_ACQUIRE, "agent");
      xb_add(&bar[XB_XGEN(bx)], 1u);
      asm volatile("s_waitcnt vmcnt(0)" ::: "memory");
    } else {
      XB_SPIN(xb_ld(&bar[XB_XGEN(bx)]) == gen, bar);
      __builtin_amdgcn_fence(__ATOMIC_ACQUIRE, "agent");
      asm volatile("s_waitcnt vmcnt(0)" ::: "memory");
    }
  }
  __syncthreads();
}


__device__ __forceinline__ void sub_barrier(unsigned* ctr, unsigned n, int wave) {
  asm volatile("s_waitcnt vmcnt(0)" ::: "memory");
  __syncthreads();
  if (opaque_tid512(wave) == 0) {
    __builtin_amdgcn_fence(__ATOMIC_RELEASE, "agent");
    asm volatile("s_waitcnt vmcnt(0)" ::: "memory");
    (void)xb_add(ctr, 1u);
    unsigned sp = 0u;
    while (xb_ld(ctr) < n) { __builtin_amdgcn_s_sleep(2); if (++sp > XB_SPIN_CAP) break; }
    __builtin_amdgcn_fence(__ATOMIC_ACQUIRE, "agent");
    asm volatile("s_waitcnt vmcnt(0)" ::: "memory");
  }
  __syncthreads();
}
#define XB_CTXDONE 160
#define XB_CTXDONE2 192

__device__ __forceinline__ int opaque_s(int x) { asm volatile("" : "+s"(x)); return x; }

#define VB_DECL(wg_bar) volatile LAS unsigned* vctr = (volatile LAS unsigned*)((wg_bar) + 2 + (cxw >> 2)); unsigned vtarget = 0u; \
  if (tid == 0) *vctr = 0u; \
  __syncthreads()
#define VB_SYNC() do { asm volatile("s_waitcnt lgkmcnt(0)" ::: "memory"); vtarget += 4u; \
    if ((tid & 63) == 0) (void)__hip_atomic_fetch_add((LAS unsigned*)vctr, 1u, __ATOMIC_RELAXED, __HIP_MEMORY_SCOPE_WORKGROUP); \
    while (*vctr < vtarget) __builtin_amdgcn_s_sleep(1); \
    asm volatile("" ::: "memory"); } while (0)

__device__ __forceinline__ float shfl_idx_f(float v, int src) { return __int_as_float(__builtin_amdgcn_ds_bpermute(src << 2, __float_as_int(v))); }
__device__ __forceinline__ float shfl_xor_f(float v, int off, int lane) { return shfl_idx_f(v, lane ^ off); }

__device__ __forceinline__ float wave_incl_scan(float v) {
#define DPP_ADD(ctrl, rmask) v += __int_as_float(__builtin_amdgcn_update_dpp(0, __float_as_int(v), ctrl, rmask, 0xf, false))
  DPP_ADD(0x111, 0xf); DPP_ADD(0x112, 0xf); DPP_ADD(0x114, 0xf); DPP_ADD(0x118, 0xf);
  DPP_ADD(0x142, 0xa); DPP_ADD(0x143, 0xc);
#undef DPP_ADD
  return v;
}

__device__ __forceinline__ float wave_sum(float v) { return __int_as_float(__builtin_amdgcn_readlane(__float_as_int(wave_incl_scan(v)), 63)); }

struct TokInfo { int s, l, L, base, mrow; };
__device__ __forceinline__ TokInfo tokinfo(int tok) {
  TokInfo t;
  if (tok < T_CTX) { t.s = tok >> 8; t.l = tok & 255; t.L = 256; t.base = tok & ~255; t.mrow = 0; }
  else { int u = tok - T_CTX; t.s = 32 + (u >> 12); t.l = u & 4095; t.L = 4096; t.base = T_CTX + (u & ~4095); t.mrow = 1 + (u >> 12); }
  return t;
}
__device__ __forceinline__ int seqpos2off(int pos, bool cm) { return cm ? (((pos & 63) << 6) | (pos >> 6)) : pos; }

struct Params {
  const float *x_prompt, *x_sample, *state_ssd, *state_lru, *c, *c_ctx, *mod_w, *mod_b, *ln_g, *ln_b;
  const float *ssd_in_w, *ssd_conv_w, *ssd_conv_b, *ssd_dt_bias, *ssd_a_log, *ssd_d, *ssd_norm_g, *ssd_out_w;
  const float *hy_in_w, *hy_conv_w, *hy_conv_b, *hy_f_w1, *hy_f_b1, *hy_f_w2, *hy_f_b2, *hy_f_w3, *hy_f_freq, *hy_f_bias, *hy_out_w;
  const float *lru_in_w, *lru_conv_w, *lru_conv_b, *lru_gate_w, *lru_gate_b, *lru_a_param, *lru_out_w;
  float *xres, *out_ssd, *out_lru;
  bf16_t *wt_ssd_in, *wt_ssd_out, *wt_hy_in, *wt_hy_out, *wt_lru_in, *wt_lru_out, *wt_lru_gate;
  float *modv;
  float *hdn2;
  bf16_t *rtab0;
  bf16_t *rtab1;
  float *knorm;
  bf16_t *hbuf;
  float *rstd;
  bf16_t *resb;
  bf16_t *outp;
  float *lru_agg;
  float *lru_hin;
  float *lru_sagg;
  unsigned char *scratch;
  unsigned *bar;
};

#define SC_SSD_Z     ((size_t)0)
#define SC_SSD_XBC   ((size_t)T_ALL * 2048 * 2)
#define SC_SSD_XBCC  (SC_SSD_XBC + (size_t)T_ALL * 4096 * 2)
#define SC_SSD_DT    (SC_SSD_XBCC + (size_t)T_ALL * 2048 * 2)
#define SC_SSD_XT    (SC_SSD_DT + (size_t)T_ALL * 64 * 4)
#define SC_SSD_BT    (SC_SSD_XT + (size_t)T_ALL * 2048 * 2)
#define SC_SSD_BF    (SC_SSD_BT + (size_t)T_ALL * 1024 * 2)
#define SC_SSD_CF    (SC_SSD_BF + (size_t)T_ALL * 1024 * 2)
#define SC_SSD_END   (SC_SSD_CF + (size_t)T_ALL * 1024 * 2)
#define SC_HY_PROJT  ((size_t)0)
#define SC_HY_YT     ((size_t)T_ALL * 4096 * 2)
#define SC_HY_YG     (SC_HY_YT + (size_t)T_ALL * 1024 * 2)
#define SC_LRU_PROJ  ((size_t)0)
#define SC_LRU_XC    ((size_t)T_ALL * 2048 * 2)
#define SC_LRU_GATES (SC_LRU_XC + (size_t)T_ALL * 1024 * 2)
#define SC_LRU_Y     (SC_LRU_GATES + (size_t)T_ALL * 4096 * 2)
#define SC_LRU_YG    (SC_LRU_Y + (size_t)T_ALL * 2048 * 2)
#define SC_TOTAL     SC_SSD_END

__device__ __forceinline__ void transpose_tile(const float* __restrict__ src, int ld_src, int n_src, bf16_t* __restrict__ dst, int K,
                               const float* __restrict__ scale, int tile, int tiles_k, float* tl, int cxw) {
  const int tidx = opaque_tid(cxw);
  int tk = tile % tiles_k, tn = tile / tiles_k;
  int k0 = tk * 64, n0 = tn * 64;
  __syncthreads();
  {
    const int c4 = (tidx & 15) * 4, r0 = tidx >> 4;
#pragma unroll
    for (int ps = 0; ps < 4; ++ps) {
      const int r = r0 + ps * 16;
      f32x4 v = {0.f, 0.f, 0.f, 0.f};
      if (n0 + c4 < n_src) v = *(const f32x4*)(src + (size_t)(k0 + r) * ld_src + n0 + c4);
      if (scale) { const float sc = scale[k0 + r]; v.x *= sc; v.y *= sc; v.z *= sc; v.w *= sc; }
      tl[r * 65 + c4] = v.x; tl[r * 65 + c4 + 1] = v.y; tl[r * 65 + c4 + 2] = v.z; tl[r * 65 + c4 + 3] = v.w;
    }
  }
  __syncthreads();
  {
    const int n = tidx >> 2, kq = (tidx & 3) * 16;
    unsigned w[8];
#pragma unroll
    for (int e = 0; e < 8; ++e) w[e] = pack2(tl[(kq + 2 * e) * 65 + n], tl[(kq + 2 * e + 1) * 65 + n]);
    u32x4 o0, o1; o0.x = w[0]; o0.y = w[1]; o0.z = w[2]; o0.w = w[3]; o1.x = w[4]; o1.y = w[5]; o1.z = w[6]; o1.w = w[7];
    bf16_t* dp = dst + (size_t)(n0 + n) * K + k0 + kq;
    *(u32x4*)dp = o0; *(u32x4*)(dp + 8) = o1;
  }
}

struct PrepTile { const float* src; int ld, nsrc, K, t; bf16_t* dst; const float* scale; };
__device__ __forceinline__ PrepTile prep_decode(const Params& p, int g) {
  PrepTile q; q.scale = nullptr;
  if (g < 3200) { const int job = g >= 1600; q.t = g - job * 1600; q.src = p.ssd_in_w + (size_t)job * 1024 * 6208; q.ld = 6208; q.nsrc = 6208; q.K = 1024; q.dst = p.wt_ssd_in + (size_t)job * 6400 * 1024; }
  else if (g < 4224) { const int sl = g >= 3712; q.t = g - 3200 - sl * 512; q.src = p.ssd_out_w + (size_t)sl * 2048 * 1024; q.ld = 1024; q.nsrc = 1024; q.K = 2048; q.dst = p.wt_ssd_out + (size_t)sl * 1024 * 2048; q.scale = p.ssd_norm_g + sl * 2048; }
  else if (g < 5248) { q.t = g - 4224; q.src = p.hy_in_w; q.ld = 4096; q.nsrc = 4096; q.K = 1024; q.dst = p.wt_hy_in; }
  else if (g < 5504) { q.t = g - 5248; q.src = p.hy_out_w; q.ld = 1024; q.nsrc = 1024; q.K = 1024; q.dst = p.wt_hy_out; }
  else if (g < 6016) { q.t = g - 5504; q.src = p.lru_in_w; q.ld = 2048; q.nsrc = 2048; q.K = 1024; q.dst = p.wt_lru_in; }
  else if (g < 6272) { q.t = g - 6016; q.src = p.lru_out_w; q.ld = 1024; q.nsrc = 1024; q.K = 1024; q.dst = p.wt_lru_out; }
  else { const int qq = (g - 6272) >> 4; q.t = (g - 6272) & 15; const int dg = qq >> 2, n = qq & 3;
    const int tn = q.t >> 2, dir = dg >> 1, gsel = dg & 1, half = tn >> 1, jj0 = (tn & 1) * 64;
    q.src = p.lru_gate_w + (size_t)(dg * 4 + n) * 65536; q.ld = 256; q.nsrc = 256; q.K = 256;
    q.dst = p.wt_lru_gate + ((size_t)n * 1024 + (dir * 2 + half) * 256 + gsel * 128 + jj0 - tn * 64) * 256; }
  return q;
}
__device__ __forceinline__ void prep_load(const PrepTile& q, int tidx, f32x4 (&v)[4]) {
  const int tiles_k = q.K >> 6, tk = q.t % tiles_k, tn = q.t / tiles_k, k0 = tk * 64, n0 = tn * 64;
  const int c4 = (tidx & 15) * 4, r0 = tidx >> 4;
#pragma unroll
  for (int ps = 0; ps < 4; ++ps) {
    const int r = r0 + ps * 16;
    f32x4 x = {0.f, 0.f, 0.f, 0.f};
    if (n0 + c4 < q.nsrc) x = *(const f32x4*)(q.src + (size_t)(k0 + r) * q.ld + n0 + c4);
    if (q.scale) { const float sc = q.scale[k0 + r]; x.x *= sc; x.y *= sc; x.z *= sc; x.w *= sc; }
    v[ps] = x;
  }
}
__device__ __forceinline__ void phase_prep(const Params& p, int bid, int nblk, unsigned char* smem, unsigned* wg_bar, int cxw) {
  const int tid = opaque_tid(cxw);
  float* tl = (float*)smem;
  VB_DECL(wg_bar);
  f32x4 v[4];
  PrepTile cur = prep_decode(p, bid < 6528 ? bid : 0);
  if (bid < 6528) prep_load(cur, tid, v);
  for (int g = bid; g < 6528; g += nblk) {
    VB_SYNC();
    {
      const int c4 = (tid & 15) * 4, r0 = tid >> 4;
#pragma unroll
      for (int ps = 0; ps < 4; ++ps) { const int r = r0 + ps * 16; tl[r * 65 + c4] = v[ps].x; tl[r * 65 + c4 + 1] = v[ps].y; tl[r * 65 + c4 + 2] = v[ps].z; tl[r * 65 + c4 + 3] = v[ps].w; }
    }
    const PrepTile ths = cur;
    if (g + nblk < 6528) { cur = prep_decode(p, g + nblk); prep_load(cur, tid, v); }
    VB_SYNC();
    {
      const int tiles_k = ths.K >> 6, tk = ths.t % tiles_k, tn = ths.t / tiles_k, k0 = tk * 64, n0 = tn * 64;
      const int n = tid >> 2, kq = (tid & 3) * 16;
      unsigned w[8];
#pragma unroll
      for (int e = 0; e < 8; ++e) w[e] = pack2(tl[(kq + 2 * e) * 65 + n], tl[(kq + 2 * e + 1) * 65 + n]);
      u32x4 o0, o1; o0.x = w[0]; o0.y = w[1]; o0.z = w[2]; o0.w = w[3]; o1.x = w[4]; o1.y = w[5]; o1.z = w[6]; o1.w = w[7];
      bf16_t* dp = ths.dst + (size_t)(n0 + n) * ths.K + k0 + kq;
      *(u32x4*)dp = o0; *(u32x4*)(dp + 8) = o1;
    }
  }
  for (int i = bid * NTHR + tid; i < 2 * 2 * 1024; i += nblk * NTHR) p.knorm[i] = 0.f;
}

__device__ __forceinline__ void phase_mod(const Params& p, int bid, int nblk, unsigned char* smem, int cxw) {
  const int tidx = opaque_tid(cxw);
  float* sc = (float*)smem;
  float* red = sc + 5 * 1024;
  __syncthreads();
  for (int i = tidx; i < 5 * 1024; i += NTHR) {
    int r = i >> 10, k = i & 1023;
    float v = (r == 0) ? p.c_ctx[k] : p.c[(r - 1) * 1024 + k];
    sc[i] = siluf(v);
  }
  __syncthreads();
  const int cj = tidx & 31, kg = tidx >> 5;
  for (int item = bid; item < 4 * 96; item += nblk) {
    const int layer = item / 96, j = (item % 96) * 32 + cj;
    const float* w = p.mod_w + (size_t)layer * 1024 * 3072 + (size_t)kg * 128 * 3072 + j;
    const float* s0 = sc + kg * 128;
    float a0 = 0, a1 = 0, a2 = 0, a3 = 0, a4 = 0;
#pragma unroll 32
    for (int k = 0; k < 128; ++k) {
      float wv = w[(size_t)k * 3072];
      a0 += s0[k] * wv; a1 += s0[1024 + k] * wv; a2 += s0[2048 + k] * wv; a3 += s0[3072 + k] * wv; a4 += s0[4096 + k] * wv;
    }
    __syncthreads();
    red[(kg * 5 + 0) * 32 + cj] = a0; red[(kg * 5 + 1) * 32 + cj] = a1; red[(kg * 5 + 2) * 32 + cj] = a2;
    red[(kg * 5 + 3) * 32 + cj] = a3; red[(kg * 5 + 4) * 32 + cj] = a4;
    __syncthreads();
    if (tidx < 160) {
      const int rr = tidx >> 5, cc = tidx & 31;
      float sum = 0.f;
#pragma unroll
      for (int g8 = 0; g8 < 8; ++g8) sum += red[(g8 * 5 + rr) * 32 + cc];
      const int jj = (item % 96) * 32 + cc;
      p.modv[((size_t)layer * 5 + rr) * 3072 + jj] = sum + p.mod_b[layer * 3072 + jj];
    }
  }
}

__device__ __forceinline__ void phase_hyfilt_a(const Params& p, int bid, int nblk, unsigned char* smem, int cxw) {
  const int tidx = opaque_tid(cxw);
  float* sz = (float*)smem;
  float* sh = sz + 4 * 36;
  float* sw1 = sh + 4 * 64;
  float* sw2 = sw1 + 33 * 64;
  int pl = tidx >> 6, m = tidx & 63;
  __syncthreads();
  for (int i = tidx; i < 33 * 64; i += NTHR) sw1[i] = p.hy_f_w1[i];
  for (int i = tidx; i < 64 * 64; i += NTHR) sw2[i] = p.hy_f_w2[i];
  const float b1 = p.hy_f_b1[m], b2 = p.hy_f_b2[m], fq1 = p.hy_f_freq[m], fq2 = p.hy_f_freq[64 + m];
  for (int item = bid; item < 4352 / 4; item += nblk) {
    int pos = item * 4 + pl;
    int L = pos < 256 ? 256 : 4096;
    int l = pos < 256 ? pos : pos - 256;
    __syncthreads();
    if (m < 33) {
      float t = (float)l / (float)L;
      float w = (6.283185307179586f * (float)l) / (float)L;
      float v;
      if (m == 0) v = t;
      else {
        int j = (m - 1) & 15;
        float fr = 1e-4f + (float)j * ((15.f - 1e-4f) / 15.f);
        float ang = w * fr;
        v = (m <= 16) ? __cosf(ang) : __sinf(ang);
      }
      sz[pl * 36 + m] = v;
    }
    __syncthreads();
    float a = b1;
#pragma unroll
    for (int e = 0; e < 33; ++e) a += sz[pl * 36 + e] * sw1[e * 64 + m];
    a = __sinf(fq1 * a);
    sh[pl * 64 + m] = a;
    __syncthreads();
    float b = b2;
#pragma unroll
    for (int e = 0; e < 64; ++e) b += sh[pl * 64 + e] * sw2[e * 64 + m];
    b = __sinf(fq2 * b);
    p.hdn2[(size_t)pos * 64 + m] = b;
  }
}

__device__ __forceinline__ void hy_split8(const f32x4 v0, const f32x4 v1, bf16x8& hi, bf16x8& lo) {
  const float x[8] = {v0.x, v0.y, v0.z, v0.w, v1.x, v1.y, v1.z, v1.w};
  u32x4 h, l;
#pragma unroll
  for (int e = 0; e < 4; ++e) {
    const unsigned ph = pack2(x[2 * e], x[2 * e + 1]);
    h[e] = ph; l[e] = pack2(x[2 * e] - bflo(ph), x[2 * e + 1] - bfhi(ph));
  }
  hi = __builtin_bit_cast(bf16x8, h); lo = __builtin_bit_cast(bf16x8, l);
}
__device__ __forceinline__ void phase_hyfilt_b(const Params& p, int bid, int nblk, unsigned char* smem, unsigned* wg_bar, int cxw) {
  const int tid = opaque_tid(cxw);
  const int lane = tid & 63, w = cxw & 3, r = lane & 31, hh = lane >> 5;
  float* sw = (float*)smem;
  bf16_t* T = (bf16_t*)(smem + 64 * 68 * 4);
  float* sred = (float*)(smem + 64 * 68 * 4 + 64 * 264 * 2);
  VB_DECL(wg_bar);
  int cur_chunk = -1;
  bf16x8 bhi[2][4], blo[2][4];
  const float min_decay = -3.0701134573253945f, max_decay = -15.350567286626973f;
  for (int item = bid; item < 17 * 64; item += nblk) {
    const int lb = item >> 6, chunk = item & 63;
    const int Lsel = lb ? 1 : 0, L = Lsel ? 4096 : 256, RL = 2 * L;
    const int lbase = Lsel ? (lb - 1) * 256 : 0, posbase = Lsel ? 256 + lbase : 0;
    const int odc0 = chunk * 64, o = odc0 >> 11, d = (odc0 >> 10) & 1, c0 = odc0 & 1023;
    VB_SYNC();
    if (chunk != cur_chunk) {
      cur_chunk = chunk;
#pragma unroll
      for (int i = 0; i < 16; ++i) {
        const int q = tid + i * 256, m = q >> 6, cc = q & 63;
        sw[cc * 68 + m] = p.hy_f_w3[(size_t)m * 4096 + odc0 + cc];
      }
      VB_SYNC();
#pragma unroll
      for (int ct2 = 0; ct2 < 2; ++ct2)
#pragma unroll
        for (int ks = 0; ks < 4; ++ks) {
          const float* bp = sw + (32 * ct2 + r) * 68 + 16 * ks + 8 * hh;
          hy_split8(*(const f32x4*)bp, *(const f32x4*)(bp + 4), bhi[ct2][ks], blo[ct2][ks]);
        }
    }
    float asum[2] = {0.f, 0.f};
    float delta[2];
#pragma unroll
    for (int ct2 = 0; ct2 < 2; ++ct2) delta[ct2] = fabsf(min_decay + (float)(c0 + 32 * ct2 + r) * ((max_decay - min_decay) / 1023.f));
    const float invL = 1.f / (float)L;
#pragma unroll
    for (int rt2 = 0; rt2 < 2; ++rt2) {
      bf16x8 ahi[4], alo[4];
      {
        const float* ap = p.hdn2 + (size_t)(posbase + 64 * w + 32 * rt2 + r) * 64 + 8 * hh;
#pragma unroll
        for (int ks = 0; ks < 4; ++ks) hy_split8(*(const f32x4*)(ap + 16 * ks), *(const f32x4*)(ap + 16 * ks + 4), ahi[ks], alo[ks]);
      }
#pragma unroll
      for (int ct2 = 0; ct2 < 2; ++ct2) {
        f32x16 acc;
#pragma unroll
        for (int e = 0; e < 16; ++e) acc[e] = 0.f;
#pragma unroll
        for (int ks = 0; ks < 4; ++ks) {
          acc = __builtin_amdgcn_mfma_f32_32x32x16_bf16(alo[ks], bhi[ct2][ks], acc, 0, 0, 0);
          acc = __builtin_amdgcn_mfma_f32_32x32x16_bf16(ahi[ks], blo[ct2][ks], acc, 0, 0, 0);
          acc = __builtin_amdgcn_mfma_f32_32x32x16_bf16(ahi[ks], bhi[ct2][ks], acc, 0, 0, 0);
        }
#pragma unroll
        for (int qd = 0; qd < 4; ++qd) {
          const int ll0 = 64 * w + 32 * rt2 + 8 * qd + 4 * hh;
          float kv[4];
#pragma unroll
          for (int u = 0; u < 4; ++u) {
            const float t = (float)(lbase + ll0 + u) * invL;
            kv[u] = acc[4 * qd + u] * __expf(-t * delta[ct2]);
            asum[ct2] += fabsf(kv[u]);
          }
          u32x2 ov;
          if (d == 0) { ov.x = pack2(kv[3], kv[2]); ov.y = pack2(kv[1], kv[0]); *(u32x2*)(T + (32 * ct2 + r) * 264 + (252 - ll0)) = ov; }
          else        { ov.x = pack2(kv[0], kv[1]); ov.y = pack2(kv[2], kv[3]); *(u32x2*)(T + (32 * ct2 + r) * 264 + ll0) = ov; }
        }
      }
    }
#pragma unroll
    for (int ct2 = 0; ct2 < 2; ++ct2) {
      const float tot = asum[ct2] + shfl_idx_f(asum[ct2], lane ^ 32);
      if (hh == 0) sred[w * 64 + 32 * ct2 + r] = tot;
    }
    VB_SYNC();
    bf16_t* rt = Lsel ? p.rtab1 : p.rtab0;
    if (d == 0) {
#pragma unroll
      for (int i = 0; i < 8; ++i) {
        const int q = tid + i * 256, cc = q >> 5, ch = q & 31;
        *(u32x4*)(rt + (size_t)(o * 1024 + c0 + cc) * RL + (L - 256 - lbase) + ch * 8) = *(const u32x4*)(T + cc * 264 + ch * 8);
      }
    } else {
#pragma unroll
      for (int i = 0; i < 8; ++i) {
        const int q = tid + i * 256, cc = q >> 5, ch = q & 31;
        const u32x4 v = *(const u32x4*)(T + cc * 264 + ch * 8);
        bf16_t* dp = rt + (size_t)(o * 1024 + c0 + cc) * RL + (L + lbase) + ch * 8;
        u32x4 sv;
        sv.x = (v.x >> 16) | (v.y << 16); sv.y = (v.y >> 16) | (v.z << 16); sv.z = (v.z >> 16) | (v.w << 16);
        if (ch < 31) {
          const unsigned nx = T[cc * 264 + ch * 8 + 8];
          sv.w = (v.w >> 16) | (nx << 16);
          *(u32x4*)dp = sv;
        } else {
          u32x2 s2; s2.x = sv.x; s2.y = sv.y;
          *(u32x2*)dp = s2; *(unsigned*)(dp + 4) = sv.z; dp[6] = (bf16_t)(v.w >> 16);
        }
      }
      if (tid < 64) {
        bf16_t* rowp = rt + (size_t)(o * 1024 + c0 + tid) * RL;
        if (lbase == 0) rowp[RL - 1] = 0;
        else rowp[L + lbase - 1] = T[tid * 264];
      }
    }
    if (tid < 64) atomicAdd(&p.knorm[(Lsel * 2 + o) * 1024 + c0 + tid], sred[tid] + sred[64 + tid] + sred[128 + tid] + sred[192 + tid]);
  }
}

__device__ __forceinline__ void phase_lnmod(const Params& p, int layer, int bid, int nblk, int cxw) {
  const int tidx = opaque_tid(cxw);
  const bool split_tail = (nblk == 512) && (layer == 2 || layer == 3);
  int lane = tidx & 63, wv = cxw & 3;
  f32x4 lg[4], lb[4];
  if (layer > 0) {
    const float* g = p.ln_g + (layer - 1) * DM; const float* b = p.ln_b + (layer - 1) * DM;
#pragma unroll
    for (int j = 0; j < 4; ++j) { lg[j] = *(const f32x4*)(g + j * 256 + lane * 4); lb[j] = *(const f32x4*)(b + j * 256 + lane * 4); }
  }
  f32x4 vn[4];
#define LNMOD_LOAD(ROW) do { const int row_ = (ROW); \
    if (layer == 0) { const float* src_ = row_ < T_CTX ? p.x_prompt + (size_t)row_ * DM : p.x_sample + (size_t)(row_ - T_CTX) * DM; \
      _Pragma("unroll") for (int j = 0; j < 4; ++j) vn[j] = *(const f32x4*)(src_ + j * 256 + lane * 4); } \
    else { const bf16_t* src_ = p.resb + (size_t)row_ * DM; \
      _Pragma("unroll") for (int j = 0; j < 4; ++j) { const u32x2 w_ = *(const u32x2*)(src_ + j * 256 + lane * 4); \
        vn[j].x = bflo(w_.x); vn[j].y = bfhi(w_.x); vn[j].z = bflo(w_.y); vn[j].w = bfhi(w_.y); } \
      if (split_tail && row_ >= 16384) { const bf16_t* ps_ = p.outp + (size_t)(row_ - 16384) * DM;     \
        _Pragma("unroll") for (int j = 0; j < 4; ++j) { const u32x2 w_ = *(const u32x2*)(ps_ + j * 256 + lane * 4); \
          vn[j].x += bflo(w_.x); vn[j].y += bfhi(w_.x); vn[j].z += bflo(w_.y); vn[j].w += bfhi(w_.y); } } } } while (0)
  if (bid * 4 + wv < T_ALL) LNMOD_LOAD(bid * 4 + wv);
  f32x4 msh[4], msc[4]; int cur_mrow = -1;
#pragma unroll
  for (int j = 0; j < 4; ++j) { msh[j] = f32x4{0.f, 0.f, 0.f, 0.f}; msc[j] = f32x4{0.f, 0.f, 0.f, 0.f}; }
  for (int row = bid * 4 + wv; row < T_ALL; row += nblk * 4) {
    f32x4 v[4];
#pragma unroll
    for (int j = 0; j < 4; ++j) v[j] = vn[j];
    if (row + nblk * 4 < T_ALL) LNMOD_LOAD(row + nblk * 4);
    if (layer < 4) {
      const int mrow_ = row < T_CTX ? 0 : 1 + ((row - T_CTX) >> 12);
      if (mrow_ != cur_mrow) {
        cur_mrow = mrow_;
        const float* mv_ = p.modv + ((size_t)layer * 5 + mrow_) * 3072;
#pragma unroll
        for (int j = 0; j < 4; ++j) { msh[j] = *(const f32x4*)(mv_ + j * 256 + lane * 4); msc[j] = *(const f32x4*)(mv_ + 1024 + j * 256 + lane * 4); }
      }
    }
    if (layer > 0) {
      float s = 0.f;
#pragma unroll
      for (int j = 0; j < 4; ++j) s += v[j].x + v[j].y + v[j].z + v[j].w;
      s = wave_sum(s);
      float mu = s * (1.f / 1024.f);
      float q = 0.f;
#pragma unroll
      for (int j = 0; j < 4; ++j) { float a = v[j].x - mu, b = v[j].y - mu, c = v[j].z - mu, d = v[j].w - mu; q += a * a + b * b + c * c + d * d; }
      q = wave_sum(q);
      float rs = rsqrtf(q * (1.f / 1024.f) + LN_EPS);
#pragma unroll
      for (int j = 0; j < 4; ++j) {
        const f32x4 gg = lg[j], bb = lb[j];
        v[j].x = (v[j].x - mu) * rs * gg.x + bb.x; v[j].y = (v[j].y - mu) * rs * gg.y + bb.y;
        v[j].z = (v[j].z - mu) * rs * gg.z + bb.z; v[j].w = (v[j].w - mu) * rs * gg.w + bb.w;
      }
    }
    if (layer == 4) {
      float* dst = p.xres + (size_t)row * DM;
#pragma unroll
      for (int j = 0; j < 4; ++j) *(f32x4*)(dst + j * 256 + lane * 4) = v[j];
    } else {
      bf16_t* dst = p.resb + (size_t)row * DM;
#pragma unroll
      for (int j = 0; j < 4; ++j) { u32x2 o; o.x = pack2(v[j].x, v[j].y); o.y = pack2(v[j].z, v[j].w); *(u32x2*)(dst + j * 256 + lane * 4) = o; }
    }
    if (layer < 4) {
#pragma unroll
      for (int j = 0; j < 4; ++j) {
        const f32x4 sh = msh[j], sc = msc[j];
        u32x2 o;
        o.x = pack2(v[j].x * (1.f + sc.x) + sh.x, v[j].y * (1.f + sc.y) + sh.y);
        o.y = pack2(v[j].z * (1.f + sc.z) + sh.z, v[j].w * (1.f + sc.w) + sh.w);
        *(u32x2*)(p.hbuf + (size_t)row * DM + j * 256 + lane * 4) = o;
      }
    }
  }
}

#define PG8_LAS __attribute__((address_space(3)))
namespace pg8 {
constexpr int BM = 256, BK = 64, HALF = 128, HTB = HALF * BK * 2, STAGE_BYTES = 8 * HTB, NXCD = 8, WGM = 8;
__device__ __forceinline__ int lds_byte(int r, int c) { const int st = (r >> 4) * 2 + (c >> 5), rr = r & 15, cc = c & 31, ob = rr * 64 + cc * 2; return st * 1024 + (ob ^ (((ob >> 9) & 1) << 5)); }
__device__ __forceinline__ void stage_rc(int b, int& R, int& C) { const int st = b / 1024, sb = b % 1024, swz = sb ^ (((sb >> 9) & 1) << 5); R = (st >> 1) * 16 + swz / 64; C = (st & 1) * 32 + (swz % 64) / 2; }
__device__ __forceinline__ int perm32(int rho) { const int n = rho >> 4, i = rho & 15; return 8 * (i >> 2) + 4 * n + (i & 3); }
struct Unit { int pm, pn; int koff, nt, part; };
struct Gemm { const bf16_t* A; const bf16_t* Bt; int M, N, K, lda; int a_grp_shift; int a_grp_bytes; };
struct StaticOrder {
  int nM, nN, nwg, G, c, ntfull, split;
  __device__ void init(int M, int N, int K, int G_, int c_, int split_) {
    nM = M / BM; nN = N / BM; nwg = nM * nN; G = G_; c = c_; ntfull = K / BK;
    split = (G_ == 256 && nM == 96 && nN == 4) ? split_ : 0;
  }
  __device__ bool next(int i, Unit& u) const {
    if (split == 2) {
      if (i != 0 || c < 128) return false;
      const int c2 = c - 128; u.pm = c2 >> 2; u.pn = c2 & 3; u.koff = 0; u.nt = ntfull; u.part = 0; return true;
    }
    if (split == 3) {
      if (i != 0) return false;
      const int xcd = c & 7, j = c >> 3; u.pm = 32 + xcd * 8 + (j >> 2); u.pn = j & 3; u.koff = 0; u.nt = ntfull; u.part = 0; return true;
    }
    if (split) {
      const int xcd = c & 7, j = c >> 3;
      if (i == 0) { u.pm = xcd * 8 + (j >> 2); u.pn = j & 3; u.koff = 0; u.nt = ntfull; u.part = 0; return true; }
      if (i == 1) { const int ul = j >> 1, kh = j & 1; u.pm = 64 + xcd * 4 + (ul >> 2); u.pn = ul & 3; u.nt = ntfull >> 1; u.koff = kh * (ntfull >> 1) * BK; u.part = 1 + kh; return true; }
      return false;
    }
    const long L = (long)i * G + c; if (L >= nwg) return false;
    int wgid = (int)L; { const int q = nwg / NXCD, r = nwg % NXCD, xcd = wgid % NXCD, off = wgid / NXCD; wgid = (xcd < r ? xcd * (q + 1) : r * (q + 1) + (xcd - r) * q) + off; }
    const int nig = WGM * nN, gid = wgid / nig, fm = gid * WGM, gsz = (nM - fm) < WGM ? (nM - fm) : WGM;
    u.pm = fm + ((wgid % nig) % gsz); u.pn = (wgid % nig) / gsz; u.koff = 0; u.nt = ntfull; u.part = 0; return true;
  }
};
__device__ __forceinline__ unsigned cvt_pk_bf16(float lo, float hi) { return pack2(lo, hi); }

template <class Epi>
__device__ __forceinline__ void gemm_phase(PG8_LAS unsigned char* lds, const Gemm g, const StaticOrder& S, const Epi& E, int wave) {
  const int tid = opaque_tid512(wave), wid = wave, lane = tid & 63, wr = wid >> 2, wc = wid & 3, fr = lane & 15, fq = lane >> 4;
  const int K = g.K, lda = g.lda;
  unsigned voffA[2], voffB[2];
#pragma unroll
  for (int i = 0; i < 2; ++i) { int R, C; stage_rc(tid * 16 + i * 8192, R, C); const int Rb = Epi::PERM ? ((R & ~31) + perm32(R & 31)) : R;
    voffA[i] = (unsigned)(R * lda + C) * 2u; voffB[i] = (unsigned)(Rb * K + C) * 2u; }
  const size_t kstep = (size_t)(BK * 2);
  const size_t hstepA = (size_t)HALF * lda * 2, hstepB = (size_t)HALF * K * 2;
  const size_t tstepA = 2 * hstepA, tstepB = 2 * hstepB;
  const unsigned ldsw = (unsigned)wid * 1024u;
  const int aoff = lds_byte(wr * 64 + fr, fq * 8), boff = lds_byte(wc * 32 + fr, fq * 8);
#define PG8_SA(b, h) (((b) * 2 + (h)) * HTB)
#define PG8_SB(b, h) ((4 + (b) * 2 + (h)) * HTB)
#define PG8_STAGE(bufoff, gbase, voff) do { _Pragma("unroll") for (int _i = 0; _i < 2; ++_i) \
    __builtin_amdgcn_global_load_lds((const unsigned*)((const char*)(gbase) + (voff)[_i]), (PG8_LAS unsigned*)(lds + (bufoff) + ldsw + _i * 8192), 16, 0, 0); } while (0)
#define PG8_LDA(dst, b, h) do { _Pragma("unroll") for (int m = 0; m < 4; ++m) _Pragma("unroll") for (int k = 0; k < 2; ++k) dst[m][k] = *(const PG8_LAS bf16x8*)(lds + PG8_SA(b, h) + aoff + m * 2048 + k * 1024); } while (0)
#define PG8_LDB(dst, b, h) do { _Pragma("unroll") for (int n = 0; n < 2; ++n) _Pragma("unroll") for (int k = 0; k < 2; ++k) dst[n][k] = *(const PG8_LAS bf16x8*)(lds + PG8_SB(b, h) + boff + n * 2048 + k * 1024); } while (0)
#define PG8_MMA(ai, bj, At, Bt) do { __builtin_amdgcn_s_setprio(1); _Pragma("unroll") for (int m = 0; m < 4; ++m) _Pragma("unroll") for (int n = 0; n < 2; ++n) _Pragma("unroll") for (int k = 0; k < 2; ++k) \
    acc[ai][bj][m][n] = __builtin_amdgcn_mfma_f32_16x16x32_bf16(Bt[n][k], At[m][k], acc[ai][bj][m][n], 0, 0, 0); __builtin_amdgcn_s_setprio(0); } while (0)
#define PG8_WAIT_V(n) asm volatile("s_waitcnt vmcnt(" #n ")" ::: "memory")
#define PG8_WAIT_L(n) asm volatile("s_waitcnt lgkmcnt(" #n ")" ::: "memory")
#define PG8_BAR __builtin_amdgcn_s_barrier()
#define PG8_SCHED __builtin_amdgcn_sched_barrier(0)
#define PG8_APTR(u) ((const char*)g.A + (size_t)(u).pm * tstepA + (size_t)(((u).pn >> g.a_grp_shift) * g.a_grp_bytes) + (size_t)(u).koff * 2)
#define PG8_BPTR(u) ((const char*)g.Bt + (size_t)(u).pn * tstepB + (size_t)(u).koff * 2)
  Unit cur, nxt; int ui = 0;
  if (!S.next(0, cur)) return;
  f32x4 acc[2][2][4][2];
#pragma unroll
  for (int a = 0; a < 2; ++a)
#pragma unroll
    for (int b = 0; b < 2; ++b)
#pragma unroll
      for (int m = 0; m < 4; ++m)
#pragma unroll
        for (int n = 0; n < 2; ++n) acc[a][b][m][n] = (f32x4){0.f, 0.f, 0.f, 0.f};
  bf16x8 At[4][2], B0[2][2], B1[2][2];
  const char* cA = PG8_APTR(cur); const char* cB = PG8_BPTR(cur);
  PG8_STAGE(PG8_SB(0, 0), cB, voffB); PG8_STAGE(PG8_SA(0, 0), cA, voffA); PG8_STAGE(PG8_SB(0, 1), cB + hstepB, voffB); PG8_STAGE(PG8_SA(0, 1), cA + hstepA, voffA);
  if (wr == 1) PG8_BAR;
  PG8_WAIT_V(4); PG8_BAR;
  PG8_STAGE(PG8_SB(1, 0), cB + kstep, voffB); PG8_STAGE(PG8_SA(1, 0), cA + kstep, voffA); PG8_STAGE(PG8_SB(1, 1), cB + hstepB + kstep, voffB);
  PG8_WAIT_V(6); PG8_BAR;
  for (;;) {
    const bool has_next = S.next(ui + 1, nxt);
    const char* nA = has_next ? PG8_APTR(nxt) : cA; const char* nB = has_next ? PG8_BPTR(nxt) : cB;
    const int nt = cur.nt;
    for (int t = 0; t < nt; t += 2) {
      const bool last = (t == nt - 2);
      const char* a1 = cA + (size_t)(t + 1) * kstep;
      const char* a2 = last ? nA : cA + (size_t)(t + 2) * kstep; const char* b2 = last ? nB : cB + (size_t)(t + 2) * kstep;
      const char* a3 = a2 + kstep; const char* b3 = b2 + kstep;
      PG8_LDB(B0, 0, 0); PG8_SCHED; PG8_LDA(At, 0, 0); PG8_STAGE(PG8_SA(1, 1), a1 + hstepA, voffA);
      PG8_WAIT_L(8); PG8_BAR; PG8_WAIT_L(0); PG8_MMA(0, 0, At, B0); PG8_BAR; PG8_SCHED;
      PG8_LDB(B1, 0, 1); PG8_STAGE(PG8_SB(0, 0), b2, voffB);
      PG8_BAR; PG8_WAIT_L(0); PG8_MMA(0, 1, At, B1); PG8_BAR;
      PG8_LDA(At, 0, 1); PG8_STAGE(PG8_SA(0, 0), a2, voffA);
      PG8_BAR; PG8_WAIT_L(0); PG8_MMA(1, 0, At, B0); PG8_BAR; PG8_SCHED;
      PG8_STAGE(PG8_SB(0, 1), b2 + hstepB, voffB);
      PG8_WAIT_V(6); PG8_BAR; PG8_MMA(1, 1, At, B1); PG8_BAR;
      PG8_LDB(B0, 1, 0); PG8_SCHED; PG8_LDA(At, 1, 0); PG8_STAGE(PG8_SA(0, 1), a2 + hstepA, voffA);
      PG8_WAIT_L(8); PG8_BAR; PG8_WAIT_L(0); PG8_MMA(0, 0, At, B0); PG8_BAR; PG8_SCHED;
      PG8_LDB(B1, 1, 1); PG8_STAGE(PG8_SB(1, 0), b3, voffB);
      PG8_BAR; PG8_WAIT_L(0); PG8_MMA(0, 1, At, B1); PG8_BAR;
      PG8_LDA(At, 1, 1); PG8_STAGE(PG8_SA(1, 0), a3, voffA);
      PG8_BAR; PG8_WAIT_L(0); PG8_MMA(1, 0, At, B0); PG8_BAR; PG8_SCHED;
      PG8_STAGE(PG8_SB(1, 1), b3 + hstepB, voffB);
      PG8_WAIT_V(6); PG8_BAR; PG8_MMA(1, 1, At, B1); PG8_BAR;
    }
    { const int lane2 = opaque_lane();
      E(acc, cur, wr, wc, lane2 & 15, lane2 >> 4); }
    if (!has_next) break;
#pragma unroll
    for (int a = 0; a < 2; ++a)
#pragma unroll
      for (int b = 0; b < 2; ++b)
#pragma unroll
        for (int m = 0; m < 4; ++m)
#pragma unroll
          for (int n = 0; n < 2; ++n) acc[a][b][m][n] = (f32x4){0.f, 0.f, 0.f, 0.f};
    cur = nxt; cA = nA; cB = nB; ++ui;
  }
  PG8_WAIT_V(0);
  if (wr == 0) PG8_BAR;
  PG8_BAR;
#undef PG8_SA
#undef PG8_SB
#undef PG8_STAGE
#undef PG8_LDA
#undef PG8_LDB
#undef PG8_MMA
#undef PG8_WAIT_V
#undef PG8_WAIT_L
#undef PG8_BAR
#undef PG8_SCHED
#undef PG8_APTR
#undef PG8_BPTR
}

struct EpiBf16 {
  static constexpr bool PERM = true;
  bf16_t* O; size_t ldc;
  __device__ __forceinline__ void operator()(const f32x4 (&acc)[2][2][4][2], const Unit& u, int wr, int wc, int fr, int fq) const {
    const int row0 = u.pm * BM + wr * 64 + fr, col0 = u.pn * BM + wc * 32 + 8 * fq;
#pragma unroll
    for (int ai = 0; ai < 2; ++ai)
#pragma unroll
      for (int m = 0; m < 4; ++m) {
        bf16_t* rowp = O + (size_t)(row0 + ai * HALF + m * 16) * ldc + col0;
#pragma unroll
        for (int bj = 0; bj < 2; ++bj) {
          const f32x4 v0 = acc[ai][bj][m][0], v1 = acc[ai][bj][m][1];
          u32x4 w; w.x = pack2(v0[0], v0[1]); w.y = pack2(v0[2], v0[3]); w.z = pack2(v1[0], v1[1]); w.w = pack2(v1[2], v1[3]);
          *(u32x4*)(rowp + bj * HALF) = w;
        }
      }
  }
};
struct EpiSsdIn {
  static constexpr bool PERM = true;
  bf16_t* z; bf16_t* xbc; float* dt; const float* dt_bias;
  __device__ __forceinline__ void operator()(const f32x4 (&acc)[2][2][4][2], const Unit& u, int wr, int wc, int fr, int fq) const {
    const int row0 = u.pm * BM + wr * 64 + fr, colt = u.pn * BM + wc * 32 + 8 * fq;
    if (u.pn < 24) {
      bf16_t* base = u.pn < 8 ? z : xbc; const size_t ldc = u.pn < 8 ? 2048 : 4096; const int col0 = u.pn < 8 ? colt : colt - 2048;
#pragma unroll
      for (int ai = 0; ai < 2; ++ai)
#pragma unroll
        for (int m = 0; m < 4; ++m) {
          bf16_t* rowp = base + (size_t)(row0 + ai * HALF + m * 16) * ldc + col0;
#pragma unroll
          for (int bj = 0; bj < 2; ++bj) {
            const f32x4 v0 = acc[ai][bj][m][0], v1 = acc[ai][bj][m][1];
            u32x4 w; w.x = pack2(v0[0], v0[1]); w.y = pack2(v0[2], v0[3]); w.z = pack2(v1[0], v1[1]); w.w = pack2(v1[2], v1[3]);
            *(u32x4*)(rowp + bj * HALF) = w;
          }
        }
    } else {
      const int c0 = wc * 32 + 8 * fq;
      if (c0 < 64) {
#pragma unroll
        for (int ai = 0; ai < 2; ++ai)
#pragma unroll
          for (int m = 0; m < 4; ++m) {
            float* rowp = dt + (size_t)(row0 + ai * HALF + m * 16) * 64 + c0;
#pragma unroll
            for (int n = 0; n < 2; ++n) {
              const f32x4 v = acc[ai][0][m][n];
              f32x4 o;
#pragma unroll
              for (int e = 0; e < 4; ++e) o[e] = softplusf(v[e] + dt_bias[c0 + 4 * n + e]);
              *(f32x4*)(rowp + 4 * n) = o;
            }
          }
      }
    }
  }
};
struct EpiOut {
  static constexpr bool PERM = true;
  bf16_t* res; const float* modv_layer; const float* rstd; bf16_t* part2;
  __device__ __forceinline__ void operator()(const f32x4 (&acc)[2][2][4][2], const Unit& u, int wr, int wc, int fr, int fq) const {
    const int row0 = u.pm * BM + wr * 64 + fr, col0 = u.pn * BM + wc * 32 + 8 * fq;
    const bool second = u.part == 2;
#pragma unroll
    for (int ai = 0; ai < 2; ++ai)
#pragma unroll
      for (int m = 0; m < 4; ++m) {
        const int row = row0 + ai * HALF + m * 16;
        const int mrow = row < T_CTX ? 0 : 1 + ((row - T_CTX) >> 12);
        const float rs = rstd ? rstd[row] : 1.f;
        const float* gp = modv_layer + (size_t)mrow * 3072 + 2048 + col0;
        bf16_t* rowp = second ? part2 + (size_t)(row - 16384) * DM + col0 : res + (size_t)row * DM + col0;
#pragma unroll
        for (int bj = 0; bj < 2; ++bj) {
          const f32x4 g0 = *(const f32x4*)(gp + bj * HALF), g1 = *(const f32x4*)(gp + bj * HALF + 4);
          u32x4 xw = {0u, 0u, 0u, 0u};
          if (!second) xw = *(const u32x4*)(rowp + bj * HALF);
          const float al = second ? 0.f : ALPHA_RES;
          const f32x4 v0 = acc[ai][bj][m][0], v1 = acc[ai][bj][m][1];
          u32x4 o;
          o.x = pack2(al * bflo(xw.x) + g0.x * (v0[0] * rs), al * bfhi(xw.x) + g0.y * (v0[1] * rs));
          o.y = pack2(al * bflo(xw.y) + g0.z * (v0[2] * rs), al * bfhi(xw.y) + g0.w * (v0[3] * rs));
          o.z = pack2(al * bflo(xw.z) + g1.x * (v1[0] * rs), al * bfhi(xw.z) + g1.y * (v1[1] * rs));
          o.w = pack2(al * bflo(xw.w) + g1.z * (v1[2] * rs), al * bfhi(xw.w) + g1.w * (v1[3] * rs));
          *(u32x4*)(rowp + bj * HALF) = o;
        }
      }
  }
};
struct EpiLruGate {
  static constexpr bool PERM = true;
  bf16_t* gates; const float* gate_b; const bf16_t* xc; const float* a_param;
  __device__ __forceinline__ void operator()(const f32x4 (&acc)[2][2][4][2], const Unit& u, int wr, int wc, int fr, int fq) const {
    const int nb = u.pn >> 2, dir = (u.pn >> 1) & 1, half = u.pn & 1;
    const int row0 = u.pm * BM + wr * 64 + fr, ch0 = nb * 256 + half * 128 + wc * 32 + 8 * fq;
    float br[8], bi[8], sp[8];
#pragma unroll
    for (int e = 0; e < 8; ++e) {
      br[e] = gate_b[(2 * dir) * 1024 + ch0 + e]; bi[e] = gate_b[(2 * dir + 1) * 1024 + ch0 + e];
      sp[e] = -8.f * softplusf(-a_param[dir * 1024 + ch0 + e]);
    }
#pragma unroll
    for (int ai = 0; ai < 2; ++ai)
#pragma unroll
      for (int m = 0; m < 4; ++m) {
        const size_t ro = (size_t)(row0 + ai * HALF + m * 16) * 1024 + ch0;
        const u32x4 xv = *(const u32x4*)(xc + ro);
        const float x[8] = {bflo(xv.x), bfhi(xv.x), bflo(xv.y), bfhi(xv.y), bflo(xv.z), bfhi(xv.z), bflo(xv.w), bfhi(xv.w)};
        float la[8], bx[8];
#pragma unroll
        for (int e = 0; e < 8; ++e) {
          const float e1 = 1.f + __expf(-fminf(fmaxf(acc[ai][0][m][e >> 2][e & 3] + br[e], -30.f), 30.f));
          const float e2 = 1.f + __expf(-fminf(fmaxf(acc[ai][1][m][e >> 2][e & 3] + bi[e], -30.f), 30.f));
          const float q = __builtin_amdgcn_rcpf(e1 * e2);
          la[e] = (q * e2) * sp[e];
          bx[e] = (q * e1) * x[e];
        }
        u32x4 w0, w1;
        w0.x = pack2(la[0], la[1]); w0.y = pack2(la[2], la[3]); w0.z = pack2(la[4], la[5]); w0.w = pack2(la[6], la[7]);
        w1.x = pack2(bx[0], bx[1]); w1.y = pack2(bx[2], bx[3]); w1.z = pack2(bx[4], bx[5]); w1.w = pack2(bx[6], bx[7]);
        *(u32x4*)(gates + (size_t)(2 * dir) * T_ALL * 1024 + ro) = w0;
        *(u32x4*)(gates + (size_t)(2 * dir + 1) * T_ALL * 1024 + ro) = w1;
      }
  }
};
}

template <int KW, bool SILU>
__device__ __forceinline__ void phase_dwconv(const bf16_t* __restrict__ src, int ld_src, bf16_t* __restrict__ dst, int ld_dst, int CH,
                             const float* __restrict__ w, const float* __restrict__ b, bool colmajor, int bid, int nblk, int cxw) {
  const int tidx = opaque_tid(cxw);
  const int cpr = CH / 8;
  const size_t total = (size_t)T_ALL * cpr;
  float wreg[KW][8], breg[8]; int wc0 = -1;
  for (size_t idx = (size_t)bid * NTHR + tidx; idx < total; idx += (size_t)nblk * NTHR) {
    int tok = (int)(idx / cpr), c0 = (int)(idx % cpr) * 8;
    if (c0 != wc0) {
      wc0 = c0;
#pragma unroll
      for (int e = 0; e < 8; ++e) breg[e] = b[c0 + e];
#pragma unroll
      for (int k = 0; k < KW; ++k)
#pragma unroll
        for (int e = 0; e < 8; ++e) wreg[k][e] = w[(size_t)k * CH + c0 + e];
    }
    TokInfo ti = tokinfo(tok);
    bool cm = colmajor && ti.s >= 32;
    int pos = seqpos2off(ti.l, cm);
    float acc[8];
#pragma unroll
    for (int e = 0; e < 8; ++e) acc[e] = breg[e];
#pragma unroll
    for (int k = 0; k < KW; ++k) {
      int pp = pos + k - 1;
      if (pp < 0 || pp >= ti.L) continue;
      int tk = ti.base + seqpos2off(pp, cm);
      u32x4 xv = *(const u32x4*)(src + (size_t)tk * ld_src + c0);
      const float* wk = wreg[k];
      acc[0] += wk[0] * bflo(xv.x); acc[1] += wk[1] * bfhi(xv.x);
      acc[2] += wk[2] * bflo(xv.y); acc[3] += wk[3] * bfhi(xv.y);
      acc[4] += wk[4] * bflo(xv.z); acc[5] += wk[5] * bfhi(xv.z);
      acc[6] += wk[6] * bflo(xv.w); acc[7] += wk[7] * bfhi(xv.w);
    }
    if (SILU) {
#pragma unroll
      for (int e = 0; e < 8; ++e) acc[e] = siluf(acc[e]);
    }
    u32x4 o;
    o.x = pack2(acc[0], acc[1]); o.y = pack2(acc[2], acc[3]); o.z = pack2(acc[4], acc[5]); o.w = pack2(acc[6], acc[7]);
    *(u32x4*)(dst + (size_t)tok * ld_dst + c0) = o;
  }
}

__device__ __forceinline__ void phase_ssd_conv(const Params& p, int slot, bool colmajor, int bid, int nblk, unsigned char* smem, unsigned* wg_bar, int cxw) {
  const int tid = opaque_tid(cxw);
  VB_DECL(wg_bar);
  const bf16_t* raw = (const bf16_t*)(p.scratch + SC_SSD_XBC);
  bf16_t* out = (bf16_t*)(p.scratch + SC_SSD_XBCC);
  bf16_t* XT = (bf16_t*)(p.scratch + SC_SSD_XT);
  bf16_t* BT = (bf16_t*)(p.scratch + SC_SSD_BT);
  bf16_t* BF = (bf16_t*)(p.scratch + SC_SSD_BF);
  bf16_t* CF = (bf16_t*)(p.scratch + SC_SSD_CF);
  const float* cw = p.ssd_conv_w + (size_t)slot * 4 * 4096;
  const float* cb = p.ssd_conv_b + slot * 4096;
  bf16_t* tl = (bf16_t*)smem;
  bf16_t* rt = tl + 64 * 72;
  const int rr = tid >> 2, cpart = tid & 3;
  const int NITEMS = 384 * 64;
  u32x4 pre[2][3];
#define CONV_PREFETCH(SET, ITEM) do { const int it_ = (ITEM); const int ptile_ = it_ >> 6, ct_ = it_ & 63; \
    const TokInfo ti_ = tokinfo(ptile_ * 64); const bool cm_ = colmajor && ti_.s >= 32; \
    _Pragma("unroll") for (int i_ = 0; i_ < 3; ++i_) { const int q_ = tid + i_ * 256; const int row_ = q_ >> 3, c8_ = (q_ & 7) * 8; \
      const int pp_ = ti_.l - 1 + row_; u32x4 v_ = {0u, 0u, 0u, 0u}; \
      if (row_ < 67 && pp_ >= 0 && pp_ < ti_.L) v_ = *(const u32x4*)(raw + (size_t)(ti_.base + seqpos2off(pp_, cm_)) * 4096 + ct_ * 64 + c8_); \
      pre[SET][i_] = v_; } } while (0)
  if (bid < NITEMS) CONV_PREFETCH(0, bid);
  if (bid + nblk < NITEMS) CONV_PREFETCH(1, bid + nblk);
  {
    const int lane_ = tid & 63, w_ = cxw & 3, r_ = lane_ & 31, hh_ = lane_ >> 5, ti_ = w_ >> 1, tj_ = w_ & 1;
    const bf16_t* Wdt = p.wt_ssd_in + (size_t)slot * 6400 * 1024 + (size_t)6144 * 1024;
    float* dto = (float*)(p.scratch + SC_SSD_DT);
    const float dbias = p.ssd_dt_bias[slot * 64 + 32 * tj_ + r_];
    for (int it2 = bid; it2 < T_ALL / 64; it2 += nblk) {
      const bf16_t* ap = p.hbuf + (size_t)(it2 * 64 + 32 * ti_ + r_) * 1024 + 32 * hh_;
      const bf16_t* bp = Wdt + (size_t)(32 * tj_ + r_) * 1024 + 32 * hh_;
      f32x16 dacc;
#pragma unroll
      for (int e = 0; e < 16; ++e) dacc[e] = 0.f;
#pragma nounroll
      for (int q0 = 0; q0 < 16; q0 += 4) {
        bf16x8 a_[16], b_[16];
#pragma unroll
        for (int i = 0; i < 16; ++i) { a_[i] = *(const bf16x8*)(ap + 64 * (q0 + (i >> 2)) + 8 * (i & 3)); b_[i] = *(const bf16x8*)(bp + 64 * (q0 + (i >> 2)) + 8 * (i & 3)); }
        __builtin_amdgcn_sched_barrier(0);
#pragma unroll
        for (int i = 0; i < 16; ++i) dacc = __builtin_amdgcn_mfma_f32_32x32x16_bf16(a_[i], b_[i], dacc, 0, 0, 0);
        __builtin_amdgcn_sched_barrier(0);
      }
#pragma unroll
      for (int e = 0; e < 16; ++e) {
        const int row = (e & 3) + 8 * (e >> 2) + 4 * hh_;
        dto[(size_t)(it2 * 64 + 32 * ti_ + row) * 64 + 32 * tj_ + r_] = softplusf(dacc[e] + dbias);
      }
    }
  }
  float wreg[4][16], wb[16]; int wct = -1;
  for (int item0 = bid; item0 < NITEMS; item0 += 2 * nblk) {
#pragma unroll
   for (int u2 = 0; u2 < 2; ++u2) {
    const int item = item0 + u2 * nblk;
    if (item >= NITEMS) break;
    const int ptile = item >> 6, ct = item & 63;
    const int ptok0 = ptile * 64;
    const int ch = ct * 64 + cpart * 16;
    VB_SYNC();
#pragma unroll
    for (int i = 0; i < 3; ++i) { const int q = tid + i * 256; if (q < 67 * 8) *(u32x4*)(rt + (q >> 3) * 72 + (q & 7) * 8) = pre[u2][i]; }
    if (item + 2 * nblk < NITEMS) CONV_PREFETCH(u2, item + 2 * nblk);
    VB_SYNC();
    if (ct != wct) {
      wct = ct;
#pragma unroll
      for (int e = 0; e < 16; ++e) wb[e] = cb[ch + e];
#pragma unroll
      for (int k = 0; k < 4; ++k)
#pragma unroll
        for (int e = 0; e < 16; ++e) wreg[k][e] = cw[(size_t)k * 4096 + ch + e];
    }
    float acc[16];
#pragma unroll
    for (int e = 0; e < 16; ++e) acc[e] = wb[e];
#pragma unroll
    for (int k = 0; k < 4; ++k) {
      const bf16_t* rp = rt + (rr + k) * 72 + cpart * 16;
      u32x4 x0 = *(const u32x4*)rp, x1 = *(const u32x4*)(rp + 8);
      unsigned xw[8] = {x0.x, x0.y, x0.z, x0.w, x1.x, x1.y, x1.z, x1.w};
#pragma unroll
      for (int e = 0; e < 8; ++e) { acc[2 * e] += wreg[k][2 * e] * bflo(xw[e]); acc[2 * e + 1] += wreg[k][2 * e + 1] * bfhi(xw[e]); }
    }
    u32x4 o0, o1;
    o0.x = pack2(siluf(acc[0]), siluf(acc[1])); o0.y = pack2(siluf(acc[2]), siluf(acc[3]));
    o0.z = pack2(siluf(acc[4]), siluf(acc[5])); o0.w = pack2(siluf(acc[6]), siluf(acc[7]));
    o1.x = pack2(siluf(acc[8]), siluf(acc[9])); o1.y = pack2(siluf(acc[10]), siluf(acc[11]));
    o1.z = pack2(siluf(acc[12]), siluf(acc[13])); o1.w = pack2(siluf(acc[14]), siluf(acc[15]));
    *(u32x4*)(tl + rr * 72 + cpart * 16) = o0;
    *(u32x4*)(tl + rr * 72 + cpart * 16 + 8) = o1;
    VB_SYNC();
    if (ct < 32) {
      const int crow = tid >> 2, part = tid & 3;
      unsigned wv[8];
#pragma unroll
      for (int e = 0; e < 8; ++e) {
        unsigned lo = tl[(part * 16 + 2 * e) * 72 + crow], hi = tl[(part * 16 + 2 * e + 1) * 72 + crow];
        wv[e] = lo | (hi << 16);
      }
      bf16_t* dp = XT + (size_t)(ct * 64 + crow) * T_ALL + ptok0 + part * 16;
      u32x4 t0, t1;
      t0.x = wv[0]; t0.y = wv[1]; t0.z = wv[2]; t0.w = wv[3]; t1.x = wv[4]; t1.y = wv[5]; t1.z = wv[6]; t1.w = wv[7];
      *(u32x4*)dp = t0; *(u32x4*)(dp + 8) = t1;
    } else {
      const bool isB = ct < 48;
      const int cq = (ct - (isB ? 32 : 48));
      const int g = cq >> 1, chhalf = cq & 1;
      const int lane = tid & 63, r = lane & 31, hh = lane >> 5;
      bf16_t* F = isB ? BF : CF;
#pragma unroll
      for (int i = 0; i < 2; ++i) {
        const int f = (cxw & 3) + 4 * i;
        const int rt2 = f >> 2, kk4 = f & 3;
        const u32x4 v = *(const u32x4*)(tl + (32 * rt2 + r) * 72 + 16 * kk4 + 8 * hh);
        const size_t rt = (size_t)(ptok0 >> 5) + rt2;
        *(u32x4*)(F + (((rt * 8 + g) * 8 + chhalf * 4 + kk4) * 64 + lane) * 8) = v;
      }
      if (isB) {
#pragma unroll
        for (int i = 0; i < 2; ++i) {
          const int f = (cxw & 3) + 4 * i;
          const int nt2 = f >> 2, ts4 = f & 3;
          unsigned wv[4];
#pragma unroll
          for (int e = 0; e < 4; ++e) {
            unsigned lo = tl[(16 * ts4 + 8 * hh + 2 * e) * 72 + 32 * nt2 + r], hi = tl[(16 * ts4 + 8 * hh + 2 * e + 1) * 72 + 32 * nt2 + r];
            wv[e] = lo | (hi << 16);
          }
          u32x4 v; v.x = wv[0]; v.y = wv[1]; v.z = wv[2]; v.w = wv[3];
          const size_t ts = (size_t)(ptok0 >> 4) + ts4;
          *(u32x4*)(BT + (((ts * 8 + g) * 4 + chhalf * 2 + nt2) * 64 + lane) * 8) = v;
        }
      }
    }
   }
  }
}

#define SH_STRIDE 136
__device__ __forceinline__ int rowmap(int e, int hh) { return (e & 3) + 8 * (e >> 2) + 4 * hh; }
__device__ __forceinline__ bf16x8 pack8(float a0, float a1, float a2, float a3, float a4, float a5, float a6, float a7) {
  u32x4 v; v.x = pack2(a0, a1); v.y = pack2(a2, a3); v.z = pack2(a4, a5); v.w = pack2(a6, a7);
  return __builtin_bit_cast(bf16x8, v);
}
#define SCAN_PRIV 56576
#define SCAN_SF 49152
__device__ __forceinline__ void phase_ssd_scan(const Params& p, int slot, bool colmajor, int bid, int nblk, unsigned char* wg_smem, int cxw) {
  const int tid = opaque_tid(cxw), lane = tid & 63, w = cxw & 3, vb = cxw >> 2, r = lane & 31, hh = lane >> 5;
  const int it = (w >> 1) ^ vb, pt = w & 1;
  const bf16_t* XT = (const bf16_t*)(p.scratch + SC_SSD_XT);
  const bf16_t* BT = (const bf16_t*)(p.scratch + SC_SSD_BT);
  const bf16_t* BF = (const bf16_t*)(p.scratch + SC_SSD_BF);
  const bf16_t* CF = (const bf16_t*)(p.scratch + SC_SSD_CF);
  const float* dtb = (const float*)(p.scratch + SC_SSD_DT);
  bf16_t* ybuf = (bf16_t*)(p.scratch + SC_SSD_XBC);
  unsigned char* priv = wg_smem + (vb ? SCAN_SF + SCAN_PRIV : 0);
  bf16_t* sXr = (bf16_t*)priv;
  bf16_t* sXs = sXr + 64 * 72;
  bf16_t* sH = sXs + 64 * 72;
  float* sW = (float*)(sH + 64 * SH_STRIDE);
  bf16_t* sY = (bf16_t*)(sW + 4 * 256);
  bf16_t* sXd = sY + 64 * 64;
  float* sDt = (float*)(sXd + 64 * 64);
  float* myW = sW + w * 256;
  const bf16_t* sfC = (const bf16_t*)(wg_smem + SCAN_PRIV);
  const bf16_t* sfB = sfC + 8192;
  const bf16_t* sfT = sfC + 16384;
  const bool bal = (nblk == 512);
  const int nit = bal ? ((bid >> 1) < 128 ? 1 : 8) : 0;
  for (int k = 0, item = bid; bal ? k < nit : item < 36 * 64; ++k, item += bal ? 256 : nblk) {
    int s, h, dir;
    if (bal && item < 256) {
      const int wgp = item >> 1, x = wgp & 7, j = wgp >> 3, hsel = j & 1, rest = (j >> 1) * 8 + x;
      s = 32 + (rest >> 4); dir = rest & 1;
      h = (((rest >> 1) & 7) * 2 + hsel) * 2 + (item & 1);
    } else {
      const int itx = item < 256 ? item : item - 256;
      const int idx = itx & 63, pairidx = idx >> 1;
      s = item < 256 ? 32 + (itx >> 6) : (itx >> 6);
      dir = pairidx & 1; h = (pairidx >> 1) * 2 + (idx & 1);
    }
    const int L = s < 32 ? 256 : 4096;
    const int base = s < 32 ? s * 256 : T_CTX + (s - 32) * 4096;
    const bool cm = colmajor && s >= 32;
    const int g = h >> 2;
    const float Aval = -expf(p.ssd_a_log[(slot * 2 + dir) * 32 + h]);
    const float dskip = p.ssd_d[slot * 32 + h];
    const int nchunks = L >> 6;
    const int pcol = 32 * pt + r;
    f32x16 hacc[2];
    if (s >= 32) {
      const float* h0 = p.state_ssd + ((((size_t)(s - 32) * 2 + slot) * 2 + dir) * 32 + h) * 8192 + (size_t)pcol * 128;
#pragma unroll
      for (int t2 = 0; t2 < 2; ++t2)
#pragma unroll
        for (int qd = 0; qd < 4; ++qd) {
          f32x4 v = *(const f32x4*)(h0 + 32 * (2 * it + t2) + 8 * qd + 4 * hh);
          hacc[t2][4 * qd] = v.x; hacc[t2][4 * qd + 1] = v.y; hacc[t2][4 * qd + 2] = v.z; hacc[t2][4 * qd + 3] = v.w;
        }
    } else {
#pragma unroll
      for (int t2 = 0; t2 < 2; ++t2)
#pragma unroll
        for (int e = 0; e < 16; ++e) hacc[t2][e] = 0.f;
    }
#define SCAN_PTOK(c) (base + 64 * (dir ? nchunks - 1 - (c) : (c)))
#define SCAN_DMA_DTX(pt0) do { \
      _Pragma("unroll") for (int i_ = 0; i_ < 2; ++i_) { \
        const bf16_t* src_ = XT + (size_t)(h * 64 + 16 * w + 8 * i_ + (lane >> 3)) * T_ALL + (pt0) + (lane & 7) * 8; \
        __builtin_amdgcn_global_load_lds((const unsigned*)src_, (PG8_LAS unsigned*)((unsigned char*)sXd + (16 * w + 8 * i_) * 128), 16, 0, 0); } \
      { const int tok_ = base + seqpos2off((pt0) - base + lane, cm); \
        const float* dsrc_ = dtb + (size_t)tok_ * 64 + dir * 32 + h; \
        __builtin_amdgcn_global_load_lds((const unsigned*)dsrc_, (PG8_LAS unsigned*)sDt, 4, 0, 0); } } while (0)
#define SCAN_DMA(pt0) do { \
      _Pragma("unroll") for (int i_ = 0; i_ < 6; ++i_) { const int q_ = cxw + 8 * (i_ & 1); \
        const bf16_t* src_; \
        if (i_ < 4) src_ = (i_ < 2 ? CF : BF) + ((((size_t)((pt0) >> 5) + (q_ >> 3)) * 8 + g) * 8 + (q_ & 7)) * 512 + lane * 8; \
        else src_ = BT + ((((size_t)((pt0) >> 4) + (q_ >> 2)) * 8 + g) * 4 + (q_ & 3)) * 512 + lane * 8; \
        __builtin_amdgcn_global_load_lds((const unsigned*)src_, (PG8_LAS unsigned*)(wg_smem + SCAN_PRIV + (i_ >> 1) * 16384 + q_ * 1024), 16, 0, 0); } } while (0)
#define SCAN_WRITE_STATE() do { \
      _Pragma("unroll") for (int t2 = 0; t2 < 2; ++t2) _Pragma("unroll") for (int qd = 0; qd < 4; ++qd) { \
        u32x2 o_; o_.x = pack2(hacc[t2][4 * qd], hacc[t2][4 * qd + 1]); o_.y = pack2(hacc[t2][4 * qd + 2], hacc[t2][4 * qd + 3]); \
        *(u32x2*)(sH + pcol * SH_STRIDE + 32 * (2 * it + t2) + 8 * qd + 4 * hh) = o_; } } while (0)
    const bool need0 = dir == 0 ? true : (it == 0);
    const bool need1 = dir == 0 ? (it == 1) : true;
    __syncthreads();
    {
      const int p0 = SCAN_PTOK(0);
      SCAN_DMA_DTX(p0);
      SCAN_DMA(p0);
      SCAN_WRITE_STATE();
    }
#define SCAN_BAR_A() do { asm volatile("s_waitcnt vmcnt(6) lgkmcnt(0)" ::: "memory"); __builtin_amdgcn_s_barrier(); asm volatile("" ::: "memory"); } while (0)
#define SCAN_BAR_LDS() do { asm volatile("s_waitcnt lgkmcnt(0)" ::: "memory"); __builtin_amdgcn_s_barrier(); asm volatile("" ::: "memory"); } while (0)
#define SCAN_BAR_MEM() do { asm volatile("s_waitcnt vmcnt(0) lgkmcnt(0)" ::: "memory"); __builtin_amdgcn_s_barrier(); asm volatile("" ::: "memory"); } while (0)
    for (int ci = 0; ci < nchunks; ++ci) {
      const int cin = ci + 1 < nchunks ? ci + 1 : ci;
      const int ptokN = SCAN_PTOK(cin);
      SCAN_BAR_A();
      float decE, gfac;
      {
        const float dtv = sDt[lane];
        const float a_ = dtv * Aval;
        const float pre = wave_incl_scan(a_);
        const float cE = __int_as_float(__builtin_amdgcn_readlane(__float_as_int(pre), 63));
        const float c = dir == 0 ? pre : cE - pre + a_;
        myW[lane] = dtv; myW[64 + lane] = c; myW[128 + lane] = __expf(c); myW[192 + lane] = dtv * __expf(cE - c);
        decE = __expf(cE);
        const float cref = __int_as_float(__builtin_amdgcn_readlane(__float_as_int(c), dir == 0 ? 31 : 32));
        const bool is_col = dir == 0 ? (lane < 32) : (lane >= 32);
        gfac = is_col ? dtv * __expf(cref - c) : __expf(c - cref);
      }
#pragma unroll
      for (int i = 0; i < 2; ++i) {
        const int q = tid + i * 256, prow = q >> 3, j8 = (q & 7) * 8;
        const u32x4 raw = *(const u32x4*)(sXd + prow * 64 + j8);
        *(u32x4*)(sXr + prow * 72 + j8) = raw;
        f32x4 f0 = *(const f32x4*)(myW + 192 + j8), f1 = *(const f32x4*)(myW + 192 + j8 + 4);
        u32x4 sc;
        sc.x = pack2(bflo(raw.x) * f0.x, bfhi(raw.x) * f0.y); sc.y = pack2(bflo(raw.y) * f0.z, bfhi(raw.y) * f0.w);
        sc.z = pack2(bflo(raw.z) * f1.x, bfhi(raw.z) * f1.y); sc.w = pack2(bflo(raw.w) * f1.z, bfhi(raw.w) * f1.w);
        *(u32x4*)(sXs + prow * 72 + j8) = sc;
      }
      SCAN_BAR_MEM();
      myW[192 + lane] = gfac;
      if (ci > 0) {
        const int ptokP = SCAN_PTOK(ci - 1);
#pragma unroll
        for (int i = 0; i < 2; ++i) {
          const int q = tid + i * 256, yrow = q >> 3, c8 = (q & 7) * 8;
          *(u32x4*)(ybuf + ((size_t)dir * T_ALL + ptokP + yrow) * 2048 + h * 64 + c8) = *(const u32x4*)(sY + yrow * 64 + c8);
        }
      }
      SCAN_DMA_DTX(ptokN);
#pragma unroll
      for (int t2 = 0; t2 < 2; ++t2) {
#pragma unroll
        for (int e = 0; e < 16; ++e) hacc[t2][e] *= decE;
        const bf16_t* xs = sXs + pcol * 72 + 8 * hh;
#pragma unroll
        for (int kk = 0; kk < 4; ++kk)
          hacc[t2] = __builtin_amdgcn_mfma_f32_32x32x16_bf16(*(const bf16x8*)(sfT + (kk * 4 + 2 * it + t2) * 512 + lane * 8), *(const bf16x8*)(xs + 16 * kk), hacc[t2], 0, 0, 0);
      }
      bf16x8 cfr[8];
#pragma unroll
      for (int kk = 0; kk < 8; ++kk) cfr[kk] = *(const bf16x8*)(sfC + (it * 8 + kk) * 512 + lane * 8);
      f32x16 acc;
#pragma unroll
      for (int e = 0; e < 16; ++e) acc[e] = 0.f;
      {
        const bf16_t* hp = sH + pcol * SH_STRIDE + 8 * hh;
#pragma unroll
        for (int kk = 0; kk < 8; ++kk) acc = __builtin_amdgcn_mfma_f32_32x32x16_bf16(cfr[kk], *(const bf16x8*)(hp + 16 * kk), acc, 0, 0, 0);
      }
      f32x16 X[2];
#pragma unroll
      for (int jt = 0; jt < 2; ++jt) {
#pragma unroll
        for (int e = 0; e < 16; ++e) X[jt][e] = 0.f;
        if (jt == 0 ? need0 : need1) {
#pragma unroll
          for (int kk = 0; kk < 8; ++kk) X[jt] = __builtin_amdgcn_mfma_f32_32x32x16_bf16(*(const bf16x8*)(sfB + (jt * 8 + kk) * 512 + lane * 8), cfr[kk], X[jt], 0, 0, 0);
        }
      }
      SCAN_BAR_LDS();
      SCAN_DMA(ptokN);
      SCAN_WRITE_STATE();
#pragma unroll
      for (int qd = 0; qd < 4; ++qd) {
        f32x4 ec = *(const f32x4*)(myW + 128 + 32 * it + 8 * qd + 4 * hh);
        acc[4 * qd] *= ec.x; acc[4 * qd + 1] *= ec.y; acc[4 * qd + 2] *= ec.z; acc[4 * qd + 3] *= ec.w;
      }
      const int icol = 32 * it + r;
      const float ci_ = myW[64 + icol];
#pragma unroll
      for (int jt = 0; jt < 2; ++jt) {
        if (jt == 0 ? need0 : need1) {
          if (jt != it) {
            const float rowf = myW[192 + icol];
#pragma unroll
            for (int qd = 0; qd < 4; ++qd) {
              const f32x4 cf = *(const f32x4*)(myW + 192 + 32 * jt + 8 * qd + 4 * hh);
              X[jt][4 * qd] *= cf.x * rowf; X[jt][4 * qd + 1] *= cf.y * rowf; X[jt][4 * qd + 2] *= cf.z * rowf; X[jt][4 * qd + 3] *= cf.w * rowf;
            }
          } else {
#pragma unroll
          for (int qd = 0; qd < 4; ++qd) {
            const int j0 = 32 * jt + 8 * qd + 4 * hh;
            f32x4 cj = *(const f32x4*)(myW + 64 + j0), dj = *(const f32x4*)(myW + j0);
            float cjv[4] = {cj.x, cj.y, cj.z, cj.w}, djv[4] = {dj.x, dj.y, dj.z, dj.w};
#pragma unroll
            for (int u = 0; u < 4; ++u) {
              const int j = j0 + u;
              const bool ok = dir == 0 ? (j <= icol) : (j >= icol);
              const float m = __expf(ci_ - cjv[u]) * djv[u];
              X[jt][4 * qd + u] = ok ? X[jt][4 * qd + u] * m : 0.f;
            }
          }
          }
#pragma unroll
          for (int sk = 0; sk < 2; ++sk) {
            bf16x8 afr = pack8(X[jt][8 * sk], X[jt][8 * sk + 1], X[jt][8 * sk + 2], X[jt][8 * sk + 3], X[jt][8 * sk + 4], X[jt][8 * sk + 5], X[jt][8 * sk + 6], X[jt][8 * sk + 7]);
            const bf16_t* xp = sXr + pcol * 72 + 32 * jt + 16 * sk + 4 * hh;
            u32x2 lo = *(const u32x2*)xp, hi = *(const u32x2*)(xp + 8);
            u32x4 xv; xv.x = lo.x; xv.y = lo.y; xv.z = hi.x; xv.w = hi.y;
            acc = __builtin_amdgcn_mfma_f32_32x32x16_bf16(afr, __builtin_bit_cast(bf16x8, xv), acc, 0, 0, 0);
          }
        }
      }
      if (dir == 0) {
#pragma unroll
        for (int qd = 0; qd < 4; ++qd) {
          const u32x2 xw = *(const u32x2*)(sXr + pcol * 72 + 32 * it + 8 * qd + 4 * hh);
          acc[4 * qd] += dskip * bflo(xw.x); acc[4 * qd + 1] += dskip * bfhi(xw.x);
          acc[4 * qd + 2] += dskip * bflo(xw.y); acc[4 * qd + 3] += dskip * bfhi(xw.y);
        }
      }
      {
        bf16_t* yo = sY + (32 * it) * 64 + pcol;
#pragma unroll
        for (int e = 0; e < 16; ++e) yo[rowmap(e, hh) * 64] = f2bf(acc[e]);
      }
    }
    __syncthreads();
    {
      const int ptokP = SCAN_PTOK(nchunks - 1);
#pragma unroll
      for (int i = 0; i < 2; ++i) {
        const int q = tid + i * 256, yrow = q >> 3, c8 = (q & 7) * 8;
        *(u32x4*)(ybuf + ((size_t)dir * T_ALL + ptokP + yrow) * 2048 + h * 64 + c8) = *(const u32x4*)(sY + yrow * 64 + c8);
      }
    }
#undef SCAN_PTOK
#undef SCAN_DMA_DTX
#undef SCAN_DMA
#undef SCAN_WRITE_STATE
    if (s < 32) {
      float* ho = p.out_ssd + ((((size_t)s * 2 + slot) * 2 + dir) * 32 + h) * 8192 + (size_t)pcol * 128;
#pragma unroll
      for (int t2 = 0; t2 < 2; ++t2)
#pragma unroll
        for (int qd = 0; qd < 4; ++qd) {
          f32x4 v; v.x = hacc[t2][4 * qd]; v.y = hacc[t2][4 * qd + 1]; v.z = hacc[t2][4 * qd + 2]; v.w = hacc[t2][4 * qd + 3];
          *(f32x4*)(ho + 32 * (2 * it + t2) + 8 * qd + 4 * hh) = v;
        }
    }
    asm volatile("s_waitcnt vmcnt(0)" ::: "memory");
  }
}

__device__ __forceinline__ void phase_ssd_gate(const Params& p, int slot, int bid, int nblk, int cxw, int row0, int row1) {
  const int tidx = opaque_tid(cxw);
  bf16_t* zb = (bf16_t*)(p.scratch + SC_SSD_Z);
  const bf16_t* yfb = (const bf16_t*)(p.scratch + SC_SSD_XBC);
  const bf16_t* ybb = yfb + (size_t)T_ALL * 2048;
  const bf16_t* xbcc = (const bf16_t*)(p.scratch + SC_SSD_XBCC);
  int lane = tidx & 63, wv = cxw & 3;
  for (int row = row0 + bid * 4 + wv; row < row1; row += nblk * 4) {
    float ss = 0.f;
    TokInfo ti = tokinfo(row);
    const int prow = ti.base + seqpos2off(ti.l, slot == 1 && ti.s >= 32);
#pragma unroll
    for (int j = 0; j < 4; ++j) {
      int c0 = j * 512 + lane * 8;
      u32x4 zv = *(const u32x4*)(zb + (size_t)row * 2048 + c0);
      u32x4 fv = *(const u32x4*)(yfb + (size_t)prow * 2048 + c0);
      u32x4 bv = *(const u32x4*)(ybb + (size_t)prow * 2048 + c0);
      unsigned zw[4] = {zv.x, zv.y, zv.z, zv.w}, fw[4] = {fv.x, fv.y, fv.z, fv.w}, bw[4] = {bv.x, bv.y, bv.z, bv.w};
      unsigned ow[4];
#pragma unroll
      for (int e = 0; e < 4; ++e) {
        float y0 = (bflo(fw[e]) + bflo(bw[e])) * siluf(bflo(zw[e]));
        float y1 = (bfhi(fw[e]) + bfhi(bw[e])) * siluf(bfhi(zw[e]));
        ss += y0 * y0 + y1 * y1;
        ow[e] = pack2(y0, y1);
      }
      u32x4 o; o.x = ow[0]; o.y = ow[1]; o.z = ow[2]; o.w = ow[3];
      *(u32x4*)(zb + (size_t)row * 2048 + c0) = o;
    }
    ss = wave_sum(ss);
    if (lane == 0) p.rstd[row] = rsqrtf(ss * (1.f / 2048.f) + 1e-5f);
  }
}

#define HY_UOFF (32768 + 64)
template <int UNR>
__device__ __forceinline__ void hy_stage_conv(const Params& p, const bf16_t* __restrict__ row, int ch, bf16_t* dst, int dstStride, int dstPad,
                                              int nelem, int L, int tid) {
  const float w0 = p.hy_conv_w[ch], w1 = p.hy_conv_w[3072 + ch], w2 = p.hy_conv_w[2 * 3072 + ch], bb = p.hy_conv_b[ch];
  for (int q0 = tid; q0 < nelem / 8; q0 += UNR * NTHR) {
    u32x4 raw[UNR]; unsigned short hl[UNR], hr[UNR];
#pragma unroll
    for (int j = 0; j < UNR; ++j) {
      const int e0 = (q0 + j * NTHR) * 8, t0 = e0 & (L - 1);
      raw[j] = *(const u32x4*)(row + e0);
      hl[j] = t0 > 0 ? *(const unsigned short*)(row + e0 - 1) : (unsigned short)0;
      hr[j] = t0 + 8 < L ? *(const unsigned short*)(row + e0 + 8) : (unsigned short)0;
    }
#pragma unroll
    for (int j = 0; j < UNR; ++j) {
      const int e0 = (q0 + j * NTHR) * 8, b = e0 / L, t0 = e0 & (L - 1);
      float x[10];
      x[0] = __uint_as_float((unsigned)hl[j] << 16);
      x[9] = __uint_as_float((unsigned)hr[j] << 16);
      x[1] = bflo(raw[j].x); x[2] = bfhi(raw[j].x); x[3] = bflo(raw[j].y); x[4] = bfhi(raw[j].y);
      x[5] = bflo(raw[j].z); x[6] = bfhi(raw[j].z); x[7] = bflo(raw[j].w); x[8] = bfhi(raw[j].w);
      float o[8];
#pragma unroll
      for (int jj = 0; jj < 8; ++jj) o[jj] = w0 * x[jj] + w1 * x[jj + 1] + w2 * x[jj + 2] + bb;
      u32x4 ov; ov.x = pack2(o[0], o[1]); ov.y = pack2(o[2], o[3]); ov.z = pack2(o[4], o[5]); ov.w = pack2(o[6], o[7]);
      *(u32x4*)(dst + b * dstStride + dstPad + t0) = ov;
    }
  }
}

__device__ __forceinline__ void phase_hy_longconv(const Params& p, int bid, int nblk, unsigned char* smem, unsigned* wg_bar, int cxw) {
  const int tid = opaque_tid(cxw), lane = tid & 63, w = cxw & 3  , r = lane & 31, hh = lane >> 5;
  const bf16_t* projT = (const bf16_t*)(p.scratch + SC_HY_PROJT);
  bf16_t* yT = (bf16_t*)(p.scratch + SC_HY_YT);
  unsigned* Rc0 = (unsigned*)smem;
  unsigned* Rc1 = Rc0 + 4096 + 16;
  bf16_t* G = (bf16_t*)smem;
  bf16_t* U = (bf16_t*)(smem + HY_UOFF);
  VB_DECL(wg_bar);
  const int nitems = (2048 - bid + nblk - 1) / nblk;
  for (int k = 0; k < nitems; ++k) {
    const int item = bid + nblk * ((cxw >> 2) ? nitems - 1 - k : k);
    const bool lat = item < 1024;
    const int c = item & 1023;
    const int L = lat ? 4096 : 256, NB = lat ? 4 : 32, RL = lat ? 8192 : 512, Lm1 = L - 1;
    const int PAD = lat ? 224 : 0, US = lat ? 4552 : 264;
    const int tokbase = lat ? T_CTX : 0;
    const int nI = L >> 5, nelem = NB * L;
    const int TPW = lat ? 4 : 2;
    VB_SYNC();
    if (lat) {
      for (int q = tid; q < 4 * 57; q += NTHR) {
        int b = q / 57, k = q % 57;
        int off = k < 28 ? k * 8 : 224 + 4096 + (k - 28) * 8;
        unsigned zz = 0u; asm volatile("" : "+v"(zz));
        u32x4 z4 = {zz, zz, zz, zz};
        *(u32x4*)(U + b * US + off) = z4;
      }
    }
    hy_stage_conv<4>(p, projT + (size_t)c * T_ALL + tokbase, c, U, US, PAD, nelem, L, tid);
    int Icol[4], bcol[4];
#pragma unroll
    for (int tt = 0; tt < 4; ++tt) {
      int n = (w * TPW + tt) * 32 + r;
      Icol[tt] = lat ? (n >> 2) : (n >> 5);
      bcol[tt] = lat ? (n & 3) : (n & 31);
    }
    const int Ilo_w = lat ? 32 * w : 2 * w, Ihi_w = lat ? 32 * w + 31 : 2 * w + 1;
    const int dlo = Ilo_w - (nI - 1), dhi = Ihi_w;
    float invs[2], biases[2];
#pragma unroll
    for (int o2 = 0; o2 < 2; ++o2) { invs[o2] = p.knorm[((lat ? 1 : 0) * 2 + o2) * 1024 + c]; biases[o2] = p.hy_f_bias[o2 * 1024 + c]; }
    for (int order = 0; order < 2; ++order) {
      {
        const bf16_t* src = (lat ? p.rtab1 : p.rtab0) + (size_t)(order * 1024 + c) * RL;
        for (int q = tid; q < RL / 8; q += NTHR) {
          u32x4 cv = *(const u32x4*)(src + q * 8);
          unsigned nx = (q + 1 < RL / 8) ? *(const unsigned*)(src + q * 8 + 8) : 0u;
          *(u32x4*)(Rc0 + q * 4) = cv;
          u32x4 sv;
          sv.x = (cv.x >> 16) | (cv.y << 16); sv.y = (cv.y >> 16) | (cv.z << 16);
          sv.z = (cv.z >> 16) | (cv.w << 16); sv.w = (cv.w >> 16) | (nx << 16);
          *(u32x4*)(Rc1 + q * 4) = sv;
        }
      }
      VB_SYNC();
      u32x2 zpre[4][4];
      if (order == 1) {
#pragma unroll
        for (int tt = 0; tt < 4; ++tt)
          if (tt < TPW) {
#pragma unroll
            for (int qd = 0; qd < 4; ++qd)
              zpre[tt][qd] = *(const u32x2*)(projT + (size_t)(3072 + c) * T_ALL + tokbase + bcol[tt] * L + 32 * Icol[tt] + 8 * qd + 4 * hh);
          }
      }
      f32x16 acc[4];
#pragma unroll
      for (int tt = 0; tt < 4; ++tt)
#pragma unroll
        for (int e = 0; e < 16; ++e) acc[tt][e] = 0.f;
      {
        int lo_t[4], hi_t[4];
        const bf16_t* ub[4];
#pragma unroll
        for (int tt = 0; tt < 4; ++tt) {
          const int tile = w * TPW + tt;
          const int Ilo_t = lat ? 8 * tile : tile, Ihi_t = lat ? 8 * tile + 7 : tile;
          lo_t[tt] = tt < TPW ? Ilo_t - (nI - 1) : 1 << 30; hi_t[tt] = tt < TPW ? Ihi_t : -(1 << 30);
          ub[tt] = U + bcol[tt] * US + PAD + 32 * Icol[tt] + 8 * hh;
        }
        const int ybase = Lm1 - r + 8 * hh;
#define LC_LOAD(T0, T1, DD0, IT, A, B) do { const int it_ = (IT); const int d_ = (DD0) + (it_ >> 1), kk_ = it_ & 1; \
          const int y0_ = ybase - 32 * d_ + 16 * kk_; const int par_ = y0_ & 1; \
          const unsigned* rp_ = (par_ ? Rc1 : Rc0) + ((y0_ - par_) >> 1); \
          u32x4 av_; av_.x = rp_[0]; av_.y = rp_[1]; av_.z = rp_[2]; av_.w = rp_[3]; A = __builtin_bit_cast(bf16x8, av_); \
          _Pragma("unroll") for (int tt = 0; tt < 4; ++tt) if (tt >= (T0) && tt < (T1)) B[tt] = *(const bf16x8*)(ub[tt] - 32 * d_ + 16 * kk_); } while (0)
#define LC_MMA(T0, T1, A, B) do { _Pragma("unroll") for (int tt = 0; tt < 4; ++tt) if (tt >= (T0) && tt < (T1)) \
          acc[tt] = __builtin_amdgcn_mfma_f32_32x32x16_bf16(A, B[tt], acc[tt], 0, 0, 0); } while (0)
#define LC_SEG(T0, T1, DD0, DD1) do { const int sd0_ = (DD0), sd1_ = (DD1); \
          if (sd1_ >= sd0_) { const int NIT_ = 2 * (sd1_ - sd0_ + 1); \
            bf16x8 a0, a1, b0[4], b1[4]; \
            LC_LOAD(T0, T1, sd0_, 0, a0, b0); \
            for (int it = 0; it < NIT_; it += 2) { \
              LC_LOAD(T0, T1, sd0_, it + 1, a1, b1); \
              __builtin_amdgcn_sched_barrier(0); \
              LC_MMA(T0, T1, a0, b0); \
              __builtin_amdgcn_sched_barrier(0); \
              LC_LOAD(T0, T1, sd0_, it + 2 < NIT_ ? it + 2 : NIT_ - 1, a0, b0); \
              __builtin_amdgcn_sched_barrier(0); \
              LC_MMA(T0, T1, a1, b1); \
              __builtin_amdgcn_sched_barrier(0); \
            } } } while (0)
        if (!lat) {
          LC_SEG(0, 1, lo_t[0], lo_t[1] - 1);
          LC_SEG(0, 2, lo_t[1], hi_t[0]);
          LC_SEG(1, 2, hi_t[0] + 1, hi_t[1]);
        } else {
          LC_SEG(0, 1, lo_t[0], lo_t[1] - 1);
          LC_SEG(0, 2, lo_t[1], lo_t[2] - 1);
          LC_SEG(0, 3, lo_t[2], lo_t[3] - 1);
          LC_SEG(0, 4, lo_t[3], hi_t[0]);
          LC_SEG(1, 4, hi_t[0] + 1, hi_t[1]);
          LC_SEG(2, 4, hi_t[1] + 1, hi_t[2]);
          LC_SEG(3, 4, hi_t[2] + 1, hi_t[3]);
        }
#undef LC_LOAD
#undef LC_MMA
#undef LC_SEG
      }
      VB_SYNC();
      hy_stage_conv<2>(p, projT + (size_t)((1 + order) * 1024 + c) * T_ALL + tokbase, (1 + order) * 1024 + c, G, L, 0, nelem, L, tid);
      VB_SYNC();
      const float inv = __builtin_amdgcn_rcpf(order ? invs[1] : invs[0]);
      const float bias = order ? biases[1] : biases[0];
#pragma unroll
      for (int tt = 0; tt < 4; ++tt) {
        if (tt < TPW) {
#pragma unroll
          for (int qd = 0; qd < 4; ++qd) {
            const int t0 = 32 * Icol[tt] + 8 * qd + 4 * hh;
            bf16_t* up = U + bcol[tt] * US + PAD + t0;
            u32x2 uc = *(const u32x2*)up;
            u32x2 gg = *(const u32x2*)(G + bcol[tt] * L + t0);
            float r0 = (inv * acc[tt][4 * qd] + bias * bflo(uc.x)) * bflo(gg.x);
            float r1 = (inv * acc[tt][4 * qd + 1] + bias * bfhi(uc.x)) * bfhi(gg.x);
            float r2 = (inv * acc[tt][4 * qd + 2] + bias * bflo(uc.y)) * bflo(gg.y);
            float r3 = (inv * acc[tt][4 * qd + 3] + bias * bfhi(uc.y)) * bfhi(gg.y);
            if (order == 1) {
              const u32x2 zz = zpre[tt][qd];
              r0 *= siluf(bflo(zz.x)); r1 *= siluf(bfhi(zz.x)); r2 *= siluf(bflo(zz.y)); r3 *= siluf(bfhi(zz.y));
            }
            u32x2 ov; ov.x = pack2(r0, r1); ov.y = pack2(r2, r3);
            *(u32x2*)up = ov;
          }
        }
      }
      VB_SYNC();
    }
    for (int q = tid; q < nelem / 8; q += NTHR) {
      const int e0 = q * 8, b = e0 / L, t0 = e0 & (L - 1);
      *(u32x4*)(yT + (size_t)c * T_ALL + tokbase + e0) = *(const u32x4*)(U + b * US + PAD + t0);
    }
  }
}

__device__ __forceinline__ void phase_hy_transpose(const Params& p, int bid, int nblk, unsigned char* smem, unsigned* wg_bar, int cxw) {
  const int tid = opaque_tid(cxw);
  const bf16_t* yT = (const bf16_t*)(p.scratch + SC_HY_YT);
  bf16_t* yg = (bf16_t*)(p.scratch + SC_HY_YG);
  bf16_t* tl = (bf16_t*)smem;
  VB_DECL(wg_bar);
  const int NIT = 16 * (T_ALL / 64);
  u32x4 pre[2];
#define HT_PREFETCH(ITEM) do { const int it_ = (ITEM), cb_ = it_ & 15, tb_ = it_ >> 4; \
    _Pragma("unroll") for (int i_ = 0; i_ < 2; ++i_) { const int q_ = tid + i_ * 256, cr_ = q_ >> 3, t8_ = (q_ & 7) * 8; \
      pre[i_] = *(const u32x4*)(yT + (size_t)(cb_ * 64 + cr_) * T_ALL + tb_ * 64 + t8_); } } while (0)
  if (bid < NIT) HT_PREFETCH(bid);
  for (int item = bid; item < NIT; item += nblk) {
    const int cb = item & 15, tb = item >> 4;
    VB_SYNC();
#pragma unroll
    for (int i = 0; i < 2; ++i) {
      int q = tid + i * 256, cr = q >> 3, t8 = (q & 7) * 8;
      const u32x4 v = pre[i];
      unsigned wv[4] = {v.x, v.y, v.z, v.w};
#pragma unroll
      for (int e = 0; e < 4; ++e) {
        tl[(t8 + 2 * e) * 72 + cr] = (bf16_t)(wv[e] & 0xffffu);
        tl[(t8 + 2 * e + 1) * 72 + cr] = (bf16_t)(wv[e] >> 16);
      }
    }
    if (item + nblk < NIT) HT_PREFETCH(item + nblk);
    VB_SYNC();
#pragma unroll
    for (int i = 0; i < 2; ++i) {
      int q = tid + i * 256, tr = q >> 3, c8 = (q & 7) * 8;
      *(u32x4*)(yg + (size_t)(tb * 64 + tr) * 1024 + cb * 64 + c8) = *(const u32x4*)(tl + tr * 72 + c8);
    }
  }
#undef HT_PREFETCH
}

#define LRU_NCH 384
struct Lru4 { float af[4], bxf[4], ab[4], bxb[4]; };
__device__ __forceinline__ void lru_unpack4(u32x2 v, float (&o)[4]) { o[0] = bflo(v.x); o[1] = bfhi(v.x); o[2] = bflo(v.y); o[3] = bfhi(v.y); }
__device__ __forceinline__ void lru_row_f(const bf16_t* gates, size_t o, float (&af)[4], float (&bxf)[4]) {
  float la[4];
  lru_unpack4(*(const u32x2*)(gates + o), la); lru_unpack4(*(const u32x2*)(gates + (size_t)T_ALL * 1024 + o), bxf);
#pragma unroll
  for (int e = 0; e < 4; ++e) { af[e] = __expf(la[e]); bxf[e] *= sqrtf(fmaxf(1.f - af[e] * af[e], 0.f)); }
}
__device__ __forceinline__ void lru_row_b(const bf16_t* gates, size_t o, float (&ab)[4], float (&bxb)[4]) {
  float la[4];
  lru_unpack4(*(const u32x2*)(gates + (size_t)2 * T_ALL * 1024 + o), la); lru_unpack4(*(const u32x2*)(gates + (size_t)3 * T_ALL * 1024 + o), bxb);
#pragma unroll
  for (int e = 0; e < 4; ++e) { ab[e] = __expf(la[e]); bxb[e] *= sqrtf(fmaxf(1.f - ab[e] * ab[e], 0.f)); }
}
__device__ __forceinline__ void phase_lru_scan_agg(const Params& p, int bid, int nblk, unsigned char* smem, int cxw) {
  const int tidx = opaque_tid(cxw);
  const bf16_t* gates = (const bf16_t*)(p.scratch + SC_LRU_GATES);
  const bf16_t* xc = (const bf16_t*)(p.scratch + SC_LRU_XC);
  float* sagg = (float*)smem;
  const int sub = cxw & 3, cq = tidx & 63;
  for (int item = bid; item < LRU_NCH * 4; item += nblk) {
    const int chunk = item >> 2, cb = item & 3;
    const int c0 = cb * 256 + 4 * cq;
    const int tok0 = chunk * 64 + 16 * sub;
    float Af[4] = {1.f, 1.f, 1.f, 1.f}, hf[4] = {0.f, 0.f, 0.f, 0.f}, Pb[4] = {1.f, 1.f, 1.f, 1.f}, Bb[4] = {0.f, 0.f, 0.f, 0.f};
#pragma unroll 8
    for (int j = 0; j < 16; ++j) {
      const size_t o = (size_t)(tok0 + j) * 1024 + c0;
      float af[4], bxf[4], ab[4], bxb[4];
      lru_row_f(gates, o, af, bxf);
      lru_row_b(gates, o, ab, bxb);
#pragma unroll
      for (int e = 0; e < 4; ++e) { hf[e] = af[e] * hf[e] + bxf[e]; Af[e] *= af[e]; Bb[e] += bxb[e] * Pb[e]; Pb[e] *= ab[e]; }
    }
    {
      const size_t sc = (size_t)chunk * 4 + sub;
      float* gf = p.lru_sagg + (((size_t)0 * (LRU_NCH * 4) + sc) * 1024 + c0) * 2;
      float* gb = p.lru_sagg + (((size_t)1 * (LRU_NCH * 4) + sc) * 1024 + c0) * 2;
      f32x4 v0 = {Af[0], hf[0], Af[1], hf[1]}, v1 = {Af[2], hf[2], Af[3], hf[3]};
      f32x4 w0 = {Pb[0], Bb[0], Pb[1], Bb[1]}, w1 = {Pb[2], Bb[2], Pb[3], Bb[3]};
      *(f32x4*)gf = v0; *(f32x4*)(gf + 4) = v1; *(f32x4*)gb = w0; *(f32x4*)(gb + 4) = w1;
      __syncthreads();
      float* sl = sagg + (sub * 64 + cq) * 16;
      *(f32x4*)sl = v0; *(f32x4*)(sl + 4) = v1; *(f32x4*)(sl + 8) = w0; *(f32x4*)(sl + 12) = w1;
      __syncthreads();
    }
    if (sub == 0) {
      float A[4], B[4], P[4], Q[4];
#pragma unroll
      for (int e = 0; e < 4; ++e) { A[e] = 1.f; B[e] = 0.f; P[e] = 1.f; Q[e] = 0.f; }
#pragma unroll
      for (int s2 = 0; s2 < 4; ++s2) {
        const float* lf = sagg + (s2 * 64 + cq) * 16;
        const float* lb = sagg + ((3 - s2) * 64 + cq) * 16 + 8;
#pragma unroll
        for (int e = 0; e < 4; ++e) {
          const float a = lf[2 * e], b = lf[2 * e + 1];
          B[e] = a * B[e] + b; A[e] *= a;
          const float pb = lb[2 * e], qb = lb[2 * e + 1];
          Q[e] = pb * Q[e] + qb; P[e] *= pb;
        }
      }
      float* gf = p.lru_agg + (((size_t)0 * LRU_NCH + chunk) * 1024 + c0) * 2;
      float* gb = p.lru_agg + (((size_t)1 * LRU_NCH + chunk) * 1024 + c0) * 2;
      f32x4 v0 = {A[0], B[0], A[1], B[1]}, v1 = {A[2], B[2], A[3], B[3]}, w0 = {P[0], Q[0], P[1], Q[1]}, w1 = {P[2], Q[2], P[3], Q[3]};
      *(f32x4*)gf = v0; *(f32x4*)(gf + 4) = v1; *(f32x4*)gb = w0; *(f32x4*)(gb + 4) = w1;
    }
  }
}
__device__ __forceinline__ void phase_lru_scan_carry(const Params& p, int bid, int nblk, int cxw) {
  const int tidx = opaque_tid(cxw);
  for (int item = bid; item < 36 * 8; item += nblk) {
    int s = item >> 3, dir = (item >> 2) & 1, cb = item & 3;
    int c = cb * 256 + tidx;
    int nch = s < 32 ? 4 : 64;
    int ch0 = s < 32 ? s * 4 : 128 + (s - 32) * 64;
    float h = s < 32 ? 0.f : p.state_lru[((size_t)(s - 32) * 2 + dir) * 1024 + c];
    for (int k0 = 0; k0 < nch; k0 += 16) {
      f32x2_t ag[16];
#pragma unroll
      for (int u = 0; u < 16; ++u) {
        const int kk = k0 + u < nch ? k0 + u : nch - 1;
        const int chunk = dir ? ch0 + nch - 1 - kk : ch0 + kk;
        ag[u] = *(const f32x2_t*)(p.lru_agg + (((size_t)dir * LRU_NCH + chunk) * 1024 + c) * 2);
      }
#pragma unroll
      for (int u = 0; u < 16; ++u) {
        if (k0 + u < nch) {
          const int chunk = dir ? ch0 + nch - 1 - (k0 + u) : ch0 + k0 + u;
          p.lru_hin[((size_t)dir * LRU_NCH + chunk) * 1024 + c] = h; h = ag[u].x * h + ag[u].y;
        }
      }
    }
    if (s < 32) p.out_lru[((size_t)s * 2 + dir) * 1024 + c] = h;
  }
}
__device__ __forceinline__ void phase_lru_scan_final(const Params& p, int bid, int nblk, unsigned char* smem, int cxw) {
  const int tidx = opaque_tid(cxw);
  const bf16_t* gates = (const bf16_t*)(p.scratch + SC_LRU_GATES);
  const bf16_t* xc = (const bf16_t*)(p.scratch + SC_LRU_XC);
  const bf16_t* proj = (const bf16_t*)(p.scratch + SC_LRU_PROJ);
  bf16_t* yg = (bf16_t*)(p.scratch + SC_LRU_YG);
  const int sub = cxw & 3, cq = tidx & 63;
  for (int item = bid; item < LRU_NCH * 4; item += nblk) {
    const int chunk = item >> 2, cb = item & 3;
    const int c0 = cb * 256 + 4 * cq;
    float hf[4], hb[4];
    {
      const f32x4 a = *(const f32x4*)(p.lru_hin + ((size_t)0 * LRU_NCH + chunk) * 1024 + c0);
      const f32x4 b = *(const f32x4*)(p.lru_hin + ((size_t)1 * LRU_NCH + chunk) * 1024 + c0);
      hf[0] = a.x; hf[1] = a.y; hf[2] = a.z; hf[3] = a.w; hb[0] = b.x; hb[1] = b.y; hb[2] = b.z; hb[3] = b.w;
    }
#pragma unroll
    for (int s2 = 0; s2 < 3; ++s2) {
      if (s2 < sub) {
        const float* g = p.lru_sagg + (((size_t)0 * (LRU_NCH * 4) + (size_t)chunk * 4 + s2) * 1024 + c0) * 2;
        const f32x4 v0 = *(const f32x4*)g, v1 = *(const f32x4*)(g + 4);
        hf[0] = v0.x * hf[0] + v0.y; hf[1] = v0.z * hf[1] + v0.w; hf[2] = v1.x * hf[2] + v1.y; hf[3] = v1.z * hf[3] + v1.w;
      }
      if (3 - s2 > sub) {
        const float* g = p.lru_sagg + (((size_t)1 * (LRU_NCH * 4) + (size_t)chunk * 4 + (3 - s2)) * 1024 + c0) * 2;
        const f32x4 v0 = *(const f32x4*)g, v1 = *(const f32x4*)(g + 4);
        hb[0] = v0.x * hb[0] + v0.y; hb[1] = v0.z * hb[1] + v0.w; hb[2] = v1.x * hb[2] + v1.y; hb[3] = v1.z * hb[3] + v1.w;
      }
    }
    const int tok0 = chunk * 64 + 16 * sub;
    float hfs[16][4];
#pragma unroll
    for (int j = 0; j < 16; ++j) {
      const size_t o = (size_t)(tok0 + j) * 1024 + c0;
      float af[4], bxf[4];
      lru_row_f(gates, o, af, bxf);
#pragma unroll
      for (int e = 0; e < 4; ++e) { hf[e] = af[e] * hf[e] + bxf[e]; hfs[j][e] = hf[e]; }
    }
#pragma unroll
    for (int j = 15; j >= 0; --j) {
      const size_t o = (size_t)(tok0 + j) * 1024 + c0;
      float ab[4], bxb[4], z[4];
      lru_row_b(gates, o, ab, bxb);
      lru_unpack4(*(const u32x2*)(proj + (size_t)(tok0 + j) * 2048 + 1024 + c0), z);
      float y[4];
#pragma unroll
      for (int e = 0; e < 4; ++e) { hb[e] = ab[e] * hb[e] + bxb[e]; y[e] = (hfs[j][e] + hb[e]) * siluf(z[e]); }
      u32x2 ov; ov.x = pack2(y[0], y[1]); ov.y = pack2(y[2], y[3]);
      *(u32x2*)(yg + o) = ov;
    }
  }
}

enum { PH_PREP = 0, PH_MOD, PH_HYA, PH_HYB, PH_LNMOD, PH_INPROJ, PH_MIX1, PH_MIX2, PH_MIX3, PH_MIX4, PH_MIX5, PH_MIX6, PH_OUTPROJ };

struct Ctx { int bid, nblk, wave; unsigned char* smem; unsigned char* wg_smem; };

template <class Epi>
__device__ __forceinline__ void run_gemm(const Ctx& cx, const bf16_t* A, int lda, const bf16_t* Bt, int M, int N, int K, int grp_shift, int grp_bytes, const Epi& e, int split = 0) {
  pg8::Gemm g{A, Bt, M, N, K, lda, grp_shift, grp_bytes};
  pg8::StaticOrder S; S.init(M, N, K, gridDim.x, opaque_s(blockIdx.x), split);
  pg8::gemm_phase((PG8_LAS unsigned char*)cx.wg_smem, g, S, e, cx.wave);
}

#define N_PARAM_WORDS (sizeof(Params) / 8)
__device__ __forceinline__ Params load_params(const unsigned char* lp) {
  Params p;
  unsigned long long* d = (unsigned long long*)&p;
  const unsigned long long* sp = (const unsigned long long*)lp;
#pragma unroll
  for (int i = 0; i < (int)N_PARAM_WORDS; ++i) {
    const unsigned long long v = sp[i];
    const unsigned lo = __builtin_amdgcn_readfirstlane((unsigned)v), hi = __builtin_amdgcn_readfirstlane((unsigned)(v >> 32));
    __attribute__((address_space(1))) char* gp = (__attribute__((address_space(1))) char*)(((unsigned long long)hi << 32) | lo);
    d[i] = (unsigned long long)(char*)gp;
  }
  return p;
}
__device__ __forceinline__ void run_phase(const unsigned char* lparams, int ph, int layer, const Ctx& cx) {
  const Params p = load_params(lparams);
  const int omode = layer >> 8; layer &= 255;
  const int kind = layer % 3, slot = layer / 3;
  const int bid = opaque_s(cx.bid), nblk = cx.nblk;
  unsigned char* smem = cx.smem;
  switch (ph) {
    case PH_PREP: phase_prep(p, bid, nblk, smem, (unsigned*)(cx.wg_smem + WG_SMEM), cx.wave); break;
    case PH_MOD: phase_mod(p, bid, nblk, smem, cx.wave); break;
    case PH_HYA: phase_hyfilt_a(p, bid, nblk, smem, cx.wave); break;
    case PH_HYB: phase_hyfilt_b(p, bid, nblk, smem, (unsigned*)(cx.wg_smem + WG_SMEM), cx.wave); break;
    case PH_LNMOD: phase_lnmod(p, layer, bid, nblk, cx.wave); break;
    case PH_INPROJ:
      if (kind == 0) {
        pg8::EpiSsdIn e{(bf16_t*)(p.scratch + SC_SSD_Z), (bf16_t*)(p.scratch + SC_SSD_XBC), (float*)(p.scratch + SC_SSD_DT), p.ssd_dt_bias + slot * 64};
        run_gemm(cx, p.hbuf, 1024, p.wt_ssd_in + (size_t)slot * 6400 * 1024, T_ALL, 6144, 1024, 30, 0, e);
      } else if (kind == 1) {
        pg8::EpiBf16 e{(bf16_t*)(p.scratch + SC_HY_PROJT), (size_t)T_ALL};
        run_gemm(cx, p.wt_hy_in, 1024, p.hbuf, 4096, T_ALL, 1024, 30, 0, e);
      } else {
        pg8::EpiBf16 e{(bf16_t*)(p.scratch + SC_LRU_PROJ), (size_t)2048};
        run_gemm(cx, p.hbuf, 1024, p.wt_lru_in, T_ALL, 2048, 1024, 30, 0, e);
      }
      break;
    case PH_MIX1:
      if (kind == 0) phase_ssd_conv(p, slot, slot == 1, bid, nblk, smem, (unsigned*)(cx.wg_smem + WG_SMEM), cx.wave);
      else if (kind == 1) phase_hy_longconv(p, bid, nblk, smem, (unsigned*)(cx.wg_smem + WG_SMEM), cx.wave);
      else phase_dwconv<4, false>((const bf16_t*)(p.scratch + SC_LRU_PROJ), 2048, (bf16_t*)(p.scratch + SC_LRU_XC), 1024, 1024,
                                  p.lru_conv_w, p.lru_conv_b, false, bid, nblk, cx.wave);
      break;
    case PH_MIX2:
      if (kind == 0) {
        phase_ssd_scan(p, slot, slot == 1, bid, nblk, cx.wg_smem, cx.wave);
        if (nblk == 512 && bid >= 256) {
          sub_barrier(p.bar + XB_CTXDONE + 16 * slot, 128u, cx.wave);
          phase_ssd_gate(p, slot, bid - 256, 256, cx.wave, 0, T_CTX);
        }
      }
      else if (kind == 1) phase_hy_transpose(p, bid, nblk, smem, (unsigned*)(cx.wg_smem + WG_SMEM), cx.wave);
      else {
        pg8::EpiLruGate e{(bf16_t*)(p.scratch + SC_LRU_GATES), p.lru_gate_b, (const bf16_t*)(p.scratch + SC_LRU_XC), p.lru_a_param};
        run_gemm(cx, (const bf16_t*)(p.scratch + SC_LRU_XC), 1024, p.wt_lru_gate, T_ALL, 4096, 256, 2, 512, e);
      }
      break;
    case PH_MIX3:
      if (kind == 0) phase_ssd_gate(p, slot, bid, nblk, cx.wave, (nblk == 512) ? T_CTX : 0, T_ALL);
      else phase_lru_scan_agg(p, bid, nblk, smem, cx.wave);
      break;
    case PH_MIX4: if (kind == 2) phase_lru_scan_carry(p, bid, nblk, cx.wave); break;
    case PH_MIX5: if (kind == 2) phase_lru_scan_final(p, bid, nblk, smem, cx.wave); break;
    case PH_OUTPROJ: {
      const float* mv = p.modv + (size_t)layer * 5 * 3072;
      if (omode == 2) sub_barrier(p.bar + XB_CTXDONE2 + 16 * slot, 128u, cx.wave);
      if (kind == 0) {
        pg8::EpiOut e{p.resb, mv, p.rstd, p.outp};
        run_gemm(cx, (const bf16_t*)(p.scratch + SC_SSD_Z), 2048, p.wt_ssd_out + (size_t)slot * 1024 * 2048, T_ALL, 1024, 2048, 30, 0, e, omode ? omode : 1);
      } else if (kind == 1) {
        pg8::EpiOut e{p.resb, mv, nullptr, p.outp};
        run_gemm(cx, (const bf16_t*)(p.scratch + SC_HY_YG), 1024, p.wt_hy_out, T_ALL, 1024, 1024, 30, 0, e, 1);
      } else {
        pg8::EpiOut e{p.resb, mv, nullptr, p.outp};
        run_gemm(cx, (const bf16_t*)(p.scratch + SC_LRU_YG), 1024, p.wt_lru_out, T_ALL, 1024, 1024, 30, 0, e, 1);
      }
    } break;
  }
}

__global__ void __launch_bounds__(WG_THREADS, 2) k_mega(Params p) {
  __shared__ __attribute__((aligned(16))) unsigned char smem[WG_SMEM + 16 + 512];
  cg::grid_group grid = cg::this_grid();
  const int wave0 = __builtin_amdgcn_readfirstlane((int)(threadIdx.x >> 6));
  const int vb = wave0 >> 2;
  Ctx cx;
  cx.wave = wave0;
  cx.bid = 2 * blockIdx.x + vb; cx.nblk = 2 * gridDim.x; cx.smem = smem + vb * SMEM_BYTES; cx.wg_smem = smem;
  volatile LAS unsigned* xst = (volatile LAS unsigned*)(smem + WG_SMEM);
  unsigned char* lparams = smem + WG_SMEM + 16;
  if (threadIdx.x == 0) { xst[0] = 0u; xst[1] = 0u; *(Params*)lparams = p; }
  __syncthreads();
  const XcdBarrier xb = xcd_barrier_post(p.bar, lparams, (unsigned)offsetof(Params, bar), xst);
  run_phase(lparams, PH_PREP, 0, cx);
  run_phase(lparams, PH_MOD, 0, cx);
  run_phase(lparams, PH_HYA, 0, cx);
  if (p.bar == nullptr) grid.sync();
  xcd_barrier(xb, cx.wave);
  run_phase(lparams, PH_HYB, 0, cx);
  for (int layer = 0; layer < 4; ++layer) {
    const int kind = layer % 3;
    run_phase(lparams, PH_LNMOD, layer, cx);
    xcd_barrier(xb, cx.wave);
    run_phase(lparams, PH_INPROJ, layer, cx);
    xcd_barrier(xb, cx.wave);
    run_phase(lparams, PH_MIX1, layer, cx);
    xcd_barrier(xb, cx.wave);
    const bool ctxo = (kind == 0) && (cx.nblk == 512);
#pragma nounroll
    for (int pass = 0; pass < 2; ++pass) {
      int omode;
      if (pass == 0) {
        run_phase(lparams, PH_MIX2, layer, cx);
        omode = (ctxo && opaque_s(cx.bid) >= 256) ? 2 : -1;
      } else {
        xcd_barrier(xb, cx.wave);
        if (kind != 1) {
          run_phase(lparams, PH_MIX3, layer, cx);
          xcd_barrier(xb, cx.wave);
        }
        if (kind == 2) {
          run_phase(lparams, PH_MIX4, layer, cx);
          xcd_barrier(xb, cx.wave);
          run_phase(lparams, PH_MIX5, layer, cx);
          xcd_barrier(xb, cx.wave);
        }
        omode = ctxo ? 3 : 0;
      }
      if (omode >= 0) run_phase(lparams, PH_OUTPROJ, layer | (omode << 8), cx);
    }
    xcd_barrier(xb, cx.wave);
  }
  run_phase(lparams, PH_LNMOD, 4, cx);
}

static inline size_t align_up(size_t x) { return (x + 255) & ~(size_t)255; }

extern "C" void kernel_launch(void* const* d_in, const int* in_sizes, int n_in, void* d_out, int out_size, void* d_ws, size_t ws_size,
                              hipStream_t stream) {
  Params p{};
  const float** fp = (const float**)&p;
  for (int i = 0; i < 36; ++i) fp[i] = (const float*)d_in[i];
  float* out = (float*)d_out;
  p.xres = out;
  p.out_ssd = out + (size_t)T_ALL * 1024;
  p.out_lru = p.out_ssd + (size_t)32 * 2 * 2 * 32 * 64 * 128;
  unsigned char* w = (unsigned char*)d_ws;
  size_t off = 0;
  auto carve = [&](size_t bytes) { unsigned char* r = w + off; off = align_up(off + bytes); return r; };
  p.wt_ssd_in = (bf16_t*)carve((size_t)2 * 6400 * 1024 * 2);
  p.wt_ssd_out = (bf16_t*)carve((size_t)2 * 1024 * 2048 * 2);
  p.wt_hy_in = (bf16_t*)carve((size_t)4096 * 1024 * 2);
  p.wt_hy_out = (bf16_t*)carve((size_t)1024 * 1024 * 2);
  p.wt_lru_in = (bf16_t*)carve((size_t)2048 * 1024 * 2);
  p.wt_lru_out = (bf16_t*)carve((size_t)1024 * 1024 * 2);
  p.wt_lru_gate = (bf16_t*)carve((size_t)4 * 1024 * 256 * 2);
  p.modv = (float*)carve((size_t)4 * 5 * 3072 * 4);
  p.hdn2 = (float*)carve((size_t)4352 * 64 * 4);
  p.rtab0 = (bf16_t*)carve((size_t)2 * 1024 * 512 * 2);
  p.rtab1 = (bf16_t*)carve((size_t)2 * 1024 * 8192 * 2);
  p.knorm = (float*)carve((size_t)4 * 1024 * 4);
  p.hbuf = (bf16_t*)carve((size_t)T_ALL * 1024 * 2);
  p.rstd = (float*)carve((size_t)T_ALL * 4);
  p.resb = (bf16_t*)carve((size_t)T_ALL * 1024 * 2);
  p.outp = (bf16_t*)carve((size_t)8192 * 1024 * 2);
  p.lru_agg = (float*)carve((size_t)2 * 384 * 1024 * 2 * 4);
  p.lru_hin = (float*)carve((size_t)2 * 384 * 1024 * 4);
  p.lru_sagg = (float*)carve((size_t)2 * 1536 * 1024 * 2 * 4);
  p.bar = (unsigned*)carve((size_t)XCD_BAR_WORDS * 4);
  p.scratch = carve(SC_TOTAL);
  if (off > ws_size) return;

  static int grid_blocks = 0;
  if (!grid_blocks) {
    int dev = 0, cus = 0, per_cu = 0;
    hipGetDevice(&dev);
    hipDeviceGetAttribute(&cus, hipDeviceAttributeMultiprocessorCount, dev);
    hipOccupancyMaxActiveBlocksPerMultiprocessor(&per_cu, k_mega, WG_THREADS, 0);
    if (per_cu > 1) per_cu = 1;
    grid_blocks = cus * per_cu;
  }
  hipMemsetAsync(p.bar, 0, (size_t)XCD_BAR_WORDS * 4, stream);
  void* args[] = {&p};
  hipError_t e = hipLaunchCooperativeKernel((void*)k_mega, dim3(grid_blocks), dim3(WG_THREADS), args, 0, stream);
  if (e != hipSuccess) fprintf(stderr, "cooperative launch failed: %s (grid %d)\n", hipGetErrorString(e), grid_blocks);
}
```

```cpp
#include <hip/hip_runtime.h>
#include <hip/hip_bf16.h>
#include <hip/hip_cooperative_groups.h>
#include <stdint.h>
#include <cstdio>
namespace cg = cooperative_groups;

typedef unsigned short bf16_t;
typedef __attribute__((ext_vector_type(8))) short bf16x8;
typedef __attribute__((ext_vector_type(16))) float f32x16;
typedef __attribute__((ext_vector_type(4))) unsigned int u32x4;
typedef __attribute__((ext_vector_type(2))) unsigned int u32x2;
typedef __attribute__((ext_vector_type(4))) float f32x4;
typedef float f32x4_t __attribute__((ext_vector_type(4)));
typedef float f32x2_t __attribute__((ext_vector_type(2)));

#define T_CTX 8192
#define T_ALL 24576
#define DM 1024
#define NTHR 256
#define SMEM_BYTES 69632
#define WG_THREADS 512
#define WG_SMEM 162304
#define ALPHA_RES 1.6817928305074290f
#define LN_EPS 1e-5f

__device__ __forceinline__ bf16_t f2bf(float f) { __bf16 h = (__bf16)f; return __builtin_bit_cast(bf16_t, h); }
__device__ __forceinline__ float bf2f(bf16_t b) { return __uint_as_float(((unsigned)b) << 16); }
__device__ __forceinline__ float bflo(unsigned w) { return __uint_as_float(w << 16); }
__device__ __forceinline__ float bfhi(unsigned w) { return __uint_as_float(w & 0xffff0000u); }
typedef __bf16 bf16v2_t __attribute__((ext_vector_type(2)));
typedef float f32v2_t __attribute__((ext_vector_type(2)));
__device__ __forceinline__ unsigned pack2(float a, float b) { f32v2_t v = {a, b}; bf16v2_t h = __builtin_convertvector(v, bf16v2_t); return __builtin_bit_cast(unsigned, h); }
__device__ __forceinline__ float siluf(float x) { return x * __builtin_amdgcn_rcpf(1.f + __expf(-x)); }
__device__ __forceinline__ float sigmoidf(float x) { return __builtin_amdgcn_rcpf(1.f + __expf(-x)); }
__device__ __forceinline__ float softplusf(float x) { return x > 20.f ? x : __logf(1.f + __expf(x)); }


__device__ __forceinline__ int opaque_lane() { int z = 0; asm volatile("" : "+v"(z)); return __builtin_amdgcn_mbcnt_hi(~0u, __builtin_amdgcn_mbcnt_lo(~0u, (unsigned)z)); }
__device__ __forceinline__ int opaque_tid512(int wave) { return (wave << 6) + opaque_lane(); }
__device__ __forceinline__ int opaque_tid(int wave) { return opaque_tid512(wave) & 255; }

#define XB_TMO      128
#define XB_XCNT(j)  (256  + 64 * (j))
#define XB_XSUB(j)  (1280 + 64 * (j))
#define XB_XGEN(j)  (2304 + 64 * (j))
#define XB_TOP      3328
#define XB_TOPGEN   3392
#define XCD_BAR_WORDS 3456
#define XB_SPIN_CAP (1u << 23)
#define LAS __attribute__((address_space(3)))
__device__ __forceinline__ unsigned xb_ld(unsigned* p)              { return __hip_atomic_load(p, __ATOMIC_RELAXED, __HIP_MEMORY_SCOPE_AGENT); }
__device__ __forceinline__ unsigned xb_add(unsigned* p, unsigned v) { return __hip_atomic_fetch_add(p, v, __ATOMIC_RELAXED, __HIP_MEMORY_SCOPE_AGENT); }
__device__ __forceinline__ unsigned xb_xcc_id() { return (unsigned)__builtin_amdgcn_s_getreg((3 << 11) | 20) & 0xFu; }
#define XB_SPIN(cond, bar) do { unsigned _sp = 0; while (cond) { __builtin_amdgcn_s_sleep(1); \
    if ((++_sp & 255u) == 0u) { if (xb_ld(&(bar)[XB_TMO])) break; if (_sp > XB_SPIN_CAP) { atomicAdd(&(bar)[XB_TMO], 1u); break; } } } } while (0)
struct XcdBarrier { const unsigned char* lparams; unsigned boff; volatile LAS unsigned* st; };
__device__ __forceinline__ XcdBarrier xcd_barrier_post(unsigned* bar, const unsigned char* lparams, unsigned boff, volatile LAS unsigned* st) {
  XcdBarrier b; b.lparams = lparams; b.boff = boff; b.st = st;
  if (threadIdx.x == 0) (void)xb_add(&bar[XB_XCNT(xb_xcc_id())], 1u);
  return b;
}
__device__ __forceinline__ void xcd_barrier_complete(unsigned* bar, unsigned x, unsigned& nloc, unsigned& nx) {
  const unsigned G = gridDim.x * gridDim.y * gridDim.z;
  unsigned sum, cnt, mine, sp = 0u;
  for (;;) {
    sum = 0u; cnt = 0u; mine = 0u;
#pragma unroll
    for (unsigned j = 0; j < 16; ++j) { const unsigned c = xb_ld(&bar[XB_XCNT(j)]); sum += c; cnt += (c > 0u) ? 1u : 0u; mine = (j == x) ? c : mine; }
    if (sum == G) break;
    __builtin_amdgcn_s_sleep(1);
    if ((++sp & 255u) == 0u) { if (xb_ld(&bar[XB_TMO])) break; if (sp > XB_SPIN_CAP) { atomicAdd(&bar[XB_TMO], 1u); break; } }
  }
  nloc = mine > 0u ? mine : 1u; nx = cnt > 0u ? cnt : 1u;
}
__device__ __forceinline__ void xcd_barrier(const XcdBarrier& b, int wave) {
  asm volatile("s_waitcnt vmcnt(0)" ::: "memory");
  __syncthreads();
  if (opaque_tid512(wave) == 0) {
    unsigned* bar;
    {
      const unsigned long long v = *(const unsigned long long*)(b.lparams + b.boff);
      const unsigned lo = __builtin_amdgcn_readfirstlane((unsigned)v), hi = __builtin_amdgcn_readfirstlane((unsigned)(v >> 32));
      __attribute__((address_space(1))) char* gp = (__attribute__((address_space(1))) char*)(((unsigned long long)hi << 32) | lo);
      bar = (unsigned*)(char*)gp;
    }
    unsigned bx = xb_xcc_id(); asm volatile("" : "+s"(bx));
    __builtin_amdgcn_s_waitcnt(0);
    unsigned nloc = b.st[0], nx = b.st[1];
    if (nloc == 0u) { xcd_barrier_complete(bar, bx, nloc, nx); b.st[0] = nloc; b.st[1] = nx; }
    const unsigned old = xb_add(&bar[XB_XSUB(bx)], 1u);
    const unsigned gen = old / nloc;
    if (old + 1u == (gen + 1u) * nloc) {
      __builtin_amdgcn_fence(__ATOMIC_RELEASE, "agent");
      asm volatile("s_waitcnt vmcnt(0)" ::: "memory");
      const unsigned og = xb_add(&bar[XB_TOP], 1u);
      const unsigned tg = og / nx;
      if (og + 1u == (tg + 1u) * nx) xb_add(&bar[XB_TOPGEN], 1u);
      else XB_SPIN(xb_ld(&bar[XB_TOPGEN]) == tg, bar);
      __builtin_amdgcn_fence(__ATOMIC_ACQUIRE, "agent");
      xb_add(&bar[XB_XGEN(bx)], 1u);
      asm volatile("s_waitcnt vmcnt(0)" ::: "memory");
    } else {
      XB_SPIN(xb_ld(&bar[XB_XGEN(bx)]) == gen, bar);
      __builtin_amdgcn_fence(__ATOMIC_ACQUIRE, "agent");
      asm volatile("s_waitcnt vmcnt(0)" ::: "memory");
    }
  }
  __syncthreads();
}


__device__ __forceinline__ void sub_barrier(unsigned* ctr, unsigned n, int wave) {
  asm volatile("s_waitcnt vmcnt(0)" ::: "memory");
  __syncthreads();
  if (opaque_tid512(wave) == 0) {
    __builtin_amdgcn_fence(__ATOMIC_RELEASE, "agent");
    asm volatile("s_waitcnt vmcnt(0)" ::: "memory");
    (void)xb_add(ctr, 1u);
    unsigned sp = 0u;
    while (xb_ld(ctr) < n) { __builtin_amdgcn_s_sleep(2); if (++sp > XB_SPIN_CAP) break; }
    __builtin_amdgcn_fence(__ATOMIC_ACQUIRE, "agent");
    asm volatile("s_waitcnt vmcnt(0)" ::: "memory");
  }
  __syncthreads();
}
#define XB_CTXDONE 160
#define XB_CTXDONE2 192

__device__ __forceinline__ int opaque_s(int x) { asm volatile("" : "+s"(x)); return x; }

#define VB_DECL(wg_bar) volatile LAS unsigned* vctr = (volatile LAS unsigned*)((wg_bar) + 2 + (cxw >> 2)); unsigned vtarget = 0u; \
  if (tid == 0) *vctr = 0u; \
  __syncthreads()
#define VB_SYNC() do { asm volatile("s_waitcnt lgkmcnt(0)" ::: "memory"); vtarget += 4u; \
    if ((tid & 63) == 0) (void)__hip_atomic_fetch_add((LAS unsigned*)vctr, 1u, __ATOMIC_RELAXED, __HIP_MEMORY_SCOPE_WORKGROUP); \
    while (*vctr < vtarget) __builtin_amdgcn_s_sleep(1); \
    asm volatile("" ::: "memory"); } while (0)

__device__ __forceinline__ float shfl_idx_f(float v, int src) { return __int_as_float(__builtin_amdgcn_ds_bpermute(src << 2, __float_as_int(v))); }
__device__ __forceinline__ float shfl_xor_f(float v, int off, int lane) { return shfl_idx_f(v, lane ^ off); }

__device__ __forceinline__ float wave_incl_scan(float v) {
#define DPP_ADD(ctrl, rmask) v += __int_as_float(__builtin_amdgcn_update_dpp(0, __float_as_int(v), ctrl, rmask, 0xf, false))
  DPP_ADD(0x111, 0xf); DPP_ADD(0x112, 0xf); DPP_ADD(0x114, 0xf); DPP_ADD(0x118, 0xf);
  DPP_ADD(0x142, 0xa); DPP_ADD(0x143, 0xc);
#undef DPP_ADD
  return v;
}

__device__ __forceinline__ float wave_sum(float v) { return __int_as_float(__builtin_amdgcn_readlane(__float_as_int(wave_incl_scan(v)), 63)); }

struct TokInfo { int s, l, L, base, mrow; };
__device__ __forceinline__ TokInfo tokinfo(int tok) {
  TokInfo t;
  if (tok < T_CTX) { t.s = tok >> 8; t.l = tok & 255; t.L = 256; t.base = tok & ~255; t.mrow = 0; }
  else { int u = tok - T_CTX; t.s = 32 + (u >> 12); t.l = u & 4095; t.L = 4096; t.base = T_CTX + (u & ~4095); t.mrow = 1 + (u >> 12); }
  return t;
}
__device__ __forceinline__ int seqpos2off(int pos, bool cm) { return cm ? (((pos & 63) << 6) | (pos >> 6)) : pos; }

struct Params {
  const float *x_prompt, *x_sample, *state_ssd, *state_lru, *c, *c_ctx, *mod_w, *mod_b, *ln_g, *ln_b;
  const float *ssd_in_w, *ssd_conv_w, *ssd_conv_b, *ssd_dt_bias, *ssd_a_log, *ssd_d, *ssd_norm_g, *ssd_out_w;
  const float *hy_in_w, *hy_conv_w, *hy_conv_b, *hy_f_w1, *hy_f_b1, *hy_f_w2, *hy_f_b2, *hy_f_w3, *hy_f_freq, *hy_f_bias, *hy_out_w;
  const float *lru_in_w, *lru_conv_w, *lru_conv_b, *lru_gate_w, *lru_gate_b, *lru_a_param, *lru_out_w;
  float *xres, *out_ssd, *out_lru;
  bf16_t *wt_ssd_in, *wt_ssd_out, *wt_hy_in, *wt_hy_out, *wt_lru_in, *wt_lru_out, *wt_lru_gate;
  float *modv;
  float *hdn2;
  bf16_t *rtab0;
  bf16_t *rtab1;
  float *knorm;
  bf16_t *hbuf;
  float *rstd;
  bf16_t *resb;
  bf16_t *outp;
  float *lru_agg;
  float *lru_hin;
  float *lru_sagg;
  unsigned char *scratch;
  unsigned *bar;
};

#define SC_SSD_Z     ((size_t)0)
#define SC_SSD_XBC   ((size_t)T_ALL * 2048 * 2)
#define SC_SSD_XBCC  (SC_SSD_XBC + (size_t)T_ALL * 4096 * 2)
#define SC_SSD_DT    (SC_SSD_XBCC + (size_t)T_ALL * 2048 * 2)
#define SC_SSD_XT    (SC_SSD_DT + (size_t)T_ALL * 64 * 4)
#define SC_SSD_BT    (SC_SSD_XT + (size_t)T_ALL * 2048 * 2)
#define SC_SSD_BF    (SC_SSD_BT + (size_t)T_ALL * 1024 * 2)
#define SC_SSD_CF    (SC_SSD_BF + (size_t)T_ALL * 1024 * 2)
#define SC_SSD_END   (SC_SSD_CF + (size_t)T_ALL * 1024 * 2)
#define SC_HY_PROJT  ((size_t)0)
#define SC_HY_YT     ((size_t)T_ALL * 4096 * 2)
#define SC_HY_YG     (SC_HY_YT + (size_t)T_ALL * 1024 * 2)
#define SC_LRU_PROJ  ((size_t)0)
#define SC_LRU_XC    ((size_t)T_ALL * 2048 * 2)
#define SC_LRU_GATES (SC_LRU_XC + (size_t)T_ALL * 1024 * 2)
#define SC_LRU_Y     (SC_LRU_GATES + (size_t)T_ALL * 4096 * 2)
#define SC_LRU_YG    (SC_LRU_Y + (size_t)T_ALL * 2048 * 2)
#define SC_TOTAL     SC_SSD_END

__device__ __forceinline__ void transpose_tile(const float* __restrict__ src, int ld_src, int n_src, bf16_t* __restrict__ dst, int K,
                               const float* __restrict__ scale, int tile, int tiles_k, float* tl, int cxw) {
  const int tidx = opaque_tid(cxw);
  int tk = tile % tiles_k, tn = tile / tiles_k;
  int k0 = tk * 64, n0 = tn * 64;
  __syncthreads();
  {
    const int c4 = (tidx & 15) * 4, r0 = tidx >> 4;
#pragma unroll
    for (int ps = 0; ps < 4; ++ps) {
      const int r = r0 + ps * 16;
      f32x4 v = {0.f, 0.f, 0.f, 0.f};
      if (n0 + c4 < n_src) v = *(const f32x4*)(src + (size_t)(k0 + r) * ld_src + n0 + c4);
      if (scale) { const float sc = scale[k0 + r]; v.x *= sc; v.y *= sc; v.z *= sc; v.w *= sc; }
      tl[r * 65 + c4] = v.x; tl[r * 65 + c4 + 1] = v.y; tl[r * 65 + c4 + 2] = v.z; tl[r * 65 + c4 + 3] = v.w;
    }
  }
  __syncthreads();
  {
    const int n = tidx >> 2, kq = (tidx & 3) * 16;
    unsigned w[8];
#pragma unroll
    for (int e = 0; e < 8; ++e) w[e] = pack2(tl[(kq + 2 * e) * 65 + n], tl[(kq + 2 * e + 1) * 65 + n]);
    u32x4 o0, o1; o0.x = w[0]; o0.y = w[1]; o0.z = w[2]; o0.w = w[3]; o1.x = w[4]; o1.y = w[5]; o1.z = w[6]; o1.w = w[7];
    bf16_t* dp = dst + (size_t)(n0 + n) * K + k0 + kq;
    *(u32x4*)dp = o0; *(u32x4*)(dp + 8) = o1;
  }
}

struct PrepTile { const float* src; int ld, nsrc, K, t; bf16_t* dst; const float* scale; };
__device__ __forceinline__ PrepTile prep_decode(const Params& p, int g) {
  PrepTile q; q.scale = nullptr;
  if (g < 3200) { const int job = g >= 1600; q.t = g - job * 1600; q.src = p.ssd_in_w + (size_t)job * 1024 * 6208; q.ld = 6208; q.nsrc = 6208; q.K = 1024; q.dst = p.wt_ssd_in + (size_t)job * 6400 * 1024; }
  else if (g < 4224) { const int sl = g >= 3712; q.t = g - 3200 - sl * 512; q.src = p.ssd_out_w + (size_t)sl * 2048 * 1024; q.ld = 1024; q.nsrc = 1024; q.K = 2048; q.dst = p.wt_ssd_out + (size_t)sl * 1024 * 2048; q.scale = p.ssd_norm_g + sl * 2048; }
  else if (g < 5248) { q.t = g - 4224; q.src = p.hy_in_w; q.ld = 4096; q.nsrc = 4096; q.K = 1024; q.dst = p.wt_hy_in; }
  else if (g < 5504) { q.t = g - 5248; q.src = p.hy_out_w; q.ld = 1024; q.nsrc = 1024; q.K = 1024; q.dst = p.wt_hy_out; }
  else if (g < 6016) { q.t = g - 5504; q.src = p.lru_in_w; q.ld = 2048; q.nsrc = 2048; q.K = 1024; q.dst = p.wt_lru_in; }
  else if (g < 6272) { q.t = g - 6016; q.src = p.lru_out_w; q.ld = 1024; q.nsrc = 1024; q.K = 1024; q.dst = p.wt_lru_out; }
  else { const int qq = (g - 6272) >> 4; q.t = (g - 6272) & 15; const int dg = qq >> 2, n = qq & 3;
    const int tn = q.t >> 2, dir = dg >> 1, gsel = dg & 1, half = tn >> 1, jj0 = (tn & 1) * 64;
    q.src = p.lru_gate_w + (size_t)(dg * 4 + n) * 65536; q.ld = 256; q.nsrc = 256; q.K = 256;
    q.dst = p.wt_lru_gate + ((size_t)n * 1024 + (dir * 2 + half) * 256 + gsel * 128 + jj0 - tn * 64) * 256; }
  return q;
}
__device__ __forceinline__ void prep_load(const PrepTile& q, int tidx, f32x4 (&v)[4]) {
  const int tiles_k = q.K >> 6, tk = q.t % tiles_k, tn = q.t / tiles_k, k0 = tk * 64, n0 = tn * 64;
  const int c4 = (tidx & 15) * 4, r0 = tidx >> 4;
#pragma unroll
  for (int ps = 0; ps < 4; ++ps) {
    const int r = r0 + ps * 16;
    f32x4 x = {0.f, 0.f, 0.f, 0.f};
    if (n0 + c4 < q.nsrc) x = *(const f32x4*)(q.src + (size_t)(k0 + r) * q.ld + n0 + c4);
    if (q.scale) { const float sc = q.scale[k0 + r]; x.x *= sc; x.y *= sc; x.z *= sc; x.w *= sc; }
    v[ps] = x;
  }
}
__device__ __forceinline__ void phase_prep(const Params& p, int bid, int nblk, unsigned char* smem, unsigned* wg_bar, int cxw) {
  const int tid = opaque_tid(cxw);
  float* tl = (float*)smem;
  VB_DECL(wg_bar);
  f32x4 v[4];
  PrepTile cur = prep_decode(p, bid < 6528 ? bid : 0);
  if (bid < 6528) prep_load(cur, tid, v);
  for (int g = bid; g < 6528; g += nblk) {
    VB_SYNC();
    {
      const int c4 = (tid & 15) * 4, r0 = tid >> 4;
#pragma unroll
      for (int ps = 0; ps < 4; ++ps) { const int r = r0 + ps * 16; tl[r * 65 + c4] = v[ps].x; tl[r * 65 + c4 + 1] = v[ps].y; tl[r * 65 + c4 + 2] = v[ps].z; tl[r * 65 + c4 + 3] = v[ps].w; }
    }
    const PrepTile ths = cur;
    if (g + nblk < 6528) { cur = prep_decode(p, g + nblk); prep_load(cur, tid, v); }
    VB_SYNC();
    {
      const int tiles_k = ths.K >> 6, tk = ths.t % tiles_k, tn = ths.t / tiles_k, k0 = tk * 64, n0 = tn * 64;
      const int n = tid >> 2, kq = (tid & 3) * 16;
      unsigned w[8];
#pragma unroll
      for (int e = 0; e < 8; ++e) w[e] = pack2(tl[(kq + 2 * e) * 65 + n], tl[(kq + 2 * e + 1) * 65 + n]);
      u32x4 o0, o1; o0.x = w[0]; o0.y = w[1]; o0.z = w[2]; o0.w = w[3]; o1.x = w[4]; o1.y = w[5]; o1.z = w[6]; o1.w = w[7];
      bf16_t* dp = ths.dst + (size_t)(n0 + n) * ths.K + k0 + kq;
      *(u32x4*)dp = o0; *(u32x4*)(dp + 8) = o1;
    }
  }
  for (int i = bid * NTHR + tid; i < 2 * 2 * 1024; i += nblk * NTHR) p.knorm[i] = 0.f;
}

__device__ __forceinline__ void phase_mod(const Params& p, int bid, int nblk, unsigned char* smem, int cxw) {
  const int tidx = opaque_tid(cxw);
  float* sc = (float*)smem;
  float* red = sc + 5 * 1024;
  __syncthreads();
  for (int i = tidx; i < 5 * 1024; i += NTHR) {
    int r = i >> 10, k = i & 1023;
    float v = (r == 0) ? p.c_ctx[k] : p.c[(r - 1) * 1024 + k];
    sc[i] = siluf(v);
  }
  __syncthreads();
  const int cj = tidx & 31, kg = tidx >> 5;
  for (int item = bid; item < 4 * 96; item += nblk) {
    const int layer = item / 96, j = (item % 96) * 32 + cj;
    const float* w = p.mod_w + (size_t)layer * 1024 * 3072 + (size_t)kg * 128 * 3072 + j;
    const float* s0 = sc + kg * 128;
    float a0 = 0, a1 = 0, a2 = 0, a3 = 0, a4 = 0;
#pragma unroll 32
    for (int k = 0; k < 128; ++k) {
      float wv = w[(size_t)k * 3072];
      a0 += s0[k] * wv; a1 += s0[1024 + k] * wv; a2 += s0[2048 + k] * wv; a3 += s0[3072 + k] * wv; a4 += s0[4096 + k] * wv;
    }
    __syncthreads();
    red[(kg * 5 + 0) * 32 + cj] = a0; red[(kg * 5 + 1) * 32 + cj] = a1; red[(kg * 5 + 2) * 32 + cj] = a2;
    red[(kg * 5 + 3) * 32 + cj] = a3; red[(kg * 5 + 4) * 32 + cj] = a4;
    __syncthreads();
    if (tidx < 160) {
      const int rr = tidx >> 5, cc = tidx & 31;
      float sum = 0.f;
#pragma unroll
      for (int g8 = 0; g8 < 8; ++g8) sum += red[(g8 * 5 + rr) * 32 + cc];
      const int jj = (item % 96) * 32 + cc;
      p.modv[((size_t)layer * 5 + rr) * 3072 + jj] = sum + p.mod_b[layer * 3072 + jj];
    }
  }
}

__device__ __forceinline__ void phase_hyfilt_a(const Params& p, int bid, int nblk, unsigned char* smem, int cxw) {
  const int tidx = opaque_tid(cxw);
  float* sz = (float*)smem;
  float* sh = sz + 4 * 36;
  float* sw1 = sh + 4 * 64;
  float* sw2 = sw1 + 33 * 64;
  int pl = tidx >> 6, m = tidx & 63;
  __syncthreads();
  for (int i = tidx; i < 33 * 64; i += NTHR) sw1[i] = p.hy_f_w1[i];
  for (int i = tidx; i < 64 * 64; i += NTHR) sw2[i] = p.hy_f_w2[i];
  const float b1 = p.hy_f_b1[m], b2 = p.hy_f_b2[m], fq1 = p.hy_f_freq[m], fq2 = p.hy_f_freq[64 + m];
  for (int item = bid; item < 4352 / 4; item += nblk) {
    int pos = item * 4 + pl;
    int L = pos < 256 ? 256 : 4096;
    int l = pos < 256 ? pos : pos - 256;
    __syncthreads();
    if (m < 33) {
      float t = (float)l / (float)L;
      float w = (6.283185307179586f * (float)l) / (float)L;
      float v;
      if (m == 0) v = t;
      else {
        int j = (m - 1) & 15;
        float fr = 1e-4f + (float)j * ((15.f - 1e-4f) / 15.f);
        float ang = w * fr;
        v = (m <= 16) ? __cosf(ang) : __sinf(ang);
      }
      sz[pl * 36 + m] = v;
    }
    __syncthreads();
    float a = b1;
#pragma unroll
    for (int e = 0; e < 33; ++e) a += sz[pl * 36 + e] * sw1[e * 64 + m];
    a = __sinf(fq1 * a);
    sh[pl * 64 + m] = a;
    __syncthreads();
    float b = b2;
#pragma unroll
    for (int e = 0; e < 64; ++e) b += sh[pl * 64 + e] * sw2[e * 64 + m];
    b = __sinf(fq2 * b);
    p.hdn2[(size_t)pos * 64 + m] = b;
  }
}

__device__ __forceinline__ void hy_split8(const f32x4 v0, const f32x4 v1, bf16x8& hi, bf16x8& lo) {
  const float x[8] = {v0.x, v0.y, v0.z, v0.w, v1.x, v1.y, v1.z, v1.w};
  u32x4 h, l;
#pragma unroll
  for (int e = 0; e < 4; ++e) {
    const unsigned ph = pack2(x[2 * e], x[2 * e + 1]);
    h[e] = ph; l[e] = pack2(x[2 * e] - bflo(ph), x[2 * e + 1] - bfhi(ph));
  }
  hi = __builtin_bit_cast(bf16x8, h); lo = __builtin_bit_cast(bf16x8, l);
}
__device__ __forceinline__ void phase_hyfilt_b(const Params& p, int bid, int nblk, unsigned char* smem, unsigned* wg_bar, int cxw) {
  const int tid = opaque_tid(cxw);
  const int lane = tid & 63, w = cxw & 3, r = lane & 31, hh = lane >> 5;
  float* sw = (float*)smem;
  bf16_t* T = (bf16_t*)(smem + 64 * 68 * 4);
  float* sred = (float*)(smem + 64 * 68 * 4 + 64 * 264 * 2);
  VB_DECL(wg_bar);
  int cur_chunk = -1;
  bf16x8 bhi[2][4], blo[2][4];
  const float min_decay = -3.0701134573253945f, max_decay = -15.350567286626973f;
  for (int item = bid; item < 17 * 64; item += nblk) {
    const int lb = item >> 6, chunk = item & 63;
    const int Lsel = lb ? 1 : 0, L = Lsel ? 4096 : 256, RL = 2 * L;
    const int lbase = Lsel ? (lb - 1) * 256 : 0, posbase = Lsel ? 256 + lbase : 0;
    const int odc0 = chunk * 64, o = odc0 >> 11, d = (odc0 >> 10) & 1, c0 = odc0 & 1023;
    VB_SYNC();
    if (chunk != cur_chunk) {
      cur_chunk = chunk;
#pragma unroll
      for (int i = 0; i < 16; ++i) {
        const int q = tid + i * 256, m = q >> 6, cc = q & 63;
        sw[cc * 68 + m] = p.hy_f_w3[(size_t)m * 4096 + odc0 + cc];
      }
      VB_SYNC();
#pragma unroll
      for (int ct2 = 0; ct2 < 2; ++ct2)
#pragma unroll
        for (int ks = 0; ks < 4; ++ks) {
          const float* bp = sw + (32 * ct2 + r) * 68 + 16 * ks + 8 * hh;
          hy_split8(*(const f32x4*)bp, *(const f32x4*)(bp + 4), bhi[ct2][ks], blo[ct2][ks]);
        }
    }
    float asum[2] = {0.f, 0.f};
    float delta[2];
#pragma unroll
    for (int ct2 = 0; ct2 < 2; ++ct2) delta[ct2] = fabsf(min_decay + (float)(c0 + 32 * ct2 + r) * ((max_decay - min_decay) / 1023.f));
    const float invL = 1.f / (float)L;
#pragma unroll
    for (int rt2 = 0; rt2 < 2; ++rt2) {
      bf16x8 ahi[4], alo[4];
      {
        const float* ap = p.hdn2 + (size_t)(posbase + 64 * w + 32 * rt2 + r) * 64 + 8 * hh;
#pragma unroll
        for (int ks = 0; ks < 4; ++ks) hy_split8(*(const f32x4*)(ap + 16 * ks), *(const f32x4*)(ap + 16 * ks + 4), ahi[ks], alo[ks]);
      }
#pragma unroll
      for (int ct2 = 0; ct2 < 2; ++ct2) {
        f32x16 acc;
#pragma unroll
        for (int e = 0; e < 16; ++e) acc[e] = 0.f;
#pragma unroll
        for (int ks = 0; ks < 4; ++ks) {
          acc = __builtin_amdgcn_mfma_f32_32x32x16_bf16(alo[ks], bhi[ct2][ks], acc, 0, 0, 0);
          acc = __builtin_amdgcn_mfma_f32_32x32x16_bf16(ahi[ks], blo[ct2][ks], acc, 0, 0, 0);
          acc = __builtin_amdgcn_mfma_f32_32x32x16_bf16(ahi[ks], bhi[ct2][ks], acc, 0, 0, 0);
        }
#pragma unroll
        for (int qd = 0; qd < 4; ++qd) {
          const int ll0 = 64 * w + 32 * rt2 + 8 * qd + 4 * hh;
          float kv[4];
#pragma unroll
          for (int u = 0; u < 4; ++u) {
            const float t = (float)(lbase + ll0 + u) * invL;
            kv[u] = acc[4 * qd + u] * __expf(-t * delta[ct2]);
            asum[ct2] += fabsf(kv[u]);
          }
          u32x2 ov;
          if (d == 0) { ov.x = pack2(kv[3], kv[2]); ov.y = pack2(kv[1], kv[0]); *(u32x2*)(T + (32 * ct2 + r) * 264 + (252 - ll0)) = ov; }
          else        { ov.x = pack2(kv[0], kv[1]); ov.y = pack2(kv[2], kv[3]); *(u32x2*)(T + (32 * ct2 + r) * 264 + ll0) = ov; }
        }
      }
    }
#pragma unroll
    for (int ct2 = 0; ct2 < 2; ++ct2) {
      const float tot = asum[ct2] + shfl_idx_f(asum[ct2], lane ^ 32);
      if (hh == 0) sred[w * 64 + 32 * ct2 + r] = tot;
    }
    VB_SYNC();
    bf16_t* rt = Lsel ? p.rtab1 : p.rtab0;
    if (d == 0) {
#pragma unroll
      for (int i = 0; i < 8; ++i) {
        const int q = tid + i * 256, cc = q >> 5, ch = q & 31;
        *(u32x4*)(rt + (size_t)(o * 1024 + c0 + cc) * RL + (L - 256 - lbase) + ch * 8) = *(const u32x4*)(T + cc * 264 + ch * 8);
      }
    } else {
#pragma unroll
      for (int i = 0; i < 8; ++i) {
        const int q = tid + i * 256, cc = q >> 5, ch = q & 31;
        const u32x4 v = *(const u32x4*)(T + cc * 264 + ch * 8);
        bf16_t* dp = rt + (size_t)(o * 1024 + c0 + cc) * RL + (L + lbase) + ch * 8;
        u32x4 sv;
        sv.x = (v.x >> 16) | (v.y << 16); sv.y = (v.y >> 16) | (v.z << 16); sv.z = (v.z >> 16) | (v.w << 16);
        if (ch < 31) {
          const unsigned nx = T[cc * 264 + ch * 8 + 8];
          sv.w = (v.w >> 16) | (nx << 16);
          *(u32x4*)dp = sv;
        } else {
          u32x2 s2; s2.x = sv.x; s2.y = sv.y;
          *(u32x2*)dp = s2; *(unsigned*)(dp + 4) = sv.z; dp[6] = (bf16_t)(v.w >> 16);
        }
      }
      if (tid < 64) {
        bf16_t* rowp = rt + (size_t)(o * 1024 + c0 + tid) * RL;
        if (lbase == 0) rowp[RL - 1] = 0;
        else rowp[L + lbase - 1] = T[tid * 264];
      }
    }
    if (tid < 64) atomicAdd(&p.knorm[(Lsel * 2 + o) * 1024 + c0 + tid], sred[tid] + sred[64 + tid] + sred[128 + tid] + sred[192 + tid]);
  }
}

__device__ __forceinline__ void phase_lnmod(const Params& p, int layer, int bid, int nblk, int cxw) {
  const int tidx = opaque_tid(cxw);
  const bool split_tail = (nblk == 512) && (layer == 2 || layer == 3);
  int lane = tidx & 63, wv = cxw & 3;
  f32x4 lg[4], lb[4];
  if (layer > 0) {
    const float* g = p.ln_g + (layer - 1) * DM; const float* b = p.ln_b + (layer - 1) * DM;
#pragma unroll
    for (int j = 0; j < 4; ++j) { lg[j] = *(const f32x4*)(g + j * 256 + lane * 4); lb[j] = *(const f32x4*)(b + j * 256 + lane * 4); }
  }
  f32x4 vn[4];
#define LNMOD_LOAD(ROW) do { const int row_ = (ROW); \
    if (layer == 0) { const float* src_ = row_ < T_CTX ? p.x_prompt + (size_t)row_ * DM : p.x_sample + (size_t)(row_ - T_CTX) * DM; \
      _Pragma("unroll") for (int j = 0; j < 4; ++j) vn[j] = *(const f32x4*)(src_ + j * 256 + lane * 4); } \
    else { const bf16_t* src_ = p.resb + (size_t)row_ * DM; \
      _Pragma("unroll") for (int j = 0; j < 4; ++j) { const u32x2 w_ = *(const u32x2*)(src_ + j * 256 + lane * 4); \
        vn[j].x = bflo(w_.x); vn[j].y = bfhi(w_.x); vn[j].z = bflo(w_.y); vn[j].w = bfhi(w_.y); } \
      if (split_tail && row_ >= 16384) { const bf16_t* ps_ = p.outp + (size_t)(row_ - 16384) * DM;     \
        _Pragma("unroll") for (int j = 0; j < 4; ++j) { const u32x2 w_ = *(const u32x2*)(ps_ + j * 256 + lane * 4); \
          vn[j].x += bflo(w_.x); vn[j].y += bfhi(w_.x); vn[j].z += bflo(w_.y); vn[j].w += bfhi(w_.y); } } } } while (0)
  if (bid * 4 + wv < T_ALL) LNMOD_LOAD(bid * 4 + wv);
  f32x4 msh[4], msc[4]; int cur_mrow = -1;
#pragma unroll
  for (int j = 0; j < 4; ++j) { msh[j] = f32x4{0.f, 0.f, 0.f, 0.f}; msc[j] = f32x4{0.f, 0.f, 0.f, 0.f}; }
  for (int row = bid * 4 + wv; row < T_ALL; row += nblk * 4) {
    f32x4 v[4];
#pragma unroll
    for (int j = 0; j < 4; ++j) v[j] = vn[j];
    if (row + nblk * 4 < T_ALL) LNMOD_LOAD(row + nblk * 4);
    if (layer < 4) {
      const int mrow_ = row < T_CTX ? 0 : 1 + ((row - T_CTX) >> 12);
      if (mrow_ != cur_mrow) {
        cur_mrow = mrow_;
        const float* mv_ = p.modv + ((size_t)layer * 5 + mrow_) * 3072;
#pragma unroll
        for (int j = 0; j < 4; ++j) { msh[j] = *(const f32x4*)(mv_ + j * 256 + lane * 4); msc[j] = *(const f32x4*)(mv_ + 1024 + j * 256 + lane * 4); }
      }
    }
    if (layer > 0) {
      float s = 0.f;
#pragma unroll
      for (int j = 0; j < 4; ++j) s += v[j].x + v[j].y + v[j].z + v[j].w;
      s = wave_sum(s);
      float mu = s * (1.f / 1024.f);
      float q = 0.f;
#pragma unroll
      for (int j = 0; j < 4; ++j) { float a = v[j].x - mu, b = v[j].y - mu, c = v[j].z - mu, d = v[j].w - mu; q += a * a + b * b + c * c + d * d; }
      q = wave_sum(q);
      float rs = rsqrtf(q * (1.f / 1024.f) + LN_EPS);
#pragma unroll
      for (int j = 0; j < 4; ++j) {
        const f32x4 gg = lg[j], bb = lb[j];
        v[j].x = (v[j].x - mu) * rs * gg.x + bb.x; v[j].y = (v[j].y - mu) * rs * gg.y + bb.y;
        v[j].z = (v[j].z - mu) * rs * gg.z + bb.z; v[j].w = (v[j].w - mu) * rs * gg.w + bb.w;
      }
    }
    if (layer == 4) {
      float* dst = p.xres + (size_t)row * DM;
#pragma unroll
      for (int j = 0; j < 4; ++j) *(f32x4*)(dst + j * 256 + lane * 4) = v[j];
    } else {
      bf16_t* dst = p.resb + (size_t)row * DM;
#pragma unroll
      for (int j = 0; j < 4; ++j) { u32x2 o; o.x = pack2(v[j].x, v[j].y); o.y = pack2(v[j].z, v[j].w); *(u32x2*)(dst + j * 256 + lane * 4) = o; }
    }
    if (layer < 4) {
#pragma unroll
      for (int j = 0; j < 4; ++j) {
        const f32x4 sh = msh[j], sc = msc[j];
        u32x2 o;
        o.x = pack2(v[j].x * (1.f + sc.x) + sh.x, v[j].y * (1.f + sc.y) + sh.y);
        o.y = pack2(v[j].z * (1.f + sc.z) + sh.z, v[j].w * (1.f + sc.w) + sh.w);
        *(u32x2*)(p.hbuf + (size_t)row * DM + j * 256 + lane * 4) = o;
      }
    }
  }
}

#define PG8_LAS __attribute__((address_space(3)))
namespace pg8 {
constexpr int BM = 256, BK = 64, HALF = 128, HTB = HALF * BK * 2, STAGE_BYTES = 8 * HTB, NXCD = 8, WGM = 8;
__device__ __forceinline__ int lds_byte(int r, int c) { const int st = (r >> 4) * 2 + (c >> 5), rr = r & 15, cc = c & 31, ob = rr * 64 + cc * 2; return st * 1024 + (ob ^ (((ob >> 9) & 1) << 5)); }
__device__ __forceinline__ void stage_rc(int b, int& R, int& C) { const int st = b / 1024, sb = b % 1024, swz = sb ^ (((sb >> 9) & 1) << 5); R = (st >> 1) * 16 + swz / 64; C = (st & 1) * 32 + (swz % 64) / 2; }
__device__ __forceinline__ int perm32(int rho) { const int n = rho >> 4, i = rho & 15; return 8 * (i >> 2) + 4 * n + (i & 3); }
struct Unit { int pm, pn; int koff, nt, part; };
struct Gemm { const bf16_t* A; const bf16_t* Bt; int M, N, K, lda; int a_grp_shift; int a_grp_bytes; };
struct StaticOrder {
  int nM, nN, nwg, G, c, ntfull, split;
  __device__ void init(int M, int N, int K, int G_, int c_, int split_) {
    nM = M / BM; nN = N / BM; nwg = nM * nN; G = G_; c = c_; ntfull = K / BK;
    split = (G_ == 256 && nM == 96 && nN == 4) ? split_ : 0;
  }
  __device__ bool next(int i, Unit& u) const {
    if (split == 2) {
      if (i != 0 || c < 128) return false;
      const int c2 = c - 128; u.pm = c2 >> 2; u.pn = c2 & 3; u.koff = 0; u.nt = ntfull; u.part = 0; return true;
    }
    if (split == 3) {
      if (i != 0) return false;
      const int xcd = c & 7, j = c >> 3; u.pm = 32 + xcd * 8 + (j >> 2); u.pn = j & 3; u.koff = 0; u.nt = ntfull; u.part = 0; return true;
    }
    if (split) {
      const int xcd = c & 7, j = c >> 3;
      if (i == 0) { u.pm = xcd * 8 + (j >> 2); u.pn = j & 3; u.koff = 0; u.nt = ntfull; u.part = 0; return true; }
      if (i == 1) { const int ul = j >> 1, kh = j & 1; u.pm = 64 + xcd * 4 + (ul >> 2); u.pn = ul & 3; u.nt = ntfull >> 1; u.koff = kh * (ntfull >> 1) * BK; u.part = 1 + kh; return true; }
      return false;
    }
    const long L = (long)i * G + c; if (L >= nwg) return false;
    int wgid = (int)L; { const int q = nwg / NXCD, r = nwg % NXCD, xcd = wgid % NXCD, off = wgid / NXCD; wgid = (xcd < r ? xcd * (q + 1) : r * (q + 1) + (xcd - r) * q) + off; }
    const int nig = WGM * nN, gid = wgid / nig, fm = gid * WGM, gsz = (nM - fm) < WGM ? (nM - fm) : WGM;
    u.pm = fm + ((wgid % nig) % gsz); u.pn = (wgid % nig) / gsz; u.koff = 0; u.nt = ntfull; u.part = 0; return true;
  }
};
__device__ __forceinline__ unsigned cvt_pk_bf16(float lo, float hi) { return pack2(lo, hi); }

template <class Epi>
__device__ __forceinline__ void gemm_phase(PG8_LAS unsigned char* lds, const Gemm g, const StaticOrder& S, const Epi& E, int wave) {
  const int tid = opaque_tid512(wave), wid = wave, lane = tid & 63, wr = wid >> 2, wc = wid & 3, fr = lane & 15, fq = lane >> 4;
  const int K = g.K, lda = g.lda;
  unsigned voffA[2], voffB[2];
#pragma unroll
  for (int i = 0; i < 2; ++i) { int R, C; stage_rc(tid * 16 + i * 8192, R, C); const int Rb = Epi::PERM ? ((R & ~31) + perm32(R & 31)) : R;
    voffA[i] = (unsigned)(R * lda + C) * 2u; voffB[i] = (unsigned)(Rb * K + C) * 2u; }
  const size_t kstep = (size_t)(BK * 2);
  const size_t hstepA = (size_t)HALF * lda * 2, hstepB = (size_t)HALF * K * 2;
  const size_t tstepA = 2 * hstepA, tstepB = 2 * hstepB;
  const unsigned ldsw = (unsigned)wid * 1024u;
  const int aoff = lds_byte(wr * 64 + fr, fq * 8), boff = lds_byte(wc * 32 + fr, fq * 8);
#define PG8_SA(b, h) (((b) * 2 + (h)) * HTB)
#define PG8_SB(b, h) ((4 + (b) * 2 + (h)) * HTB)
#define PG8_STAGE(bufoff, gbase, voff) do { _Pragma("unroll") for (int _i = 0; _i < 2; ++_i) \
    __builtin_amdgcn_global_load_lds((const unsigned*)((const char*)(gbase) + (voff)[_i]), (PG8_LAS unsigned*)(lds + (bufoff) + ldsw + _i * 8192), 16, 0, 0); } while (0)
#define PG8_LDA(dst, b, h) do { _Pragma("unroll") for (int m = 0; m < 4; ++m) _Pragma("unroll") for (int k = 0; k < 2; ++k) dst[m][k] = *(const PG8_LAS bf16x8*)(lds + PG8_SA(b, h) + aoff + m * 2048 + k * 1024); } while (0)
#define PG8_LDB(dst, b, h) do { _Pragma("unroll") for (int n = 0; n < 2; ++n) _Pragma("unroll") for (int k = 0; k < 2; ++k) dst[n][k] = *(const PG8_LAS bf16x8*)(lds + PG8_SB(b, h) + boff + n * 2048 + k * 1024); } while (0)
#define PG8_MMA(ai, bj, At, Bt) do { __builtin_amdgcn_s_setprio(1); _Pragma("unroll") for (int m = 0; m < 4; ++m) _Pragma("unroll") for (int n = 0; n < 2; ++n) _Pragma("unroll") for (int k = 0; k < 2; ++k) \
    acc[ai][bj][m][n] = __builtin_amdgcn_mfma_f32_16x16x32_bf16(Bt[n][k], At[m][k], acc[ai][bj][m][n], 0, 0, 0); __builtin_amdgcn_s_setprio(0); } while (0)
#define PG8_WAIT_V(n) asm volatile("s_waitcnt vmcnt(" #n ")" ::: "memory")
#define PG8_WAIT_L(n) asm volatile("s_waitcnt lgkmcnt(" #n ")" ::: "memory")
#define PG8_BAR __builtin_amdgcn_s_barrier()
#define PG8_SCHED __builtin_amdgcn_sched_barrier(0)
#define PG8_APTR(u) ((const char*)g.A + (size_t)(u).pm * tstepA + (size_t)(((u).pn >> g.a_grp_shift) * g.a_grp_bytes) + (size_t)(u).koff * 2)
#define PG8_BPTR(u) ((const char*)g.Bt + (size_t)(u).pn * tstepB + (size_t)(u).koff * 2)
  Unit cur, nxt; int ui = 0;
  if (!S.next(0, cur)) return;
  f32x4 acc[2][2][4][2];
#pragma unroll
  for (int a = 0; a < 2; ++a)
#pragma unroll
    for (int b = 0; b < 2; ++b)
#pragma unroll
      for (int m = 0; m < 4; ++m)
#pragma unroll
        for (int n = 0; n < 2; ++n) acc[a][b][m][n] = (f32x4){0.f, 0.f, 0.f, 0.f};
  bf16x8 At[4][2], B0[2][2], B1[2][2];
  const char* cA = PG8_APTR(cur); const char* cB = PG8_BPTR(cur);
  PG8_STAGE(PG8_SB(0, 0), cB, voffB); PG8_STAGE(PG8_SA(0, 0), cA, voffA); PG8_STAGE(PG8_SB(0, 1), cB + hstepB, voffB); PG8_STAGE(PG8_SA(0, 1), cA + hstepA, voffA);
  if (wr == 1) PG8_BAR;
  PG8_WAIT_V(4); PG8_BAR;
  PG8_STAGE(PG8_SB(1, 0), cB + kstep, voffB); PG8_STAGE(PG8_SA(1, 0), cA + kstep, voffA); PG8_STAGE(PG8_SB(1, 1), cB + hstepB + kstep, voffB);
  PG8_WAIT_V(6); PG8_BAR;
  for (;;) {
    const bool has_next = S.next(ui + 1, nxt);
    const char* nA = has_next ? PG8_APTR(nxt) : cA; const char* nB = has_next ? PG8_BPTR(nxt) : cB;
    const int nt = cur.nt;
    for (int t = 0; t < nt; t += 2) {
      const bool last = (t == nt - 2);
      const char* a1 = cA + (size_t)(t + 1) * kstep;
      const char* a2 = last ? nA : cA + (size_t)(t + 2) * kstep; const char* b2 = last ? nB : cB + (size_t)(t + 2) * kstep;
      const char* a3 = a2 + kstep; const char* b3 = b2 + kstep;
      PG8_LDB(B0, 0, 0); PG8_SCHED; PG8_LDA(At, 0, 0); PG8_STAGE(PG8_SA(1, 1), a1 + hstepA, voffA);
      PG8_WAIT_L(8); PG8_BAR; PG8_WAIT_L(0); PG8_MMA(0, 0, At, B0); PG8_BAR; PG8_SCHED;
      PG8_LDB(B1, 0, 1); PG8_STAGE(PG8_SB(0, 0), b2, voffB);
      PG8_BAR; PG8_WAIT_L(0); PG8_MMA(0, 1, At, B1); PG8_BAR;
      PG8_LDA(At, 0, 1); PG8_STAGE(PG8_SA(0, 0), a2, voffA);
      PG8_BAR; PG8_WAIT_L(0); PG8_MMA(1, 0, At, B0); PG8_BAR; PG8_SCHED;
      PG8_STAGE(PG8_SB(0, 1), b2 + hstepB, voffB);
      PG8_WAIT_V(6); PG8_BAR; PG8_MMA(1, 1, At, B1); PG8_BAR;
      PG8_LDB(B0, 1, 0); PG8_SCHED; PG8_LDA(At, 1, 0); PG8_STAGE(PG8_SA(0, 1), a2 + hstepA, voffA);
      PG8_WAIT_L(8); PG8_BAR; PG8_WAIT_L(0); PG8_MMA(0, 0, At, B0); PG8_BAR; PG8_SCHED;
      PG8_LDB(B1, 1, 1); PG8_STAGE(PG8_SB(1, 0), b3, voffB);
      PG8_BAR; PG8_WAIT_L(0); PG8_MMA(0, 1, At, B1); PG8_BAR;
      PG8_LDA(At, 1, 1); PG8_STAGE(PG8_SA(1, 0), a3, voffA);
      PG8_BAR; PG8_WAIT_L(0); PG8_MMA(1, 0, At, B0); PG8_BAR; PG8_SCHED;
      PG8_STAGE(PG8_SB(1, 1), b3 + hstepB, voffB);
      PG8_WAIT_V(6); PG8_BAR; PG8_MMA(1, 1, At, B1); PG8_BAR;
    }
    { const int lane2 = opaque_lane();
      E(acc, cur, wr, wc, lane2 & 15, lane2 >> 4); }
    if (!has_next) break;
#pragma unroll
    for (int a = 0; a < 2; ++a)
#pragma unroll
      for (int b = 0; b < 2; ++b)
#pragma unroll
        for (int m = 0; m < 4; ++m)
#pragma unroll
          for (int n = 0; n < 2; ++n) acc[a][b][m][n] = (f32x4){0.f, 0.f, 0.f, 0.f};
    cur = nxt; cA = nA; cB = nB; ++ui;
  }
  PG8_WAIT_V(0);
  if (wr == 0) PG8_BAR;
  PG8_BAR;
#undef PG8_SA
#undef PG8_SB
#undef PG8_STAGE
#undef PG8_LDA
#undef PG8_LDB
#undef PG8_MMA
#undef PG8_WAIT_V
#undef PG8_WAIT_L
#undef PG8_BAR
#undef PG8_SCHED
#undef PG8_APTR
#undef PG8_BPTR
}

struct EpiBf16 {
  static constexpr bool PERM = true;
  bf16_t* O; size_t ldc;
  __device__ __forceinline__ void operator()(const f32x4 (&acc)[2][2][4][2], const Unit& u, int wr, int wc, int fr, int fq) const {
    const int row0 = u.pm * BM + wr * 64 + fr, col0 = u.pn * BM + wc * 32 + 8 * fq;
#pragma unroll
    for (int ai = 0; ai < 2; ++ai)
#pragma unroll
      for (int m = 0; m < 4; ++m) {
        bf16_t* rowp = O + (size_t)(row0 + ai * HALF + m * 16) * ldc + col0;
#pragma unroll
        for (int bj = 0; bj < 2; ++bj) {
          const f32x4 v0 = acc[ai][bj][m][0], v1 = acc[ai][bj][m][1];
          u32x4 w; w.x = pack2(v0[0], v0[1]); w.y = pack2(v0[2], v0[3]); w.z = pack2(v1[0], v1[1]); w.w = pack2(v1[2], v1[3]);
          *(u32x4*)(rowp + bj * HALF) = w;
        }
      }
  }
};
struct EpiSsdIn {
  static constexpr bool PERM = true;
  bf16_t* z; bf16_t* xbc; float* dt; const float* dt_bias;
  __device__ __forceinline__ void operator()(const f32x4 (&acc)[2][2][4][2], const Unit& u, int wr, int wc, int fr, int fq) const {
    const int row0 = u.pm * BM + wr * 64 + fr, colt = u.pn * BM + wc * 32 + 8 * fq;
    if (u.pn < 24) {
      bf16_t* base = u.pn < 8 ? z : xbc; const size_t ldc = u.pn < 8 ? 2048 : 4096; const int col0 = u.pn < 8 ? colt : colt - 2048;
#pragma unroll
      for (int ai = 0; ai < 2; ++ai)
#pragma unroll
        for (int m = 0; m < 4; ++m) {
          bf16_t* rowp = base + (size_t)(row0 + ai * HALF + m * 16) * ldc + col0;
#pragma unroll
          for (int bj = 0; bj < 2; ++bj) {
            const f32x4 v0 = acc[ai][bj][m][0], v1 = acc[ai][bj][m][1];
            u32x4 w; w.x = pack2(v0[0], v0[1]); w.y = pack2(v0[2], v0[3]); w.z = pack2(v1[0], v1[1]); w.w = pack2(v1[2], v1[3]);
            *(u32x4*)(rowp + bj * HALF) = w;
          }
        }
    } else {
      const int c0 = wc * 32 + 8 * fq;
      if (c0 < 64) {
#pragma unroll
        for (int ai = 0; ai < 2; ++ai)
#pragma unroll
          for (int m = 0; m < 4; ++m) {
            float* rowp = dt + (size_t)(row0 + ai * HALF + m * 16) * 64 + c0;
#pragma unroll
            for (int n = 0; n < 2; ++n) {
              const f32x4 v = acc[ai][0][m][n];
              f32x4 o;
#pragma unroll
              for (int e = 0; e < 4; ++e) o[e] = softplusf(v[e] + dt_bias[c0 + 4 * n + e]);
              *(f32x4*)(rowp + 4 * n) = o;
            }
          }
      }
    }
  }
};
struct EpiOut {
  static constexpr bool PERM = true;
  bf16_t* res; const float* modv_layer; const float* rstd; bf16_t* part2;
  __device__ __forceinline__ void operator()(const f32x4 (&acc)[2][2][4][2], const Unit& u, int wr, int wc, int fr, int fq) const {
    const int row0 = u.pm * BM + wr * 64 + fr, col0 = u.pn * BM + wc * 32 + 8 * fq;
    const bool second = u.part == 2;
    const float al = second ? 0.f : ALPHA_RES;
    const int mrow = u.pm * BM < T_CTX ? 0 : 1 + ((u.pm * BM - T_CTX) >> 12);
    f32x4 gv[2][2];
#pragma unroll
    for (int bj = 0; bj < 2; ++bj) {
      const float* gp = modv_layer + (size_t)mrow * 3072 + 2048 + col0 + bj * HALF;
      gv[bj][0] = *(const f32x4*)gp; gv[bj][1] = *(const f32x4*)(gp + 4);
    }
#pragma unroll
    for (int ai = 0; ai < 2; ++ai) {
      u32x4 xw[4][2]; float rs[4];
#pragma unroll
      for (int m = 0; m < 4; ++m) {
        const int row = row0 + ai * HALF + m * 16;
        rs[m] = rstd ? rstd[row] : 1.f;
#pragma unroll
        for (int bj = 0; bj < 2; ++bj) {
          xw[m][bj] = u32x4{0u, 0u, 0u, 0u};
          if (!second) xw[m][bj] = *(const u32x4*)(res + (size_t)row * DM + col0 + bj * HALF);
        }
      }
#pragma unroll
      for (int m = 0; m < 4; ++m) {
        const int row = row0 + ai * HALF + m * 16;
        bf16_t* rowp = second ? part2 + (size_t)(row - 16384) * DM + col0 : res + (size_t)row * DM + col0;
#pragma unroll
        for (int bj = 0; bj < 2; ++bj) {
          const f32x4 g0 = gv[bj][0], g1 = gv[bj][1];
          const u32x4 x = xw[m][bj];
          const f32x4 v0 = acc[ai][bj][m][0], v1 = acc[ai][bj][m][1];
          const float r = rs[m];
          u32x4 o;
          o.x = pack2(al * bflo(x.x) + g0.x * (v0[0] * r), al * bfhi(x.x) + g0.y * (v0[1] * r));
          o.y = pack2(al * bflo(x.y) + g0.z * (v0[2] * r), al * bfhi(x.y) + g0.w * (v0[3] * r));
          o.z = pack2(al * bflo(x.z) + g1.x * (v1[0] * r), al * bfhi(x.z) + g1.y * (v1[1] * r));
          o.w = pack2(al * bflo(x.w) + g1.z * (v1[2] * r), al * bfhi(x.w) + g1.w * (v1[3] * r));
          *(u32x4*)(rowp + bj * HALF) = o;
        }
      }
    }
  }
};
struct EpiLruGate {
  static constexpr bool PERM = true;
  bf16_t* gates; const float* gate_b; const bf16_t* xc; const float* a_param;
  __device__ __forceinline__ void operator()(const f32x4 (&acc)[2][2][4][2], const Unit& u, int wr, int wc, int fr, int fq) const {
    const int nb = u.pn >> 2, dir = (u.pn >> 1) & 1, half = u.pn & 1;
    const int row0 = u.pm * BM + wr * 64 + fr, ch0 = nb * 256 + half * 128 + wc * 32 + 8 * fq;
    float br[8], bi[8], sp[8];
#pragma unroll
    for (int e = 0; e < 8; ++e) {
      br[e] = gate_b[(2 * dir) * 1024 + ch0 + e]; bi[e] = gate_b[(2 * dir + 1) * 1024 + ch0 + e];
      sp[e] = -8.f * softplusf(-a_param[dir * 1024 + ch0 + e]);
    }
    u32x4 xall[8];
#pragma unroll
    for (int i = 0; i < 8; ++i) xall[i] = *(const u32x4*)(xc + (size_t)(row0 + (i >> 2) * HALF + (i & 3) * 16) * 1024 + ch0);
#pragma unroll
    for (int ai = 0; ai < 2; ++ai)
#pragma unroll
      for (int m = 0; m < 4; ++m) {
        const size_t ro = (size_t)(row0 + ai * HALF + m * 16) * 1024 + ch0;
        const u32x4 xv = xall[ai * 4 + m];
        const float x[8] = {bflo(xv.x), bfhi(xv.x), bflo(xv.y), bfhi(xv.y), bflo(xv.z), bfhi(xv.z), bflo(xv.w), bfhi(xv.w)};
        float la[8], bx[8];
#pragma unroll
        for (int e = 0; e < 8; ++e) {
          const float e1 = 1.f + __expf(-fminf(fmaxf(acc[ai][0][m][e >> 2][e & 3] + br[e], -30.f), 30.f));
          const float e2 = 1.f + __expf(-fminf(fmaxf(acc[ai][1][m][e >> 2][e & 3] + bi[e], -30.f), 30.f));
          const float q = __builtin_amdgcn_rcpf(e1 * e2);
          la[e] = (q * e2) * sp[e];
          bx[e] = __builtin_amdgcn_sqrtf(fmaxf(1.f - __expf(2.f * la[e]), 0.f)) * (q * e1) * x[e];
        }
        u32x4 w0, w1;
        w0.x = pack2(la[0], la[1]); w0.y = pack2(la[2], la[3]); w0.z = pack2(la[4], la[5]); w0.w = pack2(la[6], la[7]);
        w1.x = pack2(bx[0], bx[1]); w1.y = pack2(bx[2], bx[3]); w1.z = pack2(bx[4], bx[5]); w1.w = pack2(bx[6], bx[7]);
        *(u32x4*)(gates + (size_t)(2 * dir) * T_ALL * 1024 + ro) = w0;
        *(u32x4*)(gates + (size_t)(2 * dir + 1) * T_ALL * 1024 + ro) = w1;
      }
  }
};
}

template <int KW, bool SILU>
__device__ __forceinline__ void phase_dwconv(const bf16_t* __restrict__ src, int ld_src, bf16_t* __restrict__ dst, int ld_dst, int CH,
                             const float* __restrict__ w, const float* __restrict__ b, bool colmajor, int bid, int nblk, int cxw) {
  const int tidx = opaque_tid(cxw);
  const int cpr = CH / 8;
  const size_t total = (size_t)T_ALL * cpr;
  float wreg[KW][8], breg[8]; int wc0 = -1;
  for (size_t idx = (size_t)bid * NTHR + tidx; idx < total; idx += (size_t)nblk * NTHR) {
    int tok = (int)(idx / cpr), c0 = (int)(idx % cpr) * 8;
    if (c0 != wc0) {
      wc0 = c0;
#pragma unroll
      for (int e = 0; e < 8; ++e) breg[e] = b[c0 + e];
#pragma unroll
      for (int k = 0; k < KW; ++k)
#pragma unroll
        for (int e = 0; e < 8; ++e) wreg[k][e] = w[(size_t)k * CH + c0 + e];
    }
    TokInfo ti = tokinfo(tok);
    bool cm = colmajor && ti.s >= 32;
    int pos = seqpos2off(ti.l, cm);
    float acc[8];
#pragma unroll
    for (int e = 0; e < 8; ++e) acc[e] = breg[e];
#pragma unroll
    for (int k = 0; k < KW; ++k) {
      int pp = pos + k - 1;
      if (pp < 0 || pp >= ti.L) continue;
      int tk = ti.base + seqpos2off(pp, cm);
      u32x4 xv = *(const u32x4*)(src + (size_t)tk * ld_src + c0);
      const float* wk = wreg[k];
      acc[0] += wk[0] * bflo(xv.x); acc[1] += wk[1] * bfhi(xv.x);
      acc[2] += wk[2] * bflo(xv.y); acc[3] += wk[3] * bfhi(xv.y);
      acc[4] += wk[4] * bflo(xv.z); acc[5] += wk[5] * bfhi(xv.z);
      acc[6] += wk[6] * bflo(xv.w); acc[7] += wk[7] * bfhi(xv.w);
    }
    if (SILU) {
#pragma unroll
      for (int e = 0; e < 8; ++e) acc[e] = siluf(acc[e]);
    }
    u32x4 o;
    o.x = pack2(acc[0], acc[1]); o.y = pack2(acc[2], acc[3]); o.z = pack2(acc[4], acc[5]); o.w = pack2(acc[6], acc[7]);
    *(u32x4*)(dst + (size_t)tok * ld_dst + c0) = o;
  }
}

__device__ __forceinline__ void phase_ssd_conv(const Params& p, int slot, bool colmajor, int bid, int nblk, unsigned char* smem, unsigned* wg_bar, int cxw) {
  const int tid = opaque_tid(cxw);
  VB_DECL(wg_bar);
  const bf16_t* raw = (const bf16_t*)(p.scratch + SC_SSD_XBC);
  bf16_t* out = (bf16_t*)(p.scratch + SC_SSD_XBCC);
  bf16_t* XT = (bf16_t*)(p.scratch + SC_SSD_XT);
  bf16_t* BT = (bf16_t*)(p.scratch + SC_SSD_BT);
  bf16_t* BF = (bf16_t*)(p.scratch + SC_SSD_BF);
  bf16_t* CF = (bf16_t*)(p.scratch + SC_SSD_CF);
  const float* cw = p.ssd_conv_w + (size_t)slot * 4 * 4096;
  const float* cb = p.ssd_conv_b + slot * 4096;
  bf16_t* tl = (bf16_t*)smem;
  bf16_t* rt = tl + 64 * 72;
  const int rr = tid >> 2, cpart = tid & 3;
  const int NITEMS = 384 * 64;
  u32x4 pre[2][3];
#define CONV_PREFETCH(SET, ITEM) do { const int it_ = (ITEM); const int ptile_ = it_ >> 6, ct_ = it_ & 63; \
    const TokInfo ti_ = tokinfo(ptile_ * 64); const bool cm_ = colmajor && ti_.s >= 32; \
    _Pragma("unroll") for (int i_ = 0; i_ < 3; ++i_) { const int q_ = tid + i_ * 256; const int row_ = q_ >> 3, c8_ = (q_ & 7) * 8; \
      const int pp_ = ti_.l - 1 + row_; u32x4 v_ = {0u, 0u, 0u, 0u}; \
      if (row_ < 67 && pp_ >= 0 && pp_ < ti_.L) v_ = *(const u32x4*)(raw + (size_t)(ti_.base + seqpos2off(pp_, cm_)) * 4096 + ct_ * 64 + c8_); \
      pre[SET][i_] = v_; } } while (0)
  if (bid < NITEMS) CONV_PREFETCH(0, bid);
  if (bid + nblk < NITEMS) CONV_PREFETCH(1, bid + nblk);
  {
    const int lane_ = tid & 63, w_ = cxw & 3, r_ = lane_ & 31, hh_ = lane_ >> 5, ti_ = w_ >> 1, tj_ = w_ & 1;
    const bf16_t* Wdt = p.wt_ssd_in + (size_t)slot * 6400 * 1024 + (size_t)6144 * 1024;
    float* dto = (float*)(p.scratch + SC_SSD_DT);
    const float dbias = p.ssd_dt_bias[slot * 64 + 32 * tj_ + r_];
    for (int it2 = bid; it2 < T_ALL / 64; it2 += nblk) {
      const bf16_t* ap = p.hbuf + (size_t)(it2 * 64 + 32 * ti_ + r_) * 1024 + 32 * hh_;
      const bf16_t* bp = Wdt + (size_t)(32 * tj_ + r_) * 1024 + 32 * hh_;
      f32x16 dacc;
#pragma unroll
      for (int e = 0; e < 16; ++e) dacc[e] = 0.f;
#pragma nounroll
      for (int q0 = 0; q0 < 16; q0 += 4) {
        bf16x8 a_[16], b_[16];
#pragma unroll
        for (int i = 0; i < 16; ++i) { a_[i] = *(const bf16x8*)(ap + 64 * (q0 + (i >> 2)) + 8 * (i & 3)); b_[i] = *(const bf16x8*)(bp + 64 * (q0 + (i >> 2)) + 8 * (i & 3)); }
        __builtin_amdgcn_sched_barrier(0);
#pragma unroll
        for (int i = 0; i < 16; ++i) dacc = __builtin_amdgcn_mfma_f32_32x32x16_bf16(a_[i], b_[i], dacc, 0, 0, 0);
        __builtin_amdgcn_sched_barrier(0);
      }
#pragma unroll
      for (int e = 0; e < 16; ++e) {
        const int row = (e & 3) + 8 * (e >> 2) + 4 * hh_;
        dto[(size_t)(it2 * 64 + 32 * ti_ + row) * 64 + 32 * tj_ + r_] = softplusf(dacc[e] + dbias);
      }
    }
  }
  float wreg[4][16], wb[16]; int wct = -1;
  for (int item0 = bid; item0 < NITEMS; item0 += 2 * nblk) {
#pragma unroll
   for (int u2 = 0; u2 < 2; ++u2) {
    const int item = item0 + u2 * nblk;
    if (item >= NITEMS) break;
    const int ptile = item >> 6, ct = item & 63;
    const int ptok0 = ptile * 64;
    const int ch = ct * 64 + cpart * 16;
    VB_SYNC();
#pragma unroll
    for (int i = 0; i < 3; ++i) { const int q = tid + i * 256; if (q < 67 * 8) *(u32x4*)(rt + (q >> 3) * 72 + (q & 7) * 8) = pre[u2][i]; }
    if (item + 2 * nblk < NITEMS) CONV_PREFETCH(u2, item + 2 * nblk);
    VB_SYNC();
    if (ct != wct) {
      wct = ct;
#pragma unroll
      for (int e = 0; e < 16; ++e) wb[e] = cb[ch + e];
#pragma unroll
      for (int k = 0; k < 4; ++k)
#pragma unroll
        for (int e = 0; e < 16; ++e) wreg[k][e] = cw[(size_t)k * 4096 + ch + e];
    }
    float acc[16];
#pragma unroll
    for (int e = 0; e < 16; ++e) acc[e] = wb[e];
#pragma unroll
    for (int k = 0; k < 4; ++k) {
      const bf16_t* rp = rt + (rr + k) * 72 + cpart * 16;
      u32x4 x0 = *(const u32x4*)rp, x1 = *(const u32x4*)(rp + 8);
      unsigned xw[8] = {x0.x, x0.y, x0.z, x0.w, x1.x, x1.y, x1.z, x1.w};
#pragma unroll
      for (int e = 0; e < 8; ++e) { acc[2 * e] += wreg[k][2 * e] * bflo(xw[e]); acc[2 * e + 1] += wreg[k][2 * e + 1] * bfhi(xw[e]); }
    }
    u32x4 o0, o1;
    o0.x = pack2(siluf(acc[0]), siluf(acc[1])); o0.y = pack2(siluf(acc[2]), siluf(acc[3]));
    o0.z = pack2(siluf(acc[4]), siluf(acc[5])); o0.w = pack2(siluf(acc[6]), siluf(acc[7]));
    o1.x = pack2(siluf(acc[8]), siluf(acc[9])); o1.y = pack2(siluf(acc[10]), siluf(acc[11]));
    o1.z = pack2(siluf(acc[12]), siluf(acc[13])); o1.w = pack2(siluf(acc[14]), siluf(acc[15]));
    *(u32x4*)(tl + rr * 72 + cpart * 16) = o0;
    *(u32x4*)(tl + rr * 72 + cpart * 16 + 8) = o1;
    VB_SYNC();
    if (ct < 32) {
      const int crow = tid >> 2, part = tid & 3;
      unsigned wv[8];
#pragma unroll
      for (int e = 0; e < 8; ++e) {
        unsigned lo = tl[(part * 16 + 2 * e) * 72 + crow], hi = tl[(part * 16 + 2 * e + 1) * 72 + crow];
        wv[e] = lo | (hi << 16);
      }
      bf16_t* dp = XT + (size_t)(ct * 64 + crow) * T_ALL + ptok0 + part * 16;
      u32x4 t0, t1;
      t0.x = wv[0]; t0.y = wv[1]; t0.z = wv[2]; t0.w = wv[3]; t1.x = wv[4]; t1.y = wv[5]; t1.z = wv[6]; t1.w = wv[7];
      *(u32x4*)dp = t0; *(u32x4*)(dp + 8) = t1;
    } else {
      const bool isB = ct < 48;
      const int cq = (ct - (isB ? 32 : 48));
      const int g = cq >> 1, chhalf = cq & 1;
      const int lane = tid & 63, r = lane & 31, hh = lane >> 5;
      bf16_t* F = isB ? BF : CF;
#pragma unroll
      for (int i = 0; i < 2; ++i) {
        const int f = (cxw & 3) + 4 * i;
        const int rt2 = f >> 2, kk4 = f & 3;
        const u32x4 v = *(const u32x4*)(tl + (32 * rt2 + r) * 72 + 16 * kk4 + 8 * hh);
        const size_t rt = (size_t)(ptok0 >> 5) + rt2;
        *(u32x4*)(F + (((rt * 8 + g) * 8 + chhalf * 4 + kk4) * 64 + lane) * 8) = v;
      }
      if (isB) {
#pragma unroll
        for (int i = 0; i < 2; ++i) {
          const int f = (cxw & 3) + 4 * i;
          const int nt2 = f >> 2, ts4 = f & 3;
          unsigned wv[4];
#pragma unroll
          for (int e = 0; e < 4; ++e) {
            unsigned lo = tl[(16 * ts4 + 8 * hh + 2 * e) * 72 + 32 * nt2 + r], hi = tl[(16 * ts4 + 8 * hh + 2 * e + 1) * 72 + 32 * nt2 + r];
            wv[e] = lo | (hi << 16);
          }
          u32x4 v; v.x = wv[0]; v.y = wv[1]; v.z = wv[2]; v.w = wv[3];
          const size_t ts = (size_t)(ptok0 >> 4) + ts4;
          *(u32x4*)(BT + (((ts * 8 + g) * 4 + chhalf * 2 + nt2) * 64 + lane) * 8) = v;
        }
      }
    }
   }
  }
}

#define SH_STRIDE 136
__device__ __forceinline__ int rowmap(int e, int hh) { return (e & 3) + 8 * (e >> 2) + 4 * hh; }
__device__ __forceinline__ bf16x8 pack8(float a0, float a1, float a2, float a3, float a4, float a5, float a6, float a7) {
  u32x4 v; v.x = pack2(a0, a1); v.y = pack2(a2, a3); v.z = pack2(a4, a5); v.w = pack2(a6, a7);
  return __builtin_bit_cast(bf16x8, v);
}
#define SCAN_PRIV 56576
#define SCAN_SF 49152
__device__ __forceinline__ void phase_ssd_scan(const Params& p, int slot, bool colmajor, int bid, int nblk, unsigned char* wg_smem, int cxw) {
  const int tid = opaque_tid(cxw), lane = tid & 63, w = cxw & 3, vb = cxw >> 2, r = lane & 31, hh = lane >> 5;
  const int it = (w >> 1) ^ vb, pt = w & 1;
  const bf16_t* XT = (const bf16_t*)(p.scratch + SC_SSD_XT);
  const bf16_t* BT = (const bf16_t*)(p.scratch + SC_SSD_BT);
  const bf16_t* BF = (const bf16_t*)(p.scratch + SC_SSD_BF);
  const bf16_t* CF = (const bf16_t*)(p.scratch + SC_SSD_CF);
  const float* dtb = (const float*)(p.scratch + SC_SSD_DT);
  bf16_t* ybuf = (bf16_t*)(p.scratch + SC_SSD_XBC);
  unsigned char* priv = wg_smem + (vb ? SCAN_SF + SCAN_PRIV : 0);
  bf16_t* sXr = (bf16_t*)priv;
  bf16_t* sXs = sXr + 64 * 72;
  bf16_t* sH = sXs + 64 * 72;
  float* sW = (float*)(sH + 64 * SH_STRIDE);
  bf16_t* sY = (bf16_t*)(sW + 4 * 256);
  bf16_t* sXd = sY + 64 * 64;
  float* sDt = (float*)(sXd + 64 * 64);
  float* myW = sW + w * 256;
  const bf16_t* sfC = (const bf16_t*)(wg_smem + SCAN_PRIV);
  const bf16_t* sfB = sfC + 8192;
  const bf16_t* sfT = sfC + 16384;
  const bool bal = (nblk == 512);
  const int nit = bal ? ((bid >> 1) < 128 ? 1 : 8) : 0;
  for (int k = 0, item = bid; bal ? k < nit : item < 36 * 64; ++k, item += bal ? 256 : nblk) {
    int s, h, dir;
    if (bal && item < 256) {
      const int wgp = item >> 1, x = wgp & 7, j = wgp >> 3, hsel = j & 1, rest = (j >> 1) * 8 + x;
      s = 32 + (rest >> 4); dir = rest & 1;
      h = (((rest >> 1) & 7) * 2 + hsel) * 2 + (item & 1);
    } else {
      const int itx = item < 256 ? item : item - 256;
      const int idx = itx & 63, pairidx = idx >> 1;
      s = item < 256 ? 32 + (itx >> 6) : (itx >> 6);
      dir = pairidx & 1; h = (pairidx >> 1) * 2 + (idx & 1);
    }
    const int L = s < 32 ? 256 : 4096;
    const int base = s < 32 ? s * 256 : T_CTX + (s - 32) * 4096;
    const bool cm = colmajor && s >= 32;
    const int g = h >> 2;
    const float Aval = -expf(p.ssd_a_log[(slot * 2 + dir) * 32 + h]);
    const float dskip = p.ssd_d[slot * 32 + h];
    const int nchunks = L >> 6;
    const int pcol = 32 * pt + r;
    f32x16 hacc[2];
    if (s >= 32) {
      const float* h0 = p.state_ssd + ((((size_t)(s - 32) * 2 + slot) * 2 + dir) * 32 + h) * 8192 + (size_t)pcol * 128;
#pragma unroll
      for (int t2 = 0; t2 < 2; ++t2)
#pragma unroll
        for (int qd = 0; qd < 4; ++qd) {
          f32x4 v = *(const f32x4*)(h0 + 32 * (2 * it + t2) + 8 * qd + 4 * hh);
          hacc[t2][4 * qd] = v.x; hacc[t2][4 * qd + 1] = v.y; hacc[t2][4 * qd + 2] = v.z; hacc[t2][4 * qd + 3] = v.w;
        }
    } else {
#pragma unroll
      for (int t2 = 0; t2 < 2; ++t2)
#pragma unroll
        for (int e = 0; e < 16; ++e) hacc[t2][e] = 0.f;
    }
#define SCAN_PTOK(c) (base + 64 * (dir ? nchunks - 1 - (c) : (c)))
#define SCAN_DMA_DTX(pt0) do { \
      _Pragma("unroll") for (int i_ = 0; i_ < 2; ++i_) { \
        const bf16_t* src_ = XT + (size_t)(h * 64 + 16 * w + 8 * i_ + (lane >> 3)) * T_ALL + (pt0) + (lane & 7) * 8; \
        __builtin_amdgcn_global_load_lds((const unsigned*)src_, (PG8_LAS unsigned*)((unsigned char*)sXd + (16 * w + 8 * i_) * 128), 16, 0, 0); } \
      { const int tok_ = base + seqpos2off((pt0) - base + lane, cm); \
        const float* dsrc_ = dtb + (size_t)tok_ * 64 + dir * 32 + h; \
        __builtin_amdgcn_global_load_lds((const unsigned*)dsrc_, (PG8_LAS unsigned*)sDt, 4, 0, 0); } } while (0)
#define SCAN_DMA(pt0) do { \
      _Pragma("unroll") for (int i_ = 0; i_ < 6; ++i_) { const int q_ = cxw + 8 * (i_ & 1); \
        const bf16_t* src_; \
        if (i_ < 4) src_ = (i_ < 2 ? CF : BF) + ((((size_t)((pt0) >> 5) + (q_ >> 3)) * 8 + g) * 8 + (q_ & 7)) * 512 + lane * 8; \
        else src_ = BT + ((((size_t)((pt0) >> 4) + (q_ >> 2)) * 8 + g) * 4 + (q_ & 3)) * 512 + lane * 8; \
        __builtin_amdgcn_global_load_lds((const unsigned*)src_, (PG8_LAS unsigned*)(wg_smem + SCAN_PRIV + (i_ >> 1) * 16384 + q_ * 1024), 16, 0, 0); } } while (0)
#define SCAN_WRITE_STATE() do { \
      _Pragma("unroll") for (int t2 = 0; t2 < 2; ++t2) _Pragma("unroll") for (int qd = 0; qd < 4; ++qd) { \
        u32x2 o_; o_.x = pack2(hacc[t2][4 * qd], hacc[t2][4 * qd + 1]); o_.y = pack2(hacc[t2][4 * qd + 2], hacc[t2][4 * qd + 3]); \
        *(u32x2*)(sH + pcol * SH_STRIDE + 32 * (2 * it + t2) + 8 * qd + 4 * hh) = o_; } } while (0)
    const bool need0 = dir == 0 ? true : (it == 0);
    const bool need1 = dir == 0 ? (it == 1) : true;
    __syncthreads();
    {
      const int p0 = SCAN_PTOK(0);
      SCAN_DMA_DTX(p0);
      SCAN_DMA(p0);
      SCAN_WRITE_STATE();
    }
#define SCAN_BAR_A() do { asm volatile("s_waitcnt vmcnt(6) lgkmcnt(0)" ::: "memory"); __builtin_amdgcn_s_barrier(); asm volatile("" ::: "memory"); } while (0)
#define SCAN_BAR_LDS() do { asm volatile("s_waitcnt lgkmcnt(0)" ::: "memory"); __builtin_amdgcn_s_barrier(); asm volatile("" ::: "memory"); } while (0)
#define SCAN_BAR_MEM() do { asm volatile("s_waitcnt vmcnt(0) lgkmcnt(0)" ::: "memory"); __builtin_amdgcn_s_barrier(); asm volatile("" ::: "memory"); } while (0)
    for (int ci = 0; ci < nchunks; ++ci) {
      const int cin = ci + 1 < nchunks ? ci + 1 : ci;
      const int ptokN = SCAN_PTOK(cin);
      SCAN_BAR_A();
      float decE, gfac;
      {
        const float dtv = sDt[lane];
        const float a_ = dtv * Aval;
        const float pre = wave_incl_scan(a_);
        const float cE = __int_as_float(__builtin_amdgcn_readlane(__float_as_int(pre), 63));
        const float c = dir == 0 ? pre : cE - pre + a_;
        myW[lane] = dtv; myW[64 + lane] = c; myW[128 + lane] = __expf(c); myW[192 + lane] = dtv * __expf(cE - c);
        decE = __expf(cE);
        const float cref = __int_as_float(__builtin_amdgcn_readlane(__float_as_int(c), dir == 0 ? 31 : 32));
        const bool is_col = dir == 0 ? (lane < 32) : (lane >= 32);
        gfac = is_col ? dtv * __expf(cref - c) : __expf(c - cref);
      }
#pragma unroll
      for (int i = 0; i < 2; ++i) {
        const int q = tid + i * 256, prow = q >> 3, j8 = (q & 7) * 8;
        const u32x4 raw = *(const u32x4*)(sXd + prow * 64 + j8);
        *(u32x4*)(sXr + prow * 72 + j8) = raw;
        f32x4 f0 = *(const f32x4*)(myW + 192 + j8), f1 = *(const f32x4*)(myW + 192 + j8 + 4);
        u32x4 sc;
        sc.x = pack2(bflo(raw.x) * f0.x, bfhi(raw.x) * f0.y); sc.y = pack2(bflo(raw.y) * f0.z, bfhi(raw.y) * f0.w);
        sc.z = pack2(bflo(raw.z) * f1.x, bfhi(raw.z) * f1.y); sc.w = pack2(bflo(raw.w) * f1.z, bfhi(raw.w) * f1.w);
        *(u32x4*)(sXs + prow * 72 + j8) = sc;
      }
      SCAN_BAR_MEM();
      myW[192 + lane] = gfac;
      if (ci > 0) {
        const int ptokP = SCAN_PTOK(ci - 1);
#pragma unroll
        for (int i = 0; i < 2; ++i) {
          const int q = tid + i * 256, yrow = q >> 3, c8 = (q & 7) * 8;
          *(u32x4*)(ybuf + ((size_t)dir * T_ALL + ptokP + yrow) * 2048 + h * 64 + c8) = *(const u32x4*)(sY + yrow * 64 + c8);
        }
      }
      SCAN_DMA_DTX(ptokN);
      bf16x8 cfr[8];
#pragma unroll
      for (int kk = 0; kk < 8; ++kk) cfr[kk] = *(const bf16x8*)(sfC + (it * 8 + kk) * 512 + lane * 8);
      const bool needo = dir == 0 ? (it == 1) : (it == 0);
      const int jo = 1 - it;
      f32x16 Xd, Xo;
#pragma unroll
      for (int e = 0; e < 16; ++e) { Xd[e] = 0.f; Xo[e] = 0.f; }
#pragma unroll
      for (int kk = 0; kk < 8; ++kk) Xd = __builtin_amdgcn_mfma_f32_32x32x16_bf16(*(const bf16x8*)(sfB + (it * 8 + kk) * 512 + lane * 8), cfr[kk], Xd, 0, 0, 0);
      if (needo) {
#pragma unroll
        for (int kk = 0; kk < 8; ++kk) Xo = __builtin_amdgcn_mfma_f32_32x32x16_bf16(*(const bf16x8*)(sfB + (jo * 8 + kk) * 512 + lane * 8), cfr[kk], Xo, 0, 0, 0);
      }
      const int icol = 32 * it + r;
      const float ci_ = myW[64 + icol];
#pragma unroll
      for (int t2 = 0; t2 < 2; ++t2) {
#pragma unroll
        for (int e = 0; e < 16; ++e) hacc[t2][e] *= decE;
        const bf16_t* xs = sXs + pcol * 72 + 8 * hh;
#pragma unroll
        for (int kk = 0; kk < 4; ++kk)
          hacc[t2] = __builtin_amdgcn_mfma_f32_32x32x16_bf16(*(const bf16x8*)(sfT + (kk * 4 + 2 * it + t2) * 512 + lane * 8), *(const bf16x8*)(xs + 16 * kk), hacc[t2], 0, 0, 0);
      }
      f32x16 acc;
#pragma unroll
      for (int e = 0; e < 16; ++e) acc[e] = 0.f;
      {
        const bf16_t* hp = sH + pcol * SH_STRIDE + 8 * hh;
#pragma unroll
        for (int kk = 0; kk < 8; ++kk) acc = __builtin_amdgcn_mfma_f32_32x32x16_bf16(cfr[kk], *(const bf16x8*)(hp + 16 * kk), acc, 0, 0, 0);
      }
#pragma unroll
      for (int qd = 0; qd < 4; ++qd) {
        const int j0 = 32 * it + 8 * qd + 4 * hh;
        f32x4 cj = *(const f32x4*)(myW + 64 + j0), dj = *(const f32x4*)(myW + j0);
        float cjv[4] = {cj.x, cj.y, cj.z, cj.w}, djv[4] = {dj.x, dj.y, dj.z, dj.w};
#pragma unroll
        for (int u = 0; u < 4; ++u) {
          const int j = j0 + u;
          const bool ok = dir == 0 ? (j <= icol) : (j >= icol);
          const float m = __expf(ci_ - cjv[u]) * djv[u];
          Xd[4 * qd + u] = ok ? Xd[4 * qd + u] * m : 0.f;
        }
      }
      bf16x8 afd[2], afo[2];
#pragma unroll
      for (int sk = 0; sk < 2; ++sk)
        afd[sk] = pack8(Xd[8 * sk], Xd[8 * sk + 1], Xd[8 * sk + 2], Xd[8 * sk + 3], Xd[8 * sk + 4], Xd[8 * sk + 5], Xd[8 * sk + 6], Xd[8 * sk + 7]);
      if (needo) {
        const float rowf = myW[192 + icol];
#pragma unroll
        for (int qd = 0; qd < 4; ++qd) {
          const f32x4 cf = *(const f32x4*)(myW + 192 + 32 * jo + 8 * qd + 4 * hh);
          Xo[4 * qd] *= cf.x * rowf; Xo[4 * qd + 1] *= cf.y * rowf; Xo[4 * qd + 2] *= cf.z * rowf; Xo[4 * qd + 3] *= cf.w * rowf;
        }
      }
#pragma unroll
      for (int sk = 0; sk < 2; ++sk)
        afo[sk] = pack8(Xo[8 * sk], Xo[8 * sk + 1], Xo[8 * sk + 2], Xo[8 * sk + 3], Xo[8 * sk + 4], Xo[8 * sk + 5], Xo[8 * sk + 6], Xo[8 * sk + 7]);
      SCAN_BAR_LDS();
      SCAN_DMA(ptokN);
      SCAN_WRITE_STATE();
#pragma unroll
      for (int qd = 0; qd < 4; ++qd) {
        f32x4 ec = *(const f32x4*)(myW + 128 + 32 * it + 8 * qd + 4 * hh);
        acc[4 * qd] *= ec.x; acc[4 * qd + 1] *= ec.y; acc[4 * qd + 2] *= ec.z; acc[4 * qd + 3] *= ec.w;
      }
#pragma unroll
      for (int sk = 0; sk < 2; ++sk) {
        const bf16_t* xp = sXr + pcol * 72 + 32 * it + 16 * sk + 4 * hh;
        u32x2 lo = *(const u32x2*)xp, hi = *(const u32x2*)(xp + 8);
        u32x4 xv; xv.x = lo.x; xv.y = lo.y; xv.z = hi.x; xv.w = hi.y;
        acc = __builtin_amdgcn_mfma_f32_32x32x16_bf16(afd[sk], __builtin_bit_cast(bf16x8, xv), acc, 0, 0, 0);
      }
      if (needo) {
#pragma unroll
        for (int sk = 0; sk < 2; ++sk) {
          const bf16_t* xp = sXr + pcol * 72 + 32 * jo + 16 * sk + 4 * hh;
          u32x2 lo = *(const u32x2*)xp, hi = *(const u32x2*)(xp + 8);
          u32x4 xv; xv.x = lo.x; xv.y = lo.y; xv.z = hi.x; xv.w = hi.y;
          acc = __builtin_amdgcn_mfma_f32_32x32x16_bf16(afo[sk], __builtin_bit_cast(bf16x8, xv), acc, 0, 0, 0);
        }
      }
      if (dir == 0) {
#pragma unroll
        for (int qd = 0; qd < 4; ++qd) {
          const u32x2 xw = *(const u32x2*)(sXr + pcol * 72 + 32 * it + 8 * qd + 4 * hh);
          acc[4 * qd] += dskip * bflo(xw.x); acc[4 * qd + 1] += dskip * bfhi(xw.x);
          acc[4 * qd + 2] += dskip * bflo(xw.y); acc[4 * qd + 3] += dskip * bfhi(xw.y);
        }
      }
      {
        bf16_t* yo = sY + (32 * it) * 64 + pcol;
#pragma unroll
        for (int e = 0; e < 16; ++e) yo[rowmap(e, hh) * 64] = f2bf(acc[e]);
      }
    }
    __syncthreads();
    {
      const int ptokP = SCAN_PTOK(nchunks - 1);
#pragma unroll
      for (int i = 0; i < 2; ++i) {
        const int q = tid + i * 256, yrow = q >> 3, c8 = (q & 7) * 8;
        *(u32x4*)(ybuf + ((size_t)dir * T_ALL + ptokP + yrow) * 2048 + h * 64 + c8) = *(const u32x4*)(sY + yrow * 64 + c8);
      }
    }
#undef SCAN_PTOK
#undef SCAN_DMA_DTX
#undef SCAN_DMA
#undef SCAN_WRITE_STATE
    if (s < 32) {
      float* ho = p.out_ssd + ((((size_t)s * 2 + slot) * 2 + dir) * 32 + h) * 8192 + (size_t)pcol * 128;
#pragma unroll
      for (int t2 = 0; t2 < 2; ++t2)
#pragma unroll
        for (int qd = 0; qd < 4; ++qd) {
          f32x4 v; v.x = hacc[t2][4 * qd]; v.y = hacc[t2][4 * qd + 1]; v.z = hacc[t2][4 * qd + 2]; v.w = hacc[t2][4 * qd + 3];
          *(f32x4*)(ho + 32 * (2 * it + t2) + 8 * qd + 4 * hh) = v;
        }
    }
    asm volatile("s_waitcnt vmcnt(0)" ::: "memory");
  }
}

__device__ __forceinline__ void phase_ssd_gate(const Params& p, int slot, int bid, int nblk, int cxw, int row0, int row1) {
  const int tidx = opaque_tid(cxw);
  bf16_t* zb = (bf16_t*)(p.scratch + SC_SSD_Z);
  const bf16_t* yfb = (const bf16_t*)(p.scratch + SC_SSD_XBC);
  const bf16_t* ybb = yfb + (size_t)T_ALL * 2048;
  const bf16_t* xbcc = (const bf16_t*)(p.scratch + SC_SSD_XBCC);
  int lane = tidx & 63, wv = cxw & 3;
  for (int row = row0 + bid * 4 + wv; row < row1; row += nblk * 4) {
    float ss = 0.f;
    TokInfo ti = tokinfo(row);
    const int prow = ti.base + seqpos2off(ti.l, slot == 1 && ti.s >= 32);
#pragma unroll
    for (int j = 0; j < 4; ++j) {
      int c0 = j * 512 + lane * 8;
      u32x4 zv = *(const u32x4*)(zb + (size_t)row * 2048 + c0);
      u32x4 fv = *(const u32x4*)(yfb + (size_t)prow * 2048 + c0);
      u32x4 bv = *(const u32x4*)(ybb + (size_t)prow * 2048 + c0);
      unsigned zw[4] = {zv.x, zv.y, zv.z, zv.w}, fw[4] = {fv.x, fv.y, fv.z, fv.w}, bw[4] = {bv.x, bv.y, bv.z, bv.w};
      unsigned ow[4];
#pragma unroll
      for (int e = 0; e < 4; ++e) {
        float y0 = (bflo(fw[e]) + bflo(bw[e])) * siluf(bflo(zw[e]));
        float y1 = (bfhi(fw[e]) + bfhi(bw[e])) * siluf(bfhi(zw[e]));
        ss += y0 * y0 + y1 * y1;
        ow[e] = pack2(y0, y1);
      }
      u32x4 o; o.x = ow[0]; o.y = ow[1]; o.z = ow[2]; o.w = ow[3];
      *(u32x4*)(zb + (size_t)row * 2048 + c0) = o;
    }
    ss = wave_sum(ss);
    if (lane == 0) p.rstd[row] = rsqrtf(ss * (1.f / 2048.f) + 1e-5f);
  }
}

#define HY_UOFF (32768 + 64)
template <int UNR>
__device__ __forceinline__ void hy_stage_conv(const Params& p, const bf16_t* __restrict__ row, int ch, bf16_t* dst, int dstStride, int dstPad,
                                              int nelem, int L, int tid) {
  const float w0 = p.hy_conv_w[ch], w1 = p.hy_conv_w[3072 + ch], w2 = p.hy_conv_w[2 * 3072 + ch], bb = p.hy_conv_b[ch];
  for (int q0 = tid; q0 < nelem / 8; q0 += UNR * NTHR) {
    u32x4 raw[UNR]; unsigned short hl[UNR], hr[UNR];
#pragma unroll
    for (int j = 0; j < UNR; ++j) {
      const int e0 = (q0 + j * NTHR) * 8, t0 = e0 & (L - 1);
      raw[j] = *(const u32x4*)(row + e0);
      hl[j] = t0 > 0 ? *(const unsigned short*)(row + e0 - 1) : (unsigned short)0;
      hr[j] = t0 + 8 < L ? *(const unsigned short*)(row + e0 + 8) : (unsigned short)0;
    }
#pragma unroll
    for (int j = 0; j < UNR; ++j) {
      const int e0 = (q0 + j * NTHR) * 8, b = e0 / L, t0 = e0 & (L - 1);
      float x[10];
      x[0] = __uint_as_float((unsigned)hl[j] << 16);
      x[9] = __uint_as_float((unsigned)hr[j] << 16);
      x[1] = bflo(raw[j].x); x[2] = bfhi(raw[j].x); x[3] = bflo(raw[j].y); x[4] = bfhi(raw[j].y);
      x[5] = bflo(raw[j].z); x[6] = bfhi(raw[j].z); x[7] = bflo(raw[j].w); x[8] = bfhi(raw[j].w);
      float o[8];
#pragma unroll
      for (int jj = 0; jj < 8; ++jj) o[jj] = w0 * x[jj] + w1 * x[jj + 1] + w2 * x[jj + 2] + bb;
      u32x4 ov; ov.x = pack2(o[0], o[1]); ov.y = pack2(o[2], o[3]); ov.z = pack2(o[4], o[5]); ov.w = pack2(o[6], o[7]);
      *(u32x4*)(dst + b * dstStride + dstPad + t0) = ov;
    }
  }
}

__device__ __forceinline__ void phase_hy_longconv(const Params& p, int bid, int nblk, unsigned char* smem, unsigned* wg_bar, int cxw) {
  const int tid = opaque_tid(cxw), lane = tid & 63, w = cxw & 3  , r = lane & 31, hh = lane >> 5;
  const bf16_t* projT = (const bf16_t*)(p.scratch + SC_HY_PROJT);
  bf16_t* yT = (bf16_t*)(p.scratch + SC_HY_YT);
  unsigned* Rc0 = (unsigned*)smem;
  unsigned* Rc1 = Rc0 + 4096 + 16;
  bf16_t* G = (bf16_t*)smem;
  bf16_t* U = (bf16_t*)(smem + HY_UOFF);
  VB_DECL(wg_bar);
  const int nitems = (2048 - bid + nblk - 1) / nblk;
  for (int k = 0; k < nitems; ++k) {
    const int item = bid + nblk * ((cxw >> 2) ? nitems - 1 - k : k);
    const bool lat = item < 1024;
    const int c = item & 1023;
    const int L = lat ? 4096 : 256, NB = lat ? 4 : 32, RL = lat ? 8192 : 512, Lm1 = L - 1;
    const int PAD = lat ? 224 : 0, US = lat ? 4552 : 264;
    const int tokbase = lat ? T_CTX : 0;
    const int nI = L >> 5, nelem = NB * L;
    const int TPW = lat ? 4 : 2;
    VB_SYNC();
    if (lat) {
      for (int q = tid; q < 4 * 57; q += NTHR) {
        int b = q / 57, k = q % 57;
        int off = k < 28 ? k * 8 : 224 + 4096 + (k - 28) * 8;
        unsigned zz = 0u; asm volatile("" : "+v"(zz));
        u32x4 z4 = {zz, zz, zz, zz};
        *(u32x4*)(U + b * US + off) = z4;
      }
    }
    hy_stage_conv<4>(p, projT + (size_t)c * T_ALL + tokbase, c, U, US, PAD, nelem, L, tid);
    int Icol[4], bcol[4];
#pragma unroll
    for (int tt = 0; tt < 4; ++tt) {
      int n = (w * TPW + tt) * 32 + r;
      Icol[tt] = lat ? (n >> 2) : (n >> 5);
      bcol[tt] = lat ? (n & 3) : (n & 31);
    }
    const int Ilo_w = lat ? 32 * w : 2 * w, Ihi_w = lat ? 32 * w + 31 : 2 * w + 1;
    const int dlo = Ilo_w - (nI - 1), dhi = Ihi_w;
    float invs[2], biases[2];
#pragma unroll
    for (int o2 = 0; o2 < 2; ++o2) { invs[o2] = p.knorm[((lat ? 1 : 0) * 2 + o2) * 1024 + c]; biases[o2] = p.hy_f_bias[o2 * 1024 + c]; }
    for (int order = 0; order < 2; ++order) {
      {
        const bf16_t* src = (lat ? p.rtab1 : p.rtab0) + (size_t)(order * 1024 + c) * RL;
        for (int q = tid; q < RL / 8; q += NTHR) {
          u32x4 cv = *(const u32x4*)(src + q * 8);
          unsigned nx = (q + 1 < RL / 8) ? *(const unsigned*)(src + q * 8 + 8) : 0u;
          *(u32x4*)(Rc0 + q * 4) = cv;
          u32x4 sv;
          sv.x = (cv.x >> 16) | (cv.y << 16); sv.y = (cv.y >> 16) | (cv.z << 16);
          sv.z = (cv.z >> 16) | (cv.w << 16); sv.w = (cv.w >> 16) | (nx << 16);
          *(u32x4*)(Rc1 + q * 4) = sv;
        }
      }
      VB_SYNC();
      u32x2 zpre[4][4];
      if (order == 1) {
#pragma unroll
        for (int tt = 0; tt < 4; ++tt)
          if (tt < TPW) {
#pragma unroll
            for (int qd = 0; qd < 4; ++qd)
              zpre[tt][qd] = *(const u32x2*)(projT + (size_t)(3072 + c) * T_ALL + tokbase + bcol[tt] * L + 32 * Icol[tt] + 8 * qd + 4 * hh);
          }
      }
      f32x16 acc[4];
#pragma unroll
      for (int tt = 0; tt < 4; ++tt)
#pragma unroll
        for (int e = 0; e < 16; ++e) acc[tt][e] = 0.f;
      {
        int lo_t[4], hi_t[4];
        const bf16_t* ub[4];
#pragma unroll
        for (int tt = 0; tt < 4; ++tt) {
          const int tile = w * TPW + tt;
          const int Ilo_t = lat ? 8 * tile : tile, Ihi_t = lat ? 8 * tile + 7 : tile;
          lo_t[tt] = tt < TPW ? Ilo_t - (nI - 1) : 1 << 30; hi_t[tt] = tt < TPW ? Ihi_t : -(1 << 30);
          ub[tt] = U + bcol[tt] * US + PAD + 32 * Icol[tt] + 8 * hh;
        }
        const int ybase = Lm1 - r + 8 * hh;
#define LC_LOAD(T0, T1, DD0, IT, A, B) do { const int it_ = (IT); const int d_ = (DD0) + (it_ >> 1), kk_ = it_ & 1; \
          const int y0_ = ybase - 32 * d_ + 16 * kk_; const int par_ = y0_ & 1; \
          const unsigned* rp_ = (par_ ? Rc1 : Rc0) + ((y0_ - par_) >> 1); \
          u32x4 av_; av_.x = rp_[0]; av_.y = rp_[1]; av_.z = rp_[2]; av_.w = rp_[3]; A = __builtin_bit_cast(bf16x8, av_); \
          _Pragma("unroll") for (int tt = 0; tt < 4; ++tt) if (tt >= (T0) && tt < (T1)) B[tt] = *(const bf16x8*)(ub[tt] - 32 * d_ + 16 * kk_); } while (0)
#define LC_MMA(T0, T1, A, B) do { _Pragma("unroll") for (int tt = 0; tt < 4; ++tt) if (tt >= (T0) && tt < (T1)) \
          acc[tt] = __builtin_amdgcn_mfma_f32_32x32x16_bf16(A, B[tt], acc[tt], 0, 0, 0); } while (0)
#define LC_SEG(T0, T1, DD0, DD1) do { const int sd0_ = (DD0), sd1_ = (DD1); \
          if (sd1_ >= sd0_) { const int NIT_ = 2 * (sd1_ - sd0_ + 1); \
            bf16x8 a0, a1, b0[4], b1[4]; \
            LC_LOAD(T0, T1, sd0_, 0, a0, b0); \
            for (int it = 0; it < NIT_; it += 2) { \
              LC_LOAD(T0, T1, sd0_, it + 1, a1, b1); \
              __builtin_amdgcn_sched_barrier(0); \
              LC_MMA(T0, T1, a0, b0); \
              __builtin_amdgcn_sched_barrier(0); \
              LC_LOAD(T0, T1, sd0_, it + 2 < NIT_ ? it + 2 : NIT_ - 1, a0, b0); \
              __builtin_amdgcn_sched_barrier(0); \
              LC_MMA(T0, T1, a1, b1); \
              __builtin_amdgcn_sched_barrier(0); \
            } } } while (0)
        if (!lat) {
          LC_SEG(0, 1, lo_t[0], lo_t[1] - 1);
          LC_SEG(0, 2, lo_t[1], hi_t[0]);
          LC_SEG(1, 2, hi_t[0] + 1, hi_t[1]);
        } else {
          LC_SEG(0, 1, lo_t[0], lo_t[1] - 1);
          LC_SEG(0, 2, lo_t[1], lo_t[2] - 1);
          LC_SEG(0, 3, lo_t[2], lo_t[3] - 1);
          LC_SEG(0, 4, lo_t[3], hi_t[0]);
          LC_SEG(1, 4, hi_t[0] + 1, hi_t[1]);
          LC_SEG(2, 4, hi_t[1] + 1, hi_t[2]);
          LC_SEG(3, 4, hi_t[2] + 1, hi_t[3]);
        }
#undef LC_LOAD
#undef LC_MMA
#undef LC_SEG
      }
      VB_SYNC();
      hy_stage_conv<2>(p, projT + (size_t)((1 + order) * 1024 + c) * T_ALL + tokbase, (1 + order) * 1024 + c, G, L, 0, nelem, L, tid);
      VB_SYNC();
      const float inv = __builtin_amdgcn_rcpf(order ? invs[1] : invs[0]);
      const float bias = order ? biases[1] : biases[0];
#pragma unroll
      for (int tt = 0; tt < 4; ++tt) {
        if (tt < TPW) {
#pragma unroll
          for (int qd = 0; qd < 4; ++qd) {
            const int t0 = 32 * Icol[tt] + 8 * qd + 4 * hh;
            bf16_t* up = U + bcol[tt] * US + PAD + t0;
            u32x2 uc = *(const u32x2*)up;
            u32x2 gg = *(const u32x2*)(G + bcol[tt] * L + t0);
            float r0 = (inv * acc[tt][4 * qd] + bias * bflo(uc.x)) * bflo(gg.x);
            float r1 = (inv * acc[tt][4 * qd + 1] + bias * bfhi(uc.x)) * bfhi(gg.x);
            float r2 = (inv * acc[tt][4 * qd + 2] + bias * bflo(uc.y)) * bflo(gg.y);
            float r3 = (inv * acc[tt][4 * qd + 3] + bias * bfhi(uc.y)) * bfhi(gg.y);
            if (order == 1) {
              const u32x2 zz = zpre[tt][qd];
              r0 *= siluf(bflo(zz.x)); r1 *= siluf(bfhi(zz.x)); r2 *= siluf(bflo(zz.y)); r3 *= siluf(bfhi(zz.y));
            }
            u32x2 ov; ov.x = pack2(r0, r1); ov.y = pack2(r2, r3);
            *(u32x2*)up = ov;
          }
        }
      }
      VB_SYNC();
    }
    for (int q = tid; q < nelem / 8; q += NTHR) {
      const int e0 = q * 8, b = e0 / L, t0 = e0 & (L - 1);
      *(u32x4*)(yT + (size_t)c * T_ALL + tokbase + e0) = *(const u32x4*)(U + b * US + PAD + t0);
    }
  }
}

__device__ __forceinline__ void phase_hy_transpose(const Params& p, int bid, int nblk, unsigned char* smem, unsigned* wg_bar, int cxw) {
  const int tid = opaque_tid(cxw);
  const bf16_t* yT = (const bf16_t*)(p.scratch + SC_HY_YT);
  bf16_t* yg = (bf16_t*)(p.scratch + SC_HY_YG);
  bf16_t* tl = (bf16_t*)smem;
  VB_DECL(wg_bar);
  const int NIT = 16 * (T_ALL / 64);
  u32x4 pre[2];
#define HT_PREFETCH(ITEM) do { const int it_ = (ITEM), cb_ = it_ & 15, tb_ = it_ >> 4; \
    _Pragma("unroll") for (int i_ = 0; i_ < 2; ++i_) { const int q_ = tid + i_ * 256, cr_ = q_ >> 3, t8_ = (q_ & 7) * 8; \
      pre[i_] = *(const u32x4*)(yT + (size_t)(cb_ * 64 + cr_) * T_ALL + tb_ * 64 + t8_); } } while (0)
  if (bid < NIT) HT_PREFETCH(bid);
  for (int item = bid; item < NIT; item += nblk) {
    const int cb = item & 15, tb = item >> 4;
    VB_SYNC();
#pragma unroll
    for (int i = 0; i < 2; ++i) {
      int q = tid + i * 256, cr = q >> 3, t8 = (q & 7) * 8;
      const u32x4 v = pre[i];
      unsigned wv[4] = {v.x, v.y, v.z, v.w};
#pragma unroll
      for (int e = 0; e < 4; ++e) {
        tl[(t8 + 2 * e) * 72 + cr] = (bf16_t)(wv[e] & 0xffffu);
        tl[(t8 + 2 * e + 1) * 72 + cr] = (bf16_t)(wv[e] >> 16);
      }
    }
    if (item + nblk < NIT) HT_PREFETCH(item + nblk);
    VB_SYNC();
#pragma unroll
    for (int i = 0; i < 2; ++i) {
      int q = tid + i * 256, tr = q >> 3, c8 = (q & 7) * 8;
      *(u32x4*)(yg + (size_t)(tb * 64 + tr) * 1024 + cb * 64 + c8) = *(const u32x4*)(tl + tr * 72 + c8);
    }
  }
#undef HT_PREFETCH
}

#define LRU_NCH 384
struct Lru4 { float af[4], bxf[4], ab[4], bxb[4]; };
__device__ __forceinline__ void lru_unpack4(u32x2 v, float (&o)[4]) { o[0] = bflo(v.x); o[1] = bfhi(v.x); o[2] = bflo(v.y); o[3] = bfhi(v.y); }
__device__ __forceinline__ void lru_row_f(const bf16_t* gates, size_t o, float (&af)[4], float (&bxf)[4]) {
  float la[4];
  lru_unpack4(*(const u32x2*)(gates + o), la); lru_unpack4(*(const u32x2*)(gates + (size_t)T_ALL * 1024 + o), bxf);
#pragma unroll
  for (int e = 0; e < 4; ++e) af[e] = __expf(la[e]);
}
__device__ __forceinline__ void lru_row_b(const bf16_t* gates, size_t o, float (&ab)[4], float (&bxb)[4]) {
  float la[4];
  lru_unpack4(*(const u32x2*)(gates + (size_t)2 * T_ALL * 1024 + o), la); lru_unpack4(*(const u32x2*)(gates + (size_t)3 * T_ALL * 1024 + o), bxb);
#pragma unroll
  for (int e = 0; e < 4; ++e) ab[e] = __expf(la[e]);
}
__device__ __forceinline__ void phase_lru_scan_agg(const Params& p, int bid, int nblk, unsigned char* smem, int cxw) {
  const int tidx = opaque_tid(cxw);
  const bf16_t* gates = (const bf16_t*)(p.scratch + SC_LRU_GATES);
  const bf16_t* xc = (const bf16_t*)(p.scratch + SC_LRU_XC);
  float* sagg = (float*)smem;
  const int sub = cxw & 3, cq = tidx & 63;
  for (int item = bid; item < LRU_NCH * 4; item += nblk) {
    const int chunk = item >> 2, cb = item & 3;
    const int c0 = cb * 256 + 4 * cq;
    const int tok0 = chunk * 64 + 16 * sub;
    float Af[4] = {1.f, 1.f, 1.f, 1.f}, hf[4] = {0.f, 0.f, 0.f, 0.f}, Pb[4] = {1.f, 1.f, 1.f, 1.f}, Bb[4] = {0.f, 0.f, 0.f, 0.f};
#pragma unroll 8
    for (int j = 0; j < 16; ++j) {
      const size_t o = (size_t)(tok0 + j) * 1024 + c0;
      float af[4], bxf[4], ab[4], bxb[4];
      lru_row_f(gates, o, af, bxf);
      lru_row_b(gates, o, ab, bxb);
#pragma unroll
      for (int e = 0; e < 4; ++e) { hf[e] = af[e] * hf[e] + bxf[e]; Af[e] *= af[e]; Bb[e] += bxb[e] * Pb[e]; Pb[e] *= ab[e]; }
    }
    {
      const size_t sc = (size_t)chunk * 4 + sub;
      float* gf = p.lru_sagg + (((size_t)0 * (LRU_NCH * 4) + sc) * 1024 + c0) * 2;
      float* gb = p.lru_sagg + (((size_t)1 * (LRU_NCH * 4) + sc) * 1024 + c0) * 2;
      f32x4 v0 = {Af[0], hf[0], Af[1], hf[1]}, v1 = {Af[2], hf[2], Af[3], hf[3]};
      f32x4 w0 = {Pb[0], Bb[0], Pb[1], Bb[1]}, w1 = {Pb[2], Bb[2], Pb[3], Bb[3]};
      *(f32x4*)gf = v0; *(f32x4*)(gf + 4) = v1; *(f32x4*)gb = w0; *(f32x4*)(gb + 4) = w1;
      __syncthreads();
      float* sl = sagg + (sub * 64 + cq) * 16;
      *(f32x4*)sl = v0; *(f32x4*)(sl + 4) = v1; *(f32x4*)(sl + 8) = w0; *(f32x4*)(sl + 12) = w1;
      __syncthreads();
    }
    if (sub == 0) {
      float A[4], B[4], P[4], Q[4];
#pragma unroll
      for (int e = 0; e < 4; ++e) { A[e] = 1.f; B[e] = 0.f; P[e] = 1.f; Q[e] = 0.f; }
#pragma unroll
      for (int s2 = 0; s2 < 4; ++s2) {
        const float* lf = sagg + (s2 * 64 + cq) * 16;
        const float* lb = sagg + ((3 - s2) * 64 + cq) * 16 + 8;
#pragma unroll
        for (int e = 0; e < 4; ++e) {
          const float a = lf[2 * e], b = lf[2 * e + 1];
          B[e] = a * B[e] + b; A[e] *= a;
          const float pb = lb[2 * e], qb = lb[2 * e + 1];
          Q[e] = pb * Q[e] + qb; P[e] *= pb;
        }
      }
      float* gf = p.lru_agg + (((size_t)0 * LRU_NCH + chunk) * 1024 + c0) * 2;
      float* gb = p.lru_agg + (((size_t)1 * LRU_NCH + chunk) * 1024 + c0) * 2;
      f32x4 v0 = {A[0], B[0], A[1], B[1]}, v1 = {A[2], B[2], A[3], B[3]}, w0 = {P[0], Q[0], P[1], Q[1]}, w1 = {P[2], Q[2], P[3], Q[3]};
      *(f32x4*)gf = v0; *(f32x4*)(gf + 4) = v1; *(f32x4*)gb = w0; *(f32x4*)(gb + 4) = w1;
    }
  }
}
__device__ __forceinline__ void phase_lru_scan_carry(const Params& p, int bid, int nblk, int cxw) {
  const int tidx = opaque_tid(cxw);
  for (int item = bid; item < 36 * 8; item += nblk) {
    int s = item >> 3, dir = (item >> 2) & 1, cb = item & 3;
    int c = cb * 256 + tidx;
    int nch = s < 32 ? 4 : 64;
    int ch0 = s < 32 ? s * 4 : 128 + (s - 32) * 64;
    float h = s < 32 ? 0.f : p.state_lru[((size_t)(s - 32) * 2 + dir) * 1024 + c];
    for (int k0 = 0; k0 < nch; k0 += 16) {
      f32x2_t ag[16];
#pragma unroll
      for (int u = 0; u < 16; ++u) {
        const int kk = k0 + u < nch ? k0 + u : nch - 1;
        const int chunk = dir ? ch0 + nch - 1 - kk : ch0 + kk;
        ag[u] = *(const f32x2_t*)(p.lru_agg + (((size_t)dir * LRU_NCH + chunk) * 1024 + c) * 2);
      }
#pragma unroll
      for (int u = 0; u < 16; ++u) {
        if (k0 + u < nch) {
          const int chunk = dir ? ch0 + nch - 1 - (k0 + u) : ch0 + k0 + u;
          p.lru_hin[((size_t)dir * LRU_NCH + chunk) * 1024 + c] = h; h = ag[u].x * h + ag[u].y;
        }
      }
    }
    if (s < 32) p.out_lru[((size_t)s * 2 + dir) * 1024 + c] = h;
  }
}
__device__ __forceinline__ void phase_lru_scan_final(const Params& p, int bid, int nblk, unsigned char* smem, int cxw) {
  const int tidx = opaque_tid(cxw);
  const bf16_t* gates = (const bf16_t*)(p.scratch + SC_LRU_GATES);
  const bf16_t* xc = (const bf16_t*)(p.scratch + SC_LRU_XC);
  const bf16_t* proj = (const bf16_t*)(p.scratch + SC_LRU_PROJ);
  bf16_t* yg = (bf16_t*)(p.scratch + SC_LRU_YG);
  const int sub = cxw & 3, cq = tidx & 63;
  for (int item = bid; item < LRU_NCH * 4; item += nblk) {
    const int chunk = item >> 2, cb = item & 3;
    const int c0 = cb * 256 + 4 * cq;
    float hf[4], hb[4];
    {
      const f32x4 a = *(const f32x4*)(p.lru_hin + ((size_t)0 * LRU_NCH + chunk) * 1024 + c0);
      const f32x4 b = *(const f32x4*)(p.lru_hin + ((size_t)1 * LRU_NCH + chunk) * 1024 + c0);
      hf[0] = a.x; hf[1] = a.y; hf[2] = a.z; hf[3] = a.w; hb[0] = b.x; hb[1] = b.y; hb[2] = b.z; hb[3] = b.w;
    }
#pragma unroll
    for (int s2 = 0; s2 < 3; ++s2) {
      if (s2 < sub) {
        const float* g = p.lru_sagg + (((size_t)0 * (LRU_NCH * 4) + (size_t)chunk * 4 + s2) * 1024 + c0) * 2;
        const f32x4 v0 = *(const f32x4*)g, v1 = *(const f32x4*)(g + 4);
        hf[0] = v0.x * hf[0] + v0.y; hf[1] = v0.z * hf[1] + v0.w; hf[2] = v1.x * hf[2] + v1.y; hf[3] = v1.z * hf[3] + v1.w;
      }
      if (3 - s2 > sub) {
        const float* g = p.lru_sagg + (((size_t)1 * (LRU_NCH * 4) + (size_t)chunk * 4 + (3 - s2)) * 1024 + c0) * 2;
        const f32x4 v0 = *(const f32x4*)g, v1 = *(const f32x4*)(g + 4);
        hb[0] = v0.x * hb[0] + v0.y; hb[1] = v0.z * hb[1] + v0.w; hb[2] = v1.x * hb[2] + v1.y; hb[3] = v1.z * hb[3] + v1.w;
      }
    }
    const int tok0 = chunk * 64 + 16 * sub;
    float hfs[16][4];
#pragma unroll
    for (int j = 0; j < 16; ++j) {
      const size_t o = (size_t)(tok0 + j) * 1024 + c0;
      float af[4], bxf[4];
      lru_row_f(gates, o, af, bxf);
#pragma unroll
      for (int e = 0; e < 4; ++e) { hf[e] = af[e] * hf[e] + bxf[e]; hfs[j][e] = hf[e]; }
    }
#pragma unroll
    for (int j = 15; j >= 0; --j) {
      const size_t o = (size_t)(tok0 + j) * 1024 + c0;
      float ab[4], bxb[4], z[4];
      lru_row_b(gates, o, ab, bxb);
      lru_unpack4(*(const u32x2*)(proj + (size_t)(tok0 + j) * 2048 + 1024 + c0), z);
      float y[4];
#pragma unroll
      for (int e = 0; e < 4; ++e) { hb[e] = ab[e] * hb[e] + bxb[e]; y[e] = (hfs[j][e] + hb[e]) * siluf(z[e]); }
      u32x2 ov; ov.x = pack2(y[0], y[1]); ov.y = pack2(y[2], y[3]);
      *(u32x2*)(yg + o) = ov;
    }
  }
}

enum { PH_PREP = 0, PH_MOD, PH_HYA, PH_HYB, PH_LNMOD, PH_INPROJ, PH_MIX1, PH_MIX2, PH_MIX3, PH_MIX4, PH_MIX5, PH_MIX6, PH_OUTPROJ };

struct Ctx { int bid, nblk, wave; unsigned char* smem; unsigned char* wg_smem; };

template <class Epi>
__device__ __forceinline__ void run_gemm(const Ctx& cx, const bf16_t* A, int lda, const bf16_t* Bt, int M, int N, int K, int grp_shift, int grp_bytes, const Epi& e, int split = 0) {
  pg8::Gemm g{A, Bt, M, N, K, lda, grp_shift, grp_bytes};
  pg8::StaticOrder S; S.init(M, N, K, gridDim.x, opaque_s(blockIdx.x), split);
  pg8::gemm_phase((PG8_LAS unsigned char*)cx.wg_smem, g, S, e, cx.wave);
}

#define N_PARAM_WORDS (sizeof(Params) / 8)
__device__ __forceinline__ Params load_params(const unsigned char* lp) {
  Params p;
  unsigned long long* d = (unsigned long long*)&p;
  const unsigned long long* sp = (const unsigned long long*)lp;
#pragma unroll
  for (int i = 0; i < (int)N_PARAM_WORDS; ++i) {
    const unsigned long long v = sp[i];
    const unsigned lo = __builtin_amdgcn_readfirstlane((unsigned)v), hi = __builtin_amdgcn_readfirstlane((unsigned)(v >> 32));
    __attribute__((address_space(1))) char* gp = (__attribute__((address_space(1))) char*)(((unsigned long long)hi << 32) | lo);
    d[i] = (unsigned long long)(char*)gp;
  }
  return p;
}
__device__ __forceinline__ void run_phase(const unsigned char* lparams, int ph, int layer, const Ctx& cx) {
  const Params p = load_params(lparams);
  const int omode = layer >> 8; layer &= 255;
  const int kind = layer % 3, slot = layer / 3;
  const int bid = opaque_s(cx.bid), nblk = cx.nblk;
  unsigned char* smem = cx.smem;
  switch (ph) {
    case PH_PREP: phase_prep(p, bid, nblk, smem, (unsigned*)(cx.wg_smem + WG_SMEM), cx.wave); break;
    case PH_MOD: phase_mod(p, bid, nblk, smem, cx.wave); break;
    case PH_HYA: phase_hyfilt_a(p, bid, nblk, smem, cx.wave); break;
    case PH_HYB: phase_hyfilt_b(p, bid, nblk, smem, (unsigned*)(cx.wg_smem + WG_SMEM), cx.wave); break;
    case PH_LNMOD: phase_lnmod(p, layer, bid, nblk, cx.wave); break;
    case PH_INPROJ:
      if (kind == 0) {
        pg8::EpiSsdIn e{(bf16_t*)(p.scratch + SC_SSD_Z), (bf16_t*)(p.scratch + SC_SSD_XBC), (float*)(p.scratch + SC_SSD_DT), p.ssd_dt_bias + slot * 64};
        run_gemm(cx, p.hbuf, 1024, p.wt_ssd_in + (size_t)slot * 6400 * 1024, T_ALL, 6144, 1024, 30, 0, e);
      } else if (kind == 1) {
        pg8::EpiBf16 e{(bf16_t*)(p.scratch + SC_HY_PROJT), (size_t)T_ALL};
        run_gemm(cx, p.wt_hy_in, 1024, p.hbuf, 4096, T_ALL, 1024, 30, 0, e);
      } else {
        pg8::EpiBf16 e{(bf16_t*)(p.scratch + SC_LRU_PROJ), (size_t)2048};
        run_gemm(cx, p.hbuf, 1024, p.wt_lru_in, T_ALL, 2048, 1024, 30, 0, e);
      }
      break;
    case PH_MIX1:
      if (kind == 0) phase_ssd_conv(p, slot, slot == 1, bid, nblk, smem, (unsigned*)(cx.wg_smem + WG_SMEM), cx.wave);
      else if (kind == 1) phase_hy_longconv(p, bid, nblk, smem, (unsigned*)(cx.wg_smem + WG_SMEM), cx.wave);
      else phase_dwconv<4, false>((const bf16_t*)(p.scratch + SC_LRU_PROJ), 2048, (bf16_t*)(p.scratch + SC_LRU_XC), 1024, 1024,
                                  p.lru_conv_w, p.lru_conv_b, false, bid, nblk, cx.wave);
      break;
    case PH_MIX2:
      if (kind == 0) {
        phase_ssd_scan(p, slot, slot == 1, bid, nblk, cx.wg_smem, cx.wave);
        if (nblk == 512 && bid >= 256) {
          sub_barrier(p.bar + XB_CTXDONE + 16 * slot, 128u, cx.wave);
          phase_ssd_gate(p, slot, bid - 256, 256, cx.wave, 0, T_CTX);
        }
      }
      else if (kind == 1) phase_hy_transpose(p, bid, nblk, smem, (unsigned*)(cx.wg_smem + WG_SMEM), cx.wave);
      else {
        pg8::EpiLruGate e{(bf16_t*)(p.scratch + SC_LRU_GATES), p.lru_gate_b, (const bf16_t*)(p.scratch + SC_LRU_XC), p.lru_a_param};
        run_gemm(cx, (const bf16_t*)(p.scratch + SC_LRU_XC), 1024, p.wt_lru_gate, T_ALL, 4096, 256, 2, 512, e);
      }
      break;
    case PH_MIX3:
      if (kind == 0) phase_ssd_gate(p, slot, bid, nblk, cx.wave, (nblk == 512) ? T_CTX : 0, T_ALL);
      else phase_lru_scan_agg(p, bid, nblk, smem, cx.wave);
      break;
    case PH_MIX4: if (kind == 2) phase_lru_scan_carry(p, bid, nblk, cx.wave); break;
    case PH_MIX5: if (kind == 2) phase_lru_scan_final(p, bid, nblk, smem, cx.wave); break;
    case PH_OUTPROJ: {
      const float* mv = p.modv + (size_t)layer * 5 * 3072;
      if (omode == 2) sub_barrier(p.bar + XB_CTXDONE2 + 16 * slot, 128u, cx.wave);
      if (kind == 0) {
        pg8::EpiOut e{p.resb, mv, p.rstd, p.outp};
        run_gemm(cx, (const bf16_t*)(p.scratch + SC_SSD_Z), 2048, p.wt_ssd_out + (size_t)slot * 1024 * 2048, T_ALL, 1024, 2048, 30, 0, e, omode ? omode : 1);
      } else if (kind == 1) {
        pg8::EpiOut e{p.resb, mv, nullptr, p.outp};
        run_gemm(cx, (const bf16_t*)(p.scratch + SC_HY_YG), 1024, p.wt_hy_out, T_ALL, 1024, 1024, 30, 0, e, 1);
      } else {
        pg8::EpiOut e{p.resb, mv, nullptr, p.outp};
        run_gemm(cx, (const bf16_t*)(p.scratch + SC_LRU_YG), 1024, p.wt_lru_out, T_ALL, 1024, 1024, 30, 0, e, 1);
      }
    } break;
  }
}

__global__ void __launch_bounds__(WG_THREADS, 2) k_mega(Params p) {
  __shared__ __attribute__((aligned(16))) unsigned char smem[WG_SMEM + 16 + 512];
  cg::grid_group grid = cg::this_grid();
  const int wave0 = __builtin_amdgcn_readfirstlane((int)(threadIdx.x >> 6));
  const int vb = wave0 >> 2;
  Ctx cx;
  cx.wave = wave0;
  cx.bid = 2 * blockIdx.x + vb; cx.nblk = 2 * gridDim.x; cx.smem = smem + vb * SMEM_BYTES; cx.wg_smem = smem;
  volatile LAS unsigned* xst = (volatile LAS unsigned*)(smem + WG_SMEM);
  unsigned char* lparams = smem + WG_SMEM + 16;
  if (threadIdx.x == 0) { xst[0] = 0u; xst[1] = 0u; *(Params*)lparams = p; }
  __syncthreads();
  const XcdBarrier xb = xcd_barrier_post(p.bar, lparams, (unsigned)offsetof(Params, bar), xst);
  run_phase(lparams, PH_PREP, 0, cx);
  run_phase(lparams, PH_MOD, 0, cx);
  run_phase(lparams, PH_HYA, 0, cx);
  if (p.bar == nullptr) grid.sync();
  xcd_barrier(xb, cx.wave);
  run_phase(lparams, PH_HYB, 0, cx);
  for (int layer = 0; layer < 4; ++layer) {
    const int kind = layer % 3;
    run_phase(lparams, PH_LNMOD, layer, cx);
    xcd_barrier(xb, cx.wave);
    run_phase(lparams, PH_INPROJ, layer, cx);
    xcd_barrier(xb, cx.wave);
    run_phase(lparams, PH_MIX1, layer, cx);
    xcd_barrier(xb, cx.wave);
    const bool ctxo = (kind == 0) && (cx.nblk == 512);
#pragma nounroll
    for (int pass = 0; pass < 2; ++pass) {
      int omode;
      if (pass == 0) {
        run_phase(lparams, PH_MIX2, layer, cx);
        omode = (ctxo && opaque_s(cx.bid) >= 256) ? 2 : -1;
      } else {
        xcd_barrier(xb, cx.wave);
        if (kind != 1) {
          run_phase(lparams, PH_MIX3, layer, cx);
          xcd_barrier(xb, cx.wave);
        }
        if (kind == 2) {
          run_phase(lparams, PH_MIX4, layer, cx);
          xcd_barrier(xb, cx.wave);
          run_phase(lparams, PH_MIX5, layer, cx);
          xcd_barrier(xb, cx.wave);
        }
        omode = ctxo ? 3 : 0;
      }
      if (omode >= 0) run_phase(lparams, PH_OUTPROJ, layer | (omode << 8), cx);
    }
    xcd_barrier(xb, cx.wave);
  }
  run_phase(lparams, PH_LNMOD, 4, cx);
}

static inline size_t align_up(size_t x) { return (x + 255) & ~(size_t)255; }

extern "C" void kernel_launch(void* const* d_in, const int* in_sizes, int n_in, void* d_out, int out_size, void* d_ws, size_t ws_size,
                              hipStream_t stream) {
  Params p{};
  const float** fp = (const float**)&p;
  for (int i = 0; i < 36; ++i) fp[i] = (const float*)d_in[i];
  float* out = (float*)d_out;
  p.xres = out;
  p.out_ssd = out + (size_t)T_ALL * 1024;
  p.out_lru = p.out_ssd + (size_t)32 * 2 * 2 * 32 * 64 * 128;
  unsigned char* w = (unsigned char*)d_ws;
  size_t off = 0;
  auto carve = [&](size_t bytes) { unsigned char* r = w + off; off = align_up(off + bytes); return r; };
  p.wt_ssd_in = (bf16_t*)carve((size_t)2 * 6400 * 1024 * 2);
  p.wt_ssd_out = (bf16_t*)carve((size_t)2 * 1024 * 2048 * 2);
  p.wt_hy_in = (bf16_t*)carve((size_t)4096 * 1024 * 2);
  p.wt_hy_out = (bf16_t*)carve((size_t)1024 * 1024 * 2);
  p.wt_lru_in = (bf16_t*)carve((size_t)2048 * 1024 * 2);
  p.wt_lru_out = (bf16_t*)carve((size_t)1024 * 1024 * 2);
  p.wt_lru_gate = (bf16_t*)carve((size_t)4 * 1024 * 256 * 2);
  p.modv = (float*)carve((size_t)4 * 5 * 3072 * 4);
  p.hdn2 = (float*)carve((size_t)4352 * 64 * 4);
  p.rtab0 = (bf16_t*)carve((size_t)2 * 1024 * 512 * 2);
  p.rtab1 = (bf16_t*)carve((size_t)2 * 1024 * 8192 * 2);
  p.knorm = (float*)carve((size_t)4 * 1024 * 4);
  p.hbuf = (bf16_t*)carve((size_t)T_ALL * 1024 * 2);
  p.rstd = (float*)carve((size_t)T_ALL * 4);
  p.resb = (bf16_t*)carve((size_t)T_ALL * 1024 * 2);
  p.outp = (bf16_t*)carve((size_t)8192 * 1024 * 2);
  p.lru_agg = (float*)carve((size_t)2 * 384 * 1024 * 2 * 4);
  p.lru_hin = (float*)carve((size_t)2 * 384 * 1024 * 4);
  p.lru_sagg = (float*)carve((size_t)2 * 1536 * 1024 * 2 * 4);
  p.bar = (unsigned*)carve((size_t)XCD_BAR_WORDS * 4);
  p.scratch = carve(SC_TOTAL);
  if (off > ws_size) return;

  static int grid_blocks = 0;
  if (!grid_blocks) {
    int dev = 0, cus = 0, per_cu = 0;
    hipGetDevice(&dev);
    hipDeviceGetAttribute(&cus, hipDeviceAttributeMultiprocessorCount, dev);
    hipOccupancyMaxActiveBlocksPerMultiprocessor(&per_cu, k_mega, WG_THREADS, 0);
    if (per_cu > 1) per_cu = 1;
    grid_blocks = cus * per_cu;
  }
  hipMemsetAsync(p.bar, 0, (size_t)XCD_BAR_WORDS * 4, stream);
  void* args[] = {&p};
  hipError_t e = hipLaunchCooperativeKernel((void*)k_mega, dim3(grid_blocks), dim3(WG_THREADS), args, 0, stream);
  if (e != hipSuccess) fprintf(stderr, "cooperative launch failed: %s (grid %d)\n", hipGetErrorString(e), grid_blocks);
}
```
